# Optimizing an MI355X kernel written in HIP

```python
import math
import jax, jax.numpy as jnp
from jax import lax
import numpy as np

D_MODEL = 1024
BATCH = 2
SEQ = 16384
DEPTH = 2

A_HEADS = 4
A_HEAD_DIM = 256
A_WIDTH = A_HEADS * A_HEAD_DIM
A_CHUNK = 64
CONV_WIDTH = 4
B_GROUPS = 4
B_GROUP_DIM = 256
B_WIDTH = B_GROUPS * B_GROUP_DIM
POOL_WINDOWS = (2, 4, 8, 16)
C_HEADS = 16
C_HEAD_DIM = 64
C_WIDTH = C_HEADS * C_HEAD_DIM
KV_RANK = 256
IDX_HEADS = 4
IDX_DIM = 64
TOP_K_MAX = 256
Q_BLOCK = 128
NUM_BUCKETS = 32
MAX_DISTANCE = 128
EPS = 1e-6

N_EVEN = (DEPTH + 1) // 2
N_ODD = DEPTH // 2
EVEN_SPLITS = (A_WIDTH, A_WIDTH, A_WIDTH, A_WIDTH, A_WIDTH, 2 * A_HEADS, B_WIDTH, B_WIDTH)
EVEN_IN = sum(EVEN_SPLITS)
ODD_SPLITS = (C_WIDTH, KV_RANK, IDX_HEADS * IDX_DIM, IDX_DIM, IDX_HEADS, C_WIDTH)
ODD_IN = sum(ODD_SPLITS)

kernel_name = 'hybrid_mlstm_pool_dsa_gated'


def _split(p, sizes):
    pts = [int(v) for v in np.cumsum(sizes)[:-1]]
    return jnp.split(p, pts, axis=-1)


def rmsnorm(x, g):
    xf = x.astype(jnp.float32)
    y = xf * lax.rsqrt(jnp.mean(xf * xf, axis=-1, keepdims=True) + EPS)
    return (y * g.astype(jnp.float32)).astype(x.dtype)


def causal_conv(u, w):
    n_taps = w.shape[0]
    s_len = u.shape[1]
    up = jnp.pad(u, ((0, 0), (n_taps - 1, 0), (0, 0)))
    out = w[0] * up[:, 0:s_len]
    for j in range(1, n_taps):
        out = out + w[j] * up[:, j:j + s_len]
    return out


def mlstm_chunkwise(q, k, v, i_pre, f_pre):
    bsz, s_len, nh, dh = q.shape
    nc = s_len // A_CHUNK
    f32 = jnp.float32

    def to_chunks(a):
        return a.astype(f32).reshape(bsz, nc, A_CHUNK, nh, -1).transpose(1, 0, 3, 2, 4)

    def gate_chunks(a):
        return a.astype(f32).reshape(bsz, nc, A_CHUNK, nh).transpose(1, 0, 3, 2)

    qc = to_chunks(q)
    kc = to_chunks(k) * (dh ** -0.5)
    vc = to_chunks(v)
    ic = gate_chunks(i_pre)
    fc = gate_chunks(f_pre)
    causal = jnp.tril(jnp.ones((A_CHUNK, A_CHUNK), dtype=bool))

    def step(carry, inp):
        c_mat, n_vec, m_prev = carry
        qb, kb, vb, ib, fb = inp
        b = jnp.cumsum(jax.nn.log_sigmoid(fb), axis=-1)
        dmat = jnp.where(causal, b[..., :, None] - b[..., None, :] + ib[..., None, :], -jnp.inf)
        inter = b + m_prev[..., None]
        m_t = jnp.maximum(inter, jnp.max(dmat, axis=-1))
        w = jnp.exp(dmat - m_t[..., None]) * jnp.einsum('bhtd,bhsd->bhts', qb, kb)
        a_inter = jnp.exp(inter - m_t)
        num = a_inter[..., None] * jnp.einsum('bhvk,bhtk->bhtv', c_mat, qb) + jnp.einsum('bhts,bhsv->bhtv', w, vb)
        nq = a_inter * jnp.einsum('bhk,bhtk->bht', n_vec, qb) + jnp.sum(w, axis=-1)
        den = jnp.maximum(jnp.abs(nq), jnp.exp(-m_t))
        h = num / den[..., None]
        b_last = b[..., -1]
        g = b_last[..., None] - b + ib
        m_new = jnp.maximum(b_last + m_prev, jnp.max(g, axis=-1))
        decay = jnp.exp(b_last + m_prev - m_new)
        sw = jnp.exp(g - m_new[..., None])
        c_new = decay[..., None, None] * c_mat + jnp.einsum('bhs,bhsv,bhsk->bhvk', sw, vb, kb)
        n_new = decay[..., None] * n_vec + jnp.einsum('bhs,bhsk->bhk', sw, kb)
        return (c_new, n_new, m_new), h

    init = (jnp.zeros((bsz, nh, dh, dh), f32), jnp.zeros((bsz, nh, dh), f32), jnp.zeros((bsz, nh), f32))
    _, hs = lax.scan(step, init, (qc, kc, vc, ic, fc))
    return hs.transpose(1, 0, 3, 2, 4).reshape(bsz, s_len, nh, dh)


def multiscale_pool(u):
    bsz, s_len, _ = u.shape
    uf = u.astype(jnp.float32)
    cs = jnp.concatenate([jnp.zeros((bsz, 1, B_WIDTH), jnp.float32), jnp.cumsum(uf, axis=1)], axis=1)
    pos = jnp.arange(s_len)
    outs = []
    for gi, win in enumerate(POOL_WINDOWS):
        sl = slice(gi * B_GROUP_DIM, (gi + 1) * B_GROUP_DIM)
        cg = cs[:, :, sl]
        hi = cg[:, 1:]
        lo = jnp.concatenate([jnp.zeros((bsz, win - 1, B_GROUP_DIM), jnp.float32), cg[:, :s_len - win + 1]], axis=1)
        cnt = jnp.minimum(pos + 1, win).astype(jnp.float32)
        outs.append((hi - lo) / cnt[None, :, None] - uf[:, :, sl])
    return jnp.stack(outs, axis=2)


def t5_bucket(rel):
    rel = jnp.maximum(rel, 0)
    max_exact = NUM_BUCKETS // 2
    rel_f = jnp.maximum(rel, 1).astype(jnp.float32)
    large = max_exact + (jnp.log(rel_f / max_exact) / math.log(MAX_DISTANCE / max_exact)
                         * (NUM_BUCKETS - max_exact)).astype(jnp.int32)
    large = jnp.minimum(large, NUM_BUCKETS - 1)
    return jnp.where(rel < max_exact, rel, large)


def even_layer(x, g_norm, w_in, conv_w, b_if, g_head, w_pool, s_pool, w_out):
    bsz, s_len, _ = x.shape
    xn = rmsnorm(x, g_norm)
    p = xn @ w_in
    q, k, v, o, z_a, gates, u, z_b = _split(p, EVEN_SPLITS)
    qk = jax.nn.silu(causal_conv(jnp.concatenate([q, k], axis=-1), conv_w))
    q, k = qk[..., :A_WIDTH], qk[..., A_WIDTH:]
    gates = gates + b_if
    i_pre, f_pre = gates[..., :A_HEADS], gates[..., A_HEADS:]
    hd = (bsz, s_len, A_HEADS, A_HEAD_DIM)
    h = mlstm_chunkwise(q.reshape(hd), k.reshape(hd), v.reshape(hd), i_pre, f_pre)
    h = jax.nn.sigmoid(o.astype(jnp.float32)).reshape(hd) * h
    h = rmsnorm(h, g_head).reshape(bsz, s_len, A_WIDTH).astype(x.dtype)
    y_a = h * jax.nn.silu(z_a)
    pooled = multiscale_pool(u).astype(x.dtype)
    y_b = jnp.einsum('bsgc,gcd->bsgd', pooled, w_pool).reshape(bsz, s_len, B_WIDTH)
    y_b = y_b * s_pool * jax.nn.silu(z_b)
    return x + jnp.concatenate([y_a, y_b], axis=-1) @ w_out


def odd_layer(x, g_norm, w_in, g_kv, w_uk, w_uv, g_q, g_k, w_out, rel_bias):
    bsz, s_len, _ = x.shape
    xn = rmsnorm(x, g_norm)
    p = xn @ w_in
    q, ckv, qi, ki, wi, z = _split(p, ODD_SPLITS)
    hd = (bsz, s_len, C_HEADS, C_HEAD_DIM)
    q = rmsnorm(q.reshape(hd), g_q)
    ckv = rmsnorm(ckv, g_kv)
    k = rmsnorm((ckv @ w_uk).reshape(hd), g_k)
    v = (ckv @ w_uv).reshape(hd)
    qi = qi.reshape(bsz, s_len, IDX_HEADS, IDX_DIM).astype(jnp.float32) * (IDX_DIM ** -0.5)
    ki = ki.astype(jnp.float32)
    wi = wi.astype(jnp.float32) * (IDX_HEADS ** -0.5)
    top_k = min(TOP_K_MAX, s_len // 4)
    n_blocks = s_len // Q_BLOCK
    key_pos = jnp.arange(s_len)

    def block(start):
        qb = lax.dynamic_slice_in_dim(q, start, Q_BLOCK, axis=1)
        qib = lax.dynamic_slice_in_dim(qi, start, Q_BLOCK, axis=1)
        wib = lax.dynamic_slice_in_dim(wi, start, Q_BLOCK, axis=1)
        t = start + jnp.arange(Q_BLOCK)
        score = jnp.einsum('bqh,bqhs->bqs', wib, jax.nn.relu(jnp.einsum('bqhd,bsd->bqhs', qib, ki)))
        score = jnp.where((key_pos[None, :] <= t[:, None])[None], score, -jnp.inf)
        _, idx = lax.top_k(score, top_k)
        valid = idx <= t[None, :, None]
        ksel = jax.vmap(lambda kk, ii: kk[ii])(k, idx)
        vsel = jax.vmap(lambda vv, ii: vv[ii])(v, idx)
        logits = jnp.einsum('bqhd,bqkhd->bqhk', qb, ksel).astype(jnp.float32) * (C_HEAD_DIM ** -0.5)
        bias = rel_bias[t5_bucket(t[None, :, None] - idx)].astype(jnp.float32)
        logits = logits + bias.transpose(0, 1, 3, 2)
        logits = jnp.where(valid[:, :, None, :], logits, -jnp.inf)
        probs = jax.nn.softmax(logits, axis=-1).astype(v.dtype)
        return jnp.einsum('bqhk,bqkhd->bqhd', probs, vsel)

    out = lax.map(block, jnp.arange(n_blocks) * Q_BLOCK)
    out = out.transpose(1, 0, 2, 3, 4).reshape(bsz, s_len, C_WIDTH)
    return x + (out * jax.nn.silu(z)) @ w_out


def setup_inputs(seed: int = 0) -> dict:
    key = jax.random.key(seed)
    ks = jax.random.split(key, 20)
    nrm = jax.random.normal
    f32 = jnp.float32
    b_i = 0.1 * nrm(ks[4], (N_EVEN, A_HEADS), f32)
    b_f = jnp.linspace(3.0, 6.0, A_HEADS, dtype=f32)[None] + 0.1 * nrm(ks[5], (N_EVEN, A_HEADS), f32)
    return {
        'x': nrm(ks[0], (BATCH, SEQ, D_MODEL), f32),
        'e_norm': 1.0 + 0.02 * nrm(ks[1], (N_EVEN, D_MODEL), f32),
        'e_w_in': nrm(ks[2], (N_EVEN, D_MODEL, EVEN_IN), f32) * D_MODEL ** -0.5,
        'e_conv': nrm(ks[3], (N_EVEN, CONV_WIDTH, 2 * A_WIDTH), f32) * CONV_WIDTH ** -0.5,
        'e_b_if': jnp.concatenate([b_i, b_f], axis=-1),
        'e_g_head': 1.0 + 0.02 * nrm(ks[6], (N_EVEN, A_HEADS, A_HEAD_DIM), f32),
        'e_w_pool': nrm(ks[7], (N_EVEN, B_GROUPS, B_GROUP_DIM, B_GROUP_DIM), f32) * B_GROUP_DIM ** -0.5,
        'e_s_pool': 1.0 + 0.02 * nrm(ks[8], (N_EVEN, B_WIDTH), f32),
        'e_w_out': nrm(ks[9], (N_EVEN, A_WIDTH + B_WIDTH, D_MODEL), f32) * (A_WIDTH + B_WIDTH) ** -0.5,
        'o_norm': 1.0 + 0.02 * nrm(ks[10], (N_ODD, D_MODEL), f32),
        'o_w_in': nrm(ks[11], (N_ODD, D_MODEL, ODD_IN), f32) * D_MODEL ** -0.5,
        'o_g_kv': 1.0 + 0.02 * nrm(ks[12], (N_ODD, KV_RANK), f32),
        'o_w_uk': nrm(ks[13], (N_ODD, KV_RANK, C_WIDTH), f32) * KV_RANK ** -0.5,
        'o_w_uv': nrm(ks[14], (N_ODD, KV_RANK, C_WIDTH), f32) * KV_RANK ** -0.5,
        'o_g_q': 1.0 + 0.02 * nrm(ks[15], (N_ODD, C_HEAD_DIM), f32),
        'o_g_k': 1.0 + 0.02 * nrm(ks[16], (N_ODD, C_HEAD_DIM), f32),
        'o_w_out': nrm(ks[17], (N_ODD, C_WIDTH, D_MODEL), f32) * C_WIDTH ** -0.5,
        'rel_bias': 0.5 * nrm(ks[18], (NUM_BUCKETS, C_HEADS), f32),
    }


def reference(x, e_norm, e_w_in, e_conv, e_b_if, e_g_head, e_w_pool, e_s_pool, e_w_out,
              o_norm, o_w_in, o_g_kv, o_w_uk, o_w_uv, o_g_q, o_g_k, o_w_out, rel_bias):
    h = x
    for layer in range(DEPTH):
        j = layer // 2
        if layer % 2 == 0:
            h = even_layer(h, e_norm[j], e_w_in[j], e_conv[j], e_b_if[j], e_g_head[j],
                           e_w_pool[j], e_s_pool[j], e_w_out[j])
        else:
            h = odd_layer(h, o_norm[j], o_w_in[j], o_g_kv[j], o_w_uk[j], o_w_uv[j],
                          o_g_q[j], o_g_k[j], o_w_out[j], rel_bias)
    return h
```

```cpp
#include <hip/hip_runtime.h>
#include <stdint.h>
#include <cstdio>

typedef unsigned short bf16_t;
typedef short bf16x8 __attribute__((ext_vector_type(8)));
typedef float f32x4 __attribute__((ext_vector_type(4)));
typedef unsigned u32x4 __attribute__((ext_vector_type(4)));
typedef unsigned u32x2 __attribute__((ext_vector_type(2)));
#define LAS __attribute__((address_space(3)))

constexpr int T = 32768, SEQ = 16384, DM = 1024;
constexpr int EIN = 7176, OIN = 2628;
constexpr float EPS = 1e-6f;
constexpr size_t MB = 1048576;
constexpr size_t OFF_CTL = 0;
constexpr size_t OFF_GATES = 64 * 1024;
constexpr size_t OFF_BQ = OFF_GATES + (size_t)T * 8 * 4;
constexpr size_t OFF_IQ = OFF_BQ + (size_t)T * 4 * 4;
constexpr size_t OFF_MT = OFF_IQ + (size_t)T * 4 * 4;
constexpr size_t OFF_WI = OFF_MT + (size_t)T * 4 * 4;
constexpr size_t OFF_CH = OFF_WI + (size_t)T * 4 * 4;
constexpr size_t OFF_W = 4 * MB;
constexpr size_t OFF_W0T = OFF_W;
constexpr size_t OFF_WPT = OFF_W0T + (size_t)7168 * 1024 * 2;
constexpr size_t OFF_WO0T = OFF_WPT + (size_t)4 * 256 * 256 * 2;
constexpr size_t OFF_W1T = OFF_WO0T + (size_t)1024 * 2048 * 2;
constexpr size_t OFF_WUKT = OFF_W1T + (size_t)2816 * 1024 * 2;
constexpr size_t OFF_WUVT = OFF_WUKT + (size_t)1024 * 256 * 2;
constexpr size_t OFF_WO1T = OFF_WUVT + (size_t)1024 * 256 * 2;
constexpr size_t OFF_XN = 36 * MB, OFF_QB = 100 * MB, OFF_KB = 164 * MB, OFF_VB = 228 * MB, OFF_TMP = 292 * MB, OFF_Y = 356 * MB;
constexpr size_t OFF_CKVR = OFF_Y;
constexpr size_t OFF_QI = OFF_Y + 32 * MB;
constexpr size_t OFF_KI = OFF_Y + 64 * MB;
constexpr size_t OFF_CKVN = OFF_Y + 72 * MB;
constexpr size_t OFF_IDX = OFF_Y + 88 * MB;
constexpr size_t OFF_CNT = OFF_Y + 120 * MB;
constexpr size_t WS_END = 484 * MB;
constexpr int LDS_BYTES = 147456;
constexpr int NPH = 16;

struct P {
    const float *x, *e_norm, *e_w_in, *e_conv, *e_b_if, *e_g_head, *e_w_pool, *e_s_pool, *e_w_out;
    const float *o_norm, *o_w_in, *o_g_kv, *o_w_uk, *o_w_uv, *o_g_q, *o_g_k, *o_w_out, *rel_bias;
    float* out; unsigned char* ws;
};

__device__ __forceinline__ bf16_t f2bf(float f) { unsigned u = __float_as_uint(f); u += 0x7FFFu + ((u >> 16) & 1u); return (bf16_t)(u >> 16); }
__device__ __forceinline__ float bf2f(bf16_t b) { return __uint_as_float(((unsigned)b) << 16); }
__device__ __forceinline__ float bflo(unsigned w) { return __uint_as_float(w << 16); }
__device__ __forceinline__ float bfhi(unsigned w) { return __uint_as_float(w & 0xffff0000u); }
__device__ __forceinline__ unsigned pk2(float a, float b) { return (unsigned)f2bf(a) | ((unsigned)f2bf(b) << 16); }
__device__ __forceinline__ float sigmoidf_(float x) { return 1.0f / (1.0f + __expf(-x)); }
__device__ __forceinline__ float siluf_(float x) { return x / (1.0f + __expf(-x)); }
__device__ __forceinline__ float wave_sum(float v) {
#pragma unroll
    for (int o = 32; o >= 1; o >>= 1) v += __shfl_xor(v, o);
    return v;
}
__device__ __forceinline__ float wave_max(float v) {
#pragma unroll
    for (int o = 32; o >= 1; o >>= 1) v = fmaxf(v, __shfl_xor(v, o));
    return v;
}

#define XB_TMO      128
#define XB_XCNT(j)  (256  + 64 * (j))
#define XB_XSUB(j)  (1280 + 64 * (j))
#define XB_XGEN(j)  (2304 + 64 * (j))
#define XB_TOP      3328
#define XB_TOPGEN   3392
#define XCD_BAR_WORDS 3456
#define XB_SPIN_CAP (1u << 22)
__device__ __forceinline__ unsigned xb_ld(unsigned* p)              { return __hip_atomic_load(p, __ATOMIC_RELAXED, __HIP_MEMORY_SCOPE_AGENT); }
__device__ __forceinline__ unsigned xb_add(unsigned* p, unsigned v) { return __hip_atomic_fetch_add(p, v, __ATOMIC_RELAXED, __HIP_MEMORY_SCOPE_AGENT); }
__device__ __forceinline__ unsigned xb_xcc_id() { return (unsigned)__builtin_amdgcn_s_getreg((3 << 11) | 20) & 0xFu; }
#define XB_SPIN(cond, bar) do { unsigned _sp = 0; while (cond) { __builtin_amdgcn_s_sleep(1); \
    if ((++_sp & 255u) == 0u) { if (xb_ld(&(bar)[XB_TMO])) break; if (_sp > XB_SPIN_CAP) { atomicAdd(&(bar)[XB_TMO], 1u); break; } } } } while (0)
struct XcdBarrier { unsigned* bar; unsigned x; volatile LAS unsigned* st; };
__device__ __forceinline__ XcdBarrier xcd_barrier_post(unsigned* bar, volatile LAS unsigned* st) {
    XcdBarrier b; b.bar = bar; b.x = xb_xcc_id(); b.st = st;
    if (threadIdx.x == 0) (void)xb_add(&bar[XB_XCNT(b.x)], 1u);
    return b;
}
__device__ __forceinline__ void xcd_barrier_complete(unsigned* bar, unsigned x, unsigned& nloc, unsigned& nx) {
    const unsigned G = gridDim.x * gridDim.y * gridDim.z;
    unsigned sum, cnt, mine, sp = 0u;
    for (;;) {
        sum = 0u; cnt = 0u; mine = 0u;
#pragma unroll
        for (unsigned j = 0; j < 16; ++j) { const unsigned c = xb_ld(&bar[XB_XCNT(j)]); sum += c; cnt += (c > 0u) ? 1u : 0u; mine = (j == x) ? c : mine; }
        if (sum == G) break;
        __builtin_amdgcn_s_sleep(1);
        if ((++sp & 255u) == 0u) { if (xb_ld(&bar[XB_TMO])) break; if (sp > XB_SPIN_CAP) { atomicAdd(&bar[XB_TMO], 1u); break; } }
    }
    nloc = mine > 0u ? mine : 1u; nx = cnt > 0u ? cnt : 1u;
}
__device__ __forceinline__ void xcd_barrier(const XcdBarrier& b) {
    asm volatile("s_waitcnt vmcnt(0)" ::: "memory");
    __syncthreads();
    if (threadIdx.x == 0) {
        unsigned* bar = b.bar;
        __builtin_amdgcn_s_waitcnt(0);
        unsigned nloc = b.st[0], nx = b.st[1];
        if (nloc == 0u) { xcd_barrier_complete(bar, b.x, nloc, nx); b.st[0] = nloc; b.st[1] = nx; }
        const unsigned old = xb_add(&bar[XB_XSUB(b.x)], 1u);
        const unsigned gen = old / nloc;
        if (old + 1u == (gen + 1u) * nloc) {
            __builtin_amdgcn_fence(__ATOMIC_RELEASE, "agent");
            asm volatile("s_waitcnt vmcnt(0)" ::: "memory");
            const unsigned og = xb_add(&bar[XB_TOP], 1u);
            const unsigned tg = og / nx;
            if (og + 1u == (tg + 1u) * nx) xb_add(&bar[XB_TOPGEN], 1u);
            else XB_SPIN(xb_ld(&bar[XB_TOPGEN]) == tg, bar);
            __builtin_amdgcn_fence(__ATOMIC_ACQUIRE, "agent");
            xb_add(&bar[XB_XGEN(b.x)], 1u);
            asm volatile("s_waitcnt vmcnt(0)" ::: "memory");
        } else {
            XB_SPIN(xb_ld(&bar[XB_XGEN(b.x)]) == gen, bar);
            __builtin_amdgcn_fence(__ATOMIC_ACQUIRE, "agent");
            asm volatile("s_waitcnt vmcnt(0)" ::: "memory");
        }
    }
    __syncthreads();
}

struct Tile { const bf16_t* A; const bf16_t* B; int lda, ldb, K; void* d0; const void* s0; int ld, mode; float aux0, aux1, aux2; int i0, i1; };
template <class F>
__device__ __forceinline__ void sgemm(const F f, int nunits) {
    const int lane = threadIdx.x & 63, wave = threadIdx.x >> 6, fr = lane & 15, fq = lane >> 4;
    for (int u = blockIdx.x * 8 + wave; u < nunits; u += gridDim.x * 8) {
        Tile tl; f.tile(u, tl);
        f32x4 acc[4][4];
#pragma unroll
        for (int m = 0; m < 4; ++m)
#pragma unroll
            for (int n = 0; n < 4; ++n) acc[m][n] = (f32x4){0.f, 0.f, 0.f, 0.f};
        const bf16_t* ap = tl.A + (size_t)fr * tl.lda + fq * 8;
        const bf16_t* bp = tl.B + (size_t)fr * tl.ldb + fq * 8;
        const int K = tl.K, lda = tl.lda, ldb = tl.ldb;
#pragma unroll 1
        for (int k0 = 0; k0 < K; k0 += 32) {
            bf16x8 a[4], b[4];
#pragma unroll
            for (int m = 0; m < 4; ++m) a[m] = *(const bf16x8*)(ap + (size_t)(m * 16) * lda + k0);
#pragma unroll
            for (int n = 0; n < 4; ++n) b[n] = *(const bf16x8*)(bp + (size_t)(n * 16) * ldb + k0);
#pragma unroll
            for (int m = 0; m < 4; ++m)
#pragma unroll
                for (int n = 0; n < 4; ++n) acc[m][n] = __builtin_amdgcn_mfma_f32_16x16x32_bf16(a[m], b[n], acc[m][n], 0, 0, 0);
        }
#pragma unroll
        for (int m = 0; m < 4; ++m)
#pragma unroll
            for (int j = 0; j < 4; ++j) {
                const int r = m * 16 + fq * 4 + j;
                asm volatile("" ::: "memory");
#pragma unroll
                for (int n = 0; n < 4; ++n) f.out(tl, r, n * 16 + fr, acc[m][n][j]);
            }
    }
}
__device__ __forceinline__ void store_mode(const Tile& tl, int r, int c, float v) {
    const size_t i = (size_t)r * tl.ld + c;
    if (tl.mode == 0) ((bf16_t*)tl.d0)[i] = f2bf(v);
    else if (tl.mode == 1) ((bf16_t*)tl.d0)[i] = f2bf(sigmoidf_(v));
    else if (tl.mode == 2) ((bf16_t*)tl.d0)[i] = f2bf(siluf_(v));
    else if (tl.mode == 3) ((float*)tl.d0)[i] = v * tl.aux0;
}

struct G1 {
    const bf16_t* XN; const bf16_t* W; bf16_t *Q, *K_, *V;
    __device__ __forceinline__ void tile(int u, Tile& tl) const {
        const int mt = u / 48, nt = u % 48; tl.A = XN + (size_t)mt * 64 * 1024; tl.lda = 1024; tl.B = W + (size_t)nt * 64 * 1024; tl.ldb = 1024; tl.K = 1024;
        const int col = nt * 64, sec = col >> 10, cc = col & 1023; bf16_t* d = Q + (size_t)sec * (32 * MB);
        tl.d0 = d + (size_t)mt * 64 * 1024 + cc; tl.ld = 1024; tl.mode = 0; }
    __device__ __forceinline__ void out(const Tile& tl, int r, int c, float v) const { store_mode(tl, r, c, v); }
};
struct G2 {
    const bf16_t* XN; const bf16_t* W; bf16_t *O, *ZA, *U, *Y;
    __device__ __forceinline__ void tile(int u, Tile& tl) const {
        const int mt = u / 64, nt = u % 64; tl.A = XN + (size_t)mt * 64 * 1024; tl.lda = 1024; tl.B = W + (size_t)(3072 + nt * 64) * 1024; tl.ldb = 1024; tl.K = 1024;
        const int col = nt * 64, sec = col >> 10, cc = col & 1023;
        if (sec == 0) { tl.d0 = O + (size_t)mt * 64 * 1024 + cc; tl.ld = 1024; tl.mode = 1; }
        else if (sec == 1) { tl.d0 = ZA + (size_t)mt * 64 * 1024 + cc; tl.ld = 1024; tl.mode = 2; }
        else if (sec == 2) { tl.d0 = U + (size_t)mt * 64 * 1024 + cc; tl.ld = 1024; tl.mode = 0; }
        else { tl.d0 = Y + (size_t)mt * 64 * 2048 + 1024 + cc; tl.ld = 2048; tl.mode = 2; } }
    __device__ __forceinline__ void out(const Tile& tl, int r, int c, float v) const { store_mode(tl, r, c, v); }
};
struct GM1 {
    const bf16_t* Y; const bf16_t* KT; const float *BQ, *IQ, *MT; float* W;
    __device__ __forceinline__ void tile(int u, Tile& tl) const {
        const int bh = u >> 8, c = u & 255, batch = bh >> 2, head = bh & 3; const size_t t0 = (size_t)batch * SEQ + c * 64;
        tl.A = Y + t0 * 2048 + 1024 + head * 256; tl.lda = 2048; tl.B = KT + t0 * 1024 + head * 256; tl.ldb = 1024; tl.K = 256;
        tl.d0 = W + (size_t)u * 4096; tl.ld = 64; tl.mode = 0; tl.i0 = (int)(t0 * 4 + head); }
    __device__ __forceinline__ void out(const Tile& tl, int r, int c, float v) const {
        float w = 0.f;
        if (c <= r) w = __expf(BQ[tl.i0 + r * 4] - BQ[tl.i0 + c * 4] + IQ[tl.i0 + c * 4] - MT[tl.i0 + r * 4]) * v;
        ((float*)tl.d0)[r * 64 + c] = w; }
};
struct G3 {
    const bf16_t* XN; const bf16_t* W; const float* sp; bf16_t* Y;
    __device__ __forceinline__ void tile(int u, Tile& tl) const {
        const int mt = u >> 4, g = (u >> 2) & 3, nt = u & 3; tl.A = XN + (size_t)mt * 64 * 1024 + g * 256; tl.lda = 1024; tl.B = W + (size_t)(g * 256 + nt * 64) * 256; tl.ldb = 256; tl.K = 256;
        const int col = g * 256 + nt * 64; tl.d0 = Y + (size_t)mt * 64 * 2048 + 1024 + col; tl.ld = 2048; tl.s0 = sp + col; tl.mode = 0; }
    __device__ __forceinline__ void out(const Tile& tl, int r, int c, float v) const {
        bf16_t* d = (bf16_t*)tl.d0 + (size_t)r * 2048 + c; *d = f2bf(v * ((const float*)tl.s0)[c] * bf2f(*d)); }
};
struct G4 {
    const bf16_t* Y; const bf16_t* W; const float* x; float* out_;
    __device__ __forceinline__ void tile(int u, Tile& tl) const {
        const int mt = u >> 4, nt = u & 15; tl.A = Y + (size_t)mt * 64 * 2048; tl.lda = 2048; tl.B = W + (size_t)nt * 64 * 2048; tl.ldb = 2048; tl.K = 2048;
        const size_t o = (size_t)mt * 64 * 1024 + nt * 64; tl.d0 = out_ + o; tl.s0 = x + o; tl.ld = 1024; tl.mode = 0; }
    __device__ __forceinline__ void out(const Tile& tl, int r, int c, float v) const { const size_t i = (size_t)r * 1024 + c; ((float*)tl.d0)[i] = ((const float*)tl.s0)[i] + v; }
};
struct G5 {
    const bf16_t* XN; const bf16_t* W; bf16_t* Q; float *CKVR, *QI, *KI; bf16_t* Z;
    __device__ __forceinline__ void tile(int u, Tile& tl) const {
        const int mt = u / 44, nt = u % 44; tl.A = XN + (size_t)mt * 64 * 1024; tl.lda = 1024; tl.B = W + (size_t)nt * 64 * 1024; tl.ldb = 1024; tl.K = 1024;
        const int col = nt * 64; const size_t row0 = (size_t)mt * 64; tl.aux0 = 1.0f;
        if (col < 1024) { tl.d0 = Q + row0 * 1024 + col; tl.ld = 1024; tl.mode = 0; }
        else if (col < 1280) { tl.d0 = CKVR + row0 * 256 + (col - 1024); tl.ld = 256; tl.mode = 3; }
        else if (col < 1536) { tl.d0 = QI + row0 * 256 + (col - 1280); tl.ld = 256; tl.mode = 3; tl.aux0 = 0.125f; }
        else if (col < 1600) { tl.d0 = KI + row0 * 64 + (col - 1536); tl.ld = 64; tl.mode = 3; }
        else if (col < 1792) { tl.d0 = nullptr; tl.ld = 0; tl.mode = 4; }
        else { tl.d0 = Z + row0 * 1024 + (col - 1792); tl.ld = 1024; tl.mode = 2; } }
    __device__ __forceinline__ void out(const Tile& tl, int r, int c, float v) const { store_mode(tl, r, c, v); }
};
struct G67 {
    const bf16_t* C; const bf16_t *WK, *WV; bf16_t *KF, *VF;
    __device__ __forceinline__ void tile(int u, Tile& tl) const {
        const int which = u >= 8192, uu = u & 8191, mt = uu >> 4, nt = uu & 15; tl.A = C + (size_t)mt * 64 * 256; tl.lda = 256; tl.B = WK + (size_t)which * (1024 * 256) + (size_t)nt * 64 * 256;     tl.ldb = 256; tl.K = 256;
        tl.d0 = KF + (size_t)which * (32 * MB) + (size_t)mt * 64 * 1024 + nt * 64;     tl.ld = 1024; tl.mode = 0; }
    __device__ __forceinline__ void out(const Tile& tl, int r, int c, float v) const { store_mode(tl, r, c, v); }
};
struct G8 {
    const bf16_t* G; const bf16_t* W; float* out_;
    __device__ __forceinline__ void tile(int u, Tile& tl) const {
        const int mt = u >> 4, nt = u & 15; tl.A = G + (size_t)mt * 64 * 1024; tl.lda = 1024; tl.B = W + (size_t)nt * 64 * 1024; tl.ldb = 1024; tl.K = 1024;
        tl.d0 = out_ + (size_t)mt * 64 * 1024 + nt * 64; tl.ld = 1024; tl.mode = 0; }
    __device__ __forceinline__ void out(const Tile& tl, int r, int c, float v) const { float* d = (float*)tl.d0 + (size_t)r * 1024 + c; *d = *d + v; }
};

__device__ __forceinline__ void tconv(const float* __restrict__ src, int ld, int col0, int ncols, int K, bf16_t* __restrict__ dst, float* tile  ) {
    const int nkt = K / 64, ntiles = nkt * (ncols / 64), tid = threadIdx.x;
    for (int id = blockIdx.x; id < ntiles; id += gridDim.x) {
        const int kt = id % nkt, nt = id / nkt;
#pragma unroll
        for (int j = 0; j < 8; ++j) { const int e = tid + 512 * j, kk = e >> 6, nn = e & 63; tile[kk * 65 + nn] = src[(size_t)(kt * 64 + kk) * ld + col0 + nt * 64 + nn]; }
        __syncthreads();
#pragma unroll
        for (int j = 0; j < 8; ++j) { const int e = tid + 512 * j, nn = e >> 6, kk = e & 63; dst[(size_t)(nt * 64 + nn) * K + kt * 64 + kk] = f2bf(tile[kk * 65 + nn]); }
        __syncthreads();
    }
}
template <int NE>
__device__ __forceinline__ void rmsnorm_rows(const float* __restrict__ src, const float* __restrict__ g, bf16_t* __restrict__ dst,
                             const float* __restrict__ Wx, int ldw, int col0, const float* __restrict__ bias, float scale, float* __restrict__ dstx) {
    const int lane = threadIdx.x & 63, wave = threadIdx.x >> 6;
    for (int row = blockIdx.x * 8 + wave; row < T; row += gridDim.x * 8) {
        f32x4 v[4]; float ss = 0.f;
#pragma unroll
        for (int i = 0; i < 4; ++i) { v[i] = *(const f32x4*)(src + (size_t)row * 1024 + i * 256 + lane * 4); ss += v[i][0] * v[i][0] + v[i][1] * v[i][1] + v[i][2] * v[i][2] + v[i][3] * v[i][3]; }
        ss = wave_sum(ss);
        const float rstd = rsqrtf(ss * (1.0f / 1024.0f) + EPS);
        float ex[NE];
#pragma unroll
        for (int e = 0; e < NE; ++e) ex[e] = 0.f;
#pragma unroll
        for (int i = 0; i < 4; ++i) {
            asm volatile("" ::: "memory");
            const f32x4 gg = *(const f32x4*)(g + i * 256 + lane * 4);
            f32x4 y; y[0] = v[i][0] * rstd * gg[0]; y[1] = v[i][1] * rstd * gg[1]; y[2] = v[i][2] * rstd * gg[2]; y[3] = v[i][3] * rstd * gg[3];
            u32x2 w; w.x = pk2(y[0], y[1]); w.y = pk2(y[2], y[3]);
            *(u32x2*)(dst + (size_t)row * 1024 + i * 256 + lane * 4) = w;
#pragma unroll
            for (int j = 0; j < 4; ++j) { const float* wr = Wx + (size_t)(i * 256 + lane * 4 + j) * ldw + col0;
#pragma unroll
                for (int e4 = 0; e4 < NE / 4; ++e4) { const f32x4 wv = *(const f32x4*)(wr + e4 * 4);
                    ex[e4 * 4 + 0] += y[j] * wv[0]; ex[e4 * 4 + 1] += y[j] * wv[1]; ex[e4 * 4 + 2] += y[j] * wv[2]; ex[e4 * 4 + 3] += y[j] * wv[3]; } }
        }
#pragma unroll
        for (int e = 0; e < NE; ++e) { const float s = wave_sum(ex[e]); if (lane == 0) dstx[(size_t)row * NE + e] = (s + (bias ? bias[e] : 0.f)) * scale; }
    }
}

__device__ __forceinline__ void phase_prep(const P& p, unsigned char* lds) {
    float* tile = (float*)lds; unsigned char* ws = p.ws;
    bf16_t* W0T = (bf16_t*)(ws + OFF_W0T);
    tconv(p.e_w_in, EIN, 0, 5120, 1024, W0T, tile);
    tconv(p.e_w_in, EIN, 5128, 2048, 1024, W0T + (size_t)5120 * 1024, tile);
    for (int g = 0; g < 4; ++g) tconv(p.e_w_pool + (size_t)g * 65536, 256, 0, 256, 256, (bf16_t*)(ws + OFF_WPT) + (size_t)g * 65536, tile);
    tconv(p.e_w_out, 1024, 0, 1024, 2048, (bf16_t*)(ws + OFF_WO0T), tile);
    bf16_t* W1T = (bf16_t*)(ws + OFF_W1T);
    tconv(p.o_w_in, OIN, 0, 1600, 1024, W1T, tile);
    for (size_t i = (size_t)blockIdx.x * 512 + threadIdx.x; i < (size_t)192 * 1024; i += (size_t)gridDim.x * 512) W1T[(size_t)1600 * 1024 + i] = 0;
    tconv(p.o_w_in, OIN, 1604, 1024, 1024, W1T + (size_t)1792 * 1024, tile);
    tconv(p.o_w_uk, 1024, 0, 1024, 256, (bf16_t*)(ws + OFF_WUKT), tile);
    tconv(p.o_w_uv, 1024, 0, 1024, 256, (bf16_t*)(ws + OFF_WUVT), tile);
    tconv(p.o_w_out, 1024, 0, 1024, 1024, (bf16_t*)(ws + OFF_WO1T), tile);
    rmsnorm_rows<8>(p.x, p.e_norm, (bf16_t*)(ws + OFF_XN), p.e_w_in, EIN, 5120, p.e_b_if, 1.0f, (float*)(ws + OFF_GATES));
}

__device__ __forceinline__ void phase_conv_scan(const P& p, unsigned char* lds) {
    unsigned char* ws = p.ws; const int tid = threadIdx.x;
    const float* GATES = (const float*)(ws + OFF_GATES);
    float *BQ = (float*)(ws + OFF_BQ), *IQ = (float*)(ws + OFF_IQ), *MT = (float*)(ws + OFF_MT), *CH = (float*)(ws + OFF_CH);
    for (int bh = blockIdx.x; bh < 8; bh += gridDim.x) {
        float* sB = (float*)lds; float* sG = sB + 256; float* sMp = sG + 256; float* sMn = sMp + 256;
        const int batch = bh >> 2, head = bh & 3;
        if (tid < 256) {
            const size_t t0 = (size_t)batch * SEQ + tid * 64; float b = 0.f, rmax = -INFINITY;
            for (int s = 0; s < 64; ++s) { const size_t t = t0 + s; const float ig = GATES[t * 8 + head], f = GATES[t * 8 + 4 + head];
                const float ls = fminf(f, 0.f) - log1pf(__expf(-fabsf(f)));
                b += ls; BQ[t * 4 + head] = b; IQ[t * 4 + head] = ig; rmax = fmaxf(rmax, ig - b); MT[t * 4 + head] = rmax; }
            sB[tid] = b; sG[tid] = b + rmax;
        }
        __syncthreads();
        if (tid == 0) { float m = 0.f; for (int c = 0; c < 256; ++c) { sMp[c] = m; m = fmaxf(sB[c] + m, sG[c]); sMn[c] = m; } }
        __syncthreads();
        if (tid < 256) {
            const float mp = sMp[tid]; CH[bh * 256 + tid] = mp; CH[2048 + bh * 256 + tid] = sMn[tid]; CH[4096 + bh * 256 + tid] = sB[tid];
            const size_t t0 = (size_t)batch * SEQ + tid * 64;
            for (int s = 0; s < 64; ++s) { const size_t t = t0 + s; MT[t * 4 + head] = BQ[t * 4 + head] + fmaxf(mp, MT[t * 4 + head]); }
        }
        __syncthreads();
    }
    const bf16_t* QB = (const bf16_t*)(ws + OFF_QB); const bf16_t* KB = (const bf16_t*)(ws + OFF_KB);
    bf16_t* Y = (bf16_t*)(ws + OFF_Y); bf16_t* KT = (bf16_t*)(ws + OFF_TMP);
    for (size_t it = (size_t)blockIdx.x * 512 + tid; it < (size_t)T * 256; it += (size_t)gridDim.x * 512) {
        const size_t t = it >> 8; const int c0 = (int)(it & 255) * 8, isk = c0 >= 1024, cc = c0 & 1023; const int s = (int)(t & (SEQ - 1));
        const bf16_t* src = isk ? KB : QB;
        float acc[8];
#pragma unroll
        for (int i = 0; i < 8; ++i) acc[i] = 0.f;
#pragma unroll
        for (int j = 0; j < 4; ++j) {
            if (s - 3 + j >= 0) {
                const u32x4 w = *(const u32x4*)(src + (t - 3 + j) * 1024 + cc);
                const f32x4 c0v = *(const f32x4*)(p.e_conv + j * 2048 + c0), c1v = *(const f32x4*)(p.e_conv + j * 2048 + c0 + 4);
                acc[0] += c0v[0] * bflo(w.x); acc[1] += c0v[1] * bfhi(w.x); acc[2] += c0v[2] * bflo(w.y); acc[3] += c0v[3] * bfhi(w.y);
                acc[4] += c1v[0] * bflo(w.z); acc[5] += c1v[1] * bfhi(w.z); acc[6] += c1v[2] * bflo(w.w); acc[7] += c1v[3] * bfhi(w.w);
            }
        }
        const float sc = isk ? 0.0625f : 1.0f;
        u32x4 o; o.x = pk2(siluf_(acc[0]) * sc, siluf_(acc[1]) * sc); o.y = pk2(siluf_(acc[2]) * sc, siluf_(acc[3]) * sc);
        o.z = pk2(siluf_(acc[4]) * sc, siluf_(acc[5]) * sc); o.w = pk2(siluf_(acc[6]) * sc, siluf_(acc[7]) * sc);
        if (isk) *(u32x4*)(KT + t * 1024 + cc) = o; else *(u32x4*)(Y + t * 2048 + 1024 + cc) = o;
    }
}

__device__ __forceinline__ void phase_mlstm_seq(const P& p, unsigned char* lds) {
    unsigned char* ws = p.ws; const int tid = threadIdx.x, lane = tid & 63;
    const bf16_t* Yc = (const bf16_t*)(ws + OFF_Y); bf16_t* Y = (bf16_t*)(ws + OFF_Y);
    const bf16_t* KT = (const bf16_t*)(ws + OFF_TMP); const bf16_t* VB = (const bf16_t*)(ws + OFF_VB);
    const float* Wg = (const float*)(ws + OFF_QB);
    const float *BQ = (const float*)(ws + OFF_BQ), *IQ = (const float*)(ws + OFF_IQ), *MT = (const float*)(ws + OFF_MT), *CH = (const float*)(ws + OFF_CH);
    bf16_t* Qs = (bf16_t*)lds;
    bf16_t* Ks = Qs + 64 * 264;
    float* Ws = (float*)(Ks + 64 * 264);
    float* Vs = Ws + 64 * 65;
    float* Cs = Vs + 64 * 8;
    float* ns = Cs + 8 * 260;
    float* sa = ns + 256;
    float* sden = sa + 64;
    float* ssw = sden + 64;
    for (int wu = blockIdx.x; wu < 256; wu += gridDim.x) {
        const int bh = wu >> 5, vs = wu & 31, batch = bh >> 2, head = bh & 3;
        float c[4] = {0.f, 0.f, 0.f, 0.f}; float nreg = 0.f;
        const int uv = tid >> 6;
        const int ot = tid >> 3, ov = tid & 7;
        for (int ch = 0; ch < 256; ++ch) {
            const size_t t0 = (size_t)batch * SEQ + ch * 64;
            const float mprev = CH[bh * 256 + ch], mnew = CH[2048 + bh * 256 + ch], blast = CH[4096 + bh * 256 + ch];
            const float decay = __expf(blast + mprev - mnew);
            __syncthreads();
#pragma unroll
            for (int j = 0; j < 4; ++j) { const int e = tid + 512 * j, r = e >> 5, cg = e & 31;
                *(u32x4*)(Qs + r * 264 + cg * 8) = *(const u32x4*)(Yc + (t0 + r) * 2048 + 1024 + head * 256 + cg * 8);
                *(u32x4*)(Ks + r * 264 + cg * 8) = *(const u32x4*)(KT + (t0 + r) * 1024 + head * 256 + cg * 8); }
#pragma unroll
            for (int j = 0; j < 8; ++j) { const int e = tid + 512 * j, r = e >> 6, cc = e & 63; Ws[r * 65 + cc] = Wg[((size_t)(bh * 256 + ch)) * 4096 + e]; }
            if (tid < 64) { const u32x4 w = *(const u32x4*)(VB + (t0 + tid) * 1024 + head * 256 + vs * 8);
                float* d = Vs + tid * 8; d[0] = bflo(w.x); d[1] = bfhi(w.x); d[2] = bflo(w.y); d[3] = bfhi(w.y); d[4] = bflo(w.z); d[5] = bfhi(w.z); d[6] = bflo(w.w); d[7] = bfhi(w.w);
                const float bq = BQ[(t0 + tid) * 4 + head], iq = IQ[(t0 + tid) * 4 + head], mt = MT[(t0 + tid) * 4 + head];
                sa[tid] = __expf(bq + mprev - mt); sden[tid] = __expf(-mt); ssw[tid] = __expf(blast - bq + iq - mnew); }
#pragma unroll
            for (int j = 0; j < 4; ++j) Cs[uv * 260 + lane + 64 * j] = c[j];
            if (tid < 256) ns[tid] = nreg;
            __syncthreads();
            {
                float inter = 0.f, ndot = 0.f, intra = 0.f, rsum = 0.f;
                const bf16_t* qr = Qs + ot * 264; const float* cr = Cs + ov * 260;
#pragma unroll 8
                for (int k = 0; k < 256; ++k) inter += cr[k] * bf2f(qr[k]);
#pragma unroll 8
                for (int k = 0; k < 32; ++k) ndot += ns[ov * 32 + k] * bf2f(qr[ov * 32 + k]);
                ndot += __shfl_xor(ndot, 1); ndot += __shfl_xor(ndot, 2); ndot += __shfl_xor(ndot, 4);
#pragma unroll 8
                for (int s = 0; s < 64; ++s) { const float w = Ws[ot * 65 + s]; intra += w * Vs[s * 8 + ov]; rsum += w; }
                const float a = sa[ot]; const float nq = a * ndot + rsum; const float den = fmaxf(fabsf(nq), sden[ot]);
                const float h = (a * inter + intra) / den;
                Y[(t0 + ot) * 2048 + head * 256 + vs * 8 + ov] = f2bf(h);
            }
            {
                float acc[4] = {0.f, 0.f, 0.f, 0.f}; float nacc = 0.f;
                for (int s = 0; s < 64; ++s) { const float sv = ssw[s] * Vs[s * 8 + uv]; const bf16_t* kr = Ks + s * 264 + lane;
#pragma unroll
                    for (int j = 0; j < 4; ++j) acc[j] += sv * bf2f(kr[64 * j]); }
#pragma unroll
                for (int j = 0; j < 4; ++j) c[j] = decay * c[j] + acc[j];
                if (tid < 256) { for (int s = 0; s < 64; ++s) nacc += ssw[s] * bf2f(Ks[s * 264 + tid]); nreg = decay * nreg + nacc; }
            }
        }
        __syncthreads();
    }
}

__device__ __forceinline__ void phase_ya_pool(const P& p) {
    unsigned char* ws = p.ws; const int tid = threadIdx.x, lane = tid & 63, wave = tid >> 6;
    bf16_t* Y = (bf16_t*)(ws + OFF_Y); const bf16_t* O = (const bf16_t*)(ws + OFF_QB); const bf16_t* ZA = (const bf16_t*)(ws + OFF_KB);
    for (int it = blockIdx.x * 8 + wave; it < T * 4; it += gridDim.x * 8) {
        const size_t t = (size_t)(it >> 2); const int head = it & 3, c = head * 256 + lane * 4;
        const u32x2 hw = *(const u32x2*)(Y + t * 2048 + c), ow = *(const u32x2*)(O + t * 1024 + c), zw = *(const u32x2*)(ZA + t * 1024 + c);
        float v[4] = {bflo(hw.x) * bflo(ow.x), bfhi(hw.x) * bfhi(ow.x), bflo(hw.y) * bflo(ow.y), bfhi(hw.y) * bfhi(ow.y)};
        float ss = wave_sum(v[0] * v[0] + v[1] * v[1] + v[2] * v[2] + v[3] * v[3]);
        const float rstd = rsqrtf(ss * (1.0f / 256.0f) + EPS);
        const f32x4 g = *(const f32x4*)(p.e_g_head + c);
        u32x2 o; o.x = pk2(v[0] * rstd * g[0] * bflo(zw.x), v[1] * rstd * g[1] * bfhi(zw.x)); o.y = pk2(v[2] * rstd * g[2] * bflo(zw.y), v[3] * rstd * g[3] * bfhi(zw.y));
        *(u32x2*)(Y + t * 2048 + c) = o;
    }
    const bf16_t* U = (const bf16_t*)(ws + OFF_VB); bf16_t* PO = (bf16_t*)(ws + OFF_XN);
    for (size_t it = (size_t)blockIdx.x * 512 + tid; it < (size_t)T * 128; it += (size_t)gridDim.x * 512) {
        const size_t t = it >> 7; const int c0 = (int)(it & 127) * 8, g = c0 >> 8, win = 2 << g, s = (int)(t & (SEQ - 1)); const int cnt = (s + 1 < win) ? s + 1 : win;
        float acc[8], self[8];
#pragma unroll
        for (int i = 0; i < 8; ++i) acc[i] = 0.f;
        for (int j = 0; j < cnt; ++j) { const u32x4 w = *(const u32x4*)(U + (t - j) * 1024 + c0);
            const float f[8] = {bflo(w.x), bfhi(w.x), bflo(w.y), bfhi(w.y), bflo(w.z), bfhi(w.z), bflo(w.w), bfhi(w.w)};
#pragma unroll
            for (int i = 0; i < 8; ++i) { acc[i] += f[i]; if (j == 0) self[i] = f[i]; } }
        const float inv = 1.0f / (float)cnt;
        u32x4 o; o.x = pk2(acc[0] * inv - self[0], acc[1] * inv - self[1]); o.y = pk2(acc[2] * inv - self[2], acc[3] * inv - self[3]);
        o.z = pk2(acc[4] * inv - self[4], acc[5] * inv - self[5]); o.w = pk2(acc[6] * inv - self[6], acc[7] * inv - self[7]);
        *(u32x4*)(PO + t * 1024 + c0) = o;
    }
}

__device__ __forceinline__ void headnorm64(bf16_t* X, const float* g) {
    const int lane = threadIdx.x & 63, wave = threadIdx.x >> 6;
    for (int t = blockIdx.x * 8 + wave; t < T; t += gridDim.x * 8) {
        bf16_t* r = X + (size_t)t * 1024 + lane * 16;
        const u32x4 a = *(const u32x4*)r, b = *(const u32x4*)(r + 8);
        float f[16] = {bflo(a.x), bfhi(a.x), bflo(a.y), bfhi(a.y), bflo(a.z), bfhi(a.z), bflo(a.w), bfhi(a.w), bflo(b.x), bfhi(b.x), bflo(b.y), bfhi(b.y), bflo(b.z), bfhi(b.z), bflo(b.w), bfhi(b.w)};
        float ss = 0.f;
#pragma unroll
        for (int i = 0; i < 16; ++i) ss += f[i] * f[i];
        ss += __shfl_xor(ss, 1); ss += __shfl_xor(ss, 2);
        const float rstd = rsqrtf(ss * (1.0f / 64.0f) + EPS);
        const float* gg = g + (lane & 3) * 16;
#pragma unroll
        for (int i = 0; i < 16; ++i) f[i] = f[i] * rstd * gg[i];
        u32x4 oa, ob; oa.x = pk2(f[0], f[1]); oa.y = pk2(f[2], f[3]); oa.z = pk2(f[4], f[5]); oa.w = pk2(f[6], f[7]);
        ob.x = pk2(f[8], f[9]); ob.y = pk2(f[10], f[11]); ob.z = pk2(f[12], f[13]); ob.w = pk2(f[14], f[15]);
        *(u32x4*)r = oa; *(u32x4*)(r + 8) = ob;
    }
}
__device__ __forceinline__ void phase_qnorm_ckvnorm(const P& p) {
    unsigned char* ws = p.ws; const int lane = threadIdx.x & 63, wave = threadIdx.x >> 6;
    headnorm64((bf16_t*)(ws + OFF_QB), p.o_g_q);
    const float* CKVR = (const float*)(ws + OFF_CKVR); bf16_t* CKVN = (bf16_t*)(ws + OFF_CKVN);
    for (int t = blockIdx.x * 8 + wave; t < T; t += gridDim.x * 8) {
        const f32x4 v = *(const f32x4*)(CKVR + (size_t)t * 256 + lane * 4);
        const float ss = wave_sum(v[0] * v[0] + v[1] * v[1] + v[2] * v[2] + v[3] * v[3]);
        const float rstd = rsqrtf(ss * (1.0f / 256.0f) + EPS);
        const f32x4 g = *(const f32x4*)(p.o_g_kv + lane * 4);
        u32x2 o; o.x = pk2(v[0] * rstd * g[0], v[1] * rstd * g[1]); o.y = pk2(v[2] * rstd * g[2], v[3] * rstd * g[3]);
        *(u32x2*)(CKVN + (size_t)t * 256 + lane * 4) = o;
    }
}

__device__ __forceinline__ unsigned okey(float s) { if (s == 0.f) s = 0.f; const unsigned u = __float_as_uint(s); return (u & 0x80000000u) ? ~u : (u | 0x80000000u); }

__device__ __forceinline__ void phase_indexer(const P& p, unsigned char* lds) {
    unsigned char* ws = p.ws; const int tid = threadIdx.x, lane = tid & 63, wave = tid >> 6;
    const float* QI = (const float*)(ws + OFF_QI); const float* KI = (const float*)(ws + OFF_KI); const float* WI = (const float*)(ws + OFF_WI);
    int* IDX = (int*)(ws + OFF_IDX); int* CNT = (int*)(ws + OFF_CNT);
    unsigned* sc = (unsigned*)lds;
    unsigned* hist = sc + 16384;
    float* qs = (float*)(hist + 256);
    unsigned* misc = (unsigned*)(qs + 256);
    unsigned* wsum = misc + 16;
    const int G = gridDim.x, nround = T / G;
    for (int i = 0; i < nround; ++i) {
        const int tq = (i & 1) ? i * G + (G - 1 - (int)blockIdx.x) : i * G + (int)blockIdx.x;
        const int batch = tq & 1, pos = tq >> 1; const size_t t = (size_t)batch * SEQ + pos; const int n = pos + 1;
        if (n <= 256) { if (tid < 256) IDX[t * 256 + tid] = tid < n ? tid : 0; if (tid == 0) CNT[t] = n; continue; }
        __syncthreads();
        if (tid < 256) qs[tid] = QI[t * 256 + tid];
        const float w0 = WI[t * 4 + 0], w1 = WI[t * 4 + 1], w2 = WI[t * 4 + 2], w3 = WI[t * 4 + 3];
        __syncthreads();
        const float* kbase = KI + (size_t)batch * SEQ * 64;
        for (int s = tid; s < n; s += 512) {
            asm volatile("" ::: "memory");
            const f32x4* kr = (const f32x4*)(kbase + (size_t)s * 64);
            float d0 = 0.f, d1 = 0.f, d2 = 0.f, d3 = 0.f;
#pragma unroll
            for (int j = 0; j < 16; ++j) { const f32x4 kv = kr[j];
#pragma unroll
                for (int e = 0; e < 4; ++e) { const int d = j * 4 + e; d0 += qs[d] * kv[e]; d1 += qs[64 + d] * kv[e]; d2 += qs[128 + d] * kv[e]; d3 += qs[192 + d] * kv[e]; } }
            float score = w0 * fmaxf(d0, 0.f); score += w1 * fmaxf(d1, 0.f); score += w2 * fmaxf(d2, 0.f); score += w3 * fmaxf(d3, 0.f);
            sc[s] = okey(score);
        }
        unsigned prefix = 0, krem = 256;
        for (int pass = 0; pass < 4; ++pass) {
            const int shift = 24 - 8 * pass;
            __syncthreads();
            if (tid < 256) hist[tid] = 0;
            __syncthreads();
            for (int s = tid; s < n; s += 512) { const unsigned k = sc[s]; if (pass == 0 || (k >> (shift + 8)) == prefix) atomicAdd(&hist[(k >> shift) & 255u], 1u); }
            __syncthreads();
            if (tid == 0) { unsigned cum = 0; int bin = 255; for (; bin > 0; --bin) { const unsigned c = hist[bin]; if (cum + c >= krem) break; cum += c; } misc[0] = (unsigned)bin; misc[1] = krem - cum; }
            __syncthreads();
            prefix = (prefix << 8) | misc[0]; krem = misc[1];
        }
        const unsigned ngt_total = 256u - krem;
        unsigned lg = 0, le = 0; const int s0 = tid * 32;
        for (int s = s0; s < s0 + 32 && s < n; ++s) { const unsigned k = sc[s]; lg += (k > prefix); le += (k == prefix); }
        unsigned pk = lg | (le << 16), incl = pk;
#pragma unroll
        for (int o = 1; o < 64; o <<= 1) { const unsigned y = __shfl_up(incl, o); if (lane >= o) incl += y; }
        if (lane == 63) wsum[wave] = incl;
        __syncthreads();
        unsigned base = 0;
        for (int w = 0; w < wave; ++w) base += wsum[w];
        const unsigned excl = base + incl - pk; unsigned bg = excl & 0xffffu, be = excl >> 16;
        for (int s = s0; s < s0 + 32 && s < n; ++s) { const unsigned k = sc[s];
            if (k > prefix) { IDX[t * 256 + bg] = s; ++bg; }
            else if (k == prefix) { if (be < krem) IDX[t * 256 + ngt_total + be] = s; ++be; } }
        if (tid == 0) CNT[t] = 256;
    }
}

__device__ __forceinline__ void phase_attn(const P& p, unsigned char* lds) {
    unsigned char* ws = p.ws; const int tid = threadIdx.x, lane = tid & 63, wave = tid >> 6;
    const bf16_t* Q = (const bf16_t*)(ws + OFF_QB); const bf16_t* Kf = (const bf16_t*)(ws + OFF_VB); const bf16_t* Vf = (const bf16_t*)(ws + OFF_TMP);
    const bf16_t* Z = (const bf16_t*)(ws + OFF_KB); bf16_t* Gout = (bf16_t*)(ws + OFF_XN);
    const int* IDX = (const int*)(ws + OFF_IDX); const int* CNT = (const int*)(ws + OFF_CNT);
    float* Pw = (float*)(lds + (size_t)wave * 17408);
    int* Iw = (int*)(Pw + 4096);
    for (int t = blockIdx.x * 8 + wave; t < T; t += gridDim.x * 8) {
        const int batch = t >> 14, pos = t & (SEQ - 1); const int cnt = CNT[t];
        const size_t rb = (size_t)batch * SEQ;
        for (int jj = 0; jj < 4; ++jj) {
            const int j = lane + 64 * jj; const int id = IDX[(size_t)t * 256 + j]; Iw[j] = id;
            if (j < cnt) {
                const int rel = pos - id; int bucket;
                if (rel < 16) bucket = rel; else { bucket = 16 + (int)(__logf((float)rel * 0.0625f) / 2.0794415416798357f * 16.0f); bucket = bucket > 31 ? 31 : bucket; }
                const bf16_t* kr = Kf + (rb + id) * 1024; const bf16_t* qr = Q + (size_t)t * 1024;
                for (int h = 0; h < 16; ++h) {
                    float d = 0.f;
#pragma unroll
                    for (int e = 0; e < 8; ++e) { const u32x4 kw = *(const u32x4*)(kr + h * 64 + e * 8), qw = *(const u32x4*)(qr + h * 64 + e * 8);
                        d += bflo(kw.x) * bflo(qw.x) + bfhi(kw.x) * bfhi(qw.x) + bflo(kw.y) * bflo(qw.y) + bfhi(kw.y) * bfhi(qw.y)
                           + bflo(kw.z) * bflo(qw.z) + bfhi(kw.z) * bfhi(qw.z) + bflo(kw.w) * bflo(qw.w) + bfhi(kw.w) * bfhi(qw.w); }
                    Pw[h * 256 + j] = d * 0.125f + p.rel_bias[bucket * 16 + h];
                }
            } else {
                for (int h = 0; h < 16; ++h) Pw[h * 256 + j] = -INFINITY;
            }
        }
        for (int h = 0; h < 16; ++h) {
            float l0 = Pw[h * 256 + lane], l1 = Pw[h * 256 + lane + 64], l2 = Pw[h * 256 + lane + 128], l3 = Pw[h * 256 + lane + 192];
            float m = fmaxf(fmaxf(l0, l1), fmaxf(l2, l3)); m = wave_max(m);
            l0 = __expf(l0 - m); l1 = __expf(l1 - m); l2 = __expf(l2 - m); l3 = __expf(l3 - m);
            const float s = wave_sum(l0 + l1 + l2 + l3); const float inv = 1.0f / s;
            Pw[h * 256 + lane] = l0 * inv; Pw[h * 256 + lane + 64] = l1 * inv; Pw[h * 256 + lane + 128] = l2 * inv; Pw[h * 256 + lane + 192] = l3 * inv;
        }
        __builtin_amdgcn_fence(__ATOMIC_RELEASE, "workgroup"); __builtin_amdgcn_wave_barrier(); __builtin_amdgcn_fence(__ATOMIC_ACQUIRE, "workgroup");
        float acc[16];
#pragma unroll
        for (int i = 0; i < 16; ++i) acc[i] = 0.f;
        const int hl = lane >> 2;
        for (int j = 0; j < cnt; ++j) {
            const int id = Iw[j]; const float pj = Pw[hl * 256 + j];
            const bf16_t* vr = Vf + (rb + id) * 1024 + lane * 16;
            const u32x4 a = *(const u32x4*)vr, b = *(const u32x4*)(vr + 8);
            acc[0] += pj * bflo(a.x); acc[1] += pj * bfhi(a.x); acc[2] += pj * bflo(a.y); acc[3] += pj * bfhi(a.y);
            acc[4] += pj * bflo(a.z); acc[5] += pj * bfhi(a.z); acc[6] += pj * bflo(a.w); acc[7] += pj * bfhi(a.w);
            acc[8] += pj * bflo(b.x); acc[9] += pj * bfhi(b.x); acc[10] += pj * bflo(b.y); acc[11] += pj * bfhi(b.y);
            acc[12] += pj * bflo(b.z); acc[13] += pj * bfhi(b.z); acc[14] += pj * bflo(b.w); acc[15] += pj * bfhi(b.w);
        }
        const bf16_t* zr = Z + (size_t)t * 1024 + lane * 16;
        const u32x4 za = *(const u32x4*)zr, zb = *(const u32x4*)(zr + 8);
        u32x4 oa, ob;
        oa.x = pk2(acc[0] * bflo(za.x), acc[1] * bfhi(za.x)); oa.y = pk2(acc[2] * bflo(za.y), acc[3] * bfhi(za.y));
        oa.z = pk2(acc[4] * bflo(za.z), acc[5] * bfhi(za.z)); oa.w = pk2(acc[6] * bflo(za.w), acc[7] * bfhi(za.w));
        ob.x = pk2(acc[8] * bflo(zb.x), acc[9] * bfhi(zb.x)); ob.y = pk2(acc[10] * bflo(zb.y), acc[11] * bfhi(zb.y));
        ob.z = pk2(acc[12] * bflo(zb.z), acc[13] * bfhi(zb.z)); ob.w = pk2(acc[14] * bflo(zb.w), acc[15] * bfhi(zb.w));
        bf16_t* go = Gout + (size_t)t * 1024 + lane * 16;
        *(u32x4*)go = oa; *(u32x4*)(go + 8) = ob;
        __builtin_amdgcn_fence(__ATOMIC_RELEASE, "workgroup"); __builtin_amdgcn_wave_barrier(); __builtin_amdgcn_fence(__ATOMIC_ACQUIRE, "workgroup");
    }
}

__global__ void __launch_bounds__(512, 2) k_fwd(P p, int ph_lo, int ph_hi) {
    extern __shared__ __attribute__((aligned(16))) unsigned char smem[];
    unsigned char* lds = smem + 16;
    unsigned char* ws = p.ws;
    XcdBarrier bar;
    const bool multi = (ph_hi - ph_lo) > 1;
    if (multi) {
        if (threadIdx.x == 0) *(uint4*)smem = make_uint4(0u, 0u, 0u, 0u);
        __syncthreads();
        bar = xcd_barrier_post((unsigned*)(ws + OFF_CTL), (volatile LAS unsigned*)smem);
    }
#define PH(i) (ph_lo <= (i) && (i) < ph_hi)
#define SEAM(i) do { if ((i) + 1 < ph_hi) xcd_barrier(bar); else __syncthreads(); } while (0)
    bf16_t *XN = (bf16_t*)(ws + OFF_XN), *QB = (bf16_t*)(ws + OFF_QB), *KB = (bf16_t*)(ws + OFF_KB), *VB = (bf16_t*)(ws + OFF_VB), *TMP = (bf16_t*)(ws + OFF_TMP), *Y = (bf16_t*)(ws + OFF_Y);
    if (PH(0)) { phase_prep(p, lds); SEAM(0); }
    if (PH(1)) { G1 f{XN, (const bf16_t*)(ws + OFF_W0T), QB, KB, VB}; sgemm(f, 512 * 48); SEAM(1); }
    if (PH(2)) { phase_conv_scan(p, lds); SEAM(2); }
    if (PH(3)) { GM1 f{Y, TMP, (const float*)(ws + OFF_BQ), (const float*)(ws + OFF_IQ), (const float*)(ws + OFF_MT), (float*)(ws + OFF_QB)}; sgemm(f, 2048); SEAM(3); }
    if (PH(4)) { phase_mlstm_seq(p, lds); SEAM(4); }
    if (PH(5)) { G2 f{XN, (const bf16_t*)(ws + OFF_W0T), QB, KB, VB, Y}; sgemm(f, 512 * 64); SEAM(5); }
    if (PH(6)) { phase_ya_pool(p); SEAM(6); }
    if (PH(7)) { G3 f{XN, (const bf16_t*)(ws + OFF_WPT), p.e_s_pool, Y}; sgemm(f, 512 * 16); SEAM(7); }
    if (PH(8)) { G4 f{Y, (const bf16_t*)(ws + OFF_WO0T), p.x, p.out}; sgemm(f, 512 * 16); SEAM(8); }
    if (PH(9)) { rmsnorm_rows<4>(p.out, p.o_norm, XN, p.o_w_in, OIN, 1600, nullptr, 0.5f, (float*)(ws + OFF_WI)); SEAM(9); }
    if (PH(10)) { G5 f{XN, (const bf16_t*)(ws + OFF_W1T), QB, (float*)(ws + OFF_CKVR), (float*)(ws + OFF_QI), (float*)(ws + OFF_KI), KB}; sgemm(f, 512 * 44); SEAM(10); }
    if (PH(11)) { phase_qnorm_ckvnorm(p); SEAM(11); }
    if (PH(12)) { G67 f{(const bf16_t*)(ws + OFF_CKVN), (const bf16_t*)(ws + OFF_WUKT), (const bf16_t*)(ws + OFF_WUVT), VB, TMP}; sgemm(f, 16384); SEAM(12); }
    if (PH(13)) { headnorm64(VB, p.o_g_k); phase_indexer(p, lds); SEAM(13); }
    if (PH(14)) { phase_attn(p, lds); SEAM(14); }
    if (PH(15)) { G8 f{XN, (const bf16_t*)(ws + OFF_WO1T), p.out}; sgemm(f, 512 * 16); }
#undef PH
#undef SEAM
}

extern "C" void kernel_launch(void* const* d_in, const int* in_sizes, int n_in, void* d_out, int out_size, void* d_ws, size_t ws_size, hipStream_t stream) {
    static int grid = 0;
    if (grid == 0) {
        if (n_in != 18 || out_size != T * DM || ws_size < WS_END) { fprintf(stderr, "kernel_launch: unexpected shapes (n_in %d out %d ws %zu)\n", n_in, out_size, ws_size); grid = -1; return; }
        if (hipFuncSetAttribute((const void*)k_fwd, hipFuncAttributeMaxDynamicSharedMemorySize, LDS_BYTES) != hipSuccess) { fprintf(stderr, "kernel_launch: hipFuncSetAttribute failed\n"); grid = -1; return; }
        grid = 256;
    }
    if (grid < 0) return;
    (void)hipMemsetAsync((char*)d_ws + OFF_CTL, 0, 16384, stream);
    P p{};
    p.x = (const float*)d_in[0]; p.e_norm = (const float*)d_in[1]; p.e_w_in = (const float*)d_in[2]; p.e_conv = (const float*)d_in[3]; p.e_b_if = (const float*)d_in[4];
    p.e_g_head = (const float*)d_in[5]; p.e_w_pool = (const float*)d_in[6]; p.e_s_pool = (const float*)d_in[7]; p.e_w_out = (const float*)d_in[8];
    p.o_norm = (const float*)d_in[9]; p.o_w_in = (const float*)d_in[10]; p.o_g_kv = (const float*)d_in[11]; p.o_w_uk = (const float*)d_in[12]; p.o_w_uv = (const float*)d_in[13];
    p.o_g_q = (const float*)d_in[14]; p.o_g_k = (const float*)d_in[15]; p.o_w_out = (const float*)d_in[16]; p.rel_bias = (const float*)d_in[17];
    p.out = (float*)d_out; p.ws = (unsigned char*)d_ws;
    for (int ph = 0; ph < NPH; ++ph) hipLaunchKernelGGL(k_fwd, dim3(grid), dim3(512), LDS_BYTES, stream, p, ph, ph + 1);
}
```

```cpp
#include <hip/hip_runtime.h>
#include <stdint.h>
#include <cstdio>

typedef unsigned short bf16_t;
typedef short bf16x8 __attribute__((ext_vector_type(8)));
typedef float f32x4 __attribute__((ext_vector_type(4)));
typedef unsigned u32x4 __attribute__((ext_vector_type(4)));
typedef unsigned u32x2 __attribute__((ext_vector_type(2)));
#define LAS __attribute__((address_space(3)))

constexpr int T = 32768, SEQ = 16384, DM = 1024;
constexpr int EIN = 7176, OIN = 2628;
constexpr float EPS = 1e-6f;
constexpr size_t MB = 1048576;
constexpr size_t OFF_CTL = 0;
constexpr size_t OFF_GATES = 64 * 1024;
constexpr size_t OFF_BQ = OFF_GATES + (size_t)T * 8 * 4;
constexpr size_t OFF_IQ = OFF_BQ + (size_t)T * 4 * 4;
constexpr size_t OFF_MT = OFF_IQ + (size_t)T * 4 * 4;
constexpr size_t OFF_WI = OFF_MT + (size_t)T * 4 * 4;
constexpr size_t OFF_CH = OFF_WI + (size_t)T * 4 * 4;
constexpr size_t OFF_W = 4 * MB;
constexpr size_t OFF_W0T = OFF_W;
constexpr size_t OFF_WPT = OFF_W0T + (size_t)7168 * 1024 * 2;
constexpr size_t OFF_WO0T = OFF_WPT + (size_t)4 * 256 * 256 * 2;
constexpr size_t OFF_W1T = OFF_WO0T + (size_t)1024 * 2048 * 2;
constexpr size_t OFF_WUKT = OFF_W1T + (size_t)2816 * 1024 * 2;
constexpr size_t OFF_WUVT = OFF_WUKT + (size_t)1024 * 256 * 2;
constexpr size_t OFF_WO1T = OFF_WUVT + (size_t)1024 * 256 * 2;
constexpr size_t OFF_XN = 36 * MB, OFF_QB = 100 * MB, OFF_KB = 164 * MB, OFF_VB = 228 * MB, OFF_TMP = 292 * MB, OFF_Y = 356 * MB;
constexpr size_t OFF_CKVR = OFF_Y;
constexpr size_t OFF_QI = OFF_Y + 32 * MB;
constexpr size_t OFF_KI = OFF_Y + 64 * MB;
constexpr size_t OFF_CKVN = OFF_Y + 72 * MB;
constexpr size_t OFF_IDX = OFF_Y + 88 * MB;
constexpr size_t OFF_CNT = OFF_Y + 120 * MB;
constexpr size_t WS_END = 484 * MB;
constexpr int LDS_BYTES = 147456;
constexpr int NPH = 16;

struct P {
    const float *x, *e_norm, *e_w_in, *e_conv, *e_b_if, *e_g_head, *e_w_pool, *e_s_pool, *e_w_out;
    const float *o_norm, *o_w_in, *o_g_kv, *o_w_uk, *o_w_uv, *o_g_q, *o_g_k, *o_w_out, *rel_bias;
    float* out; unsigned char* ws;
};

__device__ __forceinline__ bf16_t f2bf(float f) { unsigned u = __float_as_uint(f); u += 0x7FFFu + ((u >> 16) & 1u); return (bf16_t)(u >> 16); }
__device__ __forceinline__ float bf2f(bf16_t b) { return __uint_as_float(((unsigned)b) << 16); }
__device__ __forceinline__ float bflo(unsigned w) { return __uint_as_float(w << 16); }
__device__ __forceinline__ float bfhi(unsigned w) { return __uint_as_float(w & 0xffff0000u); }
__device__ __forceinline__ unsigned pk2(float a, float b) { return (unsigned)f2bf(a) | ((unsigned)f2bf(b) << 16); }
__device__ __forceinline__ float sigmoidf_(float x) { return 1.0f / (1.0f + __expf(-x)); }
__device__ __forceinline__ float siluf_(float x) { return x / (1.0f + __expf(-x)); }
__device__ __forceinline__ float wave_sum(float v) {
#pragma unroll
    for (int o = 32; o >= 1; o >>= 1) v += __shfl_xor(v, o);
    return v;
}
__device__ __forceinline__ float wave_max(float v) {
#pragma unroll
    for (int o = 32; o >= 1; o >>= 1) v = fmaxf(v, __shfl_xor(v, o));
    return v;
}

#define XB_TMO      128
#define XB_XCNT(j)  (256  + 64 * (j))
#define XB_XSUB(j)  (1280 + 64 * (j))
#define XB_XGEN(j)  (2304 + 64 * (j))
#define XB_TOP      3328
#define XB_TOPGEN   3392
#define XCD_BAR_WORDS 3456
#define XB_SPIN_CAP (1u << 22)
__device__ __forceinline__ unsigned xb_ld(unsigned* p)              { return __hip_atomic_load(p, __ATOMIC_RELAXED, __HIP_MEMORY_SCOPE_AGENT); }
__device__ __forceinline__ unsigned xb_add(unsigned* p, unsigned v) { return __hip_atomic_fetch_add(p, v, __ATOMIC_RELAXED, __HIP_MEMORY_SCOPE_AGENT); }
__device__ __forceinline__ unsigned xb_xcc_id() { return (unsigned)__builtin_amdgcn_s_getreg((3 << 11) | 20) & 0xFu; }
#define XB_SPIN(cond, bar) do { unsigned _sp = 0; while (cond) { __builtin_amdgcn_s_sleep(1); \
    if ((++_sp & 255u) == 0u) { if (xb_ld(&(bar)[XB_TMO])) break; if (_sp > XB_SPIN_CAP) { atomicAdd(&(bar)[XB_TMO], 1u); break; } } } } while (0)
struct XcdBarrier { unsigned* bar; unsigned x; volatile LAS unsigned* st; };
__device__ __forceinline__ XcdBarrier xcd_barrier_post(unsigned* bar, volatile LAS unsigned* st) {
    XcdBarrier b; b.bar = bar; b.x = xb_xcc_id(); b.st = st;
    if (threadIdx.x == 0) (void)xb_add(&bar[XB_XCNT(b.x)], 1u);
    return b;
}
__device__ __forceinline__ void xcd_barrier_complete(unsigned* bar, unsigned x, unsigned& nloc, unsigned& nx) {
    const unsigned G = gridDim.x * gridDim.y * gridDim.z;
    unsigned sum, cnt, mine, sp = 0u;
    for (;;) {
        sum = 0u; cnt = 0u; mine = 0u;
#pragma unroll
        for (unsigned j = 0; j < 16; ++j) { const unsigned c = xb_ld(&bar[XB_XCNT(j)]); sum += c; cnt += (c > 0u) ? 1u : 0u; mine = (j == x) ? c : mine; }
        if (sum == G) break;
        __builtin_amdgcn_s_sleep(1);
        if ((++sp & 255u) == 0u) { if (xb_ld(&bar[XB_TMO])) break; if (sp > XB_SPIN_CAP) { atomicAdd(&bar[XB_TMO], 1u); break; } }
    }
    nloc = mine > 0u ? mine : 1u; nx = cnt > 0u ? cnt : 1u;
}
__device__ __forceinline__ void xcd_barrier(const XcdBarrier& b) {
    asm volatile("s_waitcnt vmcnt(0)" ::: "memory");
    __syncthreads();
    if (threadIdx.x == 0) {
        unsigned* bar = b.bar;
        __builtin_amdgcn_s_waitcnt(0);
        unsigned nloc = b.st[0], nx = b.st[1];
        if (nloc == 0u) { xcd_barrier_complete(bar, b.x, nloc, nx); b.st[0] = nloc; b.st[1] = nx; }
        const unsigned old = xb_add(&bar[XB_XSUB(b.x)], 1u);
        const unsigned gen = old / nloc;
        if (old + 1u == (gen + 1u) * nloc) {
            __builtin_amdgcn_fence(__ATOMIC_RELEASE, "agent");
            asm volatile("s_waitcnt vmcnt(0)" ::: "memory");
            const unsigned og = xb_add(&bar[XB_TOP], 1u);
            const unsigned tg = og / nx;
            if (og + 1u == (tg + 1u) * nx) xb_add(&bar[XB_TOPGEN], 1u);
            else XB_SPIN(xb_ld(&bar[XB_TOPGEN]) == tg, bar);
            __builtin_amdgcn_fence(__ATOMIC_ACQUIRE, "agent");
            xb_add(&bar[XB_XGEN(b.x)], 1u);
            asm volatile("s_waitcnt vmcnt(0)" ::: "memory");
        } else {
            XB_SPIN(xb_ld(&bar[XB_XGEN(b.x)]) == gen, bar);
            __builtin_amdgcn_fence(__ATOMIC_ACQUIRE, "agent");
            asm volatile("s_waitcnt vmcnt(0)" ::: "memory");
        }
    }
    __syncthreads();
}

struct Tile { const bf16_t* A; const bf16_t* B; int lda, ldb, K; void* d0; const void* s0; int ld, mode; float aux0, aux1, aux2; int i0, i1; };
template <class F>
__device__ __forceinline__ void sgemm(const F f, int nunits) {
    const int lane = threadIdx.x & 63, wave = threadIdx.x >> 6, fr = lane & 15, fq = lane >> 4;
    for (int u = blockIdx.x * 8 + wave; u < nunits; u += gridDim.x * 8) {
        Tile tl; f.tile(u, tl);
        f32x4 acc[4][4];
#pragma unroll
        for (int m = 0; m < 4; ++m)
#pragma unroll
            for (int n = 0; n < 4; ++n) acc[m][n] = (f32x4){0.f, 0.f, 0.f, 0.f};
        const bf16_t* ap = tl.A + (size_t)fr * tl.lda + fq * 8;
        const bf16_t* bp = tl.B + (size_t)fr * tl.ldb + fq * 8;
        const int K = tl.K, lda = tl.lda, ldb = tl.ldb;
#pragma unroll 1
        for (int k0 = 0; k0 < K; k0 += 32) {
            bf16x8 a[4], b[4];
#pragma unroll
            for (int m = 0; m < 4; ++m) a[m] = *(const bf16x8*)(ap + (size_t)(m * 16) * lda + k0);
#pragma unroll
            for (int n = 0; n < 4; ++n) b[n] = *(const bf16x8*)(bp + (size_t)(n * 16) * ldb + k0);
#pragma unroll
            for (int m = 0; m < 4; ++m)
#pragma unroll
                for (int n = 0; n < 4; ++n) acc[m][n] = __builtin_amdgcn_mfma_f32_16x16x32_bf16(a[m], b[n], acc[m][n], 0, 0, 0);
        }
#pragma unroll
        for (int m = 0; m < 4; ++m)
#pragma unroll
            for (int j = 0; j < 4; ++j) {
                const int r = m * 16 + fq * 4 + j;
                asm volatile("" ::: "memory");
#pragma unroll
                for (int n = 0; n < 4; ++n) f.out(tl, r, n * 16 + fr, acc[m][n][j]);
            }
    }
}
__device__ __forceinline__ void store_mode(const Tile& tl, int r, int c, float v) {
    const size_t i = (size_t)r * tl.ld + c;
    if (tl.mode == 0) ((bf16_t*)tl.d0)[i] = f2bf(v);
    else if (tl.mode == 1) ((bf16_t*)tl.d0)[i] = f2bf(sigmoidf_(v));
    else if (tl.mode == 2) ((bf16_t*)tl.d0)[i] = f2bf(siluf_(v));
    else if (tl.mode == 3) ((float*)tl.d0)[i] = v * tl.aux0;
}

struct G1 {
    const bf16_t* XN; const bf16_t* W; bf16_t *Q, *K_, *V;
    __device__ __forceinline__ void tile(int u, Tile& tl) const {
        const int mt = u / 48, nt = u % 48; tl.A = XN + (size_t)mt * 64 * 1024; tl.lda = 1024; tl.B = W + (size_t)nt * 64 * 1024; tl.ldb = 1024; tl.K = 1024;
        const int col = nt * 64, sec = col >> 10, cc = col & 1023; bf16_t* d = Q + (size_t)sec * (32 * MB);
        tl.d0 = d + (size_t)mt * 64 * 1024 + cc; tl.ld = 1024; tl.mode = 0; }
    __device__ __forceinline__ void out(const Tile& tl, int r, int c, float v) const { store_mode(tl, r, c, v); }
};
struct G2 {
    const bf16_t* XN; const bf16_t* W; bf16_t *O, *ZA, *U, *Y;
    __device__ __forceinline__ void tile(int u, Tile& tl) const {
        const int mt = u / 64, nt = u % 64; tl.A = XN + (size_t)mt * 64 * 1024; tl.lda = 1024; tl.B = W + (size_t)(3072 + nt * 64) * 1024; tl.ldb = 1024; tl.K = 1024;
        const int col = nt * 64, sec = col >> 10, cc = col & 1023;
        if (sec == 0) { tl.d0 = O + (size_t)mt * 64 * 1024 + cc; tl.ld = 1024; tl.mode = 1; }
        else if (sec == 1) { tl.d0 = ZA + (size_t)mt * 64 * 1024 + cc; tl.ld = 1024; tl.mode = 2; }
        else if (sec == 2) { tl.d0 = U + (size_t)mt * 64 * 1024 + cc; tl.ld = 1024; tl.mode = 0; }
        else { tl.d0 = Y + (size_t)mt * 64 * 2048 + 1024 + cc; tl.ld = 2048; tl.mode = 2; } }
    __device__ __forceinline__ void out(const Tile& tl, int r, int c, float v) const { store_mode(tl, r, c, v); }
};
struct GM1 {
    const bf16_t* Y; const bf16_t* KT; const float *BQ, *IQ, *MT; float* W;
    __device__ __forceinline__ void tile(int u, Tile& tl) const {
        const int bh = u >> 8, c = u & 255, batch = bh >> 2, head = bh & 3; const size_t t0 = (size_t)batch * SEQ + c * 64;
        tl.A = Y + t0 * 2048 + 1024 + head * 256; tl.lda = 2048; tl.B = KT + t0 * 1024 + head * 256; tl.ldb = 1024; tl.K = 256;
        tl.d0 = W + (size_t)u * 4096; tl.ld = 64; tl.mode = 0; tl.i0 = (int)(t0 * 4 + head); }
    __device__ __forceinline__ void out(const Tile& tl, int r, int c, float v) const {
        float w = 0.f;
        if (c <= r) w = __expf(BQ[tl.i0 + r * 4] - BQ[tl.i0 + c * 4] + IQ[tl.i0 + c * 4] - MT[tl.i0 + r * 4]) * v;
        ((float*)tl.d0)[r * 64 + c] = w; }
};
struct G3 {
    const bf16_t* XN; const bf16_t* W; const float* sp; bf16_t* Y;
    __device__ __forceinline__ void tile(int u, Tile& tl) const {
        const int mt = u >> 4, g = (u >> 2) & 3, nt = u & 3; tl.A = XN + (size_t)mt * 64 * 1024 + g * 256; tl.lda = 1024; tl.B = W + (size_t)(g * 256 + nt * 64) * 256; tl.ldb = 256; tl.K = 256;
        const int col = g * 256 + nt * 64; tl.d0 = Y + (size_t)mt * 64 * 2048 + 1024 + col; tl.ld = 2048; tl.s0 = sp + col; tl.mode = 0; }
    __device__ __forceinline__ void out(const Tile& tl, int r, int c, float v) const {
        bf16_t* d = (bf16_t*)tl.d0 + (size_t)r * 2048 + c; *d = f2bf(v * ((const float*)tl.s0)[c] * bf2f(*d)); }
};
struct G4 {
    const bf16_t* Y; const bf16_t* W; const float* x; float* out_;
    __device__ __forceinline__ void tile(int u, Tile& tl) const {
        const int mt = u >> 4, nt = u & 15; tl.A = Y + (size_t)mt * 64 * 2048; tl.lda = 2048; tl.B = W + (size_t)nt * 64 * 2048; tl.ldb = 2048; tl.K = 2048;
        const size_t o = (size_t)mt * 64 * 1024 + nt * 64; tl.d0 = out_ + o; tl.s0 = x + o; tl.ld = 1024; tl.mode = 0; }
    __device__ __forceinline__ void out(const Tile& tl, int r, int c, float v) const { const size_t i = (size_t)r * 1024 + c; ((float*)tl.d0)[i] = ((const float*)tl.s0)[i] + v; }
};
struct G5 {
    const bf16_t* XN; const bf16_t* W; bf16_t* Q; float *CKVR, *QI, *KI; bf16_t* Z;
    __device__ __forceinline__ void tile(int u, Tile& tl) const {
        const int mt = u / 44, nt = u % 44; tl.A = XN + (size_t)mt * 64 * 1024; tl.lda = 1024; tl.B = W + (size_t)nt * 64 * 1024; tl.ldb = 1024; tl.K = 1024;
        const int col = nt * 64; const size_t row0 = (size_t)mt * 64; tl.aux0 = 1.0f;
        if (col < 1024) { tl.d0 = Q + row0 * 1024 + col; tl.ld = 1024; tl.mode = 0; }
        else if (col < 1280) { tl.d0 = CKVR + row0 * 256 + (col - 1024); tl.ld = 256; tl.mode = 3; }
        else if (col < 1536) { tl.d0 = QI + row0 * 256 + (col - 1280); tl.ld = 256; tl.mode = 3; tl.aux0 = 0.125f; }
        else if (col < 1600) { tl.d0 = KI + row0 * 64 + (col - 1536); tl.ld = 64; tl.mode = 3; }
        else if (col < 1792) { tl.d0 = nullptr; tl.ld = 0; tl.mode = 4; }
        else { tl.d0 = Z + row0 * 1024 + (col - 1792); tl.ld = 1024; tl.mode = 2; } }
    __device__ __forceinline__ void out(const Tile& tl, int r, int c, float v) const { store_mode(tl, r, c, v); }
};
struct G67 {
    const bf16_t* C; const bf16_t *WK, *WV; bf16_t *KF, *VF;
    __device__ __forceinline__ void tile(int u, Tile& tl) const {
        const int which = u >= 8192, uu = u & 8191, mt = uu >> 4, nt = uu & 15; tl.A = C + (size_t)mt * 64 * 256; tl.lda = 256; tl.B = WK + (size_t)which * (1024 * 256) + (size_t)nt * 64 * 256;     tl.ldb = 256; tl.K = 256;
        tl.d0 = KF + (size_t)which * (32 * MB) + (size_t)mt * 64 * 1024 + nt * 64;     tl.ld = 1024; tl.mode = 0; }
    __device__ __forceinline__ void out(const Tile& tl, int r, int c, float v) const { store_mode(tl, r, c, v); }
};
struct G8 {
    const bf16_t* G; const bf16_t* W; float* out_;
    __device__ __forceinline__ void tile(int u, Tile& tl) const {
        const int mt = u >> 4, nt = u & 15; tl.A = G + (size_t)mt * 64 * 1024; tl.lda = 1024; tl.B = W + (size_t)nt * 64 * 1024; tl.ldb = 1024; tl.K = 1024;
        tl.d0 = out_ + (size_t)mt * 64 * 1024 + nt * 64; tl.ld = 1024; tl.mode = 0; }
    __device__ __forceinline__ void out(const Tile& tl, int r, int c, float v) const { float* d = (float*)tl.d0 + (size_t)r * 1024 + c; *d = *d + v; }
};

__device__ __forceinline__ void tconv(const float* __restrict__ src, int ld, int col0, int ncols, int K, bf16_t* __restrict__ dst, float* tile  ) {
    const int nkt = K / 64, ntiles = nkt * (ncols / 64), tid = threadIdx.x;
    for (int id = blockIdx.x; id < ntiles; id += gridDim.x) {
        const int kt = id % nkt, nt = id / nkt;
#pragma unroll
        for (int j = 0; j < 8; ++j) { const int e = tid + 512 * j, kk = e >> 6, nn = e & 63; tile[kk * 65 + nn] = src[(size_t)(kt * 64 + kk) * ld + col0 + nt * 64 + nn]; }
        __syncthreads();
#pragma unroll
        for (int j = 0; j < 8; ++j) { const int e = tid + 512 * j, nn = e >> 6, kk = e & 63; dst[(size_t)(nt * 64 + nn) * K + kt * 64 + kk] = f2bf(tile[kk * 65 + nn]); }
        __syncthreads();
    }
}
template <int NE>
__device__ __forceinline__ void rmsnorm_rows(const float* __restrict__ src, const float* __restrict__ g, bf16_t* __restrict__ dst,
                             const float* __restrict__ Wx, int ldw, int col0, const float* __restrict__ bias, float scale, float* __restrict__ dstx) {
    const int lane = threadIdx.x & 63, wave = threadIdx.x >> 6;
    for (int row = blockIdx.x * 8 + wave; row < T; row += gridDim.x * 8) {
        f32x4 v[4]; float ss = 0.f;
#pragma unroll
        for (int i = 0; i < 4; ++i) { v[i] = *(const f32x4*)(src + (size_t)row * 1024 + i * 256 + lane * 4); ss += v[i][0] * v[i][0] + v[i][1] * v[i][1] + v[i][2] * v[i][2] + v[i][3] * v[i][3]; }
        ss = wave_sum(ss);
        const float rstd = rsqrtf(ss * (1.0f / 1024.0f) + EPS);
        float ex[NE];
#pragma unroll
        for (int e = 0; e < NE; ++e) ex[e] = 0.f;
#pragma unroll
        for (int i = 0; i < 4; ++i) {
            asm volatile("" ::: "memory");
            const f32x4 gg = *(const f32x4*)(g + i * 256 + lane * 4);
            f32x4 y; y[0] = v[i][0] * rstd * gg[0]; y[1] = v[i][1] * rstd * gg[1]; y[2] = v[i][2] * rstd * gg[2]; y[3] = v[i][3] * rstd * gg[3];
            u32x2 w; w.x = pk2(y[0], y[1]); w.y = pk2(y[2], y[3]);
            *(u32x2*)(dst + (size_t)row * 1024 + i * 256 + lane * 4) = w;
#pragma unroll
            for (int j = 0; j < 4; ++j) { const float* wr = Wx + (size_t)(i * 256 + lane * 4 + j) * ldw + col0;
#pragma unroll
                for (int e4 = 0; e4 < NE / 4; ++e4) { const f32x4 wv = *(const f32x4*)(wr + e4 * 4);
                    ex[e4 * 4 + 0] += y[j] * wv[0]; ex[e4 * 4 + 1] += y[j] * wv[1]; ex[e4 * 4 + 2] += y[j] * wv[2]; ex[e4 * 4 + 3] += y[j] * wv[3]; } }
        }
#pragma unroll
        for (int e = 0; e < NE; ++e) { const float s = wave_sum(ex[e]); if (lane == 0) dstx[(size_t)row * NE + e] = (s + (bias ? bias[e] : 0.f)) * scale; }
    }
}

__device__ __forceinline__ void phase_prep(const P& p, unsigned char* lds) {
    float* tile = (float*)lds; unsigned char* ws = p.ws;
    bf16_t* W0T = (bf16_t*)(ws + OFF_W0T);
    tconv(p.e_w_in, EIN, 0, 5120, 1024, W0T, tile);
    tconv(p.e_w_in, EIN, 5128, 2048, 1024, W0T + (size_t)5120 * 1024, tile);
    for (int g = 0; g < 4; ++g) tconv(p.e_w_pool + (size_t)g * 65536, 256, 0, 256, 256, (bf16_t*)(ws + OFF_WPT) + (size_t)g * 65536, tile);
    tconv(p.e_w_out, 1024, 0, 1024, 2048, (bf16_t*)(ws + OFF_WO0T), tile);
    bf16_t* W1T = (bf16_t*)(ws + OFF_W1T);
    tconv(p.o_w_in, OIN, 0, 1600, 1024, W1T, tile);
    for (size_t i = (size_t)blockIdx.x * 512 + threadIdx.x; i < (size_t)192 * 1024; i += (size_t)gridDim.x * 512) W1T[(size_t)1600 * 1024 + i] = 0;
    tconv(p.o_w_in, OIN, 1604, 1024, 1024, W1T + (size_t)1792 * 1024, tile);
    tconv(p.o_w_uk, 1024, 0, 1024, 256, (bf16_t*)(ws + OFF_WUKT), tile);
    tconv(p.o_w_uv, 1024, 0, 1024, 256, (bf16_t*)(ws + OFF_WUVT), tile);
    tconv(p.o_w_out, 1024, 0, 1024, 1024, (bf16_t*)(ws + OFF_WO1T), tile);
    rmsnorm_rows<8>(p.x, p.e_norm, (bf16_t*)(ws + OFF_XN), p.e_w_in, EIN, 5120, p.e_b_if, 1.0f, (float*)(ws + OFF_GATES));
}

__device__ __forceinline__ void phase_conv_scan(const P& p, unsigned char* lds) {
    unsigned char* ws = p.ws; const int tid = threadIdx.x;
    const float* GATES = (const float*)(ws + OFF_GATES);
    float *BQ = (float*)(ws + OFF_BQ), *IQ = (float*)(ws + OFF_IQ), *MT = (float*)(ws + OFF_MT), *CH = (float*)(ws + OFF_CH);
    for (int bh = blockIdx.x; bh < 8; bh += gridDim.x) {
        float* sB = (float*)lds; float* sG = sB + 256; float* sMp = sG + 256; float* sMn = sMp + 256;
        const int batch = bh >> 2, head = bh & 3;
        if (tid < 256) {
            const size_t t0 = (size_t)batch * SEQ + tid * 64; float b = 0.f, rmax = -INFINITY;
            for (int s = 0; s < 64; ++s) { const size_t t = t0 + s; const float ig = GATES[t * 8 + head], f = GATES[t * 8 + 4 + head];
                const float ls = fminf(f, 0.f) - log1pf(__expf(-fabsf(f)));
                b += ls; BQ[t * 4 + head] = b; IQ[t * 4 + head] = ig; rmax = fmaxf(rmax, ig - b); MT[t * 4 + head] = rmax; }
            sB[tid] = b; sG[tid] = b + rmax;
        }
        __syncthreads();
        if (tid == 0) { float m = 0.f; for (int c = 0; c < 256; ++c) { sMp[c] = m; m = fmaxf(sB[c] + m, sG[c]); sMn[c] = m; } }
        __syncthreads();
        if (tid < 256) {
            const float mp = sMp[tid]; CH[bh * 256 + tid] = mp; CH[2048 + bh * 256 + tid] = sMn[tid]; CH[4096 + bh * 256 + tid] = sB[tid];
            const size_t t0 = (size_t)batch * SEQ + tid * 64;
            for (int s = 0; s < 64; ++s) { const size_t t = t0 + s; MT[t * 4 + head] = BQ[t * 4 + head] + fmaxf(mp, MT[t * 4 + head]); }
        }
        __syncthreads();
    }
    const bf16_t* QB = (const bf16_t*)(ws + OFF_QB); const bf16_t* KB = (const bf16_t*)(ws + OFF_KB);
    bf16_t* Y = (bf16_t*)(ws + OFF_Y); bf16_t* KT = (bf16_t*)(ws + OFF_TMP);
    for (size_t it = (size_t)blockIdx.x * 512 + tid; it < (size_t)T * 256; it += (size_t)gridDim.x * 512) {
        const size_t t = it >> 8; const int c0 = (int)(it & 255) * 8, isk = c0 >= 1024, cc = c0 & 1023; const int s = (int)(t & (SEQ - 1));
        const bf16_t* src = isk ? KB : QB;
        float acc[8];
#pragma unroll
        for (int i = 0; i < 8; ++i) acc[i] = 0.f;
#pragma unroll
        for (int j = 0; j < 4; ++j) {
            if (s - 3 + j >= 0) {
                const u32x4 w = *(const u32x4*)(src + (t - 3 + j) * 1024 + cc);
                const f32x4 c0v = *(const f32x4*)(p.e_conv + j * 2048 + c0), c1v = *(const f32x4*)(p.e_conv + j * 2048 + c0 + 4);
                acc[0] += c0v[0] * bflo(w.x); acc[1] += c0v[1] * bfhi(w.x); acc[2] += c0v[2] * bflo(w.y); acc[3] += c0v[3] * bfhi(w.y);
                acc[4] += c1v[0] * bflo(w.z); acc[5] += c1v[1] * bfhi(w.z); acc[6] += c1v[2] * bflo(w.w); acc[7] += c1v[3] * bfhi(w.w);
            }
        }
        const float sc = isk ? 0.0625f : 1.0f;
        u32x4 o; o.x = pk2(siluf_(acc[0]) * sc, siluf_(acc[1]) * sc); o.y = pk2(siluf_(acc[2]) * sc, siluf_(acc[3]) * sc);
        o.z = pk2(siluf_(acc[4]) * sc, siluf_(acc[5]) * sc); o.w = pk2(siluf_(acc[6]) * sc, siluf_(acc[7]) * sc);
        if (isk) *(u32x4*)(KT + t * 1024 + cc) = o; else *(u32x4*)(Y + t * 2048 + 1024 + cc) = o;
    }
}

__device__ __forceinline__ void phase_mlstm_seq(const P& p, unsigned char* lds) {
    unsigned char* ws = p.ws; const int tid = threadIdx.x, lane = tid & 63;
    const bf16_t* Yc = (const bf16_t*)(ws + OFF_Y); bf16_t* Y = (bf16_t*)(ws + OFF_Y);
    const bf16_t* KT = (const bf16_t*)(ws + OFF_TMP); const bf16_t* VB = (const bf16_t*)(ws + OFF_VB);
    const float* Wg = (const float*)(ws + OFF_QB);
    const float *BQ = (const float*)(ws + OFF_BQ), *IQ = (const float*)(ws + OFF_IQ), *MT = (const float*)(ws + OFF_MT), *CH = (const float*)(ws + OFF_CH);
    bf16_t* Qs = (bf16_t*)lds;
    bf16_t* Ks = Qs + 64 * 264;
    float* Ws = (float*)(Ks + 64 * 264);
    float* Vs = Ws + 64 * 65;
    float* Cs = Vs + 64 * 8;
    float* ns = Cs + 8 * 260;
    float* sa = ns + 256;
    float* sden = sa + 64;
    float* ssw = sden + 64;
    for (int wu = blockIdx.x; wu < 256; wu += gridDim.x) {
        const int bh = wu >> 5, vs = wu & 31, batch = bh >> 2, head = bh & 3;
        float c[4] = {0.f, 0.f, 0.f, 0.f}; float nreg = 0.f;
        const int uv = tid >> 6;
        const int ot = tid >> 3, ov = tid & 7;
        for (int ch = 0; ch < 256; ++ch) {
            const size_t t0 = (size_t)batch * SEQ + ch * 64;
            const float mprev = CH[bh * 256 + ch], mnew = CH[2048 + bh * 256 + ch], blast = CH[4096 + bh * 256 + ch];
            const float decay = __expf(blast + mprev - mnew);
            __syncthreads();
#pragma unroll
            for (int j = 0; j < 4; ++j) { const int e = tid + 512 * j, r = e >> 5, cg = e & 31;
                *(u32x4*)(Qs + r * 264 + cg * 8) = *(const u32x4*)(Yc + (t0 + r) * 2048 + 1024 + head * 256 + cg * 8);
                *(u32x4*)(Ks + r * 264 + cg * 8) = *(const u32x4*)(KT + (t0 + r) * 1024 + head * 256 + cg * 8); }
#pragma unroll
            for (int j = 0; j < 8; ++j) { const int e = tid + 512 * j, r = e >> 6, cc = e & 63; Ws[r * 65 + cc] = Wg[((size_t)(bh * 256 + ch)) * 4096 + e]; }
            if (tid < 64) { const u32x4 w = *(const u32x4*)(VB + (t0 + tid) * 1024 + head * 256 + vs * 8);
                float* d = Vs + tid * 8; d[0] = bflo(w.x); d[1] = bfhi(w.x); d[2] = bflo(w.y); d[3] = bfhi(w.y); d[4] = bflo(w.z); d[5] = bfhi(w.z); d[6] = bflo(w.w); d[7] = bfhi(w.w);
                const float bq = BQ[(t0 + tid) * 4 + head], iq = IQ[(t0 + tid) * 4 + head], mt = MT[(t0 + tid) * 4 + head];
                sa[tid] = __expf(bq + mprev - mt); sden[tid] = __expf(-mt); ssw[tid] = __expf(blast - bq + iq - mnew); }
#pragma unroll
            for (int j = 0; j < 4; ++j) Cs[uv * 260 + lane + 64 * j] = c[j];
            if (tid < 256) ns[tid] = nreg;
            __syncthreads();
            {
                float inter = 0.f, ndot = 0.f, intra = 0.f, rsum = 0.f;
                const bf16_t* qr = Qs + ot * 264; const float* cr = Cs + ov * 260;
#pragma unroll 8
                for (int k = 0; k < 256; ++k) inter += cr[k] * bf2f(qr[k]);
#pragma unroll 8
                for (int k = 0; k < 32; ++k) ndot += ns[ov * 32 + k] * bf2f(qr[ov * 32 + k]);
                ndot += __shfl_xor(ndot, 1); ndot += __shfl_xor(ndot, 2); ndot += __shfl_xor(ndot, 4);
#pragma unroll 8
                for (int s = 0; s < 64; ++s) { const float w = Ws[ot * 65 + s]; intra += w * Vs[s * 8 + ov]; rsum += w; }
                const float a = sa[ot]; const float nq = a * ndot + rsum; const float den = fmaxf(fabsf(nq), sden[ot]);
                const float h = (a * inter + intra) / den;
                Y[(t0 + ot) * 2048 + head * 256 + vs * 8 + ov] = f2bf(h);
            }
            {
                float acc[4] = {0.f, 0.f, 0.f, 0.f}; float nacc = 0.f;
                for (int s = 0; s < 64; ++s) { const float sv = ssw[s] * Vs[s * 8 + uv]; const bf16_t* kr = Ks + s * 264 + lane;
#pragma unroll
                    for (int j = 0; j < 4; ++j) acc[j] += sv * bf2f(kr[64 * j]); }
#pragma unroll
                for (int j = 0; j < 4; ++j) c[j] = decay * c[j] + acc[j];
                if (tid < 256) { for (int s = 0; s < 64; ++s) nacc += ssw[s] * bf2f(Ks[s * 264 + tid]); nreg = decay * nreg + nacc; }
            }
        }
        __syncthreads();
    }
}

__device__ __forceinline__ void phase_ya_pool(const P& p) {
    unsigned char* ws = p.ws; const int tid = threadIdx.x, lane = tid & 63, wave = tid >> 6;
    bf16_t* Y = (bf16_t*)(ws + OFF_Y); const bf16_t* O = (const bf16_t*)(ws + OFF_QB); const bf16_t* ZA = (const bf16_t*)(ws + OFF_KB);
    for (int it = blockIdx.x * 8 + wave; it < T * 4; it += gridDim.x * 8) {
        const size_t t = (size_t)(it >> 2); const int head = it & 3, c = head * 256 + lane * 4;
        const u32x2 hw = *(const u32x2*)(Y + t * 2048 + c), ow = *(const u32x2*)(O + t * 1024 + c), zw = *(const u32x2*)(ZA + t * 1024 + c);
        float v[4] = {bflo(hw.x) * bflo(ow.x), bfhi(hw.x) * bfhi(ow.x), bflo(hw.y) * bflo(ow.y), bfhi(hw.y) * bfhi(ow.y)};
        float ss = wave_sum(v[0] * v[0] + v[1] * v[1] + v[2] * v[2] + v[3] * v[3]);
        const float rstd = rsqrtf(ss * (1.0f / 256.0f) + EPS);
        const f32x4 g = *(const f32x4*)(p.e_g_head + c);
        u32x2 o; o.x = pk2(v[0] * rstd * g[0] * bflo(zw.x), v[1] * rstd * g[1] * bfhi(zw.x)); o.y = pk2(v[2] * rstd * g[2] * bflo(zw.y), v[3] * rstd * g[3] * bfhi(zw.y));
        *(u32x2*)(Y + t * 2048 + c) = o;
    }
    const bf16_t* U = (const bf16_t*)(ws + OFF_VB); bf16_t* PO = (bf16_t*)(ws + OFF_XN);
    for (size_t it = (size_t)blockIdx.x * 512 + tid; it < (size_t)T * 128; it += (size_t)gridDim.x * 512) {
        const size_t t = it >> 7; const int c0 = (int)(it & 127) * 8, g = c0 >> 8, win = 2 << g, s = (int)(t & (SEQ - 1)); const int cnt = (s + 1 < win) ? s + 1 : win;
        float acc[8], self[8];
#pragma unroll
        for (int i = 0; i < 8; ++i) acc[i] = 0.f;
        for (int j = 0; j < cnt; ++j) { const u32x4 w = *(const u32x4*)(U + (t - j) * 1024 + c0);
            const float f[8] = {bflo(w.x), bfhi(w.x), bflo(w.y), bfhi(w.y), bflo(w.z), bfhi(w.z), bflo(w.w), bfhi(w.w)};
#pragma unroll
            for (int i = 0; i < 8; ++i) { acc[i] += f[i]; if (j == 0) self[i] = f[i]; } }
        const float inv = 1.0f / (float)cnt;
        u32x4 o; o.x = pk2(acc[0] * inv - self[0], acc[1] * inv - self[1]); o.y = pk2(acc[2] * inv - self[2], acc[3] * inv - self[3]);
        o.z = pk2(acc[4] * inv - self[4], acc[5] * inv - self[5]); o.w = pk2(acc[6] * inv - self[6], acc[7] * inv - self[7]);
        *(u32x4*)(PO + t * 1024 + c0) = o;
    }
}

__device__ __forceinline__ void headnorm64(bf16_t* X, const float* g) {
    const int lane = threadIdx.x & 63, wave = threadIdx.x >> 6;
    for (int t = blockIdx.x * 8 + wave; t < T; t += gridDim.x * 8) {
        bf16_t* r = X + (size_t)t * 1024 + lane * 16;
        const u32x4 a = *(const u32x4*)r, b = *(const u32x4*)(r + 8);
        float f[16] = {bflo(a.x), bfhi(a.x), bflo(a.y), bfhi(a.y), bflo(a.z), bfhi(a.z), bflo(a.w), bfhi(a.w), bflo(b.x), bfhi(b.x), bflo(b.y), bfhi(b.y), bflo(b.z), bfhi(b.z), bflo(b.w), bfhi(b.w)};
        float ss = 0.f;
#pragma unroll
        for (int i = 0; i < 16; ++i) ss += f[i] * f[i];
        ss += __shfl_xor(ss, 1); ss += __shfl_xor(ss, 2);
        const float rstd = rsqrtf(ss * (1.0f / 64.0f) + EPS);
        const float* gg = g + (lane & 3) * 16;
#pragma unroll
        for (int i = 0; i < 16; ++i) f[i] = f[i] * rstd * gg[i];
        u32x4 oa, ob; oa.x = pk2(f[0], f[1]); oa.y = pk2(f[2], f[3]); oa.z = pk2(f[4], f[5]); oa.w = pk2(f[6], f[7]);
        ob.x = pk2(f[8], f[9]); ob.y = pk2(f[10], f[11]); ob.z = pk2(f[12], f[13]); ob.w = pk2(f[14], f[15]);
        *(u32x4*)r = oa; *(u32x4*)(r + 8) = ob;
    }
}
__device__ __forceinline__ void phase_qnorm_ckvnorm(const P& p) {
    unsigned char* ws = p.ws; const int lane = threadIdx.x & 63, wave = threadIdx.x >> 6;
    headnorm64((bf16_t*)(ws + OFF_QB), p.o_g_q);
    const float* CKVR = (const float*)(ws + OFF_CKVR); bf16_t* CKVN = (bf16_t*)(ws + OFF_CKVN);
    for (int t = blockIdx.x * 8 + wave; t < T; t += gridDim.x * 8) {
        const f32x4 v = *(const f32x4*)(CKVR + (size_t)t * 256 + lane * 4);
        const float ss = wave_sum(v[0] * v[0] + v[1] * v[1] + v[2] * v[2] + v[3] * v[3]);
        const float rstd = rsqrtf(ss * (1.0f / 256.0f) + EPS);
        const f32x4 g = *(const f32x4*)(p.o_g_kv + lane * 4);
        u32x2 o; o.x = pk2(v[0] * rstd * g[0], v[1] * rstd * g[1]); o.y = pk2(v[2] * rstd * g[2], v[3] * rstd * g[3]);
        *(u32x2*)(CKVN + (size_t)t * 256 + lane * 4) = o;
    }
}

__device__ __forceinline__ unsigned okey(float s) { if (s == 0.f) s = 0.f; const unsigned u = __float_as_uint(s); return (u & 0x80000000u) ? ~u : (u | 0x80000000u); }

__device__ __forceinline__ void phase_indexer(const P& p, unsigned char* lds) {
    unsigned char* ws = p.ws; const int tid = threadIdx.x, lane = tid & 63, wave = tid >> 6;
    const float* QI = (const float*)(ws + OFF_QI); const float* KI = (const float*)(ws + OFF_KI); const float* WI = (const float*)(ws + OFF_WI);
    int* IDX = (int*)(ws + OFF_IDX); int* CNT = (int*)(ws + OFF_CNT);
    unsigned* sc = (unsigned*)lds;
    unsigned* hist = sc + 16384;
    float* qs = (float*)(hist + 256);
    unsigned* misc = (unsigned*)(qs + 256);
    unsigned* wsum = misc + 16;
    const int G = gridDim.x, nround = T / G;
    for (int i = 0; i < nround; ++i) {
        const int tq = (i & 1) ? i * G + (G - 1 - (int)blockIdx.x) : i * G + (int)blockIdx.x;
        const int batch = tq & 1, pos = tq >> 1; const size_t t = (size_t)batch * SEQ + pos; const int n = pos + 1;
        if (n <= 256) { if (tid < 256) IDX[t * 256 + tid] = tid < n ? tid : 0; if (tid == 0) CNT[t] = n; continue; }
        __syncthreads();
        if (tid < 256) qs[tid] = QI[t * 256 + tid];
        const float w0 = WI[t * 4 + 0], w1 = WI[t * 4 + 1], w2 = WI[t * 4 + 2], w3 = WI[t * 4 + 3];
        __syncthreads();
        const float* kbase = KI + (size_t)batch * SEQ * 64;
        for (int s = tid; s < n; s += 512) {
            asm volatile("" ::: "memory");
            const f32x4* kr = (const f32x4*)(kbase + (size_t)s * 64);
            float d0 = 0.f, d1 = 0.f, d2 = 0.f, d3 = 0.f;
#pragma unroll
            for (int j = 0; j < 16; ++j) { const f32x4 kv = kr[j];
#pragma unroll
                for (int e = 0; e < 4; ++e) { const int d = j * 4 + e; d0 += qs[d] * kv[e]; d1 += qs[64 + d] * kv[e]; d2 += qs[128 + d] * kv[e]; d3 += qs[192 + d] * kv[e]; } }
            float score = w0 * fmaxf(d0, 0.f); score += w1 * fmaxf(d1, 0.f); score += w2 * fmaxf(d2, 0.f); score += w3 * fmaxf(d3, 0.f);
            sc[s] = okey(score);
        }
        unsigned prefix = 0, krem = 256;
        for (int pass = 0; pass < 4; ++pass) {
            const int shift = 24 - 8 * pass;
            __syncthreads();
            if (tid < 256) hist[tid] = 0;
            __syncthreads();
            for (int s = tid; s < n; s += 512) { const unsigned k = sc[s]; if (pass == 0 || (k >> (shift + 8)) == prefix) atomicAdd(&hist[(k >> shift) & 255u], 1u); }
            __syncthreads();
            if (tid == 0) { unsigned cum = 0; int bin = 255; for (; bin > 0; --bin) { const unsigned c = hist[bin]; if (cum + c >= krem) break; cum += c; } misc[0] = (unsigned)bin; misc[1] = krem - cum; }
            __syncthreads();
            prefix = (prefix << 8) | misc[0]; krem = misc[1];
        }
        const unsigned ngt_total = 256u - krem;
        unsigned lg = 0, le = 0; const int s0 = tid * 32;
        for (int s = s0; s < s0 + 32 && s < n; ++s) { const unsigned k = sc[s]; lg += (k > prefix); le += (k == prefix); }
        unsigned pk = lg | (le << 16), incl = pk;
#pragma unroll
        for (int o = 1; o < 64; o <<= 1) { const unsigned y = __shfl_up(incl, o); if (lane >= o) incl += y; }
        if (lane == 63) wsum[wave] = incl;
        __syncthreads();
        unsigned base = 0;
        for (int w = 0; w < wave; ++w) base += wsum[w];
        const unsigned excl = base + incl - pk; unsigned bg = excl & 0xffffu, be = excl >> 16;
        for (int s = s0; s < s0 + 32 && s < n; ++s) { const unsigned k = sc[s];
            if (k > prefix) { IDX[t * 256 + bg] = s; ++bg; }
            else if (k == prefix) { if (be < krem) IDX[t * 256 + ngt_total + be] = s; ++be; } }
        if (tid == 0) CNT[t] = 256;
    }
}

__device__ __forceinline__ void phase_attn(const P& p, unsigned char* lds) {
    unsigned char* ws = p.ws; const int tid = threadIdx.x, lane = tid & 63, wave = tid >> 6;
    const bf16_t* Q = (const bf16_t*)(ws + OFF_QB); const bf16_t* Kf = (const bf16_t*)(ws + OFF_VB); const bf16_t* Vf = (const bf16_t*)(ws + OFF_TMP);
    const bf16_t* Z = (const bf16_t*)(ws + OFF_KB); bf16_t* Gout = (bf16_t*)(ws + OFF_XN);
    const int* IDX = (const int*)(ws + OFF_IDX); const int* CNT = (const int*)(ws + OFF_CNT);
    float* Pw = (float*)(lds + (size_t)wave * 17408);
    int* Iw = (int*)(Pw + 4096);
    for (int t = blockIdx.x * 8 + wave; t < T; t += gridDim.x * 8) {
        const int batch = t >> 14, pos = t & (SEQ - 1); const int cnt = CNT[t];
        const size_t rb = (size_t)batch * SEQ;
        for (int jj = 0; jj < 4; ++jj) {
            const int j = lane + 64 * jj; const int id = IDX[(size_t)t * 256 + j]; Iw[j] = id;
            if (j < cnt) {
                const int rel = pos - id; int bucket;
                if (rel < 16) bucket = rel; else { bucket = 16 + (int)(__logf((float)rel * 0.0625f) / 2.0794415416798357f * 16.0f); bucket = bucket > 31 ? 31 : bucket; }
                const bf16_t* kr = Kf + (rb + id) * 1024; const bf16_t* qr = Q + (size_t)t * 1024;
                for (int h = 0; h < 16; ++h) {
                    float d = 0.f;
#pragma unroll
                    for (int e = 0; e < 8; ++e) { const u32x4 kw = *(const u32x4*)(kr + h * 64 + e * 8), qw = *(const u32x4*)(qr + h * 64 + e * 8);
                        d += bflo(kw.x) * bflo(qw.x) + bfhi(kw.x) * bfhi(qw.x) + bflo(kw.y) * bflo(qw.y) + bfhi(kw.y) * bfhi(qw.y)
                           + bflo(kw.z) * bflo(qw.z) + bfhi(kw.z) * bfhi(qw.z) + bflo(kw.w) * bflo(qw.w) + bfhi(kw.w) * bfhi(qw.w); }
                    Pw[h * 256 + j] = d * 0.125f + p.rel_bias[bucket * 16 + h];
                }
            } else {
                for (int h = 0; h < 16; ++h) Pw[h * 256 + j] = -INFINITY;
            }
        }
        for (int h = 0; h < 16; ++h) {
            float l0 = Pw[h * 256 + lane], l1 = Pw[h * 256 + lane + 64], l2 = Pw[h * 256 + lane + 128], l3 = Pw[h * 256 + lane + 192];
            float m = fmaxf(fmaxf(l0, l1), fmaxf(l2, l3)); m = wave_max(m);
            l0 = __expf(l0 - m); l1 = __expf(l1 - m); l2 = __expf(l2 - m); l3 = __expf(l3 - m);
            const float s = wave_sum(l0 + l1 + l2 + l3); const float inv = 1.0f / s;
            Pw[h * 256 + lane] = l0 * inv; Pw[h * 256 + lane + 64] = l1 * inv; Pw[h * 256 + lane + 128] = l2 * inv; Pw[h * 256 + lane + 192] = l3 * inv;
        }
        __builtin_amdgcn_fence(__ATOMIC_RELEASE, "workgroup"); __builtin_amdgcn_wave_barrier(); __builtin_amdgcn_fence(__ATOMIC_ACQUIRE, "workgroup");
        float acc[16];
#pragma unroll
        for (int i = 0; i < 16; ++i) acc[i] = 0.f;
        const int hl = lane >> 2;
        for (int j = 0; j < cnt; ++j) {
            const int id = Iw[j]; const float pj = Pw[hl * 256 + j];
            const bf16_t* vr = Vf + (rb + id) * 1024 + lane * 16;
            const u32x4 a = *(const u32x4*)vr, b = *(const u32x4*)(vr + 8);
            acc[0] += pj * bflo(a.x); acc[1] += pj * bfhi(a.x); acc[2] += pj * bflo(a.y); acc[3] += pj * bfhi(a.y);
            acc[4] += pj * bflo(a.z); acc[5] += pj * bfhi(a.z); acc[6] += pj * bflo(a.w); acc[7] += pj * bfhi(a.w);
            acc[8] += pj * bflo(b.x); acc[9] += pj * bfhi(b.x); acc[10] += pj * bflo(b.y); acc[11] += pj * bfhi(b.y);
            acc[12] += pj * bflo(b.z); acc[13] += pj * bfhi(b.z); acc[14] += pj * bflo(b.w); acc[15] += pj * bfhi(b.w);
        }
        const bf16_t* zr = Z + (size_t)t * 1024 + lane * 16;
        const u32x4 za = *(const u32x4*)zr, zb = *(const u32x4*)(zr + 8);
        u32x4 oa, ob;
        oa.x = pk2(acc[0] * bflo(za.x), acc[1] * bfhi(za.x)); oa.y = pk2(acc[2] * bflo(za.y), acc[3] * bfhi(za.y));
        oa.z = pk2(acc[4] * bflo(za.z), acc[5] * bfhi(za.z)); oa.w = pk2(acc[6] * bflo(za.w), acc[7] * bfhi(za.w));
        ob.x = pk2(acc[8] * bflo(zb.x), acc[9] * bfhi(zb.x)); ob.y = pk2(acc[10] * bflo(zb.y), acc[11] * bfhi(zb.y));
        ob.z = pk2(acc[12] * bflo(zb.z), acc[13] * bfhi(zb.z)); ob.w = pk2(acc[14] * bflo(zb.w), acc[15] * bfhi(zb.w));
        bf16_t* go = Gout + (size_t)t * 1024 + lane * 16;
        *(u32x4*)go = oa; *(u32x4*)(go + 8) = ob;
        __builtin_amdgcn_fence(__ATOMIC_RELEASE, "workgroup"); __builtin_amdgcn_wave_barrier(); __builtin_amdgcn_fence(__ATOMIC_ACQUIRE, "workgroup");
    }
}

__global__ void __launch_bounds__(512, 2) k_fwd(P p, int ph_lo, int ph_hi) {
    extern __shared__ __attribute__((aligned(16))) unsigned char smem[];
    unsigned char* lds = smem + 16;
    unsigned char* ws = p.ws;
    XcdBarrier bar;
    const bool multi = (ph_hi - ph_lo) > 1;
    if (multi) {
        if (threadIdx.x == 0) *(uint4*)smem = make_uint4(0u, 0u, 0u, 0u);
        __syncthreads();
        bar = xcd_barrier_post((unsigned*)(ws + OFF_CTL), (volatile LAS unsigned*)smem);
    }
#define PH(i) (ph_lo <= (i) && (i) < ph_hi)
#define SEAM(i) do { if ((i) + 1 < ph_hi) xcd_barrier(bar); else __syncthreads(); } while (0)
    bf16_t *XN = (bf16_t*)(ws + OFF_XN), *QB = (bf16_t*)(ws + OFF_QB), *KB = (bf16_t*)(ws + OFF_KB), *VB = (bf16_t*)(ws + OFF_VB), *TMP = (bf16_t*)(ws + OFF_TMP), *Y = (bf16_t*)(ws + OFF_Y);
    if (PH(0)) { phase_prep(p, lds); SEAM(0); }
    if (PH(1)) { G1 f{XN, (const bf16_t*)(ws + OFF_W0T), QB, KB, VB}; sgemm(f, 512 * 48); SEAM(1); }
    if (PH(2)) { phase_conv_scan(p, lds); SEAM(2); }
    if (PH(3)) { GM1 f{Y, TMP, (const float*)(ws + OFF_BQ), (const float*)(ws + OFF_IQ), (const float*)(ws + OFF_MT), (float*)(ws + OFF_QB)}; sgemm(f, 2048); SEAM(3); }
    if (PH(4)) { phase_mlstm_seq(p, lds); SEAM(4); }
    if (PH(5)) { G2 f{XN, (const bf16_t*)(ws + OFF_W0T), QB, KB, VB, Y}; sgemm(f, 512 * 64); SEAM(5); }
    if (PH(6)) { phase_ya_pool(p); SEAM(6); }
    if (PH(7)) { G3 f{XN, (const bf16_t*)(ws + OFF_WPT), p.e_s_pool, Y}; sgemm(f, 512 * 16); SEAM(7); }
    if (PH(8)) { G4 f{Y, (const bf16_t*)(ws + OFF_WO0T), p.x, p.out}; sgemm(f, 512 * 16); SEAM(8); }
    if (PH(9)) { rmsnorm_rows<4>(p.out, p.o_norm, XN, p.o_w_in, OIN, 1600, nullptr, 0.5f, (float*)(ws + OFF_WI)); SEAM(9); }
    if (PH(10)) { G5 f{XN, (const bf16_t*)(ws + OFF_W1T), QB, (float*)(ws + OFF_CKVR), (float*)(ws + OFF_QI), (float*)(ws + OFF_KI), KB}; sgemm(f, 512 * 44); SEAM(10); }
    if (PH(11)) { phase_qnorm_ckvnorm(p); SEAM(11); }
    if (PH(12)) { G67 f{(const bf16_t*)(ws + OFF_CKVN), (const bf16_t*)(ws + OFF_WUKT), (const bf16_t*)(ws + OFF_WUVT), VB, TMP}; sgemm(f, 16384); SEAM(12); }
    if (PH(13)) { headnorm64(VB, p.o_g_k); phase_indexer(p, lds); SEAM(13); }
    if (PH(14)) { phase_attn(p, lds); SEAM(14); }
    if (PH(15)) { G8 f{XN, (const bf16_t*)(ws + OFF_WO1T), p.out}; sgemm(f, 512 * 16); }
#undef PH
#undef SEAM
}

extern "C" void kernel_launch(void* const* d_in, const int* in_sizes, int n_in, void* d_out, int out_size, void* d_ws, size_t ws_size, hipStream_t stream) {
    static int grid = 0;
    if (grid == 0) {
        if (n_in != 18 || out_size != T * DM || ws_size < WS_END) { fprintf(stderr, "kernel_launch: unexpected shapes (n_in %d out %d ws %zu)\n", n_in, out_size, ws_size); grid = -1; return; }
        if (hipFuncSetAttribute((const void*)k_fwd, hipFuncAttributeMaxDynamicSharedMemorySize, LDS_BYTES) != hipSuccess) { fprintf(stderr, "kernel_launch: hipFuncSetAttribute failed\n"); grid = -1; return; }
        grid = 256;
    }
    if (grid < 0) return;
    (void)hipMemsetAsync((char*)d_ws + OFF_CTL, 0, 16384, stream);
    P p{};
    p.x = (const float*)d_in[0]; p.e_norm = (const float*)d_in[1]; p.e_w_in = (const float*)d_in[2]; p.e_conv = (const float*)d_in[3]; p.e_b_if = (const float*)d_in[4];
    p.e_g_head = (const float*)d_in[5]; p.e_w_pool = (const float*)d_in[6]; p.e_s_pool = (const float*)d_in[7]; p.e_w_out = (const float*)d_in[8];
    p.o_norm = (const float*)d_in[9]; p.o_w_in = (const float*)d_in[10]; p.o_g_kv = (const float*)d_in[11]; p.o_w_uk = (const float*)d_in[12]; p.o_w_uv = (const float*)d_in[13];
    p.o_g_q = (const float*)d_in[14]; p.o_g_k = (const float*)d_in[15]; p.o_w_out = (const float*)d_in[16]; p.rel_bias = (const float*)d_in[17];
    p.out = (float*)d_out; p.ws = (unsigned char*)d_ws;
    hipLaunchKernelGGL(k_fwd, dim3(grid), dim3(512), LDS_BYTES, stream, p, 0, NPH);
}
```

```cpp
#include <hip/hip_runtime.h>
#include <stdint.h>
#include <cstdio>

typedef unsigned short bf16_t;
typedef short bf16x8 __attribute__((ext_vector_type(8)));
typedef float f32x4 __attribute__((ext_vector_type(4)));
typedef unsigned u32x4 __attribute__((ext_vector_type(4)));
typedef unsigned u32x2 __attribute__((ext_vector_type(2)));
#define LAS __attribute__((address_space(3)))

constexpr int T = 32768, SEQ = 16384, DM = 1024;
constexpr int EIN = 7176, OIN = 2628;
constexpr float EPS = 1e-6f;
constexpr size_t MB = 1048576;
constexpr size_t OFF_CTL = 0;
constexpr size_t OFF_GATES = 64 * 1024;
constexpr size_t OFF_BQ = OFF_GATES + (size_t)T * 8 * 4;
constexpr size_t OFF_IQ = OFF_BQ + (size_t)T * 4 * 4;
constexpr size_t OFF_MT = OFF_IQ + (size_t)T * 4 * 4;
constexpr size_t OFF_WI = OFF_MT + (size_t)T * 4 * 4;
constexpr size_t OFF_CH = OFF_WI + (size_t)T * 4 * 4;
constexpr size_t OFF_W = 4 * MB;
constexpr size_t OFF_W0T = OFF_W;
constexpr size_t OFF_WPT = OFF_W0T + (size_t)7168 * 1024 * 2;
constexpr size_t OFF_WO0T = OFF_WPT + (size_t)4 * 256 * 256 * 2;
constexpr size_t OFF_W1T = OFF_WO0T + (size_t)1024 * 2048 * 2;
constexpr size_t OFF_WUKT = OFF_W1T + (size_t)2816 * 1024 * 2;
constexpr size_t OFF_WUVT = OFF_WUKT + (size_t)1024 * 256 * 2;
constexpr size_t OFF_WO1T = OFF_WUVT + (size_t)1024 * 256 * 2;
constexpr size_t OFF_XN = 36 * MB, OFF_QB = 100 * MB, OFF_KB = 164 * MB, OFF_VB = 228 * MB, OFF_TMP = 292 * MB, OFF_Y = 356 * MB;
constexpr size_t OFF_CKVR = OFF_Y;
constexpr size_t OFF_QI = OFF_Y + 32 * MB;
constexpr size_t OFF_KI = OFF_Y + 64 * MB;
constexpr size_t OFF_CKVN = OFF_Y + 72 * MB;
constexpr size_t OFF_IDX = OFF_Y + 88 * MB;
constexpr size_t OFF_CNT = OFF_Y + 120 * MB;
constexpr size_t WS_END = 484 * MB;
constexpr int LDS_BYTES = 147456;
constexpr int NPH = 15;

struct P {
    const float *x, *e_norm, *e_w_in, *e_conv, *e_b_if, *e_g_head, *e_w_pool, *e_s_pool, *e_w_out;
    const float *o_norm, *o_w_in, *o_g_kv, *o_w_uk, *o_w_uv, *o_g_q, *o_g_k, *o_w_out, *rel_bias;
    float* out; unsigned char* ws;
};

__device__ __forceinline__ bf16_t f2bf(float f) { unsigned u = __float_as_uint(f); u += 0x7FFFu + ((u >> 16) & 1u); return (bf16_t)(u >> 16); }
__device__ __forceinline__ float bf2f(bf16_t b) { return __uint_as_float(((unsigned)b) << 16); }
__device__ __forceinline__ float bflo(unsigned w) { return __uint_as_float(w << 16); }
__device__ __forceinline__ float bfhi(unsigned w) { return __uint_as_float(w & 0xffff0000u); }
__device__ __forceinline__ unsigned pk2(float a, float b) { return (unsigned)f2bf(a) | ((unsigned)f2bf(b) << 16); }
__device__ __forceinline__ float sigmoidf_(float x) { return 1.0f / (1.0f + __expf(-x)); }
__device__ __forceinline__ float siluf_(float x) { return x / (1.0f + __expf(-x)); }
__device__ __forceinline__ float wave_sum(float v) {
#pragma unroll
    for (int o = 32; o >= 1; o >>= 1) v += __shfl_xor(v, o);
    return v;
}
__device__ __forceinline__ float wave_max(float v) {
#pragma unroll
    for (int o = 32; o >= 1; o >>= 1) v = fmaxf(v, __shfl_xor(v, o));
    return v;
}

#define XB_TMO      128
#define XB_XCNT(j)  (256  + 64 * (j))
#define XB_XSUB(j)  (1280 + 64 * (j))
#define XB_XGEN(j)  (2304 + 64 * (j))
#define XB_TOP      3328
#define XB_TOPGEN   3392
#define XCD_BAR_WORDS 3456
#define XB_SPIN_CAP (1u << 22)
__device__ __forceinline__ unsigned xb_ld(unsigned* p)              { return __hip_atomic_load(p, __ATOMIC_RELAXED, __HIP_MEMORY_SCOPE_AGENT); }
__device__ __forceinline__ unsigned xb_add(unsigned* p, unsigned v) { return __hip_atomic_fetch_add(p, v, __ATOMIC_RELAXED, __HIP_MEMORY_SCOPE_AGENT); }
__device__ __forceinline__ unsigned xb_xcc_id() { return (unsigned)__builtin_amdgcn_s_getreg((3 << 11) | 20) & 0xFu; }
#define XB_SPIN(cond, bar) do { unsigned _sp = 0; while (cond) { __builtin_amdgcn_s_sleep(1); \
    if ((++_sp & 255u) == 0u) { if (xb_ld(&(bar)[XB_TMO])) break; if (_sp > XB_SPIN_CAP) { atomicAdd(&(bar)[XB_TMO], 1u); break; } } } } while (0)
struct XcdBarrier { unsigned* bar; unsigned x; volatile LAS unsigned* st; };
__device__ __forceinline__ XcdBarrier xcd_barrier_post(unsigned* bar, volatile LAS unsigned* st) {
    XcdBarrier b; b.bar = bar; b.x = xb_xcc_id(); b.st = st;
    if (threadIdx.x == 0) (void)xb_add(&bar[XB_XCNT(b.x)], 1u);
    return b;
}
__device__ __forceinline__ void xcd_barrier_complete(unsigned* bar, unsigned x, unsigned& nloc, unsigned& nx) {
    const unsigned G = gridDim.x * gridDim.y * gridDim.z;
    unsigned sum, cnt, mine, sp = 0u;
    for (;;) {
        sum = 0u; cnt = 0u; mine = 0u;
#pragma unroll
        for (unsigned j = 0; j < 16; ++j) { const unsigned c = xb_ld(&bar[XB_XCNT(j)]); sum += c; cnt += (c > 0u) ? 1u : 0u; mine = (j == x) ? c : mine; }
        if (sum == G) break;
        __builtin_amdgcn_s_sleep(1);
        if ((++sp & 255u) == 0u) { if (xb_ld(&bar[XB_TMO])) break; if (sp > XB_SPIN_CAP) { atomicAdd(&bar[XB_TMO], 1u); break; } }
    }
    nloc = mine > 0u ? mine : 1u; nx = cnt > 0u ? cnt : 1u;
}
__device__ __forceinline__ void xcd_barrier(const XcdBarrier& b) {
    asm volatile("s_waitcnt vmcnt(0)" ::: "memory");
    __syncthreads();
    if (threadIdx.x == 0) {
        unsigned* bar = b.bar;
        __builtin_amdgcn_s_waitcnt(0);
        unsigned nloc = b.st[0], nx = b.st[1];
        if (nloc == 0u) { xcd_barrier_complete(bar, b.x, nloc, nx); b.st[0] = nloc; b.st[1] = nx; }
        const unsigned old = xb_add(&bar[XB_XSUB(b.x)], 1u);
        const unsigned gen = old / nloc;
        if (old + 1u == (gen + 1u) * nloc) {
            __builtin_amdgcn_fence(__ATOMIC_RELEASE, "agent");
            asm volatile("s_waitcnt vmcnt(0)" ::: "memory");
            const unsigned og = xb_add(&bar[XB_TOP], 1u);
            const unsigned tg = og / nx;
            if (og + 1u == (tg + 1u) * nx) xb_add(&bar[XB_TOPGEN], 1u);
            else XB_SPIN(xb_ld(&bar[XB_TOPGEN]) == tg, bar);
            __builtin_amdgcn_fence(__ATOMIC_ACQUIRE, "agent");
            xb_add(&bar[XB_XGEN(b.x)], 1u);
            asm volatile("s_waitcnt vmcnt(0)" ::: "memory");
        } else {
            XB_SPIN(xb_ld(&bar[XB_XGEN(b.x)]) == gen, bar);
            __builtin_amdgcn_fence(__ATOMIC_ACQUIRE, "agent");
            asm volatile("s_waitcnt vmcnt(0)" ::: "memory");
        }
    }
    __syncthreads();
}

struct Tile { const bf16_t* A; const bf16_t* B; int lda, ldb, K; void* d0; const void* s0; int ld, mode; float aux0, aux1, aux2; int i0, i1; };
template <class F>
__device__ __forceinline__ void sgemm(const F f, int nunits) {
    const int lane = threadIdx.x & 63, wave = threadIdx.x >> 6, fr = lane & 15, fq = lane >> 4;
    for (int u = blockIdx.x * 8 + wave; u < nunits; u += gridDim.x * 8) {
        Tile tl; f.tile(u, tl);
        f32x4 acc[4][4];
#pragma unroll
        for (int m = 0; m < 4; ++m)
#pragma unroll
            for (int n = 0; n < 4; ++n) acc[m][n] = (f32x4){0.f, 0.f, 0.f, 0.f};
        const bf16_t* ap = tl.A + (size_t)fr * tl.lda + fq * 8;
        const bf16_t* bp = tl.B + (size_t)fr * tl.ldb + fq * 8;
        const int K = tl.K, lda = tl.lda, ldb = tl.ldb;
#pragma unroll 1
        for (int k0 = 0; k0 < K; k0 += 32) {
            bf16x8 a[4], b[4];
#pragma unroll
            for (int m = 0; m < 4; ++m) a[m] = *(const bf16x8*)(ap + (size_t)(m * 16) * lda + k0);
#pragma unroll
            for (int n = 0; n < 4; ++n) b[n] = *(const bf16x8*)(bp + (size_t)(n * 16) * ldb + k0);
#pragma unroll
            for (int m = 0; m < 4; ++m)
#pragma unroll
                for (int n = 0; n < 4; ++n) acc[m][n] = __builtin_amdgcn_mfma_f32_16x16x32_bf16(a[m], b[n], acc[m][n], 0, 0, 0);
        }
#pragma unroll
        for (int m = 0; m < 4; ++m)
#pragma unroll
            for (int j = 0; j < 4; ++j) {
                const int r = m * 16 + fq * 4 + j;
                asm volatile("" ::: "memory");
#pragma unroll
                for (int n = 0; n < 4; ++n) f.out(tl, r, n * 16 + fr, acc[m][n][j]);
            }
    }
}
__device__ __forceinline__ void store_mode(const Tile& tl, int r, int c, float v) {
    const size_t i = (size_t)r * tl.ld + c;
    if (tl.mode == 0) ((bf16_t*)tl.d0)[i] = f2bf(v);
    else if (tl.mode == 1) ((bf16_t*)tl.d0)[i] = f2bf(sigmoidf_(v));
    else if (tl.mode == 2) ((bf16_t*)tl.d0)[i] = f2bf(siluf_(v));
    else if (tl.mode == 3) ((float*)tl.d0)[i] = v * tl.aux0;
}

struct G1 {
    const bf16_t* XN; const bf16_t* W; bf16_t *Q, *K_, *V;
    __device__ __forceinline__ void tile(int u, Tile& tl) const {
        const int mt = u / 48, nt = u % 48; tl.A = XN + (size_t)mt * 64 * 1024; tl.lda = 1024; tl.B = W + (size_t)nt * 64 * 1024; tl.ldb = 1024; tl.K = 1024;
        const int col = nt * 64, sec = col >> 10, cc = col & 1023; bf16_t* d = Q + (size_t)sec * (32 * MB);
        tl.d0 = d + (size_t)mt * 64 * 1024 + cc; tl.ld = 1024; tl.mode = 0; }
    __device__ __forceinline__ void out(const Tile& tl, int r, int c, float v) const { store_mode(tl, r, c, v); }
};
struct G2 {
    const bf16_t* XN; const bf16_t* W; bf16_t *O, *ZA, *U, *Y;
    __device__ __forceinline__ void tile(int u, Tile& tl) const {
        const int mt = u / 64, nt = u % 64; tl.A = XN + (size_t)mt * 64 * 1024; tl.lda = 1024; tl.B = W + (size_t)(3072 + nt * 64) * 1024; tl.ldb = 1024; tl.K = 1024;
        const int col = nt * 64, sec = col >> 10, cc = col & 1023;
        if (sec == 0) { tl.d0 = O + (size_t)mt * 64 * 1024 + cc; tl.ld = 1024; tl.mode = 1; }
        else if (sec == 1) { tl.d0 = ZA + (size_t)mt * 64 * 1024 + cc; tl.ld = 1024; tl.mode = 2; }
        else if (sec == 2) { tl.d0 = U + (size_t)mt * 64 * 1024 + cc; tl.ld = 1024; tl.mode = 0; }
        else { tl.d0 = Y + (size_t)mt * 64 * 2048 + 1024 + cc; tl.ld = 2048; tl.mode = 2; } }
    __device__ __forceinline__ void out(const Tile& tl, int r, int c, float v) const { store_mode(tl, r, c, v); }
};
struct GM1 {
    const bf16_t* Y; const bf16_t* KT; const float *BQ, *IQ, *MT; float* W;
    __device__ __forceinline__ void tile(int u, Tile& tl) const {
        const int bh = u >> 8, c = u & 255, batch = bh >> 2, head = bh & 3; const size_t t0 = (size_t)batch * SEQ + c * 64;
        tl.A = Y + t0 * 2048 + 1024 + head * 256; tl.lda = 2048; tl.B = KT + t0 * 1024 + head * 256; tl.ldb = 1024; tl.K = 256;
        tl.d0 = W + (size_t)u * 4096; tl.ld = 64; tl.mode = 0; tl.i0 = (int)(t0 * 4 + head); }
    __device__ __forceinline__ void out(const Tile& tl, int r, int c, float v) const {
        float w = 0.f;
        if (c <= r) w = __expf(BQ[tl.i0 + r * 4] - BQ[tl.i0 + c * 4] + IQ[tl.i0 + c * 4] - MT[tl.i0 + r * 4]) * v;
        ((float*)tl.d0)[r * 64 + c] = w; }
};
struct G3 {
    const bf16_t* XN; const bf16_t* W; const float* sp; bf16_t* Y;
    __device__ __forceinline__ void tile(int u, Tile& tl) const {
        const int mt = u >> 4, g = (u >> 2) & 3, nt = u & 3; tl.A = XN + (size_t)mt * 64 * 1024 + g * 256; tl.lda = 1024; tl.B = W + (size_t)(g * 256 + nt * 64) * 256; tl.ldb = 256; tl.K = 256;
        const int col = g * 256 + nt * 64; tl.d0 = Y + (size_t)mt * 64 * 2048 + 1024 + col; tl.ld = 2048; tl.s0 = sp + col; tl.mode = 0; }
    __device__ __forceinline__ void out(const Tile& tl, int r, int c, float v) const {
        bf16_t* d = (bf16_t*)tl.d0 + (size_t)r * 2048 + c; *d = f2bf(v * ((const float*)tl.s0)[c] * bf2f(*d)); }
};
struct G4 {
    const bf16_t* Y; const bf16_t* W; const float* x; float* out_;
    __device__ __forceinline__ void tile(int u, Tile& tl) const {
        const int mt = u >> 4, nt = u & 15; tl.A = Y + (size_t)mt * 64 * 2048; tl.lda = 2048; tl.B = W + (size_t)nt * 64 * 2048; tl.ldb = 2048; tl.K = 2048;
        const size_t o = (size_t)mt * 64 * 1024 + nt * 64; tl.d0 = out_ + o; tl.s0 = x + o; tl.ld = 1024; tl.mode = 0; }
    __device__ __forceinline__ void out(const Tile& tl, int r, int c, float v) const { const size_t i = (size_t)r * 1024 + c; ((float*)tl.d0)[i] = ((const float*)tl.s0)[i] + v; }
};
struct G5 {
    const bf16_t* XN; const bf16_t* W; bf16_t* Q; float *CKVR, *QI, *KI; bf16_t* Z;
    __device__ __forceinline__ void tile(int u, Tile& tl) const {
        const int mt = u / 44, nt = u % 44; tl.A = XN + (size_t)mt * 64 * 1024; tl.lda = 1024; tl.B = W + (size_t)nt * 64 * 1024; tl.ldb = 1024; tl.K = 1024;
        const int col = nt * 64; const size_t row0 = (size_t)mt * 64; tl.aux0 = 1.0f;
        if (col < 1024) { tl.d0 = Q + row0 * 1024 + col; tl.ld = 1024; tl.mode = 0; }
        else if (col < 1280) { tl.d0 = CKVR + row0 * 256 + (col - 1024); tl.ld = 256; tl.mode = 3; }
        else if (col < 1536) { tl.d0 = QI + row0 * 256 + (col - 1280); tl.ld = 256; tl.mode = 3; tl.aux0 = 0.125f; }
        else if (col < 1600) { tl.d0 = KI + row0 * 64 + (col - 1536); tl.ld = 64; tl.mode = 3; }
        else if (col < 1792) { tl.d0 = nullptr; tl.ld = 0; tl.mode = 4; }
        else { tl.d0 = Z + row0 * 1024 + (col - 1792); tl.ld = 1024; tl.mode = 2; } }
    __device__ __forceinline__ void out(const Tile& tl, int r, int c, float v) const { store_mode(tl, r, c, v); }
};
struct G67 {
    const bf16_t* C; const bf16_t *WK, *WV; bf16_t *KF, *VF;
    __device__ __forceinline__ void tile(int u, Tile& tl) const {
        const int which = u >= 8192, uu = u & 8191, mt = uu >> 4, nt = uu & 15; tl.A = C + (size_t)mt * 64 * 256; tl.lda = 256; tl.B = WK + (size_t)which * (1024 * 256) + (size_t)nt * 64 * 256;     tl.ldb = 256; tl.K = 256;
        tl.d0 = KF + (size_t)which * (32 * MB) + (size_t)mt * 64 * 1024 + nt * 64;     tl.ld = 1024; tl.mode = 0; }
    __device__ __forceinline__ void out(const Tile& tl, int r, int c, float v) const { store_mode(tl, r, c, v); }
};
struct G8 {
    const bf16_t* G; const bf16_t* W; float* out_;
    __device__ __forceinline__ void tile(int u, Tile& tl) const {
        const int mt = u >> 4, nt = u & 15; tl.A = G + (size_t)mt * 64 * 1024; tl.lda = 1024; tl.B = W + (size_t)nt * 64 * 1024; tl.ldb = 1024; tl.K = 1024;
        tl.d0 = out_ + (size_t)mt * 64 * 1024 + nt * 64; tl.ld = 1024; tl.mode = 0; }
    __device__ __forceinline__ void out(const Tile& tl, int r, int c, float v) const { float* d = (float*)tl.d0 + (size_t)r * 1024 + c; *d = *d + v; }
};

namespace pg8 {
constexpr int BM = 256, BK = 64, HALF = 128, HTB = HALF * BK * 2, STAGE_BYTES = 8 * HTB, NXCD = 8, WGM = 8;
__device__ __forceinline__ int lds_byte(int r, int c) { const int st = (r >> 4) * 2 + (c >> 5), rr = r & 15, cc = c & 31, ob = rr * 64 + cc * 2; return st * 1024 + (ob ^ (((ob >> 9) & 1) << 5)); }
__device__ __forceinline__ void stage_rc(int b, int& R, int& C) { const int st = b / 1024, sb = b % 1024, swz = sb ^ (((sb >> 9) & 1) << 5); R = (st >> 1) * 16 + swz / 64; C = (st & 1) * 32 + (swz % 64) / 2; }
__device__ __forceinline__ int perm32(int rho) { const int n = rho >> 4, i = rho & 15; return 8 * (i >> 2) + 4 * n + (i & 3); }
struct Unit { int pm, pn; };
struct Gemm { const bf16_t* A; int lda; const bf16_t* Bt; int ldb; int M, N, K; };
struct StaticOrder {
    int nM, nN, nwg, G, c;
    __device__ void init(int M, int N, int G_, int c_) { nM = M / BM; nN = N / BM; nwg = nM * nN; G = G_; c = c_; }
    __device__ bool next(int i, Unit& u) const {
        const long L = (long)i * G + c; if (L >= nwg) return false;
        int wgid = (int)L; { const int q = nwg / NXCD, r = nwg % NXCD, xcd = wgid % NXCD, off = wgid / NXCD; wgid = (xcd < r ? xcd * (q + 1) : r * (q + 1) + (xcd - r) * q) + off; }
        const int nig = WGM * nN, gid = wgid / nig, fm = gid * WGM, gsz = (nM - fm) < WGM ? (nM - fm) : WGM;
        u.pm = fm + ((wgid % nig) % gsz); u.pn = (wgid % nig) / gsz; return true;
    }
};
__device__ __forceinline__ unsigned cvt_pk_bf16(float lo, float hi) { unsigned r; asm volatile("v_cvt_pk_bf16_f32 %0, %1, %2" : "=v"(r) : "v"(lo), "v"(hi)); return r; }

struct Dst { unsigned char* base; const float* res; int ld, mode, ncol; float scale; };
template <class DescF> struct EpiGen {
    static constexpr bool PERM = true;
    DescF D;
    __device__ __forceinline__ void operator()(const f32x4 (&acc)[2][2][4][2], const Unit& u, int wr, int wc, int fr, int fq) const {
        Dst d; D.get(u, d);
        if (d.mode == 4) return;
        const int r0 = wr * 64 + fr, c0 = wc * 32 + 8 * fq;
#pragma unroll
        for (int ai = 0; ai < 2; ++ai)
#pragma unroll
            for (int m = 0; m < 4; ++m) {
                const size_t rowoff = (size_t)(ai * HALF + r0 + m * 16) * d.ld;
#pragma unroll
                for (int bj = 0; bj < 2; ++bj) {
                    const int col = bj * HALF + c0; f32x4 v0 = acc[ai][bj][m][0], v1 = acc[ai][bj][m][1];
                    if (d.mode <= 2) {
                        if (d.mode == 1) {
#pragma unroll
                            for (int j = 0; j < 4; ++j) { v0[j] = sigmoidf_(v0[j]); v1[j] = sigmoidf_(v1[j]); } }
                        if (d.mode == 2) {
#pragma unroll
                            for (int j = 0; j < 4; ++j) { v0[j] = siluf_(v0[j]); v1[j] = siluf_(v1[j]); } }
                        u32x4 w; w.x = cvt_pk_bf16(v0[0], v0[1]); w.y = cvt_pk_bf16(v0[2], v0[3]); w.z = cvt_pk_bf16(v1[0], v1[1]); w.w = cvt_pk_bf16(v1[2], v1[3]);
                        *(u32x4*)((bf16_t*)d.base + rowoff + col) = w;
                    } else if (d.mode == 3) {
                        if (col < d.ncol) { float* o = (float*)d.base + rowoff + col; *(f32x4*)o = v0 * d.scale; *(f32x4*)(o + 4) = v1 * d.scale; }
                    } else {
                        float* o = (float*)d.base + rowoff + col; const float* rs = d.res + rowoff + col;
                        const f32x4 a = *(const f32x4*)rs, b = *(const f32x4*)(rs + 4); *(f32x4*)o = a + v0; *(f32x4*)(o + 4) = b + v1;
                    }
                }
                if (m & 1) asm volatile("" ::: "memory");
            }
    }
};

template <class Epi>
__device__ __forceinline__ void gemm_phase(LAS unsigned char* lds, const Gemm g, const StaticOrder& S, const Epi& E) {
    const int tid = threadIdx.x, wid = __builtin_amdgcn_readfirstlane(tid >> 6), lane = tid & 63, wr = wid >> 2, wc = wid & 3, fr = lane & 15, fq = lane >> 4;
    const int K = g.K, nt = K / BK;
    unsigned voffA[2], voffB[2];
#pragma unroll
    for (int i = 0; i < 2; ++i) { int R, C; stage_rc(tid * 16 + i * 8192, R, C); const int Rb = Epi::PERM ? ((R & ~31) + perm32(R & 31)) : R;
        voffA[i] = (unsigned)(R * g.lda + C) * 2u; voffB[i] = (unsigned)(Rb * g.ldb + C) * 2u; }
    const size_t kstep = (size_t)(BK * 2);
    const size_t hstepA = (size_t)HALF * g.lda * 2, hstepB = (size_t)HALF * g.ldb * 2;
    const size_t tstepA = 2 * hstepA, tstepB = 2 * hstepB;
    const unsigned ldsw = (unsigned)wid * 1024u;
    const int aoff = lds_byte(wr * 64 + fr, fq * 8), boff = lds_byte(wc * 32 + fr, fq * 8);
#define PG8_SA(b, h) (((b) * 2 + (h)) * HTB)
#define PG8_SB(b, h) ((4 + (b) * 2 + (h)) * HTB)
#define PG8_STAGE(bufoff, gbase, voff) do { _Pragma("unroll") for (int _i = 0; _i < 2; ++_i) \
        __builtin_amdgcn_global_load_lds((const unsigned*)((const char*)(gbase) + (voff)[_i]), (LAS unsigned*)(lds + (bufoff) + ldsw + _i * 8192), 16, 0, 0); } while (0)
#define PG8_LDA(dst, b, h) do { _Pragma("unroll") for (int m = 0; m < 4; ++m) _Pragma("unroll") for (int k = 0; k < 2; ++k) dst[m][k] = *(const LAS bf16x8*)(lds + PG8_SA(b, h) + aoff + m * 2048 + k * 1024); } while (0)
#define PG8_LDB(dst, b, h) do { _Pragma("unroll") for (int n = 0; n < 2; ++n) _Pragma("unroll") for (int k = 0; k < 2; ++k) dst[n][k] = *(const LAS bf16x8*)(lds + PG8_SB(b, h) + boff + n * 2048 + k * 1024); } while (0)
#define PG8_MMA(ai, bj, At, Bt) do { __builtin_amdgcn_s_setprio(1); _Pragma("unroll") for (int m = 0; m < 4; ++m) _Pragma("unroll") for (int n = 0; n < 2; ++n) _Pragma("unroll") for (int k = 0; k < 2; ++k) \
        acc[ai][bj][m][n] = __builtin_amdgcn_mfma_f32_16x16x32_bf16(Bt[n][k], At[m][k], acc[ai][bj][m][n], 0, 0, 0); __builtin_amdgcn_s_setprio(0); } while (0)
#define PG8_WAIT_V(n) asm volatile("s_waitcnt vmcnt(" #n ")" ::: "memory")
#define PG8_WAIT_L(n) asm volatile("s_waitcnt lgkmcnt(" #n ")" ::: "memory")
#define PG8_BAR __builtin_amdgcn_s_barrier()
#define PG8_SCHED __builtin_amdgcn_sched_barrier(0)
    Unit cur, nxt; int ui = 0;
    if (!S.next(0, cur)) return;
    f32x4 acc[2][2][4][2];
#pragma unroll
    for (int a = 0; a < 2; ++a)
#pragma unroll
        for (int b = 0; b < 2; ++b)
#pragma unroll
            for (int m = 0; m < 4; ++m)
#pragma unroll
                for (int n = 0; n < 2; ++n) acc[a][b][m][n] = (f32x4){0.f, 0.f, 0.f, 0.f};
    bf16x8 At[4][2], B0[2][2], B1[2][2];
    const char* cA = (const char*)g.A + (size_t)cur.pm * tstepA; const char* cB = (const char*)g.Bt + (size_t)cur.pn * tstepB;
    PG8_STAGE(PG8_SB(0, 0), cB, voffB); PG8_STAGE(PG8_SA(0, 0), cA, voffA); PG8_STAGE(PG8_SB(0, 1), cB + hstepB, voffB); PG8_STAGE(PG8_SA(0, 1), cA + hstepA, voffA);
    if (wr == 1) PG8_BAR;
    PG8_WAIT_V(4); PG8_BAR;
    PG8_STAGE(PG8_SB(1, 0), cB + kstep, voffB); PG8_STAGE(PG8_SA(1, 0), cA + kstep, voffA); PG8_STAGE(PG8_SB(1, 1), cB + hstepB + kstep, voffB);
    PG8_WAIT_V(6); PG8_BAR;
    for (;;) {
        const bool has_next = S.next(ui + 1, nxt);
        const char* nA = has_next ? (const char*)g.A + (size_t)nxt.pm * tstepA : cA; const char* nB = has_next ? (const char*)g.Bt + (size_t)nxt.pn * tstepB : cB;
        for (int t = 0; t < nt; t += 2) {
            const bool last = (t == nt - 2);
            const char* a1 = cA + (size_t)(t + 1) * kstep;
            const char* a2 = last ? nA : cA + (size_t)(t + 2) * kstep; const char* b2 = last ? nB : cB + (size_t)(t + 2) * kstep;
            const char* a3 = a2 + kstep; const char* b3 = b2 + kstep;
            PG8_LDB(B0, 0, 0); PG8_SCHED; PG8_LDA(At, 0, 0); PG8_STAGE(PG8_SA(1, 1), a1 + hstepA, voffA);
            PG8_WAIT_L(8); PG8_BAR; PG8_WAIT_L(0); PG8_MMA(0, 0, At, B0); PG8_BAR; PG8_SCHED;
            PG8_LDB(B1, 0, 1); PG8_STAGE(PG8_SB(0, 0), b2, voffB);
            PG8_BAR; PG8_WAIT_L(0); PG8_MMA(0, 1, At, B1); PG8_BAR;
            PG8_LDA(At, 0, 1); PG8_STAGE(PG8_SA(0, 0), a2, voffA);
            PG8_BAR; PG8_WAIT_L(0); PG8_MMA(1, 0, At, B0); PG8_BAR; PG8_SCHED;
            PG8_STAGE(PG8_SB(0, 1), b2 + hstepB, voffB);
            PG8_WAIT_V(6); PG8_BAR; PG8_MMA(1, 1, At, B1); PG8_BAR;
            PG8_LDB(B0, 1, 0); PG8_SCHED; PG8_LDA(At, 1, 0); PG8_STAGE(PG8_SA(0, 1), a2 + hstepA, voffA);
            PG8_WAIT_L(8); PG8_BAR; PG8_WAIT_L(0); PG8_MMA(0, 0, At, B0); PG8_BAR; PG8_SCHED;
            PG8_LDB(B1, 1, 1); PG8_STAGE(PG8_SB(1, 0), b3, voffB);
            PG8_BAR; PG8_WAIT_L(0); PG8_MMA(0, 1, At, B1); PG8_BAR;
            PG8_LDA(At, 1, 1); PG8_STAGE(PG8_SA(1, 0), a3, voffA);
            PG8_BAR; PG8_WAIT_L(0); PG8_MMA(1, 0, At, B0); PG8_BAR; PG8_SCHED;
            PG8_STAGE(PG8_SB(1, 1), b3 + hstepB, voffB);
            PG8_WAIT_V(6); PG8_BAR; PG8_MMA(1, 1, At, B1); PG8_BAR;
        }
        E(acc, cur, wr, wc, fr, fq);
        if (!has_next) break;
#pragma unroll
        for (int a = 0; a < 2; ++a)
#pragma unroll
            for (int b = 0; b < 2; ++b)
#pragma unroll
                for (int m = 0; m < 4; ++m)
#pragma unroll
                    for (int n = 0; n < 2; ++n) acc[a][b][m][n] = (f32x4){0.f, 0.f, 0.f, 0.f};
        cur = nxt; cA = nA; cB = nB; ++ui;
    }
    PG8_WAIT_V(0);
    if (wr == 0) PG8_BAR;
    PG8_BAR;
#undef PG8_SA
#undef PG8_SB
#undef PG8_STAGE
#undef PG8_LDA
#undef PG8_LDB
#undef PG8_MMA
#undef PG8_WAIT_V
#undef PG8_WAIT_L
#undef PG8_BAR
#undef PG8_SCHED
}
}

struct D1 { unsigned char* ws;
    __device__ __forceinline__ void get(const pg8::Unit& u, pg8::Dst& d) const { const int sec = u.pn >> 2;
        d.base = ws + OFF_QB + (size_t)sec * (64 * MB) + ((size_t)u.pm * 256 * 1024 + (u.pn & 3) * 256) * 2; d.res = nullptr; d.ld = 1024; d.mode = 0; d.ncol = 256; d.scale = 1.f; } };
struct D2 { unsigned char* ws;
    __device__ __forceinline__ void get(const pg8::Unit& u, pg8::Dst& d) const { const int sec = u.pn >> 2, cc = (u.pn & 3) * 256; d.res = nullptr; d.ncol = 256; d.scale = 1.f;
        if (sec < 3) { d.base = ws + OFF_QB + (size_t)sec * (64 * MB) + ((size_t)u.pm * 256 * 1024 + cc) * 2; d.ld = 1024; d.mode = sec == 0 ? 1 : (sec == 1 ? 2 : 0); }
        else { d.base = ws + OFF_Y + ((size_t)u.pm * 256 * 2048 + 1024 + cc) * 2; d.ld = 2048; d.mode = 2; } } };
struct D4 { unsigned char* out; const float* x;
    __device__ __forceinline__ void get(const pg8::Unit& u, pg8::Dst& d) const { const size_t o = (size_t)u.pm * 256 * 1024 + u.pn * 256;
        d.base = out + o * 4; d.res = x + o; d.ld = 1024; d.mode = 5; d.ncol = 256; d.scale = 1.f; } };
struct D5 { unsigned char* ws;
    __device__ __forceinline__ void get(const pg8::Unit& u, pg8::Dst& d) const { const int pn = u.pn; d.res = nullptr; d.ncol = 256; d.scale = 1.f;
        if (pn < 4) { d.base = ws + OFF_QB + ((size_t)u.pm * 256 * 1024 + pn * 256) * 2; d.ld = 1024; d.mode = 0; }
        else if (pn == 4) { d.base = ws + OFF_CKVR + (size_t)u.pm * 256 * 256 * 4; d.ld = 256; d.mode = 3; }
        else if (pn == 5) { d.base = ws + OFF_QI + (size_t)u.pm * 256 * 256 * 4; d.ld = 256; d.mode = 3; d.scale = 0.125f; }
        else if (pn == 6) { d.base = ws + OFF_KI + (size_t)u.pm * 256 * 64 * 4; d.ld = 64; d.mode = 3; d.ncol = 64; }
        else { d.base = ws + OFF_KB + ((size_t)u.pm * 256 * 1024 + (pn - 7) * 256) * 2; d.ld = 1024; d.mode = 2; } } };
struct D67 { unsigned char* ws;
    __device__ __forceinline__ void get(const pg8::Unit& u, pg8::Dst& d) const { const int sec = u.pn >> 2;
        d.base = ws + OFF_VB + (size_t)sec * (64 * MB) + ((size_t)u.pm * 256 * 1024 + (u.pn & 3) * 256) * 2; d.res = nullptr; d.ld = 1024; d.mode = 0; d.ncol = 256; d.scale = 1.f; } };
struct D8 { unsigned char* out;
    __device__ __forceinline__ void get(const pg8::Unit& u, pg8::Dst& d) const { const size_t o = (size_t)u.pm * 256 * 1024 + u.pn * 256;
        d.base = out + o * 4; d.res = (const float*)out + o; d.ld = 1024; d.mode = 5; d.ncol = 256; d.scale = 1.f; } };
template <class DF>
__device__ __forceinline__ void fast_gemm(unsigned char* lds, const bf16_t* A, int lda, const bf16_t* Bt, int ldb, int N, int K, const DF& df) {
    pg8::Gemm g{A, lda, Bt, ldb, T, N, K}; pg8::StaticOrder S; S.init(T, N, (int)gridDim.x, (int)blockIdx.x);
    pg8::EpiGen<DF> E{df};
    pg8::gemm_phase(( LAS unsigned char*)lds, g, S, E);
}

__device__ __forceinline__ void tconv(const float* __restrict__ src, int ld, int col0, int ncols, int K, bf16_t* __restrict__ dst, float* tile  ) {
    const int nkt = K / 64, ntiles = nkt * (ncols / 64), tid = threadIdx.x;
    for (int id = blockIdx.x; id < ntiles; id += gridDim.x) {
        const int kt = id % nkt, nt = id / nkt;
#pragma unroll
        for (int j = 0; j < 8; ++j) { const int e = tid + 512 * j, kk = e >> 6, nn = e & 63; tile[kk * 65 + nn] = src[(size_t)(kt * 64 + kk) * ld + col0 + nt * 64 + nn]; }
        __syncthreads();
#pragma unroll
        for (int j = 0; j < 8; ++j) { const int e = tid + 512 * j, nn = e >> 6, kk = e & 63; dst[(size_t)(nt * 64 + nn) * K + kt * 64 + kk] = f2bf(tile[kk * 65 + nn]); }
        __syncthreads();
    }
}
template <int NE>
__device__ __forceinline__ void rmsnorm_rows(const float* __restrict__ src, const float* __restrict__ g, bf16_t* __restrict__ dst,
                             const float* __restrict__ Wx, int ldw, int col0, const float* __restrict__ bias, float scale, float* __restrict__ dstx) {
    const int lane = threadIdx.x & 63, wave = threadIdx.x >> 6;
    for (int row = blockIdx.x * 8 + wave; row < T; row += gridDim.x * 8) {
        f32x4 v[4]; float ss = 0.f;
#pragma unroll
        for (int i = 0; i < 4; ++i) { v[i] = *(const f32x4*)(src + (size_t)row * 1024 + i * 256 + lane * 4); ss += v[i][0] * v[i][0] + v[i][1] * v[i][1] + v[i][2] * v[i][2] + v[i][3] * v[i][3]; }
        ss = wave_sum(ss);
        const float rstd = rsqrtf(ss * (1.0f / 1024.0f) + EPS);
        float ex[NE];
#pragma unroll
        for (int e = 0; e < NE; ++e) ex[e] = 0.f;
#pragma unroll
        for (int i = 0; i < 4; ++i) {
            asm volatile("" ::: "memory");
            const f32x4 gg = *(const f32x4*)(g + i * 256 + lane * 4);
            f32x4 y; y[0] = v[i][0] * rstd * gg[0]; y[1] = v[i][1] * rstd * gg[1]; y[2] = v[i][2] * rstd * gg[2]; y[3] = v[i][3] * rstd * gg[3];
            u32x2 w; w.x = pk2(y[0], y[1]); w.y = pk2(y[2], y[3]);
            *(u32x2*)(dst + (size_t)row * 1024 + i * 256 + lane * 4) = w;
#pragma unroll
            for (int j = 0; j < 4; ++j) { const float* wr = Wx + (size_t)(i * 256 + lane * 4 + j) * ldw + col0;
#pragma unroll
                for (int e4 = 0; e4 < NE / 4; ++e4) { const f32x4 wv = *(const f32x4*)(wr + e4 * 4);
                    ex[e4 * 4 + 0] += y[j] * wv[0]; ex[e4 * 4 + 1] += y[j] * wv[1]; ex[e4 * 4 + 2] += y[j] * wv[2]; ex[e4 * 4 + 3] += y[j] * wv[3]; } }
        }
#pragma unroll
        for (int e = 0; e < NE; ++e) { const float s = wave_sum(ex[e]); if (lane == 0) dstx[(size_t)row * NE + e] = (s + (bias ? bias[e] : 0.f)) * scale; }
    }
}

__device__ __forceinline__ void phase_prep(const P& p, unsigned char* lds) {
    float* tile = (float*)lds; unsigned char* ws = p.ws;
    bf16_t* W0T = (bf16_t*)(ws + OFF_W0T);
    tconv(p.e_w_in, EIN, 0, 5120, 1024, W0T, tile);
    tconv(p.e_w_in, EIN, 6152, 1024, 1024, W0T + (size_t)6144 * 1024, tile);
    {
        float* arow = tile;
        for (int it = blockIdx.x; it < 4 * 512; it += gridDim.x) {
            const int g = it >> 9, k0 = (it & 511) * 2; const int tid = threadIdx.x, kk = tid >> 8, d = tid & 255;
            __syncthreads();
            arow[tid] = p.e_w_in[(size_t)(k0 + kk) * EIN + 5128 + g * 256 + d];
            __syncthreads();
            const float* wp = p.e_w_pool + (size_t)g * 65536 + d; const float* ar = arow + kk * 256; float acc = 0.f;
#pragma unroll 8
            for (int c = 0; c < 256; ++c) acc += ar[c] * wp[(size_t)c * 256];
            W0T[(size_t)(5120 + g * 256 + d) * 1024 + k0 + kk] = f2bf(acc);
        }
        __syncthreads();
    }
    tconv(p.e_w_out, 1024, 0, 1024, 2048, (bf16_t*)(ws + OFF_WO0T), tile);
    bf16_t* W1T = (bf16_t*)(ws + OFF_W1T);
    tconv(p.o_w_in, OIN, 0, 1600, 1024, W1T, tile);
    for (size_t i = (size_t)blockIdx.x * 512 + threadIdx.x; i < (size_t)192 * 1024; i += (size_t)gridDim.x * 512) W1T[(size_t)1600 * 1024 + i] = 0;
    tconv(p.o_w_in, OIN, 1604, 1024, 1024, W1T + (size_t)1792 * 1024, tile);
    tconv(p.o_w_uk, 1024, 0, 1024, 256, (bf16_t*)(ws + OFF_WUKT), tile);
    tconv(p.o_w_uv, 1024, 0, 1024, 256, (bf16_t*)(ws + OFF_WUVT), tile);
    tconv(p.o_w_out, 1024, 0, 1024, 1024, (bf16_t*)(ws + OFF_WO1T), tile);
    rmsnorm_rows<8>(p.x, p.e_norm, (bf16_t*)(ws + OFF_XN), p.e_w_in, EIN, 5120, p.e_b_if, 1.0f, (float*)(ws + OFF_GATES));
}

__device__ __forceinline__ void phase_conv_scan(const P& p, unsigned char* lds) {
    unsigned char* ws = p.ws; const int tid = threadIdx.x;
    const float* GATES = (const float*)(ws + OFF_GATES);
    float *BQ = (float*)(ws + OFF_BQ), *IQ = (float*)(ws + OFF_IQ), *MT = (float*)(ws + OFF_MT), *CH = (float*)(ws + OFF_CH);
    for (int bh = blockIdx.x; bh < 8; bh += gridDim.x) {
        float* sB = (float*)lds; float* sG = sB + 256; float* sMp = sG + 256; float* sMn = sMp + 256;
        const int batch = bh >> 2, head = bh & 3;
        if (tid < 256) {
            const size_t t0 = (size_t)batch * SEQ + tid * 64; float b = 0.f, rmax = -INFINITY;
            for (int s = 0; s < 64; ++s) { const size_t t = t0 + s; const float ig = GATES[t * 8 + head], f = GATES[t * 8 + 4 + head];
                const float ls = fminf(f, 0.f) - log1pf(__expf(-fabsf(f)));
                b += ls; BQ[t * 4 + head] = b; IQ[t * 4 + head] = ig; rmax = fmaxf(rmax, ig - b); MT[t * 4 + head] = rmax; }
            sB[tid] = b; sG[tid] = b + rmax;
        }
        __syncthreads();
        if (tid == 0) { float m = 0.f; for (int c = 0; c < 256; ++c) { sMp[c] = m; m = fmaxf(sB[c] + m, sG[c]); sMn[c] = m; } }
        __syncthreads();
        if (tid < 256) {
            const float mp = sMp[tid]; CH[bh * 256 + tid] = mp; CH[2048 + bh * 256 + tid] = sMn[tid]; CH[4096 + bh * 256 + tid] = sB[tid];
            const size_t t0 = (size_t)batch * SEQ + tid * 64;
            for (int s = 0; s < 64; ++s) { const size_t t = t0 + s; MT[t * 4 + head] = BQ[t * 4 + head] + fmaxf(mp, MT[t * 4 + head]); }
        }
        __syncthreads();
    }
    const bf16_t* QB = (const bf16_t*)(ws + OFF_QB); const bf16_t* KB = (const bf16_t*)(ws + OFF_KB);
    bf16_t* Y = (bf16_t*)(ws + OFF_Y); bf16_t* KT = (bf16_t*)(ws + OFF_TMP);
    for (size_t it = (size_t)blockIdx.x * 512 + tid; it < (size_t)T * 256; it += (size_t)gridDim.x * 512) {
        const size_t t = it >> 8; const int c0 = (int)(it & 255) * 8, isk = c0 >= 1024, cc = c0 & 1023; const int s = (int)(t & (SEQ - 1));
        const bf16_t* src = isk ? KB : QB;
        float acc[8];
#pragma unroll
        for (int i = 0; i < 8; ++i) acc[i] = 0.f;
#pragma unroll
        for (int j = 0; j < 4; ++j) {
            if (s - 3 + j >= 0) {
                const u32x4 w = *(const u32x4*)(src + (t - 3 + j) * 1024 + cc);
                const f32x4 c0v = *(const f32x4*)(p.e_conv + j * 2048 + c0), c1v = *(const f32x4*)(p.e_conv + j * 2048 + c0 + 4);
                acc[0] += c0v[0] * bflo(w.x); acc[1] += c0v[1] * bfhi(w.x); acc[2] += c0v[2] * bflo(w.y); acc[3] += c0v[3] * bfhi(w.y);
                acc[4] += c1v[0] * bflo(w.z); acc[5] += c1v[1] * bfhi(w.z); acc[6] += c1v[2] * bflo(w.w); acc[7] += c1v[3] * bfhi(w.w);
            }
        }
        const float sc = isk ? 0.0625f : 1.0f;
        u32x4 o; o.x = pk2(siluf_(acc[0]) * sc, siluf_(acc[1]) * sc); o.y = pk2(siluf_(acc[2]) * sc, siluf_(acc[3]) * sc);
        o.z = pk2(siluf_(acc[4]) * sc, siluf_(acc[5]) * sc); o.w = pk2(siluf_(acc[6]) * sc, siluf_(acc[7]) * sc);
        if (isk) *(u32x4*)(KT + t * 1024 + cc) = o; else *(u32x4*)(Y + t * 2048 + 1024 + cc) = o;
    }
}

__device__ __forceinline__ void phase_mlstm_seq(const P& p, unsigned char* lds) {
    unsigned char* ws = p.ws; const int tid = threadIdx.x, lane = tid & 63;
    const bf16_t* Yc = (const bf16_t*)(ws + OFF_Y); bf16_t* Y = (bf16_t*)(ws + OFF_Y);
    const bf16_t* KT = (const bf16_t*)(ws + OFF_TMP); const bf16_t* VB = (const bf16_t*)(ws + OFF_VB);
    const float* Wg = (const float*)(ws + OFF_QB);
    const float *BQ = (const float*)(ws + OFF_BQ), *IQ = (const float*)(ws + OFF_IQ), *MT = (const float*)(ws + OFF_MT), *CH = (const float*)(ws + OFF_CH);
    bf16_t* Qs = (bf16_t*)lds;
    bf16_t* Ks = Qs + 64 * 264;
    float* Ws = (float*)(Ks + 64 * 264);
    float* Vs = Ws + 64 * 65;
    float* Cs = Vs + 64 * 8;
    float* ns = Cs + 8 * 260;
    float* sa = ns + 256;
    float* sden = sa + 64;
    float* ssw = sden + 64;
    for (int wu = blockIdx.x; wu < 256; wu += gridDim.x) {
        const int bh = wu >> 5, vs = wu & 31, batch = bh >> 2, head = bh & 3;
        float c[4] = {0.f, 0.f, 0.f, 0.f}; float nreg = 0.f;
        const int uv = tid >> 6;
        const int ot = tid >> 3, ov = tid & 7;
        for (int ch = 0; ch < 256; ++ch) {
            const size_t t0 = (size_t)batch * SEQ + ch * 64;
            const float mprev = CH[bh * 256 + ch], mnew = CH[2048 + bh * 256 + ch], blast = CH[4096 + bh * 256 + ch];
            const float decay = __expf(blast + mprev - mnew);
            __syncthreads();
#pragma unroll
            for (int j = 0; j < 4; ++j) { const int e = tid + 512 * j, r = e >> 5, cg = e & 31;
                *(u32x4*)(Qs + r * 264 + cg * 8) = *(const u32x4*)(Yc + (t0 + r) * 2048 + 1024 + head * 256 + cg * 8);
                *(u32x4*)(Ks + r * 264 + cg * 8) = *(const u32x4*)(KT + (t0 + r) * 1024 + head * 256 + cg * 8); }
#pragma unroll
            for (int j = 0; j < 8; ++j) { const int e = tid + 512 * j, r = e >> 6, cc = e & 63; Ws[r * 65 + cc] = Wg[((size_t)(bh * 256 + ch)) * 4096 + e]; }
            if (tid < 64) { const u32x4 w = *(const u32x4*)(VB + (t0 + tid) * 1024 + head * 256 + vs * 8);
                float* d = Vs + tid * 8; d[0] = bflo(w.x); d[1] = bfhi(w.x); d[2] = bflo(w.y); d[3] = bfhi(w.y); d[4] = bflo(w.z); d[5] = bfhi(w.z); d[6] = bflo(w.w); d[7] = bfhi(w.w);
                const float bq = BQ[(t0 + tid) * 4 + head], iq = IQ[(t0 + tid) * 4 + head], mt = MT[(t0 + tid) * 4 + head];
                sa[tid] = __expf(bq + mprev - mt); sden[tid] = __expf(-mt); ssw[tid] = __expf(blast - bq + iq - mnew); }
#pragma unroll
            for (int j = 0; j < 4; ++j) Cs[uv * 260 + lane + 64 * j] = c[j];
            if (tid < 256) ns[tid] = nreg;
            __syncthreads();
            {
                float inter = 0.f, ndot = 0.f, intra = 0.f, rsum = 0.f;
                const bf16_t* qr = Qs + ot * 264; const float* cr = Cs + ov * 260;
#pragma unroll 8
                for (int k = 0; k < 256; ++k) inter += cr[k] * bf2f(qr[k]);
#pragma unroll 8
                for (int k = 0; k < 32; ++k) ndot += ns[ov * 32 + k] * bf2f(qr[ov * 32 + k]);
                ndot += __shfl_xor(ndot, 1); ndot += __shfl_xor(ndot, 2); ndot += __shfl_xor(ndot, 4);
#pragma unroll 8
                for (int s = 0; s < 64; ++s) { const float w = Ws[ot * 65 + s]; intra += w * Vs[s * 8 + ov]; rsum += w; }
                const float a = sa[ot]; const float nq = a * ndot + rsum; const float den = fmaxf(fabsf(nq), sden[ot]);
                const float h = (a * inter + intra) / den;
                Y[(t0 + ot) * 2048 + head * 256 + vs * 8 + ov] = f2bf(h);
            }
            {
                float acc[4] = {0.f, 0.f, 0.f, 0.f}; float nacc = 0.f;
                for (int s = 0; s < 64; ++s) { const float sv = ssw[s] * Vs[s * 8 + uv]; const bf16_t* kr = Ks + s * 264 + lane;
#pragma unroll
                    for (int j = 0; j < 4; ++j) acc[j] += sv * bf2f(kr[64 * j]); }
#pragma unroll
                for (int j = 0; j < 4; ++j) c[j] = decay * c[j] + acc[j];
                if (tid < 256) { for (int s = 0; s < 64; ++s) nacc += ssw[s] * bf2f(Ks[s * 264 + tid]); nreg = decay * nreg + nacc; }
            }
        }
        __syncthreads();
    }
}

__device__ __forceinline__ void phase_ya_pool(const P& p) {
    unsigned char* ws = p.ws; const int tid = threadIdx.x, lane = tid & 63, wave = tid >> 6;
    bf16_t* Y = (bf16_t*)(ws + OFF_Y); const bf16_t* O = (const bf16_t*)(ws + OFF_QB); const bf16_t* ZA = (const bf16_t*)(ws + OFF_KB);
    for (int it = blockIdx.x * 8 + wave; it < T * 4; it += gridDim.x * 8) {
        const size_t t = (size_t)(it >> 2); const int head = it & 3, c = head * 256 + lane * 4;
        const u32x2 hw = *(const u32x2*)(Y + t * 2048 + c), ow = *(const u32x2*)(O + t * 1024 + c), zw = *(const u32x2*)(ZA + t * 1024 + c);
        float v[4] = {bflo(hw.x) * bflo(ow.x), bfhi(hw.x) * bfhi(ow.x), bflo(hw.y) * bflo(ow.y), bfhi(hw.y) * bfhi(ow.y)};
        float ss = wave_sum(v[0] * v[0] + v[1] * v[1] + v[2] * v[2] + v[3] * v[3]);
        const float rstd = rsqrtf(ss * (1.0f / 256.0f) + EPS);
        const f32x4 g = *(const f32x4*)(p.e_g_head + c);
        u32x2 o; o.x = pk2(v[0] * rstd * g[0] * bflo(zw.x), v[1] * rstd * g[1] * bfhi(zw.x)); o.y = pk2(v[2] * rstd * g[2] * bflo(zw.y), v[3] * rstd * g[3] * bfhi(zw.y));
        *(u32x2*)(Y + t * 2048 + c) = o;
    }
    const bf16_t* U = (const bf16_t*)(ws + OFF_VB);
    for (size_t it = (size_t)blockIdx.x * 512 + tid; it < (size_t)T * 128; it += (size_t)gridDim.x * 512) {
        const size_t t = it >> 7; const int c0 = (int)(it & 127) * 8, g = c0 >> 8, win = 2 << g, s = (int)(t & (SEQ - 1)); const int cnt = (s + 1 < win) ? s + 1 : win;
        float acc[8], self[8];
#pragma unroll
        for (int i = 0; i < 8; ++i) { acc[i] = 0.f; self[i] = 0.f; }
        for (int j = 0; j < cnt; ++j) { const u32x4 w = *(const u32x4*)(U + (t - j) * 1024 + c0);
            const float f[8] = {bflo(w.x), bfhi(w.x), bflo(w.y), bfhi(w.y), bflo(w.z), bfhi(w.z), bflo(w.w), bfhi(w.w)};
#pragma unroll
            for (int i = 0; i < 8; ++i) { acc[i] += f[i]; if (j == 0) self[i] = f[i]; } }
        const float inv = 1.0f / (float)cnt;
        bf16_t* yp = Y + t * 2048 + 1024 + c0; const u32x4 z = *(const u32x4*)yp;
        const float zf[8] = {bflo(z.x), bfhi(z.x), bflo(z.y), bfhi(z.y), bflo(z.z), bfhi(z.z), bflo(z.w), bfhi(z.w)};
        const f32x4 s0 = *(const f32x4*)(p.e_s_pool + c0), s1 = *(const f32x4*)(p.e_s_pool + c0 + 4);
        float o[8];
#pragma unroll
        for (int i = 0; i < 8; ++i) o[i] = (acc[i] * inv - self[i]) * (i < 4 ? s0[i] : s1[i - 4]) * zf[i];
        u32x4 ow; ow.x = pk2(o[0], o[1]); ow.y = pk2(o[2], o[3]); ow.z = pk2(o[4], o[5]); ow.w = pk2(o[6], o[7]);
        *(u32x4*)yp = ow;
    }
}

__device__ __forceinline__ void headnorm64(bf16_t* X, const float* g) {
    const int lane = threadIdx.x & 63, wave = threadIdx.x >> 6;
    for (int t = blockIdx.x * 8 + wave; t < T; t += gridDim.x * 8) {
        bf16_t* r = X + (size_t)t * 1024 + lane * 16;
        const u32x4 a = *(const u32x4*)r, b = *(const u32x4*)(r + 8);
        float f[16] = {bflo(a.x), bfhi(a.x), bflo(a.y), bfhi(a.y), bflo(a.z), bfhi(a.z), bflo(a.w), bfhi(a.w), bflo(b.x), bfhi(b.x), bflo(b.y), bfhi(b.y), bflo(b.z), bfhi(b.z), bflo(b.w), bfhi(b.w)};
        float ss = 0.f;
#pragma unroll
        for (int i = 0; i < 16; ++i) ss += f[i] * f[i];
        ss += __shfl_xor(ss, 1); ss += __shfl_xor(ss, 2);
        const float rstd = rsqrtf(ss * (1.0f / 64.0f) + EPS);
        const float* gg = g + (lane & 3) * 16;
#pragma unroll
        for (int i = 0; i < 16; ++i) f[i] = f[i] * rstd * gg[i];
        u32x4 oa, ob; oa.x = pk2(f[0], f[1]); oa.y = pk2(f[2], f[3]); oa.z = pk2(f[4], f[5]); oa.w = pk2(f[6], f[7]);
        ob.x = pk2(f[8], f[9]); ob.y = pk2(f[10], f[11]); ob.z = pk2(f[12], f[13]); ob.w = pk2(f[14], f[15]);
        *(u32x4*)r = oa; *(u32x4*)(r + 8) = ob;
    }
}
__device__ __forceinline__ void phase_qnorm_ckvnorm(const P& p) {
    unsigned char* ws = p.ws; const int lane = threadIdx.x & 63, wave = threadIdx.x >> 6;
    headnorm64((bf16_t*)(ws + OFF_QB), p.o_g_q);
    const float* CKVR = (const float*)(ws + OFF_CKVR); bf16_t* CKVN = (bf16_t*)(ws + OFF_CKVN);
    for (int t = blockIdx.x * 8 + wave; t < T; t += gridDim.x * 8) {
        const f32x4 v = *(const f32x4*)(CKVR + (size_t)t * 256 + lane * 4);
        const float ss = wave_sum(v[0] * v[0] + v[1] * v[1] + v[2] * v[2] + v[3] * v[3]);
        const float rstd = rsqrtf(ss * (1.0f / 256.0f) + EPS);
        const f32x4 g = *(const f32x4*)(p.o_g_kv + lane * 4);
        u32x2 o; o.x = pk2(v[0] * rstd * g[0], v[1] * rstd * g[1]); o.y = pk2(v[2] * rstd * g[2], v[3] * rstd * g[3]);
        *(u32x2*)(CKVN + (size_t)t * 256 + lane * 4) = o;
    }
}

__device__ __forceinline__ unsigned okey(float s) { if (s == 0.f) s = 0.f; const unsigned u = __float_as_uint(s); return (u & 0x80000000u) ? ~u : (u | 0x80000000u); }

__device__ __forceinline__ void phase_indexer(const P& p, unsigned char* lds) {
    unsigned char* ws = p.ws; const int tid = threadIdx.x, lane = tid & 63, wave = tid >> 6;
    const float* QI = (const float*)(ws + OFF_QI); const float* KI = (const float*)(ws + OFF_KI); const float* WI = (const float*)(ws + OFF_WI);
    int* IDX = (int*)(ws + OFF_IDX); int* CNT = (int*)(ws + OFF_CNT);
    unsigned* sc = (unsigned*)lds;
    unsigned* hist = sc + 16384;
    float* qs = (float*)(hist + 256);
    unsigned* misc = (unsigned*)(qs + 256);
    unsigned* wsum = misc + 16;
    const int G = gridDim.x, nround = T / G;
    for (int i = 0; i < nround; ++i) {
        const int tq = (i & 1) ? i * G + (G - 1 - (int)blockIdx.x) : i * G + (int)blockIdx.x;
        const int batch = tq & 1, pos = tq >> 1; const size_t t = (size_t)batch * SEQ + pos; const int n = pos + 1;
        if (n <= 256) { if (tid < 256) IDX[t * 256 + tid] = tid < n ? tid : 0; if (tid == 0) CNT[t] = n; continue; }
        __syncthreads();
        if (tid < 256) qs[tid] = QI[t * 256 + tid];
        const float w0 = WI[t * 4 + 0], w1 = WI[t * 4 + 1], w2 = WI[t * 4 + 2], w3 = WI[t * 4 + 3];
        __syncthreads();
        const float* kbase = KI + (size_t)batch * SEQ * 64;
        for (int s = tid; s < n; s += 512) {
            asm volatile("" ::: "memory");
            const f32x4* kr = (const f32x4*)(kbase + (size_t)s * 64);
            float d0 = 0.f, d1 = 0.f, d2 = 0.f, d3 = 0.f;
#pragma unroll
            for (int j = 0; j < 16; ++j) { const f32x4 kv = kr[j];
#pragma unroll
                for (int e = 0; e < 4; ++e) { const int d = j * 4 + e; d0 += qs[d] * kv[e]; d1 += qs[64 + d] * kv[e]; d2 += qs[128 + d] * kv[e]; d3 += qs[192 + d] * kv[e]; } }
            float score = w0 * fmaxf(d0, 0.f); score += w1 * fmaxf(d1, 0.f); score += w2 * fmaxf(d2, 0.f); score += w3 * fmaxf(d3, 0.f);
            sc[s] = okey(score);
        }
        unsigned prefix = 0, krem = 256;
        for (int pass = 0; pass < 4; ++pass) {
            const int shift = 24 - 8 * pass;
            __syncthreads();
            if (tid < 256) hist[tid] = 0;
            __syncthreads();
            for (int s = tid; s < n; s += 512) { const unsigned k = sc[s]; if (pass == 0 || (k >> (shift + 8)) == prefix) atomicAdd(&hist[(k >> shift) & 255u], 1u); }
            __syncthreads();
            if (tid == 0) { unsigned cum = 0; int bin = 255; for (; bin > 0; --bin) { const unsigned c = hist[bin]; if (cum + c >= krem) break; cum += c; } misc[0] = (unsigned)bin; misc[1] = krem - cum; }
            __syncthreads();
            prefix = (prefix << 8) | misc[0]; krem = misc[1];
        }
        const unsigned ngt_total = 256u - krem;
        unsigned lg = 0, le = 0; const int s0 = tid * 32;
        for (int s = s0; s < s0 + 32 && s < n; ++s) { const unsigned k = sc[s]; lg += (k > prefix); le += (k == prefix); }
        unsigned pk = lg | (le << 16), incl = pk;
#pragma unroll
        for (int o = 1; o < 64; o <<= 1) { const unsigned y = __shfl_up(incl, o); if (lane >= o) incl += y; }
        if (lane == 63) wsum[wave] = incl;
        __syncthreads();
        unsigned base = 0;
        for (int w = 0; w < wave; ++w) base += wsum[w];
        const unsigned excl = base + incl - pk; unsigned bg = excl & 0xffffu, be = excl >> 16;
        for (int s = s0; s < s0 + 32 && s < n; ++s) { const unsigned k = sc[s];
            if (k > prefix) { IDX[t * 256 + bg] = s; ++bg; }
            else if (k == prefix) { if (be < krem) IDX[t * 256 + ngt_total + be] = s; ++be; } }
        if (tid == 0) CNT[t] = 256;
    }
}

__device__ __forceinline__ void phase_attn(const P& p, unsigned char* lds) {
    unsigned char* ws = p.ws; const int tid = threadIdx.x, lane = tid & 63, wave = tid >> 6;
    const bf16_t* Q = (const bf16_t*)(ws + OFF_QB); const bf16_t* Kf = (const bf16_t*)(ws + OFF_VB); const bf16_t* Vf = (const bf16_t*)(ws + OFF_TMP);
    const bf16_t* Z = (const bf16_t*)(ws + OFF_KB); bf16_t* Gout = (bf16_t*)(ws + OFF_XN);
    const int* IDX = (const int*)(ws + OFF_IDX); const int* CNT = (const int*)(ws + OFF_CNT);
    float* Pw = (float*)(lds + (size_t)wave * 17408);
    int* Iw = (int*)(Pw + 4096);
    for (int t = blockIdx.x * 8 + wave; t < T; t += gridDim.x * 8) {
        const int batch = t >> 14, pos = t & (SEQ - 1); const int cnt = CNT[t];
        const size_t rb = (size_t)batch * SEQ;
        for (int jj = 0; jj < 4; ++jj) {
            const int j = lane + 64 * jj; const int id = IDX[(size_t)t * 256 + j]; Iw[j] = id;
            if (j < cnt) {
                const int rel = pos - id; int bucket;
                if (rel < 16) bucket = rel; else { bucket = 16 + (int)(__logf((float)rel * 0.0625f) / 2.0794415416798357f * 16.0f); bucket = bucket > 31 ? 31 : bucket; }
                const bf16_t* kr = Kf + (rb + id) * 1024; const bf16_t* qr = Q + (size_t)t * 1024;
                for (int h = 0; h < 16; ++h) {
                    float d = 0.f;
#pragma unroll
                    for (int e = 0; e < 8; ++e) { const u32x4 kw = *(const u32x4*)(kr + h * 64 + e * 8), qw = *(const u32x4*)(qr + h * 64 + e * 8);
                        d += bflo(kw.x) * bflo(qw.x) + bfhi(kw.x) * bfhi(qw.x) + bflo(kw.y) * bflo(qw.y) + bfhi(kw.y) * bfhi(qw.y)
                           + bflo(kw.z) * bflo(qw.z) + bfhi(kw.z) * bfhi(qw.z) + bflo(kw.w) * bflo(qw.w) + bfhi(kw.w) * bfhi(qw.w); }
                    Pw[h * 256 + j] = d * 0.125f + p.rel_bias[bucket * 16 + h];
                }
            } else {
                for (int h = 0; h < 16; ++h) Pw[h * 256 + j] = -INFINITY;
            }
        }
        for (int h = 0; h < 16; ++h) {
            float l0 = Pw[h * 256 + lane], l1 = Pw[h * 256 + lane + 64], l2 = Pw[h * 256 + lane + 128], l3 = Pw[h * 256 + lane + 192];
            float m = fmaxf(fmaxf(l0, l1), fmaxf(l2, l3)); m = wave_max(m);
            l0 = __expf(l0 - m); l1 = __expf(l1 - m); l2 = __expf(l2 - m); l3 = __expf(l3 - m);
            const float s = wave_sum(l0 + l1 + l2 + l3); const float inv = 1.0f / s;
            Pw[h * 256 + lane] = l0 * inv; Pw[h * 256 + lane + 64] = l1 * inv; Pw[h * 256 + lane + 128] = l2 * inv; Pw[h * 256 + lane + 192] = l3 * inv;
        }
        __builtin_amdgcn_fence(__ATOMIC_RELEASE, "workgroup"); __builtin_amdgcn_wave_barrier(); __builtin_amdgcn_fence(__ATOMIC_ACQUIRE, "workgroup");
        float acc[16];
#pragma unroll
        for (int i = 0; i < 16; ++i) acc[i] = 0.f;
        const int hl = lane >> 2;
        for (int j = 0; j < cnt; ++j) {
            const int id = Iw[j]; const float pj = Pw[hl * 256 + j];
            const bf16_t* vr = Vf + (rb + id) * 1024 + lane * 16;
            const u32x4 a = *(const u32x4*)vr, b = *(const u32x4*)(vr + 8);
            acc[0] += pj * bflo(a.x); acc[1] += pj * bfhi(a.x); acc[2] += pj * bflo(a.y); acc[3] += pj * bfhi(a.y);
            acc[4] += pj * bflo(a.z); acc[5] += pj * bfhi(a.z); acc[6] += pj * bflo(a.w); acc[7] += pj * bfhi(a.w);
            acc[8] += pj * bflo(b.x); acc[9] += pj * bfhi(b.x); acc[10] += pj * bflo(b.y); acc[11] += pj * bfhi(b.y);
            acc[12] += pj * bflo(b.z); acc[13] += pj * bfhi(b.z); acc[14] += pj * bflo(b.w); acc[15] += pj * bfhi(b.w);
        }
        const bf16_t* zr = Z + (size_t)t * 1024 + lane * 16;
        const u32x4 za = *(const u32x4*)zr, zb = *(const u32x4*)(zr + 8);
        u32x4 oa, ob;
        oa.x = pk2(acc[0] * bflo(za.x), acc[1] * bfhi(za.x)); oa.y = pk2(acc[2] * bflo(za.y), acc[3] * bfhi(za.y));
        oa.z = pk2(acc[4] * bflo(za.z), acc[5] * bfhi(za.z)); oa.w = pk2(acc[6] * bflo(za.w), acc[7] * bfhi(za.w));
        ob.x = pk2(acc[8] * bflo(zb.x), acc[9] * bfhi(zb.x)); ob.y = pk2(acc[10] * bflo(zb.y), acc[11] * bfhi(zb.y));
        ob.z = pk2(acc[12] * bflo(zb.z), acc[13] * bfhi(zb.z)); ob.w = pk2(acc[14] * bflo(zb.w), acc[15] * bfhi(zb.w));
        bf16_t* go = Gout + (size_t)t * 1024 + lane * 16;
        *(u32x4*)go = oa; *(u32x4*)(go + 8) = ob;
        __builtin_amdgcn_fence(__ATOMIC_RELEASE, "workgroup"); __builtin_amdgcn_wave_barrier(); __builtin_amdgcn_fence(__ATOMIC_ACQUIRE, "workgroup");
    }
}

__global__ void __launch_bounds__(512, 2) k_fwd(P p, int ph_lo, int ph_hi) {
    extern __shared__ __attribute__((aligned(16))) unsigned char smem[];
    unsigned char* lds = smem + 16;
    unsigned char* ws = p.ws;
    XcdBarrier bar;
    const bool multi = (ph_hi - ph_lo) > 1;
    if (multi) {
        if (threadIdx.x == 0) *(uint4*)smem = make_uint4(0u, 0u, 0u, 0u);
        __syncthreads();
        bar = xcd_barrier_post((unsigned*)(ws + OFF_CTL), (volatile LAS unsigned*)smem);
    }
#define PH(i) (ph_lo <= (i) && (i) < ph_hi)
#define SEAM(i) do { if ((i) + 1 < ph_hi) xcd_barrier(bar); else __syncthreads(); } while (0)
    bf16_t *XN = (bf16_t*)(ws + OFF_XN), *QB = (bf16_t*)(ws + OFF_QB), *KB = (bf16_t*)(ws + OFF_KB), *VB = (bf16_t*)(ws + OFF_VB), *TMP = (bf16_t*)(ws + OFF_TMP), *Y = (bf16_t*)(ws + OFF_Y);
    if (PH(0)) { phase_prep(p, lds); SEAM(0); }
    if (PH(1)) { fast_gemm(lds, XN, 1024, (const bf16_t*)(ws + OFF_W0T), 1024, 3072, 1024, D1{ws}); SEAM(1); }
    if (PH(2)) { phase_conv_scan(p, lds); SEAM(2); }
    if (PH(3)) { GM1 f{Y, TMP, (const float*)(ws + OFF_BQ), (const float*)(ws + OFF_IQ), (const float*)(ws + OFF_MT), (float*)(ws + OFF_QB)}; sgemm(f, 2048); SEAM(3); }
    if (PH(4)) { phase_mlstm_seq(p, lds); SEAM(4); }
    if (PH(5)) { fast_gemm(lds, XN, 1024, (const bf16_t*)(ws + OFF_W0T) + (size_t)3072 * 1024, 1024, 4096, 1024, D2{ws}); SEAM(5); }
    if (PH(6)) { phase_ya_pool(p); SEAM(6); }
    if (PH(7)) { fast_gemm(lds, Y, 2048, (const bf16_t*)(ws + OFF_WO0T), 2048, 1024, 2048, D4{(unsigned char*)p.out, p.x}); SEAM(7); }
    if (PH(8)) { rmsnorm_rows<4>(p.out, p.o_norm, XN, p.o_w_in, OIN, 1600, nullptr, 0.5f, (float*)(ws + OFF_WI)); SEAM(8); }
    if (PH(9)) { fast_gemm(lds, XN, 1024, (const bf16_t*)(ws + OFF_W1T), 1024, 2816, 1024, D5{ws}); SEAM(9); }
    if (PH(10)) { phase_qnorm_ckvnorm(p); SEAM(10); }
    if (PH(11)) { fast_gemm(lds, (const bf16_t*)(ws + OFF_CKVN), 256, (const bf16_t*)(ws + OFF_WUKT), 256, 2048, 256, D67{ws}); SEAM(11); }
    if (PH(12)) { headnorm64(VB, p.o_g_k); phase_indexer(p, lds); SEAM(12); }
    if (PH(13)) { phase_attn(p, lds); SEAM(13); }
    if (PH(14)) { fast_gemm(lds, XN, 1024, (const bf16_t*)(ws + OFF_WO1T), 1024, 1024, 1024, D8{(unsigned char*)p.out}); }
#undef PH
#undef SEAM
}

extern "C" void kernel_launch(void* const* d_in, const int* in_sizes, int n_in, void* d_out, int out_size, void* d_ws, size_t ws_size, hipStream_t stream) {
    static int grid = 0;
    if (grid == 0) {
        if (n_in != 18 || out_size != T * DM || ws_size < WS_END) { fprintf(stderr, "kernel_launch: unexpected shapes (n_in %d out %d ws %zu)\n", n_in, out_size, ws_size); grid = -1; return; }
        if (hipFuncSetAttribute((const void*)k_fwd, hipFuncAttributeMaxDynamicSharedMemorySize, LDS_BYTES) != hipSuccess) { fprintf(stderr, "kernel_launch: hipFuncSetAttribute failed\n"); grid = -1; return; }
        grid = 256;
    }
    if (grid < 0) return;
    (void)hipMemsetAsync((char*)d_ws + OFF_CTL, 0, 16384, stream);
    P p{};
    p.x = (const float*)d_in[0]; p.e_norm = (const float*)d_in[1]; p.e_w_in = (const float*)d_in[2]; p.e_conv = (const float*)d_in[3]; p.e_b_if = (const float*)d_in[4];
    p.e_g_head = (const float*)d_in[5]; p.e_w_pool = (const float*)d_in[6]; p.e_s_pool = (const float*)d_in[7]; p.e_w_out = (const float*)d_in[8];
    p.o_norm = (const float*)d_in[9]; p.o_w_in = (const float*)d_in[10]; p.o_g_kv = (const float*)d_in[11]; p.o_w_uk = (const float*)d_in[12]; p.o_w_uv = (const float*)d_in[13];
    p.o_g_q = (const float*)d_in[14]; p.o_g_k = (const float*)d_in[15]; p.o_w_out = (const float*)d_in[16]; p.rel_bias = (const float*)d_in[17];
    p.out = (float*)d_out; p.ws = (unsigned char*)d_ws;
    hipLaunchKernelGGL(k_fwd, dim3(grid), dim3(512), LDS_BYTES, stream, p, 0, NPH);
}
```

```cpp
#include <hip/hip_runtime.h>
#include <stdint.h>
#include <cstdio>

typedef unsigned short bf16_t;
typedef short bf16x8 __attribute__((ext_vector_type(8)));
typedef float f32x4 __attribute__((ext_vector_type(4)));
typedef unsigned u32x4 __attribute__((ext_vector_type(4)));
typedef unsigned u32x2 __attribute__((ext_vector_type(2)));
#define LAS __attribute__((address_space(3)))

constexpr int T = 32768, SEQ = 16384, DM = 1024;
constexpr int EIN = 7176, OIN = 2628;
constexpr float EPS = 1e-6f;
constexpr size_t MB = 1048576;
constexpr size_t OFF_CTL = 0;
constexpr size_t OFF_GATES = 64 * 1024;
constexpr size_t OFF_BQ = OFF_GATES + (size_t)T * 8 * 4;
constexpr size_t OFF_IQ = OFF_BQ + (size_t)T * 4 * 4;
constexpr size_t OFF_MT = OFF_IQ + (size_t)T * 4 * 4;
constexpr size_t OFF_WI = OFF_MT + (size_t)T * 4 * 4;
constexpr size_t OFF_CH = OFF_WI + (size_t)T * 4 * 4;
constexpr size_t OFF_W = 4 * MB;
constexpr size_t OFF_W0T = OFF_W;
constexpr size_t OFF_WPT = OFF_W0T + (size_t)7168 * 1024 * 2;
constexpr size_t OFF_WO0T = OFF_WPT + (size_t)4 * 256 * 256 * 2;
constexpr size_t OFF_W1T = OFF_WO0T + (size_t)1024 * 2048 * 2;
constexpr size_t OFF_WUKT = OFF_W1T + (size_t)2816 * 1024 * 2;
constexpr size_t OFF_WUVT = OFF_WUKT + (size_t)1024 * 256 * 2;
constexpr size_t OFF_WO1T = OFF_WUVT + (size_t)1024 * 256 * 2;
constexpr size_t OFF_WUKP = OFF_WO1T + (size_t)1024 * 1024 * 2;
constexpr size_t OFF_WQP = OFF_WUKP + (size_t)1024 * 256 * 2;
constexpr size_t OFF_XN = 36 * MB, OFF_QB = 100 * MB, OFF_KB = 164 * MB, OFF_VB = 228 * MB, OFF_TMP = 292 * MB, OFF_Y = 356 * MB;
constexpr size_t OFF_QP = 36 * MB;
constexpr size_t OFF_CKVN = OFF_Y;
constexpr size_t OFF_QI = OFF_Y + 16 * MB;
constexpr size_t OFF_KI = OFF_Y + 32 * MB;
constexpr size_t OFF_IDX = OFF_Y + 40 * MB;
constexpr size_t OFF_RK = OFF_Y + 58 * MB;
constexpr size_t OFF_CNT = OFF_Y + 59 * MB;
constexpr size_t OFF_Z = OFF_Y + 60 * MB;
constexpr size_t WS_END = 484 * MB;
constexpr int LDS_BYTES = 151552;
constexpr int NPH = 16;

struct P {
    const float *x, *e_norm, *e_w_in, *e_conv, *e_b_if, *e_g_head, *e_w_pool, *e_s_pool, *e_w_out;
    const float *o_norm, *o_w_in, *o_g_kv, *o_w_uk, *o_w_uv, *o_g_q, *o_g_k, *o_w_out, *rel_bias;
    float* out; unsigned char* ws;
};

__device__ __forceinline__ bf16_t f2bf(float f) { unsigned u = __float_as_uint(f); u += 0x7FFFu + ((u >> 16) & 1u); return (bf16_t)(u >> 16); }
__device__ __forceinline__ float bf2f(bf16_t b) { return __uint_as_float(((unsigned)b) << 16); }
__device__ __forceinline__ float bflo(unsigned w) { return __uint_as_float(w << 16); }
__device__ __forceinline__ float bfhi(unsigned w) { return __uint_as_float(w & 0xffff0000u); }
__device__ __forceinline__ unsigned pk2(float a, float b) { return (unsigned)f2bf(a) | ((unsigned)f2bf(b) << 16); }
__device__ __forceinline__ float sigmoidf_(float x) { return 1.0f / (1.0f + __expf(-x)); }
__device__ __forceinline__ float siluf_(float x) { return x / (1.0f + __expf(-x)); }
__device__ __forceinline__ float wave_sum(float v) {
#pragma unroll
    for (int o = 32; o >= 1; o >>= 1) v += __shfl_xor(v, o);
    return v;
}
__device__ __forceinline__ float wave_max(float v) {
#pragma unroll
    for (int o = 32; o >= 1; o >>= 1) v = fmaxf(v, __shfl_xor(v, o));
    return v;
}

#define XB_TMO      128
#define XB_XCNT(j)  (256  + 64 * (j))
#define XB_XSUB(j)  (1280 + 64 * (j))
#define XB_XGEN(j)  (2304 + 64 * (j))
#define XB_TOP      3328
#define XB_TOPGEN   3392
#define XCD_BAR_WORDS 3456
#define XB_SPIN_CAP (1u << 22)
__device__ __forceinline__ unsigned xb_ld(unsigned* p)              { return __hip_atomic_load(p, __ATOMIC_RELAXED, __HIP_MEMORY_SCOPE_AGENT); }
__device__ __forceinline__ unsigned xb_add(unsigned* p, unsigned v) { return __hip_atomic_fetch_add(p, v, __ATOMIC_RELAXED, __HIP_MEMORY_SCOPE_AGENT); }
__device__ __forceinline__ unsigned xb_xcc_id() { return (unsigned)__builtin_amdgcn_s_getreg((3 << 11) | 20) & 0xFu; }
#define XB_SPIN(cond, bar) do { unsigned _sp = 0; while (cond) { __builtin_amdgcn_s_sleep(1); \
    if ((++_sp & 255u) == 0u) { if (xb_ld(&(bar)[XB_TMO])) break; if (_sp > XB_SPIN_CAP) { atomicAdd(&(bar)[XB_TMO], 1u); break; } } } } while (0)
struct XcdBarrier { unsigned* bar; unsigned x; volatile LAS unsigned* st; };
__device__ __forceinline__ XcdBarrier xcd_barrier_post(unsigned* bar, volatile LAS unsigned* st) {
    XcdBarrier b; b.bar = bar; b.x = xb_xcc_id(); b.st = st;
    if (threadIdx.x == 0) (void)xb_add(&bar[XB_XCNT(b.x)], 1u);
    return b;
}
__device__ __forceinline__ void xcd_barrier_complete(unsigned* bar, unsigned x, unsigned& nloc, unsigned& nx) {
    const unsigned G = gridDim.x * gridDim.y * gridDim.z;
    unsigned sum, cnt, mine, sp = 0u;
    for (;;) {
        sum = 0u; cnt = 0u; mine = 0u;
#pragma unroll
        for (unsigned j = 0; j < 16; ++j) { const unsigned c = xb_ld(&bar[XB_XCNT(j)]); sum += c; cnt += (c > 0u) ? 1u : 0u; mine = (j == x) ? c : mine; }
        if (sum == G) break;
        __builtin_amdgcn_s_sleep(1);
        if ((++sp & 255u) == 0u) { if (xb_ld(&bar[XB_TMO])) break; if (sp > XB_SPIN_CAP) { atomicAdd(&bar[XB_TMO], 1u); break; } }
    }
    nloc = mine > 0u ? mine : 1u; nx = cnt > 0u ? cnt : 1u;
}
__device__ __forceinline__ void xcd_barrier(const XcdBarrier& b) {
    asm volatile("s_waitcnt vmcnt(0)" ::: "memory");
    __syncthreads();
    if (threadIdx.x == 0) {
        unsigned* bar = b.bar;
        __builtin_amdgcn_s_waitcnt(0);
        unsigned nloc = b.st[0], nx = b.st[1];
        if (nloc == 0u) { xcd_barrier_complete(bar, b.x, nloc, nx); b.st[0] = nloc; b.st[1] = nx; }
        const unsigned old = xb_add(&bar[XB_XSUB(b.x)], 1u);
        const unsigned gen = old / nloc;
        if (old + 1u == (gen + 1u) * nloc) {
            __builtin_amdgcn_fence(__ATOMIC_RELEASE, "agent");
            asm volatile("s_waitcnt vmcnt(0)" ::: "memory");
            const unsigned og = xb_add(&bar[XB_TOP], 1u);
            const unsigned tg = og / nx;
            if (og + 1u == (tg + 1u) * nx) xb_add(&bar[XB_TOPGEN], 1u);
            else XB_SPIN(xb_ld(&bar[XB_TOPGEN]) == tg, bar);
            __builtin_amdgcn_fence(__ATOMIC_ACQUIRE, "agent");
            xb_add(&bar[XB_XGEN(b.x)], 1u);
            asm volatile("s_waitcnt vmcnt(0)" ::: "memory");
        } else {
            XB_SPIN(xb_ld(&bar[XB_XGEN(b.x)]) == gen, bar);
            __builtin_amdgcn_fence(__ATOMIC_ACQUIRE, "agent");
            asm volatile("s_waitcnt vmcnt(0)" ::: "memory");
        }
    }
    __syncthreads();
}

struct Tile { const bf16_t* A; const bf16_t* B; int lda, ldb, K; void* d0; const void* s0; int ld, mode; float aux0, aux1, aux2; int i0, i1; };
template <class F>
__device__ __forceinline__ void sgemm(const F f, int nunits) {
    const int lane = threadIdx.x & 63, wave = threadIdx.x >> 6, fr = lane & 15, fq = lane >> 4;
    for (int u = blockIdx.x * 8 + wave; u < nunits; u += gridDim.x * 8) {
        Tile tl; f.tile(u, tl);
        f32x4 acc[4][4];
#pragma unroll
        for (int m = 0; m < 4; ++m)
#pragma unroll
            for (int n = 0; n < 4; ++n) acc[m][n] = (f32x4){0.f, 0.f, 0.f, 0.f};
        const bf16_t* ap = tl.A + (size_t)fr * tl.lda + fq * 8;
        const bf16_t* bp = tl.B + (size_t)fr * tl.ldb + fq * 8;
        const int K = tl.K, lda = tl.lda, ldb = tl.ldb;
#pragma unroll 1
        for (int k0 = 0; k0 < K; k0 += 32) {
            bf16x8 a[4], b[4];
#pragma unroll
            for (int m = 0; m < 4; ++m) a[m] = *(const bf16x8*)(ap + (size_t)(m * 16) * lda + k0);
#pragma unroll
            for (int n = 0; n < 4; ++n) b[n] = *(const bf16x8*)(bp + (size_t)(n * 16) * ldb + k0);
#pragma unroll
            for (int m = 0; m < 4; ++m)
#pragma unroll
                for (int n = 0; n < 4; ++n) acc[m][n] = __builtin_amdgcn_mfma_f32_16x16x32_bf16(a[m], b[n], acc[m][n], 0, 0, 0);
        }
#pragma unroll
        for (int m = 0; m < 4; ++m)
#pragma unroll
            for (int j = 0; j < 4; ++j) {
                const int r = m * 16 + fq * 4 + j;
                asm volatile("" ::: "memory");
#pragma unroll
                for (int n = 0; n < 4; ++n) f.out(tl, r, n * 16 + fr, acc[m][n][j]);
            }
    }
}
__device__ __forceinline__ void store_mode(const Tile& tl, int r, int c, float v) {
    const size_t i = (size_t)r * tl.ld + c;
    if (tl.mode == 0) ((bf16_t*)tl.d0)[i] = f2bf(v);
    else if (tl.mode == 1) ((bf16_t*)tl.d0)[i] = f2bf(sigmoidf_(v));
    else if (tl.mode == 2) ((bf16_t*)tl.d0)[i] = f2bf(siluf_(v));
    else if (tl.mode == 3) ((float*)tl.d0)[i] = v * tl.aux0;
}

struct G1 {
    const bf16_t* XN; const bf16_t* W; bf16_t *Q, *K_, *V;
    __device__ __forceinline__ void tile(int u, Tile& tl) const {
        const int mt = u / 48, nt = u % 48; tl.A = XN + (size_t)mt * 64 * 1024; tl.lda = 1024; tl.B = W + (size_t)nt * 64 * 1024; tl.ldb = 1024; tl.K = 1024;
        const int col = nt * 64, sec = col >> 10, cc = col & 1023; bf16_t* d = Q + (size_t)sec * (32 * MB);
        tl.d0 = d + (size_t)mt * 64 * 1024 + cc; tl.ld = 1024; tl.mode = 0; }
    __device__ __forceinline__ void out(const Tile& tl, int r, int c, float v) const { store_mode(tl, r, c, v); }
};
struct G2 {
    const bf16_t* XN; const bf16_t* W; bf16_t *O, *ZA, *U, *Y;
    __device__ __forceinline__ void tile(int u, Tile& tl) const {
        const int mt = u / 64, nt = u % 64; tl.A = XN + (size_t)mt * 64 * 1024; tl.lda = 1024; tl.B = W + (size_t)(3072 + nt * 64) * 1024; tl.ldb = 1024; tl.K = 1024;
        const int col = nt * 64, sec = col >> 10, cc = col & 1023;
        if (sec == 0) { tl.d0 = O + (size_t)mt * 64 * 1024 + cc; tl.ld = 1024; tl.mode = 1; }
        else if (sec == 1) { tl.d0 = ZA + (size_t)mt * 64 * 1024 + cc; tl.ld = 1024; tl.mode = 2; }
        else if (sec == 2) { tl.d0 = U + (size_t)mt * 64 * 1024 + cc; tl.ld = 1024; tl.mode = 0; }
        else { tl.d0 = Y + (size_t)mt * 64 * 2048 + 1024 + cc; tl.ld = 2048; tl.mode = 2; } }
    __device__ __forceinline__ void out(const Tile& tl, int r, int c, float v) const { store_mode(tl, r, c, v); }
};
struct GM1 {
    const bf16_t* Y; const bf16_t* KT; const float *BQ, *IQ, *MT; float* W;
    __device__ __forceinline__ void tile(int u, Tile& tl) const {
        const int bh = u >> 8, c = u & 255, batch = bh >> 2, head = bh & 3; const size_t t0 = (size_t)batch * SEQ + c * 64;
        tl.A = Y + t0 * 2048 + 1024 + head * 256; tl.lda = 2048; tl.B = KT + t0 * 1024 + head * 256; tl.ldb = 1024; tl.K = 256;
        tl.d0 = W + (size_t)u * 4096; tl.ld = 64; tl.mode = 0; tl.i0 = (int)(t0 * 4 + head); }
    __device__ __forceinline__ void out(const Tile& tl, int r, int c, float v) const {
        float w = 0.f;
        if (c <= r) w = __expf(BQ[tl.i0 + r * 4] - BQ[tl.i0 + c * 4] + IQ[tl.i0 + c * 4] - MT[tl.i0 + r * 4]) * v;
        ((float*)tl.d0)[r * 64 + c] = w; }
};
struct G3 {
    const bf16_t* XN; const bf16_t* W; const float* sp; bf16_t* Y;
    __device__ __forceinline__ void tile(int u, Tile& tl) const {
        const int mt = u >> 4, g = (u >> 2) & 3, nt = u & 3; tl.A = XN + (size_t)mt * 64 * 1024 + g * 256; tl.lda = 1024; tl.B = W + (size_t)(g * 256 + nt * 64) * 256; tl.ldb = 256; tl.K = 256;
        const int col = g * 256 + nt * 64; tl.d0 = Y + (size_t)mt * 64 * 2048 + 1024 + col; tl.ld = 2048; tl.s0 = sp + col; tl.mode = 0; }
    __device__ __forceinline__ void out(const Tile& tl, int r, int c, float v) const {
        bf16_t* d = (bf16_t*)tl.d0 + (size_t)r * 2048 + c; *d = f2bf(v * ((const float*)tl.s0)[c] * bf2f(*d)); }
};
struct G4 {
    const bf16_t* Y; const bf16_t* W; const float* x; float* out_;
    __device__ __forceinline__ void tile(int u, Tile& tl) const {
        const int mt = u >> 4, nt = u & 15; tl.A = Y + (size_t)mt * 64 * 2048; tl.lda = 2048; tl.B = W + (size_t)nt * 64 * 2048; tl.ldb = 2048; tl.K = 2048;
        const size_t o = (size_t)mt * 64 * 1024 + nt * 64; tl.d0 = out_ + o; tl.s0 = x + o; tl.ld = 1024; tl.mode = 0; }
    __device__ __forceinline__ void out(const Tile& tl, int r, int c, float v) const { const size_t i = (size_t)r * 1024 + c; ((float*)tl.d0)[i] = ((const float*)tl.s0)[i] + v; }
};
struct G5 {
    const bf16_t* XN; const bf16_t* W; bf16_t* Q; float *CKVR, *QI, *KI; bf16_t* Z;
    __device__ __forceinline__ void tile(int u, Tile& tl) const {
        const int mt = u / 44, nt = u % 44; tl.A = XN + (size_t)mt * 64 * 1024; tl.lda = 1024; tl.B = W + (size_t)nt * 64 * 1024; tl.ldb = 1024; tl.K = 1024;
        const int col = nt * 64; const size_t row0 = (size_t)mt * 64; tl.aux0 = 1.0f;
        if (col < 1024) { tl.d0 = Q + row0 * 1024 + col; tl.ld = 1024; tl.mode = 0; }
        else if (col < 1280) { tl.d0 = CKVR + row0 * 256 + (col - 1024); tl.ld = 256; tl.mode = 3; }
        else if (col < 1536) { tl.d0 = QI + row0 * 256 + (col - 1280); tl.ld = 256; tl.mode = 3; tl.aux0 = 0.125f; }
        else if (col < 1600) { tl.d0 = KI + row0 * 64 + (col - 1536); tl.ld = 64; tl.mode = 3; }
        else if (col < 1792) { tl.d0 = nullptr; tl.ld = 0; tl.mode = 4; }
        else { tl.d0 = Z + row0 * 1024 + (col - 1792); tl.ld = 1024; tl.mode = 2; } }
    __device__ __forceinline__ void out(const Tile& tl, int r, int c, float v) const { store_mode(tl, r, c, v); }
};
struct G67 {
    const bf16_t* C; const bf16_t *WK, *WV; bf16_t *KF, *VF;
    __device__ __forceinline__ void tile(int u, Tile& tl) const {
        const int which = u >= 8192, uu = u & 8191, mt = uu >> 4, nt = uu & 15; tl.A = C + (size_t)mt * 64 * 256; tl.lda = 256; tl.B = WK + (size_t)which * (1024 * 256) + (size_t)nt * 64 * 256;     tl.ldb = 256; tl.K = 256;
        tl.d0 = KF + (size_t)which * (32 * MB) + (size_t)mt * 64 * 1024 + nt * 64;     tl.ld = 1024; tl.mode = 0; }
    __device__ __forceinline__ void out(const Tile& tl, int r, int c, float v) const { store_mode(tl, r, c, v); }
};
struct G8 {
    const bf16_t* G; const bf16_t* W; float* out_;
    __device__ __forceinline__ void tile(int u, Tile& tl) const {
        const int mt = u >> 4, nt = u & 15; tl.A = G + (size_t)mt * 64 * 1024; tl.lda = 1024; tl.B = W + (size_t)nt * 64 * 1024; tl.ldb = 1024; tl.K = 1024;
        tl.d0 = out_ + (size_t)mt * 64 * 1024 + nt * 64; tl.ld = 1024; tl.mode = 0; }
    __device__ __forceinline__ void out(const Tile& tl, int r, int c, float v) const { float* d = (float*)tl.d0 + (size_t)r * 1024 + c; *d = *d + v; }
};

struct GQP {
    const bf16_t* Qn; const bf16_t* W; bf16_t* QP;
    __device__ __forceinline__ void tile(int u, Tile& tl) const {
        const int nt = u & 3, head = (u >> 2) & 15, mt = u >> 6; tl.A = Qn + (size_t)mt * 64 * 1024 + head * 64; tl.lda = 1024; tl.B = W + (size_t)(head * 256 + nt * 64) * 64; tl.ldb = 64; tl.K = 64;
        tl.d0 = QP + ((size_t)mt * 64 * 16 + head) * 256 + nt * 64; tl.ld = 4096; tl.mode = 0; }
    __device__ __forceinline__ void out(const Tile& tl, int r, int c, float v) const { store_mode(tl, r, c, v); }
};
struct GOP {
    const bf16_t* OP; const bf16_t* W; const bf16_t* Z; bf16_t* G;
    __device__ __forceinline__ void tile(int u, Tile& tl) const {
        const int head = u & 15, mt = u >> 4; tl.A = OP + (size_t)mt * 64 * 4096 + head * 256; tl.lda = 4096; tl.B = W + (size_t)head * 64 * 256; tl.ldb = 256; tl.K = 256;
        const size_t o = (size_t)mt * 64 * 1024 + head * 64; tl.d0 = G + o; tl.s0 = Z + o; tl.ld = 1024; tl.mode = 0; }
    __device__ __forceinline__ void out(const Tile& tl, int r, int c, float v) const { const size_t i = (size_t)r * 1024 + c; ((bf16_t*)tl.d0)[i] = f2bf(v * bf2f(((const bf16_t*)tl.s0)[i])); }
};

namespace pg8 {
constexpr int BM = 256, BK = 64, HALF = 128, HTB = HALF * BK * 2, STAGE_BYTES = 8 * HTB, NXCD = 8, WGM = 8;
__device__ __forceinline__ int lds_byte(int r, int c) { const int st = (r >> 4) * 2 + (c >> 5), rr = r & 15, cc = c & 31, ob = rr * 64 + cc * 2; return st * 1024 + (ob ^ (((ob >> 9) & 1) << 5)); }
__device__ __forceinline__ void stage_rc(int b, int& R, int& C) { const int st = b / 1024, sb = b % 1024, swz = sb ^ (((sb >> 9) & 1) << 5); R = (st >> 1) * 16 + swz / 64; C = (st & 1) * 32 + (swz % 64) / 2; }
__device__ __forceinline__ int perm32(int rho) { const int n = rho >> 4, i = rho & 15; return 8 * (i >> 2) + 4 * n + (i & 3); }
struct Unit { int pm, pn; };
struct Gemm { const bf16_t* A; int lda; const bf16_t* Bt; int ldb; int M, N, K; };
struct StaticOrder {
    int nM, nN, nwg, G, c;
    __device__ void init(int M, int N, int G_, int c_) { nM = M / BM; nN = N / BM; nwg = nM * nN; G = G_; c = c_; }
    __device__ bool next(int i, Unit& u) const {
        const long L = (long)i * G + c; if (L >= nwg) return false;
        int wgid = (int)L; { const int q = nwg / NXCD, r = nwg % NXCD, xcd = wgid % NXCD, off = wgid / NXCD; wgid = (xcd < r ? xcd * (q + 1) : r * (q + 1) + (xcd - r) * q) + off; }
        const int nig = WGM * nN, gid = wgid / nig, fm = gid * WGM, gsz = (nM - fm) < WGM ? (nM - fm) : WGM;
        u.pm = fm + ((wgid % nig) % gsz); u.pn = (wgid % nig) / gsz; return true;
    }
};
__device__ __forceinline__ unsigned cvt_pk_bf16(float lo, float hi) { unsigned r; asm volatile("v_cvt_pk_bf16_f32 %0, %1, %2" : "=v"(r) : "v"(lo), "v"(hi)); return r; }

struct Dst { unsigned char* base; const float* res; int ld, mode, ncol; float scale; };
template <class DescF> struct EpiGen {
    static constexpr bool PERM = true;
    DescF D;
    __device__ __forceinline__ void operator()(const f32x4 (&acc)[2][2][4][2], const Unit& u, int wr, int wc, int fr, int fq) const {
        Dst d; D.get(u, d);
        if ((DescF::MODES & 16) && d.mode == 4) return;
        const int r0 = wr * 64 + fr, c0 = wc * 32 + 8 * fq;
        if constexpr ((DescF::MODES & 64) != 0) {
#pragma unroll
            for (int ai = 0; ai < 2; ++ai)
#pragma unroll
                for (int m = 0; m < 4; ++m) {
                    float ss = 0.f;
#pragma unroll
                    for (int bj = 0; bj < 2; ++bj)
#pragma unroll
                        for (int n = 0; n < 2; ++n) { const f32x4 v = acc[ai][bj][m][n]; ss += v[0] * v[0] + v[1] * v[1] + v[2] * v[2] + v[3] * v[3]; }
                    ss += __shfl_xor(ss, 16); ss += __shfl_xor(ss, 32);
                    if (fq == 0) ((bf16_t*)d.base)[(size_t)(ai * HALF + r0 + m * 16) * d.ld + wc] = f2bf(rsqrtf(ss * (1.0f / 64.0f) + EPS));
                }
            return;
        } else {
#pragma unroll
        for (int ai = 0; ai < 2; ++ai)
#pragma unroll
            for (int m = 0; m < 4; ++m) {
                const size_t rowoff = (size_t)(ai * HALF + r0 + m * 16) * d.ld;
#pragma unroll
                for (int bj = 0; bj < 2; ++bj) {
                    const int col = bj * HALF + c0; f32x4 v0 = acc[ai][bj][m][0], v1 = acc[ai][bj][m][1];
                    if ((DescF::MODES & 7) && d.mode <= 2) {
                        if ((DescF::MODES & 2) && d.mode == 1) {
#pragma unroll
                            for (int j = 0; j < 4; ++j) { v0[j] = sigmoidf_(v0[j]); v1[j] = sigmoidf_(v1[j]); } }
                        if ((DescF::MODES & 4) && d.mode == 2) {
#pragma unroll
                            for (int j = 0; j < 4; ++j) { v0[j] = siluf_(v0[j]); v1[j] = siluf_(v1[j]); } }
                        u32x4 w; w.x = cvt_pk_bf16(v0[0], v0[1]); w.y = cvt_pk_bf16(v0[2], v0[3]); w.z = cvt_pk_bf16(v1[0], v1[1]); w.w = cvt_pk_bf16(v1[2], v1[3]);
                        *(u32x4*)((bf16_t*)d.base + rowoff + col) = w;
                    } else if ((DescF::MODES & 8) && d.mode == 3) {
                        if (col < d.ncol) { float* o = (float*)d.base + rowoff + col; *(f32x4*)o = v0 * d.scale; *(f32x4*)(o + 4) = v1 * d.scale; }
                    } else if ((DescF::MODES & 128) && d.mode == 7) {
                        typedef _Float16 h8 __attribute__((ext_vector_type(8)));
                        h8 hv; hv[0] = (_Float16)(v0[0] * d.scale); hv[1] = (_Float16)(v0[1] * d.scale); hv[2] = (_Float16)(v0[2] * d.scale); hv[3] = (_Float16)(v0[3] * d.scale);
                        hv[4] = (_Float16)(v1[0] * d.scale); hv[5] = (_Float16)(v1[1] * d.scale); hv[6] = (_Float16)(v1[2] * d.scale); hv[7] = (_Float16)(v1[3] * d.scale);
                        *(h8*)((_Float16*)d.base + rowoff + col) = hv;
                    } else if constexpr ((DescF::MODES & 32) != 0) {
                        float* o = (float*)d.base + rowoff + col; const float* rs = d.res + rowoff + col;
                        const f32x4 a = *(const f32x4*)rs, b = *(const f32x4*)(rs + 4); *(f32x4*)o = a + v0; *(f32x4*)(o + 4) = b + v1;
                    }
                }
                if (m & 1) asm volatile("" ::: "memory");
            }
        }
    }
};

template <class Epi>
__device__ __forceinline__ void gemm_phase(LAS unsigned char* lds, const Gemm g, const StaticOrder& S, const Epi& E) {
    const int tid = threadIdx.x, wid = __builtin_amdgcn_readfirstlane(tid >> 6), lane = tid & 63, wr = wid >> 2, wc = wid & 3, fr = lane & 15, fq = lane >> 4;
    const int K = g.K, nt = K / BK;
    unsigned voffA[2], voffB[2];
#pragma unroll
    for (int i = 0; i < 2; ++i) { int R, C; stage_rc(tid * 16 + i * 8192, R, C); const int Rb = Epi::PERM ? ((R & ~31) + perm32(R & 31)) : R;
        voffA[i] = (unsigned)(R * g.lda + C) * 2u; voffB[i] = (unsigned)(Rb * g.ldb + C) * 2u; }
    const size_t kstep = (size_t)(BK * 2);
    const size_t hstepA = (size_t)HALF * g.lda * 2, hstepB = (size_t)HALF * g.ldb * 2;
    const size_t tstepA = 2 * hstepA, tstepB = 2 * hstepB;
    const unsigned ldsw = (unsigned)wid * 1024u;
    const int aoff = lds_byte(wr * 64 + fr, fq * 8), boff = lds_byte(wc * 32 + fr, fq * 8);
#define PG8_SA(b, h) (((b) * 2 + (h)) * HTB)
#define PG8_SB(b, h) ((4 + (b) * 2 + (h)) * HTB)
#define PG8_STAGE(bufoff, gbase, voff) do { _Pragma("unroll") for (int _i = 0; _i < 2; ++_i) \
        __builtin_amdgcn_global_load_lds((const unsigned*)((const char*)(gbase) + (voff)[_i]), (LAS unsigned*)(lds + (bufoff) + ldsw + _i * 8192), 16, 0, 0); } while (0)
#define PG8_LDA(dst, b, h) do { _Pragma("unroll") for (int m = 0; m < 4; ++m) _Pragma("unroll") for (int k = 0; k < 2; ++k) dst[m][k] = *(const LAS bf16x8*)(lds + PG8_SA(b, h) + aoff + m * 2048 + k * 1024); } while (0)
#define PG8_LDB(dst, b, h) do { _Pragma("unroll") for (int n = 0; n < 2; ++n) _Pragma("unroll") for (int k = 0; k < 2; ++k) dst[n][k] = *(const LAS bf16x8*)(lds + PG8_SB(b, h) + boff + n * 2048 + k * 1024); } while (0)
#define PG8_MMA(ai, bj, At, Bt) do { __builtin_amdgcn_s_setprio(1); _Pragma("unroll") for (int m = 0; m < 4; ++m) _Pragma("unroll") for (int n = 0; n < 2; ++n) _Pragma("unroll") for (int k = 0; k < 2; ++k) \
        acc[ai][bj][m][n] = __builtin_amdgcn_mfma_f32_16x16x32_bf16(Bt[n][k], At[m][k], acc[ai][bj][m][n], 0, 0, 0); __builtin_amdgcn_s_setprio(0); } while (0)
#define PG8_WAIT_V(n) asm volatile("s_waitcnt vmcnt(" #n ")" ::: "memory")
#define PG8_WAIT_L(n) asm volatile("s_waitcnt lgkmcnt(" #n ")" ::: "memory")
#define PG8_BAR __builtin_amdgcn_s_barrier()
#define PG8_SCHED __builtin_amdgcn_sched_barrier(0)
    Unit cur, nxt; int ui = 0;
    if (!S.next(0, cur)) return;
    f32x4 acc[2][2][4][2];
#pragma unroll
    for (int a = 0; a < 2; ++a)
#pragma unroll
        for (int b = 0; b < 2; ++b)
#pragma unroll
            for (int m = 0; m < 4; ++m)
#pragma unroll
                for (int n = 0; n < 2; ++n) acc[a][b][m][n] = (f32x4){0.f, 0.f, 0.f, 0.f};
    bf16x8 At[4][2], B0[2][2], B1[2][2];
    const char* cA = (const char*)g.A + (size_t)cur.pm * tstepA; const char* cB = (const char*)g.Bt + (size_t)cur.pn * tstepB;
    PG8_STAGE(PG8_SB(0, 0), cB, voffB); PG8_STAGE(PG8_SA(0, 0), cA, voffA); PG8_STAGE(PG8_SB(0, 1), cB + hstepB, voffB); PG8_STAGE(PG8_SA(0, 1), cA + hstepA, voffA);
    if (wr == 1) PG8_BAR;
    PG8_WAIT_V(4); PG8_BAR;
    PG8_STAGE(PG8_SB(1, 0), cB + kstep, voffB); PG8_STAGE(PG8_SA(1, 0), cA + kstep, voffA); PG8_STAGE(PG8_SB(1, 1), cB + hstepB + kstep, voffB);
    PG8_WAIT_V(6); PG8_BAR;
    for (;;) {
        const bool has_next = S.next(ui + 1, nxt);
        const char* nA = has_next ? (const char*)g.A + (size_t)nxt.pm * tstepA : cA; const char* nB = has_next ? (const char*)g.Bt + (size_t)nxt.pn * tstepB : cB;
#pragma unroll 1
        for (int t = 0; t < nt; t += 2) {
            const bool last = (t == nt - 2);
            const char* a1 = cA + (size_t)(t + 1) * kstep;
            const char* a2 = last ? nA : cA + (size_t)(t + 2) * kstep; const char* b2 = last ? nB : cB + (size_t)(t + 2) * kstep;
            const char* a3 = a2 + kstep; const char* b3 = b2 + kstep;
            PG8_LDB(B0, 0, 0); PG8_SCHED; PG8_LDA(At, 0, 0); PG8_STAGE(PG8_SA(1, 1), a1 + hstepA, voffA);
            PG8_WAIT_L(8); PG8_BAR; PG8_WAIT_L(0); PG8_MMA(0, 0, At, B0); PG8_BAR; PG8_SCHED;
            PG8_LDB(B1, 0, 1); PG8_STAGE(PG8_SB(0, 0), b2, voffB);
            PG8_BAR; PG8_WAIT_L(0); PG8_MMA(0, 1, At, B1); PG8_BAR;
            PG8_LDA(At, 0, 1); PG8_STAGE(PG8_SA(0, 0), a2, voffA);
            PG8_BAR; PG8_WAIT_L(0); PG8_MMA(1, 0, At, B0); PG8_BAR; PG8_SCHED;
            PG8_STAGE(PG8_SB(0, 1), b2 + hstepB, voffB);
            PG8_WAIT_V(6); PG8_BAR; PG8_MMA(1, 1, At, B1); PG8_BAR;
            PG8_LDB(B0, 1, 0); PG8_SCHED; PG8_LDA(At, 1, 0); PG8_STAGE(PG8_SA(0, 1), a2 + hstepA, voffA);
            PG8_WAIT_L(8); PG8_BAR; PG8_WAIT_L(0); PG8_MMA(0, 0, At, B0); PG8_BAR; PG8_SCHED;
            PG8_LDB(B1, 1, 1); PG8_STAGE(PG8_SB(1, 0), b3, voffB);
            PG8_BAR; PG8_WAIT_L(0); PG8_MMA(0, 1, At, B1); PG8_BAR;
            PG8_LDA(At, 1, 1); PG8_STAGE(PG8_SA(1, 0), a3, voffA);
            PG8_BAR; PG8_WAIT_L(0); PG8_MMA(1, 0, At, B0); PG8_BAR; PG8_SCHED;
            PG8_STAGE(PG8_SB(1, 1), b3 + hstepB, voffB);
            PG8_WAIT_V(6); PG8_BAR; PG8_MMA(1, 1, At, B1); PG8_BAR;
        }
        E(acc, cur, wr, wc, fr, fq);
        if (!has_next) break;
#pragma unroll
        for (int a = 0; a < 2; ++a)
#pragma unroll
            for (int b = 0; b < 2; ++b)
#pragma unroll
                for (int m = 0; m < 4; ++m)
#pragma unroll
                    for (int n = 0; n < 2; ++n) acc[a][b][m][n] = (f32x4){0.f, 0.f, 0.f, 0.f};
        cur = nxt; cA = nA; cB = nB; ++ui;
    }
    PG8_WAIT_V(0);
    if (wr == 0) PG8_BAR;
    PG8_BAR;
#undef PG8_SA
#undef PG8_SB
#undef PG8_STAGE
#undef PG8_LDA
#undef PG8_LDB
#undef PG8_MMA
#undef PG8_WAIT_V
#undef PG8_WAIT_L
#undef PG8_BAR
#undef PG8_SCHED
}
}

struct D1 { static constexpr int MODES = 1; unsigned char* ws;
    __device__ __forceinline__ void get(const pg8::Unit& u, pg8::Dst& d) const { const int sec = u.pn >> 2;
        d.base = ws + OFF_QB + (size_t)sec * (64 * MB) + ((size_t)u.pm * 256 * 1024 + (u.pn & 3) * 256) * 2; d.res = nullptr; d.ld = 1024; d.mode = 0; d.ncol = 256; d.scale = 1.f; } };
struct D2 { static constexpr int MODES = 7; unsigned char* ws;
    __device__ __forceinline__ void get(const pg8::Unit& u, pg8::Dst& d) const { const int sec = u.pn >> 2, cc = (u.pn & 3) * 256; d.res = nullptr; d.ncol = 256; d.scale = 1.f;
        if (sec < 3) { d.base = ws + OFF_QB + (size_t)sec * (64 * MB) + ((size_t)u.pm * 256 * 1024 + cc) * 2; d.ld = 1024; d.mode = sec == 0 ? 1 : (sec == 1 ? 2 : 0); }
        else { d.base = ws + OFF_Y + ((size_t)u.pm * 256 * 2048 + 1024 + cc) * 2; d.ld = 2048; d.mode = 2; } } };
struct D4 { static constexpr int MODES = 32; unsigned char* out; const float* x;
    __device__ __forceinline__ void get(const pg8::Unit& u, pg8::Dst& d) const { const size_t o = (size_t)u.pm * 256 * 1024 + u.pn * 256;
        d.base = out + o * 4; d.res = x + o; d.ld = 1024; d.mode = 5; d.ncol = 256; d.scale = 1.f; } };
struct D5 { static constexpr int MODES = 141; unsigned char* ws;
    __device__ __forceinline__ void get(const pg8::Unit& u, pg8::Dst& d) const { const int pn = u.pn; d.res = nullptr; d.ncol = 256; d.scale = 1.f;
        if (pn < 4) { d.base = ws + OFF_TMP + ((size_t)u.pm * 256 * 1024 + pn * 256) * 2; d.ld = 1024; d.mode = 0; }
        else if (pn == 4) { d.base = ws + OFF_CKVN + (size_t)u.pm * 256 * 256 * 2; d.ld = 256; d.mode = 0; }
        else if (pn == 5) { d.base = ws + OFF_QI + (size_t)u.pm * 256 * 256 * 2; d.ld = 256; d.mode = 7; d.scale = 0.125f; }
        else if (pn == 6) { d.base = ws + OFF_KI + (size_t)u.pm * 256 * 64 * 4; d.ld = 64; d.mode = 3; d.ncol = 64; }
        else { d.base = ws + OFF_Z + ((size_t)u.pm * 256 * 1024 + (pn - 7) * 256) * 2; d.ld = 1024; d.mode = 2; } } };
struct DK { static constexpr int MODES = 64; unsigned char* ws;
    __device__ __forceinline__ void get(const pg8::Unit& u, pg8::Dst& d) const {
        d.base = ws + OFF_RK + ((size_t)u.pm * 256 * 16 + u.pn * 4) * 2; d.res = nullptr; d.ld = 16; d.mode = 6; d.ncol = 256; d.scale = 1.f; } };
struct D8 { static constexpr int MODES = 32; unsigned char* out;
    __device__ __forceinline__ void get(const pg8::Unit& u, pg8::Dst& d) const { const size_t o = (size_t)u.pm * 256 * 1024 + u.pn * 256;
        d.base = out + o * 4; d.res = (const float*)out + o; d.ld = 1024; d.mode = 5; d.ncol = 256; d.scale = 1.f; } };
template <class DF>
__device__ __forceinline__ void fast_gemm(unsigned char* lds, const bf16_t* A, int lda, const bf16_t* Bt, int ldb, int N, int K, const DF& df) {
    pg8::Gemm g{A, lda, Bt, ldb, T, N, K}; pg8::StaticOrder S; S.init(T, N, (int)gridDim.x, (int)blockIdx.x);
    pg8::EpiGen<DF> E{df};
    pg8::gemm_phase(( LAS unsigned char*)lds, g, S, E);
}

__device__ __forceinline__ void tconv(const float* __restrict__ src, int ld, int col0, int ncols, int K, bf16_t* __restrict__ dst, float* tile  ) {
    const int nkt = K / 64, ntiles = nkt * (ncols / 64), tid = threadIdx.x;
    for (int id = blockIdx.x; id < ntiles; id += gridDim.x) {
        const int kt = id % nkt, nt = id / nkt;
#pragma unroll
        for (int j = 0; j < 8; ++j) { const int e = tid + 512 * j, kk = e >> 6, nn = e & 63; tile[kk * 65 + nn] = src[(size_t)(kt * 64 + kk) * ld + col0 + nt * 64 + nn]; }
        __syncthreads();
#pragma unroll
        for (int j = 0; j < 8; ++j) { const int e = tid + 512 * j, nn = e >> 6, kk = e & 63; dst[(size_t)(nt * 64 + nn) * K + kt * 64 + kk] = f2bf(tile[kk * 65 + nn]); }
        __syncthreads();
    }
}
template <int NE>
__device__ __forceinline__ void rmsnorm_rows(const float* __restrict__ src, const float* __restrict__ g, bf16_t* __restrict__ dst,
                             const float* __restrict__ Wx, int ldw, int col0, const float* __restrict__ bias, float scale, float* __restrict__ dstx) {
    const int lane = threadIdx.x & 63, wave = threadIdx.x >> 6;
    for (int row = blockIdx.x * 8 + wave; row < T; row += gridDim.x * 8) {
        f32x4 v[4]; float ss = 0.f;
#pragma unroll
        for (int i = 0; i < 4; ++i) { v[i] = *(const f32x4*)(src + (size_t)row * 1024 + i * 256 + lane * 4); ss += v[i][0] * v[i][0] + v[i][1] * v[i][1] + v[i][2] * v[i][2] + v[i][3] * v[i][3]; }
        ss = wave_sum(ss);
        const float rstd = rsqrtf(ss * (1.0f / 1024.0f) + EPS);
        float ex[NE];
#pragma unroll
        for (int e = 0; e < NE; ++e) ex[e] = 0.f;
#pragma unroll
        for (int i = 0; i < 4; ++i) {
            asm volatile("" ::: "memory");
            const f32x4 gg = *(const f32x4*)(g + i * 256 + lane * 4);
            f32x4 y; y[0] = v[i][0] * rstd * gg[0]; y[1] = v[i][1] * rstd * gg[1]; y[2] = v[i][2] * rstd * gg[2]; y[3] = v[i][3] * rstd * gg[3];
            u32x2 w; w.x = pk2(y[0], y[1]); w.y = pk2(y[2], y[3]);
            *(u32x2*)(dst + (size_t)row * 1024 + i * 256 + lane * 4) = w;
#pragma unroll
            for (int j = 0; j < 4; ++j) { const float* wr = Wx + (size_t)(i * 256 + lane * 4 + j) * ldw + col0;
#pragma unroll
                for (int e4 = 0; e4 < NE / 4; ++e4) { const f32x4 wv = *(const f32x4*)(wr + e4 * 4);
                    ex[e4 * 4 + 0] += y[j] * wv[0]; ex[e4 * 4 + 1] += y[j] * wv[1]; ex[e4 * 4 + 2] += y[j] * wv[2]; ex[e4 * 4 + 3] += y[j] * wv[3]; } }
        }
#pragma unroll
        for (int e = 0; e < NE; ++e) { const float s = wave_sum(ex[e]); if (lane == 0) dstx[(size_t)row * NE + e] = (s + (bias ? bias[e] : 0.f)) * scale; }
    }
}

__device__ __forceinline__ void phase_prep(const P& p, unsigned char* lds) {
    float* tile = (float*)lds; unsigned char* ws = p.ws;
    bf16_t* W0T = (bf16_t*)(ws + OFF_W0T);
    tconv(p.e_w_in, EIN, 0, 5120, 1024, W0T, tile);
    tconv(p.e_w_in, EIN, 6152, 1024, 1024, W0T + (size_t)6144 * 1024, tile);
    {
        float* arow = tile;
        for (int it = blockIdx.x; it < 4 * 512; it += gridDim.x) {
            const int g = it >> 9, k0 = (it & 511) * 2; const int tid = threadIdx.x, kk = tid >> 8, d = tid & 255;
            __syncthreads();
            arow[tid] = p.e_w_in[(size_t)(k0 + kk) * EIN + 5128 + g * 256 + d];
            __syncthreads();
            const float* wp = p.e_w_pool + (size_t)g * 65536 + d; const float* ar = arow + kk * 256; float acc = 0.f;
#pragma unroll 8
            for (int c = 0; c < 256; ++c) acc += ar[c] * wp[(size_t)c * 256];
            W0T[(size_t)(5120 + g * 256 + d) * 1024 + k0 + kk] = f2bf(acc);
        }
        __syncthreads();
    }
    tconv(p.e_w_out, 1024, 0, 1024, 2048, (bf16_t*)(ws + OFF_WO0T), tile);
    bf16_t* W1T = (bf16_t*)(ws + OFF_W1T);
    tconv(p.o_w_in, OIN, 0, 1600, 1024, W1T, tile);
    for (size_t i = (size_t)blockIdx.x * 512 + threadIdx.x; i < (size_t)192 * 1024; i += (size_t)gridDim.x * 512) W1T[(size_t)1600 * 1024 + i] = 0;
    tconv(p.o_w_in, OIN, 1604, 1024, 1024, W1T + (size_t)1792 * 1024, tile);
    {
        bf16_t* WUKP = (bf16_t*)(ws + OFF_WUKP); bf16_t* WQP = (bf16_t*)(ws + OFF_WQP);
        for (size_t i = (size_t)blockIdx.x * 512 + threadIdx.x; i < (size_t)1024 * 256; i += (size_t)gridDim.x * 512) {
            { const int n = (int)(i >> 8), k = (int)(i & 255), pn = n >> 8, rem = n & 255, bj = rem >> 7, wc = (rem >> 5) & 3, x = rem & 31;
              WUKP[i] = f2bf(p.o_w_uk[(size_t)k * 1024 + (4 * pn + wc) * 64 + 32 * bj + x]); }
            { const int d = (int)(i & 63), r = (int)((i >> 6) & 255), h = (int)(i >> 14);
              WQP[i] = f2bf(p.o_w_uk[(size_t)r * 1024 + h * 64 + d] * p.o_g_k[d] * 0.125f); }
        }
    }
    tconv(p.o_w_uv, 1024, 0, 1024, 256, (bf16_t*)(ws + OFF_WUVT), tile);
    tconv(p.o_w_out, 1024, 0, 1024, 1024, (bf16_t*)(ws + OFF_WO1T), tile);
    rmsnorm_rows<8>(p.x, p.e_norm, (bf16_t*)(ws + OFF_XN), p.e_w_in, EIN, 5120, p.e_b_if, 1.0f, (float*)(ws + OFF_GATES));
}

__device__ __forceinline__ void phase_conv_scan(const P& p, unsigned char* lds) {
    unsigned char* ws = p.ws; const int tid = threadIdx.x;
    const float* GATES = (const float*)(ws + OFF_GATES);
    float *BQ = (float*)(ws + OFF_BQ), *IQ = (float*)(ws + OFF_IQ), *MT = (float*)(ws + OFF_MT), *CH = (float*)(ws + OFF_CH);
    for (int bh = blockIdx.x; bh < 8; bh += gridDim.x) {
        float* sB = (float*)lds; float* sG = sB + 256; float* sMp = sG + 256; float* sMn = sMp + 256;
        const int batch = bh >> 2, head = bh & 3;
        if (tid < 256) {
            const size_t t0 = (size_t)batch * SEQ + tid * 64; float b = 0.f, rmax = -INFINITY;
            for (int s = 0; s < 64; ++s) { const size_t t = t0 + s; const float ig = GATES[t * 8 + head], f = GATES[t * 8 + 4 + head];
                const float ls = fminf(f, 0.f) - log1pf(__expf(-fabsf(f)));
                b += ls; BQ[t * 4 + head] = b; IQ[t * 4 + head] = ig; rmax = fmaxf(rmax, ig - b); MT[t * 4 + head] = rmax; }
            sB[tid] = b; sG[tid] = b + rmax;
        }
        __syncthreads();
        if (tid == 0) { float m = 0.f; for (int c = 0; c < 256; ++c) { sMp[c] = m; m = fmaxf(sB[c] + m, sG[c]); sMn[c] = m; } }
        __syncthreads();
        if (tid < 256) {
            const float mp = sMp[tid]; CH[bh * 256 + tid] = mp; CH[2048 + bh * 256 + tid] = sMn[tid]; CH[4096 + bh * 256 + tid] = sB[tid];
            const size_t t0 = (size_t)batch * SEQ + tid * 64;
            for (int s = 0; s < 64; ++s) { const size_t t = t0 + s; MT[t * 4 + head] = BQ[t * 4 + head] + fmaxf(mp, MT[t * 4 + head]); }
        }
        __syncthreads();
    }
    const bf16_t* QB = (const bf16_t*)(ws + OFF_QB); const bf16_t* KB = (const bf16_t*)(ws + OFF_KB);
    bf16_t* Y = (bf16_t*)(ws + OFF_Y); bf16_t* KT = (bf16_t*)(ws + OFF_TMP);
    for (size_t it = (size_t)blockIdx.x * 512 + tid; it < (size_t)T * 256; it += (size_t)gridDim.x * 512) {
        const size_t t = it >> 8; const int c0 = (int)(it & 255) * 8, isk = c0 >= 1024, cc = c0 & 1023; const int s = (int)(t & (SEQ - 1));
        const bf16_t* src = isk ? KB : QB;
        float acc[8];
#pragma unroll
        for (int i = 0; i < 8; ++i) acc[i] = 0.f;
#pragma unroll
        for (int j = 0; j < 4; ++j) {
            if (s - 3 + j >= 0) {
                const u32x4 w = *(const u32x4*)(src + (t - 3 + j) * 1024 + cc);
                const f32x4 c0v = *(const f32x4*)(p.e_conv + j * 2048 + c0), c1v = *(const f32x4*)(p.e_conv + j * 2048 + c0 + 4);
                acc[0] += c0v[0] * bflo(w.x); acc[1] += c0v[1] * bfhi(w.x); acc[2] += c0v[2] * bflo(w.y); acc[3] += c0v[3] * bfhi(w.y);
                acc[4] += c1v[0] * bflo(w.z); acc[5] += c1v[1] * bfhi(w.z); acc[6] += c1v[2] * bflo(w.w); acc[7] += c1v[3] * bfhi(w.w);
            }
        }
        const float sc = isk ? 0.0625f : 1.0f;
        u32x4 o; o.x = pk2(siluf_(acc[0]) * sc, siluf_(acc[1]) * sc); o.y = pk2(siluf_(acc[2]) * sc, siluf_(acc[3]) * sc);
        o.z = pk2(siluf_(acc[4]) * sc, siluf_(acc[5]) * sc); o.w = pk2(siluf_(acc[6]) * sc, siluf_(acc[7]) * sc);
        if (isk) *(u32x4*)(KT + t * 1024 + cc) = o; else *(u32x4*)(Y + t * 2048 + 1024 + cc) = o;
    }
}

__device__ __forceinline__ void phase_mlstm_seq(const P& p, unsigned char* lds) {
    unsigned char* ws = p.ws; const int tid = threadIdx.x, lane = tid & 63;
    const bf16_t* Yc = (const bf16_t*)(ws + OFF_Y); bf16_t* Y = (bf16_t*)(ws + OFF_Y);
    const bf16_t* KT = (const bf16_t*)(ws + OFF_TMP); const bf16_t* VB = (const bf16_t*)(ws + OFF_VB);
    const float* Wg = (const float*)(ws + OFF_QB);
    const float *BQ = (const float*)(ws + OFF_BQ), *IQ = (const float*)(ws + OFF_IQ), *MT = (const float*)(ws + OFF_MT), *CH = (const float*)(ws + OFF_CH);
    bf16_t* Qs = (bf16_t*)lds;
    bf16_t* Ks = Qs + 64 * 264;
    float* Ws = (float*)(Ks + 64 * 264);
    float* Vs = Ws + 64 * 65;
    float* Cs = Vs + 64 * 8;
    float* ns = Cs + 8 * 260;
    float* sa = ns + 256;
    float* sden = sa + 64;
    float* ssw = sden + 64;
    for (int wu = blockIdx.x; wu < 256; wu += gridDim.x) {
        const int bh = wu >> 5, vs = wu & 31, batch = bh >> 2, head = bh & 3;
        float c[4] = {0.f, 0.f, 0.f, 0.f}; float nreg = 0.f;
        const int uv = tid >> 6;
        const int ot = tid >> 3, ov = tid & 7;
        for (int ch = 0; ch < 256; ++ch) {
            const size_t t0 = (size_t)batch * SEQ + ch * 64;
            const float mprev = CH[bh * 256 + ch], mnew = CH[2048 + bh * 256 + ch], blast = CH[4096 + bh * 256 + ch];
            const float decay = __expf(blast + mprev - mnew);
            __syncthreads();
#pragma unroll
            for (int j = 0; j < 4; ++j) { const int e = tid + 512 * j, r = e >> 5, cg = e & 31;
                *(u32x4*)(Qs + r * 264 + cg * 8) = *(const u32x4*)(Yc + (t0 + r) * 2048 + 1024 + head * 256 + cg * 8);
                *(u32x4*)(Ks + r * 264 + cg * 8) = *(const u32x4*)(KT + (t0 + r) * 1024 + head * 256 + cg * 8); }
#pragma unroll
            for (int j = 0; j < 8; ++j) { const int e = tid + 512 * j, r = e >> 6, cc = e & 63; Ws[r * 65 + cc] = Wg[((size_t)(bh * 256 + ch)) * 4096 + e]; }
            if (tid < 64) { const u32x4 w = *(const u32x4*)(VB + (t0 + tid) * 1024 + head * 256 + vs * 8);
                float* d = Vs + tid * 8; d[0] = bflo(w.x); d[1] = bfhi(w.x); d[2] = bflo(w.y); d[3] = bfhi(w.y); d[4] = bflo(w.z); d[5] = bfhi(w.z); d[6] = bflo(w.w); d[7] = bfhi(w.w);
                const float bq = BQ[(t0 + tid) * 4 + head], iq = IQ[(t0 + tid) * 4 + head], mt = MT[(t0 + tid) * 4 + head];
                sa[tid] = __expf(bq + mprev - mt); sden[tid] = __expf(-mt); ssw[tid] = __expf(blast - bq + iq - mnew); }
#pragma unroll
            for (int j = 0; j < 4; ++j) Cs[uv * 260 + lane + 64 * j] = c[j];
            if (tid < 256) ns[tid] = nreg;
            __syncthreads();
            {
                float inter = 0.f, ndot = 0.f, intra = 0.f, rsum = 0.f;
                const bf16_t* qr = Qs + ot * 264; const float* cr = Cs + ov * 260;
#pragma unroll 8
                for (int k = 0; k < 256; ++k) inter += cr[k] * bf2f(qr[k]);
#pragma unroll 8
                for (int k = 0; k < 32; ++k) ndot += ns[ov * 32 + k] * bf2f(qr[ov * 32 + k]);
                ndot += __shfl_xor(ndot, 1); ndot += __shfl_xor(ndot, 2); ndot += __shfl_xor(ndot, 4);
#pragma unroll 8
                for (int s = 0; s < 64; ++s) { const float w = Ws[ot * 65 + s]; intra += w * Vs[s * 8 + ov]; rsum += w; }
                const float a = sa[ot]; const float nq = a * ndot + rsum; const float den = fmaxf(fabsf(nq), sden[ot]);
                const float h = (a * inter + intra) / den;
                Y[(t0 + ot) * 2048 + head * 256 + vs * 8 + ov] = f2bf(h);
            }
            {
                float acc[4] = {0.f, 0.f, 0.f, 0.f}; float nacc = 0.f;
                for (int s = 0; s < 64; ++s) { const float sv = ssw[s] * Vs[s * 8 + uv]; const bf16_t* kr = Ks + s * 264 + lane;
#pragma unroll
                    for (int j = 0; j < 4; ++j) acc[j] += sv * bf2f(kr[64 * j]); }
#pragma unroll
                for (int j = 0; j < 4; ++j) c[j] = decay * c[j] + acc[j];
                if (tid < 256) { for (int s = 0; s < 64; ++s) nacc += ssw[s] * bf2f(Ks[s * 264 + tid]); nreg = decay * nreg + nacc; }
            }
        }
        __syncthreads();
    }
}

__device__ __forceinline__ void phase_ya_pool(const P& p) {
    unsigned char* ws = p.ws; const int tid = threadIdx.x, lane = tid & 63, wave = tid >> 6;
    bf16_t* Y = (bf16_t*)(ws + OFF_Y); const bf16_t* O = (const bf16_t*)(ws + OFF_QB); const bf16_t* ZA = (const bf16_t*)(ws + OFF_KB);
    for (int it = blockIdx.x * 8 + wave; it < T * 4; it += gridDim.x * 8) {
        const size_t t = (size_t)(it >> 2); const int head = it & 3, c = head * 256 + lane * 4;
        const u32x2 hw = *(const u32x2*)(Y + t * 2048 + c), ow = *(const u32x2*)(O + t * 1024 + c), zw = *(const u32x2*)(ZA + t * 1024 + c);
        float v[4] = {bflo(hw.x) * bflo(ow.x), bfhi(hw.x) * bfhi(ow.x), bflo(hw.y) * bflo(ow.y), bfhi(hw.y) * bfhi(ow.y)};
        float ss = wave_sum(v[0] * v[0] + v[1] * v[1] + v[2] * v[2] + v[3] * v[3]);
        const float rstd = rsqrtf(ss * (1.0f / 256.0f) + EPS);
        const f32x4 g = *(const f32x4*)(p.e_g_head + c);
        u32x2 o; o.x = pk2(v[0] * rstd * g[0] * bflo(zw.x), v[1] * rstd * g[1] * bfhi(zw.x)); o.y = pk2(v[2] * rstd * g[2] * bflo(zw.y), v[3] * rstd * g[3] * bfhi(zw.y));
        *(u32x2*)(Y + t * 2048 + c) = o;
    }
    const bf16_t* U = (const bf16_t*)(ws + OFF_VB);
    for (size_t it = (size_t)blockIdx.x * 512 + tid; it < (size_t)T * 128; it += (size_t)gridDim.x * 512) {
        const size_t t = it >> 7; const int c0 = (int)(it & 127) * 8, g = c0 >> 8, win = 2 << g, s = (int)(t & (SEQ - 1)); const int cnt = (s + 1 < win) ? s + 1 : win;
        float acc[8], self[8];
#pragma unroll
        for (int i = 0; i < 8; ++i) { acc[i] = 0.f; self[i] = 0.f; }
        for (int j = 0; j < cnt; ++j) { const u32x4 w = *(const u32x4*)(U + (t - j) * 1024 + c0);
            const float f[8] = {bflo(w.x), bfhi(w.x), bflo(w.y), bfhi(w.y), bflo(w.z), bfhi(w.z), bflo(w.w), bfhi(w.w)};
#pragma unroll
            for (int i = 0; i < 8; ++i) { acc[i] += f[i]; if (j == 0) self[i] = f[i]; } }
        const float inv = 1.0f / (float)cnt;
        bf16_t* yp = Y + t * 2048 + 1024 + c0; const u32x4 z = *(const u32x4*)yp;
        const float zf[8] = {bflo(z.x), bfhi(z.x), bflo(z.y), bfhi(z.y), bflo(z.z), bfhi(z.z), bflo(z.w), bfhi(z.w)};
        const f32x4 s0 = *(const f32x4*)(p.e_s_pool + c0), s1 = *(const f32x4*)(p.e_s_pool + c0 + 4);
        float o[8];
#pragma unroll
        for (int i = 0; i < 8; ++i) o[i] = (acc[i] * inv - self[i]) * (i < 4 ? s0[i] : s1[i - 4]) * zf[i];
        u32x4 ow; ow.x = pk2(o[0], o[1]); ow.y = pk2(o[2], o[3]); ow.z = pk2(o[4], o[5]); ow.w = pk2(o[6], o[7]);
        *(u32x4*)yp = ow;
    }
}

__device__ __forceinline__ void headnorm64(bf16_t* X, const float* g) {
    const int lane = threadIdx.x & 63, wave = threadIdx.x >> 6;
    for (int t = blockIdx.x * 8 + wave; t < T; t += gridDim.x * 8) {
        bf16_t* r = X + (size_t)t * 1024 + lane * 16;
        const u32x4 a = *(const u32x4*)r, b = *(const u32x4*)(r + 8);
        float f[16] = {bflo(a.x), bfhi(a.x), bflo(a.y), bfhi(a.y), bflo(a.z), bfhi(a.z), bflo(a.w), bfhi(a.w), bflo(b.x), bfhi(b.x), bflo(b.y), bfhi(b.y), bflo(b.z), bfhi(b.z), bflo(b.w), bfhi(b.w)};
        float ss = 0.f;
#pragma unroll
        for (int i = 0; i < 16; ++i) ss += f[i] * f[i];
        ss += __shfl_xor(ss, 1); ss += __shfl_xor(ss, 2);
        const float rstd = rsqrtf(ss * (1.0f / 64.0f) + EPS);
        const float* gg = g + (lane & 3) * 16;
#pragma unroll
        for (int i = 0; i < 16; ++i) f[i] = f[i] * rstd * gg[i];
        u32x4 oa, ob; oa.x = pk2(f[0], f[1]); oa.y = pk2(f[2], f[3]); oa.z = pk2(f[4], f[5]); oa.w = pk2(f[6], f[7]);
        ob.x = pk2(f[8], f[9]); ob.y = pk2(f[10], f[11]); ob.z = pk2(f[12], f[13]); ob.w = pk2(f[14], f[15]);
        *(u32x4*)r = oa; *(u32x4*)(r + 8) = ob;
    }
}
__device__ __forceinline__ void phase_qnorm_ckvnorm(const P& p) {
    unsigned char* ws = p.ws; const int lane = threadIdx.x & 63, wave = threadIdx.x >> 6;
    headnorm64((bf16_t*)(ws + OFF_TMP), p.o_g_q);
    bf16_t* CKVN = (bf16_t*)(ws + OFF_CKVN);
    for (int t = blockIdx.x * 8 + wave; t < T; t += gridDim.x * 8) {
        const u32x2 w = *(const u32x2*)(CKVN + (size_t)t * 256 + lane * 4);
        const float v[4] = {bflo(w.x), bfhi(w.x), bflo(w.y), bfhi(w.y)};
        const float ss = wave_sum(v[0] * v[0] + v[1] * v[1] + v[2] * v[2] + v[3] * v[3]);
        const float rstd = rsqrtf(ss * (1.0f / 256.0f) + EPS);
        const f32x4 g = *(const f32x4*)(p.o_g_kv + lane * 4);
        u32x2 o; o.x = pk2(v[0] * rstd * g[0], v[1] * rstd * g[1]); o.y = pk2(v[2] * rstd * g[2], v[3] * rstd * g[3]);
        *(u32x2*)(CKVN + (size_t)t * 256 + lane * 4) = o;
    }
}

__device__ __forceinline__ unsigned okey(float s) { if (s == 0.f) s = 0.f; const unsigned u = __float_as_uint(s); return (u & 0x80000000u) ? ~u : (u | 0x80000000u); }

__device__ __forceinline__ void phase_indexer(const P& p, unsigned char* lds) {
    unsigned char* ws = p.ws; const int tid = threadIdx.x, lane = tid & 63, wave = tid >> 6;
    const _Float16* QI = (const _Float16*)(ws + OFF_QI); const float* KI = (const float*)(ws + OFF_KI); const float* WI = (const float*)(ws + OFF_WI);
    unsigned short* IDX = (unsigned short*)(ws + OFF_IDX); int* CNT = (int*)(ws + OFF_CNT);
    unsigned* sc = (unsigned*)lds;
    unsigned* hist = sc + 16384;
    float* qs = (float*)(hist + 256);
    unsigned* misc = (unsigned*)(qs + 256);
    unsigned* wsum = misc + 16;
    const int G = gridDim.x, nround = T / G;
    for (int i = 0; i < nround; ++i) {
        const int tq = (i & 1) ? i * G + (G - 1 - (int)blockIdx.x) : i * G + (int)blockIdx.x;
        const int batch = tq & 1, pos = tq >> 1; const size_t t = (size_t)batch * SEQ + pos; const int n = pos + 1;
        if (n <= 256) { if (tid < 256) IDX[t * 256 + tid] = (unsigned short)(tid < n ? tid : 0); if (tid == 0) CNT[t] = n; continue; }
        __syncthreads();
        if (tid < 256) qs[tid] = (float)QI[t * 256 + tid];
        const float w0 = WI[t * 4 + 0], w1 = WI[t * 4 + 1], w2 = WI[t * 4 + 2], w3 = WI[t * 4 + 3];
        __syncthreads();
        const float* kbase = KI + (size_t)batch * SEQ * 64;
        for (int s = tid; s < n; s += 512) {
            asm volatile("" ::: "memory");
            const f32x4* kr = (const f32x4*)(kbase + (size_t)s * 64);
            float d0 = 0.f, d1 = 0.f, d2 = 0.f, d3 = 0.f;
#pragma unroll
            for (int j = 0; j < 16; ++j) { const f32x4 kv = kr[j];
#pragma unroll
                for (int e = 0; e < 4; ++e) { const int d = j * 4 + e; d0 += qs[d] * kv[e]; d1 += qs[64 + d] * kv[e]; d2 += qs[128 + d] * kv[e]; d3 += qs[192 + d] * kv[e]; } }
            float score = w0 * fmaxf(d0, 0.f); score += w1 * fmaxf(d1, 0.f); score += w2 * fmaxf(d2, 0.f); score += w3 * fmaxf(d3, 0.f);
            sc[s] = okey(score);
        }
        unsigned prefix = 0, krem = 256;
        for (int pass = 0; pass < 4; ++pass) {
            const int shift = 24 - 8 * pass;
            __syncthreads();
            if (tid < 256) hist[tid] = 0;
            __syncthreads();
            for (int s = tid; s < n; s += 512) { const unsigned k = sc[s]; if (pass == 0 || (k >> (shift + 8)) == prefix) atomicAdd(&hist[(k >> shift) & 255u], 1u); }
            __syncthreads();
            if (tid == 0) { unsigned cum = 0; int bin = 255; for (; bin > 0; --bin) { const unsigned c = hist[bin]; if (cum + c >= krem) break; cum += c; } misc[0] = (unsigned)bin; misc[1] = krem - cum; }
            __syncthreads();
            prefix = (prefix << 8) | misc[0]; krem = misc[1];
        }
        const unsigned ngt_total = 256u - krem;
        unsigned lg = 0, le = 0; const int s0 = tid * 32;
        for (int s = s0; s < s0 + 32 && s < n; ++s) { const unsigned k = sc[s]; lg += (k > prefix); le += (k == prefix); }
        unsigned pk = lg | (le << 16), incl = pk;
#pragma unroll
        for (int o = 1; o < 64; o <<= 1) { const unsigned y = __shfl_up(incl, o); if (lane >= o) incl += y; }
        if (lane == 63) wsum[wave] = incl;
        __syncthreads();
        unsigned base = 0;
        for (int w = 0; w < wave; ++w) base += wsum[w];
        const unsigned excl = base + incl - pk; unsigned bg = excl & 0xffffu, be = excl >> 16;
        for (int s = s0; s < s0 + 32 && s < n; ++s) { const unsigned k = sc[s];
            if (k > prefix) { IDX[t * 256 + bg] = (unsigned short)s; ++bg; }
            else if (k == prefix) { if (be < krem) IDX[t * 256 + ngt_total + be] = (unsigned short)s; ++be; } }
        if (tid == 0) CNT[t] = 256;
    }
}

typedef short v4i16_t __attribute__((ext_vector_type(4)));
__device__ __forceinline__ void phase_attn(const P& p, unsigned char* lds) {
    unsigned char* ws = p.ws; const int tid = threadIdx.x, lane = tid & 63, hd = lane & 15, g = lane >> 4;
    const int wave = __builtin_amdgcn_readfirstlane(tid >> 6);
    bf16_t* QP = (bf16_t*)(ws + OFF_QP); const bf16_t* CK = (const bf16_t*)(ws + OFF_CKVN); const bf16_t* RK = (const bf16_t*)(ws + OFF_RK);
    const unsigned short* IDX = (const unsigned short*)(ws + OFF_IDX); const int* CNT = (const int*)(ws + OFF_CNT);
    float* biasT = (float*)lds;
    biasT[tid] = p.rel_bias[tid];
    __syncthreads();
    LAS unsigned char* rows = (LAS unsigned char*)(lds + 2048 + (size_t)wave * 18432);
    LAS bf16_t* rkb = (LAS bf16_t*)(rows + 16384);
    LAS unsigned* info = (LAS unsigned*)(rows + 17408);
    const LAS float* biasL = (const LAS float*)lds;
    for (int t = blockIdx.x * 8 + wave; t < T; t += gridDim.x * 8) {
        const int batch = t >> 14, pos = t & (SEQ - 1); const int cnt = CNT[t];
        const size_t rb = (size_t)batch * SEQ;
        asm volatile("s_waitcnt lgkmcnt(0)" ::: "memory");
#pragma unroll
        for (int jj = 0; jj < 4; ++jj) {
            const int j = lane + 64 * jj; int id = IDX[(size_t)t * 256 + j]; if (j >= cnt) id = 0;
            const int rel = pos - id; int bucket = rel < 0 ? 0 : rel;
            if (rel >= 16) { bucket = 16 + (int)(__logf((float)rel * 0.0625f) / 2.0794415416798357f * 16.0f); bucket = bucket > 31 ? 31 : bucket; }
            info[j] = (unsigned)id | ((unsigned)bucket << 16);
        }
        bf16x8 qf[8];
#pragma unroll
        for (int ks = 0; ks < 8; ++ks) qf[ks] = *(const bf16x8*)(QP + (size_t)t * 4096 + hd * 256 + ks * 32 + g * 8);
        f32x4 o[16];
#pragma unroll
        for (int rt = 0; rt < 16; ++rt) o[rt] = (f32x4){0.f, 0.f, 0.f, 0.f};
        float mrun = -1e30f, lrun = 0.f;
        asm volatile("s_waitcnt lgkmcnt(0)" ::: "memory");
        const int nch = (cnt + 31) >> 5;
        for (int ch = 0; ch < nch; ++ch) {
            asm volatile("s_waitcnt lgkmcnt(0)" ::: "memory");
#pragma unroll
            for (int i = 0; i < 16; ++i) {
                const int ksl = 2 * i + (lane >> 5); const unsigned idv = info[ch * 32 + ksl] & 0xffffu;
                const bf16_t* src = CK + (rb + idv) * 256 + (((lane & 31) ^ (ksl & 15)) * 8);
                __builtin_amdgcn_global_load_lds((const unsigned*)src, (LAS unsigned*)(rows + i * 1024), 16, 0, 0);
            }
            { const unsigned idv = info[ch * 32 + (lane >> 1)] & 0xffffu;
              __builtin_amdgcn_global_load_lds((const unsigned*)(RK + (rb + idv) * 16 + (lane & 1) * 8), (LAS unsigned*)rkb, 16, 0, 0); }
            asm volatile("s_waitcnt vmcnt(0)" ::: "memory");
            f32x4 s0 = (f32x4){0.f, 0.f, 0.f, 0.f}, s1 = (f32x4){0.f, 0.f, 0.f, 0.f};
#pragma unroll
            for (int ks = 0; ks < 8; ++ks) {
                const int pos16 = ((4 * ks + g) ^ hd) * 16;
                const bf16x8 a0 = *(const LAS bf16x8*)(rows + hd * 512 + pos16);
                const bf16x8 a1 = *(const LAS bf16x8*)(rows + (16 + hd) * 512 + pos16);
                s0 = __builtin_amdgcn_mfma_f32_16x16x32_bf16(a0, qf[ks], s0, 0, 0, 0);
                s1 = __builtin_amdgcn_mfma_f32_16x16x32_bf16(a1, qf[ks], s1, 0, 0, 0);
            }
            float x0[4], x1[4]; float cm = -INFINITY;
#pragma unroll
            for (int r = 0; r < 4; ++r) {
                const int sl0 = 4 * g + r, sl1 = 16 + 4 * g + r, j0 = ch * 32 + sl0, j1 = ch * 32 + sl1;
                const unsigned i0 = info[j0], i1 = info[j1];
                const float r0 = bf2f(rkb[sl0 * 16 + hd]), r1 = bf2f(rkb[sl1 * 16 + hd]);
                x0[r] = (j0 < cnt) ? s0[r] * r0 + biasL[(i0 >> 16) * 16 + hd] : -INFINITY;
                x1[r] = (j1 < cnt) ? s1[r] * r1 + biasL[(i1 >> 16) * 16 + hd] : -INFINITY;
                cm = fmaxf(cm, fmaxf(x0[r], x1[r]));
            }
            cm = fmaxf(cm, __shfl_xor(cm, 16)); cm = fmaxf(cm, __shfl_xor(cm, 32));
            const float mnew = fmaxf(mrun, cm); const float sc = __expf(mrun - mnew); mrun = mnew;
            float ls = 0.f;
#pragma unroll
            for (int r = 0; r < 4; ++r) { x0[r] = __expf(x0[r] - mnew); x1[r] = __expf(x1[r] - mnew); ls += x0[r] + x1[r]; }
            lrun = lrun * sc + ls;
#pragma unroll
            for (int rt = 0; rt < 16; ++rt) o[rt] *= sc;
            u32x4 pw; pw.x = pg8::cvt_pk_bf16(x0[0], x0[1]); pw.y = pg8::cvt_pk_bf16(x0[2], x0[3]); pw.z = pg8::cvt_pk_bf16(x1[0], x1[1]); pw.w = pg8::cvt_pk_bf16(x1[2], x1[3]);
            const bf16x8 pf = __builtin_bit_cast(bf16x8, pw);
            const int q = hd >> 2, pp = hd & 3, ksl = 4 * g + q;
            const LAS unsigned char* trb = rows + ksl * 512 + (pp & 1) * 8;
#pragma unroll
            for (int rt = 0; rt < 16; ++rt) {
                const int c16 = ((2 * rt + (pp >> 1)) ^ ksl) * 16;
                const v4i16_t t0 = __builtin_amdgcn_ds_read_tr16_b64_v4i16((LAS v4i16_t*)(trb + c16));
                const v4i16_t t1 = __builtin_amdgcn_ds_read_tr16_b64_v4i16((LAS v4i16_t*)(trb + c16 + 8192));
                bf16x8 af; af[0] = t0[0]; af[1] = t0[1]; af[2] = t0[2]; af[3] = t0[3]; af[4] = t1[0]; af[5] = t1[1]; af[6] = t1[2]; af[7] = t1[3];
                o[rt] = __builtin_amdgcn_mfma_f32_16x16x32_bf16(af, pf, o[rt], 0, 0, 0);
            }
        }
        float ltot = lrun; ltot += __shfl_xor(ltot, 16); ltot += __shfl_xor(ltot, 32);
        const float inv = 1.0f / ltot;
        bf16_t* op = QP + (size_t)t * 4096 + hd * 256 + 4 * g;
#pragma unroll
        for (int rt = 0; rt < 16; ++rt) { u32x2 w; w.x = pg8::cvt_pk_bf16(o[rt][0] * inv, o[rt][1] * inv); w.y = pg8::cvt_pk_bf16(o[rt][2] * inv, o[rt][3] * inv); *(u32x2*)(op + rt * 16) = w; }
    }
}

__global__ void __launch_bounds__(512, 2) k_fwd(P p, int ph_lo, int ph_hi) {
    extern __shared__ __attribute__((aligned(16))) unsigned char smem[];
    unsigned char* lds = smem + 16;
    unsigned char* ws = p.ws;
    XcdBarrier bar;
    const bool multi = (ph_hi - ph_lo) > 1;
    if (multi) {
        if (threadIdx.x == 0) *(uint4*)smem = make_uint4(0u, 0u, 0u, 0u);
        __syncthreads();
        bar = xcd_barrier_post((unsigned*)(ws + OFF_CTL), (volatile LAS unsigned*)smem);
    }
#define PH(i) (ph_lo <= (i) && (i) < ph_hi)
#define SEAM(i) do { if ((i) + 1 < ph_hi) xcd_barrier(bar); else __syncthreads(); } while (0)
    bf16_t *XN = (bf16_t*)(ws + OFF_XN), *QB = (bf16_t*)(ws + OFF_QB), *KB = (bf16_t*)(ws + OFF_KB), *VB = (bf16_t*)(ws + OFF_VB), *TMP = (bf16_t*)(ws + OFF_TMP), *Y = (bf16_t*)(ws + OFF_Y);
    if (PH(0)) { phase_prep(p, lds); SEAM(0); }
    if (PH(1)) { fast_gemm(lds, XN, 1024, (const bf16_t*)(ws + OFF_W0T), 1024, 3072, 1024, D1{ws}); SEAM(1); }
    if (PH(2)) { phase_conv_scan(p, lds); SEAM(2); }
    if (PH(3)) { GM1 f{Y, TMP, (const float*)(ws + OFF_BQ), (const float*)(ws + OFF_IQ), (const float*)(ws + OFF_MT), (float*)(ws + OFF_QB)}; sgemm(f, 2048); SEAM(3); }
    if (PH(4)) { phase_mlstm_seq(p, lds); SEAM(4); }
    if (PH(5)) { fast_gemm(lds, XN, 1024, (const bf16_t*)(ws + OFF_W0T) + (size_t)3072 * 1024, 1024, 4096, 1024, D2{ws}); SEAM(5); }
    if (PH(6)) { phase_ya_pool(p); SEAM(6); }
    if (PH(7)) { fast_gemm(lds, Y, 2048, (const bf16_t*)(ws + OFF_WO0T), 2048, 1024, 2048, D4{(unsigned char*)p.out, p.x}); SEAM(7); }
    if (PH(8)) { rmsnorm_rows<4>(p.out, p.o_norm, XN, p.o_w_in, OIN, 1600, nullptr, 0.5f, (float*)(ws + OFF_WI)); SEAM(8); }
    if (PH(9)) { fast_gemm(lds, XN, 1024, (const bf16_t*)(ws + OFF_W1T), 1024, 2816, 1024, D5{ws}); SEAM(9); }
    if (PH(10)) { phase_qnorm_ckvnorm(p); SEAM(10); }
    if (PH(11)) { fast_gemm(lds, (const bf16_t*)(ws + OFF_CKVN), 256, (const bf16_t*)(ws + OFF_WUKP), 256, 1024, 256, DK{ws}); SEAM(11); }
    if (PH(12)) { GQP f{TMP, (const bf16_t*)(ws + OFF_WQP), (bf16_t*)(ws + OFF_QP)}; sgemm(f, 512 * 64); phase_indexer(p, lds); SEAM(12); }
    if (PH(13)) { phase_attn(p, lds); SEAM(13); }
    if (PH(14)) { GOP f{(const bf16_t*)(ws + OFF_QP), (const bf16_t*)(ws + OFF_WUVT), (const bf16_t*)(ws + OFF_Z), TMP}; sgemm(f, 512 * 16); SEAM(14); }
    if (PH(15)) { fast_gemm(lds, TMP, 1024, (const bf16_t*)(ws + OFF_WO1T), 1024, 1024, 1024, D8{(unsigned char*)p.out}); }
#undef PH
#undef SEAM
}

extern "C" void kernel_launch(void* const* d_in, const int* in_sizes, int n_in, void* d_out, int out_size, void* d_ws, size_t ws_size, hipStream_t stream) {
    static int grid = 0;
    if (grid == 0) {
        if (n_in != 18 || out_size != T * DM || ws_size < WS_END) { fprintf(stderr, "kernel_launch: unexpected shapes (n_in %d out %d ws %zu)\n", n_in, out_size, ws_size); grid = -1; return; }
        if (hipFuncSetAttribute((const void*)k_fwd, hipFuncAttributeMaxDynamicSharedMemorySize, LDS_BYTES) != hipSuccess) { fprintf(stderr, "kernel_launch: hipFuncSetAttribute failed\n"); grid = -1; return; }
        grid = 256;
    }
    if (grid < 0) return;
    (void)hipMemsetAsync((char*)d_ws + OFF_CTL, 0, 16384, stream);
    P p{};
    p.x = (const float*)d_in[0]; p.e_norm = (const float*)d_in[1]; p.e_w_in = (const float*)d_in[2]; p.e_conv = (const float*)d_in[3]; p.e_b_if = (const float*)d_in[4];
    p.e_g_head = (const float*)d_in[5]; p.e_w_pool = (const float*)d_in[6]; p.e_s_pool = (const float*)d_in[7]; p.e_w_out = (const float*)d_in[8];
    p.o_norm = (const float*)d_in[9]; p.o_w_in = (const float*)d_in[10]; p.o_g_kv = (const float*)d_in[11]; p.o_w_uk = (const float*)d_in[12]; p.o_w_uv = (const float*)d_in[13];
    p.o_g_q = (const float*)d_in[14]; p.o_g_k = (const float*)d_in[15]; p.o_w_out = (const float*)d_in[16]; p.rel_bias = (const float*)d_in[17];
    p.out = (float*)d_out; p.ws = (unsigned char*)d_ws;
    hipLaunchKernelGGL(k_fwd, dim3(grid), dim3(512), LDS_BYTES, stream, p, 0, NPH);
}
```

```cpp
#include <hip/hip_runtime.h>
#include <stdint.h>
#include <cstdio>

typedef unsigned short bf16_t;
typedef short bf16x8 __attribute__((ext_vector_type(8)));
typedef float f32x4 __attribute__((ext_vector_type(4)));
typedef unsigned u32x4 __attribute__((ext_vector_type(4)));
typedef unsigned u32x2 __attribute__((ext_vector_type(2)));
#define LAS __attribute__((address_space(3)))

constexpr int T = 32768, SEQ = 16384, DM = 1024;
constexpr int EIN = 7176, OIN = 2628;
constexpr float EPS = 1e-6f;
constexpr size_t MB = 1048576;
constexpr size_t OFF_CTL = 0;
constexpr size_t OFF_GATES = 64 * 1024;
constexpr size_t OFF_BQ = OFF_GATES + (size_t)T * 8 * 4;
constexpr size_t OFF_IQ = OFF_BQ + (size_t)T * 4 * 4;
constexpr size_t OFF_MT = OFF_IQ + (size_t)T * 4 * 4;
constexpr size_t OFF_WI = OFF_MT + (size_t)T * 4 * 4;
constexpr size_t OFF_CH = OFF_WI + (size_t)T * 4 * 4;
constexpr size_t OFF_W = 4 * MB;
constexpr size_t OFF_W0T = OFF_W;
constexpr size_t OFF_WPT = OFF_W0T + (size_t)7168 * 1024 * 2;
constexpr size_t OFF_WO0T = OFF_WPT + (size_t)4 * 256 * 256 * 2;
constexpr size_t OFF_W1T = OFF_WO0T + (size_t)1024 * 2048 * 2;
constexpr size_t OFF_WUKT = OFF_W1T + (size_t)2816 * 1024 * 2;
constexpr size_t OFF_WUVT = OFF_WUKT + (size_t)1024 * 256 * 2;
constexpr size_t OFF_WO1T = OFF_WUVT + (size_t)1024 * 256 * 2;
constexpr size_t OFF_WUKP = OFF_WO1T + (size_t)1024 * 1024 * 2;
constexpr size_t OFF_WQP = OFF_WUKP + (size_t)1024 * 256 * 2;
constexpr size_t OFF_XN = 36 * MB, OFF_QB = 100 * MB, OFF_KB = 164 * MB, OFF_VB = 228 * MB, OFF_TMP = 292 * MB, OFF_Y = 356 * MB;
constexpr size_t OFF_QP = 36 * MB;
constexpr size_t OFF_CKVN = OFF_Y;
constexpr size_t OFF_QI = OFF_Y + 16 * MB;
constexpr size_t OFF_KI = OFF_Y + 32 * MB;
constexpr size_t OFF_IDX = OFF_Y + 40 * MB;
constexpr size_t OFF_RK = OFF_Y + 58 * MB;
constexpr size_t OFF_CNT = OFF_Y + 59 * MB;
constexpr size_t OFF_Z = OFF_Y + 60 * MB;
constexpr size_t WS_END = 484 * MB;
constexpr int LDS_BYTES = 151552;
constexpr int NPH = 16;

struct P {
    const float *x, *e_norm, *e_w_in, *e_conv, *e_b_if, *e_g_head, *e_w_pool, *e_s_pool, *e_w_out;
    const float *o_norm, *o_w_in, *o_g_kv, *o_w_uk, *o_w_uv, *o_g_q, *o_g_k, *o_w_out, *rel_bias;
    float* out; unsigned char* ws;
};

__device__ __forceinline__ bf16_t f2bf(float f) { unsigned u = __float_as_uint(f); u += 0x7FFFu + ((u >> 16) & 1u); return (bf16_t)(u >> 16); }
__device__ __forceinline__ float bf2f(bf16_t b) { return __uint_as_float(((unsigned)b) << 16); }
__device__ __forceinline__ float bflo(unsigned w) { return __uint_as_float(w << 16); }
__device__ __forceinline__ float bfhi(unsigned w) { return __uint_as_float(w & 0xffff0000u); }
__device__ __forceinline__ unsigned pk2(float a, float b) { return (unsigned)f2bf(a) | ((unsigned)f2bf(b) << 16); }
__device__ __forceinline__ float sigmoidf_(float x) { return 1.0f / (1.0f + __expf(-x)); }
__device__ __forceinline__ float siluf_(float x) { return x / (1.0f + __expf(-x)); }
__device__ __forceinline__ float wave_sum(float v) {
#pragma unroll
    for (int o = 32; o >= 1; o >>= 1) v += __shfl_xor(v, o);
    return v;
}
__device__ __forceinline__ float wave_max(float v) {
#pragma unroll
    for (int o = 32; o >= 1; o >>= 1) v = fmaxf(v, __shfl_xor(v, o));
    return v;
}

#define XB_TMO      128
#define XB_XCNT(j)  (256  + 64 * (j))
#define XB_XSUB(j)  (1280 + 64 * (j))
#define XB_XGEN(j)  (2304 + 64 * (j))
#define XB_TOP      3328
#define XB_TOPGEN   3392
#define XCD_BAR_WORDS 3456
#define XB_SPIN_CAP (1u << 22)
__device__ __forceinline__ unsigned xb_ld(unsigned* p)              { return __hip_atomic_load(p, __ATOMIC_RELAXED, __HIP_MEMORY_SCOPE_AGENT); }
__device__ __forceinline__ unsigned xb_add(unsigned* p, unsigned v) { return __hip_atomic_fetch_add(p, v, __ATOMIC_RELAXED, __HIP_MEMORY_SCOPE_AGENT); }
__device__ __forceinline__ unsigned xb_xcc_id() { return (unsigned)__builtin_amdgcn_s_getreg((3 << 11) | 20) & 0xFu; }
#define XB_SPIN(cond, bar) do { unsigned _sp = 0; while (cond) { __builtin_amdgcn_s_sleep(1); \
    if ((++_sp & 255u) == 0u) { if (xb_ld(&(bar)[XB_TMO])) break; if (_sp > XB_SPIN_CAP) { atomicAdd(&(bar)[XB_TMO], 1u); break; } } } } while (0)
struct XcdBarrier { unsigned* bar; unsigned x; volatile LAS unsigned* st; };
__device__ __forceinline__ XcdBarrier xcd_barrier_post(unsigned* bar, volatile LAS unsigned* st) {
    XcdBarrier b; b.bar = bar; b.x = xb_xcc_id(); b.st = st;
    if (threadIdx.x == 0) (void)xb_add(&bar[XB_XCNT(b.x)], 1u);
    return b;
}
__device__ __forceinline__ void xcd_barrier_complete(unsigned* bar, unsigned x, unsigned& nloc, unsigned& nx) {
    const unsigned G = gridDim.x * gridDim.y * gridDim.z;
    unsigned sum, cnt, mine, sp = 0u;
    for (;;) {
        sum = 0u; cnt = 0u; mine = 0u;
#pragma unroll
        for (unsigned j = 0; j < 16; ++j) { const unsigned c = xb_ld(&bar[XB_XCNT(j)]); sum += c; cnt += (c > 0u) ? 1u : 0u; mine = (j == x) ? c : mine; }
        if (sum == G) break;
        __builtin_amdgcn_s_sleep(1);
        if ((++sp & 255u) == 0u) { if (xb_ld(&bar[XB_TMO])) break; if (sp > XB_SPIN_CAP) { atomicAdd(&bar[XB_TMO], 1u); break; } }
    }
    nloc = mine > 0u ? mine : 1u; nx = cnt > 0u ? cnt : 1u;
}
__device__ __forceinline__ void xcd_barrier(const XcdBarrier& b) {
    asm volatile("s_waitcnt vmcnt(0)" ::: "memory");
    __syncthreads();
    if (threadIdx.x == 0) {
        unsigned* bar = b.bar;
        __builtin_amdgcn_s_waitcnt(0);
        unsigned nloc = b.st[0], nx = b.st[1];
        if (nloc == 0u) { xcd_barrier_complete(bar, b.x, nloc, nx); b.st[0] = nloc; b.st[1] = nx; }
        const unsigned old = xb_add(&bar[XB_XSUB(b.x)], 1u);
        const unsigned gen = old / nloc;
        if (old + 1u == (gen + 1u) * nloc) {
            __builtin_amdgcn_fence(__ATOMIC_RELEASE, "agent");
            asm volatile("s_waitcnt vmcnt(0)" ::: "memory");
            const unsigned og = xb_add(&bar[XB_TOP], 1u);
            const unsigned tg = og / nx;
            if (og + 1u == (tg + 1u) * nx) xb_add(&bar[XB_TOPGEN], 1u);
            else XB_SPIN(xb_ld(&bar[XB_TOPGEN]) == tg, bar);
            __builtin_amdgcn_fence(__ATOMIC_ACQUIRE, "agent");
            xb_add(&bar[XB_XGEN(b.x)], 1u);
            asm volatile("s_waitcnt vmcnt(0)" ::: "memory");
        } else {
            XB_SPIN(xb_ld(&bar[XB_XGEN(b.x)]) == gen, bar);
            __builtin_amdgcn_fence(__ATOMIC_ACQUIRE, "agent");
            asm volatile("s_waitcnt vmcnt(0)" ::: "memory");
        }
    }
    __syncthreads();
}

struct Tile { const bf16_t* A; const bf16_t* B; int lda, ldb, K; void* d0; const void* s0; int ld, mode; float aux0, aux1, aux2; int i0, i1; };
template <class F>
__device__ __forceinline__ void sgemm(const F f, int nunits) {
    const int lane = threadIdx.x & 63, wave = threadIdx.x >> 6, fr = lane & 15, fq = lane >> 4;
    for (int u = blockIdx.x * 8 + wave; u < nunits; u += gridDim.x * 8) {
        Tile tl; f.tile(u, tl);
        f32x4 acc[4][4];
#pragma unroll
        for (int m = 0; m < 4; ++m)
#pragma unroll
            for (int n = 0; n < 4; ++n) acc[m][n] = (f32x4){0.f, 0.f, 0.f, 0.f};
        const bf16_t* ap = tl.A + (size_t)fr * tl.lda + fq * 8;
        const bf16_t* bp = tl.B + (size_t)fr * tl.ldb + fq * 8;
        const int K = tl.K, lda = tl.lda, ldb = tl.ldb;
#pragma unroll 1
        for (int k0 = 0; k0 < K; k0 += 32) {
            bf16x8 a[4], b[4];
#pragma unroll
            for (int m = 0; m < 4; ++m) a[m] = *(const bf16x8*)(ap + (size_t)(m * 16) * lda + k0);
#pragma unroll
            for (int n = 0; n < 4; ++n) b[n] = *(const bf16x8*)(bp + (size_t)(n * 16) * ldb + k0);
#pragma unroll
            for (int m = 0; m < 4; ++m)
#pragma unroll
                for (int n = 0; n < 4; ++n) acc[m][n] = __builtin_amdgcn_mfma_f32_16x16x32_bf16(a[m], b[n], acc[m][n], 0, 0, 0);
        }
#pragma unroll
        for (int m = 0; m < 4; ++m)
#pragma unroll
            for (int j = 0; j < 4; ++j) {
                const int r = m * 16 + fq * 4 + j;
                asm volatile("" ::: "memory");
#pragma unroll
                for (int n = 0; n < 4; ++n) f.out(tl, r, n * 16 + fr, acc[m][n][j]);
            }
    }
}
__device__ __forceinline__ void store_mode(const Tile& tl, int r, int c, float v) {
    const size_t i = (size_t)r * tl.ld + c;
    if (tl.mode == 0) ((bf16_t*)tl.d0)[i] = f2bf(v);
    else if (tl.mode == 1) ((bf16_t*)tl.d0)[i] = f2bf(sigmoidf_(v));
    else if (tl.mode == 2) ((bf16_t*)tl.d0)[i] = f2bf(siluf_(v));
    else if (tl.mode == 3) ((float*)tl.d0)[i] = v * tl.aux0;
}

struct G1 {
    const bf16_t* XN; const bf16_t* W; bf16_t *Q, *K_, *V;
    __device__ __forceinline__ void tile(int u, Tile& tl) const {
        const int mt = u / 48, nt = u % 48; tl.A = XN + (size_t)mt * 64 * 1024; tl.lda = 1024; tl.B = W + (size_t)nt * 64 * 1024; tl.ldb = 1024; tl.K = 1024;
        const int col = nt * 64, sec = col >> 10, cc = col & 1023; bf16_t* d = Q + (size_t)sec * (32 * MB);
        tl.d0 = d + (size_t)mt * 64 * 1024 + cc; tl.ld = 1024; tl.mode = 0; }
    __device__ __forceinline__ void out(const Tile& tl, int r, int c, float v) const { store_mode(tl, r, c, v); }
};
struct G2 {
    const bf16_t* XN; const bf16_t* W; bf16_t *O, *ZA, *U, *Y;
    __device__ __forceinline__ void tile(int u, Tile& tl) const {
        const int mt = u / 64, nt = u % 64; tl.A = XN + (size_t)mt * 64 * 1024; tl.lda = 1024; tl.B = W + (size_t)(3072 + nt * 64) * 1024; tl.ldb = 1024; tl.K = 1024;
        const int col = nt * 64, sec = col >> 10, cc = col & 1023;
        if (sec == 0) { tl.d0 = O + (size_t)mt * 64 * 1024 + cc; tl.ld = 1024; tl.mode = 1; }
        else if (sec == 1) { tl.d0 = ZA + (size_t)mt * 64 * 1024 + cc; tl.ld = 1024; tl.mode = 2; }
        else if (sec == 2) { tl.d0 = U + (size_t)mt * 64 * 1024 + cc; tl.ld = 1024; tl.mode = 0; }
        else { tl.d0 = Y + (size_t)mt * 64 * 2048 + 1024 + cc; tl.ld = 2048; tl.mode = 2; } }
    __device__ __forceinline__ void out(const Tile& tl, int r, int c, float v) const { store_mode(tl, r, c, v); }
};
struct GM1 {
    const bf16_t* Y; const bf16_t* KT; const float *BQ, *IQ, *MT; float* W;
    __device__ __forceinline__ void tile(int u, Tile& tl) const {
        const int bh = u >> 8, c = u & 255, batch = bh >> 2, head = bh & 3; const size_t t0 = (size_t)batch * SEQ + c * 64;
        tl.A = Y + t0 * 2048 + 1024 + head * 256; tl.lda = 2048; tl.B = KT + t0 * 1024 + head * 256; tl.ldb = 1024; tl.K = 256;
        tl.d0 = W + (size_t)u * 4096; tl.ld = 64; tl.mode = 0; tl.i0 = (int)(t0 * 4 + head); }
    __device__ __forceinline__ void out(const Tile& tl, int r, int c, float v) const {
        float w = 0.f;
        if (c <= r) w = __expf(BQ[tl.i0 + r * 4] - BQ[tl.i0 + c * 4] + IQ[tl.i0 + c * 4] - MT[tl.i0 + r * 4]) * v;
        ((float*)tl.d0)[r * 64 + c] = w; }
};
struct G3 {
    const bf16_t* XN; const bf16_t* W; const float* sp; bf16_t* Y;
    __device__ __forceinline__ void tile(int u, Tile& tl) const {
        const int mt = u >> 4, g = (u >> 2) & 3, nt = u & 3; tl.A = XN + (size_t)mt * 64 * 1024 + g * 256; tl.lda = 1024; tl.B = W + (size_t)(g * 256 + nt * 64) * 256; tl.ldb = 256; tl.K = 256;
        const int col = g * 256 + nt * 64; tl.d0 = Y + (size_t)mt * 64 * 2048 + 1024 + col; tl.ld = 2048; tl.s0 = sp + col; tl.mode = 0; }
    __device__ __forceinline__ void out(const Tile& tl, int r, int c, float v) const {
        bf16_t* d = (bf16_t*)tl.d0 + (size_t)r * 2048 + c; *d = f2bf(v * ((const float*)tl.s0)[c] * bf2f(*d)); }
};
struct G4 {
    const bf16_t* Y; const bf16_t* W; const float* x; float* out_;
    __device__ __forceinline__ void tile(int u, Tile& tl) const {
        const int mt = u >> 4, nt = u & 15; tl.A = Y + (size_t)mt * 64 * 2048; tl.lda = 2048; tl.B = W + (size_t)nt * 64 * 2048; tl.ldb = 2048; tl.K = 2048;
        const size_t o = (size_t)mt * 64 * 1024 + nt * 64; tl.d0 = out_ + o; tl.s0 = x + o; tl.ld = 1024; tl.mode = 0; }
    __device__ __forceinline__ void out(const Tile& tl, int r, int c, float v) const { const size_t i = (size_t)r * 1024 + c; ((float*)tl.d0)[i] = ((const float*)tl.s0)[i] + v; }
};
struct G5 {
    const bf16_t* XN; const bf16_t* W; bf16_t* Q; float *CKVR, *QI, *KI; bf16_t* Z;
    __device__ __forceinline__ void tile(int u, Tile& tl) const {
        const int mt = u / 44, nt = u % 44; tl.A = XN + (size_t)mt * 64 * 1024; tl.lda = 1024; tl.B = W + (size_t)nt * 64 * 1024; tl.ldb = 1024; tl.K = 1024;
        const int col = nt * 64; const size_t row0 = (size_t)mt * 64; tl.aux0 = 1.0f;
        if (col < 1024) { tl.d0 = Q + row0 * 1024 + col; tl.ld = 1024; tl.mode = 0; }
        else if (col < 1280) { tl.d0 = CKVR + row0 * 256 + (col - 1024); tl.ld = 256; tl.mode = 3; }
        else if (col < 1536) { tl.d0 = QI + row0 * 256 + (col - 1280); tl.ld = 256; tl.mode = 3; tl.aux0 = 0.125f; }
        else if (col < 1600) { tl.d0 = KI + row0 * 64 + (col - 1536); tl.ld = 64; tl.mode = 3; }
        else if (col < 1792) { tl.d0 = nullptr; tl.ld = 0; tl.mode = 4; }
        else { tl.d0 = Z + row0 * 1024 + (col - 1792); tl.ld = 1024; tl.mode = 2; } }
    __device__ __forceinline__ void out(const Tile& tl, int r, int c, float v) const { store_mode(tl, r, c, v); }
};
struct G67 {
    const bf16_t* C; const bf16_t *WK, *WV; bf16_t *KF, *VF;
    __device__ __forceinline__ void tile(int u, Tile& tl) const {
        const int which = u >= 8192, uu = u & 8191, mt = uu >> 4, nt = uu & 15; tl.A = C + (size_t)mt * 64 * 256; tl.lda = 256; tl.B = WK + (size_t)which * (1024 * 256) + (size_t)nt * 64 * 256;     tl.ldb = 256; tl.K = 256;
        tl.d0 = KF + (size_t)which * (32 * MB) + (size_t)mt * 64 * 1024 + nt * 64;     tl.ld = 1024; tl.mode = 0; }
    __device__ __forceinline__ void out(const Tile& tl, int r, int c, float v) const { store_mode(tl, r, c, v); }
};
struct G8 {
    const bf16_t* G; const bf16_t* W; float* out_;
    __device__ __forceinline__ void tile(int u, Tile& tl) const {
        const int mt = u >> 4, nt = u & 15; tl.A = G + (size_t)mt * 64 * 1024; tl.lda = 1024; tl.B = W + (size_t)nt * 64 * 1024; tl.ldb = 1024; tl.K = 1024;
        tl.d0 = out_ + (size_t)mt * 64 * 1024 + nt * 64; tl.ld = 1024; tl.mode = 0; }
    __device__ __forceinline__ void out(const Tile& tl, int r, int c, float v) const { float* d = (float*)tl.d0 + (size_t)r * 1024 + c; *d = *d + v; }
};

struct GQP {
    const bf16_t* Qn; const bf16_t* W; bf16_t* QP;
    __device__ __forceinline__ void tile(int u, Tile& tl) const {
        const int nt = u & 3, head = (u >> 2) & 15, mt = u >> 6; tl.A = Qn + (size_t)mt * 64 * 1024 + head * 64; tl.lda = 1024; tl.B = W + (size_t)(head * 256 + nt * 64) * 64; tl.ldb = 64; tl.K = 64;
        tl.d0 = QP + ((size_t)mt * 64 * 16 + head) * 256 + nt * 64; tl.ld = 4096; tl.mode = 0; }
    __device__ __forceinline__ void out(const Tile& tl, int r, int c, float v) const { store_mode(tl, r, c, v); }
};
struct GOP {
    const bf16_t* OP; const bf16_t* W; const bf16_t* Z; bf16_t* G;
    __device__ __forceinline__ void tile(int u, Tile& tl) const {
        const int head = u & 15, mt = u >> 4; tl.A = OP + (size_t)mt * 64 * 4096 + head * 256; tl.lda = 4096; tl.B = W + (size_t)head * 64 * 256; tl.ldb = 256; tl.K = 256;
        const size_t o = (size_t)mt * 64 * 1024 + head * 64; tl.d0 = G + o; tl.s0 = Z + o; tl.ld = 1024; tl.mode = 0; }
    __device__ __forceinline__ void out(const Tile& tl, int r, int c, float v) const { const size_t i = (size_t)r * 1024 + c; ((bf16_t*)tl.d0)[i] = f2bf(v * bf2f(((const bf16_t*)tl.s0)[i])); }
};

namespace pg8 {
constexpr int BM = 256, BK = 64, HALF = 128, HTB = HALF * BK * 2, STAGE_BYTES = 8 * HTB, NXCD = 8, WGM = 8;
__device__ __forceinline__ int lds_byte(int r, int c) { const int st = (r >> 4) * 2 + (c >> 5), rr = r & 15, cc = c & 31, ob = rr * 64 + cc * 2; return st * 1024 + (ob ^ (((ob >> 9) & 1) << 5)); }
__device__ __forceinline__ void stage_rc(int b, int& R, int& C) { const int st = b / 1024, sb = b % 1024, swz = sb ^ (((sb >> 9) & 1) << 5); R = (st >> 1) * 16 + swz / 64; C = (st & 1) * 32 + (swz % 64) / 2; }
__device__ __forceinline__ int perm32(int rho) { const int n = rho >> 4, i = rho & 15; return 8 * (i >> 2) + 4 * n + (i & 3); }
struct Unit { int pm, pn; };
struct Gemm { const bf16_t* A; int lda; const bf16_t* Bt; int ldb; int M, N, K; };
struct StaticOrder {
    int nM, nN, nwg, G, c;
    __device__ void init(int M, int N, int G_, int c_) { nM = M / BM; nN = N / BM; nwg = nM * nN; G = G_; c = c_; }
    __device__ bool next(int i, Unit& u) const {
        const long L = (long)i * G + c; if (L >= nwg) return false;
        int wgid = (int)L; { const int q = nwg / NXCD, r = nwg % NXCD, xcd = wgid % NXCD, off = wgid / NXCD; wgid = (xcd < r ? xcd * (q + 1) : r * (q + 1) + (xcd - r) * q) + off; }
        const int nig = WGM * nN, gid = wgid / nig, fm = gid * WGM, gsz = (nM - fm) < WGM ? (nM - fm) : WGM;
        u.pm = fm + ((wgid % nig) % gsz); u.pn = (wgid % nig) / gsz; return true;
    }
};
__device__ __forceinline__ unsigned cvt_pk_bf16(float lo, float hi) { unsigned r; asm volatile("v_cvt_pk_bf16_f32 %0, %1, %2" : "=v"(r) : "v"(lo), "v"(hi)); return r; }

struct Dst { unsigned char* base; const float* res; int ld, mode, ncol; float scale; };
template <class DescF> struct EpiGen {
    static constexpr bool PERM = true;
    DescF D;
    __device__ __forceinline__ void operator()(const f32x4 (&acc)[2][2][4][2], const Unit& u, int wr, int wc, int fr, int fq) const {
        Dst d; D.get(u, d);
        if ((DescF::MODES & 16) && d.mode == 4) return;
        const int r0 = wr * 64 + fr, c0 = wc * 32 + 8 * fq;
        if constexpr ((DescF::MODES & 64) != 0) {
#pragma unroll
            for (int ai = 0; ai < 2; ++ai)
#pragma unroll
                for (int m = 0; m < 4; ++m) {
                    float ss = 0.f;
#pragma unroll
                    for (int bj = 0; bj < 2; ++bj)
#pragma unroll
                        for (int n = 0; n < 2; ++n) { const f32x4 v = acc[ai][bj][m][n]; ss += v[0] * v[0] + v[1] * v[1] + v[2] * v[2] + v[3] * v[3]; }
                    ss += __shfl_xor(ss, 16); ss += __shfl_xor(ss, 32);
                    if (fq == 0) ((bf16_t*)d.base)[(size_t)(ai * HALF + r0 + m * 16) * d.ld + wc] = f2bf(rsqrtf(ss * (1.0f / 64.0f) + EPS));
                }
            return;
        } else {
#pragma unroll
        for (int ai = 0; ai < 2; ++ai)
#pragma unroll
            for (int m = 0; m < 4; ++m) {
                const size_t rowoff = (size_t)(ai * HALF + r0 + m * 16) * d.ld;
#pragma unroll
                for (int bj = 0; bj < 2; ++bj) {
                    const int col = bj * HALF + c0; f32x4 v0 = acc[ai][bj][m][0], v1 = acc[ai][bj][m][1];
                    if ((DescF::MODES & 7) && d.mode <= 2) {
                        if ((DescF::MODES & 2) && d.mode == 1) {
#pragma unroll
                            for (int j = 0; j < 4; ++j) { v0[j] = sigmoidf_(v0[j]); v1[j] = sigmoidf_(v1[j]); } }
                        if ((DescF::MODES & 4) && d.mode == 2) {
#pragma unroll
                            for (int j = 0; j < 4; ++j) { v0[j] = siluf_(v0[j]); v1[j] = siluf_(v1[j]); } }
                        u32x4 w; w.x = cvt_pk_bf16(v0[0], v0[1]); w.y = cvt_pk_bf16(v0[2], v0[3]); w.z = cvt_pk_bf16(v1[0], v1[1]); w.w = cvt_pk_bf16(v1[2], v1[3]);
                        *(u32x4*)((bf16_t*)d.base + rowoff + col) = w;
                    } else if ((DescF::MODES & 8) && d.mode == 3) {
                        if (col < d.ncol) { float* o = (float*)d.base + rowoff + col; *(f32x4*)o = v0 * d.scale; *(f32x4*)(o + 4) = v1 * d.scale; }
                    } else if ((DescF::MODES & 128) && d.mode == 7) {
                        typedef _Float16 h8 __attribute__((ext_vector_type(8)));
                        if (col < d.ncol) {
                        h8 hv; hv[0] = (_Float16)(v0[0] * d.scale); hv[1] = (_Float16)(v0[1] * d.scale); hv[2] = (_Float16)(v0[2] * d.scale); hv[3] = (_Float16)(v0[3] * d.scale);
                        hv[4] = (_Float16)(v1[0] * d.scale); hv[5] = (_Float16)(v1[1] * d.scale); hv[6] = (_Float16)(v1[2] * d.scale); hv[7] = (_Float16)(v1[3] * d.scale);
                        *(h8*)((_Float16*)d.base + rowoff + col) = hv; }
                    } else if constexpr ((DescF::MODES & 32) != 0) {
                        float* o = (float*)d.base + rowoff + col; const float* rs = d.res + rowoff + col;
                        const f32x4 a = *(const f32x4*)rs, b = *(const f32x4*)(rs + 4); *(f32x4*)o = a + v0; *(f32x4*)(o + 4) = b + v1;
                    }
                }
                if (m & 1) asm volatile("" ::: "memory");
            }
        }
    }
};

template <class Epi>
__device__ __forceinline__ void gemm_phase(LAS unsigned char* lds, const Gemm g, const StaticOrder& S, const Epi& E) {
    const int tid = threadIdx.x, wid = __builtin_amdgcn_readfirstlane(tid >> 6), lane = tid & 63, wr = wid >> 2, wc = wid & 3, fr = lane & 15, fq = lane >> 4;
    const int K = g.K, nt = K / BK;
    unsigned voffA[2], voffB[2];
#pragma unroll
    for (int i = 0; i < 2; ++i) { int R, C; stage_rc(tid * 16 + i * 8192, R, C); const int Rb = Epi::PERM ? ((R & ~31) + perm32(R & 31)) : R;
        voffA[i] = (unsigned)(R * g.lda + C) * 2u; voffB[i] = (unsigned)(Rb * g.ldb + C) * 2u; }
    const size_t kstep = (size_t)(BK * 2);
    const size_t hstepA = (size_t)HALF * g.lda * 2, hstepB = (size_t)HALF * g.ldb * 2;
    const size_t tstepA = 2 * hstepA, tstepB = 2 * hstepB;
    const unsigned ldsw = (unsigned)wid * 1024u;
    const int aoff = lds_byte(wr * 64 + fr, fq * 8), boff = lds_byte(wc * 32 + fr, fq * 8);
#define PG8_SA(b, h) (((b) * 2 + (h)) * HTB)
#define PG8_SB(b, h) ((4 + (b) * 2 + (h)) * HTB)
#define PG8_STAGE(bufoff, gbase, voff) do { _Pragma("unroll") for (int _i = 0; _i < 2; ++_i) \
        __builtin_amdgcn_global_load_lds((const unsigned*)((const char*)(gbase) + (voff)[_i]), (LAS unsigned*)(lds + (bufoff) + ldsw + _i * 8192), 16, 0, 0); } while (0)
#define PG8_LDA(dst, b, h) do { _Pragma("unroll") for (int m = 0; m < 4; ++m) _Pragma("unroll") for (int k = 0; k < 2; ++k) dst[m][k] = *(const LAS bf16x8*)(lds + PG8_SA(b, h) + aoff + m * 2048 + k * 1024); } while (0)
#define PG8_LDB(dst, b, h) do { _Pragma("unroll") for (int n = 0; n < 2; ++n) _Pragma("unroll") for (int k = 0; k < 2; ++k) dst[n][k] = *(const LAS bf16x8*)(lds + PG8_SB(b, h) + boff + n * 2048 + k * 1024); } while (0)
#define PG8_MMA(ai, bj, At, Bt) do { __builtin_amdgcn_s_setprio(1); _Pragma("unroll") for (int m = 0; m < 4; ++m) _Pragma("unroll") for (int n = 0; n < 2; ++n) _Pragma("unroll") for (int k = 0; k < 2; ++k) \
        acc[ai][bj][m][n] = __builtin_amdgcn_mfma_f32_16x16x32_bf16(Bt[n][k], At[m][k], acc[ai][bj][m][n], 0, 0, 0); __builtin_amdgcn_s_setprio(0); } while (0)
#define PG8_WAIT_V(n) asm volatile("s_waitcnt vmcnt(" #n ")" ::: "memory")
#define PG8_WAIT_L(n) asm volatile("s_waitcnt lgkmcnt(" #n ")" ::: "memory")
#define PG8_BAR __builtin_amdgcn_s_barrier()
#define PG8_SCHED __builtin_amdgcn_sched_barrier(0)
    Unit cur, nxt; int ui = 0;
    if (!S.next(0, cur)) return;
    f32x4 acc[2][2][4][2];
#pragma unroll
    for (int a = 0; a < 2; ++a)
#pragma unroll
        for (int b = 0; b < 2; ++b)
#pragma unroll
            for (int m = 0; m < 4; ++m)
#pragma unroll
                for (int n = 0; n < 2; ++n) acc[a][b][m][n] = (f32x4){0.f, 0.f, 0.f, 0.f};
    bf16x8 At[4][2], B0[2][2], B1[2][2];
    const char* cA = (const char*)g.A + (size_t)cur.pm * tstepA; const char* cB = (const char*)g.Bt + (size_t)cur.pn * tstepB;
    PG8_STAGE(PG8_SB(0, 0), cB, voffB); PG8_STAGE(PG8_SA(0, 0), cA, voffA); PG8_STAGE(PG8_SB(0, 1), cB + hstepB, voffB); PG8_STAGE(PG8_SA(0, 1), cA + hstepA, voffA);
    if (wr == 1) PG8_BAR;
    PG8_WAIT_V(4); PG8_BAR;
    PG8_STAGE(PG8_SB(1, 0), cB + kstep, voffB); PG8_STAGE(PG8_SA(1, 0), cA + kstep, voffA); PG8_STAGE(PG8_SB(1, 1), cB + hstepB + kstep, voffB);
    PG8_WAIT_V(6); PG8_BAR;
    for (;;) {
        const bool has_next = S.next(ui + 1, nxt);
        const char* nA = has_next ? (const char*)g.A + (size_t)nxt.pm * tstepA : cA; const char* nB = has_next ? (const char*)g.Bt + (size_t)nxt.pn * tstepB : cB;
#pragma unroll 1
        for (int t = 0; t < nt; t += 2) {
            const bool last = (t == nt - 2);
            const char* a1 = cA + (size_t)(t + 1) * kstep;
            const char* a2 = last ? nA : cA + (size_t)(t + 2) * kstep; const char* b2 = last ? nB : cB + (size_t)(t + 2) * kstep;
            const char* a3 = a2 + kstep; const char* b3 = b2 + kstep;
            PG8_LDB(B0, 0, 0); PG8_SCHED; PG8_LDA(At, 0, 0); PG8_STAGE(PG8_SA(1, 1), a1 + hstepA, voffA);
            PG8_WAIT_L(8); PG8_BAR; PG8_WAIT_L(0); PG8_MMA(0, 0, At, B0); PG8_BAR; PG8_SCHED;
            PG8_LDB(B1, 0, 1); PG8_STAGE(PG8_SB(0, 0), b2, voffB);
            PG8_BAR; PG8_WAIT_L(0); PG8_MMA(0, 1, At, B1); PG8_BAR;
            PG8_LDA(At, 0, 1); PG8_STAGE(PG8_SA(0, 0), a2, voffA);
            PG8_BAR; PG8_WAIT_L(0); PG8_MMA(1, 0, At, B0); PG8_BAR; PG8_SCHED;
            PG8_STAGE(PG8_SB(0, 1), b2 + hstepB, voffB);
            PG8_WAIT_V(6); PG8_BAR; PG8_MMA(1, 1, At, B1); PG8_BAR;
            PG8_LDB(B0, 1, 0); PG8_SCHED; PG8_LDA(At, 1, 0); PG8_STAGE(PG8_SA(0, 1), a2 + hstepA, voffA);
            PG8_WAIT_L(8); PG8_BAR; PG8_WAIT_L(0); PG8_MMA(0, 0, At, B0); PG8_BAR; PG8_SCHED;
            PG8_LDB(B1, 1, 1); PG8_STAGE(PG8_SB(1, 0), b3, voffB);
            PG8_BAR; PG8_WAIT_L(0); PG8_MMA(0, 1, At, B1); PG8_BAR;
            PG8_LDA(At, 1, 1); PG8_STAGE(PG8_SA(1, 0), a3, voffA);
            PG8_BAR; PG8_WAIT_L(0); PG8_MMA(1, 0, At, B0); PG8_BAR; PG8_SCHED;
            PG8_STAGE(PG8_SB(1, 1), b3 + hstepB, voffB);
            PG8_WAIT_V(6); PG8_BAR; PG8_MMA(1, 1, At, B1); PG8_BAR;
        }
        E(acc, cur, wr, wc, fr, fq);
        if (!has_next) break;
#pragma unroll
        for (int a = 0; a < 2; ++a)
#pragma unroll
            for (int b = 0; b < 2; ++b)
#pragma unroll
                for (int m = 0; m < 4; ++m)
#pragma unroll
                    for (int n = 0; n < 2; ++n) acc[a][b][m][n] = (f32x4){0.f, 0.f, 0.f, 0.f};
        cur = nxt; cA = nA; cB = nB; ++ui;
    }
    PG8_WAIT_V(0);
    if (wr == 0) PG8_BAR;
    PG8_BAR;
#undef PG8_SA
#undef PG8_SB
#undef PG8_STAGE
#undef PG8_LDA
#undef PG8_LDB
#undef PG8_MMA
#undef PG8_WAIT_V
#undef PG8_WAIT_L
#undef PG8_BAR
#undef PG8_SCHED
}
}

struct D1 { static constexpr int MODES = 1; unsigned char* ws;
    __device__ __forceinline__ void get(const pg8::Unit& u, pg8::Dst& d) const { const int sec = u.pn >> 2;
        d.base = ws + OFF_QB + (size_t)sec * (64 * MB) + ((size_t)u.pm * 256 * 1024 + (u.pn & 3) * 256) * 2; d.res = nullptr; d.ld = 1024; d.mode = 0; d.ncol = 256; d.scale = 1.f; } };
struct D2 { static constexpr int MODES = 7; unsigned char* ws;
    __device__ __forceinline__ void get(const pg8::Unit& u, pg8::Dst& d) const { const int sec = u.pn >> 2, cc = (u.pn & 3) * 256; d.res = nullptr; d.ncol = 256; d.scale = 1.f;
        if (sec < 3) { d.base = ws + OFF_QB + (size_t)sec * (64 * MB) + ((size_t)u.pm * 256 * 1024 + cc) * 2; d.ld = 1024; d.mode = sec == 0 ? 1 : (sec == 1 ? 2 : 0); }
        else { d.base = ws + OFF_Y + ((size_t)u.pm * 256 * 2048 + 1024 + cc) * 2; d.ld = 2048; d.mode = 2; } } };
struct D4 { static constexpr int MODES = 32; unsigned char* out; const float* x;
    __device__ __forceinline__ void get(const pg8::Unit& u, pg8::Dst& d) const { const size_t o = (size_t)u.pm * 256 * 1024 + u.pn * 256;
        d.base = out + o * 4; d.res = x + o; d.ld = 1024; d.mode = 5; d.ncol = 256; d.scale = 1.f; } };
struct D5 { static constexpr int MODES = 133; unsigned char* ws;
    __device__ __forceinline__ void get(const pg8::Unit& u, pg8::Dst& d) const { const int pn = u.pn; d.res = nullptr; d.ncol = 256; d.scale = 1.f;
        if (pn < 4) { d.base = ws + OFF_TMP + ((size_t)u.pm * 256 * 1024 + pn * 256) * 2; d.ld = 1024; d.mode = 0; }
        else if (pn == 4) { d.base = ws + OFF_CKVN + (size_t)u.pm * 256 * 256 * 2; d.ld = 256; d.mode = 0; }
        else if (pn == 5) { d.base = ws + OFF_QI + (size_t)u.pm * 256 * 256 * 2; d.ld = 256; d.mode = 7; d.scale = 0.125f; }
        else if (pn == 6) { d.base = ws + OFF_KI + (size_t)u.pm * 256 * 64 * 2; d.ld = 64; d.mode = 7; d.ncol = 64; }
        else { d.base = ws + OFF_Z + ((size_t)u.pm * 256 * 1024 + (pn - 7) * 256) * 2; d.ld = 1024; d.mode = 2; } } };
struct DK { static constexpr int MODES = 64; unsigned char* ws;
    __device__ __forceinline__ void get(const pg8::Unit& u, pg8::Dst& d) const {
        d.base = ws + OFF_RK + ((size_t)u.pm * 256 * 16 + u.pn * 4) * 2; d.res = nullptr; d.ld = 16; d.mode = 6; d.ncol = 256; d.scale = 1.f; } };
struct D8 { static constexpr int MODES = 32; unsigned char* out;
    __device__ __forceinline__ void get(const pg8::Unit& u, pg8::Dst& d) const { const size_t o = (size_t)u.pm * 256 * 1024 + u.pn * 256;
        d.base = out + o * 4; d.res = (const float*)out + o; d.ld = 1024; d.mode = 5; d.ncol = 256; d.scale = 1.f; } };
template <class DF>
__device__ __forceinline__ void fast_gemm(unsigned char* lds, const bf16_t* A, int lda, const bf16_t* Bt, int ldb, int N, int K, const DF& df) {
    pg8::Gemm g{A, lda, Bt, ldb, T, N, K}; pg8::StaticOrder S; S.init(T, N, (int)gridDim.x, (int)blockIdx.x);
    pg8::EpiGen<DF> E{df};
    pg8::gemm_phase(( LAS unsigned char*)lds, g, S, E);
}

__device__ __forceinline__ void tconv(const float* __restrict__ src, int ld, int col0, int ncols, int K, bf16_t* __restrict__ dst, float* tile  ) {
    const int nkt = K / 64, ntiles = nkt * (ncols / 64), tid = threadIdx.x;
    for (int id = blockIdx.x; id < ntiles; id += gridDim.x) {
        const int kt = id % nkt, nt = id / nkt;
#pragma unroll
        for (int j = 0; j < 8; ++j) { const int e = tid + 512 * j, kk = e >> 6, nn = e & 63; tile[kk * 65 + nn] = src[(size_t)(kt * 64 + kk) * ld + col0 + nt * 64 + nn]; }
        __syncthreads();
#pragma unroll
        for (int j = 0; j < 8; ++j) { const int e = tid + 512 * j, nn = e >> 6, kk = e & 63; dst[(size_t)(nt * 64 + nn) * K + kt * 64 + kk] = f2bf(tile[kk * 65 + nn]); }
        __syncthreads();
    }
}
template <int NE>
__device__ __forceinline__ void rmsnorm_rows(const float* __restrict__ src, const float* __restrict__ g, bf16_t* __restrict__ dst,
                             const float* __restrict__ Wx, int ldw, int col0, const float* __restrict__ bias, float scale, float* __restrict__ dstx) {
    const int lane = threadIdx.x & 63, wave = threadIdx.x >> 6;
    for (int row = blockIdx.x * 8 + wave; row < T; row += gridDim.x * 8) {
        f32x4 v[4]; float ss = 0.f;
#pragma unroll
        for (int i = 0; i < 4; ++i) { v[i] = *(const f32x4*)(src + (size_t)row * 1024 + i * 256 + lane * 4); ss += v[i][0] * v[i][0] + v[i][1] * v[i][1] + v[i][2] * v[i][2] + v[i][3] * v[i][3]; }
        ss = wave_sum(ss);
        const float rstd = rsqrtf(ss * (1.0f / 1024.0f) + EPS);
        float ex[NE];
#pragma unroll
        for (int e = 0; e < NE; ++e) ex[e] = 0.f;
#pragma unroll
        for (int i = 0; i < 4; ++i) {
            asm volatile("" ::: "memory");
            const f32x4 gg = *(const f32x4*)(g + i * 256 + lane * 4);
            f32x4 y; y[0] = v[i][0] * rstd * gg[0]; y[1] = v[i][1] * rstd * gg[1]; y[2] = v[i][2] * rstd * gg[2]; y[3] = v[i][3] * rstd * gg[3];
            u32x2 w; w.x = pk2(y[0], y[1]); w.y = pk2(y[2], y[3]);
            *(u32x2*)(dst + (size_t)row * 1024 + i * 256 + lane * 4) = w;
#pragma unroll
            for (int j = 0; j < 4; ++j) { const float* wr = Wx + (size_t)(i * 256 + lane * 4 + j) * ldw + col0;
#pragma unroll
                for (int e4 = 0; e4 < NE / 4; ++e4) { const f32x4 wv = *(const f32x4*)(wr + e4 * 4);
                    ex[e4 * 4 + 0] += y[j] * wv[0]; ex[e4 * 4 + 1] += y[j] * wv[1]; ex[e4 * 4 + 2] += y[j] * wv[2]; ex[e4 * 4 + 3] += y[j] * wv[3]; } }
        }
#pragma unroll
        for (int e = 0; e < NE; ++e) { const float s = wave_sum(ex[e]); if (lane == 0) dstx[(size_t)row * NE + e] = (s + (bias ? bias[e] : 0.f)) * scale; }
    }
}

__device__ __forceinline__ void phase_prep(const P& p, unsigned char* lds) {
    float* tile = (float*)lds; unsigned char* ws = p.ws;
    bf16_t* W0T = (bf16_t*)(ws + OFF_W0T);
    tconv(p.e_w_in, EIN, 0, 5120, 1024, W0T, tile);
    tconv(p.e_w_in, EIN, 6152, 1024, 1024, W0T + (size_t)6144 * 1024, tile);
    {
        float* arow = tile;
        for (int it = blockIdx.x; it < 4 * 512; it += gridDim.x) {
            const int g = it >> 9, k0 = (it & 511) * 2; const int tid = threadIdx.x, kk = tid >> 8, d = tid & 255;
            __syncthreads();
            arow[tid] = p.e_w_in[(size_t)(k0 + kk) * EIN + 5128 + g * 256 + d];
            __syncthreads();
            const float* wp = p.e_w_pool + (size_t)g * 65536 + d; const float* ar = arow + kk * 256; float acc = 0.f;
#pragma unroll 8
            for (int c = 0; c < 256; ++c) acc += ar[c] * wp[(size_t)c * 256];
            W0T[(size_t)(5120 + g * 256 + d) * 1024 + k0 + kk] = f2bf(acc);
        }
        __syncthreads();
    }
    tconv(p.e_w_out, 1024, 0, 1024, 2048, (bf16_t*)(ws + OFF_WO0T), tile);
    bf16_t* W1T = (bf16_t*)(ws + OFF_W1T);
    tconv(p.o_w_in, OIN, 0, 1600, 1024, W1T, tile);
    for (size_t i = (size_t)blockIdx.x * 512 + threadIdx.x; i < (size_t)192 * 1024; i += (size_t)gridDim.x * 512) W1T[(size_t)1600 * 1024 + i] = 0;
    tconv(p.o_w_in, OIN, 1604, 1024, 1024, W1T + (size_t)1792 * 1024, tile);
    {
        bf16_t* WUKP = (bf16_t*)(ws + OFF_WUKP); bf16_t* WQP = (bf16_t*)(ws + OFF_WQP);
        for (size_t i = (size_t)blockIdx.x * 512 + threadIdx.x; i < (size_t)1024 * 256; i += (size_t)gridDim.x * 512) {
            { const int n = (int)(i >> 8), k = (int)(i & 255), pn = n >> 8, rem = n & 255, bj = rem >> 7, wc = (rem >> 5) & 3, x = rem & 31;
              WUKP[i] = f2bf(p.o_w_uk[(size_t)k * 1024 + (4 * pn + wc) * 64 + 32 * bj + x]); }
            { const int d = (int)(i & 63), r = (int)((i >> 6) & 255), h = (int)(i >> 14);
              WQP[i] = f2bf(p.o_w_uk[(size_t)r * 1024 + h * 64 + d] * p.o_g_k[d] * 0.125f); }
        }
    }
    tconv(p.o_w_uv, 1024, 0, 1024, 256, (bf16_t*)(ws + OFF_WUVT), tile);
    tconv(p.o_w_out, 1024, 0, 1024, 1024, (bf16_t*)(ws + OFF_WO1T), tile);
    rmsnorm_rows<8>(p.x, p.e_norm, (bf16_t*)(ws + OFF_XN), p.e_w_in, EIN, 5120, p.e_b_if, 1.0f, (float*)(ws + OFF_GATES));
}

__device__ __forceinline__ void phase_conv_scan(const P& p, unsigned char* lds) {
    unsigned char* ws = p.ws; const int tid = threadIdx.x;
    const float* GATES = (const float*)(ws + OFF_GATES);
    float *BQ = (float*)(ws + OFF_BQ), *IQ = (float*)(ws + OFF_IQ), *MT = (float*)(ws + OFF_MT), *CH = (float*)(ws + OFF_CH);
    for (int bh = blockIdx.x; bh < 8; bh += gridDim.x) {
        float* sB = (float*)lds; float* sG = sB + 256; float* sMp = sG + 256; float* sMn = sMp + 256;
        const int batch = bh >> 2, head = bh & 3;
        if (tid < 256) {
            const size_t t0 = (size_t)batch * SEQ + tid * 64; float b = 0.f, rmax = -INFINITY;
            for (int s = 0; s < 64; ++s) { const size_t t = t0 + s; const float ig = GATES[t * 8 + head], f = GATES[t * 8 + 4 + head];
                const float ls = fminf(f, 0.f) - log1pf(__expf(-fabsf(f)));
                b += ls; BQ[t * 4 + head] = b; IQ[t * 4 + head] = ig; rmax = fmaxf(rmax, ig - b); MT[t * 4 + head] = rmax; }
            sB[tid] = b; sG[tid] = b + rmax;
        }
        __syncthreads();
        if (tid == 0) { float m = 0.f; for (int c = 0; c < 256; ++c) { sMp[c] = m; m = fmaxf(sB[c] + m, sG[c]); sMn[c] = m; } }
        __syncthreads();
        if (tid < 256) {
            const float mp = sMp[tid]; CH[bh * 256 + tid] = mp; CH[2048 + bh * 256 + tid] = sMn[tid]; CH[4096 + bh * 256 + tid] = sB[tid];
            const size_t t0 = (size_t)batch * SEQ + tid * 64;
            for (int s = 0; s < 64; ++s) { const size_t t = t0 + s; MT[t * 4 + head] = BQ[t * 4 + head] + fmaxf(mp, MT[t * 4 + head]); }
        }
        __syncthreads();
    }
    const bf16_t* QB = (const bf16_t*)(ws + OFF_QB); const bf16_t* KB = (const bf16_t*)(ws + OFF_KB);
    bf16_t* Y = (bf16_t*)(ws + OFF_Y); bf16_t* KT = (bf16_t*)(ws + OFF_TMP);
    for (size_t it = (size_t)blockIdx.x * 512 + tid; it < (size_t)T * 256; it += (size_t)gridDim.x * 512) {
        const size_t t = it >> 8; const int c0 = (int)(it & 255) * 8, isk = c0 >= 1024, cc = c0 & 1023; const int s = (int)(t & (SEQ - 1));
        const bf16_t* src = isk ? KB : QB;
        float acc[8];
#pragma unroll
        for (int i = 0; i < 8; ++i) acc[i] = 0.f;
#pragma unroll
        for (int j = 0; j < 4; ++j) {
            if (s - 3 + j >= 0) {
                const u32x4 w = *(const u32x4*)(src + (t - 3 + j) * 1024 + cc);
                const f32x4 c0v = *(const f32x4*)(p.e_conv + j * 2048 + c0), c1v = *(const f32x4*)(p.e_conv + j * 2048 + c0 + 4);
                acc[0] += c0v[0] * bflo(w.x); acc[1] += c0v[1] * bfhi(w.x); acc[2] += c0v[2] * bflo(w.y); acc[3] += c0v[3] * bfhi(w.y);
                acc[4] += c1v[0] * bflo(w.z); acc[5] += c1v[1] * bfhi(w.z); acc[6] += c1v[2] * bflo(w.w); acc[7] += c1v[3] * bfhi(w.w);
            }
        }
        const float sc = isk ? 0.0625f : 1.0f;
        u32x4 o; o.x = pk2(siluf_(acc[0]) * sc, siluf_(acc[1]) * sc); o.y = pk2(siluf_(acc[2]) * sc, siluf_(acc[3]) * sc);
        o.z = pk2(siluf_(acc[4]) * sc, siluf_(acc[5]) * sc); o.w = pk2(siluf_(acc[6]) * sc, siluf_(acc[7]) * sc);
        if (isk) *(u32x4*)(KT + t * 1024 + cc) = o; else *(u32x4*)(Y + t * 2048 + 1024 + cc) = o;
    }
}

__device__ __forceinline__ void phase_mlstm_seq(const P& p, unsigned char* lds) {
    unsigned char* ws = p.ws; const int tid = threadIdx.x, lane = tid & 63;
    const bf16_t* Yc = (const bf16_t*)(ws + OFF_Y); bf16_t* Y = (bf16_t*)(ws + OFF_Y);
    const bf16_t* KT = (const bf16_t*)(ws + OFF_TMP); const bf16_t* VB = (const bf16_t*)(ws + OFF_VB);
    const float* Wg = (const float*)(ws + OFF_QB);
    const float *BQ = (const float*)(ws + OFF_BQ), *IQ = (const float*)(ws + OFF_IQ), *MT = (const float*)(ws + OFF_MT), *CH = (const float*)(ws + OFF_CH);
    bf16_t* Qs = (bf16_t*)lds;
    bf16_t* Ks = Qs + 64 * 264;
    float* Ws = (float*)(Ks + 64 * 264);
    float* Vs = Ws + 64 * 65;
    float* Cs = Vs + 64 * 8;
    float* ns = Cs + 8 * 260;
    float* sa = ns + 256;
    float* sden = sa + 64;
    float* ssw = sden + 64;
    for (int wu = blockIdx.x; wu < 256; wu += gridDim.x) {
        const int bh = wu >> 5, vs = wu & 31, batch = bh >> 2, head = bh & 3;
        float c[4] = {0.f, 0.f, 0.f, 0.f}; float nreg = 0.f;
        const int uv = tid >> 6;
        const int ot = tid >> 3, ov = tid & 7;
        for (int ch = 0; ch < 256; ++ch) {
            const size_t t0 = (size_t)batch * SEQ + ch * 64;
            const float mprev = CH[bh * 256 + ch], mnew = CH[2048 + bh * 256 + ch], blast = CH[4096 + bh * 256 + ch];
            const float decay = __expf(blast + mprev - mnew);
            __syncthreads();
#pragma unroll
            for (int j = 0; j < 4; ++j) { const int e = tid + 512 * j, r = e >> 5, cg = e & 31;
                *(u32x4*)(Qs + r * 264 + cg * 8) = *(const u32x4*)(Yc + (t0 + r) * 2048 + 1024 + head * 256 + cg * 8);
                *(u32x4*)(Ks + r * 264 + cg * 8) = *(const u32x4*)(KT + (t0 + r) * 1024 + head * 256 + cg * 8); }
#pragma unroll
            for (int j = 0; j < 8; ++j) { const int e = tid + 512 * j, r = e >> 6, cc = e & 63; Ws[r * 65 + cc] = Wg[((size_t)(bh * 256 + ch)) * 4096 + e]; }
            if (tid < 64) { const u32x4 w = *(const u32x4*)(VB + (t0 + tid) * 1024 + head * 256 + vs * 8);
                float* d = Vs + tid * 8; d[0] = bflo(w.x); d[1] = bfhi(w.x); d[2] = bflo(w.y); d[3] = bfhi(w.y); d[4] = bflo(w.z); d[5] = bfhi(w.z); d[6] = bflo(w.w); d[7] = bfhi(w.w);
                const float bq = BQ[(t0 + tid) * 4 + head], iq = IQ[(t0 + tid) * 4 + head], mt = MT[(t0 + tid) * 4 + head];
                sa[tid] = __expf(bq + mprev - mt); sden[tid] = __expf(-mt); ssw[tid] = __expf(blast - bq + iq - mnew); }
#pragma unroll
            for (int j = 0; j < 4; ++j) Cs[uv * 260 + lane + 64 * j] = c[j];
            if (tid < 256) ns[tid] = nreg;
            __syncthreads();
            {
                float inter = 0.f, ndot = 0.f, intra = 0.f, rsum = 0.f;
                const bf16_t* qr = Qs + ot * 264; const float* cr = Cs + ov * 260;
#pragma unroll 8
                for (int k = 0; k < 256; ++k) inter += cr[k] * bf2f(qr[k]);
#pragma unroll 8
                for (int k = 0; k < 32; ++k) ndot += ns[ov * 32 + k] * bf2f(qr[ov * 32 + k]);
                ndot += __shfl_xor(ndot, 1); ndot += __shfl_xor(ndot, 2); ndot += __shfl_xor(ndot, 4);
#pragma unroll 8
                for (int s = 0; s < 64; ++s) { const float w = Ws[ot * 65 + s]; intra += w * Vs[s * 8 + ov]; rsum += w; }
                const float a = sa[ot]; const float nq = a * ndot + rsum; const float den = fmaxf(fabsf(nq), sden[ot]);
                const float h = (a * inter + intra) / den;
                Y[(t0 + ot) * 2048 + head * 256 + vs * 8 + ov] = f2bf(h);
            }
            {
                float acc[4] = {0.f, 0.f, 0.f, 0.f}; float nacc = 0.f;
                for (int s = 0; s < 64; ++s) { const float sv = ssw[s] * Vs[s * 8 + uv]; const bf16_t* kr = Ks + s * 264 + lane;
#pragma unroll
                    for (int j = 0; j < 4; ++j) acc[j] += sv * bf2f(kr[64 * j]); }
#pragma unroll
                for (int j = 0; j < 4; ++j) c[j] = decay * c[j] + acc[j];
                if (tid < 256) { for (int s = 0; s < 64; ++s) nacc += ssw[s] * bf2f(Ks[s * 264 + tid]); nreg = decay * nreg + nacc; }
            }
        }
        __syncthreads();
    }
}

__device__ __forceinline__ void phase_ya_pool(const P& p) {
    unsigned char* ws = p.ws; const int tid = threadIdx.x, lane = tid & 63, wave = tid >> 6;
    bf16_t* Y = (bf16_t*)(ws + OFF_Y); const bf16_t* O = (const bf16_t*)(ws + OFF_QB); const bf16_t* ZA = (const bf16_t*)(ws + OFF_KB);
    for (int it = blockIdx.x * 8 + wave; it < T * 4; it += gridDim.x * 8) {
        const size_t t = (size_t)(it >> 2); const int head = it & 3, c = head * 256 + lane * 4;
        const u32x2 hw = *(const u32x2*)(Y + t * 2048 + c), ow = *(const u32x2*)(O + t * 1024 + c), zw = *(const u32x2*)(ZA + t * 1024 + c);
        float v[4] = {bflo(hw.x) * bflo(ow.x), bfhi(hw.x) * bfhi(ow.x), bflo(hw.y) * bflo(ow.y), bfhi(hw.y) * bfhi(ow.y)};
        float ss = wave_sum(v[0] * v[0] + v[1] * v[1] + v[2] * v[2] + v[3] * v[3]);
        const float rstd = rsqrtf(ss * (1.0f / 256.0f) + EPS);
        const f32x4 g = *(const f32x4*)(p.e_g_head + c);
        u32x2 o; o.x = pk2(v[0] * rstd * g[0] * bflo(zw.x), v[1] * rstd * g[1] * bfhi(zw.x)); o.y = pk2(v[2] * rstd * g[2] * bflo(zw.y), v[3] * rstd * g[3] * bfhi(zw.y));
        *(u32x2*)(Y + t * 2048 + c) = o;
    }
    const bf16_t* U = (const bf16_t*)(ws + OFF_VB);
    for (size_t it = (size_t)blockIdx.x * 512 + tid; it < (size_t)T * 128; it += (size_t)gridDim.x * 512) {
        const size_t t = it >> 7; const int c0 = (int)(it & 127) * 8, g = c0 >> 8, win = 2 << g, s = (int)(t & (SEQ - 1)); const int cnt = (s + 1 < win) ? s + 1 : win;
        float acc[8], self[8];
#pragma unroll
        for (int i = 0; i < 8; ++i) { acc[i] = 0.f; self[i] = 0.f; }
        for (int j = 0; j < cnt; ++j) { const u32x4 w = *(const u32x4*)(U + (t - j) * 1024 + c0);
            const float f[8] = {bflo(w.x), bfhi(w.x), bflo(w.y), bfhi(w.y), bflo(w.z), bfhi(w.z), bflo(w.w), bfhi(w.w)};
#pragma unroll
            for (int i = 0; i < 8; ++i) { acc[i] += f[i]; if (j == 0) self[i] = f[i]; } }
        const float inv = 1.0f / (float)cnt;
        bf16_t* yp = Y + t * 2048 + 1024 + c0; const u32x4 z = *(const u32x4*)yp;
        const float zf[8] = {bflo(z.x), bfhi(z.x), bflo(z.y), bfhi(z.y), bflo(z.z), bfhi(z.z), bflo(z.w), bfhi(z.w)};
        const f32x4 s0 = *(const f32x4*)(p.e_s_pool + c0), s1 = *(const f32x4*)(p.e_s_pool + c0 + 4);
        float o[8];
#pragma unroll
        for (int i = 0; i < 8; ++i) o[i] = (acc[i] * inv - self[i]) * (i < 4 ? s0[i] : s1[i - 4]) * zf[i];
        u32x4 ow; ow.x = pk2(o[0], o[1]); ow.y = pk2(o[2], o[3]); ow.z = pk2(o[4], o[5]); ow.w = pk2(o[6], o[7]);
        *(u32x4*)yp = ow;
    }
}

__device__ __forceinline__ void headnorm64(bf16_t* X, const float* g) {
    const int lane = threadIdx.x & 63, wave = threadIdx.x >> 6;
    for (int t = blockIdx.x * 8 + wave; t < T; t += gridDim.x * 8) {
        bf16_t* r = X + (size_t)t * 1024 + lane * 16;
        const u32x4 a = *(const u32x4*)r, b = *(const u32x4*)(r + 8);
        float f[16] = {bflo(a.x), bfhi(a.x), bflo(a.y), bfhi(a.y), bflo(a.z), bfhi(a.z), bflo(a.w), bfhi(a.w), bflo(b.x), bfhi(b.x), bflo(b.y), bfhi(b.y), bflo(b.z), bfhi(b.z), bflo(b.w), bfhi(b.w)};
        float ss = 0.f;
#pragma unroll
        for (int i = 0; i < 16; ++i) ss += f[i] * f[i];
        ss += __shfl_xor(ss, 1); ss += __shfl_xor(ss, 2);
        const float rstd = rsqrtf(ss * (1.0f / 64.0f) + EPS);
        const float* gg = g + (lane & 3) * 16;
#pragma unroll
        for (int i = 0; i < 16; ++i) f[i] = f[i] * rstd * gg[i];
        u32x4 oa, ob; oa.x = pk2(f[0], f[1]); oa.y = pk2(f[2], f[3]); oa.z = pk2(f[4], f[5]); oa.w = pk2(f[6], f[7]);
        ob.x = pk2(f[8], f[9]); ob.y = pk2(f[10], f[11]); ob.z = pk2(f[12], f[13]); ob.w = pk2(f[14], f[15]);
        *(u32x4*)r = oa; *(u32x4*)(r + 8) = ob;
    }
}
__device__ __forceinline__ void phase_qnorm_ckvnorm(const P& p) {
    unsigned char* ws = p.ws; const int lane = threadIdx.x & 63, wave = threadIdx.x >> 6;
    headnorm64((bf16_t*)(ws + OFF_TMP), p.o_g_q);
    bf16_t* CKVN = (bf16_t*)(ws + OFF_CKVN);
    for (int t = blockIdx.x * 8 + wave; t < T; t += gridDim.x * 8) {
        const u32x2 w = *(const u32x2*)(CKVN + (size_t)t * 256 + lane * 4);
        const float v[4] = {bflo(w.x), bfhi(w.x), bflo(w.y), bfhi(w.y)};
        const float ss = wave_sum(v[0] * v[0] + v[1] * v[1] + v[2] * v[2] + v[3] * v[3]);
        const float rstd = rsqrtf(ss * (1.0f / 256.0f) + EPS);
        const f32x4 g = *(const f32x4*)(p.o_g_kv + lane * 4);
        u32x2 o; o.x = pk2(v[0] * rstd * g[0], v[1] * rstd * g[1]); o.y = pk2(v[2] * rstd * g[2], v[3] * rstd * g[3]);
        *(u32x2*)(CKVN + (size_t)t * 256 + lane * 4) = o;
    }
}

__device__ __forceinline__ unsigned okey(float s) { if (s == 0.f) s = 0.f; const unsigned u = __float_as_uint(s); return (u & 0x80000000u) ? ~u : (u | 0x80000000u); }

__device__ __forceinline__ void indexer_slow_query(const P& p, unsigned char* lds, size_t t) {
    unsigned char* ws = p.ws; const int tid = threadIdx.x, lane = tid & 63, wave = tid >> 6;
    const _Float16* QI = (const _Float16*)(ws + OFF_QI); const _Float16* KI = (const _Float16*)(ws + OFF_KI); const float* WI = (const float*)(ws + OFF_WI);
    unsigned short* IDX = (unsigned short*)(ws + OFF_IDX);
    unsigned* sc = (unsigned*)lds; unsigned* hist = sc + 16384; float* qs = (float*)(hist + 256); unsigned* misc = (unsigned*)(qs + 256); unsigned* wsum = misc + 16;
    const int batch = (int)(t >> 14), pos = (int)(t & (SEQ - 1)), n = pos + 1;
    __syncthreads();
    if (tid < 256) qs[tid] = (float)QI[t * 256 + tid];
    const float w0 = WI[t * 4 + 0], w1 = WI[t * 4 + 1], w2 = WI[t * 4 + 2], w3 = WI[t * 4 + 3];
    __syncthreads();
    const _Float16* kbase = KI + (size_t)batch * SEQ * 64;
    for (int s = tid; s < n; s += 512) {
        asm volatile("" ::: "memory");
        typedef _Float16 h8 __attribute__((ext_vector_type(8)));
        const h8* kr = (const h8*)(kbase + (size_t)s * 64);
        float d0 = 0.f, d1 = 0.f, d2 = 0.f, d3 = 0.f;
#pragma unroll
        for (int j = 0; j < 8; ++j) { const h8 kv = kr[j];
#pragma unroll
            for (int e = 0; e < 8; ++e) { const int d = j * 8 + e; const float kf = (float)kv[e]; d0 += qs[d] * kf; d1 += qs[64 + d] * kf; d2 += qs[128 + d] * kf; d3 += qs[192 + d] * kf; } }
        float score = w0 * fmaxf(d0, 0.f); score = fmaf(w1, fmaxf(d1, 0.f), score); score = fmaf(w2, fmaxf(d2, 0.f), score); score = fmaf(w3, fmaxf(d3, 0.f), score);
        if (fabsf(score) < 1e-30f) score = 0.f;
        sc[s] = okey(score);
    }
    unsigned prefix = 0, krem = 256;
    for (int pass = 0; pass < 4; ++pass) {
        const int shift = 24 - 8 * pass;
        __syncthreads();
        if (tid < 256) hist[tid] = 0;
        __syncthreads();
        for (int s = tid; s < n; s += 512) { const unsigned k = sc[s]; if (pass == 0 || (k >> (shift + 8)) == prefix) atomicAdd(&hist[(k >> shift) & 255u], 1u); }
        __syncthreads();
        if (tid == 0) { unsigned cum = 0; int bin = 255; for (; bin > 0; --bin) { const unsigned c = hist[bin]; if (cum + c >= krem) break; cum += c; } misc[0] = (unsigned)bin; misc[1] = krem - cum; }
        __syncthreads();
        prefix = (prefix << 8) | misc[0]; krem = misc[1];
    }
    const unsigned ngt_total = 256u - krem;
    unsigned lg = 0, le = 0; const int s0 = tid * 32;
    for (int s = s0; s < s0 + 32 && s < n; ++s) { const unsigned k = sc[s]; lg += (k > prefix); le += (k == prefix); }
    unsigned pk = lg | (le << 16), incl = pk;
#pragma unroll
    for (int o = 1; o < 64; o <<= 1) { const unsigned y = __shfl_up(incl, o); if (lane >= o) incl += y; }
    if (lane == 63) wsum[wave] = incl;
    __syncthreads();
    unsigned base = 0;
    for (int w = 0; w < wave; ++w) base += wsum[w];
    const unsigned excl = base + incl - pk; unsigned bg = excl & 0xffffu, be = excl >> 16;
    for (int s = s0; s < s0 + 32 && s < n; ++s) { const unsigned k = sc[s];
        if (k > prefix) { IDX[t * 256 + bg] = (unsigned short)s; ++bg; }
        else if (k == prefix) { if (be < krem) IDX[t * 256 + ngt_total + be] = (unsigned short)s; ++be; } }
    __syncthreads();
}

typedef _Float16 half8 __attribute__((ext_vector_type(8)));
constexpr int IX_CAP = 1024, IX_ZBIN = 1024;
__device__ __forceinline__ unsigned ix_key(const f32x4 a, const f32x4 w) {
    float s = w[0] * fmaxf(a[0], 0.f); s = fmaf(w[1], fmaxf(a[1], 0.f), s); s = fmaf(w[2], fmaxf(a[2], 0.f), s); s = fmaf(w[3], fmaxf(a[3], 0.f), s);
    if (fabsf(s) < 1e-30f) s = 0.f;
    return okey(s);
}
#define LDS_ADD(ptr, v) __hip_atomic_fetch_add((ptr), (v), __ATOMIC_RELAXED, __HIP_MEMORY_SCOPE_WORKGROUP)
__device__ __forceinline__ void phase_indexer(const P& p, unsigned char* lds) {
    unsigned char* ws = p.ws; const int tid = threadIdx.x, lane = tid & 63, kl = lane & 15, g = lane >> 4;
    const int wave = __builtin_amdgcn_readfirstlane(tid >> 6);
    const _Float16* QI = (const _Float16*)(ws + OFF_QI); const _Float16* KI = (const _Float16*)(ws + OFF_KI); const float* WI = (const float*)(ws + OFF_WI);
    unsigned short* IDX = (unsigned short*)(ws + OFF_IDX); int* CNT = (int*)(ws + OFF_CNT);
    LAS unsigned* hist = (LAS unsigned*)lds;
    LAS unsigned* zc = hist + 16 * 2048;
    LAS unsigned* zpre = zc + 128;
    LAS int* qTbin = (LAS int*)(zpre + 128);
    LAS int* qCab = qTbin + 16; LAS int* qCb = qCab + 16; LAS unsigned* qNgt = (LAS unsigned*)(qCb + 16); LAS unsigned* qNcand = qNgt + 16; LAS int* qOvf = (LAS int*)(qNcand + 16);
    LAS unsigned* ovl = (LAS unsigned*)(lds + 136 * 1024);
    if (tid == 0) ovl[0] = 0u;
    const int G = gridDim.x, nround = (T / 16) / G;
#pragma unroll 1
    for (int i = 0; i < nround; ++i) {
        const int tix = (i & 1) ? i * G + (G - 1 - (int)blockIdx.x) : i * G + (int)blockIdx.x;
        const int batch = tix & 1, tb = tix >> 1, p0 = tb * 16; const size_t t0 = (size_t)batch * SEQ + p0;
        __syncthreads();
        if (p0 + 16 <= 256) {
#pragma unroll
            for (int j = 0; j < 8; ++j) { const int e = tid + 512 * j, q = e >> 8, jj = e & 255; IDX[(t0 + q) * 256 + jj] = (unsigned short)(jj <= p0 + q ? jj : 0); }
            if (tid < 16) CNT[t0 + tid] = p0 + tid + 1;
            continue;
        }
#pragma unroll
        for (int j = 0; j < 16; ++j) ((LAS u32x4*)hist)[tid + 512 * j] = (u32x4){0u, 0u, 0u, 0u};
        if (tid < 256) zc[tid] = 0u;
        if (tid < 16) { qNgt[tid] = 0u; qNcand[tid] = 0u; qOvf[tid] = 0; }
        half8 af[4][2]; f32x4 wv[4];
#pragma unroll
        for (int rt = 0; rt < 4; ++rt) {
#pragma unroll
            for (int ks = 0; ks < 2; ++ks) af[rt][ks] = *(const half8*)(QI + (t0 + 4 * rt + (kl >> 2)) * 256 + (kl & 3) * 64 + 32 * ks + 8 * g);
            wv[rt] = *(const f32x4*)(WI + (t0 + 4 * rt + g) * 4);
        }
        __syncthreads();
        const int nblk = tb + 1, L = (nblk + 7) >> 3, b0 = wave * L, b1 = (b0 + L < nblk) ? b0 + L : nblk;
        const _Float16* kb = KI + (size_t)batch * SEQ * 64 + kl * 64 + 8 * g;
#pragma unroll 1
        for (int b = b0; b < b1; ++b) {
            const int s = b * 16 + kl;
            const half8 k0 = *(const half8*)(kb + (size_t)b * 1024), k1 = *(const half8*)(kb + (size_t)b * 1024 + 32);
#pragma unroll
            for (int rt = 0; rt < 4; ++rt) {
                f32x4 acc = __builtin_amdgcn_mfma_f32_16x16x32_f16(af[rt][0], k0, (f32x4){0.f, 0.f, 0.f, 0.f}, 0, 0, 0);
                acc = __builtin_amdgcn_mfma_f32_16x16x32_f16(af[rt][1], k1, acc, 0, 0, 0);
                const unsigned key = ix_key(acc, wv[rt]); const int q = 4 * rt + g;
                if (s <= p0 + q) { LDS_ADD(hist + q * 2048 + (key >> 21), 1u); if (key == 0x80000000u) LDS_ADD(zc + q * 8 + wave, 1u); }
            }
        }
        __syncthreads();
#pragma unroll 1
        for (int qq = 0; qq < 2; ++qq) {
            const int q = 2 * wave + qq; const LAS unsigned* h = hist + q * 2048;
            unsigned cs = 0; const int top = 2047 - 32 * lane;
            for (int ii = 0; ii < 32; ++ii) cs += h[top - ((ii + lane) & 31)];
            unsigned incl = cs;
#pragma unroll
            for (int o = 1; o < 64; o <<= 1) { const unsigned y = __shfl_up(incl, o); if (lane >= o) incl += y; }
            const unsigned long long m = __ballot(incl >= 256u);
            const int Ls = m ? (__ffsll((long long)m) - 1) : 63;
            unsigned cabv = __shfl(incl - cs, Ls), cbv = 0; int tbin = 0; bool found = false;
            for (int ii = 0; ii < 32; ++ii) { const unsigned c = h[2047 - 32 * Ls - ii]; if (!found && cabv + c >= 256u) { tbin = 2047 - 32 * Ls - ii; cbv = c; found = true; } if (!found) cabv += c; }
            if (lane == 0) { qTbin[q] = tbin; qCab[q] = (int)cabv; qCb[q] = (int)cbv; if (tbin != IX_ZBIN && cbv > (unsigned)IX_CAP) qOvf[q] = 1; }
            { unsigned v = lane < 8 ? zc[q * 8 + lane] : 0u, inc = v;
#pragma unroll
              for (int o = 1; o < 8; o <<= 1) { const unsigned y = __shfl_up(inc, o); if (lane >= o) inc += y; }
              if (lane < 8) zpre[q * 8 + lane] = inc - v; }
        }
        __syncthreads();
        int tbn[4], cab[4], rr[4]; unsigned zrun[4];
#pragma unroll
        for (int rt = 0; rt < 4; ++rt) { const int q = 4 * rt + g; tbn[rt] = qOvf[q] ? 4096 : qTbin[q]; cab[rt] = qCab[q]; rr[rt] = 256 - cab[rt]; zrun[rt] = zpre[q * 8 + wave]; }
#pragma unroll 1
        for (int b = b0; b < b1; ++b) {
            const int s = b * 16 + kl;
            const half8 k0 = *(const half8*)(kb + (size_t)b * 1024), k1 = *(const half8*)(kb + (size_t)b * 1024 + 32);
#pragma unroll
            for (int rt = 0; rt < 4; ++rt) {
                f32x4 acc = __builtin_amdgcn_mfma_f32_16x16x32_f16(af[rt][0], k0, (f32x4){0.f, 0.f, 0.f, 0.f}, 0, 0, 0);
                acc = __builtin_amdgcn_mfma_f32_16x16x32_f16(af[rt][1], k1, acc, 0, 0, 0);
                const unsigned key = ix_key(acc, wv[rt]); const int q = 4 * rt + g; const int bin = (int)(key >> 21);
                const bool valid = s <= p0 + q;
                const bool inb = valid && bin == tbn[rt];
                const bool zt = inb && tbn[rt] == IX_ZBIN;
                const unsigned long long zm = __ballot(zt);
                const unsigned gm = (unsigned)(zm >> (16 * g)) & 0xffffu;
                unsigned short* irow = IDX + (t0 + q) * 256;
                if (valid && bin > tbn[rt]) { const unsigned pos = LDS_ADD(qNgt + q, 1u); irow[pos] = (unsigned short)s; }
                else if (zt) { const unsigned pos = zrun[rt] + __popc(gm & ((1u << kl) - 1u)); if ((int)pos < rr[rt]) irow[cab[rt] + pos] = (unsigned short)s; }
                else if (inb) { const unsigned pos = LDS_ADD(qNcand + q, 1u);
                    if (pos < (unsigned)IX_CAP) { ((LAS unsigned*)(lds + q * 8192))[pos] = key; ((LAS unsigned short*)(lds + q * 8192 + 4096))[pos] = (unsigned short)s; } }
                zrun[rt] += __popc(gm);
            }
        }
        __syncthreads();
#pragma unroll 1
        for (int qq = 0; qq < 2; ++qq) {
            const int q = 2 * wave + qq; const int tbin = qTbin[q], n = qCb[q], cabq = qCab[q], r = 256 - cabq;
            if (tbin == IX_ZBIN || qOvf[q]) continue;
            const LAS unsigned* ck = (const LAS unsigned*)(lds + q * 8192); const LAS unsigned short* ci = (const LAS unsigned short*)(lds + q * 8192 + 4096);
            unsigned short* irow = IDX + (t0 + q) * 256;
            if (r >= n) { for (int c = lane; c < n; c += 64) irow[cabq + c] = ci[c]; }
            else {
                for (int c0 = 0; c0 < n; c0 += 64) {
                    const int c = c0 + lane; const bool have = c < n;
                    const unsigned long long mine = have ? (((unsigned long long)ck[c] << 16) | (unsigned long long)(0xffffu - ci[c])) : ~0ull;
                    int rank = 0;
                    for (int j = 0; j < n; ++j) { const unsigned long long cj = ((unsigned long long)ck[j] << 16) | (unsigned long long)(0xffffu - ci[j]); rank += (cj > mine) ? 1 : 0; }
                    if (have && rank < r) irow[cabq + rank] = ci[c];
                }
            }
        }
        if (tid < 16) CNT[t0 + tid] = 256;
        if (tid < 16 && qOvf[tid]) { const unsigned k = LDS_ADD(ovl, 1u); ovl[1 + k] = (unsigned)(t0 + tid); }
    }
    __syncthreads();
    const unsigned novl = __builtin_amdgcn_readfirstlane(ovl[0]);
#pragma unroll 1
    for (unsigned k = 0; k < novl; ++k) { const unsigned tq = __builtin_amdgcn_readfirstlane(ovl[1 + k]); indexer_slow_query(p, lds, (size_t)tq); }
}
#undef LDS_ADD

typedef short v4i16_t __attribute__((ext_vector_type(4)));
__device__ __forceinline__ void phase_attn(const P& p, unsigned char* lds) {
    unsigned char* ws = p.ws; const int tid = threadIdx.x, lane = tid & 63, hd = lane & 15, g = lane >> 4;
    const int wave = __builtin_amdgcn_readfirstlane(tid >> 6);
    bf16_t* QP = (bf16_t*)(ws + OFF_QP); const bf16_t* CK = (const bf16_t*)(ws + OFF_CKVN); const bf16_t* RK = (const bf16_t*)(ws + OFF_RK);
    const unsigned short* IDX = (const unsigned short*)(ws + OFF_IDX); const int* CNT = (const int*)(ws + OFF_CNT);
    float* biasT = (float*)lds;
    biasT[tid] = p.rel_bias[tid];
    __syncthreads();
    LAS unsigned char* rows = (LAS unsigned char*)(lds + 2048 + (size_t)wave * 18432);
    LAS bf16_t* rkb = (LAS bf16_t*)(rows + 16384);
    LAS unsigned* info = (LAS unsigned*)(rows + 17408);
    const LAS float* biasL = (const LAS float*)lds;
    for (int t = blockIdx.x * 8 + wave; t < T; t += gridDim.x * 8) {
        const int batch = t >> 14, pos = t & (SEQ - 1); const int cnt = CNT[t];
        const size_t rb = (size_t)batch * SEQ;
        asm volatile("s_waitcnt lgkmcnt(0)" ::: "memory");
#pragma unroll
        for (int jj = 0; jj < 4; ++jj) {
            const int j = lane + 64 * jj; int id = IDX[(size_t)t * 256 + j]; if (j >= cnt) id = 0;
            const int rel = pos - id; int bucket = rel < 0 ? 0 : rel;
            if (rel >= 16) { bucket = 16 + (int)(__logf((float)rel * 0.0625f) / 2.0794415416798357f * 16.0f); bucket = bucket > 31 ? 31 : bucket; }
            info[j] = (unsigned)id | ((unsigned)bucket << 16);
        }
        bf16x8 qf[8];
#pragma unroll
        for (int ks = 0; ks < 8; ++ks) qf[ks] = *(const bf16x8*)(QP + (size_t)t * 4096 + hd * 256 + ks * 32 + g * 8);
        f32x4 o[16];
#pragma unroll
        for (int rt = 0; rt < 16; ++rt) o[rt] = (f32x4){0.f, 0.f, 0.f, 0.f};
        float mrun = -1e30f, lrun = 0.f;
        asm volatile("s_waitcnt lgkmcnt(0)" ::: "memory");
        const int nch = (cnt + 31) >> 5;
        for (int ch = 0; ch < nch; ++ch) {
            asm volatile("s_waitcnt lgkmcnt(0)" ::: "memory");
#pragma unroll
            for (int i = 0; i < 16; ++i) {
                const int ksl = 2 * i + (lane >> 5); const unsigned idv = info[ch * 32 + ksl] & 0xffffu;
                const bf16_t* src = CK + (rb + idv) * 256 + (((lane & 31) ^ (ksl & 15)) * 8);
                __builtin_amdgcn_global_load_lds((const unsigned*)src, (LAS unsigned*)(rows + i * 1024), 16, 0, 0);
            }
            { const unsigned idv = info[ch * 32 + (lane >> 1)] & 0xffffu;
              __builtin_amdgcn_global_load_lds((const unsigned*)(RK + (rb + idv) * 16 + (lane & 1) * 8), (LAS unsigned*)rkb, 16, 0, 0); }
            asm volatile("s_waitcnt vmcnt(0)" ::: "memory");
            f32x4 s0 = (f32x4){0.f, 0.f, 0.f, 0.f}, s1 = (f32x4){0.f, 0.f, 0.f, 0.f};
#pragma unroll
            for (int ks = 0; ks < 8; ++ks) {
                const int pos16 = ((4 * ks + g) ^ hd) * 16;
                const bf16x8 a0 = *(const LAS bf16x8*)(rows + hd * 512 + pos16);
                const bf16x8 a1 = *(const LAS bf16x8*)(rows + (16 + hd) * 512 + pos16);
                s0 = __builtin_amdgcn_mfma_f32_16x16x32_bf16(a0, qf[ks], s0, 0, 0, 0);
                s1 = __builtin_amdgcn_mfma_f32_16x16x32_bf16(a1, qf[ks], s1, 0, 0, 0);
            }
            float x0[4], x1[4]; float cm = -INFINITY;
#pragma unroll
            for (int r = 0; r < 4; ++r) {
                const int sl0 = 4 * g + r, sl1 = 16 + 4 * g + r, j0 = ch * 32 + sl0, j1 = ch * 32 + sl1;
                const unsigned i0 = info[j0], i1 = info[j1];
                const float r0 = bf2f(rkb[sl0 * 16 + hd]), r1 = bf2f(rkb[sl1 * 16 + hd]);
                x0[r] = (j0 < cnt) ? s0[r] * r0 + biasL[(i0 >> 16) * 16 + hd] : -INFINITY;
                x1[r] = (j1 < cnt) ? s1[r] * r1 + biasL[(i1 >> 16) * 16 + hd] : -INFINITY;
                cm = fmaxf(cm, fmaxf(x0[r], x1[r]));
            }
            cm = fmaxf(cm, __shfl_xor(cm, 16)); cm = fmaxf(cm, __shfl_xor(cm, 32));
            const float mnew = fmaxf(mrun, cm); const float sc = __expf(mrun - mnew); mrun = mnew;
            float ls = 0.f;
#pragma unroll
            for (int r = 0; r < 4; ++r) { x0[r] = __expf(x0[r] - mnew); x1[r] = __expf(x1[r] - mnew); ls += x0[r] + x1[r]; }
            lrun = lrun * sc + ls;
#pragma unroll
            for (int rt = 0; rt < 16; ++rt) o[rt] *= sc;
            u32x4 pw; pw.x = pg8::cvt_pk_bf16(x0[0], x0[1]); pw.y = pg8::cvt_pk_bf16(x0[2], x0[3]); pw.z = pg8::cvt_pk_bf16(x1[0], x1[1]); pw.w = pg8::cvt_pk_bf16(x1[2], x1[3]);
            const bf16x8 pf = __builtin_bit_cast(bf16x8, pw);
            const int q = hd >> 2, pp = hd & 3, ksl = 4 * g + q;
            const LAS unsigned char* trb = rows + ksl * 512 + (pp & 1) * 8;
#pragma unroll
            for (int rt = 0; rt < 16; ++rt) {
                const int c16 = ((2 * rt + (pp >> 1)) ^ ksl) * 16;
                const v4i16_t t0 = __builtin_amdgcn_ds_read_tr16_b64_v4i16((LAS v4i16_t*)(trb + c16));
                const v4i16_t t1 = __builtin_amdgcn_ds_read_tr16_b64_v4i16((LAS v4i16_t*)(trb + c16 + 8192));
                bf16x8 af; af[0] = t0[0]; af[1] = t0[1]; af[2] = t0[2]; af[3] = t0[3]; af[4] = t1[0]; af[5] = t1[1]; af[6] = t1[2]; af[7] = t1[3];
                o[rt] = __builtin_amdgcn_mfma_f32_16x16x32_bf16(af, pf, o[rt], 0, 0, 0);
            }
        }
        float ltot = lrun; ltot += __shfl_xor(ltot, 16); ltot += __shfl_xor(ltot, 32);
        const float inv = 1.0f / ltot;
        bf16_t* op = QP + (size_t)t * 4096 + hd * 256 + 4 * g;
#pragma unroll
        for (int rt = 0; rt < 16; ++rt) { u32x2 w; w.x = pg8::cvt_pk_bf16(o[rt][0] * inv, o[rt][1] * inv); w.y = pg8::cvt_pk_bf16(o[rt][2] * inv, o[rt][3] * inv); *(u32x2*)(op + rt * 16) = w; }
    }
}

__global__ void __launch_bounds__(512, 2) k_fwd(P p_arg, int ph_lo, int ph_hi) {
    extern __shared__ __attribute__((aligned(16))) unsigned char smem[];
    const P& p = *(const P*)__builtin_amdgcn_kernarg_segment_ptr(); (void)p_arg;
    unsigned char* lds = smem + 16;
    unsigned char* ws = p.ws;
    XcdBarrier bar;
    const bool multi = (ph_hi - ph_lo) > 1;
    if (multi) {
        if (threadIdx.x == 0) *(uint4*)smem = make_uint4(0u, 0u, 0u, 0u);
        __syncthreads();
        bar = xcd_barrier_post((unsigned*)(ws + OFF_CTL), (volatile LAS unsigned*)smem);
    }
#define PH(i) (ph_lo <= (i) && (i) < ph_hi)
#define SEAM(i) do { if ((i) + 1 < ph_hi) xcd_barrier(bar); else __syncthreads(); } while (0)
    bf16_t *XN = (bf16_t*)(ws + OFF_XN), *QB = (bf16_t*)(ws + OFF_QB), *KB = (bf16_t*)(ws + OFF_KB), *VB = (bf16_t*)(ws + OFF_VB), *TMP = (bf16_t*)(ws + OFF_TMP), *Y = (bf16_t*)(ws + OFF_Y);
    if (PH(0)) { phase_prep(p, lds); SEAM(0); }
    if (PH(1)) { fast_gemm(lds, XN, 1024, (const bf16_t*)(ws + OFF_W0T), 1024, 3072, 1024, D1{ws}); SEAM(1); }
    if (PH(2)) { phase_conv_scan(p, lds); SEAM(2); }
    if (PH(3)) { GM1 f{Y, TMP, (const float*)(ws + OFF_BQ), (const float*)(ws + OFF_IQ), (const float*)(ws + OFF_MT), (float*)(ws + OFF_QB)}; sgemm(f, 2048); SEAM(3); }
    if (PH(4)) { phase_mlstm_seq(p, lds); SEAM(4); }
    if (PH(5)) { fast_gemm(lds, XN, 1024, (const bf16_t*)(ws + OFF_W0T) + (size_t)3072 * 1024, 1024, 4096, 1024, D2{ws}); SEAM(5); }
    if (PH(6)) { phase_ya_pool(p); SEAM(6); }
    if (PH(7)) { fast_gemm(lds, Y, 2048, (const bf16_t*)(ws + OFF_WO0T), 2048, 1024, 2048, D4{(unsigned char*)p.out, p.x}); SEAM(7); }
    if (PH(8)) { rmsnorm_rows<4>(p.out, p.o_norm, XN, p.o_w_in, OIN, 1600, nullptr, 0.5f, (float*)(ws + OFF_WI)); SEAM(8); }
    if (PH(9)) { fast_gemm(lds, XN, 1024, (const bf16_t*)(ws + OFF_W1T), 1024, 2816, 1024, D5{ws}); SEAM(9); }
    if (PH(10)) { phase_qnorm_ckvnorm(p); SEAM(10); }
    if (PH(11)) { fast_gemm(lds, (const bf16_t*)(ws + OFF_CKVN), 256, (const bf16_t*)(ws + OFF_WUKP), 256, 1024, 256, DK{ws}); SEAM(11); }
    if (PH(12)) { GQP f{TMP, (const bf16_t*)(ws + OFF_WQP), (bf16_t*)(ws + OFF_QP)}; sgemm(f, 512 * 64); phase_indexer(p, lds); SEAM(12); }
    if (PH(13)) { phase_attn(p, lds); SEAM(13); }
    if (PH(14)) { GOP f{(const bf16_t*)(ws + OFF_QP), (const bf16_t*)(ws + OFF_WUVT), (const bf16_t*)(ws + OFF_Z), TMP}; sgemm(f, 512 * 16); SEAM(14); }
    if (PH(15)) { fast_gemm(lds, TMP, 1024, (const bf16_t*)(ws + OFF_WO1T), 1024, 1024, 1024, D8{(unsigned char*)p.out}); }
#undef PH
#undef SEAM
}

extern "C" void kernel_launch(void* const* d_in, const int* in_sizes, int n_in, void* d_out, int out_size, void* d_ws, size_t ws_size, hipStream_t stream) {
    static int grid = 0;
    if (grid == 0) {
        if (n_in != 18 || out_size != T * DM || ws_size < WS_END) { fprintf(stderr, "kernel_launch: unexpected shapes (n_in %d out %d ws %zu)\n", n_in, out_size, ws_size); grid = -1; return; }
        if (hipFuncSetAttribute((const void*)k_fwd, hipFuncAttributeMaxDynamicSharedMemorySize, LDS_BYTES) != hipSuccess) { fprintf(stderr, "kernel_launch: hipFuncSetAttribute failed\n"); grid = -1; return; }
        grid = 256;
    }
    if (grid < 0) return;
    (void)hipMemsetAsync((char*)d_ws + OFF_CTL, 0, 16384, stream);
    P p{};
    p.x = (const float*)d_in[0]; p.e_norm = (const float*)d_in[1]; p.e_w_in = (const float*)d_in[2]; p.e_conv = (const float*)d_in[3]; p.e_b_if = (const float*)d_in[4];
    p.e_g_head = (const float*)d_in[5]; p.e_w_pool = (const float*)d_in[6]; p.e_s_pool = (const float*)d_in[7]; p.e_w_out = (const float*)d_in[8];
    p.o_norm = (const float*)d_in[9]; p.o_w_in = (const float*)d_in[10]; p.o_g_kv = (const float*)d_in[11]; p.o_w_uk = (const float*)d_in[12]; p.o_w_uv = (const float*)d_in[13];
    p.o_g_q = (const float*)d_in[14]; p.o_g_k = (const float*)d_in[15]; p.o_w_out = (const float*)d_in[16]; p.rel_bias = (const float*)d_in[17];
    p.out = (float*)d_out; p.ws = (unsigned char*)d_ws;
    hipLaunchKernelGGL(k_fwd, dim3(grid), dim3(512), LDS_BYTES, stream, p, 0, NPH);
}
```

```cpp
#include <hip/hip_runtime.h>
#include <stdint.h>
#include <cstdio>

typedef unsigned short bf16_t;
typedef short bf16x8 __attribute__((ext_vector_type(8)));
typedef float f32x4 __attribute__((ext_vector_type(4)));
typedef unsigned u32x4 __attribute__((ext_vector_type(4)));
typedef unsigned u32x2 __attribute__((ext_vector_type(2)));
typedef short v4i16_t __attribute__((ext_vector_type(4)));
#define LAS __attribute__((address_space(3)))

constexpr int T = 32768, SEQ = 16384, DM = 1024;
constexpr int EIN = 7176, OIN = 2628;
constexpr float EPS = 1e-6f;
constexpr size_t MB = 1048576;
constexpr size_t OFF_CTL = 0;
constexpr size_t OFF_GATES = 64 * 1024;
constexpr size_t OFF_BQ = OFF_GATES + (size_t)T * 8 * 4;
constexpr size_t OFF_IQ = OFF_BQ + (size_t)T * 4 * 4;
constexpr size_t OFF_MT = OFF_IQ + (size_t)T * 4 * 4;
constexpr size_t OFF_WI = OFF_MT + (size_t)T * 4 * 4;
constexpr size_t OFF_CH = OFF_WI + (size_t)T * 4 * 4;
constexpr size_t OFF_NS = OFF_CH + 64 * 1024;
constexpr size_t OFF_W = 4 * MB;
constexpr size_t OFF_W0T = OFF_W;
constexpr size_t OFF_WPT = OFF_W0T + (size_t)7168 * 1024 * 2;
constexpr size_t OFF_WO0T = OFF_WPT + (size_t)4 * 256 * 256 * 2;
constexpr size_t OFF_W1T = OFF_WO0T + (size_t)1024 * 2048 * 2;
constexpr size_t OFF_WUKT = OFF_W1T + (size_t)2816 * 1024 * 2;
constexpr size_t OFF_WUVT = OFF_WUKT + (size_t)1024 * 256 * 2;
constexpr size_t OFF_WO1T = OFF_WUVT + (size_t)1024 * 256 * 2;
constexpr size_t OFF_WUKP = OFF_WO1T + (size_t)1024 * 1024 * 2;
constexpr size_t OFF_WQP = OFF_WUKP + (size_t)1024 * 256 * 2;
constexpr size_t OFF_XN = 36 * MB, OFF_QB = 100 * MB, OFF_KB = 164 * MB, OFF_VB = 228 * MB, OFF_TMP = 292 * MB, OFF_Y = 356 * MB;
constexpr size_t OFF_QP = 36 * MB;
constexpr size_t OFF_CKVN = OFF_Y;
constexpr size_t OFF_QI = OFF_Y + 16 * MB;
constexpr size_t OFF_KI = OFF_Y + 32 * MB;
constexpr size_t OFF_IDX = OFF_Y + 40 * MB;
constexpr size_t OFF_RK = OFF_Y + 58 * MB;
constexpr size_t OFF_CNT = OFF_Y + 59 * MB;
constexpr size_t OFF_Z = OFF_Y + 60 * MB;
constexpr size_t WS_END = 484 * MB;
constexpr int LDS_BYTES = 151552;
constexpr int NPH = 17;

struct P {
    const float *x, *e_norm, *e_w_in, *e_conv, *e_b_if, *e_g_head, *e_w_pool, *e_s_pool, *e_w_out;
    const float *o_norm, *o_w_in, *o_g_kv, *o_w_uk, *o_w_uv, *o_g_q, *o_g_k, *o_w_out, *rel_bias;
    float* out; unsigned char* ws;
};

__device__ __forceinline__ bf16_t f2bf(float f) { unsigned u = __float_as_uint(f); u += 0x7FFFu + ((u >> 16) & 1u); return (bf16_t)(u >> 16); }
__device__ __forceinline__ float bf2f(bf16_t b) { return __uint_as_float(((unsigned)b) << 16); }
__device__ __forceinline__ float bflo(unsigned w) { return __uint_as_float(w << 16); }
__device__ __forceinline__ float bfhi(unsigned w) { return __uint_as_float(w & 0xffff0000u); }
__device__ __forceinline__ unsigned pk2(float a, float b) { return (unsigned)f2bf(a) | ((unsigned)f2bf(b) << 16); }
__device__ __forceinline__ float sigmoidf_(float x) { return 1.0f / (1.0f + __expf(-x)); }
__device__ __forceinline__ float siluf_(float x) { return x / (1.0f + __expf(-x)); }
__device__ __forceinline__ float wave_sum(float v) {
#pragma unroll
    for (int o = 32; o >= 1; o >>= 1) v += __shfl_xor(v, o);
    return v;
}
__device__ __forceinline__ float wave_max(float v) {
#pragma unroll
    for (int o = 32; o >= 1; o >>= 1) v = fmaxf(v, __shfl_xor(v, o));
    return v;
}

#define XB_TMO      128
#define XB_XCNT(j)  (256  + 64 * (j))
#define XB_XSUB(j)  (1280 + 64 * (j))
#define XB_XGEN(j)  (2304 + 64 * (j))
#define XB_TOP      3328
#define XB_TOPGEN   3392
#define XCD_BAR_WORDS 3456
#define XB_SPIN_CAP (1u << 22)
__device__ __forceinline__ unsigned xb_ld(unsigned* p)              { return __hip_atomic_load(p, __ATOMIC_RELAXED, __HIP_MEMORY_SCOPE_AGENT); }
__device__ __forceinline__ unsigned xb_add(unsigned* p, unsigned v) { return __hip_atomic_fetch_add(p, v, __ATOMIC_RELAXED, __HIP_MEMORY_SCOPE_AGENT); }
__device__ __forceinline__ unsigned xb_xcc_id() { return (unsigned)__builtin_amdgcn_s_getreg((3 << 11) | 20) & 0xFu; }
#define XB_SPIN(cond, bar) do { unsigned _sp = 0; while (cond) { __builtin_amdgcn_s_sleep(1); \
    if ((++_sp & 255u) == 0u) { if (xb_ld(&(bar)[XB_TMO])) break; if (_sp > XB_SPIN_CAP) { atomicAdd(&(bar)[XB_TMO], 1u); break; } } } } while (0)
struct XcdBarrier { unsigned* bar; unsigned x; volatile LAS unsigned* st; };
__device__ __forceinline__ XcdBarrier xcd_barrier_post(unsigned* bar, volatile LAS unsigned* st) {
    XcdBarrier b; b.bar = bar; b.x = xb_xcc_id(); b.st = st;
    if (threadIdx.x == 0) (void)xb_add(&bar[XB_XCNT(b.x)], 1u);
    return b;
}
__device__ __forceinline__ void xcd_barrier_complete(unsigned* bar, unsigned x, unsigned& nloc, unsigned& nx) {
    const unsigned G = gridDim.x * gridDim.y * gridDim.z;
    unsigned sum, cnt, mine, sp = 0u;
    for (;;) {
        sum = 0u; cnt = 0u; mine = 0u;
#pragma unroll
        for (unsigned j = 0; j < 16; ++j) { const unsigned c = xb_ld(&bar[XB_XCNT(j)]); sum += c; cnt += (c > 0u) ? 1u : 0u; mine = (j == x) ? c : mine; }
        if (sum == G) break;
        __builtin_amdgcn_s_sleep(1);
        if ((++sp & 255u) == 0u) { if (xb_ld(&bar[XB_TMO])) break; if (sp > XB_SPIN_CAP) { atomicAdd(&bar[XB_TMO], 1u); break; } }
    }
    nloc = mine > 0u ? mine : 1u; nx = cnt > 0u ? cnt : 1u;
}
__device__ __forceinline__ void xcd_barrier(const XcdBarrier& b) {
    asm volatile("s_waitcnt vmcnt(0)" ::: "memory");
    __syncthreads();
    if (threadIdx.x == 0) {
        unsigned* bar = b.bar;
        __builtin_amdgcn_s_waitcnt(0);
        unsigned nloc = b.st[0], nx = b.st[1];
        if (nloc == 0u) { xcd_barrier_complete(bar, b.x, nloc, nx); b.st[0] = nloc; b.st[1] = nx; }
        const unsigned old = xb_add(&bar[XB_XSUB(b.x)], 1u);
        const unsigned gen = old / nloc;
        if (old + 1u == (gen + 1u) * nloc) {
            __builtin_amdgcn_fence(__ATOMIC_RELEASE, "agent");
            asm volatile("s_waitcnt vmcnt(0)" ::: "memory");
            const unsigned og = xb_add(&bar[XB_TOP], 1u);
            const unsigned tg = og / nx;
            if (og + 1u == (tg + 1u) * nx) xb_add(&bar[XB_TOPGEN], 1u);
            else XB_SPIN(xb_ld(&bar[XB_TOPGEN]) == tg, bar);
            __builtin_amdgcn_fence(__ATOMIC_ACQUIRE, "agent");
            xb_add(&bar[XB_XGEN(b.x)], 1u);
            asm volatile("s_waitcnt vmcnt(0)" ::: "memory");
        } else {
            XB_SPIN(xb_ld(&bar[XB_XGEN(b.x)]) == gen, bar);
            __builtin_amdgcn_fence(__ATOMIC_ACQUIRE, "agent");
            asm volatile("s_waitcnt vmcnt(0)" ::: "memory");
        }
    }
    __syncthreads();
}

struct Tile { const bf16_t* A; const bf16_t* B; int lda, ldb, K; void* d0; const void* s0; int ld, mode; float aux0, aux1, aux2; int i0, i1; };
template <class F>
__device__ __forceinline__ void sgemm(const F f, int nunits) {
    const int lane = threadIdx.x & 63, wave = threadIdx.x >> 6, fr = lane & 15, fq = lane >> 4;
    for (int u = blockIdx.x * 8 + wave; u < nunits; u += gridDim.x * 8) {
        Tile tl; f.tile(u, tl);
        f32x4 acc[4][4];
#pragma unroll
        for (int m = 0; m < 4; ++m)
#pragma unroll
            for (int n = 0; n < 4; ++n) acc[m][n] = (f32x4){0.f, 0.f, 0.f, 0.f};
        const bf16_t* ap = tl.A + (size_t)fr * tl.lda + fq * 8;
        const bf16_t* bp = tl.B + (size_t)fr * tl.ldb + fq * 8;
        const int K = tl.K, lda = tl.lda, ldb = tl.ldb;
#pragma unroll 1
        for (int k0 = 0; k0 < K; k0 += 32) {
            bf16x8 a[4], b[4];
#pragma unroll
            for (int m = 0; m < 4; ++m) a[m] = *(const bf16x8*)(ap + (size_t)(m * 16) * lda + k0);
#pragma unroll
            for (int n = 0; n < 4; ++n) b[n] = *(const bf16x8*)(bp + (size_t)(n * 16) * ldb + k0);
#pragma unroll
            for (int m = 0; m < 4; ++m)
#pragma unroll
                for (int n = 0; n < 4; ++n) acc[m][n] = __builtin_amdgcn_mfma_f32_16x16x32_bf16(a[m], b[n], acc[m][n], 0, 0, 0);
        }
#pragma unroll
        for (int m = 0; m < 4; ++m)
#pragma unroll
            for (int j = 0; j < 4; ++j) {
                const int r = m * 16 + fq * 4 + j;
                asm volatile("" ::: "memory");
#pragma unroll
                for (int n = 0; n < 4; ++n) f.out(tl, r, n * 16 + fr, acc[m][n][j]);
            }
    }
}
__device__ __forceinline__ void store_mode(const Tile& tl, int r, int c, float v) {
    const size_t i = (size_t)r * tl.ld + c;
    if (tl.mode == 0) ((bf16_t*)tl.d0)[i] = f2bf(v);
    else if (tl.mode == 1) ((bf16_t*)tl.d0)[i] = f2bf(sigmoidf_(v));
    else if (tl.mode == 2) ((bf16_t*)tl.d0)[i] = f2bf(siluf_(v));
    else if (tl.mode == 3) ((float*)tl.d0)[i] = v * tl.aux0;
}

struct G1 {
    const bf16_t* XN; const bf16_t* W; bf16_t *Q, *K_, *V;
    __device__ __forceinline__ void tile(int u, Tile& tl) const {
        const int mt = u / 48, nt = u % 48; tl.A = XN + (size_t)mt * 64 * 1024; tl.lda = 1024; tl.B = W + (size_t)nt * 64 * 1024; tl.ldb = 1024; tl.K = 1024;
        const int col = nt * 64, sec = col >> 10, cc = col & 1023; bf16_t* d = Q + (size_t)sec * (32 * MB);
        tl.d0 = d + (size_t)mt * 64 * 1024 + cc; tl.ld = 1024; tl.mode = 0; }
    __device__ __forceinline__ void out(const Tile& tl, int r, int c, float v) const { store_mode(tl, r, c, v); }
};
struct G2 {
    const bf16_t* XN; const bf16_t* W; bf16_t *O, *ZA, *U, *Y;
    __device__ __forceinline__ void tile(int u, Tile& tl) const {
        const int mt = u / 64, nt = u % 64; tl.A = XN + (size_t)mt * 64 * 1024; tl.lda = 1024; tl.B = W + (size_t)(3072 + nt * 64) * 1024; tl.ldb = 1024; tl.K = 1024;
        const int col = nt * 64, sec = col >> 10, cc = col & 1023;
        if (sec == 0) { tl.d0 = O + (size_t)mt * 64 * 1024 + cc; tl.ld = 1024; tl.mode = 1; }
        else if (sec == 1) { tl.d0 = ZA + (size_t)mt * 64 * 1024 + cc; tl.ld = 1024; tl.mode = 2; }
        else if (sec == 2) { tl.d0 = U + (size_t)mt * 64 * 1024 + cc; tl.ld = 1024; tl.mode = 0; }
        else { tl.d0 = Y + (size_t)mt * 64 * 2048 + 1024 + cc; tl.ld = 2048; tl.mode = 2; } }
    __device__ __forceinline__ void out(const Tile& tl, int r, int c, float v) const { store_mode(tl, r, c, v); }
};
struct GM1 {
    const bf16_t* Y; const bf16_t* KT; const float *BQ, *IQ, *MT; float* W;
    __device__ __forceinline__ void tile(int u, Tile& tl) const {
        const int bh = u >> 8, c = u & 255, batch = bh >> 2, head = bh & 3; const size_t t0 = (size_t)batch * SEQ + c * 64;
        tl.A = Y + t0 * 2048 + 1024 + head * 256; tl.lda = 2048; tl.B = KT + t0 * 1024 + head * 256; tl.ldb = 1024; tl.K = 256;
        tl.d0 = W + (size_t)u * 4096; tl.ld = 64; tl.mode = 0; tl.i0 = (int)(t0 * 4 + head); }
    __device__ __forceinline__ void out(const Tile& tl, int r, int c, float v) const {
        float w = 0.f;
        if (c <= r) w = __expf(BQ[tl.i0 + r * 4] - BQ[tl.i0 + c * 4] + IQ[tl.i0 + c * 4] - MT[tl.i0 + r * 4]) * v;
        ((float*)tl.d0)[r * 64 + c] = w; }
};
struct G3 {
    const bf16_t* XN; const bf16_t* W; const float* sp; bf16_t* Y;
    __device__ __forceinline__ void tile(int u, Tile& tl) const {
        const int mt = u >> 4, g = (u >> 2) & 3, nt = u & 3; tl.A = XN + (size_t)mt * 64 * 1024 + g * 256; tl.lda = 1024; tl.B = W + (size_t)(g * 256 + nt * 64) * 256; tl.ldb = 256; tl.K = 256;
        const int col = g * 256 + nt * 64; tl.d0 = Y + (size_t)mt * 64 * 2048 + 1024 + col; tl.ld = 2048; tl.s0 = sp + col; tl.mode = 0; }
    __device__ __forceinline__ void out(const Tile& tl, int r, int c, float v) const {
        bf16_t* d = (bf16_t*)tl.d0 + (size_t)r * 2048 + c; *d = f2bf(v * ((const float*)tl.s0)[c] * bf2f(*d)); }
};
struct G4 {
    const bf16_t* Y; const bf16_t* W; const float* x; float* out_;
    __device__ __forceinline__ void tile(int u, Tile& tl) const {
        const int mt = u >> 4, nt = u & 15; tl.A = Y + (size_t)mt * 64 * 2048; tl.lda = 2048; tl.B = W + (size_t)nt * 64 * 2048; tl.ldb = 2048; tl.K = 2048;
        const size_t o = (size_t)mt * 64 * 1024 + nt * 64; tl.d0 = out_ + o; tl.s0 = x + o; tl.ld = 1024; tl.mode = 0; }
    __device__ __forceinline__ void out(const Tile& tl, int r, int c, float v) const { const size_t i = (size_t)r * 1024 + c; ((float*)tl.d0)[i] = ((const float*)tl.s0)[i] + v; }
};
struct G5 {
    const bf16_t* XN; const bf16_t* W; bf16_t* Q; float *CKVR, *QI, *KI; bf16_t* Z;
    __device__ __forceinline__ void tile(int u, Tile& tl) const {
        const int mt = u / 44, nt = u % 44; tl.A = XN + (size_t)mt * 64 * 1024; tl.lda = 1024; tl.B = W + (size_t)nt * 64 * 1024; tl.ldb = 1024; tl.K = 1024;
        const int col = nt * 64; const size_t row0 = (size_t)mt * 64; tl.aux0 = 1.0f;
        if (col < 1024) { tl.d0 = Q + row0 * 1024 + col; tl.ld = 1024; tl.mode = 0; }
        else if (col < 1280) { tl.d0 = CKVR + row0 * 256 + (col - 1024); tl.ld = 256; tl.mode = 3; }
        else if (col < 1536) { tl.d0 = QI + row0 * 256 + (col - 1280); tl.ld = 256; tl.mode = 3; tl.aux0 = 0.125f; }
        else if (col < 1600) { tl.d0 = KI + row0 * 64 + (col - 1536); tl.ld = 64; tl.mode = 3; }
        else if (col < 1792) { tl.d0 = nullptr; tl.ld = 0; tl.mode = 4; }
        else { tl.d0 = Z + row0 * 1024 + (col - 1792); tl.ld = 1024; tl.mode = 2; } }
    __device__ __forceinline__ void out(const Tile& tl, int r, int c, float v) const { store_mode(tl, r, c, v); }
};
struct G67 {
    const bf16_t* C; const bf16_t *WK, *WV; bf16_t *KF, *VF;
    __device__ __forceinline__ void tile(int u, Tile& tl) const {
        const int which = u >= 8192, uu = u & 8191, mt = uu >> 4, nt = uu & 15; tl.A = C + (size_t)mt * 64 * 256; tl.lda = 256; tl.B = WK + (size_t)which * (1024 * 256) + (size_t)nt * 64 * 256;     tl.ldb = 256; tl.K = 256;
        tl.d0 = KF + (size_t)which * (32 * MB) + (size_t)mt * 64 * 1024 + nt * 64;     tl.ld = 1024; tl.mode = 0; }
    __device__ __forceinline__ void out(const Tile& tl, int r, int c, float v) const { store_mode(tl, r, c, v); }
};
struct G8 {
    const bf16_t* G; const bf16_t* W; float* out_;
    __device__ __forceinline__ void tile(int u, Tile& tl) const {
        const int mt = u >> 4, nt = u & 15; tl.A = G + (size_t)mt * 64 * 1024; tl.lda = 1024; tl.B = W + (size_t)nt * 64 * 1024; tl.ldb = 1024; tl.K = 1024;
        tl.d0 = out_ + (size_t)mt * 64 * 1024 + nt * 64; tl.ld = 1024; tl.mode = 0; }
    __device__ __forceinline__ void out(const Tile& tl, int r, int c, float v) const { float* d = (float*)tl.d0 + (size_t)r * 1024 + c; *d = *d + v; }
};

struct GQP {
    const bf16_t* Qn; const bf16_t* W; bf16_t* QP;
    __device__ __forceinline__ void tile(int u, Tile& tl) const {
        const int nt = u & 3, head = (u >> 2) & 15, mt = u >> 6; tl.A = Qn + (size_t)mt * 64 * 1024 + head * 64; tl.lda = 1024; tl.B = W + (size_t)(head * 256 + nt * 64) * 64; tl.ldb = 64; tl.K = 64;
        tl.d0 = QP + ((size_t)mt * 64 * 16 + head) * 256 + nt * 64; tl.ld = 4096; tl.mode = 0; }
    __device__ __forceinline__ void out(const Tile& tl, int r, int c, float v) const { store_mode(tl, r, c, v); }
};
struct GOP {
    const bf16_t* OP; const bf16_t* W; const bf16_t* Z; bf16_t* G;
    __device__ __forceinline__ void tile(int u, Tile& tl) const {
        const int head = u & 15, mt = u >> 4; tl.A = OP + (size_t)mt * 64 * 4096 + head * 256; tl.lda = 4096; tl.B = W + (size_t)head * 64 * 256; tl.ldb = 256; tl.K = 256;
        const size_t o = (size_t)mt * 64 * 1024 + head * 64; tl.d0 = G + o; tl.s0 = Z + o; tl.ld = 1024; tl.mode = 0; }
    __device__ __forceinline__ void out(const Tile& tl, int r, int c, float v) const { const size_t i = (size_t)r * 1024 + c; ((bf16_t*)tl.d0)[i] = f2bf(v * bf2f(((const bf16_t*)tl.s0)[i])); }
};

namespace pg8 {
constexpr int BM = 256, BK = 64, HALF = 128, HTB = HALF * BK * 2, STAGE_BYTES = 8 * HTB, NXCD = 8, WGM = 8;
__device__ __forceinline__ int lds_byte(int r, int c) { const int st = (r >> 4) * 2 + (c >> 5), rr = r & 15, cc = c & 31, ob = rr * 64 + cc * 2; return st * 1024 + (ob ^ (((ob >> 9) & 1) << 5)); }
__device__ __forceinline__ void stage_rc(int b, int& R, int& C) { const int st = b / 1024, sb = b % 1024, swz = sb ^ (((sb >> 9) & 1) << 5); R = (st >> 1) * 16 + swz / 64; C = (st & 1) * 32 + (swz % 64) / 2; }
__device__ __forceinline__ int perm32(int rho) { const int n = rho >> 4, i = rho & 15; return 8 * (i >> 2) + 4 * n + (i & 3); }
struct Unit { int pm, pn; };
struct Gemm { const bf16_t* A; int lda; const bf16_t* Bt; int ldb; int M, N, K; };
struct StaticOrder {
    int nM, nN, nwg, G, c;
    __device__ void init(int M, int N, int G_, int c_) { nM = M / BM; nN = N / BM; nwg = nM * nN; G = G_; c = c_; }
    __device__ bool next(int i, Unit& u) const {
        const long L = (long)i * G + c; if (L >= nwg) return false;
        int wgid = (int)L; { const int q = nwg / NXCD, r = nwg % NXCD, xcd = wgid % NXCD, off = wgid / NXCD; wgid = (xcd < r ? xcd * (q + 1) : r * (q + 1) + (xcd - r) * q) + off; }
        const int nig = WGM * nN, gid = wgid / nig, fm = gid * WGM, gsz = (nM - fm) < WGM ? (nM - fm) : WGM;
        u.pm = fm + ((wgid % nig) % gsz); u.pn = (wgid % nig) / gsz; return true;
    }
};
__device__ __forceinline__ unsigned cvt_pk_bf16(float lo, float hi) { unsigned r; asm volatile("v_cvt_pk_bf16_f32 %0, %1, %2" : "=v"(r) : "v"(lo), "v"(hi)); return r; }

struct Dst { unsigned char* base; const float* res; int ld, mode, ncol; float scale; };
template <class DescF> struct EpiGen {
    static constexpr bool PERM = true;
    DescF D;
    __device__ __forceinline__ void operator()(const f32x4 (&acc)[2][2][4][2], const Unit& u, int wr, int wc, int fr, int fq) const {
        Dst d; D.get(u, d);
        if ((DescF::MODES & 16) && d.mode == 4) return;
        const int r0 = wr * 64 + fr, c0 = wc * 32 + 8 * fq;
        if constexpr ((DescF::MODES & 64) != 0) {
#pragma unroll
            for (int ai = 0; ai < 2; ++ai)
#pragma unroll
                for (int m = 0; m < 4; ++m) {
                    float ss = 0.f;
#pragma unroll
                    for (int bj = 0; bj < 2; ++bj)
#pragma unroll
                        for (int n = 0; n < 2; ++n) { const f32x4 v = acc[ai][bj][m][n]; ss += v[0] * v[0] + v[1] * v[1] + v[2] * v[2] + v[3] * v[3]; }
                    ss += __shfl_xor(ss, 16); ss += __shfl_xor(ss, 32);
                    if (fq == 0) ((bf16_t*)d.base)[(size_t)(ai * HALF + r0 + m * 16) * d.ld + wc] = f2bf(rsqrtf(ss * (1.0f / 64.0f) + EPS));
                }
            return;
        } else {
#pragma unroll
        for (int ai = 0; ai < 2; ++ai)
#pragma unroll
            for (int m = 0; m < 4; ++m) {
                const size_t rowoff = (size_t)(ai * HALF + r0 + m * 16) * d.ld;
#pragma unroll
                for (int bj = 0; bj < 2; ++bj) {
                    const int col = bj * HALF + c0; f32x4 v0 = acc[ai][bj][m][0], v1 = acc[ai][bj][m][1];
                    if ((DescF::MODES & 7) && d.mode <= 2) {
                        if ((DescF::MODES & 2) && d.mode == 1) {
#pragma unroll
                            for (int j = 0; j < 4; ++j) { v0[j] = sigmoidf_(v0[j]); v1[j] = sigmoidf_(v1[j]); } }
                        if ((DescF::MODES & 4) && d.mode == 2) {
#pragma unroll
                            for (int j = 0; j < 4; ++j) { v0[j] = siluf_(v0[j]); v1[j] = siluf_(v1[j]); } }
                        u32x4 w; w.x = cvt_pk_bf16(v0[0], v0[1]); w.y = cvt_pk_bf16(v0[2], v0[3]); w.z = cvt_pk_bf16(v1[0], v1[1]); w.w = cvt_pk_bf16(v1[2], v1[3]);
                        *(u32x4*)((bf16_t*)d.base + rowoff + col) = w;
                    } else if ((DescF::MODES & 8) && d.mode == 3) {
                        if (col < d.ncol) { float* o = (float*)d.base + rowoff + col; *(f32x4*)o = v0 * d.scale; *(f32x4*)(o + 4) = v1 * d.scale; }
                    } else if ((DescF::MODES & 128) && d.mode == 7) {
                        typedef _Float16 h8 __attribute__((ext_vector_type(8)));
                        if (col < d.ncol) {
                        h8 hv; hv[0] = (_Float16)(v0[0] * d.scale); hv[1] = (_Float16)(v0[1] * d.scale); hv[2] = (_Float16)(v0[2] * d.scale); hv[3] = (_Float16)(v0[3] * d.scale);
                        hv[4] = (_Float16)(v1[0] * d.scale); hv[5] = (_Float16)(v1[1] * d.scale); hv[6] = (_Float16)(v1[2] * d.scale); hv[7] = (_Float16)(v1[3] * d.scale);
                        *(h8*)((_Float16*)d.base + rowoff + col) = hv; }
                    } else if constexpr ((DescF::MODES & 32) != 0) {
                        float* o = (float*)d.base + rowoff + col; const float* rs = d.res + rowoff + col;
                        const f32x4 a = *(const f32x4*)rs, b = *(const f32x4*)(rs + 4); *(f32x4*)o = a + v0; *(f32x4*)(o + 4) = b + v1;
                    }
                }
                if (m & 1) asm volatile("" ::: "memory");
            }
        }
    }
};

template <class Epi>
__device__ __forceinline__ void gemm_phase(LAS unsigned char* lds, const Gemm g, const StaticOrder& S, const Epi& E) {
    const int tid = threadIdx.x, wid = __builtin_amdgcn_readfirstlane(tid >> 6), lane = tid & 63, wr = wid >> 2, wc = wid & 3, fr = lane & 15, fq = lane >> 4;
    const int K = g.K, nt = K / BK;
    unsigned voffA[2], voffB[2];
#pragma unroll
    for (int i = 0; i < 2; ++i) { int R, C; stage_rc(tid * 16 + i * 8192, R, C); const int Rb = Epi::PERM ? ((R & ~31) + perm32(R & 31)) : R;
        voffA[i] = (unsigned)(R * g.lda + C) * 2u; voffB[i] = (unsigned)(Rb * g.ldb + C) * 2u; }
    const size_t kstep = (size_t)(BK * 2);
    const size_t hstepA = (size_t)HALF * g.lda * 2, hstepB = (size_t)HALF * g.ldb * 2;
    const size_t tstepA = 2 * hstepA, tstepB = 2 * hstepB;
    const unsigned ldsw = (unsigned)wid * 1024u;
    const int aoff = lds_byte(wr * 64 + fr, fq * 8), boff = lds_byte(wc * 32 + fr, fq * 8);
#define PG8_SA(b, h) (((b) * 2 + (h)) * HTB)
#define PG8_SB(b, h) ((4 + (b) * 2 + (h)) * HTB)
#define PG8_STAGE(bufoff, gbase, voff) do { _Pragma("unroll") for (int _i = 0; _i < 2; ++_i) \
        __builtin_amdgcn_global_load_lds((const unsigned*)((const char*)(gbase) + (voff)[_i]), (LAS unsigned*)(lds + (bufoff) + ldsw + _i * 8192), 16, 0, 0); } while (0)
#define PG8_LDA(dst, b, h) do { _Pragma("unroll") for (int m = 0; m < 4; ++m) _Pragma("unroll") for (int k = 0; k < 2; ++k) dst[m][k] = *(const LAS bf16x8*)(lds + PG8_SA(b, h) + aoff + m * 2048 + k * 1024); } while (0)
#define PG8_LDB(dst, b, h) do { _Pragma("unroll") for (int n = 0; n < 2; ++n) _Pragma("unroll") for (int k = 0; k < 2; ++k) dst[n][k] = *(const LAS bf16x8*)(lds + PG8_SB(b, h) + boff + n * 2048 + k * 1024); } while (0)
#define PG8_MMA(ai, bj, At, Bt) do { __builtin_amdgcn_s_setprio(1); _Pragma("unroll") for (int m = 0; m < 4; ++m) _Pragma("unroll") for (int n = 0; n < 2; ++n) _Pragma("unroll") for (int k = 0; k < 2; ++k) \
        acc[ai][bj][m][n] = __builtin_amdgcn_mfma_f32_16x16x32_bf16(Bt[n][k], At[m][k], acc[ai][bj][m][n], 0, 0, 0); __builtin_amdgcn_s_setprio(0); } while (0)
#define PG8_WAIT_V(n) asm volatile("s_waitcnt vmcnt(" #n ")" ::: "memory")
#define PG8_WAIT_L(n) asm volatile("s_waitcnt lgkmcnt(" #n ")" ::: "memory")
#define PG8_BAR __builtin_amdgcn_s_barrier()
#define PG8_SCHED __builtin_amdgcn_sched_barrier(0)
    Unit cur, nxt; int ui = 0;
    if (!S.next(0, cur)) return;
    f32x4 acc[2][2][4][2];
#pragma unroll
    for (int a = 0; a < 2; ++a)
#pragma unroll
        for (int b = 0; b < 2; ++b)
#pragma unroll
            for (int m = 0; m < 4; ++m)
#pragma unroll
                for (int n = 0; n < 2; ++n) acc[a][b][m][n] = (f32x4){0.f, 0.f, 0.f, 0.f};
    bf16x8 At[4][2], B0[2][2], B1[2][2];
    const char* cA = (const char*)g.A + (size_t)cur.pm * tstepA; const char* cB = (const char*)g.Bt + (size_t)cur.pn * tstepB;
    PG8_STAGE(PG8_SB(0, 0), cB, voffB); PG8_STAGE(PG8_SA(0, 0), cA, voffA); PG8_STAGE(PG8_SB(0, 1), cB + hstepB, voffB); PG8_STAGE(PG8_SA(0, 1), cA + hstepA, voffA);
    if (wr == 1) PG8_BAR;
    PG8_WAIT_V(4); PG8_BAR;
    PG8_STAGE(PG8_SB(1, 0), cB + kstep, voffB); PG8_STAGE(PG8_SA(1, 0), cA + kstep, voffA); PG8_STAGE(PG8_SB(1, 1), cB + hstepB + kstep, voffB);
    PG8_WAIT_V(6); PG8_BAR;
    for (;;) {
        const bool has_next = S.next(ui + 1, nxt);
        const char* nA = has_next ? (const char*)g.A + (size_t)nxt.pm * tstepA : cA; const char* nB = has_next ? (const char*)g.Bt + (size_t)nxt.pn * tstepB : cB;
#pragma unroll 1
        for (int t = 0; t < nt; t += 2) {
            const bool last = (t == nt - 2);
            const char* a1 = cA + (size_t)(t + 1) * kstep;
            const char* a2 = last ? nA : cA + (size_t)(t + 2) * kstep; const char* b2 = last ? nB : cB + (size_t)(t + 2) * kstep;
            const char* a3 = a2 + kstep; const char* b3 = b2 + kstep;
            PG8_LDB(B0, 0, 0); PG8_SCHED; PG8_LDA(At, 0, 0); PG8_STAGE(PG8_SA(1, 1), a1 + hstepA, voffA);
            PG8_WAIT_L(8); PG8_BAR; PG8_WAIT_L(0); PG8_MMA(0, 0, At, B0); PG8_BAR; PG8_SCHED;
            PG8_LDB(B1, 0, 1); PG8_STAGE(PG8_SB(0, 0), b2, voffB);
            PG8_BAR; PG8_WAIT_L(0); PG8_MMA(0, 1, At, B1); PG8_BAR;
            PG8_LDA(At, 0, 1); PG8_STAGE(PG8_SA(0, 0), a2, voffA);
            PG8_BAR; PG8_WAIT_L(0); PG8_MMA(1, 0, At, B0); PG8_BAR; PG8_SCHED;
            PG8_STAGE(PG8_SB(0, 1), b2 + hstepB, voffB);
            PG8_WAIT_V(6); PG8_BAR; PG8_MMA(1, 1, At, B1); PG8_BAR;
            PG8_LDB(B0, 1, 0); PG8_SCHED; PG8_LDA(At, 1, 0); PG8_STAGE(PG8_SA(0, 1), a2 + hstepA, voffA);
            PG8_WAIT_L(8); PG8_BAR; PG8_WAIT_L(0); PG8_MMA(0, 0, At, B0); PG8_BAR; PG8_SCHED;
            PG8_LDB(B1, 1, 1); PG8_STAGE(PG8_SB(1, 0), b3, voffB);
            PG8_BAR; PG8_WAIT_L(0); PG8_MMA(0, 1, At, B1); PG8_BAR;
            PG8_LDA(At, 1, 1); PG8_STAGE(PG8_SA(1, 0), a3, voffA);
            PG8_BAR; PG8_WAIT_L(0); PG8_MMA(1, 0, At, B0); PG8_BAR; PG8_SCHED;
            PG8_STAGE(PG8_SB(1, 1), b3 + hstepB, voffB);
            PG8_WAIT_V(6); PG8_BAR; PG8_MMA(1, 1, At, B1); PG8_BAR;
        }
        E(acc, cur, wr, wc, fr, fq);
        if (!has_next) break;
#pragma unroll
        for (int a = 0; a < 2; ++a)
#pragma unroll
            for (int b = 0; b < 2; ++b)
#pragma unroll
                for (int m = 0; m < 4; ++m)
#pragma unroll
                    for (int n = 0; n < 2; ++n) acc[a][b][m][n] = (f32x4){0.f, 0.f, 0.f, 0.f};
        cur = nxt; cA = nA; cB = nB; ++ui;
    }
    PG8_WAIT_V(0);
    if (wr == 0) PG8_BAR;
    PG8_BAR;
#undef PG8_SA
#undef PG8_SB
#undef PG8_STAGE
#undef PG8_LDA
#undef PG8_LDB
#undef PG8_MMA
#undef PG8_WAIT_V
#undef PG8_WAIT_L
#undef PG8_BAR
#undef PG8_SCHED
}
}

struct D1 { static constexpr int MODES = 1; unsigned char* ws;
    __device__ __forceinline__ void get(const pg8::Unit& u, pg8::Dst& d) const { const int sec = u.pn >> 2;
        d.base = ws + OFF_QB + (size_t)sec * (64 * MB) + ((size_t)u.pm * 256 * 1024 + (u.pn & 3) * 256) * 2; d.res = nullptr; d.ld = 1024; d.mode = 0; d.ncol = 256; d.scale = 1.f; } };
struct D2 { static constexpr int MODES = 7; unsigned char* ws;
    __device__ __forceinline__ void get(const pg8::Unit& u, pg8::Dst& d) const { const int sec = u.pn >> 2, cc = (u.pn & 3) * 256; d.res = nullptr; d.ncol = 256; d.scale = 1.f;
        if (sec < 3) { d.base = ws + OFF_QB + (size_t)sec * (64 * MB) + ((size_t)u.pm * 256 * 1024 + cc) * 2; d.ld = 1024; d.mode = sec == 0 ? 1 : (sec == 1 ? 2 : 0); }
        else { d.base = ws + OFF_Y + ((size_t)u.pm * 256 * 2048 + 1024 + cc) * 2; d.ld = 2048; d.mode = 2; } } };
struct D4 { static constexpr int MODES = 32; unsigned char* out; const float* x;
    __device__ __forceinline__ void get(const pg8::Unit& u, pg8::Dst& d) const { const size_t o = (size_t)u.pm * 256 * 1024 + u.pn * 256;
        d.base = out + o * 4; d.res = x + o; d.ld = 1024; d.mode = 5; d.ncol = 256; d.scale = 1.f; } };
struct D5 { static constexpr int MODES = 133; unsigned char* ws;
    __device__ __forceinline__ void get(const pg8::Unit& u, pg8::Dst& d) const { const int pn = u.pn; d.res = nullptr; d.ncol = 256; d.scale = 1.f;
        if (pn < 4) { d.base = ws + OFF_TMP + ((size_t)u.pm * 256 * 1024 + pn * 256) * 2; d.ld = 1024; d.mode = 0; }
        else if (pn == 4) { d.base = ws + OFF_CKVN + (size_t)u.pm * 256 * 256 * 2; d.ld = 256; d.mode = 0; }
        else if (pn == 5) { d.base = ws + OFF_QI + (size_t)u.pm * 256 * 256 * 2; d.ld = 256; d.mode = 7; d.scale = 0.125f; }
        else if (pn == 6) { d.base = ws + OFF_KI + (size_t)u.pm * 256 * 64 * 2; d.ld = 64; d.mode = 7; d.ncol = 64; }
        else { d.base = ws + OFF_Z + ((size_t)u.pm * 256 * 1024 + (pn - 7) * 256) * 2; d.ld = 1024; d.mode = 2; } } };
struct DK { static constexpr int MODES = 64; unsigned char* ws;
    __device__ __forceinline__ void get(const pg8::Unit& u, pg8::Dst& d) const {
        d.base = ws + OFF_RK + ((size_t)u.pm * 256 * 16 + u.pn * 4) * 2; d.res = nullptr; d.ld = 16; d.mode = 6; d.ncol = 256; d.scale = 1.f; } };
struct D8 { static constexpr int MODES = 32; unsigned char* out;
    __device__ __forceinline__ void get(const pg8::Unit& u, pg8::Dst& d) const { const size_t o = (size_t)u.pm * 256 * 1024 + u.pn * 256;
        d.base = out + o * 4; d.res = (const float*)out + o; d.ld = 1024; d.mode = 5; d.ncol = 256; d.scale = 1.f; } };
template <class DF>
__device__ __forceinline__ void fast_gemm(unsigned char* lds, const bf16_t* A, int lda, const bf16_t* Bt, int ldb, int N, int K, const DF& df) {
    pg8::Gemm g{A, lda, Bt, ldb, T, N, K}; pg8::StaticOrder S; S.init(T, N, (int)gridDim.x, (int)blockIdx.x);
    pg8::EpiGen<DF> E{df};
    pg8::gemm_phase(( LAS unsigned char*)lds, g, S, E);
}

__device__ __forceinline__ void tconv(const float* __restrict__ src, int ld, int col0, int ncols, int K, bf16_t* __restrict__ dst, float* tile  ) {
    const int nkt = K / 64, ntiles = nkt * (ncols / 64), tid = threadIdx.x;
    for (int id = blockIdx.x; id < ntiles; id += gridDim.x) {
        const int kt = id % nkt, nt = id / nkt;
#pragma unroll
        for (int j = 0; j < 8; ++j) { const int e = tid + 512 * j, kk = e >> 6, nn = e & 63; tile[kk * 65 + nn] = src[(size_t)(kt * 64 + kk) * ld + col0 + nt * 64 + nn]; }
        __syncthreads();
#pragma unroll
        for (int j = 0; j < 8; ++j) { const int e = tid + 512 * j, nn = e >> 6, kk = e & 63; dst[(size_t)(nt * 64 + nn) * K + kt * 64 + kk] = f2bf(tile[kk * 65 + nn]); }
        __syncthreads();
    }
}
template <int NE>
__device__ __forceinline__ void rmsnorm_rows(const float* __restrict__ src, const float* __restrict__ g, bf16_t* __restrict__ dst,
                             const float* __restrict__ Wx, int ldw, int col0, const float* __restrict__ bias, float scale, float* __restrict__ dstx) {
    const int lane = threadIdx.x & 63, wave = threadIdx.x >> 6;
    for (int row = blockIdx.x * 8 + wave; row < T; row += gridDim.x * 8) {
        f32x4 v[4]; float ss = 0.f;
#pragma unroll
        for (int i = 0; i < 4; ++i) { v[i] = *(const f32x4*)(src + (size_t)row * 1024 + i * 256 + lane * 4); ss += v[i][0] * v[i][0] + v[i][1] * v[i][1] + v[i][2] * v[i][2] + v[i][3] * v[i][3]; }
        ss = wave_sum(ss);
        const float rstd = rsqrtf(ss * (1.0f / 1024.0f) + EPS);
        float ex[NE];
#pragma unroll
        for (int e = 0; e < NE; ++e) ex[e] = 0.f;
#pragma unroll
        for (int i = 0; i < 4; ++i) {
            asm volatile("" ::: "memory");
            const f32x4 gg = *(const f32x4*)(g + i * 256 + lane * 4);
            f32x4 y; y[0] = v[i][0] * rstd * gg[0]; y[1] = v[i][1] * rstd * gg[1]; y[2] = v[i][2] * rstd * gg[2]; y[3] = v[i][3] * rstd * gg[3];
            u32x2 w; w.x = pk2(y[0], y[1]); w.y = pk2(y[2], y[3]);
            *(u32x2*)(dst + (size_t)row * 1024 + i * 256 + lane * 4) = w;
#pragma unroll
            for (int j = 0; j < 4; ++j) { const float* wr = Wx + (size_t)(i * 256 + lane * 4 + j) * ldw + col0;
#pragma unroll
                for (int e4 = 0; e4 < NE / 4; ++e4) { const f32x4 wv = *(const f32x4*)(wr + e4 * 4);
                    ex[e4 * 4 + 0] += y[j] * wv[0]; ex[e4 * 4 + 1] += y[j] * wv[1]; ex[e4 * 4 + 2] += y[j] * wv[2]; ex[e4 * 4 + 3] += y[j] * wv[3]; } }
        }
#pragma unroll
        for (int e = 0; e < NE; ++e) { const float s = wave_sum(ex[e]); if (lane == 0) dstx[(size_t)row * NE + e] = (s + (bias ? bias[e] : 0.f)) * scale; }
    }
}

__device__ __forceinline__ void phase_prep(const P& p, unsigned char* lds) {
    float* tile = (float*)lds; unsigned char* ws = p.ws;
    bf16_t* W0T = (bf16_t*)(ws + OFF_W0T);
    tconv(p.e_w_in, EIN, 0, 5120, 1024, W0T, tile);
    tconv(p.e_w_in, EIN, 6152, 1024, 1024, W0T + (size_t)6144 * 1024, tile);
    {
        float* arow = tile;
        for (int it = blockIdx.x; it < 4 * 512; it += gridDim.x) {
            const int g = it >> 9, k0 = (it & 511) * 2; const int tid = threadIdx.x, kk = tid >> 8, d = tid & 255;
            __syncthreads();
            arow[tid] = p.e_w_in[(size_t)(k0 + kk) * EIN + 5128 + g * 256 + d];
            __syncthreads();
            const float* wp = p.e_w_pool + (size_t)g * 65536 + d; const float* ar = arow + kk * 256; float acc = 0.f;
#pragma unroll 8
            for (int c = 0; c < 256; ++c) acc += ar[c] * wp[(size_t)c * 256];
            W0T[(size_t)(5120 + g * 256 + d) * 1024 + k0 + kk] = f2bf(acc);
        }
        __syncthreads();
    }
    tconv(p.e_w_out, 1024, 0, 1024, 2048, (bf16_t*)(ws + OFF_WO0T), tile);
    bf16_t* W1T = (bf16_t*)(ws + OFF_W1T);
    tconv(p.o_w_in, OIN, 0, 1600, 1024, W1T, tile);
    for (size_t i = (size_t)blockIdx.x * 512 + threadIdx.x; i < (size_t)192 * 1024; i += (size_t)gridDim.x * 512) W1T[(size_t)1600 * 1024 + i] = 0;
    tconv(p.o_w_in, OIN, 1604, 1024, 1024, W1T + (size_t)1792 * 1024, tile);
    {
        bf16_t* WUKP = (bf16_t*)(ws + OFF_WUKP); bf16_t* WQP = (bf16_t*)(ws + OFF_WQP);
        for (size_t i = (size_t)blockIdx.x * 512 + threadIdx.x; i < (size_t)1024 * 256; i += (size_t)gridDim.x * 512) {
            { const int n = (int)(i >> 8), k = (int)(i & 255), pn = n >> 8, rem = n & 255, bj = rem >> 7, wc = (rem >> 5) & 3, x = rem & 31;
              WUKP[i] = f2bf(p.o_w_uk[(size_t)k * 1024 + (4 * pn + wc) * 64 + 32 * bj + x]); }
            { const int d = (int)(i & 63), r = (int)((i >> 6) & 255), h = (int)(i >> 14);
              WQP[i] = f2bf(p.o_w_uk[(size_t)r * 1024 + h * 64 + d] * p.o_g_k[d] * 0.125f); }
        }
    }
    tconv(p.o_w_uv, 1024, 0, 1024, 256, (bf16_t*)(ws + OFF_WUVT), tile);
    tconv(p.o_w_out, 1024, 0, 1024, 1024, (bf16_t*)(ws + OFF_WO1T), tile);
    rmsnorm_rows<8>(p.x, p.e_norm, (bf16_t*)(ws + OFF_XN), p.e_w_in, EIN, 5120, p.e_b_if, 1.0f, (float*)(ws + OFF_GATES));
}

__device__ __forceinline__ void phase_conv_scan(const P& p, unsigned char* lds) {
    unsigned char* ws = p.ws; const int tid = threadIdx.x;
    const float* GATES = (const float*)(ws + OFF_GATES);
    float *BQ = (float*)(ws + OFF_BQ), *IQ = (float*)(ws + OFF_IQ), *MT = (float*)(ws + OFF_MT), *CH = (float*)(ws + OFF_CH);
    for (int bh = blockIdx.x; bh < 8; bh += gridDim.x) {
        float* sB = (float*)lds; float* sG = sB + 256; float* sMp = sG + 256; float* sMn = sMp + 256;
        const int batch = bh >> 2, head = bh & 3;
        if (tid < 256) {
            const size_t t0 = (size_t)batch * SEQ + tid * 64; float b = 0.f, rmax = -INFINITY;
            for (int s = 0; s < 64; ++s) { const size_t t = t0 + s; const float ig = GATES[t * 8 + head], f = GATES[t * 8 + 4 + head];
                const float ls = fminf(f, 0.f) - log1pf(__expf(-fabsf(f)));
                b += ls; BQ[t * 4 + head] = b; IQ[t * 4 + head] = ig; rmax = fmaxf(rmax, ig - b); MT[t * 4 + head] = rmax; }
            sB[tid] = b; sG[tid] = b + rmax;
        }
        __syncthreads();
        if (tid == 0) { float m = 0.f; for (int c = 0; c < 256; ++c) { sMp[c] = m; m = fmaxf(sB[c] + m, sG[c]); sMn[c] = m; } }
        __syncthreads();
        if (tid < 256) {
            const float mp = sMp[tid]; CH[bh * 256 + tid] = mp; CH[2048 + bh * 256 + tid] = sMn[tid]; CH[4096 + bh * 256 + tid] = sB[tid];
            const size_t t0 = (size_t)batch * SEQ + tid * 64;
            for (int s = 0; s < 64; ++s) { const size_t t = t0 + s; MT[t * 4 + head] = BQ[t * 4 + head] + fmaxf(mp, MT[t * 4 + head]); }
        }
        __syncthreads();
    }
    const bf16_t* QB = (const bf16_t*)(ws + OFF_QB); const bf16_t* KB = (const bf16_t*)(ws + OFF_KB);
    bf16_t* Y = (bf16_t*)(ws + OFF_Y); bf16_t* KT = (bf16_t*)(ws + OFF_TMP);
    for (size_t it = (size_t)blockIdx.x * 512 + tid; it < (size_t)T * 256; it += (size_t)gridDim.x * 512) {
        const size_t t = it >> 8; const int c0 = (int)(it & 255) * 8, isk = c0 >= 1024, cc = c0 & 1023; const int s = (int)(t & (SEQ - 1));
        const bf16_t* src = isk ? KB : QB;
        float acc[8];
#pragma unroll
        for (int i = 0; i < 8; ++i) acc[i] = 0.f;
#pragma unroll
        for (int j = 0; j < 4; ++j) {
            if (s - 3 + j >= 0) {
                const u32x4 w = *(const u32x4*)(src + (t - 3 + j) * 1024 + cc);
                const f32x4 c0v = *(const f32x4*)(p.e_conv + j * 2048 + c0), c1v = *(const f32x4*)(p.e_conv + j * 2048 + c0 + 4);
                acc[0] += c0v[0] * bflo(w.x); acc[1] += c0v[1] * bfhi(w.x); acc[2] += c0v[2] * bflo(w.y); acc[3] += c0v[3] * bfhi(w.y);
                acc[4] += c1v[0] * bflo(w.z); acc[5] += c1v[1] * bfhi(w.z); acc[6] += c1v[2] * bflo(w.w); acc[7] += c1v[3] * bfhi(w.w);
            }
        }
        const float sc = isk ? 0.0625f : 1.0f;
        u32x4 o; o.x = pk2(siluf_(acc[0]) * sc, siluf_(acc[1]) * sc); o.y = pk2(siluf_(acc[2]) * sc, siluf_(acc[3]) * sc);
        o.z = pk2(siluf_(acc[4]) * sc, siluf_(acc[5]) * sc); o.w = pk2(siluf_(acc[6]) * sc, siluf_(acc[7]) * sc);
        if (isk) *(u32x4*)(KT + t * 1024 + cc) = o; else *(u32x4*)(Y + t * 2048 + 1024 + cc) = o;
    }
}

typedef float f32x16 __attribute__((ext_vector_type(16)));
constexpr int ML_RS = 528, ML_WS = 144;
__device__ __forceinline__ bf16x8 ml_tr8(const LAS unsigned char* a, int second_off) {
    const v4i16_t t0 = __builtin_amdgcn_ds_read_tr16_b64_v4i16((LAS v4i16_t*)a);
    const v4i16_t t1 = __builtin_amdgcn_ds_read_tr16_b64_v4i16((LAS v4i16_t*)(a + second_off));
    bf16x8 r; r[0] = t0[0]; r[1] = t0[1]; r[2] = t0[2]; r[3] = t0[3]; r[4] = t1[0]; r[5] = t1[1]; r[6] = t1[2]; r[7] = t1[3]; return r;
}
template <bool FULL>
__device__ __forceinline__ void mlstm_units(const P& p, unsigned char* lds_) {
    unsigned char* ws = p.ws; const int tid0 = threadIdx.x;
    const int w = __builtin_amdgcn_readfirstlane(tid0 >> 6);
    const bf16_t* Yq = (const bf16_t*)(ws + OFF_Y); bf16_t* Yo = (bf16_t*)(ws + OFF_Y);
    const bf16_t* KT = (const bf16_t*)(ws + OFF_TMP); const bf16_t* VB = (const bf16_t*)(ws + OFF_VB);
    float* ST = (float*)(ws + OFF_QB); float* NS = (float*)(ws + OFF_NS);
    const float *BQ = (const float*)(ws + OFF_BQ), *IQ = (const float*)(ws + OFF_IQ), *MT = (const float*)(ws + OFF_MT), *CH = (const float*)(ws + OFF_CH);
    LAS unsigned char* Qs = (LAS unsigned char*)lds_;
    LAS unsigned char* Ks = Qs + 64 * ML_RS;
    LAS unsigned char* Vs = Ks + 64 * ML_RS;
    LAS unsigned char* Wl = Vs + 64 * ML_RS;
    LAS float* sa = (LAS float*)(Wl + 64 * ML_WS);
    LAS float* sden = sa + 64; LAS float* ssw = sden + 64; LAS float* sf = ssw + 64; LAS float* sg = sf + 64; LAS float* nd = sg + 64; LAS float* rden = nd + 64; LAS float* ns = rden + 64;
    for (int unit = blockIdx.x; unit < 256; unit += gridDim.x) {
        const int bh = unit >> 5, S = unit & 31, batch = bh >> 2, head = bh & 3;
        const int tid = tid0, lane = tid0 & 63, hh = lane >> 5;
        f32x16 st[8]; float nreg = 0.f;
        if (FULL) {
#pragma unroll
            for (int kt = 0; kt < 8; ++kt) {
                int lz = lane; asm volatile("" : "+v"(lz) :: "memory");
                const float* sp = ST + (size_t)unit * 65536 + 32 * w + (lz & 31) + (size_t)(32 * kt + 4 * (lz >> 5)) * 256;
#pragma unroll
                for (int r = 0; r < 16; ++r) st[kt][r] = sp[((r & 3) + 8 * (r >> 2)) * 256];
            }
            if (tid < 256) nreg = NS[unit * 256 + tid];
        } else {
#pragma unroll
            for (int kt = 0; kt < 8; ++kt)
#pragma unroll
                for (int r = 0; r < 16; ++r) st[kt][r] = 0.f;
        }
#pragma unroll 1
        for (int cc = 0; cc < 8; ++cc) {
            int tid = tid0; asm volatile("" : "+v"(tid));
            const int lane = tid & 63, l31 = lane & 31, hh = lane >> 5, fr = lane & 15, fq = lane >> 4;
            const int trow = 8 * hh + (fr >> 2), tcol = (16 * (fq & 1) + 4 * (fr & 3)) * 2;
            const int ch = S * 8 + cc; const size_t t0 = (size_t)batch * SEQ + ch * 64;
            const float mprev = CH[bh * 256 + ch], mnew = CH[2048 + bh * 256 + ch], blast = CH[4096 + bh * 256 + ch];
            const float decay = __expf(blast + mprev - mnew);
            __syncthreads();
#pragma unroll
            for (int j = 0; j < 4; ++j) { const int e = tid + 512 * j, r = e >> 5, cg = e & 31;
                *(LAS u32x4*)(Ks + r * ML_RS + cg * 16) = *(const u32x4*)(KT + (t0 + r) * 1024 + head * 256 + cg * 8);
                *(LAS u32x4*)(Vs + r * ML_RS + cg * 16) = *(const u32x4*)(VB + (t0 + r) * 1024 + head * 256 + cg * 8);
                if (FULL) *(LAS u32x4*)(Qs + r * ML_RS + cg * 16) = *(const u32x4*)(Yq + (t0 + r) * 2048 + 1024 + head * 256 + cg * 8); }
            if (tid < 64) { const float bq = BQ[(t0 + tid) * 4 + head], iq = IQ[(t0 + tid) * 4 + head], mt = MT[(t0 + tid) * 4 + head];
                sa[tid] = __expf(bq + mprev - mt); sden[tid] = __expf(-mt); ssw[tid] = __expf(blast - bq + iq - mnew); sf[tid] = bq - mt; sg[tid] = iq - bq; }
            if (FULL && tid < 256) ns[tid] = nreg;
            __syncthreads();
            bf16x8 bv[4];
            if (!FULL) {
#pragma unroll
                for (int ks = 0; ks < 4; ++ks) bv[ks] = ml_tr8(Vs + (16 * ks + trow) * ML_RS + 64 * w + tcol, 4 * ML_RS);
            }
            if (FULL) {
                { const int tt = w >> 1;
#pragma unroll
                  for (int si = 0; si < 2; ++si) { const int ss = 2 * (w & 1) + si;
                    f32x4 acc = (f32x4){0.f, 0.f, 0.f, 0.f};
                    if (ss <= tt) {
#pragma unroll
                        for (int ks = 0; ks < 8; ++ks) { const bf16x8 a = *(const LAS bf16x8*)(Qs + (16 * tt + fr) * ML_RS + (32 * ks + 8 * fq) * 2), b = *(const LAS bf16x8*)(Ks + (16 * ss + fr) * ML_RS + (32 * ks + 8 * fq) * 2);
                            acc = __builtin_amdgcn_mfma_f32_16x16x32_bf16(a, b, acc, 0, 0, 0); } }
                    const int sidx = 16 * ss + fr; const float gs = sg[sidx];
#pragma unroll
                    for (int j = 0; j < 4; ++j) { const int tix = 16 * tt + 4 * fq + j; const float wv = (sidx <= tix) ? __expf(sf[tix] + gs) * acc[j] : 0.f;
                        *(LAS bf16_t*)(Wl + tix * ML_WS + sidx * 2) = f2bf(wv); } } }
#pragma unroll
                for (int i = 0; i < 8; ++i) { const int tix = 8 * w + i; const u32x2 qv = *(const LAS u32x2*)(Qs + tix * ML_RS + lane * 8); const f32x4 nv = *(const LAS f32x4*)(ns + lane * 4);
                    float part = bflo(qv.x) * nv[0] + bfhi(qv.x) * nv[1] + bflo(qv.y) * nv[2] + bfhi(qv.y) * nv[3]; part = wave_sum(part); if (lane == 0) nd[tix] = part; }
                __syncthreads();
                f32x16 acc[2];
#pragma unroll
                for (int t2 = 0; t2 < 2; ++t2) {
#pragma unroll
                    for (int r = 0; r < 16; ++r) acc[t2][r] = 0.f;
                }
#pragma unroll
                for (int kt = 0; kt < 8; ++kt) {
                    asm volatile("" ::: "memory");
#pragma unroll
                    for (int s2 = 0; s2 < 2; ++s2) {
                        u32x4 bw; bw.x = pg8::cvt_pk_bf16(st[kt][8 * s2 + 0], st[kt][8 * s2 + 1]); bw.y = pg8::cvt_pk_bf16(st[kt][8 * s2 + 2], st[kt][8 * s2 + 3]);
                        bw.z = pg8::cvt_pk_bf16(st[kt][8 * s2 + 4], st[kt][8 * s2 + 5]); bw.w = pg8::cvt_pk_bf16(st[kt][8 * s2 + 6], st[kt][8 * s2 + 7]);
                        const bf16x8 bfrag = __builtin_bit_cast(bf16x8, bw);
#pragma unroll
                        for (int t2 = 0; t2 < 2; ++t2) { const LAS unsigned char* qa = Qs + (32 * t2 + l31) * ML_RS + (32 * kt + 16 * s2 + 4 * hh) * 2;
                            const u32x2 lo = *(const LAS u32x2*)qa, hi = *(const LAS u32x2*)(qa + 16); u32x4 aw; aw.x = lo.x; aw.y = lo.y; aw.z = hi.x; aw.w = hi.y;
                            acc[t2] = __builtin_amdgcn_mfma_f32_32x32x16_bf16(__builtin_bit_cast(bf16x8, aw), bfrag, acc[t2], 0, 0, 0); }
                    }
                }
                asm volatile("" ::: "memory");
#pragma unroll
                for (int t2 = 0; t2 < 2; ++t2)
#pragma unroll
                    for (int r = 0; r < 16; ++r) acc[t2][r] *= sa[32 * t2 + (r & 3) + 8 * (r >> 2) + 4 * hh];
#pragma unroll
                for (int ks = 0; ks < 4; ++ks) bv[ks] = ml_tr8(Vs + (16 * ks + trow) * ML_RS + 64 * w + tcol, 4 * ML_RS);
#pragma unroll
                for (int ks = 0; ks < 4; ++ks)
#pragma unroll
                    for (int t2 = 0; t2 < 2; ++t2) { const bf16x8 a = *(const LAS bf16x8*)(Wl + (32 * t2 + l31) * ML_WS + (16 * ks + 8 * hh) * 2);
                        acc[t2] = __builtin_amdgcn_mfma_f32_32x32x16_bf16(a, bv[ks], acc[t2], 0, 0, 0); }
#pragma unroll
                for (int i = 0; i < 8; ++i) { const int tix = 8 * w + i; float rs = bf2f(*(const LAS bf16_t*)(Wl + tix * ML_WS + lane * 2)); rs = wave_sum(rs);
                    if (lane == 0) { const float nq = sa[tix] * nd[tix] + rs; rden[tix] = 1.0f / fmaxf(fabsf(nq), sden[tix]); } }
                __syncthreads();
                bf16_t* yo = Yo + t0 * 2048 + head * 256 + 32 * w + l31;
#pragma unroll
                for (int t2 = 0; t2 < 2; ++t2)
#pragma unroll
                    for (int r = 0; r < 16; ++r) { const int tix = 32 * t2 + (r & 3) + 8 * (r >> 2) + 4 * hh; yo[(size_t)tix * 2048] = f2bf(acc[t2][r] * rden[tix]); }
            }
#pragma unroll
            for (int kt = 0; kt < 8; ++kt) st[kt] *= decay;
#pragma unroll
            for (int ks = 0; ks < 4; ++ks) {
                const u32x4 raw = __builtin_bit_cast(u32x4, bv[ks]); const LAS float* sw8 = ssw + 16 * ks + 8 * hh;
                u32x4 sc; sc.x = pg8::cvt_pk_bf16(bflo(raw.x) * sw8[0], bfhi(raw.x) * sw8[1]); sc.y = pg8::cvt_pk_bf16(bflo(raw.y) * sw8[2], bfhi(raw.y) * sw8[3]);
                sc.z = pg8::cvt_pk_bf16(bflo(raw.z) * sw8[4], bfhi(raw.z) * sw8[5]); sc.w = pg8::cvt_pk_bf16(bflo(raw.w) * sw8[6], bfhi(raw.w) * sw8[7]);
                const bf16x8 bs = __builtin_bit_cast(bf16x8, sc);
#pragma unroll
                for (int kt = 0; kt < 8; ++kt) { if ((kt & 3) == 0) asm volatile("" ::: "memory");
                    const bf16x8 a = ml_tr8(Ks + (16 * ks + trow) * ML_RS + 64 * kt + tcol, 4 * ML_RS);
                    st[kt] = __builtin_amdgcn_mfma_f32_32x32x16_bf16(a, bs, st[kt], 0, 0, 0); }
            }
            if (tid < 256) { float nacc = 0.f;
#pragma unroll 8
                for (int s2 = 0; s2 < 64; ++s2) nacc += ssw[s2] * bf2f(*(const LAS bf16_t*)(Ks + s2 * ML_RS + tid * 2));
                nreg = decay * nreg + nacc; }
        }
        if (!FULL) {
#pragma unroll
            for (int kt = 0; kt < 8; ++kt) {
                int lz = lane; asm volatile("" : "+v"(lz) :: "memory");
                float* sp = ST + (size_t)unit * 65536 + 32 * w + (lz & 31) + (size_t)(32 * kt + 4 * (lz >> 5)) * 256;
#pragma unroll
                for (int r = 0; r < 16; ++r) sp[((r & 3) + 8 * (r >> 2)) * 256] = st[kt][r];
            }
            if (tid < 256) NS[unit * 256 + tid] = nreg;
        }
    }
}
__device__ __forceinline__ void phase_mlstm_scan(const P& p, unsigned char* lds_) {
    unsigned char* ws = p.ws; const int tid = threadIdx.x;
    float* ST = (float*)(ws + OFF_QB); float* NS = (float*)(ws + OFF_NS); const float* CH = (const float*)(ws + OFF_CH);
    float* DS = (float*)lds_;
    if (tid < 256) { const int bh = tid >> 5, S = tid & 31; float e = 0.f;
        for (int c = 0; c < 8; ++c) { const int ch = S * 8 + c; e += CH[4096 + bh * 256 + ch] + CH[bh * 256 + ch] - CH[2048 + bh * 256 + ch]; }
        float d = 1.f; for (int c = 0; c < 8; ++c) { const int ch = S * 8 + c; d *= __expf(CH[4096 + bh * 256 + ch] + CH[bh * 256 + ch] - CH[2048 + bh * 256 + ch]); }
        (void)e; DS[tid] = d; }
    __syncthreads();
    const int per = 65536 + 256;
    for (int it = blockIdx.x * 512 + tid; it < 8 * per; it += gridDim.x * 512) {
        const int bh = it / per, e = it - bh * per;
        float* base; size_t stride;
        if (e < 65536) { base = ST + (size_t)bh * 32 * 65536 + e; stride = 65536; } else { base = NS + (size_t)bh * 32 * 256 + (e - 65536); stride = 256; }
        float carry = 0.f;
#pragma unroll 8
        for (int S = 0; S < 32; ++S) { const float tmp = base[S * stride]; base[S * stride] = carry; carry = DS[bh * 32 + S] * carry + tmp; }
    }
}

__device__ __forceinline__ void phase_ya_pool(const P& p) {
    unsigned char* ws = p.ws; const int tid = threadIdx.x, lane = tid & 63, wave = tid >> 6;
    bf16_t* Y = (bf16_t*)(ws + OFF_Y); const bf16_t* O = (const bf16_t*)(ws + OFF_QB); const bf16_t* ZA = (const bf16_t*)(ws + OFF_KB);
    for (int it = blockIdx.x * 8 + wave; it < T * 4; it += gridDim.x * 8) {
        const size_t t = (size_t)(it >> 2); const int head = it & 3, c = head * 256 + lane * 4;
        const u32x2 hw = *(const u32x2*)(Y + t * 2048 + c), ow = *(const u32x2*)(O + t * 1024 + c), zw = *(const u32x2*)(ZA + t * 1024 + c);
        float v[4] = {bflo(hw.x) * bflo(ow.x), bfhi(hw.x) * bfhi(ow.x), bflo(hw.y) * bflo(ow.y), bfhi(hw.y) * bfhi(ow.y)};
        float ss = wave_sum(v[0] * v[0] + v[1] * v[1] + v[2] * v[2] + v[3] * v[3]);
        const float rstd = rsqrtf(ss * (1.0f / 256.0f) + EPS);
        const f32x4 g = *(const f32x4*)(p.e_g_head + c);
        u32x2 o; o.x = pk2(v[0] * rstd * g[0] * bflo(zw.x), v[1] * rstd * g[1] * bfhi(zw.x)); o.y = pk2(v[2] * rstd * g[2] * bflo(zw.y), v[3] * rstd * g[3] * bfhi(zw.y));
        *(u32x2*)(Y + t * 2048 + c) = o;
    }
    const bf16_t* U = (const bf16_t*)(ws + OFF_VB);
    for (size_t it = (size_t)blockIdx.x * 512 + tid; it < (size_t)T * 128; it += (size_t)gridDim.x * 512) {
        const size_t t = it >> 7; const int c0 = (int)(it & 127) * 8, g = c0 >> 8, win = 2 << g, s = (int)(t & (SEQ - 1)); const int cnt = (s + 1 < win) ? s + 1 : win;
        float acc[8], self[8];
#pragma unroll
        for (int i = 0; i < 8; ++i) { acc[i] = 0.f; self[i] = 0.f; }
        for (int j = 0; j < cnt; ++j) { const u32x4 w = *(const u32x4*)(U + (t - j) * 1024 + c0);
            const float f[8] = {bflo(w.x), bfhi(w.x), bflo(w.y), bfhi(w.y), bflo(w.z), bfhi(w.z), bflo(w.w), bfhi(w.w)};
#pragma unroll
            for (int i = 0; i < 8; ++i) { acc[i] += f[i]; if (j == 0) self[i] = f[i]; } }
        const float inv = 1.0f / (float)cnt;
        bf16_t* yp = Y + t * 2048 + 1024 + c0; const u32x4 z = *(const u32x4*)yp;
        const float zf[8] = {bflo(z.x), bfhi(z.x), bflo(z.y), bfhi(z.y), bflo(z.z), bfhi(z.z), bflo(z.w), bfhi(z.w)};
        const f32x4 s0 = *(const f32x4*)(p.e_s_pool + c0), s1 = *(const f32x4*)(p.e_s_pool + c0 + 4);
        float o[8];
#pragma unroll
        for (int i = 0; i < 8; ++i) o[i] = (acc[i] * inv - self[i]) * (i < 4 ? s0[i] : s1[i - 4]) * zf[i];
        u32x4 ow; ow.x = pk2(o[0], o[1]); ow.y = pk2(o[2], o[3]); ow.z = pk2(o[4], o[5]); ow.w = pk2(o[6], o[7]);
        *(u32x4*)yp = ow;
    }
}

__device__ __forceinline__ void headnorm64(bf16_t* X, const float* g) {
    const int lane = threadIdx.x & 63, wave = threadIdx.x >> 6;
    for (int t = blockIdx.x * 8 + wave; t < T; t += gridDim.x * 8) {
        bf16_t* r = X + (size_t)t * 1024 + lane * 16;
        const u32x4 a = *(const u32x4*)r, b = *(const u32x4*)(r + 8);
        float f[16] = {bflo(a.x), bfhi(a.x), bflo(a.y), bfhi(a.y), bflo(a.z), bfhi(a.z), bflo(a.w), bfhi(a.w), bflo(b.x), bfhi(b.x), bflo(b.y), bfhi(b.y), bflo(b.z), bfhi(b.z), bflo(b.w), bfhi(b.w)};
        float ss = 0.f;
#pragma unroll
        for (int i = 0; i < 16; ++i) ss += f[i] * f[i];
        ss += __shfl_xor(ss, 1); ss += __shfl_xor(ss, 2);
        const float rstd = rsqrtf(ss * (1.0f / 64.0f) + EPS);
        const float* gg = g + (lane & 3) * 16;
#pragma unroll
        for (int i = 0; i < 16; ++i) f[i] = f[i] * rstd * gg[i];
        u32x4 oa, ob; oa.x = pk2(f[0], f[1]); oa.y = pk2(f[2], f[3]); oa.z = pk2(f[4], f[5]); oa.w = pk2(f[6], f[7]);
        ob.x = pk2(f[8], f[9]); ob.y = pk2(f[10], f[11]); ob.z = pk2(f[12], f[13]); ob.w = pk2(f[14], f[15]);
        *(u32x4*)r = oa; *(u32x4*)(r + 8) = ob;
    }
}
__device__ __forceinline__ void phase_qnorm_ckvnorm(const P& p) {
    unsigned char* ws = p.ws; const int lane = threadIdx.x & 63, wave = threadIdx.x >> 6;
    headnorm64((bf16_t*)(ws + OFF_TMP), p.o_g_q);
    bf16_t* CKVN = (bf16_t*)(ws + OFF_CKVN);
    for (int t = blockIdx.x * 8 + wave; t < T; t += gridDim.x * 8) {
        const u32x2 w = *(const u32x2*)(CKVN + (size_t)t * 256 + lane * 4);
        const float v[4] = {bflo(w.x), bfhi(w.x), bflo(w.y), bfhi(w.y)};
        const float ss = wave_sum(v[0] * v[0] + v[1] * v[1] + v[2] * v[2] + v[3] * v[3]);
        const float rstd = rsqrtf(ss * (1.0f / 256.0f) + EPS);
        const f32x4 g = *(const f32x4*)(p.o_g_kv + lane * 4);
        u32x2 o; o.x = pk2(v[0] * rstd * g[0], v[1] * rstd * g[1]); o.y = pk2(v[2] * rstd * g[2], v[3] * rstd * g[3]);
        *(u32x2*)(CKVN + (size_t)t * 256 + lane * 4) = o;
    }
}

__device__ __forceinline__ unsigned okey(float s) { if (s == 0.f) s = 0.f; const unsigned u = __float_as_uint(s); return (u & 0x80000000u) ? ~u : (u | 0x80000000u); }

__device__ __forceinline__ void indexer_slow_query(const P& p, unsigned char* lds, size_t t) {
    unsigned char* ws = p.ws; const int tid = threadIdx.x, lane = tid & 63, wave = tid >> 6;
    const _Float16* QI = (const _Float16*)(ws + OFF_QI); const _Float16* KI = (const _Float16*)(ws + OFF_KI); const float* WI = (const float*)(ws + OFF_WI);
    unsigned short* IDX = (unsigned short*)(ws + OFF_IDX);
    unsigned* sc = (unsigned*)lds; unsigned* hist = sc + 16384; float* qs = (float*)(hist + 256); unsigned* misc = (unsigned*)(qs + 256); unsigned* wsum = misc + 16;
    const int batch = (int)(t >> 14), pos = (int)(t & (SEQ - 1)), n = pos + 1;
    __syncthreads();
    if (tid < 256) qs[tid] = (float)QI[t * 256 + tid];
    const float w0 = WI[t * 4 + 0], w1 = WI[t * 4 + 1], w2 = WI[t * 4 + 2], w3 = WI[t * 4 + 3];
    __syncthreads();
    const _Float16* kbase = KI + (size_t)batch * SEQ * 64;
    for (int s = tid; s < n; s += 512) {
        asm volatile("" ::: "memory");
        typedef _Float16 h8 __attribute__((ext_vector_type(8)));
        const h8* kr = (const h8*)(kbase + (size_t)s * 64);
        float d0 = 0.f, d1 = 0.f, d2 = 0.f, d3 = 0.f;
#pragma unroll
        for (int j = 0; j < 8; ++j) { const h8 kv = kr[j];
#pragma unroll
            for (int e = 0; e < 8; ++e) { const int d = j * 8 + e; const float kf = (float)kv[e]; d0 += qs[d] * kf; d1 += qs[64 + d] * kf; d2 += qs[128 + d] * kf; d3 += qs[192 + d] * kf; } }
        float score = w0 * fmaxf(d0, 0.f); score = fmaf(w1, fmaxf(d1, 0.f), score); score = fmaf(w2, fmaxf(d2, 0.f), score); score = fmaf(w3, fmaxf(d3, 0.f), score);
        if (fabsf(score) < 1e-30f) score = 0.f;
        sc[s] = okey(score);
    }
    unsigned prefix = 0, krem = 256;
    for (int pass = 0; pass < 4; ++pass) {
        const int shift = 24 - 8 * pass;
        __syncthreads();
        if (tid < 256) hist[tid] = 0;
        __syncthreads();
        for (int s = tid; s < n; s += 512) { const unsigned k = sc[s]; if (pass == 0 || (k >> (shift + 8)) == prefix) atomicAdd(&hist[(k >> shift) & 255u], 1u); }
        __syncthreads();
        if (tid == 0) { unsigned cum = 0; int bin = 255; for (; bin > 0; --bin) { const unsigned c = hist[bin]; if (cum + c >= krem) break; cum += c; } misc[0] = (unsigned)bin; misc[1] = krem - cum; }
        __syncthreads();
        prefix = (prefix << 8) | misc[0]; krem = misc[1];
    }
    const unsigned ngt_total = 256u - krem;
    unsigned lg = 0, le = 0; const int s0 = tid * 32;
    for (int s = s0; s < s0 + 32 && s < n; ++s) { const unsigned k = sc[s]; lg += (k > prefix); le += (k == prefix); }
    unsigned pk = lg | (le << 16), incl = pk;
#pragma unroll
    for (int o = 1; o < 64; o <<= 1) { const unsigned y = __shfl_up(incl, o); if (lane >= o) incl += y; }
    if (lane == 63) wsum[wave] = incl;
    __syncthreads();
    unsigned base = 0;
    for (int w = 0; w < wave; ++w) base += wsum[w];
    const unsigned excl = base + incl - pk; unsigned bg = excl & 0xffffu, be = excl >> 16;
    for (int s = s0; s < s0 + 32 && s < n; ++s) { const unsigned k = sc[s];
        if (k > prefix) { IDX[t * 256 + bg] = (unsigned short)s; ++bg; }
        else if (k == prefix) { if (be < krem) IDX[t * 256 + ngt_total + be] = (unsigned short)s; ++be; } }
    __syncthreads();
}

typedef _Float16 half8 __attribute__((ext_vector_type(8)));
constexpr int IX_CAP = 1024, IX_ZBIN = 1024;
__device__ __forceinline__ unsigned ix_key(const f32x4 a, const f32x4 w) {
    float s = w[0] * fmaxf(a[0], 0.f); s = fmaf(w[1], fmaxf(a[1], 0.f), s); s = fmaf(w[2], fmaxf(a[2], 0.f), s); s = fmaf(w[3], fmaxf(a[3], 0.f), s);
    if (fabsf(s) < 1e-30f) s = 0.f;
    return okey(s);
}
#define LDS_ADD(ptr, v) __hip_atomic_fetch_add((ptr), (v), __ATOMIC_RELAXED, __HIP_MEMORY_SCOPE_WORKGROUP)
__device__ __forceinline__ void phase_indexer(const P& p, unsigned char* lds) {
    unsigned char* ws = p.ws; const int tid = threadIdx.x, lane = tid & 63, kl = lane & 15, g = lane >> 4;
    const int wave = __builtin_amdgcn_readfirstlane(tid >> 6);
    const _Float16* QI = (const _Float16*)(ws + OFF_QI); const _Float16* KI = (const _Float16*)(ws + OFF_KI); const float* WI = (const float*)(ws + OFF_WI);
    unsigned short* IDX = (unsigned short*)(ws + OFF_IDX); int* CNT = (int*)(ws + OFF_CNT);
    LAS unsigned* hist = (LAS unsigned*)lds;
    LAS unsigned* zc = hist + 16 * 2048;
    LAS unsigned* zpre = zc + 128;
    LAS int* qTbin = (LAS int*)(zpre + 128);
    LAS int* qCab = qTbin + 16; LAS int* qCb = qCab + 16; LAS unsigned* qNgt = (LAS unsigned*)(qCb + 16); LAS unsigned* qNcand = qNgt + 16; LAS int* qOvf = (LAS int*)(qNcand + 16);
    LAS unsigned* ovl = (LAS unsigned*)(lds + 136 * 1024);
    if (tid == 0) ovl[0] = 0u;
    const int G = gridDim.x, nround = (T / 16) / G;
#pragma unroll 1
    for (int i = 0; i < nround; ++i) {
        const int tix = (i & 1) ? i * G + (G - 1 - (int)blockIdx.x) : i * G + (int)blockIdx.x;
        const int batch = tix & 1, tb = tix >> 1, p0 = tb * 16; const size_t t0 = (size_t)batch * SEQ + p0;
        __syncthreads();
        if (p0 + 16 <= 256) {
#pragma unroll
            for (int j = 0; j < 8; ++j) { const int e = tid + 512 * j, q = e >> 8, jj = e & 255; IDX[(t0 + q) * 256 + jj] = (unsigned short)(jj <= p0 + q ? jj : 0); }
            if (tid < 16) CNT[t0 + tid] = p0 + tid + 1;
            continue;
        }
#pragma unroll
        for (int j = 0; j < 16; ++j) ((LAS u32x4*)hist)[tid + 512 * j] = (u32x4){0u, 0u, 0u, 0u};
        if (tid < 256) zc[tid] = 0u;
        if (tid < 16) { qNgt[tid] = 0u; qNcand[tid] = 0u; qOvf[tid] = 0; }
        half8 af[4][2]; f32x4 wv[4];
#pragma unroll
        for (int rt = 0; rt < 4; ++rt) {
#pragma unroll
            for (int ks = 0; ks < 2; ++ks) af[rt][ks] = *(const half8*)(QI + (t0 + 4 * rt + (kl >> 2)) * 256 + (kl & 3) * 64 + 32 * ks + 8 * g);
            wv[rt] = *(const f32x4*)(WI + (t0 + 4 * rt + g) * 4);
        }
        __syncthreads();
        const int nblk = tb + 1, L = (nblk + 7) >> 3, b0 = wave * L, b1 = (b0 + L < nblk) ? b0 + L : nblk;
        const _Float16* kb = KI + (size_t)batch * SEQ * 64 + kl * 64 + 8 * g;
#pragma unroll 1
        for (int b = b0; b < b1; ++b) {
            const int s = b * 16 + kl;
            const half8 k0 = *(const half8*)(kb + (size_t)b * 1024), k1 = *(const half8*)(kb + (size_t)b * 1024 + 32);
#pragma unroll
            for (int rt = 0; rt < 4; ++rt) {
                f32x4 acc = __builtin_amdgcn_mfma_f32_16x16x32_f16(af[rt][0], k0, (f32x4){0.f, 0.f, 0.f, 0.f}, 0, 0, 0);
                acc = __builtin_amdgcn_mfma_f32_16x16x32_f16(af[rt][1], k1, acc, 0, 0, 0);
                const unsigned key = ix_key(acc, wv[rt]); const int q = 4 * rt + g;
                if (s <= p0 + q) { LDS_ADD(hist + q * 2048 + (key >> 21), 1u); if (key == 0x80000000u) LDS_ADD(zc + q * 8 + wave, 1u); }
            }
        }
        __syncthreads();
#pragma unroll 1
        for (int qq = 0; qq < 2; ++qq) {
            const int q = 2 * wave + qq; const LAS unsigned* h = hist + q * 2048;
            unsigned cs = 0; const int top = 2047 - 32 * lane;
            for (int ii = 0; ii < 32; ++ii) cs += h[top - ((ii + lane) & 31)];
            unsigned incl = cs;
#pragma unroll
            for (int o = 1; o < 64; o <<= 1) { const unsigned y = __shfl_up(incl, o); if (lane >= o) incl += y; }
            const unsigned long long m = __ballot(incl >= 256u);
            const int Ls = m ? (__ffsll((long long)m) - 1) : 63;
            unsigned cabv = __shfl(incl - cs, Ls), cbv = 0; int tbin = 0; bool found = false;
            for (int ii = 0; ii < 32; ++ii) { const unsigned c = h[2047 - 32 * Ls - ii]; if (!found && cabv + c >= 256u) { tbin = 2047 - 32 * Ls - ii; cbv = c; found = true; } if (!found) cabv += c; }
            if (lane == 0) { qTbin[q] = tbin; qCab[q] = (int)cabv; qCb[q] = (int)cbv; if (tbin != IX_ZBIN && cbv > (unsigned)IX_CAP) qOvf[q] = 1; }
            { unsigned v = lane < 8 ? zc[q * 8 + lane] : 0u, inc = v;
#pragma unroll
              for (int o = 1; o < 8; o <<= 1) { const unsigned y = __shfl_up(inc, o); if (lane >= o) inc += y; }
              if (lane < 8) zpre[q * 8 + lane] = inc - v; }
        }
        __syncthreads();
        int tbn[4], cab[4], rr[4]; unsigned zrun[4];
#pragma unroll
        for (int rt = 0; rt < 4; ++rt) { const int q = 4 * rt + g; tbn[rt] = qOvf[q] ? 4096 : qTbin[q]; cab[rt] = qCab[q]; rr[rt] = 256 - cab[rt]; zrun[rt] = zpre[q * 8 + wave]; }
#pragma unroll 1
        for (int b = b0; b < b1; ++b) {
            const int s = b * 16 + kl;
            const half8 k0 = *(const half8*)(kb + (size_t)b * 1024), k1 = *(const half8*)(kb + (size_t)b * 1024 + 32);
#pragma unroll
            for (int rt = 0; rt < 4; ++rt) {
                f32x4 acc = __builtin_amdgcn_mfma_f32_16x16x32_f16(af[rt][0], k0, (f32x4){0.f, 0.f, 0.f, 0.f}, 0, 0, 0);
                acc = __builtin_amdgcn_mfma_f32_16x16x32_f16(af[rt][1], k1, acc, 0, 0, 0);
                const unsigned key = ix_key(acc, wv[rt]); const int q = 4 * rt + g; const int bin = (int)(key >> 21);
                const bool valid = s <= p0 + q;
                const bool inb = valid && bin == tbn[rt];
                const bool zt = inb && tbn[rt] == IX_ZBIN;
                const unsigned long long zm = __ballot(zt);
                const unsigned gm = (unsigned)(zm >> (16 * g)) & 0xffffu;
                unsigned short* irow = IDX + (t0 + q) * 256;
                if (valid && bin > tbn[rt]) { const unsigned pos = LDS_ADD(qNgt + q, 1u); irow[pos] = (unsigned short)s; }
                else if (zt) { const unsigned pos = zrun[rt] + __popc(gm & ((1u << kl) - 1u)); if ((int)pos < rr[rt]) irow[cab[rt] + pos] = (unsigned short)s; }
                else if (inb) { const unsigned pos = LDS_ADD(qNcand + q, 1u);
                    if (pos < (unsigned)IX_CAP) { ((LAS unsigned*)(lds + q * 8192))[pos] = key; ((LAS unsigned short*)(lds + q * 8192 + 4096))[pos] = (unsigned short)s; } }
                zrun[rt] += __popc(gm);
            }
        }
        __syncthreads();
#pragma unroll 1
        for (int qq = 0; qq < 2; ++qq) {
            const int q = 2 * wave + qq; const int tbin = qTbin[q], n = qCb[q], cabq = qCab[q], r = 256 - cabq;
            if (tbin == IX_ZBIN || qOvf[q]) continue;
            const LAS unsigned* ck = (const LAS unsigned*)(lds + q * 8192); const LAS unsigned short* ci = (const LAS unsigned short*)(lds + q * 8192 + 4096);
            unsigned short* irow = IDX + (t0 + q) * 256;
            if (r >= n) { for (int c = lane; c < n; c += 64) irow[cabq + c] = ci[c]; }
            else {
                for (int c0 = 0; c0 < n; c0 += 64) {
                    const int c = c0 + lane; const bool have = c < n;
                    const unsigned long long mine = have ? (((unsigned long long)ck[c] << 16) | (unsigned long long)(0xffffu - ci[c])) : ~0ull;
                    int rank = 0;
                    for (int j = 0; j < n; ++j) { const unsigned long long cj = ((unsigned long long)ck[j] << 16) | (unsigned long long)(0xffffu - ci[j]); rank += (cj > mine) ? 1 : 0; }
                    if (have && rank < r) irow[cabq + rank] = ci[c];
                }
            }
        }
        if (tid < 16) CNT[t0 + tid] = 256;
        if (tid < 16 && qOvf[tid]) { const unsigned k = LDS_ADD(ovl, 1u); ovl[1 + k] = (unsigned)(t0 + tid); }
    }
    __syncthreads();
    const unsigned novl = __builtin_amdgcn_readfirstlane(ovl[0]);
#pragma unroll 1
    for (unsigned k = 0; k < novl; ++k) { const unsigned tq = __builtin_amdgcn_readfirstlane(ovl[1 + k]); indexer_slow_query(p, lds, (size_t)tq); }
}
#undef LDS_ADD

__device__ __forceinline__ void phase_attn(const P& p, unsigned char* lds) {
    unsigned char* ws = p.ws; const int tid = threadIdx.x, lane = tid & 63, hd = lane & 15, g = lane >> 4;
    const int wave = __builtin_amdgcn_readfirstlane(tid >> 6);
    bf16_t* QP = (bf16_t*)(ws + OFF_QP); const bf16_t* CK = (const bf16_t*)(ws + OFF_CKVN); const bf16_t* RK = (const bf16_t*)(ws + OFF_RK);
    const unsigned short* IDX = (const unsigned short*)(ws + OFF_IDX); const int* CNT = (const int*)(ws + OFF_CNT);
    float* biasT = (float*)lds;
    biasT[tid] = p.rel_bias[tid];
    __syncthreads();
    LAS unsigned char* rows = (LAS unsigned char*)(lds + 2048 + (size_t)wave * 18432);
    LAS bf16_t* rkb = (LAS bf16_t*)(rows + 16384);
    LAS unsigned* info = (LAS unsigned*)(rows + 17408);
    const LAS float* biasL = (const LAS float*)lds;
    for (int t = blockIdx.x * 8 + wave; t < T; t += gridDim.x * 8) {
        const int batch = t >> 14, pos = t & (SEQ - 1); const int cnt = CNT[t];
        const size_t rb = (size_t)batch * SEQ;
        asm volatile("s_waitcnt lgkmcnt(0)" ::: "memory");
#pragma unroll
        for (int jj = 0; jj < 4; ++jj) {
            const int j = lane + 64 * jj; int id = IDX[(size_t)t * 256 + j]; if (j >= cnt) id = 0;
            const int rel = pos - id; int bucket = rel < 0 ? 0 : rel;
            if (rel >= 16) { bucket = 16 + (int)(__logf((float)rel * 0.0625f) / 2.0794415416798357f * 16.0f); bucket = bucket > 31 ? 31 : bucket; }
            info[j] = (unsigned)id | ((unsigned)bucket << 16);
        }
        bf16x8 qf[8];
#pragma unroll
        for (int ks = 0; ks < 8; ++ks) qf[ks] = *(const bf16x8*)(QP + (size_t)t * 4096 + hd * 256 + ks * 32 + g * 8);
        f32x4 o[16];
#pragma unroll
        for (int rt = 0; rt < 16; ++rt) o[rt] = (f32x4){0.f, 0.f, 0.f, 0.f};
        float mrun = -1e30f, lrun = 0.f;
        asm volatile("s_waitcnt lgkmcnt(0)" ::: "memory");
        const int nch = (cnt + 31) >> 5;
        for (int ch = 0; ch < nch; ++ch) {
            asm volatile("s_waitcnt lgkmcnt(0)" ::: "memory");
#pragma unroll
            for (int i = 0; i < 16; ++i) {
                const int ksl = 2 * i + (lane >> 5); const unsigned idv = info[ch * 32 + ksl] & 0xffffu;
                const bf16_t* src = CK + (rb + idv) * 256 + (((lane & 31) ^ (ksl & 15)) * 8);
                __builtin_amdgcn_global_load_lds((const unsigned*)src, (LAS unsigned*)(rows + i * 1024), 16, 0, 0);
            }
            { const unsigned idv = info[ch * 32 + (lane >> 1)] & 0xffffu;
              __builtin_amdgcn_global_load_lds((const unsigned*)(RK + (rb + idv) * 16 + (lane & 1) * 8), (LAS unsigned*)rkb, 16, 0, 0); }
            asm volatile("s_waitcnt vmcnt(0)" ::: "memory");
            f32x4 s0 = (f32x4){0.f, 0.f, 0.f, 0.f}, s1 = (f32x4){0.f, 0.f, 0.f, 0.f};
#pragma unroll
            for (int ks = 0; ks < 8; ++ks) {
                const int pos16 = ((4 * ks + g) ^ hd) * 16;
                const bf16x8 a0 = *(const LAS bf16x8*)(rows + hd * 512 + pos16);
                const bf16x8 a1 = *(const LAS bf16x8*)(rows + (16 + hd) * 512 + pos16);
                s0 = __builtin_amdgcn_mfma_f32_16x16x32_bf16(a0, qf[ks], s0, 0, 0, 0);
                s1 = __builtin_amdgcn_mfma_f32_16x16x32_bf16(a1, qf[ks], s1, 0, 0, 0);
            }
            float x0[4], x1[4]; float cm = -INFINITY;
#pragma unroll
            for (int r = 0; r < 4; ++r) {
                const int sl0 = 4 * g + r, sl1 = 16 + 4 * g + r, j0 = ch * 32 + sl0, j1 = ch * 32 + sl1;
                const unsigned i0 = info[j0], i1 = info[j1];
                const float r0 = bf2f(rkb[sl0 * 16 + hd]), r1 = bf2f(rkb[sl1 * 16 + hd]);
                x0[r] = (j0 < cnt) ? s0[r] * r0 + biasL[(i0 >> 16) * 16 + hd] : -INFINITY;
                x1[r] = (j1 < cnt) ? s1[r] * r1 + biasL[(i1 >> 16) * 16 + hd] : -INFINITY;
                cm = fmaxf(cm, fmaxf(x0[r], x1[r]));
            }
            cm = fmaxf(cm, __shfl_xor(cm, 16)); cm = fmaxf(cm, __shfl_xor(cm, 32));
            const float mnew = fmaxf(mrun, cm); const float sc = __expf(mrun - mnew); mrun = mnew;
            float ls = 0.f;
#pragma unroll
            for (int r = 0; r < 4; ++r) { x0[r] = __expf(x0[r] - mnew); x1[r] = __expf(x1[r] - mnew); ls += x0[r] + x1[r]; }
            lrun = lrun * sc + ls;
#pragma unroll
            for (int rt = 0; rt < 16; ++rt) o[rt] *= sc;
            u32x4 pw; pw.x = pg8::cvt_pk_bf16(x0[0], x0[1]); pw.y = pg8::cvt_pk_bf16(x0[2], x0[3]); pw.z = pg8::cvt_pk_bf16(x1[0], x1[1]); pw.w = pg8::cvt_pk_bf16(x1[2], x1[3]);
            const bf16x8 pf = __builtin_bit_cast(bf16x8, pw);
            const int q = hd >> 2, pp = hd & 3, ksl = 4 * g + q;
            const LAS unsigned char* trb = rows + ksl * 512 + (pp & 1) * 8;
#pragma unroll
            for (int rt = 0; rt < 16; ++rt) {
                const int c16 = ((2 * rt + (pp >> 1)) ^ ksl) * 16;
                const v4i16_t t0 = __builtin_amdgcn_ds_read_tr16_b64_v4i16((LAS v4i16_t*)(trb + c16));
                const v4i16_t t1 = __builtin_amdgcn_ds_read_tr16_b64_v4i16((LAS v4i16_t*)(trb + c16 + 8192));
                bf16x8 af; af[0] = t0[0]; af[1] = t0[1]; af[2] = t0[2]; af[3] = t0[3]; af[4] = t1[0]; af[5] = t1[1]; af[6] = t1[2]; af[7] = t1[3];
                o[rt] = __builtin_amdgcn_mfma_f32_16x16x32_bf16(af, pf, o[rt], 0, 0, 0);
            }
        }
        float ltot = lrun; ltot += __shfl_xor(ltot, 16); ltot += __shfl_xor(ltot, 32);
        const float inv = 1.0f / ltot;
        bf16_t* op = QP + (size_t)t * 4096 + hd * 256 + 4 * g;
#pragma unroll
        for (int rt = 0; rt < 16; ++rt) { u32x2 w; w.x = pg8::cvt_pk_bf16(o[rt][0] * inv, o[rt][1] * inv); w.y = pg8::cvt_pk_bf16(o[rt][2] * inv, o[rt][3] * inv); *(u32x2*)(op + rt * 16) = w; }
    }
}

__global__ void __launch_bounds__(512, 2) k_fwd(P p_arg, int ph_lo, int ph_hi) {
    extern __shared__ __attribute__((aligned(16))) unsigned char smem[];
    const P& p = *(const P*)__builtin_amdgcn_kernarg_segment_ptr(); (void)p_arg;
    unsigned char* lds = smem + 16;
    unsigned char* ws = p.ws;
    XcdBarrier bar;
    const bool multi = (ph_hi - ph_lo) > 1;
    if (multi) {
        if (threadIdx.x == 0) *(uint4*)smem = make_uint4(0u, 0u, 0u, 0u);
        __syncthreads();
        bar = xcd_barrier_post((unsigned*)(ws + OFF_CTL), (volatile LAS unsigned*)smem);
    }
#define PH(i) (ph_lo <= (i) && (i) < ph_hi)
#define SEAM(i) do { if ((i) + 1 < ph_hi) xcd_barrier(bar); else __syncthreads(); } while (0)
    bf16_t *XN = (bf16_t*)(ws + OFF_XN), *QB = (bf16_t*)(ws + OFF_QB), *KB = (bf16_t*)(ws + OFF_KB), *VB = (bf16_t*)(ws + OFF_VB), *TMP = (bf16_t*)(ws + OFF_TMP), *Y = (bf16_t*)(ws + OFF_Y);
    if (PH(0)) { phase_prep(p, lds); SEAM(0); }
    if (PH(1)) { fast_gemm(lds, XN, 1024, (const bf16_t*)(ws + OFF_W0T), 1024, 3072, 1024, D1{ws}); SEAM(1); }
    if (PH(2)) { phase_conv_scan(p, lds); SEAM(2); }
    if (PH(3)) { mlstm_units<false>(p, lds); SEAM(3); }
    if (PH(4)) { phase_mlstm_scan(p, lds); SEAM(4); }
    if (PH(5)) { mlstm_units<true>(p, lds); SEAM(5); }
    if (PH(6)) { fast_gemm(lds, XN, 1024, (const bf16_t*)(ws + OFF_W0T) + (size_t)3072 * 1024, 1024, 4096, 1024, D2{ws}); SEAM(6); }
    if (PH(7)) { phase_ya_pool(p); SEAM(7); }
    if (PH(8)) { fast_gemm(lds, Y, 2048, (const bf16_t*)(ws + OFF_WO0T), 2048, 1024, 2048, D4{(unsigned char*)p.out, p.x}); SEAM(8); }
    if (PH(9)) { rmsnorm_rows<4>(p.out, p.o_norm, XN, p.o_w_in, OIN, 1600, nullptr, 0.5f, (float*)(ws + OFF_WI)); SEAM(9); }
    if (PH(10)) { fast_gemm(lds, XN, 1024, (const bf16_t*)(ws + OFF_W1T), 1024, 2816, 1024, D5{ws}); SEAM(10); }
    if (PH(11)) { phase_qnorm_ckvnorm(p); SEAM(11); }
    if (PH(12)) { fast_gemm(lds, (const bf16_t*)(ws + OFF_CKVN), 256, (const bf16_t*)(ws + OFF_WUKP), 256, 1024, 256, DK{ws}); SEAM(12); }
    if (PH(13)) { GQP f{TMP, (const bf16_t*)(ws + OFF_WQP), (bf16_t*)(ws + OFF_QP)}; sgemm(f, 512 * 64); phase_indexer(p, lds); SEAM(13); }
    if (PH(14)) { phase_attn(p, lds); SEAM(14); }
    if (PH(15)) { GOP f{(const bf16_t*)(ws + OFF_QP), (const bf16_t*)(ws + OFF_WUVT), (const bf16_t*)(ws + OFF_Z), TMP}; sgemm(f, 512 * 16); SEAM(15); }
    if (PH(16)) { fast_gemm(lds, TMP, 1024, (const bf16_t*)(ws + OFF_WO1T), 1024, 1024, 1024, D8{(unsigned char*)p.out}); }
#undef PH
#undef SEAM
}

extern "C" void kernel_launch(void* const* d_in, const int* in_sizes, int n_in, void* d_out, int out_size, void* d_ws, size_t ws_size, hipStream_t stream) {
    static int grid = 0;
    if (grid == 0) {
        if (n_in != 18 || out_size != T * DM || ws_size < WS_END) { fprintf(stderr, "kernel_launch: unexpected shapes (n_in %d out %d ws %zu)\n", n_in, out_size, ws_size); grid = -1; return; }
        if (hipFuncSetAttribute((const void*)k_fwd, hipFuncAttributeMaxDynamicSharedMemorySize, LDS_BYTES) != hipSuccess) { fprintf(stderr, "kernel_launch: hipFuncSetAttribute failed\n"); grid = -1; return; }
        grid = 256;
    }
    if (grid < 0) return;
    (void)hipMemsetAsync((char*)d_ws + OFF_CTL, 0, 16384, stream);
    P p{};
    p.x = (const float*)d_in[0]; p.e_norm = (const float*)d_in[1]; p.e_w_in = (const float*)d_in[2]; p.e_conv = (const float*)d_in[3]; p.e_b_if = (const float*)d_in[4];
    p.e_g_head = (const float*)d_in[5]; p.e_w_pool = (const float*)d_in[6]; p.e_s_pool = (const float*)d_in[7]; p.e_w_out = (const float*)d_in[8];
    p.o_norm = (const float*)d_in[9]; p.o_w_in = (const float*)d_in[10]; p.o_g_kv = (const float*)d_in[11]; p.o_w_uk = (const float*)d_in[12]; p.o_w_uv = (const float*)d_in[13];
    p.o_g_q = (const float*)d_in[14]; p.o_g_k = (const float*)d_in[15]; p.o_w_out = (const float*)d_in[16]; p.rel_bias = (const float*)d_in[17];
    p.out = (float*)d_out; p.ws = (unsigned char*)d_ws;
    hipLaunchKernelGGL(k_fwd, dim3(grid), dim3(512), LDS_BYTES, stream, p, 0, NPH);
}
```

```cpp
#include <hip/hip_runtime.h>
#include <stdint.h>
#include <cstdio>

typedef unsigned short bf16_t;
typedef short bf16x8 __attribute__((ext_vector_type(8)));
typedef float f32x4 __attribute__((ext_vector_type(4)));
typedef unsigned u32x4 __attribute__((ext_vector_type(4)));
typedef unsigned u32x2 __attribute__((ext_vector_type(2)));
typedef short v4i16_t __attribute__((ext_vector_type(4)));
#define LAS __attribute__((address_space(3)))

constexpr int T = 32768, SEQ = 16384, DM = 1024;
constexpr int EIN = 7176, OIN = 2628;
constexpr float EPS = 1e-6f;
constexpr size_t MB = 1048576;
constexpr size_t OFF_CTL = 0;
constexpr size_t OFF_GATES = 64 * 1024;
constexpr size_t OFF_BQ = OFF_GATES + (size_t)T * 8 * 4;
constexpr size_t OFF_IQ = OFF_BQ + (size_t)T * 4 * 4;
constexpr size_t OFF_MT = OFF_IQ + (size_t)T * 4 * 4;
constexpr size_t OFF_WI = OFF_MT + (size_t)T * 4 * 4;
constexpr size_t OFF_CH = OFF_WI + (size_t)T * 4 * 4;
constexpr size_t OFF_NS = OFF_CH + 64 * 1024;
constexpr size_t OFF_W = 4 * MB;
constexpr size_t OFF_W0T = OFF_W;
constexpr size_t OFF_WPT = OFF_W0T + (size_t)7168 * 1024 * 2;
constexpr size_t OFF_WO0T = OFF_WPT + (size_t)4 * 256 * 256 * 2;
constexpr size_t OFF_W1T = OFF_WO0T + (size_t)1024 * 2048 * 2;
constexpr size_t OFF_WUKT = OFF_W1T + (size_t)2816 * 1024 * 2;
constexpr size_t OFF_WUVT = OFF_WUKT + (size_t)1024 * 256 * 2;
constexpr size_t OFF_WO1T = OFF_WUVT + (size_t)1024 * 256 * 2;
constexpr size_t OFF_WUKP = OFF_WO1T + (size_t)1024 * 1024 * 2;
constexpr size_t OFF_WQP = OFF_WUKP + (size_t)1024 * 256 * 2;
constexpr size_t OFF_XN = 36 * MB, OFF_QB = 100 * MB, OFF_KB = 164 * MB, OFF_VB = 228 * MB, OFF_TMP = 292 * MB, OFF_Y = 356 * MB;
constexpr size_t OFF_QP = 36 * MB;
constexpr size_t OFF_CKVN = OFF_Y;
constexpr size_t OFF_QI = OFF_Y + 16 * MB;
constexpr size_t OFF_KI = OFF_Y + 32 * MB;
constexpr size_t OFF_IDX = OFF_Y + 40 * MB;
constexpr size_t OFF_RK = OFF_Y + 58 * MB;
constexpr size_t OFF_CNT = OFF_Y + 59 * MB;
constexpr size_t OFF_Z = OFF_Y + 60 * MB;
constexpr size_t WS_END = 484 * MB;
constexpr int LDS_BYTES = 151552;
constexpr int NPH = 17;

struct P {
    const float *x, *e_norm, *e_w_in, *e_conv, *e_b_if, *e_g_head, *e_w_pool, *e_s_pool, *e_w_out;
    const float *o_norm, *o_w_in, *o_g_kv, *o_w_uk, *o_w_uv, *o_g_q, *o_g_k, *o_w_out, *rel_bias;
    float* out; unsigned char* ws;
};

__device__ __forceinline__ bf16_t f2bf(float f) { unsigned u = __float_as_uint(f); u += 0x7FFFu + ((u >> 16) & 1u); return (bf16_t)(u >> 16); }
__device__ __forceinline__ float bf2f(bf16_t b) { return __uint_as_float(((unsigned)b) << 16); }
__device__ __forceinline__ float bflo(unsigned w) { return __uint_as_float(w << 16); }
__device__ __forceinline__ float bfhi(unsigned w) { return __uint_as_float(w & 0xffff0000u); }
__device__ __forceinline__ unsigned pk2(float a, float b) { return (unsigned)f2bf(a) | ((unsigned)f2bf(b) << 16); }
__device__ __forceinline__ float sigmoidf_(float x) { return 1.0f / (1.0f + __expf(-x)); }
__device__ __forceinline__ float siluf_(float x) { return x / (1.0f + __expf(-x)); }
__device__ __forceinline__ float wave_sum(float v) {
#pragma unroll
    for (int o = 32; o >= 1; o >>= 1) v += __shfl_xor(v, o);
    return v;
}
__device__ __forceinline__ float wave_max(float v) {
#pragma unroll
    for (int o = 32; o >= 1; o >>= 1) v = fmaxf(v, __shfl_xor(v, o));
    return v;
}

#define XB_TMO      128
#define XB_XCNT(j)  (256  + 64 * (j))
#define XB_XSUB(j)  (1280 + 64 * (j))
#define XB_XGEN(j)  (2304 + 64 * (j))
#define XB_TOP      3328
#define XB_TOPGEN   3392
#define XCD_BAR_WORDS 3456
#define XB_SPIN_CAP (1u << 22)
__device__ __forceinline__ unsigned xb_ld(unsigned* p)              { return __hip_atomic_load(p, __ATOMIC_RELAXED, __HIP_MEMORY_SCOPE_AGENT); }
__device__ __forceinline__ unsigned xb_add(unsigned* p, unsigned v) { return __hip_atomic_fetch_add(p, v, __ATOMIC_RELAXED, __HIP_MEMORY_SCOPE_AGENT); }
__device__ __forceinline__ unsigned xb_xcc_id() { return (unsigned)__builtin_amdgcn_s_getreg((3 << 11) | 20) & 0xFu; }
#define XB_SPIN(cond, bar) do { unsigned _sp = 0; while (cond) { __builtin_amdgcn_s_sleep(1); \
    if ((++_sp & 255u) == 0u) { if (xb_ld(&(bar)[XB_TMO])) break; if (_sp > XB_SPIN_CAP) { atomicAdd(&(bar)[XB_TMO], 1u); break; } } } } while (0)
struct XcdBarrier { unsigned* bar; unsigned x; volatile LAS unsigned* st; };
__device__ __forceinline__ XcdBarrier xcd_barrier_post(unsigned* bar, volatile LAS unsigned* st) {
    XcdBarrier b; b.bar = bar; b.x = xb_xcc_id(); b.st = st;
    if (threadIdx.x == 0) (void)xb_add(&bar[XB_XCNT(b.x)], 1u);
    return b;
}
__device__ __forceinline__ void xcd_barrier_complete(unsigned* bar, unsigned x, unsigned& nloc, unsigned& nx) {
    const unsigned G = gridDim.x * gridDim.y * gridDim.z;
    unsigned sum, cnt, mine, sp = 0u;
    for (;;) {
        sum = 0u; cnt = 0u; mine = 0u;
#pragma unroll
        for (unsigned j = 0; j < 16; ++j) { const unsigned c = xb_ld(&bar[XB_XCNT(j)]); sum += c; cnt += (c > 0u) ? 1u : 0u; mine = (j == x) ? c : mine; }
        if (sum == G) break;
        __builtin_amdgcn_s_sleep(1);
        if ((++sp & 255u) == 0u) { if (xb_ld(&bar[XB_TMO])) break; if (sp > XB_SPIN_CAP) { atomicAdd(&bar[XB_TMO], 1u); break; } }
    }
    nloc = mine > 0u ? mine : 1u; nx = cnt > 0u ? cnt : 1u;
}
__device__ __forceinline__ void xcd_barrier(const XcdBarrier& b) {
    asm volatile("s_waitcnt vmcnt(0)" ::: "memory");
    __syncthreads();
    if (threadIdx.x == 0) {
        unsigned* bar = b.bar;
        __builtin_amdgcn_s_waitcnt(0);
        unsigned nloc = b.st[0], nx = b.st[1];
        if (nloc == 0u) { xcd_barrier_complete(bar, b.x, nloc, nx); b.st[0] = nloc; b.st[1] = nx; }
        const unsigned old = xb_add(&bar[XB_XSUB(b.x)], 1u);
        const unsigned gen = old / nloc;
        if (old + 1u == (gen + 1u) * nloc) {
            __builtin_amdgcn_fence(__ATOMIC_RELEASE, "agent");
            asm volatile("s_waitcnt vmcnt(0)" ::: "memory");
            const unsigned og = xb_add(&bar[XB_TOP], 1u);
            const unsigned tg = og / nx;
            if (og + 1u == (tg + 1u) * nx) xb_add(&bar[XB_TOPGEN], 1u);
            else XB_SPIN(xb_ld(&bar[XB_TOPGEN]) == tg, bar);
            __builtin_amdgcn_fence(__ATOMIC_ACQUIRE, "agent");
            xb_add(&bar[XB_XGEN(b.x)], 1u);
            asm volatile("s_waitcnt vmcnt(0)" ::: "memory");
        } else {
            XB_SPIN(xb_ld(&bar[XB_XGEN(b.x)]) == gen, bar);
            __builtin_amdgcn_fence(__ATOMIC_ACQUIRE, "agent");
            asm volatile("s_waitcnt vmcnt(0)" ::: "memory");
        }
    }
    __syncthreads();
}

struct Tile { const bf16_t* A; const bf16_t* B; int lda, ldb, K; void* d0; const void* s0; int ld, mode; float aux0, aux1, aux2; int i0, i1; };
template <class F>
__device__ __forceinline__ void sgemm(const F f, int nunits) {
    const int lane = threadIdx.x & 63, wave = threadIdx.x >> 6, fr = lane & 15, fq = lane >> 4;
    for (int u = blockIdx.x * 8 + wave; u < nunits; u += gridDim.x * 8) {
        Tile tl; f.tile(u, tl);
        f32x4 acc[4][4];
#pragma unroll
        for (int m = 0; m < 4; ++m)
#pragma unroll
            for (int n = 0; n < 4; ++n) acc[m][n] = (f32x4){0.f, 0.f, 0.f, 0.f};
        const bf16_t* ap = tl.A + (size_t)fr * tl.lda + fq * 8;
        const bf16_t* bp = tl.B + (size_t)fr * tl.ldb + fq * 8;
        const int K = tl.K, lda = tl.lda, ldb = tl.ldb;
#pragma unroll 1
        for (int k0 = 0; k0 < K; k0 += 32) {
            bf16x8 a[4], b[4];
#pragma unroll
            for (int m = 0; m < 4; ++m) a[m] = *(const bf16x8*)(ap + (size_t)(m * 16) * lda + k0);
#pragma unroll
            for (int n = 0; n < 4; ++n) b[n] = *(const bf16x8*)(bp + (size_t)(n * 16) * ldb + k0);
#pragma unroll
            for (int m = 0; m < 4; ++m)
#pragma unroll
                for (int n = 0; n < 4; ++n) acc[m][n] = __builtin_amdgcn_mfma_f32_16x16x32_bf16(a[m], b[n], acc[m][n], 0, 0, 0);
        }
#pragma unroll
        for (int m = 0; m < 4; ++m)
#pragma unroll
            for (int j = 0; j < 4; ++j) {
                const int r = m * 16 + fq * 4 + j;
                asm volatile("" ::: "memory");
#pragma unroll
                for (int n = 0; n < 4; ++n) f.out(tl, r, n * 16 + fr, acc[m][n][j]);
            }
    }
}
__device__ __forceinline__ void store_mode(const Tile& tl, int r, int c, float v) {
    const size_t i = (size_t)r * tl.ld + c;
    if (tl.mode == 0) ((bf16_t*)tl.d0)[i] = f2bf(v);
    else if (tl.mode == 1) ((bf16_t*)tl.d0)[i] = f2bf(sigmoidf_(v));
    else if (tl.mode == 2) ((bf16_t*)tl.d0)[i] = f2bf(siluf_(v));
    else if (tl.mode == 3) ((float*)tl.d0)[i] = v * tl.aux0;
}

struct G1 {
    const bf16_t* XN; const bf16_t* W; bf16_t *Q, *K_, *V;
    __device__ __forceinline__ void tile(int u, Tile& tl) const {
        const int mt = u / 48, nt = u % 48; tl.A = XN + (size_t)mt * 64 * 1024; tl.lda = 1024; tl.B = W + (size_t)nt * 64 * 1024; tl.ldb = 1024; tl.K = 1024;
        const int col = nt * 64, sec = col >> 10, cc = col & 1023; bf16_t* d = Q + (size_t)sec * (32 * MB);
        tl.d0 = d + (size_t)mt * 64 * 1024 + cc; tl.ld = 1024; tl.mode = 0; }
    __device__ __forceinline__ void out(const Tile& tl, int r, int c, float v) const { store_mode(tl, r, c, v); }
};
struct G2 {
    const bf16_t* XN; const bf16_t* W; bf16_t *O, *ZA, *U, *Y;
    __device__ __forceinline__ void tile(int u, Tile& tl) const {
        const int mt = u / 64, nt = u % 64; tl.A = XN + (size_t)mt * 64 * 1024; tl.lda = 1024; tl.B = W + (size_t)(3072 + nt * 64) * 1024; tl.ldb = 1024; tl.K = 1024;
        const int col = nt * 64, sec = col >> 10, cc = col & 1023;
        if (sec == 0) { tl.d0 = O + (size_t)mt * 64 * 1024 + cc; tl.ld = 1024; tl.mode = 1; }
        else if (sec == 1) { tl.d0 = ZA + (size_t)mt * 64 * 1024 + cc; tl.ld = 1024; tl.mode = 2; }
        else if (sec == 2) { tl.d0 = U + (size_t)mt * 64 * 1024 + cc; tl.ld = 1024; tl.mode = 0; }
        else { tl.d0 = Y + (size_t)mt * 64 * 2048 + 1024 + cc; tl.ld = 2048; tl.mode = 2; } }
    __device__ __forceinline__ void out(const Tile& tl, int r, int c, float v) const { store_mode(tl, r, c, v); }
};
struct GM1 {
    const bf16_t* Y; const bf16_t* KT; const float *BQ, *IQ, *MT; float* W;
    __device__ __forceinline__ void tile(int u, Tile& tl) const {
        const int bh = u >> 8, c = u & 255, batch = bh >> 2, head = bh & 3; const size_t t0 = (size_t)batch * SEQ + c * 64;
        tl.A = Y + t0 * 2048 + 1024 + head * 256; tl.lda = 2048; tl.B = KT + t0 * 1024 + head * 256; tl.ldb = 1024; tl.K = 256;
        tl.d0 = W + (size_t)u * 4096; tl.ld = 64; tl.mode = 0; tl.i0 = (int)(t0 * 4 + head); }
    __device__ __forceinline__ void out(const Tile& tl, int r, int c, float v) const {
        float w = 0.f;
        if (c <= r) w = __expf(BQ[tl.i0 + r * 4] - BQ[tl.i0 + c * 4] + IQ[tl.i0 + c * 4] - MT[tl.i0 + r * 4]) * v;
        ((float*)tl.d0)[r * 64 + c] = w; }
};
struct G3 {
    const bf16_t* XN; const bf16_t* W; const float* sp; bf16_t* Y;
    __device__ __forceinline__ void tile(int u, Tile& tl) const {
        const int mt = u >> 4, g = (u >> 2) & 3, nt = u & 3; tl.A = XN + (size_t)mt * 64 * 1024 + g * 256; tl.lda = 1024; tl.B = W + (size_t)(g * 256 + nt * 64) * 256; tl.ldb = 256; tl.K = 256;
        const int col = g * 256 + nt * 64; tl.d0 = Y + (size_t)mt * 64 * 2048 + 1024 + col; tl.ld = 2048; tl.s0 = sp + col; tl.mode = 0; }
    __device__ __forceinline__ void out(const Tile& tl, int r, int c, float v) const {
        bf16_t* d = (bf16_t*)tl.d0 + (size_t)r * 2048 + c; *d = f2bf(v * ((const float*)tl.s0)[c] * bf2f(*d)); }
};
struct G4 {
    const bf16_t* Y; const bf16_t* W; const float* x; float* out_;
    __device__ __forceinline__ void tile(int u, Tile& tl) const {
        const int mt = u >> 4, nt = u & 15; tl.A = Y + (size_t)mt * 64 * 2048; tl.lda = 2048; tl.B = W + (size_t)nt * 64 * 2048; tl.ldb = 2048; tl.K = 2048;
        const size_t o = (size_t)mt * 64 * 1024 + nt * 64; tl.d0 = out_ + o; tl.s0 = x + o; tl.ld = 1024; tl.mode = 0; }
    __device__ __forceinline__ void out(const Tile& tl, int r, int c, float v) const { const size_t i = (size_t)r * 1024 + c; ((float*)tl.d0)[i] = ((const float*)tl.s0)[i] + v; }
};
struct G5 {
    const bf16_t* XN; const bf16_t* W; bf16_t* Q; float *CKVR, *QI, *KI; bf16_t* Z;
    __device__ __forceinline__ void tile(int u, Tile& tl) const {
        const int mt = u / 44, nt = u % 44; tl.A = XN + (size_t)mt * 64 * 1024; tl.lda = 1024; tl.B = W + (size_t)nt * 64 * 1024; tl.ldb = 1024; tl.K = 1024;
        const int col = nt * 64; const size_t row0 = (size_t)mt * 64; tl.aux0 = 1.0f;
        if (col < 1024) { tl.d0 = Q + row0 * 1024 + col; tl.ld = 1024; tl.mode = 0; }
        else if (col < 1280) { tl.d0 = CKVR + row0 * 256 + (col - 1024); tl.ld = 256; tl.mode = 3; }
        else if (col < 1536) { tl.d0 = QI + row0 * 256 + (col - 1280); tl.ld = 256; tl.mode = 3; tl.aux0 = 0.125f; }
        else if (col < 1600) { tl.d0 = KI + row0 * 64 + (col - 1536); tl.ld = 64; tl.mode = 3; }
        else if (col < 1792) { tl.d0 = nullptr; tl.ld = 0; tl.mode = 4; }
        else { tl.d0 = Z + row0 * 1024 + (col - 1792); tl.ld = 1024; tl.mode = 2; } }
    __device__ __forceinline__ void out(const Tile& tl, int r, int c, float v) const { store_mode(tl, r, c, v); }
};
struct G67 {
    const bf16_t* C; const bf16_t *WK, *WV; bf16_t *KF, *VF;
    __device__ __forceinline__ void tile(int u, Tile& tl) const {
        const int which = u >= 8192, uu = u & 8191, mt = uu >> 4, nt = uu & 15; tl.A = C + (size_t)mt * 64 * 256; tl.lda = 256; tl.B = WK + (size_t)which * (1024 * 256) + (size_t)nt * 64 * 256;     tl.ldb = 256; tl.K = 256;
        tl.d0 = KF + (size_t)which * (32 * MB) + (size_t)mt * 64 * 1024 + nt * 64;     tl.ld = 1024; tl.mode = 0; }
    __device__ __forceinline__ void out(const Tile& tl, int r, int c, float v) const { store_mode(tl, r, c, v); }
};
struct G8 {
    const bf16_t* G; const bf16_t* W; float* out_;
    __device__ __forceinline__ void tile(int u, Tile& tl) const {
        const int mt = u >> 4, nt = u & 15; tl.A = G + (size_t)mt * 64 * 1024; tl.lda = 1024; tl.B = W + (size_t)nt * 64 * 1024; tl.ldb = 1024; tl.K = 1024;
        tl.d0 = out_ + (size_t)mt * 64 * 1024 + nt * 64; tl.ld = 1024; tl.mode = 0; }
    __device__ __forceinline__ void out(const Tile& tl, int r, int c, float v) const { float* d = (float*)tl.d0 + (size_t)r * 1024 + c; *d = *d + v; }
};

struct GQP {
    const bf16_t* Qn; const bf16_t* W; bf16_t* QP;
    __device__ __forceinline__ void tile(int u, Tile& tl) const {
        const int nt = u & 3, head = (u >> 2) & 15, mt = u >> 6; tl.A = Qn + (size_t)mt * 64 * 1024 + head * 64; tl.lda = 1024; tl.B = W + (size_t)(head * 256 + nt * 64) * 64; tl.ldb = 64; tl.K = 64;
        tl.d0 = QP + ((size_t)mt * 64 * 16 + head) * 256 + nt * 64; tl.ld = 4096; tl.mode = 0; }
    __device__ __forceinline__ void out(const Tile& tl, int r, int c, float v) const { store_mode(tl, r, c, v); }
};
struct GOP {
    const bf16_t* OP; const bf16_t* W; const bf16_t* Z; bf16_t* G;
    __device__ __forceinline__ void tile(int u, Tile& tl) const {
        const int head = u & 15, mt = u >> 4; tl.A = OP + (size_t)mt * 64 * 4096 + head * 256; tl.lda = 4096; tl.B = W + (size_t)head * 64 * 256; tl.ldb = 256; tl.K = 256;
        const size_t o = (size_t)mt * 64 * 1024 + head * 64; tl.d0 = G + o; tl.s0 = Z + o; tl.ld = 1024; tl.mode = 0; }
    __device__ __forceinline__ void out(const Tile& tl, int r, int c, float v) const { const size_t i = (size_t)r * 1024 + c; ((bf16_t*)tl.d0)[i] = f2bf(v * bf2f(((const bf16_t*)tl.s0)[i])); }
};

namespace pg8 {
constexpr int BM = 256, BK = 64, HALF = 128, HTB = HALF * BK * 2, STAGE_BYTES = 8 * HTB, NXCD = 8, WGM = 8;
__device__ __forceinline__ int lds_byte(int r, int c) { const int st = (r >> 4) * 2 + (c >> 5), rr = r & 15, cc = c & 31, ob = rr * 64 + cc * 2; return st * 1024 + (ob ^ (((ob >> 9) & 1) << 5)); }
__device__ __forceinline__ void stage_rc(int b, int& R, int& C) { const int st = b / 1024, sb = b % 1024, swz = sb ^ (((sb >> 9) & 1) << 5); R = (st >> 1) * 16 + swz / 64; C = (st & 1) * 32 + (swz % 64) / 2; }
__device__ __forceinline__ int perm32(int rho) { const int n = rho >> 4, i = rho & 15; return 8 * (i >> 2) + 4 * n + (i & 3); }
struct Unit { int pm, pn; };
struct Gemm { const bf16_t* A; int lda; const bf16_t* Bt; int ldb; int M, N, K; };
struct StaticOrder {
    int nM, nN, nwg, G, c;
    __device__ void init(int M, int N, int G_, int c_) { nM = M / BM; nN = N / BM; nwg = nM * nN; G = G_; c = c_; }
    __device__ bool next(int i, Unit& u) const {
        const long L = (long)i * G + c; if (L >= nwg) return false;
        int wgid = (int)L; { const int q = nwg / NXCD, r = nwg % NXCD, xcd = wgid % NXCD, off = wgid / NXCD; wgid = (xcd < r ? xcd * (q + 1) : r * (q + 1) + (xcd - r) * q) + off; }
        const int nig = WGM * nN, gid = wgid / nig, fm = gid * WGM, gsz = (nM - fm) < WGM ? (nM - fm) : WGM;
        u.pm = fm + ((wgid % nig) % gsz); u.pn = (wgid % nig) / gsz; return true;
    }
};
__device__ __forceinline__ unsigned cvt_pk_bf16(float lo, float hi) { unsigned r; asm volatile("v_cvt_pk_bf16_f32 %0, %1, %2" : "=v"(r) : "v"(lo), "v"(hi)); return r; }

struct Dst { unsigned char* base; const float* res; int ld, mode, ncol; float scale; };
template <class DescF> struct EpiGen {
    static constexpr bool PERM = true;
    DescF D;
    __device__ __forceinline__ void operator()(const f32x4 (&acc)[2][2][4][2], const Unit& u, int wr, int wc, int fr, int fq) const {
        Dst d; D.get(u, d);
        if ((DescF::MODES & 16) && d.mode == 4) return;
        const int r0 = wr * 64 + fr, c0 = wc * 32 + 8 * fq;
        if constexpr ((DescF::MODES & 64) != 0) {
#pragma unroll
            for (int ai = 0; ai < 2; ++ai)
#pragma unroll
                for (int m = 0; m < 4; ++m) {
                    float ss = 0.f;
#pragma unroll
                    for (int bj = 0; bj < 2; ++bj)
#pragma unroll
                        for (int n = 0; n < 2; ++n) { const f32x4 v = acc[ai][bj][m][n]; ss += v[0] * v[0] + v[1] * v[1] + v[2] * v[2] + v[3] * v[3]; }
                    ss += __shfl_xor(ss, 16); ss += __shfl_xor(ss, 32);
                    if (fq == 0) ((bf16_t*)d.base)[(size_t)(ai * HALF + r0 + m * 16) * d.ld + wc] = f2bf(rsqrtf(ss * (1.0f / 64.0f) + EPS));
                }
            return;
        } else {
#pragma unroll
        for (int ai = 0; ai < 2; ++ai)
#pragma unroll
            for (int m = 0; m < 4; ++m) {
                const size_t rowoff = (size_t)(ai * HALF + r0 + m * 16) * d.ld;
#pragma unroll
                for (int bj = 0; bj < 2; ++bj) {
                    const int col = bj * HALF + c0; f32x4 v0 = acc[ai][bj][m][0], v1 = acc[ai][bj][m][1];
                    if ((DescF::MODES & 7) && d.mode <= 2) {
                        if ((DescF::MODES & 2) && d.mode == 1) {
#pragma unroll
                            for (int j = 0; j < 4; ++j) { v0[j] = sigmoidf_(v0[j]); v1[j] = sigmoidf_(v1[j]); } }
                        if ((DescF::MODES & 4) && d.mode == 2) {
#pragma unroll
                            for (int j = 0; j < 4; ++j) { v0[j] = siluf_(v0[j]); v1[j] = siluf_(v1[j]); } }
                        u32x4 w; w.x = cvt_pk_bf16(v0[0], v0[1]); w.y = cvt_pk_bf16(v0[2], v0[3]); w.z = cvt_pk_bf16(v1[0], v1[1]); w.w = cvt_pk_bf16(v1[2], v1[3]);
                        *(u32x4*)((bf16_t*)d.base + rowoff + col) = w;
                    } else if ((DescF::MODES & 8) && d.mode == 3) {
                        if (col < d.ncol) { float* o = (float*)d.base + rowoff + col; *(f32x4*)o = v0 * d.scale; *(f32x4*)(o + 4) = v1 * d.scale; }
                    } else if ((DescF::MODES & 128) && d.mode == 7) {
                        typedef _Float16 h8 __attribute__((ext_vector_type(8)));
                        if (col < d.ncol) {
                        h8 hv; hv[0] = (_Float16)(v0[0] * d.scale); hv[1] = (_Float16)(v0[1] * d.scale); hv[2] = (_Float16)(v0[2] * d.scale); hv[3] = (_Float16)(v0[3] * d.scale);
                        hv[4] = (_Float16)(v1[0] * d.scale); hv[5] = (_Float16)(v1[1] * d.scale); hv[6] = (_Float16)(v1[2] * d.scale); hv[7] = (_Float16)(v1[3] * d.scale);
                        *(h8*)((_Float16*)d.base + rowoff + col) = hv; }
                    } else if constexpr ((DescF::MODES & 32) != 0) {
                        float* o = (float*)d.base + rowoff + col; const float* rs = d.res + rowoff + col;
                        const f32x4 a = *(const f32x4*)rs, b = *(const f32x4*)(rs + 4); *(f32x4*)o = a + v0; *(f32x4*)(o + 4) = b + v1;
                    }
                }
                if (m & 1) asm volatile("" ::: "memory");
            }
        }
    }
};

template <class Epi>
__device__ __forceinline__ void gemm_phase(LAS unsigned char* lds, const Gemm g, const StaticOrder& S, const Epi& E) {
    const int tid = threadIdx.x, wid = __builtin_amdgcn_readfirstlane(tid >> 6), lane = tid & 63, wr = wid >> 2, wc = wid & 3, fr = lane & 15, fq = lane >> 4;
    const int K = g.K, nt = K / BK;
    unsigned voffA[2], voffB[2];
#pragma unroll
    for (int i = 0; i < 2; ++i) { int R, C; stage_rc(tid * 16 + i * 8192, R, C); const int Rb = Epi::PERM ? ((R & ~31) + perm32(R & 31)) : R;
        voffA[i] = (unsigned)(R * g.lda + C) * 2u; voffB[i] = (unsigned)(Rb * g.ldb + C) * 2u; }
    const size_t kstep = (size_t)(BK * 2);
    const size_t hstepA = (size_t)HALF * g.lda * 2, hstepB = (size_t)HALF * g.ldb * 2;
    const size_t tstepA = 2 * hstepA, tstepB = 2 * hstepB;
    const unsigned ldsw = (unsigned)wid * 1024u;
    const int aoff = lds_byte(wr * 64 + fr, fq * 8), boff = lds_byte(wc * 32 + fr, fq * 8);
#define PG8_SA(b, h) (((b) * 2 + (h)) * HTB)
#define PG8_SB(b, h) ((4 + (b) * 2 + (h)) * HTB)
#define PG8_STAGE(bufoff, gbase, voff) do { _Pragma("unroll") for (int _i = 0; _i < 2; ++_i) \
        __builtin_amdgcn_global_load_lds((const unsigned*)((const char*)(gbase) + (voff)[_i]), (LAS unsigned*)(lds + (bufoff) + ldsw + _i * 8192), 16, 0, 0); } while (0)
#define PG8_LDA(dst, b, h) do { _Pragma("unroll") for (int m = 0; m < 4; ++m) _Pragma("unroll") for (int k = 0; k < 2; ++k) dst[m][k] = *(const LAS bf16x8*)(lds + PG8_SA(b, h) + aoff + m * 2048 + k * 1024); } while (0)
#define PG8_LDB(dst, b, h) do { _Pragma("unroll") for (int n = 0; n < 2; ++n) _Pragma("unroll") for (int k = 0; k < 2; ++k) dst[n][k] = *(const LAS bf16x8*)(lds + PG8_SB(b, h) + boff + n * 2048 + k * 1024); } while (0)
#define PG8_MMA(ai, bj, At, Bt) do { __builtin_amdgcn_s_setprio(1); _Pragma("unroll") for (int m = 0; m < 4; ++m) _Pragma("unroll") for (int n = 0; n < 2; ++n) _Pragma("unroll") for (int k = 0; k < 2; ++k) \
        acc[ai][bj][m][n] = __builtin_amdgcn_mfma_f32_16x16x32_bf16(Bt[n][k], At[m][k], acc[ai][bj][m][n], 0, 0, 0); __builtin_amdgcn_s_setprio(0); } while (0)
#define PG8_WAIT_V(n) asm volatile("s_waitcnt vmcnt(" #n ")" ::: "memory")
#define PG8_WAIT_L(n) asm volatile("s_waitcnt lgkmcnt(" #n ")" ::: "memory")
#define PG8_BAR __builtin_amdgcn_s_barrier()
#define PG8_SCHED __builtin_amdgcn_sched_barrier(0)
    Unit cur, nxt; int ui = 0;
    if (!S.next(0, cur)) return;
    f32x4 acc[2][2][4][2];
#pragma unroll
    for (int a = 0; a < 2; ++a)
#pragma unroll
        for (int b = 0; b < 2; ++b)
#pragma unroll
            for (int m = 0; m < 4; ++m)
#pragma unroll
                for (int n = 0; n < 2; ++n) acc[a][b][m][n] = (f32x4){0.f, 0.f, 0.f, 0.f};
    bf16x8 At[4][2], B0[2][2], B1[2][2];
    const char* cA = (const char*)g.A + (size_t)cur.pm * tstepA; const char* cB = (const char*)g.Bt + (size_t)cur.pn * tstepB;
    PG8_STAGE(PG8_SB(0, 0), cB, voffB); PG8_STAGE(PG8_SA(0, 0), cA, voffA); PG8_STAGE(PG8_SB(0, 1), cB + hstepB, voffB); PG8_STAGE(PG8_SA(0, 1), cA + hstepA, voffA);
    if (wr == 1) PG8_BAR;
    PG8_WAIT_V(4); PG8_BAR;
    PG8_STAGE(PG8_SB(1, 0), cB + kstep, voffB); PG8_STAGE(PG8_SA(1, 0), cA + kstep, voffA); PG8_STAGE(PG8_SB(1, 1), cB + hstepB + kstep, voffB);
    PG8_WAIT_V(6); PG8_BAR;
    for (;;) {
        const bool has_next = S.next(ui + 1, nxt);
        const char* nA = has_next ? (const char*)g.A + (size_t)nxt.pm * tstepA : cA; const char* nB = has_next ? (const char*)g.Bt + (size_t)nxt.pn * tstepB : cB;
#pragma unroll 1
        for (int t = 0; t < nt; t += 2) {
            const bool last = (t == nt - 2);
            const char* a1 = cA + (size_t)(t + 1) * kstep;
            const char* a2 = last ? nA : cA + (size_t)(t + 2) * kstep; const char* b2 = last ? nB : cB + (size_t)(t + 2) * kstep;
            const char* a3 = a2 + kstep; const char* b3 = b2 + kstep;
            PG8_LDB(B0, 0, 0); PG8_SCHED; PG8_LDA(At, 0, 0); PG8_STAGE(PG8_SA(1, 1), a1 + hstepA, voffA);
            PG8_WAIT_L(8); PG8_BAR; PG8_WAIT_L(0); PG8_MMA(0, 0, At, B0); PG8_BAR; PG8_SCHED;
            PG8_LDB(B1, 0, 1); PG8_STAGE(PG8_SB(0, 0), b2, voffB);
            PG8_BAR; PG8_WAIT_L(0); PG8_MMA(0, 1, At, B1); PG8_BAR;
            PG8_LDA(At, 0, 1); PG8_STAGE(PG8_SA(0, 0), a2, voffA);
            PG8_BAR; PG8_WAIT_L(0); PG8_MMA(1, 0, At, B0); PG8_BAR; PG8_SCHED;
            PG8_STAGE(PG8_SB(0, 1), b2 + hstepB, voffB);
            PG8_WAIT_V(6); PG8_BAR; PG8_MMA(1, 1, At, B1); PG8_BAR;
            PG8_LDB(B0, 1, 0); PG8_SCHED; PG8_LDA(At, 1, 0); PG8_STAGE(PG8_SA(0, 1), a2 + hstepA, voffA);
            PG8_WAIT_L(8); PG8_BAR; PG8_WAIT_L(0); PG8_MMA(0, 0, At, B0); PG8_BAR; PG8_SCHED;
            PG8_LDB(B1, 1, 1); PG8_STAGE(PG8_SB(1, 0), b3, voffB);
            PG8_BAR; PG8_WAIT_L(0); PG8_MMA(0, 1, At, B1); PG8_BAR;
            PG8_LDA(At, 1, 1); PG8_STAGE(PG8_SA(1, 0), a3, voffA);
            PG8_BAR; PG8_WAIT_L(0); PG8_MMA(1, 0, At, B0); PG8_BAR; PG8_SCHED;
            PG8_STAGE(PG8_SB(1, 1), b3 + hstepB, voffB);
            PG8_WAIT_V(6); PG8_BAR; PG8_MMA(1, 1, At, B1); PG8_BAR;
        }
        E(acc, cur, wr, wc, fr, fq);
        if (!has_next) break;
#pragma unroll
        for (int a = 0; a < 2; ++a)
#pragma unroll
            for (int b = 0; b < 2; ++b)
#pragma unroll
                for (int m = 0; m < 4; ++m)
#pragma unroll
                    for (int n = 0; n < 2; ++n) acc[a][b][m][n] = (f32x4){0.f, 0.f, 0.f, 0.f};
        cur = nxt; cA = nA; cB = nB; ++ui;
    }
    PG8_WAIT_V(0);
    if (wr == 0) PG8_BAR;
    PG8_BAR;
#undef PG8_SA
#undef PG8_SB
#undef PG8_STAGE
#undef PG8_LDA
#undef PG8_LDB
#undef PG8_MMA
#undef PG8_WAIT_V
#undef PG8_WAIT_L
#undef PG8_BAR
#undef PG8_SCHED
}
}

struct D1 { static constexpr int MODES = 1; unsigned char* ws;
    __device__ __forceinline__ void get(const pg8::Unit& u, pg8::Dst& d) const { const int sec = u.pn >> 2;
        d.base = ws + OFF_QB + (size_t)sec * (64 * MB) + ((size_t)u.pm * 256 * 1024 + (u.pn & 3) * 256) * 2; d.res = nullptr; d.ld = 1024; d.mode = 0; d.ncol = 256; d.scale = 1.f; } };
struct D2 { static constexpr int MODES = 7; unsigned char* ws;
    __device__ __forceinline__ void get(const pg8::Unit& u, pg8::Dst& d) const { const int sec = u.pn >> 2, cc = (u.pn & 3) * 256; d.res = nullptr; d.ncol = 256; d.scale = 1.f;
        if (sec < 3) { d.base = ws + OFF_QB + (size_t)sec * (64 * MB) + ((size_t)u.pm * 256 * 1024 + cc) * 2; d.ld = 1024; d.mode = sec == 0 ? 1 : (sec == 1 ? 2 : 0); }
        else { d.base = ws + OFF_Y + ((size_t)u.pm * 256 * 2048 + 1024 + cc) * 2; d.ld = 2048; d.mode = 2; } } };
struct D4 { static constexpr int MODES = 32; unsigned char* out; const float* x;
    __device__ __forceinline__ void get(const pg8::Unit& u, pg8::Dst& d) const { const size_t o = (size_t)u.pm * 256 * 1024 + u.pn * 256;
        d.base = out + o * 4; d.res = x + o; d.ld = 1024; d.mode = 5; d.ncol = 256; d.scale = 1.f; } };
struct D5 { static constexpr int MODES = 133; unsigned char* ws;
    __device__ __forceinline__ void get(const pg8::Unit& u, pg8::Dst& d) const { const int pn = u.pn; d.res = nullptr; d.ncol = 256; d.scale = 1.f;
        if (pn < 4) { d.base = ws + OFF_TMP + ((size_t)u.pm * 256 * 1024 + pn * 256) * 2; d.ld = 1024; d.mode = 0; }
        else if (pn == 4) { d.base = ws + OFF_CKVN + (size_t)u.pm * 256 * 256 * 2; d.ld = 256; d.mode = 0; }
        else if (pn == 5) { d.base = ws + OFF_QI + (size_t)u.pm * 256 * 256 * 2; d.ld = 256; d.mode = 7; d.scale = 0.125f; }
        else if (pn == 6) { d.base = ws + OFF_KI + (size_t)u.pm * 256 * 64 * 2; d.ld = 64; d.mode = 7; d.ncol = 64; }
        else { d.base = ws + OFF_Z + ((size_t)u.pm * 256 * 1024 + (pn - 7) * 256) * 2; d.ld = 1024; d.mode = 2; } } };
struct DK { static constexpr int MODES = 64; unsigned char* ws;
    __device__ __forceinline__ void get(const pg8::Unit& u, pg8::Dst& d) const {
        d.base = ws + OFF_RK + ((size_t)u.pm * 256 * 16 + u.pn * 4) * 2; d.res = nullptr; d.ld = 16; d.mode = 6; d.ncol = 256; d.scale = 1.f; } };
struct D8 { static constexpr int MODES = 32; unsigned char* out;
    __device__ __forceinline__ void get(const pg8::Unit& u, pg8::Dst& d) const { const size_t o = (size_t)u.pm * 256 * 1024 + u.pn * 256;
        d.base = out + o * 4; d.res = (const float*)out + o; d.ld = 1024; d.mode = 5; d.ncol = 256; d.scale = 1.f; } };
template <class DF>
__device__ __forceinline__ void fast_gemm(unsigned char* lds, const bf16_t* A, int lda, const bf16_t* Bt, int ldb, int N, int K, const DF& df) {
    pg8::Gemm g{A, lda, Bt, ldb, T, N, K}; pg8::StaticOrder S; S.init(T, N, (int)gridDim.x, (int)blockIdx.x);
    pg8::EpiGen<DF> E{df};
    pg8::gemm_phase(( LAS unsigned char*)lds, g, S, E);
}

__device__ __forceinline__ void tconv(const float* __restrict__ src, int ld, int col0, int ncols, int K, bf16_t* __restrict__ dst, float* tile  ) {
    const int nkt = K / 64, ntiles = nkt * (ncols / 64), tid = threadIdx.x;
    for (int id = blockIdx.x; id < ntiles; id += gridDim.x) {
        const int kt = id % nkt, nt = id / nkt;
#pragma unroll
        for (int j = 0; j < 8; ++j) { const int e = tid + 512 * j, kk = e >> 6, nn = e & 63; tile[kk * 65 + nn] = src[(size_t)(kt * 64 + kk) * ld + col0 + nt * 64 + nn]; }
        __syncthreads();
#pragma unroll
        for (int j = 0; j < 8; ++j) { const int e = tid + 512 * j, nn = e >> 6, kk = e & 63; dst[(size_t)(nt * 64 + nn) * K + kt * 64 + kk] = f2bf(tile[kk * 65 + nn]); }
        __syncthreads();
    }
}
template <int NE>
__device__ __forceinline__ void rmsnorm_rows(const float* __restrict__ src, const float* __restrict__ g, bf16_t* __restrict__ dst,
                             const float* __restrict__ Wx, int ldw, int col0, const float* __restrict__ bias, float scale, float* __restrict__ dstx, float* wl) {
    const int lane = threadIdx.x & 63, wave = threadIdx.x >> 6;
    __syncthreads();
    for (int i = threadIdx.x; i < NE * 1024; i += 512) { const int k = i / NE, e = i % NE; wl[e * 1024 + k] = Wx[(size_t)k * ldw + col0 + e]; }
    __syncthreads();
    for (int row = blockIdx.x * 8 + wave; row < T; row += gridDim.x * 8) {
        f32x4 v[4]; float ss = 0.f;
#pragma unroll
        for (int i = 0; i < 4; ++i) { v[i] = *(const f32x4*)(src + (size_t)row * 1024 + i * 256 + lane * 4); ss += v[i][0] * v[i][0] + v[i][1] * v[i][1] + v[i][2] * v[i][2] + v[i][3] * v[i][3]; }
        ss = wave_sum(ss);
        const float rstd = rsqrtf(ss * (1.0f / 1024.0f) + EPS);
        float ex[NE];
#pragma unroll
        for (int e = 0; e < NE; ++e) ex[e] = 0.f;
#pragma unroll
        for (int i = 0; i < 4; ++i) {
            const f32x4 gg = *(const f32x4*)(g + i * 256 + lane * 4);
            f32x4 y; y[0] = v[i][0] * rstd * gg[0]; y[1] = v[i][1] * rstd * gg[1]; y[2] = v[i][2] * rstd * gg[2]; y[3] = v[i][3] * rstd * gg[3];
            u32x2 w; w.x = pk2(y[0], y[1]); w.y = pk2(y[2], y[3]);
            *(u32x2*)(dst + (size_t)row * 1024 + i * 256 + lane * 4) = w;
#pragma unroll
            for (int e = 0; e < NE; ++e) { const f32x4 wv = *(const f32x4*)(wl + e * 1024 + i * 256 + lane * 4); ex[e] += y[0] * wv[0] + y[1] * wv[1] + y[2] * wv[2] + y[3] * wv[3]; }
        }
#pragma unroll
        for (int e = 0; e < NE; ++e) { const float s = wave_sum(ex[e]); if (lane == 0) dstx[(size_t)row * NE + e] = (s + (bias ? bias[e] : 0.f)) * scale; }
    }
}

__device__ __forceinline__ void phase_prep(const P& p, unsigned char* lds) {
    float* tile = (float*)lds; unsigned char* ws = p.ws;
    bf16_t* W0T = (bf16_t*)(ws + OFF_W0T);
    tconv(p.e_w_in, EIN, 0, 5120, 1024, W0T, tile);
    tconv(p.e_w_in, EIN, 6152, 1024, 1024, W0T + (size_t)6144 * 1024, tile);
    {
        float* arow = tile;
        for (int it = blockIdx.x; it < 4 * 512; it += gridDim.x) {
            const int g = it >> 9, k0 = (it & 511) * 2; const int tid = threadIdx.x, kk = tid >> 8, d = tid & 255;
            __syncthreads();
            arow[tid] = p.e_w_in[(size_t)(k0 + kk) * EIN + 5128 + g * 256 + d];
            __syncthreads();
            const float* wp = p.e_w_pool + (size_t)g * 65536 + d; const float* ar = arow + kk * 256; float acc = 0.f;
#pragma unroll 8
            for (int c = 0; c < 256; ++c) acc += ar[c] * wp[(size_t)c * 256];
            W0T[(size_t)(5120 + g * 256 + d) * 1024 + k0 + kk] = f2bf(acc);
        }
        __syncthreads();
    }
    tconv(p.e_w_out, 1024, 0, 1024, 2048, (bf16_t*)(ws + OFF_WO0T), tile);
    bf16_t* W1T = (bf16_t*)(ws + OFF_W1T);
    tconv(p.o_w_in, OIN, 0, 1600, 1024, W1T, tile);
    for (size_t i = (size_t)blockIdx.x * 512 + threadIdx.x; i < (size_t)192 * 1024; i += (size_t)gridDim.x * 512) W1T[(size_t)1600 * 1024 + i] = 0;
    tconv(p.o_w_in, OIN, 1604, 1024, 1024, W1T + (size_t)1792 * 1024, tile);
    {
        bf16_t* WUKP = (bf16_t*)(ws + OFF_WUKP); bf16_t* WQP = (bf16_t*)(ws + OFF_WQP);
        for (size_t i = (size_t)blockIdx.x * 512 + threadIdx.x; i < (size_t)1024 * 256; i += (size_t)gridDim.x * 512) {
            { const int n = (int)(i >> 8), k = (int)(i & 255), pn = n >> 8, rem = n & 255, bj = rem >> 7, wc = (rem >> 5) & 3, x = rem & 31;
              WUKP[i] = f2bf(p.o_w_uk[(size_t)k * 1024 + (4 * pn + wc) * 64 + 32 * bj + x]); }
            { const int d = (int)(i & 63), r = (int)((i >> 6) & 255), h = (int)(i >> 14);
              WQP[i] = f2bf(p.o_w_uk[(size_t)r * 1024 + h * 64 + d] * p.o_g_k[d] * 0.125f); }
        }
    }
    tconv(p.o_w_uv, 1024, 0, 1024, 256, (bf16_t*)(ws + OFF_WUVT), tile);
    tconv(p.o_w_out, 1024, 0, 1024, 1024, (bf16_t*)(ws + OFF_WO1T), tile);
    rmsnorm_rows<8>(p.x, p.e_norm, (bf16_t*)(ws + OFF_XN), p.e_w_in, EIN, 5120, p.e_b_if, 1.0f, (float*)(ws + OFF_GATES), (float*)lds);
}

__device__ __forceinline__ void phase_conv_scan(const P& p, unsigned char* lds) {
    unsigned char* ws = p.ws; const int tid = threadIdx.x;
    const float* GATES = (const float*)(ws + OFF_GATES);
    float *BQ = (float*)(ws + OFF_BQ), *IQ = (float*)(ws + OFF_IQ), *MT = (float*)(ws + OFF_MT), *CH = (float*)(ws + OFF_CH);
    {
        const int lane = tid & 63, wave = tid >> 6;
        for (int task = blockIdx.x * 8 + wave; task < 2048; task += gridDim.x * 8) {
            const int bh = task >> 8, c = task & 255, batch = bh >> 2, head = bh & 3; const size_t t = (size_t)batch * SEQ + c * 64 + lane;
            const float ig = GATES[t * 8 + head], f = GATES[t * 8 + 4 + head];
            float b = fminf(f, 0.f) - log1pf(__expf(-fabsf(f)));
#pragma unroll
            for (int o = 1; o < 64; o <<= 1) { const float y = __shfl_up(b, o); if (lane >= o) b += y; }
            float rm = ig - b;
#pragma unroll
            for (int o = 1; o < 64; o <<= 1) { const float y = __shfl_up(rm, o); if (lane >= o) rm = fmaxf(rm, y); }
            BQ[t * 4 + head] = b; IQ[t * 4 + head] = ig; MT[t * 4 + head] = rm;
            if (lane == 63) { CH[4096 + bh * 256 + c] = b; CH[bh * 256 + c] = b + rm; }
        }
    }
    const bf16_t* QB = (const bf16_t*)(ws + OFF_QB); const bf16_t* KB = (const bf16_t*)(ws + OFF_KB);
    bf16_t* Y = (bf16_t*)(ws + OFF_Y); bf16_t* KT = (bf16_t*)(ws + OFF_TMP);
    for (size_t it = (size_t)blockIdx.x * 512 + tid; it < (size_t)T * 256; it += (size_t)gridDim.x * 512) {
        const size_t t = it >> 8; const int c0 = (int)(it & 255) * 8, isk = c0 >= 1024, cc = c0 & 1023; const int s = (int)(t & (SEQ - 1));
        const bf16_t* src = isk ? KB : QB;
        float acc[8];
#pragma unroll
        for (int i = 0; i < 8; ++i) acc[i] = 0.f;
#pragma unroll
        for (int j = 0; j < 4; ++j) {
            if (s - 3 + j >= 0) {
                const u32x4 w = *(const u32x4*)(src + (t - 3 + j) * 1024 + cc);
                const f32x4 c0v = *(const f32x4*)(p.e_conv + j * 2048 + c0), c1v = *(const f32x4*)(p.e_conv + j * 2048 + c0 + 4);
                acc[0] += c0v[0] * bflo(w.x); acc[1] += c0v[1] * bfhi(w.x); acc[2] += c0v[2] * bflo(w.y); acc[3] += c0v[3] * bfhi(w.y);
                acc[4] += c1v[0] * bflo(w.z); acc[5] += c1v[1] * bfhi(w.z); acc[6] += c1v[2] * bflo(w.w); acc[7] += c1v[3] * bfhi(w.w);
            }
        }
        const float sc = isk ? 0.0625f : 1.0f;
        u32x4 o; o.x = pk2(siluf_(acc[0]) * sc, siluf_(acc[1]) * sc); o.y = pk2(siluf_(acc[2]) * sc, siluf_(acc[3]) * sc);
        o.z = pk2(siluf_(acc[4]) * sc, siluf_(acc[5]) * sc); o.w = pk2(siluf_(acc[6]) * sc, siluf_(acc[7]) * sc);
        if (isk) *(u32x4*)(KT + t * 1024 + cc) = o; else *(u32x4*)(Y + t * 2048 + 1024 + cc) = o;
    }
}

typedef float f32x16 __attribute__((ext_vector_type(16)));
constexpr int ML_RS = 528, ML_WS = 144;
__device__ __forceinline__ bf16x8 ml_tr8(const LAS unsigned char* a, int second_off) {
    const v4i16_t t0 = __builtin_amdgcn_ds_read_tr16_b64_v4i16((LAS v4i16_t*)a);
    const v4i16_t t1 = __builtin_amdgcn_ds_read_tr16_b64_v4i16((LAS v4i16_t*)(a + second_off));
    bf16x8 r; r[0] = t0[0]; r[1] = t0[1]; r[2] = t0[2]; r[3] = t0[3]; r[4] = t1[0]; r[5] = t1[1]; r[6] = t1[2]; r[7] = t1[3]; return r;
}
__device__ __forceinline__ void mlstm_chunk_scan(const float* CH, int bh, LAS float* sB, LAS float* sMp, LAS float* sMn) {
    const int tid = threadIdx.x;
    if (tid < 256) { sB[tid] = CH[4096 + bh * 256 + tid]; sMn[tid] = CH[bh * 256 + tid]; }
    __syncthreads();
    if (tid == 0) { float m = 0.f; for (int c = 0; c < 256; ++c) { const float g = sMn[c]; sMp[c] = m; m = fmaxf(sB[c] + m, g); sMn[c] = m; } }
    __syncthreads();
}
template <bool FULL>
__device__ __forceinline__ void mlstm_units(const P& p, unsigned char* lds_) {
    unsigned char* ws = p.ws; const int tid0 = threadIdx.x;
    const int w = __builtin_amdgcn_readfirstlane(tid0 >> 6);
    const bf16_t* Yq = (const bf16_t*)(ws + OFF_Y); bf16_t* Yo = (bf16_t*)(ws + OFF_Y);
    const bf16_t* KT = (const bf16_t*)(ws + OFF_TMP); const bf16_t* VB = (const bf16_t*)(ws + OFF_VB);
    float* ST = (float*)(ws + OFF_QB); float* NS = (float*)(ws + OFF_NS);
    const float *BQ = (const float*)(ws + OFF_BQ), *IQ = (const float*)(ws + OFF_IQ), *MT = (const float*)(ws + OFF_MT), *CH = (const float*)(ws + OFF_CH);
    LAS unsigned char* Qs = (LAS unsigned char*)lds_;
    LAS unsigned char* Ks = Qs + 64 * ML_RS;
    LAS unsigned char* Vs = Ks + 64 * ML_RS;
    LAS unsigned char* Wl = Vs + 64 * ML_RS;
    LAS float* sa = (LAS float*)(Wl + 64 * ML_WS);
    LAS float* sden = sa + 64; LAS float* ssw = sden + 64; LAS float* sf = ssw + 64; LAS float* sg = sf + 64; LAS float* nd = sg + 64; LAS float* rden = nd + 64; LAS float* ns = rden + 64;
    LAS float* cB = ns + 256; LAS float* cMp = cB + 256; LAS float* cMn = cMp + 256;
    for (int unit = blockIdx.x; unit < 256; unit += gridDim.x) {
        const int bh = unit >> 5, S = unit & 31, batch = bh >> 2, head = bh & 3;
        const int tid = tid0, lane = tid0 & 63, hh = lane >> 5;
        __syncthreads();
        mlstm_chunk_scan(CH, bh, cB, cMp, cMn);
        f32x16 st[8]; float nreg = 0.f;
        if (FULL) {
#pragma unroll
            for (int kt = 0; kt < 8; ++kt) {
                int lz = lane; asm volatile("" : "+v"(lz) :: "memory");
                const float* sp = ST + (size_t)unit * 65536 + 32 * w + (lz & 31) + (size_t)(32 * kt + 4 * (lz >> 5)) * 256;
#pragma unroll
                for (int r = 0; r < 16; ++r) st[kt][r] = sp[((r & 3) + 8 * (r >> 2)) * 256];
            }
            if (tid < 256) nreg = NS[unit * 256 + tid];
        } else {
#pragma unroll
            for (int kt = 0; kt < 8; ++kt)
#pragma unroll
                for (int r = 0; r < 16; ++r) st[kt][r] = 0.f;
        }
#pragma unroll 1
        for (int cc = 0; cc < 8; ++cc) {
            int tid = tid0; asm volatile("" : "+v"(tid));
            const int lane = tid & 63, l31 = lane & 31, hh = lane >> 5, fr = lane & 15, fq = lane >> 4;
            const int trow = 8 * hh + (fr >> 2), tcol = (16 * (fq & 1) + 4 * (fr & 3)) * 2;
            const int ch = S * 8 + cc; const size_t t0 = (size_t)batch * SEQ + ch * 64;
            const float mprev = cMp[ch], mnew = cMn[ch], blast = cB[ch];
            const float decay = __expf(blast + mprev - mnew);
            __syncthreads();
#pragma unroll
            for (int j = 0; j < 4; ++j) { const int e = tid + 512 * j, r = e >> 5, cg = e & 31;
                *(LAS u32x4*)(Ks + r * ML_RS + cg * 16) = *(const u32x4*)(KT + (t0 + r) * 1024 + head * 256 + cg * 8);
                *(LAS u32x4*)(Vs + r * ML_RS + cg * 16) = *(const u32x4*)(VB + (t0 + r) * 1024 + head * 256 + cg * 8);
                if (FULL) *(LAS u32x4*)(Qs + r * ML_RS + cg * 16) = *(const u32x4*)(Yq + (t0 + r) * 2048 + 1024 + head * 256 + cg * 8); }
            if (tid < 64) { const float bq = BQ[(t0 + tid) * 4 + head], iq = IQ[(t0 + tid) * 4 + head], mt = bq + fmaxf(mprev, MT[(t0 + tid) * 4 + head]);
                sa[tid] = __expf(bq + mprev - mt); sden[tid] = __expf(-mt); ssw[tid] = __expf(blast - bq + iq - mnew); sf[tid] = bq - mt; sg[tid] = iq - bq; }
            if (FULL && tid < 256) ns[tid] = nreg;
            __syncthreads();
            bf16x8 bv[4];
            if (!FULL) {
#pragma unroll
                for (int ks = 0; ks < 4; ++ks) bv[ks] = ml_tr8(Vs + (16 * ks + trow) * ML_RS + 64 * w + tcol, 4 * ML_RS);
            }
            if (FULL) {
                { const int tt = w >> 1;
#pragma unroll
                  for (int si = 0; si < 2; ++si) { const int ss = 2 * (w & 1) + si;
                    f32x4 acc = (f32x4){0.f, 0.f, 0.f, 0.f};
                    if (ss <= tt) {
#pragma unroll
                        for (int ks = 0; ks < 8; ++ks) { const bf16x8 a = *(const LAS bf16x8*)(Qs + (16 * tt + fr) * ML_RS + (32 * ks + 8 * fq) * 2), b = *(const LAS bf16x8*)(Ks + (16 * ss + fr) * ML_RS + (32 * ks + 8 * fq) * 2);
                            acc = __builtin_amdgcn_mfma_f32_16x16x32_bf16(a, b, acc, 0, 0, 0); } }
                    const int sidx = 16 * ss + fr; const float gs = sg[sidx];
#pragma unroll
                    for (int j = 0; j < 4; ++j) { const int tix = 16 * tt + 4 * fq + j; const float wv = (sidx <= tix) ? __expf(sf[tix] + gs) * acc[j] : 0.f;
                        *(LAS bf16_t*)(Wl + tix * ML_WS + sidx * 2) = f2bf(wv); } } }
#pragma unroll
                for (int i = 0; i < 8; ++i) { const int tix = 8 * w + i; const u32x2 qv = *(const LAS u32x2*)(Qs + tix * ML_RS + lane * 8); const f32x4 nv = *(const LAS f32x4*)(ns + lane * 4);
                    float part = bflo(qv.x) * nv[0] + bfhi(qv.x) * nv[1] + bflo(qv.y) * nv[2] + bfhi(qv.y) * nv[3]; part = wave_sum(part); if (lane == 0) nd[tix] = part; }
                __syncthreads();
                f32x16 acc[2];
#pragma unroll
                for (int t2 = 0; t2 < 2; ++t2) {
#pragma unroll
                    for (int r = 0; r < 16; ++r) acc[t2][r] = 0.f;
                }
#pragma unroll
                for (int kt = 0; kt < 8; ++kt) {
                    asm volatile("" ::: "memory");
#pragma unroll
                    for (int s2 = 0; s2 < 2; ++s2) {
                        u32x4 bw; bw.x = pg8::cvt_pk_bf16(st[kt][8 * s2 + 0], st[kt][8 * s2 + 1]); bw.y = pg8::cvt_pk_bf16(st[kt][8 * s2 + 2], st[kt][8 * s2 + 3]);
                        bw.z = pg8::cvt_pk_bf16(st[kt][8 * s2 + 4], st[kt][8 * s2 + 5]); bw.w = pg8::cvt_pk_bf16(st[kt][8 * s2 + 6], st[kt][8 * s2 + 7]);
                        const bf16x8 bfrag = __builtin_bit_cast(bf16x8, bw);
#pragma unroll
                        for (int t2 = 0; t2 < 2; ++t2) { const LAS unsigned char* qa = Qs + (32 * t2 + l31) * ML_RS + (32 * kt + 16 * s2 + 4 * hh) * 2;
                            const u32x2 lo = *(const LAS u32x2*)qa, hi = *(const LAS u32x2*)(qa + 16); u32x4 aw; aw.x = lo.x; aw.y = lo.y; aw.z = hi.x; aw.w = hi.y;
                            acc[t2] = __builtin_amdgcn_mfma_f32_32x32x16_bf16(__builtin_bit_cast(bf16x8, aw), bfrag, acc[t2], 0, 0, 0); }
                    }
                }
                asm volatile("" ::: "memory");
#pragma unroll
                for (int t2 = 0; t2 < 2; ++t2)
#pragma unroll
                    for (int r = 0; r < 16; ++r) acc[t2][r] *= sa[32 * t2 + (r & 3) + 8 * (r >> 2) + 4 * hh];
#pragma unroll
                for (int ks = 0; ks < 4; ++ks) bv[ks] = ml_tr8(Vs + (16 * ks + trow) * ML_RS + 64 * w + tcol, 4 * ML_RS);
#pragma unroll
                for (int ks = 0; ks < 4; ++ks)
#pragma unroll
                    for (int t2 = 0; t2 < 2; ++t2) { const bf16x8 a = *(const LAS bf16x8*)(Wl + (32 * t2 + l31) * ML_WS + (16 * ks + 8 * hh) * 2);
                        acc[t2] = __builtin_amdgcn_mfma_f32_32x32x16_bf16(a, bv[ks], acc[t2], 0, 0, 0); }
#pragma unroll
                for (int i = 0; i < 8; ++i) { const int tix = 8 * w + i; float rs = bf2f(*(const LAS bf16_t*)(Wl + tix * ML_WS + lane * 2)); rs = wave_sum(rs);
                    if (lane == 0) { const float nq = sa[tix] * nd[tix] + rs; rden[tix] = 1.0f / fmaxf(fabsf(nq), sden[tix]); } }
                __syncthreads();
                bf16_t* yo = Yo + t0 * 2048 + head * 256 + 32 * w + l31;
#pragma unroll
                for (int t2 = 0; t2 < 2; ++t2)
#pragma unroll
                    for (int r = 0; r < 16; ++r) { const int tix = 32 * t2 + (r & 3) + 8 * (r >> 2) + 4 * hh; yo[(size_t)tix * 2048] = f2bf(acc[t2][r] * rden[tix]); }
            }
#pragma unroll
            for (int kt = 0; kt < 8; ++kt) st[kt] *= decay;
#pragma unroll
            for (int ks = 0; ks < 4; ++ks) {
                const u32x4 raw = __builtin_bit_cast(u32x4, bv[ks]); const LAS float* sw8 = ssw + 16 * ks + 8 * hh;
                u32x4 sc; sc.x = pg8::cvt_pk_bf16(bflo(raw.x) * sw8[0], bfhi(raw.x) * sw8[1]); sc.y = pg8::cvt_pk_bf16(bflo(raw.y) * sw8[2], bfhi(raw.y) * sw8[3]);
                sc.z = pg8::cvt_pk_bf16(bflo(raw.z) * sw8[4], bfhi(raw.z) * sw8[5]); sc.w = pg8::cvt_pk_bf16(bflo(raw.w) * sw8[6], bfhi(raw.w) * sw8[7]);
                const bf16x8 bs = __builtin_bit_cast(bf16x8, sc);
#pragma unroll
                for (int kt = 0; kt < 8; ++kt) { if ((kt & 3) == 0) asm volatile("" ::: "memory");
                    const bf16x8 a = ml_tr8(Ks + (16 * ks + trow) * ML_RS + 64 * kt + tcol, 4 * ML_RS);
                    st[kt] = __builtin_amdgcn_mfma_f32_32x32x16_bf16(a, bs, st[kt], 0, 0, 0); }
            }
            if (tid < 256) { float nacc = 0.f;
#pragma unroll 8
                for (int s2 = 0; s2 < 64; ++s2) nacc += ssw[s2] * bf2f(*(const LAS bf16_t*)(Ks + s2 * ML_RS + tid * 2));
                nreg = decay * nreg + nacc; }
        }
        if (!FULL) {
#pragma unroll
            for (int kt = 0; kt < 8; ++kt) {
                int lz = lane; asm volatile("" : "+v"(lz) :: "memory");
                float* sp = ST + (size_t)unit * 65536 + 32 * w + (lz & 31) + (size_t)(32 * kt + 4 * (lz >> 5)) * 256;
#pragma unroll
                for (int r = 0; r < 16; ++r) sp[((r & 3) + 8 * (r >> 2)) * 256] = st[kt][r];
            }
            if (tid < 256) NS[unit * 256 + tid] = nreg;
        }
    }
}
__device__ __forceinline__ void phase_mlstm_scan(const P& p, unsigned char* lds_) {
    unsigned char* ws = p.ws; const int tid = threadIdx.x;
    float* ST = (float*)(ws + OFF_QB); float* NS = (float*)(ws + OFF_NS); const float* CH = (const float*)(ws + OFF_CH);
    LAS float* DS = (LAS float*)lds_;
    LAS float* cB = DS + 256; LAS float* cMp = cB + 256; LAS float* cMn = cMp + 256;
    for (int bh = 0; bh < 8; ++bh) {
        __syncthreads();
        mlstm_chunk_scan(CH, bh, cB, cMp, cMn);
        if (tid < 32) { float d = 1.f; for (int c = 0; c < 8; ++c) { const int ch = tid * 8 + c; d *= __expf(cB[ch] + cMp[ch] - cMn[ch]); } DS[bh * 32 + tid] = d; }
    }
    __syncthreads();
    const int per = 65536 + 256;
    for (int it = blockIdx.x * 512 + tid; it < 8 * per; it += gridDim.x * 512) {
        const int bh = it / per, e = it - bh * per;
        float* base; size_t stride;
        if (e < 65536) { base = ST + (size_t)bh * 32 * 65536 + e; stride = 65536; } else { base = NS + (size_t)bh * 32 * 256 + (e - 65536); stride = 256; }
        float carry = 0.f;
#pragma unroll 8
        for (int S = 0; S < 32; ++S) { const float tmp = base[S * stride]; base[S * stride] = carry; carry = DS[bh * 32 + S] * carry + tmp; }
    }
}

__device__ __forceinline__ void phase_ya_pool(const P& p) {
    unsigned char* ws = p.ws; const int tid = threadIdx.x, lane = tid & 63, wave = tid >> 6;
    bf16_t* Y = (bf16_t*)(ws + OFF_Y); const bf16_t* O = (const bf16_t*)(ws + OFF_QB); const bf16_t* ZA = (const bf16_t*)(ws + OFF_KB);
    for (int it = blockIdx.x * 8 + wave; it < T * 4; it += gridDim.x * 8) {
        const size_t t = (size_t)(it >> 2); const int head = it & 3, c = head * 256 + lane * 4;
        const u32x2 hw = *(const u32x2*)(Y + t * 2048 + c), ow = *(const u32x2*)(O + t * 1024 + c), zw = *(const u32x2*)(ZA + t * 1024 + c);
        float v[4] = {bflo(hw.x) * bflo(ow.x), bfhi(hw.x) * bfhi(ow.x), bflo(hw.y) * bflo(ow.y), bfhi(hw.y) * bfhi(ow.y)};
        float ss = wave_sum(v[0] * v[0] + v[1] * v[1] + v[2] * v[2] + v[3] * v[3]);
        const float rstd = rsqrtf(ss * (1.0f / 256.0f) + EPS);
        const f32x4 g = *(const f32x4*)(p.e_g_head + c);
        u32x2 o; o.x = pk2(v[0] * rstd * g[0] * bflo(zw.x), v[1] * rstd * g[1] * bfhi(zw.x)); o.y = pk2(v[2] * rstd * g[2] * bflo(zw.y), v[3] * rstd * g[3] * bfhi(zw.y));
        *(u32x2*)(Y + t * 2048 + c) = o;
    }
    const bf16_t* U = (const bf16_t*)(ws + OFF_VB);
    for (size_t it = (size_t)blockIdx.x * 512 + tid; it < (size_t)T * 128; it += (size_t)gridDim.x * 512) {
        const size_t t = it >> 7; const int c0 = (int)(it & 127) * 8, g = c0 >> 8, win = 2 << g, s = (int)(t & (SEQ - 1)); const int cnt = (s + 1 < win) ? s + 1 : win;
        float acc[8], self[8];
#pragma unroll
        for (int i = 0; i < 8; ++i) { acc[i] = 0.f; self[i] = 0.f; }
        for (int j = 0; j < cnt; ++j) { const u32x4 w = *(const u32x4*)(U + (t - j) * 1024 + c0);
            const float f[8] = {bflo(w.x), bfhi(w.x), bflo(w.y), bfhi(w.y), bflo(w.z), bfhi(w.z), bflo(w.w), bfhi(w.w)};
#pragma unroll
            for (int i = 0; i < 8; ++i) { acc[i] += f[i]; if (j == 0) self[i] = f[i]; } }
        const float inv = 1.0f / (float)cnt;
        bf16_t* yp = Y + t * 2048 + 1024 + c0; const u32x4 z = *(const u32x4*)yp;
        const float zf[8] = {bflo(z.x), bfhi(z.x), bflo(z.y), bfhi(z.y), bflo(z.z), bfhi(z.z), bflo(z.w), bfhi(z.w)};
        const f32x4 s0 = *(const f32x4*)(p.e_s_pool + c0), s1 = *(const f32x4*)(p.e_s_pool + c0 + 4);
        float o[8];
#pragma unroll
        for (int i = 0; i < 8; ++i) o[i] = (acc[i] * inv - self[i]) * (i < 4 ? s0[i] : s1[i - 4]) * zf[i];
        u32x4 ow; ow.x = pk2(o[0], o[1]); ow.y = pk2(o[2], o[3]); ow.z = pk2(o[4], o[5]); ow.w = pk2(o[6], o[7]);
        *(u32x4*)yp = ow;
    }
}

__device__ __forceinline__ void headnorm64(bf16_t* X, const float* g) {
    const int lane = threadIdx.x & 63, wave = threadIdx.x >> 6;
    for (int t = blockIdx.x * 8 + wave; t < T; t += gridDim.x * 8) {
        bf16_t* r = X + (size_t)t * 1024 + lane * 16;
        const u32x4 a = *(const u32x4*)r, b = *(const u32x4*)(r + 8);
        float f[16] = {bflo(a.x), bfhi(a.x), bflo(a.y), bfhi(a.y), bflo(a.z), bfhi(a.z), bflo(a.w), bfhi(a.w), bflo(b.x), bfhi(b.x), bflo(b.y), bfhi(b.y), bflo(b.z), bfhi(b.z), bflo(b.w), bfhi(b.w)};
        float ss = 0.f;
#pragma unroll
        for (int i = 0; i < 16; ++i) ss += f[i] * f[i];
        ss += __shfl_xor(ss, 1); ss += __shfl_xor(ss, 2);
        const float rstd = rsqrtf(ss * (1.0f / 64.0f) + EPS);
        const float* gg = g + (lane & 3) * 16;
#pragma unroll
        for (int i = 0; i < 16; ++i) f[i] = f[i] * rstd * gg[i];
        u32x4 oa, ob; oa.x = pk2(f[0], f[1]); oa.y = pk2(f[2], f[3]); oa.z = pk2(f[4], f[5]); oa.w = pk2(f[6], f[7]);
        ob.x = pk2(f[8], f[9]); ob.y = pk2(f[10], f[11]); ob.z = pk2(f[12], f[13]); ob.w = pk2(f[14], f[15]);
        *(u32x4*)r = oa; *(u32x4*)(r + 8) = ob;
    }
}
__device__ __forceinline__ void phase_qnorm_ckvnorm(const P& p) {
    unsigned char* ws = p.ws; const int lane = threadIdx.x & 63, wave = threadIdx.x >> 6;
    headnorm64((bf16_t*)(ws + OFF_TMP), p.o_g_q);
    bf16_t* CKVN = (bf16_t*)(ws + OFF_CKVN);
    for (int t = blockIdx.x * 8 + wave; t < T; t += gridDim.x * 8) {
        const u32x2 w = *(const u32x2*)(CKVN + (size_t)t * 256 + lane * 4);
        const float v[4] = {bflo(w.x), bfhi(w.x), bflo(w.y), bfhi(w.y)};
        const float ss = wave_sum(v[0] * v[0] + v[1] * v[1] + v[2] * v[2] + v[3] * v[3]);
        const float rstd = rsqrtf(ss * (1.0f / 256.0f) + EPS);
        const f32x4 g = *(const f32x4*)(p.o_g_kv + lane * 4);
        u32x2 o; o.x = pk2(v[0] * rstd * g[0], v[1] * rstd * g[1]); o.y = pk2(v[2] * rstd * g[2], v[3] * rstd * g[3]);
        *(u32x2*)(CKVN + (size_t)t * 256 + lane * 4) = o;
    }
}

__device__ __forceinline__ unsigned okey(float s) { if (s == 0.f) s = 0.f; const unsigned u = __float_as_uint(s); return (u & 0x80000000u) ? ~u : (u | 0x80000000u); }

__device__ __forceinline__ void indexer_slow_query(const P& p, unsigned char* lds, size_t t) {
    unsigned char* ws = p.ws; const int tid = threadIdx.x, lane = tid & 63, wave = tid >> 6;
    const _Float16* QI = (const _Float16*)(ws + OFF_QI); const _Float16* KI = (const _Float16*)(ws + OFF_KI); const float* WI = (const float*)(ws + OFF_WI);
    unsigned short* IDX = (unsigned short*)(ws + OFF_IDX);
    unsigned* sc = (unsigned*)lds; unsigned* hist = sc + 16384; float* qs = (float*)(hist + 256); unsigned* misc = (unsigned*)(qs + 256); unsigned* wsum = misc + 16;
    const int batch = (int)(t >> 14), pos = (int)(t & (SEQ - 1)), n = pos + 1;
    __syncthreads();
    if (tid < 256) qs[tid] = (float)QI[t * 256 + tid];
    const float w0 = WI[t * 4 + 0], w1 = WI[t * 4 + 1], w2 = WI[t * 4 + 2], w3 = WI[t * 4 + 3];
    __syncthreads();
    const _Float16* kbase = KI + (size_t)batch * SEQ * 64;
    for (int s = tid; s < n; s += 512) {
        asm volatile("" ::: "memory");
        typedef _Float16 h8 __attribute__((ext_vector_type(8)));
        const h8* kr = (const h8*)(kbase + (size_t)s * 64);
        float d0 = 0.f, d1 = 0.f, d2 = 0.f, d3 = 0.f;
#pragma unroll
        for (int j = 0; j < 8; ++j) { const h8 kv = kr[j];
#pragma unroll
            for (int e = 0; e < 8; ++e) { const int d = j * 8 + e; const float kf = (float)kv[e]; d0 += qs[d] * kf; d1 += qs[64 + d] * kf; d2 += qs[128 + d] * kf; d3 += qs[192 + d] * kf; } }
        float score = w0 * fmaxf(d0, 0.f); score = fmaf(w1, fmaxf(d1, 0.f), score); score = fmaf(w2, fmaxf(d2, 0.f), score); score = fmaf(w3, fmaxf(d3, 0.f), score);
        if (fabsf(score) < 1e-30f) score = 0.f;
        sc[s] = okey(score);
    }
    unsigned prefix = 0, krem = 256;
    for (int pass = 0; pass < 4; ++pass) {
        const int shift = 24 - 8 * pass;
        __syncthreads();
        if (tid < 256) hist[tid] = 0;
        __syncthreads();
        for (int s = tid; s < n; s += 512) { const unsigned k = sc[s]; if (pass == 0 || (k >> (shift + 8)) == prefix) atomicAdd(&hist[(k >> shift) & 255u], 1u); }
        __syncthreads();
        if (tid == 0) { unsigned cum = 0; int bin = 255; for (; bin > 0; --bin) { const unsigned c = hist[bin]; if (cum + c >= krem) break; cum += c; } misc[0] = (unsigned)bin; misc[1] = krem - cum; }
        __syncthreads();
        prefix = (prefix << 8) | misc[0]; krem = misc[1];
    }
    const unsigned ngt_total = 256u - krem;
    unsigned lg = 0, le = 0; const int s0 = tid * 32;
    for (int s = s0; s < s0 + 32 && s < n; ++s) { const unsigned k = sc[s]; lg += (k > prefix); le += (k == prefix); }
    unsigned pk = lg | (le << 16), incl = pk;
#pragma unroll
    for (int o = 1; o < 64; o <<= 1) { const unsigned y = __shfl_up(incl, o); if (lane >= o) incl += y; }
    if (lane == 63) wsum[wave] = incl;
    __syncthreads();
    unsigned base = 0;
    for (int w = 0; w < wave; ++w) base += wsum[w];
    const unsigned excl = base + incl - pk; unsigned bg = excl & 0xffffu, be = excl >> 16;
    for (int s = s0; s < s0 + 32 && s < n; ++s) { const unsigned k = sc[s];
        if (k > prefix) { IDX[t * 256 + bg] = (unsigned short)s; ++bg; }
        else if (k == prefix) { if (be < krem) IDX[t * 256 + ngt_total + be] = (unsigned short)s; ++be; } }
    __syncthreads();
}

typedef _Float16 half8 __attribute__((ext_vector_type(8)));
constexpr int IX_CAP = 1024, IX_ZBIN = 1024;
__device__ __forceinline__ unsigned ix_key(const f32x4 a, const f32x4 w) {
    const float r0 = a[0] > 0.f ? a[0] : 0.f, r1 = a[1] > 0.f ? a[1] : 0.f, r2 = a[2] > 0.f ? a[2] : 0.f, r3 = a[3] > 0.f ? a[3] : 0.f;
    float s = w[0] * r0; s = fmaf(w[1], r1, s); s = fmaf(w[2], r2, s); s = fmaf(w[3], r3, s);
    s = fabsf(s) < 1e-30f ? 0.f : s;
    const unsigned u = __float_as_uint(s);
    return u ^ ((unsigned)((int)u >> 31) | 0x80000000u);
}
#define LDS_ADD(ptr, v) __hip_atomic_fetch_add((ptr), (v), __ATOMIC_RELAXED, __HIP_MEMORY_SCOPE_WORKGROUP)
__device__ __forceinline__ void phase_indexer(const P& p, unsigned char* lds) {
    unsigned char* ws = p.ws; const int tid = threadIdx.x, lane = tid & 63, kl = lane & 15, g = lane >> 4;
    const int wave = __builtin_amdgcn_readfirstlane(tid >> 6);
    const _Float16* QI = (const _Float16*)(ws + OFF_QI); const _Float16* KI = (const _Float16*)(ws + OFF_KI); const float* WI = (const float*)(ws + OFF_WI);
    unsigned short* IDX = (unsigned short*)(ws + OFF_IDX); int* CNT = (int*)(ws + OFF_CNT);
    LAS unsigned* hist = (LAS unsigned*)lds;
    LAS unsigned* zc = hist + 16 * 2048;
    LAS unsigned* zpre = zc + 128;
    LAS int* qTbin = (LAS int*)(zpre + 128);
    LAS int* qCab = qTbin + 16; LAS int* qCb = qCab + 16; LAS unsigned* qNgt = (LAS unsigned*)(qCb + 16); LAS unsigned* qNcand = qNgt + 16; LAS int* qOvf = (LAS int*)(qNcand + 16);
    LAS unsigned* ovl = (LAS unsigned*)(lds + 136 * 1024);
    if (tid == 0) ovl[0] = 0u;
    const int G = gridDim.x, nround = (T / 16) / G;
#pragma unroll 1
    for (int i = 0; i < nround; ++i) {
        const int tix = (i & 1) ? i * G + (G - 1 - (int)blockIdx.x) : i * G + (int)blockIdx.x;
        const int batch = tix & 1, tb = tix >> 1, p0 = tb * 16; const size_t t0 = (size_t)batch * SEQ + p0;
        __syncthreads();
        if (p0 + 16 <= 256) {
#pragma unroll
            for (int j = 0; j < 8; ++j) { const int e = tid + 512 * j, q = e >> 8, jj = e & 255; IDX[(t0 + q) * 256 + jj] = (unsigned short)(jj <= p0 + q ? jj : 0); }
            if (tid < 16) CNT[t0 + tid] = p0 + tid + 1;
            continue;
        }
#pragma unroll
        for (int j = 0; j < 16; ++j) ((LAS u32x4*)hist)[tid + 512 * j] = (u32x4){0u, 0u, 0u, 0u};
        if (tid < 256) zc[tid] = 0u;
        if (tid < 16) { qNgt[tid] = 0u; qNcand[tid] = 0u; qOvf[tid] = 0; }
        half8 af[4][2]; f32x4 wv[4];
#pragma unroll
        for (int rt = 0; rt < 4; ++rt) {
#pragma unroll
            for (int ks = 0; ks < 2; ++ks) af[rt][ks] = *(const half8*)(QI + (t0 + 4 * rt + (kl >> 2)) * 256 + (kl & 3) * 64 + 32 * ks + 8 * g);
            wv[rt] = *(const f32x4*)(WI + (t0 + 4 * rt + g) * 4);
        }
        __syncthreads();
        const int nblk = tb + 1, L = (nblk + 7) >> 3, b0 = wave * L, b1 = (b0 + L < nblk) ? b0 + L : nblk;
        const _Float16* kb = KI + (size_t)batch * SEQ * 64 + kl * 64 + 8 * g;
        LAS unsigned* hg = hist + g * 4 * 2048;
        {
            unsigned zcnt[4] = {0u, 0u, 0u, 0u};
            half8 k0 = (half8){0, 0, 0, 0, 0, 0, 0, 0}, k1 = k0;
            if (b0 < b1) { k0 = *(const half8*)(kb + (size_t)b0 * 1024); k1 = *(const half8*)(kb + (size_t)b0 * 1024 + 32); }
#pragma unroll 1
            for (int b = b0; b < b1; ++b) {
                const int bn = (b + 1 < b1) ? b + 1 : b; const int s = b * 16 + kl;
                const half8 n0 = *(const half8*)(kb + (size_t)bn * 1024), n1 = *(const half8*)(kb + (size_t)bn * 1024 + 32);
#pragma unroll
                for (int rt = 0; rt < 4; ++rt) {
                    f32x4 acc = __builtin_amdgcn_mfma_f32_16x16x32_f16(af[rt][0], k0, (f32x4){0.f, 0.f, 0.f, 0.f}, 0, 0, 0);
                    acc = __builtin_amdgcn_mfma_f32_16x16x32_f16(af[rt][1], k1, acc, 0, 0, 0);
                    const unsigned key = ix_key(acc, wv[rt]);
                    if (s <= p0 + 4 * rt + g) { LDS_ADD(hg + rt * 2048 + (key >> 21), 1u); zcnt[rt] += (key == 0x80000000u) ? 1u : 0u; }
                }
                k0 = n0; k1 = n1;
            }
#pragma unroll
            for (int rt = 0; rt < 4; ++rt) if (zcnt[rt]) LDS_ADD(zc + (g * 4 + rt) * 8 + wave, zcnt[rt]);
        }
        __syncthreads();
#pragma unroll 1
        for (int qq = 0; qq < 2; ++qq) {
            const int q = 2 * wave + qq; const LAS unsigned* h = hist + q * 2048;
            unsigned cs = 0; const int top = 2047 - 32 * lane;
            for (int ii = 0; ii < 32; ++ii) cs += h[top - ((ii + lane) & 31)];
            unsigned incl = cs;
#pragma unroll
            for (int o = 1; o < 64; o <<= 1) { const unsigned y = __shfl_up(incl, o); if (lane >= o) incl += y; }
            const unsigned long long m = __ballot(incl >= 256u);
            const int Ls = m ? (__ffsll((long long)m) - 1) : 63;
            unsigned cabv = __shfl(incl - cs, Ls), cbv = 0; int tbin = 0; bool found = false;
            for (int ii = 0; ii < 32; ++ii) { const unsigned c = h[2047 - 32 * Ls - ii]; if (!found && cabv + c >= 256u) { tbin = 2047 - 32 * Ls - ii; cbv = c; found = true; } if (!found) cabv += c; }
            if (lane == 0) { qTbin[q] = tbin; qCab[q] = (int)cabv; qCb[q] = (int)cbv; if (tbin != IX_ZBIN && cbv > (unsigned)IX_CAP) qOvf[q] = 1; }
            { unsigned v = lane < 8 ? zc[q * 8 + lane] : 0u, inc = v;
#pragma unroll
              for (int o = 1; o < 8; o <<= 1) { const unsigned y = __shfl_up(inc, o); if (lane >= o) inc += y; }
              if (lane < 8) zpre[q * 8 + lane] = inc - v; }
        }
        __syncthreads();
        {
            int tbn[4], cab[4], rr[4]; unsigned zrun[4];
#pragma unroll
            for (int rt = 0; rt < 4; ++rt) { const int q = g * 4 + rt; tbn[rt] = qOvf[q] ? 4096 : qTbin[q]; cab[rt] = qCab[q]; rr[rt] = 256 - cab[rt]; zrun[rt] = zpre[q * 8 + wave]; }
            half8 k0 = (half8){0, 0, 0, 0, 0, 0, 0, 0}, k1 = k0;
            if (b0 < b1) { k0 = *(const half8*)(kb + (size_t)b0 * 1024); k1 = *(const half8*)(kb + (size_t)b0 * 1024 + 32); }
#pragma unroll 1
            for (int b = b0; b < b1; ++b) {
                const int bn = (b + 1 < b1) ? b + 1 : b; const int s = b * 16 + kl;
                const half8 n0 = *(const half8*)(kb + (size_t)bn * 1024), n1 = *(const half8*)(kb + (size_t)bn * 1024 + 32);
                unsigned key[4]; bool sel[4], inb[4]; unsigned pos[4];
#pragma unroll
                for (int rt = 0; rt < 4; ++rt) {
                    f32x4 acc = __builtin_amdgcn_mfma_f32_16x16x32_f16(af[rt][0], k0, (f32x4){0.f, 0.f, 0.f, 0.f}, 0, 0, 0);
                    acc = __builtin_amdgcn_mfma_f32_16x16x32_f16(af[rt][1], k1, acc, 0, 0, 0);
                    key[rt] = ix_key(acc, wv[rt]); const int bin = (int)(key[rt] >> 21);
                    const bool valid = s <= p0 + 4 * rt + g;
                    sel[rt] = valid && bin > tbn[rt]; inb[rt] = valid && bin == tbn[rt];
                }
#pragma unroll
                for (int rt = 0; rt < 4; ++rt) { const int qs = g * 4 + rt; const bool cand = inb[rt] && tbn[rt] != IX_ZBIN;
                    LAS unsigned* tgt = sel[rt] ? (qNgt + qs) : (cand ? (qNcand + qs) : (zc + lane));
                    pos[rt] = LDS_ADD(tgt, (sel[rt] || cand) ? 1u : 0u); }
#pragma unroll
                for (int rt = 0; rt < 4; ++rt) { const int qs = g * 4 + rt;
                    if (__builtin_expect(tbn[rt] == IX_ZBIN, 0)) {
                        const unsigned long long zm = __ballot(inb[rt]);
                        const unsigned gm = (unsigned)(zm >> (16 * g)) & 0xffffu;
                        if (inb[rt]) { const unsigned pz = zrun[rt] + __popc(gm & ((1u << kl) - 1u)); if ((int)pz < rr[rt]) IDX[(t0 + 4 * rt + g) * 256 + cab[rt] + pz] = (unsigned short)s; }
                        zrun[rt] += __popc(gm);
                    } else if (inb[rt]) { if (pos[rt] < (unsigned)IX_CAP) ((LAS unsigned long long*)(lds + qs * 8192))[pos[rt]] = ((unsigned long long)key[rt] << 16) | (unsigned long long)(0xffffu - (unsigned)s); }
                    if (sel[rt]) IDX[(t0 + 4 * rt + g) * 256 + pos[rt]] = (unsigned short)s;
                }
                k0 = n0; k1 = n1;
            }
        }
        __syncthreads();
#pragma unroll 1
        for (int qq = 0; qq < 2; ++qq) {
            const int qs = 2 * wave + qq; const int tbin = qTbin[qs], n = qCb[qs], cabq = qCab[qs], r = 256 - cabq;
            if (tbin == IX_ZBIN || qOvf[qs]) continue;
            const LAS unsigned long long* cd = (const LAS unsigned long long*)(lds + qs * 8192);
            unsigned short* irow = IDX + (t0 + 4 * (qs & 3) + (qs >> 2)) * 256 + cabq;
            if (r >= n) { for (int c = lane; c < n; c += 64) irow[c] = (unsigned short)(0xffffu - (unsigned)(cd[c] & 0xffffull)); }
            else {
                const int n8 = n & ~7;
                for (int c0 = 0; c0 < n; c0 += 64) {
                    const int c = c0 + lane; const bool have = c < n;
                    const unsigned long long mine = have ? cd[c] : ~0ull;
                    int rank = 0;
                    for (int j = 0; j < n8; j += 8) {
#pragma unroll
                        for (int e = 0; e < 8; ++e) rank += (cd[j + e] > mine) ? 1 : 0;
                    }
                    for (int j = n8; j < n; ++j) rank += (cd[j] > mine) ? 1 : 0;
                    if (have && rank < r) irow[rank] = (unsigned short)(0xffffu - (unsigned)(mine & 0xffffull));
                }
            }
        }
        if (tid < 16) CNT[t0 + tid] = 256;
        if (tid < 16 && qOvf[tid]) { const unsigned k = LDS_ADD(ovl, 1u); ovl[1 + k] = (unsigned)(t0 + 4 * (tid & 3) + (tid >> 2)); }
    }
    __syncthreads();
    const unsigned novl = __builtin_amdgcn_readfirstlane(ovl[0]);
#pragma unroll 1
    for (unsigned k = 0; k < novl; ++k) { const unsigned tq = __builtin_amdgcn_readfirstlane(ovl[1 + k]); indexer_slow_query(p, lds, (size_t)tq); }
}
#undef LDS_ADD

__device__ __forceinline__ void phase_attn(const P& p, unsigned char* lds) {
    unsigned char* ws = p.ws; const int tid = threadIdx.x, lane = tid & 63, hd = lane & 15, g = lane >> 4;
    const int wave = __builtin_amdgcn_readfirstlane(tid >> 6);
    bf16_t* QP = (bf16_t*)(ws + OFF_QP); const bf16_t* CK = (const bf16_t*)(ws + OFF_CKVN); const bf16_t* RK = (const bf16_t*)(ws + OFF_RK);
    const unsigned short* IDX = (const unsigned short*)(ws + OFF_IDX); const int* CNT = (const int*)(ws + OFF_CNT);
    float* biasT = (float*)lds;
    biasT[tid] = p.rel_bias[tid];
    __syncthreads();
    LAS unsigned char* rows = (LAS unsigned char*)(lds + 2048 + (size_t)wave * 18432);
    LAS bf16_t* rkb = (LAS bf16_t*)(rows + 16384);
    LAS unsigned* info = (LAS unsigned*)(rows + 17408);
    const LAS float* biasL = (const LAS float*)lds;
    for (int t = blockIdx.x * 8 + wave; t < T; t += gridDim.x * 8) {
        const int batch = t >> 14, pos = t & (SEQ - 1); const int cnt = CNT[t];
        const size_t rb = (size_t)batch * SEQ;
        asm volatile("s_waitcnt lgkmcnt(0)" ::: "memory");
#pragma unroll
        for (int jj = 0; jj < 4; ++jj) {
            const int j = lane + 64 * jj; int id = IDX[(size_t)t * 256 + j]; if (j >= cnt) id = 0;
            const int rel = pos - id; int bucket = rel < 0 ? 0 : rel;
            if (rel >= 16) { bucket = 16 + (int)(__logf((float)rel * 0.0625f) / 2.0794415416798357f * 16.0f); bucket = bucket > 31 ? 31 : bucket; }
            info[j] = (unsigned)id | ((unsigned)bucket << 16);
        }
        bf16x8 qf[8];
#pragma unroll
        for (int ks = 0; ks < 8; ++ks) qf[ks] = *(const bf16x8*)(QP + (size_t)t * 4096 + hd * 256 + ks * 32 + g * 8);
        f32x4 o[16];
#pragma unroll
        for (int rt = 0; rt < 16; ++rt) o[rt] = (f32x4){0.f, 0.f, 0.f, 0.f};
        float mrun = -1e30f, lrun = 0.f;
        asm volatile("s_waitcnt lgkmcnt(0)" ::: "memory");
        const int nch = (cnt + 31) >> 5;
        for (int ch = 0; ch < nch; ++ch) {
            asm volatile("s_waitcnt lgkmcnt(0)" ::: "memory");
#pragma unroll
            for (int i = 0; i < 16; ++i) {
                const int ksl = 2 * i + (lane >> 5); const unsigned idv = info[ch * 32 + ksl] & 0xffffu;
                const bf16_t* src = CK + (rb + idv) * 256 + (((lane & 31) ^ (ksl & 15)) * 8);
                __builtin_amdgcn_global_load_lds((const unsigned*)src, (LAS unsigned*)(rows + i * 1024), 16, 0, 0);
            }
            { const unsigned idv = info[ch * 32 + (lane >> 1)] & 0xffffu;
              __builtin_amdgcn_global_load_lds((const unsigned*)(RK + (rb + idv) * 16 + (lane & 1) * 8), (LAS unsigned*)rkb, 16, 0, 0); }
            asm volatile("s_waitcnt vmcnt(0)" ::: "memory");
            f32x4 s0 = (f32x4){0.f, 0.f, 0.f, 0.f}, s1 = (f32x4){0.f, 0.f, 0.f, 0.f};
#pragma unroll
            for (int ks = 0; ks < 8; ++ks) {
                const int pos16 = ((4 * ks + g) ^ hd) * 16;
                const bf16x8 a0 = *(const LAS bf16x8*)(rows + hd * 512 + pos16);
                const bf16x8 a1 = *(const LAS bf16x8*)(rows + (16 + hd) * 512 + pos16);
                s0 = __builtin_amdgcn_mfma_f32_16x16x32_bf16(a0, qf[ks], s0, 0, 0, 0);
                s1 = __builtin_amdgcn_mfma_f32_16x16x32_bf16(a1, qf[ks], s1, 0, 0, 0);
            }
            float x0[4], x1[4]; float cm = -INFINITY;
#pragma unroll
            for (int r = 0; r < 4; ++r) {
                const int sl0 = 4 * g + r, sl1 = 16 + 4 * g + r, j0 = ch * 32 + sl0, j1 = ch * 32 + sl1;
                const unsigned i0 = info[j0], i1 = info[j1];
                const float r0 = bf2f(rkb[sl0 * 16 + hd]), r1 = bf2f(rkb[sl1 * 16 + hd]);
                x0[r] = (j0 < cnt) ? s0[r] * r0 + biasL[(i0 >> 16) * 16 + hd] : -INFINITY;
                x1[r] = (j1 < cnt) ? s1[r] * r1 + biasL[(i1 >> 16) * 16 + hd] : -INFINITY;
                cm = fmaxf(cm, fmaxf(x0[r], x1[r]));
            }
            cm = fmaxf(cm, __shfl_xor(cm, 16)); cm = fmaxf(cm, __shfl_xor(cm, 32));
            const float mnew = fmaxf(mrun, cm); const float sc = __expf(mrun - mnew); mrun = mnew;
            float ls = 0.f;
#pragma unroll
            for (int r = 0; r < 4; ++r) { x0[r] = __expf(x0[r] - mnew); x1[r] = __expf(x1[r] - mnew); ls += x0[r] + x1[r]; }
            lrun = lrun * sc + ls;
#pragma unroll
            for (int rt = 0; rt < 16; ++rt) o[rt] *= sc;
            u32x4 pw; pw.x = pg8::cvt_pk_bf16(x0[0], x0[1]); pw.y = pg8::cvt_pk_bf16(x0[2], x0[3]); pw.z = pg8::cvt_pk_bf16(x1[0], x1[1]); pw.w = pg8::cvt_pk_bf16(x1[2], x1[3]);
            const bf16x8 pf = __builtin_bit_cast(bf16x8, pw);
            const int q = hd >> 2, pp = hd & 3, ksl = 4 * g + q;
            const LAS unsigned char* trb = rows + ksl * 512 + (pp & 1) * 8;
#pragma unroll
            for (int rt = 0; rt < 16; ++rt) {
                const int c16 = ((2 * rt + (pp >> 1)) ^ ksl) * 16;
                const v4i16_t t0 = __builtin_amdgcn_ds_read_tr16_b64_v4i16((LAS v4i16_t*)(trb + c16));
                const v4i16_t t1 = __builtin_amdgcn_ds_read_tr16_b64_v4i16((LAS v4i16_t*)(trb + c16 + 8192));
                bf16x8 af; af[0] = t0[0]; af[1] = t0[1]; af[2] = t0[2]; af[3] = t0[3]; af[4] = t1[0]; af[5] = t1[1]; af[6] = t1[2]; af[7] = t1[3];
                o[rt] = __builtin_amdgcn_mfma_f32_16x16x32_bf16(af, pf, o[rt], 0, 0, 0);
            }
        }
        float ltot = lrun; ltot += __shfl_xor(ltot, 16); ltot += __shfl_xor(ltot, 32);
        const float inv = 1.0f / ltot;
        bf16_t* op = QP + (size_t)t * 4096 + hd * 256 + 4 * g;
#pragma unroll
        for (int rt = 0; rt < 16; ++rt) { u32x2 w; w.x = pg8::cvt_pk_bf16(o[rt][0] * inv, o[rt][1] * inv); w.y = pg8::cvt_pk_bf16(o[rt][2] * inv, o[rt][3] * inv); *(u32x2*)(op + rt * 16) = w; }
    }
}

__global__ void __launch_bounds__(512, 2) k_fwd(P p_arg, int ph_lo, int ph_hi) {
    extern __shared__ __attribute__((aligned(16))) unsigned char smem[];
    const P& p = *(const P*)__builtin_amdgcn_kernarg_segment_ptr(); (void)p_arg;
    unsigned char* lds = smem + 16;
    unsigned char* ws = p.ws;
    XcdBarrier bar;
    const bool multi = (ph_hi - ph_lo) > 1;
    if (multi) {
        if (threadIdx.x == 0) *(uint4*)smem = make_uint4(0u, 0u, 0u, 0u);
        __syncthreads();
        bar = xcd_barrier_post((unsigned*)(ws + OFF_CTL), (volatile LAS unsigned*)smem);
    }
#define PH(i) (ph_lo <= (i) && (i) < ph_hi)
#define SEAM(i) do { if ((i) + 1 < ph_hi) xcd_barrier(bar); else __syncthreads(); } while (0)
    bf16_t *XN = (bf16_t*)(ws + OFF_XN), *QB = (bf16_t*)(ws + OFF_QB), *KB = (bf16_t*)(ws + OFF_KB), *VB = (bf16_t*)(ws + OFF_VB), *TMP = (bf16_t*)(ws + OFF_TMP), *Y = (bf16_t*)(ws + OFF_Y);
    if (PH(0)) { phase_prep(p, lds); SEAM(0); }
    if (PH(1)) { fast_gemm(lds, XN, 1024, (const bf16_t*)(ws + OFF_W0T), 1024, 3072, 1024, D1{ws}); SEAM(1); }
    if (PH(2)) { phase_conv_scan(p, lds); SEAM(2); }
    if (PH(3)) { mlstm_units<false>(p, lds); SEAM(3); }
    if (PH(4)) { phase_mlstm_scan(p, lds); SEAM(4); }
    if (PH(5)) { mlstm_units<true>(p, lds); SEAM(5); }
    if (PH(6)) { fast_gemm(lds, XN, 1024, (const bf16_t*)(ws + OFF_W0T) + (size_t)3072 * 1024, 1024, 4096, 1024, D2{ws}); SEAM(6); }
    if (PH(7)) { phase_ya_pool(p); SEAM(7); }
    if (PH(8)) { fast_gemm(lds, Y, 2048, (const bf16_t*)(ws + OFF_WO0T), 2048, 1024, 2048, D4{(unsigned char*)p.out, p.x}); SEAM(8); }
    if (PH(9)) { rmsnorm_rows<4>(p.out, p.o_norm, XN, p.o_w_in, OIN, 1600, nullptr, 0.5f, (float*)(ws + OFF_WI), (float*)lds); SEAM(9); }
    if (PH(10)) { fast_gemm(lds, XN, 1024, (const bf16_t*)(ws + OFF_W1T), 1024, 2816, 1024, D5{ws}); SEAM(10); }
    if (PH(11)) { phase_qnorm_ckvnorm(p); SEAM(11); }
    if (PH(12)) { fast_gemm(lds, (const bf16_t*)(ws + OFF_CKVN), 256, (const bf16_t*)(ws + OFF_WUKP), 256, 1024, 256, DK{ws}); SEAM(12); }
    if (PH(13)) { GQP f{TMP, (const bf16_t*)(ws + OFF_WQP), (bf16_t*)(ws + OFF_QP)}; sgemm(f, 512 * 64); phase_indexer(p, lds); SEAM(13); }
    if (PH(14)) { phase_attn(p, lds); SEAM(14); }
    if (PH(15)) { GOP f{(const bf16_t*)(ws + OFF_QP), (const bf16_t*)(ws + OFF_WUVT), (const bf16_t*)(ws + OFF_Z), TMP}; sgemm(f, 512 * 16); SEAM(15); }
    if (PH(16)) { fast_gemm(lds, TMP, 1024, (const bf16_t*)(ws + OFF_WO1T), 1024, 1024, 1024, D8{(unsigned char*)p.out}); }
#undef PH
#undef SEAM
}

extern "C" void kernel_launch(void* const* d_in, const int* in_sizes, int n_in, void* d_out, int out_size, void* d_ws, size_t ws_size, hipStream_t stream) {
    static int grid = 0;
    if (grid == 0) {
        if (n_in != 18 || out_size != T * DM || ws_size < WS_END) { fprintf(stderr, "kernel_launch: unexpected shapes (n_in %d out %d ws %zu)\n", n_in, out_size, ws_size); grid = -1; return; }
        if (hipFuncSetAttribute((const void*)k_fwd, hipFuncAttributeMaxDynamicSharedMemorySize, LDS_BYTES) != hipSuccess) { fprintf(stderr, "kernel_launch: hipFuncSetAttribute failed\n"); grid = -1; return; }
        grid = 256;
    }
    if (grid < 0) return;
    (void)hipMemsetAsync((char*)d_ws + OFF_CTL, 0, 16384, stream);
    P p{};
    p.x = (const float*)d_in[0]; p.e_norm = (const float*)d_in[1]; p.e_w_in = (const float*)d_in[2]; p.e_conv = (const float*)d_in[3]; p.e_b_if = (const float*)d_in[4];
    p.e_g_head = (const float*)d_in[5]; p.e_w_pool = (const float*)d_in[6]; p.e_s_pool = (const float*)d_in[7]; p.e_w_out = (const float*)d_in[8];
    p.o_norm = (const float*)d_in[9]; p.o_w_in = (const float*)d_in[10]; p.o_g_kv = (const float*)d_in[11]; p.o_w_uk = (const float*)d_in[12]; p.o_w_uv = (const float*)d_in[13];
    p.o_g_q = (const float*)d_in[14]; p.o_g_k = (const float*)d_in[15]; p.o_w_out = (const float*)d_in[16]; p.rel_bias = (const float*)d_in[17];
    p.out = (float*)d_out; p.ws = (unsigned char*)d_ws;
    hipLaunchKernelGGL(k_fwd, dim3(grid), dim3(512), LDS_BYTES, stream, p, 0, NPH);
}
```

```cpp
#include <hip/hip_runtime.h>
#include <stdint.h>
#include <cstdio>

typedef unsigned short bf16_t;
typedef short bf16x8 __attribute__((ext_vector_type(8)));
typedef float f32x4 __attribute__((ext_vector_type(4)));
typedef unsigned u32x4 __attribute__((ext_vector_type(4)));
typedef unsigned u32x2 __attribute__((ext_vector_type(2)));
typedef short v4i16_t __attribute__((ext_vector_type(4)));
#define LAS __attribute__((address_space(3)))

constexpr int T = 32768, SEQ = 16384, DM = 1024;
constexpr int EIN = 7176, OIN = 2628;
constexpr float EPS = 1e-6f;
constexpr size_t MB = 1048576;
constexpr size_t OFF_CTL = 0;
constexpr size_t OFF_GATES = 64 * 1024;
constexpr size_t OFF_BQ = OFF_GATES + (size_t)T * 8 * 4;
constexpr size_t OFF_IQ = OFF_BQ + (size_t)T * 4 * 4;
constexpr size_t OFF_MT = OFF_IQ + (size_t)T * 4 * 4;
constexpr size_t OFF_WI = OFF_MT + (size_t)T * 4 * 4;
constexpr size_t OFF_CH = OFF_WI + (size_t)T * 4 * 4;
constexpr size_t OFF_NS = OFF_CH + 64 * 1024;
constexpr size_t OFF_W = 4 * MB;
constexpr size_t OFF_W0T = OFF_W;
constexpr size_t OFF_WPT = OFF_W0T + (size_t)7168 * 1024 * 2;
constexpr size_t OFF_WO0T = OFF_WPT + (size_t)4 * 256 * 256 * 2;
constexpr size_t OFF_W1T = OFF_WO0T + (size_t)1024 * 2048 * 2;
constexpr size_t OFF_WUKT = OFF_W1T + (size_t)2816 * 1024 * 2;
constexpr size_t OFF_WUVT = OFF_WUKT + (size_t)1024 * 256 * 2;
constexpr size_t OFF_WO1T = OFF_WUVT + (size_t)1024 * 256 * 2;
constexpr size_t OFF_WUKP = OFF_WO1T + (size_t)1024 * 1024 * 2;
constexpr size_t OFF_WQP = OFF_WUKP + (size_t)1024 * 256 * 2;
constexpr size_t OFF_XN = 36 * MB, OFF_QB = 100 * MB, OFF_KB = 164 * MB, OFF_VB = 228 * MB, OFF_TMP = 292 * MB, OFF_Y = 356 * MB;
constexpr size_t OFF_QP = 36 * MB;
constexpr size_t OFF_CKVN = OFF_Y;
constexpr size_t OFF_QI = OFF_Y + 16 * MB;
constexpr size_t OFF_KI = OFF_Y + 32 * MB;
constexpr size_t OFF_IDX = OFF_Y + 40 * MB;
constexpr size_t OFF_RK = OFF_Y + 58 * MB;
constexpr size_t OFF_CNT = OFF_Y + 59 * MB;
constexpr size_t OFF_Z = OFF_Y + 60 * MB;
constexpr size_t WS_END = 484 * MB;
constexpr int LDS_BYTES = 151552;
constexpr int NPH = 17;

struct P {
    const float *x, *e_norm, *e_w_in, *e_conv, *e_b_if, *e_g_head, *e_w_pool, *e_s_pool, *e_w_out;
    const float *o_norm, *o_w_in, *o_g_kv, *o_w_uk, *o_w_uv, *o_g_q, *o_g_k, *o_w_out, *rel_bias;
    float* out; unsigned char* ws;
};

__device__ __forceinline__ bf16_t f2bf(float f) { unsigned u = __float_as_uint(f); u += 0x7FFFu + ((u >> 16) & 1u); return (bf16_t)(u >> 16); }
__device__ __forceinline__ float bf2f(bf16_t b) { return __uint_as_float(((unsigned)b) << 16); }
__device__ __forceinline__ float bflo(unsigned w) { return __uint_as_float(w << 16); }
__device__ __forceinline__ float bfhi(unsigned w) { return __uint_as_float(w & 0xffff0000u); }
__device__ __forceinline__ unsigned pk2(float a, float b) { return (unsigned)f2bf(a) | ((unsigned)f2bf(b) << 16); }
__device__ __forceinline__ float sigmoidf_(float x) { return 1.0f / (1.0f + __expf(-x)); }
__device__ __forceinline__ float siluf_(float x) { return x / (1.0f + __expf(-x)); }
__device__ __forceinline__ float wave_sum(float v) {
#pragma unroll
    for (int o = 32; o >= 1; o >>= 1) v += __shfl_xor(v, o);
    return v;
}
__device__ __forceinline__ float wave_max(float v) {
#pragma unroll
    for (int o = 32; o >= 1; o >>= 1) v = fmaxf(v, __shfl_xor(v, o));
    return v;
}

#define XB_TMO      128
#define XB_XCNT(j)  (256  + 64 * (j))
#define XB_XSUB(j)  (1280 + 64 * (j))
#define XB_XGEN(j)  (2304 + 64 * (j))
#define XB_TOP      3328
#define XB_TOPGEN   3392
#define XCD_BAR_WORDS 3456
#define XB_SPIN_CAP (1u << 22)
__device__ __forceinline__ unsigned xb_ld(unsigned* p)              { return __hip_atomic_load(p, __ATOMIC_RELAXED, __HIP_MEMORY_SCOPE_AGENT); }
__device__ __forceinline__ unsigned xb_add(unsigned* p, unsigned v) { return __hip_atomic_fetch_add(p, v, __ATOMIC_RELAXED, __HIP_MEMORY_SCOPE_AGENT); }
__device__ __forceinline__ unsigned xb_xcc_id() { return (unsigned)__builtin_amdgcn_s_getreg((3 << 11) | 20) & 0xFu; }
#define XB_SPIN(cond, bar) do { unsigned _sp = 0; while (cond) { __builtin_amdgcn_s_sleep(1); \
    if ((++_sp & 255u) == 0u) { if (xb_ld(&(bar)[XB_TMO])) break; if (_sp > XB_SPIN_CAP) { atomicAdd(&(bar)[XB_TMO], 1u); break; } } } } while (0)
struct XcdBarrier { unsigned* bar; unsigned x; volatile LAS unsigned* st; };
__device__ __forceinline__ XcdBarrier xcd_barrier_post(unsigned* bar, volatile LAS unsigned* st) {
    XcdBarrier b; b.bar = bar; b.x = xb_xcc_id(); b.st = st;
    if (threadIdx.x == 0) (void)xb_add(&bar[XB_XCNT(b.x)], 1u);
    return b;
}
__device__ __forceinline__ void xcd_barrier_complete(unsigned* bar, unsigned x, unsigned& nloc, unsigned& nx) {
    const unsigned G = gridDim.x * gridDim.y * gridDim.z;
    unsigned sum, cnt, mine, sp = 0u;
    for (;;) {
        sum = 0u; cnt = 0u; mine = 0u;
#pragma unroll
        for (unsigned j = 0; j < 16; ++j) { const unsigned c = xb_ld(&bar[XB_XCNT(j)]); sum += c; cnt += (c > 0u) ? 1u : 0u; mine = (j == x) ? c : mine; }
        if (sum == G) break;
        __builtin_amdgcn_s_sleep(1);
        if ((++sp & 255u) == 0u) { if (xb_ld(&bar[XB_TMO])) break; if (sp > XB_SPIN_CAP) { atomicAdd(&bar[XB_TMO], 1u); break; } }
    }
    nloc = mine > 0u ? mine : 1u; nx = cnt > 0u ? cnt : 1u;
}
__device__ __forceinline__ void xcd_barrier(const XcdBarrier& b) {
    asm volatile("s_waitcnt vmcnt(0)" ::: "memory");
    __syncthreads();
    if (threadIdx.x == 0) {
        unsigned* bar = b.bar;
        __builtin_amdgcn_s_waitcnt(0);
        unsigned nloc = b.st[0], nx = b.st[1];
        if (nloc == 0u) { xcd_barrier_complete(bar, b.x, nloc, nx); b.st[0] = nloc; b.st[1] = nx; }
        const unsigned old = xb_add(&bar[XB_XSUB(b.x)], 1u);
        const unsigned gen = old / nloc;
        if (old + 1u == (gen + 1u) * nloc) {
            __builtin_amdgcn_fence(__ATOMIC_RELEASE, "agent");
            asm volatile("s_waitcnt vmcnt(0)" ::: "memory");
            const unsigned og = xb_add(&bar[XB_TOP], 1u);
            const unsigned tg = og / nx;
            if (og + 1u == (tg + 1u) * nx) xb_add(&bar[XB_TOPGEN], 1u);
            else XB_SPIN(xb_ld(&bar[XB_TOPGEN]) == tg, bar);
            __builtin_amdgcn_fence(__ATOMIC_ACQUIRE, "agent");
            xb_add(&bar[XB_XGEN(b.x)], 1u);
            asm volatile("s_waitcnt vmcnt(0)" ::: "memory");
        } else {
            XB_SPIN(xb_ld(&bar[XB_XGEN(b.x)]) == gen, bar);
            __builtin_amdgcn_fence(__ATOMIC_ACQUIRE, "agent");
            asm volatile("s_waitcnt vmcnt(0)" ::: "memory");
        }
    }
    __syncthreads();
}

struct Tile { const bf16_t* A; const bf16_t* B; int lda, ldb, K; void* d0; const void* s0; int ld, mode; float aux0, aux1, aux2; int i0, i1; };
template <class F>
__device__ __forceinline__ void sgemm(const F f, int nunits) {
    const int lane = threadIdx.x & 63, wave = threadIdx.x >> 6, fr = lane & 15, fq = lane >> 4;
    for (int u = blockIdx.x * 8 + wave; u < nunits; u += gridDim.x * 8) {
        Tile tl; f.tile(u, tl);
        f32x4 acc[4][4];
#pragma unroll
        for (int m = 0; m < 4; ++m)
#pragma unroll
            for (int n = 0; n < 4; ++n) acc[m][n] = (f32x4){0.f, 0.f, 0.f, 0.f};
        const bf16_t* ap = tl.A + (size_t)fr * tl.lda + fq * 8;
        const bf16_t* bp = tl.B + (size_t)fr * tl.ldb + fq * 8;
        const int K = tl.K, lda = tl.lda, ldb = tl.ldb;
#pragma unroll 1
        for (int k0 = 0; k0 < K; k0 += 32) {
            bf16x8 a[4], b[4];
#pragma unroll
            for (int m = 0; m < 4; ++m) a[m] = *(const bf16x8*)(ap + (size_t)(m * 16) * lda + k0);
#pragma unroll
            for (int n = 0; n < 4; ++n) b[n] = *(const bf16x8*)(bp + (size_t)(n * 16) * ldb + k0);
#pragma unroll
            for (int m = 0; m < 4; ++m)
#pragma unroll
                for (int n = 0; n < 4; ++n) acc[m][n] = __builtin_amdgcn_mfma_f32_16x16x32_bf16(a[m], b[n], acc[m][n], 0, 0, 0);
        }
#pragma unroll
        for (int m = 0; m < 4; ++m)
#pragma unroll
            for (int j = 0; j < 4; ++j) {
                const int r = m * 16 + fq * 4 + j;
                asm volatile("" ::: "memory");
#pragma unroll
                for (int n = 0; n < 4; ++n) f.out(tl, r, n * 16 + fr, acc[m][n][j]);
            }
    }
}
__device__ __forceinline__ void store_mode(const Tile& tl, int r, int c, float v) {
    const size_t i = (size_t)r * tl.ld + c;
    if (tl.mode == 0) ((bf16_t*)tl.d0)[i] = f2bf(v);
    else if (tl.mode == 1) ((bf16_t*)tl.d0)[i] = f2bf(sigmoidf_(v));
    else if (tl.mode == 2) ((bf16_t*)tl.d0)[i] = f2bf(siluf_(v));
    else if (tl.mode == 3) ((float*)tl.d0)[i] = v * tl.aux0;
}

struct G1 {
    const bf16_t* XN; const bf16_t* W; bf16_t *Q, *K_, *V;
    __device__ __forceinline__ void tile(int u, Tile& tl) const {
        const int mt = u / 48, nt = u % 48; tl.A = XN + (size_t)mt * 64 * 1024; tl.lda = 1024; tl.B = W + (size_t)nt * 64 * 1024; tl.ldb = 1024; tl.K = 1024;
        const int col = nt * 64, sec = col >> 10, cc = col & 1023; bf16_t* d = Q + (size_t)sec * (32 * MB);
        tl.d0 = d + (size_t)mt * 64 * 1024 + cc; tl.ld = 1024; tl.mode = 0; }
    __device__ __forceinline__ void out(const Tile& tl, int r, int c, float v) const { store_mode(tl, r, c, v); }
};
struct G2 {
    const bf16_t* XN; const bf16_t* W; bf16_t *O, *ZA, *U, *Y;
    __device__ __forceinline__ void tile(int u, Tile& tl) const {
        const int mt = u / 64, nt = u % 64; tl.A = XN + (size_t)mt * 64 * 1024; tl.lda = 1024; tl.B = W + (size_t)(3072 + nt * 64) * 1024; tl.ldb = 1024; tl.K = 1024;
        const int col = nt * 64, sec = col >> 10, cc = col & 1023;
        if (sec == 0) { tl.d0 = O + (size_t)mt * 64 * 1024 + cc; tl.ld = 1024; tl.mode = 1; }
        else if (sec == 1) { tl.d0 = ZA + (size_t)mt * 64 * 1024 + cc; tl.ld = 1024; tl.mode = 2; }
        else if (sec == 2) { tl.d0 = U + (size_t)mt * 64 * 1024 + cc; tl.ld = 1024; tl.mode = 0; }
        else { tl.d0 = Y + (size_t)mt * 64 * 2048 + 1024 + cc; tl.ld = 2048; tl.mode = 2; } }
    __device__ __forceinline__ void out(const Tile& tl, int r, int c, float v) const { store_mode(tl, r, c, v); }
};
struct GM1 {
    const bf16_t* Y; const bf16_t* KT; const float *BQ, *IQ, *MT; float* W;
    __device__ __forceinline__ void tile(int u, Tile& tl) const {
        const int bh = u >> 8, c = u & 255, batch = bh >> 2, head = bh & 3; const size_t t0 = (size_t)batch * SEQ + c * 64;
        tl.A = Y + t0 * 2048 + 1024 + head * 256; tl.lda = 2048; tl.B = KT + t0 * 1024 + head * 256; tl.ldb = 1024; tl.K = 256;
        tl.d0 = W + (size_t)u * 4096; tl.ld = 64; tl.mode = 0; tl.i0 = (int)(t0 * 4 + head); }
    __device__ __forceinline__ void out(const Tile& tl, int r, int c, float v) const {
        float w = 0.f;
        if (c <= r) w = __expf(BQ[tl.i0 + r * 4] - BQ[tl.i0 + c * 4] + IQ[tl.i0 + c * 4] - MT[tl.i0 + r * 4]) * v;
        ((float*)tl.d0)[r * 64 + c] = w; }
};
struct G3 {
    const bf16_t* XN; const bf16_t* W; const float* sp; bf16_t* Y;
    __device__ __forceinline__ void tile(int u, Tile& tl) const {
        const int mt = u >> 4, g = (u >> 2) & 3, nt = u & 3; tl.A = XN + (size_t)mt * 64 * 1024 + g * 256; tl.lda = 1024; tl.B = W + (size_t)(g * 256 + nt * 64) * 256; tl.ldb = 256; tl.K = 256;
        const int col = g * 256 + nt * 64; tl.d0 = Y + (size_t)mt * 64 * 2048 + 1024 + col; tl.ld = 2048; tl.s0 = sp + col; tl.mode = 0; }
    __device__ __forceinline__ void out(const Tile& tl, int r, int c, float v) const {
        bf16_t* d = (bf16_t*)tl.d0 + (size_t)r * 2048 + c; *d = f2bf(v * ((const float*)tl.s0)[c] * bf2f(*d)); }
};
struct G4 {
    const bf16_t* Y; const bf16_t* W; const float* x; float* out_;
    __device__ __forceinline__ void tile(int u, Tile& tl) const {
        const int mt = u >> 4, nt = u & 15; tl.A = Y + (size_t)mt * 64 * 2048; tl.lda = 2048; tl.B = W + (size_t)nt * 64 * 2048; tl.ldb = 2048; tl.K = 2048;
        const size_t o = (size_t)mt * 64 * 1024 + nt * 64; tl.d0 = out_ + o; tl.s0 = x + o; tl.ld = 1024; tl.mode = 0; }
    __device__ __forceinline__ void out(const Tile& tl, int r, int c, float v) const { const size_t i = (size_t)r * 1024 + c; ((float*)tl.d0)[i] = ((const float*)tl.s0)[i] + v; }
};
struct G5 {
    const bf16_t* XN; const bf16_t* W; bf16_t* Q; float *CKVR, *QI, *KI; bf16_t* Z;
    __device__ __forceinline__ void tile(int u, Tile& tl) const {
        const int mt = u / 44, nt = u % 44; tl.A = XN + (size_t)mt * 64 * 1024; tl.lda = 1024; tl.B = W + (size_t)nt * 64 * 1024; tl.ldb = 1024; tl.K = 1024;
        const int col = nt * 64; const size_t row0 = (size_t)mt * 64; tl.aux0 = 1.0f;
        if (col < 1024) { tl.d0 = Q + row0 * 1024 + col; tl.ld = 1024; tl.mode = 0; }
        else if (col < 1280) { tl.d0 = CKVR + row0 * 256 + (col - 1024); tl.ld = 256; tl.mode = 3; }
        else if (col < 1536) { tl.d0 = QI + row0 * 256 + (col - 1280); tl.ld = 256; tl.mode = 3; tl.aux0 = 0.125f; }
        else if (col < 1600) { tl.d0 = KI + row0 * 64 + (col - 1536); tl.ld = 64; tl.mode = 3; }
        else if (col < 1792) { tl.d0 = nullptr; tl.ld = 0; tl.mode = 4; }
        else { tl.d0 = Z + row0 * 1024 + (col - 1792); tl.ld = 1024; tl.mode = 2; } }
    __device__ __forceinline__ void out(const Tile& tl, int r, int c, float v) const { store_mode(tl, r, c, v); }
};
struct G67 {
    const bf16_t* C; const bf16_t *WK, *WV; bf16_t *KF, *VF;
    __device__ __forceinline__ void tile(int u, Tile& tl) const {
        const int which = u >= 8192, uu = u & 8191, mt = uu >> 4, nt = uu & 15; tl.A = C + (size_t)mt * 64 * 256; tl.lda = 256; tl.B = WK + (size_t)which * (1024 * 256) + (size_t)nt * 64 * 256;     tl.ldb = 256; tl.K = 256;
        tl.d0 = KF + (size_t)which * (32 * MB) + (size_t)mt * 64 * 1024 + nt * 64;     tl.ld = 1024; tl.mode = 0; }
    __device__ __forceinline__ void out(const Tile& tl, int r, int c, float v) const { store_mode(tl, r, c, v); }
};
struct G8 {
    const bf16_t* G; const bf16_t* W; float* out_;
    __device__ __forceinline__ void tile(int u, Tile& tl) const {
        const int mt = u >> 4, nt = u & 15; tl.A = G + (size_t)mt * 64 * 1024; tl.lda = 1024; tl.B = W + (size_t)nt * 64 * 1024; tl.ldb = 1024; tl.K = 1024;
        tl.d0 = out_ + (size_t)mt * 64 * 1024 + nt * 64; tl.ld = 1024; tl.mode = 0; }
    __device__ __forceinline__ void out(const Tile& tl, int r, int c, float v) const { float* d = (float*)tl.d0 + (size_t)r * 1024 + c; *d = *d + v; }
};

struct GQP {
    const bf16_t* Qn; const bf16_t* W; bf16_t* QP;
    __device__ __forceinline__ void tile(int u, Tile& tl) const {
        const int nt = u & 3, head = (u >> 2) & 15, mt = u >> 6; tl.A = Qn + (size_t)mt * 64 * 1024 + head * 64; tl.lda = 1024; tl.B = W + (size_t)(head * 256 + nt * 64) * 64; tl.ldb = 64; tl.K = 64;
        tl.d0 = QP + ((size_t)mt * 64 * 16 + head) * 256 + nt * 64; tl.ld = 4096; tl.mode = 0; }
    __device__ __forceinline__ void out(const Tile& tl, int r, int c, float v) const { store_mode(tl, r, c, v); }
};
struct GOP {
    const bf16_t* OP; const bf16_t* W; const bf16_t* Z; bf16_t* G;
    __device__ __forceinline__ void tile(int u, Tile& tl) const {
        const int head = u & 15, mt = u >> 4; tl.A = OP + (size_t)mt * 64 * 4096 + head * 256; tl.lda = 4096; tl.B = W + (size_t)head * 64 * 256; tl.ldb = 256; tl.K = 256;
        const size_t o = (size_t)mt * 64 * 1024 + head * 64; tl.d0 = G + o; tl.s0 = Z + o; tl.ld = 1024; tl.mode = 0; }
    __device__ __forceinline__ void out(const Tile& tl, int r, int c, float v) const { const size_t i = (size_t)r * 1024 + c; ((bf16_t*)tl.d0)[i] = f2bf(v * bf2f(((const bf16_t*)tl.s0)[i])); }
};

namespace pg8 {
constexpr int BM = 256, BK = 64, HALF = 128, HTB = HALF * BK * 2, STAGE_BYTES = 8 * HTB, NXCD = 8, WGM = 8;
__device__ __forceinline__ int lds_byte(int r, int c) { const int st = (r >> 4) * 2 + (c >> 5), rr = r & 15, cc = c & 31, ob = rr * 64 + cc * 2; return st * 1024 + (ob ^ (((ob >> 9) & 1) << 5)); }
__device__ __forceinline__ void stage_rc(int b, int& R, int& C) { const int st = b / 1024, sb = b % 1024, swz = sb ^ (((sb >> 9) & 1) << 5); R = (st >> 1) * 16 + swz / 64; C = (st & 1) * 32 + (swz % 64) / 2; }
__device__ __forceinline__ int perm32(int rho) { const int n = rho >> 4, i = rho & 15; return 8 * (i >> 2) + 4 * n + (i & 3); }
struct Unit { int pm, pn; };
struct Gemm { const bf16_t* A; int lda; const bf16_t* Bt; int ldb; int M, N, K; };
struct StaticOrder {
    int nM, nN, nwg, G, c;
    __device__ void init(int M, int N, int G_, int c_) { nM = M / BM; nN = N / BM; nwg = nM * nN; G = G_; c = c_; }
    __device__ bool next(int i, Unit& u) const {
        const long L = (long)i * G + c; if (L >= nwg) return false;
        int wgid = (int)L; { const int q = nwg / NXCD, r = nwg % NXCD, xcd = wgid % NXCD, off = wgid / NXCD; wgid = (xcd < r ? xcd * (q + 1) : r * (q + 1) + (xcd - r) * q) + off; }
        const int nig = WGM * nN, gid = wgid / nig, fm = gid * WGM, gsz = (nM - fm) < WGM ? (nM - fm) : WGM;
        u.pm = fm + ((wgid % nig) % gsz); u.pn = (wgid % nig) / gsz; return true;
    }
};
__device__ __forceinline__ unsigned cvt_pk_bf16(float lo, float hi) { unsigned r; asm volatile("v_cvt_pk_bf16_f32 %0, %1, %2" : "=v"(r) : "v"(lo), "v"(hi)); return r; }

struct Dst { unsigned char* base; const float* res; int ld, mode, ncol; float scale; };
template <class DescF> struct EpiGen {
    static constexpr bool PERM = true;
    DescF D;
    __device__ __forceinline__ void operator()(const f32x4 (&acc)[2][2][4][2], const Unit& u, int wr, int wc, int fr, int fq) const {
        Dst d; D.get(u, d);
        if ((DescF::MODES & 16) && d.mode == 4) return;
        const int r0 = wr * 64 + fr, c0 = wc * 32 + 8 * fq;
        if constexpr ((DescF::MODES & 64) != 0) {
#pragma unroll
            for (int ai = 0; ai < 2; ++ai)
#pragma unroll
                for (int m = 0; m < 4; ++m) {
                    float ss = 0.f;
#pragma unroll
                    for (int bj = 0; bj < 2; ++bj)
#pragma unroll
                        for (int n = 0; n < 2; ++n) { const f32x4 v = acc[ai][bj][m][n]; ss += v[0] * v[0] + v[1] * v[1] + v[2] * v[2] + v[3] * v[3]; }
                    ss += __shfl_xor(ss, 16); ss += __shfl_xor(ss, 32);
                    if (fq == 0) ((bf16_t*)d.base)[(size_t)(ai * HALF + r0 + m * 16) * d.ld + wc] = f2bf(rsqrtf(ss * (1.0f / 64.0f) + EPS));
                }
            return;
        } else {
#pragma unroll
        for (int ai = 0; ai < 2; ++ai)
#pragma unroll
            for (int m = 0; m < 4; ++m) {
                const size_t rowoff = (size_t)(ai * HALF + r0 + m * 16) * d.ld;
#pragma unroll
                for (int bj = 0; bj < 2; ++bj) {
                    const int col = bj * HALF + c0; f32x4 v0 = acc[ai][bj][m][0], v1 = acc[ai][bj][m][1];
                    if ((DescF::MODES & 7) && d.mode <= 2) {
                        if ((DescF::MODES & 2) && d.mode == 1) {
#pragma unroll
                            for (int j = 0; j < 4; ++j) { v0[j] = sigmoidf_(v0[j]); v1[j] = sigmoidf_(v1[j]); } }
                        if ((DescF::MODES & 4) && d.mode == 2) {
#pragma unroll
                            for (int j = 0; j < 4; ++j) { v0[j] = siluf_(v0[j]); v1[j] = siluf_(v1[j]); } }
                        u32x4 w; w.x = cvt_pk_bf16(v0[0], v0[1]); w.y = cvt_pk_bf16(v0[2], v0[3]); w.z = cvt_pk_bf16(v1[0], v1[1]); w.w = cvt_pk_bf16(v1[2], v1[3]);
                        *(u32x4*)((bf16_t*)d.base + rowoff + col) = w;
                    } else if ((DescF::MODES & 8) && d.mode == 3) {
                        if (col < d.ncol) { float* o = (float*)d.base + rowoff + col; *(f32x4*)o = v0 * d.scale; *(f32x4*)(o + 4) = v1 * d.scale; }
                    } else if ((DescF::MODES & 128) && d.mode == 7) {
                        typedef _Float16 h8 __attribute__((ext_vector_type(8)));
                        if (col < d.ncol) {
                        h8 hv; hv[0] = (_Float16)(v0[0] * d.scale); hv[1] = (_Float16)(v0[1] * d.scale); hv[2] = (_Float16)(v0[2] * d.scale); hv[3] = (_Float16)(v0[3] * d.scale);
                        hv[4] = (_Float16)(v1[0] * d.scale); hv[5] = (_Float16)(v1[1] * d.scale); hv[6] = (_Float16)(v1[2] * d.scale); hv[7] = (_Float16)(v1[3] * d.scale);
                        *(h8*)((_Float16*)d.base + rowoff + col) = hv; }
                    } else if constexpr ((DescF::MODES & 32) != 0) {
                        float* o = (float*)d.base + rowoff + col; const float* rs = d.res + rowoff + col;
                        const f32x4 a = *(const f32x4*)rs, b = *(const f32x4*)(rs + 4); *(f32x4*)o = a + v0; *(f32x4*)(o + 4) = b + v1;
                    }
                }
                if (m & 1) asm volatile("" ::: "memory");
            }
        }
    }
};

template <class Epi>
__device__ __forceinline__ void gemm_phase(LAS unsigned char* lds, const Gemm g, const StaticOrder& S, const Epi& E) {
    const int tid = threadIdx.x, wid = __builtin_amdgcn_readfirstlane(tid >> 6), lane = tid & 63, wr = wid >> 2, wc = wid & 3, fr = lane & 15, fq = lane >> 4;
    const int K = g.K, nt = K / BK;
    unsigned voffA[2], voffB[2];
#pragma unroll
    for (int i = 0; i < 2; ++i) { int R, C; stage_rc(tid * 16 + i * 8192, R, C); const int Rb = Epi::PERM ? ((R & ~31) + perm32(R & 31)) : R;
        voffA[i] = (unsigned)(R * g.lda + C) * 2u; voffB[i] = (unsigned)(Rb * g.ldb + C) * 2u; }
    const size_t kstep = (size_t)(BK * 2);
    const size_t hstepA = (size_t)HALF * g.lda * 2, hstepB = (size_t)HALF * g.ldb * 2;
    const size_t tstepA = 2 * hstepA, tstepB = 2 * hstepB;
    const unsigned ldsw = (unsigned)wid * 1024u;
    const int aoff = lds_byte(wr * 64 + fr, fq * 8), boff = lds_byte(wc * 32 + fr, fq * 8);
#define PG8_SA(b, h) (((b) * 2 + (h)) * HTB)
#define PG8_SB(b, h) ((4 + (b) * 2 + (h)) * HTB)
#define PG8_STAGE(bufoff, gbase, voff) do { _Pragma("unroll") for (int _i = 0; _i < 2; ++_i) \
        __builtin_amdgcn_global_load_lds((const unsigned*)((const char*)(gbase) + (voff)[_i]), (LAS unsigned*)(lds + (bufoff) + ldsw + _i * 8192), 16, 0, 0); } while (0)
#define PG8_LDA(dst, b, h) do { _Pragma("unroll") for (int m = 0; m < 4; ++m) _Pragma("unroll") for (int k = 0; k < 2; ++k) dst[m][k] = *(const LAS bf16x8*)(lds + PG8_SA(b, h) + aoff + m * 2048 + k * 1024); } while (0)
#define PG8_LDB(dst, b, h) do { _Pragma("unroll") for (int n = 0; n < 2; ++n) _Pragma("unroll") for (int k = 0; k < 2; ++k) dst[n][k] = *(const LAS bf16x8*)(lds + PG8_SB(b, h) + boff + n * 2048 + k * 1024); } while (0)
#define PG8_MMA(ai, bj, At, Bt) do { __builtin_amdgcn_s_setprio(1); _Pragma("unroll") for (int m = 0; m < 4; ++m) _Pragma("unroll") for (int n = 0; n < 2; ++n) _Pragma("unroll") for (int k = 0; k < 2; ++k) \
        acc[ai][bj][m][n] = __builtin_amdgcn_mfma_f32_16x16x32_bf16(Bt[n][k], At[m][k], acc[ai][bj][m][n], 0, 0, 0); __builtin_amdgcn_s_setprio(0); } while (0)
#define PG8_WAIT_V(n) asm volatile("s_waitcnt vmcnt(" #n ")" ::: "memory")
#define PG8_WAIT_L(n) asm volatile("s_waitcnt lgkmcnt(" #n ")" ::: "memory")
#define PG8_BAR __builtin_amdgcn_s_barrier()
#define PG8_SCHED __builtin_amdgcn_sched_barrier(0)
    Unit cur, nxt; int ui = 0;
    if (!S.next(0, cur)) return;
    f32x4 acc[2][2][4][2];
#pragma unroll
    for (int a = 0; a < 2; ++a)
#pragma unroll
        for (int b = 0; b < 2; ++b)
#pragma unroll
            for (int m = 0; m < 4; ++m)
#pragma unroll
                for (int n = 0; n < 2; ++n) acc[a][b][m][n] = (f32x4){0.f, 0.f, 0.f, 0.f};
    bf16x8 At[4][2], B0[2][2], B1[2][2];
    const char* cA = (const char*)g.A + (size_t)cur.pm * tstepA; const char* cB = (const char*)g.Bt + (size_t)cur.pn * tstepB;
    PG8_STAGE(PG8_SB(0, 0), cB, voffB); PG8_STAGE(PG8_SA(0, 0), cA, voffA); PG8_STAGE(PG8_SB(0, 1), cB + hstepB, voffB); PG8_STAGE(PG8_SA(0, 1), cA + hstepA, voffA);
    if (wr == 1) PG8_BAR;
    PG8_WAIT_V(4); PG8_BAR;
    PG8_STAGE(PG8_SB(1, 0), cB + kstep, voffB); PG8_STAGE(PG8_SA(1, 0), cA + kstep, voffA); PG8_STAGE(PG8_SB(1, 1), cB + hstepB + kstep, voffB);
    PG8_WAIT_V(6); PG8_BAR;
    for (;;) {
        const bool has_next = S.next(ui + 1, nxt);
        const char* nA = has_next ? (const char*)g.A + (size_t)nxt.pm * tstepA : cA; const char* nB = has_next ? (const char*)g.Bt + (size_t)nxt.pn * tstepB : cB;
#pragma unroll 1
        for (int t = 0; t < nt; t += 2) {
            const bool last = (t == nt - 2);
            const char* a1 = cA + (size_t)(t + 1) * kstep;
            const char* a2 = last ? nA : cA + (size_t)(t + 2) * kstep; const char* b2 = last ? nB : cB + (size_t)(t + 2) * kstep;
            const char* a3 = a2 + kstep; const char* b3 = b2 + kstep;
            PG8_LDB(B0, 0, 0); PG8_SCHED; PG8_LDA(At, 0, 0); PG8_STAGE(PG8_SA(1, 1), a1 + hstepA, voffA);
            PG8_WAIT_L(8); PG8_BAR; PG8_WAIT_L(0); PG8_MMA(0, 0, At, B0); PG8_BAR; PG8_SCHED;
            PG8_LDB(B1, 0, 1); PG8_STAGE(PG8_SB(0, 0), b2, voffB);
            PG8_BAR; PG8_WAIT_L(0); PG8_MMA(0, 1, At, B1); PG8_BAR;
            PG8_LDA(At, 0, 1); PG8_STAGE(PG8_SA(0, 0), a2, voffA);
            PG8_BAR; PG8_WAIT_L(0); PG8_MMA(1, 0, At, B0); PG8_BAR; PG8_SCHED;
            PG8_STAGE(PG8_SB(0, 1), b2 + hstepB, voffB);
            PG8_WAIT_V(6); PG8_BAR; PG8_MMA(1, 1, At, B1); PG8_BAR;
            PG8_LDB(B0, 1, 0); PG8_SCHED; PG8_LDA(At, 1, 0); PG8_STAGE(PG8_SA(0, 1), a2 + hstepA, voffA);
            PG8_WAIT_L(8); PG8_BAR; PG8_WAIT_L(0); PG8_MMA(0, 0, At, B0); PG8_BAR; PG8_SCHED;
            PG8_LDB(B1, 1, 1); PG8_STAGE(PG8_SB(1, 0), b3, voffB);
            PG8_BAR; PG8_WAIT_L(0); PG8_MMA(0, 1, At, B1); PG8_BAR;
            PG8_LDA(At, 1, 1); PG8_STAGE(PG8_SA(1, 0), a3, voffA);
            PG8_BAR; PG8_WAIT_L(0); PG8_MMA(1, 0, At, B0); PG8_BAR; PG8_SCHED;
            PG8_STAGE(PG8_SB(1, 1), b3 + hstepB, voffB);
            PG8_WAIT_V(6); PG8_BAR; PG8_MMA(1, 1, At, B1); PG8_BAR;
        }
        E(acc, cur, wr, wc, fr, fq);
        if (!has_next) break;
#pragma unroll
        for (int a = 0; a < 2; ++a)
#pragma unroll
            for (int b = 0; b < 2; ++b)
#pragma unroll
                for (int m = 0; m < 4; ++m)
#pragma unroll
                    for (int n = 0; n < 2; ++n) acc[a][b][m][n] = (f32x4){0.f, 0.f, 0.f, 0.f};
        cur = nxt; cA = nA; cB = nB; ++ui;
    }
    PG8_WAIT_V(0);
    if (wr == 0) PG8_BAR;
    PG8_BAR;
#undef PG8_SA
#undef PG8_SB
#undef PG8_STAGE
#undef PG8_LDA
#undef PG8_LDB
#undef PG8_MMA
#undef PG8_WAIT_V
#undef PG8_WAIT_L
#undef PG8_BAR
#undef PG8_SCHED
}
}

struct D1 { static constexpr int MODES = 1; unsigned char* ws;
    __device__ __forceinline__ void get(const pg8::Unit& u, pg8::Dst& d) const { const int sec = u.pn >> 2;
        d.base = ws + OFF_QB + (size_t)sec * (64 * MB) + ((size_t)u.pm * 256 * 1024 + (u.pn & 3) * 256) * 2; d.res = nullptr; d.ld = 1024; d.mode = 0; d.ncol = 256; d.scale = 1.f; } };
struct D2 { static constexpr int MODES = 7; unsigned char* ws;
    __device__ __forceinline__ void get(const pg8::Unit& u, pg8::Dst& d) const { const int sec = u.pn >> 2, cc = (u.pn & 3) * 256; d.res = nullptr; d.ncol = 256; d.scale = 1.f;
        if (sec < 3) { d.base = ws + OFF_QB + (size_t)sec * (64 * MB) + ((size_t)u.pm * 256 * 1024 + cc) * 2; d.ld = 1024; d.mode = sec == 0 ? 1 : (sec == 1 ? 2 : 0); }
        else { d.base = ws + OFF_Y + ((size_t)u.pm * 256 * 2048 + 1024 + cc) * 2; d.ld = 2048; d.mode = 2; } } };
struct D4 { static constexpr int MODES = 32; unsigned char* out; const float* x;
    __device__ __forceinline__ void get(const pg8::Unit& u, pg8::Dst& d) const { const size_t o = (size_t)u.pm * 256 * 1024 + u.pn * 256;
        d.base = out + o * 4; d.res = x + o; d.ld = 1024; d.mode = 5; d.ncol = 256; d.scale = 1.f; } };
struct D5 { static constexpr int MODES = 133; unsigned char* ws;
    __device__ __forceinline__ void get(const pg8::Unit& u, pg8::Dst& d) const { const int pn = u.pn; d.res = nullptr; d.ncol = 256; d.scale = 1.f;
        if (pn < 4) { d.base = ws + OFF_TMP + ((size_t)u.pm * 256 * 1024 + pn * 256) * 2; d.ld = 1024; d.mode = 0; }
        else if (pn == 4) { d.base = ws + OFF_CKVN + (size_t)u.pm * 256 * 256 * 2; d.ld = 256; d.mode = 0; }
        else if (pn == 5) { d.base = ws + OFF_QI + (size_t)u.pm * 256 * 256 * 2; d.ld = 256; d.mode = 7; d.scale = 0.125f; }
        else if (pn == 6) { d.base = ws + OFF_KI + (size_t)u.pm * 256 * 64 * 2; d.ld = 64; d.mode = 7; d.ncol = 64; }
        else { d.base = ws + OFF_Z + ((size_t)u.pm * 256 * 1024 + (pn - 7) * 256) * 2; d.ld = 1024; d.mode = 2; } } };
struct DK { static constexpr int MODES = 64; unsigned char* ws;
    __device__ __forceinline__ void get(const pg8::Unit& u, pg8::Dst& d) const {
        d.base = ws + OFF_RK + ((size_t)u.pm * 256 * 16 + u.pn * 4) * 2; d.res = nullptr; d.ld = 16; d.mode = 6; d.ncol = 256; d.scale = 1.f; } };
struct D8 { static constexpr int MODES = 32; unsigned char* out;
    __device__ __forceinline__ void get(const pg8::Unit& u, pg8::Dst& d) const { const size_t o = (size_t)u.pm * 256 * 1024 + u.pn * 256;
        d.base = out + o * 4; d.res = (const float*)out + o; d.ld = 1024; d.mode = 5; d.ncol = 256; d.scale = 1.f; } };
template <class DF>
__device__ __forceinline__ void fast_gemm(unsigned char* lds, const bf16_t* A, int lda, const bf16_t* Bt, int ldb, int N, int K, const DF& df) {
    pg8::Gemm g{A, lda, Bt, ldb, T, N, K}; pg8::StaticOrder S; S.init(T, N, (int)gridDim.x, (int)blockIdx.x);
    pg8::EpiGen<DF> E{df};
    pg8::gemm_phase(( LAS unsigned char*)lds, g, S, E);
}

__device__ __forceinline__ void tconv(const float* __restrict__ src, int ld, int col0, int ncols, int K, bf16_t* __restrict__ dst, float* tile  ) {
    const int nkt = K / 64, ntiles = nkt * (ncols / 64), tid = threadIdx.x;
    for (int id = blockIdx.x; id < ntiles; id += gridDim.x) {
        const int kt = id % nkt, nt = id / nkt;
#pragma unroll
        for (int j = 0; j < 8; ++j) { const int e = tid + 512 * j, kk = e >> 6, nn = e & 63; tile[kk * 65 + nn] = src[(size_t)(kt * 64 + kk) * ld + col0 + nt * 64 + nn]; }
        __syncthreads();
#pragma unroll
        for (int j = 0; j < 8; ++j) { const int e = tid + 512 * j, nn = e >> 6, kk = e & 63; dst[(size_t)(nt * 64 + nn) * K + kt * 64 + kk] = f2bf(tile[kk * 65 + nn]); }
        __syncthreads();
    }
}
template <int NE>
__device__ __forceinline__ void rmsnorm_rows(const float* __restrict__ src, const float* __restrict__ g, bf16_t* __restrict__ dst,
                             const float* __restrict__ Wx, int ldw, int col0, const float* __restrict__ bias, float scale, float* __restrict__ dstx, float* wl) {
    const int lane = threadIdx.x & 63, wave = threadIdx.x >> 6;
    __syncthreads();
    for (int i = threadIdx.x; i < NE * 1024; i += 512) { const int k = i / NE, e = i % NE; wl[e * 1024 + k] = Wx[(size_t)k * ldw + col0 + e]; }
    __syncthreads();
    for (int row = blockIdx.x * 8 + wave; row < T; row += gridDim.x * 8) {
        f32x4 v[4]; float ss = 0.f;
#pragma unroll
        for (int i = 0; i < 4; ++i) { v[i] = *(const f32x4*)(src + (size_t)row * 1024 + i * 256 + lane * 4); ss += v[i][0] * v[i][0] + v[i][1] * v[i][1] + v[i][2] * v[i][2] + v[i][3] * v[i][3]; }
        ss = wave_sum(ss);
        const float rstd = rsqrtf(ss * (1.0f / 1024.0f) + EPS);
        float ex[NE];
#pragma unroll
        for (int e = 0; e < NE; ++e) ex[e] = 0.f;
#pragma unroll
        for (int i = 0; i < 4; ++i) {
            const f32x4 gg = *(const f32x4*)(g + i * 256 + lane * 4);
            f32x4 y; y[0] = v[i][0] * rstd * gg[0]; y[1] = v[i][1] * rstd * gg[1]; y[2] = v[i][2] * rstd * gg[2]; y[3] = v[i][3] * rstd * gg[3];
            u32x2 w; w.x = pk2(y[0], y[1]); w.y = pk2(y[2], y[3]);
            *(u32x2*)(dst + (size_t)row * 1024 + i * 256 + lane * 4) = w;
#pragma unroll
            for (int e = 0; e < NE; ++e) { const f32x4 wv = *(const f32x4*)(wl + e * 1024 + i * 256 + lane * 4); ex[e] += y[0] * wv[0] + y[1] * wv[1] + y[2] * wv[2] + y[3] * wv[3]; }
        }
#pragma unroll
        for (int e = 0; e < NE; ++e) { const float s = wave_sum(ex[e]); if (lane == 0) dstx[(size_t)row * NE + e] = (s + (bias ? bias[e] : 0.f)) * scale; }
    }
}

__device__ __forceinline__ void phase_prep(const P& p, unsigned char* lds) {
    float* tile = (float*)lds; unsigned char* ws = p.ws;
    bf16_t* W0T = (bf16_t*)(ws + OFF_W0T);
    tconv(p.e_w_in, EIN, 0, 5120, 1024, W0T, tile);
    tconv(p.e_w_in, EIN, 6152, 1024, 1024, W0T + (size_t)6144 * 1024, tile);
    {
        float* arow = tile;
        for (int it = blockIdx.x; it < 4 * 512; it += gridDim.x) {
            const int g = it >> 9, k0 = (it & 511) * 2; const int tid = threadIdx.x, kk = tid >> 8, d = tid & 255;
            __syncthreads();
            arow[tid] = p.e_w_in[(size_t)(k0 + kk) * EIN + 5128 + g * 256 + d];
            __syncthreads();
            const float* wp = p.e_w_pool + (size_t)g * 65536 + d; const float* ar = arow + kk * 256; float acc = 0.f;
#pragma unroll 8
            for (int c = 0; c < 256; ++c) acc += ar[c] * wp[(size_t)c * 256];
            W0T[(size_t)(5120 + g * 256 + d) * 1024 + k0 + kk] = f2bf(acc);
        }
        __syncthreads();
    }
    tconv(p.e_w_out, 1024, 0, 1024, 2048, (bf16_t*)(ws + OFF_WO0T), tile);
    bf16_t* W1T = (bf16_t*)(ws + OFF_W1T);
    tconv(p.o_w_in, OIN, 0, 1600, 1024, W1T, tile);
    for (size_t i = (size_t)blockIdx.x * 512 + threadIdx.x; i < (size_t)192 * 1024; i += (size_t)gridDim.x * 512) W1T[(size_t)1600 * 1024 + i] = 0;
    tconv(p.o_w_in, OIN, 1604, 1024, 1024, W1T + (size_t)1792 * 1024, tile);
    {
        bf16_t* WUKP = (bf16_t*)(ws + OFF_WUKP); bf16_t* WQP = (bf16_t*)(ws + OFF_WQP);
        for (size_t i = (size_t)blockIdx.x * 512 + threadIdx.x; i < (size_t)1024 * 256; i += (size_t)gridDim.x * 512) {
            { const int n = (int)(i >> 8), k = (int)(i & 255), pn = n >> 8, rem = n & 255, bj = rem >> 7, wc = (rem >> 5) & 3, x = rem & 31;
              WUKP[i] = f2bf(p.o_w_uk[(size_t)k * 1024 + (4 * pn + wc) * 64 + 32 * bj + x]); }
            { const int d = (int)(i & 63), r = (int)((i >> 6) & 255), h = (int)(i >> 14);
              WQP[i] = f2bf(p.o_w_uk[(size_t)r * 1024 + h * 64 + d] * p.o_g_k[d] * 0.125f); }
        }
    }
    tconv(p.o_w_uv, 1024, 0, 1024, 256, (bf16_t*)(ws + OFF_WUVT), tile);
    tconv(p.o_w_out, 1024, 0, 1024, 1024, (bf16_t*)(ws + OFF_WO1T), tile);
    rmsnorm_rows<8>(p.x, p.e_norm, (bf16_t*)(ws + OFF_XN), p.e_w_in, EIN, 5120, p.e_b_if, 1.0f, (float*)(ws + OFF_GATES), (float*)lds);
}

__device__ __forceinline__ void phase_conv_scan(const P& p, unsigned char* lds) {
    unsigned char* ws = p.ws; const int tid = threadIdx.x;
    const float* GATES = (const float*)(ws + OFF_GATES);
    float *BQ = (float*)(ws + OFF_BQ), *IQ = (float*)(ws + OFF_IQ), *MT = (float*)(ws + OFF_MT), *CH = (float*)(ws + OFF_CH);
    {
        const int lane = tid & 63, wave = tid >> 6;
        for (int task = blockIdx.x * 8 + wave; task < 2048; task += gridDim.x * 8) {
            const int bh = task >> 8, c = task & 255, batch = bh >> 2, head = bh & 3; const size_t t = (size_t)batch * SEQ + c * 64 + lane;
            const float ig = GATES[t * 8 + head], f = GATES[t * 8 + 4 + head];
            float b = fminf(f, 0.f) - log1pf(__expf(-fabsf(f)));
#pragma unroll
            for (int o = 1; o < 64; o <<= 1) { const float y = __shfl_up(b, o); if (lane >= o) b += y; }
            float rm = ig - b;
#pragma unroll
            for (int o = 1; o < 64; o <<= 1) { const float y = __shfl_up(rm, o); if (lane >= o) rm = fmaxf(rm, y); }
            BQ[t * 4 + head] = b; IQ[t * 4 + head] = ig; MT[t * 4 + head] = rm;
            if (lane == 63) { CH[4096 + bh * 256 + c] = b; CH[bh * 256 + c] = b + rm; }
        }
    }
    const bf16_t* QB = (const bf16_t*)(ws + OFF_QB); const bf16_t* KB = (const bf16_t*)(ws + OFF_KB);
    bf16_t* Y = (bf16_t*)(ws + OFF_Y); bf16_t* KT = (bf16_t*)(ws + OFF_TMP);
    for (size_t it = (size_t)blockIdx.x * 512 + tid; it < (size_t)T * 256; it += (size_t)gridDim.x * 512) {
        const size_t t = it >> 8; const int c0 = (int)(it & 255) * 8, isk = c0 >= 1024, cc = c0 & 1023; const int s = (int)(t & (SEQ - 1));
        const bf16_t* src = isk ? KB : QB;
        float acc[8];
#pragma unroll
        for (int i = 0; i < 8; ++i) acc[i] = 0.f;
#pragma unroll
        for (int j = 0; j < 4; ++j) {
            if (s - 3 + j >= 0) {
                const u32x4 w = *(const u32x4*)(src + (t - 3 + j) * 1024 + cc);
                const f32x4 c0v = *(const f32x4*)(p.e_conv + j * 2048 + c0), c1v = *(const f32x4*)(p.e_conv + j * 2048 + c0 + 4);
                acc[0] += c0v[0] * bflo(w.x); acc[1] += c0v[1] * bfhi(w.x); acc[2] += c0v[2] * bflo(w.y); acc[3] += c0v[3] * bfhi(w.y);
                acc[4] += c1v[0] * bflo(w.z); acc[5] += c1v[1] * bfhi(w.z); acc[6] += c1v[2] * bflo(w.w); acc[7] += c1v[3] * bfhi(w.w);
            }
        }
        const float sc = isk ? 0.0625f : 1.0f;
        u32x4 o; o.x = pk2(siluf_(acc[0]) * sc, siluf_(acc[1]) * sc); o.y = pk2(siluf_(acc[2]) * sc, siluf_(acc[3]) * sc);
        o.z = pk2(siluf_(acc[4]) * sc, siluf_(acc[5]) * sc); o.w = pk2(siluf_(acc[6]) * sc, siluf_(acc[7]) * sc);
        if (isk) *(u32x4*)(KT + t * 1024 + cc) = o; else *(u32x4*)(Y + t * 2048 + 1024 + cc) = o;
    }
}

typedef float f32x16 __attribute__((ext_vector_type(16)));
constexpr int ML_RS = 528, ML_WS = 144;
__device__ __forceinline__ bf16x8 ml_tr8(const LAS unsigned char* a, int second_off) {
    const v4i16_t t0 = __builtin_amdgcn_ds_read_tr16_b64_v4i16((LAS v4i16_t*)a);
    const v4i16_t t1 = __builtin_amdgcn_ds_read_tr16_b64_v4i16((LAS v4i16_t*)(a + second_off));
    bf16x8 r; r[0] = t0[0]; r[1] = t0[1]; r[2] = t0[2]; r[3] = t0[3]; r[4] = t1[0]; r[5] = t1[1]; r[6] = t1[2]; r[7] = t1[3]; return r;
}
__device__ __forceinline__ void mlstm_chunk_scan(const float* CH, int bh, LAS float* sB, LAS float* sMp, LAS float* sMn) {
    const int tid = threadIdx.x;
    if (tid < 256) { sB[tid] = CH[4096 + bh * 256 + tid]; sMn[tid] = CH[bh * 256 + tid]; }
    __syncthreads();
    if (tid == 0) { float m = 0.f; for (int c = 0; c < 256; ++c) { const float g = sMn[c]; sMp[c] = m; m = fmaxf(sB[c] + m, g); sMn[c] = m; } }
    __syncthreads();
}
template <bool FULL>
__device__ __forceinline__ void mlstm_units(const P& p, unsigned char* lds_) {
    unsigned char* ws = p.ws; const int tid0 = threadIdx.x;
    const int w = __builtin_amdgcn_readfirstlane(tid0 >> 6);
    const bf16_t* Yq = (const bf16_t*)(ws + OFF_Y); bf16_t* Yo = (bf16_t*)(ws + OFF_Y);
    const bf16_t* KT = (const bf16_t*)(ws + OFF_TMP); const bf16_t* VB = (const bf16_t*)(ws + OFF_VB);
    float* ST = (float*)(ws + OFF_QB); float* NS = (float*)(ws + OFF_NS);
    const float *BQ = (const float*)(ws + OFF_BQ), *IQ = (const float*)(ws + OFF_IQ), *MT = (const float*)(ws + OFF_MT), *CH = (const float*)(ws + OFF_CH);
    LAS unsigned char* Qs = (LAS unsigned char*)lds_;
    LAS unsigned char* Ks = Qs + 64 * ML_RS;
    LAS unsigned char* Vs = Ks + 64 * ML_RS;
    LAS unsigned char* Wl = Vs + 64 * ML_RS;
    LAS float* sa = (LAS float*)(Wl + 64 * ML_WS);
    LAS float* sden = sa + 64; LAS float* ssw = sden + 64; LAS float* sf = ssw + 64; LAS float* sg = sf + 64; LAS float* nd = sg + 64; LAS float* rden = nd + 64; LAS float* ns = rden + 64;
    LAS float* cB = ns + 256; LAS float* cMp = cB + 256; LAS float* cMn = cMp + 256;
    for (int unit = blockIdx.x; unit < 256; unit += gridDim.x) {
        const int bh = unit >> 5, S = unit & 31, batch = bh >> 2, head = bh & 3;
        const int tid = tid0, lane = tid0 & 63, hh = lane >> 5;
        __syncthreads();
        mlstm_chunk_scan(CH, bh, cB, cMp, cMn);
        f32x16 st[8]; float nreg = 0.f;
        if (FULL) {
#pragma unroll
            for (int kt = 0; kt < 8; ++kt) {
                int lz = lane; asm volatile("" : "+v"(lz) :: "memory");
                const float* sp = ST + (size_t)unit * 65536 + 32 * w + (lz & 31) + (size_t)(32 * kt + 4 * (lz >> 5)) * 256;
#pragma unroll
                for (int r = 0; r < 16; ++r) st[kt][r] = sp[((r & 3) + 8 * (r >> 2)) * 256];
            }
            if (tid < 256) nreg = NS[unit * 256 + tid];
        } else {
#pragma unroll
            for (int kt = 0; kt < 8; ++kt)
#pragma unroll
                for (int r = 0; r < 16; ++r) st[kt][r] = 0.f;
        }
#pragma unroll 1
        for (int cc = 0; cc < 8; ++cc) {
            int tid = tid0; asm volatile("" : "+v"(tid));
            const int lane = tid & 63, l31 = lane & 31, hh = lane >> 5, fr = lane & 15, fq = lane >> 4;
            const int trow = 8 * hh + (fr >> 2), tcol = (16 * (fq & 1) + 4 * (fr & 3)) * 2;
            const int ch = S * 8 + cc; const size_t t0 = (size_t)batch * SEQ + ch * 64;
            const float mprev = cMp[ch], mnew = cMn[ch], blast = cB[ch];
            const float decay = __expf(blast + mprev - mnew);
            __syncthreads();
#pragma unroll
            for (int j = 0; j < 4; ++j) { const int e = tid + 512 * j, r = e >> 5, cg = e & 31;
                *(LAS u32x4*)(Ks + r * ML_RS + cg * 16) = *(const u32x4*)(KT + (t0 + r) * 1024 + head * 256 + cg * 8);
                *(LAS u32x4*)(Vs + r * ML_RS + cg * 16) = *(const u32x4*)(VB + (t0 + r) * 1024 + head * 256 + cg * 8);
                if (FULL) *(LAS u32x4*)(Qs + r * ML_RS + cg * 16) = *(const u32x4*)(Yq + (t0 + r) * 2048 + 1024 + head * 256 + cg * 8); }
            if (tid < 64) { const float bq = BQ[(t0 + tid) * 4 + head], iq = IQ[(t0 + tid) * 4 + head], mt = bq + fmaxf(mprev, MT[(t0 + tid) * 4 + head]);
                sa[tid] = __expf(bq + mprev - mt); sden[tid] = __expf(-mt); ssw[tid] = __expf(blast - bq + iq - mnew); sf[tid] = bq - mt; sg[tid] = iq - bq; }
            if (FULL && tid < 256) ns[tid] = nreg;
            __syncthreads();
            bf16x8 bv[4];
            if (!FULL) {
#pragma unroll
                for (int ks = 0; ks < 4; ++ks) bv[ks] = ml_tr8(Vs + (16 * ks + trow) * ML_RS + 64 * w + tcol, 4 * ML_RS);
            }
            if (FULL) {
                { const int tt = w >> 1;
#pragma unroll
                  for (int si = 0; si < 2; ++si) { const int ss = 2 * (w & 1) + si;
                    f32x4 acc = (f32x4){0.f, 0.f, 0.f, 0.f};
                    if (ss <= tt) {
#pragma unroll
                        for (int ks = 0; ks < 8; ++ks) { const bf16x8 a = *(const LAS bf16x8*)(Qs + (16 * tt + fr) * ML_RS + (32 * ks + 8 * fq) * 2), b = *(const LAS bf16x8*)(Ks + (16 * ss + fr) * ML_RS + (32 * ks + 8 * fq) * 2);
                            acc = __builtin_amdgcn_mfma_f32_16x16x32_bf16(a, b, acc, 0, 0, 0); } }
                    const int sidx = 16 * ss + fr; const float gs = sg[sidx];
#pragma unroll
                    for (int j = 0; j < 4; ++j) { const int tix = 16 * tt + 4 * fq + j; const float wv = (sidx <= tix) ? __expf(sf[tix] + gs) * acc[j] : 0.f;
                        *(LAS bf16_t*)(Wl + tix * ML_WS + sidx * 2) = f2bf(wv); } } }
#pragma unroll
                for (int i = 0; i < 8; ++i) { const int tix = 8 * w + i; const u32x2 qv = *(const LAS u32x2*)(Qs + tix * ML_RS + lane * 8); const f32x4 nv = *(const LAS f32x4*)(ns + lane * 4);
                    float part = bflo(qv.x) * nv[0] + bfhi(qv.x) * nv[1] + bflo(qv.y) * nv[2] + bfhi(qv.y) * nv[3]; part = wave_sum(part); if (lane == 0) nd[tix] = part; }
                __syncthreads();
                f32x16 acc[2];
#pragma unroll
                for (int t2 = 0; t2 < 2; ++t2) {
#pragma unroll
                    for (int r = 0; r < 16; ++r) acc[t2][r] = 0.f;
                }
#pragma unroll
                for (int kt = 0; kt < 8; ++kt) {
                    asm volatile("" ::: "memory");
#pragma unroll
                    for (int s2 = 0; s2 < 2; ++s2) {
                        u32x4 bw; bw.x = pg8::cvt_pk_bf16(st[kt][8 * s2 + 0], st[kt][8 * s2 + 1]); bw.y = pg8::cvt_pk_bf16(st[kt][8 * s2 + 2], st[kt][8 * s2 + 3]);
                        bw.z = pg8::cvt_pk_bf16(st[kt][8 * s2 + 4], st[kt][8 * s2 + 5]); bw.w = pg8::cvt_pk_bf16(st[kt][8 * s2 + 6], st[kt][8 * s2 + 7]);
                        const bf16x8 bfrag = __builtin_bit_cast(bf16x8, bw);
#pragma unroll
                        for (int t2 = 0; t2 < 2; ++t2) { const LAS unsigned char* qa = Qs + (32 * t2 + l31) * ML_RS + (32 * kt + 16 * s2 + 4 * hh) * 2;
                            const u32x2 lo = *(const LAS u32x2*)qa, hi = *(const LAS u32x2*)(qa + 16); u32x4 aw; aw.x = lo.x; aw.y = lo.y; aw.z = hi.x; aw.w = hi.y;
                            acc[t2] = __builtin_amdgcn_mfma_f32_32x32x16_bf16(__builtin_bit_cast(bf16x8, aw), bfrag, acc[t2], 0, 0, 0); }
                    }
                }
                asm volatile("" ::: "memory");
#pragma unroll
                for (int t2 = 0; t2 < 2; ++t2)
#pragma unroll
                    for (int r = 0; r < 16; ++r) acc[t2][r] *= sa[32 * t2 + (r & 3) + 8 * (r >> 2) + 4 * hh];
#pragma unroll
                for (int ks = 0; ks < 4; ++ks) bv[ks] = ml_tr8(Vs + (16 * ks + trow) * ML_RS + 64 * w + tcol, 4 * ML_RS);
#pragma unroll
                for (int ks = 0; ks < 4; ++ks)
#pragma unroll
                    for (int t2 = 0; t2 < 2; ++t2) { const bf16x8 a = *(const LAS bf16x8*)(Wl + (32 * t2 + l31) * ML_WS + (16 * ks + 8 * hh) * 2);
                        acc[t2] = __builtin_amdgcn_mfma_f32_32x32x16_bf16(a, bv[ks], acc[t2], 0, 0, 0); }
#pragma unroll
                for (int i = 0; i < 8; ++i) { const int tix = 8 * w + i; float rs = bf2f(*(const LAS bf16_t*)(Wl + tix * ML_WS + lane * 2)); rs = wave_sum(rs);
                    if (lane == 0) { const float nq = sa[tix] * nd[tix] + rs; rden[tix] = 1.0f / fmaxf(fabsf(nq), sden[tix]); } }
                __syncthreads();
                bf16_t* yo = Yo + t0 * 2048 + head * 256 + 32 * w + l31;
#pragma unroll
                for (int t2 = 0; t2 < 2; ++t2)
#pragma unroll
                    for (int r = 0; r < 16; ++r) { const int tix = 32 * t2 + (r & 3) + 8 * (r >> 2) + 4 * hh; yo[(size_t)tix * 2048] = f2bf(acc[t2][r] * rden[tix]); }
            }
#pragma unroll
            for (int kt = 0; kt < 8; ++kt) st[kt] *= decay;
#pragma unroll
            for (int ks = 0; ks < 4; ++ks) {
                const u32x4 raw = __builtin_bit_cast(u32x4, bv[ks]); const LAS float* sw8 = ssw + 16 * ks + 8 * hh;
                u32x4 sc; sc.x = pg8::cvt_pk_bf16(bflo(raw.x) * sw8[0], bfhi(raw.x) * sw8[1]); sc.y = pg8::cvt_pk_bf16(bflo(raw.y) * sw8[2], bfhi(raw.y) * sw8[3]);
                sc.z = pg8::cvt_pk_bf16(bflo(raw.z) * sw8[4], bfhi(raw.z) * sw8[5]); sc.w = pg8::cvt_pk_bf16(bflo(raw.w) * sw8[6], bfhi(raw.w) * sw8[7]);
                const bf16x8 bs = __builtin_bit_cast(bf16x8, sc);
#pragma unroll
                for (int kt = 0; kt < 8; ++kt) { if ((kt & 3) == 0) asm volatile("" ::: "memory");
                    const bf16x8 a = ml_tr8(Ks + (16 * ks + trow) * ML_RS + 64 * kt + tcol, 4 * ML_RS);
                    st[kt] = __builtin_amdgcn_mfma_f32_32x32x16_bf16(a, bs, st[kt], 0, 0, 0); }
            }
            if (tid < 256) { float nacc = 0.f;
#pragma unroll 8
                for (int s2 = 0; s2 < 64; ++s2) nacc += ssw[s2] * bf2f(*(const LAS bf16_t*)(Ks + s2 * ML_RS + tid * 2));
                nreg = decay * nreg + nacc; }
        }
        if (!FULL) {
#pragma unroll
            for (int kt = 0; kt < 8; ++kt) {
                int lz = lane; asm volatile("" : "+v"(lz) :: "memory");
                float* sp = ST + (size_t)unit * 65536 + 32 * w + (lz & 31) + (size_t)(32 * kt + 4 * (lz >> 5)) * 256;
#pragma unroll
                for (int r = 0; r < 16; ++r) sp[((r & 3) + 8 * (r >> 2)) * 256] = st[kt][r];
            }
            if (tid < 256) NS[unit * 256 + tid] = nreg;
        }
    }
}
__device__ __forceinline__ void phase_mlstm_scan(const P& p, unsigned char* lds_) {
    unsigned char* ws = p.ws; const int tid = threadIdx.x;
    float* ST = (float*)(ws + OFF_QB); float* NS = (float*)(ws + OFF_NS); const float* CH = (const float*)(ws + OFF_CH);
    LAS float* DS = (LAS float*)lds_;
    LAS float* cB = DS + 256; LAS float* cMp = cB + 256; LAS float* cMn = cMp + 256;
    for (int bh = 0; bh < 8; ++bh) {
        __syncthreads();
        mlstm_chunk_scan(CH, bh, cB, cMp, cMn);
        if (tid < 32) { float d = 1.f; for (int c = 0; c < 8; ++c) { const int ch = tid * 8 + c; d *= __expf(cB[ch] + cMp[ch] - cMn[ch]); } DS[bh * 32 + tid] = d; }
    }
    __syncthreads();
    const int per = 65536 + 256;
    for (int it = blockIdx.x * 512 + tid; it < 8 * per; it += gridDim.x * 512) {
        const int bh = it / per, e = it - bh * per;
        float* base; size_t stride;
        if (e < 65536) { base = ST + (size_t)bh * 32 * 65536 + e; stride = 65536; } else { base = NS + (size_t)bh * 32 * 256 + (e - 65536); stride = 256; }
        float carry = 0.f;
#pragma unroll 8
        for (int S = 0; S < 32; ++S) { const float tmp = base[S * stride]; base[S * stride] = carry; carry = DS[bh * 32 + S] * carry + tmp; }
    }
}

__device__ __forceinline__ void phase_ya_pool(const P& p) {
    unsigned char* ws = p.ws; const int tid = threadIdx.x, lane = tid & 63, wave = tid >> 6;
    bf16_t* Y = (bf16_t*)(ws + OFF_Y); const bf16_t* O = (const bf16_t*)(ws + OFF_QB); const bf16_t* ZA = (const bf16_t*)(ws + OFF_KB);
    for (int it = blockIdx.x * 8 + wave; it < T * 4; it += gridDim.x * 8) {
        const size_t t = (size_t)(it >> 2); const int head = it & 3, c = head * 256 + lane * 4;
        const u32x2 hw = *(const u32x2*)(Y + t * 2048 + c), ow = *(const u32x2*)(O + t * 1024 + c), zw = *(const u32x2*)(ZA + t * 1024 + c);
        float v[4] = {bflo(hw.x) * bflo(ow.x), bfhi(hw.x) * bfhi(ow.x), bflo(hw.y) * bflo(ow.y), bfhi(hw.y) * bfhi(ow.y)};
        float ss = wave_sum(v[0] * v[0] + v[1] * v[1] + v[2] * v[2] + v[3] * v[3]);
        const float rstd = rsqrtf(ss * (1.0f / 256.0f) + EPS);
        const f32x4 g = *(const f32x4*)(p.e_g_head + c);
        u32x2 o; o.x = pk2(v[0] * rstd * g[0] * bflo(zw.x), v[1] * rstd * g[1] * bfhi(zw.x)); o.y = pk2(v[2] * rstd * g[2] * bflo(zw.y), v[3] * rstd * g[3] * bfhi(zw.y));
        *(u32x2*)(Y + t * 2048 + c) = o;
    }
    const bf16_t* U = (const bf16_t*)(ws + OFF_VB);
    for (size_t it = (size_t)blockIdx.x * 512 + tid; it < (size_t)T * 128; it += (size_t)gridDim.x * 512) {
        const size_t t = it >> 7; const int c0 = (int)(it & 127) * 8, g = c0 >> 8, win = 2 << g, s = (int)(t & (SEQ - 1)); const int cnt = (s + 1 < win) ? s + 1 : win;
        float acc[8], self[8];
#pragma unroll
        for (int i = 0; i < 8; ++i) { acc[i] = 0.f; self[i] = 0.f; }
        for (int j = 0; j < cnt; ++j) { const u32x4 w = *(const u32x4*)(U + (t - j) * 1024 + c0);
            const float f[8] = {bflo(w.x), bfhi(w.x), bflo(w.y), bfhi(w.y), bflo(w.z), bfhi(w.z), bflo(w.w), bfhi(w.w)};
#pragma unroll
            for (int i = 0; i < 8; ++i) { acc[i] += f[i]; if (j == 0) self[i] = f[i]; } }
        const float inv = 1.0f / (float)cnt;
        bf16_t* yp = Y + t * 2048 + 1024 + c0; const u32x4 z = *(const u32x4*)yp;
        const float zf[8] = {bflo(z.x), bfhi(z.x), bflo(z.y), bfhi(z.y), bflo(z.z), bfhi(z.z), bflo(z.w), bfhi(z.w)};
        const f32x4 s0 = *(const f32x4*)(p.e_s_pool + c0), s1 = *(const f32x4*)(p.e_s_pool + c0 + 4);
        float o[8];
#pragma unroll
        for (int i = 0; i < 8; ++i) o[i] = (acc[i] * inv - self[i]) * (i < 4 ? s0[i] : s1[i - 4]) * zf[i];
        u32x4 ow; ow.x = pk2(o[0], o[1]); ow.y = pk2(o[2], o[3]); ow.z = pk2(o[4], o[5]); ow.w = pk2(o[6], o[7]);
        *(u32x4*)yp = ow;
    }
}

__device__ __forceinline__ void headnorm64(bf16_t* X, const float* g) {
    const int lane = threadIdx.x & 63, wave = threadIdx.x >> 6;
    for (int t = blockIdx.x * 8 + wave; t < T; t += gridDim.x * 8) {
        bf16_t* r = X + (size_t)t * 1024 + lane * 16;
        const u32x4 a = *(const u32x4*)r, b = *(const u32x4*)(r + 8);
        float f[16] = {bflo(a.x), bfhi(a.x), bflo(a.y), bfhi(a.y), bflo(a.z), bfhi(a.z), bflo(a.w), bfhi(a.w), bflo(b.x), bfhi(b.x), bflo(b.y), bfhi(b.y), bflo(b.z), bfhi(b.z), bflo(b.w), bfhi(b.w)};
        float ss = 0.f;
#pragma unroll
        for (int i = 0; i < 16; ++i) ss += f[i] * f[i];
        ss += __shfl_xor(ss, 1); ss += __shfl_xor(ss, 2);
        const float rstd = rsqrtf(ss * (1.0f / 64.0f) + EPS);
        const float* gg = g + (lane & 3) * 16;
#pragma unroll
        for (int i = 0; i < 16; ++i) f[i] = f[i] * rstd * gg[i];
        u32x4 oa, ob; oa.x = pk2(f[0], f[1]); oa.y = pk2(f[2], f[3]); oa.z = pk2(f[4], f[5]); oa.w = pk2(f[6], f[7]);
        ob.x = pk2(f[8], f[9]); ob.y = pk2(f[10], f[11]); ob.z = pk2(f[12], f[13]); ob.w = pk2(f[14], f[15]);
        *(u32x4*)r = oa; *(u32x4*)(r + 8) = ob;
    }
}
__device__ __forceinline__ void phase_qnorm_ckvnorm(const P& p) {
    unsigned char* ws = p.ws; const int lane = threadIdx.x & 63, wave = threadIdx.x >> 6;
    headnorm64((bf16_t*)(ws + OFF_TMP), p.o_g_q);
    bf16_t* CKVN = (bf16_t*)(ws + OFF_CKVN);
    for (int t = blockIdx.x * 8 + wave; t < T; t += gridDim.x * 8) {
        const u32x2 w = *(const u32x2*)(CKVN + (size_t)t * 256 + lane * 4);
        const float v[4] = {bflo(w.x), bfhi(w.x), bflo(w.y), bfhi(w.y)};
        const float ss = wave_sum(v[0] * v[0] + v[1] * v[1] + v[2] * v[2] + v[3] * v[3]);
        const float rstd = rsqrtf(ss * (1.0f / 256.0f) + EPS);
        const f32x4 g = *(const f32x4*)(p.o_g_kv + lane * 4);
        u32x2 o; o.x = pk2(v[0] * rstd * g[0], v[1] * rstd * g[1]); o.y = pk2(v[2] * rstd * g[2], v[3] * rstd * g[3]);
        *(u32x2*)(CKVN + (size_t)t * 256 + lane * 4) = o;
    }
}

__device__ __forceinline__ unsigned okey(float s) { if (s == 0.f) s = 0.f; const unsigned u = __float_as_uint(s); return (u & 0x80000000u) ? ~u : (u | 0x80000000u); }

__device__ __forceinline__ void indexer_slow_query(const P& p, unsigned char* lds, size_t t) {
    unsigned char* ws = p.ws; const int tid = threadIdx.x, lane = tid & 63, wave = tid >> 6;
    const _Float16* QI = (const _Float16*)(ws + OFF_QI); const _Float16* KI = (const _Float16*)(ws + OFF_KI); const float* WI = (const float*)(ws + OFF_WI);
    unsigned short* IDX = (unsigned short*)(ws + OFF_IDX);
    unsigned* sc = (unsigned*)lds; unsigned* hist = sc + 16384; float* qs = (float*)(hist + 256); unsigned* misc = (unsigned*)(qs + 256); unsigned* wsum = misc + 16;
    const int batch = (int)(t >> 14), pos = (int)(t & (SEQ - 1)), n = pos + 1;
    __syncthreads();
    if (tid < 256) qs[tid] = (float)QI[t * 256 + tid];
    const float w0 = WI[t * 4 + 0], w1 = WI[t * 4 + 1], w2 = WI[t * 4 + 2], w3 = WI[t * 4 + 3];
    __syncthreads();
    const _Float16* kbase = KI + (size_t)batch * SEQ * 64;
    for (int s = tid; s < n; s += 512) {
        asm volatile("" ::: "memory");
        typedef _Float16 h8 __attribute__((ext_vector_type(8)));
        const h8* kr = (const h8*)(kbase + (size_t)s * 64);
        float d0 = 0.f, d1 = 0.f, d2 = 0.f, d3 = 0.f;
#pragma unroll
        for (int j = 0; j < 8; ++j) { const h8 kv = kr[j];
#pragma unroll
            for (int e = 0; e < 8; ++e) { const int d = j * 8 + e; const float kf = (float)kv[e]; d0 += qs[d] * kf; d1 += qs[64 + d] * kf; d2 += qs[128 + d] * kf; d3 += qs[192 + d] * kf; } }
        float score = w0 * fmaxf(d0, 0.f); score = fmaf(w1, fmaxf(d1, 0.f), score); score = fmaf(w2, fmaxf(d2, 0.f), score); score = fmaf(w3, fmaxf(d3, 0.f), score);
        sc[s] = okey(score);
    }
    unsigned prefix = 0, krem = 256;
    for (int pass = 0; pass < 4; ++pass) {
        const int shift = 24 - 8 * pass;
        __syncthreads();
        if (tid < 256) hist[tid] = 0;
        __syncthreads();
        for (int s = tid; s < n; s += 512) { const unsigned k = sc[s]; if (pass == 0 || (k >> (shift + 8)) == prefix) atomicAdd(&hist[(k >> shift) & 255u], 1u); }
        __syncthreads();
        if (tid == 0) { unsigned cum = 0; int bin = 255; for (; bin > 0; --bin) { const unsigned c = hist[bin]; if (cum + c >= krem) break; cum += c; } misc[0] = (unsigned)bin; misc[1] = krem - cum; }
        __syncthreads();
        prefix = (prefix << 8) | misc[0]; krem = misc[1];
    }
    const unsigned ngt_total = 256u - krem;
    unsigned lg = 0, le = 0; const int s0 = tid * 32;
    for (int s = s0; s < s0 + 32 && s < n; ++s) { const unsigned k = sc[s]; lg += (k > prefix); le += (k == prefix); }
    unsigned pk = lg | (le << 16), incl = pk;
#pragma unroll
    for (int o = 1; o < 64; o <<= 1) { const unsigned y = __shfl_up(incl, o); if (lane >= o) incl += y; }
    if (lane == 63) wsum[wave] = incl;
    __syncthreads();
    unsigned base = 0;
    for (int w = 0; w < wave; ++w) base += wsum[w];
    const unsigned excl = base + incl - pk; unsigned bg = excl & 0xffffu, be = excl >> 16;
    for (int s = s0; s < s0 + 32 && s < n; ++s) { const unsigned k = sc[s];
        if (k > prefix) { IDX[t * 256 + bg] = (unsigned short)s; ++bg; }
        else if (k == prefix) { if (be < krem) IDX[t * 256 + ngt_total + be] = (unsigned short)s; ++be; } }
    __syncthreads();
}

typedef _Float16 half8 __attribute__((ext_vector_type(8)));
constexpr int IX_CAP = 1024, IX_ZBIN = 1024;
__device__ __forceinline__ unsigned ix_key(const f32x4 a, const f32x4 w) {
    const float r0 = __int_as_float(max(__float_as_int(a[0]), 0)), r1 = __int_as_float(max(__float_as_int(a[1]), 0));
    const float r2 = __int_as_float(max(__float_as_int(a[2]), 0)), r3 = __int_as_float(max(__float_as_int(a[3]), 0));
    float s = w[0] * r0; s = fmaf(w[1], r1, s); s = fmaf(w[2], r2, s); s = fmaf(w[3], r3, s);
    unsigned u = __float_as_uint(s); u = (u == 0x80000000u) ? 0u : u;
    return u ^ ((unsigned)((int)u >> 31) | 0x80000000u);
}
#define LDS_ADD(ptr, v) __hip_atomic_fetch_add((ptr), (v), __ATOMIC_RELAXED, __HIP_MEMORY_SCOPE_WORKGROUP)
__device__ __forceinline__ void phase_indexer(const P& p, unsigned char* lds) {
    unsigned char* ws = p.ws; const int tid = threadIdx.x, lane = tid & 63, kl = lane & 15, g = lane >> 4;
    const int wave = __builtin_amdgcn_readfirstlane(tid >> 6);
    const _Float16* QI = (const _Float16*)(ws + OFF_QI); const _Float16* KI = (const _Float16*)(ws + OFF_KI); const float* WI = (const float*)(ws + OFF_WI);
    unsigned short* IDX = (unsigned short*)(ws + OFF_IDX); int* CNT = (int*)(ws + OFF_CNT);
    LAS unsigned* hist = (LAS unsigned*)lds;
    LAS unsigned* zc = hist + 16 * 2048;
    LAS unsigned* zpre = zc + 128;
    LAS int* qTbin = (LAS int*)(zpre + 128);
    LAS int* qCab = qTbin + 16; LAS int* qCb = qCab + 16; LAS unsigned* qNgt = (LAS unsigned*)(qCb + 16); LAS unsigned* qNcand = qNgt + 16; LAS int* qOvf = (LAS int*)(qNcand + 16);
    LAS unsigned* ovl = (LAS unsigned*)(lds + 132 * 1024);
    LAS unsigned* h2 = (LAS unsigned*)(lds + 133 * 1024 + wave * 1536);
    LAS unsigned long long* l2 = (LAS unsigned long long*)(h2 + 256);
    if (tid == 0) ovl[0] = 0u;
    const int G = gridDim.x, nround = (T / 16) / G;
#pragma unroll 1
    for (int i = 0; i < nround; ++i) {
        const int tix = (i & 1) ? i * G + (G - 1 - (int)blockIdx.x) : i * G + (int)blockIdx.x;
        const int batch = tix & 1, tb = tix >> 1, p0 = tb * 16; const size_t t0 = (size_t)batch * SEQ + p0;
        __syncthreads();
        if (p0 + 16 <= 256) {
#pragma unroll
            for (int j = 0; j < 8; ++j) { const int e = tid + 512 * j, q = e >> 8, jj = e & 255; IDX[(t0 + q) * 256 + jj] = (unsigned short)(jj <= p0 + q ? jj : 0); }
            if (tid < 16) CNT[t0 + tid] = p0 + tid + 1;
            continue;
        }
#pragma unroll
        for (int j = 0; j < 16; ++j) ((LAS u32x4*)hist)[tid + 512 * j] = (u32x4){0u, 0u, 0u, 0u};
        if (tid < 256) zc[tid] = 0u;
        if (tid < 16) { qNgt[tid] = 0u; qNcand[tid] = 0u; qOvf[tid] = 0; }
        half8 af[4][2]; f32x4 wv[4];
#pragma unroll
        for (int rt = 0; rt < 4; ++rt) {
#pragma unroll
            for (int ks = 0; ks < 2; ++ks) af[rt][ks] = *(const half8*)(QI + (t0 + 4 * rt + (kl >> 2)) * 256 + (kl & 3) * 64 + 32 * ks + 8 * g);
            wv[rt] = *(const f32x4*)(WI + (t0 + 4 * rt + g) * 4);
        }
        __syncthreads();
        const int nblk = tb + 1, L = (nblk + 7) >> 3, b0 = wave * L, b1 = (b0 + L < nblk) ? b0 + L : nblk;
        const _Float16* kb = KI + (size_t)batch * SEQ * 64 + kl * 64 + 8 * g;
        LAS unsigned* hg = hist + g * 4 * 2048;
        {
            unsigned zcnt[4] = {0u, 0u, 0u, 0u};
            half8 k0 = (half8){0, 0, 0, 0, 0, 0, 0, 0}, k1 = k0;
            if (b0 < b1) { k0 = *(const half8*)(kb + (size_t)b0 * 1024); k1 = *(const half8*)(kb + (size_t)b0 * 1024 + 32); }
#pragma unroll 1
            for (int b = b0; b < b1; ++b) {
                const int bn = (b + 1 < b1) ? b + 1 : b; const int s = b * 16 + kl;
                const half8 n0 = *(const half8*)(kb + (size_t)bn * 1024), n1 = *(const half8*)(kb + (size_t)bn * 1024 + 32);
#pragma unroll
                for (int rt = 0; rt < 4; ++rt) {
                    f32x4 acc = __builtin_amdgcn_mfma_f32_16x16x32_f16(af[rt][0], k0, (f32x4){0.f, 0.f, 0.f, 0.f}, 0, 0, 0);
                    acc = __builtin_amdgcn_mfma_f32_16x16x32_f16(af[rt][1], k1, acc, 0, 0, 0);
                    const unsigned key = ix_key(acc, wv[rt]);
                    if (s <= p0 + 4 * rt + g) { LDS_ADD(hg + rt * 2048 + (key >> 21), 1u); zcnt[rt] += (key == 0x80000000u) ? 1u : 0u; }
                }
                k0 = n0; k1 = n1;
            }
#pragma unroll
            for (int rt = 0; rt < 4; ++rt) if (zcnt[rt]) LDS_ADD(zc + (g * 4 + rt) * 8 + wave, zcnt[rt]);
        }
        __syncthreads();
#pragma unroll 1
        for (int qq = 0; qq < 2; ++qq) {
            const int q = 2 * wave + qq; const LAS unsigned* h = hist + q * 2048;
            unsigned cs = 0; const int top = 2047 - 32 * lane;
            for (int ii = 0; ii < 32; ++ii) cs += h[top - ((ii + lane) & 31)];
            unsigned incl = cs;
#pragma unroll
            for (int o = 1; o < 64; o <<= 1) { const unsigned y = __shfl_up(incl, o); if (lane >= o) incl += y; }
            const unsigned long long m = __ballot(incl >= 256u);
            const int Ls = m ? (__ffsll((long long)m) - 1) : 63;
            unsigned cabv = __shfl(incl - cs, Ls), cbv = 0; int tbin = 0; bool found = false;
            for (int ii = 0; ii < 32; ++ii) { const unsigned c = h[2047 - 32 * Ls - ii]; if (!found && cabv + c >= 256u) { tbin = 2047 - 32 * Ls - ii; cbv = c; found = true; } if (!found) cabv += c; }
            if (lane == 0) { qTbin[q] = tbin; qCab[q] = (int)cabv; qCb[q] = (int)cbv; if (tbin != IX_ZBIN && cbv > (unsigned)IX_CAP) qOvf[q] = 1; }
            { unsigned v = lane < 8 ? zc[q * 8 + lane] : 0u, inc = v;
#pragma unroll
              for (int o = 1; o < 8; o <<= 1) { const unsigned y = __shfl_up(inc, o); if (lane >= o) inc += y; }
              if (lane < 8) zpre[q * 8 + lane] = inc - v; }
        }
        __syncthreads();
        {
            int tbn[4], cab[4], rr[4]; unsigned zrun[4];
#pragma unroll
            for (int rt = 0; rt < 4; ++rt) { const int q = g * 4 + rt; tbn[rt] = qOvf[q] ? 4096 : qTbin[q]; cab[rt] = qCab[q]; rr[rt] = 256 - cab[rt]; zrun[rt] = zpre[q * 8 + wave]; }
            half8 k0 = (half8){0, 0, 0, 0, 0, 0, 0, 0}, k1 = k0;
            if (b0 < b1) { k0 = *(const half8*)(kb + (size_t)b0 * 1024); k1 = *(const half8*)(kb + (size_t)b0 * 1024 + 32); }
#pragma unroll 1
            for (int b = b0; b < b1; ++b) {
                const int bn = (b + 1 < b1) ? b + 1 : b; const int s = b * 16 + kl;
                const half8 n0 = *(const half8*)(kb + (size_t)bn * 1024), n1 = *(const half8*)(kb + (size_t)bn * 1024 + 32);
                unsigned key[4]; bool sel[4], inb[4]; unsigned pos[4];
#pragma unroll
                for (int rt = 0; rt < 4; ++rt) {
                    f32x4 acc = __builtin_amdgcn_mfma_f32_16x16x32_f16(af[rt][0], k0, (f32x4){0.f, 0.f, 0.f, 0.f}, 0, 0, 0);
                    acc = __builtin_amdgcn_mfma_f32_16x16x32_f16(af[rt][1], k1, acc, 0, 0, 0);
                    key[rt] = ix_key(acc, wv[rt]); const int bin = (int)(key[rt] >> 21);
                    const bool valid = s <= p0 + 4 * rt + g;
                    sel[rt] = valid && bin > tbn[rt]; inb[rt] = valid && bin == tbn[rt];
                }
#pragma unroll
                for (int rt = 0; rt < 4; ++rt) { const int qs = g * 4 + rt; const bool cand = inb[rt] && tbn[rt] != IX_ZBIN;
                    LAS unsigned* tgt = sel[rt] ? (qNgt + qs) : (cand ? (qNcand + qs) : (zc + lane));
                    pos[rt] = LDS_ADD(tgt, (sel[rt] || cand) ? 1u : 0u); }
#pragma unroll
                for (int rt = 0; rt < 4; ++rt) { const int qs = g * 4 + rt;
                    if (__builtin_expect(tbn[rt] == IX_ZBIN, 0)) {
                        const unsigned long long zm = __ballot(inb[rt]);
                        const unsigned gm = (unsigned)(zm >> (16 * g)) & 0xffffu;
                        if (inb[rt] && key[rt] != 0x80000000u) qOvf[qs] = 1;
                        if (inb[rt]) { const unsigned pz = zrun[rt] + __popc(gm & ((1u << kl) - 1u)); if ((int)pz < rr[rt]) IDX[(t0 + 4 * rt + g) * 256 + cab[rt] + pz] = (unsigned short)s; }
                        zrun[rt] += __popc(gm);
                    } else if (inb[rt]) { if (pos[rt] < (unsigned)IX_CAP) ((LAS unsigned long long*)(lds + qs * 8192))[pos[rt]] = ((unsigned long long)key[rt] << 16) | (unsigned long long)(0xffffu - (unsigned)s); }
                    if (sel[rt]) IDX[(t0 + 4 * rt + g) * 256 + pos[rt]] = (unsigned short)s;
                }
                k0 = n0; k1 = n1;
            }
        }
        __syncthreads();
#pragma unroll 1
        for (int qq = 0; qq < 2; ++qq) {
            const int qs = 2 * wave + qq; const int tbin = qTbin[qs], n = qCb[qs], cabq = qCab[qs], r = 256 - cabq;
            if (tbin == IX_ZBIN || qOvf[qs]) continue;
            const LAS unsigned long long* cd = (const LAS unsigned long long*)(lds + qs * 8192);
            unsigned short* irow = IDX + (t0 + 4 * (qs & 3) + (qs >> 2)) * 256 + cabq;
            if (r >= n) { for (int c = lane; c < n; c += 64) irow[c] = (unsigned short)(0xffffu - (unsigned)(cd[c] & 0xffffull)); continue; }
#pragma unroll
            for (int j = 0; j < 4; ++j) h2[lane + 64 * j] = 0u;
            for (int c = lane; c < n; c += 64) LDS_ADD(h2 + ((unsigned)(cd[c] >> 29) & 255u), 1u);
            const unsigned cs = h2[255 - 4 * lane] + h2[254 - 4 * lane] + h2[253 - 4 * lane] + h2[252 - 4 * lane];
            unsigned incl = cs;
#pragma unroll
            for (int o = 1; o < 64; o <<= 1) { const unsigned y = __shfl_up(incl, o); if (lane >= o) incl += y; }
            const unsigned long long m = __ballot(incl >= (unsigned)r);
            const int Ls = m ? (__ffsll((long long)m) - 1) : 63;
            unsigned above = __shfl(incl - cs, Ls), c2 = 0; int T2 = 0; bool found = false;
#pragma unroll
            for (int ii = 0; ii < 4; ++ii) { const unsigned c = h2[255 - 4 * Ls - ii]; if (!found && above + c >= (unsigned)r) { T2 = 255 - 4 * Ls - ii; c2 = c; found = true; } if (!found) above += c; }
            const int r2 = r - (int)above;
            asm volatile("" ::: "memory");
            if (lane == 0) { h2[0] = 0u; h2[1] = 0u; }
            asm volatile("" ::: "memory");
            for (int c = lane; c < n; c += 64) { const unsigned long long v = cd[c]; const int sub = (int)((unsigned)(v >> 29) & 255u);
                if (sub > T2) { const unsigned pos = LDS_ADD(h2 + 0, 1u); irow[pos] = (unsigned short)(0xffffu - (unsigned)(v & 0xffffull)); }
                else if (sub == T2) { const unsigned pos = LDS_ADD(h2 + 1, 1u); if (pos < 64u) l2[pos] = v; } }
            asm volatile("" ::: "memory");
            if (c2 <= 64u) {
                const unsigned long long mine = (unsigned)lane < c2 ? l2[lane] : ~0ull; int rank = 0;
                for (unsigned j = 0; j < c2; ++j) rank += (l2[j] > mine) ? 1 : 0;
                if ((unsigned)lane < c2 && rank < r2) irow[above + rank] = (unsigned short)(0xffffu - (unsigned)(mine & 0xffffull));
            } else {
                for (int c0 = 0; c0 < n; c0 += 64) {
                    const int c = c0 + lane; const unsigned long long mine = c < n ? cd[c] : ~0ull; const bool have = c < n && (int)((unsigned)(mine >> 29) & 255u) == T2;
                    int rank = 0;
                    for (int j = 0; j < n; ++j) { const unsigned long long cj = cd[j]; rank += ((int)((unsigned)(cj >> 29) & 255u) == T2 && cj > mine) ? 1 : 0; }
                    if (have && rank < r2) irow[above + rank] = (unsigned short)(0xffffu - (unsigned)(mine & 0xffffull));
                }
            }
        }
        if (tid < 16) CNT[t0 + tid] = 256;
        if (tid < 16 && qOvf[tid]) { const unsigned k = LDS_ADD(ovl, 1u); ovl[1 + k] = (unsigned)(t0 + 4 * (tid & 3) + (tid >> 2)); }
    }
    __syncthreads();
    const unsigned novl = __builtin_amdgcn_readfirstlane(ovl[0]);
#pragma unroll 1
    for (unsigned k = 0; k < novl; ++k) { const unsigned tq = __builtin_amdgcn_readfirstlane(ovl[1 + k]); indexer_slow_query(p, lds, (size_t)tq); }
}
#undef LDS_ADD

__device__ __forceinline__ void phase_attn(const P& p, unsigned char* lds) {
    unsigned char* ws = p.ws; const int tid = threadIdx.x, lane = tid & 63, hd = lane & 15, g = lane >> 4;
    const int wave = __builtin_amdgcn_readfirstlane(tid >> 6);
    bf16_t* QP = (bf16_t*)(ws + OFF_QP); const bf16_t* CK = (const bf16_t*)(ws + OFF_CKVN); const bf16_t* RK = (const bf16_t*)(ws + OFF_RK);
    const unsigned short* IDX = (const unsigned short*)(ws + OFF_IDX); const int* CNT = (const int*)(ws + OFF_CNT);
    float* biasT = (float*)lds;
    biasT[tid] = p.rel_bias[tid];
    __syncthreads();
    LAS unsigned char* rows = (LAS unsigned char*)(lds + 2048 + (size_t)wave * 18432);
    LAS bf16_t* rkb = (LAS bf16_t*)(rows + 16384);
    LAS unsigned* info = (LAS unsigned*)(rows + 17408);
    const LAS float* biasL = (const LAS float*)lds;
    for (int t = blockIdx.x * 8 + wave; t < T; t += gridDim.x * 8) {
        const int batch = t >> 14, pos = t & (SEQ - 1); const int cnt = CNT[t];
        const size_t rb = (size_t)batch * SEQ;
        asm volatile("s_waitcnt lgkmcnt(0)" ::: "memory");
#pragma unroll
        for (int jj = 0; jj < 4; ++jj) {
            const int j = lane + 64 * jj; int id = IDX[(size_t)t * 256 + j]; if (j >= cnt) id = 0;
            const int rel = pos - id; int bucket = rel < 0 ? 0 : rel;
            if (rel >= 16) { bucket = 16 + (int)(__logf((float)rel * 0.0625f) / 2.0794415416798357f * 16.0f); bucket = bucket > 31 ? 31 : bucket; }
            info[j] = (unsigned)id | ((unsigned)bucket << 16);
        }
        bf16x8 qf[8];
#pragma unroll
        for (int ks = 0; ks < 8; ++ks) qf[ks] = *(const bf16x8*)(QP + (size_t)t * 4096 + hd * 256 + ks * 32 + g * 8);
        f32x4 o[16];
#pragma unroll
        for (int rt = 0; rt < 16; ++rt) o[rt] = (f32x4){0.f, 0.f, 0.f, 0.f};
        float mrun = -1e30f, lrun = 0.f;
        asm volatile("s_waitcnt lgkmcnt(0)" ::: "memory");
        const int nch = (cnt + 31) >> 5;
        for (int ch = 0; ch < nch; ++ch) {
            asm volatile("s_waitcnt lgkmcnt(0)" ::: "memory");
#pragma unroll
            for (int i = 0; i < 16; ++i) {
                const int ksl = 2 * i + (lane >> 5); const unsigned idv = info[ch * 32 + ksl] & 0xffffu;
                const bf16_t* src = CK + (rb + idv) * 256 + (((lane & 31) ^ (ksl & 15)) * 8);
                __builtin_amdgcn_global_load_lds((const unsigned*)src, (LAS unsigned*)(rows + i * 1024), 16, 0, 0);
            }
            { const unsigned idv = info[ch * 32 + (lane >> 1)] & 0xffffu;
              __builtin_amdgcn_global_load_lds((const unsigned*)(RK + (rb + idv) * 16 + (lane & 1) * 8), (LAS unsigned*)rkb, 16, 0, 0); }
            asm volatile("s_waitcnt vmcnt(0)" ::: "memory");
            f32x4 s0 = (f32x4){0.f, 0.f, 0.f, 0.f}, s1 = (f32x4){0.f, 0.f, 0.f, 0.f};
#pragma unroll
            for (int ks = 0; ks < 8; ++ks) {
                const int pos16 = ((4 * ks + g) ^ hd) * 16;
                const bf16x8 a0 = *(const LAS bf16x8*)(rows + hd * 512 + pos16);
                const bf16x8 a1 = *(const LAS bf16x8*)(rows + (16 + hd) * 512 + pos16);
                s0 = __builtin_amdgcn_mfma_f32_16x16x32_bf16(a0, qf[ks], s0, 0, 0, 0);
                s1 = __builtin_amdgcn_mfma_f32_16x16x32_bf16(a1, qf[ks], s1, 0, 0, 0);
            }
            float x0[4], x1[4]; float cm = -INFINITY;
#pragma unroll
            for (int r = 0; r < 4; ++r) {
                const int sl0 = 4 * g + r, sl1 = 16 + 4 * g + r, j0 = ch * 32 + sl0, j1 = ch * 32 + sl1;
                const unsigned i0 = info[j0], i1 = info[j1];
                const float r0 = bf2f(rkb[sl0 * 16 + hd]), r1 = bf2f(rkb[sl1 * 16 + hd]);
                x0[r] = (j0 < cnt) ? s0[r] * r0 + biasL[(i0 >> 16) * 16 + hd] : -INFINITY;
                x1[r] = (j1 < cnt) ? s1[r] * r1 + biasL[(i1 >> 16) * 16 + hd] : -INFINITY;
                cm = fmaxf(cm, fmaxf(x0[r], x1[r]));
            }
            cm = fmaxf(cm, __shfl_xor(cm, 16)); cm = fmaxf(cm, __shfl_xor(cm, 32));
            const float mnew = fmaxf(mrun, cm); const float sc = __expf(mrun - mnew); mrun = mnew;
            float ls = 0.f;
#pragma unroll
            for (int r = 0; r < 4; ++r) { x0[r] = __expf(x0[r] - mnew); x1[r] = __expf(x1[r] - mnew); ls += x0[r] + x1[r]; }
            lrun = lrun * sc + ls;
#pragma unroll
            for (int rt = 0; rt < 16; ++rt) o[rt] *= sc;
            u32x4 pw; pw.x = pg8::cvt_pk_bf16(x0[0], x0[1]); pw.y = pg8::cvt_pk_bf16(x0[2], x0[3]); pw.z = pg8::cvt_pk_bf16(x1[0], x1[1]); pw.w = pg8::cvt_pk_bf16(x1[2], x1[3]);
            const bf16x8 pf = __builtin_bit_cast(bf16x8, pw);
            const int q = hd >> 2, pp = hd & 3, ksl = 4 * g + q;
            const LAS unsigned char* trb = rows + ksl * 512 + (pp & 1) * 8;
#pragma unroll
            for (int rt = 0; rt < 16; ++rt) {
                const int c16 = ((2 * rt + (pp >> 1)) ^ ksl) * 16;
                const v4i16_t t0 = __builtin_amdgcn_ds_read_tr16_b64_v4i16((LAS v4i16_t*)(trb + c16));
                const v4i16_t t1 = __builtin_amdgcn_ds_read_tr16_b64_v4i16((LAS v4i16_t*)(trb + c16 + 8192));
                bf16x8 af; af[0] = t0[0]; af[1] = t0[1]; af[2] = t0[2]; af[3] = t0[3]; af[4] = t1[0]; af[5] = t1[1]; af[6] = t1[2]; af[7] = t1[3];
                o[rt] = __builtin_amdgcn_mfma_f32_16x16x32_bf16(af, pf, o[rt], 0, 0, 0);
            }
        }
        float ltot = lrun; ltot += __shfl_xor(ltot, 16); ltot += __shfl_xor(ltot, 32);
        const float inv = 1.0f / ltot;
        bf16_t* op = QP + (size_t)t * 4096 + hd * 256 + 4 * g;
#pragma unroll
        for (int rt = 0; rt < 16; ++rt) { u32x2 w; w.x = pg8::cvt_pk_bf16(o[rt][0] * inv, o[rt][1] * inv); w.y = pg8::cvt_pk_bf16(o[rt][2] * inv, o[rt][3] * inv); *(u32x2*)(op + rt * 16) = w; }
    }
}

__global__ void __launch_bounds__(512, 2) k_fwd(P p_arg, int ph_lo, int ph_hi) {
    extern __shared__ __attribute__((aligned(16))) unsigned char smem[];
    const P& p = *(const P*)__builtin_amdgcn_kernarg_segment_ptr(); (void)p_arg;
    unsigned char* lds = smem + 16;
    unsigned char* ws = p.ws;
    XcdBarrier bar;
    const bool multi = (ph_hi - ph_lo) > 1;
    if (multi) {
        if (threadIdx.x == 0) *(uint4*)smem = make_uint4(0u, 0u, 0u, 0u);
        __syncthreads();
        bar = xcd_barrier_post((unsigned*)(ws + OFF_CTL), (volatile LAS unsigned*)smem);
    }
#define PH(i) (ph_lo <= (i) && (i) < ph_hi)
#define SEAM(i) do { if ((i) + 1 < ph_hi) xcd_barrier(bar); else __syncthreads(); } while (0)
    bf16_t *XN = (bf16_t*)(ws + OFF_XN), *QB = (bf16_t*)(ws + OFF_QB), *KB = (bf16_t*)(ws + OFF_KB), *VB = (bf16_t*)(ws + OFF_VB), *TMP = (bf16_t*)(ws + OFF_TMP), *Y = (bf16_t*)(ws + OFF_Y);
    if (PH(0)) { phase_prep(p, lds); SEAM(0); }
    if (PH(1)) { fast_gemm(lds, XN, 1024, (const bf16_t*)(ws + OFF_W0T), 1024, 3072, 1024, D1{ws}); SEAM(1); }
    if (PH(2)) { phase_conv_scan(p, lds); SEAM(2); }
    if (PH(3)) { mlstm_units<false>(p, lds); SEAM(3); }
    if (PH(4)) { phase_mlstm_scan(p, lds); SEAM(4); }
    if (PH(5)) { mlstm_units<true>(p, lds); SEAM(5); }
    if (PH(6)) { fast_gemm(lds, XN, 1024, (const bf16_t*)(ws + OFF_W0T) + (size_t)3072 * 1024, 1024, 4096, 1024, D2{ws}); SEAM(6); }
    if (PH(7)) { phase_ya_pool(p); SEAM(7); }
    if (PH(8)) { fast_gemm(lds, Y, 2048, (const bf16_t*)(ws + OFF_WO0T), 2048, 1024, 2048, D4{(unsigned char*)p.out, p.x}); SEAM(8); }
    if (PH(9)) { rmsnorm_rows<4>(p.out, p.o_norm, XN, p.o_w_in, OIN, 1600, nullptr, 0.5f, (float*)(ws + OFF_WI), (float*)lds); SEAM(9); }
    if (PH(10)) { fast_gemm(lds, XN, 1024, (const bf16_t*)(ws + OFF_W1T), 1024, 2816, 1024, D5{ws}); SEAM(10); }
    if (PH(11)) { phase_qnorm_ckvnorm(p); SEAM(11); }
    if (PH(12)) { fast_gemm(lds, (const bf16_t*)(ws + OFF_CKVN), 256, (const bf16_t*)(ws + OFF_WUKP), 256, 1024, 256, DK{ws}); SEAM(12); }
    if (PH(13)) { GQP f{TMP, (const bf16_t*)(ws + OFF_WQP), (bf16_t*)(ws + OFF_QP)}; sgemm(f, 512 * 64); phase_indexer(p, lds); SEAM(13); }
    if (PH(14)) { phase_attn(p, lds); SEAM(14); }
    if (PH(15)) { GOP f{(const bf16_t*)(ws + OFF_QP), (const bf16_t*)(ws + OFF_WUVT), (const bf16_t*)(ws + OFF_Z), TMP}; sgemm(f, 512 * 16); SEAM(15); }
    if (PH(16)) { fast_gemm(lds, TMP, 1024, (const bf16_t*)(ws + OFF_WO1T), 1024, 1024, 1024, D8{(unsigned char*)p.out}); }
#undef PH
#undef SEAM
}

extern "C" void kernel_launch(void* const* d_in, const int* in_sizes, int n_in, void* d_out, int out_size, void* d_ws, size_t ws_size, hipStream_t stream) {
    static int grid = 0;
    if (grid == 0) {
        if (n_in != 18 || out_size != T * DM || ws_size < WS_END) { fprintf(stderr, "kernel_launch: unexpected shapes (n_in %d out %d ws %zu)\n", n_in, out_size, ws_size); grid = -1; return; }
        if (hipFuncSetAttribute((const void*)k_fwd, hipFuncAttributeMaxDynamicSharedMemorySize, LDS_BYTES) != hipSuccess) { fprintf(stderr, "kernel_launch: hipFuncSetAttribute failed\n"); grid = -1; return; }
        grid = 256;
    }
    if (grid < 0) return;
    (void)hipMemsetAsync((char*)d_ws + OFF_CTL, 0, 16384, stream);
    P p{};
    p.x = (const float*)d_in[0]; p.e_norm = (const float*)d_in[1]; p.e_w_in = (const float*)d_in[2]; p.e_conv = (const float*)d_in[3]; p.e_b_if = (const float*)d_in[4];
    p.e_g_head = (const float*)d_in[5]; p.e_w_pool = (const float*)d_in[6]; p.e_s_pool = (const float*)d_in[7]; p.e_w_out = (const float*)d_in[8];
    p.o_norm = (const float*)d_in[9]; p.o_w_in = (const float*)d_in[10]; p.o_g_kv = (const float*)d_in[11]; p.o_w_uk = (const float*)d_in[12]; p.o_w_uv = (const float*)d_in[13];
    p.o_g_q = (const float*)d_in[14]; p.o_g_k = (const float*)d_in[15]; p.o_w_out = (const float*)d_in[16]; p.rel_bias = (const float*)d_in[17];
    p.out = (float*)d_out; p.ws = (unsigned char*)d_ws;
    hipLaunchKernelGGL(k_fwd, dim3(grid), dim3(512), LDS_BYTES, stream, p, 0, NPH);
}
```

```cpp
#include <hip/hip_runtime.h>
#include <stdint.h>
#include <cstdio>

typedef unsigned short bf16_t;
typedef short bf16x8 __attribute__((ext_vector_type(8)));
typedef float f32x4 __attribute__((ext_vector_type(4)));
typedef unsigned u32x4 __attribute__((ext_vector_type(4)));
typedef unsigned u32x2 __attribute__((ext_vector_type(2)));
typedef short v4i16_t __attribute__((ext_vector_type(4)));
#define LAS __attribute__((address_space(3)))

constexpr int T = 32768, SEQ = 16384, DM = 1024;
constexpr int EIN = 7176, OIN = 2628;
constexpr float EPS = 1e-6f;
constexpr size_t MB = 1048576;
constexpr size_t OFF_CTL = 0;
constexpr size_t OFF_GATES = 64 * 1024;
constexpr size_t OFF_BQ = OFF_GATES + (size_t)T * 8 * 4;
constexpr size_t OFF_IQ = OFF_BQ + (size_t)T * 4 * 4;
constexpr size_t OFF_MT = OFF_IQ + (size_t)T * 4 * 4;
constexpr size_t OFF_WI = OFF_MT + (size_t)T * 4 * 4;
constexpr size_t OFF_CH = OFF_WI + (size_t)T * 4 * 4;
constexpr size_t OFF_NS = OFF_CH + 64 * 1024;
constexpr size_t OFF_W = 4 * MB;
constexpr size_t OFF_W0T = OFF_W;
constexpr size_t OFF_WPT = OFF_W0T + (size_t)7168 * 1024 * 2;
constexpr size_t OFF_WO0T = OFF_WPT + (size_t)4 * 256 * 256 * 2;
constexpr size_t OFF_W1T = OFF_WO0T + (size_t)1024 * 2048 * 2;
constexpr size_t OFF_WUKT = OFF_W1T + (size_t)2816 * 1024 * 2;
constexpr size_t OFF_WUVT = OFF_WUKT + (size_t)1024 * 256 * 2;
constexpr size_t OFF_WO1T = OFF_WUVT + (size_t)1024 * 256 * 2;
constexpr size_t OFF_WUKP = OFF_WO1T + (size_t)1024 * 1024 * 2;
constexpr size_t OFF_WQP = OFF_WUKP + (size_t)1024 * 256 * 2;
constexpr size_t OFF_WUB = OFF_WQP + (size_t)16 * 256 * 64 * 2;
constexpr size_t OFF_XN = 36 * MB, OFF_QB = 100 * MB, OFF_KB = 164 * MB, OFF_VB = 228 * MB, OFF_TMP = 292 * MB, OFF_Y = 356 * MB;
constexpr size_t OFF_QP = 36 * MB;
constexpr size_t OFF_CKVN = OFF_Y;
constexpr size_t OFF_QI = OFF_Y + 16 * MB;
constexpr size_t OFF_KI = OFF_Y + 32 * MB;
constexpr size_t OFF_IDX = OFF_Y + 40 * MB;
constexpr size_t OFF_RK = OFF_Y + 58 * MB;
constexpr size_t OFF_CNT = OFF_Y + 59 * MB;
constexpr size_t OFF_Z = OFF_Y + 60 * MB;
constexpr size_t WS_END = 484 * MB;
constexpr int LDS_BYTES = 151552;
constexpr int NPH = 17;

struct P {
    const float *x, *e_norm, *e_w_in, *e_conv, *e_b_if, *e_g_head, *e_w_pool, *e_s_pool, *e_w_out;
    const float *o_norm, *o_w_in, *o_g_kv, *o_w_uk, *o_w_uv, *o_g_q, *o_g_k, *o_w_out, *rel_bias;
    float* out; unsigned char* ws;
};

__device__ __forceinline__ bf16_t f2bf(float f) { unsigned u = __float_as_uint(f); u += 0x7FFFu + ((u >> 16) & 1u); return (bf16_t)(u >> 16); }
__device__ __forceinline__ float bf2f(bf16_t b) { return __uint_as_float(((unsigned)b) << 16); }
__device__ __forceinline__ float bflo(unsigned w) { return __uint_as_float(w << 16); }
__device__ __forceinline__ float bfhi(unsigned w) { return __uint_as_float(w & 0xffff0000u); }
__device__ __forceinline__ unsigned pk2(float a, float b) { return (unsigned)f2bf(a) | ((unsigned)f2bf(b) << 16); }
__device__ __forceinline__ float sigmoidf_(float x) { return 1.0f / (1.0f + __expf(-x)); }
__device__ __forceinline__ float siluf_(float x) { return x / (1.0f + __expf(-x)); }
__device__ __forceinline__ float wave_sum(float v) {
#pragma unroll
    for (int o = 32; o >= 1; o >>= 1) v += __shfl_xor(v, o);
    return v;
}
__device__ __forceinline__ float wave_max(float v) {
#pragma unroll
    for (int o = 32; o >= 1; o >>= 1) v = fmaxf(v, __shfl_xor(v, o));
    return v;
}

#define XB_TMO      128
#define XB_XCNT(j)  (256  + 64 * (j))
#define XB_XSUB(j)  (1280 + 64 * (j))
#define XB_XGEN(j)  (2304 + 64 * (j))
#define XB_TOP      3328
#define XB_TOPGEN   3392
#define XCD_BAR_WORDS 3456
#define XB_SPIN_CAP (1u << 22)
__device__ __forceinline__ unsigned xb_ld(unsigned* p)              { return __hip_atomic_load(p, __ATOMIC_RELAXED, __HIP_MEMORY_SCOPE_AGENT); }
__device__ __forceinline__ unsigned xb_add(unsigned* p, unsigned v) { return __hip_atomic_fetch_add(p, v, __ATOMIC_RELAXED, __HIP_MEMORY_SCOPE_AGENT); }
__device__ __forceinline__ unsigned xb_xcc_id() { return (unsigned)__builtin_amdgcn_s_getreg((3 << 11) | 20) & 0xFu; }
#define XB_SPIN(cond, bar) do { unsigned _sp = 0; while (cond) { __builtin_amdgcn_s_sleep(1); \
    if ((++_sp & 255u) == 0u) { if (xb_ld(&(bar)[XB_TMO])) break; if (_sp > XB_SPIN_CAP) { atomicAdd(&(bar)[XB_TMO], 1u); break; } } } } while (0)
struct XcdBarrier { unsigned* bar; unsigned x; volatile LAS unsigned* st; };
__device__ __forceinline__ XcdBarrier xcd_barrier_post(unsigned* bar, volatile LAS unsigned* st) {
    XcdBarrier b; b.bar = bar; b.x = xb_xcc_id(); b.st = st;
    if (threadIdx.x == 0) (void)xb_add(&bar[XB_XCNT(b.x)], 1u);
    return b;
}
__device__ __forceinline__ void xcd_barrier_complete(unsigned* bar, unsigned x, unsigned& nloc, unsigned& nx) {
    const unsigned G = gridDim.x * gridDim.y * gridDim.z;
    unsigned sum, cnt, mine, sp = 0u;
    for (;;) {
        sum = 0u; cnt = 0u; mine = 0u;
#pragma unroll
        for (unsigned j = 0; j < 16; ++j) { const unsigned c = xb_ld(&bar[XB_XCNT(j)]); sum += c; cnt += (c > 0u) ? 1u : 0u; mine = (j == x) ? c : mine; }
        if (sum == G) break;
        __builtin_amdgcn_s_sleep(1);
        if ((++sp & 255u) == 0u) { if (xb_ld(&bar[XB_TMO])) break; if (sp > XB_SPIN_CAP) { atomicAdd(&bar[XB_TMO], 1u); break; } }
    }
    nloc = mine > 0u ? mine : 1u; nx = cnt > 0u ? cnt : 1u;
}
__device__ __forceinline__ void xcd_barrier(const XcdBarrier& b) {
    asm volatile("s_waitcnt vmcnt(0)" ::: "memory");
    __syncthreads();
    if (threadIdx.x == 0) {
        unsigned* bar = b.bar;
        __builtin_amdgcn_s_waitcnt(0);
        unsigned nloc = b.st[0], nx = b.st[1];
        if (nloc == 0u) { xcd_barrier_complete(bar, b.x, nloc, nx); b.st[0] = nloc; b.st[1] = nx; }
        const unsigned old = xb_add(&bar[XB_XSUB(b.x)], 1u);
        const unsigned gen = old / nloc;
        if (old + 1u == (gen + 1u) * nloc) {
            __builtin_amdgcn_fence(__ATOMIC_RELEASE, "agent");
            asm volatile("s_waitcnt vmcnt(0)" ::: "memory");
            const unsigned og = xb_add(&bar[XB_TOP], 1u);
            const unsigned tg = og / nx;
            if (og + 1u == (tg + 1u) * nx) xb_add(&bar[XB_TOPGEN], 1u);
            else XB_SPIN(xb_ld(&bar[XB_TOPGEN]) == tg, bar);
            __builtin_amdgcn_fence(__ATOMIC_ACQUIRE, "agent");
            xb_add(&bar[XB_XGEN(b.x)], 1u);
            asm volatile("s_waitcnt vmcnt(0)" ::: "memory");
        } else {
            XB_SPIN(xb_ld(&bar[XB_XGEN(b.x)]) == gen, bar);
            __builtin_amdgcn_fence(__ATOMIC_ACQUIRE, "agent");
            asm volatile("s_waitcnt vmcnt(0)" ::: "memory");
        }
    }
    __syncthreads();
}

struct Tile { const bf16_t* A; const bf16_t* B; int lda, ldb, K; void* d0; const void* s0; int ld, mode; float aux0, aux1, aux2; int i0, i1; };
template <class F>
__device__ __forceinline__ void sgemm(const F f, int nunits) {
    const int lane = threadIdx.x & 63, wave = threadIdx.x >> 6, fr = lane & 15, fq = lane >> 4;
    for (int u = blockIdx.x * 8 + wave; u < nunits; u += gridDim.x * 8) {
        Tile tl; f.tile(u, tl);
        f32x4 acc[4][4];
#pragma unroll
        for (int m = 0; m < 4; ++m)
#pragma unroll
            for (int n = 0; n < 4; ++n) acc[m][n] = (f32x4){0.f, 0.f, 0.f, 0.f};
        const bf16_t* ap = tl.A + (size_t)fr * tl.lda + fq * 8;
        const bf16_t* bp = tl.B + (size_t)fr * tl.ldb + fq * 8;
        const int K = tl.K, lda = tl.lda, ldb = tl.ldb;
#pragma unroll 1
        for (int k0 = 0; k0 < K; k0 += 32) {
            bf16x8 a[4], b[4];
#pragma unroll
            for (int m = 0; m < 4; ++m) a[m] = *(const bf16x8*)(ap + (size_t)(m * 16) * lda + k0);
#pragma unroll
            for (int n = 0; n < 4; ++n) b[n] = *(const bf16x8*)(bp + (size_t)(n * 16) * ldb + k0);
#pragma unroll
            for (int m = 0; m < 4; ++m)
#pragma unroll
                for (int n = 0; n < 4; ++n) acc[m][n] = __builtin_amdgcn_mfma_f32_16x16x32_bf16(a[m], b[n], acc[m][n], 0, 0, 0);
        }
#pragma unroll
        for (int m = 0; m < 4; ++m)
#pragma unroll
            for (int j = 0; j < 4; ++j) {
                const int r = m * 16 + fq * 4 + j;
                asm volatile("" ::: "memory");
#pragma unroll
                for (int n = 0; n < 4; ++n) f.out(tl, r, n * 16 + fr, acc[m][n][j]);
            }
    }
}
__device__ __forceinline__ void store_mode(const Tile& tl, int r, int c, float v) {
    const size_t i = (size_t)r * tl.ld + c;
    if (tl.mode == 0) ((bf16_t*)tl.d0)[i] = f2bf(v);
    else if (tl.mode == 1) ((bf16_t*)tl.d0)[i] = f2bf(sigmoidf_(v));
    else if (tl.mode == 2) ((bf16_t*)tl.d0)[i] = f2bf(siluf_(v));
    else if (tl.mode == 3) ((float*)tl.d0)[i] = v * tl.aux0;
}

struct G1 {
    const bf16_t* XN; const bf16_t* W; bf16_t *Q, *K_, *V;
    __device__ __forceinline__ void tile(int u, Tile& tl) const {
        const int mt = u / 48, nt = u % 48; tl.A = XN + (size_t)mt * 64 * 1024; tl.lda = 1024; tl.B = W + (size_t)nt * 64 * 1024; tl.ldb = 1024; tl.K = 1024;
        const int col = nt * 64, sec = col >> 10, cc = col & 1023; bf16_t* d = Q + (size_t)sec * (32 * MB);
        tl.d0 = d + (size_t)mt * 64 * 1024 + cc; tl.ld = 1024; tl.mode = 0; }
    __device__ __forceinline__ void out(const Tile& tl, int r, int c, float v) const { store_mode(tl, r, c, v); }
};
struct G2 {
    const bf16_t* XN; const bf16_t* W; bf16_t *O, *ZA, *U, *Y;
    __device__ __forceinline__ void tile(int u, Tile& tl) const {
        const int mt = u / 64, nt = u % 64; tl.A = XN + (size_t)mt * 64 * 1024; tl.lda = 1024; tl.B = W + (size_t)(3072 + nt * 64) * 1024; tl.ldb = 1024; tl.K = 1024;
        const int col = nt * 64, sec = col >> 10, cc = col & 1023;
        if (sec == 0) { tl.d0 = O + (size_t)mt * 64 * 1024 + cc; tl.ld = 1024; tl.mode = 1; }
        else if (sec == 1) { tl.d0 = ZA + (size_t)mt * 64 * 1024 + cc; tl.ld = 1024; tl.mode = 2; }
        else if (sec == 2) { tl.d0 = U + (size_t)mt * 64 * 1024 + cc; tl.ld = 1024; tl.mode = 0; }
        else { tl.d0 = Y + (size_t)mt * 64 * 2048 + 1024 + cc; tl.ld = 2048; tl.mode = 2; } }
    __device__ __forceinline__ void out(const Tile& tl, int r, int c, float v) const { store_mode(tl, r, c, v); }
};
struct GM1 {
    const bf16_t* Y; const bf16_t* KT; const float *BQ, *IQ, *MT; float* W;
    __device__ __forceinline__ void tile(int u, Tile& tl) const {
        const int bh = u >> 8, c = u & 255, batch = bh >> 2, head = bh & 3; const size_t t0 = (size_t)batch * SEQ + c * 64;
        tl.A = Y + t0 * 2048 + 1024 + head * 256; tl.lda = 2048; tl.B = KT + t0 * 1024 + head * 256; tl.ldb = 1024; tl.K = 256;
        tl.d0 = W + (size_t)u * 4096; tl.ld = 64; tl.mode = 0; tl.i0 = (int)(t0 * 4 + head); }
    __device__ __forceinline__ void out(const Tile& tl, int r, int c, float v) const {
        float w = 0.f;
        if (c <= r) w = __expf(BQ[tl.i0 + r * 4] - BQ[tl.i0 + c * 4] + IQ[tl.i0 + c * 4] - MT[tl.i0 + r * 4]) * v;
        ((float*)tl.d0)[r * 64 + c] = w; }
};
struct G3 {
    const bf16_t* XN; const bf16_t* W; const float* sp; bf16_t* Y;
    __device__ __forceinline__ void tile(int u, Tile& tl) const {
        const int mt = u >> 4, g = (u >> 2) & 3, nt = u & 3; tl.A = XN + (size_t)mt * 64 * 1024 + g * 256; tl.lda = 1024; tl.B = W + (size_t)(g * 256 + nt * 64) * 256; tl.ldb = 256; tl.K = 256;
        const int col = g * 256 + nt * 64; tl.d0 = Y + (size_t)mt * 64 * 2048 + 1024 + col; tl.ld = 2048; tl.s0 = sp + col; tl.mode = 0; }
    __device__ __forceinline__ void out(const Tile& tl, int r, int c, float v) const {
        bf16_t* d = (bf16_t*)tl.d0 + (size_t)r * 2048 + c; *d = f2bf(v * ((const float*)tl.s0)[c] * bf2f(*d)); }
};
struct G4 {
    const bf16_t* Y; const bf16_t* W; const float* x; float* out_;
    __device__ __forceinline__ void tile(int u, Tile& tl) const {
        const int mt = u >> 4, nt = u & 15; tl.A = Y + (size_t)mt * 64 * 2048; tl.lda = 2048; tl.B = W + (size_t)nt * 64 * 2048; tl.ldb = 2048; tl.K = 2048;
        const size_t o = (size_t)mt * 64 * 1024 + nt * 64; tl.d0 = out_ + o; tl.s0 = x + o; tl.ld = 1024; tl.mode = 0; }
    __device__ __forceinline__ void out(const Tile& tl, int r, int c, float v) const { const size_t i = (size_t)r * 1024 + c; ((float*)tl.d0)[i] = ((const float*)tl.s0)[i] + v; }
};
struct G5 {
    const bf16_t* XN; const bf16_t* W; bf16_t* Q; float *CKVR, *QI, *KI; bf16_t* Z;
    __device__ __forceinline__ void tile(int u, Tile& tl) const {
        const int mt = u / 44, nt = u % 44; tl.A = XN + (size_t)mt * 64 * 1024; tl.lda = 1024; tl.B = W + (size_t)nt * 64 * 1024; tl.ldb = 1024; tl.K = 1024;
        const int col = nt * 64; const size_t row0 = (size_t)mt * 64; tl.aux0 = 1.0f;
        if (col < 1024) { tl.d0 = Q + row0 * 1024 + col; tl.ld = 1024; tl.mode = 0; }
        else if (col < 1280) { tl.d0 = CKVR + row0 * 256 + (col - 1024); tl.ld = 256; tl.mode = 3; }
        else if (col < 1536) { tl.d0 = QI + row0 * 256 + (col - 1280); tl.ld = 256; tl.mode = 3; tl.aux0 = 0.125f; }
        else if (col < 1600) { tl.d0 = KI + row0 * 64 + (col - 1536); tl.ld = 64; tl.mode = 3; }
        else if (col < 1792) { tl.d0 = nullptr; tl.ld = 0; tl.mode = 4; }
        else { tl.d0 = Z + row0 * 1024 + (col - 1792); tl.ld = 1024; tl.mode = 2; } }
    __device__ __forceinline__ void out(const Tile& tl, int r, int c, float v) const { store_mode(tl, r, c, v); }
};
struct G67 {
    const bf16_t* C; const bf16_t *WK, *WV; bf16_t *KF, *VF;
    __device__ __forceinline__ void tile(int u, Tile& tl) const {
        const int which = u >= 8192, uu = u & 8191, mt = uu >> 4, nt = uu & 15; tl.A = C + (size_t)mt * 64 * 256; tl.lda = 256; tl.B = WK + (size_t)which * (1024 * 256) + (size_t)nt * 64 * 256;     tl.ldb = 256; tl.K = 256;
        tl.d0 = KF + (size_t)which * (32 * MB) + (size_t)mt * 64 * 1024 + nt * 64;     tl.ld = 1024; tl.mode = 0; }
    __device__ __forceinline__ void out(const Tile& tl, int r, int c, float v) const { store_mode(tl, r, c, v); }
};
struct G8 {
    const bf16_t* G; const bf16_t* W; float* out_;
    __device__ __forceinline__ void tile(int u, Tile& tl) const {
        const int mt = u >> 4, nt = u & 15; tl.A = G + (size_t)mt * 64 * 1024; tl.lda = 1024; tl.B = W + (size_t)nt * 64 * 1024; tl.ldb = 1024; tl.K = 1024;
        tl.d0 = out_ + (size_t)mt * 64 * 1024 + nt * 64; tl.ld = 1024; tl.mode = 0; }
    __device__ __forceinline__ void out(const Tile& tl, int r, int c, float v) const { float* d = (float*)tl.d0 + (size_t)r * 1024 + c; *d = *d + v; }
};

struct GWP {
    const bf16_t* WPT; const bf16_t* WUB; bf16_t* W0T;
    __device__ __forceinline__ void tile(int u, Tile& tl) const {
        const int kt = u & 15, dt = (u >> 4) & 3, g = u >> 6; tl.A = WPT + (size_t)(g * 256 + dt * 64) * 256; tl.lda = 256; tl.B = WUB + (size_t)kt * 64 * 1024 + g * 256; tl.ldb = 1024; tl.K = 256;
        tl.d0 = W0T + (size_t)(5120 + g * 256 + dt * 64) * 1024 + kt * 64; tl.ld = 1024; tl.mode = 0; }
    __device__ __forceinline__ void out(const Tile& tl, int r, int c, float v) const { store_mode(tl, r, c, v); }
};
struct GQP {
    const bf16_t* Qn; const bf16_t* W; bf16_t* QP;
    __device__ __forceinline__ void tile(int u, Tile& tl) const {
        const int nt = u & 3, head = (u >> 2) & 15, mt = u >> 6; tl.A = Qn + (size_t)mt * 64 * 1024 + head * 64; tl.lda = 1024; tl.B = W + (size_t)(head * 256 + nt * 64) * 64; tl.ldb = 64; tl.K = 64;
        tl.d0 = QP + ((size_t)mt * 64 * 16 + head) * 256 + nt * 64; tl.ld = 4096; tl.mode = 0; }
    __device__ __forceinline__ void out(const Tile& tl, int r, int c, float v) const { store_mode(tl, r, c, v); }
};
struct GOP {
    const bf16_t* OP; const bf16_t* W; const bf16_t* Z; bf16_t* G;
    __device__ __forceinline__ void tile(int u, Tile& tl) const {
        const int head = u & 15, mt = u >> 4; tl.A = OP + (size_t)mt * 64 * 4096 + head * 256; tl.lda = 4096; tl.B = W + (size_t)head * 64 * 256; tl.ldb = 256; tl.K = 256;
        const size_t o = (size_t)mt * 64 * 1024 + head * 64; tl.d0 = G + o; tl.s0 = Z + o; tl.ld = 1024; tl.mode = 0; }
    __device__ __forceinline__ void out(const Tile& tl, int r, int c, float v) const { const size_t i = (size_t)r * 1024 + c; ((bf16_t*)tl.d0)[i] = f2bf(v * bf2f(((const bf16_t*)tl.s0)[i])); }
};

namespace pg8 {
constexpr int BM = 256, BK = 64, HALF = 128, HTB = HALF * BK * 2, STAGE_BYTES = 8 * HTB, NXCD = 8, WGM = 8;
__device__ __forceinline__ int lds_byte(int r, int c) { const int st = (r >> 4) * 2 + (c >> 5), rr = r & 15, cc = c & 31, ob = rr * 64 + cc * 2; return st * 1024 + (ob ^ (((ob >> 9) & 1) << 5)); }
__device__ __forceinline__ void stage_rc(int b, int& R, int& C) { const int st = b / 1024, sb = b % 1024, swz = sb ^ (((sb >> 9) & 1) << 5); R = (st >> 1) * 16 + swz / 64; C = (st & 1) * 32 + (swz % 64) / 2; }
__device__ __forceinline__ int perm32(int rho) { const int n = rho >> 4, i = rho & 15; return 8 * (i >> 2) + 4 * n + (i & 3); }
struct Unit { int pm, pn; };
struct Gemm { const bf16_t* A; int lda; const bf16_t* Bt; int ldb; int M, N, K; };
struct StaticOrder {
    int nM, nN, nwg, G, c;
    __device__ void init(int M, int N, int G_, int c_) { nM = M / BM; nN = N / BM; nwg = nM * nN; G = G_; c = c_; }
    __device__ bool next(int i, Unit& u) const {
        const long L = (long)i * G + c; if (L >= nwg) return false;
        int wgid = (int)L; { const int q = nwg / NXCD, r = nwg % NXCD, xcd = wgid % NXCD, off = wgid / NXCD; wgid = (xcd < r ? xcd * (q + 1) : r * (q + 1) + (xcd - r) * q) + off; }
        const int nig = WGM * nN, gid = wgid / nig, fm = gid * WGM, gsz = (nM - fm) < WGM ? (nM - fm) : WGM;
        u.pm = fm + ((wgid % nig) % gsz); u.pn = (wgid % nig) / gsz; return true;
    }
};
__device__ __forceinline__ unsigned cvt_pk_bf16(float lo, float hi) { unsigned r; asm volatile("v_cvt_pk_bf16_f32 %0, %1, %2" : "=v"(r) : "v"(lo), "v"(hi)); return r; }

struct Dst { unsigned char* base; const float* res; int ld, mode, ncol; float scale; };
template <class DescF> struct EpiGen {
    static constexpr bool PERM = true;
    DescF D;
    __device__ __forceinline__ void operator()(const f32x4 (&acc)[2][2][4][2], const Unit& u, int wr, int wc, int fr, int fq) const {
        Dst d; D.get(u, d);
        if ((DescF::MODES & 16) && d.mode == 4) return;
        const int r0 = wr * 64 + fr, c0 = wc * 32 + 8 * fq;
        if constexpr ((DescF::MODES & 64) != 0) {
#pragma unroll
            for (int ai = 0; ai < 2; ++ai)
#pragma unroll
                for (int m = 0; m < 4; ++m) {
                    float ss = 0.f;
#pragma unroll
                    for (int bj = 0; bj < 2; ++bj)
#pragma unroll
                        for (int n = 0; n < 2; ++n) { const f32x4 v = acc[ai][bj][m][n]; ss += v[0] * v[0] + v[1] * v[1] + v[2] * v[2] + v[3] * v[3]; }
                    ss += __shfl_xor(ss, 16); ss += __shfl_xor(ss, 32);
                    if (fq == 0) ((bf16_t*)d.base)[(size_t)(ai * HALF + r0 + m * 16) * d.ld + wc] = f2bf(rsqrtf(ss * (1.0f / 64.0f) + EPS));
                }
            return;
        } else {
#pragma unroll
        for (int ai = 0; ai < 2; ++ai)
#pragma unroll
            for (int m = 0; m < 4; ++m) {
                const size_t rowoff = (size_t)(ai * HALF + r0 + m * 16) * d.ld;
#pragma unroll
                for (int bj = 0; bj < 2; ++bj) {
                    const int col = bj * HALF + c0; f32x4 v0 = acc[ai][bj][m][0], v1 = acc[ai][bj][m][1];
                    if ((DescF::MODES & 7) && d.mode <= 2) {
                        if ((DescF::MODES & 2) && d.mode == 1) {
#pragma unroll
                            for (int j = 0; j < 4; ++j) { v0[j] = sigmoidf_(v0[j]); v1[j] = sigmoidf_(v1[j]); } }
                        if ((DescF::MODES & 4) && d.mode == 2) {
#pragma unroll
                            for (int j = 0; j < 4; ++j) { v0[j] = siluf_(v0[j]); v1[j] = siluf_(v1[j]); } }
                        u32x4 w; w.x = cvt_pk_bf16(v0[0], v0[1]); w.y = cvt_pk_bf16(v0[2], v0[3]); w.z = cvt_pk_bf16(v1[0], v1[1]); w.w = cvt_pk_bf16(v1[2], v1[3]);
                        *(u32x4*)((bf16_t*)d.base + rowoff + col) = w;
                    } else if ((DescF::MODES & 8) && d.mode == 3) {
                        if (col < d.ncol) { float* o = (float*)d.base + rowoff + col; *(f32x4*)o = v0 * d.scale; *(f32x4*)(o + 4) = v1 * d.scale; }
                    } else if ((DescF::MODES & 128) && d.mode == 7) {
                        typedef _Float16 h8 __attribute__((ext_vector_type(8)));
                        if (col < d.ncol) {
                        h8 hv; hv[0] = (_Float16)(v0[0] * d.scale); hv[1] = (_Float16)(v0[1] * d.scale); hv[2] = (_Float16)(v0[2] * d.scale); hv[3] = (_Float16)(v0[3] * d.scale);
                        hv[4] = (_Float16)(v1[0] * d.scale); hv[5] = (_Float16)(v1[1] * d.scale); hv[6] = (_Float16)(v1[2] * d.scale); hv[7] = (_Float16)(v1[3] * d.scale);
                        *(h8*)((_Float16*)d.base + rowoff + col) = hv; }
                    } else if constexpr ((DescF::MODES & 32) != 0) {
                        float* o = (float*)d.base + rowoff + col; const float* rs = d.res + rowoff + col;
                        const f32x4 a = *(const f32x4*)rs, b = *(const f32x4*)(rs + 4); *(f32x4*)o = a + v0; *(f32x4*)(o + 4) = b + v1;
                    }
                }
                if (m & 1) asm volatile("" ::: "memory");
            }
        }
    }
};

template <class Epi>
__device__ __forceinline__ void gemm_phase(LAS unsigned char* lds, const Gemm g, const StaticOrder& S, const Epi& E) {
    const int tid = threadIdx.x, wid = __builtin_amdgcn_readfirstlane(tid >> 6), lane = tid & 63, wr = wid >> 2, wc = wid & 3, fr = lane & 15, fq = lane >> 4;
    const int K = g.K, nt = K / BK;
    unsigned voffA[2], voffB[2];
#pragma unroll
    for (int i = 0; i < 2; ++i) { int R, C; stage_rc(tid * 16 + i * 8192, R, C); const int Rb = Epi::PERM ? ((R & ~31) + perm32(R & 31)) : R;
        voffA[i] = (unsigned)(R * g.lda + C) * 2u; voffB[i] = (unsigned)(Rb * g.ldb + C) * 2u; }
    const size_t kstep = (size_t)(BK * 2);
    const size_t hstepA = (size_t)HALF * g.lda * 2, hstepB = (size_t)HALF * g.ldb * 2;
    const size_t tstepA = 2 * hstepA, tstepB = 2 * hstepB;
    const unsigned ldsw = (unsigned)wid * 1024u;
    const int aoff = lds_byte(wr * 64 + fr, fq * 8), boff = lds_byte(wc * 32 + fr, fq * 8);
#define PG8_SA(b, h) (((b) * 2 + (h)) * HTB)
#define PG8_SB(b, h) ((4 + (b) * 2 + (h)) * HTB)
#define PG8_STAGE(bufoff, gbase, voff) do { _Pragma("unroll") for (int _i = 0; _i < 2; ++_i) \
        __builtin_amdgcn_global_load_lds((const unsigned*)((const char*)(gbase) + (voff)[_i]), (LAS unsigned*)(lds + (bufoff) + ldsw + _i * 8192), 16, 0, 0); } while (0)
#define PG8_LDA(dst, b, h) do { _Pragma("unroll") for (int m = 0; m < 4; ++m) _Pragma("unroll") for (int k = 0; k < 2; ++k) dst[m][k] = *(const LAS bf16x8*)(lds + PG8_SA(b, h) + aoff + m * 2048 + k * 1024); } while (0)
#define PG8_LDB(dst, b, h) do { _Pragma("unroll") for (int n = 0; n < 2; ++n) _Pragma("unroll") for (int k = 0; k < 2; ++k) dst[n][k] = *(const LAS bf16x8*)(lds + PG8_SB(b, h) + boff + n * 2048 + k * 1024); } while (0)
#define PG8_MMA(ai, bj, At, Bt) do { __builtin_amdgcn_s_setprio(1); _Pragma("unroll") for (int m = 0; m < 4; ++m) _Pragma("unroll") for (int n = 0; n < 2; ++n) _Pragma("unroll") for (int k = 0; k < 2; ++k) \
        acc[ai][bj][m][n] = __builtin_amdgcn_mfma_f32_16x16x32_bf16(Bt[n][k], At[m][k], acc[ai][bj][m][n], 0, 0, 0); __builtin_amdgcn_s_setprio(0); } while (0)
#define PG8_WAIT_V(n) asm volatile("s_waitcnt vmcnt(" #n ")" ::: "memory")
#define PG8_WAIT_L(n) asm volatile("s_waitcnt lgkmcnt(" #n ")" ::: "memory")
#define PG8_BAR __builtin_amdgcn_s_barrier()
#define PG8_SCHED __builtin_amdgcn_sched_barrier(0)
    Unit cur, nxt; int ui = 0;
    if (!S.next(0, cur)) return;
    f32x4 acc[2][2][4][2];
#pragma unroll
    for (int a = 0; a < 2; ++a)
#pragma unroll
        for (int b = 0; b < 2; ++b)
#pragma unroll
            for (int m = 0; m < 4; ++m)
#pragma unroll
                for (int n = 0; n < 2; ++n) acc[a][b][m][n] = (f32x4){0.f, 0.f, 0.f, 0.f};
    bf16x8 At[4][2], B0[2][2], B1[2][2];
    const char* cA = (const char*)g.A + (size_t)cur.pm * tstepA; const char* cB = (const char*)g.Bt + (size_t)cur.pn * tstepB;
    PG8_STAGE(PG8_SB(0, 0), cB, voffB); PG8_STAGE(PG8_SA(0, 0), cA, voffA); PG8_STAGE(PG8_SB(0, 1), cB + hstepB, voffB); PG8_STAGE(PG8_SA(0, 1), cA + hstepA, voffA);
    if (wr == 1) PG8_BAR;
    PG8_WAIT_V(4); PG8_BAR;
    PG8_STAGE(PG8_SB(1, 0), cB + kstep, voffB); PG8_STAGE(PG8_SA(1, 0), cA + kstep, voffA); PG8_STAGE(PG8_SB(1, 1), cB + hstepB + kstep, voffB);
    PG8_WAIT_V(6); PG8_BAR;
    for (;;) {
        const bool has_next = S.next(ui + 1, nxt);
        const char* nA = has_next ? (const char*)g.A + (size_t)nxt.pm * tstepA : cA; const char* nB = has_next ? (const char*)g.Bt + (size_t)nxt.pn * tstepB : cB;
#pragma unroll 1
        for (int t = 0; t < nt; t += 2) {
            const bool last = (t == nt - 2);
            const char* a1 = cA + (size_t)(t + 1) * kstep;
            const char* a2 = last ? nA : cA + (size_t)(t + 2) * kstep; const char* b2 = last ? nB : cB + (size_t)(t + 2) * kstep;
            const char* a3 = a2 + kstep; const char* b3 = b2 + kstep;
            PG8_LDB(B0, 0, 0); PG8_SCHED; PG8_LDA(At, 0, 0); PG8_STAGE(PG8_SA(1, 1), a1 + hstepA, voffA);
            PG8_WAIT_L(8); PG8_BAR; PG8_WAIT_L(0); PG8_MMA(0, 0, At, B0); PG8_BAR; PG8_SCHED;
            PG8_LDB(B1, 0, 1); PG8_STAGE(PG8_SB(0, 0), b2, voffB);
            PG8_BAR; PG8_WAIT_L(0); PG8_MMA(0, 1, At, B1); PG8_BAR;
            PG8_LDA(At, 0, 1); PG8_STAGE(PG8_SA(0, 0), a2, voffA);
            PG8_BAR; PG8_WAIT_L(0); PG8_MMA(1, 0, At, B0); PG8_BAR; PG8_SCHED;
            PG8_STAGE(PG8_SB(0, 1), b2 + hstepB, voffB);
            PG8_WAIT_V(6); PG8_BAR; PG8_MMA(1, 1, At, B1); PG8_BAR;
            PG8_LDB(B0, 1, 0); PG8_SCHED; PG8_LDA(At, 1, 0); PG8_STAGE(PG8_SA(0, 1), a2 + hstepA, voffA);
            PG8_WAIT_L(8); PG8_BAR; PG8_WAIT_L(0); PG8_MMA(0, 0, At, B0); PG8_BAR; PG8_SCHED;
            PG8_LDB(B1, 1, 1); PG8_STAGE(PG8_SB(1, 0), b3, voffB);
            PG8_BAR; PG8_WAIT_L(0); PG8_MMA(0, 1, At, B1); PG8_BAR;
            PG8_LDA(At, 1, 1); PG8_STAGE(PG8_SA(1, 0), a3, voffA);
            PG8_BAR; PG8_WAIT_L(0); PG8_MMA(1, 0, At, B0); PG8_BAR; PG8_SCHED;
            PG8_STAGE(PG8_SB(1, 1), b3 + hstepB, voffB);
            PG8_WAIT_V(6); PG8_BAR; PG8_MMA(1, 1, At, B1); PG8_BAR;
        }
        E(acc, cur, wr, wc, fr, fq);
        if (!has_next) break;
#pragma unroll
        for (int a = 0; a < 2; ++a)
#pragma unroll
            for (int b = 0; b < 2; ++b)
#pragma unroll
                for (int m = 0; m < 4; ++m)
#pragma unroll
                    for (int n = 0; n < 2; ++n) acc[a][b][m][n] = (f32x4){0.f, 0.f, 0.f, 0.f};
        cur = nxt; cA = nA; cB = nB; ++ui;
    }
    PG8_WAIT_V(0);
    if (wr == 0) PG8_BAR;
    PG8_BAR;
#undef PG8_SA
#undef PG8_SB
#undef PG8_STAGE
#undef PG8_LDA
#undef PG8_LDB
#undef PG8_MMA
#undef PG8_WAIT_V
#undef PG8_WAIT_L
#undef PG8_BAR
#undef PG8_SCHED
}
}

struct D1 { static constexpr int MODES = 1; unsigned char* ws;
    __device__ __forceinline__ void get(const pg8::Unit& u, pg8::Dst& d) const { const int sec = u.pn >> 2;
        d.base = ws + OFF_QB + (size_t)sec * (64 * MB) + ((size_t)u.pm * 256 * 1024 + (u.pn & 3) * 256) * 2; d.res = nullptr; d.ld = 1024; d.mode = 0; d.ncol = 256; d.scale = 1.f; } };
struct D2 { static constexpr int MODES = 7; unsigned char* ws;
    __device__ __forceinline__ void get(const pg8::Unit& u, pg8::Dst& d) const { const int sec = u.pn >> 2, cc = (u.pn & 3) * 256; d.res = nullptr; d.ncol = 256; d.scale = 1.f;
        if (sec < 3) { d.base = ws + OFF_QB + (size_t)sec * (64 * MB) + ((size_t)u.pm * 256 * 1024 + cc) * 2; d.ld = 1024; d.mode = sec == 0 ? 1 : (sec == 1 ? 2 : 0); }
        else { d.base = ws + OFF_Y + ((size_t)u.pm * 256 * 2048 + 1024 + cc) * 2; d.ld = 2048; d.mode = 2; } } };
struct D4 { static constexpr int MODES = 32; unsigned char* out; const float* x;
    __device__ __forceinline__ void get(const pg8::Unit& u, pg8::Dst& d) const { const size_t o = (size_t)u.pm * 256 * 1024 + u.pn * 256;
        d.base = out + o * 4; d.res = x + o; d.ld = 1024; d.mode = 5; d.ncol = 256; d.scale = 1.f; } };
struct D5 { static constexpr int MODES = 133; unsigned char* ws;
    __device__ __forceinline__ void get(const pg8::Unit& u, pg8::Dst& d) const { const int pn = u.pn; d.res = nullptr; d.ncol = 256; d.scale = 1.f;
        if (pn < 4) { d.base = ws + OFF_TMP + ((size_t)u.pm * 256 * 1024 + pn * 256) * 2; d.ld = 1024; d.mode = 0; }
        else if (pn == 4) { d.base = ws + OFF_CKVN + (size_t)u.pm * 256 * 256 * 2; d.ld = 256; d.mode = 0; }
        else if (pn == 5) { d.base = ws + OFF_QI + (size_t)u.pm * 256 * 256 * 2; d.ld = 256; d.mode = 7; d.scale = 0.125f; }
        else if (pn == 6) { d.base = ws + OFF_KI + (size_t)u.pm * 256 * 64 * 2; d.ld = 64; d.mode = 7; d.ncol = 64; }
        else { d.base = ws + OFF_Z + ((size_t)u.pm * 256 * 1024 + (pn - 7) * 256) * 2; d.ld = 1024; d.mode = 2; } } };
struct DK { static constexpr int MODES = 64; unsigned char* ws;
    __device__ __forceinline__ void get(const pg8::Unit& u, pg8::Dst& d) const {
        d.base = ws + OFF_RK + ((size_t)u.pm * 256 * 16 + u.pn * 4) * 2; d.res = nullptr; d.ld = 16; d.mode = 6; d.ncol = 256; d.scale = 1.f; } };
struct D8 { static constexpr int MODES = 32; unsigned char* out;
    __device__ __forceinline__ void get(const pg8::Unit& u, pg8::Dst& d) const { const size_t o = (size_t)u.pm * 256 * 1024 + u.pn * 256;
        d.base = out + o * 4; d.res = (const float*)out + o; d.ld = 1024; d.mode = 5; d.ncol = 256; d.scale = 1.f; } };
template <class DF>
__device__ __forceinline__ void fast_gemm(unsigned char* lds, const bf16_t* A, int lda, const bf16_t* Bt, int ldb, int N, int K, const DF& df) {
    pg8::Gemm g{A, lda, Bt, ldb, T, N, K}; pg8::StaticOrder S; S.init(T, N, (int)gridDim.x, (int)blockIdx.x);
    pg8::EpiGen<DF> E{df};
    pg8::gemm_phase(( LAS unsigned char*)lds, g, S, E);
}

__device__ __forceinline__ void tconv(const float* __restrict__ src, int ld, int col0, int ncols, int K, bf16_t* __restrict__ dst, float* tile  ) {
    const int nkt = K / 64, ntiles = nkt * (ncols / 64), tid = threadIdx.x;
    for (int id = blockIdx.x; id < ntiles; id += gridDim.x) {
        const int kt = id % nkt, nt = id / nkt;
#pragma unroll
        for (int j = 0; j < 8; ++j) { const int e = tid + 512 * j, kk = e >> 6, nn = e & 63; tile[kk * 65 + nn] = src[(size_t)(kt * 64 + kk) * ld + col0 + nt * 64 + nn]; }
        __syncthreads();
#pragma unroll
        for (int j = 0; j < 8; ++j) { const int e = tid + 512 * j, nn = e >> 6, kk = e & 63; dst[(size_t)(nt * 64 + nn) * K + kt * 64 + kk] = f2bf(tile[kk * 65 + nn]); }
        __syncthreads();
    }
}
template <int NE>
__device__ __forceinline__ void rmsnorm_rows(const float* __restrict__ src, const float* __restrict__ g, bf16_t* __restrict__ dst,
                             const float* __restrict__ Wx, int ldw, int col0, const float* __restrict__ bias, float scale, float* __restrict__ dstx, float* wl) {
    const int lane = threadIdx.x & 63, wave = threadIdx.x >> 6;
    __syncthreads();
    for (int i = threadIdx.x; i < NE * 1024; i += 512) { const int k = i / NE, e = i % NE; wl[e * 1024 + k] = Wx[(size_t)k * ldw + col0 + e]; }
    __syncthreads();
    for (int row = blockIdx.x * 8 + wave; row < T; row += gridDim.x * 8) {
        f32x4 v[4]; float ss = 0.f;
#pragma unroll
        for (int i = 0; i < 4; ++i) { v[i] = *(const f32x4*)(src + (size_t)row * 1024 + i * 256 + lane * 4); ss += v[i][0] * v[i][0] + v[i][1] * v[i][1] + v[i][2] * v[i][2] + v[i][3] * v[i][3]; }
        ss = wave_sum(ss);
        const float rstd = rsqrtf(ss * (1.0f / 1024.0f) + EPS);
        float ex[NE];
#pragma unroll
        for (int e = 0; e < NE; ++e) ex[e] = 0.f;
#pragma unroll
        for (int i = 0; i < 4; ++i) {
            const f32x4 gg = *(const f32x4*)(g + i * 256 + lane * 4);
            f32x4 y; y[0] = v[i][0] * rstd * gg[0]; y[1] = v[i][1] * rstd * gg[1]; y[2] = v[i][2] * rstd * gg[2]; y[3] = v[i][3] * rstd * gg[3];
            u32x2 w; w.x = pk2(y[0], y[1]); w.y = pk2(y[2], y[3]);
            *(u32x2*)(dst + (size_t)row * 1024 + i * 256 + lane * 4) = w;
#pragma unroll
            for (int e = 0; e < NE; ++e) { const f32x4 wv = *(const f32x4*)(wl + e * 1024 + i * 256 + lane * 4); ex[e] += y[0] * wv[0] + y[1] * wv[1] + y[2] * wv[2] + y[3] * wv[3]; }
        }
#pragma unroll
        for (int e = 0; e < NE; ++e) { const float s = wave_sum(ex[e]); if (lane == 0) dstx[(size_t)row * NE + e] = (s + (bias ? bias[e] : 0.f)) * scale; }
    }
}

__device__ __forceinline__ void phase_prep(const P& p, unsigned char* lds) {
    float* tile = (float*)lds; unsigned char* ws = p.ws;
    bf16_t* W0T = (bf16_t*)(ws + OFF_W0T);
    tconv(p.e_w_in, EIN, 0, 5120, 1024, W0T, tile);
    tconv(p.e_w_in, EIN, 6152, 1024, 1024, W0T + (size_t)6144 * 1024, tile);
    for (int g = 0; g < 4; ++g) tconv(p.e_w_pool + (size_t)g * 65536, 256, 0, 256, 256, (bf16_t*)(ws + OFF_WPT) + (size_t)g * 65536, tile);
    { bf16_t* WUB = (bf16_t*)(ws + OFF_WUB);
      for (size_t i = (size_t)blockIdx.x * 512 + threadIdx.x; i < (size_t)1024 * 256; i += (size_t)gridDim.x * 512) {
          const size_t k = i >> 8; const int c4 = (int)(i & 255) * 4; const f32x4 v = *(const f32x4*)(p.e_w_in + k * EIN + 5128 + c4);
          u32x2 o; o.x = pk2(v[0], v[1]); o.y = pk2(v[2], v[3]); *(u32x2*)(WUB + k * 1024 + c4) = o; } }
    tconv(p.e_w_out, 1024, 0, 1024, 2048, (bf16_t*)(ws + OFF_WO0T), tile);
    bf16_t* W1T = (bf16_t*)(ws + OFF_W1T);
    tconv(p.o_w_in, OIN, 0, 1600, 1024, W1T, tile);
    for (size_t i = (size_t)blockIdx.x * 512 + threadIdx.x; i < (size_t)192 * 1024; i += (size_t)gridDim.x * 512) W1T[(size_t)1600 * 1024 + i] = 0;
    tconv(p.o_w_in, OIN, 1604, 1024, 1024, W1T + (size_t)1792 * 1024, tile);
    {
        bf16_t* WUKP = (bf16_t*)(ws + OFF_WUKP); bf16_t* WQP = (bf16_t*)(ws + OFF_WQP);
        for (size_t i = (size_t)blockIdx.x * 512 + threadIdx.x; i < (size_t)1024 * 256; i += (size_t)gridDim.x * 512) {
            { const int n = (int)(i >> 8), k = (int)(i & 255), pn = n >> 8, rem = n & 255, bj = rem >> 7, wc = (rem >> 5) & 3, x = rem & 31;
              WUKP[i] = f2bf(p.o_w_uk[(size_t)k * 1024 + (4 * pn + wc) * 64 + 32 * bj + x]); }
            { const int d = (int)(i & 63), r = (int)((i >> 6) & 255), h = (int)(i >> 14);
              WQP[i] = f2bf(p.o_w_uk[(size_t)r * 1024 + h * 64 + d] * p.o_g_k[d] * 0.125f); }
        }
    }
    tconv(p.o_w_uv, 1024, 0, 1024, 256, (bf16_t*)(ws + OFF_WUVT), tile);
    tconv(p.o_w_out, 1024, 0, 1024, 1024, (bf16_t*)(ws + OFF_WO1T), tile);
    rmsnorm_rows<8>(p.x, p.e_norm, (bf16_t*)(ws + OFF_XN), p.e_w_in, EIN, 5120, p.e_b_if, 1.0f, (float*)(ws + OFF_GATES), (float*)lds);
}

__device__ __forceinline__ void phase_conv_scan(const P& p, unsigned char* lds) {
    unsigned char* ws = p.ws; const int tid = threadIdx.x;
    const float* GATES = (const float*)(ws + OFF_GATES);
    float *BQ = (float*)(ws + OFF_BQ), *IQ = (float*)(ws + OFF_IQ), *MT = (float*)(ws + OFF_MT), *CH = (float*)(ws + OFF_CH);
    {
        const int lane = tid & 63, wave = tid >> 6;
        for (int task = blockIdx.x * 8 + wave; task < 2048; task += gridDim.x * 8) {
            const int bh = task >> 8, c = task & 255, batch = bh >> 2, head = bh & 3; const size_t t = (size_t)batch * SEQ + c * 64 + lane;
            const float ig = GATES[t * 8 + head], f = GATES[t * 8 + 4 + head];
            float b = fminf(f, 0.f) - log1pf(__expf(-fabsf(f)));
#pragma unroll
            for (int o = 1; o < 64; o <<= 1) { const float y = __shfl_up(b, o); if (lane >= o) b += y; }
            float rm = ig - b;
#pragma unroll
            for (int o = 1; o < 64; o <<= 1) { const float y = __shfl_up(rm, o); if (lane >= o) rm = fmaxf(rm, y); }
            BQ[t * 4 + head] = b; IQ[t * 4 + head] = ig; MT[t * 4 + head] = rm;
            if (lane == 63) { CH[4096 + bh * 256 + c] = b; CH[bh * 256 + c] = b + rm; }
        }
    }
    const bf16_t* QB = (const bf16_t*)(ws + OFF_QB); const bf16_t* KB = (const bf16_t*)(ws + OFF_KB);
    bf16_t* Y = (bf16_t*)(ws + OFF_Y); bf16_t* KT = (bf16_t*)(ws + OFF_TMP);
    for (size_t it = (size_t)blockIdx.x * 512 + tid; it < (size_t)T * 256; it += (size_t)gridDim.x * 512) {
        const size_t t = it >> 8; const int c0 = (int)(it & 255) * 8, isk = c0 >= 1024, cc = c0 & 1023; const int s = (int)(t & (SEQ - 1));
        const bf16_t* src = isk ? KB : QB;
        float acc[8];
#pragma unroll
        for (int i = 0; i < 8; ++i) acc[i] = 0.f;
#pragma unroll
        for (int j = 0; j < 4; ++j) {
            if (s - 3 + j >= 0) {
                const u32x4 w = *(const u32x4*)(src + (t - 3 + j) * 1024 + cc);
                const f32x4 c0v = *(const f32x4*)(p.e_conv + j * 2048 + c0), c1v = *(const f32x4*)(p.e_conv + j * 2048 + c0 + 4);
                acc[0] += c0v[0] * bflo(w.x); acc[1] += c0v[1] * bfhi(w.x); acc[2] += c0v[2] * bflo(w.y); acc[3] += c0v[3] * bfhi(w.y);
                acc[4] += c1v[0] * bflo(w.z); acc[5] += c1v[1] * bfhi(w.z); acc[6] += c1v[2] * bflo(w.w); acc[7] += c1v[3] * bfhi(w.w);
            }
        }
        const float sc = isk ? 0.0625f : 1.0f;
        u32x4 o; o.x = pk2(siluf_(acc[0]) * sc, siluf_(acc[1]) * sc); o.y = pk2(siluf_(acc[2]) * sc, siluf_(acc[3]) * sc);
        o.z = pk2(siluf_(acc[4]) * sc, siluf_(acc[5]) * sc); o.w = pk2(siluf_(acc[6]) * sc, siluf_(acc[7]) * sc);
        if (isk) *(u32x4*)(KT + t * 1024 + cc) = o; else *(u32x4*)(Y + t * 2048 + 1024 + cc) = o;
    }
}

typedef float f32x16 __attribute__((ext_vector_type(16)));
constexpr int ML_RS = 528, ML_WS = 144;
__device__ __forceinline__ bf16x8 ml_tr8(const LAS unsigned char* a, int second_off) {
    const v4i16_t t0 = __builtin_amdgcn_ds_read_tr16_b64_v4i16((LAS v4i16_t*)a);
    const v4i16_t t1 = __builtin_amdgcn_ds_read_tr16_b64_v4i16((LAS v4i16_t*)(a + second_off));
    bf16x8 r; r[0] = t0[0]; r[1] = t0[1]; r[2] = t0[2]; r[3] = t0[3]; r[4] = t1[0]; r[5] = t1[1]; r[6] = t1[2]; r[7] = t1[3]; return r;
}
__device__ __forceinline__ void mlstm_chunk_scan(const float* CH, int bh, LAS float* sB, LAS float* sMp, LAS float* sMn) {
    const int tid = threadIdx.x;
    if (tid < 256) { sB[tid] = CH[4096 + bh * 256 + tid]; sMn[tid] = CH[bh * 256 + tid]; }
    __syncthreads();
    if (tid == 0) { float m = 0.f; for (int c = 0; c < 256; ++c) { const float g = sMn[c]; sMp[c] = m; m = fmaxf(sB[c] + m, g); sMn[c] = m; } }
    __syncthreads();
}
template <bool FULL>
__device__ __forceinline__ void mlstm_units(const P& p, unsigned char* lds_) {
    unsigned char* ws = p.ws; const int tid0 = threadIdx.x;
    const int w = __builtin_amdgcn_readfirstlane(tid0 >> 6);
    const bf16_t* Yq = (const bf16_t*)(ws + OFF_Y); bf16_t* Yo = (bf16_t*)(ws + OFF_Y);
    const bf16_t* KT = (const bf16_t*)(ws + OFF_TMP); const bf16_t* VB = (const bf16_t*)(ws + OFF_VB);
    float* ST = (float*)(ws + OFF_QB); float* NS = (float*)(ws + OFF_NS);
    const float *BQ = (const float*)(ws + OFF_BQ), *IQ = (const float*)(ws + OFF_IQ), *MT = (const float*)(ws + OFF_MT), *CH = (const float*)(ws + OFF_CH);
    LAS unsigned char* Qs = (LAS unsigned char*)lds_;
    LAS unsigned char* Ks = Qs + 64 * ML_RS;
    LAS unsigned char* Vs = Ks + 64 * ML_RS;
    LAS unsigned char* Wl = Vs + 64 * ML_RS;
    LAS float* sa = (LAS float*)(Wl + 64 * ML_WS);
    LAS float* sden = sa + 64; LAS float* ssw = sden + 64; LAS float* sf = ssw + 64; LAS float* sg = sf + 64; LAS float* nd = sg + 64; LAS float* rden = nd + 64; LAS float* ns = rden + 64;
    LAS float* cB = ns + 256; LAS float* cMp = cB + 256; LAS float* cMn = cMp + 256;
    for (int unit = blockIdx.x; unit < 256; unit += gridDim.x) {
        const int bh = unit >> 5, S = unit & 31, batch = bh >> 2, head = bh & 3;
        const int tid = tid0, lane = tid0 & 63, hh = lane >> 5;
        __syncthreads();
        mlstm_chunk_scan(CH, bh, cB, cMp, cMn);
        f32x16 st[8]; float nreg = 0.f;
        if (FULL) {
#pragma unroll
            for (int kt = 0; kt < 8; ++kt) {
                int lz = lane; asm volatile("" : "+v"(lz) :: "memory");
                const float* sp = ST + (size_t)unit * 65536 + 32 * w + (lz & 31) + (size_t)(32 * kt + 4 * (lz >> 5)) * 256;
#pragma unroll
                for (int r = 0; r < 16; ++r) st[kt][r] = sp[((r & 3) + 8 * (r >> 2)) * 256];
            }
            if (tid < 256) nreg = NS[unit * 256 + tid];
        } else {
#pragma unroll
            for (int kt = 0; kt < 8; ++kt)
#pragma unroll
                for (int r = 0; r < 16; ++r) st[kt][r] = 0.f;
        }
#pragma unroll 1
        for (int cc = 0; cc < 8; ++cc) {
            int tid = tid0; asm volatile("" : "+v"(tid));
            const int lane = tid & 63, l31 = lane & 31, hh = lane >> 5, fr = lane & 15, fq = lane >> 4;
            const int trow = 8 * hh + (fr >> 2), tcol = (16 * (fq & 1) + 4 * (fr & 3)) * 2;
            const int ch = S * 8 + cc; const size_t t0 = (size_t)batch * SEQ + ch * 64;
            const float mprev = cMp[ch], mnew = cMn[ch], blast = cB[ch];
            const float decay = __expf(blast + mprev - mnew);
            __syncthreads();
#pragma unroll
            for (int j = 0; j < 4; ++j) { const int e = tid + 512 * j, r = e >> 5, cg = e & 31;
                *(LAS u32x4*)(Ks + r * ML_RS + cg * 16) = *(const u32x4*)(KT + (t0 + r) * 1024 + head * 256 + cg * 8);
                *(LAS u32x4*)(Vs + r * ML_RS + cg * 16) = *(const u32x4*)(VB + (t0 + r) * 1024 + head * 256 + cg * 8);
                if (FULL) *(LAS u32x4*)(Qs + r * ML_RS + cg * 16) = *(const u32x4*)(Yq + (t0 + r) * 2048 + 1024 + head * 256 + cg * 8); }
            if (tid < 64) { const float bq = BQ[(t0 + tid) * 4 + head], iq = IQ[(t0 + tid) * 4 + head], mt = bq + fmaxf(mprev, MT[(t0 + tid) * 4 + head]);
                sa[tid] = __expf(bq + mprev - mt); sden[tid] = __expf(-mt); ssw[tid] = __expf(blast - bq + iq - mnew); sf[tid] = bq - mt; sg[tid] = iq - bq; }
            if (FULL && tid < 256) ns[tid] = nreg;
            __syncthreads();
            bf16x8 bv[4];
            if (!FULL) {
#pragma unroll
                for (int ks = 0; ks < 4; ++ks) bv[ks] = ml_tr8(Vs + (16 * ks + trow) * ML_RS + 64 * w + tcol, 4 * ML_RS);
            }
            if (FULL) {
                { const int tt = w >> 1;
#pragma unroll
                  for (int si = 0; si < 2; ++si) { const int ss = 2 * (w & 1) + si;
                    f32x4 acc = (f32x4){0.f, 0.f, 0.f, 0.f};
                    if (ss <= tt) {
#pragma unroll
                        for (int ks = 0; ks < 8; ++ks) { const bf16x8 a = *(const LAS bf16x8*)(Qs + (16 * tt + fr) * ML_RS + (32 * ks + 8 * fq) * 2), b = *(const LAS bf16x8*)(Ks + (16 * ss + fr) * ML_RS + (32 * ks + 8 * fq) * 2);
                            acc = __builtin_amdgcn_mfma_f32_16x16x32_bf16(a, b, acc, 0, 0, 0); } }
                    const int sidx = 16 * ss + fr; const float gs = sg[sidx];
#pragma unroll
                    for (int j = 0; j < 4; ++j) { const int tix = 16 * tt + 4 * fq + j; const float wv = (sidx <= tix) ? __expf(sf[tix] + gs) * acc[j] : 0.f;
                        *(LAS bf16_t*)(Wl + tix * ML_WS + sidx * 2) = f2bf(wv); } } }
#pragma unroll
                for (int i = 0; i < 8; ++i) { const int tix = 8 * w + i; const u32x2 qv = *(const LAS u32x2*)(Qs + tix * ML_RS + lane * 8); const f32x4 nv = *(const LAS f32x4*)(ns + lane * 4);
                    float part = bflo(qv.x) * nv[0] + bfhi(qv.x) * nv[1] + bflo(qv.y) * nv[2] + bfhi(qv.y) * nv[3]; part = wave_sum(part); if (lane == 0) nd[tix] = part; }
                __syncthreads();
                f32x16 acc[2];
#pragma unroll
                for (int t2 = 0; t2 < 2; ++t2) {
#pragma unroll
                    for (int r = 0; r < 16; ++r) acc[t2][r] = 0.f;
                }
#pragma unroll
                for (int kt = 0; kt < 8; ++kt) {
                    asm volatile("" ::: "memory");
#pragma unroll
                    for (int s2 = 0; s2 < 2; ++s2) {
                        u32x4 bw; bw.x = pg8::cvt_pk_bf16(st[kt][8 * s2 + 0], st[kt][8 * s2 + 1]); bw.y = pg8::cvt_pk_bf16(st[kt][8 * s2 + 2], st[kt][8 * s2 + 3]);
                        bw.z = pg8::cvt_pk_bf16(st[kt][8 * s2 + 4], st[kt][8 * s2 + 5]); bw.w = pg8::cvt_pk_bf16(st[kt][8 * s2 + 6], st[kt][8 * s2 + 7]);
                        const bf16x8 bfrag = __builtin_bit_cast(bf16x8, bw);
#pragma unroll
                        for (int t2 = 0; t2 < 2; ++t2) { const LAS unsigned char* qa = Qs + (32 * t2 + l31) * ML_RS + (32 * kt + 16 * s2 + 4 * hh) * 2;
                            const u32x2 lo = *(const LAS u32x2*)qa, hi = *(const LAS u32x2*)(qa + 16); u32x4 aw; aw.x = lo.x; aw.y = lo.y; aw.z = hi.x; aw.w = hi.y;
                            acc[t2] = __builtin_amdgcn_mfma_f32_32x32x16_bf16(__builtin_bit_cast(bf16x8, aw), bfrag, acc[t2], 0, 0, 0); }
                    }
                }
                asm volatile("" ::: "memory");
#pragma unroll
                for (int t2 = 0; t2 < 2; ++t2)
#pragma unroll
                    for (int r = 0; r < 16; ++r) acc[t2][r] *= sa[32 * t2 + (r & 3) + 8 * (r >> 2) + 4 * hh];
#pragma unroll
                for (int ks = 0; ks < 4; ++ks) bv[ks] = ml_tr8(Vs + (16 * ks + trow) * ML_RS + 64 * w + tcol, 4 * ML_RS);
#pragma unroll
                for (int ks = 0; ks < 4; ++ks)
#pragma unroll
                    for (int t2 = 0; t2 < 2; ++t2) { const bf16x8 a = *(const LAS bf16x8*)(Wl + (32 * t2 + l31) * ML_WS + (16 * ks + 8 * hh) * 2);
                        acc[t2] = __builtin_amdgcn_mfma_f32_32x32x16_bf16(a, bv[ks], acc[t2], 0, 0, 0); }
#pragma unroll
                for (int i = 0; i < 8; ++i) { const int tix = 8 * w + i; float rs = bf2f(*(const LAS bf16_t*)(Wl + tix * ML_WS + lane * 2)); rs = wave_sum(rs);
                    if (lane == 0) { const float nq = sa[tix] * nd[tix] + rs; rden[tix] = 1.0f / fmaxf(fabsf(nq), sden[tix]); } }
                __syncthreads();
                bf16_t* yo = Yo + t0 * 2048 + head * 256 + 32 * w + l31;
#pragma unroll
                for (int t2 = 0; t2 < 2; ++t2)
#pragma unroll
                    for (int r = 0; r < 16; ++r) { const int tix = 32 * t2 + (r & 3) + 8 * (r >> 2) + 4 * hh; yo[(size_t)tix * 2048] = f2bf(acc[t2][r] * rden[tix]); }
            }
#pragma unroll
            for (int kt = 0; kt < 8; ++kt) st[kt] *= decay;
#pragma unroll
            for (int ks = 0; ks < 4; ++ks) {
                const u32x4 raw = __builtin_bit_cast(u32x4, bv[ks]); const LAS float* sw8 = ssw + 16 * ks + 8 * hh;
                u32x4 sc; sc.x = pg8::cvt_pk_bf16(bflo(raw.x) * sw8[0], bfhi(raw.x) * sw8[1]); sc.y = pg8::cvt_pk_bf16(bflo(raw.y) * sw8[2], bfhi(raw.y) * sw8[3]);
                sc.z = pg8::cvt_pk_bf16(bflo(raw.z) * sw8[4], bfhi(raw.z) * sw8[5]); sc.w = pg8::cvt_pk_bf16(bflo(raw.w) * sw8[6], bfhi(raw.w) * sw8[7]);
                const bf16x8 bs = __builtin_bit_cast(bf16x8, sc);
#pragma unroll
                for (int kt = 0; kt < 8; ++kt) { if ((kt & 3) == 0) asm volatile("" ::: "memory");
                    const bf16x8 a = ml_tr8(Ks + (16 * ks + trow) * ML_RS + 64 * kt + tcol, 4 * ML_RS);
                    st[kt] = __builtin_amdgcn_mfma_f32_32x32x16_bf16(a, bs, st[kt], 0, 0, 0); }
            }
            if (tid < 256) { float nacc = 0.f;
#pragma unroll 8
                for (int s2 = 0; s2 < 64; ++s2) nacc += ssw[s2] * bf2f(*(const LAS bf16_t*)(Ks + s2 * ML_RS + tid * 2));
                nreg = decay * nreg + nacc; }
        }
        if (!FULL) {
#pragma unroll
            for (int kt = 0; kt < 8; ++kt) {
                int lz = lane; asm volatile("" : "+v"(lz) :: "memory");
                float* sp = ST + (size_t)unit * 65536 + 32 * w + (lz & 31) + (size_t)(32 * kt + 4 * (lz >> 5)) * 256;
#pragma unroll
                for (int r = 0; r < 16; ++r) sp[((r & 3) + 8 * (r >> 2)) * 256] = st[kt][r];
            }
            if (tid < 256) NS[unit * 256 + tid] = nreg;
        }
    }
}
__device__ __forceinline__ void phase_mlstm_scan(const P& p, unsigned char* lds_) {
    unsigned char* ws = p.ws; const int tid = threadIdx.x;
    float* ST = (float*)(ws + OFF_QB); float* NS = (float*)(ws + OFF_NS); const float* CH = (const float*)(ws + OFF_CH);
    LAS float* DS = (LAS float*)lds_;
    LAS float* cB = DS + 256; LAS float* cMp = cB + 256; LAS float* cMn = cMp + 256;
    for (int bh = 0; bh < 8; ++bh) {
        __syncthreads();
        mlstm_chunk_scan(CH, bh, cB, cMp, cMn);
        if (tid < 32) { float d = 1.f; for (int c = 0; c < 8; ++c) { const int ch = tid * 8 + c; d *= __expf(cB[ch] + cMp[ch] - cMn[ch]); } DS[bh * 32 + tid] = d; }
    }
    __syncthreads();
    const int per = 65536 + 256;
    for (int it = blockIdx.x * 512 + tid; it < 8 * per; it += gridDim.x * 512) {
        const int bh = it / per, e = it - bh * per;
        float* base; size_t stride;
        if (e < 65536) { base = ST + (size_t)bh * 32 * 65536 + e; stride = 65536; } else { base = NS + (size_t)bh * 32 * 256 + (e - 65536); stride = 256; }
        float carry = 0.f;
#pragma unroll 8
        for (int S = 0; S < 32; ++S) { const float tmp = base[S * stride]; base[S * stride] = carry; carry = DS[bh * 32 + S] * carry + tmp; }
    }
}

__device__ __forceinline__ void phase_ya_pool(const P& p) {
    unsigned char* ws = p.ws; const int tid = threadIdx.x, lane = tid & 63, wave = tid >> 6;
    bf16_t* Y = (bf16_t*)(ws + OFF_Y); const bf16_t* O = (const bf16_t*)(ws + OFF_QB); const bf16_t* ZA = (const bf16_t*)(ws + OFF_KB);
    for (int it = blockIdx.x * 8 + wave; it < T * 4; it += gridDim.x * 8) {
        const size_t t = (size_t)(it >> 2); const int head = it & 3, c = head * 256 + lane * 4;
        const u32x2 hw = *(const u32x2*)(Y + t * 2048 + c), ow = *(const u32x2*)(O + t * 1024 + c), zw = *(const u32x2*)(ZA + t * 1024 + c);
        float v[4] = {bflo(hw.x) * bflo(ow.x), bfhi(hw.x) * bfhi(ow.x), bflo(hw.y) * bflo(ow.y), bfhi(hw.y) * bfhi(ow.y)};
        float ss = wave_sum(v[0] * v[0] + v[1] * v[1] + v[2] * v[2] + v[3] * v[3]);
        const float rstd = rsqrtf(ss * (1.0f / 256.0f) + EPS);
        const f32x4 g = *(const f32x4*)(p.e_g_head + c);
        u32x2 o; o.x = pk2(v[0] * rstd * g[0] * bflo(zw.x), v[1] * rstd * g[1] * bfhi(zw.x)); o.y = pk2(v[2] * rstd * g[2] * bflo(zw.y), v[3] * rstd * g[3] * bfhi(zw.y));
        *(u32x2*)(Y + t * 2048 + c) = o;
    }
    const bf16_t* U = (const bf16_t*)(ws + OFF_VB);
    for (size_t it = (size_t)blockIdx.x * 512 + tid; it < (size_t)T * 128; it += (size_t)gridDim.x * 512) {
        const size_t t = it >> 7; const int c0 = (int)(it & 127) * 8, g = c0 >> 8, win = 2 << g, s = (int)(t & (SEQ - 1)); const int cnt = (s + 1 < win) ? s + 1 : win;
        float acc[8], self[8];
#pragma unroll
        for (int i = 0; i < 8; ++i) { acc[i] = 0.f; self[i] = 0.f; }
        for (int j = 0; j < cnt; ++j) { const u32x4 w = *(const u32x4*)(U + (t - j) * 1024 + c0);
            const float f[8] = {bflo(w.x), bfhi(w.x), bflo(w.y), bfhi(w.y), bflo(w.z), bfhi(w.z), bflo(w.w), bfhi(w.w)};
#pragma unroll
            for (int i = 0; i < 8; ++i) { acc[i] += f[i]; if (j == 0) self[i] = f[i]; } }
        const float inv = 1.0f / (float)cnt;
        bf16_t* yp = Y + t * 2048 + 1024 + c0; const u32x4 z = *(const u32x4*)yp;
        const float zf[8] = {bflo(z.x), bfhi(z.x), bflo(z.y), bfhi(z.y), bflo(z.z), bfhi(z.z), bflo(z.w), bfhi(z.w)};
        const f32x4 s0 = *(const f32x4*)(p.e_s_pool + c0), s1 = *(const f32x4*)(p.e_s_pool + c0 + 4);
        float o[8];
#pragma unroll
        for (int i = 0; i < 8; ++i) o[i] = (acc[i] * inv - self[i]) * (i < 4 ? s0[i] : s1[i - 4]) * zf[i];
        u32x4 ow; ow.x = pk2(o[0], o[1]); ow.y = pk2(o[2], o[3]); ow.z = pk2(o[4], o[5]); ow.w = pk2(o[6], o[7]);
        *(u32x4*)yp = ow;
    }
}

__device__ __forceinline__ void headnorm64(bf16_t* X, const float* g) {
    const int lane = threadIdx.x & 63, wave = threadIdx.x >> 6;
    for (int t = blockIdx.x * 8 + wave; t < T; t += gridDim.x * 8) {
        bf16_t* r = X + (size_t)t * 1024 + lane * 16;
        const u32x4 a = *(const u32x4*)r, b = *(const u32x4*)(r + 8);
        float f[16] = {bflo(a.x), bfhi(a.x), bflo(a.y), bfhi(a.y), bflo(a.z), bfhi(a.z), bflo(a.w), bfhi(a.w), bflo(b.x), bfhi(b.x), bflo(b.y), bfhi(b.y), bflo(b.z), bfhi(b.z), bflo(b.w), bfhi(b.w)};
        float ss = 0.f;
#pragma unroll
        for (int i = 0; i < 16; ++i) ss += f[i] * f[i];
        ss += __shfl_xor(ss, 1); ss += __shfl_xor(ss, 2);
        const float rstd = rsqrtf(ss * (1.0f / 64.0f) + EPS);
        const float* gg = g + (lane & 3) * 16;
#pragma unroll
        for (int i = 0; i < 16; ++i) f[i] = f[i] * rstd * gg[i];
        u32x4 oa, ob; oa.x = pk2(f[0], f[1]); oa.y = pk2(f[2], f[3]); oa.z = pk2(f[4], f[5]); oa.w = pk2(f[6], f[7]);
        ob.x = pk2(f[8], f[9]); ob.y = pk2(f[10], f[11]); ob.z = pk2(f[12], f[13]); ob.w = pk2(f[14], f[15]);
        *(u32x4*)r = oa; *(u32x4*)(r + 8) = ob;
    }
}
__device__ __forceinline__ void phase_qnorm_ckvnorm(const P& p) {
    unsigned char* ws = p.ws; const int lane = threadIdx.x & 63, wave = threadIdx.x >> 6;
    headnorm64((bf16_t*)(ws + OFF_TMP), p.o_g_q);
    bf16_t* CKVN = (bf16_t*)(ws + OFF_CKVN);
    for (int t = blockIdx.x * 8 + wave; t < T; t += gridDim.x * 8) {
        const u32x2 w = *(const u32x2*)(CKVN + (size_t)t * 256 + lane * 4);
        const float v[4] = {bflo(w.x), bfhi(w.x), bflo(w.y), bfhi(w.y)};
        const float ss = wave_sum(v[0] * v[0] + v[1] * v[1] + v[2] * v[2] + v[3] * v[3]);
        const float rstd = rsqrtf(ss * (1.0f / 256.0f) + EPS);
        const f32x4 g = *(const f32x4*)(p.o_g_kv + lane * 4);
        u32x2 o; o.x = pk2(v[0] * rstd * g[0], v[1] * rstd * g[1]); o.y = pk2(v[2] * rstd * g[2], v[3] * rstd * g[3]);
        *(u32x2*)(CKVN + (size_t)t * 256 + lane * 4) = o;
    }
}

__device__ __forceinline__ unsigned okey(float s) { if (s == 0.f) s = 0.f; const unsigned u = __float_as_uint(s); return (u & 0x80000000u) ? ~u : (u | 0x80000000u); }

__device__ __forceinline__ void indexer_slow_query(const P& p, unsigned char* lds, size_t t) {
    unsigned char* ws = p.ws; const int tid = threadIdx.x, lane = tid & 63, wave = tid >> 6;
    const _Float16* QI = (const _Float16*)(ws + OFF_QI); const _Float16* KI = (const _Float16*)(ws + OFF_KI); const float* WI = (const float*)(ws + OFF_WI);
    unsigned short* IDX = (unsigned short*)(ws + OFF_IDX);
    unsigned* sc = (unsigned*)lds; unsigned* hist = sc + 16384; float* qs = (float*)(hist + 256); unsigned* misc = (unsigned*)(qs + 256); unsigned* wsum = misc + 16;
    const int batch = (int)(t >> 14), pos = (int)(t & (SEQ - 1)), n = pos + 1;
    __syncthreads();
    if (tid < 256) qs[tid] = (float)QI[t * 256 + tid];
    const float w0 = WI[t * 4 + 0], w1 = WI[t * 4 + 1], w2 = WI[t * 4 + 2], w3 = WI[t * 4 + 3];
    __syncthreads();
    const _Float16* kbase = KI + (size_t)batch * SEQ * 64;
    for (int s = tid; s < n; s += 512) {
        asm volatile("" ::: "memory");
        typedef _Float16 h8 __attribute__((ext_vector_type(8)));
        const h8* kr = (const h8*)(kbase + (size_t)s * 64);
        float d0 = 0.f, d1 = 0.f, d2 = 0.f, d3 = 0.f;
#pragma unroll
        for (int j = 0; j < 8; ++j) { const h8 kv = kr[j];
#pragma unroll
            for (int e = 0; e < 8; ++e) { const int d = j * 8 + e; const float kf = (float)kv[e]; d0 += qs[d] * kf; d1 += qs[64 + d] * kf; d2 += qs[128 + d] * kf; d3 += qs[192 + d] * kf; } }
        float score = w0 * fmaxf(d0, 0.f); score = fmaf(w1, fmaxf(d1, 0.f), score); score = fmaf(w2, fmaxf(d2, 0.f), score); score = fmaf(w3, fmaxf(d3, 0.f), score);
        sc[s] = okey(score);
    }
    unsigned prefix = 0, krem = 256;
    for (int pass = 0; pass < 4; ++pass) {
        const int shift = 24 - 8 * pass;
        __syncthreads();
        if (tid < 256) hist[tid] = 0;
        __syncthreads();
        for (int s = tid; s < n; s += 512) { const unsigned k = sc[s]; if (pass == 0 || (k >> (shift + 8)) == prefix) atomicAdd(&hist[(k >> shift) & 255u], 1u); }
        __syncthreads();
        if (tid == 0) { unsigned cum = 0; int bin = 255; for (; bin > 0; --bin) { const unsigned c = hist[bin]; if (cum + c >= krem) break; cum += c; } misc[0] = (unsigned)bin; misc[1] = krem - cum; }
        __syncthreads();
        prefix = (prefix << 8) | misc[0]; krem = misc[1];
    }
    const unsigned ngt_total = 256u - krem;
    unsigned lg = 0, le = 0; const int s0 = tid * 32;
    for (int s = s0; s < s0 + 32 && s < n; ++s) { const unsigned k = sc[s]; lg += (k > prefix); le += (k == prefix); }
    unsigned pk = lg | (le << 16), incl = pk;
#pragma unroll
    for (int o = 1; o < 64; o <<= 1) { const unsigned y = __shfl_up(incl, o); if (lane >= o) incl += y; }
    if (lane == 63) wsum[wave] = incl;
    __syncthreads();
    unsigned base = 0;
    for (int w = 0; w < wave; ++w) base += wsum[w];
    const unsigned excl = base + incl - pk; unsigned bg = excl & 0xffffu, be = excl >> 16;
    for (int s = s0; s < s0 + 32 && s < n; ++s) { const unsigned k = sc[s];
        if (k > prefix) { IDX[t * 256 + bg] = (unsigned short)s; ++bg; }
        else if (k == prefix) { if (be < krem) IDX[t * 256 + ngt_total + be] = (unsigned short)s; ++be; } }
    __syncthreads();
}

typedef _Float16 half8 __attribute__((ext_vector_type(8)));
constexpr int IX_CAP = 1024, IX_ZBIN = 1024;
__device__ __forceinline__ unsigned ix_key(const f32x4 a, const f32x4 w) {
    const float r0 = __int_as_float(max(__float_as_int(a[0]), 0)), r1 = __int_as_float(max(__float_as_int(a[1]), 0));
    const float r2 = __int_as_float(max(__float_as_int(a[2]), 0)), r3 = __int_as_float(max(__float_as_int(a[3]), 0));
    float s = w[0] * r0; s = fmaf(w[1], r1, s); s = fmaf(w[2], r2, s); s = fmaf(w[3], r3, s);
    unsigned u = __float_as_uint(s); u = (u == 0x80000000u) ? 0u : u;
    return u ^ ((unsigned)((int)u >> 31) | 0x80000000u);
}
#define LDS_ADD(ptr, v) __hip_atomic_fetch_add((ptr), (v), __ATOMIC_RELAXED, __HIP_MEMORY_SCOPE_WORKGROUP)
__device__ __forceinline__ void phase_indexer(const P& p, unsigned char* lds) {
    unsigned char* ws = p.ws; const int tid = threadIdx.x, lane = tid & 63, kl = lane & 15, g = lane >> 4;
    const int wave = __builtin_amdgcn_readfirstlane(tid >> 6);
    const _Float16* QI = (const _Float16*)(ws + OFF_QI); const _Float16* KI = (const _Float16*)(ws + OFF_KI); const float* WI = (const float*)(ws + OFF_WI);
    unsigned short* IDX = (unsigned short*)(ws + OFF_IDX); int* CNT = (int*)(ws + OFF_CNT);
    LAS unsigned* hist = (LAS unsigned*)lds;
    LAS unsigned* zc = hist + 16 * 2048;
    LAS unsigned* zpre = zc + 128;
    LAS int* qTbin = (LAS int*)(zpre + 128);
    LAS int* qCab = qTbin + 16; LAS int* qCb = qCab + 16; LAS unsigned* qNgt = (LAS unsigned*)(qCb + 16); LAS unsigned* qNcand = qNgt + 16; LAS int* qOvf = (LAS int*)(qNcand + 16);
    LAS unsigned* ovl = (LAS unsigned*)(lds + 132 * 1024);
    LAS unsigned* h2 = (LAS unsigned*)(lds + 133 * 1024 + wave * 1536);
    LAS unsigned long long* l2 = (LAS unsigned long long*)(h2 + 256);
    if (tid == 0) ovl[0] = 0u;
    const int G = gridDim.x, nround = (T / 16) / G;
#pragma unroll 1
    for (int i = 0; i < nround; ++i) {
        const int tix = (i & 1) ? i * G + (G - 1 - (int)blockIdx.x) : i * G + (int)blockIdx.x;
        const int batch = tix & 1, tb = tix >> 1, p0 = tb * 16; const size_t t0 = (size_t)batch * SEQ + p0;
        __syncthreads();
        if (p0 + 16 <= 256) {
#pragma unroll
            for (int j = 0; j < 8; ++j) { const int e = tid + 512 * j, q = e >> 8, jj = e & 255; IDX[(t0 + q) * 256 + jj] = (unsigned short)(jj <= p0 + q ? jj : 0); }
            if (tid < 16) CNT[t0 + tid] = p0 + tid + 1;
            continue;
        }
#pragma unroll
        for (int j = 0; j < 16; ++j) ((LAS u32x4*)hist)[tid + 512 * j] = (u32x4){0u, 0u, 0u, 0u};
        if (tid < 256) zc[tid] = 0u;
        if (tid < 16) { qNgt[tid] = 0u; qNcand[tid] = 0u; qOvf[tid] = 0; }
        half8 af[4][2]; f32x4 wv[4];
#pragma unroll
        for (int rt = 0; rt < 4; ++rt) {
#pragma unroll
            for (int ks = 0; ks < 2; ++ks) af[rt][ks] = *(const half8*)(QI + (t0 + 4 * rt + (kl >> 2)) * 256 + (kl & 3) * 64 + 32 * ks + 8 * g);
            wv[rt] = *(const f32x4*)(WI + (t0 + 4 * rt + g) * 4);
        }
        __syncthreads();
        const int nblk = tb + 1, L = (nblk + 7) >> 3, b0 = wave * L, b1 = (b0 + L < nblk) ? b0 + L : nblk;
        const _Float16* kb = KI + (size_t)batch * SEQ * 64 + kl * 64 + 8 * g;
        LAS unsigned* hg = hist + g * 4 * 2048;
        {
            unsigned zcnt[4] = {0u, 0u, 0u, 0u};
            half8 k0 = (half8){0, 0, 0, 0, 0, 0, 0, 0}, k1 = k0;
            if (b0 < b1) { k0 = *(const half8*)(kb + (size_t)b0 * 1024); k1 = *(const half8*)(kb + (size_t)b0 * 1024 + 32); }
#pragma unroll 1
            for (int b = b0; b < b1; ++b) {
                const int bn = (b + 1 < b1) ? b + 1 : b; const int s = b * 16 + kl;
                const half8 n0 = *(const half8*)(kb + (size_t)bn * 1024), n1 = *(const half8*)(kb + (size_t)bn * 1024 + 32);
#pragma unroll
                for (int rt = 0; rt < 4; ++rt) {
                    f32x4 acc = __builtin_amdgcn_mfma_f32_16x16x32_f16(af[rt][0], k0, (f32x4){0.f, 0.f, 0.f, 0.f}, 0, 0, 0);
                    acc = __builtin_amdgcn_mfma_f32_16x16x32_f16(af[rt][1], k1, acc, 0, 0, 0);
                    const unsigned key = ix_key(acc, wv[rt]);
                    if (s <= p0 + 4 * rt + g) { LDS_ADD(hg + rt * 2048 + (key >> 21), 1u); zcnt[rt] += (key == 0x80000000u) ? 1u : 0u; }
                }
                k0 = n0; k1 = n1;
            }
#pragma unroll
            for (int rt = 0; rt < 4; ++rt) if (zcnt[rt]) LDS_ADD(zc + (g * 4 + rt) * 8 + wave, zcnt[rt]);
        }
        __syncthreads();
#pragma unroll 1
        for (int qq = 0; qq < 2; ++qq) {
            const int q = 2 * wave + qq; const LAS unsigned* h = hist + q * 2048;
            unsigned cs = 0; const int top = 2047 - 32 * lane;
            for (int ii = 0; ii < 32; ++ii) cs += h[top - ((ii + lane) & 31)];
            unsigned incl = cs;
#pragma unroll
            for (int o = 1; o < 64; o <<= 1) { const unsigned y = __shfl_up(incl, o); if (lane >= o) incl += y; }
            const unsigned long long m = __ballot(incl >= 256u);
            const int Ls = m ? (__ffsll((long long)m) - 1) : 63;
            unsigned cabv = __shfl(incl - cs, Ls), cbv = 0; int tbin = 0; bool found = false;
            for (int ii = 0; ii < 32; ++ii) { const unsigned c = h[2047 - 32 * Ls - ii]; if (!found && cabv + c >= 256u) { tbin = 2047 - 32 * Ls - ii; cbv = c; found = true; } if (!found) cabv += c; }
            if (lane == 0) { qTbin[q] = tbin; qCab[q] = (int)cabv; qCb[q] = (int)cbv; if (tbin != IX_ZBIN && cbv > (unsigned)IX_CAP) qOvf[q] = 1; }
            { unsigned v = lane < 8 ? zc[q * 8 + lane] : 0u, inc = v;
#pragma unroll
              for (int o = 1; o < 8; o <<= 1) { const unsigned y = __shfl_up(inc, o); if (lane >= o) inc += y; }
              if (lane < 8) zpre[q * 8 + lane] = inc - v; }
        }
        __syncthreads();
        {
            int tbn[4], cab[4], rr[4]; unsigned zrun[4];
#pragma unroll
            for (int rt = 0; rt < 4; ++rt) { const int q = g * 4 + rt; tbn[rt] = qOvf[q] ? 4096 : qTbin[q]; cab[rt] = qCab[q]; rr[rt] = 256 - cab[rt]; zrun[rt] = zpre[q * 8 + wave]; }
            half8 k0 = (half8){0, 0, 0, 0, 0, 0, 0, 0}, k1 = k0;
            if (b0 < b1) { k0 = *(const half8*)(kb + (size_t)b0 * 1024); k1 = *(const half8*)(kb + (size_t)b0 * 1024 + 32); }
#pragma unroll 1
            for (int b = b0; b < b1; ++b) {
                const int bn = (b + 1 < b1) ? b + 1 : b; const int s = b * 16 + kl;
                const half8 n0 = *(const half8*)(kb + (size_t)bn * 1024), n1 = *(const half8*)(kb + (size_t)bn * 1024 + 32);
                unsigned key[4]; bool sel[4], inb[4]; unsigned pos[4];
#pragma unroll
                for (int rt = 0; rt < 4; ++rt) {
                    f32x4 acc = __builtin_amdgcn_mfma_f32_16x16x32_f16(af[rt][0], k0, (f32x4){0.f, 0.f, 0.f, 0.f}, 0, 0, 0);
                    acc = __builtin_amdgcn_mfma_f32_16x16x32_f16(af[rt][1], k1, acc, 0, 0, 0);
                    key[rt] = ix_key(acc, wv[rt]); const int bin = (int)(key[rt] >> 21);
                    const bool valid = s <= p0 + 4 * rt + g;
                    sel[rt] = valid && bin > tbn[rt]; inb[rt] = valid && bin == tbn[rt];
                }
#pragma unroll
                for (int rt = 0; rt < 4; ++rt) { const int qs = g * 4 + rt; const bool cand = inb[rt] && tbn[rt] != IX_ZBIN;
                    LAS unsigned* tgt = sel[rt] ? (qNgt + qs) : (cand ? (qNcand + qs) : (zc + lane));
                    pos[rt] = LDS_ADD(tgt, (sel[rt] || cand) ? 1u : 0u); }
#pragma unroll
                for (int rt = 0; rt < 4; ++rt) { const int qs = g * 4 + rt;
                    if (__builtin_expect(tbn[rt] == IX_ZBIN, 0)) {
                        const unsigned long long zm = __ballot(inb[rt]);
                        const unsigned gm = (unsigned)(zm >> (16 * g)) & 0xffffu;
                        if (inb[rt] && key[rt] != 0x80000000u) qOvf[qs] = 1;
                        if (inb[rt]) { const unsigned pz = zrun[rt] + __popc(gm & ((1u << kl) - 1u)); if ((int)pz < rr[rt]) IDX[(t0 + 4 * rt + g) * 256 + cab[rt] + pz] = (unsigned short)s; }
                        zrun[rt] += __popc(gm);
                    } else if (inb[rt]) { if (pos[rt] < (unsigned)IX_CAP) ((LAS unsigned long long*)(lds + qs * 8192))[pos[rt]] = ((unsigned long long)key[rt] << 16) | (unsigned long long)(0xffffu - (unsigned)s); }
                    if (sel[rt]) IDX[(t0 + 4 * rt + g) * 256 + pos[rt]] = (unsigned short)s;
                }
                k0 = n0; k1 = n1;
            }
        }
        __syncthreads();
#pragma unroll 1
        for (int qq = 0; qq < 2; ++qq) {
            const int qs = 2 * wave + qq; const int tbin = qTbin[qs], n = qCb[qs], cabq = qCab[qs], r = 256 - cabq;
            if (tbin == IX_ZBIN || qOvf[qs]) continue;
            const LAS unsigned long long* cd = (const LAS unsigned long long*)(lds + qs * 8192);
            unsigned short* irow = IDX + (t0 + 4 * (qs & 3) + (qs >> 2)) * 256 + cabq;
            if (r >= n) { for (int c = lane; c < n; c += 64) irow[c] = (unsigned short)(0xffffu - (unsigned)(cd[c] & 0xffffull)); continue; }
#pragma unroll
            for (int j = 0; j < 4; ++j) h2[lane + 64 * j] = 0u;
            for (int c = lane; c < n; c += 64) LDS_ADD(h2 + ((unsigned)(cd[c] >> 29) & 255u), 1u);
            const unsigned cs = h2[255 - 4 * lane] + h2[254 - 4 * lane] + h2[253 - 4 * lane] + h2[252 - 4 * lane];
            unsigned incl = cs;
#pragma unroll
            for (int o = 1; o < 64; o <<= 1) { const unsigned y = __shfl_up(incl, o); if (lane >= o) incl += y; }
            const unsigned long long m = __ballot(incl >= (unsigned)r);
            const int Ls = m ? (__ffsll((long long)m) - 1) : 63;
            unsigned above = __shfl(incl - cs, Ls), c2 = 0; int T2 = 0; bool found = false;
#pragma unroll
            for (int ii = 0; ii < 4; ++ii) { const unsigned c = h2[255 - 4 * Ls - ii]; if (!found && above + c >= (unsigned)r) { T2 = 255 - 4 * Ls - ii; c2 = c; found = true; } if (!found) above += c; }
            const int r2 = r - (int)above;
            asm volatile("" ::: "memory");
            if (lane == 0) { h2[0] = 0u; h2[1] = 0u; }
            asm volatile("" ::: "memory");
            for (int c = lane; c < n; c += 64) { const unsigned long long v = cd[c]; const int sub = (int)((unsigned)(v >> 29) & 255u);
                if (sub > T2) { const unsigned pos = LDS_ADD(h2 + 0, 1u); irow[pos] = (unsigned short)(0xffffu - (unsigned)(v & 0xffffull)); }
                else if (sub == T2) { const unsigned pos = LDS_ADD(h2 + 1, 1u); if (pos < 64u) l2[pos] = v; } }
            asm volatile("" ::: "memory");
            if (c2 <= 64u) {
                const unsigned long long mine = (unsigned)lane < c2 ? l2[lane] : ~0ull; int rank = 0;
                for (unsigned j = 0; j < c2; ++j) rank += (l2[j] > mine) ? 1 : 0;
                if ((unsigned)lane < c2 && rank < r2) irow[above + rank] = (unsigned short)(0xffffu - (unsigned)(mine & 0xffffull));
            } else {
                for (int c0 = 0; c0 < n; c0 += 64) {
                    const int c = c0 + lane; const unsigned long long mine = c < n ? cd[c] : ~0ull; const bool have = c < n && (int)((unsigned)(mine >> 29) & 255u) == T2;
                    int rank = 0;
                    for (int j = 0; j < n; ++j) { const unsigned long long cj = cd[j]; rank += ((int)((unsigned)(cj >> 29) & 255u) == T2 && cj > mine) ? 1 : 0; }
                    if (have && rank < r2) irow[above + rank] = (unsigned short)(0xffffu - (unsigned)(mine & 0xffffull));
                }
            }
        }
        if (tid < 16) CNT[t0 + tid] = 256;
        if (tid < 16 && qOvf[tid]) { const unsigned k = LDS_ADD(ovl, 1u); ovl[1 + k] = (unsigned)(t0 + 4 * (tid & 3) + (tid >> 2)); }
    }
    __syncthreads();
    const unsigned novl = __builtin_amdgcn_readfirstlane(ovl[0]);
#pragma unroll 1
    for (unsigned k = 0; k < novl; ++k) { const unsigned tq = __builtin_amdgcn_readfirstlane(ovl[1 + k]); indexer_slow_query(p, lds, (size_t)tq); }
}
#undef LDS_ADD

__device__ __forceinline__ void phase_attn(const P& p, unsigned char* lds) {
    unsigned char* ws = p.ws; const int tid = threadIdx.x, lane = tid & 63, hd = lane & 15, g = lane >> 4;
    const int wave = __builtin_amdgcn_readfirstlane(tid >> 6);
    bf16_t* QP = (bf16_t*)(ws + OFF_QP); const bf16_t* CK = (const bf16_t*)(ws + OFF_CKVN); const bf16_t* RK = (const bf16_t*)(ws + OFF_RK);
    const unsigned short* IDX = (const unsigned short*)(ws + OFF_IDX); const int* CNT = (const int*)(ws + OFF_CNT);
    float* biasT = (float*)lds;
    biasT[tid] = p.rel_bias[tid];
    __syncthreads();
    LAS unsigned char* rows = (LAS unsigned char*)(lds + 2048 + (size_t)wave * 18432);
    LAS bf16_t* rkb = (LAS bf16_t*)(rows + 16384);
    LAS unsigned* info = (LAS unsigned*)(rows + 17408);
    const LAS float* biasL = (const LAS float*)lds;
    for (int t = blockIdx.x * 8 + wave; t < T; t += gridDim.x * 8) {
        const int batch = t >> 14, pos = t & (SEQ - 1); const int cnt = CNT[t];
        const size_t rb = (size_t)batch * SEQ;
        asm volatile("s_waitcnt lgkmcnt(0)" ::: "memory");
#pragma unroll
        for (int jj = 0; jj < 4; ++jj) {
            const int j = lane + 64 * jj; int id = IDX[(size_t)t * 256 + j]; if (j >= cnt) id = 0;
            const int rel = pos - id; int bucket = rel < 0 ? 0 : rel;
            if (rel >= 16) { bucket = 16 + (int)(__logf((float)rel * 0.0625f) / 2.0794415416798357f * 16.0f); bucket = bucket > 31 ? 31 : bucket; }
            info[j] = (unsigned)id | ((unsigned)bucket << 16);
        }
        bf16x8 qf[8];
#pragma unroll
        for (int ks = 0; ks < 8; ++ks) qf[ks] = *(const bf16x8*)(QP + (size_t)t * 4096 + hd * 256 + ks * 32 + g * 8);
        f32x4 o[16];
#pragma unroll
        for (int rt = 0; rt < 16; ++rt) o[rt] = (f32x4){0.f, 0.f, 0.f, 0.f};
        float mrun = -1e30f, lrun = 0.f;
        asm volatile("s_waitcnt lgkmcnt(0)" ::: "memory");
        const int nch = (cnt + 31) >> 5;
        for (int ch = 0; ch < nch; ++ch) {
            asm volatile("s_waitcnt lgkmcnt(0)" ::: "memory");
#pragma unroll
            for (int i = 0; i < 16; ++i) {
                const int ksl = 2 * i + (lane >> 5); const unsigned idv = info[ch * 32 + ksl] & 0xffffu;
                const bf16_t* src = CK + (rb + idv) * 256 + (((lane & 31) ^ (ksl & 15)) * 8);
                __builtin_amdgcn_global_load_lds((const unsigned*)src, (LAS unsigned*)(rows + i * 1024), 16, 0, 0);
            }
            { const unsigned idv = info[ch * 32 + (lane >> 1)] & 0xffffu;
              __builtin_amdgcn_global_load_lds((const unsigned*)(RK + (rb + idv) * 16 + (lane & 1) * 8), (LAS unsigned*)rkb, 16, 0, 0); }
            asm volatile("s_waitcnt vmcnt(0)" ::: "memory");
            f32x4 s0 = (f32x4){0.f, 0.f, 0.f, 0.f}, s1 = (f32x4){0.f, 0.f, 0.f, 0.f};
#pragma unroll
            for (int ks = 0; ks < 8; ++ks) {
                const int pos16 = ((4 * ks + g) ^ hd) * 16;
                const bf16x8 a0 = *(const LAS bf16x8*)(rows + hd * 512 + pos16);
                const bf16x8 a1 = *(const LAS bf16x8*)(rows + (16 + hd) * 512 + pos16);
                s0 = __builtin_amdgcn_mfma_f32_16x16x32_bf16(a0, qf[ks], s0, 0, 0, 0);
                s1 = __builtin_amdgcn_mfma_f32_16x16x32_bf16(a1, qf[ks], s1, 0, 0, 0);
            }
            float x0[4], x1[4]; float cm = -INFINITY;
#pragma unroll
            for (int r = 0; r < 4; ++r) {
                const int sl0 = 4 * g + r, sl1 = 16 + 4 * g + r, j0 = ch * 32 + sl0, j1 = ch * 32 + sl1;
                const unsigned i0 = info[j0], i1 = info[j1];
                const float r0 = bf2f(rkb[sl0 * 16 + hd]), r1 = bf2f(rkb[sl1 * 16 + hd]);
                x0[r] = (j0 < cnt) ? s0[r] * r0 + biasL[(i0 >> 16) * 16 + hd] : -INFINITY;
                x1[r] = (j1 < cnt) ? s1[r] * r1 + biasL[(i1 >> 16) * 16 + hd] : -INFINITY;
                cm = fmaxf(cm, fmaxf(x0[r], x1[r]));
            }
            cm = fmaxf(cm, __shfl_xor(cm, 16)); cm = fmaxf(cm, __shfl_xor(cm, 32));
            const float mnew = fmaxf(mrun, cm); const float sc = __expf(mrun - mnew); mrun = mnew;
            float ls = 0.f;
#pragma unroll
            for (int r = 0; r < 4; ++r) { x0[r] = __expf(x0[r] - mnew); x1[r] = __expf(x1[r] - mnew); ls += x0[r] + x1[r]; }
            lrun = lrun * sc + ls;
#pragma unroll
            for (int rt = 0; rt < 16; ++rt) o[rt] *= sc;
            u32x4 pw; pw.x = pg8::cvt_pk_bf16(x0[0], x0[1]); pw.y = pg8::cvt_pk_bf16(x0[2], x0[3]); pw.z = pg8::cvt_pk_bf16(x1[0], x1[1]); pw.w = pg8::cvt_pk_bf16(x1[2], x1[3]);
            const bf16x8 pf = __builtin_bit_cast(bf16x8, pw);
            const int q = hd >> 2, pp = hd & 3, ksl = 4 * g + q;
            const LAS unsigned char* trb = rows + ksl * 512 + (pp & 1) * 8;
#pragma unroll
            for (int rt = 0; rt < 16; ++rt) {
                const int c16 = ((2 * rt + (pp >> 1)) ^ ksl) * 16;
                const v4i16_t t0 = __builtin_amdgcn_ds_read_tr16_b64_v4i16((LAS v4i16_t*)(trb + c16));
                const v4i16_t t1 = __builtin_amdgcn_ds_read_tr16_b64_v4i16((LAS v4i16_t*)(trb + c16 + 8192));
                bf16x8 af; af[0] = t0[0]; af[1] = t0[1]; af[2] = t0[2]; af[3] = t0[3]; af[4] = t1[0]; af[5] = t1[1]; af[6] = t1[2]; af[7] = t1[3];
                o[rt] = __builtin_amdgcn_mfma_f32_16x16x32_bf16(af, pf, o[rt], 0, 0, 0);
            }
        }
        float ltot = lrun; ltot += __shfl_xor(ltot, 16); ltot += __shfl_xor(ltot, 32);
        const float inv = 1.0f / ltot;
        bf16_t* op = QP + (size_t)t * 4096 + hd * 256 + 4 * g;
#pragma unroll
        for (int rt = 0; rt < 16; ++rt) { u32x2 w; w.x = pg8::cvt_pk_bf16(o[rt][0] * inv, o[rt][1] * inv); w.y = pg8::cvt_pk_bf16(o[rt][2] * inv, o[rt][3] * inv); *(u32x2*)(op + rt * 16) = w; }
    }
}

__global__ void __launch_bounds__(512, 2) k_fwd(P p_arg, int ph_lo, int ph_hi) {
    extern __shared__ __attribute__((aligned(16))) unsigned char smem[];
    const P& p = *(const P*)__builtin_amdgcn_kernarg_segment_ptr(); (void)p_arg;
    unsigned char* lds = smem + 16;
    unsigned char* ws = p.ws;
    XcdBarrier bar;
    const bool multi = (ph_hi - ph_lo) > 1;
    if (multi) {
        if (threadIdx.x == 0) *(uint4*)smem = make_uint4(0u, 0u, 0u, 0u);
        __syncthreads();
        bar = xcd_barrier_post((unsigned*)(ws + OFF_CTL), (volatile LAS unsigned*)smem);
    }
#define PH(i) (ph_lo <= (i) && (i) < ph_hi)
#define SEAM(i) do { if ((i) + 1 < ph_hi) xcd_barrier(bar); else __syncthreads(); } while (0)
    bf16_t *XN = (bf16_t*)(ws + OFF_XN), *QB = (bf16_t*)(ws + OFF_QB), *KB = (bf16_t*)(ws + OFF_KB), *VB = (bf16_t*)(ws + OFF_VB), *TMP = (bf16_t*)(ws + OFF_TMP), *Y = (bf16_t*)(ws + OFF_Y);
    if (PH(0)) { phase_prep(p, lds); SEAM(0); }
    if (PH(1)) { fast_gemm(lds, XN, 1024, (const bf16_t*)(ws + OFF_W0T), 1024, 3072, 1024, D1{ws}); SEAM(1); }
    if (PH(2)) { phase_conv_scan(p, lds); SEAM(2); }
    if (PH(3)) { mlstm_units<false>(p, lds); SEAM(3); }
    if (PH(4)) { GWP f{(const bf16_t*)(ws + OFF_WPT), (const bf16_t*)(ws + OFF_WUB), (bf16_t*)(ws + OFF_W0T)}; sgemm(f, 256); phase_mlstm_scan(p, lds); SEAM(4); }
    if (PH(5)) { mlstm_units<true>(p, lds); SEAM(5); }
    if (PH(6)) { fast_gemm(lds, XN, 1024, (const bf16_t*)(ws + OFF_W0T) + (size_t)3072 * 1024, 1024, 4096, 1024, D2{ws}); SEAM(6); }
    if (PH(7)) { phase_ya_pool(p); SEAM(7); }
    if (PH(8)) { fast_gemm(lds, Y, 2048, (const bf16_t*)(ws + OFF_WO0T), 2048, 1024, 2048, D4{(unsigned char*)p.out, p.x}); SEAM(8); }
    if (PH(9)) { rmsnorm_rows<4>(p.out, p.o_norm, XN, p.o_w_in, OIN, 1600, nullptr, 0.5f, (float*)(ws + OFF_WI), (float*)lds); SEAM(9); }
    if (PH(10)) { fast_gemm(lds, XN, 1024, (const bf16_t*)(ws + OFF_W1T), 1024, 2816, 1024, D5{ws}); SEAM(10); }
    if (PH(11)) { phase_qnorm_ckvnorm(p); SEAM(11); }
    if (PH(12)) { fast_gemm(lds, (const bf16_t*)(ws + OFF_CKVN), 256, (const bf16_t*)(ws + OFF_WUKP), 256, 1024, 256, DK{ws}); SEAM(12); }
    if (PH(13)) { GQP f{TMP, (const bf16_t*)(ws + OFF_WQP), (bf16_t*)(ws + OFF_QP)}; sgemm(f, 512 * 64); phase_indexer(p, lds); SEAM(13); }
    if (PH(14)) { phase_attn(p, lds); SEAM(14); }
    if (PH(15)) { GOP f{(const bf16_t*)(ws + OFF_QP), (const bf16_t*)(ws + OFF_WUVT), (const bf16_t*)(ws + OFF_Z), TMP}; sgemm(f, 512 * 16); SEAM(15); }
    if (PH(16)) { fast_gemm(lds, TMP, 1024, (const bf16_t*)(ws + OFF_WO1T), 1024, 1024, 1024, D8{(unsigned char*)p.out}); }
#undef PH
#undef SEAM
}

extern "C" void kernel_launch(void* const* d_in, const int* in_sizes, int n_in, void* d_out, int out_size, void* d_ws, size_t ws_size, hipStream_t stream) {
    static int grid = 0;
    if (grid == 0) {
        if (n_in != 18 || out_size != T * DM || ws_size < WS_END) { fprintf(stderr, "kernel_launch: unexpected shapes (n_in %d out %d ws %zu)\n", n_in, out_size, ws_size); grid = -1; return; }
        if (hipFuncSetAttribute((const void*)k_fwd, hipFuncAttributeMaxDynamicSharedMemorySize, LDS_BYTES) != hipSuccess) { fprintf(stderr, "kernel_launch: hipFuncSetAttribute failed\n"); grid = -1; return; }
        grid = 256;
    }
    if (grid < 0) return;
    (void)hipMemsetAsync((char*)d_ws + OFF_CTL, 0, 16384, stream);
    P p{};
    p.x = (const float*)d_in[0]; p.e_norm = (const float*)d_in[1]; p.e_w_in = (const float*)d_in[2]; p.e_conv = (const float*)d_in[3]; p.e_b_if = (const float*)d_in[4];
    p.e_g_head = (const float*)d_in[5]; p.e_w_pool = (const float*)d_in[6]; p.e_s_pool = (const float*)d_in[7]; p.e_w_out = (const float*)d_in[8];
    p.o_norm = (const float*)d_in[9]; p.o_w_in = (const float*)d_in[10]; p.o_g_kv = (const float*)d_in[11]; p.o_w_uk = (const float*)d_in[12]; p.o_w_uv = (const float*)d_in[13];
    p.o_g_q = (const float*)d_in[14]; p.o_g_k = (const float*)d_in[15]; p.o_w_out = (const float*)d_in[16]; p.rel_bias = (const float*)d_in[17];
    p.out = (float*)d_out; p.ws = (unsigned char*)d_ws;
    hipLaunchKernelGGL(k_fwd, dim3(grid), dim3(512), LDS_BYTES, stream, p, 0, NPH);
}
```

```cpp
#include <hip/hip_runtime.h>
#include <stdint.h>
#include <cstdio>

typedef unsigned short bf16_t;
typedef short bf16x8 __attribute__((ext_vector_type(8)));
typedef float f32x4 __attribute__((ext_vector_type(4)));
typedef unsigned u32x4 __attribute__((ext_vector_type(4)));
typedef unsigned u32x2 __attribute__((ext_vector_type(2)));
typedef short v4i16_t __attribute__((ext_vector_type(4)));
#define LAS __attribute__((address_space(3)))

constexpr int T = 32768, SEQ = 16384, DM = 1024;
constexpr int EIN = 7176, OIN = 2628;
constexpr float EPS = 1e-6f;
constexpr size_t MB = 1048576;
constexpr size_t OFF_CTL = 0;
constexpr size_t OFF_GATES = 64 * 1024;
constexpr size_t OFF_BQ = OFF_GATES + (size_t)T * 8 * 4;
constexpr size_t OFF_IQ = OFF_BQ + (size_t)T * 4 * 4;
constexpr size_t OFF_MT = OFF_IQ + (size_t)T * 4 * 4;
constexpr size_t OFF_WI = OFF_MT + (size_t)T * 4 * 4;
constexpr size_t OFF_CH = OFF_WI + (size_t)T * 4 * 4;
constexpr size_t OFF_NS = OFF_CH + 64 * 1024;
constexpr size_t OFF_W = 4 * MB;
constexpr size_t OFF_W0T = OFF_W;
constexpr size_t OFF_WPT = OFF_W0T + (size_t)7168 * 1024 * 2;
constexpr size_t OFF_WO0T = OFF_WPT + (size_t)4 * 256 * 256 * 2;
constexpr size_t OFF_W1T = OFF_WO0T + (size_t)1024 * 2048 * 2;
constexpr size_t OFF_WUKT = OFF_W1T + (size_t)2816 * 1024 * 2;
constexpr size_t OFF_WUVT = OFF_WUKT + (size_t)1024 * 256 * 2;
constexpr size_t OFF_WO1T = OFF_WUVT + (size_t)1024 * 256 * 2;
constexpr size_t OFF_WUKP = OFF_WO1T + (size_t)1024 * 1024 * 2;
constexpr size_t OFF_WQP = OFF_WUKP + (size_t)1024 * 256 * 2;
constexpr size_t OFF_WUB = OFF_WQP + (size_t)16 * 256 * 64 * 2;
constexpr size_t OFF_XN = 36 * MB, OFF_QB = 100 * MB, OFF_KB = 164 * MB, OFF_VB = 228 * MB, OFF_TMP = 292 * MB, OFF_Y = 356 * MB;
constexpr size_t OFF_QP = 36 * MB;
constexpr size_t OFF_CKVN = OFF_Y;
constexpr size_t OFF_QI = OFF_Y + 16 * MB;
constexpr size_t OFF_KI = OFF_Y + 32 * MB;
constexpr size_t OFF_IDX = OFF_Y + 40 * MB;
constexpr size_t OFF_RK = OFF_Y + 58 * MB;
constexpr size_t OFF_CNT = OFF_Y + 59 * MB;
constexpr size_t OFF_Z = OFF_Y + 60 * MB;
constexpr size_t WS_END = 484 * MB;
constexpr int LDS_BYTES = 151552;
constexpr int NPH = 17;

struct P {
    const float *x, *e_norm, *e_w_in, *e_conv, *e_b_if, *e_g_head, *e_w_pool, *e_s_pool, *e_w_out;
    const float *o_norm, *o_w_in, *o_g_kv, *o_w_uk, *o_w_uv, *o_g_q, *o_g_k, *o_w_out, *rel_bias;
    float* out; unsigned char* ws;
};

__device__ __forceinline__ bf16_t f2bf(float f) { unsigned u = __float_as_uint(f); u += 0x7FFFu + ((u >> 16) & 1u); return (bf16_t)(u >> 16); }
__device__ __forceinline__ float bf2f(bf16_t b) { return __uint_as_float(((unsigned)b) << 16); }
__device__ __forceinline__ float bflo(unsigned w) { return __uint_as_float(w << 16); }
__device__ __forceinline__ float bfhi(unsigned w) { return __uint_as_float(w & 0xffff0000u); }
__device__ __forceinline__ unsigned pk2(float a, float b) { return (unsigned)f2bf(a) | ((unsigned)f2bf(b) << 16); }
__device__ __forceinline__ float sigmoidf_(float x) { return __builtin_amdgcn_rcpf(1.0f + __expf(-x)); }
__device__ __forceinline__ float siluf_(float x) { return x * __builtin_amdgcn_rcpf(1.0f + __expf(-x)); }
__device__ __forceinline__ float wave_sum(float v) {
#pragma unroll
    for (int o = 32; o >= 1; o >>= 1) v += __shfl_xor(v, o);
    return v;
}
__device__ __forceinline__ float wave_max(float v) {
#pragma unroll
    for (int o = 32; o >= 1; o >>= 1) v = fmaxf(v, __shfl_xor(v, o));
    return v;
}

#define XB_TMO      128
#define XB_XCNT(j)  (256  + 64 * (j))
#define XB_XSUB(j)  (1280 + 64 * (j))
#define XB_XGEN(j)  (2304 + 64 * (j))
#define XB_TOP      3328
#define XB_TOPGEN   3392
#define XCD_BAR_WORDS 3456
#define XB_SPIN_CAP (1u << 22)
__device__ __forceinline__ unsigned xb_ld(unsigned* p)              { return __hip_atomic_load(p, __ATOMIC_RELAXED, __HIP_MEMORY_SCOPE_AGENT); }
__device__ __forceinline__ unsigned xb_add(unsigned* p, unsigned v) { return __hip_atomic_fetch_add(p, v, __ATOMIC_RELAXED, __HIP_MEMORY_SCOPE_AGENT); }
__device__ __forceinline__ unsigned xb_xcc_id() { return (unsigned)__builtin_amdgcn_s_getreg((3 << 11) | 20) & 0xFu; }
#define XB_SPIN(cond, bar) do { unsigned _sp = 0; while (cond) { __builtin_amdgcn_s_sleep(1); \
    if ((++_sp & 255u) == 0u) { if (xb_ld(&(bar)[XB_TMO])) break; if (_sp > XB_SPIN_CAP) { atomicAdd(&(bar)[XB_TMO], 1u); break; } } } } while (0)
struct XcdBarrier { unsigned* bar; unsigned x; volatile LAS unsigned* st; };
__device__ __forceinline__ XcdBarrier xcd_barrier_post(unsigned* bar, volatile LAS unsigned* st) {
    XcdBarrier b; b.bar = bar; b.x = xb_xcc_id(); b.st = st;
    if (threadIdx.x == 0) (void)xb_add(&bar[XB_XCNT(b.x)], 1u);
    return b;
}
__device__ __forceinline__ void xcd_barrier_complete(unsigned* bar, unsigned x, unsigned& nloc, unsigned& nx) {
    const unsigned G = gridDim.x * gridDim.y * gridDim.z;
    unsigned sum, cnt, mine, sp = 0u;
    for (;;) {
        sum = 0u; cnt = 0u; mine = 0u;
#pragma unroll
        for (unsigned j = 0; j < 16; ++j) { const unsigned c = xb_ld(&bar[XB_XCNT(j)]); sum += c; cnt += (c > 0u) ? 1u : 0u; mine = (j == x) ? c : mine; }
        if (sum == G) break;
        __builtin_amdgcn_s_sleep(1);
        if ((++sp & 255u) == 0u) { if (xb_ld(&bar[XB_TMO])) break; if (sp > XB_SPIN_CAP) { atomicAdd(&bar[XB_TMO], 1u); break; } }
    }
    nloc = mine > 0u ? mine : 1u; nx = cnt > 0u ? cnt : 1u;
}
__device__ __forceinline__ void xcd_barrier(const XcdBarrier& b) {
    asm volatile("s_waitcnt vmcnt(0)" ::: "memory");
    __syncthreads();
    if (threadIdx.x == 0) {
        unsigned* bar = b.bar;
        __builtin_amdgcn_s_waitcnt(0);
        unsigned nloc = b.st[0], nx = b.st[1];
        if (nloc == 0u) { xcd_barrier_complete(bar, b.x, nloc, nx); b.st[0] = nloc; b.st[1] = nx; }
        const unsigned old = xb_add(&bar[XB_XSUB(b.x)], 1u);
        const unsigned gen = old / nloc;
        if (old + 1u == (gen + 1u) * nloc) {
            __builtin_amdgcn_fence(__ATOMIC_RELEASE, "agent");
            asm volatile("s_waitcnt vmcnt(0)" ::: "memory");
            const unsigned og = xb_add(&bar[XB_TOP], 1u);
            const unsigned tg = og / nx;
            if (og + 1u == (tg + 1u) * nx) xb_add(&bar[XB_TOPGEN], 1u);
            else XB_SPIN(xb_ld(&bar[XB_TOPGEN]) == tg, bar);
            __builtin_amdgcn_fence(__ATOMIC_ACQUIRE, "agent");
            xb_add(&bar[XB_XGEN(b.x)], 1u);
            asm volatile("s_waitcnt vmcnt(0)" ::: "memory");
        } else {
            XB_SPIN(xb_ld(&bar[XB_XGEN(b.x)]) == gen, bar);
            __builtin_amdgcn_fence(__ATOMIC_ACQUIRE, "agent");
            asm volatile("s_waitcnt vmcnt(0)" ::: "memory");
        }
    }
    __syncthreads();
}

struct Tile { const bf16_t* A; const bf16_t* B; int lda, ldb, K; void* d0; const void* s0; int ld; };
template <class F>
__device__ __forceinline__ void sgemm(const F f, int nunits) {
    const int lane = threadIdx.x & 63, wave = threadIdx.x >> 6, fr = lane & 15, fq = lane >> 4;
    for (int u = blockIdx.x * 8 + wave; u < nunits; u += gridDim.x * 8) {
        Tile tl; f.tile(u, tl);
        f32x4 acc[4][4];
#pragma unroll
        for (int m = 0; m < 4; ++m)
#pragma unroll
            for (int n = 0; n < 4; ++n) acc[m][n] = (f32x4){0.f, 0.f, 0.f, 0.f};
        const bf16_t* ap = tl.A + (size_t)fr * tl.lda + fq * 8;
        const bf16_t* bp = tl.B + (size_t)fr * tl.ldb + fq * 8;
        const int K = tl.K, lda = tl.lda, ldb = tl.ldb;
        bf16x8 a[4], b[4];
#pragma unroll
        for (int m = 0; m < 4; ++m) a[m] = *(const bf16x8*)(ap + (size_t)(m * 16) * lda);
#pragma unroll
        for (int n = 0; n < 4; ++n) b[n] = *(const bf16x8*)(bp + (size_t)(n * 16) * ldb);
#pragma unroll 1
        for (int k0 = 0; k0 < K; k0 += 32) {
            bf16x8 an[4], bn[4]; const int kn = (k0 + 32 < K) ? k0 + 32 : k0;
#pragma unroll
            for (int m = 0; m < 4; ++m) an[m] = *(const bf16x8*)(ap + (size_t)(m * 16) * lda + kn);
#pragma unroll
            for (int n = 0; n < 4; ++n) bn[n] = *(const bf16x8*)(bp + (size_t)(n * 16) * ldb + kn);
#pragma unroll
            for (int m = 0; m < 4; ++m)
#pragma unroll
                for (int n = 0; n < 4; ++n) acc[m][n] = __builtin_amdgcn_mfma_f32_16x16x32_bf16(b[n], a[m], acc[m][n], 0, 0, 0);
#pragma unroll
            for (int m = 0; m < 4; ++m) { a[m] = an[m]; b[m] = bn[m]; }
        }
#pragma unroll
        for (int m = 0; m < 4; ++m) {
            asm volatile("" ::: "memory");
#pragma unroll
            for (int n = 0; n < 4; ++n) f.out4(tl, m * 16 + fr, n * 16 + 4 * fq, acc[m][n]);
        }
    }
}
__device__ __forceinline__ void store4_bf16(const Tile& tl, int r, int c, const f32x4 v) {
    u32x2 w; w.x = pk2(v[0], v[1]); w.y = pk2(v[2], v[3]); *(u32x2*)((bf16_t*)tl.d0 + (size_t)r * tl.ld + c) = w; }

struct GWP {
    const bf16_t* WPT; const bf16_t* WUB; bf16_t* W0T;
    __device__ __forceinline__ void tile(int u, Tile& tl) const {
        const int kt = u & 15, dt = (u >> 4) & 3, g = u >> 6; tl.A = WPT + (size_t)(g * 256 + dt * 64) * 256; tl.lda = 256; tl.B = WUB + (size_t)kt * 64 * 1024 + g * 256; tl.ldb = 1024; tl.K = 256;
        tl.d0 = W0T + (size_t)(5120 + g * 256 + dt * 64) * 1024 + kt * 64; tl.ld = 1024; }
    __device__ __forceinline__ void out4(const Tile& tl, int r, int c, const f32x4 v) const { store4_bf16(tl, r, c, v); }
};
struct GQP {
    const bf16_t* Qn; const bf16_t* W; bf16_t* QP;
    __device__ __forceinline__ void tile(int u, Tile& tl) const {
        const int nt = u & 3, head = (u >> 2) & 15, mt = u >> 6; tl.A = Qn + (size_t)mt * 64 * 1024 + head * 64; tl.lda = 1024; tl.B = W + (size_t)(head * 256 + nt * 64) * 64; tl.ldb = 64; tl.K = 64;
        tl.d0 = QP + ((size_t)mt * 64 * 16 + head) * 256 + nt * 64; tl.ld = 4096; }
    __device__ __forceinline__ void out4(const Tile& tl, int r, int c, const f32x4 v) const { store4_bf16(tl, r, c, v); }
};
struct GOP {
    const bf16_t* OP; const bf16_t* W; const bf16_t* Z; bf16_t* G;
    __device__ __forceinline__ void tile(int u, Tile& tl) const {
        const int head = u & 15, mt = u >> 4; tl.A = OP + (size_t)mt * 64 * 4096 + head * 256; tl.lda = 4096; tl.B = W + (size_t)head * 64 * 256; tl.ldb = 256; tl.K = 256;
        const size_t o = (size_t)mt * 64 * 1024 + head * 64; tl.d0 = G + o; tl.s0 = Z + o; tl.ld = 1024; }
    __device__ __forceinline__ void out4(const Tile& tl, int r, int c, const f32x4 v) const { const size_t i = (size_t)r * 1024 + c; const u32x2 z = *(const u32x2*)((const bf16_t*)tl.s0 + i);
        u32x2 w; w.x = pk2(v[0] * bflo(z.x), v[1] * bfhi(z.x)); w.y = pk2(v[2] * bflo(z.y), v[3] * bfhi(z.y)); *(u32x2*)((bf16_t*)tl.d0 + i) = w; }
};

namespace pg8 {
constexpr int BM = 256, BK = 64, HALF = 128, HTB = HALF * BK * 2, STAGE_BYTES = 8 * HTB, NXCD = 8, WGM = 8;
__device__ __forceinline__ int lds_byte(int r, int c) { const int st = (r >> 4) * 2 + (c >> 5), rr = r & 15, cc = c & 31, ob = rr * 64 + cc * 2; return st * 1024 + (ob ^ (((ob >> 9) & 1) << 5)); }
__device__ __forceinline__ void stage_rc(int b, int& R, int& C) { const int st = b / 1024, sb = b % 1024, swz = sb ^ (((sb >> 9) & 1) << 5); R = (st >> 1) * 16 + swz / 64; C = (st & 1) * 32 + (swz % 64) / 2; }
__device__ __forceinline__ int perm32(int rho) { const int n = rho >> 4, i = rho & 15; return 8 * (i >> 2) + 4 * n + (i & 3); }
struct Unit { int pm, pn; };
struct Gemm { const bf16_t* A; int lda; const bf16_t* Bt; int ldb; int M, N, K; };
struct StaticOrder {
    int nM, nN, nwg, G, c;
    __device__ void init(int M, int N, int G_, int c_) { nM = M / BM; nN = N / BM; nwg = nM * nN; G = G_; c = c_; }
    __device__ bool next(int i, Unit& u) const {
        const long L = (long)i * G + c; if (L >= nwg) return false;
        int wgid = (int)L; { const int q = nwg / NXCD, r = nwg % NXCD, xcd = wgid % NXCD, off = wgid / NXCD; wgid = (xcd < r ? xcd * (q + 1) : r * (q + 1) + (xcd - r) * q) + off; }
        const int nig = WGM * nN, gid = wgid / nig, fm = gid * WGM, gsz = (nM - fm) < WGM ? (nM - fm) : WGM;
        u.pm = fm + ((wgid % nig) % gsz); u.pn = (wgid % nig) / gsz; return true;
    }
};
__device__ __forceinline__ unsigned cvt_pk_bf16(float lo, float hi) { unsigned r; asm volatile("v_cvt_pk_bf16_f32 %0, %1, %2" : "=v"(r) : "v"(lo), "v"(hi)); return r; }

struct Dst { unsigned char* base; const float* res; int ld, mode, ncol; float scale; };
template <class DescF> struct EpiGen {
    static constexpr bool PERM = true;
    DescF D;
    __device__ __forceinline__ void operator()(const f32x4 (&acc)[2][2][4][2], const Unit& u, int wr, int wc, int fr, int fq) const {
        Dst d; D.get(u, d);
        if ((DescF::MODES & 16) && d.mode == 4) return;
        const int r0 = wr * 64 + fr, c0 = wc * 32 + 8 * fq;
        if constexpr ((DescF::MODES & 64) != 0) {
#pragma unroll
            for (int ai = 0; ai < 2; ++ai)
#pragma unroll
                for (int m = 0; m < 4; ++m) {
                    float ss = 0.f;
#pragma unroll
                    for (int bj = 0; bj < 2; ++bj)
#pragma unroll
                        for (int n = 0; n < 2; ++n) { const f32x4 v = acc[ai][bj][m][n]; ss += v[0] * v[0] + v[1] * v[1] + v[2] * v[2] + v[3] * v[3]; }
                    ss += __shfl_xor(ss, 16); ss += __shfl_xor(ss, 32);
                    if (fq == 0) ((bf16_t*)d.base)[(size_t)(ai * HALF + r0 + m * 16) * d.ld + wc] = f2bf(rsqrtf(ss * (1.0f / 64.0f) + EPS));
                }
            return;
        } else {
#pragma unroll
        for (int ai = 0; ai < 2; ++ai)
#pragma unroll
            for (int m = 0; m < 4; ++m) {
                const size_t rowoff = (size_t)(ai * HALF + r0 + m * 16) * d.ld;
#pragma unroll
                for (int bj = 0; bj < 2; ++bj) {
                    const int col = bj * HALF + c0; f32x4 v0 = acc[ai][bj][m][0], v1 = acc[ai][bj][m][1];
                    if ((DescF::MODES & 7) && d.mode <= 2) {
                        if ((DescF::MODES & 2) && d.mode == 1) {
#pragma unroll
                            for (int j = 0; j < 4; ++j) { v0[j] = sigmoidf_(v0[j]); v1[j] = sigmoidf_(v1[j]); } }
                        if ((DescF::MODES & 4) && d.mode == 2) {
#pragma unroll
                            for (int j = 0; j < 4; ++j) { v0[j] = siluf_(v0[j]); v1[j] = siluf_(v1[j]); } }
                        u32x4 w; w.x = cvt_pk_bf16(v0[0], v0[1]); w.y = cvt_pk_bf16(v0[2], v0[3]); w.z = cvt_pk_bf16(v1[0], v1[1]); w.w = cvt_pk_bf16(v1[2], v1[3]);
                        *(u32x4*)((bf16_t*)d.base + rowoff + col) = w;
                    } else if ((DescF::MODES & 8) && d.mode == 3) {
                        if (col < d.ncol) { float* o = (float*)d.base + rowoff + col; *(f32x4*)o = v0 * d.scale; *(f32x4*)(o + 4) = v1 * d.scale; }
                    } else if ((DescF::MODES & 128) && d.mode == 7) {
                        typedef _Float16 h8 __attribute__((ext_vector_type(8)));
                        if (col < d.ncol) {
                        h8 hv; hv[0] = (_Float16)(v0[0] * d.scale); hv[1] = (_Float16)(v0[1] * d.scale); hv[2] = (_Float16)(v0[2] * d.scale); hv[3] = (_Float16)(v0[3] * d.scale);
                        hv[4] = (_Float16)(v1[0] * d.scale); hv[5] = (_Float16)(v1[1] * d.scale); hv[6] = (_Float16)(v1[2] * d.scale); hv[7] = (_Float16)(v1[3] * d.scale);
                        *(h8*)((_Float16*)d.base + rowoff + col) = hv; }
                    } else if constexpr ((DescF::MODES & 32) != 0) {
                        float* o = (float*)d.base + rowoff + col; const float* rs = d.res + rowoff + col;
                        const f32x4 a = *(const f32x4*)rs, b = *(const f32x4*)(rs + 4); *(f32x4*)o = a + v0; *(f32x4*)(o + 4) = b + v1;
                    }
                }
                if (m & 1) asm volatile("" ::: "memory");
            }
        }
    }
};

template <class Epi>
__device__ __forceinline__ void gemm_phase(LAS unsigned char* lds, const Gemm g, const StaticOrder& S, const Epi& E) {
    const int tid = threadIdx.x, wid = __builtin_amdgcn_readfirstlane(tid >> 6), lane = tid & 63, wr = wid >> 2, wc = wid & 3, fr = lane & 15, fq = lane >> 4;
    const int K = g.K, nt = K / BK;
    unsigned voffA[2], voffB[2];
#pragma unroll
    for (int i = 0; i < 2; ++i) { int R, C; stage_rc(tid * 16 + i * 8192, R, C); const int Rb = Epi::PERM ? ((R & ~31) + perm32(R & 31)) : R;
        voffA[i] = (unsigned)(R * g.lda + C) * 2u; voffB[i] = (unsigned)(Rb * g.ldb + C) * 2u; }
    const size_t kstep = (size_t)(BK * 2);
    const size_t hstepA = (size_t)HALF * g.lda * 2, hstepB = (size_t)HALF * g.ldb * 2;
    const size_t tstepA = 2 * hstepA, tstepB = 2 * hstepB;
    const unsigned ldsw = (unsigned)wid * 1024u;
    const int aoff = lds_byte(wr * 64 + fr, fq * 8), boff = lds_byte(wc * 32 + fr, fq * 8);
#define PG8_SA(b, h) (((b) * 2 + (h)) * HTB)
#define PG8_SB(b, h) ((4 + (b) * 2 + (h)) * HTB)
#define PG8_STAGE(bufoff, gbase, voff) do { _Pragma("unroll") for (int _i = 0; _i < 2; ++_i) \
        __builtin_amdgcn_global_load_lds((const unsigned*)((const char*)(gbase) + (voff)[_i]), (LAS unsigned*)(lds + (bufoff) + ldsw + _i * 8192), 16, 0, 0); } while (0)
#define PG8_LDA(dst, b, h) do { _Pragma("unroll") for (int m = 0; m < 4; ++m) _Pragma("unroll") for (int k = 0; k < 2; ++k) dst[m][k] = *(const LAS bf16x8*)(lds + PG8_SA(b, h) + aoff + m * 2048 + k * 1024); } while (0)
#define PG8_LDB(dst, b, h) do { _Pragma("unroll") for (int n = 0; n < 2; ++n) _Pragma("unroll") for (int k = 0; k < 2; ++k) dst[n][k] = *(const LAS bf16x8*)(lds + PG8_SB(b, h) + boff + n * 2048 + k * 1024); } while (0)
#define PG8_MMA(ai, bj, At, Bt) do { __builtin_amdgcn_s_setprio(1); _Pragma("unroll") for (int m = 0; m < 4; ++m) _Pragma("unroll") for (int n = 0; n < 2; ++n) _Pragma("unroll") for (int k = 0; k < 2; ++k) \
        acc[ai][bj][m][n] = __builtin_amdgcn_mfma_f32_16x16x32_bf16(Bt[n][k], At[m][k], acc[ai][bj][m][n], 0, 0, 0); __builtin_amdgcn_s_setprio(0); } while (0)
#define PG8_WAIT_V(n) asm volatile("s_waitcnt vmcnt(" #n ")" ::: "memory")
#define PG8_WAIT_L(n) asm volatile("s_waitcnt lgkmcnt(" #n ")" ::: "memory")
#define PG8_BAR __builtin_amdgcn_s_barrier()
#define PG8_SCHED __builtin_amdgcn_sched_barrier(0)
    Unit cur, nxt; int ui = 0;
    if (!S.next(0, cur)) return;
    f32x4 acc[2][2][4][2];
#pragma unroll
    for (int a = 0; a < 2; ++a)
#pragma unroll
        for (int b = 0; b < 2; ++b)
#pragma unroll
            for (int m = 0; m < 4; ++m)
#pragma unroll
                for (int n = 0; n < 2; ++n) acc[a][b][m][n] = (f32x4){0.f, 0.f, 0.f, 0.f};
    bf16x8 At[4][2], B0[2][2], B1[2][2];
    const char* cA = (const char*)g.A + (size_t)cur.pm * tstepA; const char* cB = (const char*)g.Bt + (size_t)cur.pn * tstepB;
    PG8_STAGE(PG8_SB(0, 0), cB, voffB); PG8_STAGE(PG8_SA(0, 0), cA, voffA); PG8_STAGE(PG8_SB(0, 1), cB + hstepB, voffB); PG8_STAGE(PG8_SA(0, 1), cA + hstepA, voffA);
    if (wr == 1) PG8_BAR;
    PG8_WAIT_V(4); PG8_BAR;
    PG8_STAGE(PG8_SB(1, 0), cB + kstep, voffB); PG8_STAGE(PG8_SA(1, 0), cA + kstep, voffA); PG8_STAGE(PG8_SB(1, 1), cB + hstepB + kstep, voffB);
    PG8_WAIT_V(6); PG8_BAR;
    for (;;) {
        const bool has_next = S.next(ui + 1, nxt);
        const char* nA = has_next ? (const char*)g.A + (size_t)nxt.pm * tstepA : cA; const char* nB = has_next ? (const char*)g.Bt + (size_t)nxt.pn * tstepB : cB;
#pragma unroll 1
        for (int t = 0; t < nt; t += 2) {
            const bool last = (t == nt - 2);
            const char* a1 = cA + (size_t)(t + 1) * kstep;
            const char* a2 = last ? nA : cA + (size_t)(t + 2) * kstep; const char* b2 = last ? nB : cB + (size_t)(t + 2) * kstep;
            const char* a3 = a2 + kstep; const char* b3 = b2 + kstep;
            PG8_LDB(B0, 0, 0); PG8_SCHED; PG8_LDA(At, 0, 0); PG8_STAGE(PG8_SA(1, 1), a1 + hstepA, voffA);
            PG8_WAIT_L(8); PG8_BAR; PG8_WAIT_L(0); PG8_MMA(0, 0, At, B0); PG8_BAR; PG8_SCHED;
            PG8_LDB(B1, 0, 1); PG8_STAGE(PG8_SB(0, 0), b2, voffB);
            PG8_BAR; PG8_WAIT_L(0); PG8_MMA(0, 1, At, B1); PG8_BAR;
            PG8_LDA(At, 0, 1); PG8_STAGE(PG8_SA(0, 0), a2, voffA);
            PG8_BAR; PG8_WAIT_L(0); PG8_MMA(1, 0, At, B0); PG8_BAR; PG8_SCHED;
            PG8_STAGE(PG8_SB(0, 1), b2 + hstepB, voffB);
            PG8_WAIT_V(6); PG8_BAR; PG8_MMA(1, 1, At, B1); PG8_BAR;
            PG8_LDB(B0, 1, 0); PG8_SCHED; PG8_LDA(At, 1, 0); PG8_STAGE(PG8_SA(0, 1), a2 + hstepA, voffA);
            PG8_WAIT_L(8); PG8_BAR; PG8_WAIT_L(0); PG8_MMA(0, 0, At, B0); PG8_BAR; PG8_SCHED;
            PG8_LDB(B1, 1, 1); PG8_STAGE(PG8_SB(1, 0), b3, voffB);
            PG8_BAR; PG8_WAIT_L(0); PG8_MMA(0, 1, At, B1); PG8_BAR;
            PG8_LDA(At, 1, 1); PG8_STAGE(PG8_SA(1, 0), a3, voffA);
            PG8_BAR; PG8_WAIT_L(0); PG8_MMA(1, 0, At, B0); PG8_BAR; PG8_SCHED;
            PG8_STAGE(PG8_SB(1, 1), b3 + hstepB, voffB);
            PG8_WAIT_V(6); PG8_BAR; PG8_MMA(1, 1, At, B1); PG8_BAR;
        }
        E(acc, cur, wr, wc, fr, fq);
        if (!has_next) break;
#pragma unroll
        for (int a = 0; a < 2; ++a)
#pragma unroll
            for (int b = 0; b < 2; ++b)
#pragma unroll
                for (int m = 0; m < 4; ++m)
#pragma unroll
                    for (int n = 0; n < 2; ++n) acc[a][b][m][n] = (f32x4){0.f, 0.f, 0.f, 0.f};
        cur = nxt; cA = nA; cB = nB; ++ui;
    }
    PG8_WAIT_V(0);
    if (wr == 0) PG8_BAR;
    PG8_BAR;
#undef PG8_SA
#undef PG8_SB
#undef PG8_STAGE
#undef PG8_LDA
#undef PG8_LDB
#undef PG8_MMA
#undef PG8_WAIT_V
#undef PG8_WAIT_L
#undef PG8_BAR
#undef PG8_SCHED
}
}

struct D1 { static constexpr int MODES = 1; unsigned char* ws;
    __device__ __forceinline__ void get(const pg8::Unit& u, pg8::Dst& d) const { const int sec = u.pn >> 2;
        d.base = ws + OFF_QB + (size_t)sec * (64 * MB) + ((size_t)u.pm * 256 * 1024 + (u.pn & 3) * 256) * 2; d.res = nullptr; d.ld = 1024; d.mode = 0; d.ncol = 256; d.scale = 1.f; } };
struct D2 { static constexpr int MODES = 7; unsigned char* ws;
    __device__ __forceinline__ void get(const pg8::Unit& u, pg8::Dst& d) const { const int sec = u.pn >> 2, cc = (u.pn & 3) * 256; d.res = nullptr; d.ncol = 256; d.scale = 1.f;
        if (sec < 3) { d.base = ws + OFF_QB + (size_t)sec * (64 * MB) + ((size_t)u.pm * 256 * 1024 + cc) * 2; d.ld = 1024; d.mode = sec == 0 ? 1 : (sec == 1 ? 2 : 0); }
        else { d.base = ws + OFF_Y + ((size_t)u.pm * 256 * 2048 + 1024 + cc) * 2; d.ld = 2048; d.mode = 2; } } };
struct D4 { static constexpr int MODES = 32; unsigned char* out; const float* x;
    __device__ __forceinline__ void get(const pg8::Unit& u, pg8::Dst& d) const { const size_t o = (size_t)u.pm * 256 * 1024 + u.pn * 256;
        d.base = out + o * 4; d.res = x + o; d.ld = 1024; d.mode = 5; d.ncol = 256; d.scale = 1.f; } };
struct D5 { static constexpr int MODES = 133; unsigned char* ws;
    __device__ __forceinline__ void get(const pg8::Unit& u, pg8::Dst& d) const { const int pn = u.pn; d.res = nullptr; d.ncol = 256; d.scale = 1.f;
        if (pn < 4) { d.base = ws + OFF_TMP + ((size_t)u.pm * 256 * 1024 + pn * 256) * 2; d.ld = 1024; d.mode = 0; }
        else if (pn == 4) { d.base = ws + OFF_CKVN + (size_t)u.pm * 256 * 256 * 2; d.ld = 256; d.mode = 0; }
        else if (pn == 5) { d.base = ws + OFF_QI + (size_t)u.pm * 256 * 256 * 2; d.ld = 256; d.mode = 7; d.scale = 0.125f; }
        else if (pn == 6) { d.base = ws + OFF_KI + (size_t)u.pm * 256 * 64 * 2; d.ld = 64; d.mode = 7; d.ncol = 64; }
        else { d.base = ws + OFF_Z + ((size_t)u.pm * 256 * 1024 + (pn - 7) * 256) * 2; d.ld = 1024; d.mode = 2; } } };
struct DK { static constexpr int MODES = 64; unsigned char* ws;
    __device__ __forceinline__ void get(const pg8::Unit& u, pg8::Dst& d) const {
        d.base = ws + OFF_RK + ((size_t)u.pm * 256 * 16 + u.pn * 4) * 2; d.res = nullptr; d.ld = 16; d.mode = 6; d.ncol = 256; d.scale = 1.f; } };
struct D8 { static constexpr int MODES = 32; unsigned char* out;
    __device__ __forceinline__ void get(const pg8::Unit& u, pg8::Dst& d) const { const size_t o = (size_t)u.pm * 256 * 1024 + u.pn * 256;
        d.base = out + o * 4; d.res = (const float*)out + o; d.ld = 1024; d.mode = 5; d.ncol = 256; d.scale = 1.f; } };
template <class DF>
__device__ __forceinline__ void fast_gemm(unsigned char* lds, const bf16_t* A, int lda, const bf16_t* Bt, int ldb, int N, int K, const DF& df) {
    pg8::Gemm g{A, lda, Bt, ldb, T, N, K}; pg8::StaticOrder S; S.init(T, N, (int)gridDim.x, (int)blockIdx.x);
    pg8::EpiGen<DF> E{df};
    pg8::gemm_phase(( LAS unsigned char*)lds, g, S, E);
}

__device__ __forceinline__ void tconv(const float* __restrict__ src, int ld, int col0, int ncols, int K, bf16_t* __restrict__ dst, float* tile  ) {
    const int nkt = K / 64, ntiles = nkt * (ncols / 64), tid = threadIdx.x;
    for (int id = blockIdx.x; id < ntiles; id += gridDim.x) {
        const int kt = id % nkt, nt = id / nkt;
#pragma unroll
        for (int j = 0; j < 8; ++j) { const int e = tid + 512 * j, kk = e >> 6, nn = e & 63; tile[kk * 65 + nn] = src[(size_t)(kt * 64 + kk) * ld + col0 + nt * 64 + nn]; }
        __syncthreads();
#pragma unroll
        for (int j = 0; j < 8; ++j) { const int e = tid + 512 * j, nn = e >> 6, kk = e & 63; dst[(size_t)(nt * 64 + nn) * K + kt * 64 + kk] = f2bf(tile[kk * 65 + nn]); }
        __syncthreads();
    }
}
template <int NE>
__device__ __forceinline__ void rmsnorm_rows(const float* __restrict__ src, const float* __restrict__ g, bf16_t* __restrict__ dst,
                             const float* __restrict__ Wx, int ldw, int col0, const float* __restrict__ bias, float scale, float* __restrict__ dstx, float* wl) {
    const int lane = threadIdx.x & 63, wave = threadIdx.x >> 6;
    __syncthreads();
    for (int i = threadIdx.x; i < NE * 1024; i += 512) { const int k = i / NE, e = i % NE; wl[e * 1024 + k] = Wx[(size_t)k * ldw + col0 + e]; }
    __syncthreads();
    for (int row = blockIdx.x * 8 + wave; row < T; row += gridDim.x * 8) {
        f32x4 v[4]; float ss = 0.f;
#pragma unroll
        for (int i = 0; i < 4; ++i) { v[i] = *(const f32x4*)(src + (size_t)row * 1024 + i * 256 + lane * 4); ss += v[i][0] * v[i][0] + v[i][1] * v[i][1] + v[i][2] * v[i][2] + v[i][3] * v[i][3]; }
        ss = wave_sum(ss);
        const float rstd = rsqrtf(ss * (1.0f / 1024.0f) + EPS);
        float ex[NE];
#pragma unroll
        for (int e = 0; e < NE; ++e) ex[e] = 0.f;
#pragma unroll
        for (int i = 0; i < 4; ++i) {
            const f32x4 gg = *(const f32x4*)(g + i * 256 + lane * 4);
            f32x4 y; y[0] = v[i][0] * rstd * gg[0]; y[1] = v[i][1] * rstd * gg[1]; y[2] = v[i][2] * rstd * gg[2]; y[3] = v[i][3] * rstd * gg[3];
            u32x2 w; w.x = pk2(y[0], y[1]); w.y = pk2(y[2], y[3]);
            *(u32x2*)(dst + (size_t)row * 1024 + i * 256 + lane * 4) = w;
#pragma unroll
            for (int e = 0; e < NE; ++e) { const f32x4 wv = *(const f32x4*)(wl + e * 1024 + i * 256 + lane * 4); ex[e] += y[0] * wv[0] + y[1] * wv[1] + y[2] * wv[2] + y[3] * wv[3]; }
        }
#pragma unroll
        for (int e = 0; e < NE; ++e) { const float s = wave_sum(ex[e]); if (lane == 0) dstx[(size_t)row * NE + e] = (s + (bias ? bias[e] : 0.f)) * scale; }
    }
}

__device__ __forceinline__ void phase_prep(const P& p, unsigned char* lds) {
    float* tile = (float*)lds; unsigned char* ws = p.ws;
    bf16_t* W0T = (bf16_t*)(ws + OFF_W0T);
    tconv(p.e_w_in, EIN, 0, 5120, 1024, W0T, tile);
    tconv(p.e_w_in, EIN, 6152, 1024, 1024, W0T + (size_t)6144 * 1024, tile);
    for (int g = 0; g < 4; ++g) tconv(p.e_w_pool + (size_t)g * 65536, 256, 0, 256, 256, (bf16_t*)(ws + OFF_WPT) + (size_t)g * 65536, tile);
    { bf16_t* WUB = (bf16_t*)(ws + OFF_WUB);
      for (size_t i = (size_t)blockIdx.x * 512 + threadIdx.x; i < (size_t)1024 * 256; i += (size_t)gridDim.x * 512) {
          const size_t k = i >> 8; const int c4 = (int)(i & 255) * 4; const f32x4 v = *(const f32x4*)(p.e_w_in + k * EIN + 5128 + c4);
          u32x2 o; o.x = pk2(v[0], v[1]); o.y = pk2(v[2], v[3]); *(u32x2*)(WUB + k * 1024 + c4) = o; } }
    tconv(p.e_w_out, 1024, 0, 1024, 2048, (bf16_t*)(ws + OFF_WO0T), tile);
    bf16_t* W1T = (bf16_t*)(ws + OFF_W1T);
    tconv(p.o_w_in, OIN, 0, 1600, 1024, W1T, tile);
    for (size_t i = (size_t)blockIdx.x * 512 + threadIdx.x; i < (size_t)192 * 1024; i += (size_t)gridDim.x * 512) W1T[(size_t)1600 * 1024 + i] = 0;
    tconv(p.o_w_in, OIN, 1604, 1024, 1024, W1T + (size_t)1792 * 1024, tile);
    {
        bf16_t* WUKP = (bf16_t*)(ws + OFF_WUKP); bf16_t* WQP = (bf16_t*)(ws + OFF_WQP);
        for (size_t i = (size_t)blockIdx.x * 512 + threadIdx.x; i < (size_t)1024 * 256; i += (size_t)gridDim.x * 512) {
            { const int n = (int)(i >> 8), k = (int)(i & 255), pn = n >> 8, rem = n & 255, bj = rem >> 7, wc = (rem >> 5) & 3, x = rem & 31;
              WUKP[i] = f2bf(p.o_w_uk[(size_t)k * 1024 + (4 * pn + wc) * 64 + 32 * bj + x]); }
            { const int d = (int)(i & 63), r = (int)((i >> 6) & 255), h = (int)(i >> 14);
              WQP[i] = f2bf(p.o_w_uk[(size_t)r * 1024 + h * 64 + d] * p.o_g_k[d] * 0.125f); }
        }
    }
    tconv(p.o_w_uv, 1024, 0, 1024, 256, (bf16_t*)(ws + OFF_WUVT), tile);
    tconv(p.o_w_out, 1024, 0, 1024, 1024, (bf16_t*)(ws + OFF_WO1T), tile);
    rmsnorm_rows<8>(p.x, p.e_norm, (bf16_t*)(ws + OFF_XN), p.e_w_in, EIN, 5120, p.e_b_if, 1.0f, (float*)(ws + OFF_GATES), (float*)lds);
}

__device__ __forceinline__ void phase_conv_scan(const P& p, unsigned char* lds) {
    unsigned char* ws = p.ws; const int tid = threadIdx.x;
    const float* GATES = (const float*)(ws + OFF_GATES);
    float *BQ = (float*)(ws + OFF_BQ), *IQ = (float*)(ws + OFF_IQ), *MT = (float*)(ws + OFF_MT), *CH = (float*)(ws + OFF_CH);
    {
        const int lane = tid & 63, wave = tid >> 6;
        for (int task = blockIdx.x * 8 + wave; task < 2048; task += gridDim.x * 8) {
            const int bh = task >> 8, c = task & 255, batch = bh >> 2, head = bh & 3; const size_t t = (size_t)batch * SEQ + c * 64 + lane;
            const float ig = GATES[t * 8 + head], f = GATES[t * 8 + 4 + head];
            float b = fminf(f, 0.f) - log1pf(__expf(-fabsf(f)));
#pragma unroll
            for (int o = 1; o < 64; o <<= 1) { const float y = __shfl_up(b, o); if (lane >= o) b += y; }
            float rm = ig - b;
#pragma unroll
            for (int o = 1; o < 64; o <<= 1) { const float y = __shfl_up(rm, o); if (lane >= o) rm = fmaxf(rm, y); }
            BQ[t * 4 + head] = b; IQ[t * 4 + head] = ig; MT[t * 4 + head] = rm;
            if (lane == 63) { CH[4096 + bh * 256 + c] = b; CH[bh * 256 + c] = b + rm; }
        }
    }
    const bf16_t* QB = (const bf16_t*)(ws + OFF_QB); const bf16_t* KB = (const bf16_t*)(ws + OFF_KB);
    bf16_t* Y = (bf16_t*)(ws + OFF_Y); bf16_t* KT = (bf16_t*)(ws + OFF_TMP);
    for (size_t it = (size_t)blockIdx.x * 512 + tid; it < (size_t)T * 256; it += (size_t)gridDim.x * 512) {
        const size_t t = it >> 8; const int c0 = (int)(it & 255) * 8, isk = c0 >= 1024, cc = c0 & 1023; const int s = (int)(t & (SEQ - 1));
        const bf16_t* src = isk ? KB : QB;
        float acc[8];
#pragma unroll
        for (int i = 0; i < 8; ++i) acc[i] = 0.f;
#pragma unroll
        for (int j = 0; j < 4; ++j) {
            if (s - 3 + j >= 0) {
                const u32x4 w = *(const u32x4*)(src + (t - 3 + j) * 1024 + cc);
                const f32x4 c0v = *(const f32x4*)(p.e_conv + j * 2048 + c0), c1v = *(const f32x4*)(p.e_conv + j * 2048 + c0 + 4);
                acc[0] += c0v[0] * bflo(w.x); acc[1] += c0v[1] * bfhi(w.x); acc[2] += c0v[2] * bflo(w.y); acc[3] += c0v[3] * bfhi(w.y);
                acc[4] += c1v[0] * bflo(w.z); acc[5] += c1v[1] * bfhi(w.z); acc[6] += c1v[2] * bflo(w.w); acc[7] += c1v[3] * bfhi(w.w);
            }
        }
        const float sc = isk ? 0.0625f : 1.0f;
        u32x4 o; o.x = pk2(siluf_(acc[0]) * sc, siluf_(acc[1]) * sc); o.y = pk2(siluf_(acc[2]) * sc, siluf_(acc[3]) * sc);
        o.z = pk2(siluf_(acc[4]) * sc, siluf_(acc[5]) * sc); o.w = pk2(siluf_(acc[6]) * sc, siluf_(acc[7]) * sc);
        if (isk) *(u32x4*)(KT + t * 1024 + cc) = o; else *(u32x4*)(Y + t * 2048 + 1024 + cc) = o;
    }
}

typedef float f32x16 __attribute__((ext_vector_type(16)));
constexpr int ML_RS = 528, ML_WS = 144;
__device__ __forceinline__ bf16x8 ml_tr8(const LAS unsigned char* a, int second_off) {
    const v4i16_t t0 = __builtin_amdgcn_ds_read_tr16_b64_v4i16((LAS v4i16_t*)a);
    const v4i16_t t1 = __builtin_amdgcn_ds_read_tr16_b64_v4i16((LAS v4i16_t*)(a + second_off));
    bf16x8 r; r[0] = t0[0]; r[1] = t0[1]; r[2] = t0[2]; r[3] = t0[3]; r[4] = t1[0]; r[5] = t1[1]; r[6] = t1[2]; r[7] = t1[3]; return r;
}
__device__ __forceinline__ void mlstm_chunk_scan(const float* CH, int bh, LAS float* sB, LAS float* sMp, LAS float* sMn) {
    const int tid = threadIdx.x;
    if (tid < 256) { sB[tid] = CH[4096 + bh * 256 + tid]; sMn[tid] = CH[bh * 256 + tid]; }
    __syncthreads();
    if (tid == 0) { float m = 0.f; for (int c = 0; c < 256; ++c) { const float g = sMn[c]; sMp[c] = m; m = fmaxf(sB[c] + m, g); sMn[c] = m; } }
    __syncthreads();
}
template <bool FULL>
__device__ __forceinline__ void mlstm_units(const P& p, unsigned char* lds_) {
    unsigned char* ws = p.ws; const int tid0 = threadIdx.x;
    const int w = __builtin_amdgcn_readfirstlane(tid0 >> 6);
    const bf16_t* Yq = (const bf16_t*)(ws + OFF_Y); bf16_t* Yo = (bf16_t*)(ws + OFF_Y);
    const bf16_t* KT = (const bf16_t*)(ws + OFF_TMP); const bf16_t* VB = (const bf16_t*)(ws + OFF_VB);
    float* ST = (float*)(ws + OFF_QB); float* NS = (float*)(ws + OFF_NS);
    const float *BQ = (const float*)(ws + OFF_BQ), *IQ = (const float*)(ws + OFF_IQ), *MT = (const float*)(ws + OFF_MT), *CH = (const float*)(ws + OFF_CH);
    LAS unsigned char* Qs = (LAS unsigned char*)lds_;
    LAS unsigned char* Ks = Qs + 64 * ML_RS;
    LAS unsigned char* Vs = Ks + 64 * ML_RS;
    LAS unsigned char* Wl = Vs + 64 * ML_RS;
    LAS float* sa = (LAS float*)(Wl + 64 * ML_WS);
    LAS float* sden = sa + 64; LAS float* ssw = sden + 64; LAS float* sf = ssw + 64; LAS float* sg = sf + 64; LAS float* nd = sg + 64; LAS float* rden = nd + 64; LAS float* ns = rden + 64;
    LAS float* cB = ns + 256; LAS float* cMp = cB + 256; LAS float* cMn = cMp + 256;
    for (int unit = blockIdx.x; unit < 256; unit += gridDim.x) {
        const int bh = unit >> 5, S = unit & 31, batch = bh >> 2, head = bh & 3;
        const int tid = tid0, lane = tid0 & 63, hh = lane >> 5;
        __syncthreads();
        mlstm_chunk_scan(CH, bh, cB, cMp, cMn);
        f32x16 st[8]; float nreg = 0.f;
        if (FULL) {
#pragma unroll
            for (int kt = 0; kt < 8; ++kt) {
                int lz = lane; asm volatile("" : "+v"(lz) :: "memory");
                const float* sp = ST + (size_t)unit * 65536 + 32 * w + (lz & 31) + (size_t)(32 * kt + 4 * (lz >> 5)) * 256;
#pragma unroll
                for (int r = 0; r < 16; ++r) st[kt][r] = sp[((r & 3) + 8 * (r >> 2)) * 256];
            }
            if (tid < 256) nreg = NS[unit * 256 + tid];
        } else {
#pragma unroll
            for (int kt = 0; kt < 8; ++kt)
#pragma unroll
                for (int r = 0; r < 16; ++r) st[kt][r] = 0.f;
        }
#pragma unroll 1
        for (int cc = 0; cc < 8; ++cc) {
            int tid = tid0; asm volatile("" : "+v"(tid));
            const int lane = tid & 63, l31 = lane & 31, hh = lane >> 5, fr = lane & 15, fq = lane >> 4;
            const int trow = 8 * hh + (fr >> 2), tcol = (16 * (fq & 1) + 4 * (fr & 3)) * 2;
            const int ch = S * 8 + cc; const size_t t0 = (size_t)batch * SEQ + ch * 64;
            const float mprev = cMp[ch], mnew = cMn[ch], blast = cB[ch];
            const float decay = __expf(blast + mprev - mnew);
            __syncthreads();
#pragma unroll
            for (int j = 0; j < 4; ++j) { const int e = tid + 512 * j, r = e >> 5, cg = e & 31;
                *(LAS u32x4*)(Ks + r * ML_RS + cg * 16) = *(const u32x4*)(KT + (t0 + r) * 1024 + head * 256 + cg * 8);
                *(LAS u32x4*)(Vs + r * ML_RS + cg * 16) = *(const u32x4*)(VB + (t0 + r) * 1024 + head * 256 + cg * 8);
                if (FULL) *(LAS u32x4*)(Qs + r * ML_RS + cg * 16) = *(const u32x4*)(Yq + (t0 + r) * 2048 + 1024 + head * 256 + cg * 8); }
            if (tid < 64) { const float bq = BQ[(t0 + tid) * 4 + head], iq = IQ[(t0 + tid) * 4 + head], mt = bq + fmaxf(mprev, MT[(t0 + tid) * 4 + head]);
                sa[tid] = __expf(bq + mprev - mt); sden[tid] = __expf(-mt); ssw[tid] = __expf(blast - bq + iq - mnew); sf[tid] = bq - mt; sg[tid] = iq - bq; }
            if (FULL && tid < 256) ns[tid] = nreg;
            __syncthreads();
            bf16x8 bv[4];
            if (!FULL) {
#pragma unroll
                for (int ks = 0; ks < 4; ++ks) bv[ks] = ml_tr8(Vs + (16 * ks + trow) * ML_RS + 64 * w + tcol, 4 * ML_RS);
            }
            if (FULL) {
                { const int tt = w >> 1;
#pragma unroll
                  for (int si = 0; si < 2; ++si) { const int ss = 2 * (w & 1) + si;
                    f32x4 acc = (f32x4){0.f, 0.f, 0.f, 0.f};
                    if (ss <= tt) {
#pragma unroll
                        for (int ks = 0; ks < 8; ++ks) { const bf16x8 a = *(const LAS bf16x8*)(Qs + (16 * tt + fr) * ML_RS + (32 * ks + 8 * fq) * 2), b = *(const LAS bf16x8*)(Ks + (16 * ss + fr) * ML_RS + (32 * ks + 8 * fq) * 2);
                            acc = __builtin_amdgcn_mfma_f32_16x16x32_bf16(a, b, acc, 0, 0, 0); } }
                    const int sidx = 16 * ss + fr; const float gs = sg[sidx];
#pragma unroll
                    for (int j = 0; j < 4; ++j) { const int tix = 16 * tt + 4 * fq + j; const float wv = (sidx <= tix) ? __expf(sf[tix] + gs) * acc[j] : 0.f;
                        *(LAS bf16_t*)(Wl + tix * ML_WS + sidx * 2) = f2bf(wv); } } }
#pragma unroll
                for (int i = 0; i < 8; ++i) { const int tix = 8 * w + i; const u32x2 qv = *(const LAS u32x2*)(Qs + tix * ML_RS + lane * 8); const f32x4 nv = *(const LAS f32x4*)(ns + lane * 4);
                    float part = bflo(qv.x) * nv[0] + bfhi(qv.x) * nv[1] + bflo(qv.y) * nv[2] + bfhi(qv.y) * nv[3]; part = wave_sum(part); if (lane == 0) nd[tix] = part; }
                __syncthreads();
                f32x16 acc[2];
#pragma unroll
                for (int t2 = 0; t2 < 2; ++t2) {
#pragma unroll
                    for (int r = 0; r < 16; ++r) acc[t2][r] = 0.f;
                }
#pragma unroll
                for (int kt = 0; kt < 8; ++kt) {
                    asm volatile("" ::: "memory");
#pragma unroll
                    for (int s2 = 0; s2 < 2; ++s2) {
                        u32x4 bw; bw.x = pg8::cvt_pk_bf16(st[kt][8 * s2 + 0], st[kt][8 * s2 + 1]); bw.y = pg8::cvt_pk_bf16(st[kt][8 * s2 + 2], st[kt][8 * s2 + 3]);
                        bw.z = pg8::cvt_pk_bf16(st[kt][8 * s2 + 4], st[kt][8 * s2 + 5]); bw.w = pg8::cvt_pk_bf16(st[kt][8 * s2 + 6], st[kt][8 * s2 + 7]);
                        const bf16x8 bfrag = __builtin_bit_cast(bf16x8, bw);
#pragma unroll
                        for (int t2 = 0; t2 < 2; ++t2) { const LAS unsigned char* qa = Qs + (32 * t2 + l31) * ML_RS + (32 * kt + 16 * s2 + 4 * hh) * 2;
                            const u32x2 lo = *(const LAS u32x2*)qa, hi = *(const LAS u32x2*)(qa + 16); u32x4 aw; aw.x = lo.x; aw.y = lo.y; aw.z = hi.x; aw.w = hi.y;
                            acc[t2] = __builtin_amdgcn_mfma_f32_32x32x16_bf16(__builtin_bit_cast(bf16x8, aw), bfrag, acc[t2], 0, 0, 0); }
                    }
                }
                asm volatile("" ::: "memory");
#pragma unroll
                for (int t2 = 0; t2 < 2; ++t2)
#pragma unroll
                    for (int r = 0; r < 16; ++r) acc[t2][r] *= sa[32 * t2 + (r & 3) + 8 * (r >> 2) + 4 * hh];
#pragma unroll
                for (int ks = 0; ks < 4; ++ks) bv[ks] = ml_tr8(Vs + (16 * ks + trow) * ML_RS + 64 * w + tcol, 4 * ML_RS);
#pragma unroll
                for (int ks = 0; ks < 4; ++ks)
#pragma unroll
                    for (int t2 = 0; t2 < 2; ++t2) { const bf16x8 a = *(const LAS bf16x8*)(Wl + (32 * t2 + l31) * ML_WS + (16 * ks + 8 * hh) * 2);
                        acc[t2] = __builtin_amdgcn_mfma_f32_32x32x16_bf16(a, bv[ks], acc[t2], 0, 0, 0); }
#pragma unroll
                for (int i = 0; i < 8; ++i) { const int tix = 8 * w + i; float rs = bf2f(*(const LAS bf16_t*)(Wl + tix * ML_WS + lane * 2)); rs = wave_sum(rs);
                    if (lane == 0) { const float nq = sa[tix] * nd[tix] + rs; rden[tix] = 1.0f / fmaxf(fabsf(nq), sden[tix]); } }
                __syncthreads();
                bf16_t* yo = Yo + t0 * 2048 + head * 256 + 32 * w + l31;
#pragma unroll
                for (int t2 = 0; t2 < 2; ++t2)
#pragma unroll
                    for (int r = 0; r < 16; ++r) { const int tix = 32 * t2 + (r & 3) + 8 * (r >> 2) + 4 * hh; yo[(size_t)tix * 2048] = f2bf(acc[t2][r] * rden[tix]); }
            }
#pragma unroll
            for (int kt = 0; kt < 8; ++kt) st[kt] *= decay;
#pragma unroll
            for (int ks = 0; ks < 4; ++ks) {
                const u32x4 raw = __builtin_bit_cast(u32x4, bv[ks]); const LAS float* sw8 = ssw + 16 * ks + 8 * hh;
                u32x4 sc; sc.x = pg8::cvt_pk_bf16(bflo(raw.x) * sw8[0], bfhi(raw.x) * sw8[1]); sc.y = pg8::cvt_pk_bf16(bflo(raw.y) * sw8[2], bfhi(raw.y) * sw8[3]);
                sc.z = pg8::cvt_pk_bf16(bflo(raw.z) * sw8[4], bfhi(raw.z) * sw8[5]); sc.w = pg8::cvt_pk_bf16(bflo(raw.w) * sw8[6], bfhi(raw.w) * sw8[7]);
                const bf16x8 bs = __builtin_bit_cast(bf16x8, sc);
#pragma unroll
                for (int kt = 0; kt < 8; ++kt) { if ((kt & 3) == 0) asm volatile("" ::: "memory");
                    const bf16x8 a = ml_tr8(Ks + (16 * ks + trow) * ML_RS + 64 * kt + tcol, 4 * ML_RS);
                    st[kt] = __builtin_amdgcn_mfma_f32_32x32x16_bf16(a, bs, st[kt], 0, 0, 0); }
            }
            if (tid < 256) { float nacc = 0.f;
#pragma unroll 8
                for (int s2 = 0; s2 < 64; ++s2) nacc += ssw[s2] * bf2f(*(const LAS bf16_t*)(Ks + s2 * ML_RS + tid * 2));
                nreg = decay * nreg + nacc; }
        }
        if (!FULL) {
#pragma unroll
            for (int kt = 0; kt < 8; ++kt) {
                int lz = lane; asm volatile("" : "+v"(lz) :: "memory");
                float* sp = ST + (size_t)unit * 65536 + 32 * w + (lz & 31) + (size_t)(32 * kt + 4 * (lz >> 5)) * 256;
#pragma unroll
                for (int r = 0; r < 16; ++r) sp[((r & 3) + 8 * (r >> 2)) * 256] = st[kt][r];
            }
            if (tid < 256) NS[unit * 256 + tid] = nreg;
        }
    }
}
__device__ __forceinline__ void phase_mlstm_scan(const P& p, unsigned char* lds_) {
    unsigned char* ws = p.ws; const int tid = threadIdx.x;
    float* ST = (float*)(ws + OFF_QB); float* NS = (float*)(ws + OFF_NS); const float* CH = (const float*)(ws + OFF_CH);
    LAS float* DS = (LAS float*)lds_;
    LAS float* cB = DS + 256; LAS float* cMp = cB + 256; LAS float* cMn = cMp + 256;
    for (int bh = 0; bh < 8; ++bh) {
        __syncthreads();
        mlstm_chunk_scan(CH, bh, cB, cMp, cMn);
        if (tid < 32) { float d = 1.f; for (int c = 0; c < 8; ++c) { const int ch = tid * 8 + c; d *= __expf(cB[ch] + cMp[ch] - cMn[ch]); } DS[bh * 32 + tid] = d; }
    }
    __syncthreads();
    const int per = 65536 + 256;
    for (int it = blockIdx.x * 512 + tid; it < 8 * per; it += gridDim.x * 512) {
        const int bh = it / per, e = it - bh * per;
        float* base; size_t stride;
        if (e < 65536) { base = ST + (size_t)bh * 32 * 65536 + e; stride = 65536; } else { base = NS + (size_t)bh * 32 * 256 + (e - 65536); stride = 256; }
        float carry = 0.f;
#pragma unroll 8
        for (int S = 0; S < 32; ++S) { const float tmp = base[S * stride]; base[S * stride] = carry; carry = DS[bh * 32 + S] * carry + tmp; }
    }
}

__device__ __forceinline__ void phase_ya_pool(const P& p) {
    unsigned char* ws = p.ws; const int tid = threadIdx.x, lane = tid & 63, wave = tid >> 6;
    bf16_t* Y = (bf16_t*)(ws + OFF_Y); const bf16_t* O = (const bf16_t*)(ws + OFF_QB); const bf16_t* ZA = (const bf16_t*)(ws + OFF_KB);
    for (int it = blockIdx.x * 8 + wave; it < T * 4; it += gridDim.x * 8) {
        const size_t t = (size_t)(it >> 2); const int head = it & 3, c = head * 256 + lane * 4;
        const u32x2 hw = *(const u32x2*)(Y + t * 2048 + c), ow = *(const u32x2*)(O + t * 1024 + c), zw = *(const u32x2*)(ZA + t * 1024 + c);
        float v[4] = {bflo(hw.x) * bflo(ow.x), bfhi(hw.x) * bfhi(ow.x), bflo(hw.y) * bflo(ow.y), bfhi(hw.y) * bfhi(ow.y)};
        float ss = wave_sum(v[0] * v[0] + v[1] * v[1] + v[2] * v[2] + v[3] * v[3]);
        const float rstd = rsqrtf(ss * (1.0f / 256.0f) + EPS);
        const f32x4 g = *(const f32x4*)(p.e_g_head + c);
        u32x2 o; o.x = pk2(v[0] * rstd * g[0] * bflo(zw.x), v[1] * rstd * g[1] * bfhi(zw.x)); o.y = pk2(v[2] * rstd * g[2] * bflo(zw.y), v[3] * rstd * g[3] * bfhi(zw.y));
        *(u32x2*)(Y + t * 2048 + c) = o;
    }
    const bf16_t* U = (const bf16_t*)(ws + OFF_VB);
    for (size_t it = (size_t)blockIdx.x * 512 + tid; it < (size_t)T * 128; it += (size_t)gridDim.x * 512) {
        const size_t t = it >> 7; const int c0 = (int)(it & 127) * 8, g = c0 >> 8, win = 2 << g, s = (int)(t & (SEQ - 1)); const int cnt = (s + 1 < win) ? s + 1 : win;
        float acc[8], self[8];
#pragma unroll
        for (int i = 0; i < 8; ++i) { acc[i] = 0.f; self[i] = 0.f; }
        for (int j = 0; j < cnt; ++j) { const u32x4 w = *(const u32x4*)(U + (t - j) * 1024 + c0);
            const float f[8] = {bflo(w.x), bfhi(w.x), bflo(w.y), bfhi(w.y), bflo(w.z), bfhi(w.z), bflo(w.w), bfhi(w.w)};
#pragma unroll
            for (int i = 0; i < 8; ++i) { acc[i] += f[i]; if (j == 0) self[i] = f[i]; } }
        const float inv = 1.0f / (float)cnt;
        bf16_t* yp = Y + t * 2048 + 1024 + c0; const u32x4 z = *(const u32x4*)yp;
        const float zf[8] = {bflo(z.x), bfhi(z.x), bflo(z.y), bfhi(z.y), bflo(z.z), bfhi(z.z), bflo(z.w), bfhi(z.w)};
        const f32x4 s0 = *(const f32x4*)(p.e_s_pool + c0), s1 = *(const f32x4*)(p.e_s_pool + c0 + 4);
        float o[8];
#pragma unroll
        for (int i = 0; i < 8; ++i) o[i] = (acc[i] * inv - self[i]) * (i < 4 ? s0[i] : s1[i - 4]) * zf[i];
        u32x4 ow; ow.x = pk2(o[0], o[1]); ow.y = pk2(o[2], o[3]); ow.z = pk2(o[4], o[5]); ow.w = pk2(o[6], o[7]);
        *(u32x4*)yp = ow;
    }
}

__device__ __forceinline__ void headnorm64(bf16_t* X, const float* g) {
    const int lane = threadIdx.x & 63, wave = threadIdx.x >> 6;
    for (int t = blockIdx.x * 8 + wave; t < T; t += gridDim.x * 8) {
        bf16_t* r = X + (size_t)t * 1024 + lane * 16;
        const u32x4 a = *(const u32x4*)r, b = *(const u32x4*)(r + 8);
        float f[16] = {bflo(a.x), bfhi(a.x), bflo(a.y), bfhi(a.y), bflo(a.z), bfhi(a.z), bflo(a.w), bfhi(a.w), bflo(b.x), bfhi(b.x), bflo(b.y), bfhi(b.y), bflo(b.z), bfhi(b.z), bflo(b.w), bfhi(b.w)};
        float ss = 0.f;
#pragma unroll
        for (int i = 0; i < 16; ++i) ss += f[i] * f[i];
        ss += __shfl_xor(ss, 1); ss += __shfl_xor(ss, 2);
        const float rstd = rsqrtf(ss * (1.0f / 64.0f) + EPS);
        const float* gg = g + (lane & 3) * 16;
#pragma unroll
        for (int i = 0; i < 16; ++i) f[i] = f[i] * rstd * gg[i];
        u32x4 oa, ob; oa.x = pk2(f[0], f[1]); oa.y = pk2(f[2], f[3]); oa.z = pk2(f[4], f[5]); oa.w = pk2(f[6], f[7]);
        ob.x = pk2(f[8], f[9]); ob.y = pk2(f[10], f[11]); ob.z = pk2(f[12], f[13]); ob.w = pk2(f[14], f[15]);
        *(u32x4*)r = oa; *(u32x4*)(r + 8) = ob;
    }
}
__device__ __forceinline__ void phase_qnorm_ckvnorm(const P& p) {
    unsigned char* ws = p.ws; const int lane = threadIdx.x & 63, wave = threadIdx.x >> 6;
    headnorm64((bf16_t*)(ws + OFF_TMP), p.o_g_q);
    bf16_t* CKVN = (bf16_t*)(ws + OFF_CKVN);
    for (int t = blockIdx.x * 8 + wave; t < T; t += gridDim.x * 8) {
        const u32x2 w = *(const u32x2*)(CKVN + (size_t)t * 256 + lane * 4);
        const float v[4] = {bflo(w.x), bfhi(w.x), bflo(w.y), bfhi(w.y)};
        const float ss = wave_sum(v[0] * v[0] + v[1] * v[1] + v[2] * v[2] + v[3] * v[3]);
        const float rstd = rsqrtf(ss * (1.0f / 256.0f) + EPS);
        const f32x4 g = *(const f32x4*)(p.o_g_kv + lane * 4);
        u32x2 o; o.x = pk2(v[0] * rstd * g[0], v[1] * rstd * g[1]); o.y = pk2(v[2] * rstd * g[2], v[3] * rstd * g[3]);
        *(u32x2*)(CKVN + (size_t)t * 256 + lane * 4) = o;
    }
}

__device__ __forceinline__ unsigned okey(float s) { if (s == 0.f) s = 0.f; const unsigned u = __float_as_uint(s); return (u & 0x80000000u) ? ~u : (u | 0x80000000u); }

__device__ __forceinline__ void indexer_slow_query(const P& p, unsigned char* lds, size_t t) {
    unsigned char* ws = p.ws; const int tid = threadIdx.x, lane = tid & 63, wave = tid >> 6;
    const _Float16* QI = (const _Float16*)(ws + OFF_QI); const _Float16* KI = (const _Float16*)(ws + OFF_KI); const float* WI = (const float*)(ws + OFF_WI);
    unsigned short* IDX = (unsigned short*)(ws + OFF_IDX);
    unsigned* sc = (unsigned*)lds; unsigned* hist = sc + 16384; float* qs = (float*)(hist + 256); unsigned* misc = (unsigned*)(qs + 256); unsigned* wsum = misc + 16;
    const int batch = (int)(t >> 14), pos = (int)(t & (SEQ - 1)), n = pos + 1;
    __syncthreads();
    if (tid < 256) qs[tid] = (float)QI[t * 256 + tid];
    const float w0 = WI[t * 4 + 0], w1 = WI[t * 4 + 1], w2 = WI[t * 4 + 2], w3 = WI[t * 4 + 3];
    __syncthreads();
    const _Float16* kbase = KI + (size_t)batch * SEQ * 64;
    for (int s = tid; s < n; s += 512) {
        asm volatile("" ::: "memory");
        typedef _Float16 h8 __attribute__((ext_vector_type(8)));
        const h8* kr = (const h8*)(kbase + (size_t)s * 64);
        float d0 = 0.f, d1 = 0.f, d2 = 0.f, d3 = 0.f;
#pragma unroll
        for (int j = 0; j < 8; ++j) { const h8 kv = kr[j];
#pragma unroll
            for (int e = 0; e < 8; ++e) { const int d = j * 8 + e; const float kf = (float)kv[e]; d0 += qs[d] * kf; d1 += qs[64 + d] * kf; d2 += qs[128 + d] * kf; d3 += qs[192 + d] * kf; } }
        float score = w0 * fmaxf(d0, 0.f); score = fmaf(w1, fmaxf(d1, 0.f), score); score = fmaf(w2, fmaxf(d2, 0.f), score); score = fmaf(w3, fmaxf(d3, 0.f), score);
        sc[s] = okey(score);
    }
    unsigned prefix = 0, krem = 256;
    for (int pass = 0; pass < 4; ++pass) {
        const int shift = 24 - 8 * pass;
        __syncthreads();
        if (tid < 256) hist[tid] = 0;
        __syncthreads();
        for (int s = tid; s < n; s += 512) { const unsigned k = sc[s]; if (pass == 0 || (k >> (shift + 8)) == prefix) atomicAdd(&hist[(k >> shift) & 255u], 1u); }
        __syncthreads();
        if (tid == 0) { unsigned cum = 0; int bin = 255; for (; bin > 0; --bin) { const unsigned c = hist[bin]; if (cum + c >= krem) break; cum += c; } misc[0] = (unsigned)bin; misc[1] = krem - cum; }
        __syncthreads();
        prefix = (prefix << 8) | misc[0]; krem = misc[1];
    }
    const unsigned ngt_total = 256u - krem;
    unsigned lg = 0, le = 0; const int s0 = tid * 32;
    for (int s = s0; s < s0 + 32 && s < n; ++s) { const unsigned k = sc[s]; lg += (k > prefix); le += (k == prefix); }
    unsigned pk = lg | (le << 16), incl = pk;
#pragma unroll
    for (int o = 1; o < 64; o <<= 1) { const unsigned y = __shfl_up(incl, o); if (lane >= o) incl += y; }
    if (lane == 63) wsum[wave] = incl;
    __syncthreads();
    unsigned base = 0;
    for (int w = 0; w < wave; ++w) base += wsum[w];
    const unsigned excl = base + incl - pk; unsigned bg = excl & 0xffffu, be = excl >> 16;
    for (int s = s0; s < s0 + 32 && s < n; ++s) { const unsigned k = sc[s];
        if (k > prefix) { IDX[t * 256 + bg] = (unsigned short)s; ++bg; }
        else if (k == prefix) { if (be < krem) IDX[t * 256 + ngt_total + be] = (unsigned short)s; ++be; } }
    __syncthreads();
}

typedef _Float16 half8 __attribute__((ext_vector_type(8)));
constexpr int IX_CAP = 1024, IX_ZBIN = 1024;
__device__ __forceinline__ unsigned ix_key(const f32x4 a, const f32x4 w) {
    const float r0 = __int_as_float(max(__float_as_int(a[0]), 0)), r1 = __int_as_float(max(__float_as_int(a[1]), 0));
    const float r2 = __int_as_float(max(__float_as_int(a[2]), 0)), r3 = __int_as_float(max(__float_as_int(a[3]), 0));
    float s = w[0] * r0; s = fmaf(w[1], r1, s); s = fmaf(w[2], r2, s); s = fmaf(w[3], r3, s);
    unsigned u = __float_as_uint(s); u = (u == 0x80000000u) ? 0u : u;
    return u ^ ((unsigned)((int)u >> 31) | 0x80000000u);
}
#define LDS_ADD(ptr, v) __hip_atomic_fetch_add((ptr), (v), __ATOMIC_RELAXED, __HIP_MEMORY_SCOPE_WORKGROUP)
__device__ __forceinline__ void phase_indexer(const P& p, unsigned char* lds) {
    unsigned char* ws = p.ws; const int tid = threadIdx.x, lane = tid & 63, kl = lane & 15, g = lane >> 4;
    const int wave = __builtin_amdgcn_readfirstlane(tid >> 6);
    const _Float16* QI = (const _Float16*)(ws + OFF_QI); const _Float16* KI = (const _Float16*)(ws + OFF_KI); const float* WI = (const float*)(ws + OFF_WI);
    unsigned short* IDX = (unsigned short*)(ws + OFF_IDX); int* CNT = (int*)(ws + OFF_CNT);
    LAS unsigned* hist = (LAS unsigned*)lds;
    LAS unsigned* zc = hist + 16 * 2048;
    LAS unsigned* zpre = zc + 128;
    LAS int* qTbin = (LAS int*)(zpre + 128);
    LAS int* qCab = qTbin + 16; LAS int* qCb = qCab + 16; LAS unsigned* qNgt = (LAS unsigned*)(qCb + 16); LAS unsigned* qNcand = qNgt + 16; LAS int* qOvf = (LAS int*)(qNcand + 16);
    LAS unsigned* ovl = (LAS unsigned*)(lds + 132 * 1024);
    LAS unsigned* h2 = (LAS unsigned*)(lds + 133 * 1024 + wave * 1536);
    LAS unsigned long long* l2 = (LAS unsigned long long*)(h2 + 256);
    if (tid == 0) ovl[0] = 0u;
    const int G = gridDim.x, nround = (T / 16) / G;
#pragma unroll 1
    for (int i = 0; i < nround; ++i) {
        const int tix = (i & 1) ? i * G + (G - 1 - (int)blockIdx.x) : i * G + (int)blockIdx.x;
        const int batch = tix & 1, tb = tix >> 1, p0 = tb * 16; const size_t t0 = (size_t)batch * SEQ + p0;
        __syncthreads();
        if (p0 + 16 <= 256) {
#pragma unroll
            for (int j = 0; j < 8; ++j) { const int e = tid + 512 * j, q = e >> 8, jj = e & 255; IDX[(t0 + q) * 256 + jj] = (unsigned short)(jj <= p0 + q ? jj : 0); }
            if (tid < 16) CNT[t0 + tid] = p0 + tid + 1;
            continue;
        }
#pragma unroll
        for (int j = 0; j < 16; ++j) ((LAS u32x4*)hist)[tid + 512 * j] = (u32x4){0u, 0u, 0u, 0u};
        if (tid < 256) zc[tid] = 0u;
        if (tid < 16) { qNgt[tid] = 0u; qNcand[tid] = 0u; qOvf[tid] = 0; }
        half8 af[4][2]; f32x4 wv[4];
#pragma unroll
        for (int rt = 0; rt < 4; ++rt) {
#pragma unroll
            for (int ks = 0; ks < 2; ++ks) af[rt][ks] = *(const half8*)(QI + (t0 + 4 * rt + (kl >> 2)) * 256 + (kl & 3) * 64 + 32 * ks + 8 * g);
            wv[rt] = *(const f32x4*)(WI + (t0 + 4 * rt + g) * 4);
        }
        __syncthreads();
        const int nblk = tb + 1, L = (nblk + 7) >> 3, b0 = wave * L, b1 = (b0 + L < nblk) ? b0 + L : nblk;
        const _Float16* kb = KI + (size_t)batch * SEQ * 64 + kl * 64 + 8 * g;
        LAS unsigned* hg = hist + g * 4 * 2048;
        {
            unsigned zcnt[4] = {0u, 0u, 0u, 0u};
            half8 k0 = (half8){0, 0, 0, 0, 0, 0, 0, 0}, k1 = k0;
            if (b0 < b1) { k0 = *(const half8*)(kb + (size_t)b0 * 1024); k1 = *(const half8*)(kb + (size_t)b0 * 1024 + 32); }
#pragma unroll 1
            for (int b = b0; b < b1; ++b) {
                const int bn = (b + 1 < b1) ? b + 1 : b; const int s = b * 16 + kl;
                const half8 n0 = *(const half8*)(kb + (size_t)bn * 1024), n1 = *(const half8*)(kb + (size_t)bn * 1024 + 32);
#pragma unroll
                for (int rt = 0; rt < 4; ++rt) {
                    f32x4 acc = __builtin_amdgcn_mfma_f32_16x16x32_f16(af[rt][0], k0, (f32x4){0.f, 0.f, 0.f, 0.f}, 0, 0, 0);
                    acc = __builtin_amdgcn_mfma_f32_16x16x32_f16(af[rt][1], k1, acc, 0, 0, 0);
                    const unsigned key = ix_key(acc, wv[rt]);
                    if (s <= p0 + 4 * rt + g) { LDS_ADD(hg + rt * 2048 + (key >> 21), 1u); zcnt[rt] += (key == 0x80000000u) ? 1u : 0u; }
                }
                k0 = n0; k1 = n1;
            }
#pragma unroll
            for (int rt = 0; rt < 4; ++rt) if (zcnt[rt]) LDS_ADD(zc + (g * 4 + rt) * 8 + wave, zcnt[rt]);
        }
        __syncthreads();
#pragma unroll 1
        for (int qq = 0; qq < 2; ++qq) {
            const int q = 2 * wave + qq; const LAS unsigned* h = hist + q * 2048;
            unsigned cs = 0; const int top = 2047 - 32 * lane;
            for (int ii = 0; ii < 32; ++ii) cs += h[top - ((ii + lane) & 31)];
            unsigned incl = cs;
#pragma unroll
            for (int o = 1; o < 64; o <<= 1) { const unsigned y = __shfl_up(incl, o); if (lane >= o) incl += y; }
            const unsigned long long m = __ballot(incl >= 256u);
            const int Ls = m ? (__ffsll((long long)m) - 1) : 63;
            unsigned cabv = __shfl(incl - cs, Ls), cbv = 0; int tbin = 0; bool found = false;
            for (int ii = 0; ii < 32; ++ii) { const unsigned c = h[2047 - 32 * Ls - ii]; if (!found && cabv + c >= 256u) { tbin = 2047 - 32 * Ls - ii; cbv = c; found = true; } if (!found) cabv += c; }
            if (lane == 0) { qTbin[q] = tbin; qCab[q] = (int)cabv; qCb[q] = (int)cbv; if (tbin != IX_ZBIN && cbv > (unsigned)IX_CAP) qOvf[q] = 1; }
            { unsigned v = lane < 8 ? zc[q * 8 + lane] : 0u, inc = v;
#pragma unroll
              for (int o = 1; o < 8; o <<= 1) { const unsigned y = __shfl_up(inc, o); if (lane >= o) inc += y; }
              if (lane < 8) zpre[q * 8 + lane] = inc - v; }
        }
        __syncthreads();
        {
            int tbn[4], cab[4], rr[4]; unsigned zrun[4];
#pragma unroll
            for (int rt = 0; rt < 4; ++rt) { const int q = g * 4 + rt; tbn[rt] = qOvf[q] ? 4096 : qTbin[q]; cab[rt] = qCab[q]; rr[rt] = 256 - cab[rt]; zrun[rt] = zpre[q * 8 + wave]; }
            half8 k0 = (half8){0, 0, 0, 0, 0, 0, 0, 0}, k1 = k0;
            if (b0 < b1) { k0 = *(const half8*)(kb + (size_t)b0 * 1024); k1 = *(const half8*)(kb + (size_t)b0 * 1024 + 32); }
#pragma unroll 1
            for (int b = b0; b < b1; ++b) {
                const int bn = (b + 1 < b1) ? b + 1 : b; const int s = b * 16 + kl;
                const half8 n0 = *(const half8*)(kb + (size_t)bn * 1024), n1 = *(const half8*)(kb + (size_t)bn * 1024 + 32);
                unsigned key[4]; bool sel[4], inb[4]; unsigned pos[4];
#pragma unroll
                for (int rt = 0; rt < 4; ++rt) {
                    f32x4 acc = __builtin_amdgcn_mfma_f32_16x16x32_f16(af[rt][0], k0, (f32x4){0.f, 0.f, 0.f, 0.f}, 0, 0, 0);
                    acc = __builtin_amdgcn_mfma_f32_16x16x32_f16(af[rt][1], k1, acc, 0, 0, 0);
                    key[rt] = ix_key(acc, wv[rt]); const int bin = (int)(key[rt] >> 21);
                    const bool valid = s <= p0 + 4 * rt + g;
                    sel[rt] = valid && bin > tbn[rt]; inb[rt] = valid && bin == tbn[rt];
                }
#pragma unroll
                for (int rt = 0; rt < 4; ++rt) { const int qs = g * 4 + rt; const bool cand = inb[rt] && tbn[rt] != IX_ZBIN;
                    LAS unsigned* tgt = sel[rt] ? (qNgt + qs) : (cand ? (qNcand + qs) : (zc + lane));
                    pos[rt] = LDS_ADD(tgt, (sel[rt] || cand) ? 1u : 0u); }
#pragma unroll
                for (int rt = 0; rt < 4; ++rt) { const int qs = g * 4 + rt;
                    if (__builtin_expect(tbn[rt] == IX_ZBIN, 0)) {
                        const unsigned long long zm = __ballot(inb[rt]);
                        const unsigned gm = (unsigned)(zm >> (16 * g)) & 0xffffu;
                        if (inb[rt] && key[rt] != 0x80000000u) qOvf[qs] = 1;
                        if (inb[rt]) { const unsigned pz = zrun[rt] + __popc(gm & ((1u << kl) - 1u)); if ((int)pz < rr[rt]) IDX[(t0 + 4 * rt + g) * 256 + cab[rt] + pz] = (unsigned short)s; }
                        zrun[rt] += __popc(gm);
                    } else if (inb[rt]) { if (pos[rt] < (unsigned)IX_CAP) ((LAS unsigned long long*)(lds + qs * 8192))[pos[rt]] = ((unsigned long long)key[rt] << 16) | (unsigned long long)(0xffffu - (unsigned)s); }
                    if (sel[rt]) IDX[(t0 + 4 * rt + g) * 256 + pos[rt]] = (unsigned short)s;
                }
                k0 = n0; k1 = n1;
            }
        }
        __syncthreads();
#pragma unroll 1
        for (int qq = 0; qq < 2; ++qq) {
            const int qs = 2 * wave + qq; const int tbin = qTbin[qs], n = qCb[qs], cabq = qCab[qs], r = 256 - cabq;
            if (tbin == IX_ZBIN || qOvf[qs]) continue;
            const LAS unsigned long long* cd = (const LAS unsigned long long*)(lds + qs * 8192);
            unsigned short* irow = IDX + (t0 + 4 * (qs & 3) + (qs >> 2)) * 256 + cabq;
            if (r >= n) { for (int c = lane; c < n; c += 64) irow[c] = (unsigned short)(0xffffu - (unsigned)(cd[c] & 0xffffull)); continue; }
#pragma unroll
            for (int j = 0; j < 4; ++j) h2[lane + 64 * j] = 0u;
            for (int c = lane; c < n; c += 64) LDS_ADD(h2 + ((unsigned)(cd[c] >> 29) & 255u), 1u);
            const unsigned cs = h2[255 - 4 * lane] + h2[254 - 4 * lane] + h2[253 - 4 * lane] + h2[252 - 4 * lane];
            unsigned incl = cs;
#pragma unroll
            for (int o = 1; o < 64; o <<= 1) { const unsigned y = __shfl_up(incl, o); if (lane >= o) incl += y; }
            const unsigned long long m = __ballot(incl >= (unsigned)r);
            const int Ls = m ? (__ffsll((long long)m) - 1) : 63;
            unsigned above = __shfl(incl - cs, Ls), c2 = 0; int T2 = 0; bool found = false;
#pragma unroll
            for (int ii = 0; ii < 4; ++ii) { const unsigned c = h2[255 - 4 * Ls - ii]; if (!found && above + c >= (unsigned)r) { T2 = 255 - 4 * Ls - ii; c2 = c; found = true; } if (!found) above += c; }
            const int r2 = r - (int)above;
            asm volatile("" ::: "memory");
            if (lane == 0) { h2[0] = 0u; h2[1] = 0u; }
            asm volatile("" ::: "memory");
            for (int c = lane; c < n; c += 64) { const unsigned long long v = cd[c]; const int sub = (int)((unsigned)(v >> 29) & 255u);
                if (sub > T2) { const unsigned pos = LDS_ADD(h2 + 0, 1u); irow[pos] = (unsigned short)(0xffffu - (unsigned)(v & 0xffffull)); }
                else if (sub == T2) { const unsigned pos = LDS_ADD(h2 + 1, 1u); if (pos < 64u) l2[pos] = v; } }
            asm volatile("" ::: "memory");
            if (c2 <= 64u) {
                const unsigned long long mine = (unsigned)lane < c2 ? l2[lane] : ~0ull; int rank = 0;
                for (unsigned j = 0; j < c2; ++j) rank += (l2[j] > mine) ? 1 : 0;
                if ((unsigned)lane < c2 && rank < r2) irow[above + rank] = (unsigned short)(0xffffu - (unsigned)(mine & 0xffffull));
            } else {
                for (int c0 = 0; c0 < n; c0 += 64) {
                    const int c = c0 + lane; const unsigned long long mine = c < n ? cd[c] : ~0ull; const bool have = c < n && (int)((unsigned)(mine >> 29) & 255u) == T2;
                    int rank = 0;
                    for (int j = 0; j < n; ++j) { const unsigned long long cj = cd[j]; rank += ((int)((unsigned)(cj >> 29) & 255u) == T2 && cj > mine) ? 1 : 0; }
                    if (have && rank < r2) irow[above + rank] = (unsigned short)(0xffffu - (unsigned)(mine & 0xffffull));
                }
            }
        }
        if (tid < 16) CNT[t0 + tid] = 256;
        if (tid < 16 && qOvf[tid]) { const unsigned k = LDS_ADD(ovl, 1u); ovl[1 + k] = (unsigned)(t0 + 4 * (tid & 3) + (tid >> 2)); }
    }
    __syncthreads();
    const unsigned novl = __builtin_amdgcn_readfirstlane(ovl[0]);
#pragma unroll 1
    for (unsigned k = 0; k < novl; ++k) { const unsigned tq = __builtin_amdgcn_readfirstlane(ovl[1 + k]); indexer_slow_query(p, lds, (size_t)tq); }
}
#undef LDS_ADD

__device__ __forceinline__ void phase_attn(const P& p, unsigned char* lds) {
    unsigned char* ws = p.ws; const int tid = threadIdx.x, lane = tid & 63, hd = lane & 15, g = lane >> 4;
    const int wave = __builtin_amdgcn_readfirstlane(tid >> 6);
    bf16_t* QP = (bf16_t*)(ws + OFF_QP); const bf16_t* CK = (const bf16_t*)(ws + OFF_CKVN); const bf16_t* RK = (const bf16_t*)(ws + OFF_RK);
    const unsigned short* IDX = (const unsigned short*)(ws + OFF_IDX); const int* CNT = (const int*)(ws + OFF_CNT);
    float* biasT = (float*)lds;
    biasT[tid] = p.rel_bias[tid];
    __syncthreads();
    LAS unsigned char* rows = (LAS unsigned char*)(lds + 2048 + (size_t)wave * 18432);
    LAS bf16_t* rkb = (LAS bf16_t*)(rows + 16384);
    LAS unsigned* info = (LAS unsigned*)(rows + 17408);
    const LAS float* biasL = (const LAS float*)lds;
    for (int t = blockIdx.x * 8 + wave; t < T; t += gridDim.x * 8) {
        const int batch = t >> 14, pos = t & (SEQ - 1); const int cnt = CNT[t];
        const size_t rb = (size_t)batch * SEQ;
        asm volatile("s_waitcnt lgkmcnt(0)" ::: "memory");
#pragma unroll
        for (int jj = 0; jj < 4; ++jj) {
            const int j = lane + 64 * jj; int id = IDX[(size_t)t * 256 + j]; if (j >= cnt) id = 0;
            const int rel = pos - id; int bucket = rel < 0 ? 0 : rel;
            if (rel >= 16) { bucket = 16 + (int)(__logf((float)rel * 0.0625f) / 2.0794415416798357f * 16.0f); bucket = bucket > 31 ? 31 : bucket; }
            info[j] = (unsigned)id | ((unsigned)bucket << 16);
        }
        bf16x8 qf[8];
#pragma unroll
        for (int ks = 0; ks < 8; ++ks) qf[ks] = *(const bf16x8*)(QP + (size_t)t * 4096 + hd * 256 + ks * 32 + g * 8);
        f32x4 o[16];
#pragma unroll
        for (int rt = 0; rt < 16; ++rt) o[rt] = (f32x4){0.f, 0.f, 0.f, 0.f};
        float mrun = -1e30f, lrun = 0.f;
        asm volatile("s_waitcnt lgkmcnt(0)" ::: "memory");
        const int nch = (cnt + 31) >> 5;
        for (int ch = 0; ch < nch; ++ch) {
            asm volatile("s_waitcnt lgkmcnt(0)" ::: "memory");
#pragma unroll
            for (int i = 0; i < 16; ++i) {
                const int ksl = 2 * i + (lane >> 5); const unsigned idv = info[ch * 32 + ksl] & 0xffffu;
                const bf16_t* src = CK + (rb + idv) * 256 + (((lane & 31) ^ (ksl & 15)) * 8);
                __builtin_amdgcn_global_load_lds((const unsigned*)src, (LAS unsigned*)(rows + i * 1024), 16, 0, 0);
            }
            { const unsigned idv = info[ch * 32 + (lane >> 1)] & 0xffffu;
              __builtin_amdgcn_global_load_lds((const unsigned*)(RK + (rb + idv) * 16 + (lane & 1) * 8), (LAS unsigned*)rkb, 16, 0, 0); }
            asm volatile("s_waitcnt vmcnt(0)" ::: "memory");
            f32x4 s0 = (f32x4){0.f, 0.f, 0.f, 0.f}, s1 = (f32x4){0.f, 0.f, 0.f, 0.f};
#pragma unroll
            for (int ks = 0; ks < 8; ++ks) {
                const int pos16 = ((4 * ks + g) ^ hd) * 16;
                const bf16x8 a0 = *(const LAS bf16x8*)(rows + hd * 512 + pos16);
                const bf16x8 a1 = *(const LAS bf16x8*)(rows + (16 + hd) * 512 + pos16);
                s0 = __builtin_amdgcn_mfma_f32_16x16x32_bf16(a0, qf[ks], s0, 0, 0, 0);
                s1 = __builtin_amdgcn_mfma_f32_16x16x32_bf16(a1, qf[ks], s1, 0, 0, 0);
            }
            float x0[4], x1[4]; float cm = -INFINITY;
#pragma unroll
            for (int r = 0; r < 4; ++r) {
                const int sl0 = 4 * g + r, sl1 = 16 + 4 * g + r, j0 = ch * 32 + sl0, j1 = ch * 32 + sl1;
                const unsigned i0 = info[j0], i1 = info[j1];
                const float r0 = bf2f(rkb[sl0 * 16 + hd]), r1 = bf2f(rkb[sl1 * 16 + hd]);
                x0[r] = (j0 < cnt) ? s0[r] * r0 + biasL[(i0 >> 16) * 16 + hd] : -INFINITY;
                x1[r] = (j1 < cnt) ? s1[r] * r1 + biasL[(i1 >> 16) * 16 + hd] : -INFINITY;
                cm = fmaxf(cm, fmaxf(x0[r], x1[r]));
            }
            cm = fmaxf(cm, __shfl_xor(cm, 16)); cm = fmaxf(cm, __shfl_xor(cm, 32));
            const float mnew = fmaxf(mrun, cm); const float sc = __expf(mrun - mnew); mrun = mnew;
            float ls = 0.f;
#pragma unroll
            for (int r = 0; r < 4; ++r) { x0[r] = __expf(x0[r] - mnew); x1[r] = __expf(x1[r] - mnew); ls += x0[r] + x1[r]; }
            lrun = lrun * sc + ls;
#pragma unroll
            for (int rt = 0; rt < 16; ++rt) o[rt] *= sc;
            u32x4 pw; pw.x = pg8::cvt_pk_bf16(x0[0], x0[1]); pw.y = pg8::cvt_pk_bf16(x0[2], x0[3]); pw.z = pg8::cvt_pk_bf16(x1[0], x1[1]); pw.w = pg8::cvt_pk_bf16(x1[2], x1[3]);
            const bf16x8 pf = __builtin_bit_cast(bf16x8, pw);
            const int q = hd >> 2, pp = hd & 3, ksl = 4 * g + q;
            const LAS unsigned char* trb = rows + ksl * 512 + (pp & 1) * 8;
#pragma unroll
            for (int rt = 0; rt < 16; ++rt) {
                const int c16 = ((2 * rt + (pp >> 1)) ^ ksl) * 16;
                const v4i16_t t0 = __builtin_amdgcn_ds_read_tr16_b64_v4i16((LAS v4i16_t*)(trb + c16));
                const v4i16_t t1 = __builtin_amdgcn_ds_read_tr16_b64_v4i16((LAS v4i16_t*)(trb + c16 + 8192));
                bf16x8 af; af[0] = t0[0]; af[1] = t0[1]; af[2] = t0[2]; af[3] = t0[3]; af[4] = t1[0]; af[5] = t1[1]; af[6] = t1[2]; af[7] = t1[3];
                o[rt] = __builtin_amdgcn_mfma_f32_16x16x32_bf16(af, pf, o[rt], 0, 0, 0);
            }
        }
        float ltot = lrun; ltot += __shfl_xor(ltot, 16); ltot += __shfl_xor(ltot, 32);
        const float inv = 1.0f / ltot;
        bf16_t* op = QP + (size_t)t * 4096 + hd * 256 + 4 * g;
#pragma unroll
        for (int rt = 0; rt < 16; ++rt) { u32x2 w; w.x = pg8::cvt_pk_bf16(o[rt][0] * inv, o[rt][1] * inv); w.y = pg8::cvt_pk_bf16(o[rt][2] * inv, o[rt][3] * inv); *(u32x2*)(op + rt * 16) = w; }
    }
}

__global__ void __launch_bounds__(512, 2) k_fwd(P p_arg, int ph_lo, int ph_hi) {
    extern __shared__ __attribute__((aligned(16))) unsigned char smem[];
    const P& p = *(const P*)__builtin_amdgcn_kernarg_segment_ptr(); (void)p_arg;
    unsigned char* lds = smem + 16;
    unsigned char* ws = p.ws;
    XcdBarrier bar;
    const bool multi = (ph_hi - ph_lo) > 1;
    if (multi) {
        if (threadIdx.x == 0) *(uint4*)smem = make_uint4(0u, 0u, 0u, 0u);
        __syncthreads();
        bar = xcd_barrier_post((unsigned*)(ws + OFF_CTL), (volatile LAS unsigned*)smem);
    }
#define PH(i) (ph_lo <= (i) && (i) < ph_hi)
#define SEAM(i) do { if ((i) + 1 < ph_hi) xcd_barrier(bar); else __syncthreads(); } while (0)
    bf16_t *XN = (bf16_t*)(ws + OFF_XN), *QB = (bf16_t*)(ws + OFF_QB), *KB = (bf16_t*)(ws + OFF_KB), *VB = (bf16_t*)(ws + OFF_VB), *TMP = (bf16_t*)(ws + OFF_TMP), *Y = (bf16_t*)(ws + OFF_Y);
    if (PH(0)) { phase_prep(p, lds); SEAM(0); }
    if (PH(1)) { fast_gemm(lds, XN, 1024, (const bf16_t*)(ws + OFF_W0T), 1024, 3072, 1024, D1{ws}); SEAM(1); }
    if (PH(2)) { phase_conv_scan(p, lds); SEAM(2); }
    if (PH(3)) { mlstm_units<false>(p, lds); SEAM(3); }
    if (PH(4)) { GWP f{(const bf16_t*)(ws + OFF_WPT), (const bf16_t*)(ws + OFF_WUB), (bf16_t*)(ws + OFF_W0T)}; sgemm(f, 256); phase_mlstm_scan(p, lds); SEAM(4); }
    if (PH(5)) { mlstm_units<true>(p, lds); SEAM(5); }
    if (PH(6)) { fast_gemm(lds, XN, 1024, (const bf16_t*)(ws + OFF_W0T) + (size_t)3072 * 1024, 1024, 4096, 1024, D2{ws}); SEAM(6); }
    if (PH(7)) { phase_ya_pool(p); SEAM(7); }
    if (PH(8)) { fast_gemm(lds, Y, 2048, (const bf16_t*)(ws + OFF_WO0T), 2048, 1024, 2048, D4{(unsigned char*)p.out, p.x}); SEAM(8); }
    if (PH(9)) { rmsnorm_rows<4>(p.out, p.o_norm, XN, p.o_w_in, OIN, 1600, nullptr, 0.5f, (float*)(ws + OFF_WI), (float*)lds); SEAM(9); }
    if (PH(10)) { fast_gemm(lds, XN, 1024, (const bf16_t*)(ws + OFF_W1T), 1024, 2816, 1024, D5{ws}); SEAM(10); }
    if (PH(11)) { phase_qnorm_ckvnorm(p); SEAM(11); }
    if (PH(12)) { fast_gemm(lds, (const bf16_t*)(ws + OFF_CKVN), 256, (const bf16_t*)(ws + OFF_WUKP), 256, 1024, 256, DK{ws}); SEAM(12); }
    if (PH(13)) { GQP f{TMP, (const bf16_t*)(ws + OFF_WQP), (bf16_t*)(ws + OFF_QP)}; sgemm(f, 512 * 64); phase_indexer(p, lds); SEAM(13); }
    if (PH(14)) { phase_attn(p, lds); SEAM(14); }
    if (PH(15)) { GOP f{(const bf16_t*)(ws + OFF_QP), (const bf16_t*)(ws + OFF_WUVT), (const bf16_t*)(ws + OFF_Z), TMP}; sgemm(f, 512 * 16); SEAM(15); }
    if (PH(16)) { fast_gemm(lds, TMP, 1024, (const bf16_t*)(ws + OFF_WO1T), 1024, 1024, 1024, D8{(unsigned char*)p.out}); }
#undef PH
#undef SEAM
}

extern "C" void kernel_launch(void* const* d_in, const int* in_sizes, int n_in, void* d_out, int out_size, void* d_ws, size_t ws_size, hipStream_t stream) {
    static int grid = 0;
    if (grid == 0) {
        if (n_in != 18 || out_size != T * DM || ws_size < WS_END) { fprintf(stderr, "kernel_launch: unexpected shapes (n_in %d out %d ws %zu)\n", n_in, out_size, ws_size); grid = -1; return; }
        if (hipFuncSetAttribute((const void*)k_fwd, hipFuncAttributeMaxDynamicSharedMemorySize, LDS_BYTES) != hipSuccess) { fprintf(stderr, "kernel_launch: hipFuncSetAttribute failed\n"); grid = -1; return; }
        grid = 256;
    }
    if (grid < 0) return;
    (void)hipMemsetAsync((char*)d_ws + OFF_CTL, 0, 16384, stream);
    P p{};
    p.x = (const float*)d_in[0]; p.e_norm = (const float*)d_in[1]; p.e_w_in = (const float*)d_in[2]; p.e_conv = (const float*)d_in[3]; p.e_b_if = (const float*)d_in[4];
    p.e_g_head = (const float*)d_in[5]; p.e_w_pool = (const float*)d_in[6]; p.e_s_pool = (const float*)d_in[7]; p.e_w_out = (const float*)d_in[8];
    p.o_norm = (const float*)d_in[9]; p.o_w_in = (const float*)d_in[10]; p.o_g_kv = (const float*)d_in[11]; p.o_w_uk = (const float*)d_in[12]; p.o_w_uv = (const float*)d_in[13];
    p.o_g_q = (const float*)d_in[14]; p.o_g_k = (const float*)d_in[15]; p.o_w_out = (const float*)d_in[16]; p.rel_bias = (const float*)d_in[17];
    p.out = (float*)d_out; p.ws = (unsigned char*)d_ws;
    hipLaunchKernelGGL(k_fwd, dim3(grid), dim3(512), LDS_BYTES, stream, p, 0, NPH);
}
```

```cpp
#include <hip/hip_runtime.h>
#include <stdint.h>
#include <cstdio>

typedef unsigned short bf16_t;
typedef short bf16x8 __attribute__((ext_vector_type(8)));
typedef float f32x4 __attribute__((ext_vector_type(4)));
typedef unsigned u32x4 __attribute__((ext_vector_type(4)));
typedef unsigned u32x2 __attribute__((ext_vector_type(2)));
typedef short v4i16_t __attribute__((ext_vector_type(4)));
#define LAS __attribute__((address_space(3)))

constexpr int T = 32768, SEQ = 16384, DM = 1024;
constexpr int EIN = 7176, OIN = 2628;
constexpr float EPS = 1e-6f;
constexpr size_t MB = 1048576;
constexpr size_t OFF_CTL = 0;
constexpr size_t OFF_GATES = 64 * 1024;
constexpr size_t OFF_BQ = OFF_GATES + (size_t)T * 8 * 4;
constexpr size_t OFF_IQ = OFF_BQ + (size_t)T * 4 * 4;
constexpr size_t OFF_MT = OFF_IQ + (size_t)T * 4 * 4;
constexpr size_t OFF_WI = OFF_MT + (size_t)T * 4 * 4;
constexpr size_t OFF_CH = OFF_WI + (size_t)T * 4 * 4;
constexpr size_t OFF_NS = OFF_CH + 64 * 1024;
constexpr size_t OFF_W = 4 * MB;
constexpr size_t OFF_W0T = OFF_W;
constexpr size_t OFF_WPT = OFF_W0T + (size_t)7168 * 1024 * 2;
constexpr size_t OFF_WO0T = OFF_WPT + (size_t)4 * 256 * 256 * 2;
constexpr size_t OFF_W1T = OFF_WO0T + (size_t)1024 * 2048 * 2;
constexpr size_t OFF_WUKT = OFF_W1T + (size_t)2816 * 1024 * 2;
constexpr size_t OFF_WUVT = OFF_WUKT + (size_t)1024 * 256 * 2;
constexpr size_t OFF_WO1T = OFF_WUVT + (size_t)1024 * 256 * 2;
constexpr size_t OFF_WUKP = OFF_WO1T + (size_t)1024 * 1024 * 2;
constexpr size_t OFF_WQP = OFF_WUKP + (size_t)1024 * 256 * 2;
constexpr size_t OFF_WUB = OFF_WQP + (size_t)16 * 256 * 64 * 2;
constexpr size_t OFF_XN = 36 * MB, OFF_QB = 100 * MB, OFF_KB = 164 * MB, OFF_VB = 228 * MB, OFF_TMP = 292 * MB, OFF_Y = 356 * MB;
constexpr size_t OFF_QP = 36 * MB;
constexpr size_t OFF_CKVN = OFF_Y;
constexpr size_t OFF_QI = OFF_Y + 16 * MB;
constexpr size_t OFF_KI = OFF_Y + 32 * MB;
constexpr size_t OFF_IDX = OFF_Y + 40 * MB;
constexpr size_t OFF_RK = OFF_Y + 58 * MB;
constexpr size_t OFF_CNT = OFF_Y + 59 * MB;
constexpr size_t OFF_Z = OFF_Y + 60 * MB;
constexpr size_t WS_END = 484 * MB;
constexpr int LDS_BYTES = 151552;
constexpr int NPH = 17;

struct P {
    const float *x, *e_norm, *e_w_in, *e_conv, *e_b_if, *e_g_head, *e_w_pool, *e_s_pool, *e_w_out;
    const float *o_norm, *o_w_in, *o_g_kv, *o_w_uk, *o_w_uv, *o_g_q, *o_g_k, *o_w_out, *rel_bias;
    float* out; unsigned char* ws;
};

__device__ __forceinline__ bf16_t f2bf(float f) { unsigned u = __float_as_uint(f); u += 0x7FFFu + ((u >> 16) & 1u); return (bf16_t)(u >> 16); }
__device__ __forceinline__ float bf2f(bf16_t b) { return __uint_as_float(((unsigned)b) << 16); }
__device__ __forceinline__ float bflo(unsigned w) { return __uint_as_float(w << 16); }
__device__ __forceinline__ float bfhi(unsigned w) { return __uint_as_float(w & 0xffff0000u); }
__device__ __forceinline__ unsigned pk2(float a, float b) { return (unsigned)f2bf(a) | ((unsigned)f2bf(b) << 16); }
__device__ __forceinline__ float sigmoidf_(float x) { return __builtin_amdgcn_rcpf(1.0f + __expf(-x)); }
__device__ __forceinline__ float siluf_(float x) { return x * __builtin_amdgcn_rcpf(1.0f + __expf(-x)); }
__device__ __forceinline__ float wave_sum(float v) {
#pragma unroll
    for (int o = 32; o >= 1; o >>= 1) v += __shfl_xor(v, o);
    return v;
}
__device__ __forceinline__ float wave_max(float v) {
#pragma unroll
    for (int o = 32; o >= 1; o >>= 1) v = fmaxf(v, __shfl_xor(v, o));
    return v;
}

#define XB_TMO      128
#define XB_XCNT(j)  (256  + 64 * (j))
#define XB_XSUB(j)  (1280 + 64 * (j))
#define XB_XGEN(j)  (2304 + 64 * (j))
#define XB_TOP      3328
#define XB_TOPGEN   3392
#define XCD_BAR_WORDS 3456
#define XB_SPIN_CAP (1u << 22)
__device__ __forceinline__ unsigned xb_ld(unsigned* p)              { return __hip_atomic_load(p, __ATOMIC_RELAXED, __HIP_MEMORY_SCOPE_AGENT); }
__device__ __forceinline__ unsigned xb_add(unsigned* p, unsigned v) { return __hip_atomic_fetch_add(p, v, __ATOMIC_RELAXED, __HIP_MEMORY_SCOPE_AGENT); }
__device__ __forceinline__ unsigned xb_xcc_id() { return (unsigned)__builtin_amdgcn_s_getreg((3 << 11) | 20) & 0xFu; }
#define XB_SPIN(cond, bar) do { unsigned _sp = 0; while (cond) { __builtin_amdgcn_s_sleep(1); \
    if ((++_sp & 255u) == 0u) { if (xb_ld(&(bar)[XB_TMO])) break; if (_sp > XB_SPIN_CAP) { atomicAdd(&(bar)[XB_TMO], 1u); break; } } } } while (0)
struct XcdBarrier { unsigned* bar; unsigned x; volatile LAS unsigned* st; };
__device__ __forceinline__ XcdBarrier xcd_barrier_post(unsigned* bar, volatile LAS unsigned* st) {
    XcdBarrier b; b.bar = bar; b.x = xb_xcc_id(); b.st = st;
    if (threadIdx.x == 0) (void)xb_add(&bar[XB_XCNT(b.x)], 1u);
    return b;
}
__device__ __forceinline__ void xcd_barrier_complete(unsigned* bar, unsigned x, unsigned& nloc, unsigned& nx) {
    const unsigned G = gridDim.x * gridDim.y * gridDim.z;
    unsigned sum, cnt, mine, sp = 0u;
    for (;;) {
        sum = 0u; cnt = 0u; mine = 0u;
#pragma unroll
        for (unsigned j = 0; j < 16; ++j) { const unsigned c = xb_ld(&bar[XB_XCNT(j)]); sum += c; cnt += (c > 0u) ? 1u : 0u; mine = (j == x) ? c : mine; }
        if (sum == G) break;
        __builtin_amdgcn_s_sleep(1);
        if ((++sp & 255u) == 0u) { if (xb_ld(&bar[XB_TMO])) break; if (sp > XB_SPIN_CAP) { atomicAdd(&bar[XB_TMO], 1u); break; } }
    }
    nloc = mine > 0u ? mine : 1u; nx = cnt > 0u ? cnt : 1u;
}
__device__ __forceinline__ void xcd_barrier(const XcdBarrier& b) {
    asm volatile("s_waitcnt vmcnt(0)" ::: "memory");
    __syncthreads();
    if (threadIdx.x == 0) {
        unsigned* bar = b.bar;
        __builtin_amdgcn_s_waitcnt(0);
        unsigned nloc = b.st[0], nx = b.st[1];
        if (nloc == 0u) { xcd_barrier_complete(bar, b.x, nloc, nx); b.st[0] = nloc; b.st[1] = nx; }
        const unsigned old = xb_add(&bar[XB_XSUB(b.x)], 1u);
        const unsigned gen = old / nloc;
        if (old + 1u == (gen + 1u) * nloc) {
            __builtin_amdgcn_fence(__ATOMIC_RELEASE, "agent");
            asm volatile("s_waitcnt vmcnt(0)" ::: "memory");
            const unsigned og = xb_add(&bar[XB_TOP], 1u);
            const unsigned tg = og / nx;
            if (og + 1u == (tg + 1u) * nx) xb_add(&bar[XB_TOPGEN], 1u);
            else XB_SPIN(xb_ld(&bar[XB_TOPGEN]) == tg, bar);
            __builtin_amdgcn_fence(__ATOMIC_ACQUIRE, "agent");
            xb_add(&bar[XB_XGEN(b.x)], 1u);
            asm volatile("s_waitcnt vmcnt(0)" ::: "memory");
        } else {
            XB_SPIN(xb_ld(&bar[XB_XGEN(b.x)]) == gen, bar);
            __builtin_amdgcn_fence(__ATOMIC_ACQUIRE, "agent");
            asm volatile("s_waitcnt vmcnt(0)" ::: "memory");
        }
    }
    __syncthreads();
}

struct Tile { const bf16_t* A; const bf16_t* B; int lda, ldb, K; void* d0; const void* s0; int ld; };
template <class F>
__device__ __forceinline__ void sgemm(const F f, int nunits) {
    const int lane = threadIdx.x & 63, wave = threadIdx.x >> 6, fr = lane & 15, fq = lane >> 4;
    for (int u = blockIdx.x * 8 + wave; u < nunits; u += gridDim.x * 8) {
        Tile tl; f.tile(u, tl);
        f32x4 acc[4][4];
#pragma unroll
        for (int m = 0; m < 4; ++m)
#pragma unroll
            for (int n = 0; n < 4; ++n) acc[m][n] = (f32x4){0.f, 0.f, 0.f, 0.f};
        const bf16_t* ap = tl.A + (size_t)fr * tl.lda + fq * 8;
        const bf16_t* bp = tl.B + (size_t)fr * tl.ldb + fq * 8;
        const int K = tl.K, lda = tl.lda, ldb = tl.ldb;
        bf16x8 a[4], b[4];
#pragma unroll
        for (int m = 0; m < 4; ++m) a[m] = *(const bf16x8*)(ap + (size_t)(m * 16) * lda);
#pragma unroll
        for (int n = 0; n < 4; ++n) b[n] = *(const bf16x8*)(bp + (size_t)(n * 16) * ldb);
#pragma unroll 1
        for (int k0 = 0; k0 < K; k0 += 32) {
            bf16x8 an[4], bn[4]; const int kn = (k0 + 32 < K) ? k0 + 32 : k0;
#pragma unroll
            for (int m = 0; m < 4; ++m) an[m] = *(const bf16x8*)(ap + (size_t)(m * 16) * lda + kn);
#pragma unroll
            for (int n = 0; n < 4; ++n) bn[n] = *(const bf16x8*)(bp + (size_t)(n * 16) * ldb + kn);
#pragma unroll
            for (int m = 0; m < 4; ++m)
#pragma unroll
                for (int n = 0; n < 4; ++n) acc[m][n] = __builtin_amdgcn_mfma_f32_16x16x32_bf16(b[n], a[m], acc[m][n], 0, 0, 0);
#pragma unroll
            for (int m = 0; m < 4; ++m) { a[m] = an[m]; b[m] = bn[m]; }
        }
#pragma unroll
        for (int m = 0; m < 4; ++m) {
            asm volatile("" ::: "memory");
#pragma unroll
            for (int n = 0; n < 4; ++n) f.out4(tl, m * 16 + fr, n * 16 + 4 * fq, acc[m][n]);
        }
    }
}
__device__ __forceinline__ void store4_bf16(const Tile& tl, int r, int c, const f32x4 v) {
    u32x2 w; w.x = pk2(v[0], v[1]); w.y = pk2(v[2], v[3]); *(u32x2*)((bf16_t*)tl.d0 + (size_t)r * tl.ld + c) = w; }

struct GWP {
    const bf16_t* WPT; const bf16_t* WUB; bf16_t* W0T;
    __device__ __forceinline__ void tile(int u, Tile& tl) const {
        const int kt = u & 15, dt = (u >> 4) & 3, g = u >> 6; tl.A = WPT + (size_t)(g * 256 + dt * 64) * 256; tl.lda = 256; tl.B = WUB + (size_t)kt * 64 * 1024 + g * 256; tl.ldb = 1024; tl.K = 256;
        tl.d0 = W0T + (size_t)(5120 + g * 256 + dt * 64) * 1024 + kt * 64; tl.ld = 1024; }
    __device__ __forceinline__ void out4(const Tile& tl, int r, int c, const f32x4 v) const { store4_bf16(tl, r, c, v); }
};
struct GQP {
    const bf16_t* Qn; const bf16_t* W; bf16_t* QP;
    __device__ __forceinline__ void tile(int u, Tile& tl) const {
        const int nt = u & 3, head = (u >> 2) & 15, mt = u >> 6; tl.A = Qn + (size_t)mt * 64 * 1024 + head * 64; tl.lda = 1024; tl.B = W + (size_t)(head * 256 + nt * 64) * 64; tl.ldb = 64; tl.K = 64;
        tl.d0 = QP + ((size_t)mt * 64 * 16 + head) * 256 + nt * 64; tl.ld = 4096; }
    __device__ __forceinline__ void out4(const Tile& tl, int r, int c, const f32x4 v) const { store4_bf16(tl, r, c, v); }
};
struct GOP {
    const bf16_t* OP; const bf16_t* W; const bf16_t* Z; bf16_t* G;
    __device__ __forceinline__ void tile(int u, Tile& tl) const {
        const int head = u & 15, mt = u >> 4; tl.A = OP + (size_t)mt * 64 * 4096 + head * 256; tl.lda = 4096; tl.B = W + (size_t)head * 64 * 256; tl.ldb = 256; tl.K = 256;
        const size_t o = (size_t)mt * 64 * 1024 + head * 64; tl.d0 = G + o; tl.s0 = Z + o; tl.ld = 1024; }
    __device__ __forceinline__ void out4(const Tile& tl, int r, int c, const f32x4 v) const { const size_t i = (size_t)r * 1024 + c; const u32x2 z = *(const u32x2*)((const bf16_t*)tl.s0 + i);
        u32x2 w; w.x = pk2(v[0] * bflo(z.x), v[1] * bfhi(z.x)); w.y = pk2(v[2] * bflo(z.y), v[3] * bfhi(z.y)); *(u32x2*)((bf16_t*)tl.d0 + i) = w; }
};

namespace pg8 {
constexpr int BM = 256, BK = 64, HALF = 128, HTB = HALF * BK * 2, STAGE_BYTES = 8 * HTB, NXCD = 8, WGM = 8;
__device__ __forceinline__ int lds_byte(int r, int c) { const int st = (r >> 4) * 2 + (c >> 5), rr = r & 15, cc = c & 31, ob = rr * 64 + cc * 2; return st * 1024 + (ob ^ (((ob >> 9) & 1) << 5)); }
__device__ __forceinline__ void stage_rc(int b, int& R, int& C) { const int st = b / 1024, sb = b % 1024, swz = sb ^ (((sb >> 9) & 1) << 5); R = (st >> 1) * 16 + swz / 64; C = (st & 1) * 32 + (swz % 64) / 2; }
__device__ __forceinline__ int perm32(int rho) { const int n = rho >> 4, i = rho & 15; return 8 * (i >> 2) + 4 * n + (i & 3); }
struct Unit { int pm, pn; };
struct Gemm { const bf16_t* A; int lda; const bf16_t* Bt; int ldb; int M, N, K; };
struct StaticOrder {
    int nM, nN, nwg, G, c;
    __device__ void init(int M, int N, int G_, int c_) { nM = M / BM; nN = N / BM; nwg = nM * nN; G = G_; c = c_; }
    __device__ bool next(int i, Unit& u) const {
        const long L = (long)i * G + c; if (L >= nwg) return false;
        int wgid = (int)L; { const int q = nwg / NXCD, r = nwg % NXCD, xcd = wgid % NXCD, off = wgid / NXCD; wgid = (xcd < r ? xcd * (q + 1) : r * (q + 1) + (xcd - r) * q) + off; }
        const int nig = WGM * nN, gid = wgid / nig, fm = gid * WGM, gsz = (nM - fm) < WGM ? (nM - fm) : WGM;
        u.pm = fm + ((wgid % nig) % gsz); u.pn = (wgid % nig) / gsz; return true;
    }
};
__device__ __forceinline__ unsigned cvt_pk_bf16(float lo, float hi) { unsigned r; asm volatile("v_cvt_pk_bf16_f32 %0, %1, %2" : "=v"(r) : "v"(lo), "v"(hi)); return r; }

struct Dst { unsigned char* base; const float* res; int ld, mode, ncol; float scale; };
template <class DescF> struct EpiGen {
    static constexpr bool PERM = true;
    DescF D;
    __device__ __forceinline__ void operator()(const f32x4 (&acc)[2][2][4][2], const Unit& u, int wr, int wc, int fr, int fq) const {
        Dst d; D.get(u, d);
        if ((DescF::MODES & 16) && d.mode == 4) return;
        const int r0 = wr * 64 + fr, c0 = wc * 32 + 8 * fq;
        if constexpr ((DescF::MODES & 64) != 0) {
#pragma unroll
            for (int ai = 0; ai < 2; ++ai)
#pragma unroll
                for (int m = 0; m < 4; ++m) {
                    float ss = 0.f;
#pragma unroll
                    for (int bj = 0; bj < 2; ++bj)
#pragma unroll
                        for (int n = 0; n < 2; ++n) { const f32x4 v = acc[ai][bj][m][n]; ss += v[0] * v[0] + v[1] * v[1] + v[2] * v[2] + v[3] * v[3]; }
                    ss += __shfl_xor(ss, 16); ss += __shfl_xor(ss, 32);
                    if (fq == 0) ((bf16_t*)d.base)[(size_t)(ai * HALF + r0 + m * 16) * d.ld + wc] = f2bf(rsqrtf(ss * (1.0f / 64.0f) + EPS));
                }
            return;
        } else {
#pragma unroll
        for (int ai = 0; ai < 2; ++ai)
#pragma unroll
            for (int m = 0; m < 4; ++m) {
                const size_t rowoff = (size_t)(ai * HALF + r0 + m * 16) * d.ld;
#pragma unroll
                for (int bj = 0; bj < 2; ++bj) {
                    const int col = bj * HALF + c0; f32x4 v0 = acc[ai][bj][m][0], v1 = acc[ai][bj][m][1];
                    if ((DescF::MODES & 7) && d.mode <= 2) {
                        if ((DescF::MODES & 2) && d.mode == 1) {
#pragma unroll
                            for (int j = 0; j < 4; ++j) { v0[j] = sigmoidf_(v0[j]); v1[j] = sigmoidf_(v1[j]); } }
                        if ((DescF::MODES & 4) && d.mode == 2) {
#pragma unroll
                            for (int j = 0; j < 4; ++j) { v0[j] = siluf_(v0[j]); v1[j] = siluf_(v1[j]); } }
                        u32x4 w; w.x = cvt_pk_bf16(v0[0], v0[1]); w.y = cvt_pk_bf16(v0[2], v0[3]); w.z = cvt_pk_bf16(v1[0], v1[1]); w.w = cvt_pk_bf16(v1[2], v1[3]);
                        *(u32x4*)((bf16_t*)d.base + rowoff + col) = w;
                    } else if ((DescF::MODES & 8) && d.mode == 3) {
                        if (col < d.ncol) { float* o = (float*)d.base + rowoff + col; *(f32x4*)o = v0 * d.scale; *(f32x4*)(o + 4) = v1 * d.scale; }
                    } else if ((DescF::MODES & 128) && d.mode == 7) {
                        typedef _Float16 h8 __attribute__((ext_vector_type(8)));
                        if (col < d.ncol) {
                        h8 hv; hv[0] = (_Float16)(v0[0] * d.scale); hv[1] = (_Float16)(v0[1] * d.scale); hv[2] = (_Float16)(v0[2] * d.scale); hv[3] = (_Float16)(v0[3] * d.scale);
                        hv[4] = (_Float16)(v1[0] * d.scale); hv[5] = (_Float16)(v1[1] * d.scale); hv[6] = (_Float16)(v1[2] * d.scale); hv[7] = (_Float16)(v1[3] * d.scale);
                        *(h8*)((_Float16*)d.base + rowoff + col) = hv; }
                    } else if constexpr ((DescF::MODES & 32) != 0) {
                        float* o = (float*)d.base + rowoff + col; const float* rs = d.res + rowoff + col;
                        const f32x4 a = *(const f32x4*)rs, b = *(const f32x4*)(rs + 4); *(f32x4*)o = a + v0; *(f32x4*)(o + 4) = b + v1;
                    }
                }
                if (m & 1) asm volatile("" ::: "memory");
            }
        }
    }
};

template <class Epi>
__device__ __forceinline__ void gemm_phase(LAS unsigned char* lds, const Gemm g, const StaticOrder& S, const Epi& E) {
    const int tid = threadIdx.x, wid = __builtin_amdgcn_readfirstlane(tid >> 6), lane = tid & 63, wr = wid >> 2, wc = wid & 3, fr = lane & 15, fq = lane >> 4;
    const int K = g.K, nt = K / BK;
    unsigned voffA[2], voffB[2];
#pragma unroll
    for (int i = 0; i < 2; ++i) { int R, C; stage_rc(tid * 16 + i * 8192, R, C); const int Rb = Epi::PERM ? ((R & ~31) + perm32(R & 31)) : R;
        voffA[i] = (unsigned)(R * g.lda + C) * 2u; voffB[i] = (unsigned)(Rb * g.ldb + C) * 2u; }
    const size_t kstep = (size_t)(BK * 2);
    const size_t hstepA = (size_t)HALF * g.lda * 2, hstepB = (size_t)HALF * g.ldb * 2;
    const size_t tstepA = 2 * hstepA, tstepB = 2 * hstepB;
    const unsigned ldsw = (unsigned)wid * 1024u;
    const int aoff = lds_byte(wr * 64 + fr, fq * 8), boff = lds_byte(wc * 32 + fr, fq * 8);
#define PG8_SA(b, h) (((b) * 2 + (h)) * HTB)
#define PG8_SB(b, h) ((4 + (b) * 2 + (h)) * HTB)
#define PG8_STAGE(bufoff, gbase, voff) do { _Pragma("unroll") for (int _i = 0; _i < 2; ++_i) \
        __builtin_amdgcn_global_load_lds((const unsigned*)((const char*)(gbase) + (voff)[_i]), (LAS unsigned*)(lds + (bufoff) + ldsw + _i * 8192), 16, 0, 0); } while (0)
#define PG8_LDA(dst, b, h) do { _Pragma("unroll") for (int m = 0; m < 4; ++m) _Pragma("unroll") for (int k = 0; k < 2; ++k) dst[m][k] = *(const LAS bf16x8*)(lds + PG8_SA(b, h) + aoff + m * 2048 + k * 1024); } while (0)
#define PG8_LDB(dst, b, h) do { _Pragma("unroll") for (int n = 0; n < 2; ++n) _Pragma("unroll") for (int k = 0; k < 2; ++k) dst[n][k] = *(const LAS bf16x8*)(lds + PG8_SB(b, h) + boff + n * 2048 + k * 1024); } while (0)
#define PG8_MMA(ai, bj, At, Bt) do { __builtin_amdgcn_s_setprio(1); _Pragma("unroll") for (int m = 0; m < 4; ++m) _Pragma("unroll") for (int n = 0; n < 2; ++n) _Pragma("unroll") for (int k = 0; k < 2; ++k) \
        acc[ai][bj][m][n] = __builtin_amdgcn_mfma_f32_16x16x32_bf16(Bt[n][k], At[m][k], acc[ai][bj][m][n], 0, 0, 0); __builtin_amdgcn_s_setprio(0); } while (0)
#define PG8_WAIT_V(n) asm volatile("s_waitcnt vmcnt(" #n ")" ::: "memory")
#define PG8_WAIT_L(n) asm volatile("s_waitcnt lgkmcnt(" #n ")" ::: "memory")
#define PG8_BAR __builtin_amdgcn_s_barrier()
#define PG8_SCHED __builtin_amdgcn_sched_barrier(0)
    Unit cur, nxt; int ui = 0;
    if (!S.next(0, cur)) return;
    f32x4 acc[2][2][4][2];
#pragma unroll
    for (int a = 0; a < 2; ++a)
#pragma unroll
        for (int b = 0; b < 2; ++b)
#pragma unroll
            for (int m = 0; m < 4; ++m)
#pragma unroll
                for (int n = 0; n < 2; ++n) acc[a][b][m][n] = (f32x4){0.f, 0.f, 0.f, 0.f};
    bf16x8 At[4][2], B0[2][2], B1[2][2];
    const char* cA = (const char*)g.A + (size_t)cur.pm * tstepA; const char* cB = (const char*)g.Bt + (size_t)cur.pn * tstepB;
    PG8_STAGE(PG8_SB(0, 0), cB, voffB); PG8_STAGE(PG8_SA(0, 0), cA, voffA); PG8_STAGE(PG8_SB(0, 1), cB + hstepB, voffB); PG8_STAGE(PG8_SA(0, 1), cA + hstepA, voffA);
    if (wr == 1) PG8_BAR;
    PG8_WAIT_V(4); PG8_BAR;
    PG8_STAGE(PG8_SB(1, 0), cB + kstep, voffB); PG8_STAGE(PG8_SA(1, 0), cA + kstep, voffA); PG8_STAGE(PG8_SB(1, 1), cB + hstepB + kstep, voffB);
    PG8_WAIT_V(6); PG8_BAR;
    for (;;) {
        const bool has_next = S.next(ui + 1, nxt);
        const char* nA = has_next ? (const char*)g.A + (size_t)nxt.pm * tstepA : cA; const char* nB = has_next ? (const char*)g.Bt + (size_t)nxt.pn * tstepB : cB;
#pragma unroll 1
        for (int t = 0; t < nt; t += 2) {
            const bool last = (t == nt - 2);
            const char* a1 = cA + (size_t)(t + 1) * kstep;
            const char* a2 = last ? nA : cA + (size_t)(t + 2) * kstep; const char* b2 = last ? nB : cB + (size_t)(t + 2) * kstep;
            const char* a3 = a2 + kstep; const char* b3 = b2 + kstep;
            PG8_LDB(B0, 0, 0); PG8_SCHED; PG8_LDA(At, 0, 0); PG8_STAGE(PG8_SA(1, 1), a1 + hstepA, voffA);
            PG8_WAIT_L(8); PG8_BAR; PG8_WAIT_L(0); PG8_MMA(0, 0, At, B0); PG8_BAR; PG8_SCHED;
            PG8_LDB(B1, 0, 1); PG8_STAGE(PG8_SB(0, 0), b2, voffB);
            PG8_BAR; PG8_WAIT_L(0); PG8_MMA(0, 1, At, B1); PG8_BAR;
            PG8_LDA(At, 0, 1); PG8_STAGE(PG8_SA(0, 0), a2, voffA);
            PG8_BAR; PG8_WAIT_L(0); PG8_MMA(1, 0, At, B0); PG8_BAR; PG8_SCHED;
            PG8_STAGE(PG8_SB(0, 1), b2 + hstepB, voffB);
            PG8_WAIT_V(6); PG8_BAR; PG8_MMA(1, 1, At, B1); PG8_BAR;
            PG8_LDB(B0, 1, 0); PG8_SCHED; PG8_LDA(At, 1, 0); PG8_STAGE(PG8_SA(0, 1), a2 + hstepA, voffA);
            PG8_WAIT_L(8); PG8_BAR; PG8_WAIT_L(0); PG8_MMA(0, 0, At, B0); PG8_BAR; PG8_SCHED;
            PG8_LDB(B1, 1, 1); PG8_STAGE(PG8_SB(1, 0), b3, voffB);
            PG8_BAR; PG8_WAIT_L(0); PG8_MMA(0, 1, At, B1); PG8_BAR;
            PG8_LDA(At, 1, 1); PG8_STAGE(PG8_SA(1, 0), a3, voffA);
            PG8_BAR; PG8_WAIT_L(0); PG8_MMA(1, 0, At, B0); PG8_BAR; PG8_SCHED;
            PG8_STAGE(PG8_SB(1, 1), b3 + hstepB, voffB);
            PG8_WAIT_V(6); PG8_BAR; PG8_MMA(1, 1, At, B1); PG8_BAR;
        }
        E(acc, cur, wr, wc, fr, fq);
        if (!has_next) break;
#pragma unroll
        for (int a = 0; a < 2; ++a)
#pragma unroll
            for (int b = 0; b < 2; ++b)
#pragma unroll
                for (int m = 0; m < 4; ++m)
#pragma unroll
                    for (int n = 0; n < 2; ++n) acc[a][b][m][n] = (f32x4){0.f, 0.f, 0.f, 0.f};
        cur = nxt; cA = nA; cB = nB; ++ui;
    }
    PG8_WAIT_V(0);
    if (wr == 0) PG8_BAR;
    PG8_BAR;
#undef PG8_SA
#undef PG8_SB
#undef PG8_STAGE
#undef PG8_LDA
#undef PG8_LDB
#undef PG8_MMA
#undef PG8_WAIT_V
#undef PG8_WAIT_L
#undef PG8_BAR
#undef PG8_SCHED
}
}

struct D1 { static constexpr int MODES = 1; unsigned char* ws;
    __device__ __forceinline__ void get(const pg8::Unit& u, pg8::Dst& d) const { const int sec = u.pn >> 2;
        d.base = ws + OFF_QB + (size_t)sec * (64 * MB) + ((size_t)u.pm * 256 * 1024 + (u.pn & 3) * 256) * 2; d.res = nullptr; d.ld = 1024; d.mode = 0; d.ncol = 256; d.scale = 1.f; } };
struct D2 { static constexpr int MODES = 7; unsigned char* ws;
    __device__ __forceinline__ void get(const pg8::Unit& u, pg8::Dst& d) const { const int sec = u.pn >> 2, cc = (u.pn & 3) * 256; d.res = nullptr; d.ncol = 256; d.scale = 1.f;
        if (sec < 3) { d.base = ws + OFF_QB + (size_t)sec * (64 * MB) + ((size_t)u.pm * 256 * 1024 + cc) * 2; d.ld = 1024; d.mode = sec == 0 ? 1 : (sec == 1 ? 2 : 0); }
        else { d.base = ws + OFF_Y + ((size_t)u.pm * 256 * 2048 + 1024 + cc) * 2; d.ld = 2048; d.mode = 2; } } };
struct D4 { static constexpr int MODES = 32; unsigned char* out; const float* x;
    __device__ __forceinline__ void get(const pg8::Unit& u, pg8::Dst& d) const { const size_t o = (size_t)u.pm * 256 * 1024 + u.pn * 256;
        d.base = out + o * 4; d.res = x + o; d.ld = 1024; d.mode = 5; d.ncol = 256; d.scale = 1.f; } };
struct D5 { static constexpr int MODES = 133; unsigned char* ws;
    __device__ __forceinline__ void get(const pg8::Unit& u, pg8::Dst& d) const { const int pn = u.pn; d.res = nullptr; d.ncol = 256; d.scale = 1.f;
        if (pn < 4) { d.base = ws + OFF_TMP + ((size_t)u.pm * 256 * 1024 + pn * 256) * 2; d.ld = 1024; d.mode = 0; }
        else if (pn == 4) { d.base = ws + OFF_CKVN + (size_t)u.pm * 256 * 256 * 2; d.ld = 256; d.mode = 0; }
        else if (pn == 5) { d.base = ws + OFF_QI + (size_t)u.pm * 256 * 256 * 2; d.ld = 256; d.mode = 7; d.scale = 0.125f; }
        else if (pn == 6) { d.base = ws + OFF_KI + (size_t)u.pm * 256 * 64 * 2; d.ld = 64; d.mode = 7; d.ncol = 64; }
        else { d.base = ws + OFF_Z + ((size_t)u.pm * 256 * 1024 + (pn - 7) * 256) * 2; d.ld = 1024; d.mode = 2; } } };
struct DK { static constexpr int MODES = 64; unsigned char* ws;
    __device__ __forceinline__ void get(const pg8::Unit& u, pg8::Dst& d) const {
        d.base = ws + OFF_RK + ((size_t)u.pm * 256 * 16 + u.pn * 4) * 2; d.res = nullptr; d.ld = 16; d.mode = 6; d.ncol = 256; d.scale = 1.f; } };
struct D8 { static constexpr int MODES = 32; unsigned char* out;
    __device__ __forceinline__ void get(const pg8::Unit& u, pg8::Dst& d) const { const size_t o = (size_t)u.pm * 256 * 1024 + u.pn * 256;
        d.base = out + o * 4; d.res = (const float*)out + o; d.ld = 1024; d.mode = 5; d.ncol = 256; d.scale = 1.f; } };
template <class DF>
__device__ __forceinline__ void fast_gemm(unsigned char* lds, const bf16_t* A, int lda, const bf16_t* Bt, int ldb, int N, int K, const DF& df) {
    pg8::Gemm g{A, lda, Bt, ldb, T, N, K}; pg8::StaticOrder S; S.init(T, N, (int)gridDim.x, (int)blockIdx.x);
    pg8::EpiGen<DF> E{df};
    pg8::gemm_phase(( LAS unsigned char*)lds, g, S, E);
}

__device__ __forceinline__ void tconv(const float* __restrict__ src, int ld, int col0, int ncols, int K, bf16_t* __restrict__ dst, float* tile  ) {
    const int nkt = K / 64, ntiles = nkt * (ncols / 64), tid = threadIdx.x;
    for (int id = blockIdx.x; id < ntiles; id += gridDim.x) {
        const int kt = id % nkt, nt = id / nkt;
#pragma unroll
        for (int j = 0; j < 8; ++j) { const int e = tid + 512 * j, kk = e >> 6, nn = e & 63; tile[kk * 65 + nn] = src[(size_t)(kt * 64 + kk) * ld + col0 + nt * 64 + nn]; }
        __syncthreads();
#pragma unroll
        for (int j = 0; j < 8; ++j) { const int e = tid + 512 * j, nn = e >> 6, kk = e & 63; dst[(size_t)(nt * 64 + nn) * K + kt * 64 + kk] = f2bf(tile[kk * 65 + nn]); }
        __syncthreads();
    }
}
template <int NE>
__device__ __forceinline__ void rmsnorm_rows(const float* __restrict__ src, const float* __restrict__ g, bf16_t* __restrict__ dst,
                             const float* __restrict__ Wx, int ldw, int col0, const float* __restrict__ bias, float scale, float* __restrict__ dstx, float* wl) {
    const int lane = threadIdx.x & 63, wave = threadIdx.x >> 6;
    __syncthreads();
    for (int i = threadIdx.x; i < NE * 1024; i += 512) { const int k = i / NE, e = i % NE; wl[e * 1024 + k] = Wx[(size_t)k * ldw + col0 + e]; }
    __syncthreads();
    for (int row = blockIdx.x * 8 + wave; row < T; row += gridDim.x * 8) {
        f32x4 v[4]; float ss = 0.f;
#pragma unroll
        for (int i = 0; i < 4; ++i) { v[i] = *(const f32x4*)(src + (size_t)row * 1024 + i * 256 + lane * 4); ss += v[i][0] * v[i][0] + v[i][1] * v[i][1] + v[i][2] * v[i][2] + v[i][3] * v[i][3]; }
        ss = wave_sum(ss);
        const float rstd = rsqrtf(ss * (1.0f / 1024.0f) + EPS);
        float ex[NE];
#pragma unroll
        for (int e = 0; e < NE; ++e) ex[e] = 0.f;
#pragma unroll
        for (int i = 0; i < 4; ++i) {
            const f32x4 gg = *(const f32x4*)(g + i * 256 + lane * 4);
            f32x4 y; y[0] = v[i][0] * rstd * gg[0]; y[1] = v[i][1] * rstd * gg[1]; y[2] = v[i][2] * rstd * gg[2]; y[3] = v[i][3] * rstd * gg[3];
            u32x2 w; w.x = pk2(y[0], y[1]); w.y = pk2(y[2], y[3]);
            *(u32x2*)(dst + (size_t)row * 1024 + i * 256 + lane * 4) = w;
#pragma unroll
            for (int e = 0; e < NE; ++e) { const f32x4 wv = *(const f32x4*)(wl + e * 1024 + i * 256 + lane * 4); ex[e] += y[0] * wv[0] + y[1] * wv[1] + y[2] * wv[2] + y[3] * wv[3]; }
        }
#pragma unroll
        for (int e = 0; e < NE; ++e) { const float s = wave_sum(ex[e]); if (lane == 0) dstx[(size_t)row * NE + e] = (s + (bias ? bias[e] : 0.f)) * scale; }
    }
}

__device__ __forceinline__ void phase_prep(const P& p, unsigned char* lds) {
    float* tile = (float*)lds; unsigned char* ws = p.ws;
    bf16_t* W0T = (bf16_t*)(ws + OFF_W0T);
    tconv(p.e_w_in, EIN, 0, 5120, 1024, W0T, tile);
    tconv(p.e_w_in, EIN, 6152, 1024, 1024, W0T + (size_t)6144 * 1024, tile);
    for (int g = 0; g < 4; ++g) tconv(p.e_w_pool + (size_t)g * 65536, 256, 0, 256, 256, (bf16_t*)(ws + OFF_WPT) + (size_t)g * 65536, tile);
    { bf16_t* WUB = (bf16_t*)(ws + OFF_WUB);
      for (size_t i = (size_t)blockIdx.x * 512 + threadIdx.x; i < (size_t)1024 * 256; i += (size_t)gridDim.x * 512) {
          const size_t k = i >> 8; const int c4 = (int)(i & 255) * 4; const f32x4 v = *(const f32x4*)(p.e_w_in + k * EIN + 5128 + c4);
          u32x2 o; o.x = pk2(v[0], v[1]); o.y = pk2(v[2], v[3]); *(u32x2*)(WUB + k * 1024 + c4) = o; } }
    tconv(p.e_w_out, 1024, 0, 1024, 2048, (bf16_t*)(ws + OFF_WO0T), tile);
    bf16_t* W1T = (bf16_t*)(ws + OFF_W1T);
    tconv(p.o_w_in, OIN, 0, 1600, 1024, W1T, tile);
    for (size_t i = (size_t)blockIdx.x * 512 + threadIdx.x; i < (size_t)192 * 1024; i += (size_t)gridDim.x * 512) W1T[(size_t)1600 * 1024 + i] = 0;
    tconv(p.o_w_in, OIN, 1604, 1024, 1024, W1T + (size_t)1792 * 1024, tile);
    {
        bf16_t* WUKP = (bf16_t*)(ws + OFF_WUKP); bf16_t* WQP = (bf16_t*)(ws + OFF_WQP);
        for (size_t i = (size_t)blockIdx.x * 512 + threadIdx.x; i < (size_t)1024 * 256; i += (size_t)gridDim.x * 512) {
            { const int n = (int)(i >> 8), k = (int)(i & 255), pn = n >> 8, rem = n & 255, bj = rem >> 7, wc = (rem >> 5) & 3, x = rem & 31;
              WUKP[i] = f2bf(p.o_w_uk[(size_t)k * 1024 + (4 * pn + wc) * 64 + 32 * bj + x]); }
            { const int d = (int)(i & 63), r = (int)((i >> 6) & 255), h = (int)(i >> 14);
              WQP[i] = f2bf(p.o_w_uk[(size_t)r * 1024 + h * 64 + d] * p.o_g_k[d] * 0.125f); }
        }
    }
    tconv(p.o_w_uv, 1024, 0, 1024, 256, (bf16_t*)(ws + OFF_WUVT), tile);
    tconv(p.o_w_out, 1024, 0, 1024, 1024, (bf16_t*)(ws + OFF_WO1T), tile);
    rmsnorm_rows<8>(p.x, p.e_norm, (bf16_t*)(ws + OFF_XN), p.e_w_in, EIN, 5120, p.e_b_if, 1.0f, (float*)(ws + OFF_GATES), (float*)lds);
}

__device__ __forceinline__ void phase_conv_scan(const P& p, unsigned char* lds) {
    unsigned char* ws = p.ws; const int tid = threadIdx.x;
    const float* GATES = (const float*)(ws + OFF_GATES);
    float *BQ = (float*)(ws + OFF_BQ), *IQ = (float*)(ws + OFF_IQ), *MT = (float*)(ws + OFF_MT), *CH = (float*)(ws + OFF_CH);
    {
        const int lane = tid & 63, wave = tid >> 6;
        for (int task = blockIdx.x * 8 + wave; task < 2048; task += gridDim.x * 8) {
            const int bh = task >> 8, c = task & 255, batch = bh >> 2, head = bh & 3; const size_t t = (size_t)batch * SEQ + c * 64 + lane;
            const float ig = GATES[t * 8 + head], f = GATES[t * 8 + 4 + head];
            float b = fminf(f, 0.f) - log1pf(__expf(-fabsf(f)));
#pragma unroll
            for (int o = 1; o < 64; o <<= 1) { const float y = __shfl_up(b, o); if (lane >= o) b += y; }
            float rm = ig - b;
#pragma unroll
            for (int o = 1; o < 64; o <<= 1) { const float y = __shfl_up(rm, o); if (lane >= o) rm = fmaxf(rm, y); }
            BQ[t * 4 + head] = b; IQ[t * 4 + head] = ig; MT[t * 4 + head] = rm;
            if (lane == 63) { CH[4096 + bh * 256 + c] = b; CH[bh * 256 + c] = b + rm; }
        }
    }
    const bf16_t* QB = (const bf16_t*)(ws + OFF_QB); const bf16_t* KB = (const bf16_t*)(ws + OFF_KB);
    bf16_t* Y = (bf16_t*)(ws + OFF_Y); bf16_t* KT = (bf16_t*)(ws + OFF_TMP);
    for (size_t it = (size_t)blockIdx.x * 512 + tid; it < (size_t)T * 256; it += (size_t)gridDim.x * 512) {
        const size_t t = it >> 8; const int c0 = (int)(it & 255) * 8, isk = c0 >= 1024, cc = c0 & 1023; const int s = (int)(t & (SEQ - 1));
        const bf16_t* src = isk ? KB : QB;
        float acc[8];
#pragma unroll
        for (int i = 0; i < 8; ++i) acc[i] = 0.f;
#pragma unroll
        for (int j = 0; j < 4; ++j) {
            if (s - 3 + j >= 0) {
                const u32x4 w = *(const u32x4*)(src + (t - 3 + j) * 1024 + cc);
                const f32x4 c0v = *(const f32x4*)(p.e_conv + j * 2048 + c0), c1v = *(const f32x4*)(p.e_conv + j * 2048 + c0 + 4);
                acc[0] += c0v[0] * bflo(w.x); acc[1] += c0v[1] * bfhi(w.x); acc[2] += c0v[2] * bflo(w.y); acc[3] += c0v[3] * bfhi(w.y);
                acc[4] += c1v[0] * bflo(w.z); acc[5] += c1v[1] * bfhi(w.z); acc[6] += c1v[2] * bflo(w.w); acc[7] += c1v[3] * bfhi(w.w);
            }
        }
        const float sc = isk ? 0.0625f : 1.0f;
        u32x4 o; o.x = pk2(siluf_(acc[0]) * sc, siluf_(acc[1]) * sc); o.y = pk2(siluf_(acc[2]) * sc, siluf_(acc[3]) * sc);
        o.z = pk2(siluf_(acc[4]) * sc, siluf_(acc[5]) * sc); o.w = pk2(siluf_(acc[6]) * sc, siluf_(acc[7]) * sc);
        if (isk) *(u32x4*)(KT + t * 1024 + cc) = o; else *(u32x4*)(Y + t * 2048 + 1024 + cc) = o;
    }
}

typedef float f32x16 __attribute__((ext_vector_type(16)));
constexpr int ML_RS = 528, ML_WS = 144;
__device__ __forceinline__ bf16x8 ml_tr8(const LAS unsigned char* a, int second_off) {
    const v4i16_t t0 = __builtin_amdgcn_ds_read_tr16_b64_v4i16((LAS v4i16_t*)a);
    const v4i16_t t1 = __builtin_amdgcn_ds_read_tr16_b64_v4i16((LAS v4i16_t*)(a + second_off));
    bf16x8 r; r[0] = t0[0]; r[1] = t0[1]; r[2] = t0[2]; r[3] = t0[3]; r[4] = t1[0]; r[5] = t1[1]; r[6] = t1[2]; r[7] = t1[3]; return r;
}
__device__ __forceinline__ void mlstm_chunk_scan(const float* CH, int bh, LAS float* sB, LAS float* sMp, LAS float* sMn) {
    const int tid = threadIdx.x;
    if (tid < 256) { sB[tid] = CH[4096 + bh * 256 + tid]; sMn[tid] = CH[bh * 256 + tid]; }
    __syncthreads();
    if (tid == 0) { float m = 0.f; for (int c = 0; c < 256; ++c) { const float g = sMn[c]; sMp[c] = m; m = fmaxf(sB[c] + m, g); sMn[c] = m; } }
    __syncthreads();
}
template <bool FULL>
__device__ __forceinline__ void mlstm_units(const P& p, unsigned char* lds_) {
    unsigned char* ws = p.ws; const int tid0 = threadIdx.x;
    const int w = __builtin_amdgcn_readfirstlane(tid0 >> 6);
    const bf16_t* Yq = (const bf16_t*)(ws + OFF_Y); bf16_t* Yo = (bf16_t*)(ws + OFF_Y);
    const bf16_t* KT = (const bf16_t*)(ws + OFF_TMP); const bf16_t* VB = (const bf16_t*)(ws + OFF_VB);
    float* ST = (float*)(ws + OFF_QB); float* NS = (float*)(ws + OFF_NS);
    const float *BQ = (const float*)(ws + OFF_BQ), *IQ = (const float*)(ws + OFF_IQ), *MT = (const float*)(ws + OFF_MT), *CH = (const float*)(ws + OFF_CH);
    LAS unsigned char* Qs = (LAS unsigned char*)lds_;
    LAS unsigned char* Ks = Qs + 64 * ML_RS;
    LAS unsigned char* Vs = Ks + 64 * ML_RS;
    LAS unsigned char* Wl = Vs + 64 * ML_RS;
    LAS float* sa = (LAS float*)(Wl + 64 * ML_WS);
    LAS float* sden = sa + 64; LAS float* ssw = sden + 64; LAS float* sf = ssw + 64; LAS float* sg = sf + 64; LAS float* nd = sg + 64; LAS float* rden = nd + 64; LAS float* ns = rden + 64;
    LAS float* cB = ns + 256; LAS float* cMp = cB + 256; LAS float* cMn = cMp + 256;
    for (int unit = blockIdx.x; unit < 256; unit += gridDim.x) {
        const int bh = unit >> 5, S = unit & 31, batch = bh >> 2, head = bh & 3;
        const int tid = tid0, lane = tid0 & 63, hh = lane >> 5;
        __syncthreads();
        mlstm_chunk_scan(CH, bh, cB, cMp, cMn);
        f32x16 st[8]; float nreg = 0.f;
        if (FULL) {
#pragma unroll
            for (int kt = 0; kt < 8; ++kt) {
                int lz = lane; asm volatile("" : "+v"(lz) :: "memory");
                const float* sp = ST + (size_t)unit * 65536 + 32 * w + (lz & 31) + (size_t)(32 * kt + 4 * (lz >> 5)) * 256;
#pragma unroll
                for (int r = 0; r < 16; ++r) st[kt][r] = sp[((r & 3) + 8 * (r >> 2)) * 256];
            }
            if (tid < 256) nreg = NS[unit * 256 + tid];
        } else {
#pragma unroll
            for (int kt = 0; kt < 8; ++kt)
#pragma unroll
                for (int r = 0; r < 16; ++r) st[kt][r] = 0.f;
        }
#pragma unroll 1
        for (int cc = 0; cc < 8; ++cc) {
            int tid = tid0; asm volatile("" : "+v"(tid));
            const int lane = tid & 63, l31 = lane & 31, hh = lane >> 5, fr = lane & 15, fq = lane >> 4;
            const int trow = 8 * hh + (fr >> 2), tcol = (16 * (fq & 1) + 4 * (fr & 3)) * 2;
            const int ch = S * 8 + cc; const size_t t0 = (size_t)batch * SEQ + ch * 64;
            const float mprev = cMp[ch], mnew = cMn[ch], blast = cB[ch];
            const float decay = __expf(blast + mprev - mnew);
            __syncthreads();
#pragma unroll
            for (int j = 0; j < 4; ++j) { const int e = tid + 512 * j, r = e >> 5, cg = e & 31;
                *(LAS u32x4*)(Ks + r * ML_RS + cg * 16) = *(const u32x4*)(KT + (t0 + r) * 1024 + head * 256 + cg * 8);
                *(LAS u32x4*)(Vs + r * ML_RS + cg * 16) = *(const u32x4*)(VB + (t0 + r) * 1024 + head * 256 + cg * 8);
                if (FULL) *(LAS u32x4*)(Qs + r * ML_RS + cg * 16) = *(const u32x4*)(Yq + (t0 + r) * 2048 + 1024 + head * 256 + cg * 8); }
            if (tid < 64) { const float bq = BQ[(t0 + tid) * 4 + head], iq = IQ[(t0 + tid) * 4 + head], mt = bq + fmaxf(mprev, MT[(t0 + tid) * 4 + head]);
                sa[tid] = __expf(bq + mprev - mt); sden[tid] = __expf(-mt); ssw[tid] = __expf(blast - bq + iq - mnew); sf[tid] = bq - mt; sg[tid] = iq - bq; }
            if (FULL && tid < 256) ns[tid] = nreg;
            __syncthreads();
            bf16x8 bv[4];
            if (!FULL) {
#pragma unroll
                for (int ks = 0; ks < 4; ++ks) bv[ks] = ml_tr8(Vs + (16 * ks + trow) * ML_RS + 64 * w + tcol, 4 * ML_RS);
            }
            if (FULL) {
                { const int tt = w >> 1;
#pragma unroll
                  for (int si = 0; si < 2; ++si) { const int ss = 2 * (w & 1) + si;
                    f32x4 acc = (f32x4){0.f, 0.f, 0.f, 0.f};
                    if (ss <= tt) {
#pragma unroll
                        for (int ks = 0; ks < 8; ++ks) { const bf16x8 a = *(const LAS bf16x8*)(Qs + (16 * tt + fr) * ML_RS + (32 * ks + 8 * fq) * 2), b = *(const LAS bf16x8*)(Ks + (16 * ss + fr) * ML_RS + (32 * ks + 8 * fq) * 2);
                            acc = __builtin_amdgcn_mfma_f32_16x16x32_bf16(a, b, acc, 0, 0, 0); } }
                    const int sidx = 16 * ss + fr; const float gs = sg[sidx];
#pragma unroll
                    for (int j = 0; j < 4; ++j) { const int tix = 16 * tt + 4 * fq + j; const float wv = (sidx <= tix) ? __expf(sf[tix] + gs) * acc[j] : 0.f;
                        *(LAS bf16_t*)(Wl + tix * ML_WS + sidx * 2) = f2bf(wv); } } }
#pragma unroll
                for (int i = 0; i < 8; ++i) { const int tix = 8 * w + i; const u32x2 qv = *(const LAS u32x2*)(Qs + tix * ML_RS + lane * 8); const f32x4 nv = *(const LAS f32x4*)(ns + lane * 4);
                    float part = bflo(qv.x) * nv[0] + bfhi(qv.x) * nv[1] + bflo(qv.y) * nv[2] + bfhi(qv.y) * nv[3]; part = wave_sum(part); if (lane == 0) nd[tix] = part; }
                __syncthreads();
                f32x16 acc[2];
#pragma unroll
                for (int t2 = 0; t2 < 2; ++t2) {
#pragma unroll
                    for (int r = 0; r < 16; ++r) acc[t2][r] = 0.f;
                }
#pragma unroll
                for (int kt = 0; kt < 8; ++kt) {
                    asm volatile("" ::: "memory");
#pragma unroll
                    for (int s2 = 0; s2 < 2; ++s2) {
                        u32x4 bw; bw.x = pg8::cvt_pk_bf16(st[kt][8 * s2 + 0], st[kt][8 * s2 + 1]); bw.y = pg8::cvt_pk_bf16(st[kt][8 * s2 + 2], st[kt][8 * s2 + 3]);
                        bw.z = pg8::cvt_pk_bf16(st[kt][8 * s2 + 4], st[kt][8 * s2 + 5]); bw.w = pg8::cvt_pk_bf16(st[kt][8 * s2 + 6], st[kt][8 * s2 + 7]);
                        const bf16x8 bfrag = __builtin_bit_cast(bf16x8, bw);
#pragma unroll
                        for (int t2 = 0; t2 < 2; ++t2) { const LAS unsigned char* qa = Qs + (32 * t2 + l31) * ML_RS + (32 * kt + 16 * s2 + 4 * hh) * 2;
                            const u32x2 lo = *(const LAS u32x2*)qa, hi = *(const LAS u32x2*)(qa + 16); u32x4 aw; aw.x = lo.x; aw.y = lo.y; aw.z = hi.x; aw.w = hi.y;
                            acc[t2] = __builtin_amdgcn_mfma_f32_32x32x16_bf16(__builtin_bit_cast(bf16x8, aw), bfrag, acc[t2], 0, 0, 0); }
                    }
                }
                asm volatile("" ::: "memory");
#pragma unroll
                for (int t2 = 0; t2 < 2; ++t2)
#pragma unroll
                    for (int r = 0; r < 16; ++r) acc[t2][r] *= sa[32 * t2 + (r & 3) + 8 * (r >> 2) + 4 * hh];
#pragma unroll
                for (int ks = 0; ks < 4; ++ks) bv[ks] = ml_tr8(Vs + (16 * ks + trow) * ML_RS + 64 * w + tcol, 4 * ML_RS);
#pragma unroll
                for (int ks = 0; ks < 4; ++ks)
#pragma unroll
                    for (int t2 = 0; t2 < 2; ++t2) { const bf16x8 a = *(const LAS bf16x8*)(Wl + (32 * t2 + l31) * ML_WS + (16 * ks + 8 * hh) * 2);
                        acc[t2] = __builtin_amdgcn_mfma_f32_32x32x16_bf16(a, bv[ks], acc[t2], 0, 0, 0); }
#pragma unroll
                for (int i = 0; i < 8; ++i) { const int tix = 8 * w + i; float rs = bf2f(*(const LAS bf16_t*)(Wl + tix * ML_WS + lane * 2)); rs = wave_sum(rs);
                    if (lane == 0) { const float nq = sa[tix] * nd[tix] + rs; rden[tix] = 1.0f / fmaxf(fabsf(nq), sden[tix]); } }
                __syncthreads();
                bf16_t* yo = Yo + t0 * 2048 + head * 256 + 32 * w + l31;
#pragma unroll
                for (int t2 = 0; t2 < 2; ++t2)
#pragma unroll
                    for (int r = 0; r < 16; ++r) { const int tix = 32 * t2 + (r & 3) + 8 * (r >> 2) + 4 * hh; yo[(size_t)tix * 2048] = f2bf(acc[t2][r] * rden[tix]); }
            }
#pragma unroll
            for (int kt = 0; kt < 8; ++kt) st[kt] *= decay;
#pragma unroll
            for (int ks = 0; ks < 4; ++ks) {
                const u32x4 raw = __builtin_bit_cast(u32x4, bv[ks]); const LAS float* sw8 = ssw + 16 * ks + 8 * hh;
                u32x4 sc; sc.x = pg8::cvt_pk_bf16(bflo(raw.x) * sw8[0], bfhi(raw.x) * sw8[1]); sc.y = pg8::cvt_pk_bf16(bflo(raw.y) * sw8[2], bfhi(raw.y) * sw8[3]);
                sc.z = pg8::cvt_pk_bf16(bflo(raw.z) * sw8[4], bfhi(raw.z) * sw8[5]); sc.w = pg8::cvt_pk_bf16(bflo(raw.w) * sw8[6], bfhi(raw.w) * sw8[7]);
                const bf16x8 bs = __builtin_bit_cast(bf16x8, sc);
#pragma unroll
                for (int kt = 0; kt < 8; ++kt) { if ((kt & 3) == 0) asm volatile("" ::: "memory");
                    const bf16x8 a = ml_tr8(Ks + (16 * ks + trow) * ML_RS + 64 * kt + tcol, 4 * ML_RS);
                    st[kt] = __builtin_amdgcn_mfma_f32_32x32x16_bf16(a, bs, st[kt], 0, 0, 0); }
            }
            if (tid < 256) { float nacc = 0.f;
#pragma unroll 8
                for (int s2 = 0; s2 < 64; ++s2) nacc += ssw[s2] * bf2f(*(const LAS bf16_t*)(Ks + s2 * ML_RS + tid * 2));
                nreg = decay * nreg + nacc; }
        }
        if (!FULL) {
#pragma unroll
            for (int kt = 0; kt < 8; ++kt) {
                int lz = lane; asm volatile("" : "+v"(lz) :: "memory");
                float* sp = ST + (size_t)unit * 65536 + 32 * w + (lz & 31) + (size_t)(32 * kt + 4 * (lz >> 5)) * 256;
#pragma unroll
                for (int r = 0; r < 16; ++r) sp[((r & 3) + 8 * (r >> 2)) * 256] = st[kt][r];
            }
            if (tid < 256) NS[unit * 256 + tid] = nreg;
        }
    }
}
__device__ __forceinline__ void phase_mlstm_scan(const P& p, unsigned char* lds_) {
    unsigned char* ws = p.ws; const int tid = threadIdx.x;
    float* ST = (float*)(ws + OFF_QB); float* NS = (float*)(ws + OFF_NS); const float* CH = (const float*)(ws + OFF_CH);
    LAS float* DS = (LAS float*)lds_;
    LAS float* cB = DS + 256; LAS float* cMp = cB + 256; LAS float* cMn = cMp + 256;
    for (int bh = 0; bh < 8; ++bh) {
        __syncthreads();
        mlstm_chunk_scan(CH, bh, cB, cMp, cMn);
        if (tid < 32) { float d = 1.f; for (int c = 0; c < 8; ++c) { const int ch = tid * 8 + c; d *= __expf(cB[ch] + cMp[ch] - cMn[ch]); } DS[bh * 32 + tid] = d; }
    }
    __syncthreads();
    const int per = 65536 + 256;
    for (int it = blockIdx.x * 512 + tid; it < 8 * per; it += gridDim.x * 512) {
        const int bh = it / per, e = it - bh * per;
        float* base; size_t stride;
        if (e < 65536) { base = ST + (size_t)bh * 32 * 65536 + e; stride = 65536; } else { base = NS + (size_t)bh * 32 * 256 + (e - 65536); stride = 256; }
        float carry = 0.f;
#pragma unroll 8
        for (int S = 0; S < 32; ++S) { const float tmp = base[S * stride]; base[S * stride] = carry; carry = DS[bh * 32 + S] * carry + tmp; }
    }
}

__device__ __forceinline__ void phase_ya_pool(const P& p) {
    unsigned char* ws = p.ws; const int tid = threadIdx.x, lane = tid & 63, wave = tid >> 6;
    bf16_t* Y = (bf16_t*)(ws + OFF_Y); const bf16_t* O = (const bf16_t*)(ws + OFF_QB); const bf16_t* ZA = (const bf16_t*)(ws + OFF_KB);
    for (int it = blockIdx.x * 8 + wave; it < T * 4; it += gridDim.x * 8) {
        const size_t t = (size_t)(it >> 2); const int head = it & 3, c = head * 256 + lane * 4;
        const u32x2 hw = *(const u32x2*)(Y + t * 2048 + c), ow = *(const u32x2*)(O + t * 1024 + c), zw = *(const u32x2*)(ZA + t * 1024 + c);
        float v[4] = {bflo(hw.x) * bflo(ow.x), bfhi(hw.x) * bfhi(ow.x), bflo(hw.y) * bflo(ow.y), bfhi(hw.y) * bfhi(ow.y)};
        float ss = wave_sum(v[0] * v[0] + v[1] * v[1] + v[2] * v[2] + v[3] * v[3]);
        const float rstd = rsqrtf(ss * (1.0f / 256.0f) + EPS);
        const f32x4 g = *(const f32x4*)(p.e_g_head + c);
        u32x2 o; o.x = pk2(v[0] * rstd * g[0] * bflo(zw.x), v[1] * rstd * g[1] * bfhi(zw.x)); o.y = pk2(v[2] * rstd * g[2] * bflo(zw.y), v[3] * rstd * g[3] * bfhi(zw.y));
        *(u32x2*)(Y + t * 2048 + c) = o;
    }
    const bf16_t* U = (const bf16_t*)(ws + OFF_VB);
    for (size_t it = (size_t)blockIdx.x * 512 + tid; it < (size_t)T * 128; it += (size_t)gridDim.x * 512) {
        const size_t t = it >> 7; const int c0 = (int)(it & 127) * 8, g = c0 >> 8, win = 2 << g, s = (int)(t & (SEQ - 1)); const int cnt = (s + 1 < win) ? s + 1 : win;
        float acc[8], self[8];
#pragma unroll
        for (int i = 0; i < 8; ++i) { acc[i] = 0.f; self[i] = 0.f; }
        for (int j = 0; j < cnt; ++j) { const u32x4 w = *(const u32x4*)(U + (t - j) * 1024 + c0);
            const float f[8] = {bflo(w.x), bfhi(w.x), bflo(w.y), bfhi(w.y), bflo(w.z), bfhi(w.z), bflo(w.w), bfhi(w.w)};
#pragma unroll
            for (int i = 0; i < 8; ++i) { acc[i] += f[i]; if (j == 0) self[i] = f[i]; } }
        const float inv = 1.0f / (float)cnt;
        bf16_t* yp = Y + t * 2048 + 1024 + c0; const u32x4 z = *(const u32x4*)yp;
        const float zf[8] = {bflo(z.x), bfhi(z.x), bflo(z.y), bfhi(z.y), bflo(z.z), bfhi(z.z), bflo(z.w), bfhi(z.w)};
        const f32x4 s0 = *(const f32x4*)(p.e_s_pool + c0), s1 = *(const f32x4*)(p.e_s_pool + c0 + 4);
        float o[8];
#pragma unroll
        for (int i = 0; i < 8; ++i) o[i] = (acc[i] * inv - self[i]) * (i < 4 ? s0[i] : s1[i - 4]) * zf[i];
        u32x4 ow; ow.x = pk2(o[0], o[1]); ow.y = pk2(o[2], o[3]); ow.z = pk2(o[4], o[5]); ow.w = pk2(o[6], o[7]);
        *(u32x4*)yp = ow;
    }
}

__device__ __forceinline__ void headnorm64(bf16_t* X, const float* g) {
    const int lane = threadIdx.x & 63, wave = threadIdx.x >> 6;
    for (int t = blockIdx.x * 8 + wave; t < T; t += gridDim.x * 8) {
        bf16_t* r = X + (size_t)t * 1024 + lane * 16;
        const u32x4 a = *(const u32x4*)r, b = *(const u32x4*)(r + 8);
        float f[16] = {bflo(a.x), bfhi(a.x), bflo(a.y), bfhi(a.y), bflo(a.z), bfhi(a.z), bflo(a.w), bfhi(a.w), bflo(b.x), bfhi(b.x), bflo(b.y), bfhi(b.y), bflo(b.z), bfhi(b.z), bflo(b.w), bfhi(b.w)};
        float ss = 0.f;
#pragma unroll
        for (int i = 0; i < 16; ++i) ss += f[i] * f[i];
        ss += __shfl_xor(ss, 1); ss += __shfl_xor(ss, 2);
        const float rstd = rsqrtf(ss * (1.0f / 64.0f) + EPS);
        const float* gg = g + (lane & 3) * 16;
#pragma unroll
        for (int i = 0; i < 16; ++i) f[i] = f[i] * rstd * gg[i];
        u32x4 oa, ob; oa.x = pk2(f[0], f[1]); oa.y = pk2(f[2], f[3]); oa.z = pk2(f[4], f[5]); oa.w = pk2(f[6], f[7]);
        ob.x = pk2(f[8], f[9]); ob.y = pk2(f[10], f[11]); ob.z = pk2(f[12], f[13]); ob.w = pk2(f[14], f[15]);
        *(u32x4*)r = oa; *(u32x4*)(r + 8) = ob;
    }
}
__device__ __forceinline__ void phase_qnorm_ckvnorm(const P& p) {
    unsigned char* ws = p.ws; const int lane = threadIdx.x & 63, wave = threadIdx.x >> 6;
    headnorm64((bf16_t*)(ws + OFF_TMP), p.o_g_q);
    bf16_t* CKVN = (bf16_t*)(ws + OFF_CKVN);
    for (int t = blockIdx.x * 8 + wave; t < T; t += gridDim.x * 8) {
        const u32x2 w = *(const u32x2*)(CKVN + (size_t)t * 256 + lane * 4);
        const float v[4] = {bflo(w.x), bfhi(w.x), bflo(w.y), bfhi(w.y)};
        const float ss = wave_sum(v[0] * v[0] + v[1] * v[1] + v[2] * v[2] + v[3] * v[3]);
        const float rstd = rsqrtf(ss * (1.0f / 256.0f) + EPS);
        const f32x4 g = *(const f32x4*)(p.o_g_kv + lane * 4);
        u32x2 o; o.x = pk2(v[0] * rstd * g[0], v[1] * rstd * g[1]); o.y = pk2(v[2] * rstd * g[2], v[3] * rstd * g[3]);
        *(u32x2*)(CKVN + (size_t)t * 256 + lane * 4) = o;
    }
}

__device__ __forceinline__ unsigned okey(float s) { if (s == 0.f) s = 0.f; const unsigned u = __float_as_uint(s); return (u & 0x80000000u) ? ~u : (u | 0x80000000u); }

__device__ __forceinline__ void indexer_slow_query(const P& p, unsigned char* lds, size_t t) {
    unsigned char* ws = p.ws; const int tid = threadIdx.x, lane = tid & 63, wave = tid >> 6;
    const _Float16* QI = (const _Float16*)(ws + OFF_QI); const _Float16* KI = (const _Float16*)(ws + OFF_KI); const float* WI = (const float*)(ws + OFF_WI);
    unsigned short* IDX = (unsigned short*)(ws + OFF_IDX);
    unsigned* sc = (unsigned*)lds; unsigned* hist = sc + 16384; float* qs = (float*)(hist + 256); unsigned* misc = (unsigned*)(qs + 256); unsigned* wsum = misc + 16;
    const int batch = (int)(t >> 14), pos = (int)(t & (SEQ - 1)), n = pos + 1;
    __syncthreads();
    if (tid < 256) qs[tid] = (float)QI[t * 256 + tid];
    const float w0 = WI[t * 4 + 0], w1 = WI[t * 4 + 1], w2 = WI[t * 4 + 2], w3 = WI[t * 4 + 3];
    __syncthreads();
    const _Float16* kbase = KI + (size_t)batch * SEQ * 64;
    for (int s = tid; s < n; s += 512) {
        asm volatile("" ::: "memory");
        typedef _Float16 h8 __attribute__((ext_vector_type(8)));
        const h8* kr = (const h8*)(kbase + (size_t)s * 64);
        float d0 = 0.f, d1 = 0.f, d2 = 0.f, d3 = 0.f;
#pragma unroll
        for (int j = 0; j < 8; ++j) { const h8 kv = kr[j];
#pragma unroll
            for (int e = 0; e < 8; ++e) { const int d = j * 8 + e; const float kf = (float)kv[e]; d0 += qs[d] * kf; d1 += qs[64 + d] * kf; d2 += qs[128 + d] * kf; d3 += qs[192 + d] * kf; } }
        float score = w0 * fmaxf(d0, 0.f); score = fmaf(w1, fmaxf(d1, 0.f), score); score = fmaf(w2, fmaxf(d2, 0.f), score); score = fmaf(w3, fmaxf(d3, 0.f), score);
        sc[s] = okey(score);
    }
    unsigned prefix = 0, krem = 256;
    for (int pass = 0; pass < 4; ++pass) {
        const int shift = 24 - 8 * pass;
        __syncthreads();
        if (tid < 256) hist[tid] = 0;
        __syncthreads();
        for (int s = tid; s < n; s += 512) { const unsigned k = sc[s]; if (pass == 0 || (k >> (shift + 8)) == prefix) atomicAdd(&hist[(k >> shift) & 255u], 1u); }
        __syncthreads();
        if (tid == 0) { unsigned cum = 0; int bin = 255; for (; bin > 0; --bin) { const unsigned c = hist[bin]; if (cum + c >= krem) break; cum += c; } misc[0] = (unsigned)bin; misc[1] = krem - cum; }
        __syncthreads();
        prefix = (prefix << 8) | misc[0]; krem = misc[1];
    }
    const unsigned ngt_total = 256u - krem;
    unsigned lg = 0, le = 0; const int s0 = tid * 32;
    for (int s = s0; s < s0 + 32 && s < n; ++s) { const unsigned k = sc[s]; lg += (k > prefix); le += (k == prefix); }
    unsigned pk = lg | (le << 16), incl = pk;
#pragma unroll
    for (int o = 1; o < 64; o <<= 1) { const unsigned y = __shfl_up(incl, o); if (lane >= o) incl += y; }
    if (lane == 63) wsum[wave] = incl;
    __syncthreads();
    unsigned base = 0;
    for (int w = 0; w < wave; ++w) base += wsum[w];
    const unsigned excl = base + incl - pk; unsigned bg = excl & 0xffffu, be = excl >> 16;
    for (int s = s0; s < s0 + 32 && s < n; ++s) { const unsigned k = sc[s];
        if (k > prefix) { IDX[t * 256 + bg] = (unsigned short)s; ++bg; }
        else if (k == prefix) { if (be < krem) IDX[t * 256 + ngt_total + be] = (unsigned short)s; ++be; } }
    __syncthreads();
}

typedef _Float16 half8 __attribute__((ext_vector_type(8)));
constexpr int IX_CAP = 1024, IX_ZBIN = 1024;
__device__ __forceinline__ unsigned ix_key(const f32x4 a, const f32x4 w) {
    const float r0 = __int_as_float(max(__float_as_int(a[0]), 0)), r1 = __int_as_float(max(__float_as_int(a[1]), 0));
    const float r2 = __int_as_float(max(__float_as_int(a[2]), 0)), r3 = __int_as_float(max(__float_as_int(a[3]), 0));
    float s = fmaf(w[0], r0, 0.0f); s = fmaf(w[1], r1, s); s = fmaf(w[2], r2, s); s = fmaf(w[3], r3, s);
    const unsigned u = __float_as_uint(s);
    return u ^ ((unsigned)((int)u >> 31) | 0x80000000u);
}
#define LDS_ADD(ptr, v) __hip_atomic_fetch_add((ptr), (v), __ATOMIC_RELAXED, __HIP_MEMORY_SCOPE_WORKGROUP)
struct IxTagF { static constexpr bool value = false; }; struct IxTagT { static constexpr bool value = true; };
__device__ __forceinline__ void phase_indexer(const P& p, unsigned char* lds) {
    unsigned char* ws = p.ws; const int tid = threadIdx.x, lane = tid & 63, kl = lane & 15, g = lane >> 4;
    const int wave = __builtin_amdgcn_readfirstlane(tid >> 6);
    const _Float16* QI = (const _Float16*)(ws + OFF_QI); const _Float16* KI = (const _Float16*)(ws + OFF_KI); const float* WI = (const float*)(ws + OFF_WI);
    unsigned short* IDX = (unsigned short*)(ws + OFF_IDX); int* CNT = (int*)(ws + OFF_CNT);
    LAS unsigned* hist = (LAS unsigned*)lds;
    LAS int* qTbin = (LAS int*)(hist + 16 * 2048);
    LAS int* qCab = qTbin + 16; LAS unsigned* qN = (LAS unsigned*)(qCab + 16); LAS int* qOvf = (LAS int*)(qN + 16); LAS int* qZl = qOvf + 16;
    LAS unsigned* ovl = (LAS unsigned*)(lds + 132 * 1024);
    LAS unsigned* h2 = (LAS unsigned*)(lds + 133 * 1024 + wave * 1536);
    LAS unsigned long long* l2 = (LAS unsigned long long*)(h2 + 256);
    if (tid == 0) ovl[0] = 0u;
    const int G = gridDim.x, nround = (T / 16) / G;
#pragma unroll 1
    for (int i = 0; i < nround; ++i) {
        const int tix = (i & 1) ? i * G + (G - 1 - (int)blockIdx.x) : i * G + (int)blockIdx.x;
        const int batch = tix & 1, tb = tix >> 1, p0 = tb * 16; const size_t t0 = (size_t)batch * SEQ + p0;
        __syncthreads();
        if (p0 + 16 <= 256) {
#pragma unroll
            for (int j = 0; j < 8; ++j) { const int e = tid + 512 * j, q = e >> 8, jj = e & 255; IDX[(t0 + q) * 256 + jj] = (unsigned short)(jj <= p0 + q ? jj : 0); }
            if (tid < 16) CNT[t0 + tid] = p0 + tid + 1;
            continue;
        }
#pragma unroll
        for (int j = 0; j < 16; ++j) ((LAS u32x4*)hist)[tid + 512 * j] = (u32x4){0u, 0u, 0u, 0u};
        if (tid < 16) { qN[tid] = 0u; qOvf[tid] = 0; }
        half8 af[4][2]; f32x4 wv[4];
#pragma unroll
        for (int rt = 0; rt < 4; ++rt) {
#pragma unroll
            for (int ks = 0; ks < 2; ++ks) af[rt][ks] = *(const half8*)(QI + (t0 + 4 * rt + (kl >> 2)) * 256 + (kl & 3) * 64 + 32 * ks + 8 * g);
            wv[rt] = *(const f32x4*)(WI + (t0 + 4 * rt + g) * 4);
        }
        __syncthreads();
        const int nblk = tb + 1, L = (nblk + 7) >> 3, b0 = wave * L, b1 = (b0 + L < nblk) ? b0 + L : nblk;
        const _Float16* kb = KI + (size_t)batch * SEQ * 64 + kl * 64 + 8 * g;
        LAS unsigned* hg = hist + g * 4 * 2048;
#define IX_LOADK(u, bb) do { kq[u][0] = *(const half8*)(kb + (size_t)(bb) * 1024); kq[u][1] = *(const half8*)(kb + (size_t)(bb) * 1024 + 32); } while (0)
#define IX_MFMA(acc, k0, k1) do { _Pragma("unroll") for (int rt = 0; rt < 4; ++rt) { acc[rt] = __builtin_amdgcn_mfma_f32_16x16x32_f16(af[rt][0], k0, (f32x4){0.f, 0.f, 0.f, 0.f}, 0, 0, 0); \
            acc[rt] = __builtin_amdgcn_mfma_f32_16x16x32_f16(af[rt][1], k1, acc[rt], 0, 0, 0); } } while (0)
        if (b0 < b1) {
            half8 kq[2][2];
#pragma unroll
            for (int u = 0; u < 2; ++u) { const int bb = (b0 + u < b1) ? b0 + u : b1 - 1; IX_LOADK(u, bb); }
            auto step1 = [&](int bcur, const half8& k0, const half8& k1, auto chkTag) {
                constexpr bool CHK = decltype(chkTag)::value;
                f32x4 acc[4]; IX_MFMA(acc, k0, k1);
#pragma unroll
                for (int rt = 0; rt < 4; ++rt) { const unsigned key = ix_key(acc[rt], wv[rt]);
                    if (!CHK || bcur * 16 + kl <= p0 + 4 * rt + g) LDS_ADD(hg + rt * 2048 + (key >> 21), 1u); }
            };
            int b = b0;
#pragma unroll 1
            for (; b + 2 <= b1 && b + 2 <= nblk - 1; b += 2) {
#pragma unroll
                for (int u = 0; u < 2; ++u) { step1(b + u, kq[u][0], kq[u][1], IxTagF{}); const int bb = (b + 2 + u < b1) ? b + 2 + u : b1 - 1; IX_LOADK(u, bb); }
            }
#pragma unroll 1
            for (; b + 2 <= b1; b += 2) {
#pragma unroll
                for (int u = 0; u < 2; ++u) { step1(b + u, kq[u][0], kq[u][1], IxTagT{}); const int bb = (b + 2 + u < b1) ? b + 2 + u : b1 - 1; IX_LOADK(u, bb); }
            }
            if (b < b1) step1(b, kq[0][0], kq[0][1], IxTagT{});
        }
        __syncthreads();
#pragma unroll 1
        for (int qq = 0; qq < 2; ++qq) {
            const int q = 2 * wave + qq; const LAS unsigned* h = hist + q * 2048;
            unsigned cs = 0; const int top = 2047 - 32 * lane;
#pragma unroll 8
            for (int ii = 0; ii < 32; ++ii) cs += h[top - ((ii + lane) & 31)];
            unsigned incl = cs;
#pragma unroll
            for (int o = 1; o < 64; o <<= 1) { const unsigned y = __shfl_up(incl, o); if (lane >= o) incl += y; }
            const unsigned long long m = __ballot(incl >= 256u);
            const int Ls = m ? (__ffsll((long long)m) - 1) : 63;
            unsigned cabv = __shfl(incl - cs, Ls), cbv = 0; int tbin = 0; bool found = false;
#pragma unroll 8
            for (int ii = 0; ii < 32; ++ii) { const unsigned c = h[2047 - 32 * Ls - ii]; if (!found && cabv + c >= 256u) { tbin = 2047 - 32 * Ls - ii; cbv = c; found = true; } if (!found) cabv += c; }
            if (lane == 0) { qTbin[q] = tbin; qCab[q] = (int)cabv; int zl = 0x7fffffff;
                if (tbin == IX_ZBIN) {
                    const int nk = p0 + 4 * (q & 3) + (q >> 2) + 1; zl = (int)(((unsigned long long)384 * (unsigned)nk) / (cbv ? cbv : 1u)) + 16; }
                qZl[q] = zl; }
        }
        __syncthreads();
        if (b0 < b1) {
            unsigned lok[4]; int zl[4];
#pragma unroll
            for (int rt = 0; rt < 4; ++rt) { lok[rt] = (unsigned)qTbin[g * 4 + rt] << 21; zl[rt] = qZl[g * 4 + rt]; }
            half8 kq[2][2];
#pragma unroll
            for (int u = 0; u < 2; ++u) { const int bb = (b0 + u < b1) ? b0 + u : b1 - 1; IX_LOADK(u, bb); }
            auto step2 = [&](int bcur, const half8& k0, const half8& k1, auto chkTag) {
                constexpr bool CHK = decltype(chkTag)::value;
                const int s = bcur * 16 + kl;
                f32x4 acc[4]; IX_MFMA(acc, k0, k1);
                unsigned key[4], pos[4]; bool cand[4];
#pragma unroll
                for (int rt = 0; rt < 4; ++rt) { key[rt] = ix_key(acc[rt], wv[rt]); cand[rt] = key[rt] >= lok[rt] + (s >= zl[rt] ? 1u : 0u); if (CHK) cand[rt] = cand[rt] && s <= p0 + 4 * rt + g; }
#pragma unroll
                for (int rt = 0; rt < 4; ++rt) { pos[rt] = 0u;
                    if (cand[rt]) { int gz = g; asm volatile("" : "+v"(gz)); pos[rt] = LDS_ADD(qN + gz * 4 + rt, 1u); } }
#pragma unroll
                for (int rt = 0; rt < 4; ++rt) {
                    if (cand[rt] && pos[rt] < (unsigned)IX_CAP) { int gz = g; asm volatile("" : "+v"(gz));
                        ((LAS unsigned long long*)(lds + (gz * 4 + rt) * 8192))[pos[rt]] = ((unsigned long long)key[rt] << 16) | (unsigned long long)(0xffffu - (unsigned)s); } }
            };
            int b = b0;
#pragma unroll 1
            for (; b + 2 <= b1 && b + 2 <= nblk - 1; b += 2) {
#pragma unroll
                for (int u = 0; u < 2; ++u) { step2(b + u, kq[u][0], kq[u][1], IxTagF{}); const int bb = (b + 2 + u < b1) ? b + 2 + u : b1 - 1; IX_LOADK(u, bb); }
            }
#pragma unroll 1
            for (; b + 2 <= b1; b += 2) {
#pragma unroll
                for (int u = 0; u < 2; ++u) { step2(b + u, kq[u][0], kq[u][1], IxTagT{}); const int bb = (b + 2 + u < b1) ? b + 2 + u : b1 - 1; IX_LOADK(u, bb); }
            }
            if (b < b1) step2(b, kq[0][0], kq[0][1], IxTagT{});
        }
#undef IX_LOADK
#undef IX_MFMA
        __syncthreads();
#pragma unroll 1
        for (int qq = 0; qq < 2; ++qq) {
            const int qs = 2 * wave + qq; const int n = (int)qN[qs], cabq = qCab[qs], tbin = qTbin[qs];
            if (n > IX_CAP || n < 256) { if (lane == 0) qOvf[qs] = 1; continue; }
            const LAS unsigned long long* cd = (const LAS unsigned long long*)(lds + qs * 8192);
            unsigned short* irow = IDX + (t0 + 4 * (qs & 3) + (qs >> 2)) * 256;
            if (n == 256) { for (int c = lane; c < n; c += 64) irow[c] = (unsigned short)(0xffffu - (unsigned)(cd[c] & 0xffffull)); continue; }
            { int base = 0;
              for (int c0 = 0; c0 < n; c0 += 64) { const int c = c0 + lane; const unsigned long long v = c < n ? cd[c] : 0ull; const bool sure = c < n && (int)(v >> 37) > tbin;
                  const unsigned long long bm = __ballot(sure);
                  if (sure) irow[base + __popcll(bm & ((1ull << lane) - 1ull))] = (unsigned short)(0xffffu - (unsigned)(v & 0xffffull));
                  base += __popcll(bm); } }
            unsigned long long pmask = 0x7ffull << 37, pval = (unsigned long long)tbin << 37; int need = 256 - cabq, done = cabq; unsigned cT = (unsigned)(n - cabq);
#pragma unroll 1
            for (int shift = 29; shift >= 5 && cT > 64u; shift -= 8) {
#pragma unroll
                for (int j = 0; j < 4; ++j) h2[lane + 64 * j] = 0u;
                for (int c = lane; c < n; c += 64) { const unsigned long long v = cd[c]; if ((v & pmask) == pval) LDS_ADD(h2 + ((unsigned)(v >> shift) & 255u), 1u); }
                const unsigned cs = h2[255 - 4 * lane] + h2[254 - 4 * lane] + h2[253 - 4 * lane] + h2[252 - 4 * lane];
                unsigned incl = cs;
#pragma unroll
                for (int o = 1; o < 64; o <<= 1) { const unsigned y = __shfl_up(incl, o); if (lane >= o) incl += y; }
                const unsigned long long m = __ballot(incl >= (unsigned)need);
                const int Ls = m ? (__ffsll((long long)m) - 1) : 63;
                unsigned above = __shfl(incl - cs, Ls), c2 = 0; int T2 = 0; bool found = false;
#pragma unroll
                for (int ii = 0; ii < 4; ++ii) { const unsigned c = h2[255 - 4 * Ls - ii]; if (!found && above + c >= (unsigned)need) { T2 = 255 - 4 * Ls - ii; c2 = c; found = true; } if (!found) above += c; }
                { int base = done;
                  for (int c0 = 0; c0 < n; c0 += 64) { const int c = c0 + lane; const unsigned long long v = c < n ? cd[c] : 0ull;
                      const bool up = c < n && (v & pmask) == pval && (int)((unsigned)(v >> shift) & 255u) > T2;
                      const unsigned long long bm = __ballot(up);
                      if (up) irow[base + __popcll(bm & ((1ull << lane) - 1ull))] = (unsigned short)(0xffffu - (unsigned)(v & 0xffffull));
                      base += __popcll(bm); } }
                done += (int)above; need -= (int)above; cT = c2;
                pmask |= 255ull << shift; pval |= (unsigned long long)T2 << shift;
            }
            asm volatile("" ::: "memory");
            if (lane == 0) h2[1] = 0u;
            asm volatile("" ::: "memory");
            for (int c = lane; c < n; c += 64) { const unsigned long long v = cd[c]; if ((v & pmask) == pval) { const unsigned pos = LDS_ADD(h2 + 1, 1u); if (pos < 64u) l2[pos] = v; } }
            asm volatile("" ::: "memory");
            { const unsigned long long mine = (unsigned)lane < cT ? l2[lane] : ~0ull; int rank = 0;
              for (unsigned j = 0; j < cT; ++j) rank += (l2[j] > mine) ? 1 : 0;
              if ((unsigned)lane < cT && rank < need) irow[done + rank] = (unsigned short)(0xffffu - (unsigned)(mine & 0xffffull)); }
        }
        if (tid < 16) CNT[t0 + tid] = 256;
        __syncthreads();
        if (tid < 16 && qOvf[tid]) { const unsigned k = LDS_ADD(ovl, 1u); ovl[1 + k] = (unsigned)(t0 + 4 * (tid & 3) + (tid >> 2)); }
    }
    __syncthreads();
    const unsigned novl = __builtin_amdgcn_readfirstlane(ovl[0]);
#pragma unroll 1
    for (unsigned k = 0; k < novl; ++k) { const unsigned tq = __builtin_amdgcn_readfirstlane(ovl[1 + k]); indexer_slow_query(p, lds, (size_t)tq); }
}
#undef LDS_ADD

__device__ __forceinline__ void phase_attn(const P& p, unsigned char* lds) {
    unsigned char* ws = p.ws; const int tid = threadIdx.x, lane = tid & 63, hd = lane & 15, g = lane >> 4;
    const int wave = __builtin_amdgcn_readfirstlane(tid >> 6);
    bf16_t* QP = (bf16_t*)(ws + OFF_QP); const bf16_t* CK = (const bf16_t*)(ws + OFF_CKVN); const bf16_t* RK = (const bf16_t*)(ws + OFF_RK);
    const unsigned short* IDX = (const unsigned short*)(ws + OFF_IDX); const int* CNT = (const int*)(ws + OFF_CNT);
    float* biasT = (float*)lds;
    biasT[tid] = p.rel_bias[tid];
    __syncthreads();
    LAS unsigned char* rows = (LAS unsigned char*)(lds + 2048 + (size_t)wave * 18432);
    LAS bf16_t* rkb = (LAS bf16_t*)(rows + 16384);
    LAS unsigned* info = (LAS unsigned*)(rows + 17408);
    const LAS float* biasL = (const LAS float*)lds;
    for (int t = blockIdx.x * 8 + wave; t < T; t += gridDim.x * 8) {
        const int batch = t >> 14, pos = t & (SEQ - 1); const int cnt = CNT[t];
        const size_t rb = (size_t)batch * SEQ;
        asm volatile("s_waitcnt lgkmcnt(0)" ::: "memory");
#pragma unroll
        for (int jj = 0; jj < 4; ++jj) {
            const int j = lane + 64 * jj; int id = IDX[(size_t)t * 256 + j]; if (j >= cnt) id = 0;
            const int rel = pos - id; int bucket = rel < 0 ? 0 : rel;
            if (rel >= 16) { bucket = 16 + (int)(__logf((float)rel * 0.0625f) / 2.0794415416798357f * 16.0f); bucket = bucket > 31 ? 31 : bucket; }
            info[j] = (unsigned)id | ((unsigned)bucket << 16);
        }
        bf16x8 qf[8];
#pragma unroll
        for (int ks = 0; ks < 8; ++ks) qf[ks] = *(const bf16x8*)(QP + (size_t)t * 4096 + hd * 256 + ks * 32 + g * 8);
        f32x4 o[16];
#pragma unroll
        for (int rt = 0; rt < 16; ++rt) o[rt] = (f32x4){0.f, 0.f, 0.f, 0.f};
        float mrun = -1e30f, lrun = 0.f;
        asm volatile("s_waitcnt lgkmcnt(0)" ::: "memory");
        const int nch = (cnt + 31) >> 5;
        for (int ch = 0; ch < nch; ++ch) {
            asm volatile("s_waitcnt lgkmcnt(0)" ::: "memory");
#pragma unroll
            for (int i = 0; i < 16; ++i) {
                const int ksl = 2 * i + (lane >> 5); const unsigned idv = info[ch * 32 + ksl] & 0xffffu;
                const bf16_t* src = CK + (rb + idv) * 256 + (((lane & 31) ^ (ksl & 15)) * 8);
                __builtin_amdgcn_global_load_lds((const unsigned*)src, (LAS unsigned*)(rows + i * 1024), 16, 0, 0);
            }
            { const unsigned idv = info[ch * 32 + (lane >> 1)] & 0xffffu;
              __builtin_amdgcn_global_load_lds((const unsigned*)(RK + (rb + idv) * 16 + (lane & 1) * 8), (LAS unsigned*)rkb, 16, 0, 0); }
            asm volatile("s_waitcnt vmcnt(0)" ::: "memory");
            f32x4 s0 = (f32x4){0.f, 0.f, 0.f, 0.f}, s1 = (f32x4){0.f, 0.f, 0.f, 0.f};
#pragma unroll
            for (int ks = 0; ks < 8; ++ks) {
                const int pos16 = ((4 * ks + g) ^ hd) * 16;
                const bf16x8 a0 = *(const LAS bf16x8*)(rows + hd * 512 + pos16);
                const bf16x8 a1 = *(const LAS bf16x8*)(rows + (16 + hd) * 512 + pos16);
                s0 = __builtin_amdgcn_mfma_f32_16x16x32_bf16(a0, qf[ks], s0, 0, 0, 0);
                s1 = __builtin_amdgcn_mfma_f32_16x16x32_bf16(a1, qf[ks], s1, 0, 0, 0);
            }
            float x0[4], x1[4]; float cm = -INFINITY;
#pragma unroll
            for (int r = 0; r < 4; ++r) {
                const int sl0 = 4 * g + r, sl1 = 16 + 4 * g + r, j0 = ch * 32 + sl0, j1 = ch * 32 + sl1;
                const unsigned i0 = info[j0], i1 = info[j1];
                const float r0 = bf2f(rkb[sl0 * 16 + hd]), r1 = bf2f(rkb[sl1 * 16 + hd]);
                x0[r] = (j0 < cnt) ? s0[r] * r0 + biasL[(i0 >> 16) * 16 + hd] : -INFINITY;
                x1[r] = (j1 < cnt) ? s1[r] * r1 + biasL[(i1 >> 16) * 16 + hd] : -INFINITY;
                cm = fmaxf(cm, fmaxf(x0[r], x1[r]));
            }
            cm = fmaxf(cm, __shfl_xor(cm, 16)); cm = fmaxf(cm, __shfl_xor(cm, 32));
            const float mnew = fmaxf(mrun, cm); const float sc = __expf(mrun - mnew); mrun = mnew;
            float ls = 0.f;
#pragma unroll
            for (int r = 0; r < 4; ++r) { x0[r] = __expf(x0[r] - mnew); x1[r] = __expf(x1[r] - mnew); ls += x0[r] + x1[r]; }
            lrun = lrun * sc + ls;
#pragma unroll
            for (int rt = 0; rt < 16; ++rt) o[rt] *= sc;
            u32x4 pw; pw.x = pg8::cvt_pk_bf16(x0[0], x0[1]); pw.y = pg8::cvt_pk_bf16(x0[2], x0[3]); pw.z = pg8::cvt_pk_bf16(x1[0], x1[1]); pw.w = pg8::cvt_pk_bf16(x1[2], x1[3]);
            const bf16x8 pf = __builtin_bit_cast(bf16x8, pw);
            const int q = hd >> 2, pp = hd & 3, ksl = 4 * g + q;
            const LAS unsigned char* trb = rows + ksl * 512 + (pp & 1) * 8;
#pragma unroll
            for (int rt = 0; rt < 16; ++rt) {
                const int c16 = ((2 * rt + (pp >> 1)) ^ ksl) * 16;
                const v4i16_t t0 = __builtin_amdgcn_ds_read_tr16_b64_v4i16((LAS v4i16_t*)(trb + c16));
                const v4i16_t t1 = __builtin_amdgcn_ds_read_tr16_b64_v4i16((LAS v4i16_t*)(trb + c16 + 8192));
                bf16x8 af; af[0] = t0[0]; af[1] = t0[1]; af[2] = t0[2]; af[3] = t0[3]; af[4] = t1[0]; af[5] = t1[1]; af[6] = t1[2]; af[7] = t1[3];
                o[rt] = __builtin_amdgcn_mfma_f32_16x16x32_bf16(af, pf, o[rt], 0, 0, 0);
            }
        }
        float ltot = lrun; ltot += __shfl_xor(ltot, 16); ltot += __shfl_xor(ltot, 32);
        const float inv = 1.0f / ltot;
        bf16_t* op = QP + (size_t)t * 4096 + hd * 256 + 4 * g;
#pragma unroll
        for (int rt = 0; rt < 16; ++rt) { u32x2 w; w.x = pg8::cvt_pk_bf16(o[rt][0] * inv, o[rt][1] * inv); w.y = pg8::cvt_pk_bf16(o[rt][2] * inv, o[rt][3] * inv); *(u32x2*)(op + rt * 16) = w; }
    }
}

__global__ void __launch_bounds__(512, 2) k_fwd(P p_arg, int ph_lo, int ph_hi) {
    extern __shared__ __attribute__((aligned(16))) unsigned char smem[];
    const P& p = *(const P*)__builtin_amdgcn_kernarg_segment_ptr(); (void)p_arg;
    unsigned char* lds = smem + 16;
    unsigned char* ws = p.ws;
    XcdBarrier bar;
    const bool multi = (ph_hi - ph_lo) > 1;
    if (multi) {
        if (threadIdx.x == 0) *(uint4*)smem = make_uint4(0u, 0u, 0u, 0u);
        __syncthreads();
        bar = xcd_barrier_post((unsigned*)(ws + OFF_CTL), (volatile LAS unsigned*)smem);
    }
#define PH(i) (ph_lo <= (i) && (i) < ph_hi)
#define SEAM(i) do { if ((i) + 1 < ph_hi) xcd_barrier(bar); else __syncthreads(); } while (0)
    bf16_t *XN = (bf16_t*)(ws + OFF_XN), *QB = (bf16_t*)(ws + OFF_QB), *KB = (bf16_t*)(ws + OFF_KB), *VB = (bf16_t*)(ws + OFF_VB), *TMP = (bf16_t*)(ws + OFF_TMP), *Y = (bf16_t*)(ws + OFF_Y);
    if (PH(0)) { phase_prep(p, lds); SEAM(0); }
    if (PH(1)) { fast_gemm(lds, XN, 1024, (const bf16_t*)(ws + OFF_W0T), 1024, 3072, 1024, D1{ws}); SEAM(1); }
    if (PH(2)) { phase_conv_scan(p, lds); SEAM(2); }
    if (PH(3)) { mlstm_units<false>(p, lds); SEAM(3); }
    if (PH(4)) { GWP f{(const bf16_t*)(ws + OFF_WPT), (const bf16_t*)(ws + OFF_WUB), (bf16_t*)(ws + OFF_W0T)}; sgemm(f, 256); phase_mlstm_scan(p, lds); SEAM(4); }
    if (PH(5)) { mlstm_units<true>(p, lds); SEAM(5); }
    if (PH(6)) { fast_gemm(lds, XN, 1024, (const bf16_t*)(ws + OFF_W0T) + (size_t)3072 * 1024, 1024, 4096, 1024, D2{ws}); SEAM(6); }
    if (PH(7)) { phase_ya_pool(p); SEAM(7); }
    if (PH(8)) { fast_gemm(lds, Y, 2048, (const bf16_t*)(ws + OFF_WO0T), 2048, 1024, 2048, D4{(unsigned char*)p.out, p.x}); SEAM(8); }
    if (PH(9)) { rmsnorm_rows<4>(p.out, p.o_norm, XN, p.o_w_in, OIN, 1600, nullptr, 0.5f, (float*)(ws + OFF_WI), (float*)lds); SEAM(9); }
    if (PH(10)) { fast_gemm(lds, XN, 1024, (const bf16_t*)(ws + OFF_W1T), 1024, 2816, 1024, D5{ws}); SEAM(10); }
    if (PH(11)) { phase_qnorm_ckvnorm(p); SEAM(11); }
    if (PH(12)) { fast_gemm(lds, (const bf16_t*)(ws + OFF_CKVN), 256, (const bf16_t*)(ws + OFF_WUKP), 256, 1024, 256, DK{ws}); SEAM(12); }
    if (PH(13)) { GQP f{TMP, (const bf16_t*)(ws + OFF_WQP), (bf16_t*)(ws + OFF_QP)}; sgemm(f, 512 * 64); phase_indexer(p, lds); SEAM(13); }
    if (PH(14)) { phase_attn(p, lds); SEAM(14); }
    if (PH(15)) { GOP f{(const bf16_t*)(ws + OFF_QP), (const bf16_t*)(ws + OFF_WUVT), (const bf16_t*)(ws + OFF_Z), TMP}; sgemm(f, 512 * 16); SEAM(15); }
    if (PH(16)) { fast_gemm(lds, TMP, 1024, (const bf16_t*)(ws + OFF_WO1T), 1024, 1024, 1024, D8{(unsigned char*)p.out}); }
#undef PH
#undef SEAM
}

extern "C" void kernel_launch(void* const* d_in, const int* in_sizes, int n_in, void* d_out, int out_size, void* d_ws, size_t ws_size, hipStream_t stream) {
    static int grid = 0;
    if (grid == 0) {
        if (n_in != 18 || out_size != T * DM || ws_size < WS_END) { fprintf(stderr, "kernel_launch: unexpected shapes (n_in %d out %d ws %zu)\n", n_in, out_size, ws_size); grid = -1; return; }
        if (hipFuncSetAttribute((const void*)k_fwd, hipFuncAttributeMaxDynamicSharedMemorySize, LDS_BYTES) != hipSuccess) { fprintf(stderr, "kernel_launch: hipFuncSetAttribute failed\n"); grid = -1; return; }
        grid = 256;
    }
    if (grid < 0) return;
    (void)hipMemsetAsync((char*)d_ws + OFF_CTL, 0, 16384, stream);
    P p{};
    p.x = (const float*)d_in[0]; p.e_norm = (const float*)d_in[1]; p.e_w_in = (const float*)d_in[2]; p.e_conv = (const float*)d_in[3]; p.e_b_if = (const float*)d_in[4];
    p.e_g_head = (const float*)d_in[5]; p.e_w_pool = (const float*)d_in[6]; p.e_s_pool = (const float*)d_in[7]; p.e_w_out = (const float*)d_in[8];
    p.o_norm = (const float*)d_in[9]; p.o_w_in = (const float*)d_in[10]; p.o_g_kv = (const float*)d_in[11]; p.o_w_uk = (const float*)d_in[12]; p.o_w_uv = (const float*)d_in[13];
    p.o_g_q = (const float*)d_in[14]; p.o_g_k = (const float*)d_in[15]; p.o_w_out = (const float*)d_in[16]; p.rel_bias = (const float*)d_in[17];
    p.out = (float*)d_out; p.ws = (unsigned char*)d_ws;
    hipLaunchKernelGGL(k_fwd, dim3(grid), dim3(512), LDS_BYTES, stream, p, 0, NPH);
}
```

```cpp
#include <hip/hip_runtime.h>
#include <stdint.h>
#include <cstdio>

typedef unsigned short bf16_t;
typedef short bf16x8 __attribute__((ext_vector_type(8)));
typedef float f32x4 __attribute__((ext_vector_type(4)));
typedef unsigned u32x4 __attribute__((ext_vector_type(4)));
typedef unsigned u32x2 __attribute__((ext_vector_type(2)));
typedef short v4i16_t __attribute__((ext_vector_type(4)));
#define LAS __attribute__((address_space(3)))

constexpr int T = 32768, SEQ = 16384, DM = 1024;
constexpr int EIN = 7176, OIN = 2628;
constexpr float EPS = 1e-6f;
constexpr size_t MB = 1048576;
constexpr size_t OFF_CTL = 0;
constexpr size_t OFF_GATES = 64 * 1024;
constexpr size_t OFF_BQ = OFF_GATES + (size_t)T * 8 * 4;
constexpr size_t OFF_IQ = OFF_BQ + (size_t)T * 4 * 4;
constexpr size_t OFF_MT = OFF_IQ + (size_t)T * 4 * 4;
constexpr size_t OFF_WI = OFF_MT + (size_t)T * 4 * 4;
constexpr size_t OFF_CH = OFF_WI + (size_t)T * 4 * 4;
constexpr size_t OFF_NS = OFF_CH + 64 * 1024;
constexpr size_t OFF_W = 4 * MB;
constexpr size_t OFF_W0T = OFF_W;
constexpr size_t OFF_WPT = OFF_W0T + (size_t)7168 * 1024 * 2;
constexpr size_t OFF_WO0T = OFF_WPT + (size_t)4 * 256 * 256 * 2;
constexpr size_t OFF_W1T = OFF_WO0T + (size_t)1024 * 2048 * 2;
constexpr size_t OFF_WUKT = OFF_W1T + (size_t)2816 * 1024 * 2;
constexpr size_t OFF_WUVT = OFF_WUKT + (size_t)1024 * 256 * 2;
constexpr size_t OFF_WO1T = OFF_WUVT + (size_t)1024 * 256 * 2;
constexpr size_t OFF_WUKP = OFF_WO1T + (size_t)1024 * 1024 * 2;
constexpr size_t OFF_WQP = OFF_WUKP + (size_t)1024 * 256 * 2;
constexpr size_t OFF_WUB = OFF_WQP + (size_t)16 * 256 * 64 * 2;
constexpr size_t OFF_XN = 36 * MB, OFF_QB = 100 * MB, OFF_KB = 164 * MB, OFF_VB = 228 * MB, OFF_TMP = 292 * MB, OFF_Y = 356 * MB;
constexpr size_t OFF_QP = 36 * MB;
constexpr size_t OFF_CKVN = OFF_Y;
constexpr size_t OFF_QI = OFF_Y + 16 * MB;
constexpr size_t OFF_KI = OFF_Y + 32 * MB;
constexpr size_t OFF_IDX = OFF_Y + 40 * MB;
constexpr size_t OFF_RK = OFF_Y + 58 * MB;
constexpr size_t OFF_CNT = OFF_Y + 59 * MB;
constexpr size_t OFF_Z = OFF_Y + 60 * MB;
constexpr size_t WS_END = 484 * MB;
constexpr int LDS_BYTES = 151552;
constexpr int NPH = 17;

struct P {
    const float *x, *e_norm, *e_w_in, *e_conv, *e_b_if, *e_g_head, *e_w_pool, *e_s_pool, *e_w_out;
    const float *o_norm, *o_w_in, *o_g_kv, *o_w_uk, *o_w_uv, *o_g_q, *o_g_k, *o_w_out, *rel_bias;
    float* out; unsigned char* ws;
};

__device__ __forceinline__ bf16_t f2bf(float f) { unsigned u = __float_as_uint(f); u += 0x7FFFu + ((u >> 16) & 1u); return (bf16_t)(u >> 16); }
__device__ __forceinline__ float bf2f(bf16_t b) { return __uint_as_float(((unsigned)b) << 16); }
__device__ __forceinline__ float bflo(unsigned w) { return __uint_as_float(w << 16); }
__device__ __forceinline__ float bfhi(unsigned w) { return __uint_as_float(w & 0xffff0000u); }
__device__ __forceinline__ unsigned pk2(float a, float b) { return (unsigned)f2bf(a) | ((unsigned)f2bf(b) << 16); }
__device__ __forceinline__ float sigmoidf_(float x) { return __builtin_amdgcn_rcpf(1.0f + __expf(-x)); }
__device__ __forceinline__ float siluf_(float x) { return x * __builtin_amdgcn_rcpf(1.0f + __expf(-x)); }
__device__ __forceinline__ float wave_sum(float v) {
#pragma unroll
    for (int o = 32; o >= 1; o >>= 1) v += __shfl_xor(v, o);
    return v;
}
__device__ __forceinline__ float wave_max(float v) {
#pragma unroll
    for (int o = 32; o >= 1; o >>= 1) v = fmaxf(v, __shfl_xor(v, o));
    return v;
}

#define XB_TMO      128
#define XB_XCNT(j)  (256  + 64 * (j))
#define XB_XSUB(j)  (1280 + 64 * (j))
#define XB_XGEN(j)  (2304 + 64 * (j))
#define XB_TOP      3328
#define XB_TOPGEN   3392
#define XCD_BAR_WORDS 3456
#define XB_SPIN_CAP (1u << 22)
__device__ __forceinline__ unsigned xb_ld(unsigned* p)              { return __hip_atomic_load(p, __ATOMIC_RELAXED, __HIP_MEMORY_SCOPE_AGENT); }
__device__ __forceinline__ unsigned xb_add(unsigned* p, unsigned v) { return __hip_atomic_fetch_add(p, v, __ATOMIC_RELAXED, __HIP_MEMORY_SCOPE_AGENT); }
__device__ __forceinline__ unsigned xb_xcc_id() { return (unsigned)__builtin_amdgcn_s_getreg((3 << 11) | 20) & 0xFu; }
#define XB_SPIN(cond, bar) do { unsigned _sp = 0; while (cond) { __builtin_amdgcn_s_sleep(1); \
    if ((++_sp & 255u) == 0u) { if (xb_ld(&(bar)[XB_TMO])) break; if (_sp > XB_SPIN_CAP) { atomicAdd(&(bar)[XB_TMO], 1u); break; } } } } while (0)
struct XcdBarrier { unsigned* bar; unsigned x; volatile LAS unsigned* st; };
__device__ __forceinline__ XcdBarrier xcd_barrier_post(unsigned* bar, volatile LAS unsigned* st) {
    XcdBarrier b; b.bar = bar; b.x = xb_xcc_id(); b.st = st;
    if (threadIdx.x == 0) (void)xb_add(&bar[XB_XCNT(b.x)], 1u);
    return b;
}
__device__ __forceinline__ void xcd_barrier_complete(unsigned* bar, unsigned x, unsigned& nloc, unsigned& nx) {
    const unsigned G = gridDim.x * gridDim.y * gridDim.z;
    unsigned sum, cnt, mine, sp = 0u;
    for (;;) {
        sum = 0u; cnt = 0u; mine = 0u;
#pragma unroll
        for (unsigned j = 0; j < 16; ++j) { const unsigned c = xb_ld(&bar[XB_XCNT(j)]); sum += c; cnt += (c > 0u) ? 1u : 0u; mine = (j == x) ? c : mine; }
        if (sum == G) break;
        __builtin_amdgcn_s_sleep(1);
        if ((++sp & 255u) == 0u) { if (xb_ld(&bar[XB_TMO])) break; if (sp > XB_SPIN_CAP) { atomicAdd(&bar[XB_TMO], 1u); break; } }
    }
    nloc = mine > 0u ? mine : 1u; nx = cnt > 0u ? cnt : 1u;
}
__device__ __forceinline__ void xcd_barrier(const XcdBarrier& b) {
    asm volatile("s_waitcnt vmcnt(0)" ::: "memory");
    __syncthreads();
    if (threadIdx.x == 0) {
        unsigned* bar = b.bar;
        __builtin_amdgcn_s_waitcnt(0);
        unsigned nloc = b.st[0], nx = b.st[1];
        if (nloc == 0u) { xcd_barrier_complete(bar, b.x, nloc, nx); b.st[0] = nloc; b.st[1] = nx; }
        const unsigned old = xb_add(&bar[XB_XSUB(b.x)], 1u);
        const unsigned gen = old / nloc;
        if (old + 1u == (gen + 1u) * nloc) {
            __builtin_amdgcn_fence(__ATOMIC_RELEASE, "agent");
            asm volatile("s_waitcnt vmcnt(0)" ::: "memory");
            const unsigned og = xb_add(&bar[XB_TOP], 1u);
            const unsigned tg = og / nx;
            if (og + 1u == (tg + 1u) * nx) xb_add(&bar[XB_TOPGEN], 1u);
            else XB_SPIN(xb_ld(&bar[XB_TOPGEN]) == tg, bar);
            __builtin_amdgcn_fence(__ATOMIC_ACQUIRE, "agent");
            xb_add(&bar[XB_XGEN(b.x)], 1u);
            asm volatile("s_waitcnt vmcnt(0)" ::: "memory");
        } else {
            XB_SPIN(xb_ld(&bar[XB_XGEN(b.x)]) == gen, bar);
            __builtin_amdgcn_fence(__ATOMIC_ACQUIRE, "agent");
            asm volatile("s_waitcnt vmcnt(0)" ::: "memory");
        }
    }
    __syncthreads();
}

struct Tile { const bf16_t* A; const bf16_t* B; int lda, ldb, K; void* d0; const void* s0; int ld; };
template <class F>
__device__ __forceinline__ void sgemm(const F f, int nunits) {
    const int lane = threadIdx.x & 63, wave = threadIdx.x >> 6, fr = lane & 15, fq = lane >> 4;
    for (int u = blockIdx.x * 8 + wave; u < nunits; u += gridDim.x * 8) {
        Tile tl; f.tile(u, tl);
        f32x4 acc[4][4];
#pragma unroll
        for (int m = 0; m < 4; ++m)
#pragma unroll
            for (int n = 0; n < 4; ++n) acc[m][n] = (f32x4){0.f, 0.f, 0.f, 0.f};
        const bf16_t* ap = tl.A + (size_t)fr * tl.lda + fq * 8;
        const bf16_t* bp = tl.B + (size_t)fr * tl.ldb + fq * 8;
        const int K = tl.K, lda = tl.lda, ldb = tl.ldb;
        bf16x8 a[4], b[4];
#pragma unroll
        for (int m = 0; m < 4; ++m) a[m] = *(const bf16x8*)(ap + (size_t)(m * 16) * lda);
#pragma unroll
        for (int n = 0; n < 4; ++n) b[n] = *(const bf16x8*)(bp + (size_t)(n * 16) * ldb);
#pragma unroll 1
        for (int k0 = 0; k0 < K; k0 += 32) {
            bf16x8 an[4], bn[4]; const int kn = (k0 + 32 < K) ? k0 + 32 : k0;
#pragma unroll
            for (int m = 0; m < 4; ++m) an[m] = *(const bf16x8*)(ap + (size_t)(m * 16) * lda + kn);
#pragma unroll
            for (int n = 0; n < 4; ++n) bn[n] = *(const bf16x8*)(bp + (size_t)(n * 16) * ldb + kn);
#pragma unroll
            for (int m = 0; m < 4; ++m)
#pragma unroll
                for (int n = 0; n < 4; ++n) acc[m][n] = __builtin_amdgcn_mfma_f32_16x16x32_bf16(b[n], a[m], acc[m][n], 0, 0, 0);
#pragma unroll
            for (int m = 0; m < 4; ++m) { a[m] = an[m]; b[m] = bn[m]; }
        }
#pragma unroll
        for (int m = 0; m < 4; ++m) {
            asm volatile("" ::: "memory");
#pragma unroll
            for (int n = 0; n < 4; ++n) f.out4(tl, m * 16 + fr, n * 16 + 4 * fq, acc[m][n]);
        }
    }
}
__device__ __forceinline__ void store4_bf16(const Tile& tl, int r, int c, const f32x4 v) {
    u32x2 w; w.x = pk2(v[0], v[1]); w.y = pk2(v[2], v[3]); *(u32x2*)((bf16_t*)tl.d0 + (size_t)r * tl.ld + c) = w; }

struct GWP {
    const bf16_t* WPT; const bf16_t* WUB; bf16_t* W0T;
    __device__ __forceinline__ void tile(int u, Tile& tl) const {
        const int kt = u & 15, dt = (u >> 4) & 3, g = u >> 6; tl.A = WPT + (size_t)(g * 256 + dt * 64) * 256; tl.lda = 256; tl.B = WUB + (size_t)kt * 64 * 1024 + g * 256; tl.ldb = 1024; tl.K = 256;
        tl.d0 = W0T + (size_t)(5120 + g * 256 + dt * 64) * 1024 + kt * 64; tl.ld = 1024; }
    __device__ __forceinline__ void out4(const Tile& tl, int r, int c, const f32x4 v) const { store4_bf16(tl, r, c, v); }
};
struct GQP {
    const bf16_t* Qn; const bf16_t* W; bf16_t* QP;
    __device__ __forceinline__ void tile(int u, Tile& tl) const {
        const int nt = u & 3, head = (u >> 2) & 15, mt = u >> 6; tl.A = Qn + (size_t)mt * 64 * 1024 + head * 64; tl.lda = 1024; tl.B = W + (size_t)(head * 256 + nt * 64) * 64; tl.ldb = 64; tl.K = 64;
        tl.d0 = QP + ((size_t)mt * 64 * 16 + head) * 256 + nt * 64; tl.ld = 4096; }
    __device__ __forceinline__ void out4(const Tile& tl, int r, int c, const f32x4 v) const { store4_bf16(tl, r, c, v); }
};
struct GOP {
    const bf16_t* OP; const bf16_t* W; const bf16_t* Z; bf16_t* G;
    __device__ __forceinline__ void tile(int u, Tile& tl) const {
        const int head = u & 15, mt = u >> 4; tl.A = OP + (size_t)mt * 64 * 4096 + head * 256; tl.lda = 4096; tl.B = W + (size_t)head * 64 * 256; tl.ldb = 256; tl.K = 256;
        const size_t o = (size_t)mt * 64 * 1024 + head * 64; tl.d0 = G + o; tl.s0 = Z + o; tl.ld = 1024; }
    __device__ __forceinline__ void out4(const Tile& tl, int r, int c, const f32x4 v) const { const size_t i = (size_t)r * 1024 + c; const u32x2 z = *(const u32x2*)((const bf16_t*)tl.s0 + i);
        u32x2 w; w.x = pk2(v[0] * bflo(z.x), v[1] * bfhi(z.x)); w.y = pk2(v[2] * bflo(z.y), v[3] * bfhi(z.y)); *(u32x2*)((bf16_t*)tl.d0 + i) = w; }
};

namespace pg8 {
constexpr int BM = 256, BK = 64, HALF = 128, HTB = HALF * BK * 2, STAGE_BYTES = 8 * HTB, NXCD = 8, WGM = 8;
__device__ __forceinline__ int lds_byte(int r, int c) { const int st = (r >> 4) * 2 + (c >> 5), rr = r & 15, cc = c & 31, ob = rr * 64 + cc * 2; return st * 1024 + (ob ^ (((ob >> 9) & 1) << 5)); }
__device__ __forceinline__ void stage_rc(int b, int& R, int& C) { const int st = b / 1024, sb = b % 1024, swz = sb ^ (((sb >> 9) & 1) << 5); R = (st >> 1) * 16 + swz / 64; C = (st & 1) * 32 + (swz % 64) / 2; }
__device__ __forceinline__ int perm32(int rho) { const int n = rho >> 4, i = rho & 15; return 8 * (i >> 2) + 4 * n + (i & 3); }
struct Unit { int pm, pn; };
struct Gemm { const bf16_t* A; int lda; const bf16_t* Bt; int ldb; int M, N, K; };
struct StaticOrder {
    int nM, nN, nwg, G, c;
    __device__ void init(int M, int N, int G_, int c_) { nM = M / BM; nN = N / BM; nwg = nM * nN; G = G_; c = c_; }
    __device__ bool next(int i, Unit& u) const {
        const long L = (long)i * G + c; if (L >= nwg) return false;
        int wgid = (int)L; { const int q = nwg / NXCD, r = nwg % NXCD, xcd = wgid % NXCD, off = wgid / NXCD; wgid = (xcd < r ? xcd * (q + 1) : r * (q + 1) + (xcd - r) * q) + off; }
        const int nig = WGM * nN, gid = wgid / nig, fm = gid * WGM, gsz = (nM - fm) < WGM ? (nM - fm) : WGM;
        u.pm = fm + ((wgid % nig) % gsz); u.pn = (wgid % nig) / gsz; return true;
    }
};
__device__ __forceinline__ unsigned cvt_pk_bf16(float lo, float hi) { unsigned r; asm volatile("v_cvt_pk_bf16_f32 %0, %1, %2" : "=v"(r) : "v"(lo), "v"(hi)); return r; }

struct Dst { unsigned char* base; const float* res; int ld, mode, ncol; float scale; };
template <class DescF> struct EpiGen {
    static constexpr bool PERM = true;
    DescF D;
    __device__ __forceinline__ void operator()(const f32x4 (&acc)[2][2][4][2], const Unit& u, int wr, int wc, int fr, int fq) const {
        Dst d; D.get(u, d);
        if ((DescF::MODES & 16) && d.mode == 4) return;
        const int r0 = wr * 64 + fr, c0 = wc * 32 + 8 * fq;
        if constexpr ((DescF::MODES & 64) != 0) {
#pragma unroll
            for (int ai = 0; ai < 2; ++ai)
#pragma unroll
                for (int m = 0; m < 4; ++m) {
                    float ss = 0.f;
#pragma unroll
                    for (int bj = 0; bj < 2; ++bj)
#pragma unroll
                        for (int n = 0; n < 2; ++n) { const f32x4 v = acc[ai][bj][m][n]; ss += v[0] * v[0] + v[1] * v[1] + v[2] * v[2] + v[3] * v[3]; }
                    ss += __shfl_xor(ss, 16); ss += __shfl_xor(ss, 32);
                    if (fq == 0) ((bf16_t*)d.base)[(size_t)(ai * HALF + r0 + m * 16) * d.ld + wc] = f2bf(rsqrtf(ss * (1.0f / 64.0f) + EPS));
                }
            return;
        } else {
#pragma unroll
        for (int ai = 0; ai < 2; ++ai)
#pragma unroll
            for (int m = 0; m < 4; ++m) {
                const size_t rowoff = (size_t)(ai * HALF + r0 + m * 16) * d.ld;
#pragma unroll
                for (int bj = 0; bj < 2; ++bj) {
                    const int col = bj * HALF + c0; f32x4 v0 = acc[ai][bj][m][0], v1 = acc[ai][bj][m][1];
                    if ((DescF::MODES & 7) && d.mode <= 2) {
                        if ((DescF::MODES & 2) && d.mode == 1) {
#pragma unroll
                            for (int j = 0; j < 4; ++j) { v0[j] = sigmoidf_(v0[j]); v1[j] = sigmoidf_(v1[j]); } }
                        if ((DescF::MODES & 4) && d.mode == 2) {
#pragma unroll
                            for (int j = 0; j < 4; ++j) { v0[j] = siluf_(v0[j]); v1[j] = siluf_(v1[j]); } }
                        u32x4 w; w.x = cvt_pk_bf16(v0[0], v0[1]); w.y = cvt_pk_bf16(v0[2], v0[3]); w.z = cvt_pk_bf16(v1[0], v1[1]); w.w = cvt_pk_bf16(v1[2], v1[3]);
                        *(u32x4*)((bf16_t*)d.base + rowoff + col) = w;
                    } else if ((DescF::MODES & 8) && d.mode == 3) {
                        if (col < d.ncol) { float* o = (float*)d.base + rowoff + col; *(f32x4*)o = v0 * d.scale; *(f32x4*)(o + 4) = v1 * d.scale; }
                    } else if ((DescF::MODES & 128) && d.mode == 7) {
                        typedef _Float16 h8 __attribute__((ext_vector_type(8)));
                        if (col < d.ncol) {
                        h8 hv; hv[0] = (_Float16)(v0[0] * d.scale); hv[1] = (_Float16)(v0[1] * d.scale); hv[2] = (_Float16)(v0[2] * d.scale); hv[3] = (_Float16)(v0[3] * d.scale);
                        hv[4] = (_Float16)(v1[0] * d.scale); hv[5] = (_Float16)(v1[1] * d.scale); hv[6] = (_Float16)(v1[2] * d.scale); hv[7] = (_Float16)(v1[3] * d.scale);
                        *(h8*)((_Float16*)d.base + rowoff + col) = hv; }
                    } else if constexpr ((DescF::MODES & 32) != 0) {
                        float* o = (float*)d.base + rowoff + col; const float* rs = d.res + rowoff + col;
                        const f32x4 a = *(const f32x4*)rs, b = *(const f32x4*)(rs + 4); *(f32x4*)o = a + v0; *(f32x4*)(o + 4) = b + v1;
                    }
                }
                if (m & 1) asm volatile("" ::: "memory");
            }
        }
    }
};

template <class Epi>
__device__ __forceinline__ void gemm_phase(LAS unsigned char* lds, const Gemm g, const StaticOrder& S, const Epi& E) {
    const int tid = threadIdx.x, wid = __builtin_amdgcn_readfirstlane(tid >> 6), lane = tid & 63, wr = wid >> 2, wc = wid & 3, fr = lane & 15, fq = lane >> 4;
    const int K = g.K, nt = K / BK;
    unsigned voffA[2], voffB[2];
#pragma unroll
    for (int i = 0; i < 2; ++i) { int R, C; stage_rc(tid * 16 + i * 8192, R, C); const int Rb = Epi::PERM ? ((R & ~31) + perm32(R & 31)) : R;
        voffA[i] = (unsigned)(R * g.lda + C) * 2u; voffB[i] = (unsigned)(Rb * g.ldb + C) * 2u; }
    const size_t kstep = (size_t)(BK * 2);
    const size_t hstepA = (size_t)HALF * g.lda * 2, hstepB = (size_t)HALF * g.ldb * 2;
    const size_t tstepA = 2 * hstepA, tstepB = 2 * hstepB;
    const unsigned ldsw = (unsigned)wid * 1024u;
    const int aoff = lds_byte(wr * 64 + fr, fq * 8), boff = lds_byte(wc * 32 + fr, fq * 8);
#define PG8_SA(b, h) (((b) * 2 + (h)) * HTB)
#define PG8_SB(b, h) ((4 + (b) * 2 + (h)) * HTB)
#define PG8_STAGE(bufoff, gbase, voff) do { _Pragma("unroll") for (int _i = 0; _i < 2; ++_i) \
        __builtin_amdgcn_global_load_lds((const unsigned*)((const char*)(gbase) + (voff)[_i]), (LAS unsigned*)(lds + (bufoff) + ldsw + _i * 8192), 16, 0, 0); } while (0)
#define PG8_LDA(dst, b, h) do { _Pragma("unroll") for (int m = 0; m < 4; ++m) _Pragma("unroll") for (int k = 0; k < 2; ++k) dst[m][k] = *(const LAS bf16x8*)(lds + PG8_SA(b, h) + aoff + m * 2048 + k * 1024); } while (0)
#define PG8_LDB(dst, b, h) do { _Pragma("unroll") for (int n = 0; n < 2; ++n) _Pragma("unroll") for (int k = 0; k < 2; ++k) dst[n][k] = *(const LAS bf16x8*)(lds + PG8_SB(b, h) + boff + n * 2048 + k * 1024); } while (0)
#define PG8_MMA(ai, bj, At, Bt) do { __builtin_amdgcn_s_setprio(1); _Pragma("unroll") for (int m = 0; m < 4; ++m) _Pragma("unroll") for (int n = 0; n < 2; ++n) _Pragma("unroll") for (int k = 0; k < 2; ++k) \
        acc[ai][bj][m][n] = __builtin_amdgcn_mfma_f32_16x16x32_bf16(Bt[n][k], At[m][k], acc[ai][bj][m][n], 0, 0, 0); __builtin_amdgcn_s_setprio(0); } while (0)
#define PG8_WAIT_V(n) asm volatile("s_waitcnt vmcnt(" #n ")" ::: "memory")
#define PG8_WAIT_L(n) asm volatile("s_waitcnt lgkmcnt(" #n ")" ::: "memory")
#define PG8_BAR __builtin_amdgcn_s_barrier()
#define PG8_SCHED __builtin_amdgcn_sched_barrier(0)
    Unit cur, nxt; int ui = 0;
    if (!S.next(0, cur)) return;
    f32x4 acc[2][2][4][2];
#pragma unroll
    for (int a = 0; a < 2; ++a)
#pragma unroll
        for (int b = 0; b < 2; ++b)
#pragma unroll
            for (int m = 0; m < 4; ++m)
#pragma unroll
                for (int n = 0; n < 2; ++n) acc[a][b][m][n] = (f32x4){0.f, 0.f, 0.f, 0.f};
    bf16x8 At[4][2], B0[2][2], B1[2][2];
    const char* cA = (const char*)g.A + (size_t)cur.pm * tstepA; const char* cB = (const char*)g.Bt + (size_t)cur.pn * tstepB;
    PG8_STAGE(PG8_SB(0, 0), cB, voffB); PG8_STAGE(PG8_SA(0, 0), cA, voffA); PG8_STAGE(PG8_SB(0, 1), cB + hstepB, voffB); PG8_STAGE(PG8_SA(0, 1), cA + hstepA, voffA);
    if (wr == 1) PG8_BAR;
    PG8_WAIT_V(4); PG8_BAR;
    PG8_STAGE(PG8_SB(1, 0), cB + kstep, voffB); PG8_STAGE(PG8_SA(1, 0), cA + kstep, voffA); PG8_STAGE(PG8_SB(1, 1), cB + hstepB + kstep, voffB);
    PG8_WAIT_V(6); PG8_BAR;
    for (;;) {
        const bool has_next = S.next(ui + 1, nxt);
        const char* nA = has_next ? (const char*)g.A + (size_t)nxt.pm * tstepA : cA; const char* nB = has_next ? (const char*)g.Bt + (size_t)nxt.pn * tstepB : cB;
#pragma unroll 1
        for (int t = 0; t < nt; t += 2) {
            const bool last = (t == nt - 2);
            const char* a1 = cA + (size_t)(t + 1) * kstep;
            const char* a2 = last ? nA : cA + (size_t)(t + 2) * kstep; const char* b2 = last ? nB : cB + (size_t)(t + 2) * kstep;
            const char* a3 = a2 + kstep; const char* b3 = b2 + kstep;
            PG8_LDB(B0, 0, 0); PG8_SCHED; PG8_LDA(At, 0, 0); PG8_STAGE(PG8_SA(1, 1), a1 + hstepA, voffA);
            PG8_WAIT_L(8); PG8_BAR; PG8_WAIT_L(0); PG8_MMA(0, 0, At, B0); PG8_BAR; PG8_SCHED;
            PG8_LDB(B1, 0, 1); PG8_STAGE(PG8_SB(0, 0), b2, voffB);
            PG8_BAR; PG8_WAIT_L(0); PG8_MMA(0, 1, At, B1); PG8_BAR;
            PG8_LDA(At, 0, 1); PG8_STAGE(PG8_SA(0, 0), a2, voffA);
            PG8_BAR; PG8_WAIT_L(0); PG8_MMA(1, 0, At, B0); PG8_BAR; PG8_SCHED;
            PG8_STAGE(PG8_SB(0, 1), b2 + hstepB, voffB);
            PG8_WAIT_V(6); PG8_BAR; PG8_MMA(1, 1, At, B1); PG8_BAR;
            PG8_LDB(B0, 1, 0); PG8_SCHED; PG8_LDA(At, 1, 0); PG8_STAGE(PG8_SA(0, 1), a2 + hstepA, voffA);
            PG8_WAIT_L(8); PG8_BAR; PG8_WAIT_L(0); PG8_MMA(0, 0, At, B0); PG8_BAR; PG8_SCHED;
            PG8_LDB(B1, 1, 1); PG8_STAGE(PG8_SB(1, 0), b3, voffB);
            PG8_BAR; PG8_WAIT_L(0); PG8_MMA(0, 1, At, B1); PG8_BAR;
            PG8_LDA(At, 1, 1); PG8_STAGE(PG8_SA(1, 0), a3, voffA);
            PG8_BAR; PG8_WAIT_L(0); PG8_MMA(1, 0, At, B0); PG8_BAR; PG8_SCHED;
            PG8_STAGE(PG8_SB(1, 1), b3 + hstepB, voffB);
            PG8_WAIT_V(6); PG8_BAR; PG8_MMA(1, 1, At, B1); PG8_BAR;
        }
        E(acc, cur, wr, wc, fr, fq);
        if (!has_next) break;
#pragma unroll
        for (int a = 0; a < 2; ++a)
#pragma unroll
            for (int b = 0; b < 2; ++b)
#pragma unroll
                for (int m = 0; m < 4; ++m)
#pragma unroll
                    for (int n = 0; n < 2; ++n) acc[a][b][m][n] = (f32x4){0.f, 0.f, 0.f, 0.f};
        cur = nxt; cA = nA; cB = nB; ++ui;
    }
    PG8_WAIT_V(0);
    if (wr == 0) PG8_BAR;
    PG8_BAR;
#undef PG8_SA
#undef PG8_SB
#undef PG8_STAGE
#undef PG8_LDA
#undef PG8_LDB
#undef PG8_MMA
#undef PG8_WAIT_V
#undef PG8_WAIT_L
#undef PG8_BAR
#undef PG8_SCHED
}
}

struct D1 { static constexpr int MODES = 1; unsigned char* ws;
    __device__ __forceinline__ void get(const pg8::Unit& u, pg8::Dst& d) const { const int sec = u.pn >> 2;
        d.base = ws + OFF_QB + (size_t)sec * (64 * MB) + ((size_t)u.pm * 256 * 1024 + (u.pn & 3) * 256) * 2; d.res = nullptr; d.ld = 1024; d.mode = 0; d.ncol = 256; d.scale = 1.f; } };
struct D2 { static constexpr int MODES = 7; unsigned char* ws;
    __device__ __forceinline__ void get(const pg8::Unit& u, pg8::Dst& d) const { const int sec = u.pn >> 2, cc = (u.pn & 3) * 256; d.res = nullptr; d.ncol = 256; d.scale = 1.f;
        if (sec < 3) { d.base = ws + OFF_QB + (size_t)sec * (64 * MB) + ((size_t)u.pm * 256 * 1024 + cc) * 2; d.ld = 1024; d.mode = sec == 0 ? 1 : (sec == 1 ? 2 : 0); }
        else { d.base = ws + OFF_Y + ((size_t)u.pm * 256 * 2048 + 1024 + cc) * 2; d.ld = 2048; d.mode = 2; } } };
struct D4 { static constexpr int MODES = 32; unsigned char* out; const float* x;
    __device__ __forceinline__ void get(const pg8::Unit& u, pg8::Dst& d) const { const size_t o = (size_t)u.pm * 256 * 1024 + u.pn * 256;
        d.base = out + o * 4; d.res = x + o; d.ld = 1024; d.mode = 5; d.ncol = 256; d.scale = 1.f; } };
struct D5 { static constexpr int MODES = 133; unsigned char* ws;
    __device__ __forceinline__ void get(const pg8::Unit& u, pg8::Dst& d) const { const int pn = u.pn; d.res = nullptr; d.ncol = 256; d.scale = 1.f;
        if (pn < 4) { d.base = ws + OFF_TMP + ((size_t)u.pm * 256 * 1024 + pn * 256) * 2; d.ld = 1024; d.mode = 0; }
        else if (pn == 4) { d.base = ws + OFF_CKVN + (size_t)u.pm * 256 * 256 * 2; d.ld = 256; d.mode = 0; }
        else if (pn == 5) { d.base = ws + OFF_QI + (size_t)u.pm * 256 * 256 * 2; d.ld = 256; d.mode = 7; d.scale = 0.125f; }
        else if (pn == 6) { d.base = ws + OFF_KI + (size_t)u.pm * 256 * 64 * 2; d.ld = 64; d.mode = 7; d.ncol = 64; }
        else { d.base = ws + OFF_Z + ((size_t)u.pm * 256 * 1024 + (pn - 7) * 256) * 2; d.ld = 1024; d.mode = 2; } } };
struct DK { static constexpr int MODES = 64; unsigned char* ws;
    __device__ __forceinline__ void get(const pg8::Unit& u, pg8::Dst& d) const {
        d.base = ws + OFF_RK + ((size_t)u.pm * 256 * 16 + u.pn * 4) * 2; d.res = nullptr; d.ld = 16; d.mode = 6; d.ncol = 256; d.scale = 1.f; } };
struct D8 { static constexpr int MODES = 32; unsigned char* out;
    __device__ __forceinline__ void get(const pg8::Unit& u, pg8::Dst& d) const { const size_t o = (size_t)u.pm * 256 * 1024 + u.pn * 256;
        d.base = out + o * 4; d.res = (const float*)out + o; d.ld = 1024; d.mode = 5; d.ncol = 256; d.scale = 1.f; } };
template <class DF>
__device__ __forceinline__ void fast_gemm(unsigned char* lds, const bf16_t* A, int lda, const bf16_t* Bt, int ldb, int N, int K, const DF& df) {
    pg8::Gemm g{A, lda, Bt, ldb, T, N, K}; pg8::StaticOrder S; S.init(T, N, (int)gridDim.x, (int)blockIdx.x);
    pg8::EpiGen<DF> E{df};
    pg8::gemm_phase(( LAS unsigned char*)lds, g, S, E);
}

__device__ __forceinline__ void tconv(const float* __restrict__ src, int ld, int col0, int ncols, int K, bf16_t* __restrict__ dst, float* tile  ) {
    const int nkt = K / 64, ntiles = nkt * (ncols / 64), tid = threadIdx.x;
    for (int id = blockIdx.x; id < ntiles; id += gridDim.x) {
        const int kt = id % nkt, nt = id / nkt;
#pragma unroll
        for (int j = 0; j < 8; ++j) { const int e = tid + 512 * j, kk = e >> 6, nn = e & 63; tile[kk * 65 + nn] = src[(size_t)(kt * 64 + kk) * ld + col0 + nt * 64 + nn]; }
        __syncthreads();
#pragma unroll
        for (int j = 0; j < 8; ++j) { const int e = tid + 512 * j, nn = e >> 6, kk = e & 63; dst[(size_t)(nt * 64 + nn) * K + kt * 64 + kk] = f2bf(tile[kk * 65 + nn]); }
        __syncthreads();
    }
}
template <int NE>
__device__ __forceinline__ void rmsnorm_rows(const float* __restrict__ src, const float* __restrict__ g, bf16_t* __restrict__ dst,
                             const float* __restrict__ Wx, int ldw, int col0, const float* __restrict__ bias, float scale, float* __restrict__ dstx, float* wl) {
    const int lane = threadIdx.x & 63, wave = threadIdx.x >> 6;
    __syncthreads();
    for (int i = threadIdx.x; i < NE * 1024; i += 512) { const int k = i / NE, e = i % NE; wl[e * 1024 + k] = Wx[(size_t)k * ldw + col0 + e]; }
    __syncthreads();
    for (int row0 = (blockIdx.x * 8 + wave) * 2; row0 < T; row0 += gridDim.x * 16) {
        f32x4 v[2][4];
#pragma unroll
        for (int r = 0; r < 2; ++r)
#pragma unroll
            for (int i = 0; i < 4; ++i) v[r][i] = *(const f32x4*)(src + (size_t)(row0 + r) * 1024 + i * 256 + lane * 4);
#pragma unroll
        for (int r = 0; r < 2; ++r) {
            const int row = row0 + r; float ss = 0.f;
#pragma unroll
            for (int i = 0; i < 4; ++i) ss += v[r][i][0] * v[r][i][0] + v[r][i][1] * v[r][i][1] + v[r][i][2] * v[r][i][2] + v[r][i][3] * v[r][i][3];
            ss = wave_sum(ss);
            const float rstd = rsqrtf(ss * (1.0f / 1024.0f) + EPS);
            float ex[NE];
#pragma unroll
            for (int e = 0; e < NE; ++e) ex[e] = 0.f;
#pragma unroll
            for (int i = 0; i < 4; ++i) {
                const f32x4 gg = *(const f32x4*)(g + i * 256 + lane * 4);
                f32x4 y; y[0] = v[r][i][0] * rstd * gg[0]; y[1] = v[r][i][1] * rstd * gg[1]; y[2] = v[r][i][2] * rstd * gg[2]; y[3] = v[r][i][3] * rstd * gg[3];
                u32x2 w; w.x = pk2(y[0], y[1]); w.y = pk2(y[2], y[3]);
                *(u32x2*)(dst + (size_t)row * 1024 + i * 256 + lane * 4) = w;
#pragma unroll
                for (int e = 0; e < NE; ++e) { const f32x4 wv = *(const f32x4*)(wl + e * 1024 + i * 256 + lane * 4); ex[e] += y[0] * wv[0] + y[1] * wv[1] + y[2] * wv[2] + y[3] * wv[3]; }
            }
#pragma unroll
            for (int e = 0; e < NE; ++e) { const float sx = wave_sum(ex[e]); if (lane == 0) dstx[(size_t)row * NE + e] = (sx + (bias ? bias[e] : 0.f)) * scale; }
        }
    }
}

__device__ __forceinline__ void phase_prep(const P& p, unsigned char* lds) {
    float* tile = (float*)lds; unsigned char* ws = p.ws;
    bf16_t* W0T = (bf16_t*)(ws + OFF_W0T);
    tconv(p.e_w_in, EIN, 0, 5120, 1024, W0T, tile);
    tconv(p.e_w_in, EIN, 6152, 1024, 1024, W0T + (size_t)6144 * 1024, tile);
    for (int g = 0; g < 4; ++g) tconv(p.e_w_pool + (size_t)g * 65536, 256, 0, 256, 256, (bf16_t*)(ws + OFF_WPT) + (size_t)g * 65536, tile);
    { bf16_t* WUB = (bf16_t*)(ws + OFF_WUB);
      for (size_t i = (size_t)blockIdx.x * 512 + threadIdx.x; i < (size_t)1024 * 256; i += (size_t)gridDim.x * 512) {
          const size_t k = i >> 8; const int c4 = (int)(i & 255) * 4; const f32x4 v = *(const f32x4*)(p.e_w_in + k * EIN + 5128 + c4);
          u32x2 o; o.x = pk2(v[0], v[1]); o.y = pk2(v[2], v[3]); *(u32x2*)(WUB + k * 1024 + c4) = o; } }
    tconv(p.e_w_out, 1024, 0, 1024, 2048, (bf16_t*)(ws + OFF_WO0T), tile);
    bf16_t* W1T = (bf16_t*)(ws + OFF_W1T);
    tconv(p.o_w_in, OIN, 0, 1600, 1024, W1T, tile);
    for (size_t i = (size_t)blockIdx.x * 512 + threadIdx.x; i < (size_t)192 * 1024; i += (size_t)gridDim.x * 512) W1T[(size_t)1600 * 1024 + i] = 0;
    tconv(p.o_w_in, OIN, 1604, 1024, 1024, W1T + (size_t)1792 * 1024, tile);
    {
        bf16_t* WUKP = (bf16_t*)(ws + OFF_WUKP); bf16_t* WQP = (bf16_t*)(ws + OFF_WQP);
        for (size_t i = (size_t)blockIdx.x * 512 + threadIdx.x; i < (size_t)1024 * 256; i += (size_t)gridDim.x * 512) {
            { const int n = (int)(i >> 8), k = (int)(i & 255), pn = n >> 8, rem = n & 255, bj = rem >> 7, wc = (rem >> 5) & 3, x = rem & 31;
              WUKP[i] = f2bf(p.o_w_uk[(size_t)k * 1024 + (4 * pn + wc) * 64 + 32 * bj + x]); }
            { const int d = (int)(i & 63), r = (int)((i >> 6) & 255), h = (int)(i >> 14);
              WQP[i] = f2bf(p.o_w_uk[(size_t)r * 1024 + h * 64 + d] * p.o_g_k[d] * 0.125f); }
        }
    }
    tconv(p.o_w_uv, 1024, 0, 1024, 256, (bf16_t*)(ws + OFF_WUVT), tile);
    tconv(p.o_w_out, 1024, 0, 1024, 1024, (bf16_t*)(ws + OFF_WO1T), tile);
    rmsnorm_rows<8>(p.x, p.e_norm, (bf16_t*)(ws + OFF_XN), p.e_w_in, EIN, 5120, p.e_b_if, 1.0f, (float*)(ws + OFF_GATES), (float*)lds);
}

__device__ __forceinline__ void phase_conv_scan(const P& p, unsigned char* lds) {
    unsigned char* ws = p.ws; const int tid = threadIdx.x;
    const float* GATES = (const float*)(ws + OFF_GATES);
    float *BQ = (float*)(ws + OFF_BQ), *IQ = (float*)(ws + OFF_IQ), *MT = (float*)(ws + OFF_MT), *CH = (float*)(ws + OFF_CH);
    {
        const int lane = tid & 63, wave = tid >> 6;
        for (int task = blockIdx.x * 8 + wave; task < 2048; task += gridDim.x * 8) {
            const int bh = task >> 8, c = task & 255, batch = bh >> 2, head = bh & 3; const size_t t = (size_t)batch * SEQ + c * 64 + lane;
            const float ig = GATES[t * 8 + head], f = GATES[t * 8 + 4 + head];
            float b = fminf(f, 0.f) - log1pf(__expf(-fabsf(f)));
#pragma unroll
            for (int o = 1; o < 64; o <<= 1) { const float y = __shfl_up(b, o); if (lane >= o) b += y; }
            float rm = ig - b;
#pragma unroll
            for (int o = 1; o < 64; o <<= 1) { const float y = __shfl_up(rm, o); if (lane >= o) rm = fmaxf(rm, y); }
            BQ[t * 4 + head] = b; IQ[t * 4 + head] = ig; MT[t * 4 + head] = rm;
            if (lane == 63) { CH[4096 + bh * 256 + c] = b; CH[bh * 256 + c] = b + rm; }
        }
    }
    const bf16_t* QB = (const bf16_t*)(ws + OFF_QB); const bf16_t* KB = (const bf16_t*)(ws + OFF_KB);
    bf16_t* Y = (bf16_t*)(ws + OFF_Y); bf16_t* KT = (bf16_t*)(ws + OFF_TMP);
    for (size_t it = (size_t)blockIdx.x * 512 + tid; it < (size_t)(T / 8) * 256; it += (size_t)gridDim.x * 512) {
        const size_t t0 = (it >> 8) * 8; const int c0 = (int)(it & 255) * 8, isk = c0 >= 1024, cc = c0 & 1023; const int s0 = (int)(t0 & (SEQ - 1));
        const bf16_t* src = isk ? KB : QB;
        u32x4 rw[11];
#pragma unroll
        for (int j = 0; j < 11; ++j) rw[j] = (s0 - 3 + j >= 0) ? *(const u32x4*)(src + (t0 - 3 + j) * 1024 + cc) : (u32x4){0u, 0u, 0u, 0u};
        f32x4 cw[4][2];
#pragma unroll
        for (int j = 0; j < 4; ++j) { cw[j][0] = *(const f32x4*)(p.e_conv + j * 2048 + c0); cw[j][1] = *(const f32x4*)(p.e_conv + j * 2048 + c0 + 4); }
        const float sc = isk ? 0.0625f : 1.0f;
#pragma unroll
        for (int k = 0; k < 8; ++k) {
            float acc[8];
#pragma unroll
            for (int i = 0; i < 8; ++i) acc[i] = 0.f;
#pragma unroll
            for (int j = 0; j < 4; ++j) { const u32x4 w = rw[k + j];
                acc[0] += cw[j][0][0] * bflo(w.x); acc[1] += cw[j][0][1] * bfhi(w.x); acc[2] += cw[j][0][2] * bflo(w.y); acc[3] += cw[j][0][3] * bfhi(w.y);
                acc[4] += cw[j][1][0] * bflo(w.z); acc[5] += cw[j][1][1] * bfhi(w.z); acc[6] += cw[j][1][2] * bflo(w.w); acc[7] += cw[j][1][3] * bfhi(w.w); }
            u32x4 o; o.x = pk2(siluf_(acc[0]) * sc, siluf_(acc[1]) * sc); o.y = pk2(siluf_(acc[2]) * sc, siluf_(acc[3]) * sc);
            o.z = pk2(siluf_(acc[4]) * sc, siluf_(acc[5]) * sc); o.w = pk2(siluf_(acc[6]) * sc, siluf_(acc[7]) * sc);
            if (isk) *(u32x4*)(KT + (t0 + k) * 1024 + cc) = o; else *(u32x4*)(Y + (t0 + k) * 2048 + 1024 + cc) = o;
        }
    }
}

typedef float f32x16 __attribute__((ext_vector_type(16)));
constexpr int ML_RS = 528, ML_WS = 144;
__device__ __forceinline__ bf16x8 ml_tr8(const LAS unsigned char* a, int second_off) {
    const v4i16_t t0 = __builtin_amdgcn_ds_read_tr16_b64_v4i16((LAS v4i16_t*)a);
    const v4i16_t t1 = __builtin_amdgcn_ds_read_tr16_b64_v4i16((LAS v4i16_t*)(a + second_off));
    bf16x8 r; r[0] = t0[0]; r[1] = t0[1]; r[2] = t0[2]; r[3] = t0[3]; r[4] = t1[0]; r[5] = t1[1]; r[6] = t1[2]; r[7] = t1[3]; return r;
}
__device__ __forceinline__ void mlstm_chunk_scan(const float* CH, int bh, LAS float* sB, LAS float* sMp, LAS float* sMn) {
    const int tid = threadIdx.x;
    if (tid < 256) { sB[tid] = CH[4096 + bh * 256 + tid]; sMn[tid] = CH[bh * 256 + tid]; }
    __syncthreads();
    if (tid == 0) { float m = 0.f; for (int c = 0; c < 256; ++c) { const float g = sMn[c]; sMp[c] = m; m = fmaxf(sB[c] + m, g); sMn[c] = m; } }
    __syncthreads();
}
template <bool FULL>
__device__ __forceinline__ void mlstm_units(const P& p, unsigned char* lds_) {
    unsigned char* ws = p.ws; const int tid0 = threadIdx.x;
    const int w = __builtin_amdgcn_readfirstlane(tid0 >> 6);
    const bf16_t* Yq = (const bf16_t*)(ws + OFF_Y); bf16_t* Yo = (bf16_t*)(ws + OFF_Y);
    const bf16_t* KT = (const bf16_t*)(ws + OFF_TMP); const bf16_t* VB = (const bf16_t*)(ws + OFF_VB);
    float* ST = (float*)(ws + OFF_QB); float* NS = (float*)(ws + OFF_NS);
    const float *BQ = (const float*)(ws + OFF_BQ), *IQ = (const float*)(ws + OFF_IQ), *MT = (const float*)(ws + OFF_MT), *CH = (const float*)(ws + OFF_CH);
    LAS unsigned char* Qs = (LAS unsigned char*)lds_;
    LAS unsigned char* Ks = Qs + 64 * ML_RS;
    LAS unsigned char* Vs = Ks + 64 * ML_RS;
    LAS unsigned char* Wl = Vs + 64 * ML_RS;
    LAS float* sa = (LAS float*)(Wl + 64 * ML_WS);
    LAS float* sden = sa + 64; LAS float* ssw = sden + 64; LAS float* sf = ssw + 64; LAS float* sg = sf + 64; LAS float* nd = sg + 64; LAS float* rden = nd + 64; LAS float* ns = rden + 64;
    LAS float* cB = ns + 256; LAS float* cMp = cB + 256; LAS float* cMn = cMp + 256;
    for (int unit = blockIdx.x; unit < 256; unit += gridDim.x) {
        const int bh = unit >> 5, S = unit & 31, batch = bh >> 2, head = bh & 3;
        const int tid = tid0, lane = tid0 & 63, hh = lane >> 5;
        __syncthreads();
        mlstm_chunk_scan(CH, bh, cB, cMp, cMn);
        f32x16 st[8]; float nreg = 0.f;
        if (FULL) {
#pragma unroll
            for (int kt = 0; kt < 8; ++kt) {
                int lz = lane; asm volatile("" : "+v"(lz) :: "memory");
                const float* sp = ST + (size_t)unit * 65536 + 32 * w + (lz & 31) + (size_t)(32 * kt + 4 * (lz >> 5)) * 256;
#pragma unroll
                for (int r = 0; r < 16; ++r) st[kt][r] = sp[((r & 3) + 8 * (r >> 2)) * 256];
            }
            if (tid < 256) nreg = NS[unit * 256 + tid];
        } else {
#pragma unroll
            for (int kt = 0; kt < 8; ++kt)
#pragma unroll
                for (int r = 0; r < 16; ++r) st[kt][r] = 0.f;
        }
#pragma unroll 1
        for (int cc = 0; cc < 8; ++cc) {
            int tid = tid0; asm volatile("" : "+v"(tid));
            const int lane = tid & 63, l31 = lane & 31, hh = lane >> 5, fr = lane & 15, fq = lane >> 4;
            const int trow = 8 * hh + (fr >> 2), tcol = (16 * (fq & 1) + 4 * (fr & 3)) * 2;
            const int ch = S * 8 + cc; const size_t t0 = (size_t)batch * SEQ + ch * 64;
            const float mprev = cMp[ch], mnew = cMn[ch], blast = cB[ch];
            const float decay = __expf(blast + mprev - mnew);
            __syncthreads();
#pragma unroll
            for (int j = 0; j < 4; ++j) { const int e = tid + 512 * j, r = e >> 5, cg = e & 31;
                *(LAS u32x4*)(Ks + r * ML_RS + cg * 16) = *(const u32x4*)(KT + (t0 + r) * 1024 + head * 256 + cg * 8);
                *(LAS u32x4*)(Vs + r * ML_RS + cg * 16) = *(const u32x4*)(VB + (t0 + r) * 1024 + head * 256 + cg * 8);
                if (FULL) *(LAS u32x4*)(Qs + r * ML_RS + cg * 16) = *(const u32x4*)(Yq + (t0 + r) * 2048 + 1024 + head * 256 + cg * 8); }
            if (tid < 64) { const float bq = BQ[(t0 + tid) * 4 + head], iq = IQ[(t0 + tid) * 4 + head], mt = bq + fmaxf(mprev, MT[(t0 + tid) * 4 + head]);
                sa[tid] = __expf(bq + mprev - mt); sden[tid] = __expf(-mt); ssw[tid] = __expf(blast - bq + iq - mnew); sf[tid] = bq - mt; sg[tid] = iq - bq; }
            if (FULL && tid < 256) ns[tid] = nreg;
            __syncthreads();
            bf16x8 bv[4];
            if (!FULL) {
#pragma unroll
                for (int ks = 0; ks < 4; ++ks) bv[ks] = ml_tr8(Vs + (16 * ks + trow) * ML_RS + 64 * w + tcol, 4 * ML_RS);
            }
            if (FULL) {
                { const int tt = w >> 1;
#pragma unroll
                  for (int si = 0; si < 2; ++si) { const int ss = 2 * (w & 1) + si;
                    f32x4 acc = (f32x4){0.f, 0.f, 0.f, 0.f};
                    if (ss <= tt) {
#pragma unroll
                        for (int ks = 0; ks < 8; ++ks) { const bf16x8 a = *(const LAS bf16x8*)(Qs + (16 * tt + fr) * ML_RS + (32 * ks + 8 * fq) * 2), b = *(const LAS bf16x8*)(Ks + (16 * ss + fr) * ML_RS + (32 * ks + 8 * fq) * 2);
                            acc = __builtin_amdgcn_mfma_f32_16x16x32_bf16(a, b, acc, 0, 0, 0); } }
                    const int sidx = 16 * ss + fr; const float gs = sg[sidx];
#pragma unroll
                    for (int j = 0; j < 4; ++j) { const int tix = 16 * tt + 4 * fq + j; const float wv = (sidx <= tix) ? __expf(sf[tix] + gs) * acc[j] : 0.f;
                        *(LAS bf16_t*)(Wl + tix * ML_WS + sidx * 2) = f2bf(wv); } } }
#pragma unroll
                for (int i = 0; i < 8; ++i) { const int tix = 8 * w + i; const u32x2 qv = *(const LAS u32x2*)(Qs + tix * ML_RS + lane * 8); const f32x4 nv = *(const LAS f32x4*)(ns + lane * 4);
                    float part = bflo(qv.x) * nv[0] + bfhi(qv.x) * nv[1] + bflo(qv.y) * nv[2] + bfhi(qv.y) * nv[3]; part = wave_sum(part); if (lane == 0) nd[tix] = part; }
                __syncthreads();
                f32x16 acc[2];
#pragma unroll
                for (int t2 = 0; t2 < 2; ++t2) {
#pragma unroll
                    for (int r = 0; r < 16; ++r) acc[t2][r] = 0.f;
                }
#pragma unroll
                for (int kt = 0; kt < 8; ++kt) {
                    asm volatile("" ::: "memory");
#pragma unroll
                    for (int s2 = 0; s2 < 2; ++s2) {
                        u32x4 bw; bw.x = pg8::cvt_pk_bf16(st[kt][8 * s2 + 0], st[kt][8 * s2 + 1]); bw.y = pg8::cvt_pk_bf16(st[kt][8 * s2 + 2], st[kt][8 * s2 + 3]);
                        bw.z = pg8::cvt_pk_bf16(st[kt][8 * s2 + 4], st[kt][8 * s2 + 5]); bw.w = pg8::cvt_pk_bf16(st[kt][8 * s2 + 6], st[kt][8 * s2 + 7]);
                        const bf16x8 bfrag = __builtin_bit_cast(bf16x8, bw);
#pragma unroll
                        for (int t2 = 0; t2 < 2; ++t2) { const LAS unsigned char* qa = Qs + (32 * t2 + l31) * ML_RS + (32 * kt + 16 * s2 + 4 * hh) * 2;
                            const u32x2 lo = *(const LAS u32x2*)qa, hi = *(const LAS u32x2*)(qa + 16); u32x4 aw; aw.x = lo.x; aw.y = lo.y; aw.z = hi.x; aw.w = hi.y;
                            acc[t2] = __builtin_amdgcn_mfma_f32_32x32x16_bf16(__builtin_bit_cast(bf16x8, aw), bfrag, acc[t2], 0, 0, 0); }
                    }
                }
                asm volatile("" ::: "memory");
#pragma unroll
                for (int t2 = 0; t2 < 2; ++t2)
#pragma unroll
                    for (int r = 0; r < 16; ++r) acc[t2][r] *= sa[32 * t2 + (r & 3) + 8 * (r >> 2) + 4 * hh];
#pragma unroll
                for (int ks = 0; ks < 4; ++ks) bv[ks] = ml_tr8(Vs + (16 * ks + trow) * ML_RS + 64 * w + tcol, 4 * ML_RS);
#pragma unroll
                for (int ks = 0; ks < 4; ++ks)
#pragma unroll
                    for (int t2 = 0; t2 < 2; ++t2) { const bf16x8 a = *(const LAS bf16x8*)(Wl + (32 * t2 + l31) * ML_WS + (16 * ks + 8 * hh) * 2);
                        acc[t2] = __builtin_amdgcn_mfma_f32_32x32x16_bf16(a, bv[ks], acc[t2], 0, 0, 0); }
#pragma unroll
                for (int i = 0; i < 8; ++i) { const int tix = 8 * w + i; float rs = bf2f(*(const LAS bf16_t*)(Wl + tix * ML_WS + lane * 2)); rs = wave_sum(rs);
                    if (lane == 0) { const float nq = sa[tix] * nd[tix] + rs; rden[tix] = 1.0f / fmaxf(fabsf(nq), sden[tix]); } }
                __syncthreads();
                bf16_t* yo = Yo + t0 * 2048 + head * 256 + 32 * w + l31;
#pragma unroll
                for (int t2 = 0; t2 < 2; ++t2)
#pragma unroll
                    for (int r = 0; r < 16; ++r) { const int tix = 32 * t2 + (r & 3) + 8 * (r >> 2) + 4 * hh; yo[(size_t)tix * 2048] = f2bf(acc[t2][r] * rden[tix]); }
            }
#pragma unroll
            for (int kt = 0; kt < 8; ++kt) st[kt] *= decay;
#pragma unroll
            for (int ks = 0; ks < 4; ++ks) {
                const u32x4 raw = __builtin_bit_cast(u32x4, bv[ks]); const LAS float* sw8 = ssw + 16 * ks + 8 * hh;
                u32x4 sc; sc.x = pg8::cvt_pk_bf16(bflo(raw.x) * sw8[0], bfhi(raw.x) * sw8[1]); sc.y = pg8::cvt_pk_bf16(bflo(raw.y) * sw8[2], bfhi(raw.y) * sw8[3]);
                sc.z = pg8::cvt_pk_bf16(bflo(raw.z) * sw8[4], bfhi(raw.z) * sw8[5]); sc.w = pg8::cvt_pk_bf16(bflo(raw.w) * sw8[6], bfhi(raw.w) * sw8[7]);
                const bf16x8 bs = __builtin_bit_cast(bf16x8, sc);
#pragma unroll
                for (int kt = 0; kt < 8; ++kt) { if ((kt & 3) == 0) asm volatile("" ::: "memory");
                    const bf16x8 a = ml_tr8(Ks + (16 * ks + trow) * ML_RS + 64 * kt + tcol, 4 * ML_RS);
                    st[kt] = __builtin_amdgcn_mfma_f32_32x32x16_bf16(a, bs, st[kt], 0, 0, 0); }
            }
            if (tid < 256) { float nacc = 0.f;
#pragma unroll 8
                for (int s2 = 0; s2 < 64; ++s2) nacc += ssw[s2] * bf2f(*(const LAS bf16_t*)(Ks + s2 * ML_RS + tid * 2));
                nreg = decay * nreg + nacc; }
        }
        if (!FULL) {
#pragma unroll
            for (int kt = 0; kt < 8; ++kt) {
                int lz = lane; asm volatile("" : "+v"(lz) :: "memory");
                float* sp = ST + (size_t)unit * 65536 + 32 * w + (lz & 31) + (size_t)(32 * kt + 4 * (lz >> 5)) * 256;
#pragma unroll
                for (int r = 0; r < 16; ++r) sp[((r & 3) + 8 * (r >> 2)) * 256] = st[kt][r];
            }
            if (tid < 256) NS[unit * 256 + tid] = nreg;
        }
    }
}
__device__ __forceinline__ void phase_mlstm_scan(const P& p, unsigned char* lds_) {
    unsigned char* ws = p.ws; const int tid = threadIdx.x;
    float* ST = (float*)(ws + OFF_QB); float* NS = (float*)(ws + OFF_NS); const float* CH = (const float*)(ws + OFF_CH);
    LAS float* DS = (LAS float*)lds_;
    LAS float* cB = DS + 256; LAS float* cMp = cB + 256; LAS float* cMn = cMp + 256;
    for (int bh = 0; bh < 8; ++bh) {
        __syncthreads();
        mlstm_chunk_scan(CH, bh, cB, cMp, cMn);
        if (tid < 32) { float d = 1.f; for (int c = 0; c < 8; ++c) { const int ch = tid * 8 + c; d *= __expf(cB[ch] + cMp[ch] - cMn[ch]); } DS[bh * 32 + tid] = d; }
    }
    __syncthreads();
    const int per = 65536 + 256;
    for (int it = blockIdx.x * 512 + tid; it < 8 * per; it += gridDim.x * 512) {
        const int bh = it / per, e = it - bh * per;
        float* base; size_t stride;
        if (e < 65536) { base = ST + (size_t)bh * 32 * 65536 + e; stride = 65536; } else { base = NS + (size_t)bh * 32 * 256 + (e - 65536); stride = 256; }
        float carry = 0.f;
#pragma unroll 8
        for (int S = 0; S < 32; ++S) { const float tmp = base[S * stride]; base[S * stride] = carry; carry = DS[bh * 32 + S] * carry + tmp; }
    }
}

__device__ __forceinline__ void phase_ya_pool(const P& p) {
    unsigned char* ws = p.ws; const int tid = threadIdx.x, lane = tid & 63, wave = tid >> 6;
    bf16_t* Y = (bf16_t*)(ws + OFF_Y); const bf16_t* O = (const bf16_t*)(ws + OFF_QB); const bf16_t* ZA = (const bf16_t*)(ws + OFF_KB);
    for (int tt = blockIdx.x * 8 + wave; tt < T; tt += gridDim.x * 8) {
        const size_t t = (size_t)tt; u32x2 hw[4], ow[4], zw[4];
#pragma unroll
        for (int head = 0; head < 4; ++head) { const int c = head * 256 + lane * 4;
            hw[head] = *(const u32x2*)(Y + t * 2048 + c); ow[head] = *(const u32x2*)(O + t * 1024 + c); zw[head] = *(const u32x2*)(ZA + t * 1024 + c); }
#pragma unroll
        for (int head = 0; head < 4; ++head) { const int c = head * 256 + lane * 4;
            float v[4] = {bflo(hw[head].x) * bflo(ow[head].x), bfhi(hw[head].x) * bfhi(ow[head].x), bflo(hw[head].y) * bflo(ow[head].y), bfhi(hw[head].y) * bfhi(ow[head].y)};
            const float ss = wave_sum(v[0] * v[0] + v[1] * v[1] + v[2] * v[2] + v[3] * v[3]);
            const float rstd = rsqrtf(ss * (1.0f / 256.0f) + EPS);
            const f32x4 g = *(const f32x4*)(p.e_g_head + c);
            u32x2 o; o.x = pk2(v[0] * rstd * g[0] * bflo(zw[head].x), v[1] * rstd * g[1] * bfhi(zw[head].x)); o.y = pk2(v[2] * rstd * g[2] * bflo(zw[head].y), v[3] * rstd * g[3] * bfhi(zw[head].y));
            *(u32x2*)(Y + t * 2048 + c) = o; }
    }
    const bf16_t* U = (const bf16_t*)(ws + OFF_VB);
    for (size_t it = (size_t)blockIdx.x * 512 + tid; it < (size_t)T * 128; it += (size_t)gridDim.x * 512) {
        const size_t t = it >> 7; const int c0 = (int)(it & 127) * 8, g = c0 >> 8, win = 2 << g, s = (int)(t & (SEQ - 1)); const int cnt = (s + 1 < win) ? s + 1 : win;
        u32x4 w[16];
#pragma unroll
        for (int j = 0; j < 16; ++j) w[j] = (j < cnt) ? *(const u32x4*)(U + (t - j) * 1024 + c0) : (u32x4){0u, 0u, 0u, 0u};
        bf16_t* yp = Y + t * 2048 + 1024 + c0; const u32x4 z = *(const u32x4*)yp;
        const f32x4 s0 = *(const f32x4*)(p.e_s_pool + c0), s1 = *(const f32x4*)(p.e_s_pool + c0 + 4);
        float acc[8];
#pragma unroll
        for (int i = 0; i < 8; ++i) acc[i] = 0.f;
#pragma unroll
        for (int j = 0; j < 16; ++j) { acc[0] += bflo(w[j].x); acc[1] += bfhi(w[j].x); acc[2] += bflo(w[j].y); acc[3] += bfhi(w[j].y); acc[4] += bflo(w[j].z); acc[5] += bfhi(w[j].z); acc[6] += bflo(w[j].w); acc[7] += bfhi(w[j].w); }
        const float self[8] = {bflo(w[0].x), bfhi(w[0].x), bflo(w[0].y), bfhi(w[0].y), bflo(w[0].z), bfhi(w[0].z), bflo(w[0].w), bfhi(w[0].w)};
        const float inv = __builtin_amdgcn_rcpf((float)cnt);
        const float zf[8] = {bflo(z.x), bfhi(z.x), bflo(z.y), bfhi(z.y), bflo(z.z), bfhi(z.z), bflo(z.w), bfhi(z.w)};
        float o[8];
#pragma unroll
        for (int i = 0; i < 8; ++i) o[i] = (acc[i] * inv - self[i]) * (i < 4 ? s0[i] : s1[i - 4]) * zf[i];
        u32x4 ow; ow.x = pk2(o[0], o[1]); ow.y = pk2(o[2], o[3]); ow.z = pk2(o[4], o[5]); ow.w = pk2(o[6], o[7]);
        *(u32x4*)yp = ow;
    }
}

__device__ __forceinline__ void headnorm64(bf16_t* X, const float* g) {
    const int lane = threadIdx.x & 63, wave = threadIdx.x >> 6;
    const float* gg = g + (lane & 3) * 16;
    for (int t0 = (blockIdx.x * 8 + wave) * 4; t0 < T; t0 += gridDim.x * 32) {
        u32x4 a[4], b[4];
#pragma unroll
        for (int k = 0; k < 4; ++k) { const bf16_t* r = X + (size_t)(t0 + k) * 1024 + lane * 16; a[k] = *(const u32x4*)r; b[k] = *(const u32x4*)(r + 8); }
#pragma unroll
        for (int k = 0; k < 4; ++k) {
            float f[16] = {bflo(a[k].x), bfhi(a[k].x), bflo(a[k].y), bfhi(a[k].y), bflo(a[k].z), bfhi(a[k].z), bflo(a[k].w), bfhi(a[k].w), bflo(b[k].x), bfhi(b[k].x), bflo(b[k].y), bfhi(b[k].y), bflo(b[k].z), bfhi(b[k].z), bflo(b[k].w), bfhi(b[k].w)};
            float ss = 0.f;
#pragma unroll
            for (int i = 0; i < 16; ++i) ss += f[i] * f[i];
            ss += __shfl_xor(ss, 1); ss += __shfl_xor(ss, 2);
            const float rstd = rsqrtf(ss * (1.0f / 64.0f) + EPS);
#pragma unroll
            for (int i = 0; i < 16; ++i) f[i] = f[i] * rstd * gg[i];
            u32x4 oa, ob; oa.x = pk2(f[0], f[1]); oa.y = pk2(f[2], f[3]); oa.z = pk2(f[4], f[5]); oa.w = pk2(f[6], f[7]);
            ob.x = pk2(f[8], f[9]); ob.y = pk2(f[10], f[11]); ob.z = pk2(f[12], f[13]); ob.w = pk2(f[14], f[15]);
            bf16_t* r = X + (size_t)(t0 + k) * 1024 + lane * 16; *(u32x4*)r = oa; *(u32x4*)(r + 8) = ob;
        }
    }
}
__device__ __forceinline__ void phase_qnorm_ckvnorm(const P& p) {
    unsigned char* ws = p.ws; const int lane = threadIdx.x & 63, wave = threadIdx.x >> 6;
    headnorm64((bf16_t*)(ws + OFF_TMP), p.o_g_q);
    bf16_t* CKVN = (bf16_t*)(ws + OFF_CKVN);
    const f32x4 g = *(const f32x4*)(p.o_g_kv + lane * 4);
    for (int t0 = (blockIdx.x * 8 + wave) * 8; t0 < T; t0 += gridDim.x * 64) {
        u32x2 w[8];
#pragma unroll
        for (int k = 0; k < 8; ++k) w[k] = *(const u32x2*)(CKVN + (size_t)(t0 + k) * 256 + lane * 4);
#pragma unroll
        for (int k = 0; k < 8; ++k) {
            const float v[4] = {bflo(w[k].x), bfhi(w[k].x), bflo(w[k].y), bfhi(w[k].y)};
            const float ss = wave_sum(v[0] * v[0] + v[1] * v[1] + v[2] * v[2] + v[3] * v[3]);
            const float rstd = rsqrtf(ss * (1.0f / 256.0f) + EPS);
            u32x2 o; o.x = pk2(v[0] * rstd * g[0], v[1] * rstd * g[1]); o.y = pk2(v[2] * rstd * g[2], v[3] * rstd * g[3]);
            *(u32x2*)(CKVN + (size_t)(t0 + k) * 256 + lane * 4) = o;
        }
    }
}

__device__ __forceinline__ unsigned okey(float s) { if (s == 0.f) s = 0.f; const unsigned u = __float_as_uint(s); return (u & 0x80000000u) ? ~u : (u | 0x80000000u); }

__device__ __forceinline__ void indexer_slow_query(const P& p, unsigned char* lds, size_t t) {
    unsigned char* ws = p.ws; const int tid = threadIdx.x, lane = tid & 63, wave = tid >> 6;
    const _Float16* QI = (const _Float16*)(ws + OFF_QI); const _Float16* KI = (const _Float16*)(ws + OFF_KI); const float* WI = (const float*)(ws + OFF_WI);
    unsigned short* IDX = (unsigned short*)(ws + OFF_IDX);
    unsigned* sc = (unsigned*)lds; unsigned* hist = sc + 16384; float* qs = (float*)(hist + 256); unsigned* misc = (unsigned*)(qs + 256); unsigned* wsum = misc + 16;
    const int batch = (int)(t >> 14), pos = (int)(t & (SEQ - 1)), n = pos + 1;
    __syncthreads();
    if (tid < 256) qs[tid] = (float)QI[t * 256 + tid];
    const float w0 = WI[t * 4 + 0], w1 = WI[t * 4 + 1], w2 = WI[t * 4 + 2], w3 = WI[t * 4 + 3];
    __syncthreads();
    const _Float16* kbase = KI + (size_t)batch * SEQ * 64;
    for (int s = tid; s < n; s += 512) {
        asm volatile("" ::: "memory");
        typedef _Float16 h8 __attribute__((ext_vector_type(8)));
        const h8* kr = (const h8*)(kbase + (size_t)s * 64);
        float d0 = 0.f, d1 = 0.f, d2 = 0.f, d3 = 0.f;
#pragma unroll
        for (int j = 0; j < 8; ++j) { const h8 kv = kr[j];
#pragma unroll
            for (int e = 0; e < 8; ++e) { const int d = j * 8 + e; const float kf = (float)kv[e]; d0 += qs[d] * kf; d1 += qs[64 + d] * kf; d2 += qs[128 + d] * kf; d3 += qs[192 + d] * kf; } }
        float score = w0 * fmaxf(d0, 0.f); score = fmaf(w1, fmaxf(d1, 0.f), score); score = fmaf(w2, fmaxf(d2, 0.f), score); score = fmaf(w3, fmaxf(d3, 0.f), score);
        sc[s] = okey(score);
    }
    unsigned prefix = 0, krem = 256;
    for (int pass = 0; pass < 4; ++pass) {
        const int shift = 24 - 8 * pass;
        __syncthreads();
        if (tid < 256) hist[tid] = 0;
        __syncthreads();
        for (int s = tid; s < n; s += 512) { const unsigned k = sc[s]; if (pass == 0 || (k >> (shift + 8)) == prefix) atomicAdd(&hist[(k >> shift) & 255u], 1u); }
        __syncthreads();
        if (tid == 0) { unsigned cum = 0; int bin = 255; for (; bin > 0; --bin) { const unsigned c = hist[bin]; if (cum + c >= krem) break; cum += c; } misc[0] = (unsigned)bin; misc[1] = krem - cum; }
        __syncthreads();
        prefix = (prefix << 8) | misc[0]; krem = misc[1];
    }
    const unsigned ngt_total = 256u - krem;
    unsigned lg = 0, le = 0; const int s0 = tid * 32;
    for (int s = s0; s < s0 + 32 && s < n; ++s) { const unsigned k = sc[s]; lg += (k > prefix); le += (k == prefix); }
    unsigned pk = lg | (le << 16), incl = pk;
#pragma unroll
    for (int o = 1; o < 64; o <<= 1) { const unsigned y = __shfl_up(incl, o); if (lane >= o) incl += y; }
    if (lane == 63) wsum[wave] = incl;
    __syncthreads();
    unsigned base = 0;
    for (int w = 0; w < wave; ++w) base += wsum[w];
    const unsigned excl = base + incl - pk; unsigned bg = excl & 0xffffu, be = excl >> 16;
    for (int s = s0; s < s0 + 32 && s < n; ++s) { const unsigned k = sc[s];
        if (k > prefix) { IDX[t * 256 + bg] = (unsigned short)s; ++bg; }
        else if (k == prefix) { if (be < krem) IDX[t * 256 + ngt_total + be] = (unsigned short)s; ++be; } }
    __syncthreads();
}

typedef _Float16 half8 __attribute__((ext_vector_type(8)));
constexpr int IX_CAP = 1024, IX_ZBIN = 1024;
__device__ __forceinline__ unsigned ix_key(const f32x4 a, const f32x4 w) {
    const float r0 = __int_as_float(max(__float_as_int(a[0]), 0)), r1 = __int_as_float(max(__float_as_int(a[1]), 0));
    const float r2 = __int_as_float(max(__float_as_int(a[2]), 0)), r3 = __int_as_float(max(__float_as_int(a[3]), 0));
    float s = fmaf(w[0], r0, 0.0f); s = fmaf(w[1], r1, s); s = fmaf(w[2], r2, s); s = fmaf(w[3], r3, s);
    const unsigned u = __float_as_uint(s);
    return u ^ ((unsigned)((int)u >> 31) | 0x80000000u);
}
#define LDS_ADD(ptr, v) __hip_atomic_fetch_add((ptr), (v), __ATOMIC_RELAXED, __HIP_MEMORY_SCOPE_WORKGROUP)
struct IxTagF { static constexpr bool value = false; }; struct IxTagT { static constexpr bool value = true; };
__device__ __forceinline__ void phase_indexer(const P& p, unsigned char* lds) {
    unsigned char* ws = p.ws; const int tid = threadIdx.x, lane = tid & 63, kl = lane & 15, g = lane >> 4;
    const int wave = __builtin_amdgcn_readfirstlane(tid >> 6);
    const _Float16* QI = (const _Float16*)(ws + OFF_QI); const _Float16* KI = (const _Float16*)(ws + OFF_KI); const float* WI = (const float*)(ws + OFF_WI);
    unsigned short* IDX = (unsigned short*)(ws + OFF_IDX); int* CNT = (int*)(ws + OFF_CNT);
    LAS unsigned* hist = (LAS unsigned*)lds;
    LAS int* qTbin = (LAS int*)(hist + 16 * 2048);
    LAS int* qCab = qTbin + 16; LAS unsigned* qN = (LAS unsigned*)(qCab + 16); LAS int* qOvf = (LAS int*)(qN + 16); LAS int* qZl = qOvf + 16;
    LAS unsigned* ovl = (LAS unsigned*)(lds + 132 * 1024);
    LAS unsigned* h2 = (LAS unsigned*)(lds + 133 * 1024 + wave * 1536);
    LAS unsigned long long* l2 = (LAS unsigned long long*)(h2 + 256);
    if (tid == 0) ovl[0] = 0u;
    const int G = gridDim.x, nround = (T / 16) / G;
#pragma unroll 1
    for (int i = 0; i < nround; ++i) {
        const int tix = (i & 1) ? i * G + (G - 1 - (int)blockIdx.x) : i * G + (int)blockIdx.x;
        const int batch = tix & 1, tb = tix >> 1, p0 = tb * 16; const size_t t0 = (size_t)batch * SEQ + p0;
        __syncthreads();
        if (p0 + 16 <= 256) {
#pragma unroll
            for (int j = 0; j < 8; ++j) { const int e = tid + 512 * j, q = e >> 8, jj = e & 255; IDX[(t0 + q) * 256 + jj] = (unsigned short)(jj <= p0 + q ? jj : 0); }
            if (tid < 16) CNT[t0 + tid] = p0 + tid + 1;
            continue;
        }
#pragma unroll
        for (int j = 0; j < 16; ++j) ((LAS u32x4*)hist)[tid + 512 * j] = (u32x4){0u, 0u, 0u, 0u};
        if (tid < 16) { qN[tid] = 0u; qOvf[tid] = 0; }
        half8 af[4][2]; f32x4 wv[4];
#pragma unroll
        for (int rt = 0; rt < 4; ++rt) {
#pragma unroll
            for (int ks = 0; ks < 2; ++ks) af[rt][ks] = *(const half8*)(QI + (t0 + 4 * rt + (kl >> 2)) * 256 + (kl & 3) * 64 + 32 * ks + 8 * g);
            wv[rt] = *(const f32x4*)(WI + (t0 + 4 * rt + g) * 4);
        }
        __syncthreads();
        const int nblk = tb + 1, L = (nblk + 7) >> 3, b0 = wave * L, b1 = (b0 + L < nblk) ? b0 + L : nblk;
        const _Float16* kb = KI + (size_t)batch * SEQ * 64 + kl * 64 + 8 * g;
        LAS unsigned* hg = hist + g * 4 * 2048;
#define IX_LOADK(u, bb) do { kq[u][0] = *(const half8*)(kb + (size_t)(bb) * 1024); kq[u][1] = *(const half8*)(kb + (size_t)(bb) * 1024 + 32); } while (0)
#define IX_MFMA(acc, k0, k1) do { _Pragma("unroll") for (int rt = 0; rt < 4; ++rt) { acc[rt] = __builtin_amdgcn_mfma_f32_16x16x32_f16(af[rt][0], k0, (f32x4){0.f, 0.f, 0.f, 0.f}, 0, 0, 0); \
            acc[rt] = __builtin_amdgcn_mfma_f32_16x16x32_f16(af[rt][1], k1, acc[rt], 0, 0, 0); } } while (0)
        if (b0 < b1) {
            half8 kq[2][2];
#pragma unroll
            for (int u = 0; u < 2; ++u) { const int bb = (b0 + u < b1) ? b0 + u : b1 - 1; IX_LOADK(u, bb); }
            auto step1 = [&](int bcur, const half8& k0, const half8& k1, auto chkTag) {
                constexpr bool CHK = decltype(chkTag)::value;
                f32x4 acc[4]; IX_MFMA(acc, k0, k1);
#pragma unroll
                for (int rt = 0; rt < 4; ++rt) { const unsigned key = ix_key(acc[rt], wv[rt]);
                    if (!CHK || bcur * 16 + kl <= p0 + 4 * rt + g) LDS_ADD(hg + rt * 2048 + (key >> 21), 1u); }
            };
            int b = b0;
#pragma unroll 1
            for (; b + 2 <= b1 && b + 2 <= nblk - 1; b += 2) {
#pragma unroll
                for (int u = 0; u < 2; ++u) { step1(b + u, kq[u][0], kq[u][1], IxTagF{}); const int bb = (b + 2 + u < b1) ? b + 2 + u : b1 - 1; IX_LOADK(u, bb); }
            }
#pragma unroll 1
            for (; b + 2 <= b1; b += 2) {
#pragma unroll
                for (int u = 0; u < 2; ++u) { step1(b + u, kq[u][0], kq[u][1], IxTagT{}); const int bb = (b + 2 + u < b1) ? b + 2 + u : b1 - 1; IX_LOADK(u, bb); }
            }
            if (b < b1) step1(b, kq[0][0], kq[0][1], IxTagT{});
        }
        __syncthreads();
#pragma unroll 1
        for (int qq = 0; qq < 2; ++qq) {
            const int q = 2 * wave + qq; const LAS unsigned* h = hist + q * 2048;
            unsigned cs = 0; const int top = 2047 - 32 * lane;
#pragma unroll 8
            for (int ii = 0; ii < 32; ++ii) cs += h[top - ((ii + lane) & 31)];
            unsigned incl = cs;
#pragma unroll
            for (int o = 1; o < 64; o <<= 1) { const unsigned y = __shfl_up(incl, o); if (lane >= o) incl += y; }
            const unsigned long long m = __ballot(incl >= 256u);
            const int Ls = m ? (__ffsll((long long)m) - 1) : 63;
            unsigned cabv = __shfl(incl - cs, Ls), cbv = 0; int tbin = 0; bool found = false;
#pragma unroll 8
            for (int ii = 0; ii < 32; ++ii) { const unsigned c = h[2047 - 32 * Ls - ii]; if (!found && cabv + c >= 256u) { tbin = 2047 - 32 * Ls - ii; cbv = c; found = true; } if (!found) cabv += c; }
            if (lane == 0) { qTbin[q] = tbin; qCab[q] = (int)cabv; int zl = 0x7fffffff;
                if (tbin == IX_ZBIN) {
                    const int nk = p0 + 4 * (q & 3) + (q >> 2) + 1; zl = (int)(((unsigned long long)384 * (unsigned)nk) / (cbv ? cbv : 1u)) + 16; }
                qZl[q] = zl; }
        }
        __syncthreads();
        if (b0 < b1) {
            unsigned lok[4]; int zl[4];
#pragma unroll
            for (int rt = 0; rt < 4; ++rt) { lok[rt] = (unsigned)qTbin[g * 4 + rt] << 21; zl[rt] = qZl[g * 4 + rt]; }
            half8 kq[2][2];
#pragma unroll
            for (int u = 0; u < 2; ++u) { const int bb = (b0 + u < b1) ? b0 + u : b1 - 1; IX_LOADK(u, bb); }
            auto step2 = [&](int bcur, const half8& k0, const half8& k1, auto chkTag) {
                constexpr bool CHK = decltype(chkTag)::value;
                const int s = bcur * 16 + kl;
                f32x4 acc[4]; IX_MFMA(acc, k0, k1);
                unsigned key[4], pos[4]; bool cand[4];
#pragma unroll
                for (int rt = 0; rt < 4; ++rt) { key[rt] = ix_key(acc[rt], wv[rt]); cand[rt] = key[rt] >= lok[rt] + (s >= zl[rt] ? 1u : 0u); if (CHK) cand[rt] = cand[rt] && s <= p0 + 4 * rt + g; }
#pragma unroll
                for (int rt = 0; rt < 4; ++rt) { pos[rt] = 0u;
                    if (cand[rt]) { int gz = g; asm volatile("" : "+v"(gz)); pos[rt] = LDS_ADD(qN + gz * 4 + rt, 1u); } }
#pragma unroll
                for (int rt = 0; rt < 4; ++rt) {
                    if (cand[rt] && pos[rt] < (unsigned)IX_CAP) { int gz = g; asm volatile("" : "+v"(gz));
                        ((LAS unsigned long long*)(lds + (gz * 4 + rt) * 8192))[pos[rt]] = ((unsigned long long)key[rt] << 16) | (unsigned long long)(0xffffu - (unsigned)s); } }
            };
            int b = b0;
#pragma unroll 1
            for (; b + 2 <= b1 && b + 2 <= nblk - 1; b += 2) {
#pragma unroll
                for (int u = 0; u < 2; ++u) { step2(b + u, kq[u][0], kq[u][1], IxTagF{}); const int bb = (b + 2 + u < b1) ? b + 2 + u : b1 - 1; IX_LOADK(u, bb); }
            }
#pragma unroll 1
            for (; b + 2 <= b1; b += 2) {
#pragma unroll
                for (int u = 0; u < 2; ++u) { step2(b + u, kq[u][0], kq[u][1], IxTagT{}); const int bb = (b + 2 + u < b1) ? b + 2 + u : b1 - 1; IX_LOADK(u, bb); }
            }
            if (b < b1) step2(b, kq[0][0], kq[0][1], IxTagT{});
        }
#undef IX_LOADK
#undef IX_MFMA
        __syncthreads();
#pragma unroll 1
        for (int qq = 0; qq < 2; ++qq) {
            const int qs = 2 * wave + qq; const int n = (int)qN[qs], cabq = qCab[qs], tbin = qTbin[qs];
            if (n > IX_CAP || n < 256) { if (lane == 0) qOvf[qs] = 1; continue; }
            const LAS unsigned long long* cd = (const LAS unsigned long long*)(lds + qs * 8192);
            unsigned short* irow = IDX + (t0 + 4 * (qs & 3) + (qs >> 2)) * 256;
            if (n == 256) { for (int c = lane; c < n; c += 64) irow[c] = (unsigned short)(0xffffu - (unsigned)(cd[c] & 0xffffull)); continue; }
            { int base = 0;
              for (int c0 = 0; c0 < n; c0 += 64) { const int c = c0 + lane; const unsigned long long v = c < n ? cd[c] : 0ull; const bool sure = c < n && (int)(v >> 37) > tbin;
                  const unsigned long long bm = __ballot(sure);
                  if (sure) irow[base + __popcll(bm & ((1ull << lane) - 1ull))] = (unsigned short)(0xffffu - (unsigned)(v & 0xffffull));
                  base += __popcll(bm); } }
            unsigned long long pmask = 0x7ffull << 37, pval = (unsigned long long)tbin << 37; int need = 256 - cabq, done = cabq; unsigned cT = (unsigned)(n - cabq);
#pragma unroll 1
            for (int shift = 29; shift >= 5 && cT > 64u; shift -= 8) {
#pragma unroll
                for (int j = 0; j < 4; ++j) h2[lane + 64 * j] = 0u;
                for (int c = lane; c < n; c += 64) { const unsigned long long v = cd[c]; if ((v & pmask) == pval) LDS_ADD(h2 + ((unsigned)(v >> shift) & 255u), 1u); }
                const unsigned cs = h2[255 - 4 * lane] + h2[254 - 4 * lane] + h2[253 - 4 * lane] + h2[252 - 4 * lane];
                unsigned incl = cs;
#pragma unroll
                for (int o = 1; o < 64; o <<= 1) { const unsigned y = __shfl_up(incl, o); if (lane >= o) incl += y; }
                const unsigned long long m = __ballot(incl >= (unsigned)need);
                const int Ls = m ? (__ffsll((long long)m) - 1) : 63;
                unsigned above = __shfl(incl - cs, Ls), c2 = 0; int T2 = 0; bool found = false;
#pragma unroll
                for (int ii = 0; ii < 4; ++ii) { const unsigned c = h2[255 - 4 * Ls - ii]; if (!found && above + c >= (unsigned)need) { T2 = 255 - 4 * Ls - ii; c2 = c; found = true; } if (!found) above += c; }
                { int base = done;
                  for (int c0 = 0; c0 < n; c0 += 64) { const int c = c0 + lane; const unsigned long long v = c < n ? cd[c] : 0ull;
                      const bool up = c < n && (v & pmask) == pval && (int)((unsigned)(v >> shift) & 255u) > T2;
                      const unsigned long long bm = __ballot(up);
                      if (up) irow[base + __popcll(bm & ((1ull << lane) - 1ull))] = (unsigned short)(0xffffu - (unsigned)(v & 0xffffull));
                      base += __popcll(bm); } }
                done += (int)above; need -= (int)above; cT = c2;
                pmask |= 255ull << shift; pval |= (unsigned long long)T2 << shift;
            }
            asm volatile("" ::: "memory");
            if (lane == 0) h2[1] = 0u;
            asm volatile("" ::: "memory");
            for (int c = lane; c < n; c += 64) { const unsigned long long v = cd[c]; if ((v & pmask) == pval) { const unsigned pos = LDS_ADD(h2 + 1, 1u); if (pos < 64u) l2[pos] = v; } }
            asm volatile("" ::: "memory");
            { const unsigned long long mine = (unsigned)lane < cT ? l2[lane] : ~0ull; int rank = 0;
              for (unsigned j = 0; j < cT; ++j) rank += (l2[j] > mine) ? 1 : 0;
              if ((unsigned)lane < cT && rank < need) irow[done + rank] = (unsigned short)(0xffffu - (unsigned)(mine & 0xffffull)); }
        }
        if (tid < 16) CNT[t0 + tid] = 256;
        __syncthreads();
        if (tid < 16 && qOvf[tid]) { const unsigned k = LDS_ADD(ovl, 1u); ovl[1 + k] = (unsigned)(t0 + 4 * (tid & 3) + (tid >> 2)); }
    }
    __syncthreads();
    const unsigned novl = __builtin_amdgcn_readfirstlane(ovl[0]);
#pragma unroll 1
    for (unsigned k = 0; k < novl; ++k) { const unsigned tq = __builtin_amdgcn_readfirstlane(ovl[1 + k]); indexer_slow_query(p, lds, (size_t)tq); }
}
#undef LDS_ADD

__device__ __forceinline__ void phase_attn(const P& p, unsigned char* lds) {
    unsigned char* ws = p.ws; const int tid = threadIdx.x, lane = tid & 63, hd = lane & 15, g = lane >> 4;
    const int wave = __builtin_amdgcn_readfirstlane(tid >> 6);
    bf16_t* QP = (bf16_t*)(ws + OFF_QP); const bf16_t* CK = (const bf16_t*)(ws + OFF_CKVN); const bf16_t* RK = (const bf16_t*)(ws + OFF_RK);
    const unsigned short* IDX = (const unsigned short*)(ws + OFF_IDX); const int* CNT = (const int*)(ws + OFF_CNT);
    float* biasT = (float*)lds;
    biasT[tid] = p.rel_bias[tid];
    __syncthreads();
    LAS unsigned char* rows = (LAS unsigned char*)(lds + 2048 + (size_t)wave * 18432);
    LAS bf16_t* rkb = (LAS bf16_t*)(rows + 16384);
    LAS unsigned* info = (LAS unsigned*)(rows + 17408);
    const LAS float* biasL = (const LAS float*)lds;
    for (int t = blockIdx.x * 8 + wave; t < T; t += gridDim.x * 8) {
        const int batch = t >> 14, pos = t & (SEQ - 1); const int cnt = CNT[t];
        const size_t rb = (size_t)batch * SEQ;
        asm volatile("s_waitcnt lgkmcnt(0)" ::: "memory");
#pragma unroll
        for (int jj = 0; jj < 4; ++jj) {
            const int j = lane + 64 * jj; int id = IDX[(size_t)t * 256 + j]; if (j >= cnt) id = 0;
            const int rel = pos - id; int bucket = rel < 0 ? 0 : rel;
            if (rel >= 16) { bucket = 16 + (int)(__logf((float)rel * 0.0625f) / 2.0794415416798357f * 16.0f); bucket = bucket > 31 ? 31 : bucket; }
            info[j] = (unsigned)id | ((unsigned)bucket << 16);
        }
        bf16x8 qf[8];
#pragma unroll
        for (int ks = 0; ks < 8; ++ks) qf[ks] = *(const bf16x8*)(QP + (size_t)t * 4096 + hd * 256 + ks * 32 + g * 8);
        f32x4 o[16];
#pragma unroll
        for (int rt = 0; rt < 16; ++rt) o[rt] = (f32x4){0.f, 0.f, 0.f, 0.f};
        float mrun = -1e30f, lrun = 0.f;
        asm volatile("s_waitcnt lgkmcnt(0)" ::: "memory");
        const int nch = (cnt + 31) >> 5;
        for (int ch = 0; ch < nch; ++ch) {
            asm volatile("s_waitcnt lgkmcnt(0)" ::: "memory");
#pragma unroll
            for (int i = 0; i < 16; ++i) {
                const int ksl = 2 * i + (lane >> 5); const unsigned idv = info[ch * 32 + ksl] & 0xffffu;
                const bf16_t* src = CK + (rb + idv) * 256 + (((lane & 31) ^ (ksl & 15)) * 8);
                __builtin_amdgcn_global_load_lds((const unsigned*)src, (LAS unsigned*)(rows + i * 1024), 16, 0, 0);
            }
            { const unsigned idv = info[ch * 32 + (lane >> 1)] & 0xffffu;
              __builtin_amdgcn_global_load_lds((const unsigned*)(RK + (rb + idv) * 16 + (lane & 1) * 8), (LAS unsigned*)rkb, 16, 0, 0); }
            asm volatile("s_waitcnt vmcnt(0)" ::: "memory");
            f32x4 s0 = (f32x4){0.f, 0.f, 0.f, 0.f}, s1 = (f32x4){0.f, 0.f, 0.f, 0.f};
#pragma unroll
            for (int ks = 0; ks < 8; ++ks) {
                const int pos16 = ((4 * ks + g) ^ hd) * 16;
                const bf16x8 a0 = *(const LAS bf16x8*)(rows + hd * 512 + pos16);
                const bf16x8 a1 = *(const LAS bf16x8*)(rows + (16 + hd) * 512 + pos16);
                s0 = __builtin_amdgcn_mfma_f32_16x16x32_bf16(a0, qf[ks], s0, 0, 0, 0);
                s1 = __builtin_amdgcn_mfma_f32_16x16x32_bf16(a1, qf[ks], s1, 0, 0, 0);
            }
            float x0[4], x1[4]; float cm = -INFINITY;
#pragma unroll
            for (int r = 0; r < 4; ++r) {
                const int sl0 = 4 * g + r, sl1 = 16 + 4 * g + r, j0 = ch * 32 + sl0, j1 = ch * 32 + sl1;
                const unsigned i0 = info[j0], i1 = info[j1];
                const float r0 = bf2f(rkb[sl0 * 16 + hd]), r1 = bf2f(rkb[sl1 * 16 + hd]);
                x0[r] = (j0 < cnt) ? s0[r] * r0 + biasL[(i0 >> 16) * 16 + hd] : -INFINITY;
                x1[r] = (j1 < cnt) ? s1[r] * r1 + biasL[(i1 >> 16) * 16 + hd] : -INFINITY;
                cm = fmaxf(cm, fmaxf(x0[r], x1[r]));
            }
            cm = fmaxf(cm, __shfl_xor(cm, 16)); cm = fmaxf(cm, __shfl_xor(cm, 32));
            const float mnew = fmaxf(mrun, cm); const float sc = __expf(mrun - mnew); mrun = mnew;
            float ls = 0.f;
#pragma unroll
            for (int r = 0; r < 4; ++r) { x0[r] = __expf(x0[r] - mnew); x1[r] = __expf(x1[r] - mnew); ls += x0[r] + x1[r]; }
            lrun = lrun * sc + ls;
#pragma unroll
            for (int rt = 0; rt < 16; ++rt) o[rt] *= sc;
            u32x4 pw; pw.x = pg8::cvt_pk_bf16(x0[0], x0[1]); pw.y = pg8::cvt_pk_bf16(x0[2], x0[3]); pw.z = pg8::cvt_pk_bf16(x1[0], x1[1]); pw.w = pg8::cvt_pk_bf16(x1[2], x1[3]);
            const bf16x8 pf = __builtin_bit_cast(bf16x8, pw);
            const int q = hd >> 2, pp = hd & 3, ksl = 4 * g + q;
            const LAS unsigned char* trb = rows + ksl * 512 + (pp & 1) * 8;
#pragma unroll
            for (int rt = 0; rt < 16; ++rt) {
                const int c16 = ((2 * rt + (pp >> 1)) ^ ksl) * 16;
                const v4i16_t t0 = __builtin_amdgcn_ds_read_tr16_b64_v4i16((LAS v4i16_t*)(trb + c16));
                const v4i16_t t1 = __builtin_amdgcn_ds_read_tr16_b64_v4i16((LAS v4i16_t*)(trb + c16 + 8192));
                bf16x8 af; af[0] = t0[0]; af[1] = t0[1]; af[2] = t0[2]; af[3] = t0[3]; af[4] = t1[0]; af[5] = t1[1]; af[6] = t1[2]; af[7] = t1[3];
                o[rt] = __builtin_amdgcn_mfma_f32_16x16x32_bf16(af, pf, o[rt], 0, 0, 0);
            }
        }
        float ltot = lrun; ltot += __shfl_xor(ltot, 16); ltot += __shfl_xor(ltot, 32);
        const float inv = 1.0f / ltot;
        bf16_t* op = QP + (size_t)t * 4096 + hd * 256 + 4 * g;
#pragma unroll
        for (int rt = 0; rt < 16; ++rt) { u32x2 w; w.x = pg8::cvt_pk_bf16(o[rt][0] * inv, o[rt][1] * inv); w.y = pg8::cvt_pk_bf16(o[rt][2] * inv, o[rt][3] * inv); *(u32x2*)(op + rt * 16) = w; }
    }
}

__global__ void __launch_bounds__(512, 2) k_fwd(P p_arg, int ph_lo, int ph_hi) {
    extern __shared__ __attribute__((aligned(16))) unsigned char smem[];
    const P& p = *(const P*)__builtin_amdgcn_kernarg_segment_ptr(); (void)p_arg;
    unsigned char* lds = smem + 16;
    unsigned char* ws = p.ws;
    XcdBarrier bar;
    const bool multi = (ph_hi - ph_lo) > 1;
    if (multi) {
        if (threadIdx.x == 0) *(uint4*)smem = make_uint4(0u, 0u, 0u, 0u);
        __syncthreads();
        bar = xcd_barrier_post((unsigned*)(ws + OFF_CTL), (volatile LAS unsigned*)smem);
    }
#define PH(i) (ph_lo <= (i) && (i) < ph_hi)
#define SEAM(i) do { if ((i) + 1 < ph_hi) xcd_barrier(bar); else __syncthreads(); } while (0)
    bf16_t *XN = (bf16_t*)(ws + OFF_XN), *QB = (bf16_t*)(ws + OFF_QB), *KB = (bf16_t*)(ws + OFF_KB), *VB = (bf16_t*)(ws + OFF_VB), *TMP = (bf16_t*)(ws + OFF_TMP), *Y = (bf16_t*)(ws + OFF_Y);
    if (PH(0)) { phase_prep(p, lds); SEAM(0); }
    if (PH(1)) { fast_gemm(lds, XN, 1024, (const bf16_t*)(ws + OFF_W0T), 1024, 3072, 1024, D1{ws}); SEAM(1); }
    if (PH(2)) { phase_conv_scan(p, lds); SEAM(2); }
    if (PH(3)) { mlstm_units<false>(p, lds); SEAM(3); }
    if (PH(4)) { GWP f{(const bf16_t*)(ws + OFF_WPT), (const bf16_t*)(ws + OFF_WUB), (bf16_t*)(ws + OFF_W0T)}; sgemm(f, 256); phase_mlstm_scan(p, lds); SEAM(4); }
    if (PH(5)) { mlstm_units<true>(p, lds); SEAM(5); }
    if (PH(6)) { fast_gemm(lds, XN, 1024, (const bf16_t*)(ws + OFF_W0T) + (size_t)3072 * 1024, 1024, 4096, 1024, D2{ws}); SEAM(6); }
    if (PH(7)) { phase_ya_pool(p); SEAM(7); }
    if (PH(8)) { fast_gemm(lds, Y, 2048, (const bf16_t*)(ws + OFF_WO0T), 2048, 1024, 2048, D4{(unsigned char*)p.out, p.x}); SEAM(8); }
    if (PH(9)) { rmsnorm_rows<4>(p.out, p.o_norm, XN, p.o_w_in, OIN, 1600, nullptr, 0.5f, (float*)(ws + OFF_WI), (float*)lds); SEAM(9); }
    if (PH(10)) { fast_gemm(lds, XN, 1024, (const bf16_t*)(ws + OFF_W1T), 1024, 2816, 1024, D5{ws}); SEAM(10); }
    if (PH(11)) { phase_qnorm_ckvnorm(p); SEAM(11); }
    if (PH(12)) { fast_gemm(lds, (const bf16_t*)(ws + OFF_CKVN), 256, (const bf16_t*)(ws + OFF_WUKP), 256, 1024, 256, DK{ws}); SEAM(12); }
    if (PH(13)) { GQP f{TMP, (const bf16_t*)(ws + OFF_WQP), (bf16_t*)(ws + OFF_QP)}; sgemm(f, 512 * 64); phase_indexer(p, lds); SEAM(13); }
    if (PH(14)) { phase_attn(p, lds); SEAM(14); }
    if (PH(15)) { GOP f{(const bf16_t*)(ws + OFF_QP), (const bf16_t*)(ws + OFF_WUVT), (const bf16_t*)(ws + OFF_Z), TMP}; sgemm(f, 512 * 16); SEAM(15); }
    if (PH(16)) { fast_gemm(lds, TMP, 1024, (const bf16_t*)(ws + OFF_WO1T), 1024, 1024, 1024, D8{(unsigned char*)p.out}); }
#undef PH
#undef SEAM
}

extern "C" void kernel_launch(void* const* d_in, const int* in_sizes, int n_in, void* d_out, int out_size, void* d_ws, size_t ws_size, hipStream_t stream) {
    static int grid = 0;
    if (grid == 0) {
        if (n_in != 18 || out_size != T * DM || ws_size < WS_END) { fprintf(stderr, "kernel_launch: unexpected shapes (n_in %d out %d ws %zu)\n", n_in, out_size, ws_size); grid = -1; return; }
        if (hipFuncSetAttribute((const void*)k_fwd, hipFuncAttributeMaxDynamicSharedMemorySize, LDS_BYTES) != hipSuccess) { fprintf(stderr, "kernel_launch: hipFuncSetAttribute failed\n"); grid = -1; return; }
        grid = 256;
    }
    if (grid < 0) return;
    (void)hipMemsetAsync((char*)d_ws + OFF_CTL, 0, 16384, stream);
    P p{};
    p.x = (const float*)d_in[0]; p.e_norm = (const float*)d_in[1]; p.e_w_in = (const float*)d_in[2]; p.e_conv = (const float*)d_in[3]; p.e_b_if = (const float*)d_in[4];
    p.e_g_head = (const float*)d_in[5]; p.e_w_pool = (const float*)d_in[6]; p.e_s_pool = (const float*)d_in[7]; p.e_w_out = (const float*)d_in[8];
    p.o_norm = (const float*)d_in[9]; p.o_w_in = (const float*)d_in[10]; p.o_g_kv = (const float*)d_in[11]; p.o_w_uk = (const float*)d_in[12]; p.o_w_uv = (const float*)d_in[13];
    p.o_g_q = (const float*)d_in[14]; p.o_g_k = (const float*)d_in[15]; p.o_w_out = (const float*)d_in[16]; p.rel_bias = (const float*)d_in[17];
    p.out = (float*)d_out; p.ws = (unsigned char*)d_ws;
    hipLaunchKernelGGL(k_fwd, dim3(grid), dim3(512), LDS_BYTES, stream, p, 0, NPH);
}
```

```cpp
#include <hip/hip_runtime.h>
#include <stdint.h>
#include <cstdio>

typedef unsigned short bf16_t;
typedef short bf16x8 __attribute__((ext_vector_type(8)));
typedef float f32x4 __attribute__((ext_vector_type(4)));
typedef unsigned u32x4 __attribute__((ext_vector_type(4)));
typedef unsigned u32x2 __attribute__((ext_vector_type(2)));
typedef short v4i16_t __attribute__((ext_vector_type(4)));
#define LAS __attribute__((address_space(3)))

constexpr int T = 32768, SEQ = 16384, DM = 1024;
constexpr int EIN = 7176, OIN = 2628;
constexpr float EPS = 1e-6f;
constexpr size_t MB = 1048576;
constexpr size_t OFF_CTL = 0;
constexpr size_t OFF_GATES = 64 * 1024;
constexpr size_t OFF_BQ = OFF_GATES + (size_t)T * 8 * 4;
constexpr size_t OFF_IQ = OFF_BQ + (size_t)T * 4 * 4;
constexpr size_t OFF_MT = OFF_IQ + (size_t)T * 4 * 4;
constexpr size_t OFF_WI = OFF_MT + (size_t)T * 4 * 4;
constexpr size_t OFF_CH = OFF_WI + (size_t)T * 4 * 4;
constexpr size_t OFF_NS = OFF_CH + 64 * 1024;
constexpr size_t OFF_W = 4 * MB;
constexpr size_t OFF_W0T = OFF_W;
constexpr size_t OFF_WPT = OFF_W0T + (size_t)7168 * 1024 * 2;
constexpr size_t OFF_WO0T = OFF_WPT + (size_t)4 * 256 * 256 * 2;
constexpr size_t OFF_W1T = OFF_WO0T + (size_t)1024 * 2048 * 2;
constexpr size_t OFF_WUKT = OFF_W1T + (size_t)2816 * 1024 * 2;
constexpr size_t OFF_WUVT = OFF_WUKT + (size_t)1024 * 256 * 2;
constexpr size_t OFF_WO1T = OFF_WUVT + (size_t)1024 * 256 * 2;
constexpr size_t OFF_WUKP = OFF_WO1T + (size_t)1024 * 1024 * 2;
constexpr size_t OFF_WQP = OFF_WUKP + (size_t)1024 * 256 * 2;
constexpr size_t OFF_WUB = OFF_WQP + (size_t)16 * 256 * 64 * 2;
constexpr size_t OFF_XN = 36 * MB, OFF_QB = 100 * MB, OFF_KB = 164 * MB, OFF_VB = 228 * MB, OFF_TMP = 292 * MB, OFF_Y = 356 * MB;
constexpr size_t OFF_QP = 36 * MB;
constexpr size_t OFF_CKVN = OFF_Y;
constexpr size_t OFF_QI = OFF_Y + 16 * MB;
constexpr size_t OFF_KI = OFF_Y + 32 * MB;
constexpr size_t OFF_IDX = OFF_Y + 40 * MB;
constexpr size_t OFF_RK = OFF_Y + 58 * MB;
constexpr size_t OFF_CNT = OFF_Y + 59 * MB;
constexpr size_t OFF_Z = OFF_Y + 60 * MB;
constexpr size_t WS_END = 484 * MB;
constexpr int LDS_BYTES = 151552;
constexpr int NPH = 17;

struct P {
    const float *x, *e_norm, *e_w_in, *e_conv, *e_b_if, *e_g_head, *e_w_pool, *e_s_pool, *e_w_out;
    const float *o_norm, *o_w_in, *o_g_kv, *o_w_uk, *o_w_uv, *o_g_q, *o_g_k, *o_w_out, *rel_bias;
    float* out; unsigned char* ws;
};

__device__ __forceinline__ bf16_t f2bf(float f) { unsigned u = __float_as_uint(f); u += 0x7FFFu + ((u >> 16) & 1u); return (bf16_t)(u >> 16); }
__device__ __forceinline__ float bf2f(bf16_t b) { return __uint_as_float(((unsigned)b) << 16); }
__device__ __forceinline__ float bflo(unsigned w) { return __uint_as_float(w << 16); }
__device__ __forceinline__ float bfhi(unsigned w) { return __uint_as_float(w & 0xffff0000u); }
__device__ __forceinline__ unsigned pk2(float a, float b) { return (unsigned)f2bf(a) | ((unsigned)f2bf(b) << 16); }
__device__ __forceinline__ float sigmoidf_(float x) { return __builtin_amdgcn_rcpf(1.0f + __expf(-x)); }
__device__ __forceinline__ float siluf_(float x) { return x * __builtin_amdgcn_rcpf(1.0f + __expf(-x)); }
__device__ __forceinline__ float wave_sum(float v) {
#pragma unroll
    for (int o = 32; o >= 1; o >>= 1) v += __shfl_xor(v, o);
    return v;
}
__device__ __forceinline__ float wave_max(float v) {
#pragma unroll
    for (int o = 32; o >= 1; o >>= 1) v = fmaxf(v, __shfl_xor(v, o));
    return v;
}

#define XB_TMO      128
#define XB_XCNT(j)  (256  + 64 * (j))
#define XB_XSUB(j)  (1280 + 64 * (j))
#define XB_XGEN(j)  (2304 + 64 * (j))
#define XB_TOP      3328
#define XB_TOPGEN   3392
#define XCD_BAR_WORDS 3456
#define XB_SPIN_CAP (1u << 22)
__device__ __forceinline__ unsigned xb_ld(unsigned* p)              { return __hip_atomic_load(p, __ATOMIC_RELAXED, __HIP_MEMORY_SCOPE_AGENT); }
__device__ __forceinline__ unsigned xb_add(unsigned* p, unsigned v) { return __hip_atomic_fetch_add(p, v, __ATOMIC_RELAXED, __HIP_MEMORY_SCOPE_AGENT); }
__device__ __forceinline__ unsigned xb_xcc_id() { return (unsigned)__builtin_amdgcn_s_getreg((3 << 11) | 20) & 0xFu; }
#define XB_SPIN(cond, bar) do { unsigned _sp = 0; while (cond) { __builtin_amdgcn_s_sleep(1); \
    if ((++_sp & 255u) == 0u) { if (xb_ld(&(bar)[XB_TMO])) break; if (_sp > XB_SPIN_CAP) { atomicAdd(&(bar)[XB_TMO], 1u); break; } } } } while (0)
struct XcdBarrier { unsigned* bar; unsigned x; volatile LAS unsigned* st; };
__device__ __forceinline__ XcdBarrier xcd_barrier_post(unsigned* bar, volatile LAS unsigned* st) {
    XcdBarrier b; b.bar = bar; b.x = xb_xcc_id(); b.st = st;
    if (threadIdx.x == 0) (void)xb_add(&bar[XB_XCNT(b.x)], 1u);
    return b;
}
__device__ __forceinline__ void xcd_barrier_complete(unsigned* bar, unsigned x, unsigned& nloc, unsigned& nx) {
    const unsigned G = gridDim.x * gridDim.y * gridDim.z;
    unsigned sum, cnt, mine, sp = 0u;
    for (;;) {
        sum = 0u; cnt = 0u; mine = 0u;
#pragma unroll
        for (unsigned j = 0; j < 16; ++j) { const unsigned c = xb_ld(&bar[XB_XCNT(j)]); sum += c; cnt += (c > 0u) ? 1u : 0u; mine = (j == x) ? c : mine; }
        if (sum == G) break;
        __builtin_amdgcn_s_sleep(1);
        if ((++sp & 255u) == 0u) { if (xb_ld(&bar[XB_TMO])) break; if (sp > XB_SPIN_CAP) { atomicAdd(&bar[XB_TMO], 1u); break; } }
    }
    nloc = mine > 0u ? mine : 1u; nx = cnt > 0u ? cnt : 1u;
}
__device__ __forceinline__ void xcd_barrier(const XcdBarrier& b) {
    asm volatile("s_waitcnt vmcnt(0)" ::: "memory");
    __syncthreads();
    if (threadIdx.x == 0) {
        unsigned* bar = b.bar;
        __builtin_amdgcn_s_waitcnt(0);
        unsigned nloc = b.st[0], nx = b.st[1];
        if (nloc == 0u) { xcd_barrier_complete(bar, b.x, nloc, nx); b.st[0] = nloc; b.st[1] = nx; }
        const unsigned old = xb_add(&bar[XB_XSUB(b.x)], 1u);
        const unsigned gen = old / nloc;
        if (old + 1u == (gen + 1u) * nloc) {
            __builtin_amdgcn_fence(__ATOMIC_RELEASE, "agent");
            asm volatile("s_waitcnt vmcnt(0)" ::: "memory");
            const unsigned og = xb_add(&bar[XB_TOP], 1u);
            const unsigned tg = og / nx;
            if (og + 1u == (tg + 1u) * nx) xb_add(&bar[XB_TOPGEN], 1u);
            else XB_SPIN(xb_ld(&bar[XB_TOPGEN]) == tg, bar);
            __builtin_amdgcn_fence(__ATOMIC_ACQUIRE, "agent");
            xb_add(&bar[XB_XGEN(b.x)], 1u);
            asm volatile("s_waitcnt vmcnt(0)" ::: "memory");
        } else {
            XB_SPIN(xb_ld(&bar[XB_XGEN(b.x)]) == gen, bar);
            __builtin_amdgcn_fence(__ATOMIC_ACQUIRE, "agent");
            asm volatile("s_waitcnt vmcnt(0)" ::: "memory");
        }
    }
    __syncthreads();
}

struct Tile { const bf16_t* A; const bf16_t* B; int lda, ldb, K; void* d0; const void* s0; int ld; };
template <class F>
__device__ __forceinline__ void sgemm(const F f, int nunits) {
    const int lane = threadIdx.x & 63, wave = threadIdx.x >> 6, fr = lane & 15, fq = lane >> 4;
    for (int u = blockIdx.x * 8 + wave; u < nunits; u += gridDim.x * 8) {
        Tile tl; f.tile(u, tl);
        f32x4 acc[4][4];
#pragma unroll
        for (int m = 0; m < 4; ++m)
#pragma unroll
            for (int n = 0; n < 4; ++n) acc[m][n] = (f32x4){0.f, 0.f, 0.f, 0.f};
        const bf16_t* ap = tl.A + (size_t)fr * tl.lda + fq * 8;
        const bf16_t* bp = tl.B + (size_t)fr * tl.ldb + fq * 8;
        const int K = tl.K, lda = tl.lda, ldb = tl.ldb;
        bf16x8 a[4], b[4];
#pragma unroll
        for (int m = 0; m < 4; ++m) a[m] = *(const bf16x8*)(ap + (size_t)(m * 16) * lda);
#pragma unroll
        for (int n = 0; n < 4; ++n) b[n] = *(const bf16x8*)(bp + (size_t)(n * 16) * ldb);
#pragma unroll 1
        for (int k0 = 0; k0 < K; k0 += 32) {
            bf16x8 an[4], bn[4]; const int kn = (k0 + 32 < K) ? k0 + 32 : k0;
#pragma unroll
            for (int m = 0; m < 4; ++m) an[m] = *(const bf16x8*)(ap + (size_t)(m * 16) * lda + kn);
#pragma unroll
            for (int n = 0; n < 4; ++n) bn[n] = *(const bf16x8*)(bp + (size_t)(n * 16) * ldb + kn);
#pragma unroll
            for (int m = 0; m < 4; ++m)
#pragma unroll
                for (int n = 0; n < 4; ++n) acc[m][n] = __builtin_amdgcn_mfma_f32_16x16x32_bf16(b[n], a[m], acc[m][n], 0, 0, 0);
#pragma unroll
            for (int m = 0; m < 4; ++m) { a[m] = an[m]; b[m] = bn[m]; }
        }
#pragma unroll
        for (int m = 0; m < 4; ++m) {
            asm volatile("" ::: "memory");
#pragma unroll
            for (int n = 0; n < 4; ++n) f.out4(tl, m * 16 + fr, n * 16 + 4 * fq, acc[m][n]);
        }
    }
}
__device__ __forceinline__ void store4_bf16(const Tile& tl, int r, int c, const f32x4 v) {
    u32x2 w; w.x = pk2(v[0], v[1]); w.y = pk2(v[2], v[3]); *(u32x2*)((bf16_t*)tl.d0 + (size_t)r * tl.ld + c) = w; }

struct GWP {
    const bf16_t* WPT; const bf16_t* WUB; bf16_t* W0T;
    __device__ __forceinline__ void tile(int u, Tile& tl) const {
        const int kt = u & 15, dt = (u >> 4) & 3, g = u >> 6; tl.A = WPT + (size_t)(g * 256 + dt * 64) * 256; tl.lda = 256; tl.B = WUB + (size_t)kt * 64 * 1024 + g * 256; tl.ldb = 1024; tl.K = 256;
        tl.d0 = W0T + (size_t)(5120 + g * 256 + dt * 64) * 1024 + kt * 64; tl.ld = 1024; }
    __device__ __forceinline__ void out4(const Tile& tl, int r, int c, const f32x4 v) const { store4_bf16(tl, r, c, v); }
};
struct GQP {
    const bf16_t* Qn; const bf16_t* W; bf16_t* QP;
    __device__ __forceinline__ void tile(int u, Tile& tl) const {
        const int nt = u & 3, head = (u >> 2) & 15, mt = u >> 6; tl.A = Qn + (size_t)mt * 64 * 1024 + head * 64; tl.lda = 1024; tl.B = W + (size_t)(head * 256 + nt * 64) * 64; tl.ldb = 64; tl.K = 64;
        tl.d0 = QP + ((size_t)mt * 64 * 16 + head) * 256 + nt * 64; tl.ld = 4096; }
    __device__ __forceinline__ void out4(const Tile& tl, int r, int c, const f32x4 v) const { store4_bf16(tl, r, c, v); }
};
struct GOP {
    const bf16_t* OP; const bf16_t* W; const bf16_t* Z; bf16_t* G;
    __device__ __forceinline__ void tile(int u, Tile& tl) const {
        const int head = u & 15, mt = u >> 4; tl.A = OP + (size_t)mt * 64 * 4096 + head * 256; tl.lda = 4096; tl.B = W + (size_t)head * 64 * 256; tl.ldb = 256; tl.K = 256;
        const size_t o = (size_t)mt * 64 * 1024 + head * 64; tl.d0 = G + o; tl.s0 = Z + o; tl.ld = 1024; }
    __device__ __forceinline__ void out4(const Tile& tl, int r, int c, const f32x4 v) const { const size_t i = (size_t)r * 1024 + c; const u32x2 z = *(const u32x2*)((const bf16_t*)tl.s0 + i);
        u32x2 w; w.x = pk2(v[0] * bflo(z.x), v[1] * bfhi(z.x)); w.y = pk2(v[2] * bflo(z.y), v[3] * bfhi(z.y)); *(u32x2*)((bf16_t*)tl.d0 + i) = w; }
};

namespace pg8 {
constexpr int BM = 256, BK = 64, HALF = 128, HTB = HALF * BK * 2, STAGE_BYTES = 8 * HTB, NXCD = 8, WGM = 8;
__device__ __forceinline__ int lds_byte(int r, int c) { const int st = (r >> 4) * 2 + (c >> 5), rr = r & 15, cc = c & 31, ob = rr * 64 + cc * 2; return st * 1024 + (ob ^ (((ob >> 9) & 1) << 5)); }
__device__ __forceinline__ void stage_rc(int b, int& R, int& C) { const int st = b / 1024, sb = b % 1024, swz = sb ^ (((sb >> 9) & 1) << 5); R = (st >> 1) * 16 + swz / 64; C = (st & 1) * 32 + (swz % 64) / 2; }
__device__ __forceinline__ int perm32(int rho) { const int n = rho >> 4, i = rho & 15; return 8 * (i >> 2) + 4 * n + (i & 3); }
struct Unit { int pm, pn; };
struct Gemm { const bf16_t* A; int lda; const bf16_t* Bt; int ldb; int M, N, K; };
struct StaticOrder {
    int nM, nN, nwg, G, c;
    __device__ void init(int M, int N, int G_, int c_) { nM = M / BM; nN = N / BM; nwg = nM * nN; G = G_; c = c_; }
    __device__ bool next(int i, Unit& u) const {
        const long L = (long)i * G + c; if (L >= nwg) return false;
        int wgid = (int)L; { const int q = nwg / NXCD, r = nwg % NXCD, xcd = wgid % NXCD, off = wgid / NXCD; wgid = (xcd < r ? xcd * (q + 1) : r * (q + 1) + (xcd - r) * q) + off; }
        const int nig = WGM * nN, gid = wgid / nig, fm = gid * WGM, gsz = (nM - fm) < WGM ? (nM - fm) : WGM;
        u.pm = fm + ((wgid % nig) % gsz); u.pn = (wgid % nig) / gsz; return true;
    }
};
__device__ __forceinline__ unsigned cvt_pk_bf16(float lo, float hi) { unsigned r; asm volatile("v_cvt_pk_bf16_f32 %0, %1, %2" : "=v"(r) : "v"(lo), "v"(hi)); return r; }

struct Dst { unsigned char* base; const float* res; int ld, mode, ncol; float scale; };
template <class DescF> struct EpiGen {
    static constexpr bool PERM = true;
    DescF D;
    __device__ __forceinline__ void operator()(const f32x4 (&acc)[2][2][4][2], const Unit& u, int wr, int wc, int fr, int fq) const {
        Dst d; D.get(u, d);
        if ((DescF::MODES & 16) && d.mode == 4) return;
        const int r0 = wr * 64 + fr, c0 = wc * 32 + 8 * fq;
        if constexpr ((DescF::MODES & 64) != 0) {
#pragma unroll
            for (int ai = 0; ai < 2; ++ai)
#pragma unroll
                for (int m = 0; m < 4; ++m) {
                    float ss = 0.f;
#pragma unroll
                    for (int bj = 0; bj < 2; ++bj)
#pragma unroll
                        for (int n = 0; n < 2; ++n) { const f32x4 v = acc[ai][bj][m][n]; ss += v[0] * v[0] + v[1] * v[1] + v[2] * v[2] + v[3] * v[3]; }
                    ss += __shfl_xor(ss, 16); ss += __shfl_xor(ss, 32);
                    if (fq == 0) ((bf16_t*)d.base)[(size_t)(ai * HALF + r0 + m * 16) * d.ld + wc] = f2bf(rsqrtf(ss * (1.0f / 64.0f) + EPS));
                }
            return;
        } else {
#pragma unroll
        for (int ai = 0; ai < 2; ++ai)
#pragma unroll
            for (int m = 0; m < 4; ++m) {
                const size_t rowoff = (size_t)(ai * HALF + r0 + m * 16) * d.ld;
#pragma unroll
                for (int bj = 0; bj < 2; ++bj) {
                    const int col = bj * HALF + c0; f32x4 v0 = acc[ai][bj][m][0], v1 = acc[ai][bj][m][1];
                    if ((DescF::MODES & 7) && d.mode <= 2) {
                        if ((DescF::MODES & 2) && d.mode == 1) {
#pragma unroll
                            for (int j = 0; j < 4; ++j) { v0[j] = sigmoidf_(v0[j]); v1[j] = sigmoidf_(v1[j]); } }
                        if ((DescF::MODES & 4) && d.mode == 2) {
#pragma unroll
                            for (int j = 0; j < 4; ++j) { v0[j] = siluf_(v0[j]); v1[j] = siluf_(v1[j]); } }
                        u32x4 w; w.x = cvt_pk_bf16(v0[0], v0[1]); w.y = cvt_pk_bf16(v0[2], v0[3]); w.z = cvt_pk_bf16(v1[0], v1[1]); w.w = cvt_pk_bf16(v1[2], v1[3]);
                        *(u32x4*)((bf16_t*)d.base + rowoff + col) = w;
                    } else if ((DescF::MODES & 8) && d.mode == 3) {
                        if (col < d.ncol) { float* o = (float*)d.base + rowoff + col; *(f32x4*)o = v0 * d.scale; *(f32x4*)(o + 4) = v1 * d.scale; }
                    } else if ((DescF::MODES & 128) && d.mode == 7) {
                        typedef _Float16 h8 __attribute__((ext_vector_type(8)));
                        if (col < d.ncol) {
                        h8 hv; hv[0] = (_Float16)(v0[0] * d.scale); hv[1] = (_Float16)(v0[1] * d.scale); hv[2] = (_Float16)(v0[2] * d.scale); hv[3] = (_Float16)(v0[3] * d.scale);
                        hv[4] = (_Float16)(v1[0] * d.scale); hv[5] = (_Float16)(v1[1] * d.scale); hv[6] = (_Float16)(v1[2] * d.scale); hv[7] = (_Float16)(v1[3] * d.scale);
                        *(h8*)((_Float16*)d.base + rowoff + col) = hv; }
                    } else if constexpr ((DescF::MODES & 32) != 0) {
                        float* o = (float*)d.base + rowoff + col; const float* rs = d.res + rowoff + col;
                        const f32x4 a = *(const f32x4*)rs, b = *(const f32x4*)(rs + 4); *(f32x4*)o = a + v0; *(f32x4*)(o + 4) = b + v1;
                    }
                }
                if (m & 1) asm volatile("" ::: "memory");
            }
        }
    }
};

template <class Epi>
__device__ __forceinline__ void gemm_phase(LAS unsigned char* lds, const Gemm g, const StaticOrder& S, const Epi& E) {
    const int tid = threadIdx.x, wid = __builtin_amdgcn_readfirstlane(tid >> 6), lane = tid & 63, wr = wid >> 2, wc = wid & 3, fr = lane & 15, fq = lane >> 4;
    const int K = g.K, nt = K / BK;
    unsigned voffA[2], voffB[2];
#pragma unroll
    for (int i = 0; i < 2; ++i) { int R, C; stage_rc(tid * 16 + i * 8192, R, C); const int Rb = Epi::PERM ? ((R & ~31) + perm32(R & 31)) : R;
        voffA[i] = (unsigned)(R * g.lda + C) * 2u; voffB[i] = (unsigned)(Rb * g.ldb + C) * 2u; }
    const size_t kstep = (size_t)(BK * 2);
    const size_t hstepA = (size_t)HALF * g.lda * 2, hstepB = (size_t)HALF * g.ldb * 2;
    const size_t tstepA = 2 * hstepA, tstepB = 2 * hstepB;
    const unsigned ldsw = (unsigned)wid * 1024u;
    const int aoff = lds_byte(wr * 64 + fr, fq * 8), boff = lds_byte(wc * 32 + fr, fq * 8);
#define PG8_SA(b, h) (((b) * 2 + (h)) * HTB)
#define PG8_SB(b, h) ((4 + (b) * 2 + (h)) * HTB)
#define PG8_STAGE(bufoff, gbase, voff) do { _Pragma("unroll") for (int _i = 0; _i < 2; ++_i) \
        __builtin_amdgcn_global_load_lds((const unsigned*)((const char*)(gbase) + (voff)[_i]), (LAS unsigned*)(lds + (bufoff) + ldsw + _i * 8192), 16, 0, 0); } while (0)
#define PG8_LDA(dst, b, h) do { _Pragma("unroll") for (int m = 0; m < 4; ++m) _Pragma("unroll") for (int k = 0; k < 2; ++k) dst[m][k] = *(const LAS bf16x8*)(lds + PG8_SA(b, h) + aoff + m * 2048 + k * 1024); } while (0)
#define PG8_LDB(dst, b, h) do { _Pragma("unroll") for (int n = 0; n < 2; ++n) _Pragma("unroll") for (int k = 0; k < 2; ++k) dst[n][k] = *(const LAS bf16x8*)(lds + PG8_SB(b, h) + boff + n * 2048 + k * 1024); } while (0)
#define PG8_MMA(ai, bj, At, Bt) do { __builtin_amdgcn_s_setprio(1); _Pragma("unroll") for (int m = 0; m < 4; ++m) _Pragma("unroll") for (int n = 0; n < 2; ++n) _Pragma("unroll") for (int k = 0; k < 2; ++k) \
        acc[ai][bj][m][n] = __builtin_amdgcn_mfma_f32_16x16x32_bf16(Bt[n][k], At[m][k], acc[ai][bj][m][n], 0, 0, 0); __builtin_amdgcn_s_setprio(0); } while (0)
#define PG8_WAIT_V(n) asm volatile("s_waitcnt vmcnt(" #n ")" ::: "memory")
#define PG8_WAIT_L(n) asm volatile("s_waitcnt lgkmcnt(" #n ")" ::: "memory")
#define PG8_BAR __builtin_amdgcn_s_barrier()
#define PG8_SCHED __builtin_amdgcn_sched_barrier(0)
    Unit cur, nxt; int ui = 0;
    if (!S.next(0, cur)) return;
    f32x4 acc[2][2][4][2];
#pragma unroll
    for (int a = 0; a < 2; ++a)
#pragma unroll
        for (int b = 0; b < 2; ++b)
#pragma unroll
            for (int m = 0; m < 4; ++m)
#pragma unroll
                for (int n = 0; n < 2; ++n) acc[a][b][m][n] = (f32x4){0.f, 0.f, 0.f, 0.f};
    bf16x8 At[4][2], B0[2][2], B1[2][2];
    const char* cA = (const char*)g.A + (size_t)cur.pm * tstepA; const char* cB = (const char*)g.Bt + (size_t)cur.pn * tstepB;
    PG8_STAGE(PG8_SB(0, 0), cB, voffB); PG8_STAGE(PG8_SA(0, 0), cA, voffA); PG8_STAGE(PG8_SB(0, 1), cB + hstepB, voffB); PG8_STAGE(PG8_SA(0, 1), cA + hstepA, voffA);
    if (wr == 1) PG8_BAR;
    PG8_WAIT_V(4); PG8_BAR;
    PG8_STAGE(PG8_SB(1, 0), cB + kstep, voffB); PG8_STAGE(PG8_SA(1, 0), cA + kstep, voffA); PG8_STAGE(PG8_SB(1, 1), cB + hstepB + kstep, voffB);
    PG8_WAIT_V(6); PG8_BAR;
    for (;;) {
        const bool has_next = S.next(ui + 1, nxt);
        const char* nA = has_next ? (const char*)g.A + (size_t)nxt.pm * tstepA : cA; const char* nB = has_next ? (const char*)g.Bt + (size_t)nxt.pn * tstepB : cB;
#pragma unroll 1
        for (int t = 0; t < nt; t += 2) {
            const bool last = (t == nt - 2);
            const char* a1 = cA + (size_t)(t + 1) * kstep;
            const char* a2 = last ? nA : cA + (size_t)(t + 2) * kstep; const char* b2 = last ? nB : cB + (size_t)(t + 2) * kstep;
            const char* a3 = a2 + kstep; const char* b3 = b2 + kstep;
            PG8_LDB(B0, 0, 0); PG8_SCHED; PG8_LDA(At, 0, 0); PG8_STAGE(PG8_SA(1, 1), a1 + hstepA, voffA);
            PG8_WAIT_L(8); PG8_BAR; PG8_WAIT_L(0); PG8_MMA(0, 0, At, B0); PG8_BAR; PG8_SCHED;
            PG8_LDB(B1, 0, 1); PG8_STAGE(PG8_SB(0, 0), b2, voffB);
            PG8_BAR; PG8_WAIT_L(0); PG8_MMA(0, 1, At, B1); PG8_BAR;
            PG8_LDA(At, 0, 1); PG8_STAGE(PG8_SA(0, 0), a2, voffA);
            PG8_BAR; PG8_WAIT_L(0); PG8_MMA(1, 0, At, B0); PG8_BAR; PG8_SCHED;
            PG8_STAGE(PG8_SB(0, 1), b2 + hstepB, voffB);
            PG8_WAIT_V(6); PG8_BAR; PG8_MMA(1, 1, At, B1); PG8_BAR;
            PG8_LDB(B0, 1, 0); PG8_SCHED; PG8_LDA(At, 1, 0); PG8_STAGE(PG8_SA(0, 1), a2 + hstepA, voffA);
            PG8_WAIT_L(8); PG8_BAR; PG8_WAIT_L(0); PG8_MMA(0, 0, At, B0); PG8_BAR; PG8_SCHED;
            PG8_LDB(B1, 1, 1); PG8_STAGE(PG8_SB(1, 0), b3, voffB);
            PG8_BAR; PG8_WAIT_L(0); PG8_MMA(0, 1, At, B1); PG8_BAR;
            PG8_LDA(At, 1, 1); PG8_STAGE(PG8_SA(1, 0), a3, voffA);
            PG8_BAR; PG8_WAIT_L(0); PG8_MMA(1, 0, At, B0); PG8_BAR; PG8_SCHED;
            PG8_STAGE(PG8_SB(1, 1), b3 + hstepB, voffB);
            PG8_WAIT_V(6); PG8_BAR; PG8_MMA(1, 1, At, B1); PG8_BAR;
        }
        E(acc, cur, wr, wc, fr, fq);
        if (!has_next) break;
#pragma unroll
        for (int a = 0; a < 2; ++a)
#pragma unroll
            for (int b = 0; b < 2; ++b)
#pragma unroll
                for (int m = 0; m < 4; ++m)
#pragma unroll
                    for (int n = 0; n < 2; ++n) acc[a][b][m][n] = (f32x4){0.f, 0.f, 0.f, 0.f};
        cur = nxt; cA = nA; cB = nB; ++ui;
    }
    PG8_WAIT_V(0);
    if (wr == 0) PG8_BAR;
    PG8_BAR;
#undef PG8_SA
#undef PG8_SB
#undef PG8_STAGE
#undef PG8_LDA
#undef PG8_LDB
#undef PG8_MMA
#undef PG8_WAIT_V
#undef PG8_WAIT_L
#undef PG8_BAR
#undef PG8_SCHED
}
}

struct D1 { static constexpr int MODES = 1; unsigned char* ws;
    __device__ __forceinline__ void get(const pg8::Unit& u, pg8::Dst& d) const { const int sec = u.pn >> 2;
        d.base = ws + OFF_QB + (size_t)sec * (64 * MB) + ((size_t)u.pm * 256 * 1024 + (u.pn & 3) * 256) * 2; d.res = nullptr; d.ld = 1024; d.mode = 0; d.ncol = 256; d.scale = 1.f; } };
struct D2 { static constexpr int MODES = 7; unsigned char* ws;
    __device__ __forceinline__ void get(const pg8::Unit& u, pg8::Dst& d) const { const int sec = u.pn >> 2, cc = (u.pn & 3) * 256; d.res = nullptr; d.ncol = 256; d.scale = 1.f;
        if (sec < 3) { d.base = ws + OFF_QB + (size_t)sec * (64 * MB) + ((size_t)u.pm * 256 * 1024 + cc) * 2; d.ld = 1024; d.mode = sec == 0 ? 1 : (sec == 1 ? 2 : 0); }
        else { d.base = ws + OFF_Y + ((size_t)u.pm * 256 * 2048 + 1024 + cc) * 2; d.ld = 2048; d.mode = 2; } } };
struct D4 { static constexpr int MODES = 32; unsigned char* out; const float* x;
    __device__ __forceinline__ void get(const pg8::Unit& u, pg8::Dst& d) const { const size_t o = (size_t)u.pm * 256 * 1024 + u.pn * 256;
        d.base = out + o * 4; d.res = x + o; d.ld = 1024; d.mode = 5; d.ncol = 256; d.scale = 1.f; } };
struct D5 { static constexpr int MODES = 133; unsigned char* ws;
    __device__ __forceinline__ void get(const pg8::Unit& u, pg8::Dst& d) const { const int pn = u.pn; d.res = nullptr; d.ncol = 256; d.scale = 1.f;
        if (pn < 4) { d.base = ws + OFF_TMP + ((size_t)u.pm * 256 * 1024 + pn * 256) * 2; d.ld = 1024; d.mode = 0; }
        else if (pn == 4) { d.base = ws + OFF_CKVN + (size_t)u.pm * 256 * 256 * 2; d.ld = 256; d.mode = 0; }
        else if (pn == 5) { d.base = ws + OFF_QI + (size_t)u.pm * 256 * 256 * 2; d.ld = 256; d.mode = 7; d.scale = 0.125f; }
        else if (pn == 6) { d.base = ws + OFF_KI + (size_t)u.pm * 256 * 64 * 2; d.ld = 64; d.mode = 7; d.ncol = 64; }
        else { d.base = ws + OFF_Z + ((size_t)u.pm * 256 * 1024 + (pn - 7) * 256) * 2; d.ld = 1024; d.mode = 2; } } };
struct DK { static constexpr int MODES = 64; unsigned char* ws;
    __device__ __forceinline__ void get(const pg8::Unit& u, pg8::Dst& d) const {
        d.base = ws + OFF_RK + ((size_t)u.pm * 256 * 16 + u.pn * 4) * 2; d.res = nullptr; d.ld = 16; d.mode = 6; d.ncol = 256; d.scale = 1.f; } };
struct D8 { static constexpr int MODES = 32; unsigned char* out;
    __device__ __forceinline__ void get(const pg8::Unit& u, pg8::Dst& d) const { const size_t o = (size_t)u.pm * 256 * 1024 + u.pn * 256;
        d.base = out + o * 4; d.res = (const float*)out + o; d.ld = 1024; d.mode = 5; d.ncol = 256; d.scale = 1.f; } };
template <class DF>
__device__ __forceinline__ void fast_gemm(unsigned char* lds, const bf16_t* A, int lda, const bf16_t* Bt, int ldb, int N, int K, const DF& df) {
    pg8::Gemm g{A, lda, Bt, ldb, T, N, K}; pg8::StaticOrder S; S.init(T, N, (int)gridDim.x, (int)blockIdx.x);
    pg8::EpiGen<DF> E{df};
    pg8::gemm_phase(( LAS unsigned char*)lds, g, S, E);
}

__device__ __forceinline__ void tconv(const float* __restrict__ src, int ld, int col0, int ncols, int K, bf16_t* __restrict__ dst, float* tile  ) {
    const int nkt = K / 64, ntiles = nkt * (ncols / 64), tid = threadIdx.x;
    for (int id = blockIdx.x; id < ntiles; id += gridDim.x) {
        const int kt = id % nkt, nt = id / nkt;
#pragma unroll
        for (int j = 0; j < 8; ++j) { const int e = tid + 512 * j, kk = e >> 6, nn = e & 63; tile[kk * 65 + nn] = src[(size_t)(kt * 64 + kk) * ld + col0 + nt * 64 + nn]; }
        __syncthreads();
#pragma unroll
        for (int j = 0; j < 8; ++j) { const int e = tid + 512 * j, nn = e >> 6, kk = e & 63; dst[(size_t)(nt * 64 + nn) * K + kt * 64 + kk] = f2bf(tile[kk * 65 + nn]); }
        __syncthreads();
    }
}
template <int NE>
__device__ __forceinline__ void rmsnorm_rows(const float* __restrict__ src, const float* __restrict__ g, bf16_t* __restrict__ dst,
                             const float* __restrict__ Wx, int ldw, int col0, const float* __restrict__ bias, float scale, float* __restrict__ dstx, float* wl) {
    const int lane = threadIdx.x & 63, wave = threadIdx.x >> 6;
    __syncthreads();
    for (int i = threadIdx.x; i < NE * 1024; i += 512) { const int k = i / NE, e = i % NE; wl[e * 1024 + k] = Wx[(size_t)k * ldw + col0 + e]; }
    __syncthreads();
    for (int row0 = (blockIdx.x * 8 + wave) * 2; row0 < T; row0 += gridDim.x * 16) {
        f32x4 v[2][4];
#pragma unroll
        for (int r = 0; r < 2; ++r)
#pragma unroll
            for (int i = 0; i < 4; ++i) v[r][i] = *(const f32x4*)(src + (size_t)(row0 + r) * 1024 + i * 256 + lane * 4);
#pragma unroll
        for (int r = 0; r < 2; ++r) {
            const int row = row0 + r; float ss = 0.f;
#pragma unroll
            for (int i = 0; i < 4; ++i) ss += v[r][i][0] * v[r][i][0] + v[r][i][1] * v[r][i][1] + v[r][i][2] * v[r][i][2] + v[r][i][3] * v[r][i][3];
            ss = wave_sum(ss);
            const float rstd = rsqrtf(ss * (1.0f / 1024.0f) + EPS);
            float ex[NE];
#pragma unroll
            for (int e = 0; e < NE; ++e) ex[e] = 0.f;
#pragma unroll
            for (int i = 0; i < 4; ++i) {
                const f32x4 gg = *(const f32x4*)(g + i * 256 + lane * 4);
                f32x4 y; y[0] = v[r][i][0] * rstd * gg[0]; y[1] = v[r][i][1] * rstd * gg[1]; y[2] = v[r][i][2] * rstd * gg[2]; y[3] = v[r][i][3] * rstd * gg[3];
                u32x2 w; w.x = pk2(y[0], y[1]); w.y = pk2(y[2], y[3]);
                *(u32x2*)(dst + (size_t)row * 1024 + i * 256 + lane * 4) = w;
#pragma unroll
                for (int e = 0; e < NE; ++e) { const f32x4 wv = *(const f32x4*)(wl + e * 1024 + i * 256 + lane * 4); ex[e] += y[0] * wv[0] + y[1] * wv[1] + y[2] * wv[2] + y[3] * wv[3]; }
            }
#pragma unroll
            for (int e = 0; e < NE; ++e) { const float sx = wave_sum(ex[e]); if (lane == 0) dstx[(size_t)row * NE + e] = (sx + (bias ? bias[e] : 0.f)) * scale; }
        }
    }
}

__device__ __forceinline__ void phase_prep(const P& p, unsigned char* lds) {
    float* tile = (float*)lds; unsigned char* ws = p.ws;
    bf16_t* W0T = (bf16_t*)(ws + OFF_W0T);
    tconv(p.e_w_in, EIN, 0, 5120, 1024, W0T, tile);
    tconv(p.e_w_in, EIN, 6152, 1024, 1024, W0T + (size_t)6144 * 1024, tile);
    for (int g = 0; g < 4; ++g) tconv(p.e_w_pool + (size_t)g * 65536, 256, 0, 256, 256, (bf16_t*)(ws + OFF_WPT) + (size_t)g * 65536, tile);
    { bf16_t* WUB = (bf16_t*)(ws + OFF_WUB);
      for (size_t i = (size_t)blockIdx.x * 512 + threadIdx.x; i < (size_t)1024 * 256; i += (size_t)gridDim.x * 512) {
          const size_t k = i >> 8; const int c4 = (int)(i & 255) * 4; const f32x4 v = *(const f32x4*)(p.e_w_in + k * EIN + 5128 + c4);
          u32x2 o; o.x = pk2(v[0], v[1]); o.y = pk2(v[2], v[3]); *(u32x2*)(WUB + k * 1024 + c4) = o; } }
    tconv(p.e_w_out, 1024, 0, 1024, 2048, (bf16_t*)(ws + OFF_WO0T), tile);
    bf16_t* W1T = (bf16_t*)(ws + OFF_W1T);
    tconv(p.o_w_in, OIN, 0, 1600, 1024, W1T, tile);
    for (size_t i = (size_t)blockIdx.x * 512 + threadIdx.x; i < (size_t)192 * 1024; i += (size_t)gridDim.x * 512) W1T[(size_t)1600 * 1024 + i] = 0;
    tconv(p.o_w_in, OIN, 1604, 1024, 1024, W1T + (size_t)1792 * 1024, tile);
    {
        bf16_t* WUKP = (bf16_t*)(ws + OFF_WUKP); bf16_t* WQP = (bf16_t*)(ws + OFF_WQP);
        for (size_t i = (size_t)blockIdx.x * 512 + threadIdx.x; i < (size_t)1024 * 256; i += (size_t)gridDim.x * 512) {
            { const int n = (int)(i >> 8), k = (int)(i & 255), pn = n >> 8, rem = n & 255, bj = rem >> 7, wc = (rem >> 5) & 3, x = rem & 31;
              WUKP[i] = f2bf(p.o_w_uk[(size_t)k * 1024 + (4 * pn + wc) * 64 + 32 * bj + x]); }
            { const int d = (int)(i & 63), r = (int)((i >> 6) & 255), h = (int)(i >> 14);
              WQP[i] = f2bf(p.o_w_uk[(size_t)r * 1024 + h * 64 + d] * p.o_g_k[d] * 0.125f); }
        }
    }
    tconv(p.o_w_uv, 1024, 0, 1024, 256, (bf16_t*)(ws + OFF_WUVT), tile);
    tconv(p.o_w_out, 1024, 0, 1024, 1024, (bf16_t*)(ws + OFF_WO1T), tile);
    rmsnorm_rows<8>(p.x, p.e_norm, (bf16_t*)(ws + OFF_XN), p.e_w_in, EIN, 5120, p.e_b_if, 1.0f, (float*)(ws + OFF_GATES), (float*)lds);
}

__device__ __forceinline__ void phase_conv_scan(const P& p, unsigned char* lds) {
    unsigned char* ws = p.ws; const int tid = threadIdx.x;
    const float* GATES = (const float*)(ws + OFF_GATES);
    float *BQ = (float*)(ws + OFF_BQ), *IQ = (float*)(ws + OFF_IQ), *MT = (float*)(ws + OFF_MT), *CH = (float*)(ws + OFF_CH);
    {
        const int lane = tid & 63, wave = tid >> 6;
        for (int task = blockIdx.x * 8 + wave; task < 2048; task += gridDim.x * 8) {
            const int bh = task >> 8, c = task & 255, batch = bh >> 2, head = bh & 3; const size_t t = (size_t)batch * SEQ + c * 64 + lane;
            const float ig = GATES[t * 8 + head], f = GATES[t * 8 + 4 + head];
            float b = fminf(f, 0.f) - log1pf(__expf(-fabsf(f)));
#pragma unroll
            for (int o = 1; o < 64; o <<= 1) { const float y = __shfl_up(b, o); if (lane >= o) b += y; }
            float rm = ig - b;
#pragma unroll
            for (int o = 1; o < 64; o <<= 1) { const float y = __shfl_up(rm, o); if (lane >= o) rm = fmaxf(rm, y); }
            BQ[t * 4 + head] = b; IQ[t * 4 + head] = ig; MT[t * 4 + head] = rm;
            if (lane == 63) { CH[4096 + bh * 256 + c] = b; CH[bh * 256 + c] = b + rm; }
        }
    }
    const bf16_t* QB = (const bf16_t*)(ws + OFF_QB); const bf16_t* KB = (const bf16_t*)(ws + OFF_KB);
    bf16_t* Y = (bf16_t*)(ws + OFF_Y); bf16_t* KT = (bf16_t*)(ws + OFF_TMP);
    for (size_t it = (size_t)blockIdx.x * 512 + tid; it < (size_t)(T / 8) * 256; it += (size_t)gridDim.x * 512) {
        const size_t t0 = (it >> 8) * 8; const int c0 = (int)(it & 255) * 8, isk = c0 >= 1024, cc = c0 & 1023; const int s0 = (int)(t0 & (SEQ - 1));
        const bf16_t* src = isk ? KB : QB;
        u32x4 rw[11];
#pragma unroll
        for (int j = 0; j < 11; ++j) rw[j] = (s0 - 3 + j >= 0) ? *(const u32x4*)(src + (t0 - 3 + j) * 1024 + cc) : (u32x4){0u, 0u, 0u, 0u};
        f32x4 cw[4][2];
#pragma unroll
        for (int j = 0; j < 4; ++j) { cw[j][0] = *(const f32x4*)(p.e_conv + j * 2048 + c0); cw[j][1] = *(const f32x4*)(p.e_conv + j * 2048 + c0 + 4); }
        const float sc = isk ? 0.0625f : 1.0f;
#pragma unroll
        for (int k = 0; k < 8; ++k) {
            float acc[8];
#pragma unroll
            for (int i = 0; i < 8; ++i) acc[i] = 0.f;
#pragma unroll
            for (int j = 0; j < 4; ++j) { const u32x4 w = rw[k + j];
                acc[0] += cw[j][0][0] * bflo(w.x); acc[1] += cw[j][0][1] * bfhi(w.x); acc[2] += cw[j][0][2] * bflo(w.y); acc[3] += cw[j][0][3] * bfhi(w.y);
                acc[4] += cw[j][1][0] * bflo(w.z); acc[5] += cw[j][1][1] * bfhi(w.z); acc[6] += cw[j][1][2] * bflo(w.w); acc[7] += cw[j][1][3] * bfhi(w.w); }
            u32x4 o; o.x = pk2(siluf_(acc[0]) * sc, siluf_(acc[1]) * sc); o.y = pk2(siluf_(acc[2]) * sc, siluf_(acc[3]) * sc);
            o.z = pk2(siluf_(acc[4]) * sc, siluf_(acc[5]) * sc); o.w = pk2(siluf_(acc[6]) * sc, siluf_(acc[7]) * sc);
            if (isk) *(u32x4*)(KT + (t0 + k) * 1024 + cc) = o; else *(u32x4*)(Y + (t0 + k) * 2048 + 1024 + cc) = o;
        }
    }
}

typedef float f32x16 __attribute__((ext_vector_type(16)));
constexpr int ML_RS = 528, ML_WS = 144;
__device__ __forceinline__ bf16x8 ml_tr8(const LAS unsigned char* a, int second_off) {
    const v4i16_t t0 = __builtin_amdgcn_ds_read_tr16_b64_v4i16((LAS v4i16_t*)a);
    const v4i16_t t1 = __builtin_amdgcn_ds_read_tr16_b64_v4i16((LAS v4i16_t*)(a + second_off));
    bf16x8 r; r[0] = t0[0]; r[1] = t0[1]; r[2] = t0[2]; r[3] = t0[3]; r[4] = t1[0]; r[5] = t1[1]; r[6] = t1[2]; r[7] = t1[3]; return r;
}
struct ChunkScan { f32x4 B, mp, mn; };
__device__ __forceinline__ ChunkScan chunk_scan_wave(const float* CH, int bh, int lane) {
    ChunkScan r; r.B = *(const f32x4*)(CH + 4096 + bh * 256 + 4 * lane); const f32x4 G = *(const f32x4*)(CH + bh * 256 + 4 * lane);
    float a = r.B[0], b = G[0];
#pragma unroll
    for (int j = 1; j < 4; ++j) { b = fmaxf(r.B[j] + b, G[j]); a += r.B[j]; }
#pragma unroll
    for (int o = 1; o < 64; o <<= 1) { const float a1 = __shfl_up(a, o), b1 = __shfl_up(b, o); if (lane >= o) { b = fmaxf(a + b1, b); a += a1; } }
    const float ap = __shfl_up(a, 1), bp = __shfl_up(b, 1);
    float m = lane ? fmaxf(ap, bp) : 0.f;
#pragma unroll
    for (int j = 0; j < 4; ++j) { r.mp[j] = m; m = fmaxf(r.B[j] + m, G[j]); r.mn[j] = m; }
    return r;
}
__device__ __forceinline__ void mlstm_chunk_scan(const float* CH, int bh, LAS float* sB, LAS float* sMp, LAS float* sMn) {
    const int tid = threadIdx.x;
    if (tid < 64) { const ChunkScan r = chunk_scan_wave(CH, bh, tid); *(LAS f32x4*)(sB + 4 * tid) = r.B; *(LAS f32x4*)(sMp + 4 * tid) = r.mp; *(LAS f32x4*)(sMn + 4 * tid) = r.mn; }
    __syncthreads();
}
template <bool FULL>
__device__ __forceinline__ void mlstm_units(const P& p, unsigned char* lds_) {
    unsigned char* ws = p.ws; const int tid0 = threadIdx.x;
    const int w = __builtin_amdgcn_readfirstlane(tid0 >> 6);
    const bf16_t* Yq = (const bf16_t*)(ws + OFF_Y); bf16_t* Yo = (bf16_t*)(ws + OFF_Y);
    const bf16_t* KT = (const bf16_t*)(ws + OFF_TMP); const bf16_t* VB = (const bf16_t*)(ws + OFF_VB);
    float* ST = (float*)(ws + OFF_QB); float* NS = (float*)(ws + OFF_NS);
    const float *BQ = (const float*)(ws + OFF_BQ), *IQ = (const float*)(ws + OFF_IQ), *MT = (const float*)(ws + OFF_MT), *CH = (const float*)(ws + OFF_CH);
    LAS unsigned char* Qs = (LAS unsigned char*)lds_;
    LAS unsigned char* Ks = Qs + 64 * ML_RS;
    LAS unsigned char* Vs = Ks + 64 * ML_RS;
    LAS unsigned char* Wl = Vs + 64 * ML_RS;
    LAS float* sa = (LAS float*)(Wl + 64 * ML_WS);
    LAS float* sden = sa + 64; LAS float* ssw = sden + 64; LAS float* sf = ssw + 64; LAS float* sg = sf + 64; LAS float* nd = sg + 64; LAS float* rden = nd + 64; LAS float* ns = rden + 64;
    LAS float* cB = ns + 256; LAS float* cMp = cB + 256; LAS float* cMn = cMp + 256;
    for (int unit = blockIdx.x; unit < 256; unit += gridDim.x) {
        const int bh = unit >> 5, S = unit & 31, batch = bh >> 2, head = bh & 3;
        const int tid = tid0, lane = tid0 & 63, hh = lane >> 5;
        __syncthreads();
        mlstm_chunk_scan(CH, bh, cB, cMp, cMn);
        f32x16 st[8]; float nreg = 0.f;
        if (FULL) {
#pragma unroll
            for (int kt = 0; kt < 8; ++kt) {
                int lz = lane; asm volatile("" : "+v"(lz) :: "memory");
                const float* sp = ST + (size_t)unit * 65536 + 32 * w + (lz & 31) + (size_t)(32 * kt + 4 * (lz >> 5)) * 256;
#pragma unroll
                for (int r = 0; r < 16; ++r) st[kt][r] = sp[((r & 3) + 8 * (r >> 2)) * 256];
            }
            if (tid < 256) nreg = NS[unit * 256 + tid];
        } else {
#pragma unroll
            for (int kt = 0; kt < 8; ++kt)
#pragma unroll
                for (int r = 0; r < 16; ++r) st[kt][r] = 0.f;
        }
#pragma unroll 1
        for (int cc = 0; cc < 8; ++cc) {
            int tid = tid0; asm volatile("" : "+v"(tid));
            const int lane = tid & 63, l31 = lane & 31, hh = lane >> 5, fr = lane & 15, fq = lane >> 4;
            const int trow = 8 * hh + (fr >> 2), tcol = (16 * (fq & 1) + 4 * (fr & 3)) * 2;
            const int ch = S * 8 + cc; const size_t t0 = (size_t)batch * SEQ + ch * 64;
            const float mprev = cMp[ch], mnew = cMn[ch], blast = cB[ch];
            const float decay = __expf(blast + mprev - mnew);
            __syncthreads();
#pragma unroll
            for (int j = 0; j < 4; ++j) { const int e = tid + 512 * j, r = e >> 5, cg = e & 31;
                *(LAS u32x4*)(Ks + r * ML_RS + cg * 16) = *(const u32x4*)(KT + (t0 + r) * 1024 + head * 256 + cg * 8);
                *(LAS u32x4*)(Vs + r * ML_RS + cg * 16) = *(const u32x4*)(VB + (t0 + r) * 1024 + head * 256 + cg * 8);
                if (FULL) *(LAS u32x4*)(Qs + r * ML_RS + cg * 16) = *(const u32x4*)(Yq + (t0 + r) * 2048 + 1024 + head * 256 + cg * 8); }
            if (tid < 64) { const float bq = BQ[(t0 + tid) * 4 + head], iq = IQ[(t0 + tid) * 4 + head], mt = bq + fmaxf(mprev, MT[(t0 + tid) * 4 + head]);
                sa[tid] = __expf(bq + mprev - mt); sden[tid] = __expf(-mt); ssw[tid] = __expf(blast - bq + iq - mnew); sf[tid] = bq - mt; sg[tid] = iq - bq; }
            if (FULL && tid < 256) ns[tid] = nreg;
            __syncthreads();
            bf16x8 bv[4];
            if (!FULL) {
#pragma unroll
                for (int ks = 0; ks < 4; ++ks) bv[ks] = ml_tr8(Vs + (16 * ks + trow) * ML_RS + 64 * w + tcol, 4 * ML_RS);
            }
            if (FULL) {
                { const int tt = w >> 1;
#pragma unroll
                  for (int si = 0; si < 2; ++si) { const int ss = 2 * (w & 1) + si;
                    f32x4 acc = (f32x4){0.f, 0.f, 0.f, 0.f};
                    if (ss <= tt) {
#pragma unroll
                        for (int ks = 0; ks < 8; ++ks) { const bf16x8 a = *(const LAS bf16x8*)(Qs + (16 * tt + fr) * ML_RS + (32 * ks + 8 * fq) * 2), b = *(const LAS bf16x8*)(Ks + (16 * ss + fr) * ML_RS + (32 * ks + 8 * fq) * 2);
                            acc = __builtin_amdgcn_mfma_f32_16x16x32_bf16(a, b, acc, 0, 0, 0); } }
                    const int sidx = 16 * ss + fr; const float gs = sg[sidx];
#pragma unroll
                    for (int j = 0; j < 4; ++j) { const int tix = 16 * tt + 4 * fq + j; const float wv = (sidx <= tix) ? __expf(sf[tix] + gs) * acc[j] : 0.f;
                        *(LAS bf16_t*)(Wl + tix * ML_WS + sidx * 2) = f2bf(wv); } } }
#pragma unroll
                for (int i = 0; i < 8; ++i) { const int tix = 8 * w + i; const u32x2 qv = *(const LAS u32x2*)(Qs + tix * ML_RS + lane * 8); const f32x4 nv = *(const LAS f32x4*)(ns + lane * 4);
                    float part = bflo(qv.x) * nv[0] + bfhi(qv.x) * nv[1] + bflo(qv.y) * nv[2] + bfhi(qv.y) * nv[3]; part = wave_sum(part); if (lane == 0) nd[tix] = part; }
                __syncthreads();
                f32x16 acc[2];
#pragma unroll
                for (int t2 = 0; t2 < 2; ++t2) {
#pragma unroll
                    for (int r = 0; r < 16; ++r) acc[t2][r] = 0.f;
                }
#pragma unroll
                for (int kt = 0; kt < 8; ++kt) {
                    asm volatile("" ::: "memory");
#pragma unroll
                    for (int s2 = 0; s2 < 2; ++s2) {
                        u32x4 bw; bw.x = pg8::cvt_pk_bf16(st[kt][8 * s2 + 0], st[kt][8 * s2 + 1]); bw.y = pg8::cvt_pk_bf16(st[kt][8 * s2 + 2], st[kt][8 * s2 + 3]);
                        bw.z = pg8::cvt_pk_bf16(st[kt][8 * s2 + 4], st[kt][8 * s2 + 5]); bw.w = pg8::cvt_pk_bf16(st[kt][8 * s2 + 6], st[kt][8 * s2 + 7]);
                        const bf16x8 bfrag = __builtin_bit_cast(bf16x8, bw);
#pragma unroll
                        for (int t2 = 0; t2 < 2; ++t2) { const LAS unsigned char* qa = Qs + (32 * t2 + l31) * ML_RS + (32 * kt + 16 * s2 + 4 * hh) * 2;
                            const u32x2 lo = *(const LAS u32x2*)qa, hi = *(const LAS u32x2*)(qa + 16); u32x4 aw; aw.x = lo.x; aw.y = lo.y; aw.z = hi.x; aw.w = hi.y;
                            acc[t2] = __builtin_amdgcn_mfma_f32_32x32x16_bf16(__builtin_bit_cast(bf16x8, aw), bfrag, acc[t2], 0, 0, 0); }
                    }
                }
                asm volatile("" ::: "memory");
#pragma unroll
                for (int t2 = 0; t2 < 2; ++t2)
#pragma unroll
                    for (int r = 0; r < 16; ++r) acc[t2][r] *= sa[32 * t2 + (r & 3) + 8 * (r >> 2) + 4 * hh];
#pragma unroll
                for (int ks = 0; ks < 4; ++ks) bv[ks] = ml_tr8(Vs + (16 * ks + trow) * ML_RS + 64 * w + tcol, 4 * ML_RS);
#pragma unroll
                for (int ks = 0; ks < 4; ++ks)
#pragma unroll
                    for (int t2 = 0; t2 < 2; ++t2) { const bf16x8 a = *(const LAS bf16x8*)(Wl + (32 * t2 + l31) * ML_WS + (16 * ks + 8 * hh) * 2);
                        acc[t2] = __builtin_amdgcn_mfma_f32_32x32x16_bf16(a, bv[ks], acc[t2], 0, 0, 0); }
#pragma unroll
                for (int i = 0; i < 8; ++i) { const int tix = 8 * w + i; float rs = bf2f(*(const LAS bf16_t*)(Wl + tix * ML_WS + lane * 2)); rs = wave_sum(rs);
                    if (lane == 0) { const float nq = sa[tix] * nd[tix] + rs; rden[tix] = 1.0f / fmaxf(fabsf(nq), sden[tix]); } }
                __syncthreads();
                bf16_t* yo = Yo + t0 * 2048 + head * 256 + 32 * w + l31;
#pragma unroll
                for (int t2 = 0; t2 < 2; ++t2)
#pragma unroll
                    for (int r = 0; r < 16; ++r) { const int tix = 32 * t2 + (r & 3) + 8 * (r >> 2) + 4 * hh; yo[(size_t)tix * 2048] = f2bf(acc[t2][r] * rden[tix]); }
            }
#pragma unroll
            for (int kt = 0; kt < 8; ++kt) st[kt] *= decay;
#pragma unroll
            for (int ks = 0; ks < 4; ++ks) {
                const u32x4 raw = __builtin_bit_cast(u32x4, bv[ks]); const LAS float* sw8 = ssw + 16 * ks + 8 * hh;
                u32x4 sc; sc.x = pg8::cvt_pk_bf16(bflo(raw.x) * sw8[0], bfhi(raw.x) * sw8[1]); sc.y = pg8::cvt_pk_bf16(bflo(raw.y) * sw8[2], bfhi(raw.y) * sw8[3]);
                sc.z = pg8::cvt_pk_bf16(bflo(raw.z) * sw8[4], bfhi(raw.z) * sw8[5]); sc.w = pg8::cvt_pk_bf16(bflo(raw.w) * sw8[6], bfhi(raw.w) * sw8[7]);
                const bf16x8 bs = __builtin_bit_cast(bf16x8, sc);
#pragma unroll
                for (int kt = 0; kt < 8; ++kt) { if ((kt & 3) == 0) asm volatile("" ::: "memory");
                    const bf16x8 a = ml_tr8(Ks + (16 * ks + trow) * ML_RS + 64 * kt + tcol, 4 * ML_RS);
                    st[kt] = __builtin_amdgcn_mfma_f32_32x32x16_bf16(a, bs, st[kt], 0, 0, 0); }
            }
            if (tid < 256) { float nacc = 0.f;
#pragma unroll 8
                for (int s2 = 0; s2 < 64; ++s2) nacc += ssw[s2] * bf2f(*(const LAS bf16_t*)(Ks + s2 * ML_RS + tid * 2));
                nreg = decay * nreg + nacc; }
        }
        if (!FULL) {
#pragma unroll
            for (int kt = 0; kt < 8; ++kt) {
                int lz = lane; asm volatile("" : "+v"(lz) :: "memory");
                float* sp = ST + (size_t)unit * 65536 + 32 * w + (lz & 31) + (size_t)(32 * kt + 4 * (lz >> 5)) * 256;
#pragma unroll
                for (int r = 0; r < 16; ++r) sp[((r & 3) + 8 * (r >> 2)) * 256] = st[kt][r];
            }
            if (tid < 256) NS[unit * 256 + tid] = nreg;
        }
    }
}
__device__ __forceinline__ void phase_mlstm_scan(const P& p, unsigned char* lds_) {
    unsigned char* ws = p.ws; const int tid = threadIdx.x, lane = tid & 63, wave = tid >> 6;
    float* ST = (float*)(ws + OFF_QB); float* NS = (float*)(ws + OFF_NS); const float* CH = (const float*)(ws + OFF_CH);
    LAS float* DS = (LAS float*)lds_;
    __syncthreads();
    {
        const ChunkScan r = chunk_scan_wave(CH, wave, lane);
        float d = 1.f;
#pragma unroll
        for (int j = 0; j < 4; ++j) d *= __expf(r.B[j] + r.mp[j] - r.mn[j]);
        const float dn = __shfl_down(d, 1);
        if (!(lane & 1)) DS[wave * 32 + (lane >> 1)] = d * dn;
    }
    __syncthreads();
    {
        const int it0 = blockIdx.x * 512 + tid;
        for (int it = it0; it < 8 * 16384; it += gridDim.x * 512) {
            const int bh = it >> 14; float* base = ST + (size_t)bh * 32 * 65536 + (size_t)(it & 16383) * 4;
            f32x4 carry = (f32x4){0.f, 0.f, 0.f, 0.f};
#pragma unroll
            for (int h = 0; h < 2; ++h) {
                f32x4 tmp[16];
#pragma unroll
                for (int S = 0; S < 16; ++S) tmp[S] = *(const f32x4*)(base + (size_t)(16 * h + S) * 65536);
#pragma unroll
                for (int S = 0; S < 16; ++S) { *(f32x4*)(base + (size_t)(16 * h + S) * 65536) = carry; carry = DS[bh * 32 + 16 * h + S] * carry + tmp[S]; }
            }
        }
        if (it0 < 8 * 256) {
            const int it = it0, bh = it >> 8; float* base = NS + (size_t)bh * 32 * 256 + (it & 255);
            float carry = 0.f;
#pragma unroll 8
            for (int S = 0; S < 32; ++S) { const float tmp = base[S * 256]; base[S * 256] = carry; carry = DS[bh * 32 + S] * carry + tmp; }
        }
    }
}

__device__ __forceinline__ void unpack8(const u32x4 w, float (&f)[8]) {
    f[0] = bflo(w.x); f[1] = bfhi(w.x); f[2] = bflo(w.y); f[3] = bfhi(w.y); f[4] = bflo(w.z); f[5] = bfhi(w.z); f[6] = bflo(w.w); f[7] = bfhi(w.w); }
template <int WIN>
__device__ __forceinline__ void pool_item(const bf16_t* __restrict__ U, bf16_t* __restrict__ Y, const float* __restrict__ s_pool, size_t t0, int s0, int c0) {
    constexpr int NR = WIN + 7;
    u32x4 rw[NR], z[8];
#pragma unroll
    for (int j = 0; j < NR; ++j) rw[j] = (s0 - (WIN - 1) + j >= 0) ? *(const u32x4*)(U + ((long)t0 + j - (WIN - 1)) * 1024 + c0) : (u32x4){0u, 0u, 0u, 0u};
#pragma unroll
    for (int k = 0; k < 8; ++k) z[k] = *(const u32x4*)(Y + (t0 + k) * 2048 + 1024 + c0);
    const f32x4 s0v = *(const f32x4*)(s_pool + c0), s1v = *(const f32x4*)(s_pool + c0 + 4);
    const float sp[8] = {s0v[0], s0v[1], s0v[2], s0v[3], s1v[0], s1v[1], s1v[2], s1v[3]};
    float S[8];
#pragma unroll
    for (int i = 0; i < 8; ++i) S[i] = 0.f;
#pragma unroll
    for (int j = 0; j < WIN - 1; ++j) { float f[8]; unpack8(rw[j], f);
#pragma unroll
        for (int i = 0; i < 8; ++i) S[i] += f[i]; }
#pragma unroll
    for (int k = 0; k < 8; ++k) {
        float self[8], zf[8]; unpack8(rw[k + WIN - 1], self); unpack8(z[k], zf);
#pragma unroll
        for (int i = 0; i < 8; ++i) S[i] += self[i];
        const int cnt = (s0 + k + 1 < WIN) ? s0 + k + 1 : WIN;
        const float inv = __builtin_amdgcn_rcpf((float)cnt);
        float o[8];
#pragma unroll
        for (int i = 0; i < 8; ++i) o[i] = (S[i] * inv - self[i]) * sp[i] * zf[i];
        u32x4 ow; ow.x = pk2(o[0], o[1]); ow.y = pk2(o[2], o[3]); ow.z = pk2(o[4], o[5]); ow.w = pk2(o[6], o[7]);
        *(u32x4*)(Y + (t0 + k) * 2048 + 1024 + c0) = ow;
        float old[8]; unpack8(rw[k], old);
#pragma unroll
        for (int i = 0; i < 8; ++i) S[i] -= old[i];
    }
}
__device__ __forceinline__ void phase_ya_pool(const P& p) {
    unsigned char* ws = p.ws; const int tid = threadIdx.x, lane = tid & 63, wave = tid >> 6;
    bf16_t* Y = (bf16_t*)(ws + OFF_Y); const bf16_t* O = (const bf16_t*)(ws + OFF_QB); const bf16_t* ZA = (const bf16_t*)(ws + OFF_KB);
    for (int tt = blockIdx.x * 8 + wave; tt < T; tt += gridDim.x * 8) {
        const size_t t = (size_t)tt; u32x2 hw[4], ow[4], zw[4];
#pragma unroll
        for (int head = 0; head < 4; ++head) { const int c = head * 256 + lane * 4;
            hw[head] = *(const u32x2*)(Y + t * 2048 + c); ow[head] = *(const u32x2*)(O + t * 1024 + c); zw[head] = *(const u32x2*)(ZA + t * 1024 + c); }
#pragma unroll
        for (int head = 0; head < 4; ++head) { const int c = head * 256 + lane * 4;
            float v[4] = {bflo(hw[head].x) * bflo(ow[head].x), bfhi(hw[head].x) * bfhi(ow[head].x), bflo(hw[head].y) * bflo(ow[head].y), bfhi(hw[head].y) * bfhi(ow[head].y)};
            const float ss = wave_sum(v[0] * v[0] + v[1] * v[1] + v[2] * v[2] + v[3] * v[3]);
            const float rstd = rsqrtf(ss * (1.0f / 256.0f) + EPS);
            const f32x4 g = *(const f32x4*)(p.e_g_head + c);
            u32x2 o; o.x = pk2(v[0] * rstd * g[0] * bflo(zw[head].x), v[1] * rstd * g[1] * bfhi(zw[head].x)); o.y = pk2(v[2] * rstd * g[2] * bflo(zw[head].y), v[3] * rstd * g[3] * bfhi(zw[head].y));
            *(u32x2*)(Y + t * 2048 + c) = o; }
    }
    const bf16_t* U = (const bf16_t*)(ws + OFF_VB);
    for (int it = blockIdx.x * 512 + tid; it < (T / 8) * 128; it += gridDim.x * 512) {
        const int cgl = it & 31, tbl = (it >> 5) & 1, g = __builtin_amdgcn_readfirstlane((it >> 6) & 3), tb = 2 * (it >> 8) + tbl;
        const size_t t0 = (size_t)tb * 8; const int s0 = (int)(t0 & (SEQ - 1)), c0 = g * 256 + cgl * 8;
        if (g == 0) pool_item<2>(U, Y, p.e_s_pool, t0, s0, c0);
        else if (g == 1) pool_item<4>(U, Y, p.e_s_pool, t0, s0, c0);
        else if (g == 2) pool_item<8>(U, Y, p.e_s_pool, t0, s0, c0);
        else pool_item<16>(U, Y, p.e_s_pool, t0, s0, c0);
    }
}

__device__ __forceinline__ void headnorm64(bf16_t* X, const float* g) {
    const int lane = threadIdx.x & 63, wave = threadIdx.x >> 6;
    const float* gg = g + (lane & 3) * 16;
    for (int t0 = (blockIdx.x * 8 + wave) * 4; t0 < T; t0 += gridDim.x * 32) {
        u32x4 a[4], b[4];
#pragma unroll
        for (int k = 0; k < 4; ++k) { const bf16_t* r = X + (size_t)(t0 + k) * 1024 + lane * 16; a[k] = *(const u32x4*)r; b[k] = *(const u32x4*)(r + 8); }
#pragma unroll
        for (int k = 0; k < 4; ++k) {
            float f[16] = {bflo(a[k].x), bfhi(a[k].x), bflo(a[k].y), bfhi(a[k].y), bflo(a[k].z), bfhi(a[k].z), bflo(a[k].w), bfhi(a[k].w), bflo(b[k].x), bfhi(b[k].x), bflo(b[k].y), bfhi(b[k].y), bflo(b[k].z), bfhi(b[k].z), bflo(b[k].w), bfhi(b[k].w)};
            float ss = 0.f;
#pragma unroll
            for (int i = 0; i < 16; ++i) ss += f[i] * f[i];
            ss += __shfl_xor(ss, 1); ss += __shfl_xor(ss, 2);
            const float rstd = rsqrtf(ss * (1.0f / 64.0f) + EPS);
#pragma unroll
            for (int i = 0; i < 16; ++i) f[i] = f[i] * rstd * gg[i];
            u32x4 oa, ob; oa.x = pk2(f[0], f[1]); oa.y = pk2(f[2], f[3]); oa.z = pk2(f[4], f[5]); oa.w = pk2(f[6], f[7]);
            ob.x = pk2(f[8], f[9]); ob.y = pk2(f[10], f[11]); ob.z = pk2(f[12], f[13]); ob.w = pk2(f[14], f[15]);
            bf16_t* r = X + (size_t)(t0 + k) * 1024 + lane * 16; *(u32x4*)r = oa; *(u32x4*)(r + 8) = ob;
        }
    }
}
__device__ __forceinline__ void phase_qnorm_ckvnorm(const P& p) {
    unsigned char* ws = p.ws; const int lane = threadIdx.x & 63, wave = threadIdx.x >> 6;
    headnorm64((bf16_t*)(ws + OFF_TMP), p.o_g_q);
    bf16_t* CKVN = (bf16_t*)(ws + OFF_CKVN);
    const f32x4 g = *(const f32x4*)(p.o_g_kv + lane * 4);
    for (int t0 = (blockIdx.x * 8 + wave) * 8; t0 < T; t0 += gridDim.x * 64) {
        u32x2 w[8];
#pragma unroll
        for (int k = 0; k < 8; ++k) w[k] = *(const u32x2*)(CKVN + (size_t)(t0 + k) * 256 + lane * 4);
#pragma unroll
        for (int k = 0; k < 8; ++k) {
            const float v[4] = {bflo(w[k].x), bfhi(w[k].x), bflo(w[k].y), bfhi(w[k].y)};
            const float ss = wave_sum(v[0] * v[0] + v[1] * v[1] + v[2] * v[2] + v[3] * v[3]);
            const float rstd = rsqrtf(ss * (1.0f / 256.0f) + EPS);
            u32x2 o; o.x = pk2(v[0] * rstd * g[0], v[1] * rstd * g[1]); o.y = pk2(v[2] * rstd * g[2], v[3] * rstd * g[3]);
            *(u32x2*)(CKVN + (size_t)(t0 + k) * 256 + lane * 4) = o;
        }
    }
}

__device__ __forceinline__ unsigned okey(float s) { if (s == 0.f) s = 0.f; const unsigned u = __float_as_uint(s); return (u & 0x80000000u) ? ~u : (u | 0x80000000u); }

__device__ __forceinline__ void indexer_slow_query(const P& p, unsigned char* lds, size_t t) {
    unsigned char* ws = p.ws; const int tid = threadIdx.x, lane = tid & 63, wave = tid >> 6;
    const _Float16* QI = (const _Float16*)(ws + OFF_QI); const _Float16* KI = (const _Float16*)(ws + OFF_KI); const float* WI = (const float*)(ws + OFF_WI);
    unsigned short* IDX = (unsigned short*)(ws + OFF_IDX);
    unsigned* sc = (unsigned*)lds; unsigned* hist = sc + 16384; float* qs = (float*)(hist + 256); unsigned* misc = (unsigned*)(qs + 256); unsigned* wsum = misc + 16;
    const int batch = (int)(t >> 14), pos = (int)(t & (SEQ - 1)), n = pos + 1;
    __syncthreads();
    if (tid < 256) qs[tid] = (float)QI[t * 256 + tid];
    const float w0 = WI[t * 4 + 0], w1 = WI[t * 4 + 1], w2 = WI[t * 4 + 2], w3 = WI[t * 4 + 3];
    __syncthreads();
    const _Float16* kbase = KI + (size_t)batch * SEQ * 64;
    for (int s = tid; s < n; s += 512) {
        asm volatile("" ::: "memory");
        typedef _Float16 h8 __attribute__((ext_vector_type(8)));
        const h8* kr = (const h8*)(kbase + (size_t)s * 64);
        float d0 = 0.f, d1 = 0.f, d2 = 0.f, d3 = 0.f;
#pragma unroll
        for (int j = 0; j < 8; ++j) { const h8 kv = kr[j];
#pragma unroll
            for (int e = 0; e < 8; ++e) { const int d = j * 8 + e; const float kf = (float)kv[e]; d0 += qs[d] * kf; d1 += qs[64 + d] * kf; d2 += qs[128 + d] * kf; d3 += qs[192 + d] * kf; } }
        float score = w0 * fmaxf(d0, 0.f); score = fmaf(w1, fmaxf(d1, 0.f), score); score = fmaf(w2, fmaxf(d2, 0.f), score); score = fmaf(w3, fmaxf(d3, 0.f), score);
        sc[s] = okey(score);
    }
    unsigned prefix = 0, krem = 256;
    for (int pass = 0; pass < 4; ++pass) {
        const int shift = 24 - 8 * pass;
        __syncthreads();
        if (tid < 256) hist[tid] = 0;
        __syncthreads();
        for (int s = tid; s < n; s += 512) { const unsigned k = sc[s]; if (pass == 0 || (k >> (shift + 8)) == prefix) atomicAdd(&hist[(k >> shift) & 255u], 1u); }
        __syncthreads();
        if (tid == 0) { unsigned cum = 0; int bin = 255; for (; bin > 0; --bin) { const unsigned c = hist[bin]; if (cum + c >= krem) break; cum += c; } misc[0] = (unsigned)bin; misc[1] = krem - cum; }
        __syncthreads();
        prefix = (prefix << 8) | misc[0]; krem = misc[1];
    }
    const unsigned ngt_total = 256u - krem;
    unsigned lg = 0, le = 0; const int s0 = tid * 32;
    for (int s = s0; s < s0 + 32 && s < n; ++s) { const unsigned k = sc[s]; lg += (k > prefix); le += (k == prefix); }
    unsigned pk = lg | (le << 16), incl = pk;
#pragma unroll
    for (int o = 1; o < 64; o <<= 1) { const unsigned y = __shfl_up(incl, o); if (lane >= o) incl += y; }
    if (lane == 63) wsum[wave] = incl;
    __syncthreads();
    unsigned base = 0;
    for (int w = 0; w < wave; ++w) base += wsum[w];
    const unsigned excl = base + incl - pk; unsigned bg = excl & 0xffffu, be = excl >> 16;
    for (int s = s0; s < s0 + 32 && s < n; ++s) { const unsigned k = sc[s];
        if (k > prefix) { IDX[t * 256 + bg] = (unsigned short)s; ++bg; }
        else if (k == prefix) { if (be < krem) IDX[t * 256 + ngt_total + be] = (unsigned short)s; ++be; } }
    __syncthreads();
}

typedef _Float16 half8 __attribute__((ext_vector_type(8)));
constexpr int IX_CAP = 1024, IX_ZBIN = 1024;
__device__ __forceinline__ unsigned ix_key(const f32x4 a, const f32x4 w) {
    const float r0 = __int_as_float(max(__float_as_int(a[0]), 0)), r1 = __int_as_float(max(__float_as_int(a[1]), 0));
    const float r2 = __int_as_float(max(__float_as_int(a[2]), 0)), r3 = __int_as_float(max(__float_as_int(a[3]), 0));
    float s = fmaf(w[0], r0, 0.0f); s = fmaf(w[1], r1, s); s = fmaf(w[2], r2, s); s = fmaf(w[3], r3, s);
    const unsigned u = __float_as_uint(s);
    return u ^ ((unsigned)((int)u >> 31) | 0x80000000u);
}
#define LDS_ADD(ptr, v) __hip_atomic_fetch_add((ptr), (v), __ATOMIC_RELAXED, __HIP_MEMORY_SCOPE_WORKGROUP)
struct IxTagF { static constexpr bool value = false; }; struct IxTagT { static constexpr bool value = true; };
__device__ __forceinline__ void phase_indexer(const P& p, unsigned char* lds) {
    unsigned char* ws = p.ws; const int tid = threadIdx.x, lane = tid & 63, kl = lane & 15, g = lane >> 4;
    const int wave = __builtin_amdgcn_readfirstlane(tid >> 6);
    const _Float16* QI = (const _Float16*)(ws + OFF_QI); const _Float16* KI = (const _Float16*)(ws + OFF_KI); const float* WI = (const float*)(ws + OFF_WI);
    unsigned short* IDX = (unsigned short*)(ws + OFF_IDX); int* CNT = (int*)(ws + OFF_CNT);
    LAS unsigned* hist = (LAS unsigned*)lds;
    LAS int* qTbin = (LAS int*)(hist + 16 * 2048);
    LAS int* qCab = qTbin + 16; LAS unsigned* qN = (LAS unsigned*)(qCab + 16); LAS int* qOvf = (LAS int*)(qN + 16); LAS int* qZl = qOvf + 16;
    LAS unsigned* ovl = (LAS unsigned*)(lds + 132 * 1024);
    LAS unsigned* h2 = (LAS unsigned*)(lds + 133 * 1024 + wave * 1536);
    LAS unsigned long long* l2 = (LAS unsigned long long*)(h2 + 256);
    if (tid == 0) ovl[0] = 0u;
    const int G = gridDim.x, nround = (T / 16) / G;
#pragma unroll 1
    for (int i = 0; i < nround; ++i) {
        const int tix = (i & 1) ? i * G + (G - 1 - (int)blockIdx.x) : i * G + (int)blockIdx.x;
        const int batch = tix & 1, tb = tix >> 1, p0 = tb * 16; const size_t t0 = (size_t)batch * SEQ + p0;
        __syncthreads();
        if (p0 + 16 <= 256) {
#pragma unroll
            for (int j = 0; j < 8; ++j) { const int e = tid + 512 * j, q = e >> 8, jj = e & 255; IDX[(t0 + q) * 256 + jj] = (unsigned short)(jj <= p0 + q ? jj : 0); }
            if (tid < 16) CNT[t0 + tid] = p0 + tid + 1;
            continue;
        }
#pragma unroll
        for (int j = 0; j < 16; ++j) ((LAS u32x4*)hist)[tid + 512 * j] = (u32x4){0u, 0u, 0u, 0u};
        if (tid < 16) { qN[tid] = 0u; qOvf[tid] = 0; }
        half8 af[4][2]; f32x4 wv[4];
#pragma unroll
        for (int rt = 0; rt < 4; ++rt) {
#pragma unroll
            for (int ks = 0; ks < 2; ++ks) af[rt][ks] = *(const half8*)(QI + (t0 + 4 * rt + (kl >> 2)) * 256 + (kl & 3) * 64 + 32 * ks + 8 * g);
            wv[rt] = *(const f32x4*)(WI + (t0 + 4 * rt + g) * 4);
        }
        __syncthreads();
        const int nblk = tb + 1, L = (nblk + 7) >> 3, b0 = wave * L, b1 = (b0 + L < nblk) ? b0 + L : nblk;
        const _Float16* kb = KI + (size_t)batch * SEQ * 64 + kl * 64 + 8 * g;
        LAS unsigned* hg = hist + g * 4 * 2048;
#define IX_LOADK(u, bb) do { kq[u][0] = *(const half8*)(kb + (size_t)(bb) * 1024); kq[u][1] = *(const half8*)(kb + (size_t)(bb) * 1024 + 32); } while (0)
#define IX_MFMA(acc, k0, k1) do { _Pragma("unroll") for (int rt = 0; rt < 4; ++rt) { acc[rt] = __builtin_amdgcn_mfma_f32_16x16x32_f16(af[rt][0], k0, (f32x4){0.f, 0.f, 0.f, 0.f}, 0, 0, 0); \
            acc[rt] = __builtin_amdgcn_mfma_f32_16x16x32_f16(af[rt][1], k1, acc[rt], 0, 0, 0); } } while (0)
        if (b0 < b1) {
            half8 kq[2][2];
#pragma unroll
            for (int u = 0; u < 2; ++u) { const int bb = (b0 + u < b1) ? b0 + u : b1 - 1; IX_LOADK(u, bb); }
            auto step1 = [&](int bcur, const half8& k0, const half8& k1, auto chkTag) {
                constexpr bool CHK = decltype(chkTag)::value;
                f32x4 acc[4]; IX_MFMA(acc, k0, k1);
#pragma unroll
                for (int rt = 0; rt < 4; ++rt) { const unsigned key = ix_key(acc[rt], wv[rt]);
                    if (!CHK || bcur * 16 + kl <= p0 + 4 * rt + g) LDS_ADD(hg + rt * 2048 + (key >> 21), 1u); }
            };
            int b = b0;
#pragma unroll 1
            for (; b + 2 <= b1 && b + 2 <= nblk - 1; b += 2) {
#pragma unroll
                for (int u = 0; u < 2; ++u) { step1(b + u, kq[u][0], kq[u][1], IxTagF{}); const int bb = (b + 2 + u < b1) ? b + 2 + u : b1 - 1; IX_LOADK(u, bb); }
            }
#pragma unroll 1
            for (; b + 2 <= b1; b += 2) {
#pragma unroll
                for (int u = 0; u < 2; ++u) { step1(b + u, kq[u][0], kq[u][1], IxTagT{}); const int bb = (b + 2 + u < b1) ? b + 2 + u : b1 - 1; IX_LOADK(u, bb); }
            }
            if (b < b1) step1(b, kq[0][0], kq[0][1], IxTagT{});
        }
        __syncthreads();
#pragma unroll 1
        for (int qq = 0; qq < 2; ++qq) {
            const int q = 2 * wave + qq; const LAS unsigned* h = hist + q * 2048;
            unsigned cs = 0; const int top = 2047 - 32 * lane;
#pragma unroll 8
            for (int ii = 0; ii < 32; ++ii) cs += h[top - ((ii + lane) & 31)];
            unsigned incl = cs;
#pragma unroll
            for (int o = 1; o < 64; o <<= 1) { const unsigned y = __shfl_up(incl, o); if (lane >= o) incl += y; }
            const unsigned long long m = __ballot(incl >= 256u);
            const int Ls = m ? (__ffsll((long long)m) - 1) : 63;
            unsigned cabv = __shfl(incl - cs, Ls), cbv = 0; int tbin = 0; bool found = false;
#pragma unroll 8
            for (int ii = 0; ii < 32; ++ii) { const unsigned c = h[2047 - 32 * Ls - ii]; if (!found && cabv + c >= 256u) { tbin = 2047 - 32 * Ls - ii; cbv = c; found = true; } if (!found) cabv += c; }
            if (lane == 0) { qTbin[q] = tbin; qCab[q] = (int)cabv; int zl = 0x7fffffff;
                if (tbin == IX_ZBIN) {
                    const int nk = p0 + 4 * (q & 3) + (q >> 2) + 1; zl = (int)(((unsigned long long)384 * (unsigned)nk) / (cbv ? cbv : 1u)) + 16; }
                qZl[q] = zl; }
        }
        __syncthreads();
        if (b0 < b1) {
            unsigned lok[4]; int zl[4];
#pragma unroll
            for (int rt = 0; rt < 4; ++rt) { lok[rt] = (unsigned)qTbin[g * 4 + rt] << 21; zl[rt] = qZl[g * 4 + rt]; }
            half8 kq[2][2];
#pragma unroll
            for (int u = 0; u < 2; ++u) { const int bb = (b0 + u < b1) ? b0 + u : b1 - 1; IX_LOADK(u, bb); }
            auto step2 = [&](int bcur, const half8& k0, const half8& k1, auto chkTag) {
                constexpr bool CHK = decltype(chkTag)::value;
                const int s = bcur * 16 + kl;
                f32x4 acc[4]; IX_MFMA(acc, k0, k1);
                unsigned key[4], pos[4]; bool cand[4];
#pragma unroll
                for (int rt = 0; rt < 4; ++rt) { key[rt] = ix_key(acc[rt], wv[rt]); cand[rt] = key[rt] >= lok[rt] + (s >= zl[rt] ? 1u : 0u); if (CHK) cand[rt] = cand[rt] && s <= p0 + 4 * rt + g; }
#pragma unroll
                for (int rt = 0; rt < 4; ++rt) { pos[rt] = 0u;
                    if (cand[rt]) { int gz = g; asm volatile("" : "+v"(gz)); pos[rt] = LDS_ADD(qN + gz * 4 + rt, 1u); } }
#pragma unroll
                for (int rt = 0; rt < 4; ++rt) {
                    if (cand[rt] && pos[rt] < (unsigned)IX_CAP) { int gz = g; asm volatile("" : "+v"(gz));
                        ((LAS unsigned long long*)(lds + (gz * 4 + rt) * 8192))[pos[rt]] = ((unsigned long long)key[rt] << 16) | (unsigned long long)(0xffffu - (unsigned)s); } }
            };
            int b = b0;
#pragma unroll 1
            for (; b + 2 <= b1 && b + 2 <= nblk - 1; b += 2) {
#pragma unroll
                for (int u = 0; u < 2; ++u) { step2(b + u, kq[u][0], kq[u][1], IxTagF{}); const int bb = (b + 2 + u < b1) ? b + 2 + u : b1 - 1; IX_LOADK(u, bb); }
            }
#pragma unroll 1
            for (; b + 2 <= b1; b += 2) {
#pragma unroll
                for (int u = 0; u < 2; ++u) { step2(b + u, kq[u][0], kq[u][1], IxTagT{}); const int bb = (b + 2 + u < b1) ? b + 2 + u : b1 - 1; IX_LOADK(u, bb); }
            }
            if (b < b1) step2(b, kq[0][0], kq[0][1], IxTagT{});
        }
#undef IX_LOADK
#undef IX_MFMA
        __syncthreads();
#pragma unroll 1
        for (int qq = 0; qq < 2; ++qq) {
            const int qs = 2 * wave + qq; const int n = (int)qN[qs], cabq = qCab[qs], tbin = qTbin[qs];
            if (n > IX_CAP || n < 256) { if (lane == 0) qOvf[qs] = 1; continue; }
            const LAS unsigned long long* cd = (const LAS unsigned long long*)(lds + qs * 8192);
            unsigned short* irow = IDX + (t0 + 4 * (qs & 3) + (qs >> 2)) * 256;
            if (n == 256) { for (int c = lane; c < n; c += 64) irow[c] = (unsigned short)(0xffffu - (unsigned)(cd[c] & 0xffffull)); continue; }
            { int base = 0;
              for (int c0 = 0; c0 < n; c0 += 64) { const int c = c0 + lane; const unsigned long long v = c < n ? cd[c] : 0ull; const bool sure = c < n && (int)(v >> 37) > tbin;
                  const unsigned long long bm = __ballot(sure);
                  if (sure) irow[base + __popcll(bm & ((1ull << lane) - 1ull))] = (unsigned short)(0xffffu - (unsigned)(v & 0xffffull));
                  base += __popcll(bm); } }
            unsigned long long pmask = 0x7ffull << 37, pval = (unsigned long long)tbin << 37; int need = 256 - cabq, done = cabq; unsigned cT = (unsigned)(n - cabq);
#pragma unroll 1
            for (int shift = 29; shift >= 5 && cT > 64u; shift -= 8) {
#pragma unroll
                for (int j = 0; j < 4; ++j) h2[lane + 64 * j] = 0u;
                for (int c = lane; c < n; c += 64) { const unsigned long long v = cd[c]; if ((v & pmask) == pval) LDS_ADD(h2 + ((unsigned)(v >> shift) & 255u), 1u); }
                const unsigned cs = h2[255 - 4 * lane] + h2[254 - 4 * lane] + h2[253 - 4 * lane] + h2[252 - 4 * lane];
                unsigned incl = cs;
#pragma unroll
                for (int o = 1; o < 64; o <<= 1) { const unsigned y = __shfl_up(incl, o); if (lane >= o) incl += y; }
                const unsigned long long m = __ballot(incl >= (unsigned)need);
                const int Ls = m ? (__ffsll((long long)m) - 1) : 63;
                unsigned above = __shfl(incl - cs, Ls), c2 = 0; int T2 = 0; bool found = false;
#pragma unroll
                for (int ii = 0; ii < 4; ++ii) { const unsigned c = h2[255 - 4 * Ls - ii]; if (!found && above + c >= (unsigned)need) { T2 = 255 - 4 * Ls - ii; c2 = c; found = true; } if (!found) above += c; }
                { int base = done;
                  for (int c0 = 0; c0 < n; c0 += 64) { const int c = c0 + lane; const unsigned long long v = c < n ? cd[c] : 0ull;
                      const bool up = c < n && (v & pmask) == pval && (int)((unsigned)(v >> shift) & 255u) > T2;
                      const unsigned long long bm = __ballot(up);
                      if (up) irow[base + __popcll(bm & ((1ull << lane) - 1ull))] = (unsigned short)(0xffffu - (unsigned)(v & 0xffffull));
                      base += __popcll(bm); } }
                done += (int)above; need -= (int)above; cT = c2;
                pmask |= 255ull << shift; pval |= (unsigned long long)T2 << shift;
            }
            asm volatile("" ::: "memory");
            if (lane == 0) h2[1] = 0u;
            asm volatile("" ::: "memory");
            for (int c = lane; c < n; c += 64) { const unsigned long long v = cd[c]; if ((v & pmask) == pval) { const unsigned pos = LDS_ADD(h2 + 1, 1u); if (pos < 64u) l2[pos] = v; } }
            asm volatile("" ::: "memory");
            { const unsigned long long mine = (unsigned)lane < cT ? l2[lane] : ~0ull; int rank = 0;
              for (unsigned j = 0; j < cT; ++j) rank += (l2[j] > mine) ? 1 : 0;
              if ((unsigned)lane < cT && rank < need) irow[done + rank] = (unsigned short)(0xffffu - (unsigned)(mine & 0xffffull)); }
        }
        if (tid < 16) CNT[t0 + tid] = 256;
        __syncthreads();
        if (tid < 16 && qOvf[tid]) { const unsigned k = LDS_ADD(ovl, 1u); ovl[1 + k] = (unsigned)(t0 + 4 * (tid & 3) + (tid >> 2)); }
    }
    __syncthreads();
    const unsigned novl = __builtin_amdgcn_readfirstlane(ovl[0]);
#pragma unroll 1
    for (unsigned k = 0; k < novl; ++k) { const unsigned tq = __builtin_amdgcn_readfirstlane(ovl[1 + k]); indexer_slow_query(p, lds, (size_t)tq); }
}
#undef LDS_ADD

__device__ __forceinline__ void phase_attn(const P& p, unsigned char* lds) {
    unsigned char* ws = p.ws; const int tid = threadIdx.x, lane = tid & 63, hd = lane & 15, g = lane >> 4;
    const int wave = __builtin_amdgcn_readfirstlane(tid >> 6);
    bf16_t* QP = (bf16_t*)(ws + OFF_QP); const bf16_t* CK = (const bf16_t*)(ws + OFF_CKVN); const bf16_t* RK = (const bf16_t*)(ws + OFF_RK);
    const unsigned short* IDX = (const unsigned short*)(ws + OFF_IDX); const int* CNT = (const int*)(ws + OFF_CNT);
    float* biasT = (float*)lds;
    biasT[tid] = p.rel_bias[tid];
    __syncthreads();
    LAS unsigned char* rows = (LAS unsigned char*)(lds + 2048 + (size_t)wave * 18432);
    LAS bf16_t* rkb = (LAS bf16_t*)(rows + 16384);
    LAS unsigned* info = (LAS unsigned*)(rows + 17408);
    const LAS float* biasL = (const LAS float*)lds;
    for (int t = blockIdx.x * 8 + wave; t < T; t += gridDim.x * 8) {
        const int batch = t >> 14, pos = t & (SEQ - 1); const int cnt = CNT[t];
        const size_t rb = (size_t)batch * SEQ;
        asm volatile("s_waitcnt lgkmcnt(0)" ::: "memory");
#pragma unroll
        for (int jj = 0; jj < 4; ++jj) {
            const int j = lane + 64 * jj; int id = IDX[(size_t)t * 256 + j]; if (j >= cnt) id = 0;
            const int rel = pos - id; int bucket = rel < 0 ? 0 : rel;
            if (rel >= 16) { bucket = 16 + (int)(__logf((float)rel * 0.0625f) / 2.0794415416798357f * 16.0f); bucket = bucket > 31 ? 31 : bucket; }
            info[j] = (unsigned)id | ((unsigned)bucket << 16);
        }
        bf16x8 qf[8];
#pragma unroll
        for (int ks = 0; ks < 8; ++ks) qf[ks] = *(const bf16x8*)(QP + (size_t)t * 4096 + hd * 256 + ks * 32 + g * 8);
        f32x4 o[16];
#pragma unroll
        for (int rt = 0; rt < 16; ++rt) o[rt] = (f32x4){0.f, 0.f, 0.f, 0.f};
        float mrun = -1e30f, lrun = 0.f;
        asm volatile("s_waitcnt lgkmcnt(0)" ::: "memory");
        const int nch = (cnt + 31) >> 5;
        for (int ch = 0; ch < nch; ++ch) {
            asm volatile("s_waitcnt lgkmcnt(0)" ::: "memory");
#pragma unroll
            for (int i = 0; i < 16; ++i) {
                const int ksl = 2 * i + (lane >> 5); const unsigned idv = info[ch * 32 + ksl] & 0xffffu;
                const bf16_t* src = CK + (rb + idv) * 256 + (((lane & 31) ^ (ksl & 15)) * 8);
                __builtin_amdgcn_global_load_lds((const unsigned*)src, (LAS unsigned*)(rows + i * 1024), 16, 0, 0);
            }
            { const unsigned idv = info[ch * 32 + (lane >> 1)] & 0xffffu;
              __builtin_amdgcn_global_load_lds((const unsigned*)(RK + (rb + idv) * 16 + (lane & 1) * 8), (LAS unsigned*)rkb, 16, 0, 0); }
            asm volatile("s_waitcnt vmcnt(0)" ::: "memory");
            f32x4 s0 = (f32x4){0.f, 0.f, 0.f, 0.f}, s1 = (f32x4){0.f, 0.f, 0.f, 0.f};
#pragma unroll
            for (int ks = 0; ks < 8; ++ks) {
                const int pos16 = ((4 * ks + g) ^ hd) * 16;
                const bf16x8 a0 = *(const LAS bf16x8*)(rows + hd * 512 + pos16);
                const bf16x8 a1 = *(const LAS bf16x8*)(rows + (16 + hd) * 512 + pos16);
                s0 = __builtin_amdgcn_mfma_f32_16x16x32_bf16(a0, qf[ks], s0, 0, 0, 0);
                s1 = __builtin_amdgcn_mfma_f32_16x16x32_bf16(a1, qf[ks], s1, 0, 0, 0);
            }
            float x0[4], x1[4]; float cm = -INFINITY;
#pragma unroll
            for (int r = 0; r < 4; ++r) {
                const int sl0 = 4 * g + r, sl1 = 16 + 4 * g + r, j0 = ch * 32 + sl0, j1 = ch * 32 + sl1;
                const unsigned i0 = info[j0], i1 = info[j1];
                const float r0 = bf2f(rkb[sl0 * 16 + hd]), r1 = bf2f(rkb[sl1 * 16 + hd]);
                x0[r] = (j0 < cnt) ? s0[r] * r0 + biasL[(i0 >> 16) * 16 + hd] : -INFINITY;
                x1[r] = (j1 < cnt) ? s1[r] * r1 + biasL[(i1 >> 16) * 16 + hd] : -INFINITY;
                cm = fmaxf(cm, fmaxf(x0[r], x1[r]));
            }
            cm = fmaxf(cm, __shfl_xor(cm, 16)); cm = fmaxf(cm, __shfl_xor(cm, 32));
            const float mnew = fmaxf(mrun, cm); const float sc = __expf(mrun - mnew); mrun = mnew;
            float ls = 0.f;
#pragma unroll
            for (int r = 0; r < 4; ++r) { x0[r] = __expf(x0[r] - mnew); x1[r] = __expf(x1[r] - mnew); ls += x0[r] + x1[r]; }
            lrun = lrun * sc + ls;
#pragma unroll
            for (int rt = 0; rt < 16; ++rt) o[rt] *= sc;
            u32x4 pw; pw.x = pg8::cvt_pk_bf16(x0[0], x0[1]); pw.y = pg8::cvt_pk_bf16(x0[2], x0[3]); pw.z = pg8::cvt_pk_bf16(x1[0], x1[1]); pw.w = pg8::cvt_pk_bf16(x1[2], x1[3]);
            const bf16x8 pf = __builtin_bit_cast(bf16x8, pw);
            const int q = hd >> 2, pp = hd & 3, ksl = 4 * g + q;
            const LAS unsigned char* trb = rows + ksl * 512 + (pp & 1) * 8;
#pragma unroll
            for (int rt = 0; rt < 16; ++rt) {
                const int c16 = ((2 * rt + (pp >> 1)) ^ ksl) * 16;
                const v4i16_t t0 = __builtin_amdgcn_ds_read_tr16_b64_v4i16((LAS v4i16_t*)(trb + c16));
                const v4i16_t t1 = __builtin_amdgcn_ds_read_tr16_b64_v4i16((LAS v4i16_t*)(trb + c16 + 8192));
                bf16x8 af; af[0] = t0[0]; af[1] = t0[1]; af[2] = t0[2]; af[3] = t0[3]; af[4] = t1[0]; af[5] = t1[1]; af[6] = t1[2]; af[7] = t1[3];
                o[rt] = __builtin_amdgcn_mfma_f32_16x16x32_bf16(af, pf, o[rt], 0, 0, 0);
            }
        }
        float ltot = lrun; ltot += __shfl_xor(ltot, 16); ltot += __shfl_xor(ltot, 32);
        const float inv = 1.0f / ltot;
        bf16_t* op = QP + (size_t)t * 4096 + hd * 256 + 4 * g;
#pragma unroll
        for (int rt = 0; rt < 16; ++rt) { u32x2 w; w.x = pg8::cvt_pk_bf16(o[rt][0] * inv, o[rt][1] * inv); w.y = pg8::cvt_pk_bf16(o[rt][2] * inv, o[rt][3] * inv); *(u32x2*)(op + rt * 16) = w; }
    }
}

__global__ void __launch_bounds__(512, 2) k_fwd(P p_arg, int ph_lo, int ph_hi) {
    extern __shared__ __attribute__((aligned(16))) unsigned char smem[];
    const P& p = *(const P*)__builtin_amdgcn_kernarg_segment_ptr(); (void)p_arg;
    unsigned char* lds = smem + 16;
    unsigned char* ws = p.ws;
    XcdBarrier bar;
    const bool multi = (ph_hi - ph_lo) > 1;
    if (multi) {
        if (threadIdx.x == 0) *(uint4*)smem = make_uint4(0u, 0u, 0u, 0u);
        __syncthreads();
        bar = xcd_barrier_post((unsigned*)(ws + OFF_CTL), (volatile LAS unsigned*)smem);
    }
#define PH(i) (ph_lo <= (i) && (i) < ph_hi)
#define SEAM(i) do { if ((i) + 1 < ph_hi) xcd_barrier(bar); else __syncthreads(); } while (0)
    bf16_t *XN = (bf16_t*)(ws + OFF_XN), *QB = (bf16_t*)(ws + OFF_QB), *KB = (bf16_t*)(ws + OFF_KB), *VB = (bf16_t*)(ws + OFF_VB), *TMP = (bf16_t*)(ws + OFF_TMP), *Y = (bf16_t*)(ws + OFF_Y);
    if (PH(0)) { phase_prep(p, lds); SEAM(0); }
    if (PH(1)) { fast_gemm(lds, XN, 1024, (const bf16_t*)(ws + OFF_W0T), 1024, 3072, 1024, D1{ws}); SEAM(1); }
    if (PH(2)) { phase_conv_scan(p, lds); SEAM(2); }
    if (PH(3)) { mlstm_units<false>(p, lds); SEAM(3); }
    if (PH(4)) { GWP f{(const bf16_t*)(ws + OFF_WPT), (const bf16_t*)(ws + OFF_WUB), (bf16_t*)(ws + OFF_W0T)}; sgemm(f, 256); phase_mlstm_scan(p, lds); SEAM(4); }
    if (PH(5)) { mlstm_units<true>(p, lds); SEAM(5); }
    if (PH(6)) { fast_gemm(lds, XN, 1024, (const bf16_t*)(ws + OFF_W0T) + (size_t)3072 * 1024, 1024, 4096, 1024, D2{ws}); SEAM(6); }
    if (PH(7)) { phase_ya_pool(p); SEAM(7); }
    if (PH(8)) { fast_gemm(lds, Y, 2048, (const bf16_t*)(ws + OFF_WO0T), 2048, 1024, 2048, D4{(unsigned char*)p.out, p.x}); SEAM(8); }
    if (PH(9)) { rmsnorm_rows<4>(p.out, p.o_norm, XN, p.o_w_in, OIN, 1600, nullptr, 0.5f, (float*)(ws + OFF_WI), (float*)lds); SEAM(9); }
    if (PH(10)) { fast_gemm(lds, XN, 1024, (const bf16_t*)(ws + OFF_W1T), 1024, 2816, 1024, D5{ws}); SEAM(10); }
    if (PH(11)) { phase_qnorm_ckvnorm(p); SEAM(11); }
    if (PH(12)) { fast_gemm(lds, (const bf16_t*)(ws + OFF_CKVN), 256, (const bf16_t*)(ws + OFF_WUKP), 256, 1024, 256, DK{ws}); SEAM(12); }
    if (PH(13)) { GQP f{TMP, (const bf16_t*)(ws + OFF_WQP), (bf16_t*)(ws + OFF_QP)}; sgemm(f, 512 * 64); phase_indexer(p, lds); SEAM(13); }
    if (PH(14)) { phase_attn(p, lds); SEAM(14); }
    if (PH(15)) { GOP f{(const bf16_t*)(ws + OFF_QP), (const bf16_t*)(ws + OFF_WUVT), (const bf16_t*)(ws + OFF_Z), TMP}; sgemm(f, 512 * 16); SEAM(15); }
    if (PH(16)) { fast_gemm(lds, TMP, 1024, (const bf16_t*)(ws + OFF_WO1T), 1024, 1024, 1024, D8{(unsigned char*)p.out}); }
#undef PH
#undef SEAM
}

extern "C" void kernel_launch(void* const* d_in, const int* in_sizes, int n_in, void* d_out, int out_size, void* d_ws, size_t ws_size, hipStream_t stream) {
    static int grid = 0;
    if (grid == 0) {
        if (n_in != 18 || out_size != T * DM || ws_size < WS_END) { fprintf(stderr, "kernel_launch: unexpected shapes (n_in %d out %d ws %zu)\n", n_in, out_size, ws_size); grid = -1; return; }
        if (hipFuncSetAttribute((const void*)k_fwd, hipFuncAttributeMaxDynamicSharedMemorySize, LDS_BYTES) != hipSuccess) { fprintf(stderr, "kernel_launch: hipFuncSetAttribute failed\n"); grid = -1; return; }
        grid = 256;
    }
    if (grid < 0) return;
    (void)hipMemsetAsync((char*)d_ws + OFF_CTL, 0, 16384, stream);
    P p{};
    p.x = (const float*)d_in[0]; p.e_norm = (const float*)d_in[1]; p.e_w_in = (const float*)d_in[2]; p.e_conv = (const float*)d_in[3]; p.e_b_if = (const float*)d_in[4];
    p.e_g_head = (const float*)d_in[5]; p.e_w_pool = (const float*)d_in[6]; p.e_s_pool = (const float*)d_in[7]; p.e_w_out = (const float*)d_in[8];
    p.o_norm = (const float*)d_in[9]; p.o_w_in = (const float*)d_in[10]; p.o_g_kv = (const float*)d_in[11]; p.o_w_uk = (const float*)d_in[12]; p.o_w_uv = (const float*)d_in[13];
    p.o_g_q = (const float*)d_in[14]; p.o_g_k = (const float*)d_in[15]; p.o_w_out = (const float*)d_in[16]; p.rel_bias = (const float*)d_in[17];
    p.out = (float*)d_out; p.ws = (unsigned char*)d_ws;
    hipLaunchKernelGGL(k_fwd, dim3(grid), dim3(512), LDS_BYTES, stream, p, 0, NPH);
}
```

```cpp
#include <hip/hip_runtime.h>
#include <stdint.h>
#include <cstdio>

typedef unsigned short bf16_t;
typedef short bf16x8 __attribute__((ext_vector_type(8)));
typedef float f32x4 __attribute__((ext_vector_type(4)));
typedef unsigned u32x4 __attribute__((ext_vector_type(4)));
typedef unsigned u32x2 __attribute__((ext_vector_type(2)));
typedef short v4i16_t __attribute__((ext_vector_type(4)));
#define LAS __attribute__((address_space(3)))

constexpr int T = 32768, SEQ = 16384, DM = 1024;
constexpr int EIN = 7176, OIN = 2628;
constexpr float EPS = 1e-6f;
constexpr size_t MB = 1048576;
constexpr size_t OFF_CTL = 0;
constexpr size_t OFF_GATES = 64 * 1024;
constexpr size_t OFF_BQ = OFF_GATES + (size_t)T * 8 * 4;
constexpr size_t OFF_IQ = OFF_BQ + (size_t)T * 4 * 4;
constexpr size_t OFF_MT = OFF_IQ + (size_t)T * 4 * 4;
constexpr size_t OFF_WI = OFF_MT + (size_t)T * 4 * 4;
constexpr size_t OFF_CH = OFF_WI + (size_t)T * 4 * 4;
constexpr size_t OFF_NS = OFF_CH + 64 * 1024;
constexpr size_t OFF_W = 4 * MB;
constexpr size_t OFF_W0T = OFF_W;
constexpr size_t OFF_WPT = OFF_W0T + (size_t)7168 * 1024 * 2;
constexpr size_t OFF_WO0T = OFF_WPT + (size_t)4 * 256 * 256 * 2;
constexpr size_t OFF_W1T = OFF_WO0T + (size_t)1024 * 2048 * 2;
constexpr size_t OFF_WUKT = OFF_W1T + (size_t)2816 * 1024 * 2;
constexpr size_t OFF_WUVT = OFF_WUKT + (size_t)1024 * 256 * 2;
constexpr size_t OFF_WO1T = OFF_WUVT + (size_t)1024 * 256 * 2;
constexpr size_t OFF_WUKP = OFF_WO1T + (size_t)1024 * 1024 * 2;
constexpr size_t OFF_WQP = OFF_WUKP + (size_t)1024 * 256 * 2;
constexpr size_t OFF_WUB = OFF_WQP + (size_t)16 * 256 * 64 * 2;
constexpr size_t OFF_XN = 36 * MB, OFF_QB = 100 * MB, OFF_KB = 164 * MB, OFF_VB = 228 * MB, OFF_TMP = 292 * MB, OFF_Y = 356 * MB;
constexpr size_t OFF_QP = 36 * MB;
constexpr size_t OFF_CKVN = OFF_Y;
constexpr size_t OFF_QI = OFF_Y + 16 * MB;
constexpr size_t OFF_KI = OFF_Y + 32 * MB;
constexpr size_t OFF_KIT = OFF_Y + 36 * MB;
constexpr size_t OFF_IDX = OFF_Y + 40 * MB;
constexpr size_t OFF_RK = OFF_Y + 58 * MB;
constexpr size_t OFF_CNT = OFF_Y + 59 * MB;
constexpr size_t OFF_Z = OFF_Y + 60 * MB;
constexpr size_t OFF_WBD = 484 * MB;
constexpr size_t OFF_WQF = 486 * MB;
constexpr size_t WS_END = 487 * MB;
constexpr int LDS_BYTES = 151552;
constexpr int NPH = 17;

struct P {
    const float *x, *e_norm, *e_w_in, *e_conv, *e_b_if, *e_g_head, *e_w_pool, *e_s_pool, *e_w_out;
    const float *o_norm, *o_w_in, *o_g_kv, *o_w_uk, *o_w_uv, *o_g_q, *o_g_k, *o_w_out, *rel_bias;
    float* out; unsigned char* ws;
};

__device__ __forceinline__ bf16_t f2bf(float f) { unsigned u = __float_as_uint(f); u += 0x7FFFu + ((u >> 16) & 1u); return (bf16_t)(u >> 16); }
__device__ __forceinline__ float bf2f(bf16_t b) { return __uint_as_float(((unsigned)b) << 16); }
__device__ __forceinline__ float bflo(unsigned w) { return __uint_as_float(w << 16); }
__device__ __forceinline__ float bfhi(unsigned w) { return __uint_as_float(w & 0xffff0000u); }
__device__ __forceinline__ unsigned pk2(float a, float b) { return (unsigned)f2bf(a) | ((unsigned)f2bf(b) << 16); }
__device__ __forceinline__ float sigmoidf_(float x) { return __builtin_amdgcn_rcpf(1.0f + __expf(-x)); }
__device__ __forceinline__ float siluf_(float x) { return x * __builtin_amdgcn_rcpf(1.0f + __expf(-x)); }
__device__ __forceinline__ float wave_sum(float v) {
#pragma unroll
    for (int o = 32; o >= 1; o >>= 1) v += __shfl_xor(v, o);
    return v;
}
__device__ __forceinline__ float wave_max(float v) {
#pragma unroll
    for (int o = 32; o >= 1; o >>= 1) v = fmaxf(v, __shfl_xor(v, o));
    return v;
}

#define XB_TMO      128
#define XB_XCNT(j)  (256  + 64 * (j))
#define XB_XSUB(j)  (1280 + 64 * (j))
#define XB_XGEN(j)  (2304 + 64 * (j))
#define XB_TOP      3328
#define XB_TOPGEN   3392
#define XCD_BAR_WORDS 3456
#define XB_SPIN_CAP (1u << 22)
__device__ __forceinline__ unsigned xb_ld(unsigned* p)              { return __hip_atomic_load(p, __ATOMIC_RELAXED, __HIP_MEMORY_SCOPE_AGENT); }
__device__ __forceinline__ unsigned xb_add(unsigned* p, unsigned v) { return __hip_atomic_fetch_add(p, v, __ATOMIC_RELAXED, __HIP_MEMORY_SCOPE_AGENT); }
__device__ __forceinline__ unsigned xb_xcc_id() { return (unsigned)__builtin_amdgcn_s_getreg((3 << 11) | 20) & 0xFu; }
#define XB_SPIN(cond, bar) do { unsigned _sp = 0; while (cond) { __builtin_amdgcn_s_sleep(1); \
    if ((++_sp & 255u) == 0u) { if (xb_ld(&(bar)[XB_TMO])) break; if (_sp > XB_SPIN_CAP) { atomicAdd(&(bar)[XB_TMO], 1u); break; } } } } while (0)
struct XcdBarrier { unsigned* bar; unsigned x; volatile LAS unsigned* st; };
__device__ __forceinline__ XcdBarrier xcd_barrier_post(unsigned* bar, volatile LAS unsigned* st) {
    XcdBarrier b; b.bar = bar; b.x = xb_xcc_id(); b.st = st;
    if (threadIdx.x == 0) (void)xb_add(&bar[XB_XCNT(b.x)], 1u);
    return b;
}
__device__ __forceinline__ void xcd_barrier_complete(unsigned* bar, unsigned x, unsigned& nloc, unsigned& nx) {
    const unsigned G = gridDim.x * gridDim.y * gridDim.z;
    unsigned sum, cnt, mine, sp = 0u;
    for (;;) {
        sum = 0u; cnt = 0u; mine = 0u;
#pragma unroll
        for (unsigned j = 0; j < 16; ++j) { const unsigned c = xb_ld(&bar[XB_XCNT(j)]); sum += c; cnt += (c > 0u) ? 1u : 0u; mine = (j == x) ? c : mine; }
        if (sum == G) break;
        __builtin_amdgcn_s_sleep(1);
        if ((++sp & 255u) == 0u) { if (xb_ld(&bar[XB_TMO])) break; if (sp > XB_SPIN_CAP) { atomicAdd(&bar[XB_TMO], 1u); break; } }
    }
    nloc = mine > 0u ? mine : 1u; nx = cnt > 0u ? cnt : 1u;
}
__device__ __forceinline__ void xcd_barrier(const XcdBarrier& b) {
    asm volatile("s_waitcnt vmcnt(0)" ::: "memory");
    __syncthreads();
    if (threadIdx.x == 0) {
        unsigned* bar = b.bar;
        __builtin_amdgcn_s_waitcnt(0);
        unsigned nloc = b.st[0], nx = b.st[1];
        if (nloc == 0u) { xcd_barrier_complete(bar, b.x, nloc, nx); b.st[0] = nloc; b.st[1] = nx; }
        const unsigned old = xb_add(&bar[XB_XSUB(b.x)], 1u);
        const unsigned gen = old / nloc;
        if (old + 1u == (gen + 1u) * nloc) {
            __builtin_amdgcn_fence(__ATOMIC_RELEASE, "agent");
            asm volatile("s_waitcnt vmcnt(0)" ::: "memory");
            const unsigned og = xb_add(&bar[XB_TOP], 1u);
            const unsigned tg = og / nx;
            if (og + 1u == (tg + 1u) * nx) xb_add(&bar[XB_TOPGEN], 1u);
            else XB_SPIN(xb_ld(&bar[XB_TOPGEN]) == tg, bar);
            __builtin_amdgcn_fence(__ATOMIC_ACQUIRE, "agent");
            xb_add(&bar[XB_XGEN(b.x)], 1u);
            asm volatile("s_waitcnt vmcnt(0)" ::: "memory");
        } else {
            XB_SPIN(xb_ld(&bar[XB_XGEN(b.x)]) == gen, bar);
            __builtin_amdgcn_fence(__ATOMIC_ACQUIRE, "agent");
            asm volatile("s_waitcnt vmcnt(0)" ::: "memory");
        }
    }
    __syncthreads();
}

struct Tile { const bf16_t* A; const bf16_t* B; int lda, ldb, K; void* d0; const void* s0; int ld; };
template <class F>
__device__ __forceinline__ void sgemm(const F f, int nunits) {
    const int lane = threadIdx.x & 63, wave = threadIdx.x >> 6, fr = lane & 15, fq = lane >> 4;
    for (int u = blockIdx.x * 8 + wave; u < nunits; u += gridDim.x * 8) {
        Tile tl; f.tile(u, tl);
        f32x4 acc[4][4];
#pragma unroll
        for (int m = 0; m < 4; ++m)
#pragma unroll
            for (int n = 0; n < 4; ++n) acc[m][n] = (f32x4){0.f, 0.f, 0.f, 0.f};
        const bf16_t* ap = tl.A + (size_t)fr * tl.lda + fq * 8;
        const bf16_t* bp = tl.B + (size_t)fr * tl.ldb + fq * 8;
        const int K = tl.K, lda = tl.lda, ldb = tl.ldb;
        bf16x8 a[4], b[4];
#pragma unroll
        for (int m = 0; m < 4; ++m) a[m] = *(const bf16x8*)(ap + (size_t)(m * 16) * lda);
#pragma unroll
        for (int n = 0; n < 4; ++n) b[n] = *(const bf16x8*)(bp + (size_t)(n * 16) * ldb);
#pragma unroll 1
        for (int k0 = 0; k0 < K; k0 += 32) {
            bf16x8 an[4], bn[4]; const int kn = (k0 + 32 < K) ? k0 + 32 : k0;
#pragma unroll
            for (int m = 0; m < 4; ++m) an[m] = *(const bf16x8*)(ap + (size_t)(m * 16) * lda + kn);
#pragma unroll
            for (int n = 0; n < 4; ++n) bn[n] = *(const bf16x8*)(bp + (size_t)(n * 16) * ldb + kn);
#pragma unroll
            for (int m = 0; m < 4; ++m)
#pragma unroll
                for (int n = 0; n < 4; ++n) acc[m][n] = __builtin_amdgcn_mfma_f32_16x16x32_bf16(b[n], a[m], acc[m][n], 0, 0, 0);
#pragma unroll
            for (int m = 0; m < 4; ++m) { a[m] = an[m]; b[m] = bn[m]; }
        }
#pragma unroll
        for (int m = 0; m < 4; ++m) {
            asm volatile("" ::: "memory");
#pragma unroll
            for (int n = 0; n < 4; ++n) f.out4(tl, m * 16 + fr, n * 16 + 4 * fq, acc[m][n]);
        }
    }
}
__device__ __forceinline__ void store4_bf16(const Tile& tl, int r, int c, const f32x4 v) {
    u32x2 w; w.x = pk2(v[0], v[1]); w.y = pk2(v[2], v[3]); *(u32x2*)((bf16_t*)tl.d0 + (size_t)r * tl.ld + c) = w; }

struct GWP {
    const bf16_t* WPT; const bf16_t* WUB; bf16_t* W0T;
    __device__ __forceinline__ void tile(int u, Tile& tl) const {
        const int kt = u & 15, dt = (u >> 4) & 3, g = u >> 6; tl.A = WPT + (size_t)(g * 256 + dt * 64) * 256; tl.lda = 256; tl.B = WUB + (size_t)kt * 64 * 1024 + g * 256; tl.ldb = 1024; tl.K = 256;
        tl.d0 = W0T + (size_t)(5120 + g * 256 + dt * 64) * 1024 + kt * 64; tl.ld = 1024; }
    __device__ __forceinline__ void out4(const Tile& tl, int r, int c, const f32x4 v) const { store4_bf16(tl, r, c, v); }
};
struct GQP {
    const bf16_t* Qn; const bf16_t* W; bf16_t* QP;
    __device__ __forceinline__ void tile(int u, Tile& tl) const {
        const int nt = u & 3, head = (u >> 2) & 15, mt = u >> 6; tl.A = Qn + (size_t)mt * 64 * 1024 + head * 64; tl.lda = 1024; tl.B = W + (size_t)(head * 256 + nt * 64) * 64; tl.ldb = 64; tl.K = 64;
        tl.d0 = QP + ((size_t)mt * 64 * 16 + head) * 256 + nt * 64; tl.ld = 4096; }
    __device__ __forceinline__ void out4(const Tile& tl, int r, int c, const f32x4 v) const { store4_bf16(tl, r, c, v); }
};
struct GOP {
    const bf16_t* OP; const bf16_t* W; const bf16_t* Z; bf16_t* G;
    __device__ __forceinline__ void tile(int u, Tile& tl) const {
        const int head = u & 15, mt = u >> 4; tl.A = OP + (size_t)mt * 64 * 4096 + head * 256; tl.lda = 4096; tl.B = W + (size_t)head * 64 * 256; tl.ldb = 256; tl.K = 256;
        const size_t o = (size_t)mt * 64 * 1024 + head * 64; tl.d0 = G + o; tl.s0 = Z + o; tl.ld = 1024; }
    __device__ __forceinline__ void out4(const Tile& tl, int r, int c, const f32x4 v) const { const size_t i = (size_t)r * 1024 + c; const u32x2 z = *(const u32x2*)((const bf16_t*)tl.s0 + i);
        u32x2 w; w.x = pk2(v[0] * bflo(z.x), v[1] * bfhi(z.x)); w.y = pk2(v[2] * bflo(z.y), v[3] * bfhi(z.y)); *(u32x2*)((bf16_t*)tl.d0 + i) = w; }
};

namespace pg8 {
constexpr int BM = 256, BK = 64, HALF = 128, HTB = HALF * BK * 2, STAGE_BYTES = 8 * HTB, NXCD = 8, WGM = 8;
__device__ __forceinline__ int lds_byte(int r, int c) { const int st = (r >> 4) * 2 + (c >> 5), rr = r & 15, cc = c & 31, ob = rr * 64 + cc * 2; return st * 1024 + (ob ^ (((ob >> 9) & 1) << 5)); }
__device__ __forceinline__ void stage_rc(int b, int& R, int& C) { const int st = b / 1024, sb = b % 1024, swz = sb ^ (((sb >> 9) & 1) << 5); R = (st >> 1) * 16 + swz / 64; C = (st & 1) * 32 + (swz % 64) / 2; }
__device__ __forceinline__ int perm32(int rho) { const int n = rho >> 4, i = rho & 15; return 8 * (i >> 2) + 4 * n + (i & 3); }
struct Unit { int pm, pn; };
struct Gemm { const bf16_t* A; int lda; const bf16_t* Bt; int ldb; int M, N, K; size_t apn; };
struct StaticOrder {
    int nM, nN, nwg, G, c;
    __device__ void init(int M, int N, int G_, int c_) { nM = M / BM; nN = N / BM; nwg = nM * nN; G = G_; c = c_; }
    __device__ bool next(int i, Unit& u) const {
        const long L = (long)i * G + c; if (L >= nwg) return false;
        int wgid = (int)L; { const int q = nwg / NXCD, r = nwg % NXCD, xcd = wgid % NXCD, off = wgid / NXCD; wgid = (xcd < r ? xcd * (q + 1) : r * (q + 1) + (xcd - r) * q) + off; }
        const int nig = WGM * nN, gid = wgid / nig, fm = gid * WGM, gsz = (nM - fm) < WGM ? (nM - fm) : WGM;
        u.pm = fm + ((wgid % nig) % gsz); u.pn = (wgid % nig) / gsz; return true;
    }
};
__device__ __forceinline__ unsigned cvt_pk_bf16(float lo, float hi) { unsigned r; asm volatile("v_cvt_pk_bf16_f32 %0, %1, %2" : "=v"(r) : "v"(lo), "v"(hi)); return r; }

struct Dst { unsigned char* base; const float* res; int ld, mode, ncol; float scale; };
template <class DescF> struct EpiGen {
    static constexpr bool PERM = true;
    DescF D;
    __device__ __forceinline__ void operator()(const f32x4 (&acc)[2][2][4][2], const Unit& u, int wr, int wc, int fr, int fq) const {
        Dst d; D.get(u, d);
        if ((DescF::MODES & 16) && d.mode == 4) return;
        const int r0 = wr * 64 + fr, c0 = wc * 32 + 8 * fq;
        if constexpr ((DescF::MODES & 64) != 0) {
#pragma unroll
            for (int ai = 0; ai < 2; ++ai)
#pragma unroll
                for (int m = 0; m < 4; ++m) {
                    float ss = 0.f;
#pragma unroll
                    for (int bj = 0; bj < 2; ++bj)
#pragma unroll
                        for (int n = 0; n < 2; ++n) { const f32x4 v = acc[ai][bj][m][n]; ss += v[0] * v[0] + v[1] * v[1] + v[2] * v[2] + v[3] * v[3]; }
                    ss += __shfl_xor(ss, 16); ss += __shfl_xor(ss, 32);
                    if (fq == 0) ((bf16_t*)d.base)[(size_t)(ai * HALF + r0 + m * 16) * d.ld + wc] = f2bf(rsqrtf(ss * (1.0f / 64.0f) + EPS));
                }
            return;
        } else {
#pragma unroll
        for (int ai = 0; ai < 2; ++ai)
#pragma unroll
            for (int m = 0; m < 4; ++m) {
                const size_t rowoff = (size_t)(ai * HALF + r0 + m * 16) * d.ld;
#pragma unroll
                for (int bj = 0; bj < 2; ++bj) {
                    const int col = bj * HALF + c0; f32x4 v0 = acc[ai][bj][m][0], v1 = acc[ai][bj][m][1];
                    if ((DescF::MODES & 7) && d.mode <= 2) {
                        if ((DescF::MODES & 2) && d.mode == 1) {
#pragma unroll
                            for (int j = 0; j < 4; ++j) { v0[j] = sigmoidf_(v0[j]); v1[j] = sigmoidf_(v1[j]); } }
                        if ((DescF::MODES & 4) && d.mode == 2) {
#pragma unroll
                            for (int j = 0; j < 4; ++j) { v0[j] = siluf_(v0[j]); v1[j] = siluf_(v1[j]); } }
                        u32x4 w; w.x = cvt_pk_bf16(v0[0], v0[1]); w.y = cvt_pk_bf16(v0[2], v0[3]); w.z = cvt_pk_bf16(v1[0], v1[1]); w.w = cvt_pk_bf16(v1[2], v1[3]);
                        *(u32x4*)((bf16_t*)d.base + rowoff + col) = w;
                    } else if ((DescF::MODES & 256) && d.mode == 8) {
                        const u32x4 z = *(const u32x4*)((const bf16_t*)d.res + rowoff + col);
                        u32x4 w; w.x = cvt_pk_bf16(v0[0] * bflo(z.x), v0[1] * bfhi(z.x)); w.y = cvt_pk_bf16(v0[2] * bflo(z.y), v0[3] * bfhi(z.y));
                        w.z = cvt_pk_bf16(v1[0] * bflo(z.z), v1[1] * bfhi(z.z)); w.w = cvt_pk_bf16(v1[2] * bflo(z.w), v1[3] * bfhi(z.w));
                        *(u32x4*)((bf16_t*)d.base + rowoff + col) = w;
                    } else if ((DescF::MODES & 8) && d.mode == 3) {
                        if (col < d.ncol) { float* o = (float*)d.base + rowoff + col; *(f32x4*)o = v0 * d.scale; *(f32x4*)(o + 4) = v1 * d.scale; }
                    } else if ((DescF::MODES & 128) && d.mode == 7) {
                        typedef _Float16 h8 __attribute__((ext_vector_type(8)));
                        if (col < d.ncol) {
                        h8 hv; hv[0] = (_Float16)(v0[0] * d.scale); hv[1] = (_Float16)(v0[1] * d.scale); hv[2] = (_Float16)(v0[2] * d.scale); hv[3] = (_Float16)(v0[3] * d.scale);
                        hv[4] = (_Float16)(v1[0] * d.scale); hv[5] = (_Float16)(v1[1] * d.scale); hv[6] = (_Float16)(v1[2] * d.scale); hv[7] = (_Float16)(v1[3] * d.scale);
                        *(h8*)((_Float16*)d.base + rowoff + col) = hv; }
                    } else if constexpr ((DescF::MODES & 32) != 0) {
                        float* o = (float*)d.base + rowoff + col; const float* rs = d.res + rowoff + col;
                        const f32x4 a = *(const f32x4*)rs, b = *(const f32x4*)(rs + 4); *(f32x4*)o = a + v0; *(f32x4*)(o + 4) = b + v1;
                    }
                }
                if (m & 1) asm volatile("" ::: "memory");
            }
        }
    }
};

template <class Epi>
__device__ __forceinline__ void gemm_phase(LAS unsigned char* lds, const Gemm g, const StaticOrder& S, const Epi& E) {
    const int tid = threadIdx.x, wid = __builtin_amdgcn_readfirstlane(tid >> 6), lane = tid & 63, wr = wid >> 2, wc = wid & 3, fr = lane & 15, fq = lane >> 4;
    int K = g.K; asm volatile("" : "+s"(K));
    const int nt = K / BK;
    unsigned voffA[2], voffB[2];
#pragma unroll
    for (int i = 0; i < 2; ++i) { int R, C; stage_rc(tid * 16 + i * 8192, R, C); const int Rb = Epi::PERM ? ((R & ~31) + perm32(R & 31)) : R;
        voffA[i] = (unsigned)(R * g.lda + C) * 2u; voffB[i] = (unsigned)(Rb * g.ldb + C) * 2u; }
    const size_t kstep = (size_t)(BK * 2);
    const size_t hstepA = (size_t)HALF * g.lda * 2, hstepB = (size_t)HALF * g.ldb * 2;
    const size_t tstepA = 2 * hstepA, tstepB = 2 * hstepB;
    const unsigned ldsw = (unsigned)wid * 1024u;
    const int aoff = lds_byte(wr * 64 + fr, fq * 8), boff = lds_byte(wc * 32 + fr, fq * 8);
#define PG8_SA(b, h) (((b) * 2 + (h)) * HTB)
#define PG8_SB(b, h) ((4 + (b) * 2 + (h)) * HTB)
#define PG8_STAGE(bufoff, gbase, voff) do { _Pragma("unroll") for (int _i = 0; _i < 2; ++_i) \
        __builtin_amdgcn_global_load_lds((const unsigned*)((const char*)(gbase) + (voff)[_i]), (LAS unsigned*)(lds + (bufoff) + ldsw + _i * 8192), 16, 0, 0); } while (0)
#define PG8_LDA(dst, b, h) do { _Pragma("unroll") for (int m = 0; m < 4; ++m) _Pragma("unroll") for (int k = 0; k < 2; ++k) dst[m][k] = *(const LAS bf16x8*)(lds + PG8_SA(b, h) + aoff + m * 2048 + k * 1024); } while (0)
#define PG8_LDB(dst, b, h) do { _Pragma("unroll") for (int n = 0; n < 2; ++n) _Pragma("unroll") for (int k = 0; k < 2; ++k) dst[n][k] = *(const LAS bf16x8*)(lds + PG8_SB(b, h) + boff + n * 2048 + k * 1024); } while (0)
#define PG8_MMA(ai, bj, At, Bt) do { __builtin_amdgcn_s_setprio(1); _Pragma("unroll") for (int m = 0; m < 4; ++m) _Pragma("unroll") for (int n = 0; n < 2; ++n) _Pragma("unroll") for (int k = 0; k < 2; ++k) \
        acc[ai][bj][m][n] = __builtin_amdgcn_mfma_f32_16x16x32_bf16(Bt[n][k], At[m][k], acc[ai][bj][m][n], 0, 0, 0); __builtin_amdgcn_s_setprio(0); } while (0)
#define PG8_WAIT_V(n) asm volatile("s_waitcnt vmcnt(" #n ")" ::: "memory")
#define PG8_WAIT_L(n) asm volatile("s_waitcnt lgkmcnt(" #n ")" ::: "memory")
#define PG8_BAR __builtin_amdgcn_s_barrier()
#define PG8_SCHED __builtin_amdgcn_sched_barrier(0)
    Unit cur, nxt; int ui = 0;
    if (!S.next(0, cur)) return;
    f32x4 acc[2][2][4][2];
#pragma unroll
    for (int a = 0; a < 2; ++a)
#pragma unroll
        for (int b = 0; b < 2; ++b)
#pragma unroll
            for (int m = 0; m < 4; ++m)
#pragma unroll
                for (int n = 0; n < 2; ++n) acc[a][b][m][n] = (f32x4){0.f, 0.f, 0.f, 0.f};
    bf16x8 At[4][2], B0[2][2], B1[2][2];
    const char* cA = (const char*)g.A + (size_t)cur.pm * tstepA + (size_t)cur.pn * g.apn; const char* cB = (const char*)g.Bt + (size_t)cur.pn * tstepB;
    PG8_STAGE(PG8_SB(0, 0), cB, voffB); PG8_STAGE(PG8_SA(0, 0), cA, voffA); PG8_STAGE(PG8_SB(0, 1), cB + hstepB, voffB); PG8_STAGE(PG8_SA(0, 1), cA + hstepA, voffA);
    if (wr == 1) PG8_BAR;
    PG8_WAIT_V(4); PG8_BAR;
    PG8_STAGE(PG8_SB(1, 0), cB + kstep, voffB); PG8_STAGE(PG8_SA(1, 0), cA + kstep, voffA); PG8_STAGE(PG8_SB(1, 1), cB + hstepB + kstep, voffB);
    PG8_WAIT_V(6); PG8_BAR;
    for (;;) {
        const bool has_next = S.next(ui + 1, nxt);
        const char* nA = has_next ? (const char*)g.A + (size_t)nxt.pm * tstepA + (size_t)nxt.pn * g.apn : cA; const char* nB = has_next ? (const char*)g.Bt + (size_t)nxt.pn * tstepB : cB;
#pragma unroll 1
        for (int t = 0; t < nt; t += 2) {
            const bool last = (t == nt - 2);
            const char* a1 = cA + (size_t)(t + 1) * kstep;
            const char* a2 = last ? nA : cA + (size_t)(t + 2) * kstep; const char* b2 = last ? nB : cB + (size_t)(t + 2) * kstep;
            const char* a3 = a2 + kstep; const char* b3 = b2 + kstep;
            PG8_LDB(B0, 0, 0); PG8_SCHED; PG8_LDA(At, 0, 0); PG8_STAGE(PG8_SA(1, 1), a1 + hstepA, voffA);
            PG8_WAIT_L(8); PG8_BAR; PG8_WAIT_L(0); PG8_MMA(0, 0, At, B0); PG8_BAR; PG8_SCHED;
            PG8_LDB(B1, 0, 1); PG8_STAGE(PG8_SB(0, 0), b2, voffB);
            PG8_BAR; PG8_WAIT_L(0); PG8_MMA(0, 1, At, B1); PG8_BAR;
            PG8_LDA(At, 0, 1); PG8_STAGE(PG8_SA(0, 0), a2, voffA);
            PG8_BAR; PG8_WAIT_L(0); PG8_MMA(1, 0, At, B0); PG8_BAR; PG8_SCHED;
            PG8_STAGE(PG8_SB(0, 1), b2 + hstepB, voffB);
            PG8_WAIT_V(6); PG8_BAR; PG8_MMA(1, 1, At, B1); PG8_BAR;
            PG8_LDB(B0, 1, 0); PG8_SCHED; PG8_LDA(At, 1, 0); PG8_STAGE(PG8_SA(0, 1), a2 + hstepA, voffA);
            PG8_WAIT_L(8); PG8_BAR; PG8_WAIT_L(0); PG8_MMA(0, 0, At, B0); PG8_BAR; PG8_SCHED;
            PG8_LDB(B1, 1, 1); PG8_STAGE(PG8_SB(1, 0), b3, voffB);
            PG8_BAR; PG8_WAIT_L(0); PG8_MMA(0, 1, At, B1); PG8_BAR;
            PG8_LDA(At, 1, 1); PG8_STAGE(PG8_SA(1, 0), a3, voffA);
            PG8_BAR; PG8_WAIT_L(0); PG8_MMA(1, 0, At, B0); PG8_BAR; PG8_SCHED;
            PG8_STAGE(PG8_SB(1, 1), b3 + hstepB, voffB);
            PG8_WAIT_V(6); PG8_BAR; PG8_MMA(1, 1, At, B1); PG8_BAR;
        }
        E(acc, cur, wr, wc, fr, fq);
        if (!has_next) break;
#pragma unroll
        for (int a = 0; a < 2; ++a)
#pragma unroll
            for (int b = 0; b < 2; ++b)
#pragma unroll
                for (int m = 0; m < 4; ++m)
#pragma unroll
                    for (int n = 0; n < 2; ++n) acc[a][b][m][n] = (f32x4){0.f, 0.f, 0.f, 0.f};
        cur = nxt; cA = nA; cB = nB; ++ui;
    }
    PG8_WAIT_V(0);
    if (wr == 0) PG8_BAR;
    PG8_BAR;
#undef PG8_SA
#undef PG8_SB
#undef PG8_STAGE
#undef PG8_LDA
#undef PG8_LDB
#undef PG8_MMA
#undef PG8_WAIT_V
#undef PG8_WAIT_L
#undef PG8_BAR
#undef PG8_SCHED
}
}

struct D1 { static constexpr int MODES = 1; unsigned char* ws;
    __device__ __forceinline__ void get(const pg8::Unit& u, pg8::Dst& d) const { const int sec = u.pn >> 2;
        d.base = ws + OFF_QB + (size_t)sec * (64 * MB) + ((size_t)u.pm * 256 * 1024 + (u.pn & 3) * 256) * 2; d.res = nullptr; d.ld = 1024; d.mode = 0; d.ncol = 256; d.scale = 1.f; } };
struct D2 { static constexpr int MODES = 7; unsigned char* ws;
    __device__ __forceinline__ void get(const pg8::Unit& u, pg8::Dst& d) const { const int sec = u.pn >> 2, cc = (u.pn & 3) * 256; d.res = nullptr; d.ncol = 256; d.scale = 1.f;
        if (sec < 3) { d.base = ws + OFF_QB + (size_t)sec * (64 * MB) + ((size_t)u.pm * 256 * 1024 + cc) * 2; d.ld = 1024; d.mode = sec == 0 ? 1 : (sec == 1 ? 2 : 0); }
        else { d.base = ws + OFF_Y + ((size_t)u.pm * 256 * 2048 + 1024 + cc) * 2; d.ld = 2048; d.mode = 2; } } };
struct D4 { static constexpr int MODES = 32; unsigned char* out; const float* x;
    __device__ __forceinline__ void get(const pg8::Unit& u, pg8::Dst& d) const { const size_t o = (size_t)u.pm * 256 * 1024 + u.pn * 256;
        d.base = out + o * 4; d.res = x + o; d.ld = 1024; d.mode = 5; d.ncol = 256; d.scale = 1.f; } };
struct D5 { static constexpr int MODES = 133; unsigned char* ws;
    __device__ __forceinline__ void get(const pg8::Unit& u, pg8::Dst& d) const { const int pn = u.pn; d.res = nullptr; d.ncol = 256; d.scale = 1.f;
        if (pn < 4) { d.base = ws + OFF_TMP + ((size_t)u.pm * 256 * 1024 + pn * 256) * 2; d.ld = 1024; d.mode = 0; }
        else if (pn == 4) { d.base = ws + OFF_CKVN + (size_t)u.pm * 256 * 256 * 2; d.ld = 256; d.mode = 0; }
        else if (pn == 5) { d.base = ws + OFF_QI + (size_t)u.pm * 256 * 256 * 2; d.ld = 256; d.mode = 7; d.scale = 0.125f; }
        else if (pn == 6) { d.base = ws + OFF_KI + (size_t)u.pm * 256 * 64 * 2; d.ld = 64; d.mode = 7; d.ncol = 64; }
        else { d.base = ws + OFF_Z + ((size_t)u.pm * 256 * 1024 + (pn - 7) * 256) * 2; d.ld = 1024; d.mode = 2; } } };
struct DK { static constexpr int MODES = 64; unsigned char* ws;
    __device__ __forceinline__ void get(const pg8::Unit& u, pg8::Dst& d) const {
        d.base = ws + OFF_RK + ((size_t)u.pm * 256 * 16 + u.pn * 4) * 2; d.res = nullptr; d.ld = 16; d.mode = 6; d.ncol = 256; d.scale = 1.f; } };
struct D8 { static constexpr int MODES = 32; unsigned char* out;
    __device__ __forceinline__ void get(const pg8::Unit& u, pg8::Dst& d) const { const size_t o = (size_t)u.pm * 256 * 1024 + u.pn * 256;
        d.base = out + o * 4; d.res = (const float*)out + o; d.ld = 1024; d.mode = 5; d.ncol = 256; d.scale = 1.f; } };
struct DQ { static constexpr int MODES = 1; unsigned char* ws;
    __device__ __forceinline__ void get(const pg8::Unit& u, pg8::Dst& d) const {
        d.base = ws + OFF_QP + ((size_t)u.pm * 256 * 4096 + u.pn * 256) * 2; d.res = nullptr; d.ld = 4096; d.mode = 0; d.ncol = 256; d.scale = 1.f; } };
struct DO { static constexpr int MODES = 256; unsigned char* ws;
    __device__ __forceinline__ void get(const pg8::Unit& u, pg8::Dst& d) const { const size_t o = ((size_t)u.pm * 256 * 1024 + u.pn * 256) * 2;
        d.base = ws + OFF_TMP + o; d.res = (const float*)(ws + OFF_Z + o); d.ld = 1024; d.mode = 8; d.ncol = 256; d.scale = 1.f; } };
template <class DF>
__device__ __forceinline__ void fast_gemm(unsigned char* lds, const bf16_t* A, int lda, const bf16_t* Bt, int ldb, int N, int K, const DF& df, size_t apn = 0) {
    pg8::Gemm g{A, lda, Bt, ldb, T, N, K, apn}; pg8::StaticOrder S; S.init(T, N, (int)gridDim.x, (int)blockIdx.x);
    pg8::EpiGen<DF> E{df};
    pg8::gemm_phase(( LAS unsigned char*)lds, g, S, E);
}

__device__ __forceinline__ void tconv(const float* __restrict__ src, int ld, int col0, int ncols, int K, bf16_t* __restrict__ dst, float* tile  ) {
    const int nkt = K / 64, ntiles = nkt * (ncols / 64), tid = threadIdx.x;
    for (int id = blockIdx.x; id < ntiles; id += gridDim.x) {
        const int kt = id % nkt, nt = id / nkt;
#pragma unroll
        for (int j = 0; j < 8; ++j) { const int e = tid + 512 * j, kk = e >> 6, nn = e & 63; tile[kk * 65 + nn] = src[(size_t)(kt * 64 + kk) * ld + col0 + nt * 64 + nn]; }
        __syncthreads();
#pragma unroll
        for (int j = 0; j < 8; ++j) { const int e = tid + 512 * j, nn = e >> 6, kk = e & 63; dst[(size_t)(nt * 64 + nn) * K + kt * 64 + kk] = f2bf(tile[kk * 65 + nn]); }
        __syncthreads();
    }
}
template <int NE>
__device__ __forceinline__ void rmsnorm_rows(const float* __restrict__ src, const float* __restrict__ g, bf16_t* __restrict__ dst,
                             const float* __restrict__ Wx, int ldw, int col0, const float* __restrict__ bias, float scale, float* __restrict__ dstx, float* wl) {
    const int lane = threadIdx.x & 63, wave = threadIdx.x >> 6;
    __syncthreads();
    for (int i = threadIdx.x; i < NE * 1024; i += 512) { const int k = i / NE, e = i % NE; wl[e * 1024 + k] = Wx[(size_t)k * ldw + col0 + e]; }
    __syncthreads();
    for (int row0 = (blockIdx.x * 8 + wave) * 2; row0 < T; row0 += gridDim.x * 16) {
        f32x4 v[2][4];
#pragma unroll
        for (int r = 0; r < 2; ++r)
#pragma unroll
            for (int i = 0; i < 4; ++i) v[r][i] = *(const f32x4*)(src + (size_t)(row0 + r) * 1024 + i * 256 + lane * 4);
#pragma unroll
        for (int r = 0; r < 2; ++r) {
            const int row = row0 + r; float ss = 0.f;
#pragma unroll
            for (int i = 0; i < 4; ++i) ss += v[r][i][0] * v[r][i][0] + v[r][i][1] * v[r][i][1] + v[r][i][2] * v[r][i][2] + v[r][i][3] * v[r][i][3];
            ss = wave_sum(ss);
            const float rstd = rsqrtf(ss * (1.0f / 1024.0f) + EPS);
            float ex[NE];
#pragma unroll
            for (int e = 0; e < NE; ++e) ex[e] = 0.f;
#pragma unroll
            for (int i = 0; i < 4; ++i) {
                const f32x4 gg = *(const f32x4*)(g + i * 256 + lane * 4);
                f32x4 y; y[0] = v[r][i][0] * rstd * gg[0]; y[1] = v[r][i][1] * rstd * gg[1]; y[2] = v[r][i][2] * rstd * gg[2]; y[3] = v[r][i][3] * rstd * gg[3];
                u32x2 w; w.x = pk2(y[0], y[1]); w.y = pk2(y[2], y[3]);
                *(u32x2*)(dst + (size_t)row * 1024 + i * 256 + lane * 4) = w;
#pragma unroll
                for (int e = 0; e < NE; ++e) { const f32x4 wv = *(const f32x4*)(wl + e * 1024 + i * 256 + lane * 4); ex[e] += y[0] * wv[0] + y[1] * wv[1] + y[2] * wv[2] + y[3] * wv[3]; }
            }
#pragma unroll
            for (int e = 0; e < NE; ++e) { const float sx = wave_sum(ex[e]); if (lane == 0) dstx[(size_t)row * NE + e] = (sx + (bias ? bias[e] : 0.f)) * scale; }
        }
    }
}

__device__ __forceinline__ void phase_prep(const P& p, unsigned char* lds) {
    float* tile = (float*)lds; unsigned char* ws = p.ws;
    bf16_t* W0T = (bf16_t*)(ws + OFF_W0T);
    tconv(p.e_w_in, EIN, 0, 5120, 1024, W0T, tile);
    tconv(p.e_w_in, EIN, 6152, 1024, 1024, W0T + (size_t)6144 * 1024, tile);
    for (int g = 0; g < 4; ++g) tconv(p.e_w_pool + (size_t)g * 65536, 256, 0, 256, 256, (bf16_t*)(ws + OFF_WPT) + (size_t)g * 65536, tile);
    { bf16_t* WUB = (bf16_t*)(ws + OFF_WUB);
      for (size_t i = (size_t)blockIdx.x * 512 + threadIdx.x; i < (size_t)1024 * 256; i += (size_t)gridDim.x * 512) {
          const size_t k = i >> 8; const int c4 = (int)(i & 255) * 4; const f32x4 v = *(const f32x4*)(p.e_w_in + k * EIN + 5128 + c4);
          u32x2 o; o.x = pk2(v[0], v[1]); o.y = pk2(v[2], v[3]); *(u32x2*)(WUB + k * 1024 + c4) = o; } }
    tconv(p.e_w_out, 1024, 0, 1024, 2048, (bf16_t*)(ws + OFF_WO0T), tile);
    bf16_t* W1T = (bf16_t*)(ws + OFF_W1T);
    tconv(p.o_w_in, OIN, 0, 1600, 1024, W1T, tile);
    for (size_t i = (size_t)blockIdx.x * 512 + threadIdx.x; i < (size_t)192 * 1024; i += (size_t)gridDim.x * 512) W1T[(size_t)1600 * 1024 + i] = 0;
    tconv(p.o_w_in, OIN, 1604, 1024, 1024, W1T + (size_t)1792 * 1024, tile);
    {
        bf16_t* WUKP = (bf16_t*)(ws + OFF_WUKP); bf16_t* WQF = (bf16_t*)(ws + OFF_WQF); bf16_t* WBD = (bf16_t*)(ws + OFF_WBD);
        for (size_t i = (size_t)blockIdx.x * 512 + threadIdx.x; i < (size_t)1024 * 256; i += (size_t)gridDim.x * 512) {
            { const int n = (int)(i >> 8), k = (int)(i & 255), pn = n >> 8, rem = n & 255, bj = rem >> 7, wc = (rem >> 5) & 3, x = rem & 31;
              WUKP[i] = f2bf(p.o_w_uk[(size_t)k * 1024 + (4 * pn + wc) * 64 + 32 * bj + x]); }
            { const int d = (int)(i & 63), r = (int)((i >> 6) & 255), h = (int)(i >> 14); const size_t o = ((size_t)h * 256 + r) * 128 + d;
              WQF[o] = f2bf(p.o_w_uk[(size_t)r * 1024 + h * 64 + d] * p.o_g_k[d] * 0.125f); WQF[o + 64] = 0; }
            { const int r = (int)(i & 255), n = (int)(i >> 8), hl = (n >> 6) & 3; const float v = p.o_w_uv[(size_t)r * 1024 + n];
#pragma unroll
              for (int b = 0; b < 4; ++b) WBD[(size_t)n * 1024 + b * 256 + r] = (b == hl) ? f2bf(v) : (bf16_t)0; }
        }
    }
    tconv(p.o_w_out, 1024, 0, 1024, 1024, (bf16_t*)(ws + OFF_WO1T), tile);
    rmsnorm_rows<8>(p.x, p.e_norm, (bf16_t*)(ws + OFF_XN), p.e_w_in, EIN, 5120, p.e_b_if, 1.0f, (float*)(ws + OFF_GATES), (float*)lds);
}

__device__ __forceinline__ void phase_conv_scan(const P& p, unsigned char* lds) {
    unsigned char* ws = p.ws; const int tid = threadIdx.x;
    const float* GATES = (const float*)(ws + OFF_GATES);
    float *BQ = (float*)(ws + OFF_BQ), *IQ = (float*)(ws + OFF_IQ), *MT = (float*)(ws + OFF_MT), *CH = (float*)(ws + OFF_CH);
    {
        const int lane = tid & 63, wave = tid >> 6;
        for (int task = blockIdx.x * 8 + wave; task < 2048; task += gridDim.x * 8) {
            const int bh = task >> 8, c = task & 255, batch = bh >> 2, head = bh & 3; const size_t t = (size_t)batch * SEQ + c * 64 + lane;
            const float ig = GATES[t * 8 + head], f = GATES[t * 8 + 4 + head];
            float b = fminf(f, 0.f) - log1pf(__expf(-fabsf(f)));
#pragma unroll
            for (int o = 1; o < 64; o <<= 1) { const float y = __shfl_up(b, o); if (lane >= o) b += y; }
            float rm = ig - b;
#pragma unroll
            for (int o = 1; o < 64; o <<= 1) { const float y = __shfl_up(rm, o); if (lane >= o) rm = fmaxf(rm, y); }
            BQ[t * 4 + head] = b; IQ[t * 4 + head] = ig; MT[t * 4 + head] = rm;
            if (lane == 63) { CH[4096 + bh * 256 + c] = b; CH[bh * 256 + c] = b + rm; }
        }
    }
    const bf16_t* QB = (const bf16_t*)(ws + OFF_QB); const bf16_t* KB = (const bf16_t*)(ws + OFF_KB);
    bf16_t* Y = (bf16_t*)(ws + OFF_Y); bf16_t* KT = (bf16_t*)(ws + OFF_TMP);
    for (size_t it = (size_t)blockIdx.x * 512 + tid; it < (size_t)(T / 8) * 256; it += (size_t)gridDim.x * 512) {
        const size_t t0 = (it >> 8) * 8; const int c0 = (int)(it & 255) * 8, isk = c0 >= 1024, cc = c0 & 1023; const int s0 = (int)(t0 & (SEQ - 1));
        const bf16_t* src = isk ? KB : QB;
        u32x4 rw[11];
#pragma unroll
        for (int j = 0; j < 11; ++j) rw[j] = (s0 - 3 + j >= 0) ? *(const u32x4*)(src + (t0 - 3 + j) * 1024 + cc) : (u32x4){0u, 0u, 0u, 0u};
        f32x4 cw[4][2];
#pragma unroll
        for (int j = 0; j < 4; ++j) { cw[j][0] = *(const f32x4*)(p.e_conv + j * 2048 + c0); cw[j][1] = *(const f32x4*)(p.e_conv + j * 2048 + c0 + 4); }
        const float sc = isk ? 0.0625f : 1.0f;
#pragma unroll
        for (int k = 0; k < 8; ++k) {
            float acc[8];
#pragma unroll
            for (int i = 0; i < 8; ++i) acc[i] = 0.f;
#pragma unroll
            for (int j = 0; j < 4; ++j) { const u32x4 w = rw[k + j];
                acc[0] += cw[j][0][0] * bflo(w.x); acc[1] += cw[j][0][1] * bfhi(w.x); acc[2] += cw[j][0][2] * bflo(w.y); acc[3] += cw[j][0][3] * bfhi(w.y);
                acc[4] += cw[j][1][0] * bflo(w.z); acc[5] += cw[j][1][1] * bfhi(w.z); acc[6] += cw[j][1][2] * bflo(w.w); acc[7] += cw[j][1][3] * bfhi(w.w); }
            u32x4 o; o.x = pk2(siluf_(acc[0]) * sc, siluf_(acc[1]) * sc); o.y = pk2(siluf_(acc[2]) * sc, siluf_(acc[3]) * sc);
            o.z = pk2(siluf_(acc[4]) * sc, siluf_(acc[5]) * sc); o.w = pk2(siluf_(acc[6]) * sc, siluf_(acc[7]) * sc);
            if (isk) *(u32x4*)(KT + (t0 + k) * 1024 + cc) = o; else *(u32x4*)(Y + (t0 + k) * 2048 + 1024 + cc) = o;
        }
    }
}

typedef float f32x16 __attribute__((ext_vector_type(16)));
constexpr int ML_RS = 528, ML_WS = 144;
__device__ __forceinline__ bf16x8 ml_tr8(const LAS unsigned char* a, int second_off) {
    const v4i16_t t0 = __builtin_amdgcn_ds_read_tr16_b64_v4i16((LAS v4i16_t*)a);
    const v4i16_t t1 = __builtin_amdgcn_ds_read_tr16_b64_v4i16((LAS v4i16_t*)(a + second_off));
    bf16x8 r; r[0] = t0[0]; r[1] = t0[1]; r[2] = t0[2]; r[3] = t0[3]; r[4] = t1[0]; r[5] = t1[1]; r[6] = t1[2]; r[7] = t1[3]; return r;
}
struct ChunkScan { f32x4 B, mp, mn; };
__device__ __forceinline__ ChunkScan chunk_scan_wave(const float* CH, int bh, int lane) {
    ChunkScan r; r.B = *(const f32x4*)(CH + 4096 + bh * 256 + 4 * lane); const f32x4 G = *(const f32x4*)(CH + bh * 256 + 4 * lane);
    float a = r.B[0], b = G[0];
#pragma unroll
    for (int j = 1; j < 4; ++j) { b = fmaxf(r.B[j] + b, G[j]); a += r.B[j]; }
#pragma unroll
    for (int o = 1; o < 64; o <<= 1) { const float a1 = __shfl_up(a, o), b1 = __shfl_up(b, o); if (lane >= o) { b = fmaxf(a + b1, b); a += a1; } }
    const float ap = __shfl_up(a, 1), bp = __shfl_up(b, 1);
    float m = lane ? fmaxf(ap, bp) : 0.f;
#pragma unroll
    for (int j = 0; j < 4; ++j) { r.mp[j] = m; m = fmaxf(r.B[j] + m, G[j]); r.mn[j] = m; }
    return r;
}
__device__ __forceinline__ void mlstm_chunk_scan(const float* CH, int bh, LAS float* sB, LAS float* sMp, LAS float* sMn) {
    const int tid = threadIdx.x;
    if (tid < 64) { const ChunkScan r = chunk_scan_wave(CH, bh, tid); *(LAS f32x4*)(sB + 4 * tid) = r.B; *(LAS f32x4*)(sMp + 4 * tid) = r.mp; *(LAS f32x4*)(sMn + 4 * tid) = r.mn; }
    __syncthreads();
}
template <bool FULL>
__device__ __forceinline__ void mlstm_units(const P& p, unsigned char* lds_) {
    unsigned char* ws = p.ws; const int tid0 = threadIdx.x;
    const int w = __builtin_amdgcn_readfirstlane(tid0 >> 6);
    const bf16_t* Yq = (const bf16_t*)(ws + OFF_Y); bf16_t* Yo = (bf16_t*)(ws + OFF_Y);
    const bf16_t* KT = (const bf16_t*)(ws + OFF_TMP); const bf16_t* VB = (const bf16_t*)(ws + OFF_VB);
    float* ST = (float*)(ws + OFF_QB); float* NS = (float*)(ws + OFF_NS);
    const float *BQ = (const float*)(ws + OFF_BQ), *IQ = (const float*)(ws + OFF_IQ), *MT = (const float*)(ws + OFF_MT), *CH = (const float*)(ws + OFF_CH);
    LAS unsigned char* Qs = (LAS unsigned char*)lds_;
    LAS unsigned char* Ks = Qs + 64 * ML_RS;
    LAS unsigned char* Vs = Ks + 64 * ML_RS;
    LAS unsigned char* Wl = Vs + 64 * ML_RS;
    LAS float* sa = (LAS float*)(Wl + 64 * ML_WS);
    LAS float* sden = sa + 64; LAS float* ssw = sden + 64; LAS float* sf = ssw + 64; LAS float* sg = sf + 64; LAS float* nd = sg + 64; LAS float* rden = nd + 64; LAS float* ns = rden + 64;
    LAS float* cB = ns + 256; LAS float* cMp = cB + 256; LAS float* cMn = cMp + 256;
    for (int unit = blockIdx.x; unit < 256; unit += gridDim.x) {
        const int bh = unit >> 5, S = unit & 31, batch = bh >> 2, head = bh & 3;
        const int tid = tid0, lane = tid0 & 63, hh = lane >> 5;
        __syncthreads();
        mlstm_chunk_scan(CH, bh, cB, cMp, cMn);
        f32x16 st[8]; float nreg = 0.f;
        if (FULL) {
#pragma unroll
            for (int kt = 0; kt < 8; ++kt) {
                int lz = lane; asm volatile("" : "+v"(lz) :: "memory");
                const float* sp = ST + (size_t)unit * 65536 + 32 * w + (lz & 31) + (size_t)(32 * kt + 4 * (lz >> 5)) * 256;
#pragma unroll
                for (int r = 0; r < 16; ++r) st[kt][r] = sp[((r & 3) + 8 * (r >> 2)) * 256];
            }
            if (tid < 256) nreg = NS[unit * 256 + tid];
        } else {
#pragma unroll
            for (int kt = 0; kt < 8; ++kt)
#pragma unroll
                for (int r = 0; r < 16; ++r) st[kt][r] = 0.f;
        }
#pragma unroll 1
        for (int cc = 0; cc < 8; ++cc) {
            int tid = tid0; asm volatile("" : "+v"(tid));
            const int lane = tid & 63, l31 = lane & 31, hh = lane >> 5, fr = lane & 15, fq = lane >> 4;
            const int trow = 8 * hh + (fr >> 2), tcol = (16 * (fq & 1) + 4 * (fr & 3)) * 2;
            const int ch = S * 8 + cc; const size_t t0 = (size_t)batch * SEQ + ch * 64;
            const float mprev = cMp[ch], mnew = cMn[ch], blast = cB[ch];
            const float decay = __expf(blast + mprev - mnew);
            __syncthreads();
#pragma unroll
            for (int j = 0; j < 4; ++j) { const int e = tid + 512 * j, r = e >> 5, cg = e & 31;
                *(LAS u32x4*)(Ks + r * ML_RS + cg * 16) = *(const u32x4*)(KT + (t0 + r) * 1024 + head * 256 + cg * 8);
                *(LAS u32x4*)(Vs + r * ML_RS + cg * 16) = *(const u32x4*)(VB + (t0 + r) * 1024 + head * 256 + cg * 8);
                if (FULL) *(LAS u32x4*)(Qs + r * ML_RS + cg * 16) = *(const u32x4*)(Yq + (t0 + r) * 2048 + 1024 + head * 256 + cg * 8); }
            if (tid < 64) { const float bq = BQ[(t0 + tid) * 4 + head], iq = IQ[(t0 + tid) * 4 + head], mt = bq + fmaxf(mprev, MT[(t0 + tid) * 4 + head]);
                sa[tid] = __expf(bq + mprev - mt); sden[tid] = __expf(-mt); ssw[tid] = __expf(blast - bq + iq - mnew); sf[tid] = bq - mt; sg[tid] = iq - bq; }
            if (FULL && tid < 256) ns[tid] = nreg;
            __syncthreads();
            bf16x8 bv[4];
            if (!FULL) {
#pragma unroll
                for (int ks = 0; ks < 4; ++ks) bv[ks] = ml_tr8(Vs + (16 * ks + trow) * ML_RS + 64 * w + tcol, 4 * ML_RS);
            }
            if (FULL) {
                { const int tt = w >> 1;
#pragma unroll
                  for (int si = 0; si < 2; ++si) { const int ss = 2 * (w & 1) + si;
                    f32x4 acc = (f32x4){0.f, 0.f, 0.f, 0.f};
                    if (ss <= tt) {
#pragma unroll
                        for (int ks = 0; ks < 8; ++ks) { const bf16x8 a = *(const LAS bf16x8*)(Qs + (16 * tt + fr) * ML_RS + (32 * ks + 8 * fq) * 2), b = *(const LAS bf16x8*)(Ks + (16 * ss + fr) * ML_RS + (32 * ks + 8 * fq) * 2);
                            acc = __builtin_amdgcn_mfma_f32_16x16x32_bf16(a, b, acc, 0, 0, 0); } }
                    const int sidx = 16 * ss + fr; const float gs = sg[sidx];
#pragma unroll
                    for (int j = 0; j < 4; ++j) { const int tix = 16 * tt + 4 * fq + j; const float wv = (sidx <= tix) ? __expf(sf[tix] + gs) * acc[j] : 0.f;
                        *(LAS bf16_t*)(Wl + tix * ML_WS + sidx * 2) = f2bf(wv); } } }
#pragma unroll
                for (int i = 0; i < 8; ++i) { const int tix = 8 * w + i; const u32x2 qv = *(const LAS u32x2*)(Qs + tix * ML_RS + lane * 8); const f32x4 nv = *(const LAS f32x4*)(ns + lane * 4);
                    float part = bflo(qv.x) * nv[0] + bfhi(qv.x) * nv[1] + bflo(qv.y) * nv[2] + bfhi(qv.y) * nv[3]; part = wave_sum(part); if (lane == 0) nd[tix] = part; }
                __syncthreads();
                f32x16 acc[2];
#pragma unroll
                for (int t2 = 0; t2 < 2; ++t2) {
#pragma unroll
                    for (int r = 0; r < 16; ++r) acc[t2][r] = 0.f;
                }
#pragma unroll
                for (int kt = 0; kt < 8; ++kt) {
                    asm volatile("" ::: "memory");
#pragma unroll
                    for (int s2 = 0; s2 < 2; ++s2) {
                        u32x4 bw; bw.x = pg8::cvt_pk_bf16(st[kt][8 * s2 + 0], st[kt][8 * s2 + 1]); bw.y = pg8::cvt_pk_bf16(st[kt][8 * s2 + 2], st[kt][8 * s2 + 3]);
                        bw.z = pg8::cvt_pk_bf16(st[kt][8 * s2 + 4], st[kt][8 * s2 + 5]); bw.w = pg8::cvt_pk_bf16(st[kt][8 * s2 + 6], st[kt][8 * s2 + 7]);
                        const bf16x8 bfrag = __builtin_bit_cast(bf16x8, bw);
#pragma unroll
                        for (int t2 = 0; t2 < 2; ++t2) { const LAS unsigned char* qa = Qs + (32 * t2 + l31) * ML_RS + (32 * kt + 16 * s2 + 4 * hh) * 2;
                            const u32x2 lo = *(const LAS u32x2*)qa, hi = *(const LAS u32x2*)(qa + 16); u32x4 aw; aw.x = lo.x; aw.y = lo.y; aw.z = hi.x; aw.w = hi.y;
                            acc[t2] = __builtin_amdgcn_mfma_f32_32x32x16_bf16(__builtin_bit_cast(bf16x8, aw), bfrag, acc[t2], 0, 0, 0); }
                    }
                }
                asm volatile("" ::: "memory");
#pragma unroll
                for (int t2 = 0; t2 < 2; ++t2)
#pragma unroll
                    for (int r = 0; r < 16; ++r) acc[t2][r] *= sa[32 * t2 + (r & 3) + 8 * (r >> 2) + 4 * hh];
#pragma unroll
                for (int ks = 0; ks < 4; ++ks) bv[ks] = ml_tr8(Vs + (16 * ks + trow) * ML_RS + 64 * w + tcol, 4 * ML_RS);
#pragma unroll
                for (int ks = 0; ks < 4; ++ks)
#pragma unroll
                    for (int t2 = 0; t2 < 2; ++t2) { const bf16x8 a = *(const LAS bf16x8*)(Wl + (32 * t2 + l31) * ML_WS + (16 * ks + 8 * hh) * 2);
                        acc[t2] = __builtin_amdgcn_mfma_f32_32x32x16_bf16(a, bv[ks], acc[t2], 0, 0, 0); }
#pragma unroll
                for (int i = 0; i < 8; ++i) { const int tix = 8 * w + i; float rs = bf2f(*(const LAS bf16_t*)(Wl + tix * ML_WS + lane * 2)); rs = wave_sum(rs);
                    if (lane == 0) { const float nq = sa[tix] * nd[tix] + rs; rden[tix] = 1.0f / fmaxf(fabsf(nq), sden[tix]); } }
                __syncthreads();
                bf16_t* yo = Yo + t0 * 2048 + head * 256 + 32 * w + l31;
#pragma unroll
                for (int t2 = 0; t2 < 2; ++t2)
#pragma unroll
                    for (int r = 0; r < 16; ++r) { const int tix = 32 * t2 + (r & 3) + 8 * (r >> 2) + 4 * hh; yo[(size_t)tix * 2048] = f2bf(acc[t2][r] * rden[tix]); }
            }
#pragma unroll
            for (int kt = 0; kt < 8; ++kt) st[kt] *= decay;
#pragma unroll
            for (int ks = 0; ks < 4; ++ks) {
                const u32x4 raw = __builtin_bit_cast(u32x4, bv[ks]); const LAS float* sw8 = ssw + 16 * ks + 8 * hh;
                u32x4 sc; sc.x = pg8::cvt_pk_bf16(bflo(raw.x) * sw8[0], bfhi(raw.x) * sw8[1]); sc.y = pg8::cvt_pk_bf16(bflo(raw.y) * sw8[2], bfhi(raw.y) * sw8[3]);
                sc.z = pg8::cvt_pk_bf16(bflo(raw.z) * sw8[4], bfhi(raw.z) * sw8[5]); sc.w = pg8::cvt_pk_bf16(bflo(raw.w) * sw8[6], bfhi(raw.w) * sw8[7]);
                const bf16x8 bs = __builtin_bit_cast(bf16x8, sc);
#pragma unroll
                for (int kt = 0; kt < 8; ++kt) { if ((kt & 3) == 0) asm volatile("" ::: "memory");
                    const bf16x8 a = ml_tr8(Ks + (16 * ks + trow) * ML_RS + 64 * kt + tcol, 4 * ML_RS);
                    st[kt] = __builtin_amdgcn_mfma_f32_32x32x16_bf16(a, bs, st[kt], 0, 0, 0); }
            }
            if (tid < 256) { float nacc = 0.f;
#pragma unroll 8
                for (int s2 = 0; s2 < 64; ++s2) nacc += ssw[s2] * bf2f(*(const LAS bf16_t*)(Ks + s2 * ML_RS + tid * 2));
                nreg = decay * nreg + nacc; }
        }
        if (!FULL) {
#pragma unroll
            for (int kt = 0; kt < 8; ++kt) {
                int lz = lane; asm volatile("" : "+v"(lz) :: "memory");
                float* sp = ST + (size_t)unit * 65536 + 32 * w + (lz & 31) + (size_t)(32 * kt + 4 * (lz >> 5)) * 256;
#pragma unroll
                for (int r = 0; r < 16; ++r) sp[((r & 3) + 8 * (r >> 2)) * 256] = st[kt][r];
            }
            if (tid < 256) NS[unit * 256 + tid] = nreg;
        }
    }
}
__device__ __forceinline__ void phase_mlstm_scan(const P& p, unsigned char* lds_) {
    unsigned char* ws = p.ws; const int tid = threadIdx.x, lane = tid & 63, wave = tid >> 6;
    float* ST = (float*)(ws + OFF_QB); float* NS = (float*)(ws + OFF_NS); const float* CH = (const float*)(ws + OFF_CH);
    LAS float* DS = (LAS float*)lds_;
    __syncthreads();
    {
        const ChunkScan r = chunk_scan_wave(CH, wave, lane);
        float d = 1.f;
#pragma unroll
        for (int j = 0; j < 4; ++j) d *= __expf(r.B[j] + r.mp[j] - r.mn[j]);
        const float dn = __shfl_down(d, 1);
        if (!(lane & 1)) DS[wave * 32 + (lane >> 1)] = d * dn;
    }
    __syncthreads();
    {
        const int it0 = blockIdx.x * 512 + tid;
        for (int it = it0; it < 8 * 16384; it += gridDim.x * 512) {
            const int bh = it >> 14; float* base = ST + (size_t)bh * 32 * 65536 + (size_t)(it & 16383) * 4;
            f32x4 carry = (f32x4){0.f, 0.f, 0.f, 0.f};
#pragma unroll
            for (int h = 0; h < 2; ++h) {
                f32x4 tmp[16];
#pragma unroll
                for (int S = 0; S < 16; ++S) tmp[S] = *(const f32x4*)(base + (size_t)(16 * h + S) * 65536);
#pragma unroll
                for (int S = 0; S < 16; ++S) { *(f32x4*)(base + (size_t)(16 * h + S) * 65536) = carry; carry = DS[bh * 32 + 16 * h + S] * carry + tmp[S]; }
            }
        }
        if (it0 < 8 * 256) {
            const int it = it0, bh = it >> 8; float* base = NS + (size_t)bh * 32 * 256 + (it & 255);
            float carry = 0.f;
#pragma unroll 8
            for (int S = 0; S < 32; ++S) { const float tmp = base[S * 256]; base[S * 256] = carry; carry = DS[bh * 32 + S] * carry + tmp; }
        }
    }
}

__device__ __forceinline__ void unpack8(const u32x4 w, float (&f)[8]) {
    f[0] = bflo(w.x); f[1] = bfhi(w.x); f[2] = bflo(w.y); f[3] = bfhi(w.y); f[4] = bflo(w.z); f[5] = bfhi(w.z); f[6] = bflo(w.w); f[7] = bfhi(w.w); }
template <int WIN>
__device__ __forceinline__ void pool_item(const bf16_t* __restrict__ U, bf16_t* __restrict__ Y, const float* __restrict__ s_pool, size_t t0, int s0, int c0) {
    constexpr int NR = WIN + 7;
    u32x4 rw[NR], z[8];
#pragma unroll
    for (int j = 0; j < NR; ++j) rw[j] = (s0 - (WIN - 1) + j >= 0) ? *(const u32x4*)(U + ((long)t0 + j - (WIN - 1)) * 1024 + c0) : (u32x4){0u, 0u, 0u, 0u};
#pragma unroll
    for (int k = 0; k < 8; ++k) z[k] = *(const u32x4*)(Y + (t0 + k) * 2048 + 1024 + c0);
    const f32x4 s0v = *(const f32x4*)(s_pool + c0), s1v = *(const f32x4*)(s_pool + c0 + 4);
    const float sp[8] = {s0v[0], s0v[1], s0v[2], s0v[3], s1v[0], s1v[1], s1v[2], s1v[3]};
    float S[8];
#pragma unroll
    for (int i = 0; i < 8; ++i) S[i] = 0.f;
#pragma unroll
    for (int j = 0; j < WIN - 1; ++j) { float f[8]; unpack8(rw[j], f);
#pragma unroll
        for (int i = 0; i < 8; ++i) S[i] += f[i]; }
#pragma unroll
    for (int k = 0; k < 8; ++k) {
        float self[8], zf[8]; unpack8(rw[k + WIN - 1], self); unpack8(z[k], zf);
#pragma unroll
        for (int i = 0; i < 8; ++i) S[i] += self[i];
        const int cnt = (s0 + k + 1 < WIN) ? s0 + k + 1 : WIN;
        const float inv = __builtin_amdgcn_rcpf((float)cnt);
        float o[8];
#pragma unroll
        for (int i = 0; i < 8; ++i) o[i] = (S[i] * inv - self[i]) * sp[i] * zf[i];
        u32x4 ow; ow.x = pk2(o[0], o[1]); ow.y = pk2(o[2], o[3]); ow.z = pk2(o[4], o[5]); ow.w = pk2(o[6], o[7]);
        *(u32x4*)(Y + (t0 + k) * 2048 + 1024 + c0) = ow;
        float old[8]; unpack8(rw[k], old);
#pragma unroll
        for (int i = 0; i < 8; ++i) S[i] -= old[i];
    }
}
__device__ __forceinline__ void phase_ya_pool(const P& p) {
    unsigned char* ws = p.ws; const int tid = threadIdx.x, lane = tid & 63, wave = tid >> 6;
    bf16_t* Y = (bf16_t*)(ws + OFF_Y); const bf16_t* O = (const bf16_t*)(ws + OFF_QB); const bf16_t* ZA = (const bf16_t*)(ws + OFF_KB);
    for (int tt = blockIdx.x * 8 + wave; tt < T; tt += gridDim.x * 8) {
        const size_t t = (size_t)tt; u32x2 hw[4], ow[4], zw[4];
#pragma unroll
        for (int head = 0; head < 4; ++head) { const int c = head * 256 + lane * 4;
            hw[head] = *(const u32x2*)(Y + t * 2048 + c); ow[head] = *(const u32x2*)(O + t * 1024 + c); zw[head] = *(const u32x2*)(ZA + t * 1024 + c); }
#pragma unroll
        for (int head = 0; head < 4; ++head) { const int c = head * 256 + lane * 4;
            float v[4] = {bflo(hw[head].x) * bflo(ow[head].x), bfhi(hw[head].x) * bfhi(ow[head].x), bflo(hw[head].y) * bflo(ow[head].y), bfhi(hw[head].y) * bfhi(ow[head].y)};
            const float ss = wave_sum(v[0] * v[0] + v[1] * v[1] + v[2] * v[2] + v[3] * v[3]);
            const float rstd = rsqrtf(ss * (1.0f / 256.0f) + EPS);
            const f32x4 g = *(const f32x4*)(p.e_g_head + c);
            u32x2 o; o.x = pk2(v[0] * rstd * g[0] * bflo(zw[head].x), v[1] * rstd * g[1] * bfhi(zw[head].x)); o.y = pk2(v[2] * rstd * g[2] * bflo(zw[head].y), v[3] * rstd * g[3] * bfhi(zw[head].y));
            *(u32x2*)(Y + t * 2048 + c) = o; }
    }
    const bf16_t* U = (const bf16_t*)(ws + OFF_VB);
    for (int it = blockIdx.x * 512 + tid; it < (T / 8) * 128; it += gridDim.x * 512) {
        const int cgl = it & 31, tbl = (it >> 5) & 1, g = __builtin_amdgcn_readfirstlane((it >> 6) & 3), tb = 2 * (it >> 8) + tbl;
        const size_t t0 = (size_t)tb * 8; const int s0 = (int)(t0 & (SEQ - 1)), c0 = g * 256 + cgl * 8;
        if (g == 0) pool_item<2>(U, Y, p.e_s_pool, t0, s0, c0);
        else if (g == 1) pool_item<4>(U, Y, p.e_s_pool, t0, s0, c0);
        else if (g == 2) pool_item<8>(U, Y, p.e_s_pool, t0, s0, c0);
        else pool_item<16>(U, Y, p.e_s_pool, t0, s0, c0);
    }
}

__device__ __forceinline__ void headnorm64(bf16_t* X, const float* g) {
    const int lane = threadIdx.x & 63, wave = threadIdx.x >> 6;
    const float* gg = g + (lane & 3) * 16;
    for (int t0 = (blockIdx.x * 8 + wave) * 4; t0 < T; t0 += gridDim.x * 32) {
        u32x4 a[4], b[4];
#pragma unroll
        for (int k = 0; k < 4; ++k) { const bf16_t* r = X + (size_t)(t0 + k) * 1024 + lane * 16; a[k] = *(const u32x4*)r; b[k] = *(const u32x4*)(r + 8); }
#pragma unroll
        for (int k = 0; k < 4; ++k) {
            float f[16] = {bflo(a[k].x), bfhi(a[k].x), bflo(a[k].y), bfhi(a[k].y), bflo(a[k].z), bfhi(a[k].z), bflo(a[k].w), bfhi(a[k].w), bflo(b[k].x), bfhi(b[k].x), bflo(b[k].y), bfhi(b[k].y), bflo(b[k].z), bfhi(b[k].z), bflo(b[k].w), bfhi(b[k].w)};
            float ss = 0.f;
#pragma unroll
            for (int i = 0; i < 16; ++i) ss += f[i] * f[i];
            ss += __shfl_xor(ss, 1); ss += __shfl_xor(ss, 2);
            const float rstd = rsqrtf(ss * (1.0f / 64.0f) + EPS);
#pragma unroll
            for (int i = 0; i < 16; ++i) f[i] = f[i] * rstd * gg[i];
            u32x4 oa, ob; oa.x = pk2(f[0], f[1]); oa.y = pk2(f[2], f[3]); oa.z = pk2(f[4], f[5]); oa.w = pk2(f[6], f[7]);
            ob.x = pk2(f[8], f[9]); ob.y = pk2(f[10], f[11]); ob.z = pk2(f[12], f[13]); ob.w = pk2(f[14], f[15]);
            bf16_t* r = X + (size_t)(t0 + k) * 1024 + lane * 16; *(u32x4*)r = oa; *(u32x4*)(r + 8) = ob;
        }
    }
}
__device__ __forceinline__ void phase_qnorm_ckvnorm(const P& p) {
    unsigned char* ws = p.ws; const int lane = threadIdx.x & 63, wave = threadIdx.x >> 6;
    {
        const u32x4* KI4 = (const u32x4*)(ws + OFF_KI); u32x4* KT4 = (u32x4*)(ws + OFF_KIT);
        for (size_t it = (size_t)blockIdx.x * 512 + threadIdx.x; it < (size_t)T * 8; it += (size_t)gridDim.x * 512) {
            const int l = (int)(it & 63), ks = (int)((it >> 6) & 1); const size_t t16 = it >> 7;
            KT4[it] = KI4[(t16 * 16 + (l & 15)) * 8 + 4 * ks + (l >> 4)]; }
    }
    headnorm64((bf16_t*)(ws + OFF_TMP), p.o_g_q);
    bf16_t* CKVN = (bf16_t*)(ws + OFF_CKVN);
    const f32x4 g = *(const f32x4*)(p.o_g_kv + lane * 4);
    for (int t0 = (blockIdx.x * 8 + wave) * 8; t0 < T; t0 += gridDim.x * 64) {
        u32x2 w[8];
#pragma unroll
        for (int k = 0; k < 8; ++k) w[k] = *(const u32x2*)(CKVN + (size_t)(t0 + k) * 256 + lane * 4);
#pragma unroll
        for (int k = 0; k < 8; ++k) {
            const float v[4] = {bflo(w[k].x), bfhi(w[k].x), bflo(w[k].y), bfhi(w[k].y)};
            const float ss = wave_sum(v[0] * v[0] + v[1] * v[1] + v[2] * v[2] + v[3] * v[3]);
            const float rstd = rsqrtf(ss * (1.0f / 256.0f) + EPS);
            u32x2 o; o.x = pk2(v[0] * rstd * g[0], v[1] * rstd * g[1]); o.y = pk2(v[2] * rstd * g[2], v[3] * rstd * g[3]);
            *(u32x2*)(CKVN + (size_t)(t0 + k) * 256 + lane * 4) = o;
        }
    }
}

__device__ __forceinline__ unsigned okey(float s) { if (s == 0.f) s = 0.f; const unsigned u = __float_as_uint(s); return (u & 0x80000000u) ? ~u : (u | 0x80000000u); }

__device__ __forceinline__ void indexer_slow_query(const P& p, unsigned char* lds, size_t t) {
    unsigned char* ws = p.ws; const int tid = threadIdx.x, lane = tid & 63, wave = tid >> 6;
    const _Float16* QI = (const _Float16*)(ws + OFF_QI); const _Float16* KI = (const _Float16*)(ws + OFF_KI); const float* WI = (const float*)(ws + OFF_WI);
    unsigned short* IDX = (unsigned short*)(ws + OFF_IDX);
    unsigned* sc = (unsigned*)lds; unsigned* hist = sc + 16384; float* qs = (float*)(hist + 256); unsigned* misc = (unsigned*)(qs + 256); unsigned* wsum = misc + 16;
    const int batch = (int)(t >> 14), pos = (int)(t & (SEQ - 1)), n = pos + 1;
    __syncthreads();
    if (tid < 256) qs[tid] = (float)QI[t * 256 + tid];
    const float w0 = WI[t * 4 + 0], w1 = WI[t * 4 + 1], w2 = WI[t * 4 + 2], w3 = WI[t * 4 + 3];
    __syncthreads();
    const _Float16* kbase = KI + (size_t)batch * SEQ * 64;
    for (int s = tid; s < n; s += 512) {
        asm volatile("" ::: "memory");
        typedef _Float16 h8 __attribute__((ext_vector_type(8)));
        const h8* kr = (const h8*)(kbase + (size_t)s * 64);
        float d0 = 0.f, d1 = 0.f, d2 = 0.f, d3 = 0.f;
#pragma unroll
        for (int j = 0; j < 8; ++j) { const h8 kv = kr[j];
#pragma unroll
            for (int e = 0; e < 8; ++e) { const int d = j * 8 + e; const float kf = (float)kv[e]; d0 += qs[d] * kf; d1 += qs[64 + d] * kf; d2 += qs[128 + d] * kf; d3 += qs[192 + d] * kf; } }
        float score = w0 * fmaxf(d0, 0.f); score = fmaf(w1, fmaxf(d1, 0.f), score); score = fmaf(w2, fmaxf(d2, 0.f), score); score = fmaf(w3, fmaxf(d3, 0.f), score);
        sc[s] = okey(score);
    }
    unsigned prefix = 0, krem = 256;
    for (int pass = 0; pass < 4; ++pass) {
        const int shift = 24 - 8 * pass;
        __syncthreads();
        if (tid < 256) hist[tid] = 0;
        __syncthreads();
        for (int s = tid; s < n; s += 512) { const unsigned k = sc[s]; if (pass == 0 || (k >> (shift + 8)) == prefix) atomicAdd(&hist[(k >> shift) & 255u], 1u); }
        __syncthreads();
        if (tid == 0) { unsigned cum = 0; int bin = 255; for (; bin > 0; --bin) { const unsigned c = hist[bin]; if (cum + c >= krem) break; cum += c; } misc[0] = (unsigned)bin; misc[1] = krem - cum; }
        __syncthreads();
        prefix = (prefix << 8) | misc[0]; krem = misc[1];
    }
    const unsigned ngt_total = 256u - krem;
    unsigned lg = 0, le = 0; const int s0 = tid * 32;
    for (int s = s0; s < s0 + 32 && s < n; ++s) { const unsigned k = sc[s]; lg += (k > prefix); le += (k == prefix); }
    unsigned pk = lg | (le << 16), incl = pk;
#pragma unroll
    for (int o = 1; o < 64; o <<= 1) { const unsigned y = __shfl_up(incl, o); if (lane >= o) incl += y; }
    if (lane == 63) wsum[wave] = incl;
    __syncthreads();
    unsigned base = 0;
    for (int w = 0; w < wave; ++w) base += wsum[w];
    const unsigned excl = base + incl - pk; unsigned bg = excl & 0xffffu, be = excl >> 16;
    for (int s = s0; s < s0 + 32 && s < n; ++s) { const unsigned k = sc[s];
        if (k > prefix) { IDX[t * 256 + bg] = (unsigned short)s; ++bg; }
        else if (k == prefix) { if (be < krem) IDX[t * 256 + ngt_total + be] = (unsigned short)s; ++be; } }
    __syncthreads();
}

typedef _Float16 half8 __attribute__((ext_vector_type(8)));
constexpr int IX_CAP = 1024, IX_ZBIN = 1024;
__device__ __forceinline__ unsigned ix_key(const f32x4 a, const f32x4 w) {
    const float r0 = __int_as_float(max(__float_as_int(a[0]), 0)), r1 = __int_as_float(max(__float_as_int(a[1]), 0));
    const float r2 = __int_as_float(max(__float_as_int(a[2]), 0)), r3 = __int_as_float(max(__float_as_int(a[3]), 0));
    float s = fmaf(w[0], r0, 0.0f); s = fmaf(w[1], r1, s); s = fmaf(w[2], r2, s); s = fmaf(w[3], r3, s);
    const unsigned u = __float_as_uint(s);
    return u ^ ((unsigned)((int)u >> 31) | 0x80000000u);
}
#define LDS_ADD(ptr, v) __hip_atomic_fetch_add((ptr), (v), __ATOMIC_RELAXED, __HIP_MEMORY_SCOPE_WORKGROUP)
struct IxTagF { static constexpr bool value = false; }; struct IxTagT { static constexpr bool value = true; };
__device__ __forceinline__ void phase_indexer(const P& p, unsigned char* lds) {
    unsigned char* ws = p.ws; const int tid = threadIdx.x, lane = tid & 63, kl = lane & 15, g = lane >> 4;
    const int wave = __builtin_amdgcn_readfirstlane(tid >> 6);
    const _Float16* QI = (const _Float16*)(ws + OFF_QI); const _Float16* KIT = (const _Float16*)(ws + OFF_KIT); const float* WI = (const float*)(ws + OFF_WI);
    unsigned short* IDX = (unsigned short*)(ws + OFF_IDX); int* CNT = (int*)(ws + OFF_CNT);
    LAS unsigned* hist = (LAS unsigned*)lds;
    LAS int* qTbin = (LAS int*)(hist + 16 * 2048);
    LAS int* qCab = qTbin + 16; LAS unsigned* qN = (LAS unsigned*)(qCab + 16); LAS int* qOvf = (LAS int*)(qN + 16); LAS int* qZl = qOvf + 16;
    LAS unsigned* ovl = (LAS unsigned*)(lds + 132 * 1024);
    LAS unsigned* h2 = (LAS unsigned*)(lds + 133 * 1024 + wave * 1536);
    LAS unsigned long long* l2 = (LAS unsigned long long*)(h2 + 256);
    if (tid == 0) ovl[0] = 0u;
    const int G = gridDim.x, nround = (T / 16) / G;
#pragma unroll 1
    for (int i = 0; i < nround; ++i) {
        const int tix = (i & 1) ? i * G + (G - 1 - (int)blockIdx.x) : i * G + (int)blockIdx.x;
        const int batch = tix & 1, tb = tix >> 1, p0 = tb * 16; const size_t t0 = (size_t)batch * SEQ + p0;
        __syncthreads();
        if (p0 + 16 <= 256) {
#pragma unroll
            for (int j = 0; j < 8; ++j) { const int e = tid + 512 * j, q = e >> 8, jj = e & 255; IDX[(t0 + q) * 256 + jj] = (unsigned short)(jj <= p0 + q ? jj : 0); }
            if (tid < 16) CNT[t0 + tid] = p0 + tid + 1;
            continue;
        }
#pragma unroll
        for (int j = 0; j < 16; ++j) ((LAS u32x4*)hist)[tid + 512 * j] = (u32x4){0u, 0u, 0u, 0u};
        if (tid < 16) { qN[tid] = 0u; qOvf[tid] = 0; }
        half8 af[4][2]; f32x4 wv[4];
#pragma unroll
        for (int rt = 0; rt < 4; ++rt) {
#pragma unroll
            for (int ks = 0; ks < 2; ++ks) af[rt][ks] = *(const half8*)(QI + (t0 + 4 * rt + (kl >> 2)) * 256 + (kl & 3) * 64 + 32 * ks + 8 * g);
            wv[rt] = *(const f32x4*)(WI + (t0 + 4 * rt + g) * 4);
        }
        __syncthreads();
        const int nblk = tb + 1, L = (nblk + 7) >> 3, b0 = wave * L, b1 = (b0 + L < nblk) ? b0 + L : nblk;
        const _Float16* kb = KIT + (size_t)batch * SEQ * 64 + lane * 8;
        LAS unsigned* hg = hist + g * 4 * 2048;
#define IX_LOADK(u, bb) do { kq[u][0] = *(const half8*)(kb + (size_t)(bb) * 1024); kq[u][1] = *(const half8*)(kb + (size_t)(bb) * 1024 + 512); } while (0)
#define IX_MFMA(acc, k0, k1) do { _Pragma("unroll") for (int rt = 0; rt < 4; ++rt) { acc[rt] = __builtin_amdgcn_mfma_f32_16x16x32_f16(af[rt][0], k0, (f32x4){0.f, 0.f, 0.f, 0.f}, 0, 0, 0); \
            acc[rt] = __builtin_amdgcn_mfma_f32_16x16x32_f16(af[rt][1], k1, acc[rt], 0, 0, 0); } } while (0)
        if (b0 < b1) {
            half8 kq[2][2];
#pragma unroll
            for (int u = 0; u < 2; ++u) { const int bb = (b0 + u < b1) ? b0 + u : b1 - 1; IX_LOADK(u, bb); }
            auto step1 = [&](int bcur, const half8& k0, const half8& k1, auto chkTag) {
                constexpr bool CHK = decltype(chkTag)::value;
                f32x4 acc[4]; IX_MFMA(acc, k0, k1);
#pragma unroll
                for (int rt = 0; rt < 4; ++rt) { const unsigned key = ix_key(acc[rt], wv[rt]);
                    if (!CHK || bcur * 16 + kl <= p0 + 4 * rt + g) LDS_ADD(hg + rt * 2048 + (key >> 21), 1u); }
            };
            int b = b0;
#pragma unroll 1
            for (; b + 2 <= b1 && b + 2 <= nblk - 1; b += 2) {
#pragma unroll
                for (int u = 0; u < 2; ++u) { step1(b + u, kq[u][0], kq[u][1], IxTagF{}); const int bb = (b + 2 + u < b1) ? b + 2 + u : b1 - 1; IX_LOADK(u, bb); }
            }
#pragma unroll 1
            for (; b + 2 <= b1; b += 2) {
#pragma unroll
                for (int u = 0; u < 2; ++u) { step1(b + u, kq[u][0], kq[u][1], IxTagT{}); const int bb = (b + 2 + u < b1) ? b + 2 + u : b1 - 1; IX_LOADK(u, bb); }
            }
            if (b < b1) step1(b, kq[0][0], kq[0][1], IxTagT{});
        }
        __syncthreads();
#pragma unroll 1
        for (int qq = 0; qq < 2; ++qq) {
            const int q = 2 * wave + qq; const LAS unsigned* h = hist + q * 2048;
            unsigned cs = 0; const int top = 2047 - 32 * lane;
#pragma unroll 8
            for (int ii = 0; ii < 32; ++ii) cs += h[top - ((ii + lane) & 31)];
            unsigned incl = cs;
#pragma unroll
            for (int o = 1; o < 64; o <<= 1) { const unsigned y = __shfl_up(incl, o); if (lane >= o) incl += y; }
            const unsigned long long m = __ballot(incl >= 256u);
            const int Ls = m ? (__ffsll((long long)m) - 1) : 63;
            unsigned cabv = __shfl(incl - cs, Ls), cbv = 0; int tbin = 0; bool found = false;
#pragma unroll 8
            for (int ii = 0; ii < 32; ++ii) { const unsigned c = h[2047 - 32 * Ls - ii]; if (!found && cabv + c >= 256u) { tbin = 2047 - 32 * Ls - ii; cbv = c; found = true; } if (!found) cabv += c; }
            if (lane == 0) { qTbin[q] = tbin; qCab[q] = (int)cabv; int zl = 0x7fffffff;
                if (tbin == IX_ZBIN) {
                    const int nk = p0 + 4 * (q & 3) + (q >> 2) + 1; zl = (int)(((unsigned long long)384 * (unsigned)nk) / (cbv ? cbv : 1u)) + 16; }
                qZl[q] = zl; }
        }
        __syncthreads();
        if (b0 < b1) {
            unsigned lok[4]; int zl[4];
#pragma unroll
            for (int rt = 0; rt < 4; ++rt) { lok[rt] = (unsigned)qTbin[g * 4 + rt] << 21; zl[rt] = qZl[g * 4 + rt]; }
            half8 kq[2][2];
#pragma unroll
            for (int u = 0; u < 2; ++u) { const int bb = (b0 + u < b1) ? b0 + u : b1 - 1; IX_LOADK(u, bb); }
            auto step2 = [&](int bcur, const half8& k0, const half8& k1, auto chkTag) {
                constexpr bool CHK = decltype(chkTag)::value;
                const int s = bcur * 16 + kl;
                f32x4 acc[4]; IX_MFMA(acc, k0, k1);
                unsigned key[4], pos[4]; bool cand[4];
#pragma unroll
                for (int rt = 0; rt < 4; ++rt) { key[rt] = ix_key(acc[rt], wv[rt]); cand[rt] = key[rt] >= lok[rt] + (s >= zl[rt] ? 1u : 0u); if (CHK) cand[rt] = cand[rt] && s <= p0 + 4 * rt + g; }
#pragma unroll
                for (int rt = 0; rt < 4; ++rt) { pos[rt] = 0u;
                    if (cand[rt]) { int gz = g; asm volatile("" : "+v"(gz)); pos[rt] = LDS_ADD(qN + gz * 4 + rt, 1u); } }
#pragma unroll
                for (int rt = 0; rt < 4; ++rt) {
                    if (cand[rt] && pos[rt] < (unsigned)IX_CAP) { int gz = g; asm volatile("" : "+v"(gz));
                        ((LAS unsigned long long*)(lds + (gz * 4 + rt) * 8192))[pos[rt]] = ((unsigned long long)key[rt] << 16) | (unsigned long long)(0xffffu - (unsigned)s); } }
            };
            int b = b0;
#pragma unroll 1
            for (; b + 2 <= b1 && b + 2 <= nblk - 1; b += 2) {
#pragma unroll
                for (int u = 0; u < 2; ++u) { step2(b + u, kq[u][0], kq[u][1], IxTagF{}); const int bb = (b + 2 + u < b1) ? b + 2 + u : b1 - 1; IX_LOADK(u, bb); }
            }
#pragma unroll 1
            for (; b + 2 <= b1; b += 2) {
#pragma unroll
                for (int u = 0; u < 2; ++u) { step2(b + u, kq[u][0], kq[u][1], IxTagT{}); const int bb = (b + 2 + u < b1) ? b + 2 + u : b1 - 1; IX_LOADK(u, bb); }
            }
            if (b < b1) step2(b, kq[0][0], kq[0][1], IxTagT{});
        }
#undef IX_LOADK
#undef IX_MFMA
        __syncthreads();
#pragma unroll 1
        for (int qq = 0; qq < 2; ++qq) {
            const int qs = 2 * wave + qq; const int n = __builtin_amdgcn_readfirstlane((int)qN[qs]), cabq = __builtin_amdgcn_readfirstlane(qCab[qs]), tbin = __builtin_amdgcn_readfirstlane(qTbin[qs]);
            if (n > IX_CAP || n < 256) { if (lane == 0) qOvf[qs] = 1; continue; }
            const LAS unsigned long long* cd = (const LAS unsigned long long*)(lds + qs * 8192);
            unsigned short* irow = IDX + (t0 + 4 * (qs & 3) + (qs >> 2)) * 256;
            const int NI = (n + 63) >> 6;
            unsigned long long v[16];
#pragma unroll
            for (int i = 0; i < 16; ++i) v[i] = (i < NI && lane + 64 * i < n) ? cd[lane + 64 * i] : 0ull;
            unsigned long long tau = 1ull;
            if (n > 256) {
                unsigned long long pmask = 0x7ffull << 37, pval = (unsigned long long)tbin << 37; int need = 256 - cabq; unsigned cT = (unsigned)(n - cabq);
#pragma unroll 1
                for (int shift = 29; shift >= 5 && cT > 64u; shift -= 8) {
#pragma unroll
                    for (int j = 0; j < 4; ++j) h2[lane + 64 * j] = 0u;
                    asm volatile("" ::: "memory");
#pragma unroll
                    for (int i = 0; i < 16; ++i) if (i < NI && (v[i] & pmask) == pval) LDS_ADD(h2 + ((unsigned)(v[i] >> shift) & 255u), 1u);
                    asm volatile("" ::: "memory");
                    const unsigned cs = h2[255 - 4 * lane] + h2[254 - 4 * lane] + h2[253 - 4 * lane] + h2[252 - 4 * lane];
                    unsigned incl = cs;
#pragma unroll
                    for (int o = 1; o < 64; o <<= 1) { const unsigned y = __shfl_up(incl, o); if (lane >= o) incl += y; }
                    const unsigned long long m = __ballot(incl >= (unsigned)need);
                    const int Ls = m ? (__ffsll((long long)m) - 1) : 63;
                    unsigned above = __shfl(incl - cs, Ls), c2 = 0; int T2 = 0; bool found = false;
#pragma unroll
                    for (int ii = 0; ii < 4; ++ii) { const unsigned c = h2[255 - 4 * Ls - ii]; if (!found && above + c >= (unsigned)need) { T2 = 255 - 4 * Ls - ii; c2 = c; found = true; } if (!found) above += c; }
                    above = (unsigned)__builtin_amdgcn_readfirstlane((int)above); c2 = (unsigned)__builtin_amdgcn_readfirstlane((int)c2); T2 = __builtin_amdgcn_readfirstlane(T2);
                    need -= (int)above; cT = c2;
                    pmask |= 255ull << shift; pval |= (unsigned long long)T2 << shift;
                    asm volatile("" ::: "memory");
                }
                { int base = 0;
#pragma unroll
                  for (int i = 0; i < 16; ++i) { if (i < NI) { const bool mt = (v[i] & pmask) == pval; const unsigned long long bm = __ballot(mt);
                      if (mt) { const int pos = base + (int)__popcll(bm & ((1ull << lane) - 1ull)); if (pos < 64) l2[pos] = v[i]; }
                      base += (int)__popcll(bm); } } }
                asm volatile("" ::: "memory");
                const unsigned long long mine = (unsigned)lane < cT ? l2[lane] : 0ull;
                const unsigned mlo = (unsigned)mine, mhi = (unsigned)(mine >> 32);
                int rank = 0;
#pragma unroll 1
                for (unsigned j = 0; j < cT; ++j) { const unsigned long long o = ((unsigned long long)(unsigned)__builtin_amdgcn_readlane((int)mhi, (int)j) << 32) | (unsigned)__builtin_amdgcn_readlane((int)mlo, (int)j);
                    rank += (o > mine) ? 1 : 0; }
                const unsigned long long hit = __ballot((unsigned)lane < cT && rank == need - 1);
                const int hl = hit ? (__ffsll((long long)hit) - 1) : 0;
                tau = ((unsigned long long)(unsigned)__builtin_amdgcn_readlane((int)mhi, hl) << 32) | (unsigned)__builtin_amdgcn_readlane((int)mlo, hl);
                asm volatile("" ::: "memory");
            }
            { int base = 0;
#pragma unroll
              for (int i = 0; i < 16; ++i) { if (i < NI) { const bool e = v[i] >= tau; const unsigned long long bm = __ballot(e);
                  if (e) irow[base + (int)__popcll(bm & ((1ull << lane) - 1ull))] = (unsigned short)(0xffffu - (unsigned)(v[i] & 0xffffull));
                  base += (int)__popcll(bm); } } }
        }
        if (tid < 16) CNT[t0 + tid] = 256;
        __syncthreads();
        if (tid < 16 && qOvf[tid]) { const unsigned k = LDS_ADD(ovl, 1u); ovl[1 + k] = (unsigned)(t0 + 4 * (tid & 3) + (tid >> 2)); }
    }
    __syncthreads();
    const unsigned novl = __builtin_amdgcn_readfirstlane(ovl[0]);
#pragma unroll 1
    for (unsigned k = 0; k < novl; ++k) { const unsigned tq = __builtin_amdgcn_readfirstlane(ovl[1 + k]); indexer_slow_query(p, lds, (size_t)tq); }
}
#undef LDS_ADD

__device__ __forceinline__ void phase_attn(const P& p, unsigned char* lds) {
    unsigned char* ws = p.ws; const int tid = threadIdx.x, lane = tid & 63, hd = lane & 15, g = lane >> 4;
    const int wave = __builtin_amdgcn_readfirstlane(tid >> 6);
    bf16_t* QP = (bf16_t*)(ws + OFF_QP); const bf16_t* CK = (const bf16_t*)(ws + OFF_CKVN); const bf16_t* RK = (const bf16_t*)(ws + OFF_RK);
    const unsigned short* IDX = (const unsigned short*)(ws + OFF_IDX); const int* CNT = (const int*)(ws + OFF_CNT);
    float* biasT = (float*)lds;
    biasT[tid] = p.rel_bias[tid];
    __syncthreads();
    LAS unsigned char* rows = (LAS unsigned char*)(lds + 2048 + (size_t)wave * 18432);
    LAS bf16_t* rkb = (LAS bf16_t*)(rows + 16384);
    LAS unsigned* info = (LAS unsigned*)(rows + 17408);
    const LAS float* biasL = (const LAS float*)lds;
    for (int t = blockIdx.x * 8 + wave; t < T; t += gridDim.x * 8) {
        const int batch = t >> 14, pos = t & (SEQ - 1); const int cnt = CNT[t];
        const size_t rb = (size_t)batch * SEQ;
        asm volatile("s_waitcnt lgkmcnt(0)" ::: "memory");
#pragma unroll
        for (int jj = 0; jj < 4; ++jj) {
            const int j = lane + 64 * jj; int id = IDX[(size_t)t * 256 + j]; if (j >= cnt) id = 0;
            const int rel = pos - id; int bucket = rel < 0 ? 0 : rel;
            if (rel >= 16) { bucket = 16 + (int)(__logf((float)rel * 0.0625f) / 2.0794415416798357f * 16.0f); bucket = bucket > 31 ? 31 : bucket; }
            info[j] = (unsigned)id | ((unsigned)bucket << 16);
        }
        bf16x8 qf[8];
#pragma unroll
        for (int ks = 0; ks < 8; ++ks) qf[ks] = *(const bf16x8*)(QP + (size_t)t * 4096 + hd * 256 + ks * 32 + g * 8);
        f32x4 o[16];
#pragma unroll
        for (int rt = 0; rt < 16; ++rt) o[rt] = (f32x4){0.f, 0.f, 0.f, 0.f};
        float mrun = -1e30f, lrun = 0.f;
        asm volatile("s_waitcnt lgkmcnt(0)" ::: "memory");
        const int nch = (cnt + 31) >> 5;
        for (int ch = 0; ch < nch; ++ch) {
            asm volatile("s_waitcnt lgkmcnt(0)" ::: "memory");
#pragma unroll
            for (int i = 0; i < 16; ++i) {
                const int ksl = 2 * i + (lane >> 5); const unsigned idv = info[ch * 32 + ksl] & 0xffffu;
                const bf16_t* src = CK + (rb + idv) * 256 + (((lane & 31) ^ (ksl & 15)) * 8);
                __builtin_amdgcn_global_load_lds((const unsigned*)src, (LAS unsigned*)(rows + i * 1024), 16, 0, 0);
            }
            { const unsigned idv = info[ch * 32 + (lane >> 1)] & 0xffffu;
              __builtin_amdgcn_global_load_lds((const unsigned*)(RK + (rb + idv) * 16 + (lane & 1) * 8), (LAS unsigned*)rkb, 16, 0, 0); }
            asm volatile("s_waitcnt vmcnt(0)" ::: "memory");
            f32x4 s0 = (f32x4){0.f, 0.f, 0.f, 0.f}, s1 = (f32x4){0.f, 0.f, 0.f, 0.f};
#pragma unroll
            for (int ks = 0; ks < 8; ++ks) {
                const int pos16 = ((4 * ks + g) ^ hd) * 16;
                const bf16x8 a0 = *(const LAS bf16x8*)(rows + hd * 512 + pos16);
                const bf16x8 a1 = *(const LAS bf16x8*)(rows + (16 + hd) * 512 + pos16);
                s0 = __builtin_amdgcn_mfma_f32_16x16x32_bf16(a0, qf[ks], s0, 0, 0, 0);
                s1 = __builtin_amdgcn_mfma_f32_16x16x32_bf16(a1, qf[ks], s1, 0, 0, 0);
            }
            float x0[4], x1[4]; float cm = -INFINITY;
#pragma unroll
            for (int r = 0; r < 4; ++r) {
                const int sl0 = 4 * g + r, sl1 = 16 + 4 * g + r, j0 = ch * 32 + sl0, j1 = ch * 32 + sl1;
                const unsigned i0 = info[j0], i1 = info[j1];
                const float r0 = bf2f(rkb[sl0 * 16 + hd]), r1 = bf2f(rkb[sl1 * 16 + hd]);
                x0[r] = (j0 < cnt) ? s0[r] * r0 + biasL[(i0 >> 16) * 16 + hd] : -INFINITY;
                x1[r] = (j1 < cnt) ? s1[r] * r1 + biasL[(i1 >> 16) * 16 + hd] : -INFINITY;
                cm = fmaxf(cm, fmaxf(x0[r], x1[r]));
            }
            cm = fmaxf(cm, __shfl_xor(cm, 16)); cm = fmaxf(cm, __shfl_xor(cm, 32));
            const float mnew = fmaxf(mrun, cm); const float sc = __expf(mrun - mnew); mrun = mnew;
            float ls = 0.f;
#pragma unroll
            for (int r = 0; r < 4; ++r) { x0[r] = __expf(x0[r] - mnew); x1[r] = __expf(x1[r] - mnew); ls += x0[r] + x1[r]; }
            lrun = lrun * sc + ls;
#pragma unroll
            for (int rt = 0; rt < 16; ++rt) o[rt] *= sc;
            u32x4 pw; pw.x = pg8::cvt_pk_bf16(x0[0], x0[1]); pw.y = pg8::cvt_pk_bf16(x0[2], x0[3]); pw.z = pg8::cvt_pk_bf16(x1[0], x1[1]); pw.w = pg8::cvt_pk_bf16(x1[2], x1[3]);
            const bf16x8 pf = __builtin_bit_cast(bf16x8, pw);
            const int q = hd >> 2, pp = hd & 3, ksl = 4 * g + q;
            const LAS unsigned char* trb = rows + ksl * 512 + (pp & 1) * 8;
#pragma unroll
            for (int rt = 0; rt < 16; ++rt) {
                const int c16 = ((2 * rt + (pp >> 1)) ^ ksl) * 16;
                const v4i16_t t0 = __builtin_amdgcn_ds_read_tr16_b64_v4i16((LAS v4i16_t*)(trb + c16));
                const v4i16_t t1 = __builtin_amdgcn_ds_read_tr16_b64_v4i16((LAS v4i16_t*)(trb + c16 + 8192));
                bf16x8 af; af[0] = t0[0]; af[1] = t0[1]; af[2] = t0[2]; af[3] = t0[3]; af[4] = t1[0]; af[5] = t1[1]; af[6] = t1[2]; af[7] = t1[3];
                o[rt] = __builtin_amdgcn_mfma_f32_16x16x32_bf16(af, pf, o[rt], 0, 0, 0);
            }
        }
        float ltot = lrun; ltot += __shfl_xor(ltot, 16); ltot += __shfl_xor(ltot, 32);
        const float inv = 1.0f / ltot;
        bf16_t* op = QP + (size_t)t * 4096 + hd * 256 + 4 * g;
#pragma unroll
        for (int rt = 0; rt < 16; ++rt) { u32x2 w; w.x = pg8::cvt_pk_bf16(o[rt][0] * inv, o[rt][1] * inv); w.y = pg8::cvt_pk_bf16(o[rt][2] * inv, o[rt][3] * inv); *(u32x2*)(op + rt * 16) = w; }
    }
}

__global__ void __launch_bounds__(512, 2) k_fwd(P p_arg, int ph_lo, int ph_hi) {
    extern __shared__ __attribute__((aligned(16))) unsigned char smem[];
    const P& p = *(const P*)__builtin_amdgcn_kernarg_segment_ptr(); (void)p_arg;
    unsigned char* lds = smem + 16;
    unsigned char* ws = p.ws;
    XcdBarrier bar;
    const bool multi = (ph_hi - ph_lo) > 1;
    if (multi) {
        if (threadIdx.x == 0) *(uint4*)smem = make_uint4(0u, 0u, 0u, 0u);
        __syncthreads();
        bar = xcd_barrier_post((unsigned*)(ws + OFF_CTL), (volatile LAS unsigned*)smem);
    }
#define PH(i) (ph_lo <= (i) && (i) < ph_hi)
#define SEAM(i) do { if ((i) + 1 < ph_hi) xcd_barrier(bar); else __syncthreads(); } while (0)
    bf16_t *XN = (bf16_t*)(ws + OFF_XN), *QB = (bf16_t*)(ws + OFF_QB), *KB = (bf16_t*)(ws + OFF_KB), *VB = (bf16_t*)(ws + OFF_VB), *TMP = (bf16_t*)(ws + OFF_TMP), *Y = (bf16_t*)(ws + OFF_Y);
    if (PH(0)) { phase_prep(p, lds); SEAM(0); }
    if (PH(1)) { fast_gemm(lds, XN, 1024, (const bf16_t*)(ws + OFF_W0T), 1024, 3072, 1024, D1{ws}); SEAM(1); }
    if (PH(2)) { phase_conv_scan(p, lds); SEAM(2); }
    if (PH(3)) { mlstm_units<false>(p, lds); SEAM(3); }
    if (PH(4)) { GWP f{(const bf16_t*)(ws + OFF_WPT), (const bf16_t*)(ws + OFF_WUB), (bf16_t*)(ws + OFF_W0T)}; sgemm(f, 256); phase_mlstm_scan(p, lds); SEAM(4); }
    if (PH(5)) { mlstm_units<true>(p, lds); SEAM(5); }
    if (PH(6)) { fast_gemm(lds, XN, 1024, (const bf16_t*)(ws + OFF_W0T) + (size_t)3072 * 1024, 1024, 4096, 1024, D2{ws}); SEAM(6); }
    if (PH(7)) { phase_ya_pool(p); SEAM(7); }
    if (PH(8)) { fast_gemm(lds, Y, 2048, (const bf16_t*)(ws + OFF_WO0T), 2048, 1024, 2048, D4{(unsigned char*)p.out, p.x}); SEAM(8); }
    if (PH(9)) { rmsnorm_rows<4>(p.out, p.o_norm, XN, p.o_w_in, OIN, 1600, nullptr, 0.5f, (float*)(ws + OFF_WI), (float*)lds); SEAM(9); }
    if (PH(10)) { fast_gemm(lds, XN, 1024, (const bf16_t*)(ws + OFF_W1T), 1024, 2816, 1024, D5{ws}); SEAM(10); }
    if (PH(11)) { phase_qnorm_ckvnorm(p); SEAM(11); }
    if (PH(12)) { fast_gemm(lds, (const bf16_t*)(ws + OFF_CKVN), 256, (const bf16_t*)(ws + OFF_WUKP), 256, 1024, 256, DK{ws}); SEAM(12); }
    if (PH(13)) { fast_gemm(lds, TMP, 1024, (const bf16_t*)(ws + OFF_WQF), 128, 4096, 128, DQ{ws}, (size_t)128); phase_indexer(p, lds); SEAM(13); }
    if (PH(14)) { phase_attn(p, lds); SEAM(14); }
    if (PH(15)) { fast_gemm(lds, (const bf16_t*)(ws + OFF_QP), 4096, (const bf16_t*)(ws + OFF_WBD), 1024, 1024, 1024, DO{ws}, (size_t)2048); SEAM(15); }
    if (PH(16)) { fast_gemm(lds, TMP, 1024, (const bf16_t*)(ws + OFF_WO1T), 1024, 1024, 1024, D8{(unsigned char*)p.out}); }
#undef PH
#undef SEAM
}

extern "C" void kernel_launch(void* const* d_in, const int* in_sizes, int n_in, void* d_out, int out_size, void* d_ws, size_t ws_size, hipStream_t stream) {
    static int grid = 0;
    if (grid == 0) {
        if (n_in != 18 || out_size != T * DM || ws_size < WS_END) { fprintf(stderr, "kernel_launch: unexpected shapes (n_in %d out %d ws %zu)\n", n_in, out_size, ws_size); grid = -1; return; }
        if (hipFuncSetAttribute((const void*)k_fwd, hipFuncAttributeMaxDynamicSharedMemorySize, LDS_BYTES) != hipSuccess) { fprintf(stderr, "kernel_launch: hipFuncSetAttribute failed\n"); grid = -1; return; }
        grid = 256;
    }
    if (grid < 0) return;
    (void)hipMemsetAsync((char*)d_ws + OFF_CTL, 0, 16384, stream);
    P p{};
    p.x = (const float*)d_in[0]; p.e_norm = (const float*)d_in[1]; p.e_w_in = (const float*)d_in[2]; p.e_conv = (const float*)d_in[3]; p.e_b_if = (const float*)d_in[4];
    p.e_g_head = (const float*)d_in[5]; p.e_w_pool = (const float*)d_in[6]; p.e_s_pool = (const float*)d_in[7]; p.e_w_out = (const float*)d_in[8];
    p.o_norm = (const float*)d_in[9]; p.o_w_in = (const float*)d_in[10]; p.o_g_kv = (const float*)d_in[11]; p.o_w_uk = (const float*)d_in[12]; p.o_w_uv = (const float*)d_in[13];
    p.o_g_q = (const float*)d_in[14]; p.o_g_k = (const float*)d_in[15]; p.o_w_out = (const float*)d_in[16]; p.rel_bias = (const float*)d_in[17];
    p.out = (float*)d_out; p.ws = (unsigned char*)d_ws;
    hipLaunchKernelGGL(k_fwd, dim3(grid), dim3(512), LDS_BYTES, stream, p, 0, NPH);
}
```

```cpp
#include <hip/hip_runtime.h>
#include <stdint.h>
#include <cstdio>

typedef unsigned short bf16_t;
typedef short bf16x8 __attribute__((ext_vector_type(8)));
typedef float f32x4 __attribute__((ext_vector_type(4)));
typedef unsigned u32x4 __attribute__((ext_vector_type(4)));
typedef unsigned u32x2 __attribute__((ext_vector_type(2)));
typedef short v4i16_t __attribute__((ext_vector_type(4)));
#define LAS __attribute__((address_space(3)))

constexpr int T = 32768, SEQ = 16384, DM = 1024;
constexpr int EIN = 7176, OIN = 2628;
constexpr float EPS = 1e-6f;
constexpr size_t MB = 1048576;
constexpr size_t OFF_CTL = 0;
constexpr size_t OFF_GATES = 64 * 1024;
constexpr size_t OFF_BQ = OFF_GATES + (size_t)T * 8 * 4;
constexpr size_t OFF_IQ = OFF_BQ + (size_t)T * 4 * 4;
constexpr size_t OFF_MT = OFF_IQ + (size_t)T * 4 * 4;
constexpr size_t OFF_WI = OFF_MT + (size_t)T * 4 * 4;
constexpr size_t OFF_CH = OFF_WI + (size_t)T * 4 * 4;
constexpr size_t OFF_NS = OFF_CH + 64 * 1024;
constexpr size_t OFF_W = 4 * MB;
constexpr size_t OFF_W0T = OFF_W;
constexpr size_t OFF_WPT = OFF_W0T + (size_t)7168 * 1024 * 2;
constexpr size_t OFF_WO0T = OFF_WPT + (size_t)4 * 256 * 256 * 2;
constexpr size_t OFF_W1T = OFF_WO0T + (size_t)1024 * 2048 * 2;
constexpr size_t OFF_WUKT = OFF_W1T + (size_t)2816 * 1024 * 2;
constexpr size_t OFF_WUVT = OFF_WUKT + (size_t)1024 * 256 * 2;
constexpr size_t OFF_WO1T = OFF_WUVT + (size_t)1024 * 256 * 2;
constexpr size_t OFF_WUKP = OFF_WO1T + (size_t)1024 * 1024 * 2;
constexpr size_t OFF_WQP = OFF_WUKP + (size_t)1024 * 256 * 2;
constexpr size_t OFF_WUB = OFF_WQP + (size_t)16 * 256 * 64 * 2;
constexpr size_t OFF_XN = 36 * MB, OFF_QB = 100 * MB, OFF_KB = 164 * MB, OFF_VB = 228 * MB, OFF_TMP = 292 * MB, OFF_Y = 356 * MB;
constexpr size_t OFF_QP = 36 * MB;
constexpr size_t OFF_CKVN = OFF_Y;
constexpr size_t OFF_QI = OFF_Y + 16 * MB;
constexpr size_t OFF_KI = OFF_Y + 32 * MB;
constexpr size_t OFF_KIT = OFF_Y + 36 * MB;
constexpr size_t OFF_IDX = OFF_Y + 40 * MB;
constexpr size_t OFF_RK = OFF_Y + 58 * MB;
constexpr size_t OFF_CNT = OFF_Y + 59 * MB;
constexpr size_t OFF_Z = OFF_Y + 60 * MB;
constexpr size_t OFF_WBD = 484 * MB;
constexpr size_t OFF_WQF = 486 * MB;
constexpr size_t WS_END = 487 * MB;
constexpr int LDS_BYTES = 151552;
constexpr int NPH = 17;

struct P {
    const float *x, *e_norm, *e_w_in, *e_conv, *e_b_if, *e_g_head, *e_w_pool, *e_s_pool, *e_w_out;
    const float *o_norm, *o_w_in, *o_g_kv, *o_w_uk, *o_w_uv, *o_g_q, *o_g_k, *o_w_out, *rel_bias;
    float* out; unsigned char* ws;
};

__device__ __forceinline__ bf16_t f2bf(float f) { unsigned u = __float_as_uint(f); u += 0x7FFFu + ((u >> 16) & 1u); return (bf16_t)(u >> 16); }
__device__ __forceinline__ float bf2f(bf16_t b) { return __uint_as_float(((unsigned)b) << 16); }
__device__ __forceinline__ float bflo(unsigned w) { return __uint_as_float(w << 16); }
__device__ __forceinline__ float bfhi(unsigned w) { return __uint_as_float(w & 0xffff0000u); }
__device__ __forceinline__ unsigned pk2(float a, float b) { return (unsigned)f2bf(a) | ((unsigned)f2bf(b) << 16); }
__device__ __forceinline__ float sigmoidf_(float x) { return __builtin_amdgcn_rcpf(1.0f + __expf(-x)); }
__device__ __forceinline__ float siluf_(float x) { return x * __builtin_amdgcn_rcpf(1.0f + __expf(-x)); }
template <int CTRL> __device__ __forceinline__ float dppf(float v) { return __builtin_bit_cast(float, __builtin_amdgcn_update_dpp(0, __builtin_bit_cast(int, v), CTRL, 0xf, 0xf, true)); }
__device__ __forceinline__ float rlf(float v, int l) { return __builtin_bit_cast(float, __builtin_amdgcn_readlane(__builtin_bit_cast(int, v), l)); }
__device__ __forceinline__ float wave_sum(float v) {
    v += dppf<0xB1>(v); v += dppf<0x4E>(v); v += dppf<0x141>(v); v += dppf<0x140>(v);
    return (rlf(v, 0) + rlf(v, 16)) + (rlf(v, 32) + rlf(v, 48));
}
__device__ __forceinline__ float wave_max(float v) {
    v = fmaxf(v, dppf<0xB1>(v)); v = fmaxf(v, dppf<0x4E>(v)); v = fmaxf(v, dppf<0x141>(v)); v = fmaxf(v, dppf<0x140>(v));
    return fmaxf(fmaxf(rlf(v, 0), rlf(v, 16)), fmaxf(rlf(v, 32), rlf(v, 48)));
}

#define XB_TMO      128
#define XB_XCNT(j)  (256  + 64 * (j))
#define XB_XSUB(j)  (1280 + 64 * (j))
#define XB_XGEN(j)  (2304 + 64 * (j))
#define XB_TOP      3328
#define XB_TOPGEN   3392
#define XCD_BAR_WORDS 3456
#define XB_SPIN_CAP (1u << 22)
__device__ __forceinline__ unsigned xb_ld(unsigned* p)              { return __hip_atomic_load(p, __ATOMIC_RELAXED, __HIP_MEMORY_SCOPE_AGENT); }
__device__ __forceinline__ unsigned xb_add(unsigned* p, unsigned v) { return __hip_atomic_fetch_add(p, v, __ATOMIC_RELAXED, __HIP_MEMORY_SCOPE_AGENT); }
__device__ __forceinline__ unsigned xb_xcc_id() { return (unsigned)__builtin_amdgcn_s_getreg((3 << 11) | 20) & 0xFu; }
#define XB_SPIN(cond, bar) do { unsigned _sp = 0; while (cond) { __builtin_amdgcn_s_sleep(1); \
    if ((++_sp & 255u) == 0u) { if (xb_ld(&(bar)[XB_TMO])) break; if (_sp > XB_SPIN_CAP) { atomicAdd(&(bar)[XB_TMO], 1u); break; } } } } while (0)
struct XcdBarrier { unsigned* bar; unsigned x; volatile LAS unsigned* st; };
__device__ __forceinline__ XcdBarrier xcd_barrier_post(unsigned* bar, volatile LAS unsigned* st) {
    XcdBarrier b; b.bar = bar; b.x = xb_xcc_id(); b.st = st;
    if (threadIdx.x == 0) (void)xb_add(&bar[XB_XCNT(b.x)], 1u);
    return b;
}
__device__ __forceinline__ void xcd_barrier_complete(unsigned* bar, unsigned x, unsigned& nloc, unsigned& nx) {
    const unsigned G = gridDim.x * gridDim.y * gridDim.z;
    unsigned sum, cnt, mine, sp = 0u;
    for (;;) {
        sum = 0u; cnt = 0u; mine = 0u;
#pragma unroll
        for (unsigned j = 0; j < 16; ++j) { const unsigned c = xb_ld(&bar[XB_XCNT(j)]); sum += c; cnt += (c > 0u) ? 1u : 0u; mine = (j == x) ? c : mine; }
        if (sum == G) break;
        __builtin_amdgcn_s_sleep(1);
        if ((++sp & 255u) == 0u) { if (xb_ld(&bar[XB_TMO])) break; if (sp > XB_SPIN_CAP) { atomicAdd(&bar[XB_TMO], 1u); break; } }
    }
    nloc = mine > 0u ? mine : 1u; nx = cnt > 0u ? cnt : 1u;
}
__device__ __forceinline__ void xcd_barrier(const XcdBarrier& b) {
    asm volatile("s_waitcnt vmcnt(0)" ::: "memory");
    __syncthreads();
    if (threadIdx.x == 0) {
        unsigned* bar = b.bar;
        __builtin_amdgcn_s_waitcnt(0);
        unsigned nloc = b.st[0], nx = b.st[1];
        if (nloc == 0u) { xcd_barrier_complete(bar, b.x, nloc, nx); b.st[0] = nloc; b.st[1] = nx; }
        const unsigned old = xb_add(&bar[XB_XSUB(b.x)], 1u);
        const unsigned gen = old / nloc;
        if (old + 1u == (gen + 1u) * nloc) {
            __builtin_amdgcn_fence(__ATOMIC_RELEASE, "agent");
            asm volatile("s_waitcnt vmcnt(0)" ::: "memory");
            const unsigned og = xb_add(&bar[XB_TOP], 1u);
            const unsigned tg = og / nx;
            if (og + 1u == (tg + 1u) * nx) xb_add(&bar[XB_TOPGEN], 1u);
            else XB_SPIN(xb_ld(&bar[XB_TOPGEN]) == tg, bar);
            __builtin_amdgcn_fence(__ATOMIC_ACQUIRE, "agent");
            xb_add(&bar[XB_XGEN(b.x)], 1u);
            asm volatile("s_waitcnt vmcnt(0)" ::: "memory");
        } else {
            XB_SPIN(xb_ld(&bar[XB_XGEN(b.x)]) == gen, bar);
            __builtin_amdgcn_fence(__ATOMIC_ACQUIRE, "agent");
            asm volatile("s_waitcnt vmcnt(0)" ::: "memory");
        }
    }
    __syncthreads();
}

struct Tile { const bf16_t* A; const bf16_t* B; int lda, ldb, K; void* d0; const void* s0; int ld; };
template <class F>
__device__ __forceinline__ void sgemm(const F f, int nunits) {
    const int lane = threadIdx.x & 63, wave = threadIdx.x >> 6, fr = lane & 15, fq = lane >> 4;
    for (int u = blockIdx.x * 8 + wave; u < nunits; u += gridDim.x * 8) {
        Tile tl; f.tile(u, tl);
        f32x4 acc[4][4];
#pragma unroll
        for (int m = 0; m < 4; ++m)
#pragma unroll
            for (int n = 0; n < 4; ++n) acc[m][n] = (f32x4){0.f, 0.f, 0.f, 0.f};
        const bf16_t* ap = tl.A + (size_t)fr * tl.lda + fq * 8;
        const bf16_t* bp = tl.B + (size_t)fr * tl.ldb + fq * 8;
        const int K = tl.K, lda = tl.lda, ldb = tl.ldb;
        bf16x8 a[4], b[4];
#pragma unroll
        for (int m = 0; m < 4; ++m) a[m] = *(const bf16x8*)(ap + (size_t)(m * 16) * lda);
#pragma unroll
        for (int n = 0; n < 4; ++n) b[n] = *(const bf16x8*)(bp + (size_t)(n * 16) * ldb);
#pragma unroll 1
        for (int k0 = 0; k0 < K; k0 += 32) {
            bf16x8 an[4], bn[4]; const int kn = (k0 + 32 < K) ? k0 + 32 : k0;
#pragma unroll
            for (int m = 0; m < 4; ++m) an[m] = *(const bf16x8*)(ap + (size_t)(m * 16) * lda + kn);
#pragma unroll
            for (int n = 0; n < 4; ++n) bn[n] = *(const bf16x8*)(bp + (size_t)(n * 16) * ldb + kn);
#pragma unroll
            for (int m = 0; m < 4; ++m)
#pragma unroll
                for (int n = 0; n < 4; ++n) acc[m][n] = __builtin_amdgcn_mfma_f32_16x16x32_bf16(b[n], a[m], acc[m][n], 0, 0, 0);
#pragma unroll
            for (int m = 0; m < 4; ++m) { a[m] = an[m]; b[m] = bn[m]; }
        }
#pragma unroll
        for (int m = 0; m < 4; ++m) {
            asm volatile("" ::: "memory");
#pragma unroll
            for (int n = 0; n < 4; ++n) f.out4(tl, m * 16 + fr, n * 16 + 4 * fq, acc[m][n]);
        }
    }
}
__device__ __forceinline__ void store4_bf16(const Tile& tl, int r, int c, const f32x4 v) {
    u32x2 w; w.x = pk2(v[0], v[1]); w.y = pk2(v[2], v[3]); *(u32x2*)((bf16_t*)tl.d0 + (size_t)r * tl.ld + c) = w; }

struct GWP {
    const bf16_t* WPT; const bf16_t* WUB; bf16_t* W0T;
    __device__ __forceinline__ void tile(int u, Tile& tl) const {
        const int kt = u & 15, dt = (u >> 4) & 3, g = u >> 6; tl.A = WPT + (size_t)(g * 256 + dt * 64) * 256; tl.lda = 256; tl.B = WUB + (size_t)kt * 64 * 1024 + g * 256; tl.ldb = 1024; tl.K = 256;
        tl.d0 = W0T + (size_t)(5120 + g * 256 + dt * 64) * 1024 + kt * 64; tl.ld = 1024; }
    __device__ __forceinline__ void out4(const Tile& tl, int r, int c, const f32x4 v) const { store4_bf16(tl, r, c, v); }
};
struct GQP {
    const bf16_t* Qn; const bf16_t* W; bf16_t* QP;
    __device__ __forceinline__ void tile(int u, Tile& tl) const {
        const int nt = u & 3, head = (u >> 2) & 15, mt = u >> 6; tl.A = Qn + (size_t)mt * 64 * 1024 + head * 64; tl.lda = 1024; tl.B = W + (size_t)(head * 256 + nt * 64) * 64; tl.ldb = 64; tl.K = 64;
        tl.d0 = QP + ((size_t)mt * 64 * 16 + head) * 256 + nt * 64; tl.ld = 4096; }
    __device__ __forceinline__ void out4(const Tile& tl, int r, int c, const f32x4 v) const { store4_bf16(tl, r, c, v); }
};
struct GOP {
    const bf16_t* OP; const bf16_t* W; const bf16_t* Z; bf16_t* G;
    __device__ __forceinline__ void tile(int u, Tile& tl) const {
        const int head = u & 15, mt = u >> 4; tl.A = OP + (size_t)mt * 64 * 4096 + head * 256; tl.lda = 4096; tl.B = W + (size_t)head * 64 * 256; tl.ldb = 256; tl.K = 256;
        const size_t o = (size_t)mt * 64 * 1024 + head * 64; tl.d0 = G + o; tl.s0 = Z + o; tl.ld = 1024; }
    __device__ __forceinline__ void out4(const Tile& tl, int r, int c, const f32x4 v) const { const size_t i = (size_t)r * 1024 + c; const u32x2 z = *(const u32x2*)((const bf16_t*)tl.s0 + i);
        u32x2 w; w.x = pk2(v[0] * bflo(z.x), v[1] * bfhi(z.x)); w.y = pk2(v[2] * bflo(z.y), v[3] * bfhi(z.y)); *(u32x2*)((bf16_t*)tl.d0 + i) = w; }
};

namespace pg8 {
constexpr int BM = 256, BK = 64, HALF = 128, HTB = HALF * BK * 2, STAGE_BYTES = 8 * HTB, NXCD = 8, WGM = 8;
__device__ __forceinline__ int lds_byte(int r, int c) { return (r >> 3) * 1024 + (r & 7) * 128 + ((((c >> 3) ^ (r >> 1)) & 7) << 4) + (c & 7) * 2; }
__device__ __forceinline__ void stage_rc(int b, int& R, int& C) { const int st = b / 1024, sb = b % 1024; R = st * 8 + (sb >> 7); C = ((((sb >> 4) & 7) ^ (R >> 1)) & 7) * 8; }
__device__ __forceinline__ int perm32(int rho) { const int n = rho >> 4, i = rho & 15; return 8 * (i >> 2) + 4 * n + (i & 3); }
struct Unit { int pm, pn; };
struct Gemm { const bf16_t* A; int lda; const bf16_t* Bt; int ldb; int M, N, K; size_t apn; };
struct StaticOrder {
    int nM, nN, nwg, G, c;
    __device__ void init(int M, int N, int G_, int c_) { nM = M / BM; nN = N / BM; nwg = nM * nN; G = G_; c = c_; }
    __device__ bool next(int i, Unit& u) const {
        const long L = (long)i * G + c; if (L >= nwg) return false;
        int wgid = (int)L; { const int q = nwg / NXCD, r = nwg % NXCD, xcd = wgid % NXCD, off = wgid / NXCD; wgid = (xcd < r ? xcd * (q + 1) : r * (q + 1) + (xcd - r) * q) + off; }
        const int nig = WGM * nN, gid = wgid / nig, fm = gid * WGM, gsz = (nM - fm) < WGM ? (nM - fm) : WGM;
        u.pm = fm + ((wgid % nig) % gsz); u.pn = (wgid % nig) / gsz; return true;
    }
};
__device__ __forceinline__ unsigned cvt_pk_bf16(float lo, float hi) { unsigned r; asm volatile("v_cvt_pk_bf16_f32 %0, %1, %2" : "=v"(r) : "v"(lo), "v"(hi)); return r; }

struct Dst { unsigned char* base; const float* res; int ld, mode, ncol; float scale; };
template <class DescF> struct EpiGen {
    static constexpr bool PERM = true;
    DescF D;
    __device__ __forceinline__ void operator()(const f32x4 (&acc)[2][2][4][2], const Unit& u, int wr, int wc, int fr, int fq) const {
        Dst d; D.get(u, d);
        if ((DescF::MODES & 16) && d.mode == 4) return;
        const int r0 = wr * 64 + fr, c0 = wc * 32 + 8 * fq;
        if constexpr ((DescF::MODES & 64) != 0) {
#pragma unroll
            for (int ai = 0; ai < 2; ++ai)
#pragma unroll
                for (int m = 0; m < 4; ++m) {
                    float ss = 0.f;
#pragma unroll
                    for (int bj = 0; bj < 2; ++bj)
#pragma unroll
                        for (int n = 0; n < 2; ++n) { const f32x4 v = acc[ai][bj][m][n]; ss += v[0] * v[0] + v[1] * v[1] + v[2] * v[2] + v[3] * v[3]; }
                    ss += __shfl_xor(ss, 16); ss += __shfl_xor(ss, 32);
                    if (fq == 0) ((bf16_t*)d.base)[(size_t)(ai * HALF + r0 + m * 16) * d.ld + wc] = f2bf(rsqrtf(ss * (1.0f / 64.0f) + EPS) * 1.4426950408889634f);
                }
            return;
        } else {
#pragma unroll
        for (int ai = 0; ai < 2; ++ai)
#pragma unroll
            for (int m = 0; m < 4; ++m) {
                const size_t rowoff = (size_t)(ai * HALF + r0 + m * 16) * d.ld;
#pragma unroll
                for (int bj = 0; bj < 2; ++bj) {
                    const int col = bj * HALF + c0; f32x4 v0 = acc[ai][bj][m][0], v1 = acc[ai][bj][m][1];
                    if ((DescF::MODES & 7) && d.mode <= 2) {
                        if ((DescF::MODES & 2) && d.mode == 1) {
#pragma unroll
                            for (int j = 0; j < 4; ++j) { v0[j] = sigmoidf_(v0[j]); v1[j] = sigmoidf_(v1[j]); } }
                        if ((DescF::MODES & 4) && d.mode == 2) {
#pragma unroll
                            for (int j = 0; j < 4; ++j) { v0[j] = siluf_(v0[j]); v1[j] = siluf_(v1[j]); } }
                        u32x4 w; w.x = cvt_pk_bf16(v0[0], v0[1]); w.y = cvt_pk_bf16(v0[2], v0[3]); w.z = cvt_pk_bf16(v1[0], v1[1]); w.w = cvt_pk_bf16(v1[2], v1[3]);
                        *(u32x4*)((bf16_t*)d.base + rowoff + col) = w;
                    } else if ((DescF::MODES & 256) && d.mode == 8) {
                        const u32x4 z = *(const u32x4*)((const bf16_t*)d.res + rowoff + col);
                        u32x4 w; w.x = cvt_pk_bf16(v0[0] * bflo(z.x), v0[1] * bfhi(z.x)); w.y = cvt_pk_bf16(v0[2] * bflo(z.y), v0[3] * bfhi(z.y));
                        w.z = cvt_pk_bf16(v1[0] * bflo(z.z), v1[1] * bfhi(z.z)); w.w = cvt_pk_bf16(v1[2] * bflo(z.w), v1[3] * bfhi(z.w));
                        *(u32x4*)((bf16_t*)d.base + rowoff + col) = w;
                    } else if ((DescF::MODES & 8) && d.mode == 3) {
                        if (col < d.ncol) { float* o = (float*)d.base + rowoff + col; *(f32x4*)o = v0 * d.scale; *(f32x4*)(o + 4) = v1 * d.scale; }
                    } else if ((DescF::MODES & 128) && d.mode == 7) {
                        typedef _Float16 h8 __attribute__((ext_vector_type(8)));
                        if (col < d.ncol) {
                        h8 hv; hv[0] = (_Float16)(v0[0] * d.scale); hv[1] = (_Float16)(v0[1] * d.scale); hv[2] = (_Float16)(v0[2] * d.scale); hv[3] = (_Float16)(v0[3] * d.scale);
                        hv[4] = (_Float16)(v1[0] * d.scale); hv[5] = (_Float16)(v1[1] * d.scale); hv[6] = (_Float16)(v1[2] * d.scale); hv[7] = (_Float16)(v1[3] * d.scale);
                        *(h8*)((_Float16*)d.base + rowoff + col) = hv; }
                    } else if constexpr ((DescF::MODES & 32) != 0) {
                        float* o = (float*)d.base + rowoff + col; const float* rs = d.res + rowoff + col;
                        const f32x4 a = *(const f32x4*)rs, b = *(const f32x4*)(rs + 4); *(f32x4*)o = a + v0; *(f32x4*)(o + 4) = b + v1;
                    }
                }
                if (m & 1) asm volatile("" ::: "memory");
            }
        }
    }
};

template <class Epi>
__device__ __forceinline__ void gemm_phase(LAS unsigned char* lds, const Gemm g, const StaticOrder& S, const Epi& E) {
    const int tid = threadIdx.x, wid = __builtin_amdgcn_readfirstlane(tid >> 6), lane = tid & 63, wr = wid >> 2, wc = wid & 3, fr = lane & 15, fq = lane >> 4;
    int K = g.K; asm volatile("" : "+s"(K));
    const int nt = K / BK;
    unsigned voffA[2], voffB[2];
#pragma unroll
    for (int i = 0; i < 2; ++i) { int R, C; stage_rc(tid * 16 + i * 8192, R, C); const int Rb = Epi::PERM ? ((R & ~31) + perm32(R & 31)) : R;
        voffA[i] = (unsigned)(R * g.lda + C) * 2u; voffB[i] = (unsigned)(Rb * g.ldb + C) * 2u; }
    const size_t kstep = (size_t)(BK * 2);
    const size_t hstepA = (size_t)HALF * g.lda * 2, hstepB = (size_t)HALF * g.ldb * 2;
    const size_t tstepA = 2 * hstepA, tstepB = 2 * hstepB;
    const unsigned ldsw = (unsigned)wid * 1024u;
    const int aoff = lds_byte(wr * 64 + fr, fq * 8), boff = lds_byte(wc * 32 + fr, fq * 8), aoff1 = aoff ^ 64, boff1 = boff ^ 64;
#define PG8_SA(b, h) (((b) * 2 + (h)) * HTB)
#define PG8_SB(b, h) ((4 + (b) * 2 + (h)) * HTB)
#define PG8_STAGE(bufoff, gbase, voff) do { _Pragma("unroll") for (int _i = 0; _i < 2; ++_i) \
        __builtin_amdgcn_global_load_lds((const unsigned*)((const char*)(gbase) + (voff)[_i]), (LAS unsigned*)(lds + (bufoff) + ldsw + _i * 8192), 16, 0, 0); } while (0)
#define PG8_LDA(dst, b, h) do { _Pragma("unroll") for (int m = 0; m < 4; ++m) _Pragma("unroll") for (int k = 0; k < 2; ++k) dst[m][k] = *(const LAS bf16x8*)(lds + PG8_SA(b, h) + (k ? aoff1 : aoff) + m * 2048); } while (0)
#define PG8_LDB(dst, b, h) do { _Pragma("unroll") for (int n = 0; n < 2; ++n) _Pragma("unroll") for (int k = 0; k < 2; ++k) dst[n][k] = *(const LAS bf16x8*)(lds + PG8_SB(b, h) + (k ? boff1 : boff) + n * 2048); } while (0)
#define PG8_MMA(ai, bj, At, Bt) do { __builtin_amdgcn_s_setprio(1); _Pragma("unroll") for (int m = 0; m < 4; ++m) _Pragma("unroll") for (int n = 0; n < 2; ++n) _Pragma("unroll") for (int k = 0; k < 2; ++k) \
        acc[ai][bj][m][n] = __builtin_amdgcn_mfma_f32_16x16x32_bf16(Bt[n][k], At[m][k], acc[ai][bj][m][n], 0, 0, 0); __builtin_amdgcn_s_setprio(0); } while (0)
#define PG8_WAIT_V(n) asm volatile("s_waitcnt vmcnt(" #n ")" ::: "memory")
#define PG8_WAIT_L(n) asm volatile("s_waitcnt lgkmcnt(" #n ")" ::: "memory")
#define PG8_BAR __builtin_amdgcn_s_barrier()
#define PG8_SCHED __builtin_amdgcn_sched_barrier(0)
    Unit cur, nxt; int ui = 0;
    if (!S.next(0, cur)) return;
    f32x4 acc[2][2][4][2];
#pragma unroll
    for (int a = 0; a < 2; ++a)
#pragma unroll
        for (int b = 0; b < 2; ++b)
#pragma unroll
            for (int m = 0; m < 4; ++m)
#pragma unroll
                for (int n = 0; n < 2; ++n) acc[a][b][m][n] = (f32x4){0.f, 0.f, 0.f, 0.f};
    bf16x8 At[4][2], B0[2][2], B1[2][2];
    const char* cA = (const char*)g.A + (size_t)cur.pm * tstepA + (size_t)cur.pn * g.apn; const char* cB = (const char*)g.Bt + (size_t)cur.pn * tstepB;
    PG8_STAGE(PG8_SB(0, 0), cB, voffB); PG8_STAGE(PG8_SA(0, 0), cA, voffA); PG8_STAGE(PG8_SB(0, 1), cB + hstepB, voffB); PG8_STAGE(PG8_SA(0, 1), cA + hstepA, voffA);
    if (wr == 1) PG8_BAR;
    PG8_WAIT_V(4); PG8_BAR;
    PG8_STAGE(PG8_SB(1, 0), cB + kstep, voffB); PG8_STAGE(PG8_SA(1, 0), cA + kstep, voffA); PG8_STAGE(PG8_SB(1, 1), cB + hstepB + kstep, voffB);
    PG8_WAIT_V(6); PG8_BAR;
    for (;;) {
        const bool has_next = S.next(ui + 1, nxt);
        const char* nA = has_next ? (const char*)g.A + (size_t)nxt.pm * tstepA + (size_t)nxt.pn * g.apn : cA; const char* nB = has_next ? (const char*)g.Bt + (size_t)nxt.pn * tstepB : cB;
#pragma unroll 1
        for (int t = 0; t < nt; t += 2) {
            const bool last = (t == nt - 2);
            const char* a1 = cA + (size_t)(t + 1) * kstep;
            const char* a2 = last ? nA : cA + (size_t)(t + 2) * kstep; const char* b2 = last ? nB : cB + (size_t)(t + 2) * kstep;
            const char* a3 = a2 + kstep; const char* b3 = b2 + kstep;
            PG8_LDB(B0, 0, 0); PG8_SCHED; PG8_LDA(At, 0, 0); PG8_STAGE(PG8_SA(1, 1), a1 + hstepA, voffA);
            PG8_WAIT_L(8); PG8_BAR; PG8_WAIT_L(0); PG8_MMA(0, 0, At, B0); PG8_BAR; PG8_SCHED;
            PG8_LDB(B1, 0, 1); PG8_STAGE(PG8_SB(0, 0), b2, voffB);
            PG8_BAR; PG8_WAIT_L(0); PG8_MMA(0, 1, At, B1); PG8_BAR;
            PG8_LDA(At, 0, 1); PG8_STAGE(PG8_SA(0, 0), a2, voffA);
            PG8_BAR; PG8_WAIT_L(0); PG8_MMA(1, 0, At, B0); PG8_BAR; PG8_SCHED;
            PG8_STAGE(PG8_SB(0, 1), b2 + hstepB, voffB);
            PG8_WAIT_V(6); PG8_BAR; PG8_MMA(1, 1, At, B1); PG8_BAR;
            PG8_LDB(B0, 1, 0); PG8_SCHED; PG8_LDA(At, 1, 0); PG8_STAGE(PG8_SA(0, 1), a2 + hstepA, voffA);
            PG8_WAIT_L(8); PG8_BAR; PG8_WAIT_L(0); PG8_MMA(0, 0, At, B0); PG8_BAR; PG8_SCHED;
            PG8_LDB(B1, 1, 1); PG8_STAGE(PG8_SB(1, 0), b3, voffB);
            PG8_BAR; PG8_WAIT_L(0); PG8_MMA(0, 1, At, B1); PG8_BAR;
            PG8_LDA(At, 1, 1); PG8_STAGE(PG8_SA(1, 0), a3, voffA);
            PG8_BAR; PG8_WAIT_L(0); PG8_MMA(1, 0, At, B0); PG8_BAR; PG8_SCHED;
            PG8_STAGE(PG8_SB(1, 1), b3 + hstepB, voffB);
            PG8_WAIT_V(6); PG8_BAR; PG8_MMA(1, 1, At, B1); PG8_BAR;
        }
        E(acc, cur, wr, wc, fr, fq);
        if (!has_next) break;
#pragma unroll
        for (int a = 0; a < 2; ++a)
#pragma unroll
            for (int b = 0; b < 2; ++b)
#pragma unroll
                for (int m = 0; m < 4; ++m)
#pragma unroll
                    for (int n = 0; n < 2; ++n) acc[a][b][m][n] = (f32x4){0.f, 0.f, 0.f, 0.f};
        cur = nxt; cA = nA; cB = nB; ++ui;
    }
    PG8_WAIT_V(0);
    if (wr == 0) PG8_BAR;
    PG8_BAR;
#undef PG8_SA
#undef PG8_SB
#undef PG8_STAGE
#undef PG8_LDA
#undef PG8_LDB
#undef PG8_MMA
#undef PG8_WAIT_V
#undef PG8_WAIT_L
#undef PG8_BAR
#undef PG8_SCHED
}
}

struct D1 { static constexpr int MODES = 1; unsigned char* ws;
    __device__ __forceinline__ void get(const pg8::Unit& u, pg8::Dst& d) const { const int sec = u.pn >> 2;
        d.base = ws + OFF_QB + (size_t)sec * (64 * MB) + ((size_t)u.pm * 256 * 1024 + (u.pn & 3) * 256) * 2; d.res = nullptr; d.ld = 1024; d.mode = 0; d.ncol = 256; d.scale = 1.f; } };
struct D2 { static constexpr int MODES = 7; unsigned char* ws;
    __device__ __forceinline__ void get(const pg8::Unit& u, pg8::Dst& d) const { const int sec = u.pn >> 2, cc = (u.pn & 3) * 256; d.res = nullptr; d.ncol = 256; d.scale = 1.f;
        if (sec < 3) { d.base = ws + OFF_QB + (size_t)sec * (64 * MB) + ((size_t)u.pm * 256 * 1024 + cc) * 2; d.ld = 1024; d.mode = sec == 0 ? 1 : (sec == 1 ? 2 : 0); }
        else { d.base = ws + OFF_Y + ((size_t)u.pm * 256 * 2048 + 1024 + cc) * 2; d.ld = 2048; d.mode = 2; } } };
struct D4 { static constexpr int MODES = 32; unsigned char* out; const float* x;
    __device__ __forceinline__ void get(const pg8::Unit& u, pg8::Dst& d) const { const size_t o = (size_t)u.pm * 256 * 1024 + u.pn * 256;
        d.base = out + o * 4; d.res = x + o; d.ld = 1024; d.mode = 5; d.ncol = 256; d.scale = 1.f; } };
struct D5 { static constexpr int MODES = 133; unsigned char* ws;
    __device__ __forceinline__ void get(const pg8::Unit& u, pg8::Dst& d) const { const int pn = u.pn; d.res = nullptr; d.ncol = 256; d.scale = 1.f;
        if (pn < 4) { d.base = ws + OFF_TMP + ((size_t)u.pm * 256 * 1024 + pn * 256) * 2; d.ld = 1024; d.mode = 0; }
        else if (pn == 4) { d.base = ws + OFF_CKVN + (size_t)u.pm * 256 * 256 * 2; d.ld = 256; d.mode = 0; }
        else if (pn == 5) { d.base = ws + OFF_QI + (size_t)u.pm * 256 * 256 * 2; d.ld = 256; d.mode = 7; d.scale = 0.125f; }
        else if (pn == 6) { d.base = ws + OFF_KI + (size_t)u.pm * 256 * 64 * 2; d.ld = 64; d.mode = 7; d.ncol = 64; }
        else { d.base = ws + OFF_Z + ((size_t)u.pm * 256 * 1024 + (pn - 7) * 256) * 2; d.ld = 1024; d.mode = 2; } } };
struct DK { static constexpr int MODES = 64; unsigned char* ws;
    __device__ __forceinline__ void get(const pg8::Unit& u, pg8::Dst& d) const {
        d.base = ws + OFF_RK + ((size_t)u.pm * 256 * 16 + u.pn * 4) * 2; d.res = nullptr; d.ld = 16; d.mode = 6; d.ncol = 256; d.scale = 1.f; } };
struct D8 { static constexpr int MODES = 32; unsigned char* out;
    __device__ __forceinline__ void get(const pg8::Unit& u, pg8::Dst& d) const { const size_t o = (size_t)u.pm * 256 * 1024 + u.pn * 256;
        d.base = out + o * 4; d.res = (const float*)out + o; d.ld = 1024; d.mode = 5; d.ncol = 256; d.scale = 1.f; } };
struct DQ { static constexpr int MODES = 1; unsigned char* ws;
    __device__ __forceinline__ void get(const pg8::Unit& u, pg8::Dst& d) const {
        d.base = ws + OFF_QP + ((size_t)u.pm * 256 * 4096 + u.pn * 256) * 2; d.res = nullptr; d.ld = 4096; d.mode = 0; d.ncol = 256; d.scale = 1.f; } };
struct DO { static constexpr int MODES = 256; unsigned char* ws;
    __device__ __forceinline__ void get(const pg8::Unit& u, pg8::Dst& d) const { const size_t o = ((size_t)u.pm * 256 * 1024 + u.pn * 256) * 2;
        d.base = ws + OFF_TMP + o; d.res = (const float*)(ws + OFF_Z + o); d.ld = 1024; d.mode = 8; d.ncol = 256; d.scale = 1.f; } };
template <class DF>
__device__ __forceinline__ void fast_gemm(unsigned char* lds, const bf16_t* A, int lda, const bf16_t* Bt, int ldb, int N, int K, const DF& df, size_t apn = 0) {
    pg8::Gemm g{A, lda, Bt, ldb, T, N, K, apn}; pg8::StaticOrder S; S.init(T, N, (int)gridDim.x, (int)blockIdx.x);
    pg8::EpiGen<DF> E{df};
    pg8::gemm_phase(( LAS unsigned char*)lds, g, S, E);
}

__device__ __forceinline__ void tconv(const float* __restrict__ src, int ld, int col0, int ncols, int K, bf16_t* __restrict__ dst, float* tile  ) {
    const int nkt = K / 64, ntiles = nkt * (ncols / 64), tid = threadIdx.x;
    for (int id = blockIdx.x; id < ntiles; id += gridDim.x) {
        const int kt = id % nkt, nt = id / nkt;
#pragma unroll
        for (int j = 0; j < 8; ++j) { const int e = tid + 512 * j, kk = e >> 6, nn = e & 63; tile[kk * 65 + nn] = src[(size_t)(kt * 64 + kk) * ld + col0 + nt * 64 + nn]; }
        __syncthreads();
#pragma unroll
        for (int j = 0; j < 8; ++j) { const int e = tid + 512 * j, nn = e >> 6, kk = e & 63; dst[(size_t)(nt * 64 + nn) * K + kt * 64 + kk] = f2bf(tile[kk * 65 + nn]); }
        __syncthreads();
    }
}
template <int NE>
__device__ __forceinline__ void rmsnorm_rows(const float* __restrict__ src, const float* __restrict__ g, bf16_t* __restrict__ dst,
                             const float* __restrict__ Wx, int ldw, int col0, const float* __restrict__ bias, float scale, float* __restrict__ dstx, float* wl) {
    const int lane = threadIdx.x & 63, wave = threadIdx.x >> 6;
    __syncthreads();
    for (int i = threadIdx.x; i < NE * 1024; i += 512) { const int k = i / NE, e = i % NE; wl[e * 1024 + k] = Wx[(size_t)k * ldw + col0 + e]; }
    __syncthreads();
    for (int row0 = (blockIdx.x * 8 + wave) * 2; row0 < T; row0 += gridDim.x * 16) {
        f32x4 v[2][4];
#pragma unroll
        for (int r = 0; r < 2; ++r)
#pragma unroll
            for (int i = 0; i < 4; ++i) v[r][i] = *(const f32x4*)(src + (size_t)(row0 + r) * 1024 + i * 256 + lane * 4);
#pragma unroll
        for (int r = 0; r < 2; ++r) {
            const int row = row0 + r; float ss = 0.f;
#pragma unroll
            for (int i = 0; i < 4; ++i) ss += v[r][i][0] * v[r][i][0] + v[r][i][1] * v[r][i][1] + v[r][i][2] * v[r][i][2] + v[r][i][3] * v[r][i][3];
            ss = wave_sum(ss);
            const float rstd = rsqrtf(ss * (1.0f / 1024.0f) + EPS);
            float ex[NE];
#pragma unroll
            for (int e = 0; e < NE; ++e) ex[e] = 0.f;
#pragma unroll
            for (int i = 0; i < 4; ++i) {
                const f32x4 gg = *(const f32x4*)(g + i * 256 + lane * 4);
                f32x4 y; y[0] = v[r][i][0] * rstd * gg[0]; y[1] = v[r][i][1] * rstd * gg[1]; y[2] = v[r][i][2] * rstd * gg[2]; y[3] = v[r][i][3] * rstd * gg[3];
                u32x2 w; w.x = pk2(y[0], y[1]); w.y = pk2(y[2], y[3]);
                *(u32x2*)(dst + (size_t)row * 1024 + i * 256 + lane * 4) = w;
#pragma unroll
                for (int e = 0; e < NE; ++e) { const f32x4 wv = *(const f32x4*)(wl + e * 1024 + i * 256 + lane * 4); ex[e] += y[0] * wv[0] + y[1] * wv[1] + y[2] * wv[2] + y[3] * wv[3]; }
            }
#pragma unroll
            for (int e = 0; e < NE; ++e) { const float sx = wave_sum(ex[e]); if (lane == 0) dstx[(size_t)row * NE + e] = (sx + (bias ? bias[e] : 0.f)) * scale; }
        }
    }
}

__device__ __forceinline__ void phase_prep(const P& p, unsigned char* lds) {
    float* tile = (float*)lds; unsigned char* ws = p.ws;
    bf16_t* W0T = (bf16_t*)(ws + OFF_W0T);
    tconv(p.e_w_in, EIN, 0, 5120, 1024, W0T, tile);
    tconv(p.e_w_in, EIN, 6152, 1024, 1024, W0T + (size_t)6144 * 1024, tile);
    for (int g = 0; g < 4; ++g) tconv(p.e_w_pool + (size_t)g * 65536, 256, 0, 256, 256, (bf16_t*)(ws + OFF_WPT) + (size_t)g * 65536, tile);
    { bf16_t* WUB = (bf16_t*)(ws + OFF_WUB);
      for (size_t i = (size_t)blockIdx.x * 512 + threadIdx.x; i < (size_t)1024 * 256; i += (size_t)gridDim.x * 512) {
          const size_t k = i >> 8; const int c4 = (int)(i & 255) * 4; const f32x4 v = *(const f32x4*)(p.e_w_in + k * EIN + 5128 + c4);
          u32x2 o; o.x = pk2(v[0], v[1]); o.y = pk2(v[2], v[3]); *(u32x2*)(WUB + k * 1024 + c4) = o; } }
    tconv(p.e_w_out, 1024, 0, 1024, 2048, (bf16_t*)(ws + OFF_WO0T), tile);
    bf16_t* W1T = (bf16_t*)(ws + OFF_W1T);
    tconv(p.o_w_in, OIN, 0, 1600, 1024, W1T, tile);
    for (size_t i = (size_t)blockIdx.x * 512 + threadIdx.x; i < (size_t)192 * 1024; i += (size_t)gridDim.x * 512) W1T[(size_t)1600 * 1024 + i] = 0;
    tconv(p.o_w_in, OIN, 1604, 1024, 1024, W1T + (size_t)1792 * 1024, tile);
    {
        bf16_t* WUKP = (bf16_t*)(ws + OFF_WUKP); bf16_t* WQF = (bf16_t*)(ws + OFF_WQF); bf16_t* WBD = (bf16_t*)(ws + OFF_WBD);
        for (size_t i = (size_t)blockIdx.x * 512 + threadIdx.x; i < (size_t)1024 * 256; i += (size_t)gridDim.x * 512) {
            { const int n = (int)(i >> 8), k = (int)(i & 255), pn = n >> 8, rem = n & 255, bj = rem >> 7, wc = (rem >> 5) & 3, x = rem & 31;
              WUKP[i] = f2bf(p.o_w_uk[(size_t)k * 1024 + (4 * pn + wc) * 64 + 32 * bj + x]); }
            { const int d = (int)(i & 63), r = (int)((i >> 6) & 255), h = (int)(i >> 14); const size_t o = ((size_t)h * 256 + r) * 128 + d;
              WQF[o] = f2bf(p.o_w_uk[(size_t)r * 1024 + h * 64 + d] * p.o_g_k[d] * 0.125f); WQF[o + 64] = 0; }
            { const int r = (int)(i & 255), n = (int)(i >> 8), hl = (n >> 6) & 3; const float v = p.o_w_uv[(size_t)r * 1024 + n];
#pragma unroll
              for (int b = 0; b < 4; ++b) WBD[(size_t)n * 1024 + b * 256 + r] = (b == hl) ? f2bf(v) : (bf16_t)0; }
        }
    }
    tconv(p.o_w_out, 1024, 0, 1024, 1024, (bf16_t*)(ws + OFF_WO1T), tile);
    rmsnorm_rows<8>(p.x, p.e_norm, (bf16_t*)(ws + OFF_XN), p.e_w_in, EIN, 5120, p.e_b_if, 1.0f, (float*)(ws + OFF_GATES), (float*)lds);
}

__device__ __forceinline__ void phase_conv_scan(const P& p, unsigned char* lds) {
    unsigned char* ws = p.ws; const int tid = threadIdx.x;
    const float* GATES = (const float*)(ws + OFF_GATES);
    float *BQ = (float*)(ws + OFF_BQ), *IQ = (float*)(ws + OFF_IQ), *MT = (float*)(ws + OFF_MT), *CH = (float*)(ws + OFF_CH);
    {
        const int lane = tid & 63, wave = tid >> 6;
        for (int task = blockIdx.x * 8 + wave; task < 2048; task += gridDim.x * 8) {
            const int bh = task >> 8, c = task & 255, batch = bh >> 2, head = bh & 3; const size_t t = (size_t)batch * SEQ + c * 64 + lane;
            const float ig = GATES[t * 8 + head], f = GATES[t * 8 + 4 + head];
            float b = fminf(f, 0.f) - log1pf(__expf(-fabsf(f)));
#pragma unroll
            for (int o = 1; o < 64; o <<= 1) { const float y = __shfl_up(b, o); if (lane >= o) b += y; }
            float rm = ig - b;
#pragma unroll
            for (int o = 1; o < 64; o <<= 1) { const float y = __shfl_up(rm, o); if (lane >= o) rm = fmaxf(rm, y); }
            BQ[t * 4 + head] = b; IQ[t * 4 + head] = ig; MT[t * 4 + head] = rm;
            if (lane == 63) { CH[4096 + bh * 256 + c] = b; CH[bh * 256 + c] = b + rm; }
        }
    }
    const bf16_t* QB = (const bf16_t*)(ws + OFF_QB); const bf16_t* KB = (const bf16_t*)(ws + OFF_KB);
    bf16_t* Y = (bf16_t*)(ws + OFF_Y); bf16_t* KT = (bf16_t*)(ws + OFF_TMP);
    for (size_t it = (size_t)blockIdx.x * 512 + tid; it < (size_t)(T / 8) * 256; it += (size_t)gridDim.x * 512) {
        const size_t t0 = (it >> 8) * 8; const int c0 = (int)(it & 255) * 8, isk = c0 >= 1024, cc = c0 & 1023; const int s0 = (int)(t0 & (SEQ - 1));
        const bf16_t* src = isk ? KB : QB;
        u32x4 rw[11];
#pragma unroll
        for (int j = 0; j < 11; ++j) rw[j] = (s0 - 3 + j >= 0) ? *(const u32x4*)(src + (t0 - 3 + j) * 1024 + cc) : (u32x4){0u, 0u, 0u, 0u};
        f32x4 cw[4][2];
#pragma unroll
        for (int j = 0; j < 4; ++j) { cw[j][0] = *(const f32x4*)(p.e_conv + j * 2048 + c0); cw[j][1] = *(const f32x4*)(p.e_conv + j * 2048 + c0 + 4); }
        const float sc = isk ? 0.0625f : 1.0f;
#pragma unroll
        for (int k = 0; k < 8; ++k) {
            float acc[8];
#pragma unroll
            for (int i = 0; i < 8; ++i) acc[i] = 0.f;
#pragma unroll
            for (int j = 0; j < 4; ++j) { const u32x4 w = rw[k + j];
                acc[0] += cw[j][0][0] * bflo(w.x); acc[1] += cw[j][0][1] * bfhi(w.x); acc[2] += cw[j][0][2] * bflo(w.y); acc[3] += cw[j][0][3] * bfhi(w.y);
                acc[4] += cw[j][1][0] * bflo(w.z); acc[5] += cw[j][1][1] * bfhi(w.z); acc[6] += cw[j][1][2] * bflo(w.w); acc[7] += cw[j][1][3] * bfhi(w.w); }
            u32x4 o; o.x = pk2(siluf_(acc[0]) * sc, siluf_(acc[1]) * sc); o.y = pk2(siluf_(acc[2]) * sc, siluf_(acc[3]) * sc);
            o.z = pk2(siluf_(acc[4]) * sc, siluf_(acc[5]) * sc); o.w = pk2(siluf_(acc[6]) * sc, siluf_(acc[7]) * sc);
            if (isk) *(u32x4*)(KT + (t0 + k) * 1024 + cc) = o; else *(u32x4*)(Y + (t0 + k) * 2048 + 1024 + cc) = o;
        }
    }
}

typedef float f32x16 __attribute__((ext_vector_type(16)));
constexpr int ML_RS = 528, ML_WS = 144;
__device__ __forceinline__ bf16x8 ml_tr8(const LAS unsigned char* a, int second_off) {
    const v4i16_t t0 = __builtin_amdgcn_ds_read_tr16_b64_v4i16((LAS v4i16_t*)a);
    const v4i16_t t1 = __builtin_amdgcn_ds_read_tr16_b64_v4i16((LAS v4i16_t*)(a + second_off));
    bf16x8 r; r[0] = t0[0]; r[1] = t0[1]; r[2] = t0[2]; r[3] = t0[3]; r[4] = t1[0]; r[5] = t1[1]; r[6] = t1[2]; r[7] = t1[3]; return r;
}
struct ChunkScan { f32x4 B, mp, mn; };
__device__ __forceinline__ ChunkScan chunk_scan_wave(const float* CH, int bh, int lane) {
    ChunkScan r; r.B = *(const f32x4*)(CH + 4096 + bh * 256 + 4 * lane); const f32x4 G = *(const f32x4*)(CH + bh * 256 + 4 * lane);
    float a = r.B[0], b = G[0];
#pragma unroll
    for (int j = 1; j < 4; ++j) { b = fmaxf(r.B[j] + b, G[j]); a += r.B[j]; }
#pragma unroll
    for (int o = 1; o < 64; o <<= 1) { const float a1 = __shfl_up(a, o), b1 = __shfl_up(b, o); if (lane >= o) { b = fmaxf(a + b1, b); a += a1; } }
    const float ap = __shfl_up(a, 1), bp = __shfl_up(b, 1);
    float m = lane ? fmaxf(ap, bp) : 0.f;
#pragma unroll
    for (int j = 0; j < 4; ++j) { r.mp[j] = m; m = fmaxf(r.B[j] + m, G[j]); r.mn[j] = m; }
    return r;
}
__device__ __forceinline__ void mlstm_chunk_scan(const float* CH, int bh, LAS float* sB, LAS float* sMp, LAS float* sMn) {
    int tid = threadIdx.x; asm volatile("" : "+v"(tid));
    if (tid < 64) { const ChunkScan r = chunk_scan_wave(CH, bh, tid); *(LAS f32x4*)(sB + 4 * tid) = r.B; *(LAS f32x4*)(sMp + 4 * tid) = r.mp; *(LAS f32x4*)(sMn + 4 * tid) = r.mn; }
    __syncthreads();
}
template <bool FULL>
__device__ __forceinline__ void mlstm_units(const P& p, unsigned char* lds_) {
    unsigned char* ws = p.ws; const int tid0 = threadIdx.x;
    const int w = __builtin_amdgcn_readfirstlane(tid0 >> 6);
    const bf16_t* Yq = (const bf16_t*)(ws + OFF_Y); bf16_t* Yo = (bf16_t*)(ws + OFF_Y);
    const bf16_t* KT = (const bf16_t*)(ws + OFF_TMP); const bf16_t* VB = (const bf16_t*)(ws + OFF_VB);
    float* ST = (float*)(ws + OFF_QB); float* NS = (float*)(ws + OFF_NS);
    const float *BQ = (const float*)(ws + OFF_BQ), *IQ = (const float*)(ws + OFF_IQ), *MT = (const float*)(ws + OFF_MT), *CH = (const float*)(ws + OFF_CH);
    LAS unsigned char* Qs = (LAS unsigned char*)lds_;
    LAS unsigned char* Ks = Qs + 64 * ML_RS;
    LAS unsigned char* Vs = Ks + 64 * ML_RS;
    LAS unsigned char* Wl = Vs + 64 * ML_RS;
    LAS float* sa = (LAS float*)(Wl + 64 * ML_WS);
    LAS float* sden = sa + 64; LAS float* ssw = sden + 64; LAS float* sf = ssw + 64; LAS float* sg = sf + 64; LAS float* nd = sg + 64; LAS float* rden = nd + 64; LAS float* ns = rden + 64;
    LAS float* cB = ns + 256; LAS float* cMp = cB + 256; LAS float* cMn = cMp + 256; LAS float* gB = cMn + 256; LAS float* gI = gB + 512; LAS float* gM = gI + 512;
    for (int unit = blockIdx.x; unit < 256; unit += gridDim.x) {
        const int bh = unit >> 5, S = unit & 31, batch = bh >> 2, head = bh & 3;
        const int tid = tid0, lane = tid0 & 63, hh = lane >> 5;
        __syncthreads();
        mlstm_chunk_scan(CH, bh, cB, cMp, cMn);
        f32x16 st[8]; float nreg = 0.f;
        if (FULL) {
#pragma unroll
            for (int kt = 0; kt < 8; ++kt) {
                int lz = lane; asm volatile("" : "+v"(lz) :: "memory");
                const float* sp = ST + (size_t)unit * 65536 + 32 * w + (lz & 31) + (size_t)(32 * kt + 4 * (lz >> 5)) * 256;
#pragma unroll
                for (int r = 0; r < 16; ++r) st[kt][r] = sp[((r & 3) + 8 * (r >> 2)) * 256];
            }
            if (tid < 256) nreg = NS[unit * 256 + tid];
        } else {
#pragma unroll
            for (int kt = 0; kt < 8; ++kt)
#pragma unroll
                for (int r = 0; r < 16; ++r) st[kt][r] = 0.f;
        }
        { const size_t tS = ((size_t)batch * SEQ + (size_t)S * 512 + tid0) * 4 + head; gB[tid0] = BQ[tS]; gI[tid0] = IQ[tS]; gM[tid0] = MT[tS]; }
        u32x4 pk[4], pv[4], pq[4];
        auto prefetch = [&](int cn) {
            int tz = tid0; asm volatile("" : "+v"(tz));
            const size_t tn = (size_t)batch * SEQ + (size_t)(S * 8 + cn) * 64;
#pragma unroll
            for (int j = 0; j < 4; ++j) { const int e = tz + 512 * j, r = e >> 5, cg = e & 31;
                pk[j] = *(const u32x4*)(KT + (tn + r) * 1024 + head * 256 + cg * 8);
                if (!FULL) pv[j] = *(const u32x4*)(VB + (tn + r) * 1024 + head * 256 + cg * 8);
                if (FULL) pq[j] = *(const u32x4*)(Yq + (tn + r) * 2048 + 1024 + head * 256 + cg * 8); }
            asm volatile("" ::: "memory");
        };
        prefetch(0);
#pragma unroll 1
        for (int cc = 0; cc < 8; ++cc) {
            int tid = tid0; asm volatile("" : "+v"(tid));
            const int lane = tid & 63, l31 = lane & 31, hh = lane >> 5, fr = lane & 15, fq = lane >> 4;
            const int trow = 8 * hh + (fr >> 2), tcol = (16 * (fq & 1) + 4 * (fr & 3)) * 2;
            const int ch = S * 8 + cc; const size_t t0 = (size_t)batch * SEQ + ch * 64;
            const float mprev = cMp[ch], mnew = cMn[ch], blast = cB[ch];
            const float decay = __expf(blast + mprev - mnew);
            __syncthreads();
#pragma unroll
            for (int j = 0; j < 4; ++j) { const int e = tid + 512 * j, r = e >> 5, cg = e & 31;
                if (FULL) pv[j] = *(const u32x4*)(VB + (t0 + r) * 1024 + head * 256 + cg * 8); }
#pragma unroll
            for (int j = 0; j < 4; ++j) { const int e = tid + 512 * j, r = e >> 5, cg = e & 31;
                *(LAS u32x4*)(Ks + r * ML_RS + cg * 16) = pk[j];
                if (!FULL) *(LAS u32x4*)(Vs + r * ML_RS + cg * 16) = pv[j];
                if (FULL) *(LAS u32x4*)(Qs + r * ML_RS + cg * 16) = pq[j]; }
            if (w == cc) { const float bq = gB[tid], iq = gI[tid], mt = bq + fmaxf(mprev, gM[tid]);
                sa[lane] = __expf(bq + mprev - mt); sden[lane] = __expf(-mt); ssw[lane] = __expf(blast - bq + iq - mnew); sf[lane] = bq - mt; sg[lane] = iq - bq; }
            if (FULL && tid < 256) ns[tid] = nreg;
            __syncthreads();
            if (!FULL && cc < 7) prefetch(cc + 1);
            bf16x8 bv[4];
            if (!FULL) {
#pragma unroll
                for (int ks = 0; ks < 4; ++ks) bv[ks] = ml_tr8(Vs + (16 * ks + trow) * ML_RS + 64 * w + tcol, 4 * ML_RS);
            }
            if (FULL) {
                { const int tt = w >> 1;
#pragma unroll
                  for (int si = 0; si < 2; ++si) { const int ss = 2 * (w & 1) + si;
                    f32x4 acc = (f32x4){0.f, 0.f, 0.f, 0.f};
                    if (ss <= tt) {
#pragma unroll
                        for (int ks = 0; ks < 8; ++ks) { const bf16x8 a = *(const LAS bf16x8*)(Qs + (16 * tt + fr) * ML_RS + (32 * ks + 8 * fq) * 2), b = *(const LAS bf16x8*)(Ks + (16 * ss + fr) * ML_RS + (32 * ks + 8 * fq) * 2);
                            acc = __builtin_amdgcn_mfma_f32_16x16x32_bf16(a, b, acc, 0, 0, 0); } }
                    const int sidx = 16 * ss + fr; const float gs = sg[sidx];
#pragma unroll
                    for (int j = 0; j < 4; ++j) { const int tix = 16 * tt + 4 * fq + j; const float wv = (sidx <= tix) ? __expf(sf[tix] + gs) * acc[j] : 0.f;
                        *(LAS bf16_t*)(Wl + tix * ML_WS + sidx * 2) = f2bf(wv); } } }
#pragma unroll
                for (int i = 0; i < 8; ++i) { const int tix = 8 * w + i; const u32x2 qv = *(const LAS u32x2*)(Qs + tix * ML_RS + lane * 8); const f32x4 nv = *(const LAS f32x4*)(ns + lane * 4);
                    float part = bflo(qv.x) * nv[0] + bfhi(qv.x) * nv[1] + bflo(qv.y) * nv[2] + bfhi(qv.y) * nv[3]; part = wave_sum(part); if (lane == 0) nd[tix] = part; }
#pragma unroll
                for (int j = 0; j < 4; ++j) { const int e = tid + 512 * j, r = e >> 5, cg = e & 31; *(LAS u32x4*)(Vs + r * ML_RS + cg * 16) = pv[j]; }
                __syncthreads();
                f32x16 acc[2];
#pragma unroll
                for (int t2 = 0; t2 < 2; ++t2) {
#pragma unroll
                    for (int r = 0; r < 16; ++r) acc[t2][r] = 0.f;
                }
#pragma unroll
                for (int kt = 0; kt < 8; ++kt) {
                    asm volatile("" ::: "memory");
#pragma unroll
                    for (int s2 = 0; s2 < 2; ++s2) {
                        u32x4 bw; bw.x = pg8::cvt_pk_bf16(st[kt][8 * s2 + 0], st[kt][8 * s2 + 1]); bw.y = pg8::cvt_pk_bf16(st[kt][8 * s2 + 2], st[kt][8 * s2 + 3]);
                        bw.z = pg8::cvt_pk_bf16(st[kt][8 * s2 + 4], st[kt][8 * s2 + 5]); bw.w = pg8::cvt_pk_bf16(st[kt][8 * s2 + 6], st[kt][8 * s2 + 7]);
                        const bf16x8 bfrag = __builtin_bit_cast(bf16x8, bw);
#pragma unroll
                        for (int t2 = 0; t2 < 2; ++t2) { const LAS unsigned char* qa = Qs + (32 * t2 + l31) * ML_RS + (32 * kt + 16 * s2 + 4 * hh) * 2;
                            const u32x2 lo = *(const LAS u32x2*)qa, hi = *(const LAS u32x2*)(qa + 16); u32x4 aw; aw.x = lo.x; aw.y = lo.y; aw.z = hi.x; aw.w = hi.y;
                            acc[t2] = __builtin_amdgcn_mfma_f32_32x32x16_bf16(__builtin_bit_cast(bf16x8, aw), bfrag, acc[t2], 0, 0, 0); }
                    }
                }
                asm volatile("" ::: "memory");
#pragma unroll
                for (int t2 = 0; t2 < 2; ++t2)
#pragma unroll
                    for (int r = 0; r < 16; ++r) acc[t2][r] *= sa[32 * t2 + (r & 3) + 8 * (r >> 2) + 4 * hh];
#pragma unroll
                for (int ks = 0; ks < 4; ++ks) bv[ks] = ml_tr8(Vs + (16 * ks + trow) * ML_RS + 64 * w + tcol, 4 * ML_RS);
#pragma unroll
                for (int ks = 0; ks < 4; ++ks)
#pragma unroll
                    for (int t2 = 0; t2 < 2; ++t2) { const bf16x8 a = *(const LAS bf16x8*)(Wl + (32 * t2 + l31) * ML_WS + (16 * ks + 8 * hh) * 2);
                        acc[t2] = __builtin_amdgcn_mfma_f32_32x32x16_bf16(a, bv[ks], acc[t2], 0, 0, 0); }
#pragma unroll
                for (int i = 0; i < 8; ++i) { const int tix = 8 * w + i; float rs = bf2f(*(const LAS bf16_t*)(Wl + tix * ML_WS + lane * 2)); rs = wave_sum(rs);
                    if (lane == 0) { const float nq = sa[tix] * nd[tix] + rs; rden[tix] = 1.0f / fmaxf(fabsf(nq), sden[tix]); } }
                __syncthreads();
                bf16_t* yo = Yo + t0 * 2048 + head * 256 + 32 * w + l31;
#pragma unroll
                for (int t2 = 0; t2 < 2; ++t2)
#pragma unroll
                    for (int r = 0; r < 16; ++r) { const int tix = 32 * t2 + (r & 3) + 8 * (r >> 2) + 4 * hh; yo[(size_t)tix * 2048] = f2bf(acc[t2][r] * rden[tix]); }
                asm volatile("" ::: "memory");
                if (cc < 7) prefetch(cc + 1);
            }
#pragma unroll
            for (int kt = 0; kt < 8; ++kt) st[kt] *= decay;
#pragma unroll
            for (int ks = 0; ks < 4; ++ks) {
                const u32x4 raw = __builtin_bit_cast(u32x4, bv[ks]); const LAS float* sw8 = ssw + 16 * ks + 8 * hh;
                u32x4 sc; sc.x = pg8::cvt_pk_bf16(bflo(raw.x) * sw8[0], bfhi(raw.x) * sw8[1]); sc.y = pg8::cvt_pk_bf16(bflo(raw.y) * sw8[2], bfhi(raw.y) * sw8[3]);
                sc.z = pg8::cvt_pk_bf16(bflo(raw.z) * sw8[4], bfhi(raw.z) * sw8[5]); sc.w = pg8::cvt_pk_bf16(bflo(raw.w) * sw8[6], bfhi(raw.w) * sw8[7]);
                const bf16x8 bs = __builtin_bit_cast(bf16x8, sc);
#pragma unroll
                for (int kt = 0; kt < 8; ++kt) { if ((kt & 3) == 0) asm volatile("" ::: "memory");
                    const bf16x8 a = ml_tr8(Ks + (16 * ks + trow) * ML_RS + 64 * kt + tcol, 4 * ML_RS);
                    st[kt] = __builtin_amdgcn_mfma_f32_32x32x16_bf16(a, bs, st[kt], 0, 0, 0); }
            }
            if (tid < 256) { float nacc = 0.f;
#pragma unroll 8
                for (int s2 = 0; s2 < 64; ++s2) nacc += ssw[s2] * bf2f(*(const LAS bf16_t*)(Ks + s2 * ML_RS + tid * 2));
                nreg = decay * nreg + nacc; }
        }
        if (!FULL) {
#pragma unroll
            for (int kt = 0; kt < 8; ++kt) {
                int lz = lane; asm volatile("" : "+v"(lz) :: "memory");
                float* sp = ST + (size_t)unit * 65536 + 32 * w + (lz & 31) + (size_t)(32 * kt + 4 * (lz >> 5)) * 256;
#pragma unroll
                for (int r = 0; r < 16; ++r) sp[((r & 3) + 8 * (r >> 2)) * 256] = st[kt][r];
            }
            if (tid < 256) NS[unit * 256 + tid] = nreg;
        }
    }
}
__device__ __forceinline__ void phase_mlstm_scan(const P& p, unsigned char* lds_) {
    unsigned char* ws = p.ws; const int tid = threadIdx.x, lane = tid & 63, wave = tid >> 6;
    float* ST = (float*)(ws + OFF_QB); float* NS = (float*)(ws + OFF_NS); const float* CH = (const float*)(ws + OFF_CH);
    LAS float* DS = (LAS float*)lds_;
    __syncthreads();
    {
        const ChunkScan r = chunk_scan_wave(CH, wave, lane);
        float d = 1.f;
#pragma unroll
        for (int j = 0; j < 4; ++j) d *= __expf(r.B[j] + r.mp[j] - r.mn[j]);
        const float dn = __shfl_down(d, 1);
        if (!(lane & 1)) DS[wave * 32 + (lane >> 1)] = d * dn;
    }
    __syncthreads();
    {
        const int it0 = blockIdx.x * 512 + tid;
        for (int it = it0; it < 8 * 16384; it += gridDim.x * 512) {
            const int bh = it >> 14; float* base = ST + (size_t)bh * 32 * 65536 + (size_t)(it & 16383) * 4;
            f32x4 carry = (f32x4){0.f, 0.f, 0.f, 0.f};
#pragma unroll
            for (int h = 0; h < 2; ++h) {
                f32x4 tmp[16];
#pragma unroll
                for (int S = 0; S < 16; ++S) tmp[S] = *(const f32x4*)(base + (size_t)(16 * h + S) * 65536);
#pragma unroll
                for (int S = 0; S < 16; ++S) { *(f32x4*)(base + (size_t)(16 * h + S) * 65536) = carry; carry = DS[bh * 32 + 16 * h + S] * carry + tmp[S]; }
            }
        }
        if (it0 < 8 * 256) {
            const int it = it0, bh = it >> 8; float* base = NS + (size_t)bh * 32 * 256 + (it & 255);
            float carry = 0.f;
#pragma unroll 8
            for (int S = 0; S < 32; ++S) { const float tmp = base[S * 256]; base[S * 256] = carry; carry = DS[bh * 32 + S] * carry + tmp; }
        }
    }
}

__device__ __forceinline__ void unpack8(const u32x4 w, float (&f)[8]) {
    f[0] = bflo(w.x); f[1] = bfhi(w.x); f[2] = bflo(w.y); f[3] = bfhi(w.y); f[4] = bflo(w.z); f[5] = bfhi(w.z); f[6] = bflo(w.w); f[7] = bfhi(w.w); }
template <int WIN>
__device__ __forceinline__ void pool_item(const bf16_t* __restrict__ U, bf16_t* __restrict__ Y, const float* __restrict__ s_pool, size_t t0, int s0, int c0) {
    constexpr int NR = WIN + 7;
    u32x4 rw[NR], z[8];
#pragma unroll
    for (int j = 0; j < NR; ++j) rw[j] = (s0 - (WIN - 1) + j >= 0) ? *(const u32x4*)(U + ((long)t0 + j - (WIN - 1)) * 1024 + c0) : (u32x4){0u, 0u, 0u, 0u};
#pragma unroll
    for (int k = 0; k < 8; ++k) z[k] = *(const u32x4*)(Y + (t0 + k) * 2048 + 1024 + c0);
    const f32x4 s0v = *(const f32x4*)(s_pool + c0), s1v = *(const f32x4*)(s_pool + c0 + 4);
    const float sp[8] = {s0v[0], s0v[1], s0v[2], s0v[3], s1v[0], s1v[1], s1v[2], s1v[3]};
    float S[8];
#pragma unroll
    for (int i = 0; i < 8; ++i) S[i] = 0.f;
#pragma unroll
    for (int j = 0; j < WIN - 1; ++j) { float f[8]; unpack8(rw[j], f);
#pragma unroll
        for (int i = 0; i < 8; ++i) S[i] += f[i]; }
#pragma unroll
    for (int k = 0; k < 8; ++k) {
        float self[8], zf[8]; unpack8(rw[k + WIN - 1], self); unpack8(z[k], zf);
#pragma unroll
        for (int i = 0; i < 8; ++i) S[i] += self[i];
        const int cnt = (s0 + k + 1 < WIN) ? s0 + k + 1 : WIN;
        const float inv = __builtin_amdgcn_rcpf((float)cnt);
        float o[8];
#pragma unroll
        for (int i = 0; i < 8; ++i) o[i] = (S[i] * inv - self[i]) * sp[i] * zf[i];
        u32x4 ow; ow.x = pk2(o[0], o[1]); ow.y = pk2(o[2], o[3]); ow.z = pk2(o[4], o[5]); ow.w = pk2(o[6], o[7]);
        *(u32x4*)(Y + (t0 + k) * 2048 + 1024 + c0) = ow;
        float old[8]; unpack8(rw[k], old);
#pragma unroll
        for (int i = 0; i < 8; ++i) S[i] -= old[i];
    }
}
__device__ __forceinline__ void phase_ya_pool(const P& p) {
    unsigned char* ws = p.ws; const int tid = threadIdx.x, lane = tid & 63, wave = tid >> 6;
    bf16_t* Y = (bf16_t*)(ws + OFF_Y); const bf16_t* O = (const bf16_t*)(ws + OFF_QB); const bf16_t* ZA = (const bf16_t*)(ws + OFF_KB);
    for (int tt = blockIdx.x * 8 + wave; tt < T; tt += gridDim.x * 8) {
        const size_t t = (size_t)tt; u32x2 hw[4], ow[4], zw[4];
#pragma unroll
        for (int head = 0; head < 4; ++head) { const int c = head * 256 + lane * 4;
            hw[head] = *(const u32x2*)(Y + t * 2048 + c); ow[head] = *(const u32x2*)(O + t * 1024 + c); zw[head] = *(const u32x2*)(ZA + t * 1024 + c); }
#pragma unroll
        for (int head = 0; head < 4; ++head) { const int c = head * 256 + lane * 4;
            float v[4] = {bflo(hw[head].x) * bflo(ow[head].x), bfhi(hw[head].x) * bfhi(ow[head].x), bflo(hw[head].y) * bflo(ow[head].y), bfhi(hw[head].y) * bfhi(ow[head].y)};
            const float ss = wave_sum(v[0] * v[0] + v[1] * v[1] + v[2] * v[2] + v[3] * v[3]);
            const float rstd = rsqrtf(ss * (1.0f / 256.0f) + EPS);
            const f32x4 g = *(const f32x4*)(p.e_g_head + c);
            u32x2 o; o.x = pk2(v[0] * rstd * g[0] * bflo(zw[head].x), v[1] * rstd * g[1] * bfhi(zw[head].x)); o.y = pk2(v[2] * rstd * g[2] * bflo(zw[head].y), v[3] * rstd * g[3] * bfhi(zw[head].y));
            *(u32x2*)(Y + t * 2048 + c) = o; }
    }
    const bf16_t* U = (const bf16_t*)(ws + OFF_VB);
    for (int it = blockIdx.x * 512 + tid; it < (T / 8) * 128; it += gridDim.x * 512) {
        const int cgl = it & 31, tbl = (it >> 5) & 1, g = __builtin_amdgcn_readfirstlane((it >> 6) & 3), tb = 2 * (it >> 8) + tbl;
        const size_t t0 = (size_t)tb * 8; const int s0 = (int)(t0 & (SEQ - 1)), c0 = g * 256 + cgl * 8;
        if (g == 0) pool_item<2>(U, Y, p.e_s_pool, t0, s0, c0);
        else if (g == 1) pool_item<4>(U, Y, p.e_s_pool, t0, s0, c0);
        else if (g == 2) pool_item<8>(U, Y, p.e_s_pool, t0, s0, c0);
        else pool_item<16>(U, Y, p.e_s_pool, t0, s0, c0);
    }
}

__device__ __forceinline__ void headnorm64(bf16_t* X, const float* g) {
    const int lane = threadIdx.x & 63, wave = threadIdx.x >> 6;
    const float* gg = g + (lane & 3) * 16;
    for (int t0 = (blockIdx.x * 8 + wave) * 4; t0 < T; t0 += gridDim.x * 32) {
        u32x4 a[4], b[4];
#pragma unroll
        for (int k = 0; k < 4; ++k) { const bf16_t* r = X + (size_t)(t0 + k) * 1024 + lane * 16; a[k] = *(const u32x4*)r; b[k] = *(const u32x4*)(r + 8); }
#pragma unroll
        for (int k = 0; k < 4; ++k) {
            float f[16] = {bflo(a[k].x), bfhi(a[k].x), bflo(a[k].y), bfhi(a[k].y), bflo(a[k].z), bfhi(a[k].z), bflo(a[k].w), bfhi(a[k].w), bflo(b[k].x), bfhi(b[k].x), bflo(b[k].y), bfhi(b[k].y), bflo(b[k].z), bfhi(b[k].z), bflo(b[k].w), bfhi(b[k].w)};
            float ss = 0.f;
#pragma unroll
            for (int i = 0; i < 16; ++i) ss += f[i] * f[i];
            ss += __shfl_xor(ss, 1); ss += __shfl_xor(ss, 2);
            const float rstd = rsqrtf(ss * (1.0f / 64.0f) + EPS);
#pragma unroll
            for (int i = 0; i < 16; ++i) f[i] = f[i] * rstd * gg[i];
            u32x4 oa, ob; oa.x = pk2(f[0], f[1]); oa.y = pk2(f[2], f[3]); oa.z = pk2(f[4], f[5]); oa.w = pk2(f[6], f[7]);
            ob.x = pk2(f[8], f[9]); ob.y = pk2(f[10], f[11]); ob.z = pk2(f[12], f[13]); ob.w = pk2(f[14], f[15]);
            bf16_t* r = X + (size_t)(t0 + k) * 1024 + lane * 16; *(u32x4*)r = oa; *(u32x4*)(r + 8) = ob;
        }
    }
}
__device__ __forceinline__ void phase_qnorm_ckvnorm(const P& p) {
    unsigned char* ws = p.ws; const int lane = threadIdx.x & 63, wave = threadIdx.x >> 6;
    {
        const u32x4* KI4 = (const u32x4*)(ws + OFF_KI); u32x4* KT4 = (u32x4*)(ws + OFF_KIT);
        for (size_t it = (size_t)blockIdx.x * 512 + threadIdx.x; it < (size_t)T * 8; it += (size_t)gridDim.x * 512) {
            const int l = (int)(it & 63), ks = (int)((it >> 6) & 1); const size_t t16 = it >> 7;
            KT4[it] = KI4[(t16 * 16 + (l & 15)) * 8 + 4 * ks + (l >> 4)]; }
    }
    headnorm64((bf16_t*)(ws + OFF_TMP), p.o_g_q);
    bf16_t* CKVN = (bf16_t*)(ws + OFF_CKVN);
    const f32x4 g = *(const f32x4*)(p.o_g_kv + lane * 4);
    for (int t0 = (blockIdx.x * 8 + wave) * 8; t0 < T; t0 += gridDim.x * 64) {
        u32x2 w[8];
#pragma unroll
        for (int k = 0; k < 8; ++k) w[k] = *(const u32x2*)(CKVN + (size_t)(t0 + k) * 256 + lane * 4);
#pragma unroll
        for (int k = 0; k < 8; ++k) {
            const float v[4] = {bflo(w[k].x), bfhi(w[k].x), bflo(w[k].y), bfhi(w[k].y)};
            const float ss = wave_sum(v[0] * v[0] + v[1] * v[1] + v[2] * v[2] + v[3] * v[3]);
            const float rstd = rsqrtf(ss * (1.0f / 256.0f) + EPS);
            u32x2 o; o.x = pk2(v[0] * rstd * g[0], v[1] * rstd * g[1]); o.y = pk2(v[2] * rstd * g[2], v[3] * rstd * g[3]);
            *(u32x2*)(CKVN + (size_t)(t0 + k) * 256 + lane * 4) = o;
        }
    }
}

__device__ __forceinline__ unsigned okey(float s) { if (s == 0.f) s = 0.f; const unsigned u = __float_as_uint(s); return (u & 0x80000000u) ? ~u : (u | 0x80000000u); }

__device__ __forceinline__ void indexer_slow_query(const P& p, unsigned char* lds, size_t t) {
    unsigned char* ws = p.ws; const int tid = threadIdx.x, lane = tid & 63, wave = tid >> 6;
    const _Float16* QI = (const _Float16*)(ws + OFF_QI); const _Float16* KI = (const _Float16*)(ws + OFF_KI); const float* WI = (const float*)(ws + OFF_WI);
    unsigned short* IDX = (unsigned short*)(ws + OFF_IDX);
    unsigned* sc = (unsigned*)lds; unsigned* hist = sc + 16384; float* qs = (float*)(hist + 256); unsigned* misc = (unsigned*)(qs + 256); unsigned* wsum = misc + 16;
    const int batch = (int)(t >> 14), pos = (int)(t & (SEQ - 1)), n = pos + 1;
    __syncthreads();
    if (tid < 256) qs[tid] = (float)QI[t * 256 + tid];
    const float w0 = WI[t * 4 + 0], w1 = WI[t * 4 + 1], w2 = WI[t * 4 + 2], w3 = WI[t * 4 + 3];
    __syncthreads();
    const _Float16* kbase = KI + (size_t)batch * SEQ * 64;
    for (int s = tid; s < n; s += 512) {
        asm volatile("" ::: "memory");
        typedef _Float16 h8 __attribute__((ext_vector_type(8)));
        const h8* kr = (const h8*)(kbase + (size_t)s * 64);
        float d0 = 0.f, d1 = 0.f, d2 = 0.f, d3 = 0.f;
#pragma unroll
        for (int j = 0; j < 8; ++j) { const h8 kv = kr[j];
#pragma unroll
            for (int e = 0; e < 8; ++e) { const int d = j * 8 + e; const float kf = (float)kv[e]; d0 += qs[d] * kf; d1 += qs[64 + d] * kf; d2 += qs[128 + d] * kf; d3 += qs[192 + d] * kf; } }
        float score = w0 * fmaxf(d0, 0.f); score = fmaf(w1, fmaxf(d1, 0.f), score); score = fmaf(w2, fmaxf(d2, 0.f), score); score = fmaf(w3, fmaxf(d3, 0.f), score);
        sc[s] = okey(score);
    }
    unsigned prefix = 0, krem = 256;
    for (int pass = 0; pass < 4; ++pass) {
        const int shift = 24 - 8 * pass;
        __syncthreads();
        if (tid < 256) hist[tid] = 0;
        __syncthreads();
        for (int s = tid; s < n; s += 512) { const unsigned k = sc[s]; if (pass == 0 || (k >> (shift + 8)) == prefix) atomicAdd(&hist[(k >> shift) & 255u], 1u); }
        __syncthreads();
        if (tid == 0) { unsigned cum = 0; int bin = 255; for (; bin > 0; --bin) { const unsigned c = hist[bin]; if (cum + c >= krem) break; cum += c; } misc[0] = (unsigned)bin; misc[1] = krem - cum; }
        __syncthreads();
        prefix = (prefix << 8) | misc[0]; krem = misc[1];
    }
    const unsigned ngt_total = 256u - krem;
    unsigned lg = 0, le = 0; const int s0 = tid * 32;
    for (int s = s0; s < s0 + 32 && s < n; ++s) { const unsigned k = sc[s]; lg += (k > prefix); le += (k == prefix); }
    unsigned pk = lg | (le << 16), incl = pk;
#pragma unroll
    for (int o = 1; o < 64; o <<= 1) { const unsigned y = __shfl_up(incl, o); if (lane >= o) incl += y; }
    if (lane == 63) wsum[wave] = incl;
    __syncthreads();
    unsigned base = 0;
    for (int w = 0; w < wave; ++w) base += wsum[w];
    const unsigned excl = base + incl - pk; unsigned bg = excl & 0xffffu, be = excl >> 16;
    for (int s = s0; s < s0 + 32 && s < n; ++s) { const unsigned k = sc[s];
        if (k > prefix) { IDX[t * 256 + bg] = (unsigned short)s; ++bg; }
        else if (k == prefix) { if (be < krem) IDX[t * 256 + ngt_total + be] = (unsigned short)s; ++be; } }
    __syncthreads();
}

typedef _Float16 half8 __attribute__((ext_vector_type(8)));
constexpr int IX_CAP = 1024, IX_ZBIN = 2048;
__device__ __forceinline__ unsigned ix_key(const f32x4 a, const f32x4 w) {
    const float r0 = __int_as_float(max(__float_as_int(a[0]), 0)), r1 = __int_as_float(max(__float_as_int(a[1]), 0));
    const float r2 = __int_as_float(max(__float_as_int(a[2]), 0)), r3 = __int_as_float(max(__float_as_int(a[3]), 0));
    float s = fmaf(w[0], r0, 0.0f); s = fmaf(w[1], r1, s); s = fmaf(w[2], r2, s); s = fmaf(w[3], r3, s);
    const unsigned u = __float_as_uint(s);
    return u ^ ((unsigned)((int)u >> 31) | 0x80000000u);
}
#define LDS_ADD(ptr, v) __hip_atomic_fetch_add((ptr), (v), __ATOMIC_RELAXED, __HIP_MEMORY_SCOPE_WORKGROUP)
struct IxTagF { static constexpr bool value = false; }; struct IxTagT { static constexpr bool value = true; };
__device__ __forceinline__ void phase_indexer(const P& p, unsigned char* lds) {
    unsigned char* ws = p.ws; const int tid = threadIdx.x, lane = tid & 63, kl = lane & 15, g = lane >> 4;
    const int wave = __builtin_amdgcn_readfirstlane(tid >> 6);
    const _Float16* QI = (const _Float16*)(ws + OFF_QI); const _Float16* KIT = (const _Float16*)(ws + OFF_KIT); const float* WI = (const float*)(ws + OFF_WI);
    unsigned short* IDX = (unsigned short*)(ws + OFF_IDX); int* CNT = (int*)(ws + OFF_CNT);
    LAS unsigned* hist = (LAS unsigned*)lds;
    LAS int* qTbin = (LAS int*)(hist + 16 * 2048);
    LAS int* qCab = qTbin + 16; LAS unsigned* qN = (LAS unsigned*)(qCab + 16); LAS int* qOvf = (LAS int*)(qN + 16); LAS int* qZl = qOvf + 16;
    LAS unsigned* ovl = (LAS unsigned*)(lds + 132 * 1024);
    LAS unsigned* h2 = (LAS unsigned*)(lds + 133 * 1024 + wave * 1536);
    LAS unsigned long long* l2 = (LAS unsigned long long*)(h2 + 256);
    if (tid == 0) ovl[0] = 0u;
    const int G = gridDim.x, nround = (T / 16) / G;
#pragma unroll 1
    for (int i = 0; i < nround; ++i) {
        const int tix = (i & 1) ? i * G + (G - 1 - (int)blockIdx.x) : i * G + (int)blockIdx.x;
        const int batch = tix & 1, tb = tix >> 1, p0 = tb * 16; const size_t t0 = (size_t)batch * SEQ + p0;
        __syncthreads();
        if (p0 + 16 <= 256) {
#pragma unroll
            for (int j = 0; j < 8; ++j) { const int e = tid + 512 * j, q = e >> 8, jj = e & 255; IDX[(t0 + q) * 256 + jj] = (unsigned short)(jj <= p0 + q ? jj : 0); }
            if (tid < 16) CNT[t0 + tid] = p0 + tid + 1;
            continue;
        }
#pragma unroll
        for (int j = 0; j < 16; ++j) ((LAS u32x4*)hist)[tid + 512 * j] = (u32x4){0u, 0u, 0u, 0u};
        if (tid < 16) { qN[tid] = 0u; qOvf[tid] = 0; }
        half8 af[4][2]; f32x4 wv[4];
#pragma unroll
        for (int rt = 0; rt < 4; ++rt) {
#pragma unroll
            for (int ks = 0; ks < 2; ++ks) af[rt][ks] = *(const half8*)(QI + (t0 + 4 * rt + (kl >> 2)) * 256 + (kl & 3) * 64 + 32 * ks + 8 * g);
            wv[rt] = *(const f32x4*)(WI + (t0 + 4 * rt + g) * 4);
        }
        __syncthreads();
        const int nblk = tb + 1, L = (nblk + 7) >> 3, b0 = wave * L, b1 = (b0 + L < nblk) ? b0 + L : nblk;
        const _Float16* kb = KIT + (size_t)batch * SEQ * 64 + lane * 8;
        LAS unsigned* hg = hist + g * 4 * 2048;
#define IX_LOADK(u, bb) do { kq[u][0] = *(const half8*)(kb + (size_t)(bb) * 1024); kq[u][1] = *(const half8*)(kb + (size_t)(bb) * 1024 + 512); } while (0)
#define IX_MFMA(acc, k0, k1) do { _Pragma("unroll") for (int rt = 0; rt < 4; ++rt) { acc[rt] = __builtin_amdgcn_mfma_f32_16x16x32_f16(af[rt][0], k0, (f32x4){0.f, 0.f, 0.f, 0.f}, 0, 0, 0); \
            acc[rt] = __builtin_amdgcn_mfma_f32_16x16x32_f16(af[rt][1], k1, acc[rt], 0, 0, 0); } } while (0)
        const int sst = (nblk <= 64) ? 1 : 2;
        {
            const int bend = (b1 < nblk - 1) ? b1 : nblk - 1;
            const int ns = (bend > b0) ? ((bend - b0 + sst - 1) / sst) : 0;
            auto step1 = [&](int bcur, const half8& k0, const half8& k1, auto chkTag) {
                constexpr bool CHK = decltype(chkTag)::value;
                f32x4 acc[4]; IX_MFMA(acc, k0, k1);
#pragma unroll
                for (int rt = 0; rt < 4; ++rt) { const unsigned key = ix_key(acc[rt], wv[rt]);
                    if (!CHK || bcur * 16 + kl <= p0 + 4 * rt + g) LDS_ADD(hg + rt * 2048 + (key >> 21), 1u << ((key >> 16) & 16u)); }
            };
            if (ns > 0) {
                half8 kq[2][2];
#pragma unroll
                for (int u = 0; u < 2; ++u) { const int kk = (u < ns) ? u : ns - 1; IX_LOADK(u, b0 + sst * kk); }
                int k = 0;
#pragma unroll 1
                for (; k + 2 <= ns; k += 2) {
#pragma unroll
                    for (int u = 0; u < 2; ++u) { step1(0, kq[u][0], kq[u][1], IxTagF{}); const int kk = (k + 2 + u < ns) ? k + 2 + u : ns - 1; IX_LOADK(u, b0 + sst * kk); }
                }
                if (k < ns) step1(0, kq[0][0], kq[0][1], IxTagF{});
            }
            if (sst == 1 && b1 == nblk && b0 < b1) { half8 kq[1][2]; IX_LOADK(0, nblk - 1); step1(nblk - 1, kq[0][0], kq[0][1], IxTagT{}); }
        }
        __syncthreads();
        int nsb = 0;
#pragma unroll
        for (int ww = 0; ww < 8; ++ww) { const int c0 = ww * L, c1 = (c0 + L < nblk) ? c0 + L : nblk, ce = (c1 < nblk - 1) ? c1 : nblk - 1; nsb += (ce > c0) ? ((ce - c0 + 1) >> 1) : 0; }
        if (sst == 1) nsb = nblk;
        const float fsm = (sst == 1) ? 1.0f : fminf(1.0f, (float)(nsb * 16) / (float)(p0 + 1));
        int tgt = (int)(256.0f * fsm + 5.0f * sqrtf(256.0f * fsm * (1.0f - fsm))) + 2; tgt = tgt > 256 ? 256 : tgt;
#pragma unroll 1
        for (int qq = 0; qq < 2; ++qq) {
            const int q = 2 * wave + qq; const LAS unsigned* h = hist + q * 2048;
            unsigned cs = 0; const int top = 2047 - 32 * lane;
#pragma unroll 8
            for (int ii = 0; ii < 32; ++ii) { const unsigned w2 = h[top - ((ii + lane) & 31)]; cs += (w2 & 0xffffu) + (w2 >> 16); }
            unsigned incl = cs;
#pragma unroll
            for (int o = 1; o < 64; o <<= 1) { const unsigned y = __shfl_up(incl, o); if (lane >= o) incl += y; }
            const unsigned long long m = __ballot(incl >= (unsigned)tgt);
            const int Ls = m ? (__ffsll((long long)m) - 1) : 63;
            unsigned cabv = __shfl(incl - cs, Ls), cbv = 0; int tbin = 0; bool found = false;
#pragma unroll 8
            for (int ii = 0; ii < 32; ++ii) { const int dw = 2047 - 32 * Ls - ii; const unsigned w2 = h[dw]; const unsigned chi = w2 >> 16, clo = w2 & 0xffffu;
                if (!found && cabv + chi >= (unsigned)tgt) { tbin = 2 * dw + 1; cbv = chi; found = true; } if (!found) cabv += chi;
                if (!found && cabv + clo >= (unsigned)tgt) { tbin = 2 * dw; cbv = clo; found = true; } if (!found) cabv += clo; }
            if (lane == 0) { qTbin[q] = tbin; qCab[q] = (int)cabv; int zl = 0x7fffffff;
                if (tbin == IX_ZBIN) {
                    const int nk = p0 + 4 * (q & 3) + (q >> 2) + 1; zl = (int)(((unsigned long long)384 * (unsigned)(nsb * 16)) / (cbv ? cbv : 1u)) + 16; zl = zl < nk ? zl : 0x7fffffff; }
                qZl[q] = zl; }
        }
        __syncthreads();
        if (b0 < b1) {
            unsigned lok[4]; int zl[4];
#pragma unroll
            for (int rt = 0; rt < 4; ++rt) { lok[rt] = (unsigned)qTbin[g * 4 + rt] << 20; zl[rt] = qZl[g * 4 + rt]; }
            half8 kq[2][2];
#pragma unroll
            for (int u = 0; u < 2; ++u) { const int bb = (b0 + u < b1) ? b0 + u : b1 - 1; IX_LOADK(u, bb); }
            auto step2 = [&](int bcur, const half8& k0, const half8& k1, auto chkTag) {
                constexpr bool CHK = decltype(chkTag)::value;
                const int s = bcur * 16 + kl;
                f32x4 acc[4]; IX_MFMA(acc, k0, k1);
                unsigned key[4], pos[4]; bool cand[4];
#pragma unroll
                for (int rt = 0; rt < 4; ++rt) { key[rt] = ix_key(acc[rt], wv[rt]); cand[rt] = key[rt] >= lok[rt] + (s >= zl[rt] ? 1u : 0u); if (CHK) cand[rt] = cand[rt] && s <= p0 + 4 * rt + g; }
#pragma unroll
                for (int rt = 0; rt < 4; ++rt) { pos[rt] = 0u;
                    if (cand[rt]) { int gz = g; asm volatile("" : "+v"(gz)); pos[rt] = LDS_ADD(qN + gz * 4 + rt, 1u); } }
#pragma unroll
                for (int rt = 0; rt < 4; ++rt) {
                    if (cand[rt] && pos[rt] < (unsigned)IX_CAP) { int gz = g; asm volatile("" : "+v"(gz));
                        ((LAS unsigned long long*)(lds + (gz * 4 + rt) * 8192))[pos[rt]] = ((unsigned long long)key[rt] << 16) | (unsigned long long)(0xffffu - (unsigned)s); } }
            };
            int b = b0;
#pragma unroll 1
            for (; b + 2 <= b1 && b + 2 <= nblk - 1; b += 2) {
#pragma unroll
                for (int u = 0; u < 2; ++u) { step2(b + u, kq[u][0], kq[u][1], IxTagF{}); const int bb = (b + 2 + u < b1) ? b + 2 + u : b1 - 1; IX_LOADK(u, bb); }
            }
#pragma unroll 1
            for (; b + 2 <= b1; b += 2) {
#pragma unroll
                for (int u = 0; u < 2; ++u) { step2(b + u, kq[u][0], kq[u][1], IxTagT{}); const int bb = (b + 2 + u < b1) ? b + 2 + u : b1 - 1; IX_LOADK(u, bb); }
            }
            if (b < b1) step2(b, kq[0][0], kq[0][1], IxTagT{});
        }
#undef IX_LOADK
#undef IX_MFMA
        __syncthreads();
#pragma unroll 1
        for (int qq = 0; qq < 2; ++qq) {
            const int qs = 2 * wave + qq; const int n = __builtin_amdgcn_readfirstlane((int)qN[qs]);
            if (n > IX_CAP || n < 256) { if (lane == 0) qOvf[qs] = 1; continue; }
            const LAS unsigned long long* cd = (const LAS unsigned long long*)(lds + qs * 8192);
            unsigned short* irow = IDX + (t0 + 4 * (qs & 3) + (qs >> 2)) * 256;
            const int NI = (n + 63) >> 6;
            unsigned long long v[16];
#pragma unroll
            for (int i = 0; i < 16; ++i) v[i] = (i < NI && lane + 64 * i < n) ? cd[lane + 64 * i] : 0ull;
            unsigned long long tau = 1ull;
            if (n > 256) {
                unsigned long long pmask = 0xfffull << 36, pval; int need; unsigned cT;
                {
                    int cpos = 0, czer = 0;
#pragma unroll
                    for (int i = 0; i < 16; ++i) if (i < NI) { const int bb = (int)(v[i] >> 36); cpos += (int)__popcll(__ballot(bb > IX_ZBIN)); czer += (int)__popcll(__ballot(bb == IX_ZBIN && v[i] != 0ull)); }
                    if (cpos < 256 && cpos + czer >= 256) { need = 256 - cpos; cT = (unsigned)czer; pval = (unsigned long long)IX_ZBIN << 36; }
                    else {
                        const bool negc = cpos < 256; const int abovec = negc ? cpos + czer : 0;
                        int bmx = 0;
#pragma unroll
                        for (int i = 0; i < 16; ++i) if (i < NI) { const int bb = (int)(v[i] >> 36); const bool mem = negc ? (bb < IX_ZBIN && v[i] != 0ull) : (bb > IX_ZBIN); bmx = (mem && bb > bmx) ? bb : bmx; }
                        bmx = (int)wave_max((float)bmx);
#pragma unroll
                        for (int j = 0; j < 4; ++j) h2[lane + 64 * j] = 0u;
                        asm volatile("" ::: "memory");
#pragma unroll
                        for (int i = 0; i < 16; ++i) if (i < NI) { const int bb = (int)(v[i] >> 36); const bool mem = negc ? (bb < IX_ZBIN && v[i] != 0ull) : (bb > IX_ZBIN);
                            if (mem) { const int d = bmx - bb; LDS_ADD(h2 + (d > 255 ? 0 : 255 - d), 1u); } }
                        asm volatile("" ::: "memory");
                        const unsigned want = (unsigned)(256 - abovec);
                        const unsigned cs = h2[255 - 4 * lane] + h2[254 - 4 * lane] + h2[253 - 4 * lane] + h2[252 - 4 * lane];
                        unsigned incl = cs;
#pragma unroll
                        for (int o = 1; o < 64; o <<= 1) { const unsigned y = __shfl_up(incl, o); if (lane >= o) incl += y; }
                        const unsigned long long m = __ballot(incl >= want);
                        const int Ls = m ? (__ffsll((long long)m) - 1) : 63;
                        unsigned above = __shfl(incl - cs, Ls), c2 = 0; int T0 = 0; bool found = false;
#pragma unroll
                        for (int ii = 0; ii < 4; ++ii) { const unsigned c = h2[255 - 4 * Ls - ii]; if (!found && above + c >= want) { T0 = 255 - 4 * Ls - ii; c2 = c; found = true; } if (!found) above += c; }
                        above = (unsigned)__builtin_amdgcn_readfirstlane((int)above); c2 = (unsigned)__builtin_amdgcn_readfirstlane((int)c2); T0 = __builtin_amdgcn_readfirstlane(T0);
                        if (T0 == 0) { if (lane == 0) qOvf[qs] = 1; continue; }
                        need = (int)want - (int)above; cT = c2; pval = (unsigned long long)(unsigned)(bmx - 255 + T0) << 36;
                    }
                    asm volatile("" ::: "memory");
                }
#pragma unroll 1
                for (int shift = 28; shift >= 4 && cT > 64u; shift -= 8) {
#pragma unroll
                    for (int j = 0; j < 4; ++j) h2[lane + 64 * j] = 0u;
                    asm volatile("" ::: "memory");
#pragma unroll
                    for (int i = 0; i < 16; ++i) if (i < NI && (v[i] & pmask) == pval) LDS_ADD(h2 + ((unsigned)(v[i] >> shift) & 255u), 1u);
                    asm volatile("" ::: "memory");
                    const unsigned cs = h2[255 - 4 * lane] + h2[254 - 4 * lane] + h2[253 - 4 * lane] + h2[252 - 4 * lane];
                    unsigned incl = cs;
#pragma unroll
                    for (int o = 1; o < 64; o <<= 1) { const unsigned y = __shfl_up(incl, o); if (lane >= o) incl += y; }
                    const unsigned long long m = __ballot(incl >= (unsigned)need);
                    const int Ls = m ? (__ffsll((long long)m) - 1) : 63;
                    unsigned above = __shfl(incl - cs, Ls), c2 = 0; int T2 = 0; bool found = false;
#pragma unroll
                    for (int ii = 0; ii < 4; ++ii) { const unsigned c = h2[255 - 4 * Ls - ii]; if (!found && above + c >= (unsigned)need) { T2 = 255 - 4 * Ls - ii; c2 = c; found = true; } if (!found) above += c; }
                    above = (unsigned)__builtin_amdgcn_readfirstlane((int)above); c2 = (unsigned)__builtin_amdgcn_readfirstlane((int)c2); T2 = __builtin_amdgcn_readfirstlane(T2);
                    need -= (int)above; cT = c2;
                    pmask |= 255ull << shift; pval |= (unsigned long long)T2 << shift;
                    asm volatile("" ::: "memory");
                }
                { int base = 0;
#pragma unroll
                  for (int i = 0; i < 16; ++i) { if (i < NI) { const bool mt = (v[i] & pmask) == pval; const unsigned long long bm = __ballot(mt);
                      if (mt) { const int pos = base + (int)__popcll(bm & ((1ull << lane) - 1ull)); if (pos < 64) l2[pos] = v[i]; }
                      base += (int)__popcll(bm); } } }
                asm volatile("" ::: "memory");
                const unsigned long long mine = (unsigned)lane < cT ? l2[lane] : 0ull;
                const unsigned mlo = (unsigned)mine, mhi = (unsigned)(mine >> 32);
                int rank = 0;
#pragma unroll 1
                for (unsigned j = 0; j < cT; ++j) { const unsigned long long o = ((unsigned long long)(unsigned)__builtin_amdgcn_readlane((int)mhi, (int)j) << 32) | (unsigned)__builtin_amdgcn_readlane((int)mlo, (int)j);
                    rank += (o > mine) ? 1 : 0; }
                const unsigned long long hit = __ballot((unsigned)lane < cT && rank == need - 1);
                const int hl = hit ? (__ffsll((long long)hit) - 1) : 0;
                tau = ((unsigned long long)(unsigned)__builtin_amdgcn_readlane((int)mhi, hl) << 32) | (unsigned)__builtin_amdgcn_readlane((int)mlo, hl);
                asm volatile("" ::: "memory");
            }
            { int base = 0;
#pragma unroll
              for (int i = 0; i < 16; ++i) { if (i < NI) { const bool e = v[i] >= tau; const unsigned long long bm = __ballot(e);
                  if (e) irow[base + (int)__popcll(bm & ((1ull << lane) - 1ull))] = (unsigned short)(0xffffu - (unsigned)(v[i] & 0xffffull));
                  base += (int)__popcll(bm); } } }
        }
        if (tid < 16) CNT[t0 + tid] = 256;
        __syncthreads();
        if (tid < 16 && qOvf[tid]) { const unsigned k = LDS_ADD(ovl, 1u); ovl[1 + k] = (unsigned)(t0 + 4 * (tid & 3) + (tid >> 2)); }
    }
    __syncthreads();
    const unsigned novl = __builtin_amdgcn_readfirstlane(ovl[0]);
#pragma unroll 1
    for (unsigned k = 0; k < novl; ++k) { const unsigned tq = __builtin_amdgcn_readfirstlane(ovl[1 + k]); indexer_slow_query(p, lds, (size_t)tq); }
}
#undef LDS_ADD

__device__ __forceinline__ void phase_attn(const P& p, unsigned char* lds) {
    unsigned char* ws = p.ws; const int tid = threadIdx.x, lane = tid & 63, hd = lane & 15, g = lane >> 4;
    const int wave = __builtin_amdgcn_readfirstlane(tid >> 6);
    bf16_t* QP = (bf16_t*)(ws + OFF_QP); const bf16_t* CK = (const bf16_t*)(ws + OFF_CKVN); const bf16_t* RK = (const bf16_t*)(ws + OFF_RK);
    const unsigned short* IDX = (const unsigned short*)(ws + OFF_IDX); const int* CNT = (const int*)(ws + OFF_CNT);
    float* biasT = (float*)lds;
    biasT[tid] = p.rel_bias[tid] * 1.4426950408889634f;
    __syncthreads();
    LAS unsigned char* rows = (LAS unsigned char*)(lds + 2048 + (size_t)wave * 18432);
    LAS bf16_t* rkb = (LAS bf16_t*)(rows + 16384);
    LAS unsigned* info = (LAS unsigned*)(rows + 17408);
    const LAS float* biasL = (const LAS float*)lds;
    for (int t = blockIdx.x * 8 + wave; t < T; t += gridDim.x * 8) {
        const int batch = t >> 14, pos = t & (SEQ - 1); const int cnt = __builtin_amdgcn_readfirstlane(CNT[t]);
        const size_t rb = (size_t)batch * SEQ;
        asm volatile("s_waitcnt lgkmcnt(0)" ::: "memory");
#pragma unroll
        for (int jj = 0; jj < 4; ++jj) {
            const int j = lane + 64 * jj; int id = IDX[(size_t)t * 256 + j]; if (j >= cnt) id = 0;
            const int rel = pos - id; int bucket = rel < 0 ? 0 : rel;
            if (rel >= 16) { bucket = 16 + (int)(__logf((float)rel * 0.0625f) / 2.0794415416798357f * 16.0f); bucket = bucket > 31 ? 31 : bucket; }
            info[j] = (unsigned)id | ((unsigned)bucket << 16);
        }
        bf16x8 qf[8];
#pragma unroll
        for (int ks = 0; ks < 8; ++ks) qf[ks] = *(const bf16x8*)(QP + (size_t)t * 4096 + hd * 256 + ks * 32 + g * 8);
        f32x4 o[16];
#pragma unroll
        for (int rt = 0; rt < 16; ++rt) o[rt] = (f32x4){0.f, 0.f, 0.f, 0.f};
        float mref = 0.f, lrun = 0.f;
        asm volatile("s_waitcnt lgkmcnt(0)" ::: "memory");
        const int nch = (cnt + 31) >> 5;
        for (int ch = 0; ch < nch; ++ch) {
            asm volatile("s_waitcnt lgkmcnt(0)" ::: "memory");
#pragma unroll
            for (int i = 0; i < 16; ++i) {
                const int ksl = 2 * i + (lane >> 5); const unsigned idv = info[ch * 32 + ksl] & 0xffffu;
                const bf16_t* src = CK + (rb + idv) * 256 + (((lane & 31) ^ (ksl & 15)) * 8);
                __builtin_amdgcn_global_load_lds((const unsigned*)src, (LAS unsigned*)(rows + i * 1024), 16, 0, 0);
            }
            { const unsigned idv = info[ch * 32 + (lane >> 1)] & 0xffffu;
              __builtin_amdgcn_global_load_lds((const unsigned*)(RK + (rb + idv) * 16 + (lane & 1) * 8), (LAS unsigned*)rkb, 16, 0, 0); }
            asm volatile("s_waitcnt vmcnt(0)" ::: "memory");
            f32x4 s0 = (f32x4){0.f, 0.f, 0.f, 0.f}, s1 = (f32x4){0.f, 0.f, 0.f, 0.f};
#pragma unroll
            for (int ks = 0; ks < 8; ++ks) {
                const int pos16 = ((4 * ks + g) ^ hd) * 16;
                const bf16x8 a0 = *(const LAS bf16x8*)(rows + hd * 512 + pos16);
                const bf16x8 a1 = *(const LAS bf16x8*)(rows + (16 + hd) * 512 + pos16);
                s0 = __builtin_amdgcn_mfma_f32_16x16x32_bf16(a0, qf[ks], s0, 0, 0, 0);
                s1 = __builtin_amdgcn_mfma_f32_16x16x32_bf16(a1, qf[ks], s1, 0, 0, 0);
            }
            float x0[4], x1[4];
#pragma unroll
            for (int r = 0; r < 4; ++r) {
                const int sl0 = 4 * g + r, sl1 = 16 + 4 * g + r, j0 = ch * 32 + sl0, j1 = ch * 32 + sl1;
                const unsigned i0 = info[j0], i1 = info[j1];
                const float r0 = bf2f(rkb[sl0 * 16 + hd]), r1 = bf2f(rkb[sl1 * 16 + hd]);
                x0[r] = fmaf(s0[r], r0, biasL[(i0 >> 16) * 16 + hd]);
                x1[r] = fmaf(s1[r], r1, biasL[(i1 >> 16) * 16 + hd]);
            }
            if (cnt < 256) {
#pragma unroll
                for (int r = 0; r < 4; ++r) { if (ch * 32 + 4 * g + r >= cnt) x0[r] = -INFINITY; if (ch * 32 + 16 + 4 * g + r >= cnt) x1[r] = -INFINITY; }
            }
            const float cml = fmaxf(fmaxf(fmaxf(x0[0], x0[1]), fmaxf(x0[2], x0[3])), fmaxf(fmaxf(x1[0], x1[1]), fmaxf(x1[2], x1[3])));
            if (ch == 0 || __ballot(cml > mref + 11.5f)) {
                float cm = fmaxf(cml, __shfl_xor(cml, 16)); cm = fmaxf(cm, __shfl_xor(cm, 32));
                const float mnew = (ch == 0) ? cm : fmaxf(mref, cm);
                if (ch != 0) { const float sc = __builtin_amdgcn_exp2f(mref - mnew); lrun *= sc;
#pragma unroll
                    for (int rt = 0; rt < 16; ++rt) o[rt] *= sc; }
                mref = mnew;
            }
            float ls = 0.f;
#pragma unroll
            for (int r = 0; r < 4; ++r) { x0[r] = __builtin_amdgcn_exp2f(x0[r] - mref); x1[r] = __builtin_amdgcn_exp2f(x1[r] - mref); ls += x0[r] + x1[r]; }
            lrun += ls;
            u32x4 pw; pw.x = pg8::cvt_pk_bf16(x0[0], x0[1]); pw.y = pg8::cvt_pk_bf16(x0[2], x0[3]); pw.z = pg8::cvt_pk_bf16(x1[0], x1[1]); pw.w = pg8::cvt_pk_bf16(x1[2], x1[3]);
            const bf16x8 pf = __builtin_bit_cast(bf16x8, pw);
            const int q = hd >> 2, pp = hd & 3, ksl = 4 * g + q;
            const LAS unsigned char* trb = rows + ksl * 512 + (pp & 1) * 8;
#pragma unroll
            for (int rt = 0; rt < 16; ++rt) {
                const int c16 = ((2 * rt + (pp >> 1)) ^ ksl) * 16;
                const v4i16_t t0 = __builtin_amdgcn_ds_read_tr16_b64_v4i16((LAS v4i16_t*)(trb + c16));
                const v4i16_t t1 = __builtin_amdgcn_ds_read_tr16_b64_v4i16((LAS v4i16_t*)(trb + c16 + 8192));
                bf16x8 af; af[0] = t0[0]; af[1] = t0[1]; af[2] = t0[2]; af[3] = t0[3]; af[4] = t1[0]; af[5] = t1[1]; af[6] = t1[2]; af[7] = t1[3];
                o[rt] = __builtin_amdgcn_mfma_f32_16x16x32_bf16(af, pf, o[rt], 0, 0, 0);
            }
        }
        float ltot = lrun; ltot += __shfl_xor(ltot, 16); ltot += __shfl_xor(ltot, 32);
        const float inv = 1.0f / ltot;
        bf16_t* op = QP + (size_t)t * 4096 + hd * 256 + 4 * g;
#pragma unroll
        for (int rt = 0; rt < 16; ++rt) { u32x2 w; w.x = pg8::cvt_pk_bf16(o[rt][0] * inv, o[rt][1] * inv); w.y = pg8::cvt_pk_bf16(o[rt][2] * inv, o[rt][3] * inv); *(u32x2*)(op + rt * 16) = w; }
    }
}

__global__ void __launch_bounds__(512, 2) k_fwd(P p_arg, int ph_lo, int ph_hi) {
    extern __shared__ __attribute__((aligned(16))) unsigned char smem[];
    const P& p = *(const P*)__builtin_amdgcn_kernarg_segment_ptr(); (void)p_arg;
    unsigned char* lds = smem + 16;
    unsigned char* ws = p.ws;
    XcdBarrier bar;
    const bool multi = (ph_hi - ph_lo) > 1;
    if (multi) {
        if (threadIdx.x == 0) *(uint4*)smem = make_uint4(0u, 0u, 0u, 0u);
        __syncthreads();
        bar = xcd_barrier_post((unsigned*)(ws + OFF_CTL), (volatile LAS unsigned*)smem);
    }
#define PH(i) (ph_lo <= (i) && (i) < ph_hi)
#define SEAM(i) do { if ((i) + 1 < ph_hi) xcd_barrier(bar); else __syncthreads(); } while (0)
    bf16_t *XN = (bf16_t*)(ws + OFF_XN), *QB = (bf16_t*)(ws + OFF_QB), *KB = (bf16_t*)(ws + OFF_KB), *VB = (bf16_t*)(ws + OFF_VB), *TMP = (bf16_t*)(ws + OFF_TMP), *Y = (bf16_t*)(ws + OFF_Y);
    if (PH(0)) { phase_prep(p, lds); SEAM(0); }
    if (PH(1)) { fast_gemm(lds, XN, 1024, (const bf16_t*)(ws + OFF_W0T), 1024, 3072, 1024, D1{ws}); SEAM(1); }
    if (PH(2)) { phase_conv_scan(p, lds); SEAM(2); }
    if (PH(3)) { mlstm_units<false>(p, lds); SEAM(3); }
    if (PH(4)) { GWP f{(const bf16_t*)(ws + OFF_WPT), (const bf16_t*)(ws + OFF_WUB), (bf16_t*)(ws + OFF_W0T)}; sgemm(f, 256); phase_mlstm_scan(p, lds); SEAM(4); }
    if (PH(5)) { mlstm_units<true>(p, lds); SEAM(5); }
    if (PH(6)) { fast_gemm(lds, XN, 1024, (const bf16_t*)(ws + OFF_W0T) + (size_t)3072 * 1024, 1024, 4096, 1024, D2{ws}); SEAM(6); }
    if (PH(7)) { phase_ya_pool(p); SEAM(7); }
    if (PH(8)) { fast_gemm(lds, Y, 2048, (const bf16_t*)(ws + OFF_WO0T), 2048, 1024, 2048, D4{(unsigned char*)p.out, p.x}); SEAM(8); }
    if (PH(9)) { rmsnorm_rows<4>(p.out, p.o_norm, XN, p.o_w_in, OIN, 1600, nullptr, 0.5f, (float*)(ws + OFF_WI), (float*)lds); SEAM(9); }
    if (PH(10)) { fast_gemm(lds, XN, 1024, (const bf16_t*)(ws + OFF_W1T), 1024, 2816, 1024, D5{ws}); SEAM(10); }
    if (PH(11)) { phase_qnorm_ckvnorm(p); SEAM(11); }
    if (PH(12)) { fast_gemm(lds, (const bf16_t*)(ws + OFF_CKVN), 256, (const bf16_t*)(ws + OFF_WUKP), 256, 1024, 256, DK{ws}); SEAM(12); }
    if (PH(13)) { fast_gemm(lds, TMP, 1024, (const bf16_t*)(ws + OFF_WQF), 128, 4096, 128, DQ{ws}, (size_t)128); phase_indexer(p, lds); SEAM(13); }
    if (PH(14)) { phase_attn(p, lds); SEAM(14); }
    if (PH(15)) { fast_gemm(lds, (const bf16_t*)(ws + OFF_QP), 4096, (const bf16_t*)(ws + OFF_WBD), 1024, 1024, 1024, DO{ws}, (size_t)2048); SEAM(15); }
    if (PH(16)) { fast_gemm(lds, TMP, 1024, (const bf16_t*)(ws + OFF_WO1T), 1024, 1024, 1024, D8{(unsigned char*)p.out}); }
#undef PH
#undef SEAM
}

extern "C" void kernel_launch(void* const* d_in, const int* in_sizes, int n_in, void* d_out, int out_size, void* d_ws, size_t ws_size, hipStream_t stream) {
    static int grid = 0;
    if (grid == 0) {
        if (n_in != 18 || out_size != T * DM || ws_size < WS_END) { fprintf(stderr, "kernel_launch: unexpected shapes (n_in %d out %d ws %zu)\n", n_in, out_size, ws_size); grid = -1; return; }
        if (hipFuncSetAttribute((const void*)k_fwd, hipFuncAttributeMaxDynamicSharedMemorySize, LDS_BYTES) != hipSuccess) { fprintf(stderr, "kernel_launch: hipFuncSetAttribute failed\n"); grid = -1; return; }
        grid = 256;
    }
    if (grid < 0) return;
    (void)hipMemsetAsync((char*)d_ws + OFF_CTL, 0, 16384, stream);
    P p{};
    p.x = (const float*)d_in[0]; p.e_norm = (const float*)d_in[1]; p.e_w_in = (const float*)d_in[2]; p.e_conv = (const float*)d_in[3]; p.e_b_if = (const float*)d_in[4];
    p.e_g_head = (const float*)d_in[5]; p.e_w_pool = (const float*)d_in[6]; p.e_s_pool = (const float*)d_in[7]; p.e_w_out = (const float*)d_in[8];
    p.o_norm = (const float*)d_in[9]; p.o_w_in = (const float*)d_in[10]; p.o_g_kv = (const float*)d_in[11]; p.o_w_uk = (const float*)d_in[12]; p.o_w_uv = (const float*)d_in[13];
    p.o_g_q = (const float*)d_in[14]; p.o_g_k = (const float*)d_in[15]; p.o_w_out = (const float*)d_in[16]; p.rel_bias = (const float*)d_in[17];
    p.out = (float*)d_out; p.ws = (unsigned char*)d_ws;
    hipLaunchKernelGGL(k_fwd, dim3(grid), dim3(512), LDS_BYTES, stream, p, 0, NPH);
}
```

```cpp
#include <hip/hip_runtime.h>
#include <stdint.h>
#include <cstdio>

typedef unsigned short bf16_t;
typedef short bf16x8 __attribute__((ext_vector_type(8)));
typedef float f32x4 __attribute__((ext_vector_type(4)));
typedef unsigned u32x4 __attribute__((ext_vector_type(4)));
typedef unsigned u32x2 __attribute__((ext_vector_type(2)));
typedef short v4i16_t __attribute__((ext_vector_type(4)));
#define LAS __attribute__((address_space(3)))

constexpr int T = 32768, SEQ = 16384, DM = 1024;
constexpr int EIN = 7176, OIN = 2628;
constexpr float EPS = 1e-6f;
constexpr size_t MB = 1048576;
constexpr size_t OFF_CTL = 0;
constexpr size_t OFF_GATES = 64 * 1024;
constexpr size_t OFF_BQ = OFF_GATES + (size_t)T * 8 * 4;
constexpr size_t OFF_IQ = OFF_BQ + (size_t)T * 4 * 4;
constexpr size_t OFF_MT = OFF_IQ + (size_t)T * 4 * 4;
constexpr size_t OFF_WI = OFF_MT + (size_t)T * 4 * 4;
constexpr size_t OFF_CH = OFF_WI + (size_t)T * 4 * 4;
constexpr size_t OFF_NS = OFF_CH + 64 * 1024;
constexpr size_t OFF_W = 4 * MB;
constexpr size_t OFF_W0T = OFF_W;
constexpr size_t OFF_WPT = OFF_W0T + (size_t)7168 * 1024 * 2;
constexpr size_t OFF_WO0T = OFF_WPT + (size_t)4 * 256 * 256 * 2;
constexpr size_t OFF_W1T = OFF_WO0T + (size_t)1024 * 2048 * 2;
constexpr size_t OFF_WUKT = OFF_W1T + (size_t)2816 * 1024 * 2;
constexpr size_t OFF_WUVT = OFF_WUKT + (size_t)1024 * 256 * 2;
constexpr size_t OFF_WO1T = OFF_WUVT + (size_t)1024 * 256 * 2;
constexpr size_t OFF_WUKP = OFF_WO1T + (size_t)1024 * 1024 * 2;
constexpr size_t OFF_WQP = OFF_WUKP + (size_t)1024 * 256 * 2;
constexpr size_t OFF_WUB = OFF_WQP + (size_t)16 * 256 * 64 * 2;
constexpr size_t OFF_XN = 36 * MB, OFF_QB = 100 * MB, OFF_KB = 164 * MB, OFF_VB = 228 * MB, OFF_TMP = 292 * MB, OFF_Y = 356 * MB;
constexpr size_t OFF_QP = 36 * MB;
constexpr size_t OFF_CKVN = OFF_Y;
constexpr size_t OFF_QI = OFF_Y + 16 * MB;
constexpr size_t OFF_KI = OFF_Y + 32 * MB;
constexpr size_t OFF_KIT = OFF_Y + 36 * MB;
constexpr size_t OFF_IDX = OFF_Y + 40 * MB;
constexpr size_t OFF_RK = OFF_Y + 58 * MB;
constexpr size_t OFF_CNT = OFF_Y + 59 * MB;
constexpr size_t OFF_Z = OFF_Y + 60 * MB;
constexpr size_t OFF_WBD = 484 * MB;
constexpr size_t OFF_WQF = 486 * MB;
constexpr size_t WS_END = 487 * MB;
constexpr int LDS_BYTES = 151552;
constexpr int NPH = 17;

struct P {
    const float *x, *e_norm, *e_w_in, *e_conv, *e_b_if, *e_g_head, *e_w_pool, *e_s_pool, *e_w_out;
    const float *o_norm, *o_w_in, *o_g_kv, *o_w_uk, *o_w_uv, *o_g_q, *o_g_k, *o_w_out, *rel_bias;
    float* out; unsigned char* ws;
};

__device__ __forceinline__ bf16_t f2bf(float f) { unsigned u = __float_as_uint(f); u += 0x7FFFu + ((u >> 16) & 1u); return (bf16_t)(u >> 16); }
__device__ __forceinline__ float bf2f(bf16_t b) { return __uint_as_float(((unsigned)b) << 16); }
__device__ __forceinline__ float bflo(unsigned w) { return __uint_as_float(w << 16); }
__device__ __forceinline__ float bfhi(unsigned w) { return __uint_as_float(w & 0xffff0000u); }
__device__ __forceinline__ unsigned pk2(float a, float b) { return (unsigned)f2bf(a) | ((unsigned)f2bf(b) << 16); }
__device__ __forceinline__ float sigmoidf_(float x) { return __builtin_amdgcn_rcpf(1.0f + __expf(-x)); }
__device__ __forceinline__ float siluf_(float x) { return x * __builtin_amdgcn_rcpf(1.0f + __expf(-x)); }
template <int CTRL> __device__ __forceinline__ float dppf(float v) { return __builtin_bit_cast(float, __builtin_amdgcn_update_dpp(0, __builtin_bit_cast(int, v), CTRL, 0xf, 0xf, true)); }
__device__ __forceinline__ float rlf(float v, int l) { return __builtin_bit_cast(float, __builtin_amdgcn_readlane(__builtin_bit_cast(int, v), l)); }
__device__ __forceinline__ int tid_opaque() { int t = threadIdx.x; asm volatile("" : "+v"(t)); return t; }
__device__ __forceinline__ float wave_sum(float v) {
    v += dppf<0xB1>(v); v += dppf<0x4E>(v); v += dppf<0x141>(v); v += dppf<0x140>(v);
    return (rlf(v, 0) + rlf(v, 16)) + (rlf(v, 32) + rlf(v, 48));
}
__device__ __forceinline__ float wave_max(float v) {
    v = fmaxf(v, dppf<0xB1>(v)); v = fmaxf(v, dppf<0x4E>(v)); v = fmaxf(v, dppf<0x141>(v)); v = fmaxf(v, dppf<0x140>(v));
    return fmaxf(fmaxf(rlf(v, 0), rlf(v, 16)), fmaxf(rlf(v, 32), rlf(v, 48)));
}

template <int CTRL, int RM, bool BC> __device__ __forceinline__ unsigned dppu(unsigned v) { return (unsigned)__builtin_amdgcn_update_dpp(0, (int)v, CTRL, RM, 0xf, BC); }
__device__ __forceinline__ unsigned wave_iscan(unsigned v) {
    v += dppu<0x111, 0xf, true>(v); v += dppu<0x112, 0xf, true>(v); v += dppu<0x114, 0xf, true>(v); v += dppu<0x118, 0xf, true>(v);
    v += dppu<0x142, 0xa, false>(v); v += dppu<0x143, 0xc, false>(v);
    return v;
}
__device__ __forceinline__ unsigned rlu(unsigned v, int l) { return (unsigned)__builtin_amdgcn_readlane((int)v, l); }
__device__ __forceinline__ void radix_pick(const __attribute__((address_space(3))) unsigned* h2, int lane, unsigned want, int& T, unsigned& above, unsigned& cin) {
    asm volatile("" : "+v"(lane));
    const u32x4 hv = *(const __attribute__((address_space(3))) u32x4*)(h2 + 252 - 4 * lane);
    const unsigned cs = hv.x + hv.y + hv.z + hv.w;
    const unsigned incl = wave_iscan(cs);
    const unsigned long long m = __ballot(incl >= want);
    if (m == 0ull) { T = -1; above = rlu(incl, 63); cin = 0u; return; }
    const int Ls = __ffsll((long long)m) - 1;
    unsigned ab = rlu(incl - cs, Ls); const unsigned a0 = rlu(hv.w, Ls), a1 = rlu(hv.z, Ls), a2 = rlu(hv.y, Ls), a3 = rlu(hv.x, Ls);
    int t = 255 - 4 * Ls; unsigned c = a0;
    if (ab + a0 < want) { ab += a0; t -= 1; c = a1; if (ab + a1 < want) { ab += a1; t -= 1; c = a2; if (ab + a2 < want) { ab += a2; t -= 1; c = a3; } } }
    T = t; above = ab; cin = c;
}

#define XB_TMO      128
#define XB_XCNT(j)  (256  + 64 * (j))
#define XB_XSUB(j)  (1280 + 64 * (j))
#define XB_XGEN(j)  (2304 + 64 * (j))
#define XB_TOP      3328
#define XB_TOPGEN   3392
#define XCD_BAR_WORDS 3456
#define XB_SPIN_CAP (1u << 22)
__device__ __forceinline__ unsigned xb_ld(unsigned* p)              { return __hip_atomic_load(p, __ATOMIC_RELAXED, __HIP_MEMORY_SCOPE_AGENT); }
__device__ __forceinline__ unsigned xb_add(unsigned* p, unsigned v) { return __hip_atomic_fetch_add(p, v, __ATOMIC_RELAXED, __HIP_MEMORY_SCOPE_AGENT); }
__device__ __forceinline__ unsigned xb_xcc_id() { return (unsigned)__builtin_amdgcn_s_getreg((3 << 11) | 20) & 0xFu; }
#define XB_SPIN(cond, bar) do { unsigned _sp = 0; while (cond) { __builtin_amdgcn_s_sleep(1); \
    if ((++_sp & 255u) == 0u) { if (xb_ld(&(bar)[XB_TMO])) break; if (_sp > XB_SPIN_CAP) { atomicAdd(&(bar)[XB_TMO], 1u); break; } } } } while (0)
struct XcdBarrier { unsigned* bar; unsigned x; volatile LAS unsigned* st; };
__device__ __forceinline__ XcdBarrier xcd_barrier_post(unsigned* bar, volatile LAS unsigned* st) {
    XcdBarrier b; b.bar = bar; b.x = xb_xcc_id(); b.st = st;
    if (threadIdx.x == 0) (void)xb_add(&bar[XB_XCNT(b.x)], 1u);
    return b;
}
__device__ __forceinline__ void xcd_barrier_complete(unsigned* bar, unsigned x, unsigned& nloc, unsigned& nx) {
    const unsigned G = gridDim.x * gridDim.y * gridDim.z;
    unsigned sum, cnt, mine, sp = 0u;
    for (;;) {
        sum = 0u; cnt = 0u; mine = 0u;
#pragma unroll
        for (unsigned j = 0; j < 16; ++j) { const unsigned c = xb_ld(&bar[XB_XCNT(j)]); sum += c; cnt += (c > 0u) ? 1u : 0u; mine = (j == x) ? c : mine; }
        if (sum == G) break;
        __builtin_amdgcn_s_sleep(1);
        if ((++sp & 255u) == 0u) { if (xb_ld(&bar[XB_TMO])) break; if (sp > XB_SPIN_CAP) { atomicAdd(&bar[XB_TMO], 1u); break; } }
    }
    nloc = mine > 0u ? mine : 1u; nx = cnt > 0u ? cnt : 1u;
}
__device__ __forceinline__ void xcd_barrier(const XcdBarrier& b) {
    asm volatile("s_waitcnt vmcnt(0)" ::: "memory");
    __syncthreads();
    if (threadIdx.x == 0) {
        unsigned* bar = b.bar;
        __builtin_amdgcn_s_waitcnt(0);
        unsigned nloc = b.st[0], nx = b.st[1];
        if (nloc == 0u) { xcd_barrier_complete(bar, b.x, nloc, nx); b.st[0] = nloc; b.st[1] = nx; }
        const unsigned old = xb_add(&bar[XB_XSUB(b.x)], 1u);
        const unsigned gen = old / nloc;
        if (old + 1u == (gen + 1u) * nloc) {
            __builtin_amdgcn_fence(__ATOMIC_RELEASE, "agent");
            asm volatile("s_waitcnt vmcnt(0)" ::: "memory");
            const unsigned og = xb_add(&bar[XB_TOP], 1u);
            const unsigned tg = og / nx;
            if (og + 1u == (tg + 1u) * nx) xb_add(&bar[XB_TOPGEN], 1u);
            else XB_SPIN(xb_ld(&bar[XB_TOPGEN]) == tg, bar);
            __builtin_amdgcn_fence(__ATOMIC_ACQUIRE, "agent");
            xb_add(&bar[XB_XGEN(b.x)], 1u);
            asm volatile("s_waitcnt vmcnt(0)" ::: "memory");
        } else {
            XB_SPIN(xb_ld(&bar[XB_XGEN(b.x)]) == gen, bar);
            __builtin_amdgcn_fence(__ATOMIC_ACQUIRE, "agent");
            asm volatile("s_waitcnt vmcnt(0)" ::: "memory");
        }
    }
    __syncthreads();
}

struct Tile { const bf16_t* A; const bf16_t* B; int lda, ldb, K; void* d0; const void* s0; int ld; };
template <class F>
__device__ __forceinline__ void sgemm(const F f, int nunits) {
    const int lane = threadIdx.x & 63, wave = threadIdx.x >> 6, fr = lane & 15, fq = lane >> 4;
    for (int u = blockIdx.x * 8 + wave; u < nunits; u += gridDim.x * 8) {
        Tile tl; f.tile(u, tl);
        f32x4 acc[4][4];
#pragma unroll
        for (int m = 0; m < 4; ++m)
#pragma unroll
            for (int n = 0; n < 4; ++n) acc[m][n] = (f32x4){0.f, 0.f, 0.f, 0.f};
        const bf16_t* ap = tl.A + (size_t)fr * tl.lda + fq * 8;
        const bf16_t* bp = tl.B + (size_t)fr * tl.ldb + fq * 8;
        const int K = tl.K, lda = tl.lda, ldb = tl.ldb;
        bf16x8 a[4], b[4];
#pragma unroll
        for (int m = 0; m < 4; ++m) a[m] = *(const bf16x8*)(ap + (size_t)(m * 16) * lda);
#pragma unroll
        for (int n = 0; n < 4; ++n) b[n] = *(const bf16x8*)(bp + (size_t)(n * 16) * ldb);
#pragma unroll 1
        for (int k0 = 0; k0 < K; k0 += 32) {
            bf16x8 an[4], bn[4]; const int kn = (k0 + 32 < K) ? k0 + 32 : k0;
#pragma unroll
            for (int m = 0; m < 4; ++m) an[m] = *(const bf16x8*)(ap + (size_t)(m * 16) * lda + kn);
#pragma unroll
            for (int n = 0; n < 4; ++n) bn[n] = *(const bf16x8*)(bp + (size_t)(n * 16) * ldb + kn);
#pragma unroll
            for (int m = 0; m < 4; ++m)
#pragma unroll
                for (int n = 0; n < 4; ++n) acc[m][n] = __builtin_amdgcn_mfma_f32_16x16x32_bf16(b[n], a[m], acc[m][n], 0, 0, 0);
#pragma unroll
            for (int m = 0; m < 4; ++m) { a[m] = an[m]; b[m] = bn[m]; }
        }
#pragma unroll
        for (int m = 0; m < 4; ++m) {
            asm volatile("" ::: "memory");
#pragma unroll
            for (int n = 0; n < 4; ++n) f.out4(tl, m * 16 + fr, n * 16 + 4 * fq, acc[m][n]);
        }
    }
}
__device__ __forceinline__ void store4_bf16(const Tile& tl, int r, int c, const f32x4 v) {
    u32x2 w; w.x = pk2(v[0], v[1]); w.y = pk2(v[2], v[3]); *(u32x2*)((bf16_t*)tl.d0 + (size_t)r * tl.ld + c) = w; }

struct GWP {
    const bf16_t* WPT; const bf16_t* WUB; bf16_t* W0T;
    __device__ __forceinline__ void tile(int u, Tile& tl) const {
        const int kt = u & 15, dt = (u >> 4) & 3, g = u >> 6; tl.A = WPT + (size_t)(g * 256 + dt * 64) * 256; tl.lda = 256; tl.B = WUB + (size_t)kt * 64 * 1024 + g * 256; tl.ldb = 1024; tl.K = 256;
        tl.d0 = W0T + (size_t)(5120 + g * 256 + dt * 64) * 1024 + kt * 64; tl.ld = 1024; }
    __device__ __forceinline__ void out4(const Tile& tl, int r, int c, const f32x4 v) const { store4_bf16(tl, r, c, v); }
};
struct GQP {
    const bf16_t* Qn; const bf16_t* W; bf16_t* QP;
    __device__ __forceinline__ void tile(int u, Tile& tl) const {
        const int nt = u & 3, head = (u >> 2) & 15, mt = u >> 6; tl.A = Qn + (size_t)mt * 64 * 1024 + head * 64; tl.lda = 1024; tl.B = W + (size_t)(head * 256 + nt * 64) * 64; tl.ldb = 64; tl.K = 64;
        tl.d0 = QP + ((size_t)mt * 64 * 16 + head) * 256 + nt * 64; tl.ld = 4096; }
    __device__ __forceinline__ void out4(const Tile& tl, int r, int c, const f32x4 v) const { store4_bf16(tl, r, c, v); }
};
struct GOP {
    const bf16_t* OP; const bf16_t* W; const bf16_t* Z; bf16_t* G;
    __device__ __forceinline__ void tile(int u, Tile& tl) const {
        const int head = u & 15, mt = u >> 4; tl.A = OP + (size_t)mt * 64 * 4096 + head * 256; tl.lda = 4096; tl.B = W + (size_t)head * 64 * 256; tl.ldb = 256; tl.K = 256;
        const size_t o = (size_t)mt * 64 * 1024 + head * 64; tl.d0 = G + o; tl.s0 = Z + o; tl.ld = 1024; }
    __device__ __forceinline__ void out4(const Tile& tl, int r, int c, const f32x4 v) const { const size_t i = (size_t)r * 1024 + c; const u32x2 z = *(const u32x2*)((const bf16_t*)tl.s0 + i);
        u32x2 w; w.x = pk2(v[0] * bflo(z.x), v[1] * bfhi(z.x)); w.y = pk2(v[2] * bflo(z.y), v[3] * bfhi(z.y)); *(u32x2*)((bf16_t*)tl.d0 + i) = w; }
};

namespace pg8 {
constexpr int BM = 256, BK = 64, HALF = 128, HTB = HALF * BK * 2, STAGE_BYTES = 8 * HTB, NXCD = 8, WGM = 8;
__device__ __forceinline__ int lds_byte(int r, int c) { return (r >> 3) * 1024 + (r & 7) * 128 + ((((c >> 3) ^ (r >> 1)) & 7) << 4) + (c & 7) * 2; }
__device__ __forceinline__ void stage_rc(int b, int& R, int& C) { const int st = b / 1024, sb = b % 1024; R = st * 8 + (sb >> 7); C = ((((sb >> 4) & 7) ^ (R >> 1)) & 7) * 8; }
__device__ __forceinline__ int perm32(int rho) { const int n = rho >> 4, i = rho & 15; return 8 * (i >> 2) + 4 * n + (i & 3); }
struct Unit { int pm, pn; };
struct Gemm { const bf16_t* A; int lda; const bf16_t* Bt; int ldb; int M, N, K; size_t apn; };
struct StaticOrder {
    int nM, nN, nwg, G, c;
    __device__ void init(int M, int N, int G_, int c_) { nM = M / BM; nN = N / BM; nwg = nM * nN; G = G_; c = c_; }
    __device__ bool next(int i, Unit& u) const {
        const long L = (long)i * G + c; if (L >= nwg) return false;
        int wgid = (int)L; { const int q = nwg / NXCD, r = nwg % NXCD, xcd = wgid % NXCD, off = wgid / NXCD; wgid = (xcd < r ? xcd * (q + 1) : r * (q + 1) + (xcd - r) * q) + off; }
        const int nig = WGM * nN, gid = wgid / nig, fm = gid * WGM, gsz = (nM - fm) < WGM ? (nM - fm) : WGM;
        u.pm = fm + ((wgid % nig) % gsz); u.pn = (wgid % nig) / gsz; return true;
    }
};
__device__ __forceinline__ unsigned cvt_pk_bf16(float lo, float hi) { unsigned r; asm volatile("v_cvt_pk_bf16_f32 %0, %1, %2" : "=v"(r) : "v"(lo), "v"(hi)); return r; }

struct Dst { unsigned char* base; const float* res; int ld, mode, ncol; float scale; };
template <class DescF> struct EpiGen {
    static constexpr bool PERM = true;
    DescF D;
    __device__ __forceinline__ void operator()(const f32x4 (&acc)[2][2][4][2], const Unit& u, int wr, int wc, int fr, int fq) const {
        Dst d; D.get(u, d);
        if ((DescF::MODES & 16) && d.mode == 4) return;
        const int r0 = wr * 64 + fr, c0 = wc * 32 + 8 * fq;
        if constexpr ((DescF::MODES & 64) != 0) {
#pragma unroll
            for (int ai = 0; ai < 2; ++ai)
#pragma unroll
                for (int m = 0; m < 4; ++m) {
                    float ss = 0.f;
#pragma unroll
                    for (int bj = 0; bj < 2; ++bj)
#pragma unroll
                        for (int n = 0; n < 2; ++n) { const f32x4 v = acc[ai][bj][m][n]; ss += v[0] * v[0] + v[1] * v[1] + v[2] * v[2] + v[3] * v[3]; }
                    ss += __shfl_xor(ss, 16); ss += __shfl_xor(ss, 32);
                    if (fq == 0) ((bf16_t*)d.base)[(size_t)(ai * HALF + r0 + m * 16) * d.ld + wc] = f2bf(rsqrtf(ss * (1.0f / 64.0f) + EPS) * 1.4426950408889634f);
                }
            return;
        } else {
#pragma unroll
        for (int ai = 0; ai < 2; ++ai)
#pragma unroll
            for (int m = 0; m < 4; ++m) {
                const size_t rowoff = (size_t)(ai * HALF + r0 + m * 16) * d.ld;
#pragma unroll
                for (int bj = 0; bj < 2; ++bj) {
                    const int col = bj * HALF + c0; f32x4 v0 = acc[ai][bj][m][0], v1 = acc[ai][bj][m][1];
                    if ((DescF::MODES & 7) && d.mode <= 2) {
                        if ((DescF::MODES & 2) && d.mode == 1) {
#pragma unroll
                            for (int j = 0; j < 4; ++j) { v0[j] = sigmoidf_(v0[j]); v1[j] = sigmoidf_(v1[j]); } }
                        if ((DescF::MODES & 4) && d.mode == 2) {
#pragma unroll
                            for (int j = 0; j < 4; ++j) { v0[j] = siluf_(v0[j]); v1[j] = siluf_(v1[j]); } }
                        u32x4 w; w.x = cvt_pk_bf16(v0[0], v0[1]); w.y = cvt_pk_bf16(v0[2], v0[3]); w.z = cvt_pk_bf16(v1[0], v1[1]); w.w = cvt_pk_bf16(v1[2], v1[3]);
                        *(u32x4*)((bf16_t*)d.base + rowoff + col) = w;
                    } else if ((DescF::MODES & 256) && d.mode == 8) {
                        const u32x4 z = *(const u32x4*)((const bf16_t*)d.res + rowoff + col);
                        u32x4 w; w.x = cvt_pk_bf16(v0[0] * bflo(z.x), v0[1] * bfhi(z.x)); w.y = cvt_pk_bf16(v0[2] * bflo(z.y), v0[3] * bfhi(z.y));
                        w.z = cvt_pk_bf16(v1[0] * bflo(z.z), v1[1] * bfhi(z.z)); w.w = cvt_pk_bf16(v1[2] * bflo(z.w), v1[3] * bfhi(z.w));
                        *(u32x4*)((bf16_t*)d.base + rowoff + col) = w;
                    } else if ((DescF::MODES & 8) && d.mode == 3) {
                        if (col < d.ncol) { float* o = (float*)d.base + rowoff + col; *(f32x4*)o = v0 * d.scale; *(f32x4*)(o + 4) = v1 * d.scale; }
                    } else if ((DescF::MODES & 128) && d.mode == 7) {
                        typedef _Float16 h8 __attribute__((ext_vector_type(8)));
                        if (col < d.ncol) {
                        h8 hv; hv[0] = (_Float16)(v0[0] * d.scale); hv[1] = (_Float16)(v0[1] * d.scale); hv[2] = (_Float16)(v0[2] * d.scale); hv[3] = (_Float16)(v0[3] * d.scale);
                        hv[4] = (_Float16)(v1[0] * d.scale); hv[5] = (_Float16)(v1[1] * d.scale); hv[6] = (_Float16)(v1[2] * d.scale); hv[7] = (_Float16)(v1[3] * d.scale);
                        *(h8*)((_Float16*)d.base + rowoff + col) = hv; }
                    } else if constexpr ((DescF::MODES & 32) != 0) {
                        float* o = (float*)d.base + rowoff + col; const float* rs = d.res + rowoff + col;
                        const f32x4 a = *(const f32x4*)rs, b = *(const f32x4*)(rs + 4); *(f32x4*)o = a + v0; *(f32x4*)(o + 4) = b + v1;
                    }
                }
                if (m & 1) asm volatile("" ::: "memory");
            }
        }
    }
};

template <class Epi>
__device__ __forceinline__ void gemm_phase(LAS unsigned char* lds, const Gemm g, const StaticOrder& S, const Epi& E) {
    const int tid = threadIdx.x, wid = __builtin_amdgcn_readfirstlane(tid >> 6), lane = tid & 63, wr = wid >> 2, wc = wid & 3, fr = lane & 15, fq = lane >> 4;
    int K = g.K; asm volatile("" : "+s"(K));
    const int nt = K / BK;
    unsigned voffA[2], voffB[2];
#pragma unroll
    for (int i = 0; i < 2; ++i) { int R, C; stage_rc(tid * 16 + i * 8192, R, C); const int Rb = Epi::PERM ? ((R & ~31) + perm32(R & 31)) : R;
        voffA[i] = (unsigned)(R * g.lda + C) * 2u; voffB[i] = (unsigned)(Rb * g.ldb + C) * 2u; }
    const size_t kstep = (size_t)(BK * 2);
    const size_t hstepA = (size_t)HALF * g.lda * 2, hstepB = (size_t)HALF * g.ldb * 2;
    const size_t tstepA = 2 * hstepA, tstepB = 2 * hstepB;
    const unsigned ldsw = (unsigned)wid * 1024u;
    const int aoff = lds_byte(wr * 64 + fr, fq * 8), boff = lds_byte(wc * 32 + fr, fq * 8), aoff1 = aoff ^ 64, boff1 = boff ^ 64;
#define PG8_SA(b, h) (((b) * 2 + (h)) * HTB)
#define PG8_SB(b, h) ((4 + (b) * 2 + (h)) * HTB)
#define PG8_STAGE(bufoff, gbase, voff) do { _Pragma("unroll") for (int _i = 0; _i < 2; ++_i) \
        __builtin_amdgcn_global_load_lds((const unsigned*)((const char*)(gbase) + (voff)[_i]), (LAS unsigned*)(lds + (bufoff) + ldsw + _i * 8192), 16, 0, 0); } while (0)
#define PG8_LDA(dst, b, h) do { _Pragma("unroll") for (int m = 0; m < 4; ++m) _Pragma("unroll") for (int k = 0; k < 2; ++k) dst[m][k] = *(const LAS bf16x8*)(lds + PG8_SA(b, h) + (k ? aoff1 : aoff) + m * 2048); } while (0)
#define PG8_LDB(dst, b, h) do { _Pragma("unroll") for (int n = 0; n < 2; ++n) _Pragma("unroll") for (int k = 0; k < 2; ++k) dst[n][k] = *(const LAS bf16x8*)(lds + PG8_SB(b, h) + (k ? boff1 : boff) + n * 2048); } while (0)
#define PG8_MMA(ai, bj, At, Bt) do { __builtin_amdgcn_s_setprio(1); _Pragma("unroll") for (int m = 0; m < 4; ++m) _Pragma("unroll") for (int n = 0; n < 2; ++n) _Pragma("unroll") for (int k = 0; k < 2; ++k) \
        acc[ai][bj][m][n] = __builtin_amdgcn_mfma_f32_16x16x32_bf16(Bt[n][k], At[m][k], acc[ai][bj][m][n], 0, 0, 0); __builtin_amdgcn_s_setprio(0); } while (0)
#define PG8_WAIT_V(n) asm volatile("s_waitcnt vmcnt(" #n ")" ::: "memory")
#define PG8_WAIT_L(n) asm volatile("s_waitcnt lgkmcnt(" #n ")" ::: "memory")
#define PG8_BAR __builtin_amdgcn_s_barrier()
#define PG8_SCHED __builtin_amdgcn_sched_barrier(0)
    Unit cur, nxt; int ui = 0;
    if (!S.next(0, cur)) return;
    f32x4 acc[2][2][4][2];
#pragma unroll
    for (int a = 0; a < 2; ++a)
#pragma unroll
        for (int b = 0; b < 2; ++b)
#pragma unroll
            for (int m = 0; m < 4; ++m)
#pragma unroll
                for (int n = 0; n < 2; ++n) acc[a][b][m][n] = (f32x4){0.f, 0.f, 0.f, 0.f};
    bf16x8 At[4][2], B0[2][2], B1[2][2];
    const char* cA = (const char*)g.A + (size_t)cur.pm * tstepA + (size_t)cur.pn * g.apn; const char* cB = (const char*)g.Bt + (size_t)cur.pn * tstepB;
    PG8_STAGE(PG8_SB(0, 0), cB, voffB); PG8_STAGE(PG8_SA(0, 0), cA, voffA); PG8_STAGE(PG8_SB(0, 1), cB + hstepB, voffB); PG8_STAGE(PG8_SA(0, 1), cA + hstepA, voffA);
    if (wr == 1) PG8_BAR;
    PG8_WAIT_V(4); PG8_BAR;
    PG8_STAGE(PG8_SB(1, 0), cB + kstep, voffB); PG8_STAGE(PG8_SA(1, 0), cA + kstep, voffA); PG8_STAGE(PG8_SB(1, 1), cB + hstepB + kstep, voffB);
    PG8_WAIT_V(6); PG8_BAR;
    for (;;) {
        const bool has_next = S.next(ui + 1, nxt);
        const char* nA = has_next ? (const char*)g.A + (size_t)nxt.pm * tstepA + (size_t)nxt.pn * g.apn : cA; const char* nB = has_next ? (const char*)g.Bt + (size_t)nxt.pn * tstepB : cB;
#pragma unroll 1
        for (int t = 0; t < nt; t += 2) {
            const bool last = (t == nt - 2);
            const char* a1 = cA + (size_t)(t + 1) * kstep;
            const char* a2 = last ? nA : cA + (size_t)(t + 2) * kstep; const char* b2 = last ? nB : cB + (size_t)(t + 2) * kstep;
            const char* a3 = a2 + kstep; const char* b3 = b2 + kstep;
            PG8_LDB(B0, 0, 0); PG8_SCHED; PG8_LDA(At, 0, 0); PG8_STAGE(PG8_SA(1, 1), a1 + hstepA, voffA);
            PG8_WAIT_L(8); PG8_BAR; PG8_WAIT_L(0); PG8_MMA(0, 0, At, B0); PG8_BAR; PG8_SCHED;
            PG8_LDB(B1, 0, 1); PG8_STAGE(PG8_SB(0, 0), b2, voffB);
            PG8_BAR; PG8_WAIT_L(0); PG8_MMA(0, 1, At, B1); PG8_BAR;
            PG8_LDA(At, 0, 1); PG8_STAGE(PG8_SA(0, 0), a2, voffA);
            PG8_BAR; PG8_WAIT_L(0); PG8_MMA(1, 0, At, B0); PG8_BAR; PG8_SCHED;
            PG8_STAGE(PG8_SB(0, 1), b2 + hstepB, voffB);
            PG8_WAIT_V(6); PG8_BAR; PG8_MMA(1, 1, At, B1); PG8_BAR;
            PG8_LDB(B0, 1, 0); PG8_SCHED; PG8_LDA(At, 1, 0); PG8_STAGE(PG8_SA(0, 1), a2 + hstepA, voffA);
            PG8_WAIT_L(8); PG8_BAR; PG8_WAIT_L(0); PG8_MMA(0, 0, At, B0); PG8_BAR; PG8_SCHED;
            PG8_LDB(B1, 1, 1); PG8_STAGE(PG8_SB(1, 0), b3, voffB);
            PG8_BAR; PG8_WAIT_L(0); PG8_MMA(0, 1, At, B1); PG8_BAR;
            PG8_LDA(At, 1, 1); PG8_STAGE(PG8_SA(1, 0), a3, voffA);
            PG8_BAR; PG8_WAIT_L(0); PG8_MMA(1, 0, At, B0); PG8_BAR; PG8_SCHED;
            PG8_STAGE(PG8_SB(1, 1), b3 + hstepB, voffB);
            PG8_WAIT_V(6); PG8_BAR; PG8_MMA(1, 1, At, B1); PG8_BAR;
        }
        E(acc, cur, wr, wc, fr, fq);
        if (!has_next) break;
#pragma unroll
        for (int a = 0; a < 2; ++a)
#pragma unroll
            for (int b = 0; b < 2; ++b)
#pragma unroll
                for (int m = 0; m < 4; ++m)
#pragma unroll
                    for (int n = 0; n < 2; ++n) acc[a][b][m][n] = (f32x4){0.f, 0.f, 0.f, 0.f};
        cur = nxt; cA = nA; cB = nB; ++ui;
    }
    PG8_WAIT_V(0);
    if (wr == 0) PG8_BAR;
    PG8_BAR;
#undef PG8_SA
#undef PG8_SB
#undef PG8_STAGE
#undef PG8_LDA
#undef PG8_LDB
#undef PG8_MMA
#undef PG8_WAIT_V
#undef PG8_WAIT_L
#undef PG8_BAR
#undef PG8_SCHED
}
}

struct D1 { static constexpr int MODES = 1; unsigned char* ws;
    __device__ __forceinline__ void get(const pg8::Unit& u, pg8::Dst& d) const { const int sec = u.pn >> 2;
        d.base = ws + OFF_QB + (size_t)sec * (64 * MB) + ((size_t)u.pm * 256 * 1024 + (u.pn & 3) * 256) * 2; d.res = nullptr; d.ld = 1024; d.mode = 0; d.ncol = 256; d.scale = 1.f; } };
struct D2 { static constexpr int MODES = 7; unsigned char* ws;
    __device__ __forceinline__ void get(const pg8::Unit& u, pg8::Dst& d) const { const int sec = u.pn >> 2, cc = (u.pn & 3) * 256; d.res = nullptr; d.ncol = 256; d.scale = 1.f;
        if (sec < 3) { d.base = ws + OFF_QB + (size_t)sec * (64 * MB) + ((size_t)u.pm * 256 * 1024 + cc) * 2; d.ld = 1024; d.mode = sec == 0 ? 1 : (sec == 1 ? 2 : 0); }
        else { d.base = ws + OFF_Y + ((size_t)u.pm * 256 * 2048 + 1024 + cc) * 2; d.ld = 2048; d.mode = 2; } } };
struct D4 { static constexpr int MODES = 32; unsigned char* out; const float* x;
    __device__ __forceinline__ void get(const pg8::Unit& u, pg8::Dst& d) const { const size_t o = (size_t)u.pm * 256 * 1024 + u.pn * 256;
        d.base = out + o * 4; d.res = x + o; d.ld = 1024; d.mode = 5; d.ncol = 256; d.scale = 1.f; } };
struct D5 { static constexpr int MODES = 133; unsigned char* ws;
    __device__ __forceinline__ void get(const pg8::Unit& u, pg8::Dst& d) const { const int pn = u.pn; d.res = nullptr; d.ncol = 256; d.scale = 1.f;
        if (pn < 4) { d.base = ws + OFF_TMP + ((size_t)u.pm * 256 * 1024 + pn * 256) * 2; d.ld = 1024; d.mode = 0; }
        else if (pn == 4) { d.base = ws + OFF_CKVN + (size_t)u.pm * 256 * 256 * 2; d.ld = 256; d.mode = 0; }
        else if (pn == 5) { d.base = ws + OFF_QI + (size_t)u.pm * 256 * 256 * 2; d.ld = 256; d.mode = 7; d.scale = 0.125f; }
        else if (pn == 6) { d.base = ws + OFF_KI + (size_t)u.pm * 256 * 64 * 2; d.ld = 64; d.mode = 7; d.ncol = 64; }
        else { d.base = ws + OFF_Z + ((size_t)u.pm * 256 * 1024 + (pn - 7) * 256) * 2; d.ld = 1024; d.mode = 2; } } };
struct DK { static constexpr int MODES = 64; unsigned char* ws;
    __device__ __forceinline__ void get(const pg8::Unit& u, pg8::Dst& d) const {
        d.base = ws + OFF_RK + ((size_t)u.pm * 256 * 16 + u.pn * 4) * 2; d.res = nullptr; d.ld = 16; d.mode = 6; d.ncol = 256; d.scale = 1.f; } };
struct D8 { static constexpr int MODES = 32; unsigned char* out;
    __device__ __forceinline__ void get(const pg8::Unit& u, pg8::Dst& d) const { const size_t o = (size_t)u.pm * 256 * 1024 + u.pn * 256;
        d.base = out + o * 4; d.res = (const float*)out + o; d.ld = 1024; d.mode = 5; d.ncol = 256; d.scale = 1.f; } };
struct DQ { static constexpr int MODES = 1; unsigned char* ws;
    __device__ __forceinline__ void get(const pg8::Unit& u, pg8::Dst& d) const {
        d.base = ws + OFF_QP + ((size_t)u.pm * 256 * 4096 + u.pn * 256) * 2; d.res = nullptr; d.ld = 4096; d.mode = 0; d.ncol = 256; d.scale = 1.f; } };
struct DO { static constexpr int MODES = 256; unsigned char* ws;
    __device__ __forceinline__ void get(const pg8::Unit& u, pg8::Dst& d) const { const size_t o = ((size_t)u.pm * 256 * 1024 + u.pn * 256) * 2;
        d.base = ws + OFF_TMP + o; d.res = (const float*)(ws + OFF_Z + o); d.ld = 1024; d.mode = 8; d.ncol = 256; d.scale = 1.f; } };
template <class DF>
__device__ __forceinline__ void fast_gemm(unsigned char* lds, const bf16_t* A, int lda, const bf16_t* Bt, int ldb, int N, int K, const DF& df, size_t apn = 0) {
    pg8::Gemm g{A, lda, Bt, ldb, T, N, K, apn}; pg8::StaticOrder S; S.init(T, N, (int)gridDim.x, (int)blockIdx.x);
    pg8::EpiGen<DF> E{df};
    pg8::gemm_phase(( LAS unsigned char*)lds, g, S, E);
}

__device__ __forceinline__ void tconv(const float* __restrict__ src, int ld, int col0, int ncols, int K, bf16_t* __restrict__ dst, float* tile  ) {
    const int nkt = K / 64, ntiles = nkt * (ncols / 64), tid = threadIdx.x;
    const bool vec = ((col0 | ld) & 3) == 0;
    const int lk = tid >> 4, ln = (tid & 15) * 4;
    const int sn = tid >> 3, sk = (tid & 7) * 8;
    for (int id0 = blockIdx.x * 2; id0 < ntiles; id0 += gridDim.x * 2) {
        f32x4 v[2][2];
#pragma unroll
        for (int u = 0; u < 2; ++u) { const int id = id0 + u; if (id < ntiles) { const int kt = id % nkt, nt = id / nkt;
#pragma unroll
            for (int h = 0; h < 2; ++h) { const float* sp = src + (size_t)(kt * 64 + lk + 32 * h) * ld + col0 + nt * 64 + ln;
                if (vec) v[u][h] = *(const f32x4*)sp; else { v[u][h][0] = sp[0]; v[u][h][1] = sp[1]; v[u][h][2] = sp[2]; v[u][h][3] = sp[3]; } } } }
#pragma unroll
        for (int u = 0; u < 2; ++u) { if (id0 + u < ntiles) {
#pragma unroll
            for (int h = 0; h < 2; ++h) { const int k = lk + 32 * h; *(f32x4*)(tile + u * 4352 + k * 68 + (ln ^ (k & 56))) = v[u][h]; } } }
        __syncthreads();
#pragma unroll
        for (int u = 0; u < 2; ++u) { const int id = id0 + u; if (id < ntiles) { const int kt = id % nkt, nt = id / nkt;
            const float* tp = tile + u * 4352 + sk * 68 + (sn ^ sk);
            u32x4 o; o.x = pk2(tp[0], tp[68]); o.y = pk2(tp[136], tp[204]); o.z = pk2(tp[272], tp[340]); o.w = pk2(tp[408], tp[476]);
            *(u32x4*)(dst + (size_t)(nt * 64 + sn) * K + kt * 64 + sk) = o; } }
        __syncthreads();
    }
}
template <int NE>
__device__ __forceinline__ void rmsnorm_rows(const float* __restrict__ src, const float* __restrict__ g, bf16_t* __restrict__ dst,
                             const float* __restrict__ Wx, int ldw, int col0, const float* __restrict__ bias, float scale, float* __restrict__ dstx, float* wl) {
    const int lane = threadIdx.x & 63, wave = threadIdx.x >> 6;
    __syncthreads();
    for (int i = threadIdx.x; i < NE * 1024; i += 512) { const int k = i / NE, e = i % NE; wl[e * 1024 + k] = Wx[(size_t)k * ldw + col0 + e]; }
    __syncthreads();
    for (int row0 = (blockIdx.x * 8 + wave) * 2; row0 < T; row0 += gridDim.x * 16) {
        f32x4 v[2][4];
#pragma unroll
        for (int r = 0; r < 2; ++r)
#pragma unroll
            for (int i = 0; i < 4; ++i) v[r][i] = *(const f32x4*)(src + (size_t)(row0 + r) * 1024 + i * 256 + lane * 4);
#pragma unroll
        for (int r = 0; r < 2; ++r) {
            const int row = row0 + r; float ss = 0.f;
#pragma unroll
            for (int i = 0; i < 4; ++i) ss += v[r][i][0] * v[r][i][0] + v[r][i][1] * v[r][i][1] + v[r][i][2] * v[r][i][2] + v[r][i][3] * v[r][i][3];
            ss = wave_sum(ss);
            const float rstd = rsqrtf(ss * (1.0f / 1024.0f) + EPS);
            float ex[NE];
#pragma unroll
            for (int e = 0; e < NE; ++e) ex[e] = 0.f;
#pragma unroll
            for (int i = 0; i < 4; ++i) {
                const f32x4 gg = *(const f32x4*)(g + i * 256 + lane * 4);
                f32x4 y; y[0] = v[r][i][0] * rstd * gg[0]; y[1] = v[r][i][1] * rstd * gg[1]; y[2] = v[r][i][2] * rstd * gg[2]; y[3] = v[r][i][3] * rstd * gg[3];
                u32x2 w; w.x = pk2(y[0], y[1]); w.y = pk2(y[2], y[3]);
                *(u32x2*)(dst + (size_t)row * 1024 + i * 256 + lane * 4) = w;
#pragma unroll
                for (int e = 0; e < NE; ++e) { const f32x4 wv = *(const f32x4*)(wl + e * 1024 + i * 256 + lane * 4); ex[e] += y[0] * wv[0] + y[1] * wv[1] + y[2] * wv[2] + y[3] * wv[3]; }
            }
#pragma unroll
            for (int e = 0; e < NE; ++e) { const float sx = wave_sum(ex[e]); if (lane == 0) dstx[(size_t)row * NE + e] = (sx + (bias ? bias[e] : 0.f)) * scale; }
        }
    }
}

__device__ __forceinline__ void phase_prep(const P& p, unsigned char* lds) {
    float* tile = (float*)lds; unsigned char* ws = p.ws;
    bf16_t* W0T = (bf16_t*)(ws + OFF_W0T);
    tconv(p.e_w_in, EIN, 0, 5120, 1024, W0T, tile);
    tconv(p.e_w_in, EIN, 6152, 1024, 1024, W0T + (size_t)6144 * 1024, tile);
    for (int g = 0; g < 4; ++g) tconv(p.e_w_pool + (size_t)g * 65536, 256, 0, 256, 256, (bf16_t*)(ws + OFF_WPT) + (size_t)g * 65536, tile);
    { bf16_t* WUB = (bf16_t*)(ws + OFF_WUB);
      for (size_t i = (size_t)blockIdx.x * 512 + threadIdx.x; i < (size_t)1024 * 256; i += (size_t)gridDim.x * 512) {
          const size_t k = i >> 8; const int c4 = (int)(i & 255) * 4; const f32x4 v = *(const f32x4*)(p.e_w_in + k * EIN + 5128 + c4);
          u32x2 o; o.x = pk2(v[0], v[1]); o.y = pk2(v[2], v[3]); *(u32x2*)(WUB + k * 1024 + c4) = o; } }
    tconv(p.e_w_out, 1024, 0, 1024, 2048, (bf16_t*)(ws + OFF_WO0T), tile);
    bf16_t* W1T = (bf16_t*)(ws + OFF_W1T);
    tconv(p.o_w_in, OIN, 0, 1600, 1024, W1T, tile);
    for (size_t i = (size_t)blockIdx.x * 512 + threadIdx.x; i < (size_t)192 * 1024; i += (size_t)gridDim.x * 512) W1T[(size_t)1600 * 1024 + i] = 0;
    tconv(p.o_w_in, OIN, 1604, 1024, 1024, W1T + (size_t)1792 * 1024, tile);
    {
        bf16_t* WUKP = (bf16_t*)(ws + OFF_WUKP); bf16_t* WQF = (bf16_t*)(ws + OFF_WQF); bf16_t* WBD = (bf16_t*)(ws + OFF_WBD);
        for (size_t i = (size_t)blockIdx.x * 512 + threadIdx.x; i < (size_t)1024 * 256; i += (size_t)gridDim.x * 512) {
            { const int n = (int)(i >> 8), k = (int)(i & 255), pn = n >> 8, rem = n & 255, bj = rem >> 7, wc = (rem >> 5) & 3, x = rem & 31;
              WUKP[i] = f2bf(p.o_w_uk[(size_t)k * 1024 + (4 * pn + wc) * 64 + 32 * bj + x]); }
            { const int d = (int)(i & 63), r = (int)((i >> 6) & 255), h = (int)(i >> 14); const size_t o = ((size_t)h * 256 + r) * 128 + d;
              WQF[o] = f2bf(p.o_w_uk[(size_t)r * 1024 + h * 64 + d] * p.o_g_k[d] * 0.125f); WQF[o + 64] = 0; }
            { const int r = (int)(i & 255), n = (int)(i >> 8), hl = (n >> 6) & 3; const float v = p.o_w_uv[(size_t)r * 1024 + n];
#pragma unroll
              for (int b = 0; b < 4; ++b) WBD[(size_t)n * 1024 + b * 256 + r] = (b == hl) ? f2bf(v) : (bf16_t)0; }
        }
    }
    tconv(p.o_w_out, 1024, 0, 1024, 1024, (bf16_t*)(ws + OFF_WO1T), tile);
    rmsnorm_rows<8>(p.x, p.e_norm, (bf16_t*)(ws + OFF_XN), p.e_w_in, EIN, 5120, p.e_b_if, 1.0f, (float*)(ws + OFF_GATES), (float*)lds);
}

__device__ __forceinline__ void phase_conv_scan(const P& p, unsigned char* lds) {
    unsigned char* ws = p.ws; const int tid = threadIdx.x;
    const float* GATES = (const float*)(ws + OFF_GATES);
    float *BQ = (float*)(ws + OFF_BQ), *IQ = (float*)(ws + OFF_IQ), *MT = (float*)(ws + OFF_MT), *CH = (float*)(ws + OFF_CH);
    {
        const int lane = tid & 63, wave = tid >> 6;
        for (int task = blockIdx.x * 8 + wave; task < 2048; task += gridDim.x * 8) {
            const int bh = task >> 8, c = task & 255, batch = bh >> 2, head = bh & 3; const size_t t = (size_t)batch * SEQ + c * 64 + lane;
            const float ig = GATES[t * 8 + head], f = GATES[t * 8 + 4 + head];
            float b = fminf(f, 0.f) - log1pf(__expf(-fabsf(f)));
#pragma unroll
            for (int o = 1; o < 64; o <<= 1) { const float y = __shfl_up(b, o); if (lane >= o) b += y; }
            float rm = ig - b;
#pragma unroll
            for (int o = 1; o < 64; o <<= 1) { const float y = __shfl_up(rm, o); if (lane >= o) rm = fmaxf(rm, y); }
            BQ[t * 4 + head] = b; IQ[t * 4 + head] = ig; MT[t * 4 + head] = rm;
            if (lane == 63) { CH[4096 + bh * 256 + c] = b; CH[bh * 256 + c] = b + rm; }
        }
    }
    const bf16_t* QB = (const bf16_t*)(ws + OFF_QB); const bf16_t* KB = (const bf16_t*)(ws + OFF_KB);
    bf16_t* Y = (bf16_t*)(ws + OFF_Y); bf16_t* KT = (bf16_t*)(ws + OFF_TMP);
    for (size_t it = (size_t)blockIdx.x * 512 + tid; it < (size_t)(T / 8) * 256; it += (size_t)gridDim.x * 512) {
        const size_t t0 = (it >> 8) * 8; const int c0 = (int)(it & 255) * 8, isk = c0 >= 1024, cc = c0 & 1023; const int s0 = (int)(t0 & (SEQ - 1));
        const bf16_t* src = isk ? KB : QB;
        u32x4 rw[11];
#pragma unroll
        for (int j = 0; j < 11; ++j) rw[j] = (s0 - 3 + j >= 0) ? *(const u32x4*)(src + (t0 - 3 + j) * 1024 + cc) : (u32x4){0u, 0u, 0u, 0u};
        f32x4 cw[4][2];
#pragma unroll
        for (int j = 0; j < 4; ++j) { cw[j][0] = *(const f32x4*)(p.e_conv + j * 2048 + c0); cw[j][1] = *(const f32x4*)(p.e_conv + j * 2048 + c0 + 4); }
        const float sc = isk ? 0.0625f : 1.0f;
#pragma unroll
        for (int k = 0; k < 8; ++k) {
            float acc[8];
#pragma unroll
            for (int i = 0; i < 8; ++i) acc[i] = 0.f;
#pragma unroll
            for (int j = 0; j < 4; ++j) { const u32x4 w = rw[k + j];
                acc[0] += cw[j][0][0] * bflo(w.x); acc[1] += cw[j][0][1] * bfhi(w.x); acc[2] += cw[j][0][2] * bflo(w.y); acc[3] += cw[j][0][3] * bfhi(w.y);
                acc[4] += cw[j][1][0] * bflo(w.z); acc[5] += cw[j][1][1] * bfhi(w.z); acc[6] += cw[j][1][2] * bflo(w.w); acc[7] += cw[j][1][3] * bfhi(w.w); }
            u32x4 o; o.x = pk2(siluf_(acc[0]) * sc, siluf_(acc[1]) * sc); o.y = pk2(siluf_(acc[2]) * sc, siluf_(acc[3]) * sc);
            o.z = pk2(siluf_(acc[4]) * sc, siluf_(acc[5]) * sc); o.w = pk2(siluf_(acc[6]) * sc, siluf_(acc[7]) * sc);
            if (isk) *(u32x4*)(KT + (t0 + k) * 1024 + cc) = o; else *(u32x4*)(Y + (t0 + k) * 2048 + 1024 + cc) = o;
        }
    }
}

typedef float f32x16 __attribute__((ext_vector_type(16)));
constexpr int ML_RS = 528, ML_WS = 144;
__device__ __forceinline__ bf16x8 ml_tr8(const LAS unsigned char* a, int second_off) {
    const v4i16_t t0 = __builtin_amdgcn_ds_read_tr16_b64_v4i16((LAS v4i16_t*)a);
    const v4i16_t t1 = __builtin_amdgcn_ds_read_tr16_b64_v4i16((LAS v4i16_t*)(a + second_off));
    bf16x8 r; r[0] = t0[0]; r[1] = t0[1]; r[2] = t0[2]; r[3] = t0[3]; r[4] = t1[0]; r[5] = t1[1]; r[6] = t1[2]; r[7] = t1[3]; return r;
}
struct ChunkScan { f32x4 B, mp, mn; };
__device__ __forceinline__ ChunkScan chunk_scan_wave(const float* CH, int bh, int lane) {
    ChunkScan r; r.B = *(const f32x4*)(CH + 4096 + bh * 256 + 4 * lane); const f32x4 G = *(const f32x4*)(CH + bh * 256 + 4 * lane);
    float a = r.B[0], b = G[0];
#pragma unroll
    for (int j = 1; j < 4; ++j) { b = fmaxf(r.B[j] + b, G[j]); a += r.B[j]; }
#pragma unroll
    for (int o = 1; o < 64; o <<= 1) { const float a1 = __shfl_up(a, o), b1 = __shfl_up(b, o); if (lane >= o) { b = fmaxf(a + b1, b); a += a1; } }
    const float ap = __shfl_up(a, 1), bp = __shfl_up(b, 1);
    float m = lane ? fmaxf(ap, bp) : 0.f;
#pragma unroll
    for (int j = 0; j < 4; ++j) { r.mp[j] = m; m = fmaxf(r.B[j] + m, G[j]); r.mn[j] = m; }
    return r;
}
__device__ __forceinline__ void mlstm_chunk_scan(const float* CH, int bh, LAS float* sB, LAS float* sMp, LAS float* sMn) {
    int tid = threadIdx.x; asm volatile("" : "+v"(tid));
    if (tid < 64) { const ChunkScan r = chunk_scan_wave(CH, bh, tid); *(LAS f32x4*)(sB + 4 * tid) = r.B; *(LAS f32x4*)(sMp + 4 * tid) = r.mp; *(LAS f32x4*)(sMn + 4 * tid) = r.mn; }
    __syncthreads();
}
template <bool FULL>
__device__ __forceinline__ void mlstm_units(const P& p, unsigned char* lds_) {
    unsigned char* ws = p.ws; const int tid0 = threadIdx.x;
    const int w = __builtin_amdgcn_readfirstlane(tid0 >> 6);
    const bf16_t* Yq = (const bf16_t*)(ws + OFF_Y); bf16_t* Yo = (bf16_t*)(ws + OFF_Y);
    const bf16_t* KT = (const bf16_t*)(ws + OFF_TMP); const bf16_t* VB = (const bf16_t*)(ws + OFF_VB);
    float* ST = (float*)(ws + OFF_QB); float* NS = (float*)(ws + OFF_NS);
    const float *BQ = (const float*)(ws + OFF_BQ), *IQ = (const float*)(ws + OFF_IQ), *MT = (const float*)(ws + OFF_MT), *CH = (const float*)(ws + OFF_CH);
    LAS unsigned char* Qs = (LAS unsigned char*)lds_;
    LAS unsigned char* Ks = Qs + 64 * ML_RS;
    LAS unsigned char* Vs = Ks + 64 * ML_RS;
    LAS unsigned char* Wl = Vs + 64 * ML_RS;
    LAS float* sa = (LAS float*)(Wl + 64 * ML_WS);
    LAS float* sden = sa + 64; LAS float* ssw = sden + 64; LAS float* sf = ssw + 64; LAS float* sg = sf + 64; LAS float* nd = sg + 64; LAS float* rden = nd + 64; LAS float* ns = rden + 64;
    LAS float* cB = ns + 256; LAS float* cMp = cB + 256; LAS float* cMn = cMp + 256; LAS float* gB = cMn + 256; LAS float* gI = gB + 512; LAS float* gM = gI + 512;
    for (int unit = blockIdx.x; unit < 256; unit += gridDim.x) {
        const int bh = unit >> 5, S = unit & 31, batch = bh >> 2, head = bh & 3;
        const int tid = tid0, lane = tid0 & 63, hh = lane >> 5;
        __syncthreads();
        mlstm_chunk_scan(CH, bh, cB, cMp, cMn);
        f32x16 st[8]; float nreg = 0.f;
        if (FULL) {
#pragma unroll
            for (int kt = 0; kt < 8; ++kt) {
                int lz = lane; asm volatile("" : "+v"(lz) :: "memory");
                const float* sp = ST + (size_t)unit * 65536 + 32 * w + (lz & 31) + (size_t)(32 * kt + 4 * (lz >> 5)) * 256;
#pragma unroll
                for (int r = 0; r < 16; ++r) st[kt][r] = sp[((r & 3) + 8 * (r >> 2)) * 256];
            }
            if (tid < 256) nreg = NS[unit * 256 + tid];
        } else {
#pragma unroll
            for (int kt = 0; kt < 8; ++kt)
#pragma unroll
                for (int r = 0; r < 16; ++r) st[kt][r] = 0.f;
        }
        { const size_t tS = ((size_t)batch * SEQ + (size_t)S * 512 + tid0) * 4 + head; gB[tid0] = BQ[tS]; gI[tid0] = IQ[tS]; gM[tid0] = MT[tS]; }
        u32x4 pk[4], pv[4], pq[4];
        auto prefetch = [&](int cn) {
            int tz = tid0; asm volatile("" : "+v"(tz));
            const size_t tn = (size_t)batch * SEQ + (size_t)(S * 8 + cn) * 64;
#pragma unroll
            for (int j = 0; j < 4; ++j) { const int e = tz + 512 * j, r = e >> 5, cg = e & 31;
                pk[j] = *(const u32x4*)(KT + (tn + r) * 1024 + head * 256 + cg * 8);
                if (!FULL) pv[j] = *(const u32x4*)(VB + (tn + r) * 1024 + head * 256 + cg * 8);
                if (FULL) pq[j] = *(const u32x4*)(Yq + (tn + r) * 2048 + 1024 + head * 256 + cg * 8); }
            asm volatile("" ::: "memory");
        };
        prefetch(0);
#pragma unroll 1
        for (int cc = 0; cc < 8; ++cc) {
            int tid = tid0; asm volatile("" : "+v"(tid));
            const int lane = tid & 63, l31 = lane & 31, hh = lane >> 5, fr = lane & 15, fq = lane >> 4;
            const int trow = 8 * hh + (fr >> 2), tcol = (16 * (fq & 1) + 4 * (fr & 3)) * 2;
            const int ch = S * 8 + cc; const size_t t0 = (size_t)batch * SEQ + ch * 64;
            const float mprev = cMp[ch], mnew = cMn[ch], blast = cB[ch];
            const float decay = __expf(blast + mprev - mnew);
            __syncthreads();
#pragma unroll
            for (int j = 0; j < 4; ++j) { const int e = tid + 512 * j, r = e >> 5, cg = e & 31;
                if (FULL) pv[j] = *(const u32x4*)(VB + (t0 + r) * 1024 + head * 256 + cg * 8); }
#pragma unroll
            for (int j = 0; j < 4; ++j) { const int e = tid + 512 * j, r = e >> 5, cg = e & 31;
                *(LAS u32x4*)(Ks + r * ML_RS + cg * 16) = pk[j];
                if (!FULL) *(LAS u32x4*)(Vs + r * ML_RS + cg * 16) = pv[j];
                if (FULL) *(LAS u32x4*)(Qs + r * ML_RS + cg * 16) = pq[j]; }
            if (w == cc) { const float bq = gB[tid], iq = gI[tid], mt = bq + fmaxf(mprev, gM[tid]);
                sa[lane] = __expf(bq + mprev - mt); sden[lane] = __expf(-mt); ssw[lane] = __expf(blast - bq + iq - mnew); sf[lane] = bq - mt; sg[lane] = iq - bq; }
            if (FULL && tid < 256) ns[tid] = nreg;
            __syncthreads();
            if (!FULL && cc < 7) prefetch(cc + 1);
            bf16x8 bv[4];
            if (!FULL) {
#pragma unroll
                for (int ks = 0; ks < 4; ++ks) bv[ks] = ml_tr8(Vs + (16 * ks + trow) * ML_RS + 64 * w + tcol, 4 * ML_RS);
            }
            if (FULL) {
                { const int tt = w >> 1;
#pragma unroll
                  for (int si = 0; si < 2; ++si) { const int ss = 2 * (w & 1) + si;
                    f32x4 acc = (f32x4){0.f, 0.f, 0.f, 0.f};
                    if (ss <= tt) {
#pragma unroll
                        for (int ks = 0; ks < 8; ++ks) { const bf16x8 a = *(const LAS bf16x8*)(Qs + (16 * tt + fr) * ML_RS + (32 * ks + 8 * fq) * 2), b = *(const LAS bf16x8*)(Ks + (16 * ss + fr) * ML_RS + (32 * ks + 8 * fq) * 2);
                            acc = __builtin_amdgcn_mfma_f32_16x16x32_bf16(a, b, acc, 0, 0, 0); } }
                    const int sidx = 16 * ss + fr; const float gs = sg[sidx];
#pragma unroll
                    for (int j = 0; j < 4; ++j) { const int tix = 16 * tt + 4 * fq + j; const float wv = (sidx <= tix) ? __expf(sf[tix] + gs) * acc[j] : 0.f;
                        *(LAS bf16_t*)(Wl + tix * ML_WS + sidx * 2) = f2bf(wv); } } }
#pragma unroll
                for (int i = 0; i < 8; ++i) { const int tix = 8 * w + i; const u32x2 qv = *(const LAS u32x2*)(Qs + tix * ML_RS + lane * 8); const f32x4 nv = *(const LAS f32x4*)(ns + lane * 4);
                    float part = bflo(qv.x) * nv[0] + bfhi(qv.x) * nv[1] + bflo(qv.y) * nv[2] + bfhi(qv.y) * nv[3]; part = wave_sum(part); if (lane == 0) nd[tix] = part; }
#pragma unroll
                for (int j = 0; j < 4; ++j) { const int e = tid + 512 * j, r = e >> 5, cg = e & 31; *(LAS u32x4*)(Vs + r * ML_RS + cg * 16) = pv[j]; }
                __syncthreads();
                f32x16 acc[2];
#pragma unroll
                for (int t2 = 0; t2 < 2; ++t2) {
#pragma unroll
                    for (int r = 0; r < 16; ++r) acc[t2][r] = 0.f;
                }
#pragma unroll
                for (int kt = 0; kt < 8; ++kt) {
                    asm volatile("" ::: "memory");
#pragma unroll
                    for (int s2 = 0; s2 < 2; ++s2) {
                        u32x4 bw; bw.x = pg8::cvt_pk_bf16(st[kt][8 * s2 + 0], st[kt][8 * s2 + 1]); bw.y = pg8::cvt_pk_bf16(st[kt][8 * s2 + 2], st[kt][8 * s2 + 3]);
                        bw.z = pg8::cvt_pk_bf16(st[kt][8 * s2 + 4], st[kt][8 * s2 + 5]); bw.w = pg8::cvt_pk_bf16(st[kt][8 * s2 + 6], st[kt][8 * s2 + 7]);
                        const bf16x8 bfrag = __builtin_bit_cast(bf16x8, bw);
#pragma unroll
                        for (int t2 = 0; t2 < 2; ++t2) { const LAS unsigned char* qa = Qs + (32 * t2 + l31) * ML_RS + (32 * kt + 16 * s2 + 4 * hh) * 2;
                            const u32x2 lo = *(const LAS u32x2*)qa, hi = *(const LAS u32x2*)(qa + 16); u32x4 aw; aw.x = lo.x; aw.y = lo.y; aw.z = hi.x; aw.w = hi.y;
                            acc[t2] = __builtin_amdgcn_mfma_f32_32x32x16_bf16(__builtin_bit_cast(bf16x8, aw), bfrag, acc[t2], 0, 0, 0); }
                    }
                }
                asm volatile("" ::: "memory");
#pragma unroll
                for (int t2 = 0; t2 < 2; ++t2)
#pragma unroll
                    for (int r = 0; r < 16; ++r) acc[t2][r] *= sa[32 * t2 + (r & 3) + 8 * (r >> 2) + 4 * hh];
#pragma unroll
                for (int ks = 0; ks < 4; ++ks) bv[ks] = ml_tr8(Vs + (16 * ks + trow) * ML_RS + 64 * w + tcol, 4 * ML_RS);
#pragma unroll
                for (int ks = 0; ks < 4; ++ks)
#pragma unroll
                    for (int t2 = 0; t2 < 2; ++t2) { const bf16x8 a = *(const LAS bf16x8*)(Wl + (32 * t2 + l31) * ML_WS + (16 * ks + 8 * hh) * 2);
                        acc[t2] = __builtin_amdgcn_mfma_f32_32x32x16_bf16(a, bv[ks], acc[t2], 0, 0, 0); }
#pragma unroll
                for (int i = 0; i < 8; ++i) { const int tix = 8 * w + i; float rs = bf2f(*(const LAS bf16_t*)(Wl + tix * ML_WS + lane * 2)); rs = wave_sum(rs);
                    if (lane == 0) { const float nq = sa[tix] * nd[tix] + rs; rden[tix] = 1.0f / fmaxf(fabsf(nq), sden[tix]); } }
                __syncthreads();
                bf16_t* yo = Yo + t0 * 2048 + head * 256 + 32 * w + l31;
#pragma unroll
                for (int t2 = 0; t2 < 2; ++t2)
#pragma unroll
                    for (int r = 0; r < 16; ++r) { const int tix = 32 * t2 + (r & 3) + 8 * (r >> 2) + 4 * hh; yo[(size_t)tix * 2048] = f2bf(acc[t2][r] * rden[tix]); }
                asm volatile("" ::: "memory");
                if (cc < 7) prefetch(cc + 1);
            }
#pragma unroll
            for (int kt = 0; kt < 8; ++kt) st[kt] *= decay;
#pragma unroll
            for (int ks = 0; ks < 4; ++ks) {
                const u32x4 raw = __builtin_bit_cast(u32x4, bv[ks]); const LAS float* sw8 = ssw + 16 * ks + 8 * hh;
                u32x4 sc; sc.x = pg8::cvt_pk_bf16(bflo(raw.x) * sw8[0], bfhi(raw.x) * sw8[1]); sc.y = pg8::cvt_pk_bf16(bflo(raw.y) * sw8[2], bfhi(raw.y) * sw8[3]);
                sc.z = pg8::cvt_pk_bf16(bflo(raw.z) * sw8[4], bfhi(raw.z) * sw8[5]); sc.w = pg8::cvt_pk_bf16(bflo(raw.w) * sw8[6], bfhi(raw.w) * sw8[7]);
                const bf16x8 bs = __builtin_bit_cast(bf16x8, sc);
#pragma unroll
                for (int kt = 0; kt < 8; ++kt) { if ((kt & 3) == 0) asm volatile("" ::: "memory");
                    const bf16x8 a = ml_tr8(Ks + (16 * ks + trow) * ML_RS + 64 * kt + tcol, 4 * ML_RS);
                    st[kt] = __builtin_amdgcn_mfma_f32_32x32x16_bf16(a, bs, st[kt], 0, 0, 0); }
            }
            if (tid < 256) { float nacc = 0.f;
#pragma unroll 8
                for (int s2 = 0; s2 < 64; ++s2) nacc += ssw[s2] * bf2f(*(const LAS bf16_t*)(Ks + s2 * ML_RS + tid * 2));
                nreg = decay * nreg + nacc; }
        }
        if (!FULL) {
#pragma unroll
            for (int kt = 0; kt < 8; ++kt) {
                int lz = lane; asm volatile("" : "+v"(lz) :: "memory");
                float* sp = ST + (size_t)unit * 65536 + 32 * w + (lz & 31) + (size_t)(32 * kt + 4 * (lz >> 5)) * 256;
#pragma unroll
                for (int r = 0; r < 16; ++r) sp[((r & 3) + 8 * (r >> 2)) * 256] = st[kt][r];
            }
            if (tid < 256) NS[unit * 256 + tid] = nreg;
        }
    }
}
__device__ __forceinline__ void phase_mlstm_scan(const P& p, unsigned char* lds_) {
    unsigned char* ws = p.ws; const int tid = threadIdx.x, lane = tid & 63, wave = tid >> 6;
    float* ST = (float*)(ws + OFF_QB); float* NS = (float*)(ws + OFF_NS); const float* CH = (const float*)(ws + OFF_CH);
    LAS float* DS = (LAS float*)lds_;
    __syncthreads();
    {
        const ChunkScan r = chunk_scan_wave(CH, wave, lane);
        float d = 1.f;
#pragma unroll
        for (int j = 0; j < 4; ++j) d *= __expf(r.B[j] + r.mp[j] - r.mn[j]);
        const float dn = __shfl_down(d, 1);
        if (!(lane & 1)) DS[wave * 32 + (lane >> 1)] = d * dn;
    }
    __syncthreads();
    {
        const int it0 = blockIdx.x * 512 + tid;
        for (int it = it0; it < 8 * 16384; it += gridDim.x * 512) {
            const int bh = it >> 14; float* base = ST + (size_t)bh * 32 * 65536 + (size_t)(it & 16383) * 4;
            f32x4 carry = (f32x4){0.f, 0.f, 0.f, 0.f};
#pragma unroll
            for (int h = 0; h < 2; ++h) {
                f32x4 tmp[16];
#pragma unroll
                for (int S = 0; S < 16; ++S) tmp[S] = *(const f32x4*)(base + (size_t)(16 * h + S) * 65536);
#pragma unroll
                for (int S = 0; S < 16; ++S) { *(f32x4*)(base + (size_t)(16 * h + S) * 65536) = carry; carry = DS[bh * 32 + 16 * h + S] * carry + tmp[S]; }
            }
        }
        if (it0 < 8 * 256) {
            const int it = it0, bh = it >> 8; float* base = NS + (size_t)bh * 32 * 256 + (it & 255);
            float carry = 0.f;
#pragma unroll 8
            for (int S = 0; S < 32; ++S) { const float tmp = base[S * 256]; base[S * 256] = carry; carry = DS[bh * 32 + S] * carry + tmp; }
        }
    }
}

__device__ __forceinline__ void unpack8(const u32x4 w, float (&f)[8]) {
    f[0] = bflo(w.x); f[1] = bfhi(w.x); f[2] = bflo(w.y); f[3] = bfhi(w.y); f[4] = bflo(w.z); f[5] = bfhi(w.z); f[6] = bflo(w.w); f[7] = bfhi(w.w); }
template <int WIN>
__device__ __forceinline__ void pool_item(const bf16_t* __restrict__ U, bf16_t* __restrict__ Y, const float* __restrict__ s_pool, size_t t0, int s0, int c0) {
    constexpr int NR = WIN + 7;
    u32x4 rw[NR], z[8];
#pragma unroll
    for (int j = 0; j < NR; ++j) rw[j] = (s0 - (WIN - 1) + j >= 0) ? *(const u32x4*)(U + ((long)t0 + j - (WIN - 1)) * 1024 + c0) : (u32x4){0u, 0u, 0u, 0u};
#pragma unroll
    for (int k = 0; k < 8; ++k) z[k] = *(const u32x4*)(Y + (t0 + k) * 2048 + 1024 + c0);
    const f32x4 s0v = *(const f32x4*)(s_pool + c0), s1v = *(const f32x4*)(s_pool + c0 + 4);
    const float sp[8] = {s0v[0], s0v[1], s0v[2], s0v[3], s1v[0], s1v[1], s1v[2], s1v[3]};
    float S[8];
#pragma unroll
    for (int i = 0; i < 8; ++i) S[i] = 0.f;
#pragma unroll
    for (int j = 0; j < WIN - 1; ++j) { float f[8]; unpack8(rw[j], f);
#pragma unroll
        for (int i = 0; i < 8; ++i) S[i] += f[i]; }
#pragma unroll
    for (int k = 0; k < 8; ++k) {
        float self[8], zf[8]; unpack8(rw[k + WIN - 1], self); unpack8(z[k], zf);
#pragma unroll
        for (int i = 0; i < 8; ++i) S[i] += self[i];
        const int cnt = (s0 + k + 1 < WIN) ? s0 + k + 1 : WIN;
        const float inv = __builtin_amdgcn_rcpf((float)cnt);
        float o[8];
#pragma unroll
        for (int i = 0; i < 8; ++i) o[i] = (S[i] * inv - self[i]) * sp[i] * zf[i];
        u32x4 ow; ow.x = pk2(o[0], o[1]); ow.y = pk2(o[2], o[3]); ow.z = pk2(o[4], o[5]); ow.w = pk2(o[6], o[7]);
        *(u32x4*)(Y + (t0 + k) * 2048 + 1024 + c0) = ow;
        float old[8]; unpack8(rw[k], old);
#pragma unroll
        for (int i = 0; i < 8; ++i) S[i] -= old[i];
    }
}
__device__ __forceinline__ void phase_ya_pool(const P& p) {
    unsigned char* ws = p.ws; const int tid = threadIdx.x, lane = tid & 63, wave = tid >> 6;
    bf16_t* Y = (bf16_t*)(ws + OFF_Y); const bf16_t* O = (const bf16_t*)(ws + OFF_QB); const bf16_t* ZA = (const bf16_t*)(ws + OFF_KB);
    for (int tt = blockIdx.x * 8 + wave; tt < T; tt += gridDim.x * 8) {
        const size_t t = (size_t)tt; u32x2 hw[4], ow[4], zw[4];
#pragma unroll
        for (int head = 0; head < 4; ++head) { const int c = head * 256 + lane * 4;
            hw[head] = *(const u32x2*)(Y + t * 2048 + c); ow[head] = *(const u32x2*)(O + t * 1024 + c); zw[head] = *(const u32x2*)(ZA + t * 1024 + c); }
#pragma unroll
        for (int head = 0; head < 4; ++head) { const int c = head * 256 + lane * 4;
            float v[4] = {bflo(hw[head].x) * bflo(ow[head].x), bfhi(hw[head].x) * bfhi(ow[head].x), bflo(hw[head].y) * bflo(ow[head].y), bfhi(hw[head].y) * bfhi(ow[head].y)};
            const float ss = wave_sum(v[0] * v[0] + v[1] * v[1] + v[2] * v[2] + v[3] * v[3]);
            const float rstd = rsqrtf(ss * (1.0f / 256.0f) + EPS);
            const f32x4 g = *(const f32x4*)(p.e_g_head + c);
            u32x2 o; o.x = pk2(v[0] * rstd * g[0] * bflo(zw[head].x), v[1] * rstd * g[1] * bfhi(zw[head].x)); o.y = pk2(v[2] * rstd * g[2] * bflo(zw[head].y), v[3] * rstd * g[3] * bfhi(zw[head].y));
            *(u32x2*)(Y + t * 2048 + c) = o; }
    }
    const bf16_t* U = (const bf16_t*)(ws + OFF_VB);
    for (int it = blockIdx.x * 512 + tid; it < (T / 8) * 128; it += gridDim.x * 512) {
        const int cgl = it & 31, tbl = (it >> 5) & 1, g = __builtin_amdgcn_readfirstlane((it >> 6) & 3), tb = 2 * (it >> 8) + tbl;
        const size_t t0 = (size_t)tb * 8; const int s0 = (int)(t0 & (SEQ - 1)), c0 = g * 256 + cgl * 8;
        if (g == 0) pool_item<2>(U, Y, p.e_s_pool, t0, s0, c0);
        else if (g == 1) pool_item<4>(U, Y, p.e_s_pool, t0, s0, c0);
        else if (g == 2) pool_item<8>(U, Y, p.e_s_pool, t0, s0, c0);
        else pool_item<16>(U, Y, p.e_s_pool, t0, s0, c0);
    }
}

__device__ __forceinline__ void headnorm64(bf16_t* X, const float* g) {
    const int lane = threadIdx.x & 63, wave = threadIdx.x >> 6;
    const float* gg = g + (lane & 3) * 16;
    for (int t0 = (blockIdx.x * 8 + wave) * 4; t0 < T; t0 += gridDim.x * 32) {
        u32x4 a[4], b[4];
#pragma unroll
        for (int k = 0; k < 4; ++k) { const bf16_t* r = X + (size_t)(t0 + k) * 1024 + lane * 16; a[k] = *(const u32x4*)r; b[k] = *(const u32x4*)(r + 8); }
#pragma unroll
        for (int k = 0; k < 4; ++k) {
            float f[16] = {bflo(a[k].x), bfhi(a[k].x), bflo(a[k].y), bfhi(a[k].y), bflo(a[k].z), bfhi(a[k].z), bflo(a[k].w), bfhi(a[k].w), bflo(b[k].x), bfhi(b[k].x), bflo(b[k].y), bfhi(b[k].y), bflo(b[k].z), bfhi(b[k].z), bflo(b[k].w), bfhi(b[k].w)};
            float ss = 0.f;
#pragma unroll
            for (int i = 0; i < 16; ++i) ss += f[i] * f[i];
            ss += __shfl_xor(ss, 1); ss += __shfl_xor(ss, 2);
            const float rstd = rsqrtf(ss * (1.0f / 64.0f) + EPS);
#pragma unroll
            for (int i = 0; i < 16; ++i) f[i] = f[i] * rstd * gg[i];
            u32x4 oa, ob; oa.x = pk2(f[0], f[1]); oa.y = pk2(f[2], f[3]); oa.z = pk2(f[4], f[5]); oa.w = pk2(f[6], f[7]);
            ob.x = pk2(f[8], f[9]); ob.y = pk2(f[10], f[11]); ob.z = pk2(f[12], f[13]); ob.w = pk2(f[14], f[15]);
            bf16_t* r = X + (size_t)(t0 + k) * 1024 + lane * 16; *(u32x4*)r = oa; *(u32x4*)(r + 8) = ob;
        }
    }
}
__device__ __forceinline__ void phase_qnorm_ckvnorm(const P& p) {
    unsigned char* ws = p.ws; const int lane = threadIdx.x & 63, wave = threadIdx.x >> 6;
    {
        const u32x4* KI4 = (const u32x4*)(ws + OFF_KI); u32x4* KT4 = (u32x4*)(ws + OFF_KIT);
        for (size_t it = (size_t)blockIdx.x * 512 + threadIdx.x; it < (size_t)T * 8; it += (size_t)gridDim.x * 512) {
            const int l = (int)(it & 63), ks = (int)((it >> 6) & 1); const size_t t16 = it >> 7;
            KT4[it] = KI4[(t16 * 16 + (l & 15)) * 8 + 4 * ks + (l >> 4)]; }
    }
    headnorm64((bf16_t*)(ws + OFF_TMP), p.o_g_q);
    bf16_t* CKVN = (bf16_t*)(ws + OFF_CKVN);
    const f32x4 g = *(const f32x4*)(p.o_g_kv + lane * 4);
    for (int t0 = (blockIdx.x * 8 + wave) * 8; t0 < T; t0 += gridDim.x * 64) {
        u32x2 w[8];
#pragma unroll
        for (int k = 0; k < 8; ++k) w[k] = *(const u32x2*)(CKVN + (size_t)(t0 + k) * 256 + lane * 4);
#pragma unroll
        for (int k = 0; k < 8; ++k) {
            const float v[4] = {bflo(w[k].x), bfhi(w[k].x), bflo(w[k].y), bfhi(w[k].y)};
            const float ss = wave_sum(v[0] * v[0] + v[1] * v[1] + v[2] * v[2] + v[3] * v[3]);
            const float rstd = rsqrtf(ss * (1.0f / 256.0f) + EPS);
            u32x2 o; o.x = pk2(v[0] * rstd * g[0], v[1] * rstd * g[1]); o.y = pk2(v[2] * rstd * g[2], v[3] * rstd * g[3]);
            *(u32x2*)(CKVN + (size_t)(t0 + k) * 256 + lane * 4) = o;
        }
    }
}

__device__ __forceinline__ unsigned okey(float s) { if (s == 0.f) s = 0.f; const unsigned u = __float_as_uint(s); return (u & 0x80000000u) ? ~u : (u | 0x80000000u); }

__device__ __forceinline__ void indexer_slow_query(const P& p, unsigned char* lds, size_t t) {
    unsigned char* ws = p.ws; const int tid = threadIdx.x, lane = tid & 63, wave = tid >> 6;
    const _Float16* QI = (const _Float16*)(ws + OFF_QI); const _Float16* KI = (const _Float16*)(ws + OFF_KI); const float* WI = (const float*)(ws + OFF_WI);
    unsigned short* IDX = (unsigned short*)(ws + OFF_IDX);
    unsigned* sc = (unsigned*)lds; unsigned* hist = sc + 16384; float* qs = (float*)(hist + 256); unsigned* misc = (unsigned*)(qs + 256); unsigned* wsum = misc + 16;
    const int batch = (int)(t >> 14), pos = (int)(t & (SEQ - 1)), n = pos + 1;
    __syncthreads();
    if (tid < 256) qs[tid] = (float)QI[t * 256 + tid];
    const float w0 = WI[t * 4 + 0], w1 = WI[t * 4 + 1], w2 = WI[t * 4 + 2], w3 = WI[t * 4 + 3];
    __syncthreads();
    const _Float16* kbase = KI + (size_t)batch * SEQ * 64;
    for (int s = tid; s < n; s += 512) {
        asm volatile("" ::: "memory");
        typedef _Float16 h8 __attribute__((ext_vector_type(8)));
        const h8* kr = (const h8*)(kbase + (size_t)s * 64);
        float d0 = 0.f, d1 = 0.f, d2 = 0.f, d3 = 0.f;
#pragma unroll
        for (int j = 0; j < 8; ++j) { const h8 kv = kr[j];
#pragma unroll
            for (int e = 0; e < 8; ++e) { const int d = j * 8 + e; const float kf = (float)kv[e]; d0 += qs[d] * kf; d1 += qs[64 + d] * kf; d2 += qs[128 + d] * kf; d3 += qs[192 + d] * kf; } }
        float score = w0 * fmaxf(d0, 0.f); score = fmaf(w1, fmaxf(d1, 0.f), score); score = fmaf(w2, fmaxf(d2, 0.f), score); score = fmaf(w3, fmaxf(d3, 0.f), score);
        sc[s] = okey(score);
    }
    unsigned prefix = 0, krem = 256;
    for (int pass = 0; pass < 4; ++pass) {
        const int shift = 24 - 8 * pass;
        __syncthreads();
        if (tid < 256) hist[tid] = 0;
        __syncthreads();
        for (int s = tid; s < n; s += 512) { const unsigned k = sc[s]; if (pass == 0 || (k >> (shift + 8)) == prefix) atomicAdd(&hist[(k >> shift) & 255u], 1u); }
        __syncthreads();
        if (tid == 0) { unsigned cum = 0; int bin = 255; for (; bin > 0; --bin) { const unsigned c = hist[bin]; if (cum + c >= krem) break; cum += c; } misc[0] = (unsigned)bin; misc[1] = krem - cum; }
        __syncthreads();
        prefix = (prefix << 8) | misc[0]; krem = misc[1];
    }
    const unsigned ngt_total = 256u - krem;
    unsigned lg = 0, le = 0; const int s0 = tid * 32;
    for (int s = s0; s < s0 + 32 && s < n; ++s) { const unsigned k = sc[s]; lg += (k > prefix); le += (k == prefix); }
    unsigned pk = lg | (le << 16), incl = pk;
#pragma unroll
    for (int o = 1; o < 64; o <<= 1) { const unsigned y = __shfl_up(incl, o); if (lane >= o) incl += y; }
    if (lane == 63) wsum[wave] = incl;
    __syncthreads();
    unsigned base = 0;
    for (int w = 0; w < wave; ++w) base += wsum[w];
    const unsigned excl = base + incl - pk; unsigned bg = excl & 0xffffu, be = excl >> 16;
    for (int s = s0; s < s0 + 32 && s < n; ++s) { const unsigned k = sc[s];
        if (k > prefix) { IDX[t * 256 + bg] = (unsigned short)s; ++bg; }
        else if (k == prefix) { if (be < krem) IDX[t * 256 + ngt_total + be] = (unsigned short)s; ++be; } }
    __syncthreads();
}

typedef _Float16 half8 __attribute__((ext_vector_type(8)));
constexpr int IX_CAP = 1024, IX_ZBIN = 2048;
__device__ __forceinline__ unsigned ix_key(const f32x4 a, const f32x4 w) {
    const float r0 = __int_as_float(max(__float_as_int(a[0]), 0)), r1 = __int_as_float(max(__float_as_int(a[1]), 0));
    const float r2 = __int_as_float(max(__float_as_int(a[2]), 0)), r3 = __int_as_float(max(__float_as_int(a[3]), 0));
    float s = fmaf(w[0], r0, 0.0f); s = fmaf(w[1], r1, s); s = fmaf(w[2], r2, s); s = fmaf(w[3], r3, s);
    const unsigned u = __float_as_uint(s);
    return u ^ ((unsigned)((int)u >> 31) | 0x80000000u);
}
#define LDS_ADD(ptr, v) __hip_atomic_fetch_add((ptr), (v), __ATOMIC_RELAXED, __HIP_MEMORY_SCOPE_WORKGROUP)
struct IxTagF { static constexpr bool value = false; }; struct IxTagT { static constexpr bool value = true; };
__device__ __forceinline__ void phase_indexer(const P& p, unsigned char* lds) {
    unsigned char* ws = p.ws; const int tid = tid_opaque(), lane = tid & 63, kl = lane & 15, g = lane >> 4;
    const int wave = __builtin_amdgcn_readfirstlane(tid >> 6);
    const _Float16* QI = (const _Float16*)(ws + OFF_QI); const _Float16* KIT = (const _Float16*)(ws + OFF_KIT); const float* WI = (const float*)(ws + OFF_WI);
    unsigned short* IDX = (unsigned short*)(ws + OFF_IDX); int* CNT = (int*)(ws + OFF_CNT);
    LAS unsigned* hist = (LAS unsigned*)lds;
    LAS int* qTbin = (LAS int*)(hist + 16 * 2048);
    LAS int* qCab = qTbin + 16; LAS unsigned* qN = (LAS unsigned*)(qCab + 16); LAS int* qOvf = (LAS int*)(qN + 16); LAS int* qZl = qOvf + 16;
    LAS unsigned* ovl = (LAS unsigned*)(lds + 132 * 1024);
    LAS unsigned* h2 = (LAS unsigned*)(lds + 133 * 1024 + wave * 1536);
    LAS unsigned long long* l2 = (LAS unsigned long long*)(h2 + 256);
    if (tid == 0) ovl[0] = 0u;
    const int G = gridDim.x, nround = (T / 16) / G;
#pragma unroll 1
    for (int i = 0; i < nround; ++i) {
        const int tix = (i & 1) ? i * G + (G - 1 - (int)blockIdx.x) : i * G + (int)blockIdx.x;
        const int batch = tix & 1, tb = tix >> 1, p0 = tb * 16; const size_t t0 = (size_t)batch * SEQ + p0;
        __syncthreads();
        if (p0 + 16 <= 256) {
#pragma unroll
            for (int j = 0; j < 8; ++j) { const int e = tid + 512 * j, q = e >> 8, jj = e & 255; IDX[(t0 + q) * 256 + jj] = (unsigned short)(jj <= p0 + q ? jj : 0); }
            if (tid < 16) CNT[t0 + tid] = p0 + tid + 1;
            continue;
        }
#pragma unroll
        for (int j = 0; j < 16; ++j) ((LAS u32x4*)hist)[tid + 512 * j] = (u32x4){0u, 0u, 0u, 0u};
        if (tid < 16) { qN[tid] = 0u; qOvf[tid] = 0; }
        half8 af[4][2]; f32x4 wv[4];
#pragma unroll
        for (int rt = 0; rt < 4; ++rt) {
#pragma unroll
            for (int ks = 0; ks < 2; ++ks) af[rt][ks] = *(const half8*)(QI + (t0 + 4 * rt + (kl >> 2)) * 256 + (kl & 3) * 64 + 32 * ks + 8 * g);
            wv[rt] = *(const f32x4*)(WI + (t0 + 4 * rt + g) * 4);
        }
        __syncthreads();
        const int nblk = tb + 1, L = (nblk + 7) >> 3, b0 = wave * L, b1 = (b0 + L < nblk) ? b0 + L : nblk;
        const _Float16* kb = KIT + (size_t)batch * SEQ * 64 + lane * 8;
        LAS unsigned* hg = hist + g * 4 * 2048;
#define IX_LOADK(u, bb) do { kq[u][0] = *(const half8*)(kb + (size_t)(bb) * 1024); kq[u][1] = *(const half8*)(kb + (size_t)(bb) * 1024 + 512); } while (0)
#define IX_MFMA(acc, k0, k1) do { _Pragma("unroll") for (int rt = 0; rt < 4; ++rt) { acc[rt] = __builtin_amdgcn_mfma_f32_16x16x32_f16(af[rt][0], k0, (f32x4){0.f, 0.f, 0.f, 0.f}, 0, 0, 0); \
            acc[rt] = __builtin_amdgcn_mfma_f32_16x16x32_f16(af[rt][1], k1, acc[rt], 0, 0, 0); } } while (0)
        const int sst = (nblk <= 64) ? 1 : 2;
        {
            const int bend = (b1 < nblk - 1) ? b1 : nblk - 1;
            const int ns = (bend > b0) ? ((bend - b0 + sst - 1) / sst) : 0;
            auto step1 = [&](int bcur, const half8& k0, const half8& k1, auto chkTag) {
                constexpr bool CHK = decltype(chkTag)::value;
                f32x4 acc[4]; IX_MFMA(acc, k0, k1);
#pragma unroll
                for (int rt = 0; rt < 4; ++rt) { const unsigned key = ix_key(acc[rt], wv[rt]);
                    if (!CHK || bcur * 16 + kl <= p0 + 4 * rt + g) LDS_ADD(hg + rt * 2048 + (key >> 21), 1u << ((key >> 16) & 16u)); }
            };
            if (ns > 0) {
                half8 kq[2][2];
#pragma unroll
                for (int u = 0; u < 2; ++u) { const int kk = (u < ns) ? u : ns - 1; IX_LOADK(u, b0 + sst * kk); }
                int k = 0;
#pragma unroll 1
                for (; k + 2 <= ns; k += 2) {
#pragma unroll
                    for (int u = 0; u < 2; ++u) { step1(0, kq[u][0], kq[u][1], IxTagF{}); const int kk = (k + 2 + u < ns) ? k + 2 + u : ns - 1; IX_LOADK(u, b0 + sst * kk); }
                }
                if (k < ns) step1(0, kq[0][0], kq[0][1], IxTagF{});
            }
            if (sst == 1 && b1 == nblk && b0 < b1) { half8 kq[1][2]; IX_LOADK(0, nblk - 1); step1(nblk - 1, kq[0][0], kq[0][1], IxTagT{}); }
        }
        __syncthreads();
        int nsb = 0;
#pragma unroll
        for (int ww = 0; ww < 8; ++ww) { const int c0 = ww * L, c1 = (c0 + L < nblk) ? c0 + L : nblk, ce = (c1 < nblk - 1) ? c1 : nblk - 1; nsb += (ce > c0) ? ((ce - c0 + 1) >> 1) : 0; }
        if (sst == 1) nsb = nblk;
        const float fsm = (sst == 1) ? 1.0f : fminf(1.0f, (float)(nsb * 16) / (float)(p0 + 1));
        int tgt = (int)(256.0f * fsm + 5.0f * sqrtf(256.0f * fsm * (1.0f - fsm))) + 2; tgt = tgt > 256 ? 256 : tgt;
#pragma unroll 1
        for (int qq = 0; qq < 2; ++qq) {
            const int q = 2 * wave + qq; const LAS unsigned* h = hist + q * 2048;
            unsigned S2 = 0;
#pragma unroll
            for (int c8 = 0; c8 < 8; ++c8) { const int cc = (c8 ^ (lane >> 1)) & 7; const u32x4 w4 = *(const LAS u32x4*)(h + 2016 - 32 * lane + 4 * cc); S2 += w4.x + w4.y + w4.z + w4.w; }
            const unsigned cs = (S2 & 0xffffu) + (S2 >> 16);
            const unsigned incl = wave_iscan(cs);
            const unsigned long long m = __ballot(incl >= (unsigned)tgt);
            const int Ls = m ? (__ffsll((long long)m) - 1) : 63;
            const unsigned cab0 = rlu(incl - cs, Ls);
            const int dw = 2047 - 32 * Ls - (lane >> 1); const unsigned w2 = h[dw]; const unsigned cl = (lane & 1) ? (w2 & 0xffffu) : (w2 >> 16);
            const unsigned incl2 = wave_iscan(cl) + cab0;
            const unsigned long long m2 = __ballot(incl2 >= (unsigned)tgt);
            const int L2 = m2 ? (__ffsll((long long)m2) - 1) : 63;
            const int tbin = m2 ? 2 * (2047 - 32 * Ls) + 1 - L2 : 0; const unsigned cbv = rlu(cl, L2), cabv = rlu(incl2 - cl, L2);
            if (lane == 0) { qTbin[q] = tbin; qCab[q] = (int)cabv; int zl = 0x7fffffff;
                if (tbin == IX_ZBIN) {
                    const int nk = p0 + 4 * (q & 3) + (q >> 2) + 1; zl = (int)(((unsigned long long)384 * (unsigned)(nsb * 16)) / (cbv ? cbv : 1u)) + 16; zl = zl < nk ? zl : 0x7fffffff; }
                qZl[q] = zl; }
        }
        __syncthreads();
        if (b0 < b1) {
            unsigned lok[4]; int zl[4];
#pragma unroll
            for (int rt = 0; rt < 4; ++rt) { lok[rt] = (unsigned)qTbin[g * 4 + rt] << 20; zl[rt] = qZl[g * 4 + rt]; }
            half8 kq[2][2];
#pragma unroll
            for (int u = 0; u < 2; ++u) { const int bb = (b0 + u < b1) ? b0 + u : b1 - 1; IX_LOADK(u, bb); }
            auto step2 = [&](int bcur, const half8& k0, const half8& k1, auto chkTag) {
                constexpr bool CHK = decltype(chkTag)::value;
                const int s = bcur * 16 + kl;
                f32x4 acc[4]; IX_MFMA(acc, k0, k1);
                unsigned key[4], pos[4]; bool cand[4];
#pragma unroll
                for (int rt = 0; rt < 4; ++rt) { key[rt] = ix_key(acc[rt], wv[rt]); cand[rt] = key[rt] >= lok[rt] + (s >= zl[rt] ? 1u : 0u); if (CHK) cand[rt] = cand[rt] && s <= p0 + 4 * rt + g; }
#pragma unroll
                for (int rt = 0; rt < 4; ++rt) { pos[rt] = 0u;
                    if (cand[rt]) { int gz = g; asm volatile("" : "+v"(gz)); pos[rt] = LDS_ADD(qN + gz * 4 + rt, 1u); } }
#pragma unroll
                for (int rt = 0; rt < 4; ++rt) {
                    if (cand[rt] && pos[rt] < (unsigned)IX_CAP) { int gz = g; asm volatile("" : "+v"(gz));
                        ((LAS unsigned long long*)(lds + (gz * 4 + rt) * 8192))[pos[rt]] = ((unsigned long long)key[rt] << 16) | (unsigned long long)(0xffffu - (unsigned)s); } }
            };
            int b = b0;
#pragma unroll 1
            for (; b + 2 <= b1 && b + 2 <= nblk - 1; b += 2) {
#pragma unroll
                for (int u = 0; u < 2; ++u) { step2(b + u, kq[u][0], kq[u][1], IxTagF{}); const int bb = (b + 2 + u < b1) ? b + 2 + u : b1 - 1; IX_LOADK(u, bb); }
            }
#pragma unroll 1
            for (; b + 2 <= b1; b += 2) {
#pragma unroll
                for (int u = 0; u < 2; ++u) { step2(b + u, kq[u][0], kq[u][1], IxTagT{}); const int bb = (b + 2 + u < b1) ? b + 2 + u : b1 - 1; IX_LOADK(u, bb); }
            }
            if (b < b1) step2(b, kq[0][0], kq[0][1], IxTagT{});
        }
#undef IX_LOADK
#undef IX_MFMA
        __syncthreads();
#pragma unroll 1
        for (int qq = 0; qq < 2; ++qq) {
            const int qs = 2 * wave + qq; const int n = __builtin_amdgcn_readfirstlane((int)qN[qs]);
            if (n > IX_CAP || n < 256) { if (lane == 0) qOvf[qs] = 1; continue; }
            const LAS unsigned long long* cd = (const LAS unsigned long long*)(lds + qs * 8192);
            unsigned short* irow = IDX + (t0 + 4 * (qs & 3) + (qs >> 2)) * 256;
            const int NI = (n + 63) >> 6;
            unsigned long long v[16];
#pragma unroll
            for (int i = 0; i < 16; ++i) v[i] = (i < NI && lane + 64 * i < n) ? cd[lane + 64 * i] : 0ull;
            unsigned long long tau = 1ull;
            if (n > 256) {
                unsigned long long pmask = 0xfffull << 36, pval; int need; unsigned cT;
                {
                    int cpos = 0, czer = 0;
#pragma unroll
                    for (int i = 0; i < 16; ++i) if (i < NI) { const int bb = (int)(v[i] >> 36); cpos += (int)__popcll(__ballot(bb > IX_ZBIN)); czer += (int)__popcll(__ballot(bb == IX_ZBIN && v[i] != 0ull)); }
                    if (cpos < 256 && cpos + czer >= 256) { need = 256 - cpos; cT = (unsigned)czer; pval = (unsigned long long)IX_ZBIN << 36; }
                    else {
                        const bool negc = cpos < 256; const int abovec = negc ? cpos + czer : 0;
                        int bmx = 0;
#pragma unroll
                        for (int i = 0; i < 16; ++i) if (i < NI) { const int bb = (int)(v[i] >> 36); const bool mem = negc ? (bb < IX_ZBIN && v[i] != 0ull) : (bb > IX_ZBIN); bmx = (mem && bb > bmx) ? bb : bmx; }
                        bmx = (int)wave_max((float)bmx);
#pragma unroll
                        for (int j = 0; j < 4; ++j) h2[lane + 64 * j] = 0u;
                        asm volatile("" ::: "memory");
#pragma unroll
                        for (int i = 0; i < 16; ++i) if (i < NI) { const int bb = (int)(v[i] >> 36); const bool mem = negc ? (bb < IX_ZBIN && v[i] != 0ull) : (bb > IX_ZBIN);
                            if (mem) { const int d = bmx - bb; LDS_ADD(h2 + (d > 255 ? 0 : 255 - d), 1u); } }
                        asm volatile("" ::: "memory");
                        const unsigned want = (unsigned)(256 - abovec);
                        int T0; unsigned above, c2; radix_pick(h2, lane, want, T0, above, c2);
                        if (T0 <= 0) { if (lane == 0) qOvf[qs] = 1; continue; }
                        need = (int)want - (int)above; cT = c2; pval = (unsigned long long)(unsigned)(bmx - 255 + T0) << 36;
                    }
                    asm volatile("" ::: "memory");
                }
#pragma unroll 1
                for (int shift = 28; shift >= 4 && cT > 64u; shift -= 8) {
#pragma unroll
                    for (int j = 0; j < 4; ++j) h2[lane + 64 * j] = 0u;
                    asm volatile("" ::: "memory");
#pragma unroll
                    for (int i = 0; i < 16; ++i) if (i < NI && (v[i] & pmask) == pval) LDS_ADD(h2 + ((unsigned)(v[i] >> shift) & 255u), 1u);
                    asm volatile("" ::: "memory");
                    int T2; unsigned above, c2; radix_pick(h2, lane, (unsigned)need, T2, above, c2);
                    if (T2 < 0) { T2 = 0; }
                    need -= (int)above; cT = c2;
                    pmask |= 255ull << shift; pval |= (unsigned long long)T2 << shift;
                    asm volatile("" ::: "memory");
                }
                { int base = 0;
#pragma unroll
                  for (int i = 0; i < 16; ++i) { if (i < NI) { const bool mt = (v[i] & pmask) == pval; const unsigned long long bm = __ballot(mt);
                      if (mt) { const int pos = base + (int)__popcll(bm & ((1ull << lane) - 1ull)); if (pos < 64) l2[pos] = v[i]; }
                      base += (int)__popcll(bm); } } }
                asm volatile("" ::: "memory");
                const unsigned long long mine = (unsigned)lane < cT ? l2[lane] : 0ull;
                const unsigned mlo = (unsigned)mine, mhi = (unsigned)(mine >> 32);
                int rank = 0;
#pragma unroll 1
                for (unsigned j = 0; j < cT; ++j) { const unsigned long long o = ((unsigned long long)(unsigned)__builtin_amdgcn_readlane((int)mhi, (int)j) << 32) | (unsigned)__builtin_amdgcn_readlane((int)mlo, (int)j);
                    rank += (o > mine) ? 1 : 0; }
                const unsigned long long hit = __ballot((unsigned)lane < cT && rank == need - 1);
                const int hl = hit ? (__ffsll((long long)hit) - 1) : 0;
                tau = ((unsigned long long)(unsigned)__builtin_amdgcn_readlane((int)mhi, hl) << 32) | (unsigned)__builtin_amdgcn_readlane((int)mlo, hl);
                asm volatile("" ::: "memory");
            }
            { int base = 0;
#pragma unroll
              for (int i = 0; i < 16; ++i) { if (i < NI) { const bool e = v[i] >= tau; const unsigned long long bm = __ballot(e);
                  if (e) irow[base + (int)__popcll(bm & ((1ull << lane) - 1ull))] = (unsigned short)(0xffffu - (unsigned)(v[i] & 0xffffull));
                  base += (int)__popcll(bm); } } }
        }
        if (tid < 16) CNT[t0 + tid] = 256;
        __syncthreads();
        if (tid < 16 && qOvf[tid]) { const unsigned k = LDS_ADD(ovl, 1u); ovl[1 + k] = (unsigned)(t0 + 4 * (tid & 3) + (tid >> 2)); }
    }
    __syncthreads();
    const unsigned novl = __builtin_amdgcn_readfirstlane(ovl[0]);
#pragma unroll 1
    for (unsigned k = 0; k < novl; ++k) { const unsigned tq = __builtin_amdgcn_readfirstlane(ovl[1 + k]); indexer_slow_query(p, lds, (size_t)tq); }
}
#undef LDS_ADD

__device__ __forceinline__ void phase_attn(const P& p, unsigned char* lds) {
    unsigned char* ws = p.ws; const int tid = tid_opaque(), lane = tid & 63, hd = lane & 15, g = lane >> 4;
    const int wave = __builtin_amdgcn_readfirstlane(tid >> 6);
    bf16_t* QP = (bf16_t*)(ws + OFF_QP); const bf16_t* CK = (const bf16_t*)(ws + OFF_CKVN); const bf16_t* RK = (const bf16_t*)(ws + OFF_RK);
    const unsigned short* IDX = (const unsigned short*)(ws + OFF_IDX); const int* CNT = (const int*)(ws + OFF_CNT);
    float* biasT = (float*)lds;
    biasT[tid] = p.rel_bias[tid] * 1.4426950408889634f;
    __syncthreads();
    LAS unsigned char* rows = (LAS unsigned char*)(lds + 2048 + (size_t)wave * 18432);
    LAS bf16_t* rkb = (LAS bf16_t*)(rows + 16384);
    LAS unsigned* info = (LAS unsigned*)(rows + 17408);
    const LAS float* biasL = (const LAS float*)lds;
    for (int t = blockIdx.x * 8 + wave; t < T; t += gridDim.x * 8) {
        const int batch = t >> 14, pos = t & (SEQ - 1); const int cnt = __builtin_amdgcn_readfirstlane(CNT[t]);
        const size_t rb = (size_t)batch * SEQ;
        asm volatile("s_waitcnt lgkmcnt(0)" ::: "memory");
#pragma unroll
        for (int jj = 0; jj < 4; ++jj) {
            const int j = lane + 64 * jj; int id = IDX[(size_t)t * 256 + j]; if (j >= cnt) id = 0;
            const int rel = pos - id; int bucket = rel < 0 ? 0 : rel;
            if (rel >= 16) { bucket = 16 + (int)(__logf((float)rel * 0.0625f) / 2.0794415416798357f * 16.0f); bucket = bucket > 31 ? 31 : bucket; }
            info[j] = (unsigned)id | ((unsigned)bucket << 16);
        }
        bf16x8 qf[8];
#pragma unroll
        for (int ks = 0; ks < 8; ++ks) qf[ks] = *(const bf16x8*)(QP + (size_t)t * 4096 + hd * 256 + ks * 32 + g * 8);
        f32x4 o[16];
#pragma unroll
        for (int rt = 0; rt < 16; ++rt) o[rt] = (f32x4){0.f, 0.f, 0.f, 0.f};
        float mref = 0.f, lrun = 0.f;
        asm volatile("s_waitcnt lgkmcnt(0)" ::: "memory");
        const int nch = (cnt + 31) >> 5;
        for (int ch = 0; ch < nch; ++ch) {
            asm volatile("s_waitcnt lgkmcnt(0)" ::: "memory");
#pragma unroll
            for (int i = 0; i < 16; ++i) {
                const int ksl = 2 * i + (lane >> 5); const unsigned idv = info[ch * 32 + ksl] & 0xffffu;
                const bf16_t* src = CK + (rb + idv) * 256 + (((lane & 31) ^ (ksl & 15)) * 8);
                __builtin_amdgcn_global_load_lds((const unsigned*)src, (LAS unsigned*)(rows + i * 1024), 16, 0, 0);
            }
            { const unsigned idv = info[ch * 32 + (lane >> 1)] & 0xffffu;
              __builtin_amdgcn_global_load_lds((const unsigned*)(RK + (rb + idv) * 16 + (lane & 1) * 8), (LAS unsigned*)rkb, 16, 0, 0); }
            asm volatile("s_waitcnt vmcnt(0)" ::: "memory");
            f32x4 s0 = (f32x4){0.f, 0.f, 0.f, 0.f}, s1 = (f32x4){0.f, 0.f, 0.f, 0.f};
#pragma unroll
            for (int ks = 0; ks < 8; ++ks) {
                const int pos16 = ((4 * ks + g) ^ hd) * 16;
                const bf16x8 a0 = *(const LAS bf16x8*)(rows + hd * 512 + pos16);
                const bf16x8 a1 = *(const LAS bf16x8*)(rows + (16 + hd) * 512 + pos16);
                s0 = __builtin_amdgcn_mfma_f32_16x16x32_bf16(a0, qf[ks], s0, 0, 0, 0);
                s1 = __builtin_amdgcn_mfma_f32_16x16x32_bf16(a1, qf[ks], s1, 0, 0, 0);
            }
            float x0[4], x1[4];
#pragma unroll
            for (int r = 0; r < 4; ++r) {
                const int sl0 = 4 * g + r, sl1 = 16 + 4 * g + r, j0 = ch * 32 + sl0, j1 = ch * 32 + sl1;
                const unsigned i0 = info[j0], i1 = info[j1];
                const float r0 = bf2f(rkb[sl0 * 16 + hd]), r1 = bf2f(rkb[sl1 * 16 + hd]);
                x0[r] = fmaf(s0[r], r0, biasL[(i0 >> 16) * 16 + hd]);
                x1[r] = fmaf(s1[r], r1, biasL[(i1 >> 16) * 16 + hd]);
            }
            if (cnt < 256) {
#pragma unroll
                for (int r = 0; r < 4; ++r) { if (ch * 32 + 4 * g + r >= cnt) x0[r] = -INFINITY; if (ch * 32 + 16 + 4 * g + r >= cnt) x1[r] = -INFINITY; }
            }
            const float cml = fmaxf(fmaxf(fmaxf(x0[0], x0[1]), fmaxf(x0[2], x0[3])), fmaxf(fmaxf(x1[0], x1[1]), fmaxf(x1[2], x1[3])));
            if (ch == 0 || __ballot(cml > mref + 11.5f)) {
                float cm = fmaxf(cml, __shfl_xor(cml, 16)); cm = fmaxf(cm, __shfl_xor(cm, 32));
                const float mnew = (ch == 0) ? cm : fmaxf(mref, cm);
                if (ch != 0) { const float sc = __builtin_amdgcn_exp2f(mref - mnew); lrun *= sc;
#pragma unroll
                    for (int rt = 0; rt < 16; ++rt) o[rt] *= sc; }
                mref = mnew;
            }
            float ls = 0.f;
#pragma unroll
            for (int r = 0; r < 4; ++r) { x0[r] = __builtin_amdgcn_exp2f(x0[r] - mref); x1[r] = __builtin_amdgcn_exp2f(x1[r] - mref); ls += x0[r] + x1[r]; }
            lrun += ls;
            u32x4 pw; pw.x = pg8::cvt_pk_bf16(x0[0], x0[1]); pw.y = pg8::cvt_pk_bf16(x0[2], x0[3]); pw.z = pg8::cvt_pk_bf16(x1[0], x1[1]); pw.w = pg8::cvt_pk_bf16(x1[2], x1[3]);
            const bf16x8 pf = __builtin_bit_cast(bf16x8, pw);
            const int q = hd >> 2, pp = hd & 3, ksl = 4 * g + q;
            const LAS unsigned char* trb = rows + ksl * 512 + (pp & 1) * 8;
#pragma unroll
            for (int rt = 0; rt < 16; ++rt) {
                const int c16 = ((2 * rt + (pp >> 1)) ^ ksl) * 16;
                const v4i16_t t0 = __builtin_amdgcn_ds_read_tr16_b64_v4i16((LAS v4i16_t*)(trb + c16));
                const v4i16_t t1 = __builtin_amdgcn_ds_read_tr16_b64_v4i16((LAS v4i16_t*)(trb + c16 + 8192));
                bf16x8 af; af[0] = t0[0]; af[1] = t0[1]; af[2] = t0[2]; af[3] = t0[3]; af[4] = t1[0]; af[5] = t1[1]; af[6] = t1[2]; af[7] = t1[3];
                o[rt] = __builtin_amdgcn_mfma_f32_16x16x32_bf16(af, pf, o[rt], 0, 0, 0);
            }
        }
        float ltot = lrun; ltot += __shfl_xor(ltot, 16); ltot += __shfl_xor(ltot, 32);
        const float inv = 1.0f / ltot;
        bf16_t* op = QP + (size_t)t * 4096 + hd * 256 + 4 * g;
#pragma unroll
        for (int rt = 0; rt < 16; ++rt) { u32x2 w; w.x = pg8::cvt_pk_bf16(o[rt][0] * inv, o[rt][1] * inv); w.y = pg8::cvt_pk_bf16(o[rt][2] * inv, o[rt][3] * inv); *(u32x2*)(op + rt * 16) = w; }
    }
}

__global__ void __launch_bounds__(512, 2) k_fwd(P p_arg, int ph_lo, int ph_hi) {
    extern __shared__ __attribute__((aligned(16))) unsigned char smem[];
    const P& p = *(const P*)__builtin_amdgcn_kernarg_segment_ptr(); (void)p_arg;
    unsigned char* lds = smem + 16;
    unsigned char* ws = p.ws;
    XcdBarrier bar;
    const bool multi = (ph_hi - ph_lo) > 1;
    if (multi) {
        if (threadIdx.x == 0) *(uint4*)smem = make_uint4(0u, 0u, 0u, 0u);
        __syncthreads();
        bar = xcd_barrier_post((unsigned*)(ws + OFF_CTL), (volatile LAS unsigned*)smem);
    }
#define PH(i) (ph_lo <= (i) && (i) < ph_hi)
#define SEAM(i) do { if ((i) + 1 < ph_hi) xcd_barrier(bar); else __syncthreads(); } while (0)
    bf16_t *XN = (bf16_t*)(ws + OFF_XN), *QB = (bf16_t*)(ws + OFF_QB), *KB = (bf16_t*)(ws + OFF_KB), *VB = (bf16_t*)(ws + OFF_VB), *TMP = (bf16_t*)(ws + OFF_TMP), *Y = (bf16_t*)(ws + OFF_Y);
    if (PH(0)) { phase_prep(p, lds); SEAM(0); }
    if (PH(1)) { fast_gemm(lds, XN, 1024, (const bf16_t*)(ws + OFF_W0T), 1024, 3072, 1024, D1{ws}); SEAM(1); }
    if (PH(2)) { phase_conv_scan(p, lds); SEAM(2); }
    if (PH(3)) { mlstm_units<false>(p, lds); SEAM(3); }
    if (PH(4)) { GWP f{(const bf16_t*)(ws + OFF_WPT), (const bf16_t*)(ws + OFF_WUB), (bf16_t*)(ws + OFF_W0T)}; sgemm(f, 256); phase_mlstm_scan(p, lds); SEAM(4); }
    if (PH(5)) { mlstm_units<true>(p, lds); SEAM(5); }
    if (PH(6)) { fast_gemm(lds, XN, 1024, (const bf16_t*)(ws + OFF_W0T) + (size_t)3072 * 1024, 1024, 4096, 1024, D2{ws}); SEAM(6); }
    if (PH(7)) { phase_ya_pool(p); SEAM(7); }
    if (PH(8)) { fast_gemm(lds, Y, 2048, (const bf16_t*)(ws + OFF_WO0T), 2048, 1024, 2048, D4{(unsigned char*)p.out, p.x}); SEAM(8); }
    if (PH(9)) { rmsnorm_rows<4>(p.out, p.o_norm, XN, p.o_w_in, OIN, 1600, nullptr, 0.5f, (float*)(ws + OFF_WI), (float*)lds); SEAM(9); }
    if (PH(10)) { fast_gemm(lds, XN, 1024, (const bf16_t*)(ws + OFF_W1T), 1024, 2816, 1024, D5{ws}); SEAM(10); }
    if (PH(11)) { phase_qnorm_ckvnorm(p); SEAM(11); }
    if (PH(12)) { fast_gemm(lds, (const bf16_t*)(ws + OFF_CKVN), 256, (const bf16_t*)(ws + OFF_WUKP), 256, 1024, 256, DK{ws}); SEAM(12); }
    if (PH(13)) { fast_gemm(lds, TMP, 1024, (const bf16_t*)(ws + OFF_WQF), 128, 4096, 128, DQ{ws}, (size_t)128); phase_indexer(p, lds); SEAM(13); }
    if (PH(14)) { phase_attn(p, lds); SEAM(14); }
    if (PH(15)) { fast_gemm(lds, (const bf16_t*)(ws + OFF_QP), 4096, (const bf16_t*)(ws + OFF_WBD), 1024, 1024, 1024, DO{ws}, (size_t)2048); SEAM(15); }
    if (PH(16)) { fast_gemm(lds, TMP, 1024, (const bf16_t*)(ws + OFF_WO1T), 1024, 1024, 1024, D8{(unsigned char*)p.out}); }
#undef PH
#undef SEAM
}

extern "C" void kernel_launch(void* const* d_in, const int* in_sizes, int n_in, void* d_out, int out_size, void* d_ws, size_t ws_size, hipStream_t stream) {
    static int grid = 0;
    if (grid == 0) {
        if (n_in != 18 || out_size != T * DM || ws_size < WS_END) { fprintf(stderr, "kernel_launch: unexpected shapes (n_in %d out %d ws %zu)\n", n_in, out_size, ws_size); grid = -1; return; }
        if (hipFuncSetAttribute((const void*)k_fwd, hipFuncAttributeMaxDynamicSharedMemorySize, LDS_BYTES) != hipSuccess) { fprintf(stderr, "kernel_launch: hipFuncSetAttribute failed\n"); grid = -1; return; }
        grid = 256;
    }
    if (grid < 0) return;
    (void)hipMemsetAsync((char*)d_ws + OFF_CTL, 0, 16384, stream);
    P p{};
    p.x = (const float*)d_in[0]; p.e_norm = (const float*)d_in[1]; p.e_w_in = (const float*)d_in[2]; p.e_conv = (const float*)d_in[3]; p.e_b_if = (const float*)d_in[4];
    p.e_g_head = (const float*)d_in[5]; p.e_w_pool = (const float*)d_in[6]; p.e_s_pool = (const float*)d_in[7]; p.e_w_out = (const float*)d_in[8];
    p.o_norm = (const float*)d_in[9]; p.o_w_in = (const float*)d_in[10]; p.o_g_kv = (const float*)d_in[11]; p.o_w_uk = (const float*)d_in[12]; p.o_w_uv = (const float*)d_in[13];
    p.o_g_q = (const float*)d_in[14]; p.o_g_k = (const float*)d_in[15]; p.o_w_out = (const float*)d_in[16]; p.rel_bias = (const float*)d_in[17];
    p.out = (float*)d_out; p.ws = (unsigned char*)d_ws;
    hipLaunchKernelGGL(k_fwd, dim3(grid), dim3(512), LDS_BYTES, stream, p, 0, NPH);
}
```

```cpp
#include <hip/hip_runtime.h>
#include <stdint.h>
#include <cstdio>

typedef unsigned short bf16_t;
typedef short bf16x8 __attribute__((ext_vector_type(8)));
typedef float f32x4 __attribute__((ext_vector_type(4)));
typedef unsigned u32x4 __attribute__((ext_vector_type(4)));
typedef unsigned u32x2 __attribute__((ext_vector_type(2)));
typedef short v4i16_t __attribute__((ext_vector_type(4)));
#define LAS __attribute__((address_space(3)))

constexpr int T = 32768, SEQ = 16384, DM = 1024;
constexpr int EIN = 7176, OIN = 2628;
constexpr float EPS = 1e-6f;
constexpr size_t MB = 1048576;
constexpr size_t OFF_CTL = 0;
constexpr size_t OFF_GATES = 64 * 1024;
constexpr size_t OFF_BQ = OFF_GATES + (size_t)T * 8 * 4;
constexpr size_t OFF_IQ = OFF_BQ + (size_t)T * 4 * 4;
constexpr size_t OFF_MT = OFF_IQ + (size_t)T * 4 * 4;
constexpr size_t OFF_WI = OFF_MT + (size_t)T * 4 * 4;
constexpr size_t OFF_CH = OFF_WI + (size_t)T * 4 * 4;
constexpr size_t OFF_NS = OFF_CH + 64 * 1024;
constexpr size_t OFF_RSQ = OFF_GATES;
constexpr size_t OFF_W = 4 * MB;
constexpr size_t OFF_W0T = OFF_W;
constexpr size_t OFF_WPT = OFF_W0T + (size_t)7168 * 1024 * 2;
constexpr size_t OFF_WO0T = OFF_WPT + (size_t)4 * 256 * 256 * 2;
constexpr size_t OFF_W1T = OFF_WO0T + (size_t)1024 * 2048 * 2;
constexpr size_t OFF_WUKT = OFF_W1T + (size_t)2816 * 1024 * 2;
constexpr size_t OFF_WUVT = OFF_WUKT + (size_t)1024 * 256 * 2;
constexpr size_t OFF_WO1T = OFF_WUVT + (size_t)1024 * 256 * 2;
constexpr size_t OFF_WUKP = OFF_WO1T + (size_t)1024 * 1024 * 2;
constexpr size_t OFF_WQP = OFF_WUKP + (size_t)1024 * 256 * 2;
constexpr size_t OFF_WUB = OFF_WQP + (size_t)16 * 256 * 64 * 2;
constexpr size_t OFF_XN = 36 * MB, OFF_QB = 100 * MB, OFF_KB = 164 * MB, OFF_VB = 228 * MB, OFF_TMP = 292 * MB, OFF_Y = 356 * MB;
constexpr size_t OFF_QP = 36 * MB;
constexpr size_t OFF_CKVN = OFF_Y;
constexpr size_t OFF_QI = OFF_Y + 16 * MB;
constexpr size_t OFF_KI = OFF_Y + 32 * MB;
constexpr size_t OFF_KIT = OFF_Y + 36 * MB;
constexpr size_t OFF_IDX = OFF_Y + 40 * MB;
constexpr size_t OFF_RK = OFF_Y + 58 * MB;
constexpr size_t OFF_CNT = OFF_Y + 59 * MB;
constexpr size_t OFF_Z = OFF_Y + 60 * MB;
constexpr size_t OFF_WBD = 484 * MB;
constexpr size_t OFF_WQF = 486 * MB;
constexpr size_t WS_END = 487 * MB;
constexpr int LDS_BYTES = 151552;
constexpr int NPH = 17;

struct P {
    const float *x, *e_norm, *e_w_in, *e_conv, *e_b_if, *e_g_head, *e_w_pool, *e_s_pool, *e_w_out;
    const float *o_norm, *o_w_in, *o_g_kv, *o_w_uk, *o_w_uv, *o_g_q, *o_g_k, *o_w_out, *rel_bias;
    float* out; unsigned char* ws;
};

__device__ __forceinline__ bf16_t f2bf(float f) { unsigned u = __float_as_uint(f); u += 0x7FFFu + ((u >> 16) & 1u); return (bf16_t)(u >> 16); }
__device__ __forceinline__ float bf2f(bf16_t b) { return __uint_as_float(((unsigned)b) << 16); }
__device__ __forceinline__ float bflo(unsigned w) { return __uint_as_float(w << 16); }
__device__ __forceinline__ float bfhi(unsigned w) { return __uint_as_float(w & 0xffff0000u); }
__device__ __forceinline__ unsigned pk2(float a, float b) { return (unsigned)f2bf(a) | ((unsigned)f2bf(b) << 16); }
__device__ __forceinline__ float sigmoidf_(float x) { return __builtin_amdgcn_rcpf(1.0f + __expf(-x)); }
__device__ __forceinline__ float siluf_(float x) { return x * __builtin_amdgcn_rcpf(1.0f + __expf(-x)); }
template <int CTRL> __device__ __forceinline__ float dppf(float v) { return __builtin_bit_cast(float, __builtin_amdgcn_update_dpp(0, __builtin_bit_cast(int, v), CTRL, 0xf, 0xf, true)); }
__device__ __forceinline__ float rlf(float v, int l) { return __builtin_bit_cast(float, __builtin_amdgcn_readlane(__builtin_bit_cast(int, v), l)); }
__device__ __forceinline__ int tid_opaque() { int t = threadIdx.x; asm volatile("" : "+v"(t)); return t; }
__device__ __forceinline__ float wave_sum(float v) {
    v += dppf<0xB1>(v); v += dppf<0x4E>(v); v += dppf<0x141>(v); v += dppf<0x140>(v);
    return (rlf(v, 0) + rlf(v, 16)) + (rlf(v, 32) + rlf(v, 48));
}
__device__ __forceinline__ float wave_max(float v) {
    v = fmaxf(v, dppf<0xB1>(v)); v = fmaxf(v, dppf<0x4E>(v)); v = fmaxf(v, dppf<0x141>(v)); v = fmaxf(v, dppf<0x140>(v));
    return fmaxf(fmaxf(rlf(v, 0), rlf(v, 16)), fmaxf(rlf(v, 32), rlf(v, 48)));
}

template <int CTRL, int RM, bool BC> __device__ __forceinline__ unsigned dppu(unsigned v) { return (unsigned)__builtin_amdgcn_update_dpp(0, (int)v, CTRL, RM, 0xf, BC); }
__device__ __forceinline__ unsigned wave_iscan(unsigned v) {
    v += dppu<0x111, 0xf, true>(v); v += dppu<0x112, 0xf, true>(v); v += dppu<0x114, 0xf, true>(v); v += dppu<0x118, 0xf, true>(v);
    v += dppu<0x142, 0xa, false>(v); v += dppu<0x143, 0xc, false>(v);
    return v;
}
__device__ __forceinline__ unsigned rlu(unsigned v, int l) { return (unsigned)__builtin_amdgcn_readlane((int)v, l); }
__device__ __forceinline__ void radix_pick(const __attribute__((address_space(3))) unsigned* h2, int lane, unsigned want, int& T, unsigned& above, unsigned& cin) {
    asm volatile("" : "+v"(lane));
    const u32x4 hv = *(const __attribute__((address_space(3))) u32x4*)(h2 + 252 - 4 * lane);
    const unsigned cs = hv.x + hv.y + hv.z + hv.w;
    const unsigned incl = wave_iscan(cs);
    const unsigned long long m = __ballot(incl >= want);
    if (m == 0ull) { T = -1; above = rlu(incl, 63); cin = 0u; return; }
    const int Ls = __ffsll((long long)m) - 1;
    unsigned ab = rlu(incl - cs, Ls); const unsigned a0 = rlu(hv.w, Ls), a1 = rlu(hv.z, Ls), a2 = rlu(hv.y, Ls), a3 = rlu(hv.x, Ls);
    int t = 255 - 4 * Ls; unsigned c = a0;
    if (ab + a0 < want) { ab += a0; t -= 1; c = a1; if (ab + a1 < want) { ab += a1; t -= 1; c = a2; if (ab + a2 < want) { ab += a2; t -= 1; c = a3; } } }
    T = t; above = ab; cin = c;
}

#define XB_TMO      128
#define XB_XCNT(j)  (256  + 64 * (j))
#define XB_XSUB(j)  (1280 + 64 * (j))
#define XB_XGEN(j)  (2304 + 64 * (j))
#define XB_TOP      3328
#define XB_TOPGEN   3392
#define XCD_BAR_WORDS 3456
#define XB_SPIN_CAP (1u << 22)
__device__ __forceinline__ unsigned xb_ld(unsigned* p)              { return __hip_atomic_load(p, __ATOMIC_RELAXED, __HIP_MEMORY_SCOPE_AGENT); }
__device__ __forceinline__ unsigned xb_add(unsigned* p, unsigned v) { return __hip_atomic_fetch_add(p, v, __ATOMIC_RELAXED, __HIP_MEMORY_SCOPE_AGENT); }
__device__ __forceinline__ unsigned xb_xcc_id() { return (unsigned)__builtin_amdgcn_s_getreg((3 << 11) | 20) & 0xFu; }
#define XB_SPIN(cond, bar) do { unsigned _sp = 0; while (cond) { __builtin_amdgcn_s_sleep(1); \
    if ((++_sp & 255u) == 0u) { if (xb_ld(&(bar)[XB_TMO])) break; if (_sp > XB_SPIN_CAP) { atomicAdd(&(bar)[XB_TMO], 1u); break; } } } } while (0)
struct XcdBarrier { unsigned* bar; unsigned x; volatile LAS unsigned* st; };
__device__ __forceinline__ XcdBarrier xcd_barrier_post(unsigned* bar, volatile LAS unsigned* st) {
    XcdBarrier b; b.bar = bar; b.x = xb_xcc_id(); b.st = st;
    if (threadIdx.x == 0) (void)xb_add(&bar[XB_XCNT(b.x)], 1u);
    return b;
}
__device__ __forceinline__ void xcd_barrier_complete(unsigned* bar, unsigned x, unsigned& nloc, unsigned& nx) {
    const unsigned G = gridDim.x * gridDim.y * gridDim.z;
    unsigned sum, cnt, mine, sp = 0u;
    for (;;) {
        sum = 0u; cnt = 0u; mine = 0u;
#pragma unroll
        for (unsigned j = 0; j < 16; ++j) { const unsigned c = xb_ld(&bar[XB_XCNT(j)]); sum += c; cnt += (c > 0u) ? 1u : 0u; mine = (j == x) ? c : mine; }
        if (sum == G) break;
        __builtin_amdgcn_s_sleep(1);
        if ((++sp & 255u) == 0u) { if (xb_ld(&bar[XB_TMO])) break; if (sp > XB_SPIN_CAP) { atomicAdd(&bar[XB_TMO], 1u); break; } }
    }
    nloc = mine > 0u ? mine : 1u; nx = cnt > 0u ? cnt : 1u;
}
__device__ __forceinline__ void xcd_barrier(const XcdBarrier& b) {
    asm volatile("s_waitcnt vmcnt(0)" ::: "memory");
    __syncthreads();
    if (threadIdx.x == 0) {
        unsigned* bar = b.bar;
        __builtin_amdgcn_s_waitcnt(0);
        unsigned nloc = b.st[0], nx = b.st[1];
        if (nloc == 0u) { xcd_barrier_complete(bar, b.x, nloc, nx); b.st[0] = nloc; b.st[1] = nx; }
        const unsigned old = xb_add(&bar[XB_XSUB(b.x)], 1u);
        const unsigned gen = old / nloc;
        if (old + 1u == (gen + 1u) * nloc) {
            __builtin_amdgcn_fence(__ATOMIC_RELEASE, "agent");
            asm volatile("s_waitcnt vmcnt(0)" ::: "memory");
            const unsigned og = xb_add(&bar[XB_TOP], 1u);
            const unsigned tg = og / nx;
            if (og + 1u == (tg + 1u) * nx) xb_add(&bar[XB_TOPGEN], 1u);
            else XB_SPIN(xb_ld(&bar[XB_TOPGEN]) == tg, bar);
            __builtin_amdgcn_fence(__ATOMIC_ACQUIRE, "agent");
            xb_add(&bar[XB_XGEN(b.x)], 1u);
            asm volatile("s_waitcnt vmcnt(0)" ::: "memory");
        } else {
            XB_SPIN(xb_ld(&bar[XB_XGEN(b.x)]) == gen, bar);
            __builtin_amdgcn_fence(__ATOMIC_ACQUIRE, "agent");
            asm volatile("s_waitcnt vmcnt(0)" ::: "memory");
        }
    }
    __syncthreads();
}

struct Tile { const bf16_t* A; const bf16_t* B; int lda, ldb, K; void* d0; const void* s0; int ld; };
template <class F>
__device__ __forceinline__ void sgemm(const F f, int nunits) {
    const int lane = threadIdx.x & 63, wave = threadIdx.x >> 6, fr = lane & 15, fq = lane >> 4;
    for (int u = blockIdx.x * 8 + wave; u < nunits; u += gridDim.x * 8) {
        Tile tl; f.tile(u, tl);
        f32x4 acc[4][4];
#pragma unroll
        for (int m = 0; m < 4; ++m)
#pragma unroll
            for (int n = 0; n < 4; ++n) acc[m][n] = (f32x4){0.f, 0.f, 0.f, 0.f};
        const bf16_t* ap = tl.A + (size_t)fr * tl.lda + fq * 8;
        const bf16_t* bp = tl.B + (size_t)fr * tl.ldb + fq * 8;
        const int K = tl.K, lda = tl.lda, ldb = tl.ldb;
        bf16x8 a[4], b[4];
#pragma unroll
        for (int m = 0; m < 4; ++m) a[m] = *(const bf16x8*)(ap + (size_t)(m * 16) * lda);
#pragma unroll
        for (int n = 0; n < 4; ++n) b[n] = *(const bf16x8*)(bp + (size_t)(n * 16) * ldb);
#pragma unroll 1
        for (int k0 = 0; k0 < K; k0 += 32) {
            bf16x8 an[4], bn[4]; const int kn = (k0 + 32 < K) ? k0 + 32 : k0;
#pragma unroll
            for (int m = 0; m < 4; ++m) an[m] = *(const bf16x8*)(ap + (size_t)(m * 16) * lda + kn);
#pragma unroll
            for (int n = 0; n < 4; ++n) bn[n] = *(const bf16x8*)(bp + (size_t)(n * 16) * ldb + kn);
#pragma unroll
            for (int m = 0; m < 4; ++m)
#pragma unroll
                for (int n = 0; n < 4; ++n) acc[m][n] = __builtin_amdgcn_mfma_f32_16x16x32_bf16(b[n], a[m], acc[m][n], 0, 0, 0);
#pragma unroll
            for (int m = 0; m < 4; ++m) { a[m] = an[m]; b[m] = bn[m]; }
        }
#pragma unroll
        for (int m = 0; m < 4; ++m) {
            asm volatile("" ::: "memory");
#pragma unroll
            for (int n = 0; n < 4; ++n) f.out4(tl, m * 16 + fr, n * 16 + 4 * fq, acc[m][n]);
        }
    }
}
__device__ __forceinline__ void store4_bf16(const Tile& tl, int r, int c, const f32x4 v) {
    u32x2 w; w.x = pk2(v[0], v[1]); w.y = pk2(v[2], v[3]); *(u32x2*)((bf16_t*)tl.d0 + (size_t)r * tl.ld + c) = w; }

struct GWP {
    const bf16_t* WPT; const bf16_t* WUB; bf16_t* W0T;
    __device__ __forceinline__ void tile(int u, Tile& tl) const {
        const int kt = u & 15, dt = (u >> 4) & 3, g = u >> 6; tl.A = WPT + (size_t)(g * 256 + dt * 64) * 256; tl.lda = 256; tl.B = WUB + (size_t)kt * 64 * 1024 + g * 256; tl.ldb = 1024; tl.K = 256;
        tl.d0 = W0T + (size_t)(5120 + g * 256 + dt * 64) * 1024 + kt * 64; tl.ld = 1024; }
    __device__ __forceinline__ void out4(const Tile& tl, int r, int c, const f32x4 v) const { store4_bf16(tl, r, c, v); }
};
struct GQP {
    const bf16_t* Qn; const bf16_t* W; bf16_t* QP;
    __device__ __forceinline__ void tile(int u, Tile& tl) const {
        const int nt = u & 3, head = (u >> 2) & 15, mt = u >> 6; tl.A = Qn + (size_t)mt * 64 * 1024 + head * 64; tl.lda = 1024; tl.B = W + (size_t)(head * 256 + nt * 64) * 64; tl.ldb = 64; tl.K = 64;
        tl.d0 = QP + ((size_t)mt * 64 * 16 + head) * 256 + nt * 64; tl.ld = 4096; }
    __device__ __forceinline__ void out4(const Tile& tl, int r, int c, const f32x4 v) const { store4_bf16(tl, r, c, v); }
};
struct GOP {
    const bf16_t* OP; const bf16_t* W; const bf16_t* Z; bf16_t* G;
    __device__ __forceinline__ void tile(int u, Tile& tl) const {
        const int head = u & 15, mt = u >> 4; tl.A = OP + (size_t)mt * 64 * 4096 + head * 256; tl.lda = 4096; tl.B = W + (size_t)head * 64 * 256; tl.ldb = 256; tl.K = 256;
        const size_t o = (size_t)mt * 64 * 1024 + head * 64; tl.d0 = G + o; tl.s0 = Z + o; tl.ld = 1024; }
    __device__ __forceinline__ void out4(const Tile& tl, int r, int c, const f32x4 v) const { const size_t i = (size_t)r * 1024 + c; const u32x2 z = *(const u32x2*)((const bf16_t*)tl.s0 + i);
        u32x2 w; w.x = pk2(v[0] * bflo(z.x), v[1] * bfhi(z.x)); w.y = pk2(v[2] * bflo(z.y), v[3] * bfhi(z.y)); *(u32x2*)((bf16_t*)tl.d0 + i) = w; }
};

namespace pg8 {
constexpr int BM = 256, BK = 64, HALF = 128, HTB = HALF * BK * 2, STAGE_BYTES = 8 * HTB, NXCD = 8, WGM = 8;
__device__ __forceinline__ int lds_byte(int r, int c) { return (r >> 3) * 1024 + (r & 7) * 128 + ((((c >> 3) ^ (r >> 1)) & 7) << 4) + (c & 7) * 2; }
__device__ __forceinline__ void stage_rc(int b, int& R, int& C) { const int st = b / 1024, sb = b % 1024; R = st * 8 + (sb >> 7); C = ((((sb >> 4) & 7) ^ (R >> 1)) & 7) * 8; }
__device__ __forceinline__ int perm32(int rho) { const int n = rho >> 4, i = rho & 15; return 8 * (i >> 2) + 4 * n + (i & 3); }
struct Unit { int pm, pn; };
struct Gemm { const bf16_t* A; int lda; const bf16_t* Bt; int ldb; int M, N, K; size_t apn; };
struct StaticOrder {
    int nM, nN, nwg, G, c;
    __device__ void init(int M, int N, int G_, int c_) { nM = M / BM; nN = N / BM; nwg = nM * nN; G = G_; c = c_; }
    __device__ bool next(int i, Unit& u) const {
        const long L = (long)i * G + c; if (L >= nwg) return false;
        int wgid = (int)L; { const int q = nwg / NXCD, r = nwg % NXCD, xcd = wgid % NXCD, off = wgid / NXCD; wgid = (xcd < r ? xcd * (q + 1) : r * (q + 1) + (xcd - r) * q) + off; }
        const int nig = WGM * nN, gid = wgid / nig, fm = gid * WGM, gsz = (nM - fm) < WGM ? (nM - fm) : WGM;
        u.pm = fm + ((wgid % nig) % gsz); u.pn = (wgid % nig) / gsz; return true;
    }
};
__device__ __forceinline__ unsigned cvt_pk_bf16(float lo, float hi) { unsigned r; asm volatile("v_cvt_pk_bf16_f32 %0, %1, %2" : "=v"(r) : "v"(lo), "v"(hi)); return r; }

struct Dst { unsigned char* base; const float* res; int ld, mode, ncol; float scale; unsigned char* aux; float* rsq; };
template <class DescF> struct EpiGen {
    static constexpr bool PERM = true;
    DescF D;
    __device__ __forceinline__ void operator()(const f32x4 (&acc)[2][2][4][2], const Unit& u, int wr, int wc, int fr, int fq) const {
        Dst d; D.get(u, d);
        if ((DescF::MODES & 16) && d.mode == 4) return;
        const int r0 = wr * 64 + fr, c0 = wc * 32 + 8 * fq;
        if constexpr ((DescF::MODES & 64) != 0) {
#pragma unroll
            for (int ai = 0; ai < 2; ++ai)
#pragma unroll
                for (int m = 0; m < 4; ++m) {
                    float ss = 0.f;
#pragma unroll
                    for (int bj = 0; bj < 2; ++bj)
#pragma unroll
                        for (int n = 0; n < 2; ++n) { const f32x4 v = acc[ai][bj][m][n]; ss += v[0] * v[0] + v[1] * v[1] + v[2] * v[2] + v[3] * v[3]; }
                    ss += __shfl_xor(ss, 16); ss += __shfl_xor(ss, 32);
                    if (fq == 0) ((bf16_t*)d.base)[(size_t)(ai * HALF + r0 + m * 16) * d.ld + wc] = f2bf(rsqrtf(ss * (1.0f / 64.0f) + EPS) * 1.4426950408889634f);
                }
            return;
        } else {
        float rsd[2][4];
        if constexpr ((DescF::MODES & 1024) != 0) {
#pragma unroll
            for (int ai = 0; ai < 2; ++ai)
#pragma unroll
                for (int m = 0; m < 4; ++m) { const size_t grow = (size_t)u.pm * BM + ai * HALF + r0 + m * 16; const f32x4 pp = *(const f32x4*)(d.rsq + grow * 16 + fq * 4);
                    float t = (pp[0] + pp[1]) + (pp[2] + pp[3]); t += __shfl_xor(t, 16); t += __shfl_xor(t, 32); rsd[ai][m] = rsqrtf(t * (1.0f / 1024.0f) + EPS); }
        }
        f32x4 gq[2][2];
        if constexpr ((DescF::MODES & 2048) != 0) { if (d.mode == 10) {
#pragma unroll
            for (int bj = 0; bj < 2; ++bj) { gq[bj][0] = *(const f32x4*)(d.res + 32 * bj + 8 * fq); gq[bj][1] = *(const f32x4*)(d.res + 32 * bj + 8 * fq + 4); } } }
#pragma unroll
        for (int ai = 0; ai < 2; ++ai)
#pragma unroll
            for (int m = 0; m < 4; ++m) {
                const size_t rowoff = (size_t)(ai * HALF + r0 + m * 16) * d.ld;
                if constexpr ((DescF::MODES & 2048) != 0) { if (d.mode == 10) {
                    f32x4 q[2][2]; float ss = 0.f;
#pragma unroll
                    for (int bj = 0; bj < 2; ++bj)
#pragma unroll
                        for (int n = 0; n < 2; ++n) { q[bj][n] = acc[ai][bj][m][n] * rsd[ai][m]; ss += q[bj][n][0] * q[bj][n][0] + q[bj][n][1] * q[bj][n][1] + q[bj][n][2] * q[bj][n][2] + q[bj][n][3] * q[bj][n][3]; }
                    ss += __shfl_xor(ss, 16); ss += __shfl_xor(ss, 32);
                    const float rh = rsqrtf(ss * (1.0f / 64.0f) + EPS);
#pragma unroll
                    for (int bj = 0; bj < 2; ++bj) { const f32x4 x0 = q[bj][0] * rh * gq[bj][0], x1 = q[bj][1] * rh * gq[bj][1];
                        u32x4 w; w.x = cvt_pk_bf16(x0[0], x0[1]); w.y = cvt_pk_bf16(x0[2], x0[3]); w.z = cvt_pk_bf16(x1[0], x1[1]); w.w = cvt_pk_bf16(x1[2], x1[3]);
                        *(u32x4*)((bf16_t*)d.base + rowoff + (4 * (u.pn & 3) + wc) * 64 + 32 * bj + 8 * fq) = w; }
                    continue; } }
                float ssq = 0.f;
#pragma unroll
                for (int bj = 0; bj < 2; ++bj) {
                    const int col = bj * HALF + c0; f32x4 v0 = acc[ai][bj][m][0], v1 = acc[ai][bj][m][1];
                    if constexpr ((DescF::MODES & 1024) != 0) { v0 *= rsd[ai][m]; v1 *= rsd[ai][m]; }
                    if ((DescF::MODES & 7) && d.mode <= 2) {
                        if ((DescF::MODES & 2) && d.mode == 1) {
#pragma unroll
                            for (int j = 0; j < 4; ++j) { v0[j] = sigmoidf_(v0[j]); v1[j] = sigmoidf_(v1[j]); } }
                        if ((DescF::MODES & 4) && d.mode == 2) {
#pragma unroll
                            for (int j = 0; j < 4; ++j) { v0[j] = siluf_(v0[j]); v1[j] = siluf_(v1[j]); } }
                        u32x4 w; w.x = cvt_pk_bf16(v0[0], v0[1]); w.y = cvt_pk_bf16(v0[2], v0[3]); w.z = cvt_pk_bf16(v1[0], v1[1]); w.w = cvt_pk_bf16(v1[2], v1[3]);
                        *(u32x4*)((bf16_t*)d.base + rowoff + col) = w;
                    } else if ((DescF::MODES & 256) && d.mode == 8) {
                        const u32x4 z = *(const u32x4*)((const bf16_t*)d.res + rowoff + col);
                        u32x4 w; w.x = cvt_pk_bf16(v0[0] * bflo(z.x), v0[1] * bfhi(z.x)); w.y = cvt_pk_bf16(v0[2] * bflo(z.y), v0[3] * bfhi(z.y));
                        w.z = cvt_pk_bf16(v1[0] * bflo(z.z), v1[1] * bfhi(z.z)); w.w = cvt_pk_bf16(v1[2] * bflo(z.w), v1[3] * bfhi(z.w));
                        *(u32x4*)((bf16_t*)d.base + rowoff + col) = w;
                    } else if ((DescF::MODES & 8) && d.mode == 3) {
                        if (col < d.ncol) { float* o = (float*)d.base + rowoff + col; *(f32x4*)o = v0 * d.scale; *(f32x4*)(o + 4) = v1 * d.scale; }
                    } else if ((DescF::MODES & 128) && d.mode == 7) {
                        typedef _Float16 h8 __attribute__((ext_vector_type(8)));
                        if (col < d.ncol) {
                        h8 hv; hv[0] = (_Float16)(v0[0] * d.scale); hv[1] = (_Float16)(v0[1] * d.scale); hv[2] = (_Float16)(v0[2] * d.scale); hv[3] = (_Float16)(v0[3] * d.scale);
                        hv[4] = (_Float16)(v1[0] * d.scale); hv[5] = (_Float16)(v1[1] * d.scale); hv[6] = (_Float16)(v1[2] * d.scale); hv[7] = (_Float16)(v1[3] * d.scale);
                        *(h8*)((_Float16*)d.base + rowoff + col) = hv; }
                        if constexpr ((DescF::MODES & 4096) != 0) { if (col == 64 && d.ncol == 64) *(f32x4*)((float*)d.aux + ((size_t)u.pm * BM + ai * HALF + r0 + m * 16) * 4) = v0 * 0.5f; }
                    } else if constexpr ((DescF::MODES & 32) != 0) {
                        float* o = (float*)d.base + rowoff + col; const float* rs = d.res + rowoff + col;
                        const f32x4 a = *(const f32x4*)rs + v0, b = *(const f32x4*)(rs + 4) + v1; *(f32x4*)o = a; *(f32x4*)(o + 4) = b;
                        if constexpr ((DescF::MODES & 512) != 0) {
                            u32x4 w; w.x = cvt_pk_bf16(a[0], a[1]); w.y = cvt_pk_bf16(a[2], a[3]); w.z = cvt_pk_bf16(b[0], b[1]); w.w = cvt_pk_bf16(b[2], b[3]);
                            *(u32x4*)((bf16_t*)d.aux + rowoff + col) = w;
                            ssq += (a[0] * a[0] + a[1] * a[1]) + (a[2] * a[2] + a[3] * a[3]) + (b[0] * b[0] + b[1] * b[1]) + (b[2] * b[2] + b[3] * b[3]); }
                    }
                }
                if constexpr ((DescF::MODES & 512) != 0) { ssq += __shfl_xor(ssq, 16); ssq += __shfl_xor(ssq, 32);
                    if (fq == 0) d.rsq[((size_t)u.pm * BM + ai * HALF + r0 + m * 16) * 16 + 4 * u.pn + wc] = ssq; }
                if (m & 1) asm volatile("" ::: "memory");
            }
        }
    }
};

template <class Epi>
__device__ __forceinline__ void gemm_phase(LAS unsigned char* lds, const Gemm g, const StaticOrder& S, const Epi& E) {
    const int tid = threadIdx.x, wid = __builtin_amdgcn_readfirstlane(tid >> 6), lane = tid & 63, wr = wid >> 2, wc = wid & 3, fr = lane & 15, fq = lane >> 4;
    int K = g.K; asm volatile("" : "+s"(K));
    const int nt = K / BK;
    unsigned voffA[2], voffB[2];
#pragma unroll
    for (int i = 0; i < 2; ++i) { int R, C; stage_rc(tid * 16 + i * 8192, R, C); const int Rb = Epi::PERM ? ((R & ~31) + perm32(R & 31)) : R;
        voffA[i] = (unsigned)(R * g.lda + C) * 2u; voffB[i] = (unsigned)(Rb * g.ldb + C) * 2u; }
    const size_t kstep = (size_t)(BK * 2);
    const size_t hstepA = (size_t)HALF * g.lda * 2, hstepB = (size_t)HALF * g.ldb * 2;
    const size_t tstepA = 2 * hstepA, tstepB = 2 * hstepB;
    const unsigned ldsw = (unsigned)wid * 1024u;
    const int aoff = lds_byte(wr * 64 + fr, fq * 8), boff = lds_byte(wc * 32 + fr, fq * 8), aoff1 = aoff ^ 64, boff1 = boff ^ 64;
#define PG8_SA(b, h) (((b) * 2 + (h)) * HTB)
#define PG8_SB(b, h) ((4 + (b) * 2 + (h)) * HTB)
#define PG8_STAGE(bufoff, gbase, voff) do { _Pragma("unroll") for (int _i = 0; _i < 2; ++_i) \
        __builtin_amdgcn_global_load_lds((const unsigned*)((const char*)(gbase) + (voff)[_i]), (LAS unsigned*)(lds + (bufoff) + ldsw + _i * 8192), 16, 0, 0); } while (0)
#define PG8_LDA(dst, b, h) do { _Pragma("unroll") for (int m = 0; m < 4; ++m) _Pragma("unroll") for (int k = 0; k < 2; ++k) dst[m][k] = *(const LAS bf16x8*)(lds + PG8_SA(b, h) + (k ? aoff1 : aoff) + m * 2048); } while (0)
#define PG8_LDB(dst, b, h) do { _Pragma("unroll") for (int n = 0; n < 2; ++n) _Pragma("unroll") for (int k = 0; k < 2; ++k) dst[n][k] = *(const LAS bf16x8*)(lds + PG8_SB(b, h) + (k ? boff1 : boff) + n * 2048); } while (0)
#define PG8_MMA(ai, bj, At, Bt) do { __builtin_amdgcn_s_setprio(1); _Pragma("unroll") for (int m = 0; m < 4; ++m) _Pragma("unroll") for (int n = 0; n < 2; ++n) _Pragma("unroll") for (int k = 0; k < 2; ++k) \
        acc[ai][bj][m][n] = __builtin_amdgcn_mfma_f32_16x16x32_bf16(Bt[n][k], At[m][k], acc[ai][bj][m][n], 0, 0, 0); __builtin_amdgcn_s_setprio(0); } while (0)
#define PG8_WAIT_V(n) asm volatile("s_waitcnt vmcnt(" #n ")" ::: "memory")
#define PG8_WAIT_L(n) asm volatile("s_waitcnt lgkmcnt(" #n ")" ::: "memory")
#define PG8_BAR __builtin_amdgcn_s_barrier()
#define PG8_SCHED __builtin_amdgcn_sched_barrier(0)
    Unit cur, nxt; int ui = 0;
    if (!S.next(0, cur)) return;
    f32x4 acc[2][2][4][2];
#pragma unroll
    for (int a = 0; a < 2; ++a)
#pragma unroll
        for (int b = 0; b < 2; ++b)
#pragma unroll
            for (int m = 0; m < 4; ++m)
#pragma unroll
                for (int n = 0; n < 2; ++n) acc[a][b][m][n] = (f32x4){0.f, 0.f, 0.f, 0.f};
    bf16x8 At[4][2], B0[2][2], B1[2][2];
    const char* cA = (const char*)g.A + (size_t)cur.pm * tstepA + (size_t)cur.pn * g.apn; const char* cB = (const char*)g.Bt + (size_t)cur.pn * tstepB;
    PG8_STAGE(PG8_SB(0, 0), cB, voffB); PG8_STAGE(PG8_SA(0, 0), cA, voffA); PG8_STAGE(PG8_SB(0, 1), cB + hstepB, voffB); PG8_STAGE(PG8_SA(0, 1), cA + hstepA, voffA);
    if (wr == 1) PG8_BAR;
    PG8_WAIT_V(4); PG8_BAR;
    PG8_STAGE(PG8_SB(1, 0), cB + kstep, voffB); PG8_STAGE(PG8_SA(1, 0), cA + kstep, voffA); PG8_STAGE(PG8_SB(1, 1), cB + hstepB + kstep, voffB);
    PG8_WAIT_V(6); PG8_BAR;
    for (;;) {
        const bool has_next = S.next(ui + 1, nxt);
        const char* nA = has_next ? (const char*)g.A + (size_t)nxt.pm * tstepA + (size_t)nxt.pn * g.apn : cA; const char* nB = has_next ? (const char*)g.Bt + (size_t)nxt.pn * tstepB : cB;
#pragma unroll 1
        for (int t = 0; t < nt; t += 2) {
            const bool last = (t == nt - 2);
            const char* a1 = cA + (size_t)(t + 1) * kstep;
            const char* a2 = last ? nA : cA + (size_t)(t + 2) * kstep; const char* b2 = last ? nB : cB + (size_t)(t + 2) * kstep;
            const char* a3 = a2 + kstep; const char* b3 = b2 + kstep;
            PG8_LDB(B0, 0, 0); PG8_SCHED; PG8_LDA(At, 0, 0); PG8_STAGE(PG8_SA(1, 1), a1 + hstepA, voffA);
            PG8_WAIT_L(8); PG8_BAR; PG8_WAIT_L(0); PG8_MMA(0, 0, At, B0); PG8_BAR; PG8_SCHED;
            PG8_LDB(B1, 0, 1); PG8_STAGE(PG8_SB(0, 0), b2, voffB);
            PG8_BAR; PG8_WAIT_L(0); PG8_MMA(0, 1, At, B1); PG8_BAR;
            PG8_LDA(At, 0, 1); PG8_STAGE(PG8_SA(0, 0), a2, voffA);
            PG8_BAR; PG8_WAIT_L(0); PG8_MMA(1, 0, At, B0); PG8_BAR; PG8_SCHED;
            PG8_STAGE(PG8_SB(0, 1), b2 + hstepB, voffB);
            PG8_WAIT_V(6); PG8_BAR; PG8_MMA(1, 1, At, B1); PG8_BAR;
            PG8_LDB(B0, 1, 0); PG8_SCHED; PG8_LDA(At, 1, 0); PG8_STAGE(PG8_SA(0, 1), a2 + hstepA, voffA);
            PG8_WAIT_L(8); PG8_BAR; PG8_WAIT_L(0); PG8_MMA(0, 0, At, B0); PG8_BAR; PG8_SCHED;
            PG8_LDB(B1, 1, 1); PG8_STAGE(PG8_SB(1, 0), b3, voffB);
            PG8_BAR; PG8_WAIT_L(0); PG8_MMA(0, 1, At, B1); PG8_BAR;
            PG8_LDA(At, 1, 1); PG8_STAGE(PG8_SA(1, 0), a3, voffA);
            PG8_BAR; PG8_WAIT_L(0); PG8_MMA(1, 0, At, B0); PG8_BAR; PG8_SCHED;
            PG8_STAGE(PG8_SB(1, 1), b3 + hstepB, voffB);
            PG8_WAIT_V(6); PG8_BAR; PG8_MMA(1, 1, At, B1); PG8_BAR;
        }
        E(acc, cur, wr, wc, fr, fq);
        if (!has_next) break;
#pragma unroll
        for (int a = 0; a < 2; ++a)
#pragma unroll
            for (int b = 0; b < 2; ++b)
#pragma unroll
                for (int m = 0; m < 4; ++m)
#pragma unroll
                    for (int n = 0; n < 2; ++n) acc[a][b][m][n] = (f32x4){0.f, 0.f, 0.f, 0.f};
        cur = nxt; cA = nA; cB = nB; ++ui;
    }
    PG8_WAIT_V(0);
    if (wr == 0) PG8_BAR;
    PG8_BAR;
#undef PG8_SA
#undef PG8_SB
#undef PG8_STAGE
#undef PG8_LDA
#undef PG8_LDB
#undef PG8_MMA
#undef PG8_WAIT_V
#undef PG8_WAIT_L
#undef PG8_BAR
#undef PG8_SCHED
}
}

struct D1 { static constexpr int MODES = 1; unsigned char* ws;
    __device__ __forceinline__ void get(const pg8::Unit& u, pg8::Dst& d) const { const int sec = u.pn >> 2;
        d.base = ws + OFF_QB + (size_t)sec * (64 * MB) + ((size_t)u.pm * 256 * 1024 + (u.pn & 3) * 256) * 2; d.res = nullptr; d.ld = 1024; d.mode = 0; d.ncol = 256; d.scale = 1.f; } };
struct D2 { static constexpr int MODES = 7; unsigned char* ws;
    __device__ __forceinline__ void get(const pg8::Unit& u, pg8::Dst& d) const { const int sec = u.pn >> 2, cc = (u.pn & 3) * 256; d.res = nullptr; d.ncol = 256; d.scale = 1.f;
        if (sec < 3) { d.base = ws + OFF_QB + (size_t)sec * (64 * MB) + ((size_t)u.pm * 256 * 1024 + cc) * 2; d.ld = 1024; d.mode = sec == 0 ? 1 : (sec == 1 ? 2 : 0); }
        else { d.base = ws + OFF_Y + ((size_t)u.pm * 256 * 2048 + 1024 + cc) * 2; d.ld = 2048; d.mode = 2; } } };
struct D4 { static constexpr int MODES = 32 | 512; unsigned char* out; const float* x; unsigned char* ws;
    __device__ __forceinline__ void get(const pg8::Unit& u, pg8::Dst& d) const { const size_t o = (size_t)u.pm * 256 * 1024 + u.pn * 256;
        d.base = out + o * 4; d.res = x + o; d.ld = 1024; d.mode = 5; d.ncol = 256; d.scale = 1.f; d.aux = ws + OFF_XN + o * 2; d.rsq = (float*)(ws + OFF_RSQ); } };
struct D5 { static constexpr int MODES = 133 | 1024 | 2048 | 4096; unsigned char* ws; const float* g_q;
    __device__ __forceinline__ void get(const pg8::Unit& u, pg8::Dst& d) const { const int pn = u.pn; d.res = nullptr; d.ncol = 256; d.scale = 1.f; d.rsq = (float*)(ws + OFF_RSQ); d.aux = ws + OFF_WI;
        if (pn < 4) { d.base = ws + OFF_TMP + (size_t)u.pm * 256 * 1024 * 2; d.res = g_q; d.ld = 1024; d.mode = 10; }
        else if (pn == 4) { d.base = ws + OFF_CKVN + (size_t)u.pm * 256 * 256 * 2; d.ld = 256; d.mode = 0; }
        else if (pn == 5) { d.base = ws + OFF_QI + (size_t)u.pm * 256 * 256 * 2; d.ld = 256; d.mode = 7; d.scale = 0.125f; }
        else if (pn == 6) { d.base = ws + OFF_KI + (size_t)u.pm * 256 * 64 * 2; d.ld = 64; d.mode = 7; d.ncol = 64; }
        else { d.base = ws + OFF_Z + ((size_t)u.pm * 256 * 1024 + (pn - 7) * 256) * 2; d.ld = 1024; d.mode = 2; } } };
struct DK { static constexpr int MODES = 64; unsigned char* ws;
    __device__ __forceinline__ void get(const pg8::Unit& u, pg8::Dst& d) const {
        d.base = ws + OFF_RK + ((size_t)u.pm * 256 * 16 + u.pn * 4) * 2; d.res = nullptr; d.ld = 16; d.mode = 6; d.ncol = 256; d.scale = 1.f; } };
struct D8 { static constexpr int MODES = 32; unsigned char* out;
    __device__ __forceinline__ void get(const pg8::Unit& u, pg8::Dst& d) const { const size_t o = (size_t)u.pm * 256 * 1024 + u.pn * 256;
        d.base = out + o * 4; d.res = (const float*)out + o; d.ld = 1024; d.mode = 5; d.ncol = 256; d.scale = 1.f; } };
struct DQ { static constexpr int MODES = 1; unsigned char* ws;
    __device__ __forceinline__ void get(const pg8::Unit& u, pg8::Dst& d) const {
        d.base = ws + OFF_QP + ((size_t)u.pm * 256 * 4096 + u.pn * 256) * 2; d.res = nullptr; d.ld = 4096; d.mode = 0; d.ncol = 256; d.scale = 1.f; } };
struct DO { static constexpr int MODES = 256; unsigned char* ws;
    __device__ __forceinline__ void get(const pg8::Unit& u, pg8::Dst& d) const { const size_t o = ((size_t)u.pm * 256 * 1024 + u.pn * 256) * 2;
        d.base = ws + OFF_TMP + o; d.res = (const float*)(ws + OFF_Z + o); d.ld = 1024; d.mode = 8; d.ncol = 256; d.scale = 1.f; } };
template <class DF>
__device__ __forceinline__ void fast_gemm(unsigned char* lds, const bf16_t* A, int lda, const bf16_t* Bt, int ldb, int N, int K, const DF& df, size_t apn = 0) {
    pg8::Gemm g{A, lda, Bt, ldb, T, N, K, apn}; pg8::StaticOrder S; S.init(T, N, (int)gridDim.x, (int)blockIdx.x);
    pg8::EpiGen<DF> E{df};
    pg8::gemm_phase(( LAS unsigned char*)lds, g, S, E);
}

template <bool QPERM = false>
__device__ __forceinline__ void tconv(const float* __restrict__ src, int ld, int col0, int ncols, int K, bf16_t* __restrict__ dst, float* tile  , const float* __restrict__ kscale = nullptr) {
    const int nkt = K / 64, ntiles = nkt * (ncols / 64), tid = threadIdx.x;
    const bool vec = ((col0 | ld) & 3) == 0;
    const int lk = tid >> 4, ln = (tid & 15) * 4;
    const int sn = tid >> 3, sk = (tid & 7) * 8;
    for (int id0 = blockIdx.x * 2; id0 < ntiles; id0 += gridDim.x * 2) {
        f32x4 v[2][2];
#pragma unroll
        for (int u = 0; u < 2; ++u) { const int id = id0 + u; if (id < ntiles) { const int kt = id % nkt, nt = id / nkt;
#pragma unroll
            for (int h = 0; h < 2; ++h) { const float* sp = src + (size_t)(kt * 64 + lk + 32 * h) * ld + col0 + nt * 64 + ln;
                if (vec) v[u][h] = *(const f32x4*)sp; else { v[u][h][0] = sp[0]; v[u][h][1] = sp[1]; v[u][h][2] = sp[2]; v[u][h][3] = sp[3]; }
                if (kscale) v[u][h] *= kscale[kt * 64 + lk + 32 * h]; } } }
#pragma unroll
        for (int u = 0; u < 2; ++u) { if (id0 + u < ntiles) {
#pragma unroll
            for (int h = 0; h < 2; ++h) { const int k = lk + 32 * h; *(f32x4*)(tile + u * 4352 + k * 68 + (ln ^ (k & 56))) = v[u][h]; } } }
        __syncthreads();
#pragma unroll
        for (int u = 0; u < 2; ++u) { const int id = id0 + u; if (id < ntiles) { const int kt = id % nkt, nt = id / nkt;
            const float* tp = tile + u * 4352 + sk * 68 + (sn ^ sk);
            u32x4 o; o.x = pk2(tp[0], tp[68]); o.y = pk2(tp[136], tp[204]); o.z = pk2(tp[272], tp[340]); o.w = pk2(tp[408], tp[476]);
            int nrow = nt * 64 + sn; if (QPERM) { const int hq = nrow >> 6, dq = nrow & 63; nrow = (hq >> 2) * 256 + 128 * (dq >> 5) + 32 * (hq & 3) + (dq & 31); }
            *(u32x4*)(dst + (size_t)nrow * K + kt * 64 + sk) = o; } }
        __syncthreads();
    }
}
template <int NE>
__device__ __forceinline__ void rmsnorm_rows(const float* __restrict__ src, const float* __restrict__ g, bf16_t* __restrict__ dst,
                             const float* __restrict__ Wx, int ldw, int col0, const float* __restrict__ bias, float scale, float* __restrict__ dstx, float* wl) {
    const int lane = threadIdx.x & 63, wave = threadIdx.x >> 6;
    __syncthreads();
    for (int i = threadIdx.x; i < NE * 1024; i += 512) { const int k = i / NE, e = i % NE; wl[e * 1024 + k] = Wx[(size_t)k * ldw + col0 + e]; }
    __syncthreads();
    for (int row0 = (blockIdx.x * 8 + wave) * 2; row0 < T; row0 += gridDim.x * 16) {
        f32x4 v[2][4];
#pragma unroll
        for (int r = 0; r < 2; ++r)
#pragma unroll
            for (int i = 0; i < 4; ++i) v[r][i] = *(const f32x4*)(src + (size_t)(row0 + r) * 1024 + i * 256 + lane * 4);
#pragma unroll
        for (int r = 0; r < 2; ++r) {
            const int row = row0 + r; float ss = 0.f;
#pragma unroll
            for (int i = 0; i < 4; ++i) ss += v[r][i][0] * v[r][i][0] + v[r][i][1] * v[r][i][1] + v[r][i][2] * v[r][i][2] + v[r][i][3] * v[r][i][3];
            ss = wave_sum(ss);
            const float rstd = rsqrtf(ss * (1.0f / 1024.0f) + EPS);
            float ex[NE];
#pragma unroll
            for (int e = 0; e < NE; ++e) ex[e] = 0.f;
#pragma unroll
            for (int i = 0; i < 4; ++i) {
                const f32x4 gg = *(const f32x4*)(g + i * 256 + lane * 4);
                f32x4 y; y[0] = v[r][i][0] * rstd * gg[0]; y[1] = v[r][i][1] * rstd * gg[1]; y[2] = v[r][i][2] * rstd * gg[2]; y[3] = v[r][i][3] * rstd * gg[3];
                u32x2 w; w.x = pk2(y[0], y[1]); w.y = pk2(y[2], y[3]);
                *(u32x2*)(dst + (size_t)row * 1024 + i * 256 + lane * 4) = w;
#pragma unroll
                for (int e = 0; e < NE; ++e) { const f32x4 wv = *(const f32x4*)(wl + e * 1024 + i * 256 + lane * 4); ex[e] += y[0] * wv[0] + y[1] * wv[1] + y[2] * wv[2] + y[3] * wv[3]; }
            }
#pragma unroll
            for (int e = 0; e < NE; ++e) { const float sx = wave_sum(ex[e]); if (lane == 0) dstx[(size_t)row * NE + e] = (sx + (bias ? bias[e] : 0.f)) * scale; }
        }
    }
}

__device__ __forceinline__ void phase_prep(const P& p, unsigned char* lds) {
    float* tile = (float*)lds; unsigned char* ws = p.ws;
    bf16_t* W0T = (bf16_t*)(ws + OFF_W0T);
    tconv(p.e_w_in, EIN, 0, 5120, 1024, W0T, tile);
    tconv(p.e_w_in, EIN, 6152, 1024, 1024, W0T + (size_t)6144 * 1024, tile);
    for (int g = 0; g < 4; ++g) tconv(p.e_w_pool + (size_t)g * 65536, 256, 0, 256, 256, (bf16_t*)(ws + OFF_WPT) + (size_t)g * 65536, tile);
    { bf16_t* WUB = (bf16_t*)(ws + OFF_WUB);
      for (size_t i = (size_t)blockIdx.x * 512 + threadIdx.x; i < (size_t)1024 * 256; i += (size_t)gridDim.x * 512) {
          const size_t k = i >> 8; const int c4 = (int)(i & 255) * 4; const f32x4 v = *(const f32x4*)(p.e_w_in + k * EIN + 5128 + c4);
          u32x2 o; o.x = pk2(v[0], v[1]); o.y = pk2(v[2], v[3]); *(u32x2*)(WUB + k * 1024 + c4) = o; } }
    tconv(p.e_w_out, 1024, 0, 1024, 2048, (bf16_t*)(ws + OFF_WO0T), tile);
    bf16_t* W1T = (bf16_t*)(ws + OFF_W1T);
    tconv<true>(p.o_w_in, OIN, 0, 1024, 1024, W1T, tile, p.o_norm);
    tconv(p.o_w_in, OIN, 1024, 576, 1024, W1T + (size_t)1024 * 1024, tile, p.o_norm);
    for (size_t i = (size_t)blockIdx.x * 512 + threadIdx.x; i < (size_t)192 * 1024; i += (size_t)gridDim.x * 512) { const int e = (int)(i >> 10), k = (int)(i & 1023);
        W1T[(size_t)1600 * 1024 + i] = e < 4 ? f2bf(p.o_w_in[(size_t)k * OIN + 1600 + e] * p.o_norm[k]) : (bf16_t)0; }
    tconv(p.o_w_in, OIN, 1604, 1024, 1024, W1T + (size_t)1792 * 1024, tile, p.o_norm);
    {
        bf16_t* WUKP = (bf16_t*)(ws + OFF_WUKP); bf16_t* WQF = (bf16_t*)(ws + OFF_WQF); bf16_t* WBD = (bf16_t*)(ws + OFF_WBD);
        for (size_t i = (size_t)blockIdx.x * 512 + threadIdx.x; i < (size_t)1024 * 256; i += (size_t)gridDim.x * 512) {
            { const int n = (int)(i >> 8), k = (int)(i & 255), pn = n >> 8, rem = n & 255, bj = rem >> 7, wc = (rem >> 5) & 3, x = rem & 31;
              WUKP[i] = f2bf(p.o_w_uk[(size_t)k * 1024 + (4 * pn + wc) * 64 + 32 * bj + x]); }
            { const int d = (int)(i & 63), r = (int)((i >> 6) & 255), h = (int)(i >> 14); const size_t o = ((size_t)h * 256 + r) * 128 + d;
              WQF[o] = f2bf(p.o_w_uk[(size_t)r * 1024 + h * 64 + d] * p.o_g_k[d] * 0.125f); WQF[o + 64] = 0; }
            { const int r = (int)(i & 255), n = (int)(i >> 8), hl = (n >> 6) & 3; const float v = p.o_w_uv[(size_t)r * 1024 + n];
#pragma unroll
              for (int b = 0; b < 4; ++b) WBD[(size_t)n * 1024 + b * 256 + r] = (b == hl) ? f2bf(v) : (bf16_t)0; }
        }
    }
    tconv(p.o_w_out, 1024, 0, 1024, 1024, (bf16_t*)(ws + OFF_WO1T), tile);
    rmsnorm_rows<8>(p.x, p.e_norm, (bf16_t*)(ws + OFF_XN), p.e_w_in, EIN, 5120, p.e_b_if, 1.0f, (float*)(ws + OFF_GATES), (float*)lds);
}

__device__ __forceinline__ void phase_conv_scan(const P& p, unsigned char* lds) {
    unsigned char* ws = p.ws; const int tid = threadIdx.x;
    const float* GATES = (const float*)(ws + OFF_GATES);
    float *BQ = (float*)(ws + OFF_BQ), *IQ = (float*)(ws + OFF_IQ), *MT = (float*)(ws + OFF_MT), *CH = (float*)(ws + OFF_CH);
    {
        const int lane = tid & 63, wave = tid >> 6;
        for (int task = blockIdx.x * 8 + wave; task < 2048; task += gridDim.x * 8) {
            const int bh = task >> 8, c = task & 255, batch = bh >> 2, head = bh & 3; const size_t t = (size_t)batch * SEQ + c * 64 + lane;
            const float ig = GATES[t * 8 + head], f = GATES[t * 8 + 4 + head];
            float b = fminf(f, 0.f) - log1pf(__expf(-fabsf(f)));
#pragma unroll
            for (int o = 1; o < 64; o <<= 1) { const float y = __shfl_up(b, o); if (lane >= o) b += y; }
            float rm = ig - b;
#pragma unroll
            for (int o = 1; o < 64; o <<= 1) { const float y = __shfl_up(rm, o); if (lane >= o) rm = fmaxf(rm, y); }
            BQ[t * 4 + head] = b; IQ[t * 4 + head] = ig; MT[t * 4 + head] = rm;
            if (lane == 63) { CH[4096 + bh * 256 + c] = b; CH[bh * 256 + c] = b + rm; }
        }
    }
    const bf16_t* QB = (const bf16_t*)(ws + OFF_QB); const bf16_t* KB = (const bf16_t*)(ws + OFF_KB);
    bf16_t* Y = (bf16_t*)(ws + OFF_Y); bf16_t* KT = (bf16_t*)(ws + OFF_TMP);
    for (size_t it = (size_t)blockIdx.x * 512 + tid; it < (size_t)(T / 8) * 256; it += (size_t)gridDim.x * 512) {
        const size_t t0 = (it >> 8) * 8; const int c0 = (int)(it & 255) * 8, isk = c0 >= 1024, cc = c0 & 1023; const int s0 = (int)(t0 & (SEQ - 1));
        const bf16_t* src = isk ? KB : QB;
        u32x4 rw[11];
#pragma unroll
        for (int j = 0; j < 11; ++j) rw[j] = (s0 - 3 + j >= 0) ? *(const u32x4*)(src + (t0 - 3 + j) * 1024 + cc) : (u32x4){0u, 0u, 0u, 0u};
        f32x4 cw[4][2];
#pragma unroll
        for (int j = 0; j < 4; ++j) { cw[j][0] = *(const f32x4*)(p.e_conv + j * 2048 + c0); cw[j][1] = *(const f32x4*)(p.e_conv + j * 2048 + c0 + 4); }
        const float sc = isk ? 0.0625f : 1.0f;
#pragma unroll
        for (int k = 0; k < 8; ++k) {
            float acc[8];
#pragma unroll
            for (int i = 0; i < 8; ++i) acc[i] = 0.f;
#pragma unroll
            for (int j = 0; j < 4; ++j) { const u32x4 w = rw[k + j];
                acc[0] += cw[j][0][0] * bflo(w.x); acc[1] += cw[j][0][1] * bfhi(w.x); acc[2] += cw[j][0][2] * bflo(w.y); acc[3] += cw[j][0][3] * bfhi(w.y);
                acc[4] += cw[j][1][0] * bflo(w.z); acc[5] += cw[j][1][1] * bfhi(w.z); acc[6] += cw[j][1][2] * bflo(w.w); acc[7] += cw[j][1][3] * bfhi(w.w); }
            u32x4 o; o.x = pk2(siluf_(acc[0]) * sc, siluf_(acc[1]) * sc); o.y = pk2(siluf_(acc[2]) * sc, siluf_(acc[3]) * sc);
            o.z = pk2(siluf_(acc[4]) * sc, siluf_(acc[5]) * sc); o.w = pk2(siluf_(acc[6]) * sc, siluf_(acc[7]) * sc);
            if (isk) *(u32x4*)(KT + (t0 + k) * 1024 + cc) = o; else *(u32x4*)(Y + (t0 + k) * 2048 + 1024 + cc) = o;
        }
    }
}

typedef float f32x16 __attribute__((ext_vector_type(16)));
constexpr int ML_RS = 528, ML_WS = 144;
__device__ __forceinline__ bf16x8 ml_tr8(const LAS unsigned char* a, int second_off) {
    const v4i16_t t0 = __builtin_amdgcn_ds_read_tr16_b64_v4i16((LAS v4i16_t*)a);
    const v4i16_t t1 = __builtin_amdgcn_ds_read_tr16_b64_v4i16((LAS v4i16_t*)(a + second_off));
    bf16x8 r; r[0] = t0[0]; r[1] = t0[1]; r[2] = t0[2]; r[3] = t0[3]; r[4] = t1[0]; r[5] = t1[1]; r[6] = t1[2]; r[7] = t1[3]; return r;
}
struct ChunkScan { f32x4 B, mp, mn; };
__device__ __forceinline__ ChunkScan chunk_scan_wave(const float* CH, int bh, int lane) {
    ChunkScan r; r.B = *(const f32x4*)(CH + 4096 + bh * 256 + 4 * lane); const f32x4 G = *(const f32x4*)(CH + bh * 256 + 4 * lane);
    float a = r.B[0], b = G[0];
#pragma unroll
    for (int j = 1; j < 4; ++j) { b = fmaxf(r.B[j] + b, G[j]); a += r.B[j]; }
#pragma unroll
    for (int o = 1; o < 64; o <<= 1) { const float a1 = __shfl_up(a, o), b1 = __shfl_up(b, o); if (lane >= o) { b = fmaxf(a + b1, b); a += a1; } }
    const float ap = __shfl_up(a, 1), bp = __shfl_up(b, 1);
    float m = lane ? fmaxf(ap, bp) : 0.f;
#pragma unroll
    for (int j = 0; j < 4; ++j) { r.mp[j] = m; m = fmaxf(r.B[j] + m, G[j]); r.mn[j] = m; }
    return r;
}
__device__ __forceinline__ void mlstm_chunk_scan(const float* CH, int bh, LAS float* sB, LAS float* sMp, LAS float* sMn) {
    int tid = threadIdx.x; asm volatile("" : "+v"(tid));
    if (tid < 64) { const ChunkScan r = chunk_scan_wave(CH, bh, tid); *(LAS f32x4*)(sB + 4 * tid) = r.B; *(LAS f32x4*)(sMp + 4 * tid) = r.mp; *(LAS f32x4*)(sMn + 4 * tid) = r.mn; }
    __syncthreads();
}
template <bool FULL>
__device__ __forceinline__ void mlstm_units(const P& p, unsigned char* lds_) {
    unsigned char* ws = p.ws; const int tid0 = threadIdx.x;
    const int w = __builtin_amdgcn_readfirstlane(tid0 >> 6);
    const bf16_t* Yq = (const bf16_t*)(ws + OFF_Y); bf16_t* Yo = (bf16_t*)(ws + OFF_Y);
    const bf16_t* KT = (const bf16_t*)(ws + OFF_TMP); const bf16_t* VB = (const bf16_t*)(ws + OFF_VB);
    float* ST = (float*)(ws + OFF_QB); float* NS = (float*)(ws + OFF_NS);
    const float *BQ = (const float*)(ws + OFF_BQ), *IQ = (const float*)(ws + OFF_IQ), *MT = (const float*)(ws + OFF_MT), *CH = (const float*)(ws + OFF_CH);
    LAS unsigned char* Qs = (LAS unsigned char*)lds_;
    LAS unsigned char* Ks = Qs + 64 * ML_RS;
    LAS unsigned char* Vs = Ks + 64 * ML_RS;
    LAS unsigned char* Wl = Vs + 64 * ML_RS;
    LAS float* sa = (LAS float*)(Wl + 64 * ML_WS);
    LAS float* sden = sa + 64; LAS float* ssw = sden + 64; LAS float* sf = ssw + 64; LAS float* sg = sf + 64; LAS float* nd = sg + 64; LAS float* rden = nd + 64; LAS float* ns = rden + 64;
    LAS float* cB = ns + 256; LAS float* cMp = cB + 256; LAS float* cMn = cMp + 256; LAS float* gB = cMn + 256; LAS float* gI = gB + 512; LAS float* gM = gI + 512;
    for (int unit = blockIdx.x; unit < 256; unit += gridDim.x) {
        const int bh = unit >> 5, S = unit & 31, batch = bh >> 2, head = bh & 3;
        const int tid = tid0, lane = tid0 & 63, hh = lane >> 5;
        __syncthreads();
        mlstm_chunk_scan(CH, bh, cB, cMp, cMn);
        f32x16 st[8]; float nreg = 0.f;
        if (FULL) {
#pragma unroll
            for (int kt = 0; kt < 8; ++kt) {
                int lz = lane; asm volatile("" : "+v"(lz));
                const f32x4* sp = (const f32x4*)(ST + (size_t)unit * 65536 + (size_t)(kt * 8 + w) * 1024) + lz;
#pragma unroll
                for (int j = 0; j < 4; ++j) { const f32x4 v4 = sp[j * 64]; st[kt][4 * j + 0] = v4[0]; st[kt][4 * j + 1] = v4[1]; st[kt][4 * j + 2] = v4[2]; st[kt][4 * j + 3] = v4[3]; }
            }
            if (tid < 256) nreg = NS[unit * 256 + tid];
        } else {
#pragma unroll
            for (int kt = 0; kt < 8; ++kt)
#pragma unroll
                for (int r = 0; r < 16; ++r) st[kt][r] = 0.f;
        }
        { const size_t tS = ((size_t)batch * SEQ + (size_t)S * 512 + tid0) * 4 + head; gB[tid0] = BQ[tS]; gI[tid0] = IQ[tS]; gM[tid0] = MT[tS]; }
        u32x4 pk[4], pv[4], pq[4];
        auto prefetch = [&](int cn) {
            int tz = tid0; asm volatile("" : "+v"(tz));
            const size_t tn = (size_t)batch * SEQ + (size_t)(S * 8 + cn) * 64;
#pragma unroll
            for (int j = 0; j < 4; ++j) { const int e = tz + 512 * j, r = e >> 5, cg = e & 31;
                pk[j] = *(const u32x4*)(KT + (tn + r) * 1024 + head * 256 + cg * 8);
                if (!FULL) pv[j] = *(const u32x4*)(VB + (tn + r) * 1024 + head * 256 + cg * 8);
                if (FULL) pq[j] = *(const u32x4*)(Yq + (tn + r) * 2048 + 1024 + head * 256 + cg * 8); }
            asm volatile("" ::: "memory");
        };
        prefetch(0);
#pragma unroll 1
        for (int cc = 0; cc < 8; ++cc) {
            int tid = tid0; asm volatile("" : "+v"(tid));
            const int lane = tid & 63, l31 = lane & 31, hh = lane >> 5, fr = lane & 15, fq = lane >> 4;
            const int trow = 8 * hh + (fr >> 2), tcol = (16 * (fq & 1) + 4 * (fr & 3)) * 2;
            const int ch = S * 8 + cc; const size_t t0 = (size_t)batch * SEQ + ch * 64;
            const float mprev = cMp[ch], mnew = cMn[ch], blast = cB[ch];
            const float decay = __expf(blast + mprev - mnew);
            __syncthreads();
#pragma unroll
            for (int j = 0; j < 4; ++j) { const int e = tid + 512 * j, r = e >> 5, cg = e & 31;
                if (FULL) pv[j] = *(const u32x4*)(VB + (t0 + r) * 1024 + head * 256 + cg * 8); }
#pragma unroll
            for (int j = 0; j < 4; ++j) { const int e = tid + 512 * j, r = e >> 5, cg = e & 31;
                *(LAS u32x4*)(Ks + r * ML_RS + cg * 16) = pk[j];
                if (!FULL) *(LAS u32x4*)(Vs + r * ML_RS + cg * 16) = pv[j];
                if (FULL) *(LAS u32x4*)(Qs + r * ML_RS + cg * 16) = pq[j]; }
            if (w == cc) { const float bq = gB[tid], iq = gI[tid], mt = bq + fmaxf(mprev, gM[tid]);
                sa[lane] = __expf(bq + mprev - mt); sden[lane] = __expf(-mt); ssw[lane] = __expf(blast - bq + iq - mnew); sf[lane] = bq - mt; sg[lane] = iq - bq; }
            if (FULL && tid < 256) ns[tid] = nreg;
            __syncthreads();
            if (!FULL && cc < 7) prefetch(cc + 1);
            bf16x8 bv[4];
            if (!FULL) {
#pragma unroll
                for (int ks = 0; ks < 4; ++ks) bv[ks] = ml_tr8(Vs + (16 * ks + trow) * ML_RS + 64 * w + tcol, 4 * ML_RS);
            }
            if (FULL) {
                { const int tt = w >> 1;
#pragma unroll
                  for (int si = 0; si < 2; ++si) { const int ss = 2 * (w & 1) + si;
                    f32x4 acc = (f32x4){0.f, 0.f, 0.f, 0.f};
                    if (ss <= tt) {
#pragma unroll
                        for (int ks = 0; ks < 8; ++ks) { const bf16x8 a = *(const LAS bf16x8*)(Qs + (16 * tt + fr) * ML_RS + (32 * ks + 8 * fq) * 2), b = *(const LAS bf16x8*)(Ks + (16 * ss + fr) * ML_RS + (32 * ks + 8 * fq) * 2);
                            acc = __builtin_amdgcn_mfma_f32_16x16x32_bf16(a, b, acc, 0, 0, 0); } }
                    const int sidx = 16 * ss + fr; const float gs = sg[sidx];
#pragma unroll
                    for (int j = 0; j < 4; ++j) { const int tix = 16 * tt + 4 * fq + j; const float wv = (sidx <= tix) ? __expf(sf[tix] + gs) * acc[j] : 0.f;
                        *(LAS bf16_t*)(Wl + tix * ML_WS + sidx * 2) = f2bf(wv); } } }
#pragma unroll
                for (int i = 0; i < 8; ++i) { const int tix = 8 * w + i; const u32x2 qv = *(const LAS u32x2*)(Qs + tix * ML_RS + lane * 8); const f32x4 nv = *(const LAS f32x4*)(ns + lane * 4);
                    float part = bflo(qv.x) * nv[0] + bfhi(qv.x) * nv[1] + bflo(qv.y) * nv[2] + bfhi(qv.y) * nv[3]; part = wave_sum(part); if (lane == 0) nd[tix] = part; }
#pragma unroll
                for (int j = 0; j < 4; ++j) { const int e = tid + 512 * j, r = e >> 5, cg = e & 31; *(LAS u32x4*)(Vs + r * ML_RS + cg * 16) = pv[j]; }
                __syncthreads();
                f32x16 acc[2];
#pragma unroll
                for (int t2 = 0; t2 < 2; ++t2) {
#pragma unroll
                    for (int r = 0; r < 16; ++r) acc[t2][r] = 0.f;
                }
#pragma unroll
                for (int kt = 0; kt < 8; ++kt) {
                    asm volatile("" ::: "memory");
#pragma unroll
                    for (int s2 = 0; s2 < 2; ++s2) {
                        u32x4 bw; bw.x = pg8::cvt_pk_bf16(st[kt][8 * s2 + 0], st[kt][8 * s2 + 1]); bw.y = pg8::cvt_pk_bf16(st[kt][8 * s2 + 2], st[kt][8 * s2 + 3]);
                        bw.z = pg8::cvt_pk_bf16(st[kt][8 * s2 + 4], st[kt][8 * s2 + 5]); bw.w = pg8::cvt_pk_bf16(st[kt][8 * s2 + 6], st[kt][8 * s2 + 7]);
                        const bf16x8 bfrag = __builtin_bit_cast(bf16x8, bw);
#pragma unroll
                        for (int t2 = 0; t2 < 2; ++t2) { const LAS unsigned char* qa = Qs + (32 * t2 + l31) * ML_RS + (32 * kt + 16 * s2 + 4 * hh) * 2;
                            const u32x2 lo = *(const LAS u32x2*)qa, hi = *(const LAS u32x2*)(qa + 16); u32x4 aw; aw.x = lo.x; aw.y = lo.y; aw.z = hi.x; aw.w = hi.y;
                            acc[t2] = __builtin_amdgcn_mfma_f32_32x32x16_bf16(__builtin_bit_cast(bf16x8, aw), bfrag, acc[t2], 0, 0, 0); }
                    }
                }
                asm volatile("" ::: "memory");
#pragma unroll
                for (int t2 = 0; t2 < 2; ++t2)
#pragma unroll
                    for (int r = 0; r < 16; ++r) acc[t2][r] *= sa[32 * t2 + (r & 3) + 8 * (r >> 2) + 4 * hh];
#pragma unroll
                for (int ks = 0; ks < 4; ++ks) bv[ks] = ml_tr8(Vs + (16 * ks + trow) * ML_RS + 64 * w + tcol, 4 * ML_RS);
#pragma unroll
                for (int ks = 0; ks < 4; ++ks)
#pragma unroll
                    for (int t2 = 0; t2 < 2; ++t2) { const bf16x8 a = *(const LAS bf16x8*)(Wl + (32 * t2 + l31) * ML_WS + (16 * ks + 8 * hh) * 2);
                        acc[t2] = __builtin_amdgcn_mfma_f32_32x32x16_bf16(a, bv[ks], acc[t2], 0, 0, 0); }
#pragma unroll
                for (int i = 0; i < 8; ++i) { const int tix = 8 * w + i; float rs = bf2f(*(const LAS bf16_t*)(Wl + tix * ML_WS + lane * 2)); rs = wave_sum(rs);
                    if (lane == 0) { const float nq = sa[tix] * nd[tix] + rs; rden[tix] = 1.0f / fmaxf(fabsf(nq), sden[tix]); } }
                __syncthreads();
                bf16_t* yo = Yo + t0 * 2048 + head * 256 + 32 * w + l31;
#pragma unroll
                for (int t2 = 0; t2 < 2; ++t2)
#pragma unroll
                    for (int r = 0; r < 16; ++r) { const int tix = 32 * t2 + (r & 3) + 8 * (r >> 2) + 4 * hh; yo[(size_t)tix * 2048] = f2bf(acc[t2][r] * rden[tix]); }
                asm volatile("" ::: "memory");
                if (cc < 7) prefetch(cc + 1);
            }
#pragma unroll
            for (int kt = 0; kt < 8; ++kt) st[kt] *= decay;
#pragma unroll
            for (int ks = 0; ks < 4; ++ks) {
                const u32x4 raw = __builtin_bit_cast(u32x4, bv[ks]); const LAS float* sw8 = ssw + 16 * ks + 8 * hh;
                u32x4 sc; sc.x = pg8::cvt_pk_bf16(bflo(raw.x) * sw8[0], bfhi(raw.x) * sw8[1]); sc.y = pg8::cvt_pk_bf16(bflo(raw.y) * sw8[2], bfhi(raw.y) * sw8[3]);
                sc.z = pg8::cvt_pk_bf16(bflo(raw.z) * sw8[4], bfhi(raw.z) * sw8[5]); sc.w = pg8::cvt_pk_bf16(bflo(raw.w) * sw8[6], bfhi(raw.w) * sw8[7]);
                const bf16x8 bs = __builtin_bit_cast(bf16x8, sc);
#pragma unroll
                for (int kt = 0; kt < 8; ++kt) { if ((kt & 3) == 0) asm volatile("" ::: "memory");
                    const bf16x8 a = ml_tr8(Ks + (16 * ks + trow) * ML_RS + 64 * kt + tcol, 4 * ML_RS);
                    st[kt] = __builtin_amdgcn_mfma_f32_32x32x16_bf16(a, bs, st[kt], 0, 0, 0); }
            }
            if (tid < 256) { float nacc = 0.f;
#pragma unroll 8
                for (int s2 = 0; s2 < 64; ++s2) nacc += ssw[s2] * bf2f(*(const LAS bf16_t*)(Ks + s2 * ML_RS + tid * 2));
                nreg = decay * nreg + nacc; }
        }
        if (!FULL) {
#pragma unroll
            for (int kt = 0; kt < 8; ++kt) {
                int lz = lane; asm volatile("" : "+v"(lz));
                f32x4* sp = (f32x4*)(ST + (size_t)unit * 65536 + (size_t)(kt * 8 + w) * 1024) + lz;
#pragma unroll
                for (int j = 0; j < 4; ++j) sp[j * 64] = (f32x4){st[kt][4 * j + 0], st[kt][4 * j + 1], st[kt][4 * j + 2], st[kt][4 * j + 3]};
            }
            if (tid < 256) NS[unit * 256 + tid] = nreg;
        }
    }
}
__device__ __forceinline__ void phase_mlstm_scan(const P& p, unsigned char* lds_) {
    unsigned char* ws = p.ws; const int tid = threadIdx.x, lane = tid & 63, wave = tid >> 6;
    float* ST = (float*)(ws + OFF_QB); float* NS = (float*)(ws + OFF_NS); const float* CH = (const float*)(ws + OFF_CH);
    LAS float* DS = (LAS float*)lds_;
    __syncthreads();
    {
        const ChunkScan r = chunk_scan_wave(CH, wave, lane);
        float d = 1.f;
#pragma unroll
        for (int j = 0; j < 4; ++j) d *= __expf(r.B[j] + r.mp[j] - r.mn[j]);
        const float dn = __shfl_down(d, 1);
        if (!(lane & 1)) DS[wave * 32 + (lane >> 1)] = d * dn;
    }
    __syncthreads();
    {
        const int it0 = blockIdx.x * 512 + tid;
        for (int it = it0; it < 8 * 16384; it += gridDim.x * 512) {
            const int bh = it >> 14; float* base = ST + (size_t)bh * 32 * 65536 + (size_t)(it & 16383) * 4;
            f32x4 carry = (f32x4){0.f, 0.f, 0.f, 0.f};
#pragma unroll
            for (int h = 0; h < 2; ++h) {
                f32x4 tmp[16];
#pragma unroll
                for (int S = 0; S < 16; ++S) tmp[S] = *(const f32x4*)(base + (size_t)(16 * h + S) * 65536);
#pragma unroll
                for (int S = 0; S < 16; ++S) { *(f32x4*)(base + (size_t)(16 * h + S) * 65536) = carry; carry = DS[bh * 32 + 16 * h + S] * carry + tmp[S]; }
            }
        }
        if (it0 < 8 * 256) {
            const int it = it0, bh = it >> 8; float* base = NS + (size_t)bh * 32 * 256 + (it & 255);
            float carry = 0.f;
#pragma unroll 8
            for (int S = 0; S < 32; ++S) { const float tmp = base[S * 256]; base[S * 256] = carry; carry = DS[bh * 32 + S] * carry + tmp; }
        }
    }
}

__device__ __forceinline__ void unpack8(const u32x4 w, float (&f)[8]) {
    f[0] = bflo(w.x); f[1] = bfhi(w.x); f[2] = bflo(w.y); f[3] = bfhi(w.y); f[4] = bflo(w.z); f[5] = bfhi(w.z); f[6] = bflo(w.w); f[7] = bfhi(w.w); }
template <int WIN>
__device__ __forceinline__ void pool_item(const bf16_t* __restrict__ U, bf16_t* __restrict__ Y, const float* __restrict__ s_pool, size_t t0, int s0, int c0) {
    constexpr int NR = WIN + 7;
    u32x4 rw[NR], z[8];
#pragma unroll
    for (int j = 0; j < NR; ++j) rw[j] = (s0 - (WIN - 1) + j >= 0) ? *(const u32x4*)(U + ((long)t0 + j - (WIN - 1)) * 1024 + c0) : (u32x4){0u, 0u, 0u, 0u};
#pragma unroll
    for (int k = 0; k < 8; ++k) z[k] = *(const u32x4*)(Y + (t0 + k) * 2048 + 1024 + c0);
    const f32x4 s0v = *(const f32x4*)(s_pool + c0), s1v = *(const f32x4*)(s_pool + c0 + 4);
    const float sp[8] = {s0v[0], s0v[1], s0v[2], s0v[3], s1v[0], s1v[1], s1v[2], s1v[3]};
    float S[8];
#pragma unroll
    for (int i = 0; i < 8; ++i) S[i] = 0.f;
#pragma unroll
    for (int j = 0; j < WIN - 1; ++j) { float f[8]; unpack8(rw[j], f);
#pragma unroll
        for (int i = 0; i < 8; ++i) S[i] += f[i]; }
#pragma unroll
    for (int k = 0; k < 8; ++k) {
        float self[8], zf[8]; unpack8(rw[k + WIN - 1], self); unpack8(z[k], zf);
#pragma unroll
        for (int i = 0; i < 8; ++i) S[i] += self[i];
        const int cnt = (s0 + k + 1 < WIN) ? s0 + k + 1 : WIN;
        const float inv = __builtin_amdgcn_rcpf((float)cnt);
        float o[8];
#pragma unroll
        for (int i = 0; i < 8; ++i) o[i] = (S[i] * inv - self[i]) * sp[i] * zf[i];
        u32x4 ow; ow.x = pk2(o[0], o[1]); ow.y = pk2(o[2], o[3]); ow.z = pk2(o[4], o[5]); ow.w = pk2(o[6], o[7]);
        *(u32x4*)(Y + (t0 + k) * 2048 + 1024 + c0) = ow;
        float old[8]; unpack8(rw[k], old);
#pragma unroll
        for (int i = 0; i < 8; ++i) S[i] -= old[i];
    }
}
__device__ __forceinline__ void phase_ya_pool(const P& p) {
    unsigned char* ws = p.ws; const int tid = threadIdx.x, lane = tid & 63, wave = tid >> 6;
    bf16_t* Y = (bf16_t*)(ws + OFF_Y); const bf16_t* O = (const bf16_t*)(ws + OFF_QB); const bf16_t* ZA = (const bf16_t*)(ws + OFF_KB);
    for (int tt = blockIdx.x * 8 + wave; tt < T; tt += gridDim.x * 8) {
        const size_t t = (size_t)tt; u32x2 hw[4], ow[4], zw[4];
#pragma unroll
        for (int head = 0; head < 4; ++head) { const int c = head * 256 + lane * 4;
            hw[head] = *(const u32x2*)(Y + t * 2048 + c); ow[head] = *(const u32x2*)(O + t * 1024 + c); zw[head] = *(const u32x2*)(ZA + t * 1024 + c); }
#pragma unroll
        for (int head = 0; head < 4; ++head) { const int c = head * 256 + lane * 4;
            float v[4] = {bflo(hw[head].x) * bflo(ow[head].x), bfhi(hw[head].x) * bfhi(ow[head].x), bflo(hw[head].y) * bflo(ow[head].y), bfhi(hw[head].y) * bfhi(ow[head].y)};
            const float ss = wave_sum(v[0] * v[0] + v[1] * v[1] + v[2] * v[2] + v[3] * v[3]);
            const float rstd = rsqrtf(ss * (1.0f / 256.0f) + EPS);
            const f32x4 g = *(const f32x4*)(p.e_g_head + c);
            u32x2 o; o.x = pk2(v[0] * rstd * g[0] * bflo(zw[head].x), v[1] * rstd * g[1] * bfhi(zw[head].x)); o.y = pk2(v[2] * rstd * g[2] * bflo(zw[head].y), v[3] * rstd * g[3] * bfhi(zw[head].y));
            *(u32x2*)(Y + t * 2048 + c) = o; }
    }
    const bf16_t* U = (const bf16_t*)(ws + OFF_VB);
    for (int it = blockIdx.x * 512 + tid; it < (T / 8) * 128; it += gridDim.x * 512) {
        const int cgl = it & 31, tbl = (it >> 5) & 1, g = __builtin_amdgcn_readfirstlane((it >> 6) & 3), tb = 2 * (it >> 8) + tbl;
        const size_t t0 = (size_t)tb * 8; const int s0 = (int)(t0 & (SEQ - 1)), c0 = g * 256 + cgl * 8;
        if (g == 0) pool_item<2>(U, Y, p.e_s_pool, t0, s0, c0);
        else if (g == 1) pool_item<4>(U, Y, p.e_s_pool, t0, s0, c0);
        else if (g == 2) pool_item<8>(U, Y, p.e_s_pool, t0, s0, c0);
        else pool_item<16>(U, Y, p.e_s_pool, t0, s0, c0);
    }
}

__device__ __forceinline__ void headnorm64(bf16_t* X, const float* g) {
    const int lane = threadIdx.x & 63, wave = threadIdx.x >> 6;
    const float* gg = g + (lane & 3) * 16;
    for (int t0 = (blockIdx.x * 8 + wave) * 4; t0 < T; t0 += gridDim.x * 32) {
        u32x4 a[4], b[4];
#pragma unroll
        for (int k = 0; k < 4; ++k) { const bf16_t* r = X + (size_t)(t0 + k) * 1024 + lane * 16; a[k] = *(const u32x4*)r; b[k] = *(const u32x4*)(r + 8); }
#pragma unroll
        for (int k = 0; k < 4; ++k) {
            float f[16] = {bflo(a[k].x), bfhi(a[k].x), bflo(a[k].y), bfhi(a[k].y), bflo(a[k].z), bfhi(a[k].z), bflo(a[k].w), bfhi(a[k].w), bflo(b[k].x), bfhi(b[k].x), bflo(b[k].y), bfhi(b[k].y), bflo(b[k].z), bfhi(b[k].z), bflo(b[k].w), bfhi(b[k].w)};
            float ss = 0.f;
#pragma unroll
            for (int i = 0; i < 16; ++i) ss += f[i] * f[i];
            ss += dppf<0xB1>(ss); ss += dppf<0x4E>(ss);
            const float rstd = rsqrtf(ss * (1.0f / 64.0f) + EPS);
#pragma unroll
            for (int i = 0; i < 16; ++i) f[i] = f[i] * rstd * gg[i];
            u32x4 oa, ob; oa.x = pk2(f[0], f[1]); oa.y = pk2(f[2], f[3]); oa.z = pk2(f[4], f[5]); oa.w = pk2(f[6], f[7]);
            ob.x = pk2(f[8], f[9]); ob.y = pk2(f[10], f[11]); ob.z = pk2(f[12], f[13]); ob.w = pk2(f[14], f[15]);
            bf16_t* r = X + (size_t)(t0 + k) * 1024 + lane * 16; *(u32x4*)r = oa; *(u32x4*)(r + 8) = ob;
        }
    }
}
__device__ __forceinline__ void phase_qnorm_ckvnorm(const P& p) {
    unsigned char* ws = p.ws; const int lane = threadIdx.x & 63, wave = threadIdx.x >> 6;
    {
        const u32x4* KI4 = (const u32x4*)(ws + OFF_KI); u32x4* KT4 = (u32x4*)(ws + OFF_KIT);
        for (size_t it = (size_t)blockIdx.x * 512 + threadIdx.x; it < (size_t)T * 8; it += (size_t)gridDim.x * 512) {
            const int l = (int)(it & 63), ks = (int)((it >> 6) & 1); const size_t t16 = it >> 7;
            KT4[it] = KI4[(t16 * 16 + (l & 15)) * 8 + 4 * ks + (l >> 4)]; }
    }
    bf16_t* CKVN = (bf16_t*)(ws + OFF_CKVN);
    const f32x4 g = *(const f32x4*)(p.o_g_kv + lane * 4);
    for (int t0 = (blockIdx.x * 8 + wave) * 8; t0 < T; t0 += gridDim.x * 64) {
        u32x2 w[8];
#pragma unroll
        for (int k = 0; k < 8; ++k) w[k] = *(const u32x2*)(CKVN + (size_t)(t0 + k) * 256 + lane * 4);
#pragma unroll
        for (int k = 0; k < 8; ++k) {
            const float v[4] = {bflo(w[k].x), bfhi(w[k].x), bflo(w[k].y), bfhi(w[k].y)};
            const float ss = wave_sum(v[0] * v[0] + v[1] * v[1] + v[2] * v[2] + v[3] * v[3]);
            const float rstd = rsqrtf(ss * (1.0f / 256.0f) + EPS);
            u32x2 o; o.x = pk2(v[0] * rstd * g[0], v[1] * rstd * g[1]); o.y = pk2(v[2] * rstd * g[2], v[3] * rstd * g[3]);
            *(u32x2*)(CKVN + (size_t)(t0 + k) * 256 + lane * 4) = o;
        }
    }
}

__device__ __forceinline__ unsigned okey(float s) { if (s == 0.f) s = 0.f; const unsigned u = __float_as_uint(s); return (u & 0x80000000u) ? ~u : (u | 0x80000000u); }

__device__ __forceinline__ void indexer_slow_query(const P& p, unsigned char* lds, size_t t) {
    unsigned char* ws = p.ws; const int tid = threadIdx.x, lane = tid & 63, wave = tid >> 6;
    const _Float16* QI = (const _Float16*)(ws + OFF_QI); const _Float16* KI = (const _Float16*)(ws + OFF_KI); const float* WI = (const float*)(ws + OFF_WI);
    unsigned short* IDX = (unsigned short*)(ws + OFF_IDX);
    unsigned* sc = (unsigned*)lds; unsigned* hist = sc + 16384; float* qs = (float*)(hist + 256); unsigned* misc = (unsigned*)(qs + 256); unsigned* wsum = misc + 16;
    const int batch = (int)(t >> 14), pos = (int)(t & (SEQ - 1)), n = pos + 1;
    __syncthreads();
    if (tid < 256) qs[tid] = (float)QI[t * 256 + tid];
    const float w0 = WI[t * 4 + 0], w1 = WI[t * 4 + 1], w2 = WI[t * 4 + 2], w3 = WI[t * 4 + 3];
    __syncthreads();
    const _Float16* kbase = KI + (size_t)batch * SEQ * 64;
    for (int s = tid; s < n; s += 512) {
        asm volatile("" ::: "memory");
        typedef _Float16 h8 __attribute__((ext_vector_type(8)));
        const h8* kr = (const h8*)(kbase + (size_t)s * 64);
        float d0 = 0.f, d1 = 0.f, d2 = 0.f, d3 = 0.f;
#pragma unroll
        for (int j = 0; j < 8; ++j) { const h8 kv = kr[j];
#pragma unroll
            for (int e = 0; e < 8; ++e) { const int d = j * 8 + e; const float kf = (float)kv[e]; d0 += qs[d] * kf; d1 += qs[64 + d] * kf; d2 += qs[128 + d] * kf; d3 += qs[192 + d] * kf; } }
        float score = w0 * fmaxf(d0, 0.f); score = fmaf(w1, fmaxf(d1, 0.f), score); score = fmaf(w2, fmaxf(d2, 0.f), score); score = fmaf(w3, fmaxf(d3, 0.f), score);
        sc[s] = okey(score);
    }
    unsigned prefix = 0, krem = 256;
    for (int pass = 0; pass < 4; ++pass) {
        const int shift = 24 - 8 * pass;
        __syncthreads();
        if (tid < 256) hist[tid] = 0;
        __syncthreads();
        for (int s = tid; s < n; s += 512) { const unsigned k = sc[s]; if (pass == 0 || (k >> (shift + 8)) == prefix) atomicAdd(&hist[(k >> shift) & 255u], 1u); }
        __syncthreads();
        if (tid == 0) { unsigned cum = 0; int bin = 255; for (; bin > 0; --bin) { const unsigned c = hist[bin]; if (cum + c >= krem) break; cum += c; } misc[0] = (unsigned)bin; misc[1] = krem - cum; }
        __syncthreads();
        prefix = (prefix << 8) | misc[0]; krem = misc[1];
    }
    const unsigned ngt_total = 256u - krem;
    unsigned lg = 0, le = 0; const int s0 = tid * 32;
    for (int s = s0; s < s0 + 32 && s < n; ++s) { const unsigned k = sc[s]; lg += (k > prefix); le += (k == prefix); }
    unsigned pk = lg | (le << 16), incl = pk;
#pragma unroll
    for (int o = 1; o < 64; o <<= 1) { const unsigned y = __shfl_up(incl, o); if (lane >= o) incl += y; }
    if (lane == 63) wsum[wave] = incl;
    __syncthreads();
    unsigned base = 0;
    for (int w = 0; w < wave; ++w) base += wsum[w];
    const unsigned excl = base + incl - pk; unsigned bg = excl & 0xffffu, be = excl >> 16;
    for (int s = s0; s < s0 + 32 && s < n; ++s) { const unsigned k = sc[s];
        if (k > prefix) { IDX[t * 256 + bg] = (unsigned short)s; ++bg; }
        else if (k == prefix) { if (be < krem) IDX[t * 256 + ngt_total + be] = (unsigned short)s; ++be; } }
    __syncthreads();
}

typedef _Float16 half8 __attribute__((ext_vector_type(8)));
constexpr int IX_CAP = 1024, IX_ZBIN = 2048;
__device__ __forceinline__ unsigned ix_key(const f32x4 a, const f32x4 w) {
    const float r0 = __int_as_float(max(__float_as_int(a[0]), 0)), r1 = __int_as_float(max(__float_as_int(a[1]), 0));
    const float r2 = __int_as_float(max(__float_as_int(a[2]), 0)), r3 = __int_as_float(max(__float_as_int(a[3]), 0));
    float s = fmaf(w[0], r0, 0.0f); s = fmaf(w[1], r1, s); s = fmaf(w[2], r2, s); s = fmaf(w[3], r3, s);
    const unsigned u = __float_as_uint(s);
    return u ^ ((unsigned)((int)u >> 31) | 0x80000000u);
}
#define LDS_ADD(ptr, v) __hip_atomic_fetch_add((ptr), (v), __ATOMIC_RELAXED, __HIP_MEMORY_SCOPE_WORKGROUP)
struct IxTagF { static constexpr bool value = false; }; struct IxTagT { static constexpr bool value = true; };
__device__ __forceinline__ void phase_indexer(const P& p, unsigned char* lds) {
    unsigned char* ws = p.ws; const int tid = tid_opaque(), lane = tid & 63, kl = lane & 15, g = lane >> 4;
    const int wave = __builtin_amdgcn_readfirstlane(tid >> 6);
    const _Float16* QI = (const _Float16*)(ws + OFF_QI); const _Float16* KIT = (const _Float16*)(ws + OFF_KIT); const float* WI = (const float*)(ws + OFF_WI);
    unsigned short* IDX = (unsigned short*)(ws + OFF_IDX); int* CNT = (int*)(ws + OFF_CNT);
    LAS unsigned* hist = (LAS unsigned*)lds;
    LAS int* qTbin = (LAS int*)(hist + 16 * 2048);
    LAS int* qCab = qTbin + 16; LAS unsigned* qN = (LAS unsigned*)(qCab + 16); LAS int* qOvf = (LAS int*)(qN + 16); LAS int* qZl = qOvf + 16;
    LAS unsigned* ovl = (LAS unsigned*)(lds + 132 * 1024);
    LAS unsigned* h2 = (LAS unsigned*)(lds + 133 * 1024 + wave * 1536);
    LAS unsigned long long* l2 = (LAS unsigned long long*)(h2 + 256);
    if (tid == 0) ovl[0] = 0u;
    const int G = gridDim.x, nround = (T / 16) / G;
#pragma unroll 1
    for (int i = 0; i < nround; ++i) {
        const int tix = (i & 1) ? i * G + (G - 1 - (int)blockIdx.x) : i * G + (int)blockIdx.x;
        const int batch = tix & 1, tb = tix >> 1, p0 = tb * 16; const size_t t0 = (size_t)batch * SEQ + p0;
        __syncthreads();
        if (p0 + 16 <= 256) {
#pragma unroll
            for (int j = 0; j < 8; ++j) { const int e = tid + 512 * j, q = e >> 8, jj = e & 255; IDX[(t0 + q) * 256 + jj] = (unsigned short)(jj <= p0 + q ? jj : 0); }
            if (tid < 16) CNT[t0 + tid] = p0 + tid + 1;
            continue;
        }
#pragma unroll
        for (int j = 0; j < 16; ++j) ((LAS u32x4*)hist)[tid + 512 * j] = (u32x4){0u, 0u, 0u, 0u};
        if (tid < 16) { qN[tid] = 0u; qOvf[tid] = 0; }
        half8 af[4][2]; f32x4 wv[4];
#pragma unroll
        for (int rt = 0; rt < 4; ++rt) {
#pragma unroll
            for (int ks = 0; ks < 2; ++ks) af[rt][ks] = *(const half8*)(QI + (t0 + 4 * rt + (kl >> 2)) * 256 + (kl & 3) * 64 + 32 * ks + 8 * g);
            wv[rt] = *(const f32x4*)(WI + (t0 + 4 * rt + g) * 4);
        }
        __syncthreads();
        const int nblk = tb + 1, L = (nblk + 7) >> 3, b0 = wave * L, b1 = (b0 + L < nblk) ? b0 + L : nblk;
        const _Float16* kb = KIT + (size_t)batch * SEQ * 64 + lane * 8;
        LAS unsigned* hg = hist + g * 4 * 2048;
#define IX_LOADK(u, bb) do { kq[u][0] = *(const half8*)(kb + (size_t)(bb) * 1024); kq[u][1] = *(const half8*)(kb + (size_t)(bb) * 1024 + 512); } while (0)
#define IX_MFMA(acc, k0, k1) do { _Pragma("unroll") for (int rt = 0; rt < 4; ++rt) { acc[rt] = __builtin_amdgcn_mfma_f32_16x16x32_f16(af[rt][0], k0, (f32x4){0.f, 0.f, 0.f, 0.f}, 0, 0, 0); \
            acc[rt] = __builtin_amdgcn_mfma_f32_16x16x32_f16(af[rt][1], k1, acc[rt], 0, 0, 0); } } while (0)
        const int sst = (nblk <= 64) ? 1 : 2;
        {
            const int bend = (b1 < nblk - 1) ? b1 : nblk - 1;
            const int ns = (bend > b0) ? ((bend - b0 + sst - 1) / sst) : 0;
            auto step1 = [&](int bcur, const half8& k0, const half8& k1, auto chkTag) {
                constexpr bool CHK = decltype(chkTag)::value;
                f32x4 acc[4]; IX_MFMA(acc, k0, k1);
#pragma unroll
                for (int rt = 0; rt < 4; ++rt) { const unsigned key = ix_key(acc[rt], wv[rt]);
                    if (!CHK || bcur * 16 + kl <= p0 + 4 * rt + g) LDS_ADD(hg + rt * 2048 + (key >> 21), 1u << ((key >> 16) & 16u)); }
            };
            if (ns > 0) {
                half8 kq[2][2];
#pragma unroll
                for (int u = 0; u < 2; ++u) { const int kk = (u < ns) ? u : ns - 1; IX_LOADK(u, b0 + sst * kk); }
                int k = 0;
#pragma unroll 1
                for (; k + 2 <= ns; k += 2) {
#pragma unroll
                    for (int u = 0; u < 2; ++u) { step1(0, kq[u][0], kq[u][1], IxTagF{}); const int kk = (k + 2 + u < ns) ? k + 2 + u : ns - 1; IX_LOADK(u, b0 + sst * kk); }
                }
                if (k < ns) step1(0, kq[0][0], kq[0][1], IxTagF{});
            }
            if (sst == 1 && b1 == nblk && b0 < b1) { half8 kq[1][2]; IX_LOADK(0, nblk - 1); step1(nblk - 1, kq[0][0], kq[0][1], IxTagT{}); }
        }
        __syncthreads();
        int nsb = 0;
#pragma unroll
        for (int ww = 0; ww < 8; ++ww) { const int c0 = ww * L, c1 = (c0 + L < nblk) ? c0 + L : nblk, ce = (c1 < nblk - 1) ? c1 : nblk - 1; nsb += (ce > c0) ? ((ce - c0 + 1) >> 1) : 0; }
        if (sst == 1) nsb = nblk;
        const float fsm = (sst == 1) ? 1.0f : fminf(1.0f, (float)(nsb * 16) / (float)(p0 + 1));
        int tgt = (int)(256.0f * fsm + 5.0f * sqrtf(256.0f * fsm * (1.0f - fsm))) + 2; tgt = tgt > 256 ? 256 : tgt;
#pragma unroll 1
        for (int qq = 0; qq < 2; ++qq) {
            const int q = 2 * wave + qq; const LAS unsigned* h = hist + q * 2048;
            unsigned S2 = 0;
#pragma unroll
            for (int c8 = 0; c8 < 8; ++c8) { const int cc = (c8 ^ (lane >> 1)) & 7; const u32x4 w4 = *(const LAS u32x4*)(h + 2016 - 32 * lane + 4 * cc); S2 += w4.x + w4.y + w4.z + w4.w; }
            const unsigned cs = (S2 & 0xffffu) + (S2 >> 16);
            const unsigned incl = wave_iscan(cs);
            const unsigned long long m = __ballot(incl >= (unsigned)tgt);
            const int Ls = m ? (__ffsll((long long)m) - 1) : 63;
            const unsigned cab0 = rlu(incl - cs, Ls);
            const int dw = 2047 - 32 * Ls - (lane >> 1); const unsigned w2 = h[dw]; const unsigned cl = (lane & 1) ? (w2 & 0xffffu) : (w2 >> 16);
            const unsigned incl2 = wave_iscan(cl) + cab0;
            const unsigned long long m2 = __ballot(incl2 >= (unsigned)tgt);
            const int L2 = m2 ? (__ffsll((long long)m2) - 1) : 63;
            const int tbin = m2 ? 2 * (2047 - 32 * Ls) + 1 - L2 : 0; const unsigned cbv = rlu(cl, L2), cabv = rlu(incl2 - cl, L2);
            if (lane == 0) { qTbin[q] = tbin; qCab[q] = (int)cabv; int zl = 0x7fffffff;
                if (tbin == IX_ZBIN) {
                    const int nk = p0 + 4 * (q & 3) + (q >> 2) + 1; zl = (int)(((unsigned long long)384 * (unsigned)(nsb * 16)) / (cbv ? cbv : 1u)) + 16; zl = zl < nk ? zl : 0x7fffffff; }
                qZl[q] = zl; }
        }
        __syncthreads();
        if (b0 < b1) {
            unsigned lok[4]; int zl[4];
#pragma unroll
            for (int rt = 0; rt < 4; ++rt) { lok[rt] = (unsigned)qTbin[g * 4 + rt] << 20; zl[rt] = qZl[g * 4 + rt]; }
            half8 kq[2][2];
#pragma unroll
            for (int u = 0; u < 2; ++u) { const int bb = (b0 + u < b1) ? b0 + u : b1 - 1; IX_LOADK(u, bb); }
            auto step2 = [&](int bcur, const half8& k0, const half8& k1, auto chkTag) {
                constexpr bool CHK = decltype(chkTag)::value;
                const int s = bcur * 16 + kl;
                f32x4 acc[4]; IX_MFMA(acc, k0, k1);
                unsigned key[4], pos[4]; bool cand[4];
#pragma unroll
                for (int rt = 0; rt < 4; ++rt) { key[rt] = ix_key(acc[rt], wv[rt]); cand[rt] = key[rt] >= lok[rt] + (s >= zl[rt] ? 1u : 0u); if (CHK) cand[rt] = cand[rt] && s <= p0 + 4 * rt + g; }
#pragma unroll
                for (int rt = 0; rt < 4; ++rt) { pos[rt] = 0u;
                    if (cand[rt]) { int gz = g; asm volatile("" : "+v"(gz)); pos[rt] = LDS_ADD(qN + gz * 4 + rt, 1u); } }
#pragma unroll
                for (int rt = 0; rt < 4; ++rt) {
                    if (cand[rt] && pos[rt] < (unsigned)IX_CAP) { int gz = g; asm volatile("" : "+v"(gz));
                        ((LAS unsigned long long*)(lds + (gz * 4 + rt) * 8192))[pos[rt]] = ((unsigned long long)key[rt] << 16) | (unsigned long long)(0xffffu - (unsigned)s); } }
            };
            int b = b0;
#pragma unroll 1
            for (; b + 2 <= b1 && b + 2 <= nblk - 1; b += 2) {
#pragma unroll
                for (int u = 0; u < 2; ++u) { step2(b + u, kq[u][0], kq[u][1], IxTagF{}); const int bb = (b + 2 + u < b1) ? b + 2 + u : b1 - 1; IX_LOADK(u, bb); }
            }
#pragma unroll 1
            for (; b + 2 <= b1; b += 2) {
#pragma unroll
                for (int u = 0; u < 2; ++u) { step2(b + u, kq[u][0], kq[u][1], IxTagT{}); const int bb = (b + 2 + u < b1) ? b + 2 + u : b1 - 1; IX_LOADK(u, bb); }
            }
            if (b < b1) step2(b, kq[0][0], kq[0][1], IxTagT{});
        }
#undef IX_LOADK
#undef IX_MFMA
        __syncthreads();
#pragma unroll 1
        for (int qq = 0; qq < 2; ++qq) {
            const int qs = 2 * wave + qq; const int n = __builtin_amdgcn_readfirstlane((int)qN[qs]);
            if (n > IX_CAP || n < 256) { if (lane == 0) qOvf[qs] = 1; continue; }
            const LAS unsigned long long* cd = (const LAS unsigned long long*)(lds + qs * 8192);
            unsigned short* irow = IDX + (t0 + 4 * (qs & 3) + (qs >> 2)) * 256;
            const int NI = (n + 63) >> 6;
            unsigned long long v[16];
#pragma unroll
            for (int i = 0; i < 16; ++i) v[i] = (i < NI && lane + 64 * i < n) ? cd[lane + 64 * i] : 0ull;
            unsigned long long tau = 1ull;
            if (n > 256) {
                unsigned long long pmask = 0xfffull << 36, pval; int need; unsigned cT;
                {
                    int cpos = 0, czer = 0;
#pragma unroll
                    for (int i = 0; i < 16; ++i) if (i < NI) { const int bb = (int)(v[i] >> 36); cpos += (int)__popcll(__ballot(bb > IX_ZBIN)); czer += (int)__popcll(__ballot(bb == IX_ZBIN && v[i] != 0ull)); }
                    if (cpos < 256 && cpos + czer >= 256) { need = 256 - cpos; cT = (unsigned)czer; pval = (unsigned long long)IX_ZBIN << 36; }
                    else {
                        const bool negc = cpos < 256; const int abovec = negc ? cpos + czer : 0;
                        int bmx = 0;
#pragma unroll
                        for (int i = 0; i < 16; ++i) if (i < NI) { const int bb = (int)(v[i] >> 36); const bool mem = negc ? (bb < IX_ZBIN && v[i] != 0ull) : (bb > IX_ZBIN); bmx = (mem && bb > bmx) ? bb : bmx; }
                        bmx = (int)wave_max((float)bmx);
#pragma unroll
                        for (int j = 0; j < 4; ++j) h2[lane + 64 * j] = 0u;
                        asm volatile("" ::: "memory");
#pragma unroll
                        for (int i = 0; i < 16; ++i) if (i < NI) { const int bb = (int)(v[i] >> 36); const bool mem = negc ? (bb < IX_ZBIN && v[i] != 0ull) : (bb > IX_ZBIN);
                            if (mem) { const int d = bmx - bb; LDS_ADD(h2 + (d > 255 ? 0 : 255 - d), 1u); } }
                        asm volatile("" ::: "memory");
                        const unsigned want = (unsigned)(256 - abovec);
                        int T0; unsigned above, c2; radix_pick(h2, lane, want, T0, above, c2);
                        if (T0 <= 0) { if (lane == 0) qOvf[qs] = 1; continue; }
                        need = (int)want - (int)above; cT = c2; pval = (unsigned long long)(unsigned)(bmx - 255 + T0) << 36;
                    }
                    asm volatile("" ::: "memory");
                }
#pragma unroll 1
                for (int shift = 28; shift >= 4 && cT > 64u; shift -= 8) {
#pragma unroll
                    for (int j = 0; j < 4; ++j) h2[lane + 64 * j] = 0u;
                    asm volatile("" ::: "memory");
#pragma unroll
                    for (int i = 0; i < 16; ++i) if (i < NI && (v[i] & pmask) == pval) LDS_ADD(h2 + ((unsigned)(v[i] >> shift) & 255u), 1u);
                    asm volatile("" ::: "memory");
                    int T2; unsigned above, c2; radix_pick(h2, lane, (unsigned)need, T2, above, c2);
                    if (T2 < 0) { T2 = 0; }
                    need -= (int)above; cT = c2;
                    pmask |= 255ull << shift; pval |= (unsigned long long)T2 << shift;
                    asm volatile("" ::: "memory");
                }
                { int base = 0;
#pragma unroll
                  for (int i = 0; i < 16; ++i) { if (i < NI) { const bool mt = (v[i] & pmask) == pval; const unsigned long long bm = __ballot(mt);
                      if (mt) { const int pos = base + (int)__popcll(bm & ((1ull << lane) - 1ull)); if (pos < 64) l2[pos] = v[i]; }
                      base += (int)__popcll(bm); } } }
                asm volatile("" ::: "memory");
                const unsigned long long mine = (unsigned)lane < cT ? l2[lane] : 0ull;
                const unsigned mlo = (unsigned)mine, mhi = (unsigned)(mine >> 32);
                int rank = 0;
#pragma unroll 1
                for (unsigned j = 0; j < cT; ++j) { const unsigned long long o = ((unsigned long long)(unsigned)__builtin_amdgcn_readlane((int)mhi, (int)j) << 32) | (unsigned)__builtin_amdgcn_readlane((int)mlo, (int)j);
                    rank += (o > mine) ? 1 : 0; }
                const unsigned long long hit = __ballot((unsigned)lane < cT && rank == need - 1);
                const int hl = hit ? (__ffsll((long long)hit) - 1) : 0;
                tau = ((unsigned long long)(unsigned)__builtin_amdgcn_readlane((int)mhi, hl) << 32) | (unsigned)__builtin_amdgcn_readlane((int)mlo, hl);
                asm volatile("" ::: "memory");
            }
            { int base = 0;
#pragma unroll
              for (int i = 0; i < 16; ++i) { if (i < NI) { const bool e = v[i] >= tau; const unsigned long long bm = __ballot(e);
                  if (e) irow[base + (int)__popcll(bm & ((1ull << lane) - 1ull))] = (unsigned short)(0xffffu - (unsigned)(v[i] & 0xffffull));
                  base += (int)__popcll(bm); } } }
        }
        if (tid < 16) CNT[t0 + tid] = 256;
        __syncthreads();
        if (tid < 16 && qOvf[tid]) { const unsigned k = LDS_ADD(ovl, 1u); ovl[1 + k] = (unsigned)(t0 + 4 * (tid & 3) + (tid >> 2)); }
    }
    __syncthreads();
    const unsigned novl = __builtin_amdgcn_readfirstlane(ovl[0]);
#pragma unroll 1
    for (unsigned k = 0; k < novl; ++k) { const unsigned tq = __builtin_amdgcn_readfirstlane(ovl[1 + k]); indexer_slow_query(p, lds, (size_t)tq); }
}
#undef LDS_ADD

__device__ __forceinline__ void phase_attn(const P& p, unsigned char* lds) {
    unsigned char* ws = p.ws; const int tid = tid_opaque(), lane = tid & 63, hd = lane & 15, g = lane >> 4;
    const int wave = __builtin_amdgcn_readfirstlane(tid >> 6);
    bf16_t* QP = (bf16_t*)(ws + OFF_QP); const bf16_t* CK = (const bf16_t*)(ws + OFF_CKVN); const bf16_t* RK = (const bf16_t*)(ws + OFF_RK);
    const unsigned short* IDX = (const unsigned short*)(ws + OFF_IDX); const int* CNT = (const int*)(ws + OFF_CNT);
    float* biasT = (float*)lds;
    biasT[tid] = p.rel_bias[tid] * 1.4426950408889634f;
    __syncthreads();
    LAS unsigned char* rows = (LAS unsigned char*)(lds + 2048 + (size_t)wave * 18432);
    LAS bf16_t* rkb = (LAS bf16_t*)(rows + 16384);
    LAS unsigned* info = (LAS unsigned*)(rows + 17408);
    const LAS float* biasL = (const LAS float*)lds;
    for (int t = blockIdx.x * 8 + wave; t < T; t += gridDim.x * 8) {
        const int batch = t >> 14, pos = t & (SEQ - 1); const int cnt = __builtin_amdgcn_readfirstlane(CNT[t]);
        const size_t rb = (size_t)batch * SEQ;
        asm volatile("s_waitcnt lgkmcnt(0)" ::: "memory");
#pragma unroll
        for (int jj = 0; jj < 4; ++jj) {
            const int j = lane + 64 * jj; int id = IDX[(size_t)t * 256 + j]; if (j >= cnt) id = 0;
            const int rel = pos - id; int bucket = rel < 0 ? 0 : rel;
            if (rel >= 16) { bucket = 16 + (int)(__logf((float)rel * 0.0625f) / 2.0794415416798357f * 16.0f); bucket = bucket > 31 ? 31 : bucket; }
            info[j] = (unsigned)id | ((unsigned)bucket << 16);
        }
        bf16x8 qf[8];
#pragma unroll
        for (int ks = 0; ks < 8; ++ks) qf[ks] = *(const bf16x8*)(QP + (size_t)t * 4096 + hd * 256 + ks * 32 + g * 8);
        f32x4 o[16];
#pragma unroll
        for (int rt = 0; rt < 16; ++rt) o[rt] = (f32x4){0.f, 0.f, 0.f, 0.f};
        float mref = 0.f, lrun = 0.f;
        asm volatile("s_waitcnt lgkmcnt(0)" ::: "memory");
        const int nch = (cnt + 31) >> 5;
        for (int ch = 0; ch < nch; ++ch) {
            asm volatile("s_waitcnt lgkmcnt(0)" ::: "memory");
#pragma unroll
            for (int i = 0; i < 16; ++i) {
                const int ksl = 2 * i + (lane >> 5); const unsigned idv = info[ch * 32 + ksl] & 0xffffu;
                const bf16_t* src = CK + (rb + idv) * 256 + (((lane & 31) ^ (ksl & 15)) * 8);
                __builtin_amdgcn_global_load_lds((const unsigned*)src, (LAS unsigned*)(rows + i * 1024), 16, 0, 0);
            }
            { const unsigned idv = info[ch * 32 + (lane >> 1)] & 0xffffu;
              __builtin_amdgcn_global_load_lds((const unsigned*)(RK + (rb + idv) * 16 + (lane & 1) * 8), (LAS unsigned*)rkb, 16, 0, 0); }
            asm volatile("s_waitcnt vmcnt(0)" ::: "memory");
            f32x4 s0 = (f32x4){0.f, 0.f, 0.f, 0.f}, s1 = (f32x4){0.f, 0.f, 0.f, 0.f};
#pragma unroll
            for (int ks = 0; ks < 8; ++ks) {
                const int pos16 = ((4 * ks + g) ^ hd) * 16;
                const bf16x8 a0 = *(const LAS bf16x8*)(rows + hd * 512 + pos16);
                const bf16x8 a1 = *(const LAS bf16x8*)(rows + (16 + hd) * 512 + pos16);
                s0 = __builtin_amdgcn_mfma_f32_16x16x32_bf16(a0, qf[ks], s0, 0, 0, 0);
                s1 = __builtin_amdgcn_mfma_f32_16x16x32_bf16(a1, qf[ks], s1, 0, 0, 0);
            }
            float x0[4], x1[4];
#pragma unroll
            for (int r = 0; r < 4; ++r) {
                const int sl0 = 4 * g + r, sl1 = 16 + 4 * g + r, j0 = ch * 32 + sl0, j1 = ch * 32 + sl1;
                const unsigned i0 = info[j0], i1 = info[j1];
                const float r0 = bf2f(rkb[sl0 * 16 + hd]), r1 = bf2f(rkb[sl1 * 16 + hd]);
                x0[r] = fmaf(s0[r], r0, biasL[(i0 >> 16) * 16 + hd]);
                x1[r] = fmaf(s1[r], r1, biasL[(i1 >> 16) * 16 + hd]);
            }
            if (cnt < 256) {
#pragma unroll
                for (int r = 0; r < 4; ++r) { if (ch * 32 + 4 * g + r >= cnt) x0[r] = -INFINITY; if (ch * 32 + 16 + 4 * g + r >= cnt) x1[r] = -INFINITY; }
            }
            const float cml = fmaxf(fmaxf(fmaxf(x0[0], x0[1]), fmaxf(x0[2], x0[3])), fmaxf(fmaxf(x1[0], x1[1]), fmaxf(x1[2], x1[3])));
            if (ch == 0 || __ballot(cml > mref + 11.5f)) {
                float cm = fmaxf(cml, __shfl_xor(cml, 16)); cm = fmaxf(cm, __shfl_xor(cm, 32));
                const float mnew = (ch == 0) ? cm : fmaxf(mref, cm);
                if (ch != 0) { const float sc = __builtin_amdgcn_exp2f(mref - mnew); lrun *= sc;
#pragma unroll
                    for (int rt = 0; rt < 16; ++rt) o[rt] *= sc; }
                mref = mnew;
            }
            float ls = 0.f;
#pragma unroll
            for (int r = 0; r < 4; ++r) { x0[r] = __builtin_amdgcn_exp2f(x0[r] - mref); x1[r] = __builtin_amdgcn_exp2f(x1[r] - mref); ls += x0[r] + x1[r]; }
            lrun += ls;
            u32x4 pw; pw.x = pg8::cvt_pk_bf16(x0[0], x0[1]); pw.y = pg8::cvt_pk_bf16(x0[2], x0[3]); pw.z = pg8::cvt_pk_bf16(x1[0], x1[1]); pw.w = pg8::cvt_pk_bf16(x1[2], x1[3]);
            const bf16x8 pf = __builtin_bit_cast(bf16x8, pw);
            const int q = hd >> 2, pp = hd & 3, ksl = 4 * g + q;
            const LAS unsigned char* trb = rows + ksl * 512 + (pp & 1) * 8;
#pragma unroll
            for (int rt = 0; rt < 16; ++rt) {
                const int c16 = ((2 * rt + (pp >> 1)) ^ ksl) * 16;
                const v4i16_t t0 = __builtin_amdgcn_ds_read_tr16_b64_v4i16((LAS v4i16_t*)(trb + c16));
                const v4i16_t t1 = __builtin_amdgcn_ds_read_tr16_b64_v4i16((LAS v4i16_t*)(trb + c16 + 8192));
                bf16x8 af; af[0] = t0[0]; af[1] = t0[1]; af[2] = t0[2]; af[3] = t0[3]; af[4] = t1[0]; af[5] = t1[1]; af[6] = t1[2]; af[7] = t1[3];
                o[rt] = __builtin_amdgcn_mfma_f32_16x16x32_bf16(af, pf, o[rt], 0, 0, 0);
            }
        }
        float ltot = lrun; ltot += __shfl_xor(ltot, 16); ltot += __shfl_xor(ltot, 32);
        const float inv = 1.0f / ltot;
        bf16_t* op = QP + (size_t)t * 4096 + hd * 256 + 4 * g;
#pragma unroll
        for (int rt = 0; rt < 16; ++rt) { u32x2 w; w.x = pg8::cvt_pk_bf16(o[rt][0] * inv, o[rt][1] * inv); w.y = pg8::cvt_pk_bf16(o[rt][2] * inv, o[rt][3] * inv); *(u32x2*)(op + rt * 16) = w; }
    }
}

__global__ void __launch_bounds__(512, 2) k_fwd(P p_arg, int ph_lo, int ph_hi) {
    extern __shared__ __attribute__((aligned(16))) unsigned char smem[];
    const P& p = *(const P*)__builtin_amdgcn_kernarg_segment_ptr(); (void)p_arg;
    unsigned char* lds = smem + 16;
    unsigned char* ws = p.ws;
    XcdBarrier bar;
    const bool multi = (ph_hi - ph_lo) > 1;
    if (multi) {
        if (threadIdx.x == 0) *(uint4*)smem = make_uint4(0u, 0u, 0u, 0u);
        __syncthreads();
        bar = xcd_barrier_post((unsigned*)(ws + OFF_CTL), (volatile LAS unsigned*)smem);
    }
#define PH(i) (ph_lo <= (i) && (i) < ph_hi)
#define SEAM(i) do { if ((i) + 1 < ph_hi) xcd_barrier(bar); else __syncthreads(); } while (0)
    bf16_t *XN = (bf16_t*)(ws + OFF_XN), *QB = (bf16_t*)(ws + OFF_QB), *KB = (bf16_t*)(ws + OFF_KB), *VB = (bf16_t*)(ws + OFF_VB), *TMP = (bf16_t*)(ws + OFF_TMP), *Y = (bf16_t*)(ws + OFF_Y);
    if (PH(0)) { phase_prep(p, lds); SEAM(0); }
    if (PH(1)) { fast_gemm(lds, XN, 1024, (const bf16_t*)(ws + OFF_W0T), 1024, 3072, 1024, D1{ws}); SEAM(1); }
    if (PH(2)) { phase_conv_scan(p, lds); SEAM(2); }
    if (PH(3)) { mlstm_units<false>(p, lds); SEAM(3); }
    if (PH(4)) { GWP f{(const bf16_t*)(ws + OFF_WPT), (const bf16_t*)(ws + OFF_WUB), (bf16_t*)(ws + OFF_W0T)}; sgemm(f, 256); phase_mlstm_scan(p, lds); SEAM(4); }
    if (PH(5)) { mlstm_units<true>(p, lds); SEAM(5); }
    if (PH(6)) { fast_gemm(lds, XN, 1024, (const bf16_t*)(ws + OFF_W0T) + (size_t)3072 * 1024, 1024, 4096, 1024, D2{ws}); SEAM(6); }
    if (PH(7)) { phase_ya_pool(p); SEAM(7); }
    if (PH(8)) { fast_gemm(lds, Y, 2048, (const bf16_t*)(ws + OFF_WO0T), 2048, 1024, 2048, D4{(unsigned char*)p.out, p.x, ws}); SEAM(8); }
    if (PH(10)) { fast_gemm(lds, XN, 1024, (const bf16_t*)(ws + OFF_W1T), 1024, 2816, 1024, D5{ws, p.o_g_q}); SEAM(10); }
    if (PH(11)) { phase_qnorm_ckvnorm(p); SEAM(11); }
    if (PH(12)) { fast_gemm(lds, (const bf16_t*)(ws + OFF_CKVN), 256, (const bf16_t*)(ws + OFF_WUKP), 256, 1024, 256, DK{ws}); SEAM(12); }
    if (PH(13)) { fast_gemm(lds, TMP, 1024, (const bf16_t*)(ws + OFF_WQF), 128, 4096, 128, DQ{ws}, (size_t)128); phase_indexer(p, lds); SEAM(13); }
    if (PH(14)) { phase_attn(p, lds); SEAM(14); }
    if (PH(15)) { fast_gemm(lds, (const bf16_t*)(ws + OFF_QP), 4096, (const bf16_t*)(ws + OFF_WBD), 1024, 1024, 1024, DO{ws}, (size_t)2048); SEAM(15); }
    if (PH(16)) { fast_gemm(lds, TMP, 1024, (const bf16_t*)(ws + OFF_WO1T), 1024, 1024, 1024, D8{(unsigned char*)p.out}); }
#undef PH
#undef SEAM
}

extern "C" void kernel_launch(void* const* d_in, const int* in_sizes, int n_in, void* d_out, int out_size, void* d_ws, size_t ws_size, hipStream_t stream) {
    static int grid = 0;
    if (grid == 0) {
        if (n_in != 18 || out_size != T * DM || ws_size < WS_END) { fprintf(stderr, "kernel_launch: unexpected shapes (n_in %d out %d ws %zu)\n", n_in, out_size, ws_size); grid = -1; return; }
        if (hipFuncSetAttribute((const void*)k_fwd, hipFuncAttributeMaxDynamicSharedMemorySize, LDS_BYTES) != hipSuccess) { fprintf(stderr, "kernel_launch: hipFuncSetAttribute failed\n"); grid = -1; return; }
        grid = 256;
    }
    if (grid < 0) return;
    (void)hipMemsetAsync((char*)d_ws + OFF_CTL, 0, 16384, stream);
    P p{};
    p.x = (const float*)d_in[0]; p.e_norm = (const float*)d_in[1]; p.e_w_in = (const float*)d_in[2]; p.e_conv = (const float*)d_in[3]; p.e_b_if = (const float*)d_in[4];
    p.e_g_head = (const float*)d_in[5]; p.e_w_pool = (const float*)d_in[6]; p.e_s_pool = (const float*)d_in[7]; p.e_w_out = (const float*)d_in[8];
    p.o_norm = (const float*)d_in[9]; p.o_w_in = (const float*)d_in[10]; p.o_g_kv = (const float*)d_in[11]; p.o_w_uk = (const float*)d_in[12]; p.o_w_uv = (const float*)d_in[13];
    p.o_g_q = (const float*)d_in[14]; p.o_g_k = (const float*)d_in[15]; p.o_w_out = (const float*)d_in[16]; p.rel_bias = (const float*)d_in[17];
    p.out = (float*)d_out; p.ws = (unsigned char*)d_ws;
    hipLaunchKernelGGL(k_fwd, dim3(grid), dim3(512), LDS_BYTES, stream, p, 0, NPH);
}
```

```cpp
#include <hip/hip_runtime.h>
#include <stdint.h>
#include <cstdio>

typedef unsigned short bf16_t;
typedef short bf16x8 __attribute__((ext_vector_type(8)));
typedef float f32x4 __attribute__((ext_vector_type(4)));
typedef unsigned u32x4 __attribute__((ext_vector_type(4)));
typedef unsigned u32x2 __attribute__((ext_vector_type(2)));
typedef short v4i16_t __attribute__((ext_vector_type(4)));
#define LAS __attribute__((address_space(3)))

constexpr int T = 32768, SEQ = 16384, DM = 1024;
constexpr int EIN = 7176, OIN = 2628;
constexpr float EPS = 1e-6f;
constexpr size_t MB = 1048576;
constexpr size_t OFF_CTL = 0;
constexpr size_t OFF_GATES = 64 * 1024;
constexpr size_t OFF_BQ = OFF_GATES + (size_t)T * 8 * 4;
constexpr size_t OFF_IQ = OFF_BQ + (size_t)T * 4 * 4;
constexpr size_t OFF_MT = OFF_IQ + (size_t)T * 4 * 4;
constexpr size_t OFF_WI = OFF_MT + (size_t)T * 4 * 4;
constexpr size_t OFF_CH = OFF_WI + (size_t)T * 4 * 4;
constexpr size_t OFF_NS = OFF_CH + 64 * 1024;
constexpr size_t OFF_RSQ = OFF_GATES;
constexpr size_t OFF_W = 4 * MB;
constexpr size_t OFF_W0T = OFF_W;
constexpr size_t OFF_WPT = OFF_W0T + (size_t)7168 * 1024 * 2;
constexpr size_t OFF_WO0T = OFF_WPT + (size_t)4 * 256 * 256 * 2;
constexpr size_t OFF_W1T = OFF_WO0T + (size_t)1024 * 2048 * 2;
constexpr size_t OFF_WUKT = OFF_W1T + (size_t)2816 * 1024 * 2;
constexpr size_t OFF_WUVT = OFF_WUKT + (size_t)1024 * 256 * 2;
constexpr size_t OFF_WO1T = OFF_WUVT + (size_t)1024 * 256 * 2;
constexpr size_t OFF_WUKP = OFF_WO1T + (size_t)1024 * 1024 * 2;
constexpr size_t OFF_WQP = OFF_WUKP + (size_t)1024 * 256 * 2;
constexpr size_t OFF_WUB = OFF_WQP + (size_t)16 * 256 * 64 * 2;
constexpr size_t OFF_XN = 36 * MB, OFF_QB = 100 * MB, OFF_KB = 164 * MB, OFF_VB = 228 * MB, OFF_TMP = 292 * MB, OFF_Y = 356 * MB;
constexpr size_t OFF_QP = 36 * MB;
constexpr size_t OFF_CKVN = OFF_Y;
constexpr size_t OFF_QI = OFF_Y + 16 * MB;
constexpr size_t OFF_KI = OFF_Y + 32 * MB;
constexpr size_t OFF_KIT = OFF_Y + 36 * MB;
constexpr size_t OFF_IDX = OFF_Y + 40 * MB;
constexpr size_t OFF_RK = OFF_Y + 58 * MB;
constexpr size_t OFF_CNT = OFF_Y + 59 * MB;
constexpr size_t OFF_Z = OFF_Y + 60 * MB;
constexpr size_t OFF_WBD = 484 * MB;
constexpr size_t OFF_WQF = 486 * MB;
constexpr size_t WS_END = 487 * MB;
constexpr int LDS_BYTES = 151552;
constexpr int NPH = 17;

struct P {
    const float *x, *e_norm, *e_w_in, *e_conv, *e_b_if, *e_g_head, *e_w_pool, *e_s_pool, *e_w_out;
    const float *o_norm, *o_w_in, *o_g_kv, *o_w_uk, *o_w_uv, *o_g_q, *o_g_k, *o_w_out, *rel_bias;
    float* out; unsigned char* ws;
};

__device__ __forceinline__ bf16_t f2bf(float f) { unsigned u = __float_as_uint(f); u += 0x7FFFu + ((u >> 16) & 1u); return (bf16_t)(u >> 16); }
__device__ __forceinline__ float bf2f(bf16_t b) { return __uint_as_float(((unsigned)b) << 16); }
__device__ __forceinline__ float bflo(unsigned w) { return __uint_as_float(w << 16); }
__device__ __forceinline__ float bfhi(unsigned w) { return __uint_as_float(w & 0xffff0000u); }
__device__ __forceinline__ unsigned pk2(float a, float b) { return (unsigned)f2bf(a) | ((unsigned)f2bf(b) << 16); }
__device__ __forceinline__ float sigmoidf_(float x) { return __builtin_amdgcn_rcpf(1.0f + __expf(-x)); }
__device__ __forceinline__ float siluf_(float x) { return x * __builtin_amdgcn_rcpf(1.0f + __expf(-x)); }
template <int CTRL> __device__ __forceinline__ float dppf(float v) { return __builtin_bit_cast(float, __builtin_amdgcn_update_dpp(0, __builtin_bit_cast(int, v), CTRL, 0xf, 0xf, true)); }
__device__ __forceinline__ float rlf(float v, int l) { return __builtin_bit_cast(float, __builtin_amdgcn_readlane(__builtin_bit_cast(int, v), l)); }
__device__ __forceinline__ int tid_opaque() { int t = threadIdx.x; asm volatile("" : "+v"(t)); return t; }
__device__ __forceinline__ float wave_sum(float v) {
    v += dppf<0xB1>(v); v += dppf<0x4E>(v); v += dppf<0x141>(v); v += dppf<0x140>(v);
    return (rlf(v, 0) + rlf(v, 16)) + (rlf(v, 32) + rlf(v, 48));
}
__device__ __forceinline__ float wave_max(float v) {
    v = fmaxf(v, dppf<0xB1>(v)); v = fmaxf(v, dppf<0x4E>(v)); v = fmaxf(v, dppf<0x141>(v)); v = fmaxf(v, dppf<0x140>(v));
    return fmaxf(fmaxf(rlf(v, 0), rlf(v, 16)), fmaxf(rlf(v, 32), rlf(v, 48)));
}

template <int CTRL, int RM, bool BC> __device__ __forceinline__ unsigned dppu(unsigned v) { return (unsigned)__builtin_amdgcn_update_dpp(0, (int)v, CTRL, RM, 0xf, BC); }
__device__ __forceinline__ unsigned wave_iscan(unsigned v) {
    v += dppu<0x111, 0xf, true>(v); v += dppu<0x112, 0xf, true>(v); v += dppu<0x114, 0xf, true>(v); v += dppu<0x118, 0xf, true>(v);
    v += dppu<0x142, 0xa, false>(v); v += dppu<0x143, 0xc, false>(v);
    return v;
}
__device__ __forceinline__ unsigned rlu(unsigned v, int l) { return (unsigned)__builtin_amdgcn_readlane((int)v, l); }
__device__ __forceinline__ void radix_pick(const __attribute__((address_space(3))) unsigned* h2, int lane, unsigned want, int& T, unsigned& above, unsigned& cin) {
    asm volatile("" : "+v"(lane));
    const u32x4 hv = *(const __attribute__((address_space(3))) u32x4*)(h2 + 252 - 4 * lane);
    const unsigned cs = hv.x + hv.y + hv.z + hv.w;
    const unsigned incl = wave_iscan(cs);
    const unsigned long long m = __ballot(incl >= want);
    if (m == 0ull) { T = -1; above = rlu(incl, 63); cin = 0u; return; }
    const int Ls = __ffsll((long long)m) - 1;
    unsigned ab = rlu(incl - cs, Ls); const unsigned a0 = rlu(hv.w, Ls), a1 = rlu(hv.z, Ls), a2 = rlu(hv.y, Ls), a3 = rlu(hv.x, Ls);
    int t = 255 - 4 * Ls; unsigned c = a0;
    if (ab + a0 < want) { ab += a0; t -= 1; c = a1; if (ab + a1 < want) { ab += a1; t -= 1; c = a2; if (ab + a2 < want) { ab += a2; t -= 1; c = a3; } } }
    T = t; above = ab; cin = c;
}

#define XB_TMO      128
#define XB_XCNT(j)  (256  + 64 * (j))
#define XB_XSUB(j)  (1280 + 64 * (j))
#define XB_XGEN(j)  (2304 + 64 * (j))
#define XB_TOP      3328
#define XB_TOPGEN   3392
#define XCD_BAR_WORDS 3456
#define XB_SPIN_CAP (1u << 22)
__device__ __forceinline__ unsigned xb_ld(unsigned* p)              { return __hip_atomic_load(p, __ATOMIC_RELAXED, __HIP_MEMORY_SCOPE_AGENT); }
__device__ __forceinline__ unsigned xb_add(unsigned* p, unsigned v) { return __hip_atomic_fetch_add(p, v, __ATOMIC_RELAXED, __HIP_MEMORY_SCOPE_AGENT); }
__device__ __forceinline__ unsigned xb_xcc_id() { return (unsigned)__builtin_amdgcn_s_getreg((3 << 11) | 20) & 0xFu; }
#define XB_SPIN(cond, bar) do { unsigned _sp = 0; while (cond) { __builtin_amdgcn_s_sleep(1); \
    if ((++_sp & 255u) == 0u) { if (xb_ld(&(bar)[XB_TMO])) break; if (_sp > XB_SPIN_CAP) { atomicAdd(&(bar)[XB_TMO], 1u); break; } } } } while (0)
struct XcdBarrier { unsigned* bar; unsigned x; volatile LAS unsigned* st; };
__device__ __forceinline__ XcdBarrier xcd_barrier_post(unsigned* bar, volatile LAS unsigned* st) {
    XcdBarrier b; b.bar = bar; b.x = xb_xcc_id(); b.st = st;
    if (threadIdx.x == 0) (void)xb_add(&bar[XB_XCNT(b.x)], 1u);
    return b;
}
__device__ __forceinline__ void xcd_barrier_complete(unsigned* bar, unsigned x, unsigned& nloc, unsigned& nx) {
    const unsigned G = gridDim.x * gridDim.y * gridDim.z;
    unsigned sum, cnt, mine, sp = 0u;
    for (;;) {
        sum = 0u; cnt = 0u; mine = 0u;
#pragma unroll
        for (unsigned j = 0; j < 16; ++j) { const unsigned c = xb_ld(&bar[XB_XCNT(j)]); sum += c; cnt += (c > 0u) ? 1u : 0u; mine = (j == x) ? c : mine; }
        if (sum == G) break;
        __builtin_amdgcn_s_sleep(1);
        if ((++sp & 255u) == 0u) { if (xb_ld(&bar[XB_TMO])) break; if (sp > XB_SPIN_CAP) { atomicAdd(&bar[XB_TMO], 1u); break; } }
    }
    nloc = mine > 0u ? mine : 1u; nx = cnt > 0u ? cnt : 1u;
}
__device__ __forceinline__ void xcd_barrier(const XcdBarrier& b) {
    asm volatile("s_waitcnt vmcnt(0)" ::: "memory");
    __syncthreads();
    if (threadIdx.x == 0) {
        unsigned* bar = b.bar;
        __builtin_amdgcn_s_waitcnt(0);
        unsigned nloc = b.st[0], nx = b.st[1];
        if (nloc == 0u) { xcd_barrier_complete(bar, b.x, nloc, nx); b.st[0] = nloc; b.st[1] = nx; }
        const unsigned old = xb_add(&bar[XB_XSUB(b.x)], 1u);
        const unsigned gen = old / nloc;
        if (old + 1u == (gen + 1u) * nloc) {
            __builtin_amdgcn_fence(__ATOMIC_RELEASE, "agent");
            asm volatile("s_waitcnt vmcnt(0)" ::: "memory");
            const unsigned og = xb_add(&bar[XB_TOP], 1u);
            const unsigned tg = og / nx;
            if (og + 1u == (tg + 1u) * nx) xb_add(&bar[XB_TOPGEN], 1u);
            else XB_SPIN(xb_ld(&bar[XB_TOPGEN]) == tg, bar);
            __builtin_amdgcn_fence(__ATOMIC_ACQUIRE, "agent");
            xb_add(&bar[XB_XGEN(b.x)], 1u);
            asm volatile("s_waitcnt vmcnt(0)" ::: "memory");
        } else {
            XB_SPIN(xb_ld(&bar[XB_XGEN(b.x)]) == gen, bar);
            __builtin_amdgcn_fence(__ATOMIC_ACQUIRE, "agent");
            asm volatile("s_waitcnt vmcnt(0)" ::: "memory");
        }
    }
    __syncthreads();
}

struct Tile { const bf16_t* A; const bf16_t* B; int lda, ldb, K; void* d0; const void* s0; int ld; };
template <class F>
__device__ __forceinline__ void sgemm(const F f, int nunits) {
    const int lane = threadIdx.x & 63, wave = threadIdx.x >> 6, fr = lane & 15, fq = lane >> 4;
    for (int u = blockIdx.x * 8 + wave; u < nunits; u += gridDim.x * 8) {
        Tile tl; f.tile(u, tl);
        f32x4 acc[4][4];
#pragma unroll
        for (int m = 0; m < 4; ++m)
#pragma unroll
            for (int n = 0; n < 4; ++n) acc[m][n] = (f32x4){0.f, 0.f, 0.f, 0.f};
        const bf16_t* ap = tl.A + (size_t)fr * tl.lda + fq * 8;
        const bf16_t* bp = tl.B + (size_t)fr * tl.ldb + fq * 8;
        const int K = tl.K, lda = tl.lda, ldb = tl.ldb;
        bf16x8 a[4], b[4];
#pragma unroll
        for (int m = 0; m < 4; ++m) a[m] = *(const bf16x8*)(ap + (size_t)(m * 16) * lda);
#pragma unroll
        for (int n = 0; n < 4; ++n) b[n] = *(const bf16x8*)(bp + (size_t)(n * 16) * ldb);
#pragma unroll 1
        for (int k0 = 0; k0 < K; k0 += 32) {
            bf16x8 an[4], bn[4]; const int kn = (k0 + 32 < K) ? k0 + 32 : k0;
#pragma unroll
            for (int m = 0; m < 4; ++m) an[m] = *(const bf16x8*)(ap + (size_t)(m * 16) * lda + kn);
#pragma unroll
            for (int n = 0; n < 4; ++n) bn[n] = *(const bf16x8*)(bp + (size_t)(n * 16) * ldb + kn);
#pragma unroll
            for (int m = 0; m < 4; ++m)
#pragma unroll
                for (int n = 0; n < 4; ++n) acc[m][n] = __builtin_amdgcn_mfma_f32_16x16x32_bf16(b[n], a[m], acc[m][n], 0, 0, 0);
#pragma unroll
            for (int m = 0; m < 4; ++m) { a[m] = an[m]; b[m] = bn[m]; }
        }
#pragma unroll
        for (int m = 0; m < 4; ++m) {
            asm volatile("" ::: "memory");
#pragma unroll
            for (int n = 0; n < 4; ++n) f.out4(tl, m * 16 + fr, n * 16 + 4 * fq, acc[m][n]);
        }
    }
}
__device__ __forceinline__ void store4_bf16(const Tile& tl, int r, int c, const f32x4 v) {
    u32x2 w; w.x = pk2(v[0], v[1]); w.y = pk2(v[2], v[3]); *(u32x2*)((bf16_t*)tl.d0 + (size_t)r * tl.ld + c) = w; }

struct GWP {
    const bf16_t* WPT; const bf16_t* WUB; bf16_t* W0T;
    __device__ __forceinline__ void tile(int u, Tile& tl) const {
        const int kt = u & 15, dt = (u >> 4) & 3, g = u >> 6; tl.A = WPT + (size_t)(g * 256 + dt * 64) * 256; tl.lda = 256; tl.B = WUB + (size_t)kt * 64 * 1024 + g * 256; tl.ldb = 1024; tl.K = 256;
        tl.d0 = W0T + (size_t)(5120 + g * 256 + dt * 64) * 1024 + kt * 64; tl.ld = 1024; }
    __device__ __forceinline__ void out4(const Tile& tl, int r, int c, const f32x4 v) const { store4_bf16(tl, r, c, v); }
};
struct GQP {
    const bf16_t* Qn; const bf16_t* W; bf16_t* QP;
    __device__ __forceinline__ void tile(int u, Tile& tl) const {
        const int nt = u & 3, head = (u >> 2) & 15, mt = u >> 6; tl.A = Qn + (size_t)mt * 64 * 1024 + head * 64; tl.lda = 1024; tl.B = W + (size_t)(head * 256 + nt * 64) * 64; tl.ldb = 64; tl.K = 64;
        tl.d0 = QP + ((size_t)mt * 64 * 16 + head) * 256 + nt * 64; tl.ld = 4096; }
    __device__ __forceinline__ void out4(const Tile& tl, int r, int c, const f32x4 v) const { store4_bf16(tl, r, c, v); }
};
struct GOP {
    const bf16_t* OP; const bf16_t* W; const bf16_t* Z; bf16_t* G;
    __device__ __forceinline__ void tile(int u, Tile& tl) const {
        const int head = u & 15, mt = u >> 4; tl.A = OP + (size_t)mt * 64 * 4096 + head * 256; tl.lda = 4096; tl.B = W + (size_t)head * 64 * 256; tl.ldb = 256; tl.K = 256;
        const size_t o = (size_t)mt * 64 * 1024 + head * 64; tl.d0 = G + o; tl.s0 = Z + o; tl.ld = 1024; }
    __device__ __forceinline__ void out4(const Tile& tl, int r, int c, const f32x4 v) const { const size_t i = (size_t)r * 1024 + c; const u32x2 z = *(const u32x2*)((const bf16_t*)tl.s0 + i);
        u32x2 w; w.x = pk2(v[0] * bflo(z.x), v[1] * bfhi(z.x)); w.y = pk2(v[2] * bflo(z.y), v[3] * bfhi(z.y)); *(u32x2*)((bf16_t*)tl.d0 + i) = w; }
};

namespace pg8 {
constexpr int BM = 256, BK = 64, HALF = 128, HTB = HALF * BK * 2, STAGE_BYTES = 8 * HTB, NXCD = 8, WGM = 8;
__device__ __forceinline__ int lds_byte(int r, int c) { return (r >> 3) * 1024 + (r & 7) * 128 + ((((c >> 3) ^ (r >> 1)) & 7) << 4) + (c & 7) * 2; }
__device__ __forceinline__ void stage_rc(int b, int& R, int& C) { const int st = b / 1024, sb = b % 1024; R = st * 8 + (sb >> 7); C = ((((sb >> 4) & 7) ^ (R >> 1)) & 7) * 8; }
__device__ __forceinline__ int perm32(int rho) { const int n = rho >> 4, i = rho & 15; return 8 * (i >> 2) + 4 * n + (i & 3); }
struct Unit { int pm, pn; };
struct Gemm { const bf16_t* A; int lda; const bf16_t* Bt; int ldb; int M, N, K; size_t apn; };
struct StaticOrder {
    int nM, nN, nwg, G, c;
    __device__ void init(int M, int N, int G_, int c_) { nM = M / BM; nN = N / BM; nwg = nM * nN; G = G_; c = c_; }
    __device__ bool next(int i, Unit& u) const {
        const long L = (long)i * G + c; if (L >= nwg) return false;
        int wgid = (int)L; { const int q = nwg / NXCD, r = nwg % NXCD, xcd = wgid % NXCD, off = wgid / NXCD; wgid = (xcd < r ? xcd * (q + 1) : r * (q + 1) + (xcd - r) * q) + off; }
        const int nig = WGM * nN, gid = wgid / nig, fm = gid * WGM, gsz = (nM - fm) < WGM ? (nM - fm) : WGM;
        u.pm = fm + ((wgid % nig) % gsz); u.pn = (wgid % nig) / gsz; return true;
    }
};
__device__ __forceinline__ unsigned cvt_pk_bf16(float lo, float hi) { unsigned r; asm volatile("v_cvt_pk_bf16_f32 %0, %1, %2" : "=v"(r) : "v"(lo), "v"(hi)); return r; }

struct Dst { unsigned char* base; const float* res; int ld, mode, ncol; float scale; unsigned char* aux; float* rsq; };
template <class DescF> struct EpiGen {
    static constexpr bool PERM = true;
    DescF D;
    __device__ __forceinline__ void operator()(const f32x4 (&acc)[2][2][4][2], const Unit& u, int wr, int wc, int fr, int fq) const {
        Dst d; D.get(u, d);
        if ((DescF::MODES & 16) && d.mode == 4) return;
        const int r0 = wr * 64 + fr, c0 = wc * 32 + 8 * fq;
        if constexpr ((DescF::MODES & 64) != 0) {
#pragma unroll
            for (int ai = 0; ai < 2; ++ai)
#pragma unroll
                for (int m = 0; m < 4; ++m) {
                    float ss = 0.f;
#pragma unroll
                    for (int bj = 0; bj < 2; ++bj)
#pragma unroll
                        for (int n = 0; n < 2; ++n) { const f32x4 v = acc[ai][bj][m][n]; ss += v[0] * v[0] + v[1] * v[1] + v[2] * v[2] + v[3] * v[3]; }
                    ss += __shfl_xor(ss, 16); ss += __shfl_xor(ss, 32);
                    if (fq == 0) ((bf16_t*)d.base)[(size_t)(ai * HALF + r0 + m * 16) * d.ld + wc] = f2bf(rsqrtf(ss * (1.0f / 64.0f) + EPS) * 1.4426950408889634f);
                }
            return;
        } else {
        float rsd[2][4];
        if constexpr ((DescF::MODES & 1024) != 0) {
#pragma unroll
            for (int ai = 0; ai < 2; ++ai)
#pragma unroll
                for (int m = 0; m < 4; ++m) { const size_t grow = (size_t)u.pm * BM + ai * HALF + r0 + m * 16; const f32x4 pp = *(const f32x4*)(d.rsq + grow * 16 + fq * 4);
                    float t = (pp[0] + pp[1]) + (pp[2] + pp[3]); t += __shfl_xor(t, 16); t += __shfl_xor(t, 32); rsd[ai][m] = rsqrtf(t * (1.0f / 1024.0f) + EPS); }
        }
        f32x4 gq[2][2];
        if constexpr ((DescF::MODES & 2048) != 0) { if (d.mode == 10) {
#pragma unroll
            for (int bj = 0; bj < 2; ++bj) { gq[bj][0] = *(const f32x4*)(d.res + 32 * bj + 8 * fq); gq[bj][1] = *(const f32x4*)(d.res + 32 * bj + 8 * fq + 4); } } }
#pragma unroll
        for (int ai = 0; ai < 2; ++ai)
#pragma unroll
            for (int m = 0; m < 4; ++m) {
                const size_t rowoff = (size_t)(ai * HALF + r0 + m * 16) * d.ld;
                if constexpr ((DescF::MODES & 2048) != 0) { if (d.mode == 10) {
                    f32x4 q[2][2]; float ss = 0.f;
#pragma unroll
                    for (int bj = 0; bj < 2; ++bj)
#pragma unroll
                        for (int n = 0; n < 2; ++n) { q[bj][n] = acc[ai][bj][m][n] * rsd[ai][m]; ss += q[bj][n][0] * q[bj][n][0] + q[bj][n][1] * q[bj][n][1] + q[bj][n][2] * q[bj][n][2] + q[bj][n][3] * q[bj][n][3]; }
                    ss += __shfl_xor(ss, 16); ss += __shfl_xor(ss, 32);
                    const float rh = rsqrtf(ss * (1.0f / 64.0f) + EPS);
#pragma unroll
                    for (int bj = 0; bj < 2; ++bj) { const f32x4 x0 = q[bj][0] * rh * gq[bj][0], x1 = q[bj][1] * rh * gq[bj][1];
                        u32x4 w; w.x = cvt_pk_bf16(x0[0], x0[1]); w.y = cvt_pk_bf16(x0[2], x0[3]); w.z = cvt_pk_bf16(x1[0], x1[1]); w.w = cvt_pk_bf16(x1[2], x1[3]);
                        *(u32x4*)((bf16_t*)d.base + rowoff + (4 * (u.pn & 3) + wc) * 64 + 32 * bj + 8 * fq) = w; }
                    continue; } }
                float ssq = 0.f;
#pragma unroll
                for (int bj = 0; bj < 2; ++bj) {
                    const int col = bj * HALF + c0; f32x4 v0 = acc[ai][bj][m][0], v1 = acc[ai][bj][m][1];
                    if constexpr ((DescF::MODES & 1024) != 0) { v0 *= rsd[ai][m]; v1 *= rsd[ai][m]; }
                    if ((DescF::MODES & 7) && d.mode <= 2) {
                        if ((DescF::MODES & 2) && d.mode == 1) {
#pragma unroll
                            for (int j = 0; j < 4; ++j) { v0[j] = sigmoidf_(v0[j]); v1[j] = sigmoidf_(v1[j]); } }
                        if ((DescF::MODES & 4) && d.mode == 2) {
#pragma unroll
                            for (int j = 0; j < 4; ++j) { v0[j] = siluf_(v0[j]); v1[j] = siluf_(v1[j]); } }
                        u32x4 w; w.x = cvt_pk_bf16(v0[0], v0[1]); w.y = cvt_pk_bf16(v0[2], v0[3]); w.z = cvt_pk_bf16(v1[0], v1[1]); w.w = cvt_pk_bf16(v1[2], v1[3]);
                        *(u32x4*)((bf16_t*)d.base + rowoff + col) = w;
                    } else if ((DescF::MODES & 256) && d.mode == 8) {
                        const u32x4 z = *(const u32x4*)((const bf16_t*)d.res + rowoff + col);
                        u32x4 w; w.x = cvt_pk_bf16(v0[0] * bflo(z.x), v0[1] * bfhi(z.x)); w.y = cvt_pk_bf16(v0[2] * bflo(z.y), v0[3] * bfhi(z.y));
                        w.z = cvt_pk_bf16(v1[0] * bflo(z.z), v1[1] * bfhi(z.z)); w.w = cvt_pk_bf16(v1[2] * bflo(z.w), v1[3] * bfhi(z.w));
                        *(u32x4*)((bf16_t*)d.base + rowoff + col) = w;
                    } else if ((DescF::MODES & 8) && d.mode == 3) {
                        if (col < d.ncol) { float* o = (float*)d.base + rowoff + col; *(f32x4*)o = v0 * d.scale; *(f32x4*)(o + 4) = v1 * d.scale; }
                    } else if ((DescF::MODES & 128) && d.mode == 7) {
                        typedef _Float16 h8 __attribute__((ext_vector_type(8)));
                        if (col < d.ncol) {
                        h8 hv; hv[0] = (_Float16)(v0[0] * d.scale); hv[1] = (_Float16)(v0[1] * d.scale); hv[2] = (_Float16)(v0[2] * d.scale); hv[3] = (_Float16)(v0[3] * d.scale);
                        hv[4] = (_Float16)(v1[0] * d.scale); hv[5] = (_Float16)(v1[1] * d.scale); hv[6] = (_Float16)(v1[2] * d.scale); hv[7] = (_Float16)(v1[3] * d.scale);
                        *(h8*)((_Float16*)d.base + rowoff + col) = hv; }
                        if constexpr ((DescF::MODES & 4096) != 0) { if (col == 64 && d.ncol == 64) *(f32x4*)((float*)d.aux + ((size_t)u.pm * BM + ai * HALF + r0 + m * 16) * 4) = v0 * 0.5f; }
                    } else if constexpr ((DescF::MODES & 32) != 0) {
                        float* o = (float*)d.base + rowoff + col; const float* rs = d.res + rowoff + col;
                        const f32x4 a = *(const f32x4*)rs + v0, b = *(const f32x4*)(rs + 4) + v1; *(f32x4*)o = a; *(f32x4*)(o + 4) = b;
                        if constexpr ((DescF::MODES & 512) != 0) {
                            u32x4 w; w.x = cvt_pk_bf16(a[0], a[1]); w.y = cvt_pk_bf16(a[2], a[3]); w.z = cvt_pk_bf16(b[0], b[1]); w.w = cvt_pk_bf16(b[2], b[3]);
                            *(u32x4*)((bf16_t*)d.aux + rowoff + col) = w;
                            ssq += (a[0] * a[0] + a[1] * a[1]) + (a[2] * a[2] + a[3] * a[3]) + (b[0] * b[0] + b[1] * b[1]) + (b[2] * b[2] + b[3] * b[3]); }
                    }
                }
                if constexpr ((DescF::MODES & 512) != 0) { ssq += __shfl_xor(ssq, 16); ssq += __shfl_xor(ssq, 32);
                    if (fq == 0) d.rsq[((size_t)u.pm * BM + ai * HALF + r0 + m * 16) * 16 + 4 * u.pn + wc] = ssq; }
                if (m & 1) asm volatile("" ::: "memory");
            }
        }
    }
};

template <class Epi>
__device__ __forceinline__ void gemm_phase(LAS unsigned char* lds, const Gemm g, const StaticOrder& S, const Epi& E) {
    const int tid = threadIdx.x, wid = __builtin_amdgcn_readfirstlane(tid >> 6), lane = tid & 63, wr = wid >> 2, wc = wid & 3, fr = lane & 15, fq = lane >> 4;
    int K = g.K; asm volatile("" : "+s"(K));
    const int nt = K / BK;
    unsigned voffA[2], voffB[2];
#pragma unroll
    for (int i = 0; i < 2; ++i) { int R, C; stage_rc(tid * 16 + i * 8192, R, C); const int Rb = Epi::PERM ? ((R & ~31) + perm32(R & 31)) : R;
        voffA[i] = (unsigned)(R * g.lda + C) * 2u; voffB[i] = (unsigned)(Rb * g.ldb + C) * 2u; }
    const size_t kstep = (size_t)(BK * 2);
    const size_t hstepA = (size_t)HALF * g.lda * 2, hstepB = (size_t)HALF * g.ldb * 2;
    const size_t tstepA = 2 * hstepA, tstepB = 2 * hstepB;
    const unsigned ldsw = (unsigned)wid * 1024u;
    const int aoff = lds_byte(wr * 64 + fr, fq * 8), boff = lds_byte(wc * 32 + fr, fq * 8), aoff1 = aoff ^ 64, boff1 = boff ^ 64;
#define PG8_SA(b, h) (((b) * 2 + (h)) * HTB)
#define PG8_SB(b, h) ((4 + (b) * 2 + (h)) * HTB)
#define PG8_STAGE(bufoff, gbase, voff) do { _Pragma("unroll") for (int _i = 0; _i < 2; ++_i) \
        __builtin_amdgcn_global_load_lds((const unsigned*)((const char*)(gbase) + (voff)[_i]), (LAS unsigned*)(lds + (bufoff) + ldsw + _i * 8192), 16, 0, 0); } while (0)
#define PG8_LDA(dst, b, h) do { _Pragma("unroll") for (int m = 0; m < 4; ++m) _Pragma("unroll") for (int k = 0; k < 2; ++k) dst[m][k] = *(const LAS bf16x8*)(lds + PG8_SA(b, h) + (k ? aoff1 : aoff) + m * 2048); } while (0)
#define PG8_LDB(dst, b, h) do { _Pragma("unroll") for (int n = 0; n < 2; ++n) _Pragma("unroll") for (int k = 0; k < 2; ++k) dst[n][k] = *(const LAS bf16x8*)(lds + PG8_SB(b, h) + (k ? boff1 : boff) + n * 2048); } while (0)
#define PG8_MMA(ai, bj, At, Bt) do { __builtin_amdgcn_s_setprio(1); _Pragma("unroll") for (int m = 0; m < 4; ++m) _Pragma("unroll") for (int n = 0; n < 2; ++n) _Pragma("unroll") for (int k = 0; k < 2; ++k) \
        acc[ai][bj][m][n] = __builtin_amdgcn_mfma_f32_16x16x32_bf16(Bt[n][k], At[m][k], acc[ai][bj][m][n], 0, 0, 0); __builtin_amdgcn_s_setprio(0); } while (0)
#define PG8_WAIT_V(n) asm volatile("s_waitcnt vmcnt(" #n ")" ::: "memory")
#define PG8_WAIT_L(n) asm volatile("s_waitcnt lgkmcnt(" #n ")" ::: "memory")
#define PG8_BAR __builtin_amdgcn_s_barrier()
#define PG8_SCHED __builtin_amdgcn_sched_barrier(0)
    Unit cur, nxt; int ui = 0;
    if (!S.next(0, cur)) return;
    f32x4 acc[2][2][4][2];
#pragma unroll
    for (int a = 0; a < 2; ++a)
#pragma unroll
        for (int b = 0; b < 2; ++b)
#pragma unroll
            for (int m = 0; m < 4; ++m)
#pragma unroll
                for (int n = 0; n < 2; ++n) acc[a][b][m][n] = (f32x4){0.f, 0.f, 0.f, 0.f};
    bf16x8 At[4][2], B0[2][2], B1[2][2];
    const char* cA = (const char*)g.A + (size_t)cur.pm * tstepA + (size_t)cur.pn * g.apn; const char* cB = (const char*)g.Bt + (size_t)cur.pn * tstepB;
    PG8_STAGE(PG8_SB(0, 0), cB, voffB); PG8_STAGE(PG8_SA(0, 0), cA, voffA); PG8_STAGE(PG8_SB(0, 1), cB + hstepB, voffB); PG8_STAGE(PG8_SA(0, 1), cA + hstepA, voffA);
    if (wr == 1) PG8_BAR;
    PG8_WAIT_V(4); PG8_BAR;
    PG8_STAGE(PG8_SB(1, 0), cB + kstep, voffB); PG8_STAGE(PG8_SA(1, 0), cA + kstep, voffA); PG8_STAGE(PG8_SB(1, 1), cB + hstepB + kstep, voffB);
    PG8_WAIT_V(6); PG8_BAR;
    for (;;) {
        const bool has_next = S.next(ui + 1, nxt);
        const char* nA = has_next ? (const char*)g.A + (size_t)nxt.pm * tstepA + (size_t)nxt.pn * g.apn : cA; const char* nB = has_next ? (const char*)g.Bt + (size_t)nxt.pn * tstepB : cB;
#pragma unroll 1
        for (int t = 0; t < nt; t += 2) {
            const bool last = (t == nt - 2);
            const char* a1 = cA + (size_t)(t + 1) * kstep;
            const char* a2 = last ? nA : cA + (size_t)(t + 2) * kstep; const char* b2 = last ? nB : cB + (size_t)(t + 2) * kstep;
            const char* a3 = a2 + kstep; const char* b3 = b2 + kstep;
            PG8_LDB(B0, 0, 0); PG8_SCHED; PG8_LDA(At, 0, 0); PG8_STAGE(PG8_SA(1, 1), a1 + hstepA, voffA);
            PG8_WAIT_L(8); PG8_BAR; PG8_WAIT_L(0); PG8_MMA(0, 0, At, B0); PG8_BAR; PG8_SCHED;
            PG8_LDB(B1, 0, 1); PG8_STAGE(PG8_SB(0, 0), b2, voffB);
            PG8_BAR; PG8_WAIT_L(0); PG8_MMA(0, 1, At, B1); PG8_BAR;
            PG8_LDA(At, 0, 1); PG8_STAGE(PG8_SA(0, 0), a2, voffA);
            PG8_BAR; PG8_WAIT_L(0); PG8_MMA(1, 0, At, B0); PG8_BAR; PG8_SCHED;
            PG8_STAGE(PG8_SB(0, 1), b2 + hstepB, voffB);
            PG8_WAIT_V(6); PG8_BAR; PG8_MMA(1, 1, At, B1); PG8_BAR;
            PG8_LDB(B0, 1, 0); PG8_SCHED; PG8_LDA(At, 1, 0); PG8_STAGE(PG8_SA(0, 1), a2 + hstepA, voffA);
            PG8_WAIT_L(8); PG8_BAR; PG8_WAIT_L(0); PG8_MMA(0, 0, At, B0); PG8_BAR; PG8_SCHED;
            PG8_LDB(B1, 1, 1); PG8_STAGE(PG8_SB(1, 0), b3, voffB);
            PG8_BAR; PG8_WAIT_L(0); PG8_MMA(0, 1, At, B1); PG8_BAR;
            PG8_LDA(At, 1, 1); PG8_STAGE(PG8_SA(1, 0), a3, voffA);
            PG8_BAR; PG8_WAIT_L(0); PG8_MMA(1, 0, At, B0); PG8_BAR; PG8_SCHED;
            PG8_STAGE(PG8_SB(1, 1), b3 + hstepB, voffB);
            PG8_WAIT_V(6); PG8_BAR; PG8_MMA(1, 1, At, B1); PG8_BAR;
        }
        E(acc, cur, wr, wc, fr, fq);
        if (!has_next) break;
#pragma unroll
        for (int a = 0; a < 2; ++a)
#pragma unroll
            for (int b = 0; b < 2; ++b)
#pragma unroll
                for (int m = 0; m < 4; ++m)
#pragma unroll
                    for (int n = 0; n < 2; ++n) acc[a][b][m][n] = (f32x4){0.f, 0.f, 0.f, 0.f};
        cur = nxt; cA = nA; cB = nB; ++ui;
    }
    PG8_WAIT_V(0);
    if (wr == 0) PG8_BAR;
    PG8_BAR;
#undef PG8_SA
#undef PG8_SB
#undef PG8_STAGE
#undef PG8_LDA
#undef PG8_LDB
#undef PG8_MMA
#undef PG8_WAIT_V
#undef PG8_WAIT_L
#undef PG8_BAR
#undef PG8_SCHED
}
}

struct D1 { static constexpr int MODES = 1; unsigned char* ws;
    __device__ __forceinline__ void get(const pg8::Unit& u, pg8::Dst& d) const { const int sec = u.pn >> 2;
        d.base = ws + OFF_QB + (size_t)sec * (64 * MB) + ((size_t)u.pm * 256 * 1024 + (u.pn & 3) * 256) * 2; d.res = nullptr; d.ld = 1024; d.mode = 0; d.ncol = 256; d.scale = 1.f; } };
struct D2 { static constexpr int MODES = 7; unsigned char* ws;
    __device__ __forceinline__ void get(const pg8::Unit& u, pg8::Dst& d) const { const int sec = u.pn >> 2, cc = (u.pn & 3) * 256; d.res = nullptr; d.ncol = 256; d.scale = 1.f;
        if (sec < 3) { d.base = ws + OFF_QB + (size_t)sec * (64 * MB) + ((size_t)u.pm * 256 * 1024 + cc) * 2; d.ld = 1024; d.mode = sec == 0 ? 1 : (sec == 1 ? 2 : 0); }
        else { d.base = ws + OFF_Y + ((size_t)u.pm * 256 * 2048 + 1024 + cc) * 2; d.ld = 2048; d.mode = 2; } } };
struct D4 { static constexpr int MODES = 32 | 512; unsigned char* out; const float* x; unsigned char* ws;
    __device__ __forceinline__ void get(const pg8::Unit& u, pg8::Dst& d) const { const size_t o = (size_t)u.pm * 256 * 1024 + u.pn * 256;
        d.base = out + o * 4; d.res = x + o; d.ld = 1024; d.mode = 5; d.ncol = 256; d.scale = 1.f; d.aux = ws + OFF_XN + o * 2; d.rsq = (float*)(ws + OFF_RSQ); } };
struct D5 { static constexpr int MODES = 133 | 1024 | 2048 | 4096; unsigned char* ws; const float* g_q;
    __device__ __forceinline__ void get(const pg8::Unit& u, pg8::Dst& d) const { const int pn = u.pn; d.res = nullptr; d.ncol = 256; d.scale = 1.f; d.rsq = (float*)(ws + OFF_RSQ); d.aux = ws + OFF_WI;
        if (pn < 4) { d.base = ws + OFF_TMP + (size_t)u.pm * 256 * 1024 * 2; d.res = g_q; d.ld = 1024; d.mode = 10; }
        else if (pn == 4) { d.base = ws + OFF_CKVN + (size_t)u.pm * 256 * 256 * 2; d.ld = 256; d.mode = 0; }
        else if (pn == 5) { d.base = ws + OFF_QI + (size_t)u.pm * 256 * 256 * 2; d.ld = 256; d.mode = 7; d.scale = 0.125f; }
        else if (pn == 6) { d.base = ws + OFF_KI + (size_t)u.pm * 256 * 64 * 2; d.ld = 64; d.mode = 7; d.ncol = 64; }
        else { d.base = ws + OFF_Z + ((size_t)u.pm * 256 * 1024 + (pn - 7) * 256) * 2; d.ld = 1024; d.mode = 2; } } };
struct DK { static constexpr int MODES = 64; unsigned char* ws;
    __device__ __forceinline__ void get(const pg8::Unit& u, pg8::Dst& d) const {
        d.base = ws + OFF_RK + ((size_t)u.pm * 256 * 16 + u.pn * 4) * 2; d.res = nullptr; d.ld = 16; d.mode = 6; d.ncol = 256; d.scale = 1.f; } };
struct D8 { static constexpr int MODES = 32; unsigned char* out;
    __device__ __forceinline__ void get(const pg8::Unit& u, pg8::Dst& d) const { const size_t o = (size_t)u.pm * 256 * 1024 + u.pn * 256;
        d.base = out + o * 4; d.res = (const float*)out + o; d.ld = 1024; d.mode = 5; d.ncol = 256; d.scale = 1.f; } };
struct DQ { static constexpr int MODES = 1; unsigned char* ws;
    __device__ __forceinline__ void get(const pg8::Unit& u, pg8::Dst& d) const {
        d.base = ws + OFF_QP + ((size_t)u.pm * 256 * 4096 + u.pn * 256) * 2; d.res = nullptr; d.ld = 4096; d.mode = 0; d.ncol = 256; d.scale = 1.f; } };
struct DO { static constexpr int MODES = 256; unsigned char* ws;
    __device__ __forceinline__ void get(const pg8::Unit& u, pg8::Dst& d) const { const size_t o = ((size_t)u.pm * 256 * 1024 + u.pn * 256) * 2;
        d.base = ws + OFF_TMP + o; d.res = (const float*)(ws + OFF_Z + o); d.ld = 1024; d.mode = 8; d.ncol = 256; d.scale = 1.f; } };
template <class DF>
__device__ __forceinline__ void fast_gemm(unsigned char* lds, const bf16_t* A, int lda, const bf16_t* Bt, int ldb, int N, int K, const DF& df, size_t apn = 0) {
    pg8::Gemm g{A, lda, Bt, ldb, T, N, K, apn}; pg8::StaticOrder S; S.init(T, N, (int)gridDim.x, (int)blockIdx.x);
    pg8::EpiGen<DF> E{df};
    pg8::gemm_phase(( LAS unsigned char*)lds, g, S, E);
}

template <bool QPERM = false>
__device__ __forceinline__ void tconv(const float* __restrict__ src, int ld, int col0, int ncols, int K, bf16_t* __restrict__ dst, float* tile  , const float* __restrict__ kscale = nullptr) {
    const int nkt = K / 64, ntiles = nkt * (ncols / 64), tid = threadIdx.x;
    const bool vec = ((col0 | ld) & 3) == 0;
    const int lk = tid >> 4, ln = (tid & 15) * 4;
    const int sn = tid >> 3, sk = (tid & 7) * 8;
    for (int id0 = blockIdx.x * 2; id0 < ntiles; id0 += gridDim.x * 2) {
        f32x4 v[2][2];
#pragma unroll
        for (int u = 0; u < 2; ++u) { const int id = id0 + u; if (id < ntiles) { const int kt = id % nkt, nt = id / nkt;
#pragma unroll
            for (int h = 0; h < 2; ++h) { const float* sp = src + (size_t)(kt * 64 + lk + 32 * h) * ld + col0 + nt * 64 + ln;
                if (vec) v[u][h] = *(const f32x4*)sp; else { v[u][h][0] = sp[0]; v[u][h][1] = sp[1]; v[u][h][2] = sp[2]; v[u][h][3] = sp[3]; }
                if (kscale) v[u][h] *= kscale[kt * 64 + lk + 32 * h]; } } }
#pragma unroll
        for (int u = 0; u < 2; ++u) { if (id0 + u < ntiles) {
#pragma unroll
            for (int h = 0; h < 2; ++h) { const int k = lk + 32 * h; *(f32x4*)(tile + u * 4352 + k * 68 + (ln ^ (k & 56))) = v[u][h]; } } }
        __syncthreads();
#pragma unroll
        for (int u = 0; u < 2; ++u) { const int id = id0 + u; if (id < ntiles) { const int kt = id % nkt, nt = id / nkt;
            const float* tp = tile + u * 4352 + sk * 68 + (sn ^ sk);
            u32x4 o; o.x = pk2(tp[0], tp[68]); o.y = pk2(tp[136], tp[204]); o.z = pk2(tp[272], tp[340]); o.w = pk2(tp[408], tp[476]);
            int nrow = nt * 64 + sn; if (QPERM) { const int hq = nrow >> 6, dq = nrow & 63; nrow = (hq >> 2) * 256 + 128 * (dq >> 5) + 32 * (hq & 3) + (dq & 31); }
            *(u32x4*)(dst + (size_t)nrow * K + kt * 64 + sk) = o; } }
        __syncthreads();
    }
}
template <int NE>
__device__ __forceinline__ void rmsnorm_rows(const float* __restrict__ src, const float* __restrict__ g, bf16_t* __restrict__ dst,
                             const float* __restrict__ Wx, int ldw, int col0, const float* __restrict__ bias, float scale, float* __restrict__ dstx, float* wl) {
    const int lane = threadIdx.x & 63, wave = threadIdx.x >> 6;
    __syncthreads();
    for (int i = threadIdx.x; i < NE * 1024; i += 512) { const int k = i / NE, e = i % NE; wl[e * 1024 + k] = Wx[(size_t)k * ldw + col0 + e]; }
    __syncthreads();
    for (int row0 = (blockIdx.x * 8 + wave) * 2; row0 < T; row0 += gridDim.x * 16) {
        f32x4 v[2][4];
#pragma unroll
        for (int r = 0; r < 2; ++r)
#pragma unroll
            for (int i = 0; i < 4; ++i) v[r][i] = *(const f32x4*)(src + (size_t)(row0 + r) * 1024 + i * 256 + lane * 4);
#pragma unroll
        for (int r = 0; r < 2; ++r) {
            const int row = row0 + r; float ss = 0.f;
#pragma unroll
            for (int i = 0; i < 4; ++i) ss += v[r][i][0] * v[r][i][0] + v[r][i][1] * v[r][i][1] + v[r][i][2] * v[r][i][2] + v[r][i][3] * v[r][i][3];
            ss = wave_sum(ss);
            const float rstd = rsqrtf(ss * (1.0f / 1024.0f) + EPS);
            float ex[NE];
#pragma unroll
            for (int e = 0; e < NE; ++e) ex[e] = 0.f;
#pragma unroll
            for (int i = 0; i < 4; ++i) {
                const f32x4 gg = *(const f32x4*)(g + i * 256 + lane * 4);
                f32x4 y; y[0] = v[r][i][0] * rstd * gg[0]; y[1] = v[r][i][1] * rstd * gg[1]; y[2] = v[r][i][2] * rstd * gg[2]; y[3] = v[r][i][3] * rstd * gg[3];
                u32x2 w; w.x = pk2(y[0], y[1]); w.y = pk2(y[2], y[3]);
                *(u32x2*)(dst + (size_t)row * 1024 + i * 256 + lane * 4) = w;
#pragma unroll
                for (int e = 0; e < NE; ++e) { const f32x4 wv = *(const f32x4*)(wl + e * 1024 + i * 256 + lane * 4); ex[e] += y[0] * wv[0] + y[1] * wv[1] + y[2] * wv[2] + y[3] * wv[3]; }
            }
#pragma unroll
            for (int e = 0; e < NE; ++e) { const float sx = wave_sum(ex[e]); if (lane == 0) dstx[(size_t)row * NE + e] = (sx + (bias ? bias[e] : 0.f)) * scale; }
        }
    }
}

__device__ __forceinline__ void phase_prep(const P& p, unsigned char* lds) {
    float* tile = (float*)lds; unsigned char* ws = p.ws;
    bf16_t* W0T = (bf16_t*)(ws + OFF_W0T);
    tconv(p.e_w_in, EIN, 0, 5120, 1024, W0T, tile);
    tconv(p.e_w_in, EIN, 6152, 1024, 1024, W0T + (size_t)6144 * 1024, tile);
    for (int g = 0; g < 4; ++g) tconv(p.e_w_pool + (size_t)g * 65536, 256, 0, 256, 256, (bf16_t*)(ws + OFF_WPT) + (size_t)g * 65536, tile);
    { bf16_t* WUB = (bf16_t*)(ws + OFF_WUB);
      for (size_t i = (size_t)blockIdx.x * 512 + threadIdx.x; i < (size_t)1024 * 256; i += (size_t)gridDim.x * 512) {
          const size_t k = i >> 8; const int c4 = (int)(i & 255) * 4; const f32x4 v = *(const f32x4*)(p.e_w_in + k * EIN + 5128 + c4);
          u32x2 o; o.x = pk2(v[0], v[1]); o.y = pk2(v[2], v[3]); *(u32x2*)(WUB + k * 1024 + c4) = o; } }
    tconv(p.e_w_out, 1024, 0, 1024, 2048, (bf16_t*)(ws + OFF_WO0T), tile);
    bf16_t* W1T = (bf16_t*)(ws + OFF_W1T);
    tconv<true>(p.o_w_in, OIN, 0, 1024, 1024, W1T, tile, p.o_norm);
    tconv(p.o_w_in, OIN, 1024, 576, 1024, W1T + (size_t)1024 * 1024, tile, p.o_norm);
    for (size_t i = (size_t)blockIdx.x * 512 + threadIdx.x; i < (size_t)192 * 1024; i += (size_t)gridDim.x * 512) { const int e = (int)(i >> 10), k = (int)(i & 1023);
        W1T[(size_t)1600 * 1024 + i] = e < 4 ? f2bf(p.o_w_in[(size_t)k * OIN + 1600 + e] * p.o_norm[k]) : (bf16_t)0; }
    tconv(p.o_w_in, OIN, 1604, 1024, 1024, W1T + (size_t)1792 * 1024, tile, p.o_norm);
    {
        bf16_t* WUKP = (bf16_t*)(ws + OFF_WUKP); bf16_t* WQF = (bf16_t*)(ws + OFF_WQF); bf16_t* WBD = (bf16_t*)(ws + OFF_WBD);
        for (size_t i = (size_t)blockIdx.x * 512 + threadIdx.x; i < (size_t)1024 * 256; i += (size_t)gridDim.x * 512) {
            { const int n = (int)(i >> 8), k = (int)(i & 255), pn = n >> 8, rem = n & 255, bj = rem >> 7, wc = (rem >> 5) & 3, x = rem & 31;
              WUKP[i] = f2bf(p.o_w_uk[(size_t)k * 1024 + (4 * pn + wc) * 64 + 32 * bj + x]); }
            { const int d = (int)(i & 63), r = (int)((i >> 6) & 255), h = (int)(i >> 14); const size_t o = ((size_t)h * 256 + r) * 128 + d;
              WQF[o] = f2bf(p.o_w_uk[(size_t)r * 1024 + h * 64 + d] * p.o_g_k[d] * 0.125f); WQF[o + 64] = 0; }
            { const int r = (int)(i & 255), n = (int)(i >> 8), hl = (n >> 6) & 3; const float v = p.o_w_uv[(size_t)r * 1024 + n];
#pragma unroll
              for (int b = 0; b < 4; ++b) WBD[(size_t)n * 1024 + b * 256 + r] = (b == hl) ? f2bf(v) : (bf16_t)0; }
        }
    }
    tconv(p.o_w_out, 1024, 0, 1024, 1024, (bf16_t*)(ws + OFF_WO1T), tile);
    rmsnorm_rows<8>(p.x, p.e_norm, (bf16_t*)(ws + OFF_XN), p.e_w_in, EIN, 5120, p.e_b_if, 1.0f, (float*)(ws + OFF_GATES), (float*)lds);
}

__device__ __forceinline__ void phase_conv_scan(const P& p, unsigned char* lds) {
    unsigned char* ws = p.ws; const int tid = threadIdx.x;
    const float* GATES = (const float*)(ws + OFF_GATES);
    float *BQ = (float*)(ws + OFF_BQ), *IQ = (float*)(ws + OFF_IQ), *MT = (float*)(ws + OFF_MT), *CH = (float*)(ws + OFF_CH);
    {
        const int lane = tid & 63, wave = tid >> 6;
        for (int task = blockIdx.x * 8 + wave; task < 2048; task += gridDim.x * 8) {
            const int bh = task >> 8, c = task & 255, batch = bh >> 2, head = bh & 3; const size_t t = (size_t)batch * SEQ + c * 64 + lane;
            const float ig = GATES[t * 8 + head], f = GATES[t * 8 + 4 + head];
            float b = fminf(f, 0.f) - log1pf(__expf(-fabsf(f)));
#pragma unroll
            for (int o = 1; o < 64; o <<= 1) { const float y = __shfl_up(b, o); if (lane >= o) b += y; }
            float rm = ig - b;
#pragma unroll
            for (int o = 1; o < 64; o <<= 1) { const float y = __shfl_up(rm, o); if (lane >= o) rm = fmaxf(rm, y); }
            BQ[t * 4 + head] = b; IQ[t * 4 + head] = ig; MT[t * 4 + head] = rm;
            if (lane == 63) { CH[4096 + bh * 256 + c] = b; CH[bh * 256 + c] = b + rm; }
        }
    }
    const bf16_t* QB = (const bf16_t*)(ws + OFF_QB); const bf16_t* KB = (const bf16_t*)(ws + OFF_KB);
    bf16_t* Y = (bf16_t*)(ws + OFF_Y); bf16_t* KT = (bf16_t*)(ws + OFF_TMP);
    for (size_t it = (size_t)blockIdx.x * 512 + tid; it < (size_t)(T / 8) * 256; it += (size_t)gridDim.x * 512) {
        const size_t t0 = (it >> 8) * 8; const int c0 = (int)(it & 255) * 8, isk = c0 >= 1024, cc = c0 & 1023; const int s0 = (int)(t0 & (SEQ - 1));
        const bf16_t* src = isk ? KB : QB;
        u32x4 rw[11];
#pragma unroll
        for (int j = 0; j < 11; ++j) rw[j] = (s0 - 3 + j >= 0) ? *(const u32x4*)(src + (t0 - 3 + j) * 1024 + cc) : (u32x4){0u, 0u, 0u, 0u};
        f32x4 cw[4][2];
#pragma unroll
        for (int j = 0; j < 4; ++j) { cw[j][0] = *(const f32x4*)(p.e_conv + j * 2048 + c0); cw[j][1] = *(const f32x4*)(p.e_conv + j * 2048 + c0 + 4); }
        const float sc = isk ? 0.0625f : 1.0f;
#pragma unroll
        for (int k = 0; k < 8; ++k) {
            float acc[8];
#pragma unroll
            for (int i = 0; i < 8; ++i) acc[i] = 0.f;
#pragma unroll
            for (int j = 0; j < 4; ++j) { const u32x4 w = rw[k + j];
                acc[0] += cw[j][0][0] * bflo(w.x); acc[1] += cw[j][0][1] * bfhi(w.x); acc[2] += cw[j][0][2] * bflo(w.y); acc[3] += cw[j][0][3] * bfhi(w.y);
                acc[4] += cw[j][1][0] * bflo(w.z); acc[5] += cw[j][1][1] * bfhi(w.z); acc[6] += cw[j][1][2] * bflo(w.w); acc[7] += cw[j][1][3] * bfhi(w.w); }
            u32x4 o; o.x = pk2(siluf_(acc[0]) * sc, siluf_(acc[1]) * sc); o.y = pk2(siluf_(acc[2]) * sc, siluf_(acc[3]) * sc);
            o.z = pk2(siluf_(acc[4]) * sc, siluf_(acc[5]) * sc); o.w = pk2(siluf_(acc[6]) * sc, siluf_(acc[7]) * sc);
            if (isk) *(u32x4*)(KT + (t0 + k) * 1024 + cc) = o; else *(u32x4*)(Y + (t0 + k) * 2048 + 1024 + cc) = o;
        }
    }
}

typedef float f32x16 __attribute__((ext_vector_type(16)));
constexpr int ML_RS = 528, ML_WS = 144;
__device__ __forceinline__ bf16x8 ml_tr8(const LAS unsigned char* a, int second_off) {
    const v4i16_t t0 = __builtin_amdgcn_ds_read_tr16_b64_v4i16((LAS v4i16_t*)a);
    const v4i16_t t1 = __builtin_amdgcn_ds_read_tr16_b64_v4i16((LAS v4i16_t*)(a + second_off));
    bf16x8 r; r[0] = t0[0]; r[1] = t0[1]; r[2] = t0[2]; r[3] = t0[3]; r[4] = t1[0]; r[5] = t1[1]; r[6] = t1[2]; r[7] = t1[3]; return r;
}
struct ChunkScan { f32x4 B, mp, mn; };
__device__ __forceinline__ ChunkScan chunk_scan_wave(const float* CH, int bh, int lane) {
    ChunkScan r; r.B = *(const f32x4*)(CH + 4096 + bh * 256 + 4 * lane); const f32x4 G = *(const f32x4*)(CH + bh * 256 + 4 * lane);
    float a = r.B[0], b = G[0];
#pragma unroll
    for (int j = 1; j < 4; ++j) { b = fmaxf(r.B[j] + b, G[j]); a += r.B[j]; }
#pragma unroll
    for (int o = 1; o < 64; o <<= 1) { const float a1 = __shfl_up(a, o), b1 = __shfl_up(b, o); if (lane >= o) { b = fmaxf(a + b1, b); a += a1; } }
    const float ap = __shfl_up(a, 1), bp = __shfl_up(b, 1);
    float m = lane ? fmaxf(ap, bp) : 0.f;
#pragma unroll
    for (int j = 0; j < 4; ++j) { r.mp[j] = m; m = fmaxf(r.B[j] + m, G[j]); r.mn[j] = m; }
    return r;
}
__device__ __forceinline__ void mlstm_chunk_scan(const float* CH, int bh, LAS float* sB, LAS float* sMp, LAS float* sMn) {
    int tid = threadIdx.x; asm volatile("" : "+v"(tid));
    if (tid < 64) { const ChunkScan r = chunk_scan_wave(CH, bh, tid); *(LAS f32x4*)(sB + 4 * tid) = r.B; *(LAS f32x4*)(sMp + 4 * tid) = r.mp; *(LAS f32x4*)(sMn + 4 * tid) = r.mn; }
    __syncthreads();
}
template <bool FULL>
__device__ __forceinline__ void mlstm_units(const P& p, unsigned char* lds_) {
    unsigned char* ws = p.ws; const int tid0 = threadIdx.x;
    const int w = __builtin_amdgcn_readfirstlane(tid0 >> 6);
    const bf16_t* Yq = (const bf16_t*)(ws + OFF_Y); bf16_t* Yo = (bf16_t*)(ws + OFF_Y);
    const bf16_t* KT = (const bf16_t*)(ws + OFF_TMP); const bf16_t* VB = (const bf16_t*)(ws + OFF_VB);
    float* ST = (float*)(ws + OFF_QB); float* NS = (float*)(ws + OFF_NS);
    const float *BQ = (const float*)(ws + OFF_BQ), *IQ = (const float*)(ws + OFF_IQ), *MT = (const float*)(ws + OFF_MT), *CH = (const float*)(ws + OFF_CH);
    LAS unsigned char* Qs = (LAS unsigned char*)lds_;
    LAS unsigned char* Ks = Qs + 64 * ML_RS;
    LAS unsigned char* Vs = Ks + 64 * ML_RS;
    LAS unsigned char* Wl = Vs + 64 * ML_RS;
    LAS float* sa = (LAS float*)(Wl + 64 * ML_WS);
    LAS float* sden = sa + 64; LAS float* ssw = sden + 64; LAS float* sf = ssw + 64; LAS float* sg = sf + 64; LAS float* nd = sg + 64; LAS float* rden = nd + 64; LAS float* ns = rden + 64;
    LAS float* cB = ns + 256; LAS float* cMp = cB + 256; LAS float* cMn = cMp + 256; LAS float* gB = cMn + 256; LAS float* gI = gB + 512; LAS float* gM = gI + 512;
    for (int unit = blockIdx.x; unit < 256; unit += gridDim.x) {
        const int bh = unit >> 5, S = unit & 31, batch = bh >> 2, head = bh & 3;
        const int tid = tid0, lane = tid0 & 63, hh = lane >> 5;
        __syncthreads();
        mlstm_chunk_scan(CH, bh, cB, cMp, cMn);
        f32x16 st[8]; float nreg = 0.f;
        if (FULL) {
#pragma unroll
            for (int kt = 0; kt < 8; ++kt) {
                int lz = lane; asm volatile("" : "+v"(lz));
                const f32x4* sp = (const f32x4*)(ST + (size_t)unit * 65536 + (size_t)(kt * 8 + w) * 1024) + lz;
#pragma unroll
                for (int j = 0; j < 4; ++j) { const f32x4 v4 = sp[j * 64]; st[kt][4 * j + 0] = v4[0]; st[kt][4 * j + 1] = v4[1]; st[kt][4 * j + 2] = v4[2]; st[kt][4 * j + 3] = v4[3]; }
            }
            if (tid < 256) nreg = NS[unit * 256 + tid];
        } else {
#pragma unroll
            for (int kt = 0; kt < 8; ++kt)
#pragma unroll
                for (int r = 0; r < 16; ++r) st[kt][r] = 0.f;
        }
        { const size_t tS = ((size_t)batch * SEQ + (size_t)S * 512 + tid0) * 4 + head; gB[tid0] = BQ[tS]; gI[tid0] = IQ[tS]; gM[tid0] = MT[tS]; }
        u32x4 pk[4], pv[4], pq[4];
        auto prefetch = [&](int cn) {
            int tz = tid0; asm volatile("" : "+v"(tz));
            const size_t tn = (size_t)batch * SEQ + (size_t)(S * 8 + cn) * 64;
#pragma unroll
            for (int j = 0; j < 4; ++j) { const int e = tz + 512 * j, r = e >> 5, cg = e & 31;
                pk[j] = *(const u32x4*)(KT + (tn + r) * 1024 + head * 256 + cg * 8);
                if (!FULL) pv[j] = *(const u32x4*)(VB + (tn + r) * 1024 + head * 256 + cg * 8);
                if (FULL) pq[j] = *(const u32x4*)(Yq + (tn + r) * 2048 + 1024 + head * 256 + cg * 8); }
            asm volatile("" ::: "memory");
        };
        prefetch(0);
#pragma unroll 1
        for (int cc = 0; cc < 8; ++cc) {
            int tid = tid0; asm volatile("" : "+v"(tid));
            const int lane = tid & 63, l31 = lane & 31, hh = lane >> 5, fr = lane & 15, fq = lane >> 4;
            const int trow = 8 * hh + (fr >> 2), tcol = (16 * (fq & 1) + 4 * (fr & 3)) * 2;
            const int ch = S * 8 + cc; const size_t t0 = (size_t)batch * SEQ + ch * 64;
            const float mprev = cMp[ch], mnew = cMn[ch], blast = cB[ch];
            const float decay = __expf(blast + mprev - mnew);
            __syncthreads();
#pragma unroll
            for (int j = 0; j < 4; ++j) { const int e = tid + 512 * j, r = e >> 5, cg = e & 31;
                if (FULL) pv[j] = *(const u32x4*)(VB + (t0 + r) * 1024 + head * 256 + cg * 8); }
#pragma unroll
            for (int j = 0; j < 4; ++j) { const int e = tid + 512 * j, r = e >> 5, cg = e & 31;
                *(LAS u32x4*)(Ks + r * ML_RS + cg * 16) = pk[j];
                if (!FULL) *(LAS u32x4*)(Vs + r * ML_RS + cg * 16) = pv[j];
                if (FULL) *(LAS u32x4*)(Qs + r * ML_RS + cg * 16) = pq[j]; }
            if (w == cc) { const float bq = gB[tid], iq = gI[tid], mt = bq + fmaxf(mprev, gM[tid]);
                sa[lane] = __expf(bq + mprev - mt); sden[lane] = __expf(-mt); ssw[lane] = __expf(blast - bq + iq - mnew); sf[lane] = bq - mt; sg[lane] = iq - bq; }
            if (FULL && tid < 256) ns[tid] = nreg;
            __syncthreads();
            if (!FULL && cc < 7) prefetch(cc + 1);
            bf16x8 bv[4];
            if (!FULL) {
#pragma unroll
                for (int ks = 0; ks < 4; ++ks) bv[ks] = ml_tr8(Vs + (16 * ks + trow) * ML_RS + 64 * w + tcol, 4 * ML_RS);
            }
            if (FULL) {
                { const int tt = w >> 1;
#pragma unroll
                  for (int si = 0; si < 2; ++si) { const int ss = 2 * (w & 1) + si;
                    f32x4 acc = (f32x4){0.f, 0.f, 0.f, 0.f};
                    if (ss <= tt) {
#pragma unroll
                        for (int ks = 0; ks < 8; ++ks) { const bf16x8 a = *(const LAS bf16x8*)(Qs + (16 * tt + fr) * ML_RS + (32 * ks + 8 * fq) * 2), b = *(const LAS bf16x8*)(Ks + (16 * ss + fr) * ML_RS + (32 * ks + 8 * fq) * 2);
                            acc = __builtin_amdgcn_mfma_f32_16x16x32_bf16(a, b, acc, 0, 0, 0); } }
                    const int sidx = 16 * ss + fr; const float gs = sg[sidx];
#pragma unroll
                    for (int j = 0; j < 4; ++j) { const int tix = 16 * tt + 4 * fq + j; const float wv = (sidx <= tix) ? __expf(sf[tix] + gs) * acc[j] : 0.f;
                        *(LAS bf16_t*)(Wl + tix * ML_WS + sidx * 2) = f2bf(wv); } } }
#pragma unroll
                for (int i = 0; i < 8; ++i) { const int tix = 8 * w + i; const u32x2 qv = *(const LAS u32x2*)(Qs + tix * ML_RS + lane * 8); const f32x4 nv = *(const LAS f32x4*)(ns + lane * 4);
                    float part = bflo(qv.x) * nv[0] + bfhi(qv.x) * nv[1] + bflo(qv.y) * nv[2] + bfhi(qv.y) * nv[3]; part = wave_sum(part); if (lane == 0) nd[tix] = part; }
#pragma unroll
                for (int j = 0; j < 4; ++j) { const int e = tid + 512 * j, r = e >> 5, cg = e & 31; *(LAS u32x4*)(Vs + r * ML_RS + cg * 16) = pv[j]; }
                __syncthreads();
                f32x16 acc[2];
#pragma unroll
                for (int t2 = 0; t2 < 2; ++t2) {
#pragma unroll
                    for (int r = 0; r < 16; ++r) acc[t2][r] = 0.f;
                }
#pragma unroll
                for (int kt = 0; kt < 8; ++kt) {
                    asm volatile("" ::: "memory");
#pragma unroll
                    for (int s2 = 0; s2 < 2; ++s2) {
                        u32x4 bw; bw.x = pg8::cvt_pk_bf16(st[kt][8 * s2 + 0], st[kt][8 * s2 + 1]); bw.y = pg8::cvt_pk_bf16(st[kt][8 * s2 + 2], st[kt][8 * s2 + 3]);
                        bw.z = pg8::cvt_pk_bf16(st[kt][8 * s2 + 4], st[kt][8 * s2 + 5]); bw.w = pg8::cvt_pk_bf16(st[kt][8 * s2 + 6], st[kt][8 * s2 + 7]);
                        const bf16x8 bfrag = __builtin_bit_cast(bf16x8, bw);
#pragma unroll
                        for (int t2 = 0; t2 < 2; ++t2) { const LAS unsigned char* qa = Qs + (32 * t2 + l31) * ML_RS + (32 * kt + 16 * s2 + 4 * hh) * 2;
                            const u32x2 lo = *(const LAS u32x2*)qa, hi = *(const LAS u32x2*)(qa + 16); u32x4 aw; aw.x = lo.x; aw.y = lo.y; aw.z = hi.x; aw.w = hi.y;
                            acc[t2] = __builtin_amdgcn_mfma_f32_32x32x16_bf16(__builtin_bit_cast(bf16x8, aw), bfrag, acc[t2], 0, 0, 0); }
                    }
                }
                asm volatile("" ::: "memory");
#pragma unroll
                for (int t2 = 0; t2 < 2; ++t2)
#pragma unroll
                    for (int r = 0; r < 16; ++r) acc[t2][r] *= sa[32 * t2 + (r & 3) + 8 * (r >> 2) + 4 * hh];
#pragma unroll
                for (int ks = 0; ks < 4; ++ks) bv[ks] = ml_tr8(Vs + (16 * ks + trow) * ML_RS + 64 * w + tcol, 4 * ML_RS);
#pragma unroll
                for (int ks = 0; ks < 4; ++ks)
#pragma unroll
                    for (int t2 = 0; t2 < 2; ++t2) { const bf16x8 a = *(const LAS bf16x8*)(Wl + (32 * t2 + l31) * ML_WS + (16 * ks + 8 * hh) * 2);
                        acc[t2] = __builtin_amdgcn_mfma_f32_32x32x16_bf16(a, bv[ks], acc[t2], 0, 0, 0); }
#pragma unroll
                for (int i = 0; i < 8; ++i) { const int tix = 8 * w + i; float rs = bf2f(*(const LAS bf16_t*)(Wl + tix * ML_WS + lane * 2)); rs = wave_sum(rs);
                    if (lane == 0) { const float nq = sa[tix] * nd[tix] + rs; rden[tix] = 1.0f / fmaxf(fabsf(nq), sden[tix]); } }
                __syncthreads();
                bf16_t* yo = Yo + t0 * 2048 + head * 256 + 32 * w + l31;
#pragma unroll
                for (int t2 = 0; t2 < 2; ++t2)
#pragma unroll
                    for (int r = 0; r < 16; ++r) { const int tix = 32 * t2 + (r & 3) + 8 * (r >> 2) + 4 * hh; yo[(size_t)tix * 2048] = f2bf(acc[t2][r] * rden[tix]); }
                asm volatile("" ::: "memory");
                if (cc < 7) prefetch(cc + 1);
            }
#pragma unroll
            for (int kt = 0; kt < 8; ++kt) st[kt] *= decay;
#pragma unroll
            for (int ks = 0; ks < 4; ++ks) {
                const u32x4 raw = __builtin_bit_cast(u32x4, bv[ks]); const LAS float* sw8 = ssw + 16 * ks + 8 * hh;
                u32x4 sc; sc.x = pg8::cvt_pk_bf16(bflo(raw.x) * sw8[0], bfhi(raw.x) * sw8[1]); sc.y = pg8::cvt_pk_bf16(bflo(raw.y) * sw8[2], bfhi(raw.y) * sw8[3]);
                sc.z = pg8::cvt_pk_bf16(bflo(raw.z) * sw8[4], bfhi(raw.z) * sw8[5]); sc.w = pg8::cvt_pk_bf16(bflo(raw.w) * sw8[6], bfhi(raw.w) * sw8[7]);
                const bf16x8 bs = __builtin_bit_cast(bf16x8, sc);
#pragma unroll
                for (int kt = 0; kt < 8; ++kt) { if ((kt & 3) == 0) asm volatile("" ::: "memory");
                    const bf16x8 a = ml_tr8(Ks + (16 * ks + trow) * ML_RS + 64 * kt + tcol, 4 * ML_RS);
                    st[kt] = __builtin_amdgcn_mfma_f32_32x32x16_bf16(a, bs, st[kt], 0, 0, 0); }
            }
            if (tid < 256) { float nacc = 0.f;
#pragma unroll 8
                for (int s2 = 0; s2 < 64; ++s2) nacc += ssw[s2] * bf2f(*(const LAS bf16_t*)(Ks + s2 * ML_RS + tid * 2));
                nreg = decay * nreg + nacc; }
        }
        if (!FULL) {
#pragma unroll
            for (int kt = 0; kt < 8; ++kt) {
                int lz = lane; asm volatile("" : "+v"(lz));
                f32x4* sp = (f32x4*)(ST + (size_t)unit * 65536 + (size_t)(kt * 8 + w) * 1024) + lz;
#pragma unroll
                for (int j = 0; j < 4; ++j) sp[j * 64] = (f32x4){st[kt][4 * j + 0], st[kt][4 * j + 1], st[kt][4 * j + 2], st[kt][4 * j + 3]};
            }
            if (tid < 256) NS[unit * 256 + tid] = nreg;
        }
    }
}
__device__ __forceinline__ void phase_mlstm_scan(const P& p, unsigned char* lds_) {
    unsigned char* ws = p.ws; const int tid = threadIdx.x, lane = tid & 63, wave = tid >> 6;
    float* ST = (float*)(ws + OFF_QB); float* NS = (float*)(ws + OFF_NS); const float* CH = (const float*)(ws + OFF_CH);
    LAS float* DS = (LAS float*)lds_;
    __syncthreads();
    {
        const ChunkScan r = chunk_scan_wave(CH, wave, lane);
        float d = 1.f;
#pragma unroll
        for (int j = 0; j < 4; ++j) d *= __expf(r.B[j] + r.mp[j] - r.mn[j]);
        const float dn = __shfl_down(d, 1);
        if (!(lane & 1)) DS[wave * 32 + (lane >> 1)] = d * dn;
    }
    __syncthreads();
    {
        const int it0 = blockIdx.x * 512 + tid;
        for (int it = it0; it < 8 * 16384; it += gridDim.x * 512) {
            const int bh = it >> 14; float* base = ST + (size_t)bh * 32 * 65536 + (size_t)(it & 16383) * 4;
            f32x4 carry = (f32x4){0.f, 0.f, 0.f, 0.f};
#pragma unroll
            for (int h = 0; h < 2; ++h) {
                f32x4 tmp[16];
#pragma unroll
                for (int S = 0; S < 16; ++S) tmp[S] = *(const f32x4*)(base + (size_t)(16 * h + S) * 65536);
#pragma unroll
                for (int S = 0; S < 16; ++S) { *(f32x4*)(base + (size_t)(16 * h + S) * 65536) = carry; carry = DS[bh * 32 + 16 * h + S] * carry + tmp[S]; }
            }
        }
        if (it0 < 8 * 256) {
            const int it = it0, bh = it >> 8; float* base = NS + (size_t)bh * 32 * 256 + (it & 255);
            float carry = 0.f;
#pragma unroll 8
            for (int S = 0; S < 32; ++S) { const float tmp = base[S * 256]; base[S * 256] = carry; carry = DS[bh * 32 + S] * carry + tmp; }
        }
    }
}

__device__ __forceinline__ void unpack8(const u32x4 w, float (&f)[8]) {
    f[0] = bflo(w.x); f[1] = bfhi(w.x); f[2] = bflo(w.y); f[3] = bfhi(w.y); f[4] = bflo(w.z); f[5] = bfhi(w.z); f[6] = bflo(w.w); f[7] = bfhi(w.w); }
template <int WIN>
__device__ __forceinline__ void pool_item(const bf16_t* __restrict__ U, bf16_t* __restrict__ Y, const float* __restrict__ s_pool, size_t t0, int s0, int c0) {
    constexpr int NR = WIN + 7;
    u32x4 rw[NR], z[8];
#pragma unroll
    for (int j = 0; j < NR; ++j) rw[j] = (s0 - (WIN - 1) + j >= 0) ? *(const u32x4*)(U + ((long)t0 + j - (WIN - 1)) * 1024 + c0) : (u32x4){0u, 0u, 0u, 0u};
#pragma unroll
    for (int k = 0; k < 8; ++k) z[k] = *(const u32x4*)(Y + (t0 + k) * 2048 + 1024 + c0);
    const f32x4 s0v = *(const f32x4*)(s_pool + c0), s1v = *(const f32x4*)(s_pool + c0 + 4);
    const float sp[8] = {s0v[0], s0v[1], s0v[2], s0v[3], s1v[0], s1v[1], s1v[2], s1v[3]};
    float S[8];
#pragma unroll
    for (int i = 0; i < 8; ++i) S[i] = 0.f;
#pragma unroll
    for (int j = 0; j < WIN - 1; ++j) { float f[8]; unpack8(rw[j], f);
#pragma unroll
        for (int i = 0; i < 8; ++i) S[i] += f[i]; }
#pragma unroll
    for (int k = 0; k < 8; ++k) {
        float self[8], zf[8]; unpack8(rw[k + WIN - 1], self); unpack8(z[k], zf);
#pragma unroll
        for (int i = 0; i < 8; ++i) S[i] += self[i];
        const int cnt = (s0 + k + 1 < WIN) ? s0 + k + 1 : WIN;
        const float inv = __builtin_amdgcn_rcpf((float)cnt);
        float o[8];
#pragma unroll
        for (int i = 0; i < 8; ++i) o[i] = (S[i] * inv - self[i]) * sp[i] * zf[i];
        u32x4 ow; ow.x = pk2(o[0], o[1]); ow.y = pk2(o[2], o[3]); ow.z = pk2(o[4], o[5]); ow.w = pk2(o[6], o[7]);
        *(u32x4*)(Y + (t0 + k) * 2048 + 1024 + c0) = ow;
        float old[8]; unpack8(rw[k], old);
#pragma unroll
        for (int i = 0; i < 8; ++i) S[i] -= old[i];
    }
}
__device__ __forceinline__ void phase_ya_pool(const P& p) {
    unsigned char* ws = p.ws; const int tid = threadIdx.x, lane = tid & 63, wave = tid >> 6;
    bf16_t* Y = (bf16_t*)(ws + OFF_Y); const bf16_t* O = (const bf16_t*)(ws + OFF_QB); const bf16_t* ZA = (const bf16_t*)(ws + OFF_KB);
    for (int tt = blockIdx.x * 8 + wave; tt < T; tt += gridDim.x * 8) {
        const size_t t = (size_t)tt; u32x2 hw[4], ow[4], zw[4];
#pragma unroll
        for (int head = 0; head < 4; ++head) { const int c = head * 256 + lane * 4;
            hw[head] = *(const u32x2*)(Y + t * 2048 + c); ow[head] = *(const u32x2*)(O + t * 1024 + c); zw[head] = *(const u32x2*)(ZA + t * 1024 + c); }
#pragma unroll
        for (int head = 0; head < 4; ++head) { const int c = head * 256 + lane * 4;
            float v[4] = {bflo(hw[head].x) * bflo(ow[head].x), bfhi(hw[head].x) * bfhi(ow[head].x), bflo(hw[head].y) * bflo(ow[head].y), bfhi(hw[head].y) * bfhi(ow[head].y)};
            const float ss = wave_sum(v[0] * v[0] + v[1] * v[1] + v[2] * v[2] + v[3] * v[3]);
            const float rstd = rsqrtf(ss * (1.0f / 256.0f) + EPS);
            const f32x4 g = *(const f32x4*)(p.e_g_head + c);
            u32x2 o; o.x = pk2(v[0] * rstd * g[0] * bflo(zw[head].x), v[1] * rstd * g[1] * bfhi(zw[head].x)); o.y = pk2(v[2] * rstd * g[2] * bflo(zw[head].y), v[3] * rstd * g[3] * bfhi(zw[head].y));
            *(u32x2*)(Y + t * 2048 + c) = o; }
    }
    const bf16_t* U = (const bf16_t*)(ws + OFF_VB);
    for (int it = blockIdx.x * 512 + tid; it < (T / 8) * 128; it += gridDim.x * 512) {
        const int cgl = it & 31, tbl = (it >> 5) & 1, g = __builtin_amdgcn_readfirstlane((it >> 6) & 3), tb = 2 * (it >> 8) + tbl;
        const size_t t0 = (size_t)tb * 8; const int s0 = (int)(t0 & (SEQ - 1)), c0 = g * 256 + cgl * 8;
        if (g == 0) pool_item<2>(U, Y, p.e_s_pool, t0, s0, c0);
        else if (g == 1) pool_item<4>(U, Y, p.e_s_pool, t0, s0, c0);
        else if (g == 2) pool_item<8>(U, Y, p.e_s_pool, t0, s0, c0);
        else pool_item<16>(U, Y, p.e_s_pool, t0, s0, c0);
    }
}

__device__ __forceinline__ void headnorm64(bf16_t* X, const float* g) {
    const int lane = threadIdx.x & 63, wave = threadIdx.x >> 6;
    const float* gg = g + (lane & 3) * 16;
    for (int t0 = (blockIdx.x * 8 + wave) * 4; t0 < T; t0 += gridDim.x * 32) {
        u32x4 a[4], b[4];
#pragma unroll
        for (int k = 0; k < 4; ++k) { const bf16_t* r = X + (size_t)(t0 + k) * 1024 + lane * 16; a[k] = *(const u32x4*)r; b[k] = *(const u32x4*)(r + 8); }
#pragma unroll
        for (int k = 0; k < 4; ++k) {
            float f[16] = {bflo(a[k].x), bfhi(a[k].x), bflo(a[k].y), bfhi(a[k].y), bflo(a[k].z), bfhi(a[k].z), bflo(a[k].w), bfhi(a[k].w), bflo(b[k].x), bfhi(b[k].x), bflo(b[k].y), bfhi(b[k].y), bflo(b[k].z), bfhi(b[k].z), bflo(b[k].w), bfhi(b[k].w)};
            float ss = 0.f;
#pragma unroll
            for (int i = 0; i < 16; ++i) ss += f[i] * f[i];
            ss += dppf<0xB1>(ss); ss += dppf<0x4E>(ss);
            const float rstd = rsqrtf(ss * (1.0f / 64.0f) + EPS);
#pragma unroll
            for (int i = 0; i < 16; ++i) f[i] = f[i] * rstd * gg[i];
            u32x4 oa, ob; oa.x = pk2(f[0], f[1]); oa.y = pk2(f[2], f[3]); oa.z = pk2(f[4], f[5]); oa.w = pk2(f[6], f[7]);
            ob.x = pk2(f[8], f[9]); ob.y = pk2(f[10], f[11]); ob.z = pk2(f[12], f[13]); ob.w = pk2(f[14], f[15]);
            bf16_t* r = X + (size_t)(t0 + k) * 1024 + lane * 16; *(u32x4*)r = oa; *(u32x4*)(r + 8) = ob;
        }
    }
}
__device__ __forceinline__ void phase_qnorm_ckvnorm(const P& p) {
    unsigned char* ws = p.ws; const int lane = threadIdx.x & 63, wave = threadIdx.x >> 6;
    {
        const u32x4* KI4 = (const u32x4*)(ws + OFF_KI); u32x4* KT4 = (u32x4*)(ws + OFF_KIT);
        for (size_t it = (size_t)blockIdx.x * 512 + threadIdx.x; it < (size_t)T * 8; it += (size_t)gridDim.x * 512) {
            const int l = (int)(it & 63), ks = (int)((it >> 6) & 1); const size_t t16 = it >> 7;
            KT4[it] = KI4[(t16 * 16 + (l & 15)) * 8 + 4 * ks + (l >> 4)]; }
    }
    bf16_t* CKVN = (bf16_t*)(ws + OFF_CKVN);
    const f32x4 g = *(const f32x4*)(p.o_g_kv + lane * 4);
    for (int t0 = (blockIdx.x * 8 + wave) * 8; t0 < T; t0 += gridDim.x * 64) {
        u32x2 w[8];
#pragma unroll
        for (int k = 0; k < 8; ++k) w[k] = *(const u32x2*)(CKVN + (size_t)(t0 + k) * 256 + lane * 4);
#pragma unroll
        for (int k = 0; k < 8; ++k) {
            const float v[4] = {bflo(w[k].x), bfhi(w[k].x), bflo(w[k].y), bfhi(w[k].y)};
            const float ss = wave_sum(v[0] * v[0] + v[1] * v[1] + v[2] * v[2] + v[3] * v[3]);
            const float rstd = rsqrtf(ss * (1.0f / 256.0f) + EPS);
            u32x2 o; o.x = pk2(v[0] * rstd * g[0], v[1] * rstd * g[1]); o.y = pk2(v[2] * rstd * g[2], v[3] * rstd * g[3]);
            *(u32x2*)(CKVN + (size_t)(t0 + k) * 256 + lane * 4) = o;
        }
    }
}

__device__ __forceinline__ unsigned okey(float s) { if (s == 0.f) s = 0.f; const unsigned u = __float_as_uint(s); return (u & 0x80000000u) ? ~u : (u | 0x80000000u); }

__device__ __forceinline__ void indexer_slow_query(const P& p, unsigned char* lds, size_t t) {
    unsigned char* ws = p.ws; const int tid = threadIdx.x, lane = tid & 63, wave = tid >> 6;
    const _Float16* QI = (const _Float16*)(ws + OFF_QI); const _Float16* KI = (const _Float16*)(ws + OFF_KI); const float* WI = (const float*)(ws + OFF_WI);
    unsigned short* IDX = (unsigned short*)(ws + OFF_IDX);
    unsigned* sc = (unsigned*)lds; unsigned* hist = sc + 16384; float* qs = (float*)(hist + 256); unsigned* misc = (unsigned*)(qs + 256); unsigned* wsum = misc + 16;
    const int batch = (int)(t >> 14), pos = (int)(t & (SEQ - 1)), n = pos + 1;
    __syncthreads();
    if (tid < 256) qs[tid] = (float)QI[t * 256 + tid];
    const float w0 = WI[t * 4 + 0], w1 = WI[t * 4 + 1], w2 = WI[t * 4 + 2], w3 = WI[t * 4 + 3];
    __syncthreads();
    const _Float16* kbase = KI + (size_t)batch * SEQ * 64;
    for (int s = tid; s < n; s += 512) {
        asm volatile("" ::: "memory");
        typedef _Float16 h8 __attribute__((ext_vector_type(8)));
        const h8* kr = (const h8*)(kbase + (size_t)s * 64);
        float d0 = 0.f, d1 = 0.f, d2 = 0.f, d3 = 0.f;
#pragma unroll
        for (int j = 0; j < 8; ++j) { const h8 kv = kr[j];
#pragma unroll
            for (int e = 0; e < 8; ++e) { const int d = j * 8 + e; const float kf = (float)kv[e]; d0 += qs[d] * kf; d1 += qs[64 + d] * kf; d2 += qs[128 + d] * kf; d3 += qs[192 + d] * kf; } }
        float score = w0 * fmaxf(d0, 0.f); score = fmaf(w1, fmaxf(d1, 0.f), score); score = fmaf(w2, fmaxf(d2, 0.f), score); score = fmaf(w3, fmaxf(d3, 0.f), score);
        sc[s] = okey(score);
    }
    unsigned prefix = 0, krem = 256;
    for (int pass = 0; pass < 4; ++pass) {
        const int shift = 24 - 8 * pass;
        __syncthreads();
        if (tid < 256) hist[tid] = 0;
        __syncthreads();
        for (int s = tid; s < n; s += 512) { const unsigned k = sc[s]; if (pass == 0 || (k >> (shift + 8)) == prefix) atomicAdd(&hist[(k >> shift) & 255u], 1u); }
        __syncthreads();
        if (tid == 0) { unsigned cum = 0; int bin = 255; for (; bin > 0; --bin) { const unsigned c = hist[bin]; if (cum + c >= krem) break; cum += c; } misc[0] = (unsigned)bin; misc[1] = krem - cum; }
        __syncthreads();
        prefix = (prefix << 8) | misc[0]; krem = misc[1];
    }
    const unsigned ngt_total = 256u - krem;
    unsigned lg = 0, le = 0; const int s0 = tid * 32;
    for (int s = s0; s < s0 + 32 && s < n; ++s) { const unsigned k = sc[s]; lg += (k > prefix); le += (k == prefix); }
    unsigned pk = lg | (le << 16), incl = pk;
#pragma unroll
    for (int o = 1; o < 64; o <<= 1) { const unsigned y = __shfl_up(incl, o); if (lane >= o) incl += y; }
    if (lane == 63) wsum[wave] = incl;
    __syncthreads();
    unsigned base = 0;
    for (int w = 0; w < wave; ++w) base += wsum[w];
    const unsigned excl = base + incl - pk; unsigned bg = excl & 0xffffu, be = excl >> 16;
    for (int s = s0; s < s0 + 32 && s < n; ++s) { const unsigned k = sc[s];
        if (k > prefix) { IDX[t * 256 + bg] = (unsigned short)s; ++bg; }
        else if (k == prefix) { if (be < krem) IDX[t * 256 + ngt_total + be] = (unsigned short)s; ++be; } }
    __syncthreads();
}

typedef _Float16 half8 __attribute__((ext_vector_type(8)));
constexpr int IX_CAP = 1024, IX_ZBIN = 2048;
__device__ __forceinline__ unsigned ix_key(const f32x4 a, const f32x4 w) {
    const float r0 = __int_as_float(max(__float_as_int(a[0]), 0)), r1 = __int_as_float(max(__float_as_int(a[1]), 0));
    const float r2 = __int_as_float(max(__float_as_int(a[2]), 0)), r3 = __int_as_float(max(__float_as_int(a[3]), 0));
    float s = fmaf(w[0], r0, 0.0f); s = fmaf(w[1], r1, s); s = fmaf(w[2], r2, s); s = fmaf(w[3], r3, s);
    const unsigned u = __float_as_uint(s);
    return u ^ ((unsigned)((int)u >> 31) | 0x80000000u);
}
#define LDS_ADD(ptr, v) __hip_atomic_fetch_add((ptr), (v), __ATOMIC_RELAXED, __HIP_MEMORY_SCOPE_WORKGROUP)
struct IxTagF { static constexpr bool value = false; }; struct IxTagT { static constexpr bool value = true; };
__device__ __forceinline__ void phase_indexer(const P& p, unsigned char* lds) {
    unsigned char* ws = p.ws; const int tid = tid_opaque(), lane = tid & 63, kl = lane & 15, g = lane >> 4;
    const int wave = __builtin_amdgcn_readfirstlane(tid >> 6);
    const _Float16* QI = (const _Float16*)(ws + OFF_QI); const _Float16* KIT = (const _Float16*)(ws + OFF_KIT); const float* WI = (const float*)(ws + OFF_WI);
    unsigned short* IDX = (unsigned short*)(ws + OFF_IDX); int* CNT = (int*)(ws + OFF_CNT);
    LAS unsigned* hist = (LAS unsigned*)lds;
    LAS int* qTbin = (LAS int*)(hist + 16 * 2048);
    LAS int* qCab = qTbin + 16; LAS unsigned* qN = (LAS unsigned*)(qCab + 16); LAS int* qOvf = (LAS int*)(qN + 16); LAS int* qZl = qOvf + 16;
    LAS unsigned* ovl = (LAS unsigned*)(lds + 132 * 1024);
    LAS unsigned* h2 = (LAS unsigned*)(lds + 133 * 1024 + wave * 1536);
    LAS unsigned long long* l2 = (LAS unsigned long long*)(h2 + 256);
    if (tid == 0) ovl[0] = 0u;
    const int G = gridDim.x, nround = (T / 16) / G;
#pragma unroll 1
    for (int i = 0; i < nround; ++i) {
        const int tix = (i & 1) ? i * G + (G - 1 - (int)blockIdx.x) : i * G + (int)blockIdx.x;
        const int batch = tix & 1, tb = tix >> 1, p0 = tb * 16; const size_t t0 = (size_t)batch * SEQ + p0;
        __syncthreads();
        if (p0 + 16 <= 256) {
#pragma unroll
            for (int j = 0; j < 8; ++j) { const int e = tid + 512 * j, q = e >> 8, jj = e & 255; IDX[(t0 + q) * 256 + jj] = (unsigned short)(jj <= p0 + q ? jj : 0); }
            if (tid < 16) CNT[t0 + tid] = p0 + tid + 1;
            continue;
        }
#pragma unroll
        for (int j = 0; j < 16; ++j) ((LAS u32x4*)hist)[tid + 512 * j] = (u32x4){0u, 0u, 0u, 0u};
        if (tid < 16) { qN[tid] = 0u; qOvf[tid] = 0; }
        half8 af[4][2]; f32x4 wv[4];
#pragma unroll
        for (int rt = 0; rt < 4; ++rt) {
#pragma unroll
            for (int ks = 0; ks < 2; ++ks) af[rt][ks] = *(const half8*)(QI + (t0 + 4 * rt + (kl >> 2)) * 256 + (kl & 3) * 64 + 32 * ks + 8 * g);
            wv[rt] = *(const f32x4*)(WI + (t0 + 4 * rt + g) * 4);
        }
        __syncthreads();
        const int nblk = tb + 1, L = (nblk + 7) >> 3, b0 = wave * L, b1 = (b0 + L < nblk) ? b0 + L : nblk;
        const _Float16* kb = KIT + (size_t)batch * SEQ * 64 + lane * 8;
        LAS unsigned* hg = hist + g * 4 * 2048;
#define IX_LOADK(u, bb) do { kq[u][0] = *(const half8*)(kb + (size_t)(bb) * 1024); kq[u][1] = *(const half8*)(kb + (size_t)(bb) * 1024 + 512); } while (0)
#define IX_MFMA(acc, k0, k1) do { _Pragma("unroll") for (int rt = 0; rt < 4; ++rt) { acc[rt] = __builtin_amdgcn_mfma_f32_16x16x32_f16(af[rt][0], k0, (f32x4){0.f, 0.f, 0.f, 0.f}, 0, 0, 0); \
            acc[rt] = __builtin_amdgcn_mfma_f32_16x16x32_f16(af[rt][1], k1, acc[rt], 0, 0, 0); } } while (0)
        const int sst = (nblk <= 64) ? 1 : ((nblk <= 256) ? 2 : 4);
        {
            const int bend = (b1 < nblk - 1) ? b1 : nblk - 1;
            const int ns = (bend > b0) ? ((bend - b0 + sst - 1) / sst) : 0;
            auto step1 = [&](int bcur, const half8& k0, const half8& k1, auto chkTag) {
                constexpr bool CHK = decltype(chkTag)::value;
                f32x4 acc[4]; IX_MFMA(acc, k0, k1);
#pragma unroll
                for (int rt = 0; rt < 4; ++rt) { const unsigned key = ix_key(acc[rt], wv[rt]);
                    if (!CHK || bcur * 16 + kl <= p0 + 4 * rt + g) LDS_ADD(hg + rt * 2048 + (key >> 21), 1u << ((key >> 16) & 16u)); }
            };
            if (ns > 0) {
                half8 kq[2][2];
#pragma unroll
                for (int u = 0; u < 2; ++u) { const int kk = (u < ns) ? u : ns - 1; IX_LOADK(u, b0 + sst * kk); }
                int k = 0;
#pragma unroll 1
                for (; k + 2 <= ns; k += 2) {
#pragma unroll
                    for (int u = 0; u < 2; ++u) { step1(0, kq[u][0], kq[u][1], IxTagF{}); const int kk = (k + 2 + u < ns) ? k + 2 + u : ns - 1; IX_LOADK(u, b0 + sst * kk); }
                }
                if (k < ns) step1(0, kq[0][0], kq[0][1], IxTagF{});
            }
            if (sst == 1 && b1 == nblk && b0 < b1) { half8 kq[1][2]; IX_LOADK(0, nblk - 1); step1(nblk - 1, kq[0][0], kq[0][1], IxTagT{}); }
        }
        __syncthreads();
        int nsb = 0;
#pragma unroll
        for (int ww = 0; ww < 8; ++ww) { const int c0 = ww * L, c1 = (c0 + L < nblk) ? c0 + L : nblk, ce = (c1 < nblk - 1) ? c1 : nblk - 1; nsb += (ce > c0) ? ((ce - c0 + sst - 1) / sst) : 0; }
        if (sst == 1) nsb = nblk;
        const float fsm = (sst == 1) ? 1.0f : fminf(1.0f, (float)(nsb * 16) / (float)(p0 + 1));
        int tgt = (int)(256.0f * fsm + 5.0f * sqrtf(256.0f * fsm * (1.0f - fsm))) + 2; tgt = tgt > 256 ? 256 : tgt;
#pragma unroll 1
        for (int qq = 0; qq < 2; ++qq) {
            const int q = 2 * wave + qq; const LAS unsigned* h = hist + q * 2048;
            unsigned S2 = 0;
#pragma unroll
            for (int c8 = 0; c8 < 8; ++c8) { const int cc = (c8 ^ (lane >> 1)) & 7; const u32x4 w4 = *(const LAS u32x4*)(h + 2016 - 32 * lane + 4 * cc); S2 += w4.x + w4.y + w4.z + w4.w; }
            const unsigned cs = (S2 & 0xffffu) + (S2 >> 16);
            const unsigned incl = wave_iscan(cs);
            const unsigned long long m = __ballot(incl >= (unsigned)tgt);
            const int Ls = m ? (__ffsll((long long)m) - 1) : 63;
            const unsigned cab0 = rlu(incl - cs, Ls);
            const int dw = 2047 - 32 * Ls - (lane >> 1); const unsigned w2 = h[dw]; const unsigned cl = (lane & 1) ? (w2 & 0xffffu) : (w2 >> 16);
            const unsigned incl2 = wave_iscan(cl) + cab0;
            const unsigned long long m2 = __ballot(incl2 >= (unsigned)tgt);
            const int L2 = m2 ? (__ffsll((long long)m2) - 1) : 63;
            const int tbin = m2 ? 2 * (2047 - 32 * Ls) + 1 - L2 : 0; const unsigned cbv = rlu(cl, L2), cabv = rlu(incl2 - cl, L2);
            if (lane == 0) { qTbin[q] = tbin; qCab[q] = (int)cabv; int zl = 0x7fffffff;
                if (tbin == IX_ZBIN) {
                    const int nk = p0 + 4 * (q & 3) + (q >> 2) + 1; zl = (int)(((unsigned long long)384 * (unsigned)(nsb * 16)) / (cbv ? cbv : 1u)) + 16; zl = zl < nk ? zl : 0x7fffffff; }
                qZl[q] = zl; }
        }
        __syncthreads();
        if (b0 < b1) {
            unsigned lok[4]; int zl[4];
#pragma unroll
            for (int rt = 0; rt < 4; ++rt) { lok[rt] = (unsigned)qTbin[g * 4 + rt] << 20; zl[rt] = qZl[g * 4 + rt]; }
            half8 kq[2][2];
#pragma unroll
            for (int u = 0; u < 2; ++u) { const int bb = (b0 + u < b1) ? b0 + u : b1 - 1; IX_LOADK(u, bb); }
            auto step2 = [&](int bcur, const half8& k0, const half8& k1, auto chkTag) {
                constexpr bool CHK = decltype(chkTag)::value;
                const int s = bcur * 16 + kl;
                f32x4 acc[4]; IX_MFMA(acc, k0, k1);
                unsigned key[4], pos[4]; bool cand[4];
#pragma unroll
                for (int rt = 0; rt < 4; ++rt) { key[rt] = ix_key(acc[rt], wv[rt]); cand[rt] = key[rt] >= lok[rt] + (s >= zl[rt] ? 1u : 0u); if (CHK) cand[rt] = cand[rt] && s <= p0 + 4 * rt + g; }
#pragma unroll
                for (int rt = 0; rt < 4; ++rt) { pos[rt] = 0u;
                    if (cand[rt]) { int gz = g; asm volatile("" : "+v"(gz)); pos[rt] = LDS_ADD(qN + gz * 4 + rt, 1u); } }
#pragma unroll
                for (int rt = 0; rt < 4; ++rt) {
                    if (cand[rt] && pos[rt] < (unsigned)IX_CAP) { int gz = g; asm volatile("" : "+v"(gz));
                        ((LAS unsigned long long*)(lds + (gz * 4 + rt) * 8192))[pos[rt]] = ((unsigned long long)key[rt] << 16) | (unsigned long long)(0xffffu - (unsigned)s); } }
            };
            int b = b0;
#pragma unroll 1
            for (; b + 2 <= b1 && b + 2 <= nblk - 1; b += 2) {
#pragma unroll
                for (int u = 0; u < 2; ++u) { step2(b + u, kq[u][0], kq[u][1], IxTagF{}); const int bb = (b + 2 + u < b1) ? b + 2 + u : b1 - 1; IX_LOADK(u, bb); }
            }
#pragma unroll 1
            for (; b + 2 <= b1; b += 2) {
#pragma unroll
                for (int u = 0; u < 2; ++u) { step2(b + u, kq[u][0], kq[u][1], IxTagT{}); const int bb = (b + 2 + u < b1) ? b + 2 + u : b1 - 1; IX_LOADK(u, bb); }
            }
            if (b < b1) step2(b, kq[0][0], kq[0][1], IxTagT{});
        }
#undef IX_LOADK
#undef IX_MFMA
        __syncthreads();
#pragma unroll 1
        for (int qq = 0; qq < 2; ++qq) {
            const int qs = 2 * wave + qq; const int n = __builtin_amdgcn_readfirstlane((int)qN[qs]);
            if (n > IX_CAP || n < 256) { if (lane == 0) qOvf[qs] = 1; continue; }
            const LAS unsigned long long* cd = (const LAS unsigned long long*)(lds + qs * 8192);
            unsigned short* irow = IDX + (t0 + 4 * (qs & 3) + (qs >> 2)) * 256;
            const int NI = (n + 63) >> 6;
            unsigned long long v[16];
#pragma unroll
            for (int i = 0; i < 16; ++i) v[i] = (i < NI && lane + 64 * i < n) ? cd[lane + 64 * i] : 0ull;
            unsigned long long tau = 1ull;
            if (n > 256) {
                unsigned long long pmask = 0xfffull << 36, pval; int need; unsigned cT;
                {
                    int cpos = 0, czer = 0;
#pragma unroll
                    for (int i = 0; i < 16; ++i) if (i < NI) { const int bb = (int)(v[i] >> 36); cpos += (int)__popcll(__ballot(bb > IX_ZBIN)); czer += (int)__popcll(__ballot(bb == IX_ZBIN && v[i] != 0ull)); }
                    if (cpos < 256 && cpos + czer >= 256) { need = 256 - cpos; cT = (unsigned)czer; pval = (unsigned long long)IX_ZBIN << 36; }
                    else {
                        const bool negc = cpos < 256; const int abovec = negc ? cpos + czer : 0;
                        int bmx = 0;
#pragma unroll
                        for (int i = 0; i < 16; ++i) if (i < NI) { const int bb = (int)(v[i] >> 36); const bool mem = negc ? (bb < IX_ZBIN && v[i] != 0ull) : (bb > IX_ZBIN); bmx = (mem && bb > bmx) ? bb : bmx; }
                        bmx = (int)wave_max((float)bmx);
#pragma unroll
                        for (int j = 0; j < 4; ++j) h2[lane + 64 * j] = 0u;
                        asm volatile("" ::: "memory");
#pragma unroll
                        for (int i = 0; i < 16; ++i) if (i < NI) { const int bb = (int)(v[i] >> 36); const bool mem = negc ? (bb < IX_ZBIN && v[i] != 0ull) : (bb > IX_ZBIN);
                            if (mem) { const int d = bmx - bb; LDS_ADD(h2 + (d > 255 ? 0 : 255 - d), 1u); } }
                        asm volatile("" ::: "memory");
                        const unsigned want = (unsigned)(256 - abovec);
                        int T0; unsigned above, c2; radix_pick(h2, lane, want, T0, above, c2);
                        if (T0 <= 0) { if (lane == 0) qOvf[qs] = 1; continue; }
                        need = (int)want - (int)above; cT = c2; pval = (unsigned long long)(unsigned)(bmx - 255 + T0) << 36;
                    }
                    asm volatile("" ::: "memory");
                }
#pragma unroll 1
                for (int shift = 28; shift >= 4 && cT > 64u; shift -= 8) {
#pragma unroll
                    for (int j = 0; j < 4; ++j) h2[lane + 64 * j] = 0u;
                    asm volatile("" ::: "memory");
#pragma unroll
                    for (int i = 0; i < 16; ++i) if (i < NI && (v[i] & pmask) == pval) LDS_ADD(h2 + ((unsigned)(v[i] >> shift) & 255u), 1u);
                    asm volatile("" ::: "memory");
                    int T2; unsigned above, c2; radix_pick(h2, lane, (unsigned)need, T2, above, c2);
                    if (T2 < 0) { T2 = 0; }
                    need -= (int)above; cT = c2;
                    pmask |= 255ull << shift; pval |= (unsigned long long)T2 << shift;
                    asm volatile("" ::: "memory");
                }
                { int base = 0;
#pragma unroll
                  for (int i = 0; i < 16; ++i) { if (i < NI) { const bool mt = (v[i] & pmask) == pval; const unsigned long long bm = __ballot(mt);
                      if (mt) { const int pos = base + (int)__popcll(bm & ((1ull << lane) - 1ull)); if (pos < 64) l2[pos] = v[i]; }
                      base += (int)__popcll(bm); } } }
                asm volatile("" ::: "memory");
                const unsigned long long mine = (unsigned)lane < cT ? l2[lane] : 0ull;
                const unsigned mlo = (unsigned)mine, mhi = (unsigned)(mine >> 32);
                int rank = 0;
#pragma unroll 1
                for (unsigned j = 0; j < cT; ++j) { const unsigned long long o = ((unsigned long long)(unsigned)__builtin_amdgcn_readlane((int)mhi, (int)j) << 32) | (unsigned)__builtin_amdgcn_readlane((int)mlo, (int)j);
                    rank += (o > mine) ? 1 : 0; }
                const unsigned long long hit = __ballot((unsigned)lane < cT && rank == need - 1);
                const int hl = hit ? (__ffsll((long long)hit) - 1) : 0;
                tau = ((unsigned long long)(unsigned)__builtin_amdgcn_readlane((int)mhi, hl) << 32) | (unsigned)__builtin_amdgcn_readlane((int)mlo, hl);
                asm volatile("" ::: "memory");
            }
            { int base = 0;
#pragma unroll
              for (int i = 0; i < 16; ++i) { if (i < NI) { const bool e = v[i] >= tau; const unsigned long long bm = __ballot(e);
                  if (e) irow[base + (int)__popcll(bm & ((1ull << lane) - 1ull))] = (unsigned short)(0xffffu - (unsigned)(v[i] & 0xffffull));
                  base += (int)__popcll(bm); } } }
        }
        if (tid < 16) CNT[t0 + tid] = 256;
        __syncthreads();
        if (tid < 16 && qOvf[tid]) { const unsigned k = LDS_ADD(ovl, 1u); ovl[1 + k] = (unsigned)(t0 + 4 * (tid & 3) + (tid >> 2)); }
    }
    __syncthreads();
    const unsigned novl = __builtin_amdgcn_readfirstlane(ovl[0]);
#pragma unroll 1
    for (unsigned k = 0; k < novl; ++k) { const unsigned tq = __builtin_amdgcn_readfirstlane(ovl[1 + k]); indexer_slow_query(p, lds, (size_t)tq); }
}
#undef LDS_ADD

__device__ __forceinline__ void phase_attn(const P& p, unsigned char* lds) {
    unsigned char* ws = p.ws; const int tid = tid_opaque(), lane = tid & 63, hd = lane & 15, g = lane >> 4;
    const int wave = __builtin_amdgcn_readfirstlane(tid >> 6);
    bf16_t* QP = (bf16_t*)(ws + OFF_QP); const bf16_t* CK = (const bf16_t*)(ws + OFF_CKVN); const bf16_t* RK = (const bf16_t*)(ws + OFF_RK);
    const unsigned short* IDX = (const unsigned short*)(ws + OFF_IDX); const int* CNT = (const int*)(ws + OFF_CNT);
    float* biasT = (float*)lds;
    biasT[tid] = p.rel_bias[tid] * 1.4426950408889634f;
    __syncthreads();
    LAS unsigned char* rows = (LAS unsigned char*)(lds + 2048 + (size_t)wave * 18432);
    LAS bf16_t* rkb = (LAS bf16_t*)(rows + 16384);
    LAS unsigned* info = (LAS unsigned*)(rows + 17408);
    const LAS float* biasL = (const LAS float*)lds;
    for (int t = blockIdx.x * 8 + wave; t < T; t += gridDim.x * 8) {
        const int batch = t >> 14, pos = t & (SEQ - 1); const int cnt = __builtin_amdgcn_readfirstlane(CNT[t]);
        const size_t rb = (size_t)batch * SEQ;
        asm volatile("s_waitcnt lgkmcnt(0)" ::: "memory");
#pragma unroll
        for (int jj = 0; jj < 4; ++jj) {
            const int j = lane + 64 * jj; int id = IDX[(size_t)t * 256 + j]; if (j >= cnt) id = 0;
            const int rel = pos - id; int bucket = rel < 0 ? 0 : rel;
            if (rel >= 16) { bucket = 16 + (int)(__logf((float)rel * 0.0625f) / 2.0794415416798357f * 16.0f); bucket = bucket > 31 ? 31 : bucket; }
            info[j] = (unsigned)id | ((unsigned)bucket << 16);
        }
        bf16x8 qf[8];
#pragma unroll
        for (int ks = 0; ks < 8; ++ks) qf[ks] = *(const bf16x8*)(QP + (size_t)t * 4096 + hd * 256 + ks * 32 + g * 8);
        f32x4 o[16];
#pragma unroll
        for (int rt = 0; rt < 16; ++rt) o[rt] = (f32x4){0.f, 0.f, 0.f, 0.f};
        float mref = 0.f, lrun = 0.f;
        asm volatile("s_waitcnt lgkmcnt(0)" ::: "memory");
        const int nch = (cnt + 31) >> 5;
        for (int ch = 0; ch < nch; ++ch) {
            asm volatile("s_waitcnt lgkmcnt(0)" ::: "memory");
#pragma unroll
            for (int i = 0; i < 16; ++i) {
                const int ksl = 2 * i + (lane >> 5); const unsigned idv = info[ch * 32 + ksl] & 0xffffu;
                const bf16_t* src = CK + (rb + idv) * 256 + (((lane & 31) ^ (ksl & 15)) * 8);
                __builtin_amdgcn_global_load_lds((const unsigned*)src, (LAS unsigned*)(rows + i * 1024), 16, 0, 0);
            }
            { const unsigned idv = info[ch * 32 + (lane >> 1)] & 0xffffu;
              __builtin_amdgcn_global_load_lds((const unsigned*)(RK + (rb + idv) * 16 + (lane & 1) * 8), (LAS unsigned*)rkb, 16, 0, 0); }
            asm volatile("s_waitcnt vmcnt(0)" ::: "memory");
            f32x4 s0 = (f32x4){0.f, 0.f, 0.f, 0.f}, s1 = (f32x4){0.f, 0.f, 0.f, 0.f};
#pragma unroll
            for (int ks = 0; ks < 8; ++ks) {
                const int pos16 = ((4 * ks + g) ^ hd) * 16;
                const bf16x8 a0 = *(const LAS bf16x8*)(rows + hd * 512 + pos16);
                const bf16x8 a1 = *(const LAS bf16x8*)(rows + (16 + hd) * 512 + pos16);
                s0 = __builtin_amdgcn_mfma_f32_16x16x32_bf16(a0, qf[ks], s0, 0, 0, 0);
                s1 = __builtin_amdgcn_mfma_f32_16x16x32_bf16(a1, qf[ks], s1, 0, 0, 0);
            }
            float x0[4], x1[4];
#pragma unroll
            for (int r = 0; r < 4; ++r) {
                const int sl0 = 4 * g + r, sl1 = 16 + 4 * g + r, j0 = ch * 32 + sl0, j1 = ch * 32 + sl1;
                const unsigned i0 = info[j0], i1 = info[j1];
                const float r0 = bf2f(rkb[sl0 * 16 + hd]), r1 = bf2f(rkb[sl1 * 16 + hd]);
                x0[r] = fmaf(s0[r], r0, biasL[(i0 >> 16) * 16 + hd]);
                x1[r] = fmaf(s1[r], r1, biasL[(i1 >> 16) * 16 + hd]);
            }
            if (cnt < 256) {
#pragma unroll
                for (int r = 0; r < 4; ++r) { if (ch * 32 + 4 * g + r >= cnt) x0[r] = -INFINITY; if (ch * 32 + 16 + 4 * g + r >= cnt) x1[r] = -INFINITY; }
            }
            const float cml = fmaxf(fmaxf(fmaxf(x0[0], x0[1]), fmaxf(x0[2], x0[3])), fmaxf(fmaxf(x1[0], x1[1]), fmaxf(x1[2], x1[3])));
            if (ch == 0 || __ballot(cml > mref + 11.5f)) {
                float cm = fmaxf(cml, __shfl_xor(cml, 16)); cm = fmaxf(cm, __shfl_xor(cm, 32));
                const float mnew = (ch == 0) ? cm : fmaxf(mref, cm);
                if (ch != 0) { const float sc = __builtin_amdgcn_exp2f(mref - mnew); lrun *= sc;
#pragma unroll
                    for (int rt = 0; rt < 16; ++rt) o[rt] *= sc; }
                mref = mnew;
            }
            float ls = 0.f;
#pragma unroll
            for (int r = 0; r < 4; ++r) { x0[r] = __builtin_amdgcn_exp2f(x0[r] - mref); x1[r] = __builtin_amdgcn_exp2f(x1[r] - mref); ls += x0[r] + x1[r]; }
            lrun += ls;
            u32x4 pw; pw.x = pg8::cvt_pk_bf16(x0[0], x0[1]); pw.y = pg8::cvt_pk_bf16(x0[2], x0[3]); pw.z = pg8::cvt_pk_bf16(x1[0], x1[1]); pw.w = pg8::cvt_pk_bf16(x1[2], x1[3]);
            const bf16x8 pf = __builtin_bit_cast(bf16x8, pw);
            const int q = hd >> 2, pp = hd & 3, ksl = 4 * g + q;
            const LAS unsigned char* trb = rows + ksl * 512 + (pp & 1) * 8;
#pragma unroll
            for (int rt = 0; rt < 16; ++rt) {
                const int c16 = ((2 * rt + (pp >> 1)) ^ ksl) * 16;
                const v4i16_t t0 = __builtin_amdgcn_ds_read_tr16_b64_v4i16((LAS v4i16_t*)(trb + c16));
                const v4i16_t t1 = __builtin_amdgcn_ds_read_tr16_b64_v4i16((LAS v4i16_t*)(trb + c16 + 8192));
                bf16x8 af; af[0] = t0[0]; af[1] = t0[1]; af[2] = t0[2]; af[3] = t0[3]; af[4] = t1[0]; af[5] = t1[1]; af[6] = t1[2]; af[7] = t1[3];
                o[rt] = __builtin_amdgcn_mfma_f32_16x16x32_bf16(af, pf, o[rt], 0, 0, 0);
            }
        }
        float ltot = lrun; ltot += __shfl_xor(ltot, 16); ltot += __shfl_xor(ltot, 32);
        const float inv = 1.0f / ltot;
        bf16_t* op = QP + (size_t)t * 4096 + hd * 256 + 4 * g;
#pragma unroll
        for (int rt = 0; rt < 16; ++rt) { u32x2 w; w.x = pg8::cvt_pk_bf16(o[rt][0] * inv, o[rt][1] * inv); w.y = pg8::cvt_pk_bf16(o[rt][2] * inv, o[rt][3] * inv); *(u32x2*)(op + rt * 16) = w; }
    }
}

__global__ void __launch_bounds__(512, 2) k_fwd(P p_arg, int ph_lo, int ph_hi) {
    extern __shared__ __attribute__((aligned(16))) unsigned char smem[];
    const P& p = *(const P*)__builtin_amdgcn_kernarg_segment_ptr(); (void)p_arg;
    unsigned char* lds = smem + 16;
    unsigned char* ws = p.ws;
    XcdBarrier bar;
    const bool multi = (ph_hi - ph_lo) > 1;
    if (multi) {
        if (threadIdx.x == 0) *(uint4*)smem = make_uint4(0u, 0u, 0u, 0u);
        __syncthreads();
        bar = xcd_barrier_post((unsigned*)(ws + OFF_CTL), (volatile LAS unsigned*)smem);
    }
#define PH(i) (ph_lo <= (i) && (i) < ph_hi)
#define SEAM(i) do { if ((i) + 1 < ph_hi) xcd_barrier(bar); else __syncthreads(); } while (0)
    bf16_t *XN = (bf16_t*)(ws + OFF_XN), *QB = (bf16_t*)(ws + OFF_QB), *KB = (bf16_t*)(ws + OFF_KB), *VB = (bf16_t*)(ws + OFF_VB), *TMP = (bf16_t*)(ws + OFF_TMP), *Y = (bf16_t*)(ws + OFF_Y);
    if (PH(0)) { phase_prep(p, lds); SEAM(0); }
    if (PH(1)) { fast_gemm(lds, XN, 1024, (const bf16_t*)(ws + OFF_W0T), 1024, 3072, 1024, D1{ws}); SEAM(1); }
    if (PH(2)) { phase_conv_scan(p, lds); SEAM(2); }
    if (PH(3)) { mlstm_units<false>(p, lds); SEAM(3); }
    if (PH(4)) { GWP f{(const bf16_t*)(ws + OFF_WPT), (const bf16_t*)(ws + OFF_WUB), (bf16_t*)(ws + OFF_W0T)}; sgemm(f, 256); phase_mlstm_scan(p, lds); SEAM(4); }
    if (PH(5)) { mlstm_units<true>(p, lds); SEAM(5); }
    if (PH(6)) { fast_gemm(lds, XN, 1024, (const bf16_t*)(ws + OFF_W0T) + (size_t)3072 * 1024, 1024, 4096, 1024, D2{ws}); SEAM(6); }
    if (PH(7)) { phase_ya_pool(p); SEAM(7); }
    if (PH(8)) { fast_gemm(lds, Y, 2048, (const bf16_t*)(ws + OFF_WO0T), 2048, 1024, 2048, D4{(unsigned char*)p.out, p.x, ws}); SEAM(8); }
    if (PH(10)) { fast_gemm(lds, XN, 1024, (const bf16_t*)(ws + OFF_W1T), 1024, 2816, 1024, D5{ws, p.o_g_q}); SEAM(10); }
    if (PH(11)) { phase_qnorm_ckvnorm(p); SEAM(11); }
    if (PH(12)) { fast_gemm(lds, (const bf16_t*)(ws + OFF_CKVN), 256, (const bf16_t*)(ws + OFF_WUKP), 256, 1024, 256, DK{ws}); SEAM(12); }
    if (PH(13)) { fast_gemm(lds, TMP, 1024, (const bf16_t*)(ws + OFF_WQF), 128, 4096, 128, DQ{ws}, (size_t)128); phase_indexer(p, lds); SEAM(13); }
    if (PH(14)) { phase_attn(p, lds); SEAM(14); }
    if (PH(15)) { fast_gemm(lds, (const bf16_t*)(ws + OFF_QP), 4096, (const bf16_t*)(ws + OFF_WBD), 1024, 1024, 1024, DO{ws}, (size_t)2048); SEAM(15); }
    if (PH(16)) { fast_gemm(lds, TMP, 1024, (const bf16_t*)(ws + OFF_WO1T), 1024, 1024, 1024, D8{(unsigned char*)p.out}); }
#undef PH
#undef SEAM
}

extern "C" void kernel_launch(void* const* d_in, const int* in_sizes, int n_in, void* d_out, int out_size, void* d_ws, size_t ws_size, hipStream_t stream) {
    static int grid = 0;
    if (grid == 0) {
        if (n_in != 18 || out_size != T * DM || ws_size < WS_END) { fprintf(stderr, "kernel_launch: unexpected shapes (n_in %d out %d ws %zu)\n", n_in, out_size, ws_size); grid = -1; return; }
        if (hipFuncSetAttribute((const void*)k_fwd, hipFuncAttributeMaxDynamicSharedMemorySize, LDS_BYTES) != hipSuccess) { fprintf(stderr, "kernel_launch: hipFuncSetAttribute failed\n"); grid = -1; return; }
        grid = 256;
    }
    if (grid < 0) return;
    (void)hipMemsetAsync((char*)d_ws + OFF_CTL, 0, 16384, stream);
    P p{};
    p.x = (const float*)d_in[0]; p.e_norm = (const float*)d_in[1]; p.e_w_in = (const float*)d_in[2]; p.e_conv = (const float*)d_in[3]; p.e_b_if = (const float*)d_in[4];
    p.e_g_head = (const float*)d_in[5]; p.e_w_pool = (const float*)d_in[6]; p.e_s_pool = (const float*)d_in[7]; p.e_w_out = (const float*)d_in[8];
    p.o_norm = (const float*)d_in[9]; p.o_w_in = (const float*)d_in[10]; p.o_g_kv = (const float*)d_in[11]; p.o_w_uk = (const float*)d_in[12]; p.o_w_uv = (const float*)d_in[13];
    p.o_g_q = (const float*)d_in[14]; p.o_g_k = (const float*)d_in[15]; p.o_w_out = (const float*)d_in[16]; p.rel_bias = (const float*)d_in[17];
    p.out = (float*)d_out; p.ws = (unsigned char*)d_ws;
    hipLaunchKernelGGL(k_fwd, dim3(grid), dim3(512), LDS_BYTES, stream, p, 0, NPH);
}
```

```cpp
#include <hip/hip_runtime.h>
#include <stdint.h>
#include <cstdio>

typedef unsigned short bf16_t;
typedef short bf16x8 __attribute__((ext_vector_type(8)));
typedef float f32x4 __attribute__((ext_vector_type(4)));
typedef unsigned u32x4 __attribute__((ext_vector_type(4)));
typedef unsigned u32x2 __attribute__((ext_vector_type(2)));
typedef float f32x2 __attribute__((ext_vector_type(2)));
typedef short v4i16_t __attribute__((ext_vector_type(4)));
#define LAS __attribute__((address_space(3)))

constexpr int T = 32768, SEQ = 16384, DM = 1024;
constexpr int EIN = 7176, OIN = 2628;
constexpr float EPS = 1e-6f;
constexpr size_t MB = 1048576;
constexpr size_t OFF_CTL = 0;
constexpr size_t OFF_GATES = 64 * 1024;
constexpr size_t OFF_BQ = OFF_GATES + (size_t)T * 8 * 4;
constexpr size_t OFF_IQ = OFF_BQ + (size_t)T * 4 * 4;
constexpr size_t OFF_MT = OFF_IQ + (size_t)T * 4 * 4;
constexpr size_t OFF_WI = OFF_MT + (size_t)T * 4 * 4;
constexpr size_t OFF_CH = OFF_WI + (size_t)T * 4 * 4;
constexpr size_t OFF_NS = OFF_CH + 64 * 1024;
constexpr size_t OFF_RSQ = OFF_GATES;
constexpr size_t OFF_W = 4 * MB;
constexpr size_t OFF_W0T = OFF_W;
constexpr size_t OFF_WPT = OFF_W0T + (size_t)7168 * 1024 * 2;
constexpr size_t OFF_WO0T = OFF_WPT + (size_t)4 * 256 * 256 * 2;
constexpr size_t OFF_W1T = OFF_WO0T + (size_t)1024 * 2048 * 2;
constexpr size_t OFF_WUKT = OFF_W1T + (size_t)2816 * 1024 * 2;
constexpr size_t OFF_WUVT = OFF_WUKT + (size_t)1024 * 256 * 2;
constexpr size_t OFF_WO1T = OFF_WUVT + (size_t)1024 * 256 * 2;
constexpr size_t OFF_WUKP = OFF_WO1T + (size_t)1024 * 1024 * 2;
constexpr size_t OFF_WQP = OFF_WUKP + (size_t)1024 * 256 * 2;
constexpr size_t OFF_WUB = OFF_WQP + (size_t)16 * 256 * 64 * 2;
constexpr size_t OFF_XN = 36 * MB, OFF_QB = 100 * MB, OFF_KB = 164 * MB, OFF_VB = 228 * MB, OFF_TMP = 292 * MB, OFF_Y = 356 * MB;
constexpr size_t OFF_QP = 36 * MB;
constexpr size_t OFF_CKVN = OFF_Y;
constexpr size_t OFF_QI = OFF_Y + 16 * MB;
constexpr size_t OFF_KI = OFF_Y + 32 * MB;
constexpr size_t OFF_KIT = OFF_Y + 36 * MB;
constexpr size_t OFF_IDX = OFF_Y + 40 * MB;
constexpr size_t OFF_RK = OFF_Y + 58 * MB;
constexpr size_t OFF_CNT = OFF_Y + 59 * MB;
constexpr size_t OFF_Z = OFF_Y + 60 * MB;
constexpr size_t OFF_WBD = 484 * MB;
constexpr size_t OFF_WQF = 486 * MB;
constexpr size_t WS_END = 487 * MB;
constexpr int LDS_BYTES = 151552;
constexpr int NPH = 17;

struct P {
    const float *x, *e_norm, *e_w_in, *e_conv, *e_b_if, *e_g_head, *e_w_pool, *e_s_pool, *e_w_out;
    const float *o_norm, *o_w_in, *o_g_kv, *o_w_uk, *o_w_uv, *o_g_q, *o_g_k, *o_w_out, *rel_bias;
    float* out; unsigned char* ws;
};

__device__ __forceinline__ unsigned pk2(float a, float b) { unsigned r; asm("v_cvt_pk_bf16_f32 %0, %1, %2" : "=v"(r) : "v"(a), "v"(b)); return r; }
__device__ __forceinline__ bf16_t f2bf(float f) { return (bf16_t)(pk2(f, f) & 0xffffu); }
__device__ __forceinline__ float bf2f(bf16_t b) { return __uint_as_float(((unsigned)b) << 16); }
__device__ __forceinline__ float bflo(unsigned w) { return __uint_as_float(w << 16); }
__device__ __forceinline__ float bfhi(unsigned w) { return __uint_as_float(w & 0xffff0000u); }
__device__ __forceinline__ float sigmoidf_(float x) { return __builtin_amdgcn_rcpf(1.0f + __expf(-x)); }
__device__ __forceinline__ float siluf_(float x) { return x * __builtin_amdgcn_rcpf(1.0f + __expf(-x)); }
template <bool SILU> __device__ __forceinline__ f32x4 act4(const f32x4 x) {
    const f32x2 a = (f32x2){x[0], x[1]}, b = (f32x2){x[2], x[3]}, nl = (f32x2){-1.4426950408889634f, -1.4426950408889634f}, one = (f32x2){1.0f, 1.0f};
    const f32x2 ea = a * nl, eb = b * nl;
    const f32x2 da = (f32x2){__builtin_amdgcn_exp2f(ea.x), __builtin_amdgcn_exp2f(ea.y)} + one, db = (f32x2){__builtin_amdgcn_exp2f(eb.x), __builtin_amdgcn_exp2f(eb.y)} + one;
    f32x2 ra = (f32x2){__builtin_amdgcn_rcpf(da.x), __builtin_amdgcn_rcpf(da.y)}, rb = (f32x2){__builtin_amdgcn_rcpf(db.x), __builtin_amdgcn_rcpf(db.y)};
    if (SILU) { ra = ra * a; rb = rb * b; }
    return (f32x4){ra.x, ra.y, rb.x, rb.y};
}
template <int CTRL> __device__ __forceinline__ float dppf(float v) { return __builtin_bit_cast(float, __builtin_amdgcn_update_dpp(0, __builtin_bit_cast(int, v), CTRL, 0xf, 0xf, true)); }
__device__ __forceinline__ float rlf(float v, int l) { return __builtin_bit_cast(float, __builtin_amdgcn_readlane(__builtin_bit_cast(int, v), l)); }
__device__ __forceinline__ int tid_opaque() { int t = threadIdx.x; asm volatile("" : "+v"(t)); return t; }
__device__ __forceinline__ float wave_sum(float v) {
    v += dppf<0xB1>(v); v += dppf<0x4E>(v); v += dppf<0x141>(v); v += dppf<0x140>(v);
    return (rlf(v, 0) + rlf(v, 16)) + (rlf(v, 32) + rlf(v, 48));
}
__device__ __forceinline__ float wave_max(float v) {
    v = fmaxf(v, dppf<0xB1>(v)); v = fmaxf(v, dppf<0x4E>(v)); v = fmaxf(v, dppf<0x141>(v)); v = fmaxf(v, dppf<0x140>(v));
    return fmaxf(fmaxf(rlf(v, 0), rlf(v, 16)), fmaxf(rlf(v, 32), rlf(v, 48)));
}

__device__ __forceinline__ float wave_sum8(const float (&x)[8], int lane) {
    const bool b5 = (lane & 32) != 0, b4 = (lane & 16) != 0, b0 = (lane & 1) != 0;
    float y[4], z[2];
#pragma unroll
    for (int k = 0; k < 4; ++k) { const float keep = b5 ? x[2 * k + 1] : x[2 * k], give = b5 ? x[2 * k] : x[2 * k + 1]; y[k] = keep + __shfl_xor(give, 32); }
#pragma unroll
    for (int m = 0; m < 2; ++m) { const float keep = b4 ? y[2 * m + 1] : y[2 * m], give = b4 ? y[2 * m] : y[2 * m + 1]; z[m] = keep + __shfl_xor(give, 16); }
    const float keep = b0 ? z[1] : z[0], give = b0 ? z[0] : z[1];
    float v = keep + dppf<0xB1>(give);
    v += dppf<0x4E>(v); v += dppf<0x124>(v); v += dppf<0x128>(v);
    return v;
}
template <int CTRL, int RM, bool BC> __device__ __forceinline__ unsigned dppu(unsigned v) { return (unsigned)__builtin_amdgcn_update_dpp(0, (int)v, CTRL, RM, 0xf, BC); }
__device__ __forceinline__ unsigned wave_iscan(unsigned v) {
    v += dppu<0x111, 0xf, true>(v); v += dppu<0x112, 0xf, true>(v); v += dppu<0x114, 0xf, true>(v); v += dppu<0x118, 0xf, true>(v);
    v += dppu<0x142, 0xa, false>(v); v += dppu<0x143, 0xc, false>(v);
    return v;
}
__device__ __forceinline__ unsigned rlu(unsigned v, int l) { return (unsigned)__builtin_amdgcn_readlane((int)v, l); }
__device__ __forceinline__ void radix_pick(const __attribute__((address_space(3))) unsigned* h2, int lane, unsigned want, int& T, unsigned& above, unsigned& cin) {
    asm volatile("" : "+v"(lane));
    const u32x4 hv = *(const __attribute__((address_space(3))) u32x4*)(h2 + 252 - 4 * lane);
    const unsigned cs = hv.x + hv.y + hv.z + hv.w;
    const unsigned incl = wave_iscan(cs);
    const unsigned long long m = __ballot(incl >= want);
    if (m == 0ull) { T = -1; above = rlu(incl, 63); cin = 0u; return; }
    const int Ls = __ffsll((long long)m) - 1;
    unsigned ab = rlu(incl - cs, Ls); const unsigned a0 = rlu(hv.w, Ls), a1 = rlu(hv.z, Ls), a2 = rlu(hv.y, Ls), a3 = rlu(hv.x, Ls);
    int t = 255 - 4 * Ls; unsigned c = a0;
    if (ab + a0 < want) { ab += a0; t -= 1; c = a1; if (ab + a1 < want) { ab += a1; t -= 1; c = a2; if (ab + a2 < want) { ab += a2; t -= 1; c = a3; } } }
    T = t; above = ab; cin = c;
}

#define XB_TMO      128
#define XB_XCNT(j)  (256  + 64 * (j))
#define XB_XSUB(j)  (1280 + 64 * (j))
#define XB_XGEN(j)  (2304 + 64 * (j))
#define XB_TOP      3328
#define XB_TOPGEN   3392
#define XCD_BAR_WORDS 3456
#define XB_SPIN_CAP (1u << 22)
__device__ __forceinline__ unsigned xb_ld(unsigned* p)              { return __hip_atomic_load(p, __ATOMIC_RELAXED, __HIP_MEMORY_SCOPE_AGENT); }
__device__ __forceinline__ unsigned xb_add(unsigned* p, unsigned v) { return __hip_atomic_fetch_add(p, v, __ATOMIC_RELAXED, __HIP_MEMORY_SCOPE_AGENT); }
__device__ __forceinline__ unsigned xb_xcc_id() { return (unsigned)__builtin_amdgcn_s_getreg((3 << 11) | 20) & 0xFu; }
#define XB_SPIN(cond, bar) do { unsigned _sp = 0; while (cond) { __builtin_amdgcn_s_sleep(1); \
    if ((++_sp & 255u) == 0u) { if (xb_ld(&(bar)[XB_TMO])) break; if (_sp > XB_SPIN_CAP) { atomicAdd(&(bar)[XB_TMO], 1u); break; } } } } while (0)
struct XcdBarrier { unsigned* bar; unsigned x; volatile LAS unsigned* st; };
__device__ __forceinline__ XcdBarrier xcd_barrier_post(unsigned* bar, volatile LAS unsigned* st) {
    XcdBarrier b; b.bar = bar; b.x = xb_xcc_id(); b.st = st;
    if (threadIdx.x == 0) (void)xb_add(&bar[XB_XCNT(b.x)], 1u);
    return b;
}
__device__ __forceinline__ void xcd_barrier_complete(unsigned* bar, unsigned x, unsigned& nloc, unsigned& nx) {
    const unsigned G = gridDim.x * gridDim.y * gridDim.z;
    unsigned sum, cnt, mine, sp = 0u;
    for (;;) {
        sum = 0u; cnt = 0u; mine = 0u;
#pragma unroll
        for (unsigned j = 0; j < 16; ++j) { const unsigned c = xb_ld(&bar[XB_XCNT(j)]); sum += c; cnt += (c > 0u) ? 1u : 0u; mine = (j == x) ? c : mine; }
        if (sum == G) break;
        __builtin_amdgcn_s_sleep(1);
        if ((++sp & 255u) == 0u) { if (xb_ld(&bar[XB_TMO])) break; if (sp > XB_SPIN_CAP) { atomicAdd(&bar[XB_TMO], 1u); break; } }
    }
    nloc = mine > 0u ? mine : 1u; nx = cnt > 0u ? cnt : 1u;
}
__device__ __forceinline__ void xcd_barrier(const XcdBarrier& b) {
    asm volatile("s_waitcnt vmcnt(0)" ::: "memory");
    __syncthreads();
    if (threadIdx.x == 0) {
        unsigned* bar = b.bar;
        __builtin_amdgcn_s_waitcnt(0);
        unsigned nloc = b.st[0], nx = b.st[1];
        if (nloc == 0u) { xcd_barrier_complete(bar, b.x, nloc, nx); b.st[0] = nloc; b.st[1] = nx; }
        const unsigned old = xb_add(&bar[XB_XSUB(b.x)], 1u);
        const unsigned gen = old / nloc;
        if (old + 1u == (gen + 1u) * nloc) {
            __builtin_amdgcn_fence(__ATOMIC_RELEASE, "agent");
            asm volatile("s_waitcnt vmcnt(0)" ::: "memory");
            const unsigned og = xb_add(&bar[XB_TOP], 1u);
            const unsigned tg = og / nx;
            if (og + 1u == (tg + 1u) * nx) xb_add(&bar[XB_TOPGEN], 1u);
            else XB_SPIN(xb_ld(&bar[XB_TOPGEN]) == tg, bar);
            __builtin_amdgcn_fence(__ATOMIC_ACQUIRE, "agent");
            xb_add(&bar[XB_XGEN(b.x)], 1u);
            asm volatile("s_waitcnt vmcnt(0)" ::: "memory");
        } else {
            XB_SPIN(xb_ld(&bar[XB_XGEN(b.x)]) == gen, bar);
            __builtin_amdgcn_fence(__ATOMIC_ACQUIRE, "agent");
            asm volatile("s_waitcnt vmcnt(0)" ::: "memory");
        }
    }
    __syncthreads();
}

struct Tile { const bf16_t* A; const bf16_t* B; int lda, ldb, K; void* d0; const void* s0; int ld; };
template <class F>
__device__ __forceinline__ void sgemm(const F f, int nunits) {
    const int lane = threadIdx.x & 63, wave = threadIdx.x >> 6, fr = lane & 15, fq = lane >> 4;
    for (int u = blockIdx.x * 8 + wave; u < nunits; u += gridDim.x * 8) {
        Tile tl; f.tile(u, tl);
        f32x4 acc[4][4];
#pragma unroll
        for (int m = 0; m < 4; ++m)
#pragma unroll
            for (int n = 0; n < 4; ++n) acc[m][n] = (f32x4){0.f, 0.f, 0.f, 0.f};
        const bf16_t* ap = tl.A + (size_t)fr * tl.lda + fq * 8;
        const bf16_t* bp = tl.B + (size_t)fr * tl.ldb + fq * 8;
        const int K = tl.K, lda = tl.lda, ldb = tl.ldb;
        bf16x8 a[4], b[4];
#pragma unroll
        for (int m = 0; m < 4; ++m) a[m] = *(const bf16x8*)(ap + (size_t)(m * 16) * lda);
#pragma unroll
        for (int n = 0; n < 4; ++n) b[n] = *(const bf16x8*)(bp + (size_t)(n * 16) * ldb);
#pragma unroll 1
        for (int k0 = 0; k0 < K; k0 += 32) {
            bf16x8 an[4], bn[4]; const int kn = (k0 + 32 < K) ? k0 + 32 : k0;
#pragma unroll
            for (int m = 0; m < 4; ++m) an[m] = *(const bf16x8*)(ap + (size_t)(m * 16) * lda + kn);
#pragma unroll
            for (int n = 0; n < 4; ++n) bn[n] = *(const bf16x8*)(bp + (size_t)(n * 16) * ldb + kn);
#pragma unroll
            for (int m = 0; m < 4; ++m)
#pragma unroll
                for (int n = 0; n < 4; ++n) acc[m][n] = __builtin_amdgcn_mfma_f32_16x16x32_bf16(b[n], a[m], acc[m][n], 0, 0, 0);
#pragma unroll
            for (int m = 0; m < 4; ++m) { a[m] = an[m]; b[m] = bn[m]; }
        }
#pragma unroll
        for (int m = 0; m < 4; ++m) {
            asm volatile("" ::: "memory");
#pragma unroll
            for (int n = 0; n < 4; ++n) f.out4(tl, m * 16 + fr, n * 16 + 4 * fq, acc[m][n]);
        }
    }
}
__device__ __forceinline__ void store4_bf16(const Tile& tl, int r, int c, const f32x4 v) {
    u32x2 w; w.x = pk2(v[0], v[1]); w.y = pk2(v[2], v[3]); *(u32x2*)((bf16_t*)tl.d0 + (size_t)r * tl.ld + c) = w; }

struct GWP {
    const bf16_t* WPT; const bf16_t* WUB; bf16_t* W0T;
    __device__ __forceinline__ void tile(int u, Tile& tl) const {
        const int kt = u & 15, dt = (u >> 4) & 3, g = u >> 6; tl.A = WPT + (size_t)(g * 256 + dt * 64) * 256; tl.lda = 256; tl.B = WUB + (size_t)kt * 64 * 1024 + g * 256; tl.ldb = 1024; tl.K = 256;
        tl.d0 = W0T + (size_t)(5120 + g * 256 + dt * 64) * 1024 + kt * 64; tl.ld = 1024; }
    __device__ __forceinline__ void out4(const Tile& tl, int r, int c, const f32x4 v) const { store4_bf16(tl, r, c, v); }
};
struct GQP {
    const bf16_t* Qn; const bf16_t* W; bf16_t* QP;
    __device__ __forceinline__ void tile(int u, Tile& tl) const {
        const int nt = u & 3, head = (u >> 2) & 15, mt = u >> 6; tl.A = Qn + (size_t)mt * 64 * 1024 + head * 64; tl.lda = 1024; tl.B = W + (size_t)(head * 256 + nt * 64) * 64; tl.ldb = 64; tl.K = 64;
        tl.d0 = QP + ((size_t)mt * 64 * 16 + head) * 256 + nt * 64; tl.ld = 4096; }
    __device__ __forceinline__ void out4(const Tile& tl, int r, int c, const f32x4 v) const { store4_bf16(tl, r, c, v); }
};
struct GOP {
    const bf16_t* OP; const bf16_t* W; const bf16_t* Z; bf16_t* G;
    __device__ __forceinline__ void tile(int u, Tile& tl) const {
        const int head = u & 15, mt = u >> 4; tl.A = OP + (size_t)mt * 64 * 4096 + head * 256; tl.lda = 4096; tl.B = W + (size_t)head * 64 * 256; tl.ldb = 256; tl.K = 256;
        const size_t o = (size_t)mt * 64 * 1024 + head * 64; tl.d0 = G + o; tl.s0 = Z + o; tl.ld = 1024; }
    __device__ __forceinline__ void out4(const Tile& tl, int r, int c, const f32x4 v) const { const size_t i = (size_t)r * 1024 + c; const u32x2 z = *(const u32x2*)((const bf16_t*)tl.s0 + i);
        u32x2 w; w.x = pk2(v[0] * bflo(z.x), v[1] * bfhi(z.x)); w.y = pk2(v[2] * bflo(z.y), v[3] * bfhi(z.y)); *(u32x2*)((bf16_t*)tl.d0 + i) = w; }
};

namespace pg8 {
constexpr int BM = 256, BK = 64, HALF = 128, HTB = HALF * BK * 2, STAGE_BYTES = 8 * HTB, NXCD = 8, WGM = 8;
__device__ __forceinline__ int lds_byte(int r, int c) { return (r >> 3) * 1024 + (r & 7) * 128 + ((((c >> 3) ^ (r >> 1)) & 7) << 4) + (c & 7) * 2; }
__device__ __forceinline__ void stage_rc(int b, int& R, int& C) { const int st = b / 1024, sb = b % 1024; R = st * 8 + (sb >> 7); C = ((((sb >> 4) & 7) ^ (R >> 1)) & 7) * 8; }
__device__ __forceinline__ int perm32(int rho) { const int n = rho >> 4, i = rho & 15; return 8 * (i >> 2) + 4 * n + (i & 3); }
struct Unit { int pm, pn; };
struct Gemm { const bf16_t* A; int lda; const bf16_t* Bt; int ldb; int M, N, K; size_t apn; };
struct StaticOrder {
    int nM, nN, nwg, G, c;
    __device__ void init(int M, int N, int G_, int c_) { nM = M / BM; nN = N / BM; nwg = nM * nN; G = G_; c = c_; }
    __device__ bool next(int i, Unit& u) const {
        const long L = (long)i * G + c; if (L >= nwg) return false;
        int wgid = (int)L; { const int q = nwg / NXCD, r = nwg % NXCD, xcd = wgid % NXCD, off = wgid / NXCD; wgid = (xcd < r ? xcd * (q + 1) : r * (q + 1) + (xcd - r) * q) + off; }
        const int nig = WGM * nN, gid = wgid / nig, fm = gid * WGM, gsz = (nM - fm) < WGM ? (nM - fm) : WGM;
        u.pm = fm + ((wgid % nig) % gsz); u.pn = (wgid % nig) / gsz; return true;
    }
};
__device__ __forceinline__ unsigned cvt_pk_bf16(float lo, float hi) { unsigned r; asm volatile("v_cvt_pk_bf16_f32 %0, %1, %2" : "=v"(r) : "v"(lo), "v"(hi)); return r; }

struct Dst { unsigned char* base; const float* res; int ld, mode, ncol; float scale; unsigned char* aux; float* rsq; };
template <class DescF> struct EpiGen {
    static constexpr bool PERM = true;
    DescF D;
    __device__ __forceinline__ void operator()(const f32x4 (&acc)[2][2][4][2], const Unit& u, int wr, int wc, int fr, int fq) const {
        Dst d; D.get(u, d);
        if ((DescF::MODES & 16) && d.mode == 4) return;
        const int r0 = wr * 64 + fr, c0 = wc * 32 + 8 * fq;
        if constexpr ((DescF::MODES & 64) != 0) {
#pragma unroll
            for (int ai = 0; ai < 2; ++ai)
#pragma unroll
                for (int m = 0; m < 4; ++m) {
                    float ss = 0.f;
#pragma unroll
                    for (int bj = 0; bj < 2; ++bj)
#pragma unroll
                        for (int n = 0; n < 2; ++n) { const f32x4 v = acc[ai][bj][m][n]; ss += v[0] * v[0] + v[1] * v[1] + v[2] * v[2] + v[3] * v[3]; }
                    ss += __shfl_xor(ss, 16); ss += __shfl_xor(ss, 32);
                    if (fq == 0) ((bf16_t*)d.base)[(size_t)(ai * HALF + r0 + m * 16) * d.ld + wc] = f2bf(__builtin_amdgcn_rsqf(ss * (1.0f / 64.0f) + EPS) * 1.4426950408889634f);
                }
            return;
        } else {
        float rsd[2][4];
        if constexpr ((DescF::MODES & 1024) != 0) {
#pragma unroll
            for (int ai = 0; ai < 2; ++ai)
#pragma unroll
                for (int m = 0; m < 4; ++m) { const size_t grow = (size_t)u.pm * BM + ai * HALF + r0 + m * 16; const f32x4 pp = *(const f32x4*)(d.rsq + grow * 16 + fq * 4);
                    float t = (pp[0] + pp[1]) + (pp[2] + pp[3]); t += __shfl_xor(t, 16); t += __shfl_xor(t, 32); rsd[ai][m] = __builtin_amdgcn_rsqf(t * (1.0f / 1024.0f) + EPS); }
        }
        f32x4 gq[2][2];
        if constexpr ((DescF::MODES & 2048) != 0) { if (d.mode == 10) {
#pragma unroll
            for (int bj = 0; bj < 2; ++bj) { gq[bj][0] = *(const f32x4*)(d.res + 32 * bj + 8 * fq); gq[bj][1] = *(const f32x4*)(d.res + 32 * bj + 8 * fq + 4); } } }
        constexpr bool PIPE = (DescF::MODES & (32 | 256)) != 0 && (DescF::MODES & 512) == 0;
        constexpr int DEPTH = (DescF::MODES & 256) ? 3 : 2, NSL = DEPTH + 1;
        f32x4 rq[NSL][4]; u32x4 zq[NSL][2];
        auto prefetch_rg = [&](int ai, int m, int slot) { const size_t ro = (size_t)(ai * HALF + r0 + m * 16) * d.ld;
            if constexpr ((DescF::MODES & 32) != 0) {
#pragma unroll
                for (int bj = 0; bj < 2; ++bj) { const float* rs = d.res + ro + bj * HALF + c0; rq[slot][2 * bj] = *(const f32x4*)rs; rq[slot][2 * bj + 1] = *(const f32x4*)(rs + 4); } }
            if constexpr ((DescF::MODES & 256) != 0) {
#pragma unroll
                for (int bj = 0; bj < 2; ++bj) zq[slot][bj] = *(const u32x4*)((const bf16_t*)d.res + ro + bj * HALF + c0); } };
        if constexpr (PIPE) {
#pragma unroll
            for (int k = 0; k < DEPTH; ++k) prefetch_rg(k >> 2, k & 3, k); }
#pragma unroll
        for (int ai = 0; ai < 2; ++ai)
#pragma unroll
            for (int m = 0; m < 4; ++m) {
                const size_t rowoff = (size_t)(ai * HALF + r0 + m * 16) * d.ld;
                const int slot = (ai * 4 + m) % NSL;
                if constexpr (PIPE) { if (ai * 4 + m + DEPTH < 8) prefetch_rg((ai * 4 + m + DEPTH) >> 2, (m + DEPTH) & 3, (ai * 4 + m + DEPTH) % NSL); }
                if constexpr ((DescF::MODES & 2048) != 0) { if (d.mode == 10) {
                    f32x4 q[2][2]; float ss = 0.f;
#pragma unroll
                    for (int bj = 0; bj < 2; ++bj)
#pragma unroll
                        for (int n = 0; n < 2; ++n) { q[bj][n] = acc[ai][bj][m][n] * rsd[ai][m]; ss += q[bj][n][0] * q[bj][n][0] + q[bj][n][1] * q[bj][n][1] + q[bj][n][2] * q[bj][n][2] + q[bj][n][3] * q[bj][n][3]; }
                    ss += __shfl_xor(ss, 16); ss += __shfl_xor(ss, 32);
                    const float rh = __builtin_amdgcn_rsqf(ss * (1.0f / 64.0f) + EPS);
#pragma unroll
                    for (int bj = 0; bj < 2; ++bj) { const f32x4 x0 = q[bj][0] * rh * gq[bj][0], x1 = q[bj][1] * rh * gq[bj][1];
                        u32x4 w; w.x = cvt_pk_bf16(x0[0], x0[1]); w.y = cvt_pk_bf16(x0[2], x0[3]); w.z = cvt_pk_bf16(x1[0], x1[1]); w.w = cvt_pk_bf16(x1[2], x1[3]);
                        *(u32x4*)((bf16_t*)d.base + rowoff + (4 * (u.pn & 3) + wc) * 64 + 32 * bj + 8 * fq) = w; }
                    continue; } }
                float ssq = 0.f;
#pragma unroll
                for (int bj = 0; bj < 2; ++bj) {
                    const int col = bj * HALF + c0; f32x4 v0 = acc[ai][bj][m][0], v1 = acc[ai][bj][m][1];
                    if constexpr ((DescF::MODES & 1024) != 0) { v0 *= rsd[ai][m]; v1 *= rsd[ai][m]; }
                    if ((DescF::MODES & 7) && d.mode <= 2) {
                        if ((DescF::MODES & 2) && d.mode == 1) {
#pragma unroll
                            for (int j = 0; j < 1; ++j) { v0 = act4<false>(v0); v1 = act4<false>(v1); } }
                        if ((DescF::MODES & 4) && d.mode == 2) {
#pragma unroll
                            for (int j = 0; j < 1; ++j) { v0 = act4<true>(v0); v1 = act4<true>(v1); } }
                        u32x4 w; w.x = cvt_pk_bf16(v0[0], v0[1]); w.y = cvt_pk_bf16(v0[2], v0[3]); w.z = cvt_pk_bf16(v1[0], v1[1]); w.w = cvt_pk_bf16(v1[2], v1[3]);
                        *(u32x4*)((bf16_t*)d.base + rowoff + col) = w;
                    } else if ((DescF::MODES & 256) && d.mode == 8) {
                        const u32x4 z = zq[slot][bj];
                        u32x4 w; w.x = cvt_pk_bf16(v0[0] * bflo(z.x), v0[1] * bfhi(z.x)); w.y = cvt_pk_bf16(v0[2] * bflo(z.y), v0[3] * bfhi(z.y));
                        w.z = cvt_pk_bf16(v1[0] * bflo(z.z), v1[1] * bfhi(z.z)); w.w = cvt_pk_bf16(v1[2] * bflo(z.w), v1[3] * bfhi(z.w));
                        *(u32x4*)((bf16_t*)d.base + rowoff + col) = w;
                    } else if ((DescF::MODES & 8) && d.mode == 3) {
                        if (col < d.ncol) { float* o = (float*)d.base + rowoff + col; *(f32x4*)o = v0 * d.scale; *(f32x4*)(o + 4) = v1 * d.scale; }
                    } else if ((DescF::MODES & 128) && d.mode == 7) {
                        typedef _Float16 h8 __attribute__((ext_vector_type(8)));
                        if (col < d.ncol) {
                        h8 hv; hv[0] = (_Float16)(v0[0] * d.scale); hv[1] = (_Float16)(v0[1] * d.scale); hv[2] = (_Float16)(v0[2] * d.scale); hv[3] = (_Float16)(v0[3] * d.scale);
                        hv[4] = (_Float16)(v1[0] * d.scale); hv[5] = (_Float16)(v1[1] * d.scale); hv[6] = (_Float16)(v1[2] * d.scale); hv[7] = (_Float16)(v1[3] * d.scale);
                        *(h8*)((_Float16*)d.base + rowoff + col) = hv; }
                        if constexpr ((DescF::MODES & 4096) != 0) { if (col == 64 && d.ncol == 64) *(f32x4*)((float*)d.aux + ((size_t)u.pm * BM + ai * HALF + r0 + m * 16) * 4) = v0 * 0.5f; }
                    } else if constexpr ((DescF::MODES & 32) != 0) {
                        float* o = (float*)d.base + rowoff + col;
                        f32x4 a, b;
                        if constexpr (PIPE) { a = rq[slot][2 * bj] + v0; b = rq[slot][2 * bj + 1] + v1; } else { const float* rs = d.res + rowoff + col; a = *(const f32x4*)rs + v0; b = *(const f32x4*)(rs + 4) + v1; }
                        *(f32x4*)o = a; *(f32x4*)(o + 4) = b;
                        if constexpr ((DescF::MODES & 512) != 0) {
                            u32x4 w; w.x = cvt_pk_bf16(a[0], a[1]); w.y = cvt_pk_bf16(a[2], a[3]); w.z = cvt_pk_bf16(b[0], b[1]); w.w = cvt_pk_bf16(b[2], b[3]);
                            *(u32x4*)((bf16_t*)d.aux + rowoff + col) = w;
                            ssq += (a[0] * a[0] + a[1] * a[1]) + (a[2] * a[2] + a[3] * a[3]) + (b[0] * b[0] + b[1] * b[1]) + (b[2] * b[2] + b[3] * b[3]); }
                    }
                }
                if constexpr ((DescF::MODES & 512) != 0) { ssq += __shfl_xor(ssq, 16); ssq += __shfl_xor(ssq, 32);
                    if (fq == 0) d.rsq[((size_t)u.pm * BM + ai * HALF + r0 + m * 16) * 16 + 4 * u.pn + wc] = ssq; }
                if (m & 1) asm volatile("" ::: "memory");
            }
        }
    }
};

template <class Epi>
__device__ __forceinline__ void gemm_phase(LAS unsigned char* lds, const Gemm g, const StaticOrder& S, const Epi& E) {
    const int tid = threadIdx.x, wid = __builtin_amdgcn_readfirstlane(tid >> 6), lane = tid & 63, wr = wid >> 2, wc = wid & 3, fr = lane & 15, fq = lane >> 4;
    int K = g.K; asm volatile("" : "+s"(K));
    const int nt = K / BK;
    unsigned voffA[2], voffB[2];
#pragma unroll
    for (int i = 0; i < 2; ++i) { int R, C; stage_rc(tid * 16 + i * 8192, R, C); const int Rb = Epi::PERM ? ((R & ~31) + perm32(R & 31)) : R;
        voffA[i] = (unsigned)(R * g.lda + C) * 2u; voffB[i] = (unsigned)(Rb * g.ldb + C) * 2u; }
    const size_t kstep = (size_t)(BK * 2);
    const size_t hstepA = (size_t)HALF * g.lda * 2, hstepB = (size_t)HALF * g.ldb * 2;
    const size_t tstepA = 2 * hstepA, tstepB = 2 * hstepB;
    const unsigned ldsw = (unsigned)wid * 1024u;
    const int aoff = lds_byte(wr * 64 + fr, fq * 8), boff = lds_byte(wc * 32 + fr, fq * 8), aoff1 = aoff ^ 64, boff1 = boff ^ 64;
#define PG8_SA(b, h) (((b) * 2 + (h)) * HTB)
#define PG8_SB(b, h) ((4 + (b) * 2 + (h)) * HTB)
#define PG8_STAGE(bufoff, gbase, voff) do { _Pragma("unroll") for (int _i = 0; _i < 2; ++_i) \
        __builtin_amdgcn_global_load_lds((const unsigned*)((const char*)(gbase) + (voff)[_i]), (LAS unsigned*)(lds + (bufoff) + ldsw + _i * 8192), 16, 0, 0); } while (0)
#define PG8_LDA(dst, b, h) do { _Pragma("unroll") for (int m = 0; m < 4; ++m) _Pragma("unroll") for (int k = 0; k < 2; ++k) dst[m][k] = *(const LAS bf16x8*)(lds + PG8_SA(b, h) + (k ? aoff1 : aoff) + m * 2048); } while (0)
#define PG8_LDB(dst, b, h) do { _Pragma("unroll") for (int n = 0; n < 2; ++n) _Pragma("unroll") for (int k = 0; k < 2; ++k) dst[n][k] = *(const LAS bf16x8*)(lds + PG8_SB(b, h) + (k ? boff1 : boff) + n * 2048); } while (0)
#define PG8_MMA(ai, bj, At, Bt) do { __builtin_amdgcn_s_setprio(1); _Pragma("unroll") for (int m = 0; m < 4; ++m) _Pragma("unroll") for (int n = 0; n < 2; ++n) _Pragma("unroll") for (int k = 0; k < 2; ++k) \
        acc[ai][bj][m][n] = __builtin_amdgcn_mfma_f32_16x16x32_bf16(Bt[n][k], At[m][k], acc[ai][bj][m][n], 0, 0, 0); __builtin_amdgcn_s_setprio(0); } while (0)
#define PG8_WAIT_V(n) asm volatile("s_waitcnt vmcnt(" #n ")" ::: "memory")
#define PG8_WAIT_L(n) asm volatile("s_waitcnt lgkmcnt(" #n ")" ::: "memory")
#define PG8_BAR __builtin_amdgcn_s_barrier()
#define PG8_SCHED __builtin_amdgcn_sched_barrier(0)
    Unit cur, nxt; int ui = 0;
    if (!S.next(0, cur)) return;
    f32x4 acc[2][2][4][2];
#pragma unroll
    for (int a = 0; a < 2; ++a)
#pragma unroll
        for (int b = 0; b < 2; ++b)
#pragma unroll
            for (int m = 0; m < 4; ++m)
#pragma unroll
                for (int n = 0; n < 2; ++n) acc[a][b][m][n] = (f32x4){0.f, 0.f, 0.f, 0.f};
    bf16x8 At[4][2], B0[2][2], B1[2][2];
    const char* cA = (const char*)g.A + (size_t)cur.pm * tstepA + (size_t)cur.pn * g.apn; const char* cB = (const char*)g.Bt + (size_t)cur.pn * tstepB;
    PG8_STAGE(PG8_SB(0, 0), cB, voffB); PG8_STAGE(PG8_SA(0, 0), cA, voffA); PG8_STAGE(PG8_SB(0, 1), cB + hstepB, voffB); PG8_STAGE(PG8_SA(0, 1), cA + hstepA, voffA);
    if (wr == 1) PG8_BAR;
    PG8_WAIT_V(4); PG8_BAR;
    PG8_STAGE(PG8_SB(1, 0), cB + kstep, voffB); PG8_STAGE(PG8_SA(1, 0), cA + kstep, voffA); PG8_STAGE(PG8_SB(1, 1), cB + hstepB + kstep, voffB);
    PG8_WAIT_V(6); PG8_BAR;
    for (;;) {
        const bool has_next = S.next(ui + 1, nxt);
        const char* nA = has_next ? (const char*)g.A + (size_t)nxt.pm * tstepA + (size_t)nxt.pn * g.apn : cA; const char* nB = has_next ? (const char*)g.Bt + (size_t)nxt.pn * tstepB : cB;
#pragma unroll 1
        for (int t = 0; t < nt; t += 2) {
            const bool last = (t == nt - 2);
            const char* a1 = cA + (size_t)(t + 1) * kstep;
            const char* a2 = last ? nA : cA + (size_t)(t + 2) * kstep; const char* b2 = last ? nB : cB + (size_t)(t + 2) * kstep;
            const char* a3 = a2 + kstep; const char* b3 = b2 + kstep;
            PG8_LDB(B0, 0, 0); PG8_SCHED; PG8_LDA(At, 0, 0); PG8_STAGE(PG8_SA(1, 1), a1 + hstepA, voffA);
            PG8_WAIT_L(8); PG8_BAR; PG8_WAIT_L(0); PG8_MMA(0, 0, At, B0); PG8_BAR; PG8_SCHED;
            PG8_LDB(B1, 0, 1); PG8_STAGE(PG8_SB(0, 0), b2, voffB);
            PG8_BAR; PG8_WAIT_L(0); PG8_MMA(0, 1, At, B1); PG8_BAR;
            PG8_LDA(At, 0, 1); PG8_STAGE(PG8_SA(0, 0), a2, voffA);
            PG8_BAR; PG8_WAIT_L(0); PG8_MMA(1, 0, At, B0); PG8_BAR; PG8_SCHED;
            PG8_STAGE(PG8_SB(0, 1), b2 + hstepB, voffB);
            PG8_WAIT_V(6); PG8_BAR; PG8_MMA(1, 1, At, B1); PG8_BAR;
            PG8_LDB(B0, 1, 0); PG8_SCHED; PG8_LDA(At, 1, 0); PG8_STAGE(PG8_SA(0, 1), a2 + hstepA, voffA);
            PG8_WAIT_L(8); PG8_BAR; PG8_WAIT_L(0); PG8_MMA(0, 0, At, B0); PG8_BAR; PG8_SCHED;
            PG8_LDB(B1, 1, 1); PG8_STAGE(PG8_SB(1, 0), b3, voffB);
            PG8_BAR; PG8_WAIT_L(0); PG8_MMA(0, 1, At, B1); PG8_BAR;
            PG8_LDA(At, 1, 1); PG8_STAGE(PG8_SA(1, 0), a3, voffA);
            PG8_BAR; PG8_WAIT_L(0); PG8_MMA(1, 0, At, B0); PG8_BAR; PG8_SCHED;
            PG8_STAGE(PG8_SB(1, 1), b3 + hstepB, voffB);
            PG8_WAIT_V(6); PG8_BAR; PG8_MMA(1, 1, At, B1); PG8_BAR;
        }
        E(acc, cur, wr, wc, fr, fq);
        if (!has_next) break;
#pragma unroll
        for (int a = 0; a < 2; ++a)
#pragma unroll
            for (int b = 0; b < 2; ++b)
#pragma unroll
                for (int m = 0; m < 4; ++m)
#pragma unroll
                    for (int n = 0; n < 2; ++n) acc[a][b][m][n] = (f32x4){0.f, 0.f, 0.f, 0.f};
        cur = nxt; cA = nA; cB = nB; ++ui;
    }
    PG8_WAIT_V(0);
    if (wr == 0) PG8_BAR;
    PG8_BAR;
#undef PG8_SA
#undef PG8_SB
#undef PG8_STAGE
#undef PG8_LDA
#undef PG8_LDB
#undef PG8_MMA
#undef PG8_WAIT_V
#undef PG8_WAIT_L
#undef PG8_BAR
#undef PG8_SCHED
}
}

struct D1 { static constexpr int MODES = 1; unsigned char* ws;
    __device__ __forceinline__ void get(const pg8::Unit& u, pg8::Dst& d) const { const int sec = u.pn >> 2;
        d.base = ws + OFF_QB + (size_t)sec * (64 * MB) + ((size_t)u.pm * 256 * 1024 + (u.pn & 3) * 256) * 2; d.res = nullptr; d.ld = 1024; d.mode = 0; d.ncol = 256; d.scale = 1.f; } };
struct D2 { static constexpr int MODES = 7; unsigned char* ws;
    __device__ __forceinline__ void get(const pg8::Unit& u, pg8::Dst& d) const { const int sec = u.pn >> 2, cc = (u.pn & 3) * 256; d.res = nullptr; d.ncol = 256; d.scale = 1.f;
        if (sec < 3) { d.base = ws + OFF_QB + (size_t)sec * (64 * MB) + ((size_t)u.pm * 256 * 1024 + cc) * 2; d.ld = 1024; d.mode = sec == 0 ? 1 : (sec == 1 ? 2 : 0); }
        else { d.base = ws + OFF_Y + ((size_t)u.pm * 256 * 2048 + 1024 + cc) * 2; d.ld = 2048; d.mode = 2; } } };
struct D4 { static constexpr int MODES = 32 | 512; unsigned char* out; const float* x; unsigned char* ws;
    __device__ __forceinline__ void get(const pg8::Unit& u, pg8::Dst& d) const { const size_t o = (size_t)u.pm * 256 * 1024 + u.pn * 256;
        d.base = out + o * 4; d.res = x + o; d.ld = 1024; d.mode = 5; d.ncol = 256; d.scale = 1.f; d.aux = ws + OFF_XN + o * 2; d.rsq = (float*)(ws + OFF_RSQ); } };
struct D5 { static constexpr int MODES = 133 | 1024 | 2048 | 4096; unsigned char* ws; const float* g_q;
    __device__ __forceinline__ void get(const pg8::Unit& u, pg8::Dst& d) const { const int pn = u.pn; d.res = nullptr; d.ncol = 256; d.scale = 1.f; d.rsq = (float*)(ws + OFF_RSQ); d.aux = ws + OFF_WI;
        if (pn < 4) { d.base = ws + OFF_TMP + (size_t)u.pm * 256 * 1024 * 2; d.res = g_q; d.ld = 1024; d.mode = 10; }
        else if (pn == 4) { d.base = ws + OFF_CKVN + (size_t)u.pm * 256 * 256 * 2; d.ld = 256; d.mode = 0; }
        else if (pn == 5) { d.base = ws + OFF_QI + (size_t)u.pm * 256 * 256 * 2; d.ld = 256; d.mode = 7; d.scale = 0.125f; }
        else if (pn == 6) { d.base = ws + OFF_KI + (size_t)u.pm * 256 * 64 * 2; d.ld = 64; d.mode = 7; d.ncol = 64; }
        else { d.base = ws + OFF_Z + ((size_t)u.pm * 256 * 1024 + (pn - 7) * 256) * 2; d.ld = 1024; d.mode = 2; } } };
struct DK { static constexpr int MODES = 64; unsigned char* ws;
    __device__ __forceinline__ void get(const pg8::Unit& u, pg8::Dst& d) const {
        d.base = ws + OFF_RK + ((size_t)u.pm * 256 * 16 + u.pn * 4) * 2; d.res = nullptr; d.ld = 16; d.mode = 6; d.ncol = 256; d.scale = 1.f; } };
struct D8 { static constexpr int MODES = 32; unsigned char* out;
    __device__ __forceinline__ void get(const pg8::Unit& u, pg8::Dst& d) const { const size_t o = (size_t)u.pm * 256 * 1024 + u.pn * 256;
        d.base = out + o * 4; d.res = (const float*)out + o; d.ld = 1024; d.mode = 5; d.ncol = 256; d.scale = 1.f; } };
struct DQ { static constexpr int MODES = 1; unsigned char* ws;
    __device__ __forceinline__ void get(const pg8::Unit& u, pg8::Dst& d) const {
        d.base = ws + OFF_QP + ((size_t)u.pm * 256 * 4096 + u.pn * 256) * 2; d.res = nullptr; d.ld = 4096; d.mode = 0; d.ncol = 256; d.scale = 1.f; } };
struct DO { static constexpr int MODES = 256; unsigned char* ws;
    __device__ __forceinline__ void get(const pg8::Unit& u, pg8::Dst& d) const { const size_t o = ((size_t)u.pm * 256 * 1024 + u.pn * 256) * 2;
        d.base = ws + OFF_TMP + o; d.res = (const float*)(ws + OFF_Z + o); d.ld = 1024; d.mode = 8; d.ncol = 256; d.scale = 1.f; } };
template <class DF>
__device__ __forceinline__ void fast_gemm(unsigned char* lds, const bf16_t* A, int lda, const bf16_t* Bt, int ldb, int N, int K, const DF& df, size_t apn = 0) {
    pg8::Gemm g{A, lda, Bt, ldb, T, N, K, apn}; pg8::StaticOrder S; S.init(T, N, (int)gridDim.x, (int)blockIdx.x);
    pg8::EpiGen<DF> E{df};
    pg8::gemm_phase(( LAS unsigned char*)lds, g, S, E);
}

template <bool QPERM = false>
__device__ __forceinline__ void tconv(const float* __restrict__ src, int ld, int col0, int ncols, int K, bf16_t* __restrict__ dst, float* tile  , const float* __restrict__ kscale = nullptr) {
    const int nkt = K / 64, ntiles = nkt * (ncols / 64), tid = threadIdx.x;
    const bool vec = ((col0 | ld) & 3) == 0;
    const int lk = tid >> 4, ln = (tid & 15) * 4;
    const int sn = tid >> 3, sk = (tid & 7) * 8;
    for (int id0 = blockIdx.x * 2; id0 < ntiles; id0 += gridDim.x * 2) {
        f32x4 v[2][2];
#pragma unroll
        for (int u = 0; u < 2; ++u) { const int id = id0 + u; if (id < ntiles) { const int kt = id % nkt, nt = id / nkt;
#pragma unroll
            for (int h = 0; h < 2; ++h) { const float* sp = src + (size_t)(kt * 64 + lk + 32 * h) * ld + col0 + nt * 64 + ln;
                if (vec) v[u][h] = *(const f32x4*)sp; else { v[u][h][0] = sp[0]; v[u][h][1] = sp[1]; v[u][h][2] = sp[2]; v[u][h][3] = sp[3]; }
                if (kscale) v[u][h] *= kscale[kt * 64 + lk + 32 * h]; } } }
#pragma unroll
        for (int u = 0; u < 2; ++u) { if (id0 + u < ntiles) {
#pragma unroll
            for (int h = 0; h < 2; ++h) { const int k = lk + 32 * h; *(f32x4*)(tile + u * 4352 + k * 68 + (ln ^ (k & 56))) = v[u][h]; } } }
        __syncthreads();
#pragma unroll
        for (int u = 0; u < 2; ++u) { const int id = id0 + u; if (id < ntiles) { const int kt = id % nkt, nt = id / nkt;
            const float* tp = tile + u * 4352 + sk * 68 + (sn ^ sk);
            u32x4 o; o.x = pk2(tp[0], tp[68]); o.y = pk2(tp[136], tp[204]); o.z = pk2(tp[272], tp[340]); o.w = pk2(tp[408], tp[476]);
            int nrow = nt * 64 + sn; if (QPERM) { const int hq = nrow >> 6, dq = nrow & 63; nrow = (hq >> 2) * 256 + 128 * (dq >> 5) + 32 * (hq & 3) + (dq & 31); }
            *(u32x4*)(dst + (size_t)nrow * K + kt * 64 + sk) = o; } }
        __syncthreads();
    }
}
template <int NE>
__device__ __forceinline__ void rmsnorm_rows(const float* __restrict__ src, const float* __restrict__ g, bf16_t* __restrict__ dst,
                             const float* __restrict__ Wx, int ldw, int col0, const float* __restrict__ bias, float scale, float* __restrict__ dstx, float* wl) {
    const int lane = threadIdx.x & 63, wave = threadIdx.x >> 6;
    __syncthreads();
    for (int i = threadIdx.x; i < NE * 1024; i += 512) { const int k = i / NE, e = i % NE; wl[e * 1024 + k] = Wx[(size_t)k * ldw + col0 + e]; }
    __syncthreads();
    for (int row0 = (blockIdx.x * 8 + wave) * 2; row0 < T; row0 += gridDim.x * 16) {
        f32x4 v[2][4];
#pragma unroll
        for (int r = 0; r < 2; ++r)
#pragma unroll
            for (int i = 0; i < 4; ++i) v[r][i] = *(const f32x4*)(src + (size_t)(row0 + r) * 1024 + i * 256 + lane * 4);
#pragma unroll
        for (int r = 0; r < 2; ++r) {
            const int row = row0 + r; f32x2 ss2 = (f32x2){0.f, 0.f};
#pragma unroll
            for (int i = 0; i < 4; ++i) { const f32x2 a = (f32x2){v[r][i][0], v[r][i][1]}, b = (f32x2){v[r][i][2], v[r][i][3]}; ss2 = __builtin_elementwise_fma(a, a, ss2); ss2 = __builtin_elementwise_fma(b, b, ss2); }
            const float ss = wave_sum(ss2.x + ss2.y);
            const float rstd = __builtin_amdgcn_rsqf(ss * (1.0f / 1024.0f) + EPS);
            f32x2 ex2[NE];
#pragma unroll
            for (int e = 0; e < NE; ++e) ex2[e] = (f32x2){0.f, 0.f};
#pragma unroll
            for (int i = 0; i < 4; ++i) {
                const f32x4 gg = *(const f32x4*)(g + i * 256 + lane * 4);
                const f32x4 y = (v[r][i] * rstd) * gg;
                u32x2 w; w.x = pk2(y[0], y[1]); w.y = pk2(y[2], y[3]);
                *(u32x2*)(dst + (size_t)row * 1024 + i * 256 + lane * 4) = w;
#pragma unroll
                for (int e = 0; e < NE; ++e) { const f32x4 wv = *(const f32x4*)(wl + e * 1024 + i * 256 + lane * 4);
                    ex2[e] = __builtin_elementwise_fma((f32x2){y[0], y[1]}, (f32x2){wv[0], wv[1]}, ex2[e]); ex2[e] = __builtin_elementwise_fma((f32x2){y[2], y[3]}, (f32x2){wv[2], wv[3]}, ex2[e]); }
            }
            if constexpr (NE == 8) {
                float ex[8];
#pragma unroll
                for (int e = 0; e < 8; ++e) ex[e] = ex2[e].x + ex2[e].y;
                const float tot = wave_sum8(ex, lane); const int e = 4 * (lane & 1) + 2 * ((lane >> 4) & 1) + (lane >> 5);
                if ((lane & 0xE) == 0) dstx[(size_t)row * 8 + e] = (tot + (bias ? bias[e] : 0.f)) * scale;
            } else {
            float mine = 0.f;
#pragma unroll
            for (int e = 0; e < NE; ++e) { const float sx = wave_sum(ex2[e].x + ex2[e].y); mine = (lane == e) ? sx : mine; }
            if (lane < NE) dstx[(size_t)row * NE + lane] = (mine + (bias ? bias[lane] : 0.f)) * scale;
            }
        }
    }
}

__device__ __forceinline__ void phase_prep(const P& p, unsigned char* lds) {
    float* tile = (float*)lds; unsigned char* ws = p.ws;
    bf16_t* W0T = (bf16_t*)(ws + OFF_W0T);
    tconv(p.e_w_in, EIN, 0, 5120, 1024, W0T, tile);
    tconv(p.e_w_in, EIN, 6152, 1024, 1024, W0T + (size_t)6144 * 1024, tile);
    for (int g = 0; g < 4; ++g) tconv(p.e_w_pool + (size_t)g * 65536, 256, 0, 256, 256, (bf16_t*)(ws + OFF_WPT) + (size_t)g * 65536, tile);
    { bf16_t* WUB = (bf16_t*)(ws + OFF_WUB);
      for (size_t i = (size_t)blockIdx.x * 512 + threadIdx.x; i < (size_t)1024 * 256; i += (size_t)gridDim.x * 512) {
          const size_t k = i >> 8; const int c4 = (int)(i & 255) * 4; const f32x4 v = *(const f32x4*)(p.e_w_in + k * EIN + 5128 + c4);
          u32x2 o; o.x = pk2(v[0], v[1]); o.y = pk2(v[2], v[3]); *(u32x2*)(WUB + k * 1024 + c4) = o; } }
    tconv(p.e_w_out, 1024, 0, 1024, 2048, (bf16_t*)(ws + OFF_WO0T), tile);
    bf16_t* W1T = (bf16_t*)(ws + OFF_W1T);
    tconv<true>(p.o_w_in, OIN, 0, 1024, 1024, W1T, tile, p.o_norm);
    tconv(p.o_w_in, OIN, 1024, 576, 1024, W1T + (size_t)1024 * 1024, tile, p.o_norm);
    for (size_t i = (size_t)blockIdx.x * 512 + threadIdx.x; i < (size_t)192 * 1024; i += (size_t)gridDim.x * 512) { const int e = (int)(i >> 10), k = (int)(i & 1023);
        W1T[(size_t)1600 * 1024 + i] = e < 4 ? f2bf(p.o_w_in[(size_t)k * OIN + 1600 + e] * p.o_norm[k]) : (bf16_t)0; }
    tconv(p.o_w_in, OIN, 1604, 1024, 1024, W1T + (size_t)1792 * 1024, tile, p.o_norm);
    {
        bf16_t* WUKP = (bf16_t*)(ws + OFF_WUKP); bf16_t* WQF = (bf16_t*)(ws + OFF_WQF); bf16_t* WBD = (bf16_t*)(ws + OFF_WBD);
        for (size_t i = (size_t)blockIdx.x * 512 + threadIdx.x; i < (size_t)1024 * 256; i += (size_t)gridDim.x * 512) {
            { const int n = (int)(i >> 8), k = (int)(i & 255), pn = n >> 8, rem = n & 255, bj = rem >> 7, wc = (rem >> 5) & 3, x = rem & 31;
              WUKP[i] = f2bf(p.o_w_uk[(size_t)k * 1024 + (4 * pn + wc) * 64 + 32 * bj + x]); }
            { const int d = (int)(i & 63), r = (int)((i >> 6) & 255), h = (int)(i >> 14); const size_t o = ((size_t)h * 256 + r) * 128 + d;
              WQF[o] = f2bf(p.o_w_uk[(size_t)r * 1024 + h * 64 + d] * p.o_g_k[d] * 0.125f); WQF[o + 64] = 0; }
            { const int r = (int)(i & 255), n = (int)(i >> 8), hl = (n >> 6) & 3; const float v = p.o_w_uv[(size_t)r * 1024 + n];
#pragma unroll
              for (int b = 0; b < 4; ++b) WBD[(size_t)n * 1024 + b * 256 + r] = (b == hl) ? f2bf(v) : (bf16_t)0; }
        }
    }
    tconv(p.o_w_out, 1024, 0, 1024, 1024, (bf16_t*)(ws + OFF_WO1T), tile);
    rmsnorm_rows<8>(p.x, p.e_norm, (bf16_t*)(ws + OFF_XN), p.e_w_in, EIN, 5120, p.e_b_if, 1.0f, (float*)(ws + OFF_GATES), (float*)lds);
}

__device__ __forceinline__ void phase_conv_scan(const P& p, unsigned char* lds) {
    unsigned char* ws = p.ws; const int tid = threadIdx.x;
    const float* GATES = (const float*)(ws + OFF_GATES);
    float *BQ = (float*)(ws + OFF_BQ), *IQ = (float*)(ws + OFF_IQ), *MT = (float*)(ws + OFF_MT), *CH = (float*)(ws + OFF_CH);
    {
        const int lane = tid & 63, wave = tid >> 6;
        for (int task = blockIdx.x * 8 + wave; task < 2048; task += gridDim.x * 8) {
            const int bh = task >> 8, c = task & 255, batch = bh >> 2, head = bh & 3; const size_t t = (size_t)batch * SEQ + c * 64 + lane;
            const float ig = GATES[t * 8 + head], f = GATES[t * 8 + 4 + head];
            float b = fminf(f, 0.f) - log1pf(__expf(-fabsf(f)));
#pragma unroll
            for (int o = 1; o < 64; o <<= 1) { const float y = __shfl_up(b, o); if (lane >= o) b += y; }
            float rm = ig - b;
#pragma unroll
            for (int o = 1; o < 64; o <<= 1) { const float y = __shfl_up(rm, o); if (lane >= o) rm = fmaxf(rm, y); }
            BQ[t * 4 + head] = b; IQ[t * 4 + head] = ig; MT[t * 4 + head] = rm;
            if (lane == 63) { CH[4096 + bh * 256 + c] = b; CH[bh * 256 + c] = b + rm; }
        }
    }
    const bf16_t* QB = (const bf16_t*)(ws + OFF_QB); const bf16_t* KB = (const bf16_t*)(ws + OFF_KB);
    bf16_t* Y = (bf16_t*)(ws + OFF_Y); bf16_t* KT = (bf16_t*)(ws + OFF_TMP);
    for (size_t it = (size_t)blockIdx.x * 512 + tid; it < (size_t)(T / 8) * 256; it += (size_t)gridDim.x * 512) {
        const size_t t0 = (it >> 8) * 8; const int c0 = (int)(it & 255) * 8, isk = c0 >= 1024, cc = c0 & 1023; const int s0 = (int)(t0 & (SEQ - 1));
        const bf16_t* src = isk ? KB : QB;
        u32x4 rw[11];
#pragma unroll
        for (int j = 0; j < 11; ++j) rw[j] = (s0 - 3 + j >= 0) ? *(const u32x4*)(src + (t0 - 3 + j) * 1024 + cc) : (u32x4){0u, 0u, 0u, 0u};
        f32x2 cw[4][4];
#pragma unroll
        for (int j = 0; j < 4; ++j) { const f32x4 a = *(const f32x4*)(p.e_conv + j * 2048 + c0), b = *(const f32x4*)(p.e_conv + j * 2048 + c0 + 4);
            cw[j][0] = (f32x2){a[0], a[1]}; cw[j][1] = (f32x2){a[2], a[3]}; cw[j][2] = (f32x2){b[0], b[1]}; cw[j][3] = (f32x2){b[2], b[3]}; }
        const float sc = isk ? 0.0625f : 1.0f; const f32x2 sc2 = (f32x2){sc, sc};
        f32x2 xr[11][4];
#pragma unroll
        for (int j = 0; j < 11; ++j) { xr[j][0] = (f32x2){bflo(rw[j].x), bfhi(rw[j].x)}; xr[j][1] = (f32x2){bflo(rw[j].y), bfhi(rw[j].y)}; xr[j][2] = (f32x2){bflo(rw[j].z), bfhi(rw[j].z)}; xr[j][3] = (f32x2){bflo(rw[j].w), bfhi(rw[j].w)}; }
#pragma unroll
        for (int k = 0; k < 8; ++k) {
            u32x4 o;
#pragma unroll
            for (int i = 0; i < 4; ++i) {
                f32x2 acc = (f32x2){0.f, 0.f};
#pragma unroll
                for (int j = 0; j < 4; ++j) acc = __builtin_elementwise_fma(cw[j][i], xr[k + j][i], acc);
                const f32x2 e = acc * (f32x2){-1.4426950408889634f, -1.4426950408889634f};
                const f32x2 d = (f32x2){__builtin_amdgcn_exp2f(e.x), __builtin_amdgcn_exp2f(e.y)} + (f32x2){1.0f, 1.0f};
                const f32x2 y = (acc * sc2) * (f32x2){__builtin_amdgcn_rcpf(d.x), __builtin_amdgcn_rcpf(d.y)};
                o[i] = pk2(y.x, y.y);
            }
            if (isk) *(u32x4*)(KT + (t0 + k) * 1024 + cc) = o; else *(u32x4*)(Y + (t0 + k) * 2048 + 1024 + cc) = o;
        }
    }
}

typedef float f32x16 __attribute__((ext_vector_type(16)));
constexpr int ML_RS = 528, ML_WS = 144;
__device__ __forceinline__ bf16x8 ml_tr8(const LAS unsigned char* a, int second_off) {
    const v4i16_t t0 = __builtin_amdgcn_ds_read_tr16_b64_v4i16((LAS v4i16_t*)a);
    const v4i16_t t1 = __builtin_amdgcn_ds_read_tr16_b64_v4i16((LAS v4i16_t*)(a + second_off));
    bf16x8 r; r[0] = t0[0]; r[1] = t0[1]; r[2] = t0[2]; r[3] = t0[3]; r[4] = t1[0]; r[5] = t1[1]; r[6] = t1[2]; r[7] = t1[3]; return r;
}
struct ChunkScan { f32x4 B, mp, mn; };
__device__ __forceinline__ ChunkScan chunk_scan_wave(const float* CH, int bh, int lane) {
    ChunkScan r; r.B = *(const f32x4*)(CH + 4096 + bh * 256 + 4 * lane); const f32x4 G = *(const f32x4*)(CH + bh * 256 + 4 * lane);
    float a = r.B[0], b = G[0];
#pragma unroll
    for (int j = 1; j < 4; ++j) { b = fmaxf(r.B[j] + b, G[j]); a += r.B[j]; }
#pragma unroll
    for (int o = 1; o < 64; o <<= 1) { const float a1 = __shfl_up(a, o), b1 = __shfl_up(b, o); if (lane >= o) { b = fmaxf(a + b1, b); a += a1; } }
    const float ap = __shfl_up(a, 1), bp = __shfl_up(b, 1);
    float m = lane ? fmaxf(ap, bp) : 0.f;
#pragma unroll
    for (int j = 0; j < 4; ++j) { r.mp[j] = m; m = fmaxf(r.B[j] + m, G[j]); r.mn[j] = m; }
    return r;
}
__device__ __forceinline__ void mlstm_chunk_scan(const float* CH, int bh, LAS float* sB, LAS float* sMp, LAS float* sMn) {
    int tid = threadIdx.x; asm volatile("" : "+v"(tid));
    if (tid < 64) { const ChunkScan r = chunk_scan_wave(CH, bh, tid); *(LAS f32x4*)(sB + 4 * tid) = r.B; *(LAS f32x4*)(sMp + 4 * tid) = r.mp; *(LAS f32x4*)(sMn + 4 * tid) = r.mn; }
    __syncthreads();
}
template <bool FULL>
__device__ __forceinline__ void mlstm_units(const P& p, unsigned char* lds_) {
    unsigned char* ws = p.ws; const int tid0 = threadIdx.x;
    const int w = __builtin_amdgcn_readfirstlane(tid0 >> 6);
    const bf16_t* Yq = (const bf16_t*)(ws + OFF_Y); bf16_t* Yo = (bf16_t*)(ws + OFF_Y);
    const bf16_t* KT = (const bf16_t*)(ws + OFF_TMP); const bf16_t* VB = (const bf16_t*)(ws + OFF_VB);
    float* ST = (float*)(ws + OFF_QB); float* NS = (float*)(ws + OFF_NS);
    const float *BQ = (const float*)(ws + OFF_BQ), *IQ = (const float*)(ws + OFF_IQ), *MT = (const float*)(ws + OFF_MT), *CH = (const float*)(ws + OFF_CH);
    LAS unsigned char* Qs = (LAS unsigned char*)lds_;
    LAS unsigned char* Ks = Qs + 64 * ML_RS;
    LAS unsigned char* Vs = Ks + 64 * ML_RS;
    LAS unsigned char* Wl = Vs + 64 * ML_RS;
    LAS float* sa = (LAS float*)(Wl + 64 * ML_WS);
    LAS float* sden = sa + 64; LAS float* ssw = sden + 64; LAS float* sf = ssw + 64; LAS float* sg = sf + 64; LAS float* nd = sg + 64; LAS float* rden = nd + 64; LAS float* ns = rden + 64;
    LAS float* cB = ns + 256; LAS float* cMp = cB + 256; LAS float* cMn = cMp + 256; LAS float* gB = cMn + 256; LAS float* gI = gB + 512; LAS float* gM = gI + 512;
    for (int unit = blockIdx.x; unit < 256; unit += gridDim.x) {
        const int bh = unit >> 5, S = unit & 31, batch = bh >> 2, head = bh & 3;
        const int tid = tid0, lane = tid0 & 63, hh = lane >> 5;
        __syncthreads();
        mlstm_chunk_scan(CH, bh, cB, cMp, cMn);
        f32x16 st[8]; float nreg = 0.f;
        if (FULL) {
#pragma unroll
            for (int kt = 0; kt < 8; ++kt) {
                int lz = lane; asm volatile("" : "+v"(lz));
                const f32x4* sp = (const f32x4*)(ST + (size_t)unit * 65536 + (size_t)(kt * 8 + w) * 1024) + lz;
#pragma unroll
                for (int j = 0; j < 4; ++j) { const f32x4 v4 = sp[j * 64]; st[kt][4 * j + 0] = v4[0]; st[kt][4 * j + 1] = v4[1]; st[kt][4 * j + 2] = v4[2]; st[kt][4 * j + 3] = v4[3]; }
            }
            if (tid < 256) nreg = NS[unit * 256 + tid];
        } else {
#pragma unroll
            for (int kt = 0; kt < 8; ++kt)
#pragma unroll
                for (int r = 0; r < 16; ++r) st[kt][r] = 0.f;
        }
        { const size_t tS = ((size_t)batch * SEQ + (size_t)S * 512 + tid0) * 4 + head; gB[tid0] = BQ[tS]; gI[tid0] = IQ[tS]; gM[tid0] = MT[tS]; }
        u32x4 pk[4], pv[4], pq[4];
        auto prefetch = [&](int cn) {
            int tz = tid0; asm volatile("" : "+v"(tz));
            const size_t tn = (size_t)batch * SEQ + (size_t)(S * 8 + cn) * 64;
#pragma unroll
            for (int j = 0; j < 4; ++j) { const int e = tz + 512 * j, r = e >> 5, cg = e & 31;
                pk[j] = *(const u32x4*)(KT + (tn + r) * 1024 + head * 256 + cg * 8);
                if (!FULL) pv[j] = *(const u32x4*)(VB + (tn + r) * 1024 + head * 256 + cg * 8);
                if (FULL) pq[j] = *(const u32x4*)(Yq + (tn + r) * 2048 + 1024 + head * 256 + cg * 8); }
            asm volatile("" ::: "memory");
        };
        prefetch(0);
#pragma unroll 1
        for (int cc = 0; cc < 8; ++cc) {
            int tid = tid0; asm volatile("" : "+v"(tid));
            const int lane = tid & 63, l31 = lane & 31, hh = lane >> 5, fr = lane & 15, fq = lane >> 4;
            const int trow = 8 * hh + (fr >> 2), tcol = (16 * (fq & 1) + 4 * (fr & 3)) * 2;
            const int ch = S * 8 + cc; const size_t t0 = (size_t)batch * SEQ + ch * 64;
            const float mprev = cMp[ch], mnew = cMn[ch], blast = cB[ch];
            const float decay = __expf(blast + mprev - mnew);
            __syncthreads();
#pragma unroll
            for (int j = 0; j < 4; ++j) { const int e = tid + 512 * j, r = e >> 5, cg = e & 31;
                if (FULL) pv[j] = *(const u32x4*)(VB + (t0 + r) * 1024 + head * 256 + cg * 8); }
#pragma unroll
            for (int j = 0; j < 4; ++j) { const int e = tid + 512 * j, r = e >> 5, cg = e & 31;
                *(LAS u32x4*)(Ks + r * ML_RS + cg * 16) = pk[j];
                if (!FULL) *(LAS u32x4*)(Vs + r * ML_RS + cg * 16) = pv[j];
                if (FULL) *(LAS u32x4*)(Qs + r * ML_RS + cg * 16) = pq[j]; }
            if (w == cc) { const float bq = gB[tid], iq = gI[tid], mt = bq + fmaxf(mprev, gM[tid]);
                sa[lane] = __expf(bq + mprev - mt); sden[lane] = __expf(-mt); ssw[lane] = __expf(blast - bq + iq - mnew); sf[lane] = bq - mt; sg[lane] = iq - bq; }
            if (FULL && tid < 256) ns[tid] = nreg;
            __syncthreads();
            if (!FULL && cc < 7) prefetch(cc + 1);
            bf16x8 bv[4];
            if (!FULL) {
#pragma unroll
                for (int ks = 0; ks < 4; ++ks) bv[ks] = ml_tr8(Vs + (16 * ks + trow) * ML_RS + 64 * w + tcol, 4 * ML_RS);
            }
            if (FULL) {
                { const int tt = w >> 1;
#pragma unroll
                  for (int si = 0; si < 2; ++si) { const int ss = 2 * (w & 1) + si;
                    f32x4 acc = (f32x4){0.f, 0.f, 0.f, 0.f};
                    if (ss <= tt) {
#pragma unroll
                        for (int ks = 0; ks < 8; ++ks) { const bf16x8 a = *(const LAS bf16x8*)(Qs + (16 * tt + fr) * ML_RS + (32 * ks + 8 * fq) * 2), b = *(const LAS bf16x8*)(Ks + (16 * ss + fr) * ML_RS + (32 * ks + 8 * fq) * 2);
                            acc = __builtin_amdgcn_mfma_f32_16x16x32_bf16(a, b, acc, 0, 0, 0); } }
                    const int sidx = 16 * ss + fr; const float gs = sg[sidx];
#pragma unroll
                    for (int j = 0; j < 4; ++j) { const int tix = 16 * tt + 4 * fq + j; const float wv = (sidx <= tix) ? __expf(sf[tix] + gs) * acc[j] : 0.f;
                        *(LAS bf16_t*)(Wl + tix * ML_WS + sidx * 2) = f2bf(wv); } } }
#pragma unroll
                for (int i = 0; i < 8; ++i) { const int tix = 8 * w + i; const u32x2 qv = *(const LAS u32x2*)(Qs + tix * ML_RS + lane * 8); const f32x4 nv = *(const LAS f32x4*)(ns + lane * 4);
                    float part = bflo(qv.x) * nv[0] + bfhi(qv.x) * nv[1] + bflo(qv.y) * nv[2] + bfhi(qv.y) * nv[3]; part = wave_sum(part); if (lane == 0) nd[tix] = part; }
#pragma unroll
                for (int j = 0; j < 4; ++j) { const int e = tid + 512 * j, r = e >> 5, cg = e & 31; *(LAS u32x4*)(Vs + r * ML_RS + cg * 16) = pv[j]; }
                __syncthreads();
                f32x16 acc[2];
#pragma unroll
                for (int t2 = 0; t2 < 2; ++t2) {
#pragma unroll
                    for (int r = 0; r < 16; ++r) acc[t2][r] = 0.f;
                }
#pragma unroll
                for (int kt = 0; kt < 8; ++kt) {
                    asm volatile("" ::: "memory");
#pragma unroll
                    for (int s2 = 0; s2 < 2; ++s2) {
                        u32x4 bw; bw.x = pg8::cvt_pk_bf16(st[kt][8 * s2 + 0], st[kt][8 * s2 + 1]); bw.y = pg8::cvt_pk_bf16(st[kt][8 * s2 + 2], st[kt][8 * s2 + 3]);
                        bw.z = pg8::cvt_pk_bf16(st[kt][8 * s2 + 4], st[kt][8 * s2 + 5]); bw.w = pg8::cvt_pk_bf16(st[kt][8 * s2 + 6], st[kt][8 * s2 + 7]);
                        const bf16x8 bfrag = __builtin_bit_cast(bf16x8, bw);
#pragma unroll
                        for (int t2 = 0; t2 < 2; ++t2) { const LAS unsigned char* qa = Qs + (32 * t2 + l31) * ML_RS + (32 * kt + 16 * s2 + 4 * hh) * 2;
                            const u32x2 lo = *(const LAS u32x2*)qa, hi = *(const LAS u32x2*)(qa + 16); u32x4 aw; aw.x = lo.x; aw.y = lo.y; aw.z = hi.x; aw.w = hi.y;
                            acc[t2] = __builtin_amdgcn_mfma_f32_32x32x16_bf16(__builtin_bit_cast(bf16x8, aw), bfrag, acc[t2], 0, 0, 0); }
                    }
                }
                asm volatile("" ::: "memory");
#pragma unroll
                for (int t2 = 0; t2 < 2; ++t2)
#pragma unroll
                    for (int r = 0; r < 16; ++r) acc[t2][r] *= sa[32 * t2 + (r & 3) + 8 * (r >> 2) + 4 * hh];
#pragma unroll
                for (int ks = 0; ks < 4; ++ks) bv[ks] = ml_tr8(Vs + (16 * ks + trow) * ML_RS + 64 * w + tcol, 4 * ML_RS);
#pragma unroll
                for (int ks = 0; ks < 4; ++ks)
#pragma unroll
                    for (int t2 = 0; t2 < 2; ++t2) { const bf16x8 a = *(const LAS bf16x8*)(Wl + (32 * t2 + l31) * ML_WS + (16 * ks + 8 * hh) * 2);
                        acc[t2] = __builtin_amdgcn_mfma_f32_32x32x16_bf16(a, bv[ks], acc[t2], 0, 0, 0); }
#pragma unroll
                for (int i = 0; i < 8; ++i) { const int tix = 8 * w + i; float rs = bf2f(*(const LAS bf16_t*)(Wl + tix * ML_WS + lane * 2)); rs = wave_sum(rs);
                    if (lane == 0) { const float nq = sa[tix] * nd[tix] + rs; rden[tix] = __builtin_amdgcn_rcpf(fmaxf(fabsf(nq), sden[tix])); } }
                __syncthreads();
                bf16_t* yo = Yo + t0 * 2048 + head * 256 + 32 * w + l31;
#pragma unroll
                for (int t2 = 0; t2 < 2; ++t2)
#pragma unroll
                    for (int r = 0; r < 16; ++r) { const int tix = 32 * t2 + (r & 3) + 8 * (r >> 2) + 4 * hh; yo[(size_t)tix * 2048] = f2bf(acc[t2][r] * rden[tix]); }
                asm volatile("" ::: "memory");
                if (cc < 7) prefetch(cc + 1);
            }
#pragma unroll
            for (int kt = 0; kt < 8; ++kt) st[kt] *= decay;
#pragma unroll
            for (int ks = 0; ks < 4; ++ks) {
                const u32x4 raw = __builtin_bit_cast(u32x4, bv[ks]); const LAS float* sw8 = ssw + 16 * ks + 8 * hh;
                u32x4 sc; sc.x = pg8::cvt_pk_bf16(bflo(raw.x) * sw8[0], bfhi(raw.x) * sw8[1]); sc.y = pg8::cvt_pk_bf16(bflo(raw.y) * sw8[2], bfhi(raw.y) * sw8[3]);
                sc.z = pg8::cvt_pk_bf16(bflo(raw.z) * sw8[4], bfhi(raw.z) * sw8[5]); sc.w = pg8::cvt_pk_bf16(bflo(raw.w) * sw8[6], bfhi(raw.w) * sw8[7]);
                const bf16x8 bs = __builtin_bit_cast(bf16x8, sc);
#pragma unroll
                for (int kt = 0; kt < 8; ++kt) { if ((kt & 3) == 0) asm volatile("" ::: "memory");
                    const bf16x8 a = ml_tr8(Ks + (16 * ks + trow) * ML_RS + 64 * kt + tcol, 4 * ML_RS);
                    st[kt] = __builtin_amdgcn_mfma_f32_32x32x16_bf16(a, bs, st[kt], 0, 0, 0); }
            }
            if (tid < 256) { float nacc = 0.f;
#pragma unroll 8
                for (int s2 = 0; s2 < 64; ++s2) nacc += ssw[s2] * bf2f(*(const LAS bf16_t*)(Ks + s2 * ML_RS + tid * 2));
                nreg = decay * nreg + nacc; }
        }
        if (!FULL) {
#pragma unroll
            for (int kt = 0; kt < 8; ++kt) {
                int lz = lane; asm volatile("" : "+v"(lz));
                f32x4* sp = (f32x4*)(ST + (size_t)unit * 65536 + (size_t)(kt * 8 + w) * 1024) + lz;
#pragma unroll
                for (int j = 0; j < 4; ++j) sp[j * 64] = (f32x4){st[kt][4 * j + 0], st[kt][4 * j + 1], st[kt][4 * j + 2], st[kt][4 * j + 3]};
            }
            if (tid < 256) NS[unit * 256 + tid] = nreg;
        }
    }
}
__device__ __forceinline__ void phase_mlstm_scan(const P& p, unsigned char* lds_) {
    unsigned char* ws = p.ws; const int tid = threadIdx.x, lane = tid & 63, wave = tid >> 6;
    float* ST = (float*)(ws + OFF_QB); float* NS = (float*)(ws + OFF_NS); const float* CH = (const float*)(ws + OFF_CH);
    LAS float* DS = (LAS float*)lds_;
    __syncthreads();
    {
        const ChunkScan r = chunk_scan_wave(CH, wave, lane);
        float d = 1.f;
#pragma unroll
        for (int j = 0; j < 4; ++j) d *= __expf(r.B[j] + r.mp[j] - r.mn[j]);
        const float dn = __shfl_down(d, 1);
        if (!(lane & 1)) DS[wave * 32 + (lane >> 1)] = d * dn;
    }
    __syncthreads();
    {
        const int it0 = blockIdx.x * 512 + tid;
        for (int it = it0; it < 8 * 16384; it += gridDim.x * 512) {
            const int bh = it >> 14; float* base = ST + (size_t)bh * 32 * 65536 + (size_t)(it & 16383) * 4;
            f32x4 carry = (f32x4){0.f, 0.f, 0.f, 0.f};
#pragma unroll
            for (int h = 0; h < 2; ++h) {
                f32x4 tmp[16];
#pragma unroll
                for (int S = 0; S < 16; ++S) tmp[S] = *(const f32x4*)(base + (size_t)(16 * h + S) * 65536);
#pragma unroll
                for (int S = 0; S < 16; ++S) { *(f32x4*)(base + (size_t)(16 * h + S) * 65536) = carry; carry = DS[bh * 32 + 16 * h + S] * carry + tmp[S]; }
            }
        }
        if (it0 < 8 * 256) {
            const int it = it0, bh = it >> 8; float* base = NS + (size_t)bh * 32 * 256 + (it & 255);
            float carry = 0.f;
#pragma unroll 8
            for (int S = 0; S < 32; ++S) { const float tmp = base[S * 256]; base[S * 256] = carry; carry = DS[bh * 32 + S] * carry + tmp; }
        }
    }
}

__device__ __forceinline__ void unpack8(const u32x4 w, float (&f)[8]) {
    f[0] = bflo(w.x); f[1] = bfhi(w.x); f[2] = bflo(w.y); f[3] = bfhi(w.y); f[4] = bflo(w.z); f[5] = bfhi(w.z); f[6] = bflo(w.w); f[7] = bfhi(w.w); }
__device__ __forceinline__ void unpack8p(const u32x4 w, f32x2 (&f)[4]) {
    f[0] = (f32x2){bflo(w.x), bfhi(w.x)}; f[1] = (f32x2){bflo(w.y), bfhi(w.y)}; f[2] = (f32x2){bflo(w.z), bfhi(w.z)}; f[3] = (f32x2){bflo(w.w), bfhi(w.w)}; }
template <int WIN>
__device__ __forceinline__ void pool_item(const bf16_t* __restrict__ U, bf16_t* __restrict__ Y, const float* __restrict__ s_pool, size_t t0, int s0, int c0) {
    constexpr int NR = WIN + 7;
    u32x4 rw[NR], z[8];
#pragma unroll
    for (int j = 0; j < NR; ++j) rw[j] = (s0 - (WIN - 1) + j >= 0) ? *(const u32x4*)(U + ((long)t0 + j - (WIN - 1)) * 1024 + c0) : (u32x4){0u, 0u, 0u, 0u};
#pragma unroll
    for (int k = 0; k < 8; ++k) z[k] = *(const u32x4*)(Y + (t0 + k) * 2048 + 1024 + c0);
    const f32x4 s0v = *(const f32x4*)(s_pool + c0), s1v = *(const f32x4*)(s_pool + c0 + 4);
    const f32x2 sp[4] = {(f32x2){s0v[0], s0v[1]}, (f32x2){s0v[2], s0v[3]}, (f32x2){s1v[0], s1v[1]}, (f32x2){s1v[2], s1v[3]}};
    f32x2 S[4];
#pragma unroll
    for (int i = 0; i < 4; ++i) S[i] = (f32x2){0.f, 0.f};
#pragma unroll
    for (int j = 0; j < WIN - 1; ++j) { f32x2 f[4]; unpack8p(rw[j], f);
#pragma unroll
        for (int i = 0; i < 4; ++i) S[i] += f[i]; }
#pragma unroll
    for (int k = 0; k < 8; ++k) {
        f32x2 self[4], zf[4]; unpack8p(rw[k + WIN - 1], self); unpack8p(z[k], zf);
#pragma unroll
        for (int i = 0; i < 4; ++i) S[i] += self[i];
        const int cnt = (s0 + k + 1 < WIN) ? s0 + k + 1 : WIN;
        const float inv = __builtin_amdgcn_rcpf((float)cnt);
        const f32x2 inv2 = (f32x2){inv, inv};
        f32x2 o[4];
#pragma unroll
        for (int i = 0; i < 4; ++i) o[i] = ((__builtin_elementwise_fma(S[i], inv2, -self[i])) * sp[i]) * zf[i];
        u32x4 ow; ow.x = pk2(o[0].x, o[0].y); ow.y = pk2(o[1].x, o[1].y); ow.z = pk2(o[2].x, o[2].y); ow.w = pk2(o[3].x, o[3].y);
        *(u32x4*)(Y + (t0 + k) * 2048 + 1024 + c0) = ow;
        f32x2 old[4]; unpack8p(rw[k], old);
#pragma unroll
        for (int i = 0; i < 4; ++i) S[i] -= old[i];
    }
}
__device__ __forceinline__ void phase_ya_pool(const P& p) {
    unsigned char* ws = p.ws; const int tid = threadIdx.x, lane = tid & 63, wave = tid >> 6;
    bf16_t* Y = (bf16_t*)(ws + OFF_Y); const bf16_t* O = (const bf16_t*)(ws + OFF_QB); const bf16_t* ZA = (const bf16_t*)(ws + OFF_KB);
    f32x4 gh[4];
#pragma unroll
    for (int head = 0; head < 4; ++head) gh[head] = *(const f32x4*)(p.e_g_head + head * 256 + lane * 4);
    for (int tt = blockIdx.x * 8 + wave; tt < T; tt += gridDim.x * 8) {
        const size_t t = (size_t)tt; u32x2 hw[4], ow[4], zw[4];
#pragma unroll
        for (int head = 0; head < 4; ++head) { const int c = head * 256 + lane * 4;
            hw[head] = *(const u32x2*)(Y + t * 2048 + c); ow[head] = *(const u32x2*)(O + t * 1024 + c); zw[head] = *(const u32x2*)(ZA + t * 1024 + c); }
#pragma unroll
        for (int head = 0; head < 4; ++head) { const int c = head * 256 + lane * 4;
            const f32x2 va = (f32x2){bflo(hw[head].x), bfhi(hw[head].x)} * (f32x2){bflo(ow[head].x), bfhi(ow[head].x)}, vb = (f32x2){bflo(hw[head].y), bfhi(hw[head].y)} * (f32x2){bflo(ow[head].y), bfhi(ow[head].y)};
            const f32x2 sq = __builtin_elementwise_fma(vb, vb, va * va);
            const float ss = wave_sum(sq.x + sq.y);
            const float rstd = __builtin_amdgcn_rsqf(ss * (1.0f / 256.0f) + EPS);
            const f32x4 g = gh[head]; const f32x2 r2 = (f32x2){rstd, rstd};
            const f32x2 oa = ((va * r2) * (f32x2){g[0], g[1]}) * (f32x2){bflo(zw[head].x), bfhi(zw[head].x)}, ob = ((vb * r2) * (f32x2){g[2], g[3]}) * (f32x2){bflo(zw[head].y), bfhi(zw[head].y)};
            u32x2 o; o.x = pk2(oa.x, oa.y); o.y = pk2(ob.x, ob.y);
            *(u32x2*)(Y + t * 2048 + c) = o; }
    }
    const bf16_t* U = (const bf16_t*)(ws + OFF_VB);
    for (int it = blockIdx.x * 512 + tid; it < (T / 8) * 128; it += gridDim.x * 512) {
        const int cgl = it & 31, tbl = (it >> 5) & 1, g = __builtin_amdgcn_readfirstlane((it >> 6) & 3), tb = 2 * (it >> 8) + tbl;
        const size_t t0 = (size_t)tb * 8; const int s0 = (int)(t0 & (SEQ - 1)), c0 = g * 256 + cgl * 8;
        if (g == 0) pool_item<2>(U, Y, p.e_s_pool, t0, s0, c0);
        else if (g == 1) pool_item<4>(U, Y, p.e_s_pool, t0, s0, c0);
        else if (g == 2) pool_item<8>(U, Y, p.e_s_pool, t0, s0, c0);
        else pool_item<16>(U, Y, p.e_s_pool, t0, s0, c0);
    }
}

__device__ __forceinline__ void headnorm64(bf16_t* X, const float* g) {
    const int lane = threadIdx.x & 63, wave = threadIdx.x >> 6;
    const float* gg = g + (lane & 3) * 16;
    for (int t0 = (blockIdx.x * 8 + wave) * 4; t0 < T; t0 += gridDim.x * 32) {
        u32x4 a[4], b[4];
#pragma unroll
        for (int k = 0; k < 4; ++k) { const bf16_t* r = X + (size_t)(t0 + k) * 1024 + lane * 16; a[k] = *(const u32x4*)r; b[k] = *(const u32x4*)(r + 8); }
#pragma unroll
        for (int k = 0; k < 4; ++k) {
            float f[16] = {bflo(a[k].x), bfhi(a[k].x), bflo(a[k].y), bfhi(a[k].y), bflo(a[k].z), bfhi(a[k].z), bflo(a[k].w), bfhi(a[k].w), bflo(b[k].x), bfhi(b[k].x), bflo(b[k].y), bfhi(b[k].y), bflo(b[k].z), bfhi(b[k].z), bflo(b[k].w), bfhi(b[k].w)};
            float ss = 0.f;
#pragma unroll
            for (int i = 0; i < 16; ++i) ss += f[i] * f[i];
            ss += dppf<0xB1>(ss); ss += dppf<0x4E>(ss);
            const float rstd = __builtin_amdgcn_rsqf(ss * (1.0f / 64.0f) + EPS);
#pragma unroll
            for (int i = 0; i < 16; ++i) f[i] = f[i] * rstd * gg[i];
            u32x4 oa, ob; oa.x = pk2(f[0], f[1]); oa.y = pk2(f[2], f[3]); oa.z = pk2(f[4], f[5]); oa.w = pk2(f[6], f[7]);
            ob.x = pk2(f[8], f[9]); ob.y = pk2(f[10], f[11]); ob.z = pk2(f[12], f[13]); ob.w = pk2(f[14], f[15]);
            bf16_t* r = X + (size_t)(t0 + k) * 1024 + lane * 16; *(u32x4*)r = oa; *(u32x4*)(r + 8) = ob;
        }
    }
}
__device__ __forceinline__ void phase_qnorm_ckvnorm(const P& p) {
    unsigned char* ws = p.ws; const int lane = threadIdx.x & 63, wave = threadIdx.x >> 6;
    {
        const u32x4* KI4 = (const u32x4*)(ws + OFF_KI); u32x4* KT4 = (u32x4*)(ws + OFF_KIT);
        for (size_t it = (size_t)blockIdx.x * 512 + threadIdx.x; it < (size_t)T * 8; it += (size_t)gridDim.x * 512) {
            const int l = (int)(it & 63), ks = (int)((it >> 6) & 1); const size_t t16 = it >> 7;
            KT4[it] = KI4[(t16 * 16 + (l & 15)) * 8 + 4 * ks + (l >> 4)]; }
    }
    bf16_t* CKVN = (bf16_t*)(ws + OFF_CKVN);
    const f32x4 g = *(const f32x4*)(p.o_g_kv + lane * 4);
    for (int t0 = (blockIdx.x * 8 + wave) * 8; t0 < T; t0 += gridDim.x * 64) {
        u32x2 w[8];
#pragma unroll
        for (int k = 0; k < 8; ++k) w[k] = *(const u32x2*)(CKVN + (size_t)(t0 + k) * 256 + lane * 4);
#pragma unroll
        for (int k = 0; k < 8; ++k) {
            const float v[4] = {bflo(w[k].x), bfhi(w[k].x), bflo(w[k].y), bfhi(w[k].y)};
            const float ss = wave_sum(v[0] * v[0] + v[1] * v[1] + v[2] * v[2] + v[3] * v[3]);
            const float rstd = __builtin_amdgcn_rsqf(ss * (1.0f / 256.0f) + EPS);
            u32x2 o; o.x = pk2(v[0] * rstd * g[0], v[1] * rstd * g[1]); o.y = pk2(v[2] * rstd * g[2], v[3] * rstd * g[3]);
            *(u32x2*)(CKVN + (size_t)(t0 + k) * 256 + lane * 4) = o;
        }
    }
}

__device__ __forceinline__ unsigned okey(float s) { if (s == 0.f) s = 0.f; const unsigned u = __float_as_uint(s); return (u & 0x80000000u) ? ~u : (u | 0x80000000u); }

__device__ __forceinline__ void indexer_slow_query(const P& p, unsigned char* lds, size_t t) {
    unsigned char* ws = p.ws; const int tid = threadIdx.x, lane = tid & 63, wave = tid >> 6;
    const _Float16* QI = (const _Float16*)(ws + OFF_QI); const _Float16* KI = (const _Float16*)(ws + OFF_KI); const float* WI = (const float*)(ws + OFF_WI);
    unsigned short* IDX = (unsigned short*)(ws + OFF_IDX);
    unsigned* sc = (unsigned*)lds; unsigned* hist = sc + 16384; float* qs = (float*)(hist + 256); unsigned* misc = (unsigned*)(qs + 256); unsigned* wsum = misc + 16;
    const int batch = (int)(t >> 14), pos = (int)(t & (SEQ - 1)), n = pos + 1;
    __syncthreads();
    if (tid < 256) qs[tid] = (float)QI[t * 256 + tid];
    const float w0 = WI[t * 4 + 0], w1 = WI[t * 4 + 1], w2 = WI[t * 4 + 2], w3 = WI[t * 4 + 3];
    __syncthreads();
    const _Float16* kbase = KI + (size_t)batch * SEQ * 64;
    for (int s = tid; s < n; s += 512) {
        asm volatile("" ::: "memory");
        typedef _Float16 h8 __attribute__((ext_vector_type(8)));
        const h8* kr = (const h8*)(kbase + (size_t)s * 64);
        float d0 = 0.f, d1 = 0.f, d2 = 0.f, d3 = 0.f;
#pragma unroll
        for (int j = 0; j < 8; ++j) { const h8 kv = kr[j];
#pragma unroll
            for (int e = 0; e < 8; ++e) { const int d = j * 8 + e; const float kf = (float)kv[e]; d0 += qs[d] * kf; d1 += qs[64 + d] * kf; d2 += qs[128 + d] * kf; d3 += qs[192 + d] * kf; } }
        float score = w0 * fmaxf(d0, 0.f); score = fmaf(w1, fmaxf(d1, 0.f), score); score = fmaf(w2, fmaxf(d2, 0.f), score); score = fmaf(w3, fmaxf(d3, 0.f), score);
        sc[s] = okey(score);
    }
    unsigned prefix = 0, krem = 256;
    for (int pass = 0; pass < 4; ++pass) {
        const int shift = 24 - 8 * pass;
        __syncthreads();
        if (tid < 256) hist[tid] = 0;
        __syncthreads();
        for (int s = tid; s < n; s += 512) { const unsigned k = sc[s]; if (pass == 0 || (k >> (shift + 8)) == prefix) atomicAdd(&hist[(k >> shift) & 255u], 1u); }
        __syncthreads();
        if (tid == 0) { unsigned cum = 0; int bin = 255; for (; bin > 0; --bin) { const unsigned c = hist[bin]; if (cum + c >= krem) break; cum += c; } misc[0] = (unsigned)bin; misc[1] = krem - cum; }
        __syncthreads();
        prefix = (prefix << 8) | misc[0]; krem = misc[1];
    }
    const unsigned ngt_total = 256u - krem;
    unsigned lg = 0, le = 0; const int s0 = tid * 32;
    for (int s = s0; s < s0 + 32 && s < n; ++s) { const unsigned k = sc[s]; lg += (k > prefix); le += (k == prefix); }
    unsigned pk = lg | (le << 16), incl = pk;
#pragma unroll
    for (int o = 1; o < 64; o <<= 1) { const unsigned y = __shfl_up(incl, o); if (lane >= o) incl += y; }
    if (lane == 63) wsum[wave] = incl;
    __syncthreads();
    unsigned base = 0;
    for (int w = 0; w < wave; ++w) base += wsum[w];
    const unsigned excl = base + incl - pk; unsigned bg = excl & 0xffffu, be = excl >> 16;
    for (int s = s0; s < s0 + 32 && s < n; ++s) { const unsigned k = sc[s];
        if (k > prefix) { IDX[t * 256 + bg] = (unsigned short)s; ++bg; }
        else if (k == prefix) { if (be < krem) IDX[t * 256 + ngt_total + be] = (unsigned short)s; ++be; } }
    __syncthreads();
}

typedef _Float16 half8 __attribute__((ext_vector_type(8)));
constexpr int IX_CAP = 1023, IX_ZBIN = 2048;
__device__ __forceinline__ unsigned ix_key(const f32x4 a, const f32x4 w) {
    const float r0 = __int_as_float(max(__float_as_int(a[0]), 0)), r1 = __int_as_float(max(__float_as_int(a[1]), 0));
    const float r2 = __int_as_float(max(__float_as_int(a[2]), 0)), r3 = __int_as_float(max(__float_as_int(a[3]), 0));
    float s = fmaf(w[0], r0, 0.0f); s = fmaf(w[1], r1, s); s = fmaf(w[2], r2, s); s = fmaf(w[3], r3, s);
    const unsigned u = __float_as_uint(s);
    return u ^ ((unsigned)((int)u >> 31) | 0x80000000u);
}
__device__ __forceinline__ void ix_key2(const f32x4 a, const f32x4 b, const f32x2 (&w)[4], unsigned& ka, unsigned& kb) {
    f32x2 s = (f32x2){0.0f, 0.0f};
#pragma unroll
    for (int h = 0; h < 4; ++h) { const f32x2 r = (f32x2){__int_as_float(max(__float_as_int(a[h]), 0)), __int_as_float(max(__float_as_int(b[h]), 0))}; s = __builtin_elementwise_fma(w[h], r, s); }
    const unsigned u0 = __float_as_uint(s.x), u1 = __float_as_uint(s.y);
    ka = u0 ^ ((unsigned)((int)u0 >> 31) | 0x80000000u); kb = u1 ^ ((unsigned)((int)u1 >> 31) | 0x80000000u);
}
#define LDS_ADD(ptr, v) __hip_atomic_fetch_add((ptr), (v), __ATOMIC_RELAXED, __HIP_MEMORY_SCOPE_WORKGROUP)
#define IX_BAR asm volatile("s_waitcnt lgkmcnt(0)\n\ts_barrier" ::: "memory")
struct IxTagF { static constexpr bool value = false; }; struct IxTagT { static constexpr bool value = true; };
template <int N> struct IxN { static constexpr int value = N; };
__device__ __forceinline__ void phase_indexer(const P& p, unsigned char* lds) {
    unsigned char* ws = p.ws; const int tid = tid_opaque(), lane = tid & 63, kl = lane & 15, g = lane >> 4;
    const int wave = __builtin_amdgcn_readfirstlane(tid >> 6);
    const _Float16* QI = (const _Float16*)(ws + OFF_QI); const _Float16* KIT = (const _Float16*)(ws + OFF_KIT); const float* WI = (const float*)(ws + OFF_WI);
    unsigned short* IDX = (unsigned short*)(ws + OFF_IDX); int* CNT = (int*)(ws + OFF_CNT);
    LAS unsigned* hist = (LAS unsigned*)lds;
    LAS int* qTbin = (LAS int*)(hist + 16 * 2048);
    LAS int* qCab = qTbin + 16; LAS unsigned* qN = (LAS unsigned*)(qCab + 16); LAS int* qOvf = (LAS int*)(qN + 16); LAS int* qZl = qOvf + 16;
    LAS unsigned* ovl = (LAS unsigned*)(lds + 132 * 1024);
    LAS unsigned* h2 = (LAS unsigned*)(lds + 133 * 1024 + wave * 1536);
    LAS unsigned long long* l2 = (LAS unsigned long long*)(h2 + 256);
    if (tid == 0) ovl[0] = 0u;
    const int G = gridDim.x, nround = (T / 16) / G;
    bool zeroed = false;
    auto zslot = [&](int qs) { LAS u32x4* zs = (LAS u32x4*)(lds + qs * 8192) + lane;
#pragma unroll
        for (int j = 0; j < 8; ++j) zs[64 * j] = (u32x4){0u, 0u, 0u, 0u}; };
#pragma unroll 1
    for (int i = 0; i < nround; ++i) {
        const int tix = (i & 1) ? i * G + (G - 1 - (int)blockIdx.x) : i * G + (int)blockIdx.x;
        const int batch = tix & 1, tb = tix >> 1, p0 = tb * 16; const size_t t0 = (size_t)batch * SEQ + p0;
        __syncthreads();
        if (p0 + 16 <= 256) {
#pragma unroll
            for (int j = 0; j < 8; ++j) { const int e = tid + 512 * j, q = e >> 8, jj = e & 255; IDX[(t0 + q) * 256 + jj] = (unsigned short)(jj <= p0 + q ? jj : 0); }
            if (tid < 16) CNT[t0 + tid] = p0 + tid + 1;
            continue;
        }
        if (!zeroed) {
#pragma unroll
            for (int j = 0; j < 16; ++j) ((LAS u32x4*)hist)[tid + 512 * j] = (u32x4){0u, 0u, 0u, 0u};
        }
        if (tid < 16) { qN[tid] = 0u; qOvf[tid] = 0; }
        half8 af[4][2]; f32x4 wv[4];
#pragma unroll
        for (int rt = 0; rt < 4; ++rt) {
#pragma unroll
            for (int ks = 0; ks < 2; ++ks) af[rt][ks] = *(const half8*)(QI + (t0 + 4 * rt + (kl >> 2)) * 256 + (kl & 3) * 64 + 32 * ks + 8 * g);
            wv[rt] = *(const f32x4*)(WI + (t0 + 4 * rt + g) * 4);
        }
        f32x2 w01[4], w23[4];
#pragma unroll
        for (int h = 0; h < 4; ++h) { w01[h] = (f32x2){wv[0][h], wv[1][h]}; w23[h] = (f32x2){wv[2][h], wv[3][h]}; }
        IX_BAR;
        const int nblk = tb + 1, L = (nblk + 7) >> 3, b0 = wave * L, b1 = (b0 + L < nblk) ? b0 + L : nblk;
        const _Float16* kb = KIT + (size_t)batch * SEQ * 64 + lane * 8;
        LAS unsigned* hg = hist + g * 4 * 2048;
#define IX_LOADK(u, bb) do { kq[u][0] = *(const half8*)(kb + (size_t)(bb) * 1024); kq[u][1] = *(const half8*)(kb + (size_t)(bb) * 1024 + 512); } while (0)
#define IX_MFMA(acc, k0, k1) do { _Pragma("unroll") for (int rt = 0; rt < 4; ++rt) { acc[rt] = __builtin_amdgcn_mfma_f32_16x16x32_f16(af[rt][0], k0, (f32x4){0.f, 0.f, 0.f, 0.f}, 0, 0, 0); \
            acc[rt] = __builtin_amdgcn_mfma_f32_16x16x32_f16(af[rt][1], k1, acc[rt], 0, 0, 0); } } while (0)
        const int sst = (nblk <= 64) ? 1 : ((nblk <= 256) ? 2 : 4);
        {
            const int bend = (b1 < nblk - 1) ? b1 : nblk - 1;
            const int ns = (bend > b0) ? ((bend - b0 + sst - 1) / sst) : 0;
            auto post1 = [&](int bcur, const f32x4 (&acc)[4], auto chkTag) {
                constexpr bool CHK = decltype(chkTag)::value;
                unsigned key[4]; ix_key2(acc[0], acc[1], w01, key[0], key[1]); ix_key2(acc[2], acc[3], w23, key[2], key[3]);
#pragma unroll
                for (int rt = 0; rt < 4; ++rt) {
                    if (!CHK || bcur * 16 + kl <= p0 + 4 * rt + g) LDS_ADD(hg + rt * 2048 + (key[rt] >> 21), 1u << ((key[rt] >> 16) & 16u)); }
            };
            if (ns > 0) {
                half8 kq[2][2];
#pragma unroll
                for (int u = 0; u < 2; ++u) { const int kk = (u < ns) ? u : ns - 1; IX_LOADK(u, b0 + sst * kk); }
                int k = 0;
#pragma unroll 1
                for (; k + 2 <= ns; k += 2) {
#pragma unroll
                    for (int u = 0; u < 2; ++u) { f32x4 acc[4]; IX_MFMA(acc, kq[u][0], kq[u][1]); post1(0, acc, IxTagF{}); const int kk = (k + 2 + u < ns) ? k + 2 + u : ns - 1; IX_LOADK(u, b0 + sst * kk); }
                }
                if (k < ns) { f32x4 acc[4]; IX_MFMA(acc, kq[0][0], kq[0][1]); post1(0, acc, IxTagF{}); }
            }
            if (sst == 1 && b1 == nblk && b0 < b1) { half8 kq[1][2]; IX_LOADK(0, nblk - 1); f32x4 acc[4]; IX_MFMA(acc, kq[0][0], kq[0][1]); post1(nblk - 1, acc, IxTagT{}); }
        }
        IX_BAR;
        int nsb = 0;
#pragma unroll
        for (int ww = 0; ww < 8; ++ww) { const int c0 = ww * L, c1 = (c0 + L < nblk) ? c0 + L : nblk, ce = (c1 < nblk - 1) ? c1 : nblk - 1; nsb += (ce > c0) ? ((ce - c0 + sst - 1) / sst) : 0; }
        if (sst == 1) nsb = nblk;
        const float fsm = (sst == 1) ? 1.0f : fminf(1.0f, (float)(nsb * 16) / (float)(p0 + 1));
        int tgt = (int)(256.0f * fsm + 5.5f * sqrtf(256.0f * fsm * (1.0f - fsm))) + 2; tgt = tgt > 256 ? 256 : tgt;
#pragma unroll 1
        for (int qq = 0; qq < 2; ++qq) {
            const int q = 2 * wave + qq; const LAS unsigned* h = hist + q * 2048;
            unsigned S2 = 0;
#pragma unroll
            for (int c8 = 0; c8 < 8; ++c8) { const int cc = (c8 ^ (lane >> 1)) & 7; const u32x4 w4 = *(const LAS u32x4*)(h + 2016 - 32 * lane + 4 * cc); S2 += w4.x + w4.y + w4.z + w4.w; }
            const unsigned cs = (S2 & 0xffffu) + (S2 >> 16);
            const unsigned incl = wave_iscan(cs);
            const unsigned long long m = __ballot(incl >= (unsigned)tgt);
            const int Ls = m ? (__ffsll((long long)m) - 1) : 63;
            const unsigned cab0 = rlu(incl - cs, Ls);
            const int dw = 2047 - 32 * Ls - (lane >> 1); const unsigned w2 = h[dw]; const unsigned cl = (lane & 1) ? (w2 & 0xffffu) : (w2 >> 16);
            const unsigned incl2 = wave_iscan(cl) + cab0;
            const unsigned long long m2 = __ballot(incl2 >= (unsigned)tgt);
            const int L2 = m2 ? (__ffsll((long long)m2) - 1) : 63;
            const int tbin = m2 ? 2 * (2047 - 32 * Ls) + 1 - L2 : 0; const unsigned cbv = rlu(cl, L2), cabv = rlu(incl2 - cl, L2);
            if (lane == 0) { qTbin[q] = tbin; qCab[q] = (int)cabv; int zl = 0x7fffffff;
                if (tbin == IX_ZBIN) {
                    const int nk = p0 + 4 * (q & 3) + (q >> 2) + 1; zl = (int)(((unsigned long long)384 * (unsigned)(nsb * 16)) / (cbv ? cbv : 1u)) + 16; zl = zl < nk ? zl : 0x7fffffff; }
                qZl[q] = zl; }
        }
        IX_BAR;
        if (b0 < b1) {
            unsigned lok[4]; int zl[4];
#pragma unroll
            for (int rt = 0; rt < 4; ++rt) { lok[rt] = (unsigned)qTbin[g * 4 + rt] << 20; zl[rt] = qZl[g * 4 + rt]; }
            const bool zany = __ballot((zl[0] & zl[1] & zl[2] & zl[3]) != 0x7fffffff) != 0ull;
            half8 kq[2][2];
#pragma unroll
            for (int u = 0; u < 2; ++u) { const int bb = (b0 + u < b1) ? b0 + u : b1 - 1; IX_LOADK(u, bb); }
          auto run2 = [&](auto zTag) {
            constexpr bool ZT = decltype(zTag)::value;
            auto post2 = [&](int bcur, const f32x4 (&acc)[4], auto chkTag) {
                constexpr bool CHK = decltype(chkTag)::value;
                const int s = bcur * 16 + kl;
                unsigned key[4], pos[4]; bool cand[4];
                ix_key2(acc[0], acc[1], w01, key[0], key[1]); ix_key2(acc[2], acc[3], w23, key[2], key[3]);
#pragma unroll
                for (int rt = 0; rt < 4; ++rt) { cand[rt] = key[rt] >= lok[rt]; if (CHK) cand[rt] = cand[rt] && s <= p0 + 4 * rt + g; }
                if (ZT) {
#pragma unroll
                    for (int rt = 0; rt < 4; ++rt) cand[rt] = cand[rt] && !(key[rt] == lok[rt] && s >= zl[rt]);
                }
                const unsigned long long many = (__ballot(cand[0]) | __ballot(cand[1])) | (__ballot(cand[2]) | __ballot(cand[3]));
                if (__builtin_amdgcn_inverse_ballot_w64(many)) {
                    const int gz = g;
                    const unsigned sinv = 0xffffu - (unsigned)s;
                    LAS unsigned* qnp = qN + gz * 4; LAS unsigned* dmp = ovl + 160;
                    LAS unsigned char* sl = (LAS unsigned char*)lds + ((unsigned)gz << 15);
#pragma unroll
                    for (int rt = 0; rt < 4; ++rt) { LAS unsigned* ctr = cand[rt] ? qnp : dmp; pos[rt] = LDS_ADD(ctr + rt, 8u); }
#pragma unroll
                    for (int rt = 0; rt < 4; ++rt) {
                        const unsigned off = cand[rt] ? (pos[rt] & 0x1ff8u) : 0x1ff8u;
                        *(LAS u32x2*)(sl + off + rt * 8192) = (u32x2){sinv, key[rt]}; }
                }
            };
            int b = b0; f32x4 accA[4], accB[4];
            IX_MFMA(accA, kq[0][0], kq[0][1]); { const int bb = (b + 2 < b1) ? b + 2 : b1 - 1; IX_LOADK(0, bb); }
#pragma unroll 1
            for (; b + 2 <= b1 && b + 2 <= nblk - 1; b += 2) {
                IX_MFMA(accB, kq[1][0], kq[1][1]); { const int bb = (b + 3 < b1) ? b + 3 : b1 - 1; IX_LOADK(1, bb); }
                post2(b, accA, IxTagF{});
                IX_MFMA(accA, kq[0][0], kq[0][1]); { const int bb = (b + 4 < b1) ? b + 4 : b1 - 1; IX_LOADK(0, bb); }
                post2(b + 1, accB, IxTagF{});
            }
#pragma unroll 1
            for (; b + 2 <= b1; b += 2) {
                IX_MFMA(accB, kq[1][0], kq[1][1]); { const int bb = (b + 3 < b1) ? b + 3 : b1 - 1; IX_LOADK(1, bb); }
                post2(b, accA, IxTagT{});
                IX_MFMA(accA, kq[0][0], kq[0][1]); { const int bb = (b + 4 < b1) ? b + 4 : b1 - 1; IX_LOADK(0, bb); }
                post2(b + 1, accB, IxTagT{});
            }
            if (b < b1) post2(b, accA, IxTagT{});
          };
          if (zany) run2(IxTagT{}); else run2(IxTagF{});
        }
#undef IX_LOADK
#undef IX_MFMA
        IX_BAR;
        auto select = [&](auto nmTag, int qs, int n) -> bool {
            constexpr int NM = decltype(nmTag)::value;
            const LAS unsigned long long* cd = (const LAS unsigned long long*)(lds + qs * 8192);
            unsigned short* irow = IDX + (t0 + 4 * (qs & 3) + (qs >> 2)) * 256;
            unsigned long long v[NM];
#pragma unroll
            for (int i = 0; i < NM; ++i) v[i] = (lane + 64 * i < n) ? cd[lane + 64 * i] : 0ull;
            asm volatile("" ::: "memory");
            zslot(qs);
            asm volatile("" ::: "memory");
            unsigned long long tau = 1ull;
            if (n > 256) {
                unsigned long long pmask = 0xfffull << 52, pval; int need; unsigned cT;
                {
                    constexpr unsigned ZK = (unsigned)IX_ZBIN << 20, PK = ZK + 0x100000u;
                    int cpz = 0;
#pragma unroll
                    for (int i = 0; i < NM; ++i) { const unsigned hi = (unsigned)(v[i] >> 32); cpz += (hi >= PK) ? 1 : 0; cpz += ((hi >> 20) == (unsigned)IX_ZBIN) ? 4096 : 0; }
                    const int tot = __builtin_amdgcn_readfirstlane((int)wave_sum((float)cpz)); const int cpos = tot & 4095, czer = tot >> 12;
                    if (cpos < 256 && cpos + czer >= 256) { need = 256 - cpos; cT = (unsigned)czer; pval = (unsigned long long)IX_ZBIN << 52; }
                    else {
                        const bool negc = cpos < 256; const int abovec = negc ? cpos + czer : 0;
                        unsigned mh = 0u;
                        if (!negc) {
#pragma unroll
                            for (int i = 0; i < NM; ++i) { const unsigned hi = (unsigned)(v[i] >> 32); mh = hi > mh ? hi : mh; }
                        } else {
#pragma unroll
                            for (int i = 0; i < NM; ++i) { const unsigned hi = (unsigned)(v[i] >> 32); const unsigned c = hi < ZK ? hi : 0u; mh = c > mh ? c : mh; }
                        }
                        const int bmx = (int)wave_max((float)(mh >> 20));
#pragma unroll
                        for (int j = 0; j < 4; ++j) h2[lane + 64 * j] = 0u;
                        asm volatile("" ::: "memory");
                        if (!negc) {
#pragma unroll
                            for (int i = 0; i < NM; ++i) { const unsigned hi = (unsigned)(v[i] >> 32);
                                if (hi >= PK) { const int d = 255 - (bmx - (int)(hi >> 20)); LDS_ADD(h2 + (d < 0 ? 0 : d), 1u); } }
                        } else {
#pragma unroll
                            for (int i = 0; i < NM; ++i) { const unsigned hi = (unsigned)(v[i] >> 32);
                                if (hi < ZK && hi != 0u) { const int d = 255 - (bmx - (int)(hi >> 20)); LDS_ADD(h2 + (d < 0 ? 0 : d), 1u); } }
                        }
                        asm volatile("" ::: "memory");
                        const unsigned want = (unsigned)(256 - abovec);
                        int T0; unsigned above, c2; radix_pick(h2, lane, want, T0, above, c2);
                        if (T0 <= 0) return false;
                        need = (int)want - (int)above; cT = c2; pval = (unsigned long long)(unsigned)(bmx - 255 + T0) << 52;
                    }
                    asm volatile("" ::: "memory");
                }
#pragma unroll 1
                for (int lv = 0; lv < 5 && cT > 16u; ++lv) {
                    const int shift = (lv == 0) ? 44 : (lv == 1) ? 36 : (lv == 2) ? 32 : (lv == 3) ? 8 : 0;
#pragma unroll
                    for (int j = 0; j < 4; ++j) h2[lane + 64 * j] = 0u;
                    asm volatile("" ::: "memory");
#pragma unroll
                    for (int i = 0; i < NM; ++i) if ((v[i] & pmask) == pval) LDS_ADD(h2 + ((unsigned)(v[i] >> shift) & 255u), 1u);
                    asm volatile("" ::: "memory");
                    int T2; unsigned above, c2; radix_pick(h2, lane, (unsigned)need, T2, above, c2);
                    if (T2 < 0) { T2 = 0; }
                    need -= (int)above; cT = c2;
                    pmask |= 255ull << shift; pval |= (unsigned long long)T2 << shift;
                    asm volatile("" ::: "memory");
                }
                { unsigned cm = 0;
#pragma unroll
                  for (int i = 0; i < NM; ++i) cm += ((v[i] & pmask) == pval) ? 1u : 0u;
                  unsigned pb = wave_iscan(cm) - cm;
#pragma unroll
                  for (int i = 0; i < NM; ++i) if ((v[i] & pmask) == pval) { l2[pb] = v[i]; ++pb; } }
                asm volatile("" ::: "memory");
                const unsigned long long mine = (unsigned)lane < cT ? l2[lane] : 0ull;
                const unsigned mlo = (unsigned)mine, mhi = (unsigned)(mine >> 32);
                int rank = 0;
#pragma unroll 1
                for (unsigned j = 0; j < cT; ++j) { const unsigned long long o = ((unsigned long long)(unsigned)__builtin_amdgcn_readlane((int)mhi, (int)j) << 32) | (unsigned)__builtin_amdgcn_readlane((int)mlo, (int)j);
                    rank += (o > mine) ? 1 : 0; }
                const unsigned long long hit = __ballot((unsigned)lane < cT && rank == need - 1);
                const int hl = hit ? (__ffsll((long long)hit) - 1) : 0;
                tau = ((unsigned long long)(unsigned)__builtin_amdgcn_readlane((int)mhi, hl) << 32) | (unsigned)__builtin_amdgcn_readlane((int)mlo, hl);
                asm volatile("" ::: "memory");
            }
            { unsigned ce = 0;
#pragma unroll
              for (int i = 0; i < NM; ++i) ce += (v[i] >= tau) ? 1u : 0u;
              unsigned pb = wave_iscan(ce) - ce;
#pragma unroll
              for (int i = 0; i < NM; ++i) if (v[i] >= tau) { irow[pb] = (unsigned short)(0xffffu - (unsigned)(v[i] & 0xffffull)); ++pb; } }
            return true;
        };
#pragma unroll 1
        for (int qq = 0; qq < 2; ++qq) {
            const int qs = 2 * wave + qq; const int n = __builtin_amdgcn_readfirstlane((int)(qN[qs] >> 3));
            bool ok = !(n > IX_CAP || n < 256);
            if (ok) { if (n <= 512) ok = select(IxN<8>{}, qs, n); else if (n <= 768) ok = select(IxN<12>{}, qs, n); else ok = select(IxN<16>{}, qs, n); }
            else zslot(qs);
            if (!ok && lane == 0) qOvf[qs] = 1;
        }
        zeroed = true;
        if (tid < 16) CNT[t0 + tid] = 256;
        __syncthreads();
        if (tid < 16 && qOvf[tid]) { const unsigned k = LDS_ADD(ovl, 1u); ovl[1 + k] = (unsigned)(t0 + 4 * (tid & 3) + (tid >> 2)); }
    }
    __syncthreads();
    const unsigned novl = __builtin_amdgcn_readfirstlane(ovl[0]);
#pragma unroll 1
    for (unsigned k = 0; k < novl; ++k) { const unsigned tq = __builtin_amdgcn_readfirstlane(ovl[1 + k]); indexer_slow_query(p, lds, (size_t)tq); }
}
#undef LDS_ADD

__device__ __forceinline__ void phase_attn(const P& p, unsigned char* lds) {
    unsigned char* ws = p.ws; const int tid = tid_opaque(), lane = tid & 63, hd = lane & 15, g = lane >> 4;
    const int wave = __builtin_amdgcn_readfirstlane(tid >> 6);
    bf16_t* QP = (bf16_t*)(ws + OFF_QP); const bf16_t* CK = (const bf16_t*)(ws + OFF_CKVN); const bf16_t* RK = (const bf16_t*)(ws + OFF_RK);
    const unsigned short* IDX = (const unsigned short*)(ws + OFF_IDX); const int* CNT = (const int*)(ws + OFF_CNT);
    float* biasT = (float*)lds;
    biasT[tid] = p.rel_bias[tid] * 1.4426950408889634f;
    __syncthreads();
    LAS unsigned char* rows = (LAS unsigned char*)(lds + 2048 + (size_t)wave * 18432);
    LAS bf16_t* rkb = (LAS bf16_t*)(rows + 16384);
    LAS unsigned* info = (LAS unsigned*)(rows + 17408);
    const LAS float* biasL = (const LAS float*)lds;
    for (int t = blockIdx.x * 8 + wave; t < T; t += gridDim.x * 8) {
        if ((((t >> 11) ^ (wave >> 2)) & 1) != 0) __builtin_amdgcn_s_setprio(1); else __builtin_amdgcn_s_setprio(0);
        const int batch = t >> 14, pos = t & (SEQ - 1); const int cnt = __builtin_amdgcn_readfirstlane(CNT[t]);
        const size_t rb = (size_t)batch * SEQ;
        const unsigned lp = (unsigned)(((lane & 31) ^ (lane >> 5)) * 16);
        asm volatile("s_waitcnt lgkmcnt(0)" ::: "memory");
#pragma unroll
        for (int jj = 0; jj < 4; ++jj) {
            const int j = lane + 64 * jj; int id = IDX[(size_t)t * 256 + j]; if (j >= cnt) id = 0;
            const int rel = pos - id; int bucket = rel < 0 ? 0 : rel;
            if (rel >= 16) { bucket = 16 + (int)(__logf((float)rel * 0.0625f) * 7.694373551407805f); bucket = bucket > 31 ? 31 : bucket; }
            info[j] = ((unsigned)((int)rb + id) << 9) | (unsigned)bucket;
        }
        bf16x8 qf[8];
#pragma unroll
        for (int ks = 0; ks < 8; ++ks) qf[ks] = *(const bf16x8*)(QP + (size_t)t * 4096 + hd * 256 + ks * 32 + g * 8);
        f32x4 o[16];
#pragma unroll
        for (int rt = 0; rt < 16; ++rt) o[rt] = (f32x4){0.f, 0.f, 0.f, 0.f};
        float mref = 0.f, lrun = 0.f;
        asm volatile("s_waitcnt lgkmcnt(0)" ::: "memory");
        const int nch = (cnt + 31) >> 5;
        for (int ch = 0; ch < nch; ++ch) {
            asm volatile("s_waitcnt lgkmcnt(0)" ::: "memory");
#pragma unroll
            for (int i = 0; i < 16; ++i) {
                const unsigned off = (info[ch * 32 + 2 * i + (lane >> 5)] & 0xfffffe00u) | (lp ^ (unsigned)(32 * (i & 7)));
                __builtin_amdgcn_global_load_lds((const unsigned*)((const unsigned char*)CK + off), (LAS unsigned*)(rows + i * 1024), 16, 0, 0);
            }
            { const unsigned off = ((info[ch * 32 + (lane >> 1)] >> 4) & 0xffffffe0u) | (unsigned)((lane & 1) * 16);
              __builtin_amdgcn_global_load_lds((const unsigned*)((const unsigned char*)RK + off), (LAS unsigned*)rkb, 16, 0, 0); }
            asm volatile("s_waitcnt vmcnt(0)" ::: "memory");
            f32x4 s0 = (f32x4){0.f, 0.f, 0.f, 0.f}, s1 = (f32x4){0.f, 0.f, 0.f, 0.f};
#pragma unroll
            for (int ks = 0; ks < 8; ++ks) {
                const int pos16 = ((4 * ks + g) ^ hd) * 16;
                const bf16x8 a0 = *(const LAS bf16x8*)(rows + hd * 512 + pos16);
                const bf16x8 a1 = *(const LAS bf16x8*)(rows + (16 + hd) * 512 + pos16);
                s0 = __builtin_amdgcn_mfma_f32_16x16x32_bf16(a0, qf[ks], s0, 0, 0, 0);
                s1 = __builtin_amdgcn_mfma_f32_16x16x32_bf16(a1, qf[ks], s1, 0, 0, 0);
            }
            float x0[4], x1[4];
#pragma unroll
            for (int r = 0; r < 4; ++r) {
                const int sl0 = 4 * g + r, sl1 = 16 + 4 * g + r, j0 = ch * 32 + sl0, j1 = ch * 32 + sl1;
                const unsigned i0 = info[j0], i1 = info[j1];
                const float r0 = bf2f(rkb[sl0 * 16 + hd]), r1 = bf2f(rkb[sl1 * 16 + hd]);
                x0[r] = fmaf(s0[r], r0, biasL[(i0 & 31u) * 16 + hd]);
                x1[r] = fmaf(s1[r], r1, biasL[(i1 & 31u) * 16 + hd]);
            }
            if (cnt < 256) {
#pragma unroll
                for (int r = 0; r < 4; ++r) { if (ch * 32 + 4 * g + r >= cnt) x0[r] = -INFINITY; if (ch * 32 + 16 + 4 * g + r >= cnt) x1[r] = -INFINITY; }
            }
            const float cml = fmaxf(fmaxf(fmaxf(x0[0], x0[1]), fmaxf(x0[2], x0[3])), fmaxf(fmaxf(x1[0], x1[1]), fmaxf(x1[2], x1[3])));
            if (ch == 0 || __ballot(cml > mref + 11.5f)) {
                float cm = fmaxf(cml, __shfl_xor(cml, 16)); cm = fmaxf(cm, __shfl_xor(cm, 32));
                const float mnew = (ch == 0) ? cm : fmaxf(mref, cm);
                if (ch != 0) { const float sc = __builtin_amdgcn_exp2f(mref - mnew); lrun *= sc;
#pragma unroll
                    for (int rt = 0; rt < 16; ++rt) o[rt] *= sc; }
                mref = mnew;
            }
            float ls = 0.f;
#pragma unroll
            for (int r = 0; r < 4; ++r) { x0[r] = __builtin_amdgcn_exp2f(x0[r] - mref); x1[r] = __builtin_amdgcn_exp2f(x1[r] - mref); ls += x0[r] + x1[r]; }
            lrun += ls;
            u32x4 pw; pw.x = pg8::cvt_pk_bf16(x0[0], x0[1]); pw.y = pg8::cvt_pk_bf16(x0[2], x0[3]); pw.z = pg8::cvt_pk_bf16(x1[0], x1[1]); pw.w = pg8::cvt_pk_bf16(x1[2], x1[3]);
            const bf16x8 pf = __builtin_bit_cast(bf16x8, pw);
            const int q = hd >> 2, pp = hd & 3, ksl = 4 * g + q;
            const LAS unsigned char* trb = rows + ksl * 512 + (pp & 1) * 8;
#pragma unroll
            for (int rt = 0; rt < 16; ++rt) {
                const int c16 = ((2 * rt + (pp >> 1)) ^ ksl) * 16;
                const v4i16_t t0 = __builtin_amdgcn_ds_read_tr16_b64_v4i16((LAS v4i16_t*)(trb + c16));
                const v4i16_t t1 = __builtin_amdgcn_ds_read_tr16_b64_v4i16((LAS v4i16_t*)(trb + c16 + 8192));
                bf16x8 af; af[0] = t0[0]; af[1] = t0[1]; af[2] = t0[2]; af[3] = t0[3]; af[4] = t1[0]; af[5] = t1[1]; af[6] = t1[2]; af[7] = t1[3];
                o[rt] = __builtin_amdgcn_mfma_f32_16x16x32_bf16(af, pf, o[rt], 0, 0, 0);
            }
        }
        float ltot = lrun; ltot += __shfl_xor(ltot, 16); ltot += __shfl_xor(ltot, 32);
        const float inv = __builtin_amdgcn_rcpf(ltot);
        bf16_t* op = QP + (size_t)t * 4096 + hd * 256 + 4 * g;
#pragma unroll
        for (int rt = 0; rt < 16; ++rt) { u32x2 w; w.x = pg8::cvt_pk_bf16(o[rt][0] * inv, o[rt][1] * inv); w.y = pg8::cvt_pk_bf16(o[rt][2] * inv, o[rt][3] * inv); *(u32x2*)(op + rt * 16) = w; }
    }
    __builtin_amdgcn_s_setprio(0);
}

__global__ void __launch_bounds__(512, 2) __attribute__((amdgpu_waves_per_eu(2, 2))) k_fwd(P p_arg, int ph_lo, int ph_hi) {
    extern __shared__ __attribute__((aligned(16))) unsigned char smem[];
    const P& p = *(const P*)__builtin_amdgcn_kernarg_segment_ptr(); (void)p_arg;
    unsigned char* lds = smem + 16;
    unsigned char* ws = p.ws;
    XcdBarrier bar;
    const bool multi = (ph_hi - ph_lo) > 1;
    if (multi) {
        if (threadIdx.x == 0) *(uint4*)smem = make_uint4(0u, 0u, 0u, 0u);
        __syncthreads();
        bar = xcd_barrier_post((unsigned*)(ws + OFF_CTL), (volatile LAS unsigned*)smem);
    }
#define PH(i) (ph_lo <= (i) && (i) < ph_hi)
#define SEAM(i) do { if ((i) + 1 < ph_hi) xcd_barrier(bar); else __syncthreads(); } while (0)
    bf16_t *XN = (bf16_t*)(ws + OFF_XN), *QB = (bf16_t*)(ws + OFF_QB), *KB = (bf16_t*)(ws + OFF_KB), *VB = (bf16_t*)(ws + OFF_VB), *TMP = (bf16_t*)(ws + OFF_TMP), *Y = (bf16_t*)(ws + OFF_Y);
    if (PH(0)) { phase_prep(p, lds); SEAM(0); }
    if (PH(1)) { fast_gemm(lds, XN, 1024, (const bf16_t*)(ws + OFF_W0T), 1024, 3072, 1024, D1{ws}); SEAM(1); }
    if (PH(2)) { phase_conv_scan(p, lds); SEAM(2); }
    if (PH(3)) { mlstm_units<false>(p, lds); SEAM(3); }
    if (PH(4)) { GWP f{(const bf16_t*)(ws + OFF_WPT), (const bf16_t*)(ws + OFF_WUB), (bf16_t*)(ws + OFF_W0T)}; sgemm(f, 256); phase_mlstm_scan(p, lds); SEAM(4); }
    if (PH(5)) { mlstm_units<true>(p, lds); SEAM(5); }
    if (PH(6)) { fast_gemm(lds, XN, 1024, (const bf16_t*)(ws + OFF_W0T) + (size_t)3072 * 1024, 1024, 4096, 1024, D2{ws}); SEAM(6); }
    if (PH(7)) { phase_ya_pool(p); SEAM(7); }
    if (PH(8)) { fast_gemm(lds, Y, 2048, (const bf16_t*)(ws + OFF_WO0T), 2048, 1024, 2048, D4{(unsigned char*)p.out, p.x, ws}); SEAM(8); }
    if (PH(10)) { fast_gemm(lds, XN, 1024, (const bf16_t*)(ws + OFF_W1T), 1024, 2816, 1024, D5{ws, p.o_g_q}); SEAM(10); }
    if (PH(11)) { phase_qnorm_ckvnorm(p); SEAM(11); }
    if (PH(12)) { fast_gemm(lds, (const bf16_t*)(ws + OFF_CKVN), 256, (const bf16_t*)(ws + OFF_WUKP), 256, 1024, 256, DK{ws}); __syncthreads(); }
    if (PH(13)) { fast_gemm(lds, TMP, 1024, (const bf16_t*)(ws + OFF_WQF), 128, 4096, 128, DQ{ws}, (size_t)128); phase_indexer(p, lds); SEAM(13); }
    if (PH(14)) { phase_attn(p, lds); SEAM(14); }
    if (PH(15)) { fast_gemm(lds, (const bf16_t*)(ws + OFF_QP), 4096, (const bf16_t*)(ws + OFF_WBD), 1024, 1024, 1024, DO{ws}, (size_t)2048); SEAM(15); }
    if (PH(16)) { fast_gemm(lds, TMP, 1024, (const bf16_t*)(ws + OFF_WO1T), 1024, 1024, 1024, D8{(unsigned char*)p.out}); }
#undef PH
#undef SEAM
}

extern "C" void kernel_launch(void* const* d_in, const int* in_sizes, int n_in, void* d_out, int out_size, void* d_ws, size_t ws_size, hipStream_t stream) {
    static int grid = 0;
    if (grid == 0) {
        if (n_in != 18 || out_size != T * DM || ws_size < WS_END) { fprintf(stderr, "kernel_launch: unexpected shapes (n_in %d out %d ws %zu)\n", n_in, out_size, ws_size); grid = -1; return; }
        if (hipFuncSetAttribute((const void*)k_fwd, hipFuncAttributeMaxDynamicSharedMemorySize, LDS_BYTES) != hipSuccess) { fprintf(stderr, "kernel_launch: hipFuncSetAttribute failed\n"); grid = -1; return; }
        grid = 256;
    }
    if (grid < 0) return;
    (void)hipMemsetAsync((char*)d_ws + OFF_CTL, 0, 16384, stream);
    P p{};
    p.x = (const float*)d_in[0]; p.e_norm = (const float*)d_in[1]; p.e_w_in = (const float*)d_in[2]; p.e_conv = (const float*)d_in[3]; p.e_b_if = (const float*)d_in[4];
    p.e_g_head = (const float*)d_in[5]; p.e_w_pool = (const float*)d_in[6]; p.e_s_pool = (const float*)d_in[7]; p.e_w_out = (const float*)d_in[8];
    p.o_norm = (const float*)d_in[9]; p.o_w_in = (const float*)d_in[10]; p.o_g_kv = (const float*)d_in[11]; p.o_w_uk = (const float*)d_in[12]; p.o_w_uv = (const float*)d_in[13];
    p.o_g_q = (const float*)d_in[14]; p.o_g_k = (const float*)d_in[15]; p.o_w_out = (const float*)d_in[16]; p.rel_bias = (const float*)d_in[17];
    p.out = (float*)d_out; p.ws = (unsigned char*)d_ws;
    hipLaunchKernelGGL(k_fwd, dim3(grid), dim3(512), LDS_BYTES, stream, p, 0, NPH);
}
```
